# Optimizing an MI355X kernel written in HIP

```python
import jax, jax.numpy as jnp
from jax import lax
import numpy as np

D_MODEL = 2048
BATCH = 2
SEQ = 8192
DEPTH = 4

GRID_W = 64
CTX_LEN = 256
HEAD_DIM = 128
N_Q_HEADS = 8
N_KV_HEADS = 2
Q_PER_KV = N_Q_HEADS // N_KV_HEADS
ATTN_W = N_Q_HEADS * HEAD_DIM
KV_W = N_KV_HEADS * HEAD_DIM
WINDOW = 128
BLOCK = 128
ROPE_BASE = 10000.0
ROT_HALF = HEAD_DIM // 2
CONV_W = D_MODEL // 2
CONV_K = 3
MIX_W = ATTN_W + CONV_W
OFF_C = CONV_W
OFF_X = 2 * CONV_W
OFF_Q = 3 * CONV_W
OFF_K = OFF_Q + ATTN_W
OFF_V = OFF_K + KV_W
IN_COLS = OFF_V + KV_W
PEER_HEADS = 8
N_KEYS = 128
N_EXPERTS = N_KEYS * N_KEYS
PEER_TOPK = 16
PEER_DKEY = 256
PEER_HALF = PEER_DKEY // 2
PEER_CHUNK = 128
DEEPNORM_ALPHA = (2.0 * DEPTH) ** 0.25
DEEPNORM_BETA = (8.0 * DEPTH) ** -0.25
LN_EPS = 1e-6

kernel_name = "hymba_conv_swa_peer_dit"


def layer_norm(x):
    xf = x.astype(jnp.float32)
    mu = jnp.mean(xf, axis=-1, keepdims=True)
    var = jnp.mean(jnp.square(xf - mu), axis=-1, keepdims=True)
    return ((xf - mu) * lax.rsqrt(var + LN_EPS)).astype(x.dtype)


def post_norm(x, g, b):
    return layer_norm(x) * g + b


def modulate(x, shift, scale):
    return layer_norm(x) * (1 + scale) + shift


def group_rms(y, gain):
    b_, t, w = y.shape
    yf = y.astype(jnp.float32).reshape(b_, t, w // HEAD_DIM, HEAD_DIM)
    yf = yf * lax.rsqrt(jnp.mean(jnp.square(yf), axis=-1, keepdims=True) + LN_EPS)
    return yf.reshape(b_, t, w).astype(y.dtype) * gain


def axial_rope_tables(n_tokens):
    rows = n_tokens // GRID_W
    row = jnp.broadcast_to(jnp.arange(rows)[:, None], (rows, GRID_W)).reshape(-1)
    col = jnp.broadcast_to(jnp.arange(GRID_W)[None, :], (rows, GRID_W)).reshape(-1)
    inv = ROPE_BASE ** (-jnp.arange(0, ROT_HALF, 2, dtype=jnp.float32) / ROT_HALF)
    ar = row.astype(jnp.float32)[:, None] * inv
    ac = col.astype(jnp.float32)[:, None] * inv
    ang = jnp.concatenate([ar, ar, ac, ac], axis=-1)
    return jnp.cos(ang), jnp.sin(ang)


def apply_rope(x, cos, sin):
    x1, x2, x3, x4 = jnp.split(x, 4, axis=-1)
    rot = jnp.concatenate([-x2, x1, -x4, x3], axis=-1)
    return (x * cos[:, None, :] + rot * sin[:, None, :]).astype(x.dtype)


def short_conv(u, w):
    up = jnp.pad(u, ((0, 0), (1, 1), (0, 0)))
    return up[:, :-2] * w[0] + up[:, 1:-1] * w[1] + up[:, 2:] * w[2]


def sink_softmax(logits, sink):
    full = jnp.concatenate([logits, jnp.broadcast_to(sink, logits.shape[:-1] + (1,))], axis=-1)
    return jax.nn.softmax(full, axis=-1)[..., :-1]


def banded(t):
    b_, s, g, d = t.shape
    nb = s // BLOCK
    tp = jnp.pad(t, ((0, 0), (BLOCK, BLOCK), (0, 0), (0, 0))).reshape(b_, nb + 2, BLOCK, g, d)
    return jnp.concatenate([tp[:, :-2], tp[:, 1:-1], tp[:, 2:]], axis=2)


def latent_attention(q, k, v, kc, vc, sink):
    b_, s = q.shape[0], q.shape[1]
    nb = s // BLOCK
    scale = HEAD_DIM ** -0.5
    qb = q.reshape(b_, nb, BLOCK, N_KV_HEADS, Q_PER_KV, HEAD_DIM)
    kw, vw = banded(k), banded(v)
    s_win = jnp.einsum('bnqgrd,bnkgd->bngrqk', qb, kw).astype(jnp.float32) * scale
    s_ctx = jnp.einsum('bnqgrd,blgd->bngrql', qb, kc).astype(jnp.float32) * scale
    qpos = jnp.arange(nb)[:, None] * BLOCK + jnp.arange(BLOCK)[None, :]
    kpos = (jnp.arange(nb)[:, None] - 1) * BLOCK + jnp.arange(3 * BLOCK)[None, :]
    valid = ((jnp.abs(qpos[:, :, None] - kpos[:, None, :]) <= WINDOW)
             & (kpos[:, None, :] >= 0) & (kpos[:, None, :] < s))
    s_win = jnp.where(valid[None, :, None, None], s_win, -jnp.inf)
    sink_b = sink.astype(jnp.float32).reshape(1, 1, N_KV_HEADS, Q_PER_KV, 1, 1)
    p = sink_softmax(jnp.concatenate([s_win, s_ctx], axis=-1), sink_b).astype(v.dtype)
    out = (jnp.einsum('bngrqk,bnkgd->bnqgrd', p[..., :3 * BLOCK], vw)
           + jnp.einsum('bngrql,blgd->bnqgrd', p[..., 3 * BLOCK:], vc))
    return out.reshape(b_, s, ATTN_W)


def context_attention(qc, kc, vc, sink):
    b_, l = qc.shape[0], qc.shape[1]
    qg = qc.reshape(b_, l, N_KV_HEADS, Q_PER_KV, HEAD_DIM)
    s = jnp.einsum('blgrd,bmgd->bgrlm', qg, kc).astype(jnp.float32) * (HEAD_DIM ** -0.5)
    p = sink_softmax(s, sink.astype(jnp.float32).reshape(1, N_KV_HEADS, Q_PER_KV, 1, 1)).astype(vc.dtype)
    return jnp.einsum('bgrlm,bmgd->blgrd', p, vc).reshape(b_, l, ATTN_W)


def split_proj(p):
    return jnp.split(p, [OFF_C, OFF_X, OFF_Q, OFF_K, OFF_V], axis=-1)


def merge_groups(y_attn, y_conv, g_attn, g_conv, w_out):
    return jnp.concatenate([group_rms(y_attn, g_attn), group_rms(y_conv, g_conv)], axis=-1) @ w_out


def mixer(h, hc, w_in, conv_w, sink, g_attn, g_conv, w_out, cos, sin, ctx_out):
    b_, s, _ = h.shape
    l = hc.shape[1]
    gb, gc, xt, q, k, v = split_proj(h @ w_in)
    y_conv = gb * short_conv(gc * xt, conv_w)
    q = apply_rope(q.reshape(b_, s, N_Q_HEADS, HEAD_DIM), cos, sin)
    k = apply_rope(k.reshape(b_, s, N_KV_HEADS, HEAD_DIM), cos, sin)
    v = v.reshape(b_, s, N_KV_HEADS, HEAD_DIM)
    if ctx_out:
        gbc, gcc, xtc, qc, kc, vc = split_proj(hc @ w_in)
    else:
        kc, vc = jnp.split(hc @ w_in[:, OFF_K:], 2, axis=-1)
    kc = kc.reshape(b_, l, N_KV_HEADS, HEAD_DIM)
    vc = vc.reshape(b_, l, N_KV_HEADS, HEAD_DIM)
    y_attn = latent_attention(q, k, v, kc, vc, sink)
    y = merge_groups(y_attn, y_conv, g_attn, g_conv, w_out)
    if not ctx_out:
        return y, None
    yc_conv = gbc * short_conv(gcc * xtc, conv_w)
    yc_attn = context_attention(qc.reshape(b_, l, N_Q_HEADS, HEAD_DIM), kc, vc, sink)
    yc = merge_groups(yc_attn, yc_conv, g_attn, g_conv, w_out)
    return y, yc


def peer(h, w_q, sub_keys, u_tab, v_tab):
    b_, t, d = h.shape
    q = (h @ w_q).reshape(b_, t, PEER_HEADS, 2, PEER_HALF)
    s = jnp.einsum('bthpd,hpkd->bthpk', q, sub_keys).astype(jnp.float32)
    s1, i1 = lax.top_k(s[..., 0, :], PEER_TOPK)
    s2, i2 = lax.top_k(s[..., 1, :], PEER_TOPK)
    cand_s = (s1[..., :, None] + s2[..., None, :]).reshape(b_, t, PEER_HEADS, PEER_TOPK * PEER_TOPK)
    cand_i = (i1[..., :, None] * N_KEYS + i2[..., None, :]).reshape(b_, t, PEER_HEADS, PEER_TOPK * PEER_TOPK)
    top_s, top_pos = lax.top_k(cand_s, PEER_TOPK)
    idx = jnp.take_along_axis(cand_i, top_pos, axis=-1)
    gate = jax.nn.softmax(top_s, axis=-1).astype(h.dtype)
    n = (b_ * t) // PEER_CHUNK

    def experts(args):
        hb, ib, gb = args
        a = jax.nn.gelu(jnp.einsum('chkd,cd->chk', u_tab[ib], hb), approximate=False)
        return jnp.einsum('chk,chkd->cd', gb * a, v_tab[ib])

    out = lax.map(experts, (h.reshape(n, PEER_CHUNK, d),
                            idx.reshape(n, PEER_CHUNK, PEER_HEADS, PEER_TOPK),
                            gate.reshape(n, PEER_CHUNK, PEER_HEADS, PEER_TOPK)))
    return out.reshape(b_, t, d)


def setup_inputs(seed: int = 0) -> dict:
    key = jax.random.key(seed)
    ks = jax.random.split(key, 22)
    f32 = jnp.float32

    def nrm(k, shape, std):
        return jax.random.normal(k, shape, f32) * std

    return {
        "x": nrm(ks[0], (BATCH, SEQ, D_MODEL), 1.0),
        "c": nrm(ks[1], (BATCH, D_MODEL), 1.0),
        "ctx": nrm(ks[2], (BATCH, CTX_LEN, D_MODEL), 1.0),
        "c_ctx": nrm(ks[3], (D_MODEL,), 1.0),
        "w_ada": nrm(ks[4], (DEPTH, D_MODEL, 6 * D_MODEL), D_MODEL ** -0.5),
        "b_ada": nrm(ks[5], (DEPTH, 6 * D_MODEL), 0.02),
        "w_in": nrm(ks[6], (DEPTH, D_MODEL, IN_COLS), D_MODEL ** -0.5),
        "conv_w": nrm(ks[7], (DEPTH, CONV_K, CONV_W), CONV_K ** -0.5),
        "attn_sink": nrm(ks[8], (DEPTH, N_Q_HEADS), 0.5),
        "g_attn": 1.0 + nrm(ks[9], (DEPTH, ATTN_W), 0.02),
        "g_conv": 1.0 + nrm(ks[10], (DEPTH, CONV_W), 0.02),
        "w_out": nrm(ks[11], (DEPTH, MIX_W, D_MODEL), DEEPNORM_BETA * MIX_W ** -0.5),
        "ln1_g": 1.0 + nrm(ks[12], (DEPTH, D_MODEL), 0.02),
        "ln1_b": nrm(ks[13], (DEPTH, D_MODEL), 0.02),
        "peer_wq": nrm(ks[14], (DEPTH, D_MODEL, PEER_HEADS * PEER_DKEY), D_MODEL ** -0.5),
        "peer_keys": nrm(ks[15], (DEPTH, PEER_HEADS, 2, N_KEYS, PEER_HALF), PEER_HALF ** -0.5),
        "peer_u": nrm(ks[16], (DEPTH, N_EXPERTS, D_MODEL), D_MODEL ** -0.5),
        "peer_v": nrm(ks[17], (DEPTH, N_EXPERTS, D_MODEL), DEEPNORM_BETA),
        "ln2_g": 1.0 + nrm(ks[18], (DEPTH, D_MODEL), 0.02),
        "ln2_b": nrm(ks[19], (DEPTH, D_MODEL), 0.02),
    }


def reference(x, c, ctx, c_ctx, w_ada, b_ada, w_in, conv_w, attn_sink, g_attn, g_conv, w_out,
              ln1_g, ln1_b, peer_wq, peer_keys, peer_u, peer_v, ln2_g, ln2_b):
    s = x.shape[1]
    cos, sin = axial_rope_tables(s)
    cond = jax.nn.silu(c)
    cond_ctx = jax.nn.silu(c_ctx)
    xc = ctx
    for layer in range(DEPTH):
        ctx_out = layer < DEPTH - 1
        mod = (cond @ w_ada[layer] + b_ada[layer])[:, None, :]
        mod_c = cond_ctx @ w_ada[layer] + b_ada[layer]
        sh1, sc1, ga1, sh2, sc2, ga2 = jnp.split(mod, 6, axis=-1)
        sh1c, sc1c, ga1c, sh2c, sc2c, ga2c = jnp.split(mod_c, 6, axis=-1)
        h = modulate(x, sh1, sc1)
        hc = modulate(xc, sh1c, sc1c)
        y, yc = mixer(h, hc, w_in[layer], conv_w[layer], attn_sink[layer], g_attn[layer],
                      g_conv[layer], w_out[layer], cos, sin, ctx_out)
        x = post_norm(DEEPNORM_ALPHA * x + ga1 * y, ln1_g[layer], ln1_b[layer])
        h = modulate(x, sh2, sc2)
        if ctx_out:
            xc = post_norm(DEEPNORM_ALPHA * xc + ga1c * yc, ln1_g[layer], ln1_b[layer])
            hc = modulate(xc, sh2c, sc2c)
            y_all = peer(jnp.concatenate([h, hc], axis=1), peer_wq[layer], peer_keys[layer],
                         peer_u[layer], peer_v[layer])
            y, yc = y_all[:, :s], y_all[:, s:]
            xc = post_norm(DEEPNORM_ALPHA * xc + ga2c * yc, ln2_g[layer], ln2_b[layer])
        else:
            y = peer(h, peer_wq[layer], peer_keys[layer], peer_u[layer], peer_v[layer])
        x = post_norm(DEEPNORM_ALPHA * x + ga2 * y, ln2_g[layer], ln2_b[layer])
    return x
```

```cpp
#include <hip/hip_runtime.h>
#include <cstdio>
#include <cstdint>

#ifndef MK_N_LAUNCHES
#define MK_N_LAUNCHES 1
#endif

#define LAS __attribute__((address_space(3)))
typedef unsigned short bf16_t;
typedef short bf16x8 __attribute__((ext_vector_type(8)));
typedef short s16x4 __attribute__((ext_vector_type(4)));
typedef float f32x2 __attribute__((ext_vector_type(2)));
typedef float f32x4 __attribute__((ext_vector_type(4)));
typedef float f32x16 __attribute__((ext_vector_type(16)));
typedef unsigned u32x2 __attribute__((ext_vector_type(2)));
typedef unsigned u32x4 __attribute__((ext_vector_type(4)));
typedef __bf16 bf16x2_t __attribute__((ext_vector_type(2)));

constexpr int D = 2048, NB = 2, SEQ = 8192, CTXL = 256, NLAYER = 4;
constexpr int TL = NB * SEQ, TC = NB * CTXL, TT = TL + TC;
constexpr int INC = 4608, OFF_C = 1024, OFF_X = 2048, OFF_Q = 3072, OFF_K = 4096, OFF_V = 4352;
constexpr int NEXP = 16384;
constexpr float LN_EPS = 1e-6f;
constexpr float DN_ALPHA = 1.681792830507429f;
constexpr float QSCALE = 0.08838834764831845f * 1.4426950408889634f;
constexpr float LOG2E = 1.4426950408889634f;

constexpr size_t MiB = 1u << 20;
constexpr size_t WS_CTL = 0, CTL_ZERO_BYTES = 1 * MiB;
constexpr size_t WS_MODS = 1 * MiB;
constexpr size_t WS_ROPE = 2 * MiB;
constexpr size_t WS_KBD = 3 * MiB;
constexpr size_t WS_WQR = 8 * MiB;
constexpr size_t WS_WINT = 40 * MiB;
constexpr size_t WS_WOUTT = 112 * MiB;
constexpr size_t WS_WEFFT = 144 * MiB;
constexpr size_t WS_X = 176 * MiB;
constexpr size_t WS_H = 308 * MiB;
constexpr size_t WS_PROJ = 374 * MiB;
constexpr size_t WS_MIX = 523 * MiB;
constexpr size_t WS_SC = 589 * MiB;
constexpr size_t WS_UT = 721 * MiB;
constexpr size_t WS_VT = 977 * MiB;
constexpr size_t WS_END = 1233 * MiB;

constexpr int CW_BAR = 4096;

namespace pg8 {
constexpr int BM = 256, BK = 64, HALF = 128, HTB = HALF * BK * 2, STAGE_BYTES = 8 * HTB, NXCD = 8, WGM = 8;
__host__ __device__ __forceinline__ int lds_byte(int r, int c) { const int st = (r >> 4) * 2 + (c >> 5), rr = r & 15, cc = c & 31, ob = rr * 64 + cc * 2; return st * 1024 + (ob ^ (((ob >> 9) & 1) << 5)); }
__host__ __device__ __forceinline__ void stage_rc(int b, int& R, int& C) { const int st = b / 1024, sb = b % 1024, swz = sb ^ (((sb >> 9) & 1) << 5); R = (st >> 1) * 16 + swz / 64; C = (st & 1) * 32 + (swz % 64) / 2; }
__host__ __device__ __forceinline__ int perm32(int rho) { const int n = rho >> 4, i = rho & 15; return 8 * (i >> 2) + 4 * n + (i & 3); }

struct Unit { int pm, pn; };
struct Gemm { const bf16_t* A; const bf16_t* Bt; int M, N, K; };

struct StaticOrder {
    int nM, nN, nwg, G, c;
    __host__ __device__ void init(int M, int N, int G_, int c_) { nM = M / BM; nN = N / BM; nwg = nM * nN; G = G_; c = c_; }
    __host__ __device__ bool next(int i, Unit& u) const {
        const long L = (long)i * G + c; if (L >= nwg) return false;
        int wgid = (int)L; { const int q = nwg / NXCD, r = nwg % NXCD, xcd = wgid % NXCD, off = wgid / NXCD; wgid = (xcd < r ? xcd * (q + 1) : r * (q + 1) + (xcd - r) * q) + off; }
        const int nig = WGM * nN, gid = wgid / nig, fm = gid * WGM, gsz = (nM - fm) < WGM ? (nM - fm) : WGM;
        u.pm = fm + ((wgid % nig) % gsz); u.pn = (wgid % nig) / gsz; return true;
    }
    __device__ __forceinline__ int btile(const Unit& u) const { return u.pn; }
    __device__ __forceinline__ void a_ready(const Unit&) const {}
    __device__ __forceinline__ void done(const Unit&) const {}
};
struct BatchOrder {
    int G, c;
    __device__ bool next(int i, Unit& u) const { const int L = i * G + c; if (L >= 256) return false; u.pm = L >> 3; u.pn = L & 7; return true; }
    __device__ __forceinline__ int btile(const Unit& u) const { return u.pm * 8 + u.pn; }
    __device__ __forceinline__ void a_ready(const Unit&) const {}
    __device__ __forceinline__ void done(const Unit&) const {}
};

__device__ __forceinline__ unsigned cvt_pk_bf16(float lo, float hi) { f32x2 x = {lo, hi}; bf16x2_t y = __builtin_convertvector(x, bf16x2_t); return __builtin_bit_cast(unsigned, y); }

struct EpiBf16 {
    static constexpr bool PERM = true;
    bf16_t* O; int ldc;
    __device__ __forceinline__ void operator()(const f32x4 (&acc)[2][2][4][2], const Unit& u, int wr, int wc, int fr, int fq) const {
        const int row0 = u.pm * BM + wr * 64 + fr, col0 = u.pn * BM + wc * 32 + 8 * fq;
#pragma unroll
        for (int ai = 0; ai < 2; ++ai)
#pragma unroll
            for (int m = 0; m < 4; ++m) { bf16_t* rowp = O + (size_t)(row0 + ai * HALF + m * 16) * ldc + col0;
#pragma unroll
                for (int bj = 0; bj < 2; ++bj) { const f32x4 v0 = acc[ai][bj][m][0], v1 = acc[ai][bj][m][1];
                    u32x4 w; w.x = cvt_pk_bf16(v0[0], v0[1]); w.y = cvt_pk_bf16(v0[2], v0[3]); w.z = cvt_pk_bf16(v1[0], v1[1]); w.w = cvt_pk_bf16(v1[2], v1[3]);
                    *(u32x4*)(rowp + bj * HALF) = w; } }
    }
};
struct EpiF32 {
    static constexpr bool PERM = false;
    float* C; int ldc;
    __device__ __forceinline__ void operator()(const f32x4 (&acc)[2][2][4][2], const Unit& u, int wr, int wc, int fr, int fq) const {
        const int row0 = u.pm * BM + wr * 64 + fr, col0 = u.pn * BM + wc * 32 + 4 * fq;
#pragma unroll
        for (int ai = 0; ai < 2; ++ai)
#pragma unroll
            for (int m = 0; m < 4; ++m) { float* rowp = C + (size_t)(row0 + ai * HALF + m * 16) * ldc + col0;
#pragma unroll
                for (int bj = 0; bj < 2; ++bj)
#pragma unroll
                    for (int n = 0; n < 2; ++n) *(f32x4*)(rowp + bj * HALF + n * 16) = acc[ai][bj][m][n]; }
    }
};
struct EpiResid {
    static constexpr bool PERM = false;
    const float* xin_lat; const float* xin_ctx;
    float* xout; const float* gate;
    __device__ __forceinline__ void operator()(const f32x4 (&acc)[2][2][4][2], const Unit& u, int wr, int wc, int fr, int fq) const {
        const int rt = u.pm * BM;
        const int mr = rt < TL ? rt / SEQ : 2;
        const float* xin = rt < TL ? xin_lat + (size_t)rt * D : xin_ctx + (size_t)(rt - TL) * D;
        float* xo = xout + (size_t)rt * D;
        const int row0 = wr * 64 + fr, col0 = u.pn * BM + wc * 32 + 4 * fq;
        f32x4 gv[2][2];
#pragma unroll
        for (int bj = 0; bj < 2; ++bj)
#pragma unroll
            for (int n = 0; n < 2; ++n) gv[bj][n] = *(const f32x4*)(gate + (size_t)mr * 12288 + col0 + bj * HALF + n * 16);
#pragma unroll
        for (int ai = 0; ai < 2; ++ai)
#pragma unroll
            for (int m = 0; m < 4; ++m) { const size_t ro = (size_t)(row0 + ai * HALF + m * 16) * D + col0;
#pragma unroll
                for (int bj = 0; bj < 2; ++bj)
#pragma unroll
                    for (int n = 0; n < 2; ++n) { const f32x4 xv = *(const f32x4*)(xin + ro + bj * HALF + n * 16);
                        *(f32x4*)(xo + ro + bj * HALF + n * 16) = xv * DN_ALPHA + gv[bj][n] * acc[ai][bj][m][n]; } }
    }
};

template <class Epi, class Sched, bool ALIGN_EPI = false, bool SP2 = false>
__device__ __forceinline__ void gemm_phase(LAS unsigned char* lds, const Gemm g, const Sched& S, const Epi& E) {
    int tid = threadIdx.x; asm volatile("" : "+v"(tid));
    const int wid = __builtin_amdgcn_readfirstlane(tid >> 6), lane = tid & 63, wr = wid >> 2, wc = wid & 3, fr = lane & 15, fq = lane >> 4;
    const int K = g.K, nt = K / BK;
    unsigned voffA[2], voffB[2];
#pragma unroll
    for (int i = 0; i < 2; ++i) { int R, C; stage_rc(tid * 16 + i * 8192, R, C); const int Rb = Epi::PERM ? ((R & ~31) + perm32(R & 31)) : R;
        voffA[i] = (unsigned)(R * K + C) * 2u; voffB[i] = (unsigned)(Rb * K + C) * 2u; }
    const size_t kstep = (size_t)(BK * 2);
    const size_t hstep = (size_t)HALF * K * 2;
    const size_t tstep = 2 * hstep;
    const unsigned ldsw = (unsigned)wid * 1024u;
    const int aoff = lds_byte(wr * 64 + fr, fq * 8), boff = lds_byte(wc * 32 + fr, fq * 8);
#define PG8_SA(b, h) (((b) * 2 + (h)) * HTB)
#define PG8_SB(b, h) ((4 + (b) * 2 + (h)) * HTB)
#define PG8_STAGE(bufoff, gbase, voff) do { _Pragma("unroll") for (int _i = 0; _i < 2; ++_i) \
        __builtin_amdgcn_global_load_lds((const unsigned*)((const char*)(gbase) + (voff)[_i]), (LAS unsigned*)(lds + (bufoff) + ldsw + _i * 8192), 16, 0, 0); } while (0)
#define PG8_LDA(dst, b, h) do { _Pragma("unroll") for (int m = 0; m < 4; ++m) _Pragma("unroll") for (int k = 0; k < 2; ++k) dst[m][k] = *(const LAS bf16x8*)(lds + PG8_SA(b, h) + aoff + m * 2048 + k * 1024); } while (0)
#define PG8_LDB(dst, b, h) do { _Pragma("unroll") for (int n = 0; n < 2; ++n) _Pragma("unroll") for (int k = 0; k < 2; ++k) dst[n][k] = *(const LAS bf16x8*)(lds + PG8_SB(b, h) + boff + n * 2048 + k * 1024); } while (0)
#define PG8_MMA(ai, bj, At, Bt) do { __builtin_amdgcn_s_setprio(1); _Pragma("unroll") for (int m = 0; m < 4; ++m) _Pragma("unroll") for (int n = 0; n < 2; ++n) _Pragma("unroll") for (int k = 0; k < 2; ++k) \
        acc[ai][bj][m][n] = __builtin_amdgcn_mfma_f32_16x16x32_bf16(Bt[n][k], At[m][k], acc[ai][bj][m][n], 0, 0, 0); __builtin_amdgcn_s_setprio(0); } while (0)
#define PG8_WAIT_V(n) asm volatile("s_waitcnt vmcnt(" #n ")" ::: "memory")
#define PG8_WAIT_L(n) asm volatile("s_waitcnt lgkmcnt(" #n ")" ::: "memory")
#define PG8_BAR __builtin_amdgcn_s_barrier()
#define PG8_SCHED __builtin_amdgcn_sched_barrier(0)
    Unit cur, nxt; int ui = 0;
    if (!S.next(0, cur)) return;
    f32x4 acc[2][2][4][2];
#pragma unroll
    for (int a = 0; a < 2; ++a)
#pragma unroll
        for (int b = 0; b < 2; ++b)
#pragma unroll
            for (int m = 0; m < 4; ++m)
#pragma unroll
                for (int n = 0; n < 2; ++n) acc[a][b][m][n] = (f32x4){0.f, 0.f, 0.f, 0.f};
    bf16x8 At[4][2], B0[2][2], B1[2][2];
    const char* cA = (const char*)g.A + (size_t)cur.pm * tstep; const char* cB = (const char*)g.Bt + (size_t)S.btile(cur) * tstep;
    S.a_ready(cur);
    if constexpr (SP2) {
        PG8_STAGE(PG8_SB(0, 0), cB, voffB); PG8_STAGE(PG8_SB(0, 1), cB + hstep, voffB); PG8_STAGE(PG8_SA(0, 0), cA, voffA); PG8_STAGE(PG8_SA(0, 1), cA + hstep, voffA);
        if (wr == 1) PG8_BAR;
        PG8_WAIT_V(2); PG8_BAR;
        PG8_STAGE(PG8_SB(1, 0), cB + kstep, voffB); PG8_STAGE(PG8_SA(1, 0), cA + kstep, voffA); PG8_STAGE(PG8_SB(1, 1), cB + hstep + kstep, voffB);
        PG8_WAIT_V(6); PG8_BAR;
    } else {
        PG8_STAGE(PG8_SB(0, 0), cB, voffB); PG8_STAGE(PG8_SA(0, 0), cA, voffA); PG8_STAGE(PG8_SB(0, 1), cB + hstep, voffB); PG8_STAGE(PG8_SA(0, 1), cA + hstep, voffA);
        if (wr == 1) PG8_BAR;
        PG8_WAIT_V(4); PG8_BAR;
        PG8_STAGE(PG8_SB(1, 0), cB + kstep, voffB); PG8_STAGE(PG8_SA(1, 0), cA + kstep, voffA); PG8_STAGE(PG8_SB(1, 1), cB + hstep + kstep, voffB);
        PG8_WAIT_V(6); PG8_BAR;
    }
    for (;;) {
        const bool has_next = S.next(ui + 1, nxt);
        const char* nA = has_next ? (const char*)g.A + (size_t)nxt.pm * tstep : cA; const char* nB = has_next ? (const char*)g.Bt + (size_t)S.btile(nxt) * tstep : cB;
        for (int t = 0; t < nt; t += 2) {
            const bool last = (t == nt - 2);
            const char* a1 = cA + (size_t)(t + 1) * kstep;
            const char* a2 = last ? nA : cA + (size_t)(t + 2) * kstep; const char* b2 = last ? nB : cB + (size_t)(t + 2) * kstep;
            const char* a3 = a2 + kstep; const char* b3 = b2 + kstep;
            if (last && has_next) S.a_ready(nxt);
            if constexpr (SP2) {
            PG8_LDB(B0, 0, 0); PG8_LDB(B1, 0, 1); PG8_SCHED; PG8_LDA(At, 0, 0); PG8_STAGE(PG8_SA(1, 1), a1 + hstep, voffA);
            PG8_WAIT_V(8); PG8_WAIT_L(0); PG8_BAR; PG8_MMA(0, 0, At, B0); PG8_MMA(0, 1, At, B1); PG8_BAR; PG8_SCHED;
            PG8_LDA(At, 0, 1); PG8_STAGE(PG8_SB(0, 0), b2, voffB); PG8_STAGE(PG8_SB(0, 1), b2 + hstep, voffB); PG8_STAGE(PG8_SA(0, 0), a2, voffA);
            PG8_WAIT_V(8); PG8_WAIT_L(0); PG8_BAR; PG8_MMA(1, 0, At, B0); PG8_MMA(1, 1, At, B1); PG8_BAR; PG8_SCHED;
            PG8_LDB(B0, 1, 0); PG8_LDB(B1, 1, 1); PG8_SCHED; PG8_LDA(At, 1, 0); PG8_STAGE(PG8_SA(0, 1), a2 + hstep, voffA);
            PG8_WAIT_V(8); PG8_WAIT_L(0); PG8_BAR; PG8_MMA(0, 0, At, B0); PG8_MMA(0, 1, At, B1); PG8_BAR; PG8_SCHED;
            PG8_LDA(At, 1, 1); PG8_STAGE(PG8_SB(1, 0), b3, voffB); PG8_STAGE(PG8_SB(1, 1), b3 + hstep, voffB); PG8_STAGE(PG8_SA(1, 0), a3, voffA);
            PG8_WAIT_V(8); PG8_WAIT_L(0); PG8_BAR; PG8_MMA(1, 0, At, B0); PG8_MMA(1, 1, At, B1); PG8_BAR; PG8_SCHED;
            } else {
            PG8_LDB(B0, 0, 0); PG8_SCHED; PG8_LDA(At, 0, 0); PG8_STAGE(PG8_SA(1, 1), a1 + hstep, voffA);
            PG8_WAIT_L(8); PG8_BAR; PG8_WAIT_L(0); PG8_MMA(0, 0, At, B0); PG8_BAR; PG8_SCHED;
            PG8_LDB(B1, 0, 1); PG8_STAGE(PG8_SB(0, 0), b2, voffB);
            PG8_BAR; PG8_WAIT_L(0); PG8_MMA(0, 1, At, B1); PG8_BAR;
            PG8_LDA(At, 0, 1); PG8_STAGE(PG8_SA(0, 0), a2, voffA);
            PG8_BAR; PG8_WAIT_L(0); PG8_MMA(1, 0, At, B0); PG8_BAR; PG8_SCHED;
            PG8_STAGE(PG8_SB(0, 1), b2 + hstep, voffB);
            PG8_WAIT_V(6); PG8_BAR; PG8_MMA(1, 1, At, B1); PG8_BAR;
            PG8_LDB(B0, 1, 0); PG8_SCHED; PG8_LDA(At, 1, 0); PG8_STAGE(PG8_SA(0, 1), a2 + hstep, voffA);
            PG8_WAIT_L(8); PG8_BAR; PG8_WAIT_L(0); PG8_MMA(0, 0, At, B0); PG8_BAR; PG8_SCHED;
            PG8_LDB(B1, 1, 1); PG8_STAGE(PG8_SB(1, 0), b3, voffB);
            PG8_BAR; PG8_WAIT_L(0); PG8_MMA(0, 1, At, B1); PG8_BAR;
            PG8_LDA(At, 1, 1); PG8_STAGE(PG8_SA(1, 0), a3, voffA);
            PG8_BAR; PG8_WAIT_L(0); PG8_MMA(1, 0, At, B0); PG8_BAR; PG8_SCHED;
            PG8_STAGE(PG8_SB(1, 1), b3 + hstep, voffB);
            PG8_WAIT_V(6); PG8_BAR; PG8_MMA(1, 1, At, B1); PG8_BAR;
            }
        }
        if constexpr (ALIGN_EPI) { if (wr == 0) PG8_BAR; }
        E(acc, cur, wr, wc, fr, fq); S.done(cur);
        if (!has_next) break;
#pragma unroll
        for (int a = 0; a < 2; ++a)
#pragma unroll
            for (int b = 0; b < 2; ++b)
#pragma unroll
                for (int m = 0; m < 4; ++m)
#pragma unroll
                    for (int n = 0; n < 2; ++n) acc[a][b][m][n] = (f32x4){0.f, 0.f, 0.f, 0.f};
        cur = nxt; cA = nA; cB = nB; ++ui;
        if constexpr (ALIGN_EPI) { if (wr == 1) PG8_BAR; }
    }
    PG8_WAIT_V(0);
    if constexpr (!ALIGN_EPI) { if (wr == 0) PG8_BAR; }
    PG8_BAR;
#undef PG8_SA
#undef PG8_SB
#undef PG8_STAGE
#undef PG8_LDA
#undef PG8_LDB
#undef PG8_MMA
#undef PG8_WAIT_V
#undef PG8_WAIT_L
#undef PG8_BAR
#undef PG8_SCHED
}
}

#define XB_TMO      128
#define XB_XCNT(j)  (256  + 64 * (j))
#define XB_XSUB(j)  (1280 + 64 * (j))
#define XB_XGEN(j)  (2304 + 64 * (j))
#define XB_TOP      3328
#define XB_TOPGEN   3392
#define XCD_BAR_WORDS 3456
#define XB_SPIN_CAP (1u << 18)

__device__ __forceinline__ unsigned xb_ld(unsigned* p)              { return __hip_atomic_load(p, __ATOMIC_RELAXED, __HIP_MEMORY_SCOPE_AGENT); }
__device__ __forceinline__ unsigned xb_add(unsigned* p, unsigned v) { return __hip_atomic_fetch_add(p, v, __ATOMIC_RELAXED, __HIP_MEMORY_SCOPE_AGENT); }
__device__ __forceinline__ unsigned xb_xcc_id() { return (unsigned)__builtin_amdgcn_s_getreg((3 << 11) | 20) & 0xFu; }
#define XB_SPIN(cond, bar) do { unsigned _sp = 0; while (cond) { __builtin_amdgcn_s_sleep(1); \
    if ((++_sp & 255u) == 0u) { if (xb_ld(&(bar)[XB_TMO])) break; if (_sp > XB_SPIN_CAP) { atomicAdd(&(bar)[XB_TMO], 1u); break; } } } } while (0)

struct XcdBarrier { unsigned* bar; unsigned x; volatile LAS unsigned* st; };

__device__ __forceinline__ XcdBarrier xcd_barrier_post(unsigned* bar, volatile LAS unsigned* st) {
    XcdBarrier b; b.bar = bar; b.x = xb_xcc_id(); b.st = st;
    if (threadIdx.x == 0) (void)xb_add(&bar[XB_XCNT(b.x)], 1u);
    return b;
}
__device__ __forceinline__ void xcd_barrier_complete(unsigned* bar, unsigned x, unsigned& nloc, unsigned& nx) {
    const unsigned G = gridDim.x * gridDim.y * gridDim.z;
    unsigned sum, cnt, mine, sp = 0u;
    for (;;) {
        sum = 0u; cnt = 0u; mine = 0u;
#pragma unroll
        for (unsigned j = 0; j < 16; ++j) { const unsigned c = xb_ld(&bar[XB_XCNT(j)]); sum += c; cnt += (c > 0u) ? 1u : 0u; mine = (j == x) ? c : mine; }
        if (sum == G) break;
        __builtin_amdgcn_s_sleep(1);
        if ((++sp & 255u) == 0u) { if (xb_ld(&bar[XB_TMO])) break; if (sp > XB_SPIN_CAP) { atomicAdd(&bar[XB_TMO], 1u); break; } }
    }
    nloc = mine > 0u ? mine : 1u; nx = cnt > 0u ? cnt : 1u;
}
__device__ __forceinline__ void xcd_barrier(const XcdBarrier& b) {
    asm volatile("s_waitcnt vmcnt(0)" ::: "memory");
    __syncthreads();
    if (threadIdx.x == 0) {
        unsigned* bar = b.bar;
        __builtin_amdgcn_s_waitcnt(0);
        unsigned nloc = b.st[0], nx = b.st[1];
        if (nloc == 0u) { xcd_barrier_complete(bar, b.x, nloc, nx); b.st[0] = nloc; b.st[1] = nx; }
        const unsigned old = xb_add(&bar[XB_XSUB(b.x)], 1u);
        const unsigned gen = old / nloc;
        if (old + 1u == (gen + 1u) * nloc) {
            __builtin_amdgcn_fence(__ATOMIC_RELEASE, "agent");
            asm volatile("s_waitcnt vmcnt(0)" ::: "memory");
            const unsigned og = xb_add(&bar[XB_TOP], 1u);
            const unsigned tg = og / nx;
            if (og + 1u == (tg + 1u) * nx) xb_add(&bar[XB_TOPGEN], 1u);
            else XB_SPIN(xb_ld(&bar[XB_TOPGEN]) == tg, bar);
            __builtin_amdgcn_fence(__ATOMIC_ACQUIRE, "agent");
            xb_add(&bar[XB_XGEN(b.x)], 1u);
            asm volatile("s_waitcnt vmcnt(0)" ::: "memory");
        } else {
            XB_SPIN(xb_ld(&bar[XB_XGEN(b.x)]) == gen, bar);
            __builtin_amdgcn_fence(__ATOMIC_ACQUIRE, "agent");
            asm volatile("s_waitcnt vmcnt(0)" ::: "memory");
        }
    }
    __syncthreads();
}

constexpr int NWAVES = 8;
constexpr int RING_BYTES = 131072;
constexpr int LDSCTL_OFF = RING_BYTES, MISC_OFF = LDSCTL_OFF + 320;
constexpr int LDS_BYTES = 147456;
constexpr int NPHASE = 2 + 6 * NLAYER;

#define LDS_WAIT() asm volatile("s_waitcnt lgkmcnt(0)" ::: "memory")

struct Args { const float* in[20]; float* out; unsigned char* ws; int ph_lo, ph_hi, li, pad; };

struct Frame {
    LAS unsigned char* lds;
    int tid, lane, wave, G, gw, NGW;
    const float *x, *c, *ctx, *c_ctx, *w_ada, *b_ada, *w_in, *conv_w, *sink, *g_attn, *g_conv, *w_out, *ln1_g, *ln1_b, *wq, *keys, *pu, *pv, *ln2_g, *ln2_b;
    float* out;
    float *MODS, *ROPE, *X, *SC;
    bf16_t *KBD, *WQR, *WINT, *WOUTT, *WEFFT, *H, *PROJ, *MIX, *UT, *VT;
};

__device__ __forceinline__ void frame_ids(Frame& F) {
    int tz = threadIdx.x; asm volatile("" : "+v"(tz));
    F.tid = tz; F.lane = tz & 63; F.wave = __builtin_amdgcn_readfirstlane(tz >> 6);
    F.gw = blockIdx.x * NWAVES + F.wave;
}
__device__ __forceinline__ float wave_sum(float v) {
#pragma unroll
    for (int o = 1; o < 64; o <<= 1) v += __shfl_xor(v, o);
    return v;
}
__device__ __forceinline__ unsigned pk2(float lo, float hi) { return pg8::cvt_pk_bf16(lo, hi); }
__device__ __forceinline__ float bf_lo(unsigned u) { return __uint_as_float(u << 16); }
__device__ __forceinline__ float bf_hi(unsigned u) { return __uint_as_float(u & 0xffff0000u); }
__device__ __forceinline__ int modrow(int t) { return t < TL ? t / SEQ : 2; }

__device__ __forceinline__ void transpose_item(const float* W, int K, int N, bf16_t* WT, LAS float* scr, int item, int lane) {
    const int nblk = N / 32, kb = item / nblk, nb = item % nblk, k0 = 64 * kb, n0 = 32 * nb;
#pragma unroll 8
    for (int i = 0; i < 32; ++i) { const int kk = 2 * i + (lane >> 5); scr[kk * 33 + (lane & 31)] = W[(size_t)(k0 + kk) * N + n0 + (lane & 31)]; }
    LDS_WAIT(); asm volatile("" ::: "memory");
    const int c = lane & 7;
#pragma unroll
    for (int j = 0; j < 4; ++j) { const int n = (lane >> 3) + 8 * j; const LAS float* s = scr + (8 * c) * 33 + n;
        u32x4 o; o.x = pk2(s[0 * 33], s[1 * 33]); o.y = pk2(s[2 * 33], s[3 * 33]); o.z = pk2(s[4 * 33], s[5 * 33]); o.w = pk2(s[6 * 33], s[7 * 33]);
        *(u32x4*)(WT + (size_t)(n0 + n) * K + k0 + 8 * c) = o; }
    LDS_WAIT(); asm volatile("" ::: "memory");
}

__device__ __forceinline__ void cvt_row_bf16(const float* src, bf16_t* dst, int lane) {
    const f32x4* s = (const f32x4*)src + lane; u32x2* d = (u32x2*)dst + lane;
    f32x4 v[8];
#pragma unroll
    for (int j = 0; j < 8; ++j) v[j] = __builtin_nontemporal_load(s + 64 * j);
#pragma unroll
    for (int j = 0; j < 8; ++j) { u32x2 o; o.x = pk2(v[j].x, v[j].y); o.y = pk2(v[j].z, v[j].w); d[64 * j] = o; }
}

__device__ __forceinline__ void row_stats(const f32x4 (&v)[8], float& mean, float& rstd) {
    float s = 0.f;
#pragma unroll
    for (int j = 0; j < 8; ++j) s += (v[j].x + v[j].y) + (v[j].z + v[j].w);
    mean = wave_sum(s) * (1.f / D);
    float s2 = 0.f;
#pragma unroll
    for (int j = 0; j < 8; ++j) { const f32x4 d = v[j] - mean; s2 += (d.x * d.x + d.y * d.y) + (d.z * d.z + d.w * d.w); }
    rstd = 1.f / sqrtf(wave_sum(s2) * (1.f / D) + LN_EPS);
}
__device__ __forceinline__ void modulate_store(const f32x4 (&v)[8], const float* shift, const float* scale, bf16_t* dst, int lane) {
    float mean, rstd; row_stats(v, mean, rstd);
    u32x2* d = (u32x2*)dst + lane;
#pragma unroll
    for (int j = 0; j < 8; ++j) { const f32x4 sc = *((const f32x4*)scale + lane + 64 * j), sh = *((const f32x4*)shift + lane + 64 * j);
        const f32x4 y = (v[j] - mean) * rstd * (sc + 1.f) + sh;
        u32x2 o; o.x = pk2(y.x, y.y); o.y = pk2(y.z, y.w); d[64 * j] = o; }
}

__device__ __forceinline__ void p0a_prologue(Frame& F) {
    LAS float* condL = (LAS float*)F.lds;
    LAS float* red = (LAS float*)(F.lds + 24576);
    for (int i = F.tid; i < 3 * D; i += NWAVES * 64) { const int r = i / D, k = i % D; const float v = r < 2 ? F.c[r * D + k] : F.c_ctx[k]; condL[i] = v / (1.f + __expf(-v)); }
    __syncthreads();
    for (int item = blockIdx.x; item < 384; item += F.G) {
        const int l = item / 96, n0 = (item % 96) * 128;
        const float* wp = F.w_ada + ((size_t)l * D + F.wave * 256) * 12288 + n0 + 2 * F.lane;
        f32x2 a0 = {0.f, 0.f}, a1 = {0.f, 0.f}, a2 = {0.f, 0.f};
#pragma unroll 8
        for (int k = 0; k < 256; ++k) { const f32x2 w = __builtin_nontemporal_load((const f32x2*)(wp + (size_t)k * 12288)); const int kk = F.wave * 256 + k;
            a0 += w * condL[kk]; a1 += w * condL[D + kk]; a2 += w * condL[2 * D + kk]; }
        LAS float* rp = red + F.wave * 384 + 2 * F.lane;
        rp[0] = a0.x; rp[1] = a0.y; rp[128] = a1.x; rp[129] = a1.y; rp[256] = a2.x; rp[257] = a2.y;
        __syncthreads();
        if (F.tid < 384) { const int r = F.tid / 128, n = F.tid % 128; float s = 0.f;
#pragma unroll
            for (int w = 0; w < 8; ++w) s += red[w * 384 + r * 128 + n];
            F.MODS[((size_t)l * 3 + r) * 12288 + n0 + n] = s + F.b_ada[(size_t)l * 12288 + n0 + n]; }
        __syncthreads();
    }
    LAS float* scr = (LAS float*)(F.lds + 40960 + F.wave * 8448);
    constexpr int I_IN = (D / 64) * (INC / 32), I_OUT = (D / 64) * (D / 32);
    for (int it = F.gw; it < NLAYER * (I_IN + I_OUT); it += F.NGW) {
        const int l = it / (I_IN + I_OUT); int r = it % (I_IN + I_OUT);
        if (r < I_IN) transpose_item(F.w_in + (size_t)l * D * INC, D, INC, F.WINT + (size_t)l * INC * D, scr, r, F.lane);
        else transpose_item(F.w_out + (size_t)l * D * D, D, D, F.WOUTT + (size_t)l * D * D, scr, r - I_IN, F.lane);
    }
    for (int row = F.gw; row < NLAYER * D; row += F.NGW) {
        const int l = row / D, c = row % D; const f32x4* s = (const f32x4*)(F.wq + (size_t)row * D) + F.lane;
#pragma unroll
        for (int j = 0; j < 8; ++j) { const f32x4 v = s[64 * j]; u32x2 o; o.x = pk2(v.x, v.y); o.y = pk2(v.z, v.w);
            *((u32x2*)(F.WQR + ((size_t)(l * 8 + j) * D + c) * 256) + F.lane) = o; }
    }
    for (int row = F.gw; row < 32 * 256; row += F.NGW) {
        const int lh = row >> 8, pk = row & 255, p = pk >> 7;
        u32x2 o = {0u, 0u};
        if ((F.lane >> 5) == p) { const f32x4 v = *((const f32x4*)(F.keys + ((size_t)lh * 256 + pk) * 128) + (F.lane & 31)); o.x = pk2(v.x, v.y); o.y = pk2(v.z, v.w); }
        *((u32x2*)(F.KBD + (size_t)row * 256) + F.lane) = o;
    }
    for (int row = F.gw; row < NLAYER * NEXP; row += F.NGW) {
        cvt_row_bf16(F.pu + (size_t)row * D, F.UT + (size_t)row * D, F.lane);
        cvt_row_bf16(F.pv + (size_t)row * D, F.VT + (size_t)row * D, F.lane);
    }
    for (int i = blockIdx.x * (NWAVES * 64) + F.tid; i < 192 * 32; i += F.G * NWAVES * 64) {
        const int idx = i >> 5, f = i & 31; const float pos = (float)(idx < 128 ? idx : idx - 128);
        const float inv = powf(10000.f, -(float)(2 * f) / 64.f); const float ang = pos * inv;
        F.ROPE[2 * i] = cosf(ang); F.ROPE[2 * i + 1] = sinf(ang);
    }
}

__device__ __forceinline__ void p0b_mod0(Frame& F) {
    for (int t = F.gw; t < TT; t += F.NGW) {
        const float* src = t < TL ? F.x + (size_t)t * D : F.ctx + (size_t)(t - TL) * D;
        f32x4 v[8];
#pragma unroll
        for (int j = 0; j < 8; ++j) v[j] = *((const f32x4*)src + F.lane + 64 * j);
        const float* mp = F.MODS + (size_t)modrow(t) * 12288;
        modulate_store(v, mp, mp + D, F.H + (size_t)t * D, F.lane);
    }
}

constexpr int KP = 272, VP = 320, KS_BYTES = 64 * KP, VS_BYTES = 64 * VP;
struct KVRegs { u32x4 k1, k2, v1, v2; f32x4 cs[4]; };

__device__ __forceinline__ void attn_load_tile(Frame& F, KVRegs& R, int ti, int b, int n, int g) {
    const int key = F.tid >> 3, c8 = F.tid & 7;
    int row, pos = 0;
    if (ti < 6) { pos = (n - 1) * 128 + 64 * ti + key; row = b * SEQ + pos; } else row = TL + b * CTXL + 64 * (ti - 6) + key;
    const bf16_t* base = F.PROJ + (size_t)row * INC;
    const int d1 = (c8 >> 2) * 64 + (c8 & 3) * 8;
    R.k1 = *(const u32x4*)(base + OFF_K + g * 128 + d1); R.k2 = *(const u32x4*)(base + OFF_K + g * 128 + d1 + 32);
    R.v1 = *(const u32x4*)(base + OFF_V + g * 128 + 8 * c8); R.v2 = *(const u32x4*)(base + OFF_V + g * 128 + 64 + 8 * c8);
    if (ti < 6) { const int tidx = (c8 >> 2) ? 128 + (pos & 63) : (pos >> 6); const f32x4* cp = (const f32x4*)(F.ROPE + ((size_t)tidx * 32 + (c8 & 3) * 8) * 2);
#pragma unroll
        for (int m = 0; m < 4; ++m) R.cs[m] = cp[m]; }
}
__device__ __forceinline__ void rope8(u32x4& a, u32x4& bq, const f32x4 (&cs)[4], float scale) {
    u32x4 oa, ob;
#pragma unroll
    for (int w = 0; w < 4; ++w) {
        const float x1l = bf_lo(a[w]), x1h = bf_hi(a[w]), x2l = bf_lo(bq[w]), x2h = bf_hi(bq[w]);
        const float cl = cs[w].x, sl = cs[w].y, ch = cs[w].z, sh = cs[w].w;
        oa[w] = pk2((x1l * cl - x2l * sl) * scale, (x1h * ch - x2h * sh) * scale);
        ob[w] = pk2((x2l * cl + x1l * sl) * scale, (x2h * ch + x1h * sh) * scale);
    }
    a = oa; bq = ob;
}
__device__ __forceinline__ void attn_store_tile(Frame& F, KVRegs& R, int ti, int buf) {
    const int key = F.tid >> 3, c8 = F.tid & 7;
    if (ti < 6) rope8(R.k1, R.k2, R.cs, 1.f);
    const int d1 = (c8 >> 2) * 64 + (c8 & 3) * 8;
    LAS unsigned char* kp = F.lds + buf * KS_BYTES + key * KP;
    *(LAS u32x4*)(kp + d1 * 2) = R.k1; *(LAS u32x4*)(kp + (d1 + 32) * 2) = R.k2;
    LAS unsigned char* vp = F.lds + 2 * KS_BYTES + buf * VS_BYTES + key * VP;
    *(LAS u32x4*)(vp + 16 * c8) = R.v1; *(LAS u32x4*)(vp + 128 + 16 * c8) = R.v2;
}

#define MFMA32(a, b, c) __builtin_amdgcn_mfma_f32_32x32x16_bf16((a), (b), (c), 0, 0, 0)

__device__ __forceinline__ void attn_unit(Frame& F, int layer, int u) {
    const bool latent = u < 512;
    int b, n, g, hp;
    if (latent) { hp = u & 1; g = (u >> 1) & 1; n = (u >> 2) & 63; b = u >> 8; }
    else { const int v = u - 512; hp = v & 1; g = (v >> 1) & 1; n = (v >> 2) & 1; b = v >> 3; }
    const int lane = F.lane, r = lane & 31, h = lane >> 5, wave = F.wave;
    const int head = g * 4 + hp * 2 + (wave >> 2), qb = wave & 3;
    const int tq = latent ? b * SEQ + n * 128 + 32 * qb + r : TL + b * CTXL + n * 128 + 32 * qb + r;
    bf16x8 qf[8];
    {
        u32x4 raw[8];
        const bf16_t* qp = F.PROJ + (size_t)tq * INC + OFF_Q + head * 128 + 8 * h;
#pragma unroll
        for (int ks = 0; ks < 8; ++ks) raw[ks] = *(const u32x4*)(qp + 16 * ks);
        if (latent) {
            const int pos = n * 128 + 32 * qb + r;
#pragma unroll
            for (int half = 0; half < 2; ++half) {
                const int tidx = half ? 128 + (pos & 63) : (pos >> 6);
#pragma unroll
                for (int kk = 0; kk < 2; ++kk) {
                    const f32x4* cp = (const f32x4*)(F.ROPE + ((size_t)tidx * 32 + 16 * kk + 8 * h) * 2);
                    f32x4 cs[4];
#pragma unroll
                    for (int m = 0; m < 4; ++m) cs[m] = cp[m];
                    rope8(raw[4 * half + kk], raw[4 * half + kk + 2], cs, QSCALE);
                }
            }
        } else {
#pragma unroll
            for (int ks = 0; ks < 8; ++ks)
#pragma unroll
                for (int w = 0; w < 4; ++w) raw[ks][w] = pk2(bf_lo(raw[ks][w]) * QSCALE, bf_hi(raw[ks][w]) * QSCALE);
        }
#pragma unroll
        for (int ks = 0; ks < 8; ++ks) qf[ks] = __builtin_bit_cast(bf16x8, raw[ks]);
    }
    int tlo = 6, nw = 0;
    if (latent) { tlo = (n == 0) ? 2 : 0; const int thi = (n == 63) ? 3 : 5; nw = thi - tlo + 1; }
    const int ntiles = nw + 4;
    f32x16 o[4];
#pragma unroll
    for (int db = 0; db < 4; ++db)
#pragma unroll
        for (int i = 0; i < 16; ++i) o[db][i] = 0.f;
    float m_run = F.sink[layer * 8 + head] * LOG2E;
    float lsum = h == 0 ? 1.f : 0.f;
    const int iq = 32 * qb + r;
    KVRegs R;
    __syncthreads();
    attn_load_tile(F, R, nw > 0 ? tlo : 6, b, n, g);
    attn_store_tile(F, R, nw > 0 ? tlo : 6, 0);
    __syncthreads();
    const int i16 = lane & 15, tq4 = i16 >> 2, tp = i16 & 3, blk = (lane >> 4) & 1;
    for (int j = 0; j < ntiles; ++j) {
        const int ti = j < nw ? tlo + j : 6 + (j - nw);
        const int buf = j & 1;
        const bool more = j + 1 < ntiles;
        const int tin = (j + 1) < nw ? tlo + j + 1 : 6 + (j + 1 - nw);
        if (more) attn_load_tile(F, R, tin, b, n, g);
        const bool part = ti >= 6 || (ti >= (qb >> 1) && ti <= (qb >> 1) + 4);
        if (part) {
            f32x16 s0, s1;
#pragma unroll
            for (int i = 0; i < 16; ++i) { s0[i] = 0.f; s1[i] = 0.f; }
            const LAS unsigned char* kb = F.lds + buf * KS_BYTES + r * KP + h * 16;
#pragma unroll
            for (int ks = 0; ks < 8; ++ks) {
                const bf16x8 a0 = *(const LAS bf16x8*)(kb + ks * 32), a1 = *(const LAS bf16x8*)(kb + 32 * KP + ks * 32);
                s0 = MFMA32(a0, qf[ks], s0); s1 = MFMA32(a1, qf[ks], s1);
            }
            float mx = -INFINITY;
            if (ti < 6) {
                const int jb = 64 * ti + 4 * h - iq;
#pragma unroll
                for (int i = 0; i < 16; ++i) { const int j0 = jb + (i & 3) + 8 * (i >> 2), j1 = j0 + 32;
                    s0[i] = (j0 >= 0 && j0 <= 256) ? s0[i] : -INFINITY; s1[i] = (j1 >= 0 && j1 <= 256) ? s1[i] : -INFINITY; }
            }
#pragma unroll
            for (int i = 0; i < 16; ++i) mx = fmaxf(mx, fmaxf(s0[i], s1[i]));
            mx = fmaxf(mx, __shfl_xor(mx, 32));
            const float m_new = fmaxf(m_run, mx), alpha = exp2f(m_run - m_new);
            m_run = m_new; lsum *= alpha;
#pragma unroll
            for (int i = 0; i < 16; ++i) { s0[i] = exp2f(s0[i] - m_new); s1[i] = exp2f(s1[i] - m_new); lsum += s0[i] + s1[i]; }
#pragma unroll
            for (int db = 0; db < 4; ++db)
#pragma unroll
                for (int i = 0; i < 16; ++i) o[db][i] *= alpha;
            bf16x8 pf[2][2];
#pragma unroll
            for (int s2 = 0; s2 < 2; ++s2) {
                u32x4 p0, p1;
#pragma unroll
                for (int w = 0; w < 4; ++w) { p0[w] = pk2(s0[8 * s2 + 2 * w], s0[8 * s2 + 2 * w + 1]); p1[w] = pk2(s1[8 * s2 + 2 * w], s1[8 * s2 + 2 * w + 1]); }
                pf[0][s2] = __builtin_bit_cast(bf16x8, p0); pf[1][s2] = __builtin_bit_cast(bf16x8, p1);
            }
            const LAS unsigned char* vb = F.lds + 2 * KS_BYTES + buf * VS_BYTES + (4 * h + tq4) * VP + 32 * blk + 8 * tp;
#pragma unroll
            for (int db = 0; db < 4; ++db)
#pragma unroll
                for (int kb2 = 0; kb2 < 2; ++kb2)
#pragma unroll
                    for (int s2 = 0; s2 < 2; ++s2) {
                        const int off = (32 * kb2 + 16 * s2) * VP + db * 64;
                        const s16x4 lo = __builtin_amdgcn_ds_read_tr16_b64_v4i16((LAS s16x4*)(vb + off));
                        const s16x4 hi = __builtin_amdgcn_ds_read_tr16_b64_v4i16((LAS s16x4*)(vb + off + 8 * VP));
                        const bf16x8 av = __builtin_shufflevector(lo, hi, 0, 1, 2, 3, 4, 5, 6, 7);
                        o[db] = MFMA32(av, pf[kb2][s2], o[db]);
                    }
        }
        if (more) attn_store_tile(F, R, tin, buf ^ 1);
        __syncthreads();
    }
    const float lt = lsum + __shfl_xor(lsum, 32);
    const float inv = 1.f / lt;
    float ss = 0.f;
#pragma unroll
    for (int db = 0; db < 4; ++db)
#pragma unroll
        for (int i = 0; i < 16; ++i) { o[db][i] *= inv; ss += o[db][i] * o[db][i]; }
    ss += __shfl_xor(ss, 32);
    const float rn = 1.f / sqrtf(ss * (1.f / 128.f) + LN_EPS);
    bf16_t* op = F.MIX + (size_t)tq * D + head * 128 + 4 * h;
    const float* gp = F.g_attn + layer * 1024 + head * 128 + 4 * h;
#pragma unroll
    for (int db = 0; db < 4; ++db)
#pragma unroll
        for (int g4 = 0; g4 < 4; ++g4) {
            const f32x4 gv = *(const f32x4*)(gp + 32 * db + 8 * g4);
            u32x2 w; w.x = pk2(o[db][4 * g4] * rn * gv.x, o[db][4 * g4 + 1] * rn * gv.y); w.y = pk2(o[db][4 * g4 + 2] * rn * gv.z, o[db][4 * g4 + 3] * rn * gv.w);
            *(u32x2*)(op + 32 * db + 8 * g4) = w;
        }
}

__device__ __forceinline__ void unpack8(const u32x4 v, float (&f)[8]) {
#pragma unroll
    for (int w = 0; w < 4; ++w) { f[2 * w] = bf_lo(v[w]); f[2 * w + 1] = bf_hi(v[w]); }
}
__device__ __forceinline__ void conv_row(Frame& F, int layer, int t) {
    bool first, last;
    if (t < TL) { const int pos = t & (SEQ - 1); first = pos == 0; last = pos == SEQ - 1; } else { const int pc = (t - TL) & (CTXL - 1); first = pc == 0; last = pc == CTXL - 1; }
    const bf16_t* p = F.PROJ + (size_t)t * INC;
    const float* cw = F.conv_w + (size_t)layer * 3 * 1024;
#pragma unroll
    for (int jc = 0; jc < 2; ++jc) {
        const int c = 8 * F.lane + 512 * jc;
        float gb[8], a[8], bq[8], um[8], ut[8], up[8];
        unpack8(*(const u32x4*)(p + c), gb);
        unpack8(*(const u32x4*)(p + OFF_C + c), a); unpack8(*(const u32x4*)(p + OFF_X + c), bq);
#pragma unroll
        for (int e = 0; e < 8; ++e) ut[e] = a[e] * bq[e];
        if (!first) { unpack8(*(const u32x4*)(p - INC + OFF_C + c), a); unpack8(*(const u32x4*)(p - INC + OFF_X + c), bq);
#pragma unroll
            for (int e = 0; e < 8; ++e) um[e] = a[e] * bq[e]; }
        else {
#pragma unroll
            for (int e = 0; e < 8; ++e) um[e] = 0.f; }
        if (!last) { unpack8(*(const u32x4*)(p + INC + OFF_C + c), a); unpack8(*(const u32x4*)(p + INC + OFF_X + c), bq);
#pragma unroll
            for (int e = 0; e < 8; ++e) up[e] = a[e] * bq[e]; }
        else {
#pragma unroll
            for (int e = 0; e < 8; ++e) up[e] = 0.f; }
        float y[8], ss = 0.f;
#pragma unroll
        for (int e = 0; e < 8; ++e) { y[e] = gb[e] * (cw[c + e] * um[e] + cw[1024 + c + e] * ut[e] + cw[2048 + c + e] * up[e]); ss += y[e] * y[e]; }
        ss += __shfl_xor(ss, 1); ss += __shfl_xor(ss, 2); ss += __shfl_xor(ss, 4); ss += __shfl_xor(ss, 8);
        const float rn = 1.f / sqrtf(ss * (1.f / 128.f) + LN_EPS);
        const float* gc = F.g_conv + layer * 1024 + c;
        u32x4 w;
#pragma unroll
        for (int q = 0; q < 4; ++q) w[q] = pk2(y[2 * q] * rn * gc[2 * q], y[2 * q + 1] * rn * gc[2 * q + 1]);
        *(u32x4*)(F.MIX + (size_t)t * D + 1024 + c) = w;
    }
}

__device__ __forceinline__ void ln_phase(Frame& F, int layer, int rows) {
    for (int t = F.gw; t < rows; t += F.NGW) {
        float* xr = F.X + (size_t)t * D;
        f32x4 v[8];
#pragma unroll
        for (int j = 0; j < 8; ++j) v[j] = *((const f32x4*)xr + F.lane + 64 * j);
        float mean, rstd; row_stats(v, mean, rstd);
        const float* g1 = F.ln1_g + layer * D; const float* b1 = F.ln1_b + layer * D;
#pragma unroll
        for (int j = 0; j < 8; ++j) { const f32x4 gg = *((const f32x4*)g1 + F.lane + 64 * j), bb = *((const f32x4*)b1 + F.lane + 64 * j);
            v[j] = (v[j] - mean) * rstd * gg + bb; *((f32x4*)xr + F.lane + 64 * j) = v[j]; }
        const float* mp = F.MODS + ((size_t)layer * 3 + modrow(t)) * 12288;
        modulate_store(v, mp + 3 * D, mp + 4 * D, F.H + (size_t)t * D, F.lane);
    }
}

__device__ __forceinline__ unsigned ordkey(float f) { const unsigned u = __float_as_uint(f); return u ^ ((u >> 31) ? 0xFFFFFFFFu : 0x80000000u); }
__device__ __forceinline__ float gelu_erf(float a) { return 0.5f * a * (1.f + erff(a * 0.70710678118654752f)); }

__device__ __forceinline__ void peer_topk(Frame& F, LAS unsigned char* ws, int t) {
    const int lane = F.lane; const bool hi = lane >= 32; const int l31 = lane & 31;
    LAS float* s1v = (LAS float*)ws; LAS int* s1i = (LAS int*)(ws + 128);
    LAS float* fv = (LAS float*)(ws + 256); LAS int* fi = (LAS int*)(ws + 320);
    LAS int* EL = (LAS int*)(ws + 512); LAS float* GL = (LAS float*)(ws + 1024);
    const unsigned lm = (1u << l31) - 1u;
    for (int hd = 0; hd < 8; ++hd) {
        const f32x4 sv = *((const f32x4*)(F.SC + (size_t)t * D + hd * 256) + lane);
        unsigned k[4];
#pragma unroll
        for (int j = 0; j < 4; ++j) k[j] = ordkey(sv[j]);
        unsigned T0 = 0u, T1 = 0u;
        for (int bit = 31; bit >= 0; --bit) {
            const unsigned c0 = T0 | (1u << bit), c1 = T1 | (1u << bit);
            const unsigned cand = hi ? c1 : c0;
            int n0 = 0, n1 = 0;
#pragma unroll
            for (int j = 0; j < 4; ++j) { const unsigned long long m = __ballot(k[j] >= cand); n0 += __popc((unsigned)m); n1 += __popc((unsigned)(m >> 32)); }
            if (n0 >= 16) T0 = c0;
            if (n1 >= 16) T1 = c1;
        }
        {
            const unsigned thr = hi ? T1 : T0; int base = 0; const int hb = hi ? 16 : 0;
#pragma unroll
            for (int j = 0; j < 4; ++j) { const bool gt = k[j] > thr; const unsigned long long m = __ballot(gt); const unsigned mh = hi ? (unsigned)(m >> 32) : (unsigned)m;
                const int pos = base + __popc(mh & lm); if (gt) { s1v[hb + pos] = sv[j]; s1i[hb + pos] = 4 * l31 + j; } base += __popc(mh); }
#pragma unroll
            for (int j = 0; j < 4; ++j) { const bool eq = k[j] == thr; const unsigned long long m = __ballot(eq); const unsigned mh = hi ? (unsigned)(m >> 32) : (unsigned)m;
                const int pos = base + __popc(mh & lm); if (eq && pos < 16) { s1v[hb + pos] = sv[j]; s1i[hb + pos] = 4 * l31 + j; } base += __popc(mh); }
        }
        LDS_WAIT(); __builtin_amdgcn_wave_barrier();
        const int a = lane >> 2, b0 = (lane & 3) * 4;
        const float av = s1v[a]; const int ai = s1i[a];
        float cv[4]; int ce[4]; unsigned ck[4];
#pragma unroll
        for (int j = 0; j < 4; ++j) { cv[j] = av + s1v[16 + b0 + j]; ce[j] = ai * 128 + s1i[16 + b0 + j]; ck[j] = ordkey(cv[j]); }
        unsigned T2 = 0u;
        for (int bit = 31; bit >= 0; --bit) {
            const unsigned c2 = T2 | (1u << bit); int nn = 0;
#pragma unroll
            for (int j = 0; j < 4; ++j) nn += __popcll(__ballot(ck[j] >= c2));
            if (nn >= 16) T2 = c2;
        }
        {
            const unsigned long long lm64 = (1ull << lane) - 1ull; int base = 0;
#pragma unroll
            for (int j = 0; j < 4; ++j) { const bool gt = ck[j] > T2; const unsigned long long m = __ballot(gt);
                const int pos = base + __popcll(m & lm64); if (gt) { fv[pos] = cv[j]; fi[pos] = ce[j]; } base += __popcll(m); }
#pragma unroll
            for (int j = 0; j < 4; ++j) { const bool eq = ck[j] == T2; const unsigned long long m = __ballot(eq);
                const int pos = base + __popcll(m & lm64); if (eq && pos < 16) { fv[pos] = cv[j]; fi[pos] = ce[j]; } base += __popcll(m); }
        }
        LDS_WAIT(); __builtin_amdgcn_wave_barrier();
        float mxv = -INFINITY, f16v[16];
#pragma unroll
        for (int i = 0; i < 16; ++i) { f16v[i] = fv[i]; mxv = fmaxf(mxv, f16v[i]); }
        float den = 0.f;
#pragma unroll
        for (int i = 0; i < 16; ++i) den += __expf(f16v[i] - mxv);
        if (lane < 16) { GL[hd * 16 + lane] = __expf(fv[lane] - mxv) / den; EL[hd * 16 + lane] = fi[lane]; }
        LDS_WAIT(); __builtin_amdgcn_wave_barrier();
    }
}

constexpr int EB = 2;
__device__ __forceinline__ void peer_phase(Frame& F, int layer, int rows) {
    LAS unsigned char* ws = F.lds + F.wave * 2048;
    LAS int* EL = (LAS int*)(ws + 512); LAS float* GL = (LAS float*)(ws + 1024);
    const int lane = F.lane;
    const bf16_t* UTl = F.UT + (size_t)layer * NEXP * D + 8 * lane;
    const bf16_t* VTl = F.VT + (size_t)layer * NEXP * D + 8 * lane;
    for (int t = F.gw; t < rows; t += F.NGW) {
        peer_topk(F, ws, t);
        float hv[32], acc[32];
#pragma unroll
        for (int j = 0; j < 4; ++j) { float f[8]; unpack8(*(const u32x4*)(F.H + (size_t)t * D + 8 * lane + 512 * j), f);
#pragma unroll
            for (int e = 0; e < 8; ++e) { hv[8 * j + e] = f[e]; acc[8 * j + e] = 0.f; } }
        for (int i0 = 0; i0 < 128; i0 += EB) {
            int ex[EB]; float gx[EB];
#pragma unroll
            for (int q = 0; q < EB; ++q) { ex[q] = __builtin_amdgcn_readfirstlane(EL[i0 + q]); gx[q] = __uint_as_float(__builtin_amdgcn_readfirstlane(__float_as_uint(GL[i0 + q]))); }
            u32x4 uu[EB][4], vv[EB][4];
#pragma unroll
            for (int q = 0; q < EB; ++q)
#pragma unroll
                for (int j = 0; j < 4; ++j) { uu[q][j] = *(const u32x4*)(UTl + (size_t)ex[q] * D + 512 * j); vv[q][j] = *(const u32x4*)(VTl + (size_t)ex[q] * D + 512 * j); }
            float dot[EB];
#pragma unroll
            for (int q = 0; q < EB; ++q) { float s = 0.f;
#pragma unroll
                for (int j = 0; j < 4; ++j)
#pragma unroll
                    for (int w = 0; w < 4; ++w) { s += bf_lo(uu[q][j][w]) * hv[8 * j + 2 * w]; s += bf_hi(uu[q][j][w]) * hv[8 * j + 2 * w + 1]; }
                dot[q] = s; }
#pragma unroll
            for (int q = 0; q < EB; ++q) dot[q] = wave_sum(dot[q]);
#pragma unroll
            for (int q = 0; q < EB; ++q) { const float cf = gx[q] * gelu_erf(dot[q]);
#pragma unroll
                for (int j = 0; j < 4; ++j)
#pragma unroll
                    for (int w = 0; w < 4; ++w) { acc[8 * j + 2 * w] += cf * bf_lo(vv[q][j][w]); acc[8 * j + 2 * w + 1] += cf * bf_hi(vv[q][j][w]); } }
        }
        const int mr = modrow(t);
        const float* mp = F.MODS + ((size_t)layer * 3 + mr) * 12288;
        float* xr = F.X + (size_t)t * D;
        float rr[32]; float s = 0.f;
#pragma unroll
        for (int j = 0; j < 4; ++j)
#pragma unroll
            for (int q = 0; q < 2; ++q) { const int c = 8 * lane + 512 * j + 4 * q; const f32x4 xv = *(const f32x4*)(xr + c), gv = *(const f32x4*)(mp + 5 * D + c);
#pragma unroll
                for (int e = 0; e < 4; ++e) { const float v = DN_ALPHA * xv[e] + gv[e] * acc[8 * j + 4 * q + e]; rr[8 * j + 4 * q + e] = v; s += v; } }
        const float mean = wave_sum(s) * (1.f / D);
        float s2 = 0.f;
#pragma unroll
        for (int i = 0; i < 32; ++i) { rr[i] -= mean; s2 += rr[i] * rr[i]; }
        const float rstd = 1.f / sqrtf(wave_sum(s2) * (1.f / D) + LN_EPS);
        const float* g2 = F.ln2_g + layer * D; const float* b2 = F.ln2_b + layer * D;
        float s3 = 0.f;
#pragma unroll
        for (int j = 0; j < 4; ++j)
#pragma unroll
            for (int q = 0; q < 2; ++q) { const int c = 8 * lane + 512 * j + 4 * q; const f32x4 gg = *(const f32x4*)(g2 + c), bb = *(const f32x4*)(b2 + c);
                f32x4 xo;
#pragma unroll
                for (int e = 0; e < 4; ++e) { xo[e] = rr[8 * j + 4 * q + e] * rstd * gg[e] + bb[e]; rr[8 * j + 4 * q + e] = xo[e]; s3 += xo[e]; }
                if (layer < NLAYER - 1) *(f32x4*)(xr + c) = xo; else if (t < TL) *(f32x4*)(F.out + (size_t)t * D + c) = xo; }
        if (layer < NLAYER - 1) {
            const float mean2 = wave_sum(s3) * (1.f / D);
            float s4 = 0.f;
#pragma unroll
            for (int i = 0; i < 32; ++i) { rr[i] -= mean2; s4 += rr[i] * rr[i]; }
            const float rstd2 = 1.f / sqrtf(wave_sum(s4) * (1.f / D) + LN_EPS);
            const float* np = F.MODS + ((size_t)(layer + 1) * 3 + mr) * 12288;
#pragma unroll
            for (int j = 0; j < 4; ++j) { const int c = 8 * lane + 512 * j; u32x4 w;
#pragma unroll
                for (int q = 0; q < 2; ++q) { const f32x4 sh = *(const f32x4*)(np + c + 4 * q), sc = *(const f32x4*)(np + D + c + 4 * q);
                    const float y0 = rr[8 * j + 4 * q] * rstd2 * (1.f + sc[0]) + sh[0], y1 = rr[8 * j + 4 * q + 1] * rstd2 * (1.f + sc[1]) + sh[1];
                    const float y2 = rr[8 * j + 4 * q + 2] * rstd2 * (1.f + sc[2]) + sh[2], y3 = rr[8 * j + 4 * q + 3] * rstd2 * (1.f + sc[3]) + sh[3];
                    w[2 * q] = pk2(y0, y1); w[2 * q + 1] = pk2(y2, y3); }
                *(u32x4*)(F.H + (size_t)t * D + c) = w; }
        }
    }
}

__global__ void __launch_bounds__(NWAVES * 64, 2) skel_fwd(Args args) {
    extern __shared__ __attribute__((aligned(16))) unsigned char lds[];
    Frame F;
    F.lds = (LAS unsigned char*)lds;
    F.tid = threadIdx.x; F.lane = F.tid & 63; F.wave = __builtin_amdgcn_readfirstlane(F.tid >> 6);
    F.G = gridDim.x; F.gw = blockIdx.x * NWAVES + F.wave; F.NGW = F.G * NWAVES;
    unsigned char* ws = args.ws;
    F.x = args.in[0]; F.c = args.in[1]; F.ctx = args.in[2]; F.c_ctx = args.in[3]; F.w_ada = args.in[4]; F.b_ada = args.in[5]; F.w_in = args.in[6]; F.conv_w = args.in[7];
    F.sink = args.in[8]; F.g_attn = args.in[9]; F.g_conv = args.in[10]; F.w_out = args.in[11]; F.ln1_g = args.in[12]; F.ln1_b = args.in[13]; F.wq = args.in[14]; F.keys = args.in[15];
    F.pu = args.in[16]; F.pv = args.in[17]; F.ln2_g = args.in[18]; F.ln2_b = args.in[19]; F.out = args.out;
    F.MODS = (float*)(ws + WS_MODS); F.ROPE = (float*)(ws + WS_ROPE); F.X = (float*)(ws + WS_X); F.SC = (float*)(ws + WS_SC);
    F.KBD = (bf16_t*)(ws + WS_KBD); F.WQR = (bf16_t*)(ws + WS_WQR); F.WINT = (bf16_t*)(ws + WS_WINT); F.WOUTT = (bf16_t*)(ws + WS_WOUTT); F.WEFFT = (bf16_t*)(ws + WS_WEFFT);
    F.H = (bf16_t*)(ws + WS_H); F.PROJ = (bf16_t*)(ws + WS_PROJ); F.MIX = (bf16_t*)(ws + WS_MIX); F.UT = (bf16_t*)(ws + WS_UT); F.VT = (bf16_t*)(ws + WS_VT);
    for (int u = F.tid; u < (LDS_BYTES - LDSCTL_OFF) / 4; u += NWAVES * 64) ((LAS unsigned*)(F.lds + LDSCTL_OFF))[u] = 0u;
    __syncthreads();
    unsigned* ctl = (unsigned*)(ws + WS_CTL);
    const int lo = args.ph_lo, hi = args.ph_hi;
    XcdBarrier bar; bar.bar = ctl + CW_BAR + args.li * XCD_BAR_WORDS; bar.x = 0; bar.st = nullptr;
    if (hi - lo > 1) bar = xcd_barrier_post(ctl + CW_BAR + args.li * XCD_BAR_WORDS, (volatile LAS unsigned*)(F.lds + MISC_OFF) + 8);
#define IN(k) (lo <= (k) && (k) < hi)
#define BOTH(k) (IN(k) && IN((k) + 1))
#define SEAM(k) do { if (BOTH(k)) xcd_barrier(bar); } while (0)

    if (IN(0)) { frame_ids(F); p0a_prologue(F); SEAM(0); }
    if (IN(1)) {
        frame_ids(F);
        { pg8::Gemm g{F.KBD, F.WQR, 32 * 256, 2048, 256}; pg8::BatchOrder S{F.G, (int)blockIdx.x}; pg8::EpiBf16 E{F.WEFFT, D};
          pg8::gemm_phase<pg8::EpiBf16, pg8::BatchOrder, false, true>(F.lds, g, S, E); }
        p0b_mod0(F);
        SEAM(1);
    }
    for (int layer = 0; layer < NLAYER; ++layer) {
        const int pb = 2 + 6 * layer;
        const bool lastl = layer == NLAYER - 1;
        const int rows = lastl ? TL : TT;
        if (IN(pb + 0)) {
            frame_ids(F);
            pg8::Gemm g{F.H, F.WINT + (size_t)layer * INC * D, TT, INC, D}; pg8::StaticOrder S; S.init(TT, INC, F.G, (int)blockIdx.x);
            pg8::EpiBf16 E{F.PROJ, INC};
            pg8::gemm_phase<pg8::EpiBf16, pg8::StaticOrder, true, true>(F.lds, g, S, E);
            SEAM(pb + 0);
        }
        if (IN(pb + 1)) {
            frame_ids(F);
            const int nunits = lastl ? 512 : 528;
            for (int u = blockIdx.x; u < nunits; u += F.G) attn_unit(F, layer, u);
            for (int t = F.gw; t < rows; t += F.NGW) conv_row(F, layer, t);
            SEAM(pb + 1);
        }
        if (IN(pb + 2)) {
            frame_ids(F);
            pg8::Gemm g{F.MIX, F.WOUTT + (size_t)layer * D * D, rows, D, D}; pg8::StaticOrder S; S.init(rows, D, F.G, (int)blockIdx.x);
            pg8::EpiResid E{layer == 0 ? F.x : F.X, layer == 0 ? F.ctx : F.X + (size_t)TL * D, F.X, F.MODS + (size_t)layer * 3 * 12288 + 2 * D};
            pg8::gemm_phase<pg8::EpiResid, pg8::StaticOrder, true, true>(F.lds, g, S, E);
            SEAM(pb + 2);
        }
        if (IN(pb + 3)) { frame_ids(F); ln_phase(F, layer, rows); SEAM(pb + 3); }
        if (IN(pb + 4)) {
            frame_ids(F);
            pg8::Gemm g{F.H, F.WEFFT + (size_t)layer * D * D, rows, D, D}; pg8::StaticOrder S; S.init(rows, D, F.G, (int)blockIdx.x);
            pg8::EpiF32 E{F.SC, D};
            pg8::gemm_phase<pg8::EpiF32, pg8::StaticOrder, true, true>(F.lds, g, S, E);
            SEAM(pb + 4);
        }
        if (IN(pb + 5)) { frame_ids(F); peer_phase(F, layer, rows); SEAM(pb + 5); }
    }
#undef IN
#undef BOTH
#undef SEAM
}

extern "C" void kernel_launch(void* const* d_in, const int* in_sizes, int n_in, void* d_out, int out_size, void* d_ws, size_t ws_size, hipStream_t stream) {
    static int grid = 0;
    if (grid == 0) {
        if (n_in != 20 || in_sizes[0] != TL * D || out_size != TL * D || ws_size < WS_END) {
            fprintf(stderr, "kernel_launch: unexpected problem shape (n_in %d, in0 %d, out %d, ws %zu, need %zu)\n", n_in, n_in > 0 ? in_sizes[0] : -1, out_size, ws_size, (size_t)WS_END); grid = -1; return; }
        int dev = 0, cus = 0, per_cu = 0;
        if (hipGetDevice(&dev) != hipSuccess || hipDeviceGetAttribute(&cus, hipDeviceAttributeMultiprocessorCount, dev) != hipSuccess) { grid = -1; return; }
        if (hipFuncSetAttribute((const void*)skel_fwd, hipFuncAttributeMaxDynamicSharedMemorySize, LDS_BYTES) != hipSuccess) { fprintf(stderr, "kernel_launch: hipFuncSetAttribute failed\n"); grid = -1; return; }
        if (hipOccupancyMaxActiveBlocksPerMultiprocessor(&per_cu, (const void*)skel_fwd, NWAVES * 64, LDS_BYTES) != hipSuccess || per_cu < 1)
            fprintf(stderr, "kernel_launch: occupancy query reports %d workgroups per CU\n", per_cu);
        (void)hipGetLastError();
        grid = cus;
    }
    if (grid < 0) return;
    if (hipMemsetAsync((char*)d_ws + WS_CTL, 0, CTL_ZERO_BYTES, stream) != hipSuccess) return;
    Args a{};
    for (int i = 0; i < 20; ++i) a.in[i] = (const float*)d_in[i];
    a.out = (float*)d_out; a.ws = (unsigned char*)d_ws; a.pad = 0;
#if MK_N_LAUNCHES == 1
    a.ph_lo = 0; a.ph_hi = NPHASE; a.li = 0;
    hipLaunchKernelGGL(skel_fwd, dim3(grid), dim3(NWAVES * 64), LDS_BYTES, stream, a);
#else
    for (int ph = 0; ph < NPHASE; ++ph) { a.ph_lo = ph; a.ph_hi = ph + 1; a.li = 0;
        hipLaunchKernelGGL(skel_fwd, dim3(grid), dim3(NWAVES * 64), LDS_BYTES, stream, a); }
#endif
}
```

```cpp
#include <hip/hip_runtime.h>
#include <cstdio>
#include <cstdint>

#ifndef MK_N_LAUNCHES
#define MK_N_LAUNCHES 1
#endif

#define LAS __attribute__((address_space(3)))
typedef unsigned short bf16_t;
typedef short bf16x8 __attribute__((ext_vector_type(8)));
typedef short s16x4 __attribute__((ext_vector_type(4)));
typedef float f32x2 __attribute__((ext_vector_type(2)));
typedef float f32x4 __attribute__((ext_vector_type(4)));
typedef float f32x16 __attribute__((ext_vector_type(16)));
typedef unsigned u32x2 __attribute__((ext_vector_type(2)));
typedef unsigned u32x4 __attribute__((ext_vector_type(4)));
typedef __bf16 bf16x2_t __attribute__((ext_vector_type(2)));

constexpr int D = 2048, NB = 2, SEQ = 8192, CTXL = 256, NLAYER = 4;
constexpr int TL = NB * SEQ, TC = NB * CTXL, TT = TL + TC;
constexpr int INC = 4608, OFF_C = 1024, OFF_X = 2048, OFF_Q = 3072, OFF_K = 4096, OFF_V = 4352;
constexpr int NEXP = 16384;
constexpr float LN_EPS = 1e-6f;
constexpr float DN_ALPHA = 1.681792830507429f;
constexpr float QSCALE = 0.08838834764831845f * 1.4426950408889634f;
constexpr float LOG2E = 1.4426950408889634f;

constexpr size_t MiB = 1u << 20;
constexpr size_t WS_CTL = 0, CTL_ZERO_BYTES = 1 * MiB;
constexpr size_t WS_MODS = 1 * MiB;
constexpr size_t WS_ROPE = 2 * MiB;
constexpr size_t WS_KBD = 3 * MiB;
constexpr size_t WS_WQR = 8 * MiB;
constexpr size_t WS_WINT = 40 * MiB;
constexpr size_t WS_WOUTT = 112 * MiB;
constexpr size_t WS_WEFFT = 144 * MiB;
constexpr size_t WS_X = 176 * MiB;
constexpr size_t WS_H = 308 * MiB;
constexpr size_t WS_PROJ = 374 * MiB;
constexpr size_t WS_MIX = 523 * MiB;
constexpr size_t WS_SC = 589 * MiB;
constexpr size_t WS_UT = 721 * MiB;
constexpr size_t WS_VT = 849 * MiB;
constexpr size_t WS_US = 977 * MiB;
constexpr size_t WS_VS = 978 * MiB;
constexpr size_t WS_END = 979 * MiB;

constexpr int CW_BAR = 4096;

namespace pg8 {
constexpr int BM = 256, BK = 64, HALF = 128, HTB = HALF * BK * 2, STAGE_BYTES = 8 * HTB, NXCD = 8, WGM = 8;
__host__ __device__ __forceinline__ int lds_byte(int r, int c) { const int st = (r >> 4) * 2 + (c >> 5), rr = r & 15, cc = c & 31, ob = rr * 64 + cc * 2; return st * 1024 + (ob ^ (((ob >> 9) & 1) << 5)); }
__host__ __device__ __forceinline__ void stage_rc(int b, int& R, int& C) { const int st = b / 1024, sb = b % 1024, swz = sb ^ (((sb >> 9) & 1) << 5); R = (st >> 1) * 16 + swz / 64; C = (st & 1) * 32 + (swz % 64) / 2; }
__host__ __device__ __forceinline__ int perm32(int rho) { const int n = rho >> 4, i = rho & 15; return 8 * (i >> 2) + 4 * n + (i & 3); }

struct Unit { int pm, pn; };
struct Gemm { const bf16_t* A; const bf16_t* Bt; int M, N, K; };

struct StaticOrder {
    int nM, nN, nwg, G, c;
    __host__ __device__ void init(int M, int N, int G_, int c_) { nM = M / BM; nN = N / BM; nwg = nM * nN; G = G_; c = c_; }
    __host__ __device__ bool next(int i, Unit& u) const {
        const long L = (long)i * G + c; if (L >= nwg) return false;
        int wgid = (int)L; { const int q = nwg / NXCD, r = nwg % NXCD, xcd = wgid % NXCD, off = wgid / NXCD; wgid = (xcd < r ? xcd * (q + 1) : r * (q + 1) + (xcd - r) * q) + off; }
        const int nig = WGM * nN, gid = wgid / nig, fm = gid * WGM, gsz = (nM - fm) < WGM ? (nM - fm) : WGM;
        u.pm = fm + ((wgid % nig) % gsz); u.pn = (wgid % nig) / gsz; return true;
    }
    __device__ __forceinline__ int btile(const Unit& u) const { return u.pn; }
    __device__ __forceinline__ void a_ready(const Unit&) const {}
    __device__ __forceinline__ void done(const Unit&) const {}
};
struct BatchOrder {
    int G, c;
    __device__ bool next(int i, Unit& u) const { const int L = i * G + c; if (L >= 256) return false; u.pm = L >> 3; u.pn = L & 7; return true; }
    __device__ __forceinline__ int btile(const Unit& u) const { return u.pm * 8 + u.pn; }
    __device__ __forceinline__ void a_ready(const Unit&) const {}
    __device__ __forceinline__ void done(const Unit&) const {}
};

__device__ __forceinline__ unsigned cvt_pk_bf16(float lo, float hi) { f32x2 x = {lo, hi}; bf16x2_t y = __builtin_convertvector(x, bf16x2_t); return __builtin_bit_cast(unsigned, y); }

struct EpiBf16 {
    static constexpr bool PERM = true;
    bf16_t* O; int ldc;
    __device__ __forceinline__ void operator()(const f32x4 (&acc)[2][2][4][2], const Unit& u, int wr, int wc, int fr, int fq) const {
        const int row0 = u.pm * BM + wr * 64 + fr, col0 = u.pn * BM + wc * 32 + 8 * fq;
#pragma unroll
        for (int ai = 0; ai < 2; ++ai)
#pragma unroll
            for (int m = 0; m < 4; ++m) { bf16_t* rowp = O + (size_t)(row0 + ai * HALF + m * 16) * ldc + col0;
#pragma unroll
                for (int bj = 0; bj < 2; ++bj) { const f32x4 v0 = acc[ai][bj][m][0], v1 = acc[ai][bj][m][1];
                    u32x4 w; w.x = cvt_pk_bf16(v0[0], v0[1]); w.y = cvt_pk_bf16(v0[2], v0[3]); w.z = cvt_pk_bf16(v1[0], v1[1]); w.w = cvt_pk_bf16(v1[2], v1[3]);
                    *(u32x4*)(rowp + bj * HALF) = w; } }
    }
};
struct EpiF32 {
    static constexpr bool PERM = false;
    float* C; int ldc;
    __device__ __forceinline__ void operator()(const f32x4 (&acc)[2][2][4][2], const Unit& u, int wr, int wc, int fr, int fq) const {
        const int row0 = u.pm * BM + wr * 64 + fr, col0 = u.pn * BM + wc * 32 + 4 * fq;
#pragma unroll
        for (int ai = 0; ai < 2; ++ai)
#pragma unroll
            for (int m = 0; m < 4; ++m) { float* rowp = C + (size_t)(row0 + ai * HALF + m * 16) * ldc + col0;
#pragma unroll
                for (int bj = 0; bj < 2; ++bj)
#pragma unroll
                    for (int n = 0; n < 2; ++n) *(f32x4*)(rowp + bj * HALF + n * 16) = acc[ai][bj][m][n]; }
    }
};
struct EpiResid {
    static constexpr bool PERM = false;
    const float* xin_lat; const float* xin_ctx;
    float* xout; const float* gate;
    __device__ __forceinline__ void operator()(const f32x4 (&acc)[2][2][4][2], const Unit& u, int wr, int wc, int fr, int fq) const {
        const int rt = u.pm * BM;
        const int mr = rt < TL ? rt / SEQ : 2;
        const float* xin = rt < TL ? xin_lat + (size_t)rt * D : xin_ctx + (size_t)(rt - TL) * D;
        float* xo = xout + (size_t)rt * D;
        const int row0 = wr * 64 + fr, col0 = u.pn * BM + wc * 32 + 4 * fq;
        f32x4 gv[2][2];
#pragma unroll
        for (int bj = 0; bj < 2; ++bj)
#pragma unroll
            for (int n = 0; n < 2; ++n) gv[bj][n] = *(const f32x4*)(gate + (size_t)mr * 12288 + col0 + bj * HALF + n * 16);
#pragma unroll
        for (int ai = 0; ai < 2; ++ai)
#pragma unroll
            for (int m = 0; m < 4; ++m) { const size_t ro = (size_t)(row0 + ai * HALF + m * 16) * D + col0;
#pragma unroll
                for (int bj = 0; bj < 2; ++bj)
#pragma unroll
                    for (int n = 0; n < 2; ++n) { const f32x4 xv = *(const f32x4*)(xin + ro + bj * HALF + n * 16);
                        *(f32x4*)(xo + ro + bj * HALF + n * 16) = xv * DN_ALPHA + gv[bj][n] * acc[ai][bj][m][n]; } }
    }
};

template <class Epi, class Sched, bool ALIGN_EPI = false, bool SP2 = false>
__device__ __forceinline__ void gemm_phase(LAS unsigned char* lds, const Gemm g, const Sched& S, const Epi& E) {
    int tid = threadIdx.x; asm volatile("" : "+v"(tid));
    const int wid = __builtin_amdgcn_readfirstlane(tid >> 6), lane = tid & 63, wr = wid >> 2, wc = wid & 3, fr = lane & 15, fq = lane >> 4;
    const int K = g.K, nt = K / BK;
    unsigned voffA[2], voffB[2];
#pragma unroll
    for (int i = 0; i < 2; ++i) { int R, C; stage_rc(tid * 16 + i * 8192, R, C); const int Rb = Epi::PERM ? ((R & ~31) + perm32(R & 31)) : R;
        voffA[i] = (unsigned)(R * K + C) * 2u; voffB[i] = (unsigned)(Rb * K + C) * 2u; }
    const size_t kstep = (size_t)(BK * 2);
    const size_t hstep = (size_t)HALF * K * 2;
    const size_t tstep = 2 * hstep;
    const unsigned ldsw = (unsigned)wid * 1024u;
    const int aoff = lds_byte(wr * 64 + fr, fq * 8), boff = lds_byte(wc * 32 + fr, fq * 8);
#define PG8_SA(b, h) (((b) * 2 + (h)) * HTB)
#define PG8_SB(b, h) ((4 + (b) * 2 + (h)) * HTB)
#define PG8_STAGE(bufoff, gbase, voff) do { _Pragma("unroll") for (int _i = 0; _i < 2; ++_i) \
        __builtin_amdgcn_global_load_lds((const unsigned*)((const char*)(gbase) + (voff)[_i]), (LAS unsigned*)(lds + (bufoff) + ldsw + _i * 8192), 16, 0, 0); } while (0)
#define PG8_LDA(dst, b, h) do { _Pragma("unroll") for (int m = 0; m < 4; ++m) _Pragma("unroll") for (int k = 0; k < 2; ++k) dst[m][k] = *(const LAS bf16x8*)(lds + PG8_SA(b, h) + aoff + m * 2048 + k * 1024); } while (0)
#define PG8_LDB(dst, b, h) do { _Pragma("unroll") for (int n = 0; n < 2; ++n) _Pragma("unroll") for (int k = 0; k < 2; ++k) dst[n][k] = *(const LAS bf16x8*)(lds + PG8_SB(b, h) + boff + n * 2048 + k * 1024); } while (0)
#define PG8_MMA(ai, bj, At, Bt) do { __builtin_amdgcn_s_setprio(1); _Pragma("unroll") for (int m = 0; m < 4; ++m) _Pragma("unroll") for (int n = 0; n < 2; ++n) _Pragma("unroll") for (int k = 0; k < 2; ++k) \
        acc[ai][bj][m][n] = __builtin_amdgcn_mfma_f32_16x16x32_bf16(Bt[n][k], At[m][k], acc[ai][bj][m][n], 0, 0, 0); __builtin_amdgcn_s_setprio(0); } while (0)
#define PG8_WAIT_V(n) asm volatile("s_waitcnt vmcnt(" #n ")" ::: "memory")
#define PG8_WAIT_L(n) asm volatile("s_waitcnt lgkmcnt(" #n ")" ::: "memory")
#define PG8_BAR __builtin_amdgcn_s_barrier()
#define PG8_SCHED __builtin_amdgcn_sched_barrier(0)
    Unit cur, nxt; int ui = 0;
    if (!S.next(0, cur)) return;
    f32x4 acc[2][2][4][2];
#pragma unroll
    for (int a = 0; a < 2; ++a)
#pragma unroll
        for (int b = 0; b < 2; ++b)
#pragma unroll
            for (int m = 0; m < 4; ++m)
#pragma unroll
                for (int n = 0; n < 2; ++n) acc[a][b][m][n] = (f32x4){0.f, 0.f, 0.f, 0.f};
    bf16x8 At[4][2], B0[2][2], B1[2][2];
    const char* cA = (const char*)g.A + (size_t)cur.pm * tstep; const char* cB = (const char*)g.Bt + (size_t)S.btile(cur) * tstep;
    S.a_ready(cur);
    if constexpr (SP2) {
        PG8_STAGE(PG8_SB(0, 0), cB, voffB); PG8_STAGE(PG8_SB(0, 1), cB + hstep, voffB); PG8_STAGE(PG8_SA(0, 0), cA, voffA); PG8_STAGE(PG8_SA(0, 1), cA + hstep, voffA);
        if (wr == 1) PG8_BAR;
        PG8_WAIT_V(2); PG8_BAR;
        PG8_STAGE(PG8_SB(1, 0), cB + kstep, voffB); PG8_STAGE(PG8_SA(1, 0), cA + kstep, voffA); PG8_STAGE(PG8_SB(1, 1), cB + hstep + kstep, voffB);
        PG8_WAIT_V(6); PG8_BAR;
    } else {
        PG8_STAGE(PG8_SB(0, 0), cB, voffB); PG8_STAGE(PG8_SA(0, 0), cA, voffA); PG8_STAGE(PG8_SB(0, 1), cB + hstep, voffB); PG8_STAGE(PG8_SA(0, 1), cA + hstep, voffA);
        if (wr == 1) PG8_BAR;
        PG8_WAIT_V(4); PG8_BAR;
        PG8_STAGE(PG8_SB(1, 0), cB + kstep, voffB); PG8_STAGE(PG8_SA(1, 0), cA + kstep, voffA); PG8_STAGE(PG8_SB(1, 1), cB + hstep + kstep, voffB);
        PG8_WAIT_V(6); PG8_BAR;
    }
    for (;;) {
        const bool has_next = S.next(ui + 1, nxt);
        const char* nA = has_next ? (const char*)g.A + (size_t)nxt.pm * tstep : cA; const char* nB = has_next ? (const char*)g.Bt + (size_t)S.btile(nxt) * tstep : cB;
        for (int t = 0; t < nt; t += 2) {
            const bool last = (t == nt - 2);
            const char* a1 = cA + (size_t)(t + 1) * kstep;
            const char* a2 = last ? nA : cA + (size_t)(t + 2) * kstep; const char* b2 = last ? nB : cB + (size_t)(t + 2) * kstep;
            const char* a3 = a2 + kstep; const char* b3 = b2 + kstep;
            if (last && has_next) S.a_ready(nxt);
            if constexpr (SP2) {
            PG8_LDB(B0, 0, 0); PG8_LDB(B1, 0, 1); PG8_SCHED; PG8_LDA(At, 0, 0); PG8_STAGE(PG8_SA(1, 1), a1 + hstep, voffA);
            PG8_WAIT_V(8); PG8_WAIT_L(0); PG8_BAR; PG8_MMA(0, 0, At, B0); PG8_MMA(0, 1, At, B1); PG8_BAR; PG8_SCHED;
            PG8_LDA(At, 0, 1); PG8_STAGE(PG8_SB(0, 0), b2, voffB); PG8_STAGE(PG8_SB(0, 1), b2 + hstep, voffB); PG8_STAGE(PG8_SA(0, 0), a2, voffA);
            PG8_WAIT_V(8); PG8_WAIT_L(0); PG8_BAR; PG8_MMA(1, 0, At, B0); PG8_MMA(1, 1, At, B1); PG8_BAR; PG8_SCHED;
            PG8_LDB(B0, 1, 0); PG8_LDB(B1, 1, 1); PG8_SCHED; PG8_LDA(At, 1, 0); PG8_STAGE(PG8_SA(0, 1), a2 + hstep, voffA);
            PG8_WAIT_V(8); PG8_WAIT_L(0); PG8_BAR; PG8_MMA(0, 0, At, B0); PG8_MMA(0, 1, At, B1); PG8_BAR; PG8_SCHED;
            PG8_LDA(At, 1, 1); PG8_STAGE(PG8_SB(1, 0), b3, voffB); PG8_STAGE(PG8_SB(1, 1), b3 + hstep, voffB); PG8_STAGE(PG8_SA(1, 0), a3, voffA);
            PG8_WAIT_V(8); PG8_WAIT_L(0); PG8_BAR; PG8_MMA(1, 0, At, B0); PG8_MMA(1, 1, At, B1); PG8_BAR; PG8_SCHED;
            } else {
            PG8_LDB(B0, 0, 0); PG8_SCHED; PG8_LDA(At, 0, 0); PG8_STAGE(PG8_SA(1, 1), a1 + hstep, voffA);
            PG8_WAIT_L(8); PG8_BAR; PG8_WAIT_L(0); PG8_MMA(0, 0, At, B0); PG8_BAR; PG8_SCHED;
            PG8_LDB(B1, 0, 1); PG8_STAGE(PG8_SB(0, 0), b2, voffB);
            PG8_BAR; PG8_WAIT_L(0); PG8_MMA(0, 1, At, B1); PG8_BAR;
            PG8_LDA(At, 0, 1); PG8_STAGE(PG8_SA(0, 0), a2, voffA);
            PG8_BAR; PG8_WAIT_L(0); PG8_MMA(1, 0, At, B0); PG8_BAR; PG8_SCHED;
            PG8_STAGE(PG8_SB(0, 1), b2 + hstep, voffB);
            PG8_WAIT_V(6); PG8_BAR; PG8_MMA(1, 1, At, B1); PG8_BAR;
            PG8_LDB(B0, 1, 0); PG8_SCHED; PG8_LDA(At, 1, 0); PG8_STAGE(PG8_SA(0, 1), a2 + hstep, voffA);
            PG8_WAIT_L(8); PG8_BAR; PG8_WAIT_L(0); PG8_MMA(0, 0, At, B0); PG8_BAR; PG8_SCHED;
            PG8_LDB(B1, 1, 1); PG8_STAGE(PG8_SB(1, 0), b3, voffB);
            PG8_BAR; PG8_WAIT_L(0); PG8_MMA(0, 1, At, B1); PG8_BAR;
            PG8_LDA(At, 1, 1); PG8_STAGE(PG8_SA(1, 0), a3, voffA);
            PG8_BAR; PG8_WAIT_L(0); PG8_MMA(1, 0, At, B0); PG8_BAR; PG8_SCHED;
            PG8_STAGE(PG8_SB(1, 1), b3 + hstep, voffB);
            PG8_WAIT_V(6); PG8_BAR; PG8_MMA(1, 1, At, B1); PG8_BAR;
            }
        }
        if constexpr (ALIGN_EPI) { if (wr == 0) PG8_BAR; }
        E(acc, cur, wr, wc, fr, fq); S.done(cur);
        if (!has_next) break;
#pragma unroll
        for (int a = 0; a < 2; ++a)
#pragma unroll
            for (int b = 0; b < 2; ++b)
#pragma unroll
                for (int m = 0; m < 4; ++m)
#pragma unroll
                    for (int n = 0; n < 2; ++n) acc[a][b][m][n] = (f32x4){0.f, 0.f, 0.f, 0.f};
        cur = nxt; cA = nA; cB = nB; ++ui;
        if constexpr (ALIGN_EPI) { if (wr == 1) PG8_BAR; }
    }
    PG8_WAIT_V(0);
    if constexpr (!ALIGN_EPI) { if (wr == 0) PG8_BAR; }
    PG8_BAR;
#undef PG8_SA
#undef PG8_SB
#undef PG8_STAGE
#undef PG8_LDA
#undef PG8_LDB
#undef PG8_MMA
#undef PG8_WAIT_V
#undef PG8_WAIT_L
#undef PG8_BAR
#undef PG8_SCHED
}
}

#define XB_TMO      128
#define XB_XCNT(j)  (256  + 64 * (j))
#define XB_XSUB(j)  (1280 + 64 * (j))
#define XB_XGEN(j)  (2304 + 64 * (j))
#define XB_TOP      3328
#define XB_TOPGEN   3392
#define XCD_BAR_WORDS 3456
#define XB_SPIN_CAP (1u << 18)

__device__ __forceinline__ unsigned xb_ld(unsigned* p)              { return __hip_atomic_load(p, __ATOMIC_RELAXED, __HIP_MEMORY_SCOPE_AGENT); }
__device__ __forceinline__ unsigned xb_add(unsigned* p, unsigned v) { return __hip_atomic_fetch_add(p, v, __ATOMIC_RELAXED, __HIP_MEMORY_SCOPE_AGENT); }
__device__ __forceinline__ unsigned xb_xcc_id() { return (unsigned)__builtin_amdgcn_s_getreg((3 << 11) | 20) & 0xFu; }
#define XB_SPIN(cond, bar) do { unsigned _sp = 0; while (cond) { __builtin_amdgcn_s_sleep(1); \
    if ((++_sp & 255u) == 0u) { if (xb_ld(&(bar)[XB_TMO])) break; if (_sp > XB_SPIN_CAP) { atomicAdd(&(bar)[XB_TMO], 1u); break; } } } } while (0)

struct XcdBarrier { unsigned* bar; unsigned x; volatile LAS unsigned* st; };

__device__ __forceinline__ XcdBarrier xcd_barrier_post(unsigned* bar, volatile LAS unsigned* st) {
    XcdBarrier b; b.bar = bar; b.x = xb_xcc_id(); b.st = st;
    if (threadIdx.x == 0) (void)xb_add(&bar[XB_XCNT(b.x)], 1u);
    return b;
}
__device__ __forceinline__ void xcd_barrier_complete(unsigned* bar, unsigned x, unsigned& nloc, unsigned& nx) {
    const unsigned G = gridDim.x * gridDim.y * gridDim.z;
    unsigned sum, cnt, mine, sp = 0u;
    for (;;) {
        sum = 0u; cnt = 0u; mine = 0u;
#pragma unroll
        for (unsigned j = 0; j < 16; ++j) { const unsigned c = xb_ld(&bar[XB_XCNT(j)]); sum += c; cnt += (c > 0u) ? 1u : 0u; mine = (j == x) ? c : mine; }
        if (sum == G) break;
        __builtin_amdgcn_s_sleep(1);
        if ((++sp & 255u) == 0u) { if (xb_ld(&bar[XB_TMO])) break; if (sp > XB_SPIN_CAP) { atomicAdd(&bar[XB_TMO], 1u); break; } }
    }
    nloc = mine > 0u ? mine : 1u; nx = cnt > 0u ? cnt : 1u;
}
__device__ __forceinline__ void xcd_barrier(const XcdBarrier& b) {
    asm volatile("s_waitcnt vmcnt(0)" ::: "memory");
    __syncthreads();
    if (threadIdx.x == 0) {
        unsigned* bar = b.bar;
        __builtin_amdgcn_s_waitcnt(0);
        unsigned nloc = b.st[0], nx = b.st[1];
        if (nloc == 0u) { xcd_barrier_complete(bar, b.x, nloc, nx); b.st[0] = nloc; b.st[1] = nx; }
        const unsigned old = xb_add(&bar[XB_XSUB(b.x)], 1u);
        const unsigned gen = old / nloc;
        if (old + 1u == (gen + 1u) * nloc) {
            __builtin_amdgcn_fence(__ATOMIC_RELEASE, "agent");
            asm volatile("s_waitcnt vmcnt(0)" ::: "memory");
            const unsigned og = xb_add(&bar[XB_TOP], 1u);
            const unsigned tg = og / nx;
            if (og + 1u == (tg + 1u) * nx) xb_add(&bar[XB_TOPGEN], 1u);
            else XB_SPIN(xb_ld(&bar[XB_TOPGEN]) == tg, bar);
            __builtin_amdgcn_fence(__ATOMIC_ACQUIRE, "agent");
            xb_add(&bar[XB_XGEN(b.x)], 1u);
            asm volatile("s_waitcnt vmcnt(0)" ::: "memory");
        } else {
            XB_SPIN(xb_ld(&bar[XB_XGEN(b.x)]) == gen, bar);
            __builtin_amdgcn_fence(__ATOMIC_ACQUIRE, "agent");
            asm volatile("s_waitcnt vmcnt(0)" ::: "memory");
        }
    }
    __syncthreads();
}

constexpr int NWAVES = 8;
constexpr int RING_BYTES = 131072;
constexpr int LDSCTL_OFF = RING_BYTES, MISC_OFF = LDSCTL_OFF + 320;
constexpr int LDS_BYTES = 147456;
constexpr int NPHASE = 2 + 6 * NLAYER;

#define LDS_WAIT() asm volatile("s_waitcnt lgkmcnt(0)" ::: "memory")

struct Args { const float* in[20]; float* out; unsigned char* ws; int ph_lo, ph_hi, li, pad; };

struct Frame {
    LAS unsigned char* lds;
    int tid, lane, wave, G, gw, NGW;
    const float *x, *c, *ctx, *c_ctx, *w_ada, *b_ada, *w_in, *conv_w, *sink, *g_attn, *g_conv, *w_out, *ln1_g, *ln1_b, *wq, *keys, *pu, *pv, *ln2_g, *ln2_b;
    float* out;
    float *MODS, *ROPE, *X, *SC;
    bf16_t *KBD, *WQR, *WINT, *WOUTT, *WEFFT, *H, *PROJ, *MIX;
    unsigned char *UT, *VT; float *US, *VS;
};

__device__ __forceinline__ void frame_ids(Frame& F) {
    int tz = threadIdx.x; asm volatile("" : "+v"(tz));
    F.tid = tz; F.lane = tz & 63; F.wave = __builtin_amdgcn_readfirstlane(tz >> 6);
    F.gw = blockIdx.x * NWAVES + F.wave;
}
__device__ __forceinline__ float wave_sum(float v) {
#pragma unroll
    for (int o = 1; o < 64; o <<= 1) v += __shfl_xor(v, o);
    return v;
}
__device__ __forceinline__ unsigned pk2(float lo, float hi) { return pg8::cvt_pk_bf16(lo, hi); }
__device__ __forceinline__ float bf_lo(unsigned u) { return __uint_as_float(u << 16); }
__device__ __forceinline__ float bf_hi(unsigned u) { return __uint_as_float(u & 0xffff0000u); }
__device__ __forceinline__ int modrow(int t) { return t < TL ? t / SEQ : 2; }

__device__ __forceinline__ void transpose_item(const float* W, int K, int N, bf16_t* WT, LAS float* scr, int item, int lane) {
    const int nblk = N / 32, kb = item / nblk, nb = item % nblk, k0 = 64 * kb, n0 = 32 * nb;
#pragma unroll 8
    for (int i = 0; i < 32; ++i) { const int kk = 2 * i + (lane >> 5); scr[kk * 33 + (lane & 31)] = W[(size_t)(k0 + kk) * N + n0 + (lane & 31)]; }
    LDS_WAIT(); asm volatile("" ::: "memory");
    const int c = lane & 7;
#pragma unroll
    for (int j = 0; j < 4; ++j) { const int n = (lane >> 3) + 8 * j; const LAS float* s = scr + (8 * c) * 33 + n;
        u32x4 o; o.x = pk2(s[0 * 33], s[1 * 33]); o.y = pk2(s[2 * 33], s[3 * 33]); o.z = pk2(s[4 * 33], s[5 * 33]); o.w = pk2(s[6 * 33], s[7 * 33]);
        *(u32x4*)(WT + (size_t)(n0 + n) * K + k0 + 8 * c) = o; }
    LDS_WAIT(); asm volatile("" ::: "memory");
}

__device__ __forceinline__ void cvt_row_bf16(const float* src, bf16_t* dst, int lane) {
    const f32x4* s = (const f32x4*)src + lane; u32x2* d = (u32x2*)dst + lane;
    f32x4 v[8];
#pragma unroll
    for (int j = 0; j < 8; ++j) v[j] = __builtin_nontemporal_load(s + 64 * j);
#pragma unroll
    for (int j = 0; j < 8; ++j) { u32x2 o; o.x = pk2(v[j].x, v[j].y); o.y = pk2(v[j].z, v[j].w); d[64 * j] = o; }
}

__device__ __forceinline__ void cvt_row_fp8(const float* src, unsigned char* dst, float* inv, int lane) {
    const f32x4* s = (const f32x4*)src + lane; unsigned* d = (unsigned*)dst + lane;
    f32x4 v[8]; float am = 0.f;
#pragma unroll
    for (int j = 0; j < 8; ++j) v[j] = __builtin_nontemporal_load(s + 64 * j);
#pragma unroll
    for (int j = 0; j < 8; ++j) am = fmaxf(fmaxf(am, fmaxf(fabsf(v[j].x), fabsf(v[j].y))), fmaxf(fabsf(v[j].z), fabsf(v[j].w)));
#pragma unroll
    for (int o = 1; o < 64; o <<= 1) am = fmaxf(am, __shfl_xor(am, o));
    const float sc = am > 0.f ? 224.f / am : 1.f;
#pragma unroll
    for (int j = 0; j < 8; ++j) { int w = __builtin_amdgcn_cvt_pk_fp8_f32(v[j].x * sc, v[j].y * sc, 0, false); w = __builtin_amdgcn_cvt_pk_fp8_f32(v[j].z * sc, v[j].w * sc, w, true); d[64 * j] = (unsigned)w; }
    if (lane == 0) *inv = am > 0.f ? am * (1.f / 224.f) : 1.f;
}

__device__ __forceinline__ void row_stats(const f32x4 (&v)[8], float& mean, float& rstd) {
    float s = 0.f;
#pragma unroll
    for (int j = 0; j < 8; ++j) s += (v[j].x + v[j].y) + (v[j].z + v[j].w);
    mean = wave_sum(s) * (1.f / D);
    float s2 = 0.f;
#pragma unroll
    for (int j = 0; j < 8; ++j) { const f32x4 d = v[j] - mean; s2 += (d.x * d.x + d.y * d.y) + (d.z * d.z + d.w * d.w); }
    rstd = 1.f / sqrtf(wave_sum(s2) * (1.f / D) + LN_EPS);
}
__device__ __forceinline__ void modulate_store(const f32x4 (&v)[8], const float* shift, const float* scale, bf16_t* dst, int lane) {
    float mean, rstd; row_stats(v, mean, rstd);
    u32x2* d = (u32x2*)dst + lane;
#pragma unroll
    for (int j = 0; j < 8; ++j) { const f32x4 sc = *((const f32x4*)scale + lane + 64 * j), sh = *((const f32x4*)shift + lane + 64 * j);
        const f32x4 y = (v[j] - mean) * rstd * (sc + 1.f) + sh;
        u32x2 o; o.x = pk2(y.x, y.y); o.y = pk2(y.z, y.w); d[64 * j] = o; }
}

__device__ __forceinline__ void p0a_prologue(Frame& F) {
    LAS float* condL = (LAS float*)F.lds;
    LAS float* red = (LAS float*)(F.lds + 24576);
    for (int i = F.tid; i < 3 * D; i += NWAVES * 64) { const int r = i / D, k = i % D; const float v = r < 2 ? F.c[r * D + k] : F.c_ctx[k]; condL[i] = v / (1.f + __expf(-v)); }
    __syncthreads();
    for (int item = blockIdx.x; item < 384; item += F.G) {
        const int l = item / 96, n0 = (item % 96) * 128;
        const float* wp = F.w_ada + ((size_t)l * D + F.wave * 256) * 12288 + n0 + 2 * F.lane;
        f32x2 a0 = {0.f, 0.f}, a1 = {0.f, 0.f}, a2 = {0.f, 0.f};
#pragma unroll 8
        for (int k = 0; k < 256; ++k) { const f32x2 w = __builtin_nontemporal_load((const f32x2*)(wp + (size_t)k * 12288)); const int kk = F.wave * 256 + k;
            a0 += w * condL[kk]; a1 += w * condL[D + kk]; a2 += w * condL[2 * D + kk]; }
        LAS float* rp = red + F.wave * 384 + 2 * F.lane;
        rp[0] = a0.x; rp[1] = a0.y; rp[128] = a1.x; rp[129] = a1.y; rp[256] = a2.x; rp[257] = a2.y;
        __syncthreads();
        if (F.tid < 384) { const int r = F.tid / 128, n = F.tid % 128; float s = 0.f;
#pragma unroll
            for (int w = 0; w < 8; ++w) s += red[w * 384 + r * 128 + n];
            F.MODS[((size_t)l * 3 + r) * 12288 + n0 + n] = s + F.b_ada[(size_t)l * 12288 + n0 + n]; }
        __syncthreads();
    }
    LAS float* scr = (LAS float*)(F.lds + 40960 + F.wave * 8448);
    constexpr int I_IN = (D / 64) * (INC / 32), I_OUT = (D / 64) * (D / 32);
    for (int it = F.gw; it < NLAYER * (I_IN + I_OUT); it += F.NGW) {
        const int l = it / (I_IN + I_OUT); int r = it % (I_IN + I_OUT);
        if (r < I_IN) transpose_item(F.w_in + (size_t)l * D * INC, D, INC, F.WINT + (size_t)l * INC * D, scr, r, F.lane);
        else transpose_item(F.w_out + (size_t)l * D * D, D, D, F.WOUTT + (size_t)l * D * D, scr, r - I_IN, F.lane);
    }
    for (int row = F.gw; row < NLAYER * D; row += F.NGW) {
        const int l = row / D, c = row % D; const f32x4* s = (const f32x4*)(F.wq + (size_t)row * D) + F.lane;
#pragma unroll
        for (int j = 0; j < 8; ++j) { const f32x4 v = s[64 * j]; u32x2 o; o.x = pk2(v.x, v.y); o.y = pk2(v.z, v.w);
            *((u32x2*)(F.WQR + ((size_t)(l * 8 + j) * D + c) * 256) + F.lane) = o; }
    }
    for (int row = F.gw; row < 32 * 256; row += F.NGW) {
        const int lh = row >> 8, pk = row & 255, p = pk >> 7;
        u32x2 o = {0u, 0u};
        if ((F.lane >> 5) == p) { const f32x4 v = *((const f32x4*)(F.keys + ((size_t)lh * 256 + pk) * 128) + (F.lane & 31)); o.x = pk2(v.x, v.y); o.y = pk2(v.z, v.w); }
        *((u32x2*)(F.KBD + (size_t)row * 256) + F.lane) = o;
    }
    for (int row = F.gw; row < NLAYER * NEXP; row += F.NGW) {
        cvt_row_fp8(F.pu + (size_t)row * D, F.UT + (size_t)row * D, F.US + row, F.lane);
        cvt_row_fp8(F.pv + (size_t)row * D, F.VT + (size_t)row * D, F.VS + row, F.lane);
    }
    for (int i = blockIdx.x * (NWAVES * 64) + F.tid; i < 192 * 32; i += F.G * NWAVES * 64) {
        const int idx = i >> 5, f = i & 31; const float pos = (float)(idx < 128 ? idx : idx - 128);
        const float inv = powf(10000.f, -(float)(2 * f) / 64.f); const float ang = pos * inv;
        F.ROPE[2 * i] = cosf(ang); F.ROPE[2 * i + 1] = sinf(ang);
    }
}

__device__ __forceinline__ void p0b_mod0(Frame& F) {
    for (int t = F.gw; t < TT; t += F.NGW) {
        const float* src = t < TL ? F.x + (size_t)t * D : F.ctx + (size_t)(t - TL) * D;
        f32x4 v[8];
#pragma unroll
        for (int j = 0; j < 8; ++j) v[j] = *((const f32x4*)src + F.lane + 64 * j);
        const float* mp = F.MODS + (size_t)modrow(t) * 12288;
        modulate_store(v, mp, mp + D, F.H + (size_t)t * D, F.lane);
    }
}

constexpr int KP = 272, VP = 320, KS_BYTES = 64 * KP, VS_BYTES = 64 * VP;
struct KVRegs { u32x4 k1, k2, v1, v2; f32x4 cs[4]; };

__device__ __forceinline__ void attn_load_tile(Frame& F, KVRegs& R, int ti, int b, int n, int g) {
    const int key = F.tid >> 3, c8 = F.tid & 7;
    int row, pos = 0;
    if (ti < 6) { pos = (n - 1) * 128 + 64 * ti + key; row = b * SEQ + pos; } else row = TL + b * CTXL + 64 * (ti - 6) + key;
    const bf16_t* base = F.PROJ + (size_t)row * INC;
    const int d1 = (c8 >> 2) * 64 + (c8 & 3) * 8;
    R.k1 = *(const u32x4*)(base + OFF_K + g * 128 + d1); R.k2 = *(const u32x4*)(base + OFF_K + g * 128 + d1 + 32);
    R.v1 = *(const u32x4*)(base + OFF_V + g * 128 + 8 * c8); R.v2 = *(const u32x4*)(base + OFF_V + g * 128 + 64 + 8 * c8);
    if (ti < 6) { const int tidx = (c8 >> 2) ? 128 + (pos & 63) : (pos >> 6); const f32x4* cp = (const f32x4*)(F.ROPE + ((size_t)tidx * 32 + (c8 & 3) * 8) * 2);
#pragma unroll
        for (int m = 0; m < 4; ++m) R.cs[m] = cp[m]; }
}
__device__ __forceinline__ void rope8(u32x4& a, u32x4& bq, const f32x4 (&cs)[4], float scale) {
    u32x4 oa, ob;
#pragma unroll
    for (int w = 0; w < 4; ++w) {
        const float x1l = bf_lo(a[w]), x1h = bf_hi(a[w]), x2l = bf_lo(bq[w]), x2h = bf_hi(bq[w]);
        const float cl = cs[w].x, sl = cs[w].y, ch = cs[w].z, sh = cs[w].w;
        oa[w] = pk2((x1l * cl - x2l * sl) * scale, (x1h * ch - x2h * sh) * scale);
        ob[w] = pk2((x2l * cl + x1l * sl) * scale, (x2h * ch + x1h * sh) * scale);
    }
    a = oa; bq = ob;
}
__device__ __forceinline__ void attn_store_tile(Frame& F, KVRegs& R, int ti, int buf) {
    const int key = F.tid >> 3, c8 = F.tid & 7;
    if (ti < 6) rope8(R.k1, R.k2, R.cs, 1.f);
    const int d1 = (c8 >> 2) * 64 + (c8 & 3) * 8;
    LAS unsigned char* kp = F.lds + buf * KS_BYTES + key * KP;
    *(LAS u32x4*)(kp + d1 * 2) = R.k1; *(LAS u32x4*)(kp + (d1 + 32) * 2) = R.k2;
    LAS unsigned char* vp = F.lds + 2 * KS_BYTES + buf * VS_BYTES + key * VP;
    *(LAS u32x4*)(vp + 16 * c8) = R.v1; *(LAS u32x4*)(vp + 128 + 16 * c8) = R.v2;
}

#define MFMA32(a, b, c) __builtin_amdgcn_mfma_f32_32x32x16_bf16((a), (b), (c), 0, 0, 0)

__device__ __forceinline__ void attn_unit(Frame& F, int layer, int u) {
    const bool latent = u < 512;
    int b, n, g, hp;
    if (latent) { hp = u & 1; g = (u >> 1) & 1; n = (u >> 2) & 63; b = u >> 8; }
    else { const int v = u - 512; hp = v & 1; g = (v >> 1) & 1; n = (v >> 2) & 1; b = v >> 3; }
    const int lane = F.lane, r = lane & 31, h = lane >> 5, wave = F.wave;
    const int head = g * 4 + hp * 2 + (wave >> 2), qb = wave & 3;
    const int tq = latent ? b * SEQ + n * 128 + 32 * qb + r : TL + b * CTXL + n * 128 + 32 * qb + r;
    bf16x8 qf[8];
    {
        u32x4 raw[8];
        const bf16_t* qp = F.PROJ + (size_t)tq * INC + OFF_Q + head * 128 + 8 * h;
#pragma unroll
        for (int ks = 0; ks < 8; ++ks) raw[ks] = *(const u32x4*)(qp + 16 * ks);
        if (latent) {
            const int pos = n * 128 + 32 * qb + r;
#pragma unroll
            for (int half = 0; half < 2; ++half) {
                const int tidx = half ? 128 + (pos & 63) : (pos >> 6);
#pragma unroll
                for (int kk = 0; kk < 2; ++kk) {
                    const f32x4* cp = (const f32x4*)(F.ROPE + ((size_t)tidx * 32 + 16 * kk + 8 * h) * 2);
                    f32x4 cs[4];
#pragma unroll
                    for (int m = 0; m < 4; ++m) cs[m] = cp[m];
                    rope8(raw[4 * half + kk], raw[4 * half + kk + 2], cs, QSCALE);
                }
            }
        } else {
#pragma unroll
            for (int ks = 0; ks < 8; ++ks)
#pragma unroll
                for (int w = 0; w < 4; ++w) raw[ks][w] = pk2(bf_lo(raw[ks][w]) * QSCALE, bf_hi(raw[ks][w]) * QSCALE);
        }
#pragma unroll
        for (int ks = 0; ks < 8; ++ks) qf[ks] = __builtin_bit_cast(bf16x8, raw[ks]);
    }
    int tlo = 6, nw = 0;
    if (latent) { tlo = (n == 0) ? 2 : 0; const int thi = (n == 63) ? 3 : 5; nw = thi - tlo + 1; }
    const int ntiles = nw + 4;
    f32x16 o[4];
#pragma unroll
    for (int db = 0; db < 4; ++db)
#pragma unroll
        for (int i = 0; i < 16; ++i) o[db][i] = 0.f;
    float m_run = F.sink[layer * 8 + head] * LOG2E;
    float lsum = h == 0 ? 1.f : 0.f;
    const int iq = 32 * qb + r;
    KVRegs R;
    __syncthreads();
    attn_load_tile(F, R, nw > 0 ? tlo : 6, b, n, g);
    attn_store_tile(F, R, nw > 0 ? tlo : 6, 0);
    __syncthreads();
    const int i16 = lane & 15, tq4 = i16 >> 2, tp = i16 & 3, blk = (lane >> 4) & 1;
    for (int j = 0; j < ntiles; ++j) {
        const int ti = j < nw ? tlo + j : 6 + (j - nw);
        const int buf = j & 1;
        const bool more = j + 1 < ntiles;
        const int tin = (j + 1) < nw ? tlo + j + 1 : 6 + (j + 1 - nw);
        if (more) attn_load_tile(F, R, tin, b, n, g);
        const bool part = ti >= 6 || (ti >= (qb >> 1) && ti <= (qb >> 1) + 4);
        if (part) {
            f32x16 s0, s1;
#pragma unroll
            for (int i = 0; i < 16; ++i) { s0[i] = 0.f; s1[i] = 0.f; }
            const LAS unsigned char* kb = F.lds + buf * KS_BYTES + r * KP + h * 16;
#pragma unroll
            for (int ks = 0; ks < 8; ++ks) {
                const bf16x8 a0 = *(const LAS bf16x8*)(kb + ks * 32), a1 = *(const LAS bf16x8*)(kb + 32 * KP + ks * 32);
                s0 = MFMA32(a0, qf[ks], s0); s1 = MFMA32(a1, qf[ks], s1);
            }
            float mx = -INFINITY;
            if (ti < 6) {
                const int jb = 64 * ti + 4 * h - iq;
#pragma unroll
                for (int i = 0; i < 16; ++i) { const int j0 = jb + (i & 3) + 8 * (i >> 2), j1 = j0 + 32;
                    s0[i] = (j0 >= 0 && j0 <= 256) ? s0[i] : -INFINITY; s1[i] = (j1 >= 0 && j1 <= 256) ? s1[i] : -INFINITY; }
            }
#pragma unroll
            for (int i = 0; i < 16; ++i) mx = fmaxf(mx, fmaxf(s0[i], s1[i]));
            mx = fmaxf(mx, __shfl_xor(mx, 32));
            const float m_new = fmaxf(m_run, mx), alpha = exp2f(m_run - m_new);
            m_run = m_new; lsum *= alpha;
#pragma unroll
            for (int i = 0; i < 16; ++i) { s0[i] = exp2f(s0[i] - m_new); s1[i] = exp2f(s1[i] - m_new); lsum += s0[i] + s1[i]; }
#pragma unroll
            for (int db = 0; db < 4; ++db)
#pragma unroll
                for (int i = 0; i < 16; ++i) o[db][i] *= alpha;
            bf16x8 pf[2][2];
#pragma unroll
            for (int s2 = 0; s2 < 2; ++s2) {
                u32x4 p0, p1;
#pragma unroll
                for (int w = 0; w < 4; ++w) { p0[w] = pk2(s0[8 * s2 + 2 * w], s0[8 * s2 + 2 * w + 1]); p1[w] = pk2(s1[8 * s2 + 2 * w], s1[8 * s2 + 2 * w + 1]); }
                pf[0][s2] = __builtin_bit_cast(bf16x8, p0); pf[1][s2] = __builtin_bit_cast(bf16x8, p1);
            }
            const LAS unsigned char* vb = F.lds + 2 * KS_BYTES + buf * VS_BYTES + (4 * h + tq4) * VP + 32 * blk + 8 * tp;
#pragma unroll
            for (int db = 0; db < 4; ++db)
#pragma unroll
                for (int kb2 = 0; kb2 < 2; ++kb2)
#pragma unroll
                    for (int s2 = 0; s2 < 2; ++s2) {
                        const int off = (32 * kb2 + 16 * s2) * VP + db * 64;
                        const s16x4 lo = __builtin_amdgcn_ds_read_tr16_b64_v4i16((LAS s16x4*)(vb + off));
                        const s16x4 hi = __builtin_amdgcn_ds_read_tr16_b64_v4i16((LAS s16x4*)(vb + off + 8 * VP));
                        const bf16x8 av = __builtin_shufflevector(lo, hi, 0, 1, 2, 3, 4, 5, 6, 7);
                        o[db] = MFMA32(av, pf[kb2][s2], o[db]);
                    }
        }
        if (more) attn_store_tile(F, R, tin, buf ^ 1);
        __syncthreads();
    }
    const float lt = lsum + __shfl_xor(lsum, 32);
    const float inv = 1.f / lt;
    float ss = 0.f;
#pragma unroll
    for (int db = 0; db < 4; ++db)
#pragma unroll
        for (int i = 0; i < 16; ++i) { o[db][i] *= inv; ss += o[db][i] * o[db][i]; }
    ss += __shfl_xor(ss, 32);
    const float rn = 1.f / sqrtf(ss * (1.f / 128.f) + LN_EPS);
    bf16_t* op = F.MIX + (size_t)tq * D + head * 128 + 4 * h;
    const float* gp = F.g_attn + layer * 1024 + head * 128 + 4 * h;
#pragma unroll
    for (int db = 0; db < 4; ++db)
#pragma unroll
        for (int g4 = 0; g4 < 4; ++g4) {
            const f32x4 gv = *(const f32x4*)(gp + 32 * db + 8 * g4);
            u32x2 w; w.x = pk2(o[db][4 * g4] * rn * gv.x, o[db][4 * g4 + 1] * rn * gv.y); w.y = pk2(o[db][4 * g4 + 2] * rn * gv.z, o[db][4 * g4 + 3] * rn * gv.w);
            *(u32x2*)(op + 32 * db + 8 * g4) = w;
        }
}

__device__ __forceinline__ void unpack8(const u32x4 v, float (&f)[8]) {
#pragma unroll
    for (int w = 0; w < 4; ++w) { f[2 * w] = bf_lo(v[w]); f[2 * w + 1] = bf_hi(v[w]); }
}
__device__ __forceinline__ void conv_row(Frame& F, int layer, int t) {
    bool first, last;
    if (t < TL) { const int pos = t & (SEQ - 1); first = pos == 0; last = pos == SEQ - 1; } else { const int pc = (t - TL) & (CTXL - 1); first = pc == 0; last = pc == CTXL - 1; }
    const bf16_t* p = F.PROJ + (size_t)t * INC;
    const float* cw = F.conv_w + (size_t)layer * 3 * 1024;
#pragma unroll
    for (int jc = 0; jc < 2; ++jc) {
        const int c = 8 * F.lane + 512 * jc;
        float gb[8], a[8], bq[8], um[8], ut[8], up[8];
        unpack8(*(const u32x4*)(p + c), gb);
        unpack8(*(const u32x4*)(p + OFF_C + c), a); unpack8(*(const u32x4*)(p + OFF_X + c), bq);
#pragma unroll
        for (int e = 0; e < 8; ++e) ut[e] = a[e] * bq[e];
        if (!first) { unpack8(*(const u32x4*)(p - INC + OFF_C + c), a); unpack8(*(const u32x4*)(p - INC + OFF_X + c), bq);
#pragma unroll
            for (int e = 0; e < 8; ++e) um[e] = a[e] * bq[e]; }
        else {
#pragma unroll
            for (int e = 0; e < 8; ++e) um[e] = 0.f; }
        if (!last) { unpack8(*(const u32x4*)(p + INC + OFF_C + c), a); unpack8(*(const u32x4*)(p + INC + OFF_X + c), bq);
#pragma unroll
            for (int e = 0; e < 8; ++e) up[e] = a[e] * bq[e]; }
        else {
#pragma unroll
            for (int e = 0; e < 8; ++e) up[e] = 0.f; }
        float y[8], ss = 0.f;
#pragma unroll
        for (int e = 0; e < 8; ++e) { y[e] = gb[e] * (cw[c + e] * um[e] + cw[1024 + c + e] * ut[e] + cw[2048 + c + e] * up[e]); ss += y[e] * y[e]; }
        ss += __shfl_xor(ss, 1); ss += __shfl_xor(ss, 2); ss += __shfl_xor(ss, 4); ss += __shfl_xor(ss, 8);
        const float rn = 1.f / sqrtf(ss * (1.f / 128.f) + LN_EPS);
        const float* gc = F.g_conv + layer * 1024 + c;
        u32x4 w;
#pragma unroll
        for (int q = 0; q < 4; ++q) w[q] = pk2(y[2 * q] * rn * gc[2 * q], y[2 * q + 1] * rn * gc[2 * q + 1]);
        *(u32x4*)(F.MIX + (size_t)t * D + 1024 + c) = w;
    }
}

__device__ __forceinline__ void ln_phase(Frame& F, int layer, int rows) {
    for (int t = F.gw; t < rows; t += F.NGW) {
        float* xr = F.X + (size_t)t * D;
        f32x4 v[8];
#pragma unroll
        for (int j = 0; j < 8; ++j) v[j] = *((const f32x4*)xr + F.lane + 64 * j);
        float mean, rstd; row_stats(v, mean, rstd);
        const float* g1 = F.ln1_g + layer * D; const float* b1 = F.ln1_b + layer * D;
#pragma unroll
        for (int j = 0; j < 8; ++j) { const f32x4 gg = *((const f32x4*)g1 + F.lane + 64 * j), bb = *((const f32x4*)b1 + F.lane + 64 * j);
            v[j] = (v[j] - mean) * rstd * gg + bb; *((f32x4*)xr + F.lane + 64 * j) = v[j]; }
        const float* mp = F.MODS + ((size_t)layer * 3 + modrow(t)) * 12288;
        modulate_store(v, mp + 3 * D, mp + 4 * D, F.H + (size_t)t * D, F.lane);
    }
}

__device__ __forceinline__ unsigned ordkey(float f) { const unsigned u = __float_as_uint(f); return u ^ ((u >> 31) ? 0xFFFFFFFFu : 0x80000000u); }
__device__ __forceinline__ float gelu_erf(float a) { return 0.5f * a * (1.f + erff(a * 0.70710678118654752f)); }

__device__ __forceinline__ void peer_topk(Frame& F, LAS unsigned char* ws, int t) {
    const int lane = F.lane; const bool hi = lane >= 32; const int l31 = lane & 31;
    LAS float* s1v = (LAS float*)ws; LAS int* s1i = (LAS int*)(ws + 128);
    LAS float* fv = (LAS float*)(ws + 256); LAS int* fi = (LAS int*)(ws + 320);
    LAS int* EL = (LAS int*)(ws + 512); LAS float* GL = (LAS float*)(ws + 1024);
    const unsigned lm = (1u << l31) - 1u;
    for (int hd = 0; hd < 8; ++hd) {
        const f32x4 sv = *((const f32x4*)(F.SC + (size_t)t * D + hd * 256) + lane);
        unsigned k[4];
#pragma unroll
        for (int j = 0; j < 4; ++j) k[j] = ordkey(sv[j]);
        unsigned T0 = 0u, T1 = 0u;
        for (int bit = 31; bit >= 0; --bit) {
            const unsigned c0 = T0 | (1u << bit), c1 = T1 | (1u << bit);
            const unsigned cand = hi ? c1 : c0;
            int n0 = 0, n1 = 0;
#pragma unroll
            for (int j = 0; j < 4; ++j) { const unsigned long long m = __ballot(k[j] >= cand); n0 += __popc((unsigned)m); n1 += __popc((unsigned)(m >> 32)); }
            if (n0 >= 16) T0 = c0;
            if (n1 >= 16) T1 = c1;
        }
        {
            const unsigned thr = hi ? T1 : T0; int base = 0; const int hb = hi ? 16 : 0;
#pragma unroll
            for (int j = 0; j < 4; ++j) { const bool gt = k[j] > thr; const unsigned long long m = __ballot(gt); const unsigned mh = hi ? (unsigned)(m >> 32) : (unsigned)m;
                const int pos = base + __popc(mh & lm); if (gt) { s1v[hb + pos] = sv[j]; s1i[hb + pos] = 4 * l31 + j; } base += __popc(mh); }
#pragma unroll
            for (int j = 0; j < 4; ++j) { const bool eq = k[j] == thr; const unsigned long long m = __ballot(eq); const unsigned mh = hi ? (unsigned)(m >> 32) : (unsigned)m;
                const int pos = base + __popc(mh & lm); if (eq && pos < 16) { s1v[hb + pos] = sv[j]; s1i[hb + pos] = 4 * l31 + j; } base += __popc(mh); }
        }
        LDS_WAIT(); __builtin_amdgcn_wave_barrier();
        const int a = lane >> 2, b0 = (lane & 3) * 4;
        const float av = s1v[a]; const int ai = s1i[a];
        float cv[4]; int ce[4]; unsigned ck[4];
#pragma unroll
        for (int j = 0; j < 4; ++j) { cv[j] = av + s1v[16 + b0 + j]; ce[j] = ai * 128 + s1i[16 + b0 + j]; ck[j] = ordkey(cv[j]); }
        unsigned T2 = 0u;
        for (int bit = 31; bit >= 0; --bit) {
            const unsigned c2 = T2 | (1u << bit); int nn = 0;
#pragma unroll
            for (int j = 0; j < 4; ++j) nn += __popcll(__ballot(ck[j] >= c2));
            if (nn >= 16) T2 = c2;
        }
        {
            const unsigned long long lm64 = (1ull << lane) - 1ull; int base = 0;
#pragma unroll
            for (int j = 0; j < 4; ++j) { const bool gt = ck[j] > T2; const unsigned long long m = __ballot(gt);
                const int pos = base + __popcll(m & lm64); if (gt) { fv[pos] = cv[j]; fi[pos] = ce[j]; } base += __popcll(m); }
#pragma unroll
            for (int j = 0; j < 4; ++j) { const bool eq = ck[j] == T2; const unsigned long long m = __ballot(eq);
                const int pos = base + __popcll(m & lm64); if (eq && pos < 16) { fv[pos] = cv[j]; fi[pos] = ce[j]; } base += __popcll(m); }
        }
        LDS_WAIT(); __builtin_amdgcn_wave_barrier();
        float mxv = -INFINITY, f16v[16];
#pragma unroll
        for (int i = 0; i < 16; ++i) { f16v[i] = fv[i]; mxv = fmaxf(mxv, f16v[i]); }
        float den = 0.f;
#pragma unroll
        for (int i = 0; i < 16; ++i) den += __expf(f16v[i] - mxv);
        if (lane < 16) { GL[hd * 16 + lane] = __expf(fv[lane] - mxv) / den; EL[hd * 16 + lane] = fi[lane]; }
        LDS_WAIT(); __builtin_amdgcn_wave_barrier();
    }
}

constexpr int EB = 4;
__device__ __forceinline__ void peer_phase(Frame& F, int layer, int rows) {
    LAS unsigned char* ws = F.lds + F.wave * 2048;
    LAS int* EL = (LAS int*)(ws + 512); LAS float* GL = (LAS float*)(ws + 1024);
    const int lane = F.lane;
    const unsigned char* UTl = F.UT + (size_t)layer * NEXP * D + 16 * lane;
    const unsigned char* VTl = F.VT + (size_t)layer * NEXP * D + 16 * lane;
    const float* USl = F.US + (size_t)layer * NEXP; const float* VSl = F.VS + (size_t)layer * NEXP;
    for (int t = F.gw; t < rows; t += F.NGW) {
        peer_topk(F, ws, t);
        float hv[32], acc[32];
#pragma unroll
        for (int j = 0; j < 2; ++j)
#pragma unroll
            for (int q = 0; q < 2; ++q) { float f[8]; unpack8(*(const u32x4*)(F.H + (size_t)t * D + 16 * lane + 1024 * j + 8 * q), f);
#pragma unroll
                for (int e = 0; e < 8; ++e) { hv[16 * j + 8 * q + e] = f[e]; acc[16 * j + 8 * q + e] = 0.f; } }
        for (int i0 = 0; i0 < 128; i0 += EB) {
            int ex[EB]; float gx[EB];
#pragma unroll
            for (int q = 0; q < EB; ++q) { ex[q] = __builtin_amdgcn_readfirstlane(EL[i0 + q]); gx[q] = __uint_as_float(__builtin_amdgcn_readfirstlane(__float_as_uint(GL[i0 + q]))); }
            u32x4 uu[EB][2], vv[EB][2]; float su[EB], sv[EB];
#pragma unroll
            for (int q = 0; q < EB; ++q) {
#pragma unroll
                for (int j = 0; j < 2; ++j) { uu[q][j] = *(const u32x4*)(UTl + (size_t)ex[q] * D + 1024 * j); vv[q][j] = *(const u32x4*)(VTl + (size_t)ex[q] * D + 1024 * j); }
                su[q] = USl[ex[q]]; sv[q] = VSl[ex[q]]; }
            float dot[EB];
#pragma unroll
            for (int q = 0; q < EB; ++q) { float s = 0.f;
#pragma unroll
                for (int j = 0; j < 2; ++j)
#pragma unroll
                    for (int w = 0; w < 4; ++w) { const f32x2 lo = __builtin_amdgcn_cvt_pk_f32_fp8((int)uu[q][j][w], false), hi2 = __builtin_amdgcn_cvt_pk_f32_fp8((int)uu[q][j][w], true);
                        s += lo.x * hv[16 * j + 4 * w] + lo.y * hv[16 * j + 4 * w + 1]; s += hi2.x * hv[16 * j + 4 * w + 2] + hi2.y * hv[16 * j + 4 * w + 3]; }
                dot[q] = s; }
#pragma unroll
            for (int q = 0; q < EB; ++q) dot[q] = wave_sum(dot[q]);
#pragma unroll
            for (int q = 0; q < EB; ++q) { const float cf = gx[q] * gelu_erf(dot[q] * su[q]) * sv[q];
#pragma unroll
                for (int j = 0; j < 2; ++j)
#pragma unroll
                    for (int w = 0; w < 4; ++w) { const f32x2 lo = __builtin_amdgcn_cvt_pk_f32_fp8((int)vv[q][j][w], false), hi2 = __builtin_amdgcn_cvt_pk_f32_fp8((int)vv[q][j][w], true);
                        acc[16 * j + 4 * w] += cf * lo.x; acc[16 * j + 4 * w + 1] += cf * lo.y; acc[16 * j + 4 * w + 2] += cf * hi2.x; acc[16 * j + 4 * w + 3] += cf * hi2.y; } }
        }
        const int mr = modrow(t);
        const float* mp = F.MODS + ((size_t)layer * 3 + mr) * 12288;
        float* xr = F.X + (size_t)t * D;
        float rr[32]; float s = 0.f;
#pragma unroll
        for (int j = 0; j < 2; ++j)
#pragma unroll
            for (int q = 0; q < 4; ++q) { const int c = 16 * lane + 1024 * j + 4 * q; const f32x4 xv = *(const f32x4*)(xr + c), gv = *(const f32x4*)(mp + 5 * D + c);
#pragma unroll
                for (int e = 0; e < 4; ++e) { const float v = DN_ALPHA * xv[e] + gv[e] * acc[16 * j + 4 * q + e]; rr[16 * j + 4 * q + e] = v; s += v; } }
        const float mean = wave_sum(s) * (1.f / D);
        float s2 = 0.f;
#pragma unroll
        for (int i = 0; i < 32; ++i) { rr[i] -= mean; s2 += rr[i] * rr[i]; }
        const float rstd = 1.f / sqrtf(wave_sum(s2) * (1.f / D) + LN_EPS);
        const float* g2 = F.ln2_g + layer * D; const float* b2 = F.ln2_b + layer * D;
        float s3 = 0.f;
#pragma unroll
        for (int j = 0; j < 2; ++j)
#pragma unroll
            for (int q = 0; q < 4; ++q) { const int c = 16 * lane + 1024 * j + 4 * q; const f32x4 gg = *(const f32x4*)(g2 + c), bb = *(const f32x4*)(b2 + c);
                f32x4 xo;
#pragma unroll
                for (int e = 0; e < 4; ++e) { xo[e] = rr[16 * j + 4 * q + e] * rstd * gg[e] + bb[e]; rr[16 * j + 4 * q + e] = xo[e]; s3 += xo[e]; }
                if (layer < NLAYER - 1) *(f32x4*)(xr + c) = xo; else if (t < TL) *(f32x4*)(F.out + (size_t)t * D + c) = xo; }
        if (layer < NLAYER - 1) {
            const float mean2 = wave_sum(s3) * (1.f / D);
            float s4 = 0.f;
#pragma unroll
            for (int i = 0; i < 32; ++i) { rr[i] -= mean2; s4 += rr[i] * rr[i]; }
            const float rstd2 = 1.f / sqrtf(wave_sum(s4) * (1.f / D) + LN_EPS);
            const float* np = F.MODS + ((size_t)(layer + 1) * 3 + mr) * 12288;
#pragma unroll
            for (int j = 0; j < 2; ++j)
#pragma unroll
                for (int q2 = 0; q2 < 2; ++q2) { const int c = 16 * lane + 1024 * j + 8 * q2; u32x4 w;
#pragma unroll
                    for (int q = 0; q < 2; ++q) { const f32x4 sh = *(const f32x4*)(np + c + 4 * q), sc = *(const f32x4*)(np + D + c + 4 * q); const int ri = 16 * j + 8 * q2 + 4 * q;
                        const float y0 = rr[ri] * rstd2 * (1.f + sc[0]) + sh[0], y1 = rr[ri + 1] * rstd2 * (1.f + sc[1]) + sh[1];
                        const float y2 = rr[ri + 2] * rstd2 * (1.f + sc[2]) + sh[2], y3 = rr[ri + 3] * rstd2 * (1.f + sc[3]) + sh[3];
                        w[2 * q] = pk2(y0, y1); w[2 * q + 1] = pk2(y2, y3); }
                    *(u32x4*)(F.H + (size_t)t * D + c) = w; }
        }
    }
}

__global__ void __launch_bounds__(NWAVES * 64, 2) skel_fwd(Args args) {
    extern __shared__ __attribute__((aligned(16))) unsigned char lds[];
    Frame F;
    F.lds = (LAS unsigned char*)lds;
    F.tid = threadIdx.x; F.lane = F.tid & 63; F.wave = __builtin_amdgcn_readfirstlane(F.tid >> 6);
    F.G = gridDim.x; F.gw = blockIdx.x * NWAVES + F.wave; F.NGW = F.G * NWAVES;
    unsigned char* ws = args.ws;
    F.x = args.in[0]; F.c = args.in[1]; F.ctx = args.in[2]; F.c_ctx = args.in[3]; F.w_ada = args.in[4]; F.b_ada = args.in[5]; F.w_in = args.in[6]; F.conv_w = args.in[7];
    F.sink = args.in[8]; F.g_attn = args.in[9]; F.g_conv = args.in[10]; F.w_out = args.in[11]; F.ln1_g = args.in[12]; F.ln1_b = args.in[13]; F.wq = args.in[14]; F.keys = args.in[15];
    F.pu = args.in[16]; F.pv = args.in[17]; F.ln2_g = args.in[18]; F.ln2_b = args.in[19]; F.out = args.out;
    F.MODS = (float*)(ws + WS_MODS); F.ROPE = (float*)(ws + WS_ROPE); F.X = (float*)(ws + WS_X); F.SC = (float*)(ws + WS_SC);
    F.KBD = (bf16_t*)(ws + WS_KBD); F.WQR = (bf16_t*)(ws + WS_WQR); F.WINT = (bf16_t*)(ws + WS_WINT); F.WOUTT = (bf16_t*)(ws + WS_WOUTT); F.WEFFT = (bf16_t*)(ws + WS_WEFFT);
    F.H = (bf16_t*)(ws + WS_H); F.PROJ = (bf16_t*)(ws + WS_PROJ); F.MIX = (bf16_t*)(ws + WS_MIX); F.UT = ws + WS_UT; F.VT = ws + WS_VT; F.US = (float*)(ws + WS_US); F.VS = (float*)(ws + WS_VS);
    for (int u = F.tid; u < (LDS_BYTES - LDSCTL_OFF) / 4; u += NWAVES * 64) ((LAS unsigned*)(F.lds + LDSCTL_OFF))[u] = 0u;
    __syncthreads();
    unsigned* ctl = (unsigned*)(ws + WS_CTL);
    const int lo = args.ph_lo, hi = args.ph_hi;
    XcdBarrier bar; bar.bar = ctl + CW_BAR + args.li * XCD_BAR_WORDS; bar.x = 0; bar.st = nullptr;
    if (hi - lo > 1) bar = xcd_barrier_post(ctl + CW_BAR + args.li * XCD_BAR_WORDS, (volatile LAS unsigned*)(F.lds + MISC_OFF) + 8);
#define IN(k) (lo <= (k) && (k) < hi)
#define BOTH(k) (IN(k) && IN((k) + 1))
#define SEAM(k) do { if (BOTH(k)) xcd_barrier(bar); } while (0)

    if (IN(0)) { frame_ids(F); p0a_prologue(F); SEAM(0); }
    if (IN(1)) {
        frame_ids(F);
        { pg8::Gemm g{F.KBD, F.WQR, 32 * 256, 2048, 256}; pg8::BatchOrder S{F.G, (int)blockIdx.x}; pg8::EpiBf16 E{F.WEFFT, D};
          pg8::gemm_phase<pg8::EpiBf16, pg8::BatchOrder, false, true>(F.lds, g, S, E); }
        p0b_mod0(F);
        SEAM(1);
    }
    for (int layer = 0; layer < NLAYER; ++layer) {
        const int pb = 2 + 6 * layer;
        const bool lastl = layer == NLAYER - 1;
        const int rows = lastl ? TL : TT;
        if (IN(pb + 0)) {
            frame_ids(F);
            pg8::Gemm g{F.H, F.WINT + (size_t)layer * INC * D, TT, INC, D}; pg8::StaticOrder S; S.init(TT, INC, F.G, (int)blockIdx.x);
            pg8::EpiBf16 E{F.PROJ, INC};
            pg8::gemm_phase<pg8::EpiBf16, pg8::StaticOrder, true, true>(F.lds, g, S, E);
            SEAM(pb + 0);
        }
        if (IN(pb + 1)) {
            frame_ids(F);
            const int nunits = lastl ? 512 : 528;
            for (int u = blockIdx.x; u < nunits; u += F.G) attn_unit(F, layer, u);
            for (int t = F.gw; t < rows; t += F.NGW) conv_row(F, layer, t);
            SEAM(pb + 1);
        }
        if (IN(pb + 2)) {
            frame_ids(F);
            pg8::Gemm g{F.MIX, F.WOUTT + (size_t)layer * D * D, rows, D, D}; pg8::StaticOrder S; S.init(rows, D, F.G, (int)blockIdx.x);
            pg8::EpiResid E{layer == 0 ? F.x : F.X, layer == 0 ? F.ctx : F.X + (size_t)TL * D, F.X, F.MODS + (size_t)layer * 3 * 12288 + 2 * D};
            pg8::gemm_phase<pg8::EpiResid, pg8::StaticOrder, true, true>(F.lds, g, S, E);
            SEAM(pb + 2);
        }
        if (IN(pb + 3)) { frame_ids(F); ln_phase(F, layer, rows); SEAM(pb + 3); }
        if (IN(pb + 4)) {
            frame_ids(F);
            pg8::Gemm g{F.H, F.WEFFT + (size_t)layer * D * D, rows, D, D}; pg8::StaticOrder S; S.init(rows, D, F.G, (int)blockIdx.x);
            pg8::EpiF32 E{F.SC, D};
            pg8::gemm_phase<pg8::EpiF32, pg8::StaticOrder, true, true>(F.lds, g, S, E);
            SEAM(pb + 4);
        }
        if (IN(pb + 5)) { frame_ids(F); peer_phase(F, layer, rows); SEAM(pb + 5); }
    }
#undef IN
#undef BOTH
#undef SEAM
}

extern "C" void kernel_launch(void* const* d_in, const int* in_sizes, int n_in, void* d_out, int out_size, void* d_ws, size_t ws_size, hipStream_t stream) {
    static int grid = 0;
    if (grid == 0) {
        if (n_in != 20 || in_sizes[0] != TL * D || out_size != TL * D || ws_size < WS_END) {
            fprintf(stderr, "kernel_launch: unexpected problem shape (n_in %d, in0 %d, out %d, ws %zu, need %zu)\n", n_in, n_in > 0 ? in_sizes[0] : -1, out_size, ws_size, (size_t)WS_END); grid = -1; return; }
        int dev = 0, cus = 0, per_cu = 0;
        if (hipGetDevice(&dev) != hipSuccess || hipDeviceGetAttribute(&cus, hipDeviceAttributeMultiprocessorCount, dev) != hipSuccess) { grid = -1; return; }
        if (hipFuncSetAttribute((const void*)skel_fwd, hipFuncAttributeMaxDynamicSharedMemorySize, LDS_BYTES) != hipSuccess) { fprintf(stderr, "kernel_launch: hipFuncSetAttribute failed\n"); grid = -1; return; }
        if (hipOccupancyMaxActiveBlocksPerMultiprocessor(&per_cu, (const void*)skel_fwd, NWAVES * 64, LDS_BYTES) != hipSuccess || per_cu < 1)
            fprintf(stderr, "kernel_launch: occupancy query reports %d workgroups per CU\n", per_cu);
        (void)hipGetLastError();
        grid = cus;
    }
    if (grid < 0) return;
    if (hipMemsetAsync((char*)d_ws + WS_CTL, 0, CTL_ZERO_BYTES, stream) != hipSuccess) return;
    Args a{};
    for (int i = 0; i < 20; ++i) a.in[i] = (const float*)d_in[i];
    a.out = (float*)d_out; a.ws = (unsigned char*)d_ws; a.pad = 0;
#if MK_N_LAUNCHES == 1
    a.ph_lo = 0; a.ph_hi = NPHASE; a.li = 0;
    hipLaunchKernelGGL(skel_fwd, dim3(grid), dim3(NWAVES * 64), LDS_BYTES, stream, a);
#else
    for (int ph = 0; ph < NPHASE; ++ph) { a.ph_lo = ph; a.ph_hi = ph + 1; a.li = 0;
        hipLaunchKernelGGL(skel_fwd, dim3(grid), dim3(NWAVES * 64), LDS_BYTES, stream, a); }
#endif
}
```

```cpp
#include <hip/hip_runtime.h>
#include <cstdio>
#include <cstdint>

#ifndef MK_N_LAUNCHES
#define MK_N_LAUNCHES 1
#endif

#define LAS __attribute__((address_space(3)))
typedef unsigned short bf16_t;
typedef short bf16x8 __attribute__((ext_vector_type(8)));
typedef short s16x4 __attribute__((ext_vector_type(4)));
typedef float f32x2 __attribute__((ext_vector_type(2)));
typedef float f32x4 __attribute__((ext_vector_type(4)));
typedef float f32x16 __attribute__((ext_vector_type(16)));
typedef unsigned u32x2 __attribute__((ext_vector_type(2)));
typedef unsigned u32x4 __attribute__((ext_vector_type(4)));
typedef __bf16 bf16x2_t __attribute__((ext_vector_type(2)));

constexpr int D = 2048, NB = 2, SEQ = 8192, CTXL = 256, NLAYER = 4;
constexpr int TL = NB * SEQ, TC = NB * CTXL, TT = TL + TC;
constexpr int INC = 4608, OFF_C = 1024, OFF_X = 2048, OFF_Q = 3072, OFF_K = 4096, OFF_V = 4352;
constexpr int NEXP = 16384;
#ifndef U_FMT
#define U_FMT 4
#endif
#ifndef V_FMT
#define V_FMT 4
#endif
constexpr int UROW = D * U_FMT / 8, VROW = D * V_FMT / 8;
constexpr float LN_EPS = 1e-6f;
constexpr float DN_ALPHA = 1.681792830507429f;
constexpr float QSCALE = 0.08838834764831845f * 1.4426950408889634f;
constexpr float LOG2E = 1.4426950408889634f;

constexpr size_t MiB = 1u << 20;
constexpr size_t WS_CTL = 0, CTL_ZERO_BYTES = 1 * MiB;
constexpr size_t WS_MODS = 1 * MiB;
constexpr size_t WS_ROPE = 2 * MiB;
constexpr size_t WS_KBD = 3 * MiB;
constexpr size_t WS_WQR = 8 * MiB;
constexpr size_t WS_WINT = 40 * MiB;
constexpr size_t WS_WOUTT = 112 * MiB;
constexpr size_t WS_WEFFT = 144 * MiB;
constexpr size_t WS_X = 176 * MiB;
constexpr size_t WS_H = 308 * MiB;
constexpr size_t WS_PROJ = 374 * MiB;
constexpr size_t WS_MIX = 523 * MiB;
constexpr size_t WS_SC = 589 * MiB;
constexpr size_t WS_UT = 721 * MiB;
constexpr size_t WS_VT = 849 * MiB;
constexpr size_t WS_US = 977 * MiB;
constexpr size_t WS_VS = 978 * MiB;
constexpr size_t WS_END = 979 * MiB;

constexpr int CW_BAR = 4096;

namespace pg8 {
constexpr int BM = 256, BK = 64, HALF = 128, HTB = HALF * BK * 2, STAGE_BYTES = 8 * HTB, NXCD = 8, WGM = 8;
__host__ __device__ __forceinline__ int lds_byte(int r, int c) { const int st = (r >> 4) * 2 + (c >> 5), rr = r & 15, cc = c & 31, ob = rr * 64 + cc * 2; return st * 1024 + (ob ^ (((ob >> 9) & 1) << 5)); }
__host__ __device__ __forceinline__ void stage_rc(int b, int& R, int& C) { const int st = b / 1024, sb = b % 1024, swz = sb ^ (((sb >> 9) & 1) << 5); R = (st >> 1) * 16 + swz / 64; C = (st & 1) * 32 + (swz % 64) / 2; }
__host__ __device__ __forceinline__ int perm32(int rho) { const int n = rho >> 4, i = rho & 15; return 8 * (i >> 2) + 4 * n + (i & 3); }

struct Unit { int pm, pn; };
struct Gemm { const bf16_t* A; const bf16_t* Bt; int M, N, K; };

struct StaticOrder {
    int nM, nN, nwg, G, c;
    __host__ __device__ void init(int M, int N, int G_, int c_) { nM = M / BM; nN = N / BM; nwg = nM * nN; G = G_; c = c_; }
    __host__ __device__ bool next(int i, Unit& u) const {
        const long L = (long)i * G + c; if (L >= nwg) return false;
        int wgid = (int)L; { const int q = nwg / NXCD, r = nwg % NXCD, xcd = wgid % NXCD, off = wgid / NXCD; wgid = (xcd < r ? xcd * (q + 1) : r * (q + 1) + (xcd - r) * q) + off; }
        const int nig = WGM * nN, gid = wgid / nig, fm = gid * WGM, gsz = (nM - fm) < WGM ? (nM - fm) : WGM;
        u.pm = fm + ((wgid % nig) % gsz); u.pn = (wgid % nig) / gsz; return true;
    }
    __device__ __forceinline__ int btile(const Unit& u) const { return u.pn; }
    __device__ __forceinline__ void a_ready(const Unit&) const {}
    __device__ __forceinline__ void done(const Unit&) const {}
};
struct BatchOrder {
    int G, c;
    __device__ bool next(int i, Unit& u) const { const int L = i * G + c; if (L >= 256) return false; u.pm = L >> 3; u.pn = L & 7; return true; }
    __device__ __forceinline__ int btile(const Unit& u) const { return u.pm * 8 + u.pn; }
    __device__ __forceinline__ void a_ready(const Unit&) const {}
    __device__ __forceinline__ void done(const Unit&) const {}
};

__device__ __forceinline__ unsigned cvt_pk_bf16(float lo, float hi) { f32x2 x = {lo, hi}; bf16x2_t y = __builtin_convertvector(x, bf16x2_t); return __builtin_bit_cast(unsigned, y); }

struct EpiBf16 {
    static constexpr bool PERM = true;
    bf16_t* O; int ldc;
    __device__ __forceinline__ void operator()(const f32x4 (&acc)[2][2][4][2], const Unit& u, int wr, int wc, int fr, int fq) const {
        const int row0 = u.pm * BM + wr * 64 + fr, col0 = u.pn * BM + wc * 32 + 8 * fq;
#pragma unroll
        for (int ai = 0; ai < 2; ++ai)
#pragma unroll
            for (int m = 0; m < 4; ++m) { bf16_t* rowp = O + (size_t)(row0 + ai * HALF + m * 16) * ldc + col0;
#pragma unroll
                for (int bj = 0; bj < 2; ++bj) { const f32x4 v0 = acc[ai][bj][m][0], v1 = acc[ai][bj][m][1];
                    u32x4 w; w.x = cvt_pk_bf16(v0[0], v0[1]); w.y = cvt_pk_bf16(v0[2], v0[3]); w.z = cvt_pk_bf16(v1[0], v1[1]); w.w = cvt_pk_bf16(v1[2], v1[3]);
                    *(u32x4*)(rowp + bj * HALF) = w; } }
    }
};
struct EpiF32 {
    static constexpr bool PERM = false;
    float* C; int ldc;
    __device__ __forceinline__ void operator()(const f32x4 (&acc)[2][2][4][2], const Unit& u, int wr, int wc, int fr, int fq) const {
        const int row0 = u.pm * BM + wr * 64 + fr, col0 = u.pn * BM + wc * 32 + 4 * fq;
#pragma unroll
        for (int ai = 0; ai < 2; ++ai)
#pragma unroll
            for (int m = 0; m < 4; ++m) { float* rowp = C + (size_t)(row0 + ai * HALF + m * 16) * ldc + col0;
#pragma unroll
                for (int bj = 0; bj < 2; ++bj)
#pragma unroll
                    for (int n = 0; n < 2; ++n) *(f32x4*)(rowp + bj * HALF + n * 16) = acc[ai][bj][m][n]; }
    }
};
struct EpiResid {
    static constexpr bool PERM = false;
    const float* xin_lat; const float* xin_ctx;
    float* xout; const float* gate;
    __device__ __forceinline__ void operator()(const f32x4 (&acc)[2][2][4][2], const Unit& u, int wr, int wc, int fr, int fq) const {
        const int rt = u.pm * BM;
        const int mr = rt < TL ? rt / SEQ : 2;
        const float* xin = rt < TL ? xin_lat + (size_t)rt * D : xin_ctx + (size_t)(rt - TL) * D;
        float* xo = xout + (size_t)rt * D;
        const int row0 = wr * 64 + fr, col0 = u.pn * BM + wc * 32 + 4 * fq;
        f32x4 gv[2][2];
#pragma unroll
        for (int bj = 0; bj < 2; ++bj)
#pragma unroll
            for (int n = 0; n < 2; ++n) gv[bj][n] = *(const f32x4*)(gate + (size_t)mr * 12288 + col0 + bj * HALF + n * 16);
#pragma unroll
        for (int ai = 0; ai < 2; ++ai)
#pragma unroll
            for (int m = 0; m < 4; ++m) { const size_t ro = (size_t)(row0 + ai * HALF + m * 16) * D + col0;
#pragma unroll
                for (int bj = 0; bj < 2; ++bj)
#pragma unroll
                    for (int n = 0; n < 2; ++n) { const f32x4 xv = *(const f32x4*)(xin + ro + bj * HALF + n * 16);
                        *(f32x4*)(xo + ro + bj * HALF + n * 16) = xv * DN_ALPHA + gv[bj][n] * acc[ai][bj][m][n]; } }
    }
};

template <class Epi, class Sched, bool ALIGN_EPI = false, bool SP2 = false>
__device__ __forceinline__ void gemm_phase(LAS unsigned char* lds, const Gemm g, const Sched& S, const Epi& E) {
    int tid = threadIdx.x; asm volatile("" : "+v"(tid));
    const int wid = __builtin_amdgcn_readfirstlane(tid >> 6), lane = tid & 63, wr = wid >> 2, wc = wid & 3, fr = lane & 15, fq = lane >> 4;
    const int K = g.K, nt = K / BK;
    unsigned voffA[2], voffB[2];
#pragma unroll
    for (int i = 0; i < 2; ++i) { int R, C; stage_rc(tid * 16 + i * 8192, R, C); const int Rb = Epi::PERM ? ((R & ~31) + perm32(R & 31)) : R;
        voffA[i] = (unsigned)(R * K + C) * 2u; voffB[i] = (unsigned)(Rb * K + C) * 2u; }
    const size_t kstep = (size_t)(BK * 2);
    const size_t hstep = (size_t)HALF * K * 2;
    const size_t tstep = 2 * hstep;
    const unsigned ldsw = (unsigned)wid * 1024u;
    const int aoff = lds_byte(wr * 64 + fr, fq * 8), boff = lds_byte(wc * 32 + fr, fq * 8);
#define PG8_SA(b, h) (((b) * 2 + (h)) * HTB)
#define PG8_SB(b, h) ((4 + (b) * 2 + (h)) * HTB)
#define PG8_STAGE(bufoff, gbase, voff) do { _Pragma("unroll") for (int _i = 0; _i < 2; ++_i) \
        __builtin_amdgcn_global_load_lds((const unsigned*)((const char*)(gbase) + (voff)[_i]), (LAS unsigned*)(lds + (bufoff) + ldsw + _i * 8192), 16, 0, 0); } while (0)
#define PG8_LDA(dst, b, h) do { _Pragma("unroll") for (int m = 0; m < 4; ++m) _Pragma("unroll") for (int k = 0; k < 2; ++k) dst[m][k] = *(const LAS bf16x8*)(lds + PG8_SA(b, h) + aoff + m * 2048 + k * 1024); } while (0)
#define PG8_LDB(dst, b, h) do { _Pragma("unroll") for (int n = 0; n < 2; ++n) _Pragma("unroll") for (int k = 0; k < 2; ++k) dst[n][k] = *(const LAS bf16x8*)(lds + PG8_SB(b, h) + boff + n * 2048 + k * 1024); } while (0)
#define PG8_MMA(ai, bj, At, Bt) do { __builtin_amdgcn_s_setprio(1); _Pragma("unroll") for (int m = 0; m < 4; ++m) _Pragma("unroll") for (int n = 0; n < 2; ++n) _Pragma("unroll") for (int k = 0; k < 2; ++k) \
        acc[ai][bj][m][n] = __builtin_amdgcn_mfma_f32_16x16x32_bf16(Bt[n][k], At[m][k], acc[ai][bj][m][n], 0, 0, 0); __builtin_amdgcn_s_setprio(0); } while (0)
#define PG8_WAIT_V(n) asm volatile("s_waitcnt vmcnt(" #n ")" ::: "memory")
#define PG8_WAIT_L(n) asm volatile("s_waitcnt lgkmcnt(" #n ")" ::: "memory")
#define PG8_BAR __builtin_amdgcn_s_barrier()
#define PG8_SCHED __builtin_amdgcn_sched_barrier(0)
    Unit cur, nxt; int ui = 0;
    if (!S.next(0, cur)) return;
    f32x4 acc[2][2][4][2];
#pragma unroll
    for (int a = 0; a < 2; ++a)
#pragma unroll
        for (int b = 0; b < 2; ++b)
#pragma unroll
            for (int m = 0; m < 4; ++m)
#pragma unroll
                for (int n = 0; n < 2; ++n) acc[a][b][m][n] = (f32x4){0.f, 0.f, 0.f, 0.f};
    bf16x8 At[4][2], B0[2][2], B1[2][2];
    const char* cA = (const char*)g.A + (size_t)cur.pm * tstep; const char* cB = (const char*)g.Bt + (size_t)S.btile(cur) * tstep;
    S.a_ready(cur);
    if constexpr (SP2) {
        PG8_STAGE(PG8_SB(0, 0), cB, voffB); PG8_STAGE(PG8_SB(0, 1), cB + hstep, voffB); PG8_STAGE(PG8_SA(0, 0), cA, voffA); PG8_STAGE(PG8_SA(0, 1), cA + hstep, voffA);
        if (wr == 1) PG8_BAR;
        PG8_WAIT_V(2); PG8_BAR;
        PG8_STAGE(PG8_SB(1, 0), cB + kstep, voffB); PG8_STAGE(PG8_SA(1, 0), cA + kstep, voffA); PG8_STAGE(PG8_SB(1, 1), cB + hstep + kstep, voffB);
        PG8_WAIT_V(6); PG8_BAR;
    } else {
        PG8_STAGE(PG8_SB(0, 0), cB, voffB); PG8_STAGE(PG8_SA(0, 0), cA, voffA); PG8_STAGE(PG8_SB(0, 1), cB + hstep, voffB); PG8_STAGE(PG8_SA(0, 1), cA + hstep, voffA);
        if (wr == 1) PG8_BAR;
        PG8_WAIT_V(4); PG8_BAR;
        PG8_STAGE(PG8_SB(1, 0), cB + kstep, voffB); PG8_STAGE(PG8_SA(1, 0), cA + kstep, voffA); PG8_STAGE(PG8_SB(1, 1), cB + hstep + kstep, voffB);
        PG8_WAIT_V(6); PG8_BAR;
    }
    for (;;) {
        const bool has_next = S.next(ui + 1, nxt);
        const char* nA = has_next ? (const char*)g.A + (size_t)nxt.pm * tstep : cA; const char* nB = has_next ? (const char*)g.Bt + (size_t)S.btile(nxt) * tstep : cB;
        for (int t = 0; t < nt; t += 2) {
            const bool last = (t == nt - 2);
            const char* a1 = cA + (size_t)(t + 1) * kstep;
            const char* a2 = last ? nA : cA + (size_t)(t + 2) * kstep; const char* b2 = last ? nB : cB + (size_t)(t + 2) * kstep;
            const char* a3 = a2 + kstep; const char* b3 = b2 + kstep;
            if (last && has_next) S.a_ready(nxt);
            if constexpr (SP2) {
            PG8_LDB(B0, 0, 0); PG8_LDB(B1, 0, 1); PG8_SCHED; PG8_LDA(At, 0, 0); PG8_STAGE(PG8_SA(1, 1), a1 + hstep, voffA);
            PG8_WAIT_V(8); PG8_WAIT_L(0); PG8_BAR; PG8_MMA(0, 0, At, B0); PG8_MMA(0, 1, At, B1); PG8_BAR; PG8_SCHED;
            PG8_LDA(At, 0, 1); PG8_STAGE(PG8_SB(0, 0), b2, voffB); PG8_STAGE(PG8_SB(0, 1), b2 + hstep, voffB); PG8_STAGE(PG8_SA(0, 0), a2, voffA);
            PG8_WAIT_V(8); PG8_WAIT_L(0); PG8_BAR; PG8_MMA(1, 0, At, B0); PG8_MMA(1, 1, At, B1); PG8_BAR; PG8_SCHED;
            PG8_LDB(B0, 1, 0); PG8_LDB(B1, 1, 1); PG8_SCHED; PG8_LDA(At, 1, 0); PG8_STAGE(PG8_SA(0, 1), a2 + hstep, voffA);
            PG8_WAIT_V(8); PG8_WAIT_L(0); PG8_BAR; PG8_MMA(0, 0, At, B0); PG8_MMA(0, 1, At, B1); PG8_BAR; PG8_SCHED;
            PG8_LDA(At, 1, 1); PG8_STAGE(PG8_SB(1, 0), b3, voffB); PG8_STAGE(PG8_SB(1, 1), b3 + hstep, voffB); PG8_STAGE(PG8_SA(1, 0), a3, voffA);
            PG8_WAIT_V(8); PG8_WAIT_L(0); PG8_BAR; PG8_MMA(1, 0, At, B0); PG8_MMA(1, 1, At, B1); PG8_BAR; PG8_SCHED;
            } else {
            PG8_LDB(B0, 0, 0); PG8_SCHED; PG8_LDA(At, 0, 0); PG8_STAGE(PG8_SA(1, 1), a1 + hstep, voffA);
            PG8_WAIT_L(8); PG8_BAR; PG8_WAIT_L(0); PG8_MMA(0, 0, At, B0); PG8_BAR; PG8_SCHED;
            PG8_LDB(B1, 0, 1); PG8_STAGE(PG8_SB(0, 0), b2, voffB);
            PG8_BAR; PG8_WAIT_L(0); PG8_MMA(0, 1, At, B1); PG8_BAR;
            PG8_LDA(At, 0, 1); PG8_STAGE(PG8_SA(0, 0), a2, voffA);
            PG8_BAR; PG8_WAIT_L(0); PG8_MMA(1, 0, At, B0); PG8_BAR; PG8_SCHED;
            PG8_STAGE(PG8_SB(0, 1), b2 + hstep, voffB);
            PG8_WAIT_V(6); PG8_BAR; PG8_MMA(1, 1, At, B1); PG8_BAR;
            PG8_LDB(B0, 1, 0); PG8_SCHED; PG8_LDA(At, 1, 0); PG8_STAGE(PG8_SA(0, 1), a2 + hstep, voffA);
            PG8_WAIT_L(8); PG8_BAR; PG8_WAIT_L(0); PG8_MMA(0, 0, At, B0); PG8_BAR; PG8_SCHED;
            PG8_LDB(B1, 1, 1); PG8_STAGE(PG8_SB(1, 0), b3, voffB);
            PG8_BAR; PG8_WAIT_L(0); PG8_MMA(0, 1, At, B1); PG8_BAR;
            PG8_LDA(At, 1, 1); PG8_STAGE(PG8_SA(1, 0), a3, voffA);
            PG8_BAR; PG8_WAIT_L(0); PG8_MMA(1, 0, At, B0); PG8_BAR; PG8_SCHED;
            PG8_STAGE(PG8_SB(1, 1), b3 + hstep, voffB);
            PG8_WAIT_V(6); PG8_BAR; PG8_MMA(1, 1, At, B1); PG8_BAR;
            }
        }
        if constexpr (ALIGN_EPI) { if (wr == 0) PG8_BAR; }
        E(acc, cur, wr, wc, fr, fq); S.done(cur);
        if (!has_next) break;
#pragma unroll
        for (int a = 0; a < 2; ++a)
#pragma unroll
            for (int b = 0; b < 2; ++b)
#pragma unroll
                for (int m = 0; m < 4; ++m)
#pragma unroll
                    for (int n = 0; n < 2; ++n) acc[a][b][m][n] = (f32x4){0.f, 0.f, 0.f, 0.f};
        cur = nxt; cA = nA; cB = nB; ++ui;
        if constexpr (ALIGN_EPI) { if (wr == 1) PG8_BAR; }
    }
    PG8_WAIT_V(0);
    if constexpr (!ALIGN_EPI) { if (wr == 0) PG8_BAR; }
    PG8_BAR;
#undef PG8_SA
#undef PG8_SB
#undef PG8_STAGE
#undef PG8_LDA
#undef PG8_LDB
#undef PG8_MMA
#undef PG8_WAIT_V
#undef PG8_WAIT_L
#undef PG8_BAR
#undef PG8_SCHED
}
}

#define XB_TMO      128
#define XB_XCNT(j)  (256  + 64 * (j))
#define XB_XSUB(j)  (1280 + 64 * (j))
#define XB_XGEN(j)  (2304 + 64 * (j))
#define XB_TOP      3328
#define XB_TOPGEN   3392
#define XCD_BAR_WORDS 3456
#define XB_SPIN_CAP (1u << 18)

__device__ __forceinline__ unsigned xb_ld(unsigned* p)              { return __hip_atomic_load(p, __ATOMIC_RELAXED, __HIP_MEMORY_SCOPE_AGENT); }
__device__ __forceinline__ unsigned xb_add(unsigned* p, unsigned v) { return __hip_atomic_fetch_add(p, v, __ATOMIC_RELAXED, __HIP_MEMORY_SCOPE_AGENT); }
__device__ __forceinline__ unsigned xb_xcc_id() { return (unsigned)__builtin_amdgcn_s_getreg((3 << 11) | 20) & 0xFu; }
#define XB_SPIN(cond, bar) do { unsigned _sp = 0; while (cond) { __builtin_amdgcn_s_sleep(1); \
    if ((++_sp & 255u) == 0u) { if (xb_ld(&(bar)[XB_TMO])) break; if (_sp > XB_SPIN_CAP) { atomicAdd(&(bar)[XB_TMO], 1u); break; } } } } while (0)

struct XcdBarrier { unsigned* bar; unsigned x; volatile LAS unsigned* st; };

__device__ __forceinline__ XcdBarrier xcd_barrier_post(unsigned* bar, volatile LAS unsigned* st) {
    XcdBarrier b; b.bar = bar; b.x = xb_xcc_id(); b.st = st;
    if (threadIdx.x == 0) (void)xb_add(&bar[XB_XCNT(b.x)], 1u);
    return b;
}
__device__ __forceinline__ void xcd_barrier_complete(unsigned* bar, unsigned x, unsigned& nloc, unsigned& nx) {
    const unsigned G = gridDim.x * gridDim.y * gridDim.z;
    unsigned sum, cnt, mine, sp = 0u;
    for (;;) {
        sum = 0u; cnt = 0u; mine = 0u;
#pragma unroll
        for (unsigned j = 0; j < 16; ++j) { const unsigned c = xb_ld(&bar[XB_XCNT(j)]); sum += c; cnt += (c > 0u) ? 1u : 0u; mine = (j == x) ? c : mine; }
        if (sum == G) break;
        __builtin_amdgcn_s_sleep(1);
        if ((++sp & 255u) == 0u) { if (xb_ld(&bar[XB_TMO])) break; if (sp > XB_SPIN_CAP) { atomicAdd(&bar[XB_TMO], 1u); break; } }
    }
    nloc = mine > 0u ? mine : 1u; nx = cnt > 0u ? cnt : 1u;
}
__device__ __forceinline__ void xcd_barrier(const XcdBarrier& b) {
    asm volatile("s_waitcnt vmcnt(0)" ::: "memory");
    __syncthreads();
    if (threadIdx.x == 0) {
        unsigned* bar = b.bar;
        __builtin_amdgcn_s_waitcnt(0);
        unsigned nloc = b.st[0], nx = b.st[1];
        if (nloc == 0u) { xcd_barrier_complete(bar, b.x, nloc, nx); b.st[0] = nloc; b.st[1] = nx; }
        const unsigned old = xb_add(&bar[XB_XSUB(b.x)], 1u);
        const unsigned gen = old / nloc;
        if (old + 1u == (gen + 1u) * nloc) {
            __builtin_amdgcn_fence(__ATOMIC_RELEASE, "agent");
            asm volatile("s_waitcnt vmcnt(0)" ::: "memory");
            const unsigned og = xb_add(&bar[XB_TOP], 1u);
            const unsigned tg = og / nx;
            if (og + 1u == (tg + 1u) * nx) xb_add(&bar[XB_TOPGEN], 1u);
            else XB_SPIN(xb_ld(&bar[XB_TOPGEN]) == tg, bar);
            __builtin_amdgcn_fence(__ATOMIC_ACQUIRE, "agent");
            xb_add(&bar[XB_XGEN(b.x)], 1u);
            asm volatile("s_waitcnt vmcnt(0)" ::: "memory");
        } else {
            XB_SPIN(xb_ld(&bar[XB_XGEN(b.x)]) == gen, bar);
            __builtin_amdgcn_fence(__ATOMIC_ACQUIRE, "agent");
            asm volatile("s_waitcnt vmcnt(0)" ::: "memory");
        }
    }
    __syncthreads();
}

constexpr int NWAVES = 8;
constexpr int RING_BYTES = 131072;
constexpr int LDSCTL_OFF = RING_BYTES, MISC_OFF = LDSCTL_OFF + 320;
constexpr int LDS_BYTES = 147456;
constexpr int NPHASE = 2 + 6 * NLAYER;

#define LDS_WAIT() asm volatile("s_waitcnt lgkmcnt(0)" ::: "memory")

struct Args { const float* in[20]; float* out; unsigned char* ws; int ph_lo, ph_hi, li, pad; };

struct Frame {
    LAS unsigned char* lds;
    int tid, lane, wave, G, gw, NGW;
    const float *x, *c, *ctx, *c_ctx, *w_ada, *b_ada, *w_in, *conv_w, *sink, *g_attn, *g_conv, *w_out, *ln1_g, *ln1_b, *wq, *keys, *pu, *pv, *ln2_g, *ln2_b;
    float* out;
    float *MODS, *ROPE, *X, *SC;
    bf16_t *KBD, *WQR, *WINT, *WOUTT, *WEFFT, *H, *PROJ, *MIX;
    unsigned char *UT, *VT; float *US, *VS;
};

__device__ __forceinline__ void frame_ids(Frame& F) {
    int tz = threadIdx.x; asm volatile("" : "+v"(tz));
    F.tid = tz; F.lane = tz & 63; F.wave = __builtin_amdgcn_readfirstlane(tz >> 6);
    F.gw = blockIdx.x * NWAVES + F.wave;
}
__device__ __forceinline__ float wave_sum(float v) {
#pragma unroll
    for (int o = 1; o < 64; o <<= 1) v += __shfl_xor(v, o);
    return v;
}
__device__ __forceinline__ unsigned pk2(float lo, float hi) { return pg8::cvt_pk_bf16(lo, hi); }
__device__ __forceinline__ float bf_lo(unsigned u) { return __uint_as_float(u << 16); }
__device__ __forceinline__ float bf_hi(unsigned u) { return __uint_as_float(u & 0xffff0000u); }
__device__ __forceinline__ int modrow(int t) { return t < TL ? t / SEQ : 2; }

__device__ __forceinline__ void transpose_item(const float* W, int K, int N, bf16_t* WT, LAS float* scr, int item, int lane) {
    const int nblk = N / 32, kb = item / nblk, nb = item % nblk, k0 = 64 * kb, n0 = 32 * nb;
#pragma unroll 8
    for (int i = 0; i < 32; ++i) { const int kk = 2 * i + (lane >> 5); scr[kk * 33 + (lane & 31)] = W[(size_t)(k0 + kk) * N + n0 + (lane & 31)]; }
    LDS_WAIT(); asm volatile("" ::: "memory");
    const int c = lane & 7;
#pragma unroll
    for (int j = 0; j < 4; ++j) { const int n = (lane >> 3) + 8 * j; const LAS float* s = scr + (8 * c) * 33 + n;
        u32x4 o; o.x = pk2(s[0 * 33], s[1 * 33]); o.y = pk2(s[2 * 33], s[3 * 33]); o.z = pk2(s[4 * 33], s[5 * 33]); o.w = pk2(s[6 * 33], s[7 * 33]);
        *(u32x4*)(WT + (size_t)(n0 + n) * K + k0 + 8 * c) = o; }
    LDS_WAIT(); asm volatile("" ::: "memory");
}

__device__ __forceinline__ void cvt_row_bf16(const float* src, bf16_t* dst, int lane) {
    const f32x4* s = (const f32x4*)src + lane; u32x2* d = (u32x2*)dst + lane;
    f32x4 v[8];
#pragma unroll
    for (int j = 0; j < 8; ++j) v[j] = __builtin_nontemporal_load(s + 64 * j);
#pragma unroll
    for (int j = 0; j < 8; ++j) { u32x2 o; o.x = pk2(v[j].x, v[j].y); o.y = pk2(v[j].z, v[j].w); d[64 * j] = o; }
}

template <int FMT>
__device__ __forceinline__ void cvt_row_lp(const float* src, unsigned char* dst, float* inv, int lane) {
    constexpr float QMAX = FMT == 8 ? 224.f : 6.f;
    const f32x4* s = (const f32x4*)src + 2 * lane;
    f32x4 v[4][2]; float am = 0.f;
#pragma unroll
    for (int j = 0; j < 4; ++j) { v[j][0] = __builtin_nontemporal_load(s + 128 * j); v[j][1] = __builtin_nontemporal_load(s + 128 * j + 1); }
#pragma unroll
    for (int j = 0; j < 4; ++j)
#pragma unroll
        for (int q = 0; q < 2; ++q) am = fmaxf(fmaxf(am, fmaxf(fabsf(v[j][q].x), fabsf(v[j][q].y))), fmaxf(fabsf(v[j][q].z), fabsf(v[j][q].w)));
#pragma unroll
    for (int o = 1; o < 64; o <<= 1) am = fmaxf(am, __shfl_xor(am, o));
    const float sc = am > 0.f ? QMAX / am : 1.f;
#pragma unroll
    for (int j = 0; j < 4; ++j) {
        if constexpr (FMT == 8) {
            u32x2 w;
#pragma unroll
            for (int q = 0; q < 2; ++q) { int t = __builtin_amdgcn_cvt_pk_fp8_f32(v[j][q].x * sc, v[j][q].y * sc, 0, false); t = __builtin_amdgcn_cvt_pk_fp8_f32(v[j][q].z * sc, v[j][q].w * sc, t, true); w[q] = (unsigned)t; }
            *((u32x2*)dst + lane + 64 * j) = w;
        } else {
            unsigned w = 0u;
            w = __builtin_amdgcn_cvt_scalef32_pk_fp4_f32(w, v[j][0].x * sc, v[j][0].y * sc, 1.0f, 0);
            w = __builtin_amdgcn_cvt_scalef32_pk_fp4_f32(w, v[j][0].z * sc, v[j][0].w * sc, 1.0f, 1);
            w = __builtin_amdgcn_cvt_scalef32_pk_fp4_f32(w, v[j][1].x * sc, v[j][1].y * sc, 1.0f, 2);
            w = __builtin_amdgcn_cvt_scalef32_pk_fp4_f32(w, v[j][1].z * sc, v[j][1].w * sc, 1.0f, 3);
            *((unsigned*)dst + lane + 64 * j) = w;
        }
    }
    if (lane == 0) *inv = am > 0.f ? am * (1.f / QMAX) : 1.f;
}
template <int FMT> struct LpRow;
template <> struct LpRow<8> { u32x4 a, b;
    __device__ __forceinline__ void load(const unsigned char* rowp, int lane) { a = *(const u32x4*)(rowp + 32 * lane); b = *(const u32x4*)(rowp + 32 * lane + 16); }
    template <class Fn> __device__ __forceinline__ void each(Fn&& f) const {
#pragma unroll
        for (int w = 0; w < 4; ++w) { const f32x2 l0 = __builtin_amdgcn_cvt_pk_f32_fp8((int)a[w], false), h0 = __builtin_amdgcn_cvt_pk_f32_fp8((int)a[w], true);
            f(4 * w, l0.x, l0.y); f(4 * w + 2, h0.x, h0.y); }
#pragma unroll
        for (int w = 0; w < 4; ++w) { const f32x2 l0 = __builtin_amdgcn_cvt_pk_f32_fp8((int)b[w], false), h0 = __builtin_amdgcn_cvt_pk_f32_fp8((int)b[w], true);
            f(16 + 4 * w, l0.x, l0.y); f(16 + 4 * w + 2, h0.x, h0.y); }
    } };
template <> struct LpRow<4> { u32x4 a;
    __device__ __forceinline__ void load(const unsigned char* rowp, int lane) { a = *(const u32x4*)(rowp + 16 * lane); }
    template <class Fn> __device__ __forceinline__ void each(Fn&& f) const {
#pragma unroll
        for (int w = 0; w < 4; ++w) {
            const f32x2 d0 = __builtin_amdgcn_cvt_scalef32_pk_f32_fp4(a[w], 1.0f, 0), d1 = __builtin_amdgcn_cvt_scalef32_pk_f32_fp4(a[w], 1.0f, 1);
            const f32x2 d2 = __builtin_amdgcn_cvt_scalef32_pk_f32_fp4(a[w], 1.0f, 2), d3 = __builtin_amdgcn_cvt_scalef32_pk_f32_fp4(a[w], 1.0f, 3);
            f(8 * w, d0.x, d0.y); f(8 * w + 2, d1.x, d1.y); f(8 * w + 4, d2.x, d2.y); f(8 * w + 6, d3.x, d3.y); }
    } };

__device__ __forceinline__ void row_stats(const f32x4 (&v)[8], float& mean, float& rstd) {
    float s = 0.f;
#pragma unroll
    for (int j = 0; j < 8; ++j) s += (v[j].x + v[j].y) + (v[j].z + v[j].w);
    mean = wave_sum(s) * (1.f / D);
    float s2 = 0.f;
#pragma unroll
    for (int j = 0; j < 8; ++j) { const f32x4 d = v[j] - mean; s2 += (d.x * d.x + d.y * d.y) + (d.z * d.z + d.w * d.w); }
    rstd = 1.f / sqrtf(wave_sum(s2) * (1.f / D) + LN_EPS);
}
__device__ __forceinline__ void modulate_store(const f32x4 (&v)[8], const float* shift, const float* scale, bf16_t* dst, int lane) {
    float mean, rstd; row_stats(v, mean, rstd);
    u32x2* d = (u32x2*)dst + lane;
#pragma unroll
    for (int j = 0; j < 8; ++j) { const f32x4 sc = *((const f32x4*)scale + lane + 64 * j), sh = *((const f32x4*)shift + lane + 64 * j);
        const f32x4 y = (v[j] - mean) * rstd * (sc + 1.f) + sh;
        u32x2 o; o.x = pk2(y.x, y.y); o.y = pk2(y.z, y.w); d[64 * j] = o; }
}

__device__ __forceinline__ void p0a_prologue(Frame& F) {
    LAS float* condL = (LAS float*)F.lds;
    LAS float* red = (LAS float*)(F.lds + 24576);
    for (int i = F.tid; i < 3 * D; i += NWAVES * 64) { const int r = i / D, k = i % D; const float v = r < 2 ? F.c[r * D + k] : F.c_ctx[k]; condL[i] = v / (1.f + __expf(-v)); }
    __syncthreads();
    for (int item = blockIdx.x; item < 384; item += F.G) {
        const int l = item / 96, n0 = (item % 96) * 128;
        const float* wp = F.w_ada + ((size_t)l * D + F.wave * 256) * 12288 + n0 + 2 * F.lane;
        f32x2 a0 = {0.f, 0.f}, a1 = {0.f, 0.f}, a2 = {0.f, 0.f};
#pragma unroll 8
        for (int k = 0; k < 256; ++k) { const f32x2 w = __builtin_nontemporal_load((const f32x2*)(wp + (size_t)k * 12288)); const int kk = F.wave * 256 + k;
            a0 += w * condL[kk]; a1 += w * condL[D + kk]; a2 += w * condL[2 * D + kk]; }
        LAS float* rp = red + F.wave * 384 + 2 * F.lane;
        rp[0] = a0.x; rp[1] = a0.y; rp[128] = a1.x; rp[129] = a1.y; rp[256] = a2.x; rp[257] = a2.y;
        __syncthreads();
        if (F.tid < 384) { const int r = F.tid / 128, n = F.tid % 128; float s = 0.f;
#pragma unroll
            for (int w = 0; w < 8; ++w) s += red[w * 384 + r * 128 + n];
            F.MODS[((size_t)l * 3 + r) * 12288 + n0 + n] = s + F.b_ada[(size_t)l * 12288 + n0 + n]; }
        __syncthreads();
    }
    LAS float* scr = (LAS float*)(F.lds + 40960 + F.wave * 8448);
    constexpr int I_IN = (D / 64) * (INC / 32), I_OUT = (D / 64) * (D / 32);
    for (int it = F.gw; it < NLAYER * (I_IN + I_OUT); it += F.NGW) {
        const int l = it / (I_IN + I_OUT); int r = it % (I_IN + I_OUT);
        if (r < I_IN) transpose_item(F.w_in + (size_t)l * D * INC, D, INC, F.WINT + (size_t)l * INC * D, scr, r, F.lane);
        else transpose_item(F.w_out + (size_t)l * D * D, D, D, F.WOUTT + (size_t)l * D * D, scr, r - I_IN, F.lane);
    }
    for (int row = F.gw; row < NLAYER * D; row += F.NGW) {
        const int l = row / D, c = row % D; const f32x4* s = (const f32x4*)(F.wq + (size_t)row * D) + F.lane;
#pragma unroll
        for (int j = 0; j < 8; ++j) { const f32x4 v = s[64 * j]; u32x2 o; o.x = pk2(v.x, v.y); o.y = pk2(v.z, v.w);
            *((u32x2*)(F.WQR + ((size_t)(l * 8 + j) * D + c) * 256) + F.lane) = o; }
    }
    for (int row = F.gw; row < 32 * 256; row += F.NGW) {
        const int lh = row >> 8, pk = row & 255, p = pk >> 7;
        u32x2 o = {0u, 0u};
        if ((F.lane >> 5) == p) { const f32x4 v = *((const f32x4*)(F.keys + ((size_t)lh * 256 + pk) * 128) + (F.lane & 31)); o.x = pk2(v.x, v.y); o.y = pk2(v.z, v.w); }
        *((u32x2*)(F.KBD + (size_t)row * 256) + F.lane) = o;
    }
    for (int row = F.gw; row < NLAYER * NEXP; row += F.NGW) {
        cvt_row_lp<U_FMT>(F.pu + (size_t)row * D, F.UT + (size_t)row * UROW, F.US + row, F.lane);
        cvt_row_lp<V_FMT>(F.pv + (size_t)row * D, F.VT + (size_t)row * VROW, F.VS + row, F.lane);
    }
    for (int i = blockIdx.x * (NWAVES * 64) + F.tid; i < 192 * 32; i += F.G * NWAVES * 64) {
        const int idx = i >> 5, f = i & 31; const float pos = (float)(idx < 128 ? idx : idx - 128);
        const float inv = powf(10000.f, -(float)(2 * f) / 64.f); const float ang = pos * inv;
        F.ROPE[2 * i] = cosf(ang); F.ROPE[2 * i + 1] = sinf(ang);
    }
}

__device__ __forceinline__ void p0b_mod0(Frame& F) {
    for (int t = F.gw; t < TT; t += F.NGW) {
        const float* src = t < TL ? F.x + (size_t)t * D : F.ctx + (size_t)(t - TL) * D;
        f32x4 v[8];
#pragma unroll
        for (int j = 0; j < 8; ++j) v[j] = *((const f32x4*)src + F.lane + 64 * j);
        const float* mp = F.MODS + (size_t)modrow(t) * 12288;
        modulate_store(v, mp, mp + D, F.H + (size_t)t * D, F.lane);
    }
}

constexpr int KP = 272, VP = 320, KS_BYTES = 64 * KP, VS_BYTES = 64 * VP;
struct KVRegs { u32x4 k1, k2, v1, v2; f32x4 cs[4]; };

__device__ __forceinline__ void attn_load_tile(Frame& F, KVRegs& R, int ti, int b, int n, int g) {
    const int key = F.tid >> 3, c8 = F.tid & 7;
    int row, pos = 0;
    if (ti < 6) { pos = (n - 1) * 128 + 64 * ti + key; row = b * SEQ + pos; } else row = TL + b * CTXL + 64 * (ti - 6) + key;
    const bf16_t* base = F.PROJ + (size_t)row * INC;
    const int d1 = (c8 >> 2) * 64 + (c8 & 3) * 8;
    R.k1 = *(const u32x4*)(base + OFF_K + g * 128 + d1); R.k2 = *(const u32x4*)(base + OFF_K + g * 128 + d1 + 32);
    R.v1 = *(const u32x4*)(base + OFF_V + g * 128 + 8 * c8); R.v2 = *(const u32x4*)(base + OFF_V + g * 128 + 64 + 8 * c8);
    if (ti < 6) { const int tidx = (c8 >> 2) ? 128 + (pos & 63) : (pos >> 6); const f32x4* cp = (const f32x4*)(F.ROPE + ((size_t)tidx * 32 + (c8 & 3) * 8) * 2);
#pragma unroll
        for (int m = 0; m < 4; ++m) R.cs[m] = cp[m]; }
}
__device__ __forceinline__ void rope8(u32x4& a, u32x4& bq, const f32x4 (&cs)[4], float scale) {
    u32x4 oa, ob;
#pragma unroll
    for (int w = 0; w < 4; ++w) {
        const float x1l = bf_lo(a[w]), x1h = bf_hi(a[w]), x2l = bf_lo(bq[w]), x2h = bf_hi(bq[w]);
        const float cl = cs[w].x, sl = cs[w].y, ch = cs[w].z, sh = cs[w].w;
        oa[w] = pk2((x1l * cl - x2l * sl) * scale, (x1h * ch - x2h * sh) * scale);
        ob[w] = pk2((x2l * cl + x1l * sl) * scale, (x2h * ch + x1h * sh) * scale);
    }
    a = oa; bq = ob;
}
__device__ __forceinline__ void attn_store_tile(Frame& F, KVRegs& R, int ti, int buf) {
    const int key = F.tid >> 3, c8 = F.tid & 7;
    if (ti < 6) rope8(R.k1, R.k2, R.cs, 1.f);
    const int d1 = (c8 >> 2) * 64 + (c8 & 3) * 8;
    LAS unsigned char* kp = F.lds + buf * KS_BYTES + key * KP;
    *(LAS u32x4*)(kp + d1 * 2) = R.k1; *(LAS u32x4*)(kp + (d1 + 32) * 2) = R.k2;
    LAS unsigned char* vp = F.lds + 2 * KS_BYTES + buf * VS_BYTES + key * VP;
    *(LAS u32x4*)(vp + 16 * c8) = R.v1; *(LAS u32x4*)(vp + 128 + 16 * c8) = R.v2;
}

#define MFMA32(a, b, c) __builtin_amdgcn_mfma_f32_32x32x16_bf16((a), (b), (c), 0, 0, 0)

__device__ __forceinline__ void attn_unit(Frame& F, int layer, int u) {
    const bool latent = u < 512;
    int b, n, g, hp;
    if (latent) { hp = u & 1; g = (u >> 1) & 1; n = (u >> 2) & 63; b = u >> 8; }
    else { const int v = u - 512; hp = v & 1; g = (v >> 1) & 1; n = (v >> 2) & 1; b = v >> 3; }
    const int lane = F.lane, r = lane & 31, h = lane >> 5, wave = F.wave;
    const int head = g * 4 + hp * 2 + (wave >> 2), qb = wave & 3;
    const int tq = latent ? b * SEQ + n * 128 + 32 * qb + r : TL + b * CTXL + n * 128 + 32 * qb + r;
    bf16x8 qf[8];
    {
        u32x4 raw[8];
        const bf16_t* qp = F.PROJ + (size_t)tq * INC + OFF_Q + head * 128 + 8 * h;
#pragma unroll
        for (int ks = 0; ks < 8; ++ks) raw[ks] = *(const u32x4*)(qp + 16 * ks);
        if (latent) {
            const int pos = n * 128 + 32 * qb + r;
#pragma unroll
            for (int half = 0; half < 2; ++half) {
                const int tidx = half ? 128 + (pos & 63) : (pos >> 6);
#pragma unroll
                for (int kk = 0; kk < 2; ++kk) {
                    const f32x4* cp = (const f32x4*)(F.ROPE + ((size_t)tidx * 32 + 16 * kk + 8 * h) * 2);
                    f32x4 cs[4];
#pragma unroll
                    for (int m = 0; m < 4; ++m) cs[m] = cp[m];
                    rope8(raw[4 * half + kk], raw[4 * half + kk + 2], cs, QSCALE);
                }
            }
        } else {
#pragma unroll
            for (int ks = 0; ks < 8; ++ks)
#pragma unroll
                for (int w = 0; w < 4; ++w) raw[ks][w] = pk2(bf_lo(raw[ks][w]) * QSCALE, bf_hi(raw[ks][w]) * QSCALE);
        }
#pragma unroll
        for (int ks = 0; ks < 8; ++ks) qf[ks] = __builtin_bit_cast(bf16x8, raw[ks]);
    }
    int tlo = 6, nw = 0;
    if (latent) { tlo = (n == 0) ? 2 : 0; const int thi = (n == 63) ? 3 : 5; nw = thi - tlo + 1; }
    const int ntiles = nw + 4;
    f32x16 o[4];
#pragma unroll
    for (int db = 0; db < 4; ++db)
#pragma unroll
        for (int i = 0; i < 16; ++i) o[db][i] = 0.f;
    float m_run = F.sink[layer * 8 + head] * LOG2E;
    float lsum = h == 0 ? 1.f : 0.f;
    const int iq = 32 * qb + r;
    KVRegs R;
    __syncthreads();
    attn_load_tile(F, R, nw > 0 ? tlo : 6, b, n, g);
    attn_store_tile(F, R, nw > 0 ? tlo : 6, 0);
    __syncthreads();
    const int i16 = lane & 15, tq4 = i16 >> 2, tp = i16 & 3, blk = (lane >> 4) & 1;
    for (int j = 0; j < ntiles; ++j) {
        const int ti = j < nw ? tlo + j : 6 + (j - nw);
        const int buf = j & 1;
        const bool more = j + 1 < ntiles;
        const int tin = (j + 1) < nw ? tlo + j + 1 : 6 + (j + 1 - nw);
        if (more) attn_load_tile(F, R, tin, b, n, g);
        const bool part = ti >= 6 || (ti >= (qb >> 1) && ti <= (qb >> 1) + 4);
        if (part) {
            f32x16 s0, s1;
#pragma unroll
            for (int i = 0; i < 16; ++i) { s0[i] = 0.f; s1[i] = 0.f; }
            const LAS unsigned char* kb = F.lds + buf * KS_BYTES + r * KP + h * 16;
#pragma unroll
            for (int ks = 0; ks < 8; ++ks) {
                const bf16x8 a0 = *(const LAS bf16x8*)(kb + ks * 32), a1 = *(const LAS bf16x8*)(kb + 32 * KP + ks * 32);
                s0 = MFMA32(a0, qf[ks], s0); s1 = MFMA32(a1, qf[ks], s1);
            }
            float mx = -INFINITY;
            if (ti < 6) {
                const int jb = 64 * ti + 4 * h - iq;
#pragma unroll
                for (int i = 0; i < 16; ++i) { const int j0 = jb + (i & 3) + 8 * (i >> 2), j1 = j0 + 32;
                    s0[i] = (j0 >= 0 && j0 <= 256) ? s0[i] : -INFINITY; s1[i] = (j1 >= 0 && j1 <= 256) ? s1[i] : -INFINITY; }
            }
#pragma unroll
            for (int i = 0; i < 16; ++i) mx = fmaxf(mx, fmaxf(s0[i], s1[i]));
            mx = fmaxf(mx, __shfl_xor(mx, 32));
            const float m_new = fmaxf(m_run, mx), alpha = exp2f(m_run - m_new);
            m_run = m_new; lsum *= alpha;
#pragma unroll
            for (int i = 0; i < 16; ++i) { s0[i] = exp2f(s0[i] - m_new); s1[i] = exp2f(s1[i] - m_new); lsum += s0[i] + s1[i]; }
#pragma unroll
            for (int db = 0; db < 4; ++db)
#pragma unroll
                for (int i = 0; i < 16; ++i) o[db][i] *= alpha;
            bf16x8 pf[2][2];
#pragma unroll
            for (int s2 = 0; s2 < 2; ++s2) {
                u32x4 p0, p1;
#pragma unroll
                for (int w = 0; w < 4; ++w) { p0[w] = pk2(s0[8 * s2 + 2 * w], s0[8 * s2 + 2 * w + 1]); p1[w] = pk2(s1[8 * s2 + 2 * w], s1[8 * s2 + 2 * w + 1]); }
                pf[0][s2] = __builtin_bit_cast(bf16x8, p0); pf[1][s2] = __builtin_bit_cast(bf16x8, p1);
            }
            const LAS unsigned char* vb = F.lds + 2 * KS_BYTES + buf * VS_BYTES + (4 * h + tq4) * VP + 32 * blk + 8 * tp;
#pragma unroll
            for (int db = 0; db < 4; ++db)
#pragma unroll
                for (int kb2 = 0; kb2 < 2; ++kb2)
#pragma unroll
                    for (int s2 = 0; s2 < 2; ++s2) {
                        const int off = (32 * kb2 + 16 * s2) * VP + db * 64;
                        const s16x4 lo = __builtin_amdgcn_ds_read_tr16_b64_v4i16((LAS s16x4*)(vb + off));
                        const s16x4 hi = __builtin_amdgcn_ds_read_tr16_b64_v4i16((LAS s16x4*)(vb + off + 8 * VP));
                        const bf16x8 av = __builtin_shufflevector(lo, hi, 0, 1, 2, 3, 4, 5, 6, 7);
                        o[db] = MFMA32(av, pf[kb2][s2], o[db]);
                    }
        }
        if (more) attn_store_tile(F, R, tin, buf ^ 1);
        __syncthreads();
    }
    const float lt = lsum + __shfl_xor(lsum, 32);
    const float inv = 1.f / lt;
    float ss = 0.f;
#pragma unroll
    for (int db = 0; db < 4; ++db)
#pragma unroll
        for (int i = 0; i < 16; ++i) { o[db][i] *= inv; ss += o[db][i] * o[db][i]; }
    ss += __shfl_xor(ss, 32);
    const float rn = 1.f / sqrtf(ss * (1.f / 128.f) + LN_EPS);
    bf16_t* op = F.MIX + (size_t)tq * D + head * 128 + 4 * h;
    const float* gp = F.g_attn + layer * 1024 + head * 128 + 4 * h;
#pragma unroll
    for (int db = 0; db < 4; ++db)
#pragma unroll
        for (int g4 = 0; g4 < 4; ++g4) {
            const f32x4 gv = *(const f32x4*)(gp + 32 * db + 8 * g4);
            u32x2 w; w.x = pk2(o[db][4 * g4] * rn * gv.x, o[db][4 * g4 + 1] * rn * gv.y); w.y = pk2(o[db][4 * g4 + 2] * rn * gv.z, o[db][4 * g4 + 3] * rn * gv.w);
            *(u32x2*)(op + 32 * db + 8 * g4) = w;
        }
}

__device__ __forceinline__ void unpack8(const u32x4 v, float (&f)[8]) {
#pragma unroll
    for (int w = 0; w < 4; ++w) { f[2 * w] = bf_lo(v[w]); f[2 * w + 1] = bf_hi(v[w]); }
}
__device__ __forceinline__ void conv_row(Frame& F, int layer, int t) {
    bool first, last;
    if (t < TL) { const int pos = t & (SEQ - 1); first = pos == 0; last = pos == SEQ - 1; } else { const int pc = (t - TL) & (CTXL - 1); first = pc == 0; last = pc == CTXL - 1; }
    const bf16_t* p = F.PROJ + (size_t)t * INC;
    const float* cw = F.conv_w + (size_t)layer * 3 * 1024;
#pragma unroll
    for (int jc = 0; jc < 2; ++jc) {
        const int c = 8 * F.lane + 512 * jc;
        float gb[8], a[8], bq[8], um[8], ut[8], up[8];
        unpack8(*(const u32x4*)(p + c), gb);
        unpack8(*(const u32x4*)(p + OFF_C + c), a); unpack8(*(const u32x4*)(p + OFF_X + c), bq);
#pragma unroll
        for (int e = 0; e < 8; ++e) ut[e] = a[e] * bq[e];
        if (!first) { unpack8(*(const u32x4*)(p - INC + OFF_C + c), a); unpack8(*(const u32x4*)(p - INC + OFF_X + c), bq);
#pragma unroll
            for (int e = 0; e < 8; ++e) um[e] = a[e] * bq[e]; }
        else {
#pragma unroll
            for (int e = 0; e < 8; ++e) um[e] = 0.f; }
        if (!last) { unpack8(*(const u32x4*)(p + INC + OFF_C + c), a); unpack8(*(const u32x4*)(p + INC + OFF_X + c), bq);
#pragma unroll
            for (int e = 0; e < 8; ++e) up[e] = a[e] * bq[e]; }
        else {
#pragma unroll
            for (int e = 0; e < 8; ++e) up[e] = 0.f; }
        float y[8], ss = 0.f;
#pragma unroll
        for (int e = 0; e < 8; ++e) { y[e] = gb[e] * (cw[c + e] * um[e] + cw[1024 + c + e] * ut[e] + cw[2048 + c + e] * up[e]); ss += y[e] * y[e]; }
        ss += __shfl_xor(ss, 1); ss += __shfl_xor(ss, 2); ss += __shfl_xor(ss, 4); ss += __shfl_xor(ss, 8);
        const float rn = 1.f / sqrtf(ss * (1.f / 128.f) + LN_EPS);
        const float* gc = F.g_conv + layer * 1024 + c;
        u32x4 w;
#pragma unroll
        for (int q = 0; q < 4; ++q) w[q] = pk2(y[2 * q] * rn * gc[2 * q], y[2 * q + 1] * rn * gc[2 * q + 1]);
        *(u32x4*)(F.MIX + (size_t)t * D + 1024 + c) = w;
    }
}

__device__ __forceinline__ void ln_phase(Frame& F, int layer, int rows) {
    for (int t = F.gw; t < rows; t += F.NGW) {
        float* xr = F.X + (size_t)t * D;
        f32x4 v[8];
#pragma unroll
        for (int j = 0; j < 8; ++j) v[j] = *((const f32x4*)xr + F.lane + 64 * j);
        float mean, rstd; row_stats(v, mean, rstd);
        const float* g1 = F.ln1_g + layer * D; const float* b1 = F.ln1_b + layer * D;
#pragma unroll
        for (int j = 0; j < 8; ++j) { const f32x4 gg = *((const f32x4*)g1 + F.lane + 64 * j), bb = *((const f32x4*)b1 + F.lane + 64 * j);
            v[j] = (v[j] - mean) * rstd * gg + bb; *((f32x4*)xr + F.lane + 64 * j) = v[j]; }
        const float* mp = F.MODS + ((size_t)layer * 3 + modrow(t)) * 12288;
        modulate_store(v, mp + 3 * D, mp + 4 * D, F.H + (size_t)t * D, F.lane);
    }
}

__device__ __forceinline__ unsigned ordkey(float f) { const unsigned u = __float_as_uint(f); return u ^ ((u >> 31) ? 0xFFFFFFFFu : 0x80000000u); }
__device__ __forceinline__ float gelu_erf(float a) { return 0.5f * a * (1.f + erff(a * 0.70710678118654752f)); }

__device__ __forceinline__ void peer_topk(Frame& F, LAS unsigned char* ws, int t) {
    const int lane = F.lane; const bool hi = lane >= 32; const int l31 = lane & 31;
    LAS float* s1v = (LAS float*)ws; LAS int* s1i = (LAS int*)(ws + 128);
    LAS float* fv = (LAS float*)(ws + 256); LAS int* fi = (LAS int*)(ws + 320);
    LAS int* EL = (LAS int*)(ws + 512); LAS float* GL = (LAS float*)(ws + 1024);
    const unsigned lm = (1u << l31) - 1u;
    for (int hd = 0; hd < 8; ++hd) {
        const f32x4 sv = *((const f32x4*)(F.SC + (size_t)t * D + hd * 256) + lane);
        unsigned k[4];
#pragma unroll
        for (int j = 0; j < 4; ++j) k[j] = ordkey(sv[j]);
        unsigned T0 = 0u, T1 = 0u;
        for (int bit = 31; bit >= 0; --bit) {
            const unsigned c0 = T0 | (1u << bit), c1 = T1 | (1u << bit);
            const unsigned cand = hi ? c1 : c0;
            int n0 = 0, n1 = 0;
#pragma unroll
            for (int j = 0; j < 4; ++j) { const unsigned long long m = __ballot(k[j] >= cand); n0 += __popc((unsigned)m); n1 += __popc((unsigned)(m >> 32)); }
            if (n0 >= 16) T0 = c0;
            if (n1 >= 16) T1 = c1;
        }
        {
            const unsigned thr = hi ? T1 : T0; int base = 0; const int hb = hi ? 16 : 0;
#pragma unroll
            for (int j = 0; j < 4; ++j) { const bool gt = k[j] > thr; const unsigned long long m = __ballot(gt); const unsigned mh = hi ? (unsigned)(m >> 32) : (unsigned)m;
                const int pos = base + __popc(mh & lm); if (gt) { s1v[hb + pos] = sv[j]; s1i[hb + pos] = 4 * l31 + j; } base += __popc(mh); }
#pragma unroll
            for (int j = 0; j < 4; ++j) { const bool eq = k[j] == thr; const unsigned long long m = __ballot(eq); const unsigned mh = hi ? (unsigned)(m >> 32) : (unsigned)m;
                const int pos = base + __popc(mh & lm); if (eq && pos < 16) { s1v[hb + pos] = sv[j]; s1i[hb + pos] = 4 * l31 + j; } base += __popc(mh); }
        }
        LDS_WAIT(); __builtin_amdgcn_wave_barrier();
        const int a = lane >> 2, b0 = (lane & 3) * 4;
        const float av = s1v[a]; const int ai = s1i[a];
        float cv[4]; int ce[4]; unsigned ck[4];
#pragma unroll
        for (int j = 0; j < 4; ++j) { cv[j] = av + s1v[16 + b0 + j]; ce[j] = ai * 128 + s1i[16 + b0 + j]; ck[j] = ordkey(cv[j]); }
        unsigned T2 = 0u;
        for (int bit = 31; bit >= 0; --bit) {
            const unsigned c2 = T2 | (1u << bit); int nn = 0;
#pragma unroll
            for (int j = 0; j < 4; ++j) nn += __popcll(__ballot(ck[j] >= c2));
            if (nn >= 16) T2 = c2;
        }
        {
            const unsigned long long lm64 = (1ull << lane) - 1ull; int base = 0;
#pragma unroll
            for (int j = 0; j < 4; ++j) { const bool gt = ck[j] > T2; const unsigned long long m = __ballot(gt);
                const int pos = base + __popcll(m & lm64); if (gt) { fv[pos] = cv[j]; fi[pos] = ce[j]; } base += __popcll(m); }
#pragma unroll
            for (int j = 0; j < 4; ++j) { const bool eq = ck[j] == T2; const unsigned long long m = __ballot(eq);
                const int pos = base + __popcll(m & lm64); if (eq && pos < 16) { fv[pos] = cv[j]; fi[pos] = ce[j]; } base += __popcll(m); }
        }
        LDS_WAIT(); __builtin_amdgcn_wave_barrier();
        float mxv = -INFINITY, f16v[16];
#pragma unroll
        for (int i = 0; i < 16; ++i) { f16v[i] = fv[i]; mxv = fmaxf(mxv, f16v[i]); }
        float den = 0.f;
#pragma unroll
        for (int i = 0; i < 16; ++i) den += __expf(f16v[i] - mxv);
        if (lane < 16) { GL[hd * 16 + lane] = __expf(fv[lane] - mxv) / den; EL[hd * 16 + lane] = fi[lane]; }
        LDS_WAIT(); __builtin_amdgcn_wave_barrier();
    }
}

constexpr int EB = (U_FMT == 4 && V_FMT == 4) ? 8 : 4;
__device__ __forceinline__ void peer_phase(Frame& F, int layer, int rows) {
    LAS unsigned char* ws = F.lds + F.wave * 2048;
    LAS int* EL = (LAS int*)(ws + 512); LAS float* GL = (LAS float*)(ws + 1024);
    const int lane = F.lane;
    const unsigned char* UTl = F.UT + (size_t)layer * NEXP * UROW;
    const unsigned char* VTl = F.VT + (size_t)layer * NEXP * VROW;
    const float* USl = F.US + (size_t)layer * NEXP; const float* VSl = F.VS + (size_t)layer * NEXP;
    for (int t = F.gw; t < rows; t += F.NGW) {
        peer_topk(F, ws, t);
        float hv[32], acc[32];
#pragma unroll
        for (int q = 0; q < 4; ++q) { float f[8]; unpack8(*(const u32x4*)(F.H + (size_t)t * D + 32 * lane + 8 * q), f);
#pragma unroll
            for (int e = 0; e < 8; ++e) { hv[8 * q + e] = f[e]; acc[8 * q + e] = 0.f; } }
        for (int i0 = 0; i0 < 128; i0 += EB) {
            int ex[EB]; float gx[EB];
#pragma unroll
            for (int q = 0; q < EB; ++q) { ex[q] = __builtin_amdgcn_readfirstlane(EL[i0 + q]); gx[q] = __uint_as_float(__builtin_amdgcn_readfirstlane(__float_as_uint(GL[i0 + q]))); }
            LpRow<U_FMT> uu[EB]; LpRow<V_FMT> vv[EB]; float su[EB], sv[EB];
#pragma unroll
            for (int q = 0; q < EB; ++q) { uu[q].load(UTl + (size_t)ex[q] * UROW, lane); vv[q].load(VTl + (size_t)ex[q] * VROW, lane); su[q] = USl[ex[q]]; sv[q] = VSl[ex[q]]; }
            float dot[EB];
#pragma unroll
            for (int q = 0; q < EB; ++q) { float s = 0.f; uu[q].each([&](int i, float x0, float x1) { s += x0 * hv[i] + x1 * hv[i + 1]; }); dot[q] = s; }
#pragma unroll
            for (int q = 0; q < EB; ++q) dot[q] = wave_sum(dot[q]);
#pragma unroll
            for (int q = 0; q < EB; ++q) { const float cf = gx[q] * gelu_erf(dot[q] * su[q]) * sv[q];
                vv[q].each([&](int i, float x0, float x1) { acc[i] += cf * x0; acc[i + 1] += cf * x1; }); }
        }
        const int mr = modrow(t);
        const float* mp = F.MODS + ((size_t)layer * 3 + mr) * 12288;
        float* xr = F.X + (size_t)t * D;
        float rr[32]; float s = 0.f;
#pragma unroll
        for (int q = 0; q < 8; ++q) { const int c = 32 * lane + 4 * q; const f32x4 xv = *(const f32x4*)(xr + c), gv = *(const f32x4*)(mp + 5 * D + c);
#pragma unroll
            for (int e = 0; e < 4; ++e) { const float v = DN_ALPHA * xv[e] + gv[e] * acc[4 * q + e]; rr[4 * q + e] = v; s += v; } }
        const float mean = wave_sum(s) * (1.f / D);
        float s2 = 0.f;
#pragma unroll
        for (int i = 0; i < 32; ++i) { rr[i] -= mean; s2 += rr[i] * rr[i]; }
        const float rstd = 1.f / sqrtf(wave_sum(s2) * (1.f / D) + LN_EPS);
        const float* g2 = F.ln2_g + layer * D; const float* b2 = F.ln2_b + layer * D;
        float s3 = 0.f;
#pragma unroll
        for (int q = 0; q < 8; ++q) { const int c = 32 * lane + 4 * q; const f32x4 gg = *(const f32x4*)(g2 + c), bb = *(const f32x4*)(b2 + c);
            f32x4 xo;
#pragma unroll
            for (int e = 0; e < 4; ++e) { xo[e] = rr[4 * q + e] * rstd * gg[e] + bb[e]; rr[4 * q + e] = xo[e]; s3 += xo[e]; }
            if (layer < NLAYER - 1) *(f32x4*)(xr + c) = xo; else if (t < TL) *(f32x4*)(F.out + (size_t)t * D + c) = xo; }
        if (layer < NLAYER - 1) {
            const float mean2 = wave_sum(s3) * (1.f / D);
            float s4 = 0.f;
#pragma unroll
            for (int i = 0; i < 32; ++i) { rr[i] -= mean2; s4 += rr[i] * rr[i]; }
            const float rstd2 = 1.f / sqrtf(wave_sum(s4) * (1.f / D) + LN_EPS);
            const float* np = F.MODS + ((size_t)(layer + 1) * 3 + mr) * 12288;
#pragma unroll
            for (int q2 = 0; q2 < 4; ++q2) { const int c = 32 * lane + 8 * q2; u32x4 w;
#pragma unroll
                for (int q = 0; q < 2; ++q) { const f32x4 sh = *(const f32x4*)(np + c + 4 * q), sc = *(const f32x4*)(np + D + c + 4 * q); const int ri = 8 * q2 + 4 * q;
                    const float y0 = rr[ri] * rstd2 * (1.f + sc[0]) + sh[0], y1 = rr[ri + 1] * rstd2 * (1.f + sc[1]) + sh[1];
                    const float y2 = rr[ri + 2] * rstd2 * (1.f + sc[2]) + sh[2], y3 = rr[ri + 3] * rstd2 * (1.f + sc[3]) + sh[3];
                    w[2 * q] = pk2(y0, y1); w[2 * q + 1] = pk2(y2, y3); }
                *(u32x4*)(F.H + (size_t)t * D + c) = w; }
        }
    }
}

__global__ void __launch_bounds__(NWAVES * 64, 2) skel_fwd(Args args) {
    extern __shared__ __attribute__((aligned(16))) unsigned char lds[];
    Frame F;
    F.lds = (LAS unsigned char*)lds;
    F.tid = threadIdx.x; F.lane = F.tid & 63; F.wave = __builtin_amdgcn_readfirstlane(F.tid >> 6);
    F.G = gridDim.x; F.gw = blockIdx.x * NWAVES + F.wave; F.NGW = F.G * NWAVES;
    unsigned char* ws = args.ws;
    F.x = args.in[0]; F.c = args.in[1]; F.ctx = args.in[2]; F.c_ctx = args.in[3]; F.w_ada = args.in[4]; F.b_ada = args.in[5]; F.w_in = args.in[6]; F.conv_w = args.in[7];
    F.sink = args.in[8]; F.g_attn = args.in[9]; F.g_conv = args.in[10]; F.w_out = args.in[11]; F.ln1_g = args.in[12]; F.ln1_b = args.in[13]; F.wq = args.in[14]; F.keys = args.in[15];
    F.pu = args.in[16]; F.pv = args.in[17]; F.ln2_g = args.in[18]; F.ln2_b = args.in[19]; F.out = args.out;
    F.MODS = (float*)(ws + WS_MODS); F.ROPE = (float*)(ws + WS_ROPE); F.X = (float*)(ws + WS_X); F.SC = (float*)(ws + WS_SC);
    F.KBD = (bf16_t*)(ws + WS_KBD); F.WQR = (bf16_t*)(ws + WS_WQR); F.WINT = (bf16_t*)(ws + WS_WINT); F.WOUTT = (bf16_t*)(ws + WS_WOUTT); F.WEFFT = (bf16_t*)(ws + WS_WEFFT);
    F.H = (bf16_t*)(ws + WS_H); F.PROJ = (bf16_t*)(ws + WS_PROJ); F.MIX = (bf16_t*)(ws + WS_MIX); F.UT = ws + WS_UT; F.VT = ws + WS_VT; F.US = (float*)(ws + WS_US); F.VS = (float*)(ws + WS_VS);
    for (int u = F.tid; u < (LDS_BYTES - LDSCTL_OFF) / 4; u += NWAVES * 64) ((LAS unsigned*)(F.lds + LDSCTL_OFF))[u] = 0u;
    __syncthreads();
    unsigned* ctl = (unsigned*)(ws + WS_CTL);
    const int lo = args.ph_lo, hi = args.ph_hi;
    XcdBarrier bar; bar.bar = ctl + CW_BAR + args.li * XCD_BAR_WORDS; bar.x = 0; bar.st = nullptr;
    if (hi - lo > 1) bar = xcd_barrier_post(ctl + CW_BAR + args.li * XCD_BAR_WORDS, (volatile LAS unsigned*)(F.lds + MISC_OFF) + 8);
#define IN(k) (lo <= (k) && (k) < hi)
#ifndef PROBE_PHASE
#define PROBE_PHASE -1
#endif
#ifndef PROBE_MULT
#define PROBE_MULT 1
#endif
    unsigned long long pr_acc = 0ull, pr_t0 = 0ull;
#define PR_BEGIN(ty) do { if (PROBE_PHASE == (ty)) pr_t0 = __builtin_amdgcn_s_memrealtime(); } while (0)
#define PR_END(ty) do { if (PROBE_PHASE == (ty)) pr_acc += __builtin_amdgcn_s_memrealtime() - pr_t0; } while (0)
#define BOTH(k) (IN(k) && IN((k) + 1))
#define SEAM(k) do { if (BOTH(k)) xcd_barrier(bar); } while (0)

    if (IN(0)) { PR_BEGIN(0); frame_ids(F); p0a_prologue(F); SEAM(0); PR_END(0); }
    if (IN(1)) {
        PR_BEGIN(1); frame_ids(F);
        { pg8::Gemm g{F.KBD, F.WQR, 32 * 256, 2048, 256}; pg8::BatchOrder S{F.G, (int)blockIdx.x}; pg8::EpiBf16 E{F.WEFFT, D};
          pg8::gemm_phase<pg8::EpiBf16, pg8::BatchOrder, false, true>(F.lds, g, S, E); }
        p0b_mod0(F);
        SEAM(1); PR_END(1);
    }
    for (int layer = 0; layer < NLAYER; ++layer) {
        const int pb = 2 + 6 * layer;
        const bool lastl = layer == NLAYER - 1;
        const int rows = lastl ? TL : TT;
        if (IN(pb + 0)) {
            PR_BEGIN(2); frame_ids(F);
            pg8::Gemm g{F.H, F.WINT + (size_t)layer * INC * D, TT, INC, D}; pg8::StaticOrder S; S.init(TT, INC, F.G, (int)blockIdx.x);
            pg8::EpiBf16 E{F.PROJ, INC};
            pg8::gemm_phase<pg8::EpiBf16, pg8::StaticOrder, true, true>(F.lds, g, S, E);
            SEAM(pb + 0); PR_END(2);
        }
        if (IN(pb + 1)) {
            PR_BEGIN(3); frame_ids(F);
            const int nunits = lastl ? 512 : 528;
            for (int u = blockIdx.x; u < nunits; u += F.G) attn_unit(F, layer, u);
            for (int t = F.gw; t < rows; t += F.NGW) conv_row(F, layer, t);
            SEAM(pb + 1); PR_END(3);
        }
        if (IN(pb + 2)) {
            PR_BEGIN(4); frame_ids(F);
            pg8::Gemm g{F.MIX, F.WOUTT + (size_t)layer * D * D, rows, D, D}; pg8::StaticOrder S; S.init(rows, D, F.G, (int)blockIdx.x);
            pg8::EpiResid E{layer == 0 ? F.x : F.X, layer == 0 ? F.ctx : F.X + (size_t)TL * D, F.X, F.MODS + (size_t)layer * 3 * 12288 + 2 * D};
            pg8::gemm_phase<pg8::EpiResid, pg8::StaticOrder, true, true>(F.lds, g, S, E);
            SEAM(pb + 2); PR_END(4);
        }
        if (IN(pb + 3)) { PR_BEGIN(5); frame_ids(F); ln_phase(F, layer, rows); SEAM(pb + 3); PR_END(5); }
        if (IN(pb + 4)) {
            PR_BEGIN(6); frame_ids(F);
            pg8::Gemm g{F.H, F.WEFFT + (size_t)layer * D * D, rows, D, D}; pg8::StaticOrder S; S.init(rows, D, F.G, (int)blockIdx.x);
            pg8::EpiF32 E{F.SC, D};
            pg8::gemm_phase<pg8::EpiF32, pg8::StaticOrder, true, true>(F.lds, g, S, E);
            SEAM(pb + 4); PR_END(6);
        }
        if (IN(pb + 5)) { PR_BEGIN(7); frame_ids(F); peer_phase(F, layer, rows); SEAM(pb + 5); PR_END(7); }
    }
    if (PROBE_PHASE >= 0 && blockIdx.x == 0 && threadIdx.x == 0) { const unsigned long long t1 = __builtin_amdgcn_s_memrealtime() + (unsigned long long)PROBE_MULT * pr_acc; while (__builtin_amdgcn_s_memrealtime() < t1) __builtin_amdgcn_s_sleep(8); }
#undef IN
#undef BOTH
#undef SEAM
}

extern "C" void kernel_launch(void* const* d_in, const int* in_sizes, int n_in, void* d_out, int out_size, void* d_ws, size_t ws_size, hipStream_t stream) {
    static int grid = 0;
    if (grid == 0) {
        if (n_in != 20 || in_sizes[0] != TL * D || out_size != TL * D || ws_size < WS_END) {
            fprintf(stderr, "kernel_launch: unexpected problem shape (n_in %d, in0 %d, out %d, ws %zu, need %zu)\n", n_in, n_in > 0 ? in_sizes[0] : -1, out_size, ws_size, (size_t)WS_END); grid = -1; return; }
        int dev = 0, cus = 0, per_cu = 0;
        if (hipGetDevice(&dev) != hipSuccess || hipDeviceGetAttribute(&cus, hipDeviceAttributeMultiprocessorCount, dev) != hipSuccess) { grid = -1; return; }
        if (hipFuncSetAttribute((const void*)skel_fwd, hipFuncAttributeMaxDynamicSharedMemorySize, LDS_BYTES) != hipSuccess) { fprintf(stderr, "kernel_launch: hipFuncSetAttribute failed\n"); grid = -1; return; }
        if (hipOccupancyMaxActiveBlocksPerMultiprocessor(&per_cu, (const void*)skel_fwd, NWAVES * 64, LDS_BYTES) != hipSuccess || per_cu < 1)
            fprintf(stderr, "kernel_launch: occupancy query reports %d workgroups per CU\n", per_cu);
        (void)hipGetLastError();
        grid = cus;
    }
    if (grid < 0) return;
    if (hipMemsetAsync((char*)d_ws + WS_CTL, 0, CTL_ZERO_BYTES, stream) != hipSuccess) return;
    Args a{};
    for (int i = 0; i < 20; ++i) a.in[i] = (const float*)d_in[i];
    a.out = (float*)d_out; a.ws = (unsigned char*)d_ws; a.pad = 0;
#if MK_N_LAUNCHES == 1
    a.ph_lo = 0; a.ph_hi = NPHASE; a.li = 0;
    hipLaunchKernelGGL(skel_fwd, dim3(grid), dim3(NWAVES * 64), LDS_BYTES, stream, a);
#else
    for (int ph = 0; ph < NPHASE; ++ph) { a.ph_lo = ph; a.ph_hi = ph + 1; a.li = 0;
        hipLaunchKernelGGL(skel_fwd, dim3(grid), dim3(NWAVES * 64), LDS_BYTES, stream, a); }
#endif
}
```

```cpp
#include <hip/hip_runtime.h>
#include <cstdio>
#include <cstdint>

#ifndef MK_N_LAUNCHES
#define MK_N_LAUNCHES 1
#endif

#define LAS __attribute__((address_space(3)))
typedef unsigned short bf16_t;
typedef short bf16x8 __attribute__((ext_vector_type(8)));
typedef short s16x4 __attribute__((ext_vector_type(4)));
typedef float f32x2 __attribute__((ext_vector_type(2)));
typedef float f32x4 __attribute__((ext_vector_type(4)));
typedef float f32x16 __attribute__((ext_vector_type(16)));
typedef unsigned u32x2 __attribute__((ext_vector_type(2)));
typedef unsigned u32x4 __attribute__((ext_vector_type(4)));
typedef __bf16 bf16x2_t __attribute__((ext_vector_type(2)));

constexpr int D = 2048, NB = 2, SEQ = 8192, CTXL = 256, NLAYER = 4;
constexpr int TL = NB * SEQ, TC = NB * CTXL, TT = TL + TC;
constexpr int INC = 4608, OFF_C = 1024, OFF_X = 2048, OFF_Q = 3072, OFF_K = 4096, OFF_V = 4352;
constexpr int NEXP = 16384;
#ifndef U_FMT
#define U_FMT 4
#endif
#ifndef V_FMT
#define V_FMT 4
#endif
constexpr int UROW = D * U_FMT / 8, VROW = D * V_FMT / 8;
constexpr float LN_EPS = 1e-6f;
constexpr float DN_ALPHA = 1.681792830507429f;
constexpr float QSCALE = 0.08838834764831845f * 1.4426950408889634f;
constexpr float LOG2E = 1.4426950408889634f;

constexpr size_t MiB = 1u << 20;
constexpr size_t WS_CTL = 0, CTL_ZERO_BYTES = 1 * MiB;
constexpr size_t WS_MODS = 1 * MiB;
constexpr size_t WS_ROPE = 2 * MiB;
constexpr size_t WS_KBD = 3 * MiB;
constexpr size_t WS_WQR = 8 * MiB;
constexpr size_t WS_WINT = 40 * MiB;
constexpr size_t WS_WOUTT = 112 * MiB;
constexpr size_t WS_WEFFT = 144 * MiB;
constexpr size_t WS_X = 176 * MiB;
constexpr size_t WS_H = 308 * MiB;
constexpr size_t WS_PROJ = 374 * MiB;
constexpr size_t WS_MIX = 523 * MiB;
constexpr size_t WS_SC = 589 * MiB;
constexpr size_t WS_UT = 721 * MiB;
constexpr size_t WS_VT = 849 * MiB;
constexpr size_t WS_US = 977 * MiB;
constexpr size_t WS_VS = 978 * MiB;
constexpr size_t WS_END = 979 * MiB;

constexpr int CW_BAR = 4096;

namespace pg8 {
constexpr int BM = 256, BK = 64, HALF = 128, HTB = HALF * BK * 2, STAGE_BYTES = 8 * HTB, NXCD = 8, WGM = 8;
__host__ __device__ __forceinline__ int lds_byte(int r, int c) { const int st = (r >> 4) * 2 + (c >> 5), rr = r & 15, cc = c & 31, ob = rr * 64 + cc * 2; return st * 1024 + (ob ^ (((ob >> 9) & 1) << 5)); }
__host__ __device__ __forceinline__ void stage_rc(int b, int& R, int& C) { const int st = b / 1024, sb = b % 1024, swz = sb ^ (((sb >> 9) & 1) << 5); R = (st >> 1) * 16 + swz / 64; C = (st & 1) * 32 + (swz % 64) / 2; }
__host__ __device__ __forceinline__ int perm32(int rho) { const int n = rho >> 4, i = rho & 15; return 8 * (i >> 2) + 4 * n + (i & 3); }

struct Unit { int pm, pn; };
struct Gemm { const bf16_t* A; const bf16_t* Bt; int M, N, K; };

struct StaticOrder {
    int nM, nN, nwg, G, c;
    __host__ __device__ void init(int M, int N, int G_, int c_) { nM = M / BM; nN = N / BM; nwg = nM * nN; G = G_; c = c_; }
    __host__ __device__ bool next(int i, Unit& u) const {
        const long L = (long)i * G + c; if (L >= nwg) return false;
        int wgid = (int)L; { const int q = nwg / NXCD, r = nwg % NXCD, xcd = wgid % NXCD, off = wgid / NXCD; wgid = (xcd < r ? xcd * (q + 1) : r * (q + 1) + (xcd - r) * q) + off; }
        const int nig = WGM * nN, gid = wgid / nig, fm = gid * WGM, gsz = (nM - fm) < WGM ? (nM - fm) : WGM;
        u.pm = fm + ((wgid % nig) % gsz); u.pn = (wgid % nig) / gsz; return true;
    }
    __device__ __forceinline__ int btile(const Unit& u) const { return u.pn; }
    __device__ __forceinline__ void a_ready(const Unit&) const {}
    __device__ __forceinline__ void done(const Unit&) const {}
};
struct BatchOrder {
    int G, c;
    __device__ bool next(int i, Unit& u) const { const int L = i * G + c; if (L >= 256) return false; u.pm = L >> 3; u.pn = L & 7; return true; }
    __device__ __forceinline__ int btile(const Unit& u) const { return u.pm * 8 + u.pn; }
    __device__ __forceinline__ void a_ready(const Unit&) const {}
    __device__ __forceinline__ void done(const Unit&) const {}
};

__device__ __forceinline__ unsigned cvt_pk_bf16(float lo, float hi) { f32x2 x = {lo, hi}; bf16x2_t y = __builtin_convertvector(x, bf16x2_t); return __builtin_bit_cast(unsigned, y); }

struct EpiBf16 {
    static constexpr bool PERM = true;
    bf16_t* O; int ldc;
    __device__ __forceinline__ void operator()(const f32x4 (&acc)[2][2][4][2], const Unit& u, int wr, int wc, int fr, int fq) const {
        const int row0 = u.pm * BM + wr * 64 + fr, col0 = u.pn * BM + wc * 32 + 8 * fq;
#pragma unroll
        for (int ai = 0; ai < 2; ++ai)
#pragma unroll
            for (int m = 0; m < 4; ++m) { bf16_t* rowp = O + (size_t)(row0 + ai * HALF + m * 16) * ldc + col0;
#pragma unroll
                for (int bj = 0; bj < 2; ++bj) { const f32x4 v0 = acc[ai][bj][m][0], v1 = acc[ai][bj][m][1];
                    u32x4 w; w.x = cvt_pk_bf16(v0[0], v0[1]); w.y = cvt_pk_bf16(v0[2], v0[3]); w.z = cvt_pk_bf16(v1[0], v1[1]); w.w = cvt_pk_bf16(v1[2], v1[3]);
                    *(u32x4*)(rowp + bj * HALF) = w; } }
    }
};
struct EpiF32 {
    static constexpr bool PERM = false;
    float* C; int ldc;
    __device__ __forceinline__ void operator()(const f32x4 (&acc)[2][2][4][2], const Unit& u, int wr, int wc, int fr, int fq) const {
        const int row0 = u.pm * BM + wr * 64 + fr, col0 = u.pn * BM + wc * 32 + 4 * fq;
#pragma unroll
        for (int ai = 0; ai < 2; ++ai)
#pragma unroll
            for (int m = 0; m < 4; ++m) { float* rowp = C + (size_t)(row0 + ai * HALF + m * 16) * ldc + col0;
#pragma unroll
                for (int bj = 0; bj < 2; ++bj)
#pragma unroll
                    for (int n = 0; n < 2; ++n) *(f32x4*)(rowp + bj * HALF + n * 16) = acc[ai][bj][m][n]; }
    }
};
struct EpiResid {
    static constexpr bool PERM = false;
    const float* xin_lat; const float* xin_ctx;
    float* xout; const float* gate;
    __device__ __forceinline__ void operator()(const f32x4 (&acc)[2][2][4][2], const Unit& u, int wr, int wc, int fr, int fq) const {
        const int rt = u.pm * BM;
        const int mr = rt < TL ? rt / SEQ : 2;
        const float* xin = rt < TL ? xin_lat + (size_t)rt * D : xin_ctx + (size_t)(rt - TL) * D;
        float* xo = xout + (size_t)rt * D;
        const int row0 = wr * 64 + fr, col0 = u.pn * BM + wc * 32 + 4 * fq;
        f32x4 gv[2][2];
#pragma unroll
        for (int bj = 0; bj < 2; ++bj)
#pragma unroll
            for (int n = 0; n < 2; ++n) gv[bj][n] = *(const f32x4*)(gate + (size_t)mr * 12288 + col0 + bj * HALF + n * 16);
#pragma unroll
        for (int ai = 0; ai < 2; ++ai)
#pragma unroll
            for (int m = 0; m < 4; ++m) { const size_t ro = (size_t)(row0 + ai * HALF + m * 16) * D + col0;
#pragma unroll
                for (int bj = 0; bj < 2; ++bj)
#pragma unroll
                    for (int n = 0; n < 2; ++n) { const f32x4 xv = *(const f32x4*)(xin + ro + bj * HALF + n * 16);
                        *(f32x4*)(xo + ro + bj * HALF + n * 16) = xv * DN_ALPHA + gv[bj][n] * acc[ai][bj][m][n]; } }
    }
};

template <class Epi, class Sched, bool ALIGN_EPI = false, bool SP2 = false>
__device__ __forceinline__ void gemm_phase(LAS unsigned char* lds, const Gemm g, const Sched& S, const Epi& E) {
    int tid = threadIdx.x; asm volatile("" : "+v"(tid));
    const int wid = __builtin_amdgcn_readfirstlane(tid >> 6), lane = tid & 63, wr = wid >> 2, wc = wid & 3, fr = lane & 15, fq = lane >> 4;
    const int K = g.K, nt = K / BK;
    unsigned voffA[2], voffB[2];
#pragma unroll
    for (int i = 0; i < 2; ++i) { int R, C; stage_rc(tid * 16 + i * 8192, R, C); const int Rb = Epi::PERM ? ((R & ~31) + perm32(R & 31)) : R;
        voffA[i] = (unsigned)(R * K + C) * 2u; voffB[i] = (unsigned)(Rb * K + C) * 2u; }
    const size_t kstep = (size_t)(BK * 2);
    const size_t hstep = (size_t)HALF * K * 2;
    const size_t tstep = 2 * hstep;
    const unsigned ldsw = (unsigned)wid * 1024u;
    const int aoff = lds_byte(wr * 64 + fr, fq * 8), boff = lds_byte(wc * 32 + fr, fq * 8);
#define PG8_SA(b, h) (((b) * 2 + (h)) * HTB)
#define PG8_SB(b, h) ((4 + (b) * 2 + (h)) * HTB)
#define PG8_STAGE(bufoff, gbase, voff) do { _Pragma("unroll") for (int _i = 0; _i < 2; ++_i) \
        __builtin_amdgcn_global_load_lds((const unsigned*)((const char*)(gbase) + (voff)[_i]), (LAS unsigned*)(lds + (bufoff) + ldsw + _i * 8192), 16, 0, 0); } while (0)
#define PG8_LDA(dst, b, h) do { _Pragma("unroll") for (int m = 0; m < 4; ++m) _Pragma("unroll") for (int k = 0; k < 2; ++k) dst[m][k] = *(const LAS bf16x8*)(lds + PG8_SA(b, h) + aoff + m * 2048 + k * 1024); } while (0)
#define PG8_LDB(dst, b, h) do { _Pragma("unroll") for (int n = 0; n < 2; ++n) _Pragma("unroll") for (int k = 0; k < 2; ++k) dst[n][k] = *(const LAS bf16x8*)(lds + PG8_SB(b, h) + boff + n * 2048 + k * 1024); } while (0)
#define PG8_MMA(ai, bj, At, Bt) do { __builtin_amdgcn_s_setprio(1); _Pragma("unroll") for (int m = 0; m < 4; ++m) _Pragma("unroll") for (int n = 0; n < 2; ++n) _Pragma("unroll") for (int k = 0; k < 2; ++k) \
        acc[ai][bj][m][n] = __builtin_amdgcn_mfma_f32_16x16x32_bf16(Bt[n][k], At[m][k], acc[ai][bj][m][n], 0, 0, 0); __builtin_amdgcn_s_setprio(0); } while (0)
#define PG8_WAIT_V(n) asm volatile("s_waitcnt vmcnt(" #n ")" ::: "memory")
#define PG8_WAIT_L(n) asm volatile("s_waitcnt lgkmcnt(" #n ")" ::: "memory")
#define PG8_BAR __builtin_amdgcn_s_barrier()
#define PG8_SCHED __builtin_amdgcn_sched_barrier(0)
    Unit cur, nxt; int ui = 0;
    if (!S.next(0, cur)) return;
    f32x4 acc[2][2][4][2];
#pragma unroll
    for (int a = 0; a < 2; ++a)
#pragma unroll
        for (int b = 0; b < 2; ++b)
#pragma unroll
            for (int m = 0; m < 4; ++m)
#pragma unroll
                for (int n = 0; n < 2; ++n) acc[a][b][m][n] = (f32x4){0.f, 0.f, 0.f, 0.f};
    bf16x8 At[4][2], B0[2][2], B1[2][2];
    const char* cA = (const char*)g.A + (size_t)cur.pm * tstep; const char* cB = (const char*)g.Bt + (size_t)S.btile(cur) * tstep;
    S.a_ready(cur);
    if constexpr (SP2) {
        PG8_STAGE(PG8_SB(0, 0), cB, voffB); PG8_STAGE(PG8_SB(0, 1), cB + hstep, voffB); PG8_STAGE(PG8_SA(0, 0), cA, voffA); PG8_STAGE(PG8_SA(0, 1), cA + hstep, voffA);
        if (wr == 1) PG8_BAR;
        PG8_WAIT_V(2); PG8_BAR;
        PG8_STAGE(PG8_SB(1, 0), cB + kstep, voffB); PG8_STAGE(PG8_SA(1, 0), cA + kstep, voffA); PG8_STAGE(PG8_SB(1, 1), cB + hstep + kstep, voffB);
        PG8_WAIT_V(6); PG8_BAR;
    } else {
        PG8_STAGE(PG8_SB(0, 0), cB, voffB); PG8_STAGE(PG8_SA(0, 0), cA, voffA); PG8_STAGE(PG8_SB(0, 1), cB + hstep, voffB); PG8_STAGE(PG8_SA(0, 1), cA + hstep, voffA);
        if (wr == 1) PG8_BAR;
        PG8_WAIT_V(4); PG8_BAR;
        PG8_STAGE(PG8_SB(1, 0), cB + kstep, voffB); PG8_STAGE(PG8_SA(1, 0), cA + kstep, voffA); PG8_STAGE(PG8_SB(1, 1), cB + hstep + kstep, voffB);
        PG8_WAIT_V(6); PG8_BAR;
    }
    for (;;) {
        const bool has_next = S.next(ui + 1, nxt);
        const char* nA = has_next ? (const char*)g.A + (size_t)nxt.pm * tstep : cA; const char* nB = has_next ? (const char*)g.Bt + (size_t)S.btile(nxt) * tstep : cB;
        for (int t = 0; t < nt; t += 2) {
            const bool last = (t == nt - 2);
            const char* a1 = cA + (size_t)(t + 1) * kstep;
            const char* a2 = last ? nA : cA + (size_t)(t + 2) * kstep; const char* b2 = last ? nB : cB + (size_t)(t + 2) * kstep;
            const char* a3 = a2 + kstep; const char* b3 = b2 + kstep;
            if (last && has_next) S.a_ready(nxt);
            if constexpr (SP2) {
            PG8_LDB(B0, 0, 0); PG8_LDB(B1, 0, 1); PG8_SCHED; PG8_LDA(At, 0, 0); PG8_STAGE(PG8_SA(1, 1), a1 + hstep, voffA);
            PG8_WAIT_V(8); PG8_WAIT_L(0); PG8_BAR; PG8_MMA(0, 0, At, B0); PG8_MMA(0, 1, At, B1); PG8_BAR; PG8_SCHED;
            PG8_LDA(At, 0, 1); PG8_STAGE(PG8_SB(0, 0), b2, voffB); PG8_STAGE(PG8_SB(0, 1), b2 + hstep, voffB); PG8_STAGE(PG8_SA(0, 0), a2, voffA);
            PG8_WAIT_V(8); PG8_WAIT_L(0); PG8_BAR; PG8_MMA(1, 0, At, B0); PG8_MMA(1, 1, At, B1); PG8_BAR; PG8_SCHED;
            PG8_LDB(B0, 1, 0); PG8_LDB(B1, 1, 1); PG8_SCHED; PG8_LDA(At, 1, 0); PG8_STAGE(PG8_SA(0, 1), a2 + hstep, voffA);
            PG8_WAIT_V(8); PG8_WAIT_L(0); PG8_BAR; PG8_MMA(0, 0, At, B0); PG8_MMA(0, 1, At, B1); PG8_BAR; PG8_SCHED;
            PG8_LDA(At, 1, 1); PG8_STAGE(PG8_SB(1, 0), b3, voffB); PG8_STAGE(PG8_SB(1, 1), b3 + hstep, voffB); PG8_STAGE(PG8_SA(1, 0), a3, voffA);
            PG8_WAIT_V(8); PG8_WAIT_L(0); PG8_BAR; PG8_MMA(1, 0, At, B0); PG8_MMA(1, 1, At, B1); PG8_BAR; PG8_SCHED;
            } else {
            PG8_LDB(B0, 0, 0); PG8_SCHED; PG8_LDA(At, 0, 0); PG8_STAGE(PG8_SA(1, 1), a1 + hstep, voffA);
            PG8_WAIT_L(8); PG8_BAR; PG8_WAIT_L(0); PG8_MMA(0, 0, At, B0); PG8_BAR; PG8_SCHED;
            PG8_LDB(B1, 0, 1); PG8_STAGE(PG8_SB(0, 0), b2, voffB);
            PG8_BAR; PG8_WAIT_L(0); PG8_MMA(0, 1, At, B1); PG8_BAR;
            PG8_LDA(At, 0, 1); PG8_STAGE(PG8_SA(0, 0), a2, voffA);
            PG8_BAR; PG8_WAIT_L(0); PG8_MMA(1, 0, At, B0); PG8_BAR; PG8_SCHED;
            PG8_STAGE(PG8_SB(0, 1), b2 + hstep, voffB);
            PG8_WAIT_V(6); PG8_BAR; PG8_MMA(1, 1, At, B1); PG8_BAR;
            PG8_LDB(B0, 1, 0); PG8_SCHED; PG8_LDA(At, 1, 0); PG8_STAGE(PG8_SA(0, 1), a2 + hstep, voffA);
            PG8_WAIT_L(8); PG8_BAR; PG8_WAIT_L(0); PG8_MMA(0, 0, At, B0); PG8_BAR; PG8_SCHED;
            PG8_LDB(B1, 1, 1); PG8_STAGE(PG8_SB(1, 0), b3, voffB);
            PG8_BAR; PG8_WAIT_L(0); PG8_MMA(0, 1, At, B1); PG8_BAR;
            PG8_LDA(At, 1, 1); PG8_STAGE(PG8_SA(1, 0), a3, voffA);
            PG8_BAR; PG8_WAIT_L(0); PG8_MMA(1, 0, At, B0); PG8_BAR; PG8_SCHED;
            PG8_STAGE(PG8_SB(1, 1), b3 + hstep, voffB);
            PG8_WAIT_V(6); PG8_BAR; PG8_MMA(1, 1, At, B1); PG8_BAR;
            }
        }
        if constexpr (ALIGN_EPI) { if (wr == 0) PG8_BAR; }
        E(acc, cur, wr, wc, fr, fq); S.done(cur);
        if (!has_next) break;
#pragma unroll
        for (int a = 0; a < 2; ++a)
#pragma unroll
            for (int b = 0; b < 2; ++b)
#pragma unroll
                for (int m = 0; m < 4; ++m)
#pragma unroll
                    for (int n = 0; n < 2; ++n) acc[a][b][m][n] = (f32x4){0.f, 0.f, 0.f, 0.f};
        cur = nxt; cA = nA; cB = nB; ++ui;
        if constexpr (ALIGN_EPI) { if (wr == 1) PG8_BAR; }
    }
    PG8_WAIT_V(0);
    if constexpr (!ALIGN_EPI) { if (wr == 0) PG8_BAR; }
    PG8_BAR;
#undef PG8_SA
#undef PG8_SB
#undef PG8_STAGE
#undef PG8_LDA
#undef PG8_LDB
#undef PG8_MMA
#undef PG8_WAIT_V
#undef PG8_WAIT_L
#undef PG8_BAR
#undef PG8_SCHED
}
}

#define XB_TMO      128
#define XB_XCNT(j)  (256  + 64 * (j))
#define XB_XSUB(j)  (1280 + 64 * (j))
#define XB_XGEN(j)  (2304 + 64 * (j))
#define XB_TOP      3328
#define XB_TOPGEN   3392
#define XCD_BAR_WORDS 3456
#define XB_SPIN_CAP (1u << 18)

__device__ __forceinline__ unsigned xb_ld(unsigned* p)              { return __hip_atomic_load(p, __ATOMIC_RELAXED, __HIP_MEMORY_SCOPE_AGENT); }
__device__ __forceinline__ unsigned xb_add(unsigned* p, unsigned v) { return __hip_atomic_fetch_add(p, v, __ATOMIC_RELAXED, __HIP_MEMORY_SCOPE_AGENT); }
__device__ __forceinline__ unsigned xb_xcc_id() { return (unsigned)__builtin_amdgcn_s_getreg((3 << 11) | 20) & 0xFu; }
#define XB_SPIN(cond, bar) do { unsigned _sp = 0; while (cond) { __builtin_amdgcn_s_sleep(1); \
    if ((++_sp & 255u) == 0u) { if (xb_ld(&(bar)[XB_TMO])) break; if (_sp > XB_SPIN_CAP) { atomicAdd(&(bar)[XB_TMO], 1u); break; } } } } while (0)

struct XcdBarrier { unsigned* bar; unsigned x; volatile LAS unsigned* st; };

__device__ __forceinline__ XcdBarrier xcd_barrier_post(unsigned* bar, volatile LAS unsigned* st) {
    XcdBarrier b; b.bar = bar; b.x = xb_xcc_id(); b.st = st;
    if (threadIdx.x == 0) (void)xb_add(&bar[XB_XCNT(b.x)], 1u);
    return b;
}
__device__ __forceinline__ void xcd_barrier_complete(unsigned* bar, unsigned x, unsigned& nloc, unsigned& nx) {
    const unsigned G = gridDim.x * gridDim.y * gridDim.z;
    unsigned sum, cnt, mine, sp = 0u;
    for (;;) {
        sum = 0u; cnt = 0u; mine = 0u;
#pragma unroll
        for (unsigned j = 0; j < 16; ++j) { const unsigned c = xb_ld(&bar[XB_XCNT(j)]); sum += c; cnt += (c > 0u) ? 1u : 0u; mine = (j == x) ? c : mine; }
        if (sum == G) break;
        __builtin_amdgcn_s_sleep(1);
        if ((++sp & 255u) == 0u) { if (xb_ld(&bar[XB_TMO])) break; if (sp > XB_SPIN_CAP) { atomicAdd(&bar[XB_TMO], 1u); break; } }
    }
    nloc = mine > 0u ? mine : 1u; nx = cnt > 0u ? cnt : 1u;
}
__device__ __forceinline__ void xcd_barrier(const XcdBarrier& b) {
    asm volatile("s_waitcnt vmcnt(0)" ::: "memory");
    __syncthreads();
    if (threadIdx.x == 0) {
        unsigned* bar = b.bar;
        __builtin_amdgcn_s_waitcnt(0);
        unsigned nloc = b.st[0], nx = b.st[1];
        if (nloc == 0u) { xcd_barrier_complete(bar, b.x, nloc, nx); b.st[0] = nloc; b.st[1] = nx; }
        const unsigned old = xb_add(&bar[XB_XSUB(b.x)], 1u);
        const unsigned gen = old / nloc;
        if (old + 1u == (gen + 1u) * nloc) {
            __builtin_amdgcn_fence(__ATOMIC_RELEASE, "agent");
            asm volatile("s_waitcnt vmcnt(0)" ::: "memory");
            const unsigned og = xb_add(&bar[XB_TOP], 1u);
            const unsigned tg = og / nx;
            if (og + 1u == (tg + 1u) * nx) xb_add(&bar[XB_TOPGEN], 1u);
            else XB_SPIN(xb_ld(&bar[XB_TOPGEN]) == tg, bar);
            __builtin_amdgcn_fence(__ATOMIC_ACQUIRE, "agent");
            xb_add(&bar[XB_XGEN(b.x)], 1u);
            asm volatile("s_waitcnt vmcnt(0)" ::: "memory");
        } else {
            XB_SPIN(xb_ld(&bar[XB_XGEN(b.x)]) == gen, bar);
            __builtin_amdgcn_fence(__ATOMIC_ACQUIRE, "agent");
            asm volatile("s_waitcnt vmcnt(0)" ::: "memory");
        }
    }
    __syncthreads();
}

constexpr int NWAVES = 8;
constexpr int RING_BYTES = 131072;
constexpr int LDSCTL_OFF = RING_BYTES, MISC_OFF = LDSCTL_OFF + 320;
constexpr int LDS_BYTES = 147456;
constexpr int NPHASE = 2 + 6 * NLAYER;

#define LDS_WAIT() asm volatile("s_waitcnt lgkmcnt(0)" ::: "memory")

struct Args { const float* in[20]; float* out; unsigned char* ws; int ph_lo, ph_hi, li, pad; };

#define CAS __attribute__((address_space(4)))
struct Frame {
    LAS unsigned char* lds;
    int tid, lane, wave, G, gw, NGW;
    const CAS unsigned char* ka;
    __device__ __forceinline__ const float* x() const { return *(const float* const CAS*)(ka + 0); }
    __device__ __forceinline__ const float* c() const { return *(const float* const CAS*)(ka + 8); }
    __device__ __forceinline__ const float* ctx() const { return *(const float* const CAS*)(ka + 16); }
    __device__ __forceinline__ const float* c_ctx() const { return *(const float* const CAS*)(ka + 24); }
    __device__ __forceinline__ const float* w_ada() const { return *(const float* const CAS*)(ka + 32); }
    __device__ __forceinline__ const float* b_ada() const { return *(const float* const CAS*)(ka + 40); }
    __device__ __forceinline__ const float* w_in() const { return *(const float* const CAS*)(ka + 48); }
    __device__ __forceinline__ const float* conv_w() const { return *(const float* const CAS*)(ka + 56); }
    __device__ __forceinline__ const float* sink() const { return *(const float* const CAS*)(ka + 64); }
    __device__ __forceinline__ const float* g_attn() const { return *(const float* const CAS*)(ka + 72); }
    __device__ __forceinline__ const float* g_conv() const { return *(const float* const CAS*)(ka + 80); }
    __device__ __forceinline__ const float* w_out() const { return *(const float* const CAS*)(ka + 88); }
    __device__ __forceinline__ const float* ln1_g() const { return *(const float* const CAS*)(ka + 96); }
    __device__ __forceinline__ const float* ln1_b() const { return *(const float* const CAS*)(ka + 104); }
    __device__ __forceinline__ const float* wq() const { return *(const float* const CAS*)(ka + 112); }
    __device__ __forceinline__ const float* keys() const { return *(const float* const CAS*)(ka + 120); }
    __device__ __forceinline__ const float* pu() const { return *(const float* const CAS*)(ka + 128); }
    __device__ __forceinline__ const float* pv() const { return *(const float* const CAS*)(ka + 136); }
    __device__ __forceinline__ const float* ln2_g() const { return *(const float* const CAS*)(ka + 144); }
    __device__ __forceinline__ const float* ln2_b() const { return *(const float* const CAS*)(ka + 152); }
    __device__ __forceinline__ float* out() const { return *(float* const CAS*)(ka + 160); }
    __device__ __forceinline__ unsigned char* ws() const { return *(unsigned char* const CAS*)(ka + 168); }
    __device__ __forceinline__ float* MODS() const { return (float*)(ws() + WS_MODS); }
    __device__ __forceinline__ float* ROPE() const { return (float*)(ws() + WS_ROPE); }
    __device__ __forceinline__ float* X() const { return (float*)(ws() + WS_X); }
    __device__ __forceinline__ float* SC() const { return (float*)(ws() + WS_SC); }
    __device__ __forceinline__ bf16_t* KBD() const { return (bf16_t*)(ws() + WS_KBD); }
    __device__ __forceinline__ bf16_t* WQR() const { return (bf16_t*)(ws() + WS_WQR); }
    __device__ __forceinline__ bf16_t* WINT() const { return (bf16_t*)(ws() + WS_WINT); }
    __device__ __forceinline__ bf16_t* WOUTT() const { return (bf16_t*)(ws() + WS_WOUTT); }
    __device__ __forceinline__ bf16_t* WEFFT() const { return (bf16_t*)(ws() + WS_WEFFT); }
    __device__ __forceinline__ bf16_t* H() const { return (bf16_t*)(ws() + WS_H); }
    __device__ __forceinline__ bf16_t* PROJ() const { return (bf16_t*)(ws() + WS_PROJ); }
    __device__ __forceinline__ bf16_t* MIX() const { return (bf16_t*)(ws() + WS_MIX); }
    __device__ __forceinline__ unsigned char* UT() const { return (unsigned char*)(ws() + WS_UT); }
    __device__ __forceinline__ unsigned char* VT() const { return (unsigned char*)(ws() + WS_VT); }
    __device__ __forceinline__ float* US() const { return (float*)(ws() + WS_US); }
    __device__ __forceinline__ float* VS() const { return (float*)(ws() + WS_VS); }
};

__device__ __forceinline__ void frame_ids(Frame& F) {
    int tz = threadIdx.x; asm volatile("" : "+v"(tz));
    F.tid = tz; F.lane = tz & 63; F.wave = __builtin_amdgcn_readfirstlane(tz >> 6);
    F.gw = blockIdx.x * NWAVES + F.wave;
    const CAS unsigned char* k = (const CAS unsigned char*)__builtin_amdgcn_kernarg_segment_ptr(); asm volatile("" : "+s"(k)); F.ka = k;
}
__device__ __forceinline__ float wave_sum(float v) {
#pragma unroll
    for (int o = 1; o < 64; o <<= 1) v += __shfl_xor(v, o);
    return v;
}
__device__ __forceinline__ unsigned pk2(float lo, float hi) { return pg8::cvt_pk_bf16(lo, hi); }
__device__ __forceinline__ float bf_lo(unsigned u) { return __uint_as_float(u << 16); }
__device__ __forceinline__ float bf_hi(unsigned u) { return __uint_as_float(u & 0xffff0000u); }
__device__ __forceinline__ int modrow(int t) { return t < TL ? t / SEQ : 2; }

__device__ __forceinline__ void transpose_item(const float* W, int K, int N, bf16_t* WT, LAS float* scr, int item, int lane) {
    const int nblk = N / 32, kb = item / nblk, nb = item % nblk, k0 = 64 * kb, n0 = 32 * nb;
#pragma unroll 8
    for (int i = 0; i < 32; ++i) { const int kk = 2 * i + (lane >> 5); scr[kk * 33 + (lane & 31)] = W[(size_t)(k0 + kk) * N + n0 + (lane & 31)]; }
    LDS_WAIT(); asm volatile("" ::: "memory");
    const int c = lane & 7;
#pragma unroll
    for (int j = 0; j < 4; ++j) { const int n = (lane >> 3) + 8 * j; const LAS float* s = scr + (8 * c) * 33 + n;
        u32x4 o; o.x = pk2(s[0 * 33], s[1 * 33]); o.y = pk2(s[2 * 33], s[3 * 33]); o.z = pk2(s[4 * 33], s[5 * 33]); o.w = pk2(s[6 * 33], s[7 * 33]);
        *(u32x4*)(WT + (size_t)(n0 + n) * K + k0 + 8 * c) = o; }
    LDS_WAIT(); asm volatile("" ::: "memory");
}

__device__ __forceinline__ void cvt_row_bf16(const float* src, bf16_t* dst, int lane) {
    const f32x4* s = (const f32x4*)src + lane; u32x2* d = (u32x2*)dst + lane;
    f32x4 v[8];
#pragma unroll
    for (int j = 0; j < 8; ++j) v[j] = __builtin_nontemporal_load(s + 64 * j);
#pragma unroll
    for (int j = 0; j < 8; ++j) { u32x2 o; o.x = pk2(v[j].x, v[j].y); o.y = pk2(v[j].z, v[j].w); d[64 * j] = o; }
}

template <int FMT>
__device__ __forceinline__ void cvt_row_lp(const float* src, unsigned char* dst, float* inv, int lane) {
    constexpr float QMAX = FMT == 8 ? 224.f : 6.f;
    const f32x4* s = (const f32x4*)src + 2 * lane;
    f32x4 v[4][2]; float am = 0.f;
#pragma unroll
    for (int j = 0; j < 4; ++j) { v[j][0] = __builtin_nontemporal_load(s + 128 * j); v[j][1] = __builtin_nontemporal_load(s + 128 * j + 1); }
#pragma unroll
    for (int j = 0; j < 4; ++j)
#pragma unroll
        for (int q = 0; q < 2; ++q) am = fmaxf(fmaxf(am, fmaxf(fabsf(v[j][q].x), fabsf(v[j][q].y))), fmaxf(fabsf(v[j][q].z), fabsf(v[j][q].w)));
#pragma unroll
    for (int o = 1; o < 64; o <<= 1) am = fmaxf(am, __shfl_xor(am, o));
    const float sc = am > 0.f ? QMAX / am : 1.f;
#pragma unroll
    for (int j = 0; j < 4; ++j) {
        if constexpr (FMT == 8) {
            u32x2 w;
#pragma unroll
            for (int q = 0; q < 2; ++q) { int t = __builtin_amdgcn_cvt_pk_fp8_f32(v[j][q].x * sc, v[j][q].y * sc, 0, false); t = __builtin_amdgcn_cvt_pk_fp8_f32(v[j][q].z * sc, v[j][q].w * sc, t, true); w[q] = (unsigned)t; }
            *((u32x2*)dst + lane + 64 * j) = w;
        } else {
            unsigned w = 0u;
            w = __builtin_amdgcn_cvt_scalef32_pk_fp4_f32(w, v[j][0].x * sc, v[j][0].y * sc, 1.0f, 0);
            w = __builtin_amdgcn_cvt_scalef32_pk_fp4_f32(w, v[j][0].z * sc, v[j][0].w * sc, 1.0f, 1);
            w = __builtin_amdgcn_cvt_scalef32_pk_fp4_f32(w, v[j][1].x * sc, v[j][1].y * sc, 1.0f, 2);
            w = __builtin_amdgcn_cvt_scalef32_pk_fp4_f32(w, v[j][1].z * sc, v[j][1].w * sc, 1.0f, 3);
            *((unsigned*)dst + lane + 64 * j) = w;
        }
    }
    if (lane == 0) *inv = am > 0.f ? am * (1.f / QMAX) : 1.f;
}
template <int FMT> struct LpRow;
template <> struct LpRow<8> { u32x4 a, b;
    __device__ __forceinline__ void load(const unsigned char* rowp, int lane) { a = *(const u32x4*)(rowp + 32 * lane); b = *(const u32x4*)(rowp + 32 * lane + 16); }
    template <class Fn> __device__ __forceinline__ void each(Fn&& f) const {
#pragma unroll
        for (int w = 0; w < 4; ++w) { const f32x2 l0 = __builtin_amdgcn_cvt_pk_f32_fp8((int)a[w], false), h0 = __builtin_amdgcn_cvt_pk_f32_fp8((int)a[w], true);
            f(4 * w, l0.x, l0.y); f(4 * w + 2, h0.x, h0.y); }
#pragma unroll
        for (int w = 0; w < 4; ++w) { const f32x2 l0 = __builtin_amdgcn_cvt_pk_f32_fp8((int)b[w], false), h0 = __builtin_amdgcn_cvt_pk_f32_fp8((int)b[w], true);
            f(16 + 4 * w, l0.x, l0.y); f(16 + 4 * w + 2, h0.x, h0.y); }
    } };
template <> struct LpRow<4> { u32x4 a;
    __device__ __forceinline__ void load(const unsigned char* rowp, int lane) { a = *(const u32x4*)(rowp + 16 * lane); }
    template <class Fn> __device__ __forceinline__ void each(Fn&& f) const {
#pragma unroll
        for (int w = 0; w < 4; ++w) {
            const f32x2 d0 = __builtin_amdgcn_cvt_scalef32_pk_f32_fp4(a[w], 1.0f, 0), d1 = __builtin_amdgcn_cvt_scalef32_pk_f32_fp4(a[w], 1.0f, 1);
            const f32x2 d2 = __builtin_amdgcn_cvt_scalef32_pk_f32_fp4(a[w], 1.0f, 2), d3 = __builtin_amdgcn_cvt_scalef32_pk_f32_fp4(a[w], 1.0f, 3);
            f(8 * w, d0.x, d0.y); f(8 * w + 2, d1.x, d1.y); f(8 * w + 4, d2.x, d2.y); f(8 * w + 6, d3.x, d3.y); }
    } };

__device__ __forceinline__ void row_stats(const f32x4 (&v)[8], float& mean, float& rstd) {
    float s = 0.f;
#pragma unroll
    for (int j = 0; j < 8; ++j) s += (v[j].x + v[j].y) + (v[j].z + v[j].w);
    mean = wave_sum(s) * (1.f / D);
    float s2 = 0.f;
#pragma unroll
    for (int j = 0; j < 8; ++j) { const f32x4 d = v[j] - mean; s2 += (d.x * d.x + d.y * d.y) + (d.z * d.z + d.w * d.w); }
    rstd = 1.f / sqrtf(wave_sum(s2) * (1.f / D) + LN_EPS);
}
__device__ __forceinline__ void modulate_store(const f32x4 (&v)[8], const float* shift, const float* scale, bf16_t* dst, int lane) {
    float mean, rstd; row_stats(v, mean, rstd);
    u32x2* d = (u32x2*)dst + lane;
#pragma unroll
    for (int j = 0; j < 8; ++j) { const f32x4 sc = *((const f32x4*)scale + lane + 64 * j), sh = *((const f32x4*)shift + lane + 64 * j);
        const f32x4 y = (v[j] - mean) * rstd * (sc + 1.f) + sh;
        u32x2 o; o.x = pk2(y.x, y.y); o.y = pk2(y.z, y.w); d[64 * j] = o; }
}

__device__ __forceinline__ void p0a_prologue(Frame& F) {
    LAS float* condL = (LAS float*)F.lds;
    LAS float* red = (LAS float*)(F.lds + 24576);
    for (int i = F.tid; i < 3 * D; i += NWAVES * 64) { const int r = i / D, k = i % D; const float v = r < 2 ? F.c()[r * D + k] : F.c_ctx()[k]; condL[i] = v / (1.f + __expf(-v)); }
    __syncthreads();
    for (int item = blockIdx.x; item < 384; item += F.G) {
        const int l = item / 96, n0 = (item % 96) * 128;
        const float* wp = F.w_ada() + ((size_t)l * D + F.wave * 256) * 12288 + n0 + 2 * F.lane;
        f32x2 a0 = {0.f, 0.f}, a1 = {0.f, 0.f}, a2 = {0.f, 0.f};
#pragma unroll 8
        for (int k = 0; k < 256; ++k) { const f32x2 w = __builtin_nontemporal_load((const f32x2*)(wp + (size_t)k * 12288)); const int kk = F.wave * 256 + k;
            a0 += w * condL[kk]; a1 += w * condL[D + kk]; a2 += w * condL[2 * D + kk]; }
        LAS float* rp = red + F.wave * 384 + 2 * F.lane;
        rp[0] = a0.x; rp[1] = a0.y; rp[128] = a1.x; rp[129] = a1.y; rp[256] = a2.x; rp[257] = a2.y;
        __syncthreads();
        if (F.tid < 384) { const int r = F.tid / 128, n = F.tid % 128; float s = 0.f;
#pragma unroll
            for (int w = 0; w < 8; ++w) s += red[w * 384 + r * 128 + n];
            F.MODS()[((size_t)l * 3 + r) * 12288 + n0 + n] = s + F.b_ada()[(size_t)l * 12288 + n0 + n]; }
        __syncthreads();
    }
    LAS float* scr = (LAS float*)(F.lds + 40960 + F.wave * 8448);
    constexpr int I_IN = (D / 64) * (INC / 32), I_OUT = (D / 64) * (D / 32);
    for (int it = F.gw; it < NLAYER * (I_IN + I_OUT); it += F.NGW) {
        const int l = it / (I_IN + I_OUT); int r = it % (I_IN + I_OUT);
        if (r < I_IN) transpose_item(F.w_in() + (size_t)l * D * INC, D, INC, F.WINT() + (size_t)l * INC * D, scr, r, F.lane);
        else transpose_item(F.w_out() + (size_t)l * D * D, D, D, F.WOUTT() + (size_t)l * D * D, scr, r - I_IN, F.lane);
    }
    for (int row = F.gw; row < NLAYER * D; row += F.NGW) {
        const int l = row / D, c = row % D; const f32x4* s = (const f32x4*)(F.wq() + (size_t)row * D) + F.lane;
#pragma unroll
        for (int j = 0; j < 8; ++j) { const f32x4 v = s[64 * j]; u32x2 o; o.x = pk2(v.x, v.y); o.y = pk2(v.z, v.w);
            *((u32x2*)(F.WQR() + ((size_t)(l * 8 + j) * D + c) * 256) + F.lane) = o; }
    }
    for (int row = F.gw; row < 32 * 256; row += F.NGW) {
        const int lh = row >> 8, pk = row & 255, p = pk >> 7;
        u32x2 o = {0u, 0u};
        if ((F.lane >> 5) == p) { const f32x4 v = *((const f32x4*)(F.keys() + ((size_t)lh * 256 + pk) * 128) + (F.lane & 31)); o.x = pk2(v.x, v.y); o.y = pk2(v.z, v.w); }
        *((u32x2*)(F.KBD() + (size_t)row * 256) + F.lane) = o;
    }
    for (int row = F.gw; row < NLAYER * NEXP; row += F.NGW) {
        cvt_row_lp<U_FMT>(F.pu() + (size_t)row * D, F.UT() + (size_t)row * UROW, F.US() + row, F.lane);
        cvt_row_lp<V_FMT>(F.pv() + (size_t)row * D, F.VT() + (size_t)row * VROW, F.VS() + row, F.lane);
    }
    for (int i = blockIdx.x * (NWAVES * 64) + F.tid; i < 192 * 32; i += F.G * NWAVES * 64) {
        const int idx = i >> 5, f = i & 31; const float pos = (float)(idx < 128 ? idx : idx - 128);
        const float inv = powf(10000.f, -(float)(2 * f) / 64.f); const float ang = pos * inv;
        F.ROPE()[2 * i] = cosf(ang); F.ROPE()[2 * i + 1] = sinf(ang);
    }
}

__device__ __forceinline__ void p0b_mod0(Frame& F) {
    for (int t = F.gw; t < TT; t += F.NGW) {
        const float* src = t < TL ? F.x() + (size_t)t * D : F.ctx() + (size_t)(t - TL) * D;
        f32x4 v[8];
#pragma unroll
        for (int j = 0; j < 8; ++j) v[j] = *((const f32x4*)src + F.lane + 64 * j);
        const float* mp = F.MODS() + (size_t)modrow(t) * 12288;
        modulate_store(v, mp, mp + D, F.H() + (size_t)t * D, F.lane);
    }
}

constexpr int KP = 272, VP = 320, KS_BYTES = 64 * KP, VS_BYTES = 64 * VP;
struct KVRegs { u32x4 k1, k2, v1, v2; f32x4 cs[4]; };

__device__ __forceinline__ void attn_load_tile(Frame& F, KVRegs& R, int ti, int b, int n, int g) {
    const int key = F.tid >> 3, c8 = F.tid & 7;
    int row, pos = 0;
    if (ti < 6) { pos = (n - 1) * 128 + 64 * ti + key; row = b * SEQ + pos; } else row = TL + b * CTXL + 64 * (ti - 6) + key;
    const bf16_t* base = F.PROJ() + (size_t)row * INC;
    const int d1 = (c8 >> 2) * 64 + (c8 & 3) * 8;
    R.k1 = *(const u32x4*)(base + OFF_K + g * 128 + d1); R.k2 = *(const u32x4*)(base + OFF_K + g * 128 + d1 + 32);
    R.v1 = *(const u32x4*)(base + OFF_V + g * 128 + 8 * c8); R.v2 = *(const u32x4*)(base + OFF_V + g * 128 + 64 + 8 * c8);
    if (ti < 6) { const int tidx = (c8 >> 2) ? 128 + (pos & 63) : (pos >> 6); const f32x4* cp = (const f32x4*)(F.ROPE() + ((size_t)tidx * 32 + (c8 & 3) * 8) * 2);
#pragma unroll
        for (int m = 0; m < 4; ++m) R.cs[m] = cp[m]; }
}
__device__ __forceinline__ void rope8(u32x4& a, u32x4& bq, const f32x4 (&cs)[4], float scale) {
    u32x4 oa, ob;
#pragma unroll
    for (int w = 0; w < 4; ++w) {
        const float x1l = bf_lo(a[w]), x1h = bf_hi(a[w]), x2l = bf_lo(bq[w]), x2h = bf_hi(bq[w]);
        const float cl = cs[w].x, sl = cs[w].y, ch = cs[w].z, sh = cs[w].w;
        oa[w] = pk2((x1l * cl - x2l * sl) * scale, (x1h * ch - x2h * sh) * scale);
        ob[w] = pk2((x2l * cl + x1l * sl) * scale, (x2h * ch + x1h * sh) * scale);
    }
    a = oa; bq = ob;
}
__device__ __forceinline__ void attn_store_tile(Frame& F, KVRegs& R, int ti, int buf) {
    const int key = F.tid >> 3, c8 = F.tid & 7;
    if (ti < 6) rope8(R.k1, R.k2, R.cs, 1.f);
    const int d1 = (c8 >> 2) * 64 + (c8 & 3) * 8;
    LAS unsigned char* kp = F.lds + buf * KS_BYTES + key * KP;
    *(LAS u32x4*)(kp + d1 * 2) = R.k1; *(LAS u32x4*)(kp + (d1 + 32) * 2) = R.k2;
    LAS unsigned char* vp = F.lds + 2 * KS_BYTES + buf * VS_BYTES + key * VP;
    *(LAS u32x4*)(vp + 16 * c8) = R.v1; *(LAS u32x4*)(vp + 128 + 16 * c8) = R.v2;
}

#define MFMA32(a, b, c) __builtin_amdgcn_mfma_f32_32x32x16_bf16((a), (b), (c), 0, 0, 0)

__device__ __forceinline__ void attn_unit(Frame& F, int layer, int u) {
    const bool latent = u < 512;
    int b, n, g, hp;
    if (latent) { hp = u & 1; g = (u >> 1) & 1; n = (u >> 2) & 63; b = u >> 8; }
    else { const int v = u - 512; hp = v & 1; g = (v >> 1) & 1; n = (v >> 2) & 1; b = v >> 3; }
    const int lane = F.lane, r = lane & 31, h = lane >> 5, wave = F.wave;
    const int head = g * 4 + hp * 2 + (wave >> 2), qb = wave & 3;
    const int tq = latent ? b * SEQ + n * 128 + 32 * qb + r : TL + b * CTXL + n * 128 + 32 * qb + r;
    bf16x8 qf[8];
    {
        u32x4 raw[8];
        const bf16_t* qp = F.PROJ() + (size_t)tq * INC + OFF_Q + head * 128 + 8 * h;
#pragma unroll
        for (int ks = 0; ks < 8; ++ks) raw[ks] = *(const u32x4*)(qp + 16 * ks);
        if (latent) {
            const int pos = n * 128 + 32 * qb + r;
#pragma unroll
            for (int half = 0; half < 2; ++half) {
                const int tidx = half ? 128 + (pos & 63) : (pos >> 6);
#pragma unroll
                for (int kk = 0; kk < 2; ++kk) {
                    const f32x4* cp = (const f32x4*)(F.ROPE() + ((size_t)tidx * 32 + 16 * kk + 8 * h) * 2);
                    f32x4 cs[4];
#pragma unroll
                    for (int m = 0; m < 4; ++m) cs[m] = cp[m];
                    rope8(raw[4 * half + kk], raw[4 * half + kk + 2], cs, QSCALE);
                }
            }
        } else {
#pragma unroll
            for (int ks = 0; ks < 8; ++ks)
#pragma unroll
                for (int w = 0; w < 4; ++w) raw[ks][w] = pk2(bf_lo(raw[ks][w]) * QSCALE, bf_hi(raw[ks][w]) * QSCALE);
        }
#pragma unroll
        for (int ks = 0; ks < 8; ++ks) qf[ks] = __builtin_bit_cast(bf16x8, raw[ks]);
    }
    int tlo = 6, nw = 0;
    if (latent) { tlo = (n == 0) ? 2 : 0; const int thi = (n == 63) ? 3 : 5; nw = thi - tlo + 1; }
    const int ntiles = nw + 4;
    f32x16 o[4];
#pragma unroll
    for (int db = 0; db < 4; ++db)
#pragma unroll
        for (int i = 0; i < 16; ++i) o[db][i] = 0.f;
    float m_run = F.sink()[layer * 8 + head] * LOG2E;
    float lsum = h == 0 ? 1.f : 0.f;
    const int iq = 32 * qb + r;
    KVRegs R;
    __syncthreads();
    attn_load_tile(F, R, nw > 0 ? tlo : 6, b, n, g);
    attn_store_tile(F, R, nw > 0 ? tlo : 6, 0);
    __syncthreads();
    const int i16 = lane & 15, tq4 = i16 >> 2, tp = i16 & 3, blk = (lane >> 4) & 1;
    for (int j = 0; j < ntiles; ++j) {
        const int ti = j < nw ? tlo + j : 6 + (j - nw);
        const int buf = j & 1;
        const bool more = j + 1 < ntiles;
        const int tin = (j + 1) < nw ? tlo + j + 1 : 6 + (j + 1 - nw);
        if (more) attn_load_tile(F, R, tin, b, n, g);
        const bool part = ti >= 6 || (ti >= (qb >> 1) && ti <= (qb >> 1) + 4);
        if (part) {
            f32x16 s0, s1;
#pragma unroll
            for (int i = 0; i < 16; ++i) { s0[i] = 0.f; s1[i] = 0.f; }
            const LAS unsigned char* kb = F.lds + buf * KS_BYTES + r * KP + h * 16;
#pragma unroll
            for (int ks = 0; ks < 8; ++ks) {
                const bf16x8 a0 = *(const LAS bf16x8*)(kb + ks * 32), a1 = *(const LAS bf16x8*)(kb + 32 * KP + ks * 32);
                s0 = MFMA32(a0, qf[ks], s0); s1 = MFMA32(a1, qf[ks], s1);
            }
            float mx = -INFINITY;
            if (ti < 6) {
                const int jb = 64 * ti + 4 * h - iq;
#pragma unroll
                for (int i = 0; i < 16; ++i) { const int j0 = jb + (i & 3) + 8 * (i >> 2), j1 = j0 + 32;
                    s0[i] = (j0 >= 0 && j0 <= 256) ? s0[i] : -INFINITY; s1[i] = (j1 >= 0 && j1 <= 256) ? s1[i] : -INFINITY; }
            }
#pragma unroll
            for (int i = 0; i < 16; ++i) mx = fmaxf(mx, fmaxf(s0[i], s1[i]));
            mx = fmaxf(mx, __shfl_xor(mx, 32));
            const float m_new = fmaxf(m_run, mx), alpha = exp2f(m_run - m_new);
            m_run = m_new; lsum *= alpha;
#pragma unroll
            for (int i = 0; i < 16; ++i) { s0[i] = exp2f(s0[i] - m_new); s1[i] = exp2f(s1[i] - m_new); lsum += s0[i] + s1[i]; }
#pragma unroll
            for (int db = 0; db < 4; ++db)
#pragma unroll
                for (int i = 0; i < 16; ++i) o[db][i] *= alpha;
            bf16x8 pf[2][2];
#pragma unroll
            for (int s2 = 0; s2 < 2; ++s2) {
                u32x4 p0, p1;
#pragma unroll
                for (int w = 0; w < 4; ++w) { p0[w] = pk2(s0[8 * s2 + 2 * w], s0[8 * s2 + 2 * w + 1]); p1[w] = pk2(s1[8 * s2 + 2 * w], s1[8 * s2 + 2 * w + 1]); }
                pf[0][s2] = __builtin_bit_cast(bf16x8, p0); pf[1][s2] = __builtin_bit_cast(bf16x8, p1);
            }
            const LAS unsigned char* vb = F.lds + 2 * KS_BYTES + buf * VS_BYTES + (4 * h + tq4) * VP + 32 * blk + 8 * tp;
#pragma unroll
            for (int db = 0; db < 4; ++db)
#pragma unroll
                for (int kb2 = 0; kb2 < 2; ++kb2)
#pragma unroll
                    for (int s2 = 0; s2 < 2; ++s2) {
                        const int off = (32 * kb2 + 16 * s2) * VP + db * 64;
                        const s16x4 lo = __builtin_amdgcn_ds_read_tr16_b64_v4i16((LAS s16x4*)(vb + off));
                        const s16x4 hi = __builtin_amdgcn_ds_read_tr16_b64_v4i16((LAS s16x4*)(vb + off + 8 * VP));
                        const bf16x8 av = __builtin_shufflevector(lo, hi, 0, 1, 2, 3, 4, 5, 6, 7);
                        o[db] = MFMA32(av, pf[kb2][s2], o[db]);
                    }
        }
        if (more) attn_store_tile(F, R, tin, buf ^ 1);
        __syncthreads();
    }
    const float lt = lsum + __shfl_xor(lsum, 32);
    const float inv = 1.f / lt;
    float ss = 0.f;
#pragma unroll
    for (int db = 0; db < 4; ++db)
#pragma unroll
        for (int i = 0; i < 16; ++i) { o[db][i] *= inv; ss += o[db][i] * o[db][i]; }
    ss += __shfl_xor(ss, 32);
    const float rn = 1.f / sqrtf(ss * (1.f / 128.f) + LN_EPS);
    bf16_t* op = F.MIX() + (size_t)tq * D + head * 128 + 4 * h;
    const float* gp = F.g_attn() + layer * 1024 + head * 128 + 4 * h;
#pragma unroll
    for (int db = 0; db < 4; ++db)
#pragma unroll
        for (int g4 = 0; g4 < 4; ++g4) {
            const f32x4 gv = *(const f32x4*)(gp + 32 * db + 8 * g4);
            u32x2 w; w.x = pk2(o[db][4 * g4] * rn * gv.x, o[db][4 * g4 + 1] * rn * gv.y); w.y = pk2(o[db][4 * g4 + 2] * rn * gv.z, o[db][4 * g4 + 3] * rn * gv.w);
            *(u32x2*)(op + 32 * db + 8 * g4) = w;
        }
}

__device__ __forceinline__ void unpack8(const u32x4 v, float (&f)[8]) {
#pragma unroll
    for (int w = 0; w < 4; ++w) { f[2 * w] = bf_lo(v[w]); f[2 * w + 1] = bf_hi(v[w]); }
}
__device__ __forceinline__ void conv_row(Frame& F, int layer, int t) {
    bool first, last;
    if (t < TL) { const int pos = t & (SEQ - 1); first = pos == 0; last = pos == SEQ - 1; } else { const int pc = (t - TL) & (CTXL - 1); first = pc == 0; last = pc == CTXL - 1; }
    const bf16_t* p = F.PROJ() + (size_t)t * INC;
    const float* cw = F.conv_w() + (size_t)layer * 3 * 1024;
#pragma unroll
    for (int jc = 0; jc < 2; ++jc) {
        const int c = 8 * F.lane + 512 * jc;
        float gb[8], a[8], bq[8], um[8], ut[8], up[8];
        unpack8(*(const u32x4*)(p + c), gb);
        unpack8(*(const u32x4*)(p + OFF_C + c), a); unpack8(*(const u32x4*)(p + OFF_X + c), bq);
#pragma unroll
        for (int e = 0; e < 8; ++e) ut[e] = a[e] * bq[e];
        if (!first) { unpack8(*(const u32x4*)(p - INC + OFF_C + c), a); unpack8(*(const u32x4*)(p - INC + OFF_X + c), bq);
#pragma unroll
            for (int e = 0; e < 8; ++e) um[e] = a[e] * bq[e]; }
        else {
#pragma unroll
            for (int e = 0; e < 8; ++e) um[e] = 0.f; }
        if (!last) { unpack8(*(const u32x4*)(p + INC + OFF_C + c), a); unpack8(*(const u32x4*)(p + INC + OFF_X + c), bq);
#pragma unroll
            for (int e = 0; e < 8; ++e) up[e] = a[e] * bq[e]; }
        else {
#pragma unroll
            for (int e = 0; e < 8; ++e) up[e] = 0.f; }
        float y[8], ss = 0.f;
#pragma unroll
        for (int e = 0; e < 8; ++e) { y[e] = gb[e] * (cw[c + e] * um[e] + cw[1024 + c + e] * ut[e] + cw[2048 + c + e] * up[e]); ss += y[e] * y[e]; }
        ss += __shfl_xor(ss, 1); ss += __shfl_xor(ss, 2); ss += __shfl_xor(ss, 4); ss += __shfl_xor(ss, 8);
        const float rn = 1.f / sqrtf(ss * (1.f / 128.f) + LN_EPS);
        const float* gc = F.g_conv() + layer * 1024 + c;
        u32x4 w;
#pragma unroll
        for (int q = 0; q < 4; ++q) w[q] = pk2(y[2 * q] * rn * gc[2 * q], y[2 * q + 1] * rn * gc[2 * q + 1]);
        *(u32x4*)(F.MIX() + (size_t)t * D + 1024 + c) = w;
    }
}

__device__ __forceinline__ void ln_phase(Frame& F, int layer, int rows) {
    for (int t = F.gw; t < rows; t += F.NGW) {
        float* xr = F.X() + (size_t)t * D;
        f32x4 v[8];
#pragma unroll
        for (int j = 0; j < 8; ++j) v[j] = *((const f32x4*)xr + F.lane + 64 * j);
        float mean, rstd; row_stats(v, mean, rstd);
        const float* g1 = F.ln1_g() + layer * D; const float* b1 = F.ln1_b() + layer * D;
#pragma unroll
        for (int j = 0; j < 8; ++j) { const f32x4 gg = *((const f32x4*)g1 + F.lane + 64 * j), bb = *((const f32x4*)b1 + F.lane + 64 * j);
            v[j] = (v[j] - mean) * rstd * gg + bb; *((f32x4*)xr + F.lane + 64 * j) = v[j]; }
        const float* mp = F.MODS() + ((size_t)layer * 3 + modrow(t)) * 12288;
        modulate_store(v, mp + 3 * D, mp + 4 * D, F.H() + (size_t)t * D, F.lane);
    }
}

__device__ __forceinline__ unsigned ordkey(float f) { const unsigned u = __float_as_uint(f); return u ^ ((u >> 31) ? 0xFFFFFFFFu : 0x80000000u); }
__device__ __forceinline__ float gelu_erf(float a) { return 0.5f * a * (1.f + erff(a * 0.70710678118654752f)); }

template <int CTRL> __device__ __forceinline__ int dpp_i(int v) { return __builtin_amdgcn_update_dpp(0, v, CTRL, 0xf, 0xf, true); }
template <int CTRL> __device__ __forceinline__ float dpp_f(float v) { return __int_as_float(dpp_i<CTRL>(__float_as_int(v))); }
constexpr int DPP_XOR1 = 0xB1, DPP_XOR2 = 0x4E, DPP_HMIRROR = 0x141, DPP_ROR4 = 0x124, DPP_ROR8 = 0x128;
__device__ __forceinline__ float wave_sum_u(float v) {
    v += dpp_f<DPP_XOR1>(v); v += dpp_f<DPP_XOR2>(v); v += dpp_f<DPP_ROR4>(v); v += dpp_f<DPP_ROR8>(v);
    const float r0 = __int_as_float(__builtin_amdgcn_readlane(__float_as_int(v), 0)), r1 = __int_as_float(__builtin_amdgcn_readlane(__float_as_int(v), 16));
    const float r2 = __int_as_float(__builtin_amdgcn_readlane(__float_as_int(v), 32)), r3 = __int_as_float(__builtin_amdgcn_readlane(__float_as_int(v), 48));
    return (r0 + r1) + (r2 + r3);
}
__device__ __forceinline__ float unordkey(unsigned k) { return __uint_as_float(k ^ ((k >> 31) ? 0x80000000u : 0xFFFFFFFFu)); }
__device__ __forceinline__ float gelu_as(float v) {
    const float av = fabsf(v), t = __builtin_amdgcn_rcpf(av * 0.2316418882f + 1.0f);
    float q = t * 0.5307027145f + (-0.7265760135f); q = q * t + 0.7107068705f; q = q * t + (-0.142248368f); q = q * t + 0.127414796f; q = q * t;
    const float e = __builtin_amdgcn_exp2f((v * v) * (-0.72134752044f));
    const float m = v * (q * e);
    return v < 0.f ? m : v - m;
}

constexpr int PE_WS = 5120;
template <int NL>
__device__ __forceinline__ unsigned topk_threshold(const unsigned (&k)[32]) {
    unsigned T = 0u; int cT = 32 * NL;
    for (int bit = 31; bit >= 0; --bit) {
        const unsigned cand = T | (1u << bit);
        int c = 0;
#pragma unroll
        for (int i = 0; i < 32; ++i) c += (k[i] >= cand) ? 1 : 0;
        c += dpp_i<DPP_XOR1>(c); c += dpp_i<DPP_XOR2>(c);
        if (NL == 8) c += dpp_i<DPP_HMIRROR>(c);
        const bool ok = c >= 16;
        T = ok ? cand : T; cT = ok ? c : cT;
        if (__all(cT == 16)) break;
    }
    return T;
}
template <int NL, class PayFn>
__device__ __forceinline__ void topk_compact(const unsigned (&k)[32], unsigned T, LAS int* cnt, int lane, int sl, LAS unsigned char* dst, LAS unsigned char* trash, PayFn&& pay) {
    int ng = 0, ne = 0;
#pragma unroll
    for (int i = 0; i < 32; ++i) { ng += (k[i] > T) ? 1 : 0; ne += (k[i] == T) ? 1 : 0; }
    cnt[lane] = ng | (ne << 8);
    LDS_WAIT(); __builtin_amdgcn_wave_barrier();
    int pg = 0, pe = 0, tg = 0;
#pragma unroll
    for (int j = 0; j < NL; ++j) { const int c = cnt[(lane & ~(NL - 1)) + j]; const int g = c & 255, e = c >> 8; tg += g; if (j < sl) { pg += g; pe += e; } }
    pe += tg;
    LDS_WAIT(); __builtin_amdgcn_wave_barrier();
#pragma unroll
    for (int i = 0; i < 32; ++i) {
        const bool g = k[i] > T, e = k[i] == T;
        const bool wr = g || (e && pe < 16);
        const int pos = g ? pg : pe;
        LAS unsigned char* p = wr ? dst + 8 * pos : trash;
        u32x2 w; w.x = __float_as_uint(unordkey(k[i])); w.y = (unsigned)pay(i);
        *(LAS u32x2*)p = w;
        pg += g ? 1 : 0; pe += e ? 1 : 0;
    }
    LDS_WAIT(); __builtin_amdgcn_wave_barrier();
}

__device__ __forceinline__ void peer_topk(Frame& F, LAS unsigned char* ws, int t) {
    const int lane = F.lane;
    LAS unsigned char* S1 = ws; LAS unsigned char* FL = ws + 2048; LAS int* CNT = (LAS int*)(ws + 3072);
    LAS int* EL = (LAS int*)(ws + 3328); LAS float* GL = (LAS float*)(ws + 3840); LAS unsigned char* trash = ws + 4352 + 8 * lane;
    {
        const int L = lane >> 2, sub = lane & 3;
        const float* sp = F.SC() + (size_t)t * D + L * 128 + sub * 4;
        unsigned k[32];
#pragma unroll
        for (int r = 0; r < 8; ++r) { const f32x4 v = *(const f32x4*)(sp + 16 * r);
#pragma unroll
            for (int e = 0; e < 4; ++e) k[4 * r + e] = ordkey(v[e]); }
        const unsigned T = topk_threshold<4>(k);
        topk_compact<4>(k, T, CNT, lane, sub, S1 + L * 128, trash, [&](int i) { return 4 * sub + 16 * (i >> 2) + (i & 3); });
    }
    {
        const int hd = lane >> 3, s8 = lane & 7;
        const LAS unsigned char* la = S1 + (2 * hd) * 128, *lb = S1 + (2 * hd + 1) * 128;
        const u32x4 A = *(const LAS u32x4*)(la + 16 * s8);
        float bv[16]; unsigned k[32];
#pragma unroll
        for (int q = 0; q < 8; ++q) { const u32x4 B = *(const LAS u32x4*)(lb + 16 * q); bv[2 * q] = __uint_as_float(B.x); bv[2 * q + 1] = __uint_as_float(B.z); }
#pragma unroll
        for (int i = 0; i < 32; ++i) k[i] = ordkey(__uint_as_float(i < 16 ? A.x : A.z) + bv[i & 15]);
        const unsigned T = topk_threshold<8>(k);
        topk_compact<8>(k, T, CNT, lane, s8, FL + hd * 128, trash, [&](int i) { const int bi = (int)*(const LAS unsigned*)(lb + 8 * (i & 15) + 4); return (int)(i < 16 ? A.y : A.w) * 128 + bi; });
        float fvv[16]; float mx = -INFINITY;
#pragma unroll
        for (int q = 0; q < 8; ++q) { const u32x4 Q = *(const LAS u32x4*)(FL + hd * 128 + 16 * q); fvv[2 * q] = __uint_as_float(Q.x); fvv[2 * q + 1] = __uint_as_float(Q.z); }
#pragma unroll
        for (int i = 0; i < 16; ++i) mx = fmaxf(mx, fvv[i]);
        float den = 0.f;
#pragma unroll
        for (int i = 0; i < 16; ++i) den += __expf(fvv[i] - mx);
        const u32x4 Me = *(const LAS u32x4*)(FL + hd * 128 + 16 * s8);
        const float rd = 1.f / den;
        GL[hd * 16 + 2 * s8] = __expf(__uint_as_float(Me.x) - mx) * rd; GL[hd * 16 + 2 * s8 + 1] = __expf(__uint_as_float(Me.z) - mx) * rd;
        EL[hd * 16 + 2 * s8] = (int)Me.y; EL[hd * 16 + 2 * s8 + 1] = (int)Me.w;
        LDS_WAIT(); __builtin_amdgcn_wave_barrier();
    }
}

#ifndef PROBE_PHASE
#define PROBE_PHASE -1
#endif
#ifndef PROBE_MULT
#define PROBE_MULT 1
#endif
constexpr int EB = 4;
constexpr int CW_TICKET = 20480;

struct GBuf { LpRow<U_FMT> u[EB]; LpRow<V_FMT> v[EB]; float su[EB], sv[EB], g[EB]; };
__device__ __forceinline__ void gather_issue(GBuf& B, const LAS int* EL, const LAS float* GL, int i0, const unsigned char* UTl, const unsigned char* VTl, const float* USl, const float* VSl, int lane) {
#pragma unroll
    for (int q = 0; q < EB; ++q) {
        const int ex = __builtin_amdgcn_readfirstlane(EL[i0 + q]);
        B.g[q] = __uint_as_float(__builtin_amdgcn_readfirstlane(__float_as_uint(GL[i0 + q])));
        B.u[q].load(UTl + (size_t)ex * UROW, lane); B.v[q].load(VTl + (size_t)ex * VROW, lane); B.su[q] = USl[ex]; B.sv[q] = VSl[ex];
    }
}
__device__ __forceinline__ void gather_compute(const GBuf& B, const f32x2 (&hv)[16], f32x2 (&acc)[16]) {
    float dot[EB];
#pragma unroll
    for (int q = 0; q < EB; ++q) { f32x2 s = {0.f, 0.f};
        B.u[q].each([&](int i, float x0, float x1) { const f32x2 x = {x0, x1}; s = __builtin_elementwise_fma(x, hv[i >> 1], s); });
        dot[q] = s.x + s.y; }
#pragma unroll
    for (int q = 0; q < EB; ++q) dot[q] = wave_sum_u(dot[q]);
#pragma unroll
    for (int q = 0; q < EB; ++q) { const float cf = B.g[q] * gelu_as(dot[q] * B.su[q]) * B.sv[q]; const f32x2 c2 = {cf, cf};
        B.v[q].each([&](int i, float x0, float x1) { const f32x2 x = {x0, x1}; acc[i >> 1] = __builtin_elementwise_fma(x, c2, acc[i >> 1]); }); }
}

__device__ __forceinline__ void peer_phase(Frame& F, int layer, int rows, unsigned* ctl, unsigned long long& pr_acc) {
    unsigned long long pt0 = 0ull;
#define SUB_BEGIN(ty) do { if (PROBE_PHASE == (ty)) pt0 = __builtin_amdgcn_s_memrealtime(); } while (0)
#define SUB_END(ty) do { if (PROBE_PHASE == (ty)) pr_acc += __builtin_amdgcn_s_memrealtime() - pt0; } while (0)
    LAS unsigned char* ws = F.lds + F.wave * PE_WS;
    LAS int* EL = (LAS int*)(ws + 3328); LAS float* GL = (LAS float*)(ws + 3840);
    const int lane = F.lane;
    const unsigned char* UTl = F.UT() + (size_t)layer * NEXP * UROW;
    const unsigned char* VTl = F.VT() + (size_t)layer * NEXP * VROW;
    const float* USl = F.US() + (size_t)layer * NEXP; const float* VSl = F.VS() + (size_t)layer * NEXP;
    unsigned* ticket = ctl + CW_TICKET + 64 * layer;
    unsigned tk = 0u;
    if (lane == 0) tk = __hip_atomic_fetch_add(ticket, 1u, __ATOMIC_RELAXED, __HIP_MEMORY_SCOPE_AGENT);
    int t = (int)__builtin_amdgcn_readfirstlane(tk);
    while (t < rows) {
        unsigned tkn = 0u;
        if (lane == 0) tkn = __hip_atomic_fetch_add(ticket, 1u, __ATOMIC_RELAXED, __HIP_MEMORY_SCOPE_AGENT);
        SUB_BEGIN(8); peer_topk(F, ws, t); SUB_END(8);
        SUB_BEGIN(9);
        f32x2 hv[16], acc[16];
#pragma unroll
        for (int q = 0; q < 4; ++q) { const u32x4 w = *(const u32x4*)(F.H() + (size_t)t * D + 32 * lane + 8 * q);
#pragma unroll
            for (int e = 0; e < 4; ++e) { hv[4 * q + e] = (f32x2){bf_lo(w[e]), bf_hi(w[e])}; acc[4 * q + e] = (f32x2){0.f, 0.f}; } }
        {
            GBuf A, B;
            gather_issue(A, EL, GL, 0, UTl, VTl, USl, VSl, lane);
            for (int i0 = 0; i0 < 128; i0 += 2 * EB) {
                gather_issue(B, EL, GL, i0 + EB, UTl, VTl, USl, VSl, lane);
                gather_compute(A, hv, acc);
                if (i0 + 2 * EB < 128) gather_issue(A, EL, GL, i0 + 2 * EB, UTl, VTl, USl, VSl, lane);
                gather_compute(B, hv, acc);
            }
        }
        SUB_END(9); SUB_BEGIN(10);
        const int mr = modrow(t);
        const float* mp = F.MODS() + ((size_t)layer * 3 + mr) * 12288;
        float* xr = F.X() + (size_t)t * D;
        float rr[32]; float s = 0.f;
#pragma unroll
        for (int q = 0; q < 8; ++q) { const int c = 32 * lane + 4 * q; const f32x4 xv = *(const f32x4*)(xr + c), gv = *(const f32x4*)(mp + 5 * D + c);
            const f32x4 av = {acc[2 * q].x, acc[2 * q].y, acc[2 * q + 1].x, acc[2 * q + 1].y};
#pragma unroll
            for (int e = 0; e < 4; ++e) { const float v = DN_ALPHA * xv[e] + gv[e] * av[e]; rr[4 * q + e] = v; s += v; } }
        const float mean = wave_sum_u(s) * (1.f / D);
        float s2 = 0.f;
#pragma unroll
        for (int i = 0; i < 32; ++i) { rr[i] -= mean; s2 += rr[i] * rr[i]; }
        const float rstd = 1.f / sqrtf(wave_sum_u(s2) * (1.f / D) + LN_EPS);
        const float* g2 = F.ln2_g() + layer * D; const float* b2 = F.ln2_b() + layer * D;
        float s3 = 0.f;
#pragma unroll
        for (int q = 0; q < 8; ++q) { const int c = 32 * lane + 4 * q; const f32x4 gg = *(const f32x4*)(g2 + c), bb = *(const f32x4*)(b2 + c);
            f32x4 xo;
#pragma unroll
            for (int e = 0; e < 4; ++e) { xo[e] = rr[4 * q + e] * rstd * gg[e] + bb[e]; rr[4 * q + e] = xo[e]; s3 += xo[e]; }
            if (layer < NLAYER - 1) *(f32x4*)(xr + c) = xo; else if (t < TL) *(f32x4*)(F.out() + (size_t)t * D + c) = xo; }
        if (layer < NLAYER - 1) {
            const float mean2 = wave_sum_u(s3) * (1.f / D);
            float s4 = 0.f;
#pragma unroll
            for (int i = 0; i < 32; ++i) { rr[i] -= mean2; s4 += rr[i] * rr[i]; }
            const float rstd2 = 1.f / sqrtf(wave_sum_u(s4) * (1.f / D) + LN_EPS);
            const float* np = F.MODS() + ((size_t)(layer + 1) * 3 + mr) * 12288;
#pragma unroll
            for (int q2 = 0; q2 < 4; ++q2) { const int c = 32 * lane + 8 * q2; u32x4 w;
#pragma unroll
                for (int q = 0; q < 2; ++q) { const f32x4 sh = *(const f32x4*)(np + c + 4 * q), sc = *(const f32x4*)(np + D + c + 4 * q); const int ri = 8 * q2 + 4 * q;
                    const float y0 = rr[ri] * rstd2 * (1.f + sc[0]) + sh[0], y1 = rr[ri + 1] * rstd2 * (1.f + sc[1]) + sh[1];
                    const float y2 = rr[ri + 2] * rstd2 * (1.f + sc[2]) + sh[2], y3 = rr[ri + 3] * rstd2 * (1.f + sc[3]) + sh[3];
                    w[2 * q] = pk2(y0, y1); w[2 * q + 1] = pk2(y2, y3); }
                *(u32x4*)(F.H() + (size_t)t * D + c) = w; }
        }
        SUB_END(10);
        t = (int)__builtin_amdgcn_readfirstlane(tkn);
    }
#undef SUB_BEGIN
#undef SUB_END
}

__global__ void __launch_bounds__(NWAVES * 64, 2) skel_fwd(Args args) {
    extern __shared__ __attribute__((aligned(16))) unsigned char lds[];
    Frame F;
    F.lds = (LAS unsigned char*)lds;
    F.tid = threadIdx.x; F.lane = F.tid & 63; F.wave = __builtin_amdgcn_readfirstlane(F.tid >> 6);
    F.G = gridDim.x; F.gw = blockIdx.x * NWAVES + F.wave; F.NGW = F.G * NWAVES;
    unsigned char* ws = args.ws;
    F.ka = (const CAS unsigned char*)__builtin_amdgcn_kernarg_segment_ptr();
    for (int u = F.tid; u < (LDS_BYTES - LDSCTL_OFF) / 4; u += NWAVES * 64) ((LAS unsigned*)(F.lds + LDSCTL_OFF))[u] = 0u;
    __syncthreads();
    unsigned* ctl = (unsigned*)(ws + WS_CTL);
    const int lo = args.ph_lo, hi = args.ph_hi;
    XcdBarrier bar; bar.bar = ctl + CW_BAR + args.li * XCD_BAR_WORDS; bar.x = 0; bar.st = nullptr;
    if (hi - lo > 1) bar = xcd_barrier_post(ctl + CW_BAR + args.li * XCD_BAR_WORDS, (volatile LAS unsigned*)(F.lds + MISC_OFF) + 8);
#define IN(k) (lo <= (k) && (k) < hi)
    unsigned long long pr_acc = 0ull, pr_t0 = 0ull;
#define PR_BEGIN(ty) do { if (PROBE_PHASE == (ty)) pr_t0 = __builtin_amdgcn_s_memrealtime(); } while (0)
#define PR_END(ty) do { if (PROBE_PHASE == (ty)) pr_acc += __builtin_amdgcn_s_memrealtime() - pr_t0; } while (0)
#define BOTH(k) (IN(k) && IN((k) + 1))
#define SEAM(k) do { if (BOTH(k)) xcd_barrier(bar); } while (0)

    if (IN(0)) { PR_BEGIN(0); frame_ids(F); p0a_prologue(F); SEAM(0); PR_END(0); }
    if (IN(1)) {
        PR_BEGIN(1); frame_ids(F);
        { pg8::Gemm g{F.KBD(), F.WQR(), 32 * 256, 2048, 256}; pg8::BatchOrder S{F.G, (int)blockIdx.x}; pg8::EpiBf16 E{F.WEFFT(), D};
          pg8::gemm_phase<pg8::EpiBf16, pg8::BatchOrder, false, true>(F.lds, g, S, E); }
        p0b_mod0(F);
        SEAM(1); PR_END(1);
    }
    for (int layer = 0; layer < NLAYER; ++layer) {
        const int pb = 2 + 6 * layer;
        const bool lastl = layer == NLAYER - 1;
        const int rows = lastl ? TL : TT;
        if (IN(pb + 0)) {
            PR_BEGIN(2); frame_ids(F);
            pg8::Gemm g{F.H(), F.WINT() + (size_t)layer * INC * D, TT, INC, D}; pg8::StaticOrder S; S.init(TT, INC, F.G, (int)blockIdx.x);
            pg8::EpiBf16 E{F.PROJ(), INC};
            pg8::gemm_phase<pg8::EpiBf16, pg8::StaticOrder, true, true>(F.lds, g, S, E);
            SEAM(pb + 0); PR_END(2);
        }
        if (IN(pb + 1)) {
            PR_BEGIN(3); frame_ids(F);
            const int nunits = lastl ? 512 : 528;
            for (int u = blockIdx.x; u < nunits; u += F.G) attn_unit(F, layer, u);
            for (int t = F.gw; t < rows; t += F.NGW) conv_row(F, layer, t);
            SEAM(pb + 1); PR_END(3);
        }
        if (IN(pb + 2)) {
            PR_BEGIN(4); frame_ids(F);
            pg8::Gemm g{F.MIX(), F.WOUTT() + (size_t)layer * D * D, rows, D, D}; pg8::StaticOrder S; S.init(rows, D, F.G, (int)blockIdx.x);
            pg8::EpiResid E{layer == 0 ? F.x() : F.X(), layer == 0 ? F.ctx() : F.X() + (size_t)TL * D, F.X(), F.MODS() + (size_t)layer * 3 * 12288 + 2 * D};
            pg8::gemm_phase<pg8::EpiResid, pg8::StaticOrder, true, true>(F.lds, g, S, E);
            SEAM(pb + 2); PR_END(4);
        }
        if (IN(pb + 3)) { PR_BEGIN(5); frame_ids(F); ln_phase(F, layer, rows); SEAM(pb + 3); PR_END(5); }
        if (IN(pb + 4)) {
            PR_BEGIN(6); frame_ids(F);
            pg8::Gemm g{F.H(), F.WEFFT() + (size_t)layer * D * D, rows, D, D}; pg8::StaticOrder S; S.init(rows, D, F.G, (int)blockIdx.x);
            pg8::EpiF32 E{F.SC(), D};
            pg8::gemm_phase<pg8::EpiF32, pg8::StaticOrder, true, true>(F.lds, g, S, E);
            SEAM(pb + 4); PR_END(6);
        }
        if (IN(pb + 5)) { PR_BEGIN(7); frame_ids(F); peer_phase(F, layer, rows, ctl, pr_acc); SEAM(pb + 5); PR_END(7); }
    }
    if (PROBE_PHASE >= 0 && hi - lo > 1) xcd_barrier(bar);
    if (PROBE_PHASE >= 0 && blockIdx.x == 0 && threadIdx.x == 0) { const unsigned long long t1 = __builtin_amdgcn_s_memrealtime() + (unsigned long long)PROBE_MULT * pr_acc; while (__builtin_amdgcn_s_memrealtime() < t1) __builtin_amdgcn_s_sleep(8); }
#undef IN
#undef BOTH
#undef SEAM
}

extern "C" void kernel_launch(void* const* d_in, const int* in_sizes, int n_in, void* d_out, int out_size, void* d_ws, size_t ws_size, hipStream_t stream) {
    static int grid = 0;
    if (grid == 0) {
        if (n_in != 20 || in_sizes[0] != TL * D || out_size != TL * D || ws_size < WS_END) {
            fprintf(stderr, "kernel_launch: unexpected problem shape (n_in %d, in0 %d, out %d, ws %zu, need %zu)\n", n_in, n_in > 0 ? in_sizes[0] : -1, out_size, ws_size, (size_t)WS_END); grid = -1; return; }
        int dev = 0, cus = 0, per_cu = 0;
        if (hipGetDevice(&dev) != hipSuccess || hipDeviceGetAttribute(&cus, hipDeviceAttributeMultiprocessorCount, dev) != hipSuccess) { grid = -1; return; }
        if (hipFuncSetAttribute((const void*)skel_fwd, hipFuncAttributeMaxDynamicSharedMemorySize, LDS_BYTES) != hipSuccess) { fprintf(stderr, "kernel_launch: hipFuncSetAttribute failed\n"); grid = -1; return; }
        if (hipOccupancyMaxActiveBlocksPerMultiprocessor(&per_cu, (const void*)skel_fwd, NWAVES * 64, LDS_BYTES) != hipSuccess || per_cu < 1)
            fprintf(stderr, "kernel_launch: occupancy query reports %d workgroups per CU\n", per_cu);
        (void)hipGetLastError();
        grid = cus;
    }
    if (grid < 0) return;
    if (hipMemsetAsync((char*)d_ws + WS_CTL, 0, CTL_ZERO_BYTES, stream) != hipSuccess) return;
    Args a{};
    for (int i = 0; i < 20; ++i) a.in[i] = (const float*)d_in[i];
    a.out = (float*)d_out; a.ws = (unsigned char*)d_ws; a.pad = 0;
#if MK_N_LAUNCHES == 1
    a.ph_lo = 0; a.ph_hi = NPHASE; a.li = 0;
    hipLaunchKernelGGL(skel_fwd, dim3(grid), dim3(NWAVES * 64), LDS_BYTES, stream, a);
#else
    for (int ph = 0; ph < NPHASE; ++ph) { a.ph_lo = ph; a.ph_hi = ph + 1; a.li = 0;
        hipLaunchKernelGGL(skel_fwd, dim3(grid), dim3(NWAVES * 64), LDS_BYTES, stream, a); }
#endif
}
```

```cpp
#include <hip/hip_runtime.h>
#include <cstdio>
#include <cstdint>

#ifndef MK_N_LAUNCHES
#define MK_N_LAUNCHES 1
#endif

#define LAS __attribute__((address_space(3)))
typedef unsigned short bf16_t;
typedef short bf16x8 __attribute__((ext_vector_type(8)));
typedef short s16x4 __attribute__((ext_vector_type(4)));
typedef float f32x2 __attribute__((ext_vector_type(2)));
typedef float f32x4 __attribute__((ext_vector_type(4)));
typedef float f32x16 __attribute__((ext_vector_type(16)));
typedef unsigned u32x2 __attribute__((ext_vector_type(2)));
typedef unsigned u32x4 __attribute__((ext_vector_type(4)));
typedef __bf16 bf16x2_t __attribute__((ext_vector_type(2)));

constexpr int D = 2048, NB = 2, SEQ = 8192, CTXL = 256, NLAYER = 4;
constexpr int TL = NB * SEQ, TC = NB * CTXL, TT = TL + TC;
constexpr int INC = 4608, OFF_C = 1024, OFF_X = 2048, OFF_Q = 3072, OFF_K = 4096, OFF_V = 4352;
constexpr int NEXP = 16384;
#ifndef U_FMT
#define U_FMT 4
#endif
#ifndef V_FMT
#define V_FMT 4
#endif
constexpr int UROW = D * U_FMT / 8, VROW = D * V_FMT / 8;
constexpr float LN_EPS = 1e-6f;
constexpr float DN_ALPHA = 1.681792830507429f;
constexpr float QSCALE = 0.08838834764831845f * 1.4426950408889634f;
constexpr float LOG2E = 1.4426950408889634f;

constexpr size_t MiB = 1u << 20;
constexpr size_t WS_CTL = 0, CTL_ZERO_BYTES = 1 * MiB;
constexpr size_t WS_MODS = 1 * MiB;
constexpr size_t WS_ROPE = 2 * MiB;
constexpr size_t WS_KBD = 3 * MiB;
constexpr size_t WS_WQR = 8 * MiB;
constexpr size_t WS_WINT = 40 * MiB;
constexpr size_t WS_WOUTT = 112 * MiB;
constexpr size_t WS_WEFFT = 144 * MiB;
constexpr size_t WS_X = 176 * MiB;
constexpr size_t WS_H = 308 * MiB;
constexpr size_t WS_PROJ = 374 * MiB;
constexpr size_t WS_MIX = 523 * MiB;
constexpr size_t WS_SC = 589 * MiB;
constexpr size_t WS_UT = 721 * MiB;
constexpr size_t WS_VT = 849 * MiB;
constexpr size_t WS_US = 977 * MiB;
constexpr size_t WS_VS = 978 * MiB;
constexpr size_t WS_END = 979 * MiB;

constexpr int CW_BAR = 4096;

namespace pg8 {
constexpr int BM = 256, BK = 64, HALF = 128, HTB = HALF * BK * 2, STAGE_BYTES = 8 * HTB, NXCD = 8, WGM = 8;
__host__ __device__ __forceinline__ int lds_byte(int r, int c) { const int st = (r >> 4) * 2 + (c >> 5), rr = r & 15, cc = c & 31, ob = rr * 64 + cc * 2; return st * 1024 + (ob ^ (((ob >> 9) & 1) << 5)); }
__host__ __device__ __forceinline__ void stage_rc(int b, int& R, int& C) { const int st = b / 1024, sb = b % 1024, swz = sb ^ (((sb >> 9) & 1) << 5); R = (st >> 1) * 16 + swz / 64; C = (st & 1) * 32 + (swz % 64) / 2; }
__host__ __device__ __forceinline__ int perm32(int rho) { const int n = rho >> 4, i = rho & 15; return 8 * (i >> 2) + 4 * n + (i & 3); }

struct Unit { int pm, pn; };
struct Gemm { const bf16_t* A; const bf16_t* Bt; int M, N, K; };

struct StaticOrder {
    int nM, nN, nwg, G, c;
    __host__ __device__ void init(int M, int N, int G_, int c_) { nM = M / BM; nN = N / BM; nwg = nM * nN; G = G_; c = c_; }
    __host__ __device__ bool next(int i, Unit& u) const {
        const long L = (long)i * G + c; if (L >= nwg) return false;
        int wgid = (int)L; { const int q = nwg / NXCD, r = nwg % NXCD, xcd = wgid % NXCD, off = wgid / NXCD; wgid = (xcd < r ? xcd * (q + 1) : r * (q + 1) + (xcd - r) * q) + off; }
        const int nig = WGM * nN, gid = wgid / nig, fm = gid * WGM, gsz = (nM - fm) < WGM ? (nM - fm) : WGM;
        u.pm = fm + ((wgid % nig) % gsz); u.pn = (wgid % nig) / gsz; return true;
    }
    __device__ __forceinline__ int btile(const Unit& u) const { return u.pn; }
    __device__ __forceinline__ void a_ready(const Unit&) const {}
    __device__ __forceinline__ void done(const Unit&) const {}
};
struct BatchOrder {
    int G, c;
    __device__ bool next(int i, Unit& u) const { const int L = i * G + c; if (L >= 256) return false; u.pm = L >> 3; u.pn = L & 7; return true; }
    __device__ __forceinline__ int btile(const Unit& u) const { return u.pm * 8 + u.pn; }
    __device__ __forceinline__ void a_ready(const Unit&) const {}
    __device__ __forceinline__ void done(const Unit&) const {}
};

__device__ __forceinline__ unsigned cvt_pk_bf16(float lo, float hi) { f32x2 x = {lo, hi}; bf16x2_t y = __builtin_convertvector(x, bf16x2_t); return __builtin_bit_cast(unsigned, y); }

struct EpiBf16 {
    static constexpr bool PERM = true;
    bf16_t* O; int ldc;
    __device__ __forceinline__ void operator()(const f32x4 (&acc)[2][2][4][2], const Unit& u, int wr, int wc, int fr, int fq) const {
        const int row0 = u.pm * BM + wr * 64 + fr, col0 = u.pn * BM + wc * 32 + 8 * fq;
#pragma unroll
        for (int ai = 0; ai < 2; ++ai)
#pragma unroll
            for (int m = 0; m < 4; ++m) { bf16_t* rowp = O + (size_t)(row0 + ai * HALF + m * 16) * ldc + col0;
#pragma unroll
                for (int bj = 0; bj < 2; ++bj) { const f32x4 v0 = acc[ai][bj][m][0], v1 = acc[ai][bj][m][1];
                    u32x4 w; w.x = cvt_pk_bf16(v0[0], v0[1]); w.y = cvt_pk_bf16(v0[2], v0[3]); w.z = cvt_pk_bf16(v1[0], v1[1]); w.w = cvt_pk_bf16(v1[2], v1[3]);
                    *(u32x4*)(rowp + bj * HALF) = w; } }
    }
};
struct EpiF32 {
    static constexpr bool PERM = false;
    float* C; int ldc;
    __device__ __forceinline__ void operator()(const f32x4 (&acc)[2][2][4][2], const Unit& u, int wr, int wc, int fr, int fq) const {
        const int row0 = u.pm * BM + wr * 64 + fr, col0 = u.pn * BM + wc * 32 + 4 * fq;
#pragma unroll
        for (int ai = 0; ai < 2; ++ai)
#pragma unroll
            for (int m = 0; m < 4; ++m) { float* rowp = C + (size_t)(row0 + ai * HALF + m * 16) * ldc + col0;
#pragma unroll
                for (int bj = 0; bj < 2; ++bj)
#pragma unroll
                    for (int n = 0; n < 2; ++n) *(f32x4*)(rowp + bj * HALF + n * 16) = acc[ai][bj][m][n]; }
    }
};
struct EpiResid {
    static constexpr bool PERM = false;
    const float* xin_lat; const float* xin_ctx;
    float* xout; const float* gate;
    __device__ __forceinline__ void operator()(const f32x4 (&acc)[2][2][4][2], const Unit& u, int wr, int wc, int fr, int fq) const {
        const int rt = u.pm * BM;
        const int mr = rt < TL ? rt / SEQ : 2;
        const float* xin = rt < TL ? xin_lat + (size_t)rt * D : xin_ctx + (size_t)(rt - TL) * D;
        float* xo = xout + (size_t)rt * D;
        const int row0 = wr * 64 + fr, col0 = u.pn * BM + wc * 32 + 4 * fq;
        f32x4 gv[2][2];
#pragma unroll
        for (int bj = 0; bj < 2; ++bj)
#pragma unroll
            for (int n = 0; n < 2; ++n) gv[bj][n] = *(const f32x4*)(gate + (size_t)mr * 12288 + col0 + bj * HALF + n * 16);
#pragma unroll
        for (int ai = 0; ai < 2; ++ai)
#pragma unroll
            for (int m = 0; m < 4; ++m) { const size_t ro = (size_t)(row0 + ai * HALF + m * 16) * D + col0;
#pragma unroll
                for (int bj = 0; bj < 2; ++bj)
#pragma unroll
                    for (int n = 0; n < 2; ++n) { const f32x4 xv = *(const f32x4*)(xin + ro + bj * HALF + n * 16);
                        *(f32x4*)(xo + ro + bj * HALF + n * 16) = xv * DN_ALPHA + gv[bj][n] * acc[ai][bj][m][n]; } }
    }
};

template <class Epi, class Sched, bool ALIGN_EPI = false, bool SP2 = false>
__device__ __forceinline__ void gemm_phase(LAS unsigned char* lds, const Gemm g, const Sched& S, const Epi& E) {
    int tid = threadIdx.x; asm volatile("" : "+v"(tid));
    const int wid = __builtin_amdgcn_readfirstlane(tid >> 6), lane = tid & 63, wr = wid >> 2, wc = wid & 3, fr = lane & 15, fq = lane >> 4;
    const int K = g.K, nt = K / BK;
    unsigned voffA[2], voffB[2];
#pragma unroll
    for (int i = 0; i < 2; ++i) { int R, C; stage_rc(tid * 16 + i * 8192, R, C); const int Rb = Epi::PERM ? ((R & ~31) + perm32(R & 31)) : R;
        voffA[i] = (unsigned)(R * K + C) * 2u; voffB[i] = (unsigned)(Rb * K + C) * 2u; }
    const size_t kstep = (size_t)(BK * 2);
    const size_t hstep = (size_t)HALF * K * 2;
    const size_t tstep = 2 * hstep;
    const unsigned ldsw = (unsigned)wid * 1024u;
    const int aoff = lds_byte(wr * 64 + fr, fq * 8), boff = lds_byte(wc * 32 + fr, fq * 8);
#define PG8_SA(b, h) (((b) * 2 + (h)) * HTB)
#define PG8_SB(b, h) ((4 + (b) * 2 + (h)) * HTB)
#define PG8_STAGE(bufoff, gbase, voff) do { _Pragma("unroll") for (int _i = 0; _i < 2; ++_i) \
        __builtin_amdgcn_global_load_lds((const unsigned*)((const char*)(gbase) + (voff)[_i]), (LAS unsigned*)(lds + (bufoff) + ldsw + _i * 8192), 16, 0, 0); } while (0)
#define PG8_LDA(dst, b, h) do { _Pragma("unroll") for (int m = 0; m < 4; ++m) _Pragma("unroll") for (int k = 0; k < 2; ++k) dst[m][k] = *(const LAS bf16x8*)(lds + PG8_SA(b, h) + aoff + m * 2048 + k * 1024); } while (0)
#define PG8_LDB(dst, b, h) do { _Pragma("unroll") for (int n = 0; n < 2; ++n) _Pragma("unroll") for (int k = 0; k < 2; ++k) dst[n][k] = *(const LAS bf16x8*)(lds + PG8_SB(b, h) + boff + n * 2048 + k * 1024); } while (0)
#define PG8_MMA(ai, bj, At, Bt) do { __builtin_amdgcn_s_setprio(1); _Pragma("unroll") for (int m = 0; m < 4; ++m) _Pragma("unroll") for (int n = 0; n < 2; ++n) _Pragma("unroll") for (int k = 0; k < 2; ++k) \
        acc[ai][bj][m][n] = __builtin_amdgcn_mfma_f32_16x16x32_bf16(Bt[n][k], At[m][k], acc[ai][bj][m][n], 0, 0, 0); __builtin_amdgcn_s_setprio(0); } while (0)
#define PG8_WAIT_V(n) asm volatile("s_waitcnt vmcnt(" #n ")" ::: "memory")
#define PG8_WAIT_L(n) asm volatile("s_waitcnt lgkmcnt(" #n ")" ::: "memory")
#define PG8_BAR __builtin_amdgcn_s_barrier()
#define PG8_SCHED __builtin_amdgcn_sched_barrier(0)
    Unit cur, nxt; int ui = 0;
    if (!S.next(0, cur)) return;
    f32x4 acc[2][2][4][2];
#pragma unroll
    for (int a = 0; a < 2; ++a)
#pragma unroll
        for (int b = 0; b < 2; ++b)
#pragma unroll
            for (int m = 0; m < 4; ++m)
#pragma unroll
                for (int n = 0; n < 2; ++n) acc[a][b][m][n] = (f32x4){0.f, 0.f, 0.f, 0.f};
    bf16x8 At[4][2], B0[2][2], B1[2][2];
    const char* cA = (const char*)g.A + (size_t)cur.pm * tstep; const char* cB = (const char*)g.Bt + (size_t)S.btile(cur) * tstep;
    S.a_ready(cur);
    if constexpr (SP2) {
        PG8_STAGE(PG8_SB(0, 0), cB, voffB); PG8_STAGE(PG8_SB(0, 1), cB + hstep, voffB); PG8_STAGE(PG8_SA(0, 0), cA, voffA); PG8_STAGE(PG8_SA(0, 1), cA + hstep, voffA);
        if (wr == 1) PG8_BAR;
        PG8_WAIT_V(2); PG8_BAR;
        PG8_STAGE(PG8_SB(1, 0), cB + kstep, voffB); PG8_STAGE(PG8_SA(1, 0), cA + kstep, voffA); PG8_STAGE(PG8_SB(1, 1), cB + hstep + kstep, voffB);
        PG8_WAIT_V(6); PG8_BAR;
    } else {
        PG8_STAGE(PG8_SB(0, 0), cB, voffB); PG8_STAGE(PG8_SA(0, 0), cA, voffA); PG8_STAGE(PG8_SB(0, 1), cB + hstep, voffB); PG8_STAGE(PG8_SA(0, 1), cA + hstep, voffA);
        if (wr == 1) PG8_BAR;
        PG8_WAIT_V(4); PG8_BAR;
        PG8_STAGE(PG8_SB(1, 0), cB + kstep, voffB); PG8_STAGE(PG8_SA(1, 0), cA + kstep, voffA); PG8_STAGE(PG8_SB(1, 1), cB + hstep + kstep, voffB);
        PG8_WAIT_V(6); PG8_BAR;
    }
    for (;;) {
        const bool has_next = S.next(ui + 1, nxt);
        const char* nA = has_next ? (const char*)g.A + (size_t)nxt.pm * tstep : cA; const char* nB = has_next ? (const char*)g.Bt + (size_t)S.btile(nxt) * tstep : cB;
        for (int t = 0; t < nt; t += 2) {
            const bool last = (t == nt - 2);
            const char* a1 = cA + (size_t)(t + 1) * kstep;
            const char* a2 = last ? nA : cA + (size_t)(t + 2) * kstep; const char* b2 = last ? nB : cB + (size_t)(t + 2) * kstep;
            const char* a3 = a2 + kstep; const char* b3 = b2 + kstep;
            if (last && has_next) S.a_ready(nxt);
            if constexpr (SP2) {
            PG8_LDB(B0, 0, 0); PG8_LDB(B1, 0, 1); PG8_SCHED; PG8_LDA(At, 0, 0); PG8_STAGE(PG8_SA(1, 1), a1 + hstep, voffA);
            PG8_WAIT_V(8); PG8_WAIT_L(0); PG8_BAR; PG8_MMA(0, 0, At, B0); PG8_MMA(0, 1, At, B1); PG8_BAR; PG8_SCHED;
            PG8_LDA(At, 0, 1); PG8_STAGE(PG8_SB(0, 0), b2, voffB); PG8_STAGE(PG8_SB(0, 1), b2 + hstep, voffB); PG8_STAGE(PG8_SA(0, 0), a2, voffA);
            PG8_WAIT_V(8); PG8_WAIT_L(0); PG8_BAR; PG8_MMA(1, 0, At, B0); PG8_MMA(1, 1, At, B1); PG8_BAR; PG8_SCHED;
            PG8_LDB(B0, 1, 0); PG8_LDB(B1, 1, 1); PG8_SCHED; PG8_LDA(At, 1, 0); PG8_STAGE(PG8_SA(0, 1), a2 + hstep, voffA);
            PG8_WAIT_V(8); PG8_WAIT_L(0); PG8_BAR; PG8_MMA(0, 0, At, B0); PG8_MMA(0, 1, At, B1); PG8_BAR; PG8_SCHED;
            PG8_LDA(At, 1, 1); PG8_STAGE(PG8_SB(1, 0), b3, voffB); PG8_STAGE(PG8_SB(1, 1), b3 + hstep, voffB); PG8_STAGE(PG8_SA(1, 0), a3, voffA);
            PG8_WAIT_V(8); PG8_WAIT_L(0); PG8_BAR; PG8_MMA(1, 0, At, B0); PG8_MMA(1, 1, At, B1); PG8_BAR; PG8_SCHED;
            } else {
            PG8_LDB(B0, 0, 0); PG8_SCHED; PG8_LDA(At, 0, 0); PG8_STAGE(PG8_SA(1, 1), a1 + hstep, voffA);
            PG8_WAIT_L(8); PG8_BAR; PG8_WAIT_L(0); PG8_MMA(0, 0, At, B0); PG8_BAR; PG8_SCHED;
            PG8_LDB(B1, 0, 1); PG8_STAGE(PG8_SB(0, 0), b2, voffB);
            PG8_BAR; PG8_WAIT_L(0); PG8_MMA(0, 1, At, B1); PG8_BAR;
            PG8_LDA(At, 0, 1); PG8_STAGE(PG8_SA(0, 0), a2, voffA);
            PG8_BAR; PG8_WAIT_L(0); PG8_MMA(1, 0, At, B0); PG8_BAR; PG8_SCHED;
            PG8_STAGE(PG8_SB(0, 1), b2 + hstep, voffB);
            PG8_WAIT_V(6); PG8_BAR; PG8_MMA(1, 1, At, B1); PG8_BAR;
            PG8_LDB(B0, 1, 0); PG8_SCHED; PG8_LDA(At, 1, 0); PG8_STAGE(PG8_SA(0, 1), a2 + hstep, voffA);
            PG8_WAIT_L(8); PG8_BAR; PG8_WAIT_L(0); PG8_MMA(0, 0, At, B0); PG8_BAR; PG8_SCHED;
            PG8_LDB(B1, 1, 1); PG8_STAGE(PG8_SB(1, 0), b3, voffB);
            PG8_BAR; PG8_WAIT_L(0); PG8_MMA(0, 1, At, B1); PG8_BAR;
            PG8_LDA(At, 1, 1); PG8_STAGE(PG8_SA(1, 0), a3, voffA);
            PG8_BAR; PG8_WAIT_L(0); PG8_MMA(1, 0, At, B0); PG8_BAR; PG8_SCHED;
            PG8_STAGE(PG8_SB(1, 1), b3 + hstep, voffB);
            PG8_WAIT_V(6); PG8_BAR; PG8_MMA(1, 1, At, B1); PG8_BAR;
            }
        }
        if constexpr (ALIGN_EPI) { if (wr == 0) PG8_BAR; }
        E(acc, cur, wr, wc, fr, fq); S.done(cur);
        if (!has_next) break;
#pragma unroll
        for (int a = 0; a < 2; ++a)
#pragma unroll
            for (int b = 0; b < 2; ++b)
#pragma unroll
                for (int m = 0; m < 4; ++m)
#pragma unroll
                    for (int n = 0; n < 2; ++n) acc[a][b][m][n] = (f32x4){0.f, 0.f, 0.f, 0.f};
        cur = nxt; cA = nA; cB = nB; ++ui;
        if constexpr (ALIGN_EPI) { if (wr == 1) PG8_BAR; }
    }
    PG8_WAIT_V(0);
    if constexpr (!ALIGN_EPI) { if (wr == 0) PG8_BAR; }
    PG8_BAR;
#undef PG8_SA
#undef PG8_SB
#undef PG8_STAGE
#undef PG8_LDA
#undef PG8_LDB
#undef PG8_MMA
#undef PG8_WAIT_V
#undef PG8_WAIT_L
#undef PG8_BAR
#undef PG8_SCHED
}
}

#define XB_TMO      128
#define XB_XCNT(j)  (256  + 64 * (j))
#define XB_XSUB(j)  (1280 + 64 * (j))
#define XB_XGEN(j)  (2304 + 64 * (j))
#define XB_TOP      3328
#define XB_TOPGEN   3392
#define XCD_BAR_WORDS 3456
#define XB_SPIN_CAP (1u << 18)

__device__ __forceinline__ unsigned xb_ld(unsigned* p)              { return __hip_atomic_load(p, __ATOMIC_RELAXED, __HIP_MEMORY_SCOPE_AGENT); }
__device__ __forceinline__ unsigned xb_add(unsigned* p, unsigned v) { return __hip_atomic_fetch_add(p, v, __ATOMIC_RELAXED, __HIP_MEMORY_SCOPE_AGENT); }
__device__ __forceinline__ unsigned xb_xcc_id() { return (unsigned)__builtin_amdgcn_s_getreg((3 << 11) | 20) & 0xFu; }
#define XB_SPIN(cond, bar) do { unsigned _sp = 0; while (cond) { __builtin_amdgcn_s_sleep(1); \
    if ((++_sp & 255u) == 0u) { if (xb_ld(&(bar)[XB_TMO])) break; if (_sp > XB_SPIN_CAP) { atomicAdd(&(bar)[XB_TMO], 1u); break; } } } } while (0)

struct XcdBarrier { unsigned* bar; unsigned x; volatile LAS unsigned* st; };

__device__ __forceinline__ XcdBarrier xcd_barrier_post(unsigned* bar, volatile LAS unsigned* st) {
    XcdBarrier b; b.bar = bar; b.x = xb_xcc_id(); b.st = st;
    if (threadIdx.x == 0) (void)xb_add(&bar[XB_XCNT(b.x)], 1u);
    return b;
}
__device__ __forceinline__ void xcd_barrier_complete(unsigned* bar, unsigned x, unsigned& nloc, unsigned& nx) {
    const unsigned G = gridDim.x * gridDim.y * gridDim.z;
    unsigned sum, cnt, mine, sp = 0u;
    for (;;) {
        sum = 0u; cnt = 0u; mine = 0u;
#pragma unroll
        for (unsigned j = 0; j < 16; ++j) { const unsigned c = xb_ld(&bar[XB_XCNT(j)]); sum += c; cnt += (c > 0u) ? 1u : 0u; mine = (j == x) ? c : mine; }
        if (sum == G) break;
        __builtin_amdgcn_s_sleep(1);
        if ((++sp & 255u) == 0u) { if (xb_ld(&bar[XB_TMO])) break; if (sp > XB_SPIN_CAP) { atomicAdd(&bar[XB_TMO], 1u); break; } }
    }
    nloc = mine > 0u ? mine : 1u; nx = cnt > 0u ? cnt : 1u;
}
__device__ __forceinline__ void xcd_barrier(const XcdBarrier& b) {
    asm volatile("s_waitcnt vmcnt(0)" ::: "memory");
    __syncthreads();
    if (threadIdx.x == 0) {
        unsigned* bar = b.bar;
        __builtin_amdgcn_s_waitcnt(0);
        unsigned nloc = b.st[0], nx = b.st[1];
        if (nloc == 0u) { xcd_barrier_complete(bar, b.x, nloc, nx); b.st[0] = nloc; b.st[1] = nx; }
        const unsigned old = xb_add(&bar[XB_XSUB(b.x)], 1u);
        const unsigned gen = old / nloc;
        if (old + 1u == (gen + 1u) * nloc) {
            __builtin_amdgcn_fence(__ATOMIC_RELEASE, "agent");
            asm volatile("s_waitcnt vmcnt(0)" ::: "memory");
            const unsigned og = xb_add(&bar[XB_TOP], 1u);
            const unsigned tg = og / nx;
            if (og + 1u == (tg + 1u) * nx) xb_add(&bar[XB_TOPGEN], 1u);
            else XB_SPIN(xb_ld(&bar[XB_TOPGEN]) == tg, bar);
            __builtin_amdgcn_fence(__ATOMIC_ACQUIRE, "agent");
            xb_add(&bar[XB_XGEN(b.x)], 1u);
            asm volatile("s_waitcnt vmcnt(0)" ::: "memory");
        } else {
            XB_SPIN(xb_ld(&bar[XB_XGEN(b.x)]) == gen, bar);
            __builtin_amdgcn_fence(__ATOMIC_ACQUIRE, "agent");
            asm volatile("s_waitcnt vmcnt(0)" ::: "memory");
        }
    }
    __syncthreads();
}

constexpr int NWAVES = 8;
constexpr int RING_BYTES = 131072;
constexpr int LDSCTL_OFF = RING_BYTES, MISC_OFF = LDSCTL_OFF + 320;
constexpr int LDS_BYTES = 147456;
constexpr int NPHASE = 2 + 6 * NLAYER;

#define LDS_WAIT() asm volatile("s_waitcnt lgkmcnt(0)" ::: "memory")

struct Args { const float* in[20]; float* out; unsigned char* ws; int ph_lo, ph_hi, li, pad; };

#define CAS __attribute__((address_space(4)))
struct Frame {
    LAS unsigned char* lds;
    int tid, lane, wave, G, gw, NGW;
    const CAS unsigned char* ka;
    __device__ __forceinline__ const float* x() const { return *(const float* const CAS*)(ka + 0); }
    __device__ __forceinline__ const float* c() const { return *(const float* const CAS*)(ka + 8); }
    __device__ __forceinline__ const float* ctx() const { return *(const float* const CAS*)(ka + 16); }
    __device__ __forceinline__ const float* c_ctx() const { return *(const float* const CAS*)(ka + 24); }
    __device__ __forceinline__ const float* w_ada() const { return *(const float* const CAS*)(ka + 32); }
    __device__ __forceinline__ const float* b_ada() const { return *(const float* const CAS*)(ka + 40); }
    __device__ __forceinline__ const float* w_in() const { return *(const float* const CAS*)(ka + 48); }
    __device__ __forceinline__ const float* conv_w() const { return *(const float* const CAS*)(ka + 56); }
    __device__ __forceinline__ const float* sink() const { return *(const float* const CAS*)(ka + 64); }
    __device__ __forceinline__ const float* g_attn() const { return *(const float* const CAS*)(ka + 72); }
    __device__ __forceinline__ const float* g_conv() const { return *(const float* const CAS*)(ka + 80); }
    __device__ __forceinline__ const float* w_out() const { return *(const float* const CAS*)(ka + 88); }
    __device__ __forceinline__ const float* ln1_g() const { return *(const float* const CAS*)(ka + 96); }
    __device__ __forceinline__ const float* ln1_b() const { return *(const float* const CAS*)(ka + 104); }
    __device__ __forceinline__ const float* wq() const { return *(const float* const CAS*)(ka + 112); }
    __device__ __forceinline__ const float* keys() const { return *(const float* const CAS*)(ka + 120); }
    __device__ __forceinline__ const float* pu() const { return *(const float* const CAS*)(ka + 128); }
    __device__ __forceinline__ const float* pv() const { return *(const float* const CAS*)(ka + 136); }
    __device__ __forceinline__ const float* ln2_g() const { return *(const float* const CAS*)(ka + 144); }
    __device__ __forceinline__ const float* ln2_b() const { return *(const float* const CAS*)(ka + 152); }
    __device__ __forceinline__ float* out() const { return *(float* const CAS*)(ka + 160); }
    __device__ __forceinline__ unsigned char* ws() const { return *(unsigned char* const CAS*)(ka + 168); }
    __device__ __forceinline__ float* MODS() const { return (float*)(ws() + WS_MODS); }
    __device__ __forceinline__ float* ROPE() const { return (float*)(ws() + WS_ROPE); }
    __device__ __forceinline__ float* X() const { return (float*)(ws() + WS_X); }
    __device__ __forceinline__ float* SC() const { return (float*)(ws() + WS_SC); }
    __device__ __forceinline__ bf16_t* KBD() const { return (bf16_t*)(ws() + WS_KBD); }
    __device__ __forceinline__ bf16_t* WQR() const { return (bf16_t*)(ws() + WS_WQR); }
    __device__ __forceinline__ bf16_t* WINT() const { return (bf16_t*)(ws() + WS_WINT); }
    __device__ __forceinline__ bf16_t* WOUTT() const { return (bf16_t*)(ws() + WS_WOUTT); }
    __device__ __forceinline__ bf16_t* WEFFT() const { return (bf16_t*)(ws() + WS_WEFFT); }
    __device__ __forceinline__ bf16_t* H() const { return (bf16_t*)(ws() + WS_H); }
    __device__ __forceinline__ bf16_t* PROJ() const { return (bf16_t*)(ws() + WS_PROJ); }
    __device__ __forceinline__ bf16_t* MIX() const { return (bf16_t*)(ws() + WS_MIX); }
    __device__ __forceinline__ unsigned char* UT() const { return (unsigned char*)(ws() + WS_UT); }
    __device__ __forceinline__ unsigned char* VT() const { return (unsigned char*)(ws() + WS_VT); }
    __device__ __forceinline__ float* US() const { return (float*)(ws() + WS_US); }
    __device__ __forceinline__ float* VS() const { return (float*)(ws() + WS_VS); }
};

__device__ __forceinline__ void frame_ids(Frame& F) {
    int tz = threadIdx.x; asm volatile("" : "+v"(tz));
    F.tid = tz; F.lane = tz & 63; F.wave = __builtin_amdgcn_readfirstlane(tz >> 6);
    F.gw = blockIdx.x * NWAVES + F.wave;
    const CAS unsigned char* k = (const CAS unsigned char*)__builtin_amdgcn_kernarg_segment_ptr(); asm volatile("" : "+s"(k)); F.ka = k;
}
__device__ __forceinline__ float wave_sum(float v) {
#pragma unroll
    for (int o = 1; o < 64; o <<= 1) v += __shfl_xor(v, o);
    return v;
}
__device__ __forceinline__ unsigned pk2(float lo, float hi) { return pg8::cvt_pk_bf16(lo, hi); }
__device__ __forceinline__ float bf_lo(unsigned u) { return __uint_as_float(u << 16); }
__device__ __forceinline__ float bf_hi(unsigned u) { return __uint_as_float(u & 0xffff0000u); }
__device__ __forceinline__ int modrow(int t) { return t < TL ? t / SEQ : 2; }

__device__ __forceinline__ void transpose_item(const float* W, int K, int N, bf16_t* WT, LAS float* scr, int item, int lane) {
    const int nblk = N / 32, kb = item / nblk, nb = item % nblk, k0 = 64 * kb, n0 = 32 * nb;
#pragma unroll 8
    for (int i = 0; i < 32; ++i) { const int kk = 2 * i + (lane >> 5); scr[kk * 33 + (lane & 31)] = W[(size_t)(k0 + kk) * N + n0 + (lane & 31)]; }
    LDS_WAIT(); asm volatile("" ::: "memory");
    const int c = lane & 7;
#pragma unroll
    for (int j = 0; j < 4; ++j) { const int n = (lane >> 3) + 8 * j; const LAS float* s = scr + (8 * c) * 33 + n;
        u32x4 o; o.x = pk2(s[0 * 33], s[1 * 33]); o.y = pk2(s[2 * 33], s[3 * 33]); o.z = pk2(s[4 * 33], s[5 * 33]); o.w = pk2(s[6 * 33], s[7 * 33]);
        *(u32x4*)(WT + (size_t)(n0 + n) * K + k0 + 8 * c) = o; }
    LDS_WAIT(); asm volatile("" ::: "memory");
}

__device__ __forceinline__ void cvt_row_bf16(const float* src, bf16_t* dst, int lane) {
    const f32x4* s = (const f32x4*)src + lane; u32x2* d = (u32x2*)dst + lane;
    f32x4 v[8];
#pragma unroll
    for (int j = 0; j < 8; ++j) v[j] = __builtin_nontemporal_load(s + 64 * j);
#pragma unroll
    for (int j = 0; j < 8; ++j) { u32x2 o; o.x = pk2(v[j].x, v[j].y); o.y = pk2(v[j].z, v[j].w); d[64 * j] = o; }
}

template <int FMT>
__device__ __forceinline__ void cvt_row_lp(const float* src, unsigned char* dst, float* inv, int lane) {
    constexpr float QMAX = FMT == 8 ? 224.f : 6.f;
    const f32x4* s = (const f32x4*)src + 2 * lane;
    f32x4 v[4][2]; float am = 0.f;
#pragma unroll
    for (int j = 0; j < 4; ++j) { v[j][0] = __builtin_nontemporal_load(s + 128 * j); v[j][1] = __builtin_nontemporal_load(s + 128 * j + 1); }
#pragma unroll
    for (int j = 0; j < 4; ++j)
#pragma unroll
        for (int q = 0; q < 2; ++q) am = fmaxf(fmaxf(am, fmaxf(fabsf(v[j][q].x), fabsf(v[j][q].y))), fmaxf(fabsf(v[j][q].z), fabsf(v[j][q].w)));
#pragma unroll
    for (int o = 1; o < 64; o <<= 1) am = fmaxf(am, __shfl_xor(am, o));
    const float sc = am > 0.f ? QMAX / am : 1.f;
#pragma unroll
    for (int j = 0; j < 4; ++j) {
        if constexpr (FMT == 8) {
            u32x2 w;
#pragma unroll
            for (int q = 0; q < 2; ++q) { int t = __builtin_amdgcn_cvt_pk_fp8_f32(v[j][q].x * sc, v[j][q].y * sc, 0, false); t = __builtin_amdgcn_cvt_pk_fp8_f32(v[j][q].z * sc, v[j][q].w * sc, t, true); w[q] = (unsigned)t; }
            *((u32x2*)dst + lane + 64 * j) = w;
        } else {
            unsigned w = 0u;
            w = __builtin_amdgcn_cvt_scalef32_pk_fp4_f32(w, v[j][0].x * sc, v[j][0].y * sc, 1.0f, 0);
            w = __builtin_amdgcn_cvt_scalef32_pk_fp4_f32(w, v[j][0].z * sc, v[j][0].w * sc, 1.0f, 1);
            w = __builtin_amdgcn_cvt_scalef32_pk_fp4_f32(w, v[j][1].x * sc, v[j][1].y * sc, 1.0f, 2);
            w = __builtin_amdgcn_cvt_scalef32_pk_fp4_f32(w, v[j][1].z * sc, v[j][1].w * sc, 1.0f, 3);
            *((unsigned*)dst + lane + 64 * j) = w;
        }
    }
    if (lane == 0) *inv = am > 0.f ? am * (1.f / QMAX) : 1.f;
}
template <int FMT> struct LpRow;
template <> struct LpRow<8> { u32x4 a, b;
    __device__ __forceinline__ void load(const unsigned char* rowp, int lane) { a = *(const u32x4*)(rowp + 32 * lane); b = *(const u32x4*)(rowp + 32 * lane + 16); }
    template <class Fn> __device__ __forceinline__ void each(Fn&& f) const {
#pragma unroll
        for (int w = 0; w < 4; ++w) { const f32x2 l0 = __builtin_amdgcn_cvt_pk_f32_fp8((int)a[w], false), h0 = __builtin_amdgcn_cvt_pk_f32_fp8((int)a[w], true);
            f(4 * w, l0.x, l0.y); f(4 * w + 2, h0.x, h0.y); }
#pragma unroll
        for (int w = 0; w < 4; ++w) { const f32x2 l0 = __builtin_amdgcn_cvt_pk_f32_fp8((int)b[w], false), h0 = __builtin_amdgcn_cvt_pk_f32_fp8((int)b[w], true);
            f(16 + 4 * w, l0.x, l0.y); f(16 + 4 * w + 2, h0.x, h0.y); }
    } };
template <> struct LpRow<4> { u32x4 a;
    __device__ __forceinline__ void load(const unsigned char* rowp, int lane) { a = *(const u32x4*)(rowp + 16 * lane); }
    template <class Fn> __device__ __forceinline__ void each(Fn&& f) const {
#pragma unroll
        for (int w = 0; w < 4; ++w) {
            const f32x2 d0 = __builtin_amdgcn_cvt_scalef32_pk_f32_fp4(a[w], 1.0f, 0), d1 = __builtin_amdgcn_cvt_scalef32_pk_f32_fp4(a[w], 1.0f, 1);
            const f32x2 d2 = __builtin_amdgcn_cvt_scalef32_pk_f32_fp4(a[w], 1.0f, 2), d3 = __builtin_amdgcn_cvt_scalef32_pk_f32_fp4(a[w], 1.0f, 3);
            f(8 * w, d0.x, d0.y); f(8 * w + 2, d1.x, d1.y); f(8 * w + 4, d2.x, d2.y); f(8 * w + 6, d3.x, d3.y); }
    } };

__device__ __forceinline__ void row_stats(const f32x4 (&v)[8], float& mean, float& rstd) {
    float s = 0.f;
#pragma unroll
    for (int j = 0; j < 8; ++j) s += (v[j].x + v[j].y) + (v[j].z + v[j].w);
    mean = wave_sum(s) * (1.f / D);
    float s2 = 0.f;
#pragma unroll
    for (int j = 0; j < 8; ++j) { const f32x4 d = v[j] - mean; s2 += (d.x * d.x + d.y * d.y) + (d.z * d.z + d.w * d.w); }
    rstd = 1.f / sqrtf(wave_sum(s2) * (1.f / D) + LN_EPS);
}
__device__ __forceinline__ void modulate_store(const f32x4 (&v)[8], const float* shift, const float* scale, bf16_t* dst, int lane) {
    float mean, rstd; row_stats(v, mean, rstd);
    u32x2* d = (u32x2*)dst + lane;
#pragma unroll
    for (int j = 0; j < 8; ++j) { const f32x4 sc = *((const f32x4*)scale + lane + 64 * j), sh = *((const f32x4*)shift + lane + 64 * j);
        const f32x4 y = (v[j] - mean) * rstd * (sc + 1.f) + sh;
        u32x2 o; o.x = pk2(y.x, y.y); o.y = pk2(y.z, y.w); d[64 * j] = o; }
}

__device__ __forceinline__ void p0a_prologue(Frame& F) {
    LAS float* condL = (LAS float*)F.lds;
    LAS float* red = (LAS float*)(F.lds + 24576);
    for (int i = F.tid; i < 3 * D; i += NWAVES * 64) { const int r = i / D, k = i % D; const float v = r < 2 ? F.c()[r * D + k] : F.c_ctx()[k]; condL[i] = v / (1.f + __expf(-v)); }
    __syncthreads();
    for (int item = blockIdx.x; item < 384; item += F.G) {
        const int l = item / 96, n0 = (item % 96) * 128;
        const float* wp = F.w_ada() + ((size_t)l * D + F.wave * 256) * 12288 + n0 + 2 * F.lane;
        f32x2 a0 = {0.f, 0.f}, a1 = {0.f, 0.f}, a2 = {0.f, 0.f};
#pragma unroll 8
        for (int k = 0; k < 256; ++k) { const f32x2 w = __builtin_nontemporal_load((const f32x2*)(wp + (size_t)k * 12288)); const int kk = F.wave * 256 + k;
            a0 += w * condL[kk]; a1 += w * condL[D + kk]; a2 += w * condL[2 * D + kk]; }
        LAS float* rp = red + F.wave * 384 + 2 * F.lane;
        rp[0] = a0.x; rp[1] = a0.y; rp[128] = a1.x; rp[129] = a1.y; rp[256] = a2.x; rp[257] = a2.y;
        __syncthreads();
        if (F.tid < 384) { const int r = F.tid / 128, n = F.tid % 128; float s = 0.f;
#pragma unroll
            for (int w = 0; w < 8; ++w) s += red[w * 384 + r * 128 + n];
            F.MODS()[((size_t)l * 3 + r) * 12288 + n0 + n] = s + F.b_ada()[(size_t)l * 12288 + n0 + n]; }
        __syncthreads();
    }
    LAS float* scr = (LAS float*)(F.lds + 40960 + F.wave * 8448);
    constexpr int I_IN = (D / 64) * (INC / 32), I_OUT = (D / 64) * (D / 32);
    for (int it = F.gw; it < NLAYER * (I_IN + I_OUT); it += F.NGW) {
        const int l = it / (I_IN + I_OUT); int r = it % (I_IN + I_OUT);
        if (r < I_IN) transpose_item(F.w_in() + (size_t)l * D * INC, D, INC, F.WINT() + (size_t)l * INC * D, scr, r, F.lane);
        else transpose_item(F.w_out() + (size_t)l * D * D, D, D, F.WOUTT() + (size_t)l * D * D, scr, r - I_IN, F.lane);
    }
    for (int row = F.gw; row < NLAYER * D; row += F.NGW) {
        const int l = row / D, c = row % D; const f32x4* s = (const f32x4*)(F.wq() + (size_t)row * D) + F.lane;
#pragma unroll
        for (int j = 0; j < 8; ++j) { const f32x4 v = s[64 * j]; u32x2 o; o.x = pk2(v.x, v.y); o.y = pk2(v.z, v.w);
            *((u32x2*)(F.WQR() + ((size_t)(l * 8 + j) * D + c) * 256) + F.lane) = o; }
    }
    for (int row = F.gw; row < 32 * 256; row += F.NGW) {
        const int lh = row >> 8, pk = row & 255, p = pk >> 7;
        u32x2 o = {0u, 0u};
        if ((F.lane >> 5) == p) { const f32x4 v = *((const f32x4*)(F.keys() + ((size_t)lh * 256 + pk) * 128) + (F.lane & 31)); o.x = pk2(v.x, v.y); o.y = pk2(v.z, v.w); }
        *((u32x2*)(F.KBD() + (size_t)row * 256) + F.lane) = o;
    }
    for (int row = F.gw; row < NLAYER * NEXP; row += F.NGW) {
        cvt_row_lp<U_FMT>(F.pu() + (size_t)row * D, F.UT() + (size_t)row * UROW, F.US() + row, F.lane);
        cvt_row_lp<V_FMT>(F.pv() + (size_t)row * D, F.VT() + (size_t)row * VROW, F.VS() + row, F.lane);
    }
    for (int i = blockIdx.x * (NWAVES * 64) + F.tid; i < 192 * 32; i += F.G * NWAVES * 64) {
        const int idx = i >> 5, f = i & 31; const float pos = (float)(idx < 128 ? idx : idx - 128);
        const float inv = powf(10000.f, -(float)(2 * f) / 64.f); const float ang = pos * inv;
        F.ROPE()[2 * i] = cosf(ang); F.ROPE()[2 * i + 1] = sinf(ang);
    }
}

__device__ __forceinline__ void p0b_mod0(Frame& F) {
    for (int t = F.gw; t < TT; t += F.NGW) {
        const float* src = t < TL ? F.x() + (size_t)t * D : F.ctx() + (size_t)(t - TL) * D;
        f32x4 v[8];
#pragma unroll
        for (int j = 0; j < 8; ++j) v[j] = *((const f32x4*)src + F.lane + 64 * j);
        const float* mp = F.MODS() + (size_t)modrow(t) * 12288;
        modulate_store(v, mp, mp + D, F.H() + (size_t)t * D, F.lane);
    }
}

constexpr int KP = 272, VP = 320, KS_BYTES = 64 * KP, VS_BYTES = 64 * VP;
struct KVRegs { u32x4 k1, k2, v1, v2; f32x4 cs[4]; };

__device__ __forceinline__ void attn_load_tile(Frame& F, KVRegs& R, int ti, int b, int n, int g) {
    const int key = F.tid >> 3, c8 = F.tid & 7;
    int row, pos = 0;
    if (ti < 6) { pos = (n - 1) * 128 + 64 * ti + key; row = b * SEQ + pos; } else row = TL + b * CTXL + 64 * (ti - 6) + key;
    const bf16_t* base = F.PROJ() + (size_t)row * INC;
    const int d1 = (c8 >> 2) * 64 + (c8 & 3) * 8;
    R.k1 = *(const u32x4*)(base + OFF_K + g * 128 + d1); R.k2 = *(const u32x4*)(base + OFF_K + g * 128 + d1 + 32);
    R.v1 = *(const u32x4*)(base + OFF_V + g * 128 + 8 * c8); R.v2 = *(const u32x4*)(base + OFF_V + g * 128 + 64 + 8 * c8);
    if (ti < 6) { const int tidx = (c8 >> 2) ? 128 + (pos & 63) : (pos >> 6); const f32x4* cp = (const f32x4*)(F.ROPE() + ((size_t)tidx * 32 + (c8 & 3) * 8) * 2);
#pragma unroll
        for (int m = 0; m < 4; ++m) R.cs[m] = cp[m]; }
}
__device__ __forceinline__ void rope8(u32x4& a, u32x4& bq, const f32x4 (&cs)[4], float scale) {
    u32x4 oa, ob;
#pragma unroll
    for (int w = 0; w < 4; ++w) {
        const float x1l = bf_lo(a[w]), x1h = bf_hi(a[w]), x2l = bf_lo(bq[w]), x2h = bf_hi(bq[w]);
        const float cl = cs[w].x, sl = cs[w].y, ch = cs[w].z, sh = cs[w].w;
        oa[w] = pk2((x1l * cl - x2l * sl) * scale, (x1h * ch - x2h * sh) * scale);
        ob[w] = pk2((x2l * cl + x1l * sl) * scale, (x2h * ch + x1h * sh) * scale);
    }
    a = oa; bq = ob;
}
__device__ __forceinline__ void attn_store_tile(Frame& F, KVRegs& R, int ti, int buf) {
    const int key = F.tid >> 3, c8 = F.tid & 7;
    if (ti < 6) rope8(R.k1, R.k2, R.cs, 1.f);
    const int d1 = (c8 >> 2) * 64 + (c8 & 3) * 8;
    LAS unsigned char* kp = F.lds + buf * KS_BYTES + key * KP;
    *(LAS u32x4*)(kp + d1 * 2) = R.k1; *(LAS u32x4*)(kp + (d1 + 32) * 2) = R.k2;
    LAS unsigned char* vp = F.lds + 2 * KS_BYTES + buf * VS_BYTES + key * VP;
    *(LAS u32x4*)(vp + 16 * c8) = R.v1; *(LAS u32x4*)(vp + 128 + 16 * c8) = R.v2;
}

#define MFMA32(a, b, c) __builtin_amdgcn_mfma_f32_32x32x16_bf16((a), (b), (c), 0, 0, 0)

__device__ __forceinline__ void attn_unit(Frame& F, int layer, int u) {
    const bool latent = u < 512;
    int b, n, g, hp;
    if (latent) { hp = u & 1; g = (u >> 1) & 1; n = (u >> 2) & 63; b = u >> 8; }
    else { const int v = u - 512; hp = v & 1; g = (v >> 1) & 1; n = (v >> 2) & 1; b = v >> 3; }
    const int lane = F.lane, r = lane & 31, h = lane >> 5, wave = F.wave;
    const int head = g * 4 + hp * 2 + (wave >> 2), qb = wave & 3;
    const int tq = latent ? b * SEQ + n * 128 + 32 * qb + r : TL + b * CTXL + n * 128 + 32 * qb + r;
    bf16x8 qf[8];
    {
        u32x4 raw[8];
        const bf16_t* qp = F.PROJ() + (size_t)tq * INC + OFF_Q + head * 128 + 8 * h;
#pragma unroll
        for (int ks = 0; ks < 8; ++ks) raw[ks] = *(const u32x4*)(qp + 16 * ks);
        if (latent) {
            const int pos = n * 128 + 32 * qb + r;
#pragma unroll
            for (int half = 0; half < 2; ++half) {
                const int tidx = half ? 128 + (pos & 63) : (pos >> 6);
#pragma unroll
                for (int kk = 0; kk < 2; ++kk) {
                    const f32x4* cp = (const f32x4*)(F.ROPE() + ((size_t)tidx * 32 + 16 * kk + 8 * h) * 2);
                    f32x4 cs[4];
#pragma unroll
                    for (int m = 0; m < 4; ++m) cs[m] = cp[m];
                    rope8(raw[4 * half + kk], raw[4 * half + kk + 2], cs, QSCALE);
                }
            }
        } else {
#pragma unroll
            for (int ks = 0; ks < 8; ++ks)
#pragma unroll
                for (int w = 0; w < 4; ++w) raw[ks][w] = pk2(bf_lo(raw[ks][w]) * QSCALE, bf_hi(raw[ks][w]) * QSCALE);
        }
#pragma unroll
        for (int ks = 0; ks < 8; ++ks) qf[ks] = __builtin_bit_cast(bf16x8, raw[ks]);
    }
    int tlo = 6, nw = 0;
    if (latent) { tlo = (n == 0) ? 2 : 0; const int thi = (n == 63) ? 3 : 5; nw = thi - tlo + 1; }
    const int ntiles = nw + 4;
    f32x16 o[4];
#pragma unroll
    for (int db = 0; db < 4; ++db)
#pragma unroll
        for (int i = 0; i < 16; ++i) o[db][i] = 0.f;
    float m_run = F.sink()[layer * 8 + head] * LOG2E;
    float lsum = h == 0 ? 1.f : 0.f;
    const int iq = 32 * qb + r;
    KVRegs R;
    __syncthreads();
    attn_load_tile(F, R, nw > 0 ? tlo : 6, b, n, g);
    attn_store_tile(F, R, nw > 0 ? tlo : 6, 0);
    __syncthreads();
    const int i16 = lane & 15, tq4 = i16 >> 2, tp = i16 & 3, blk = (lane >> 4) & 1;
    for (int j = 0; j < ntiles; ++j) {
        const int ti = j < nw ? tlo + j : 6 + (j - nw);
        const int buf = j & 1;
        const bool more = j + 1 < ntiles;
        const int tin = (j + 1) < nw ? tlo + j + 1 : 6 + (j + 1 - nw);
        if (more) attn_load_tile(F, R, tin, b, n, g);
        const bool part = ti >= 6 || (ti >= (qb >> 1) && ti <= (qb >> 1) + 4);
        if (part) {
            f32x16 s0, s1;
#pragma unroll
            for (int i = 0; i < 16; ++i) { s0[i] = 0.f; s1[i] = 0.f; }
            const LAS unsigned char* kb = F.lds + buf * KS_BYTES + r * KP + h * 16;
#pragma unroll
            for (int ks = 0; ks < 8; ++ks) {
                const bf16x8 a0 = *(const LAS bf16x8*)(kb + ks * 32), a1 = *(const LAS bf16x8*)(kb + 32 * KP + ks * 32);
                s0 = MFMA32(a0, qf[ks], s0); s1 = MFMA32(a1, qf[ks], s1);
            }
            float mx = -INFINITY;
            if (ti < 6) {
                const int jb = 64 * ti + 4 * h - iq;
#pragma unroll
                for (int i = 0; i < 16; ++i) { const int j0 = jb + (i & 3) + 8 * (i >> 2), j1 = j0 + 32;
                    s0[i] = (j0 >= 0 && j0 <= 256) ? s0[i] : -INFINITY; s1[i] = (j1 >= 0 && j1 <= 256) ? s1[i] : -INFINITY; }
            }
#pragma unroll
            for (int i = 0; i < 16; ++i) mx = fmaxf(mx, fmaxf(s0[i], s1[i]));
            mx = fmaxf(mx, __shfl_xor(mx, 32));
            const float m_new = fmaxf(m_run, mx), alpha = exp2f(m_run - m_new);
            m_run = m_new; lsum *= alpha;
#pragma unroll
            for (int i = 0; i < 16; ++i) { s0[i] = exp2f(s0[i] - m_new); s1[i] = exp2f(s1[i] - m_new); lsum += s0[i] + s1[i]; }
#pragma unroll
            for (int db = 0; db < 4; ++db)
#pragma unroll
                for (int i = 0; i < 16; ++i) o[db][i] *= alpha;
            bf16x8 pf[2][2];
#pragma unroll
            for (int s2 = 0; s2 < 2; ++s2) {
                u32x4 p0, p1;
#pragma unroll
                for (int w = 0; w < 4; ++w) { p0[w] = pk2(s0[8 * s2 + 2 * w], s0[8 * s2 + 2 * w + 1]); p1[w] = pk2(s1[8 * s2 + 2 * w], s1[8 * s2 + 2 * w + 1]); }
                pf[0][s2] = __builtin_bit_cast(bf16x8, p0); pf[1][s2] = __builtin_bit_cast(bf16x8, p1);
            }
            const LAS unsigned char* vb = F.lds + 2 * KS_BYTES + buf * VS_BYTES + (4 * h + tq4) * VP + 32 * blk + 8 * tp;
#pragma unroll
            for (int db = 0; db < 4; ++db)
#pragma unroll
                for (int kb2 = 0; kb2 < 2; ++kb2)
#pragma unroll
                    for (int s2 = 0; s2 < 2; ++s2) {
                        const int off = (32 * kb2 + 16 * s2) * VP + db * 64;
                        const s16x4 lo = __builtin_amdgcn_ds_read_tr16_b64_v4i16((LAS s16x4*)(vb + off));
                        const s16x4 hi = __builtin_amdgcn_ds_read_tr16_b64_v4i16((LAS s16x4*)(vb + off + 8 * VP));
                        const bf16x8 av = __builtin_shufflevector(lo, hi, 0, 1, 2, 3, 4, 5, 6, 7);
                        o[db] = MFMA32(av, pf[kb2][s2], o[db]);
                    }
        }
        if (more) attn_store_tile(F, R, tin, buf ^ 1);
        __syncthreads();
    }
    const float lt = lsum + __shfl_xor(lsum, 32);
    const float inv = 1.f / lt;
    float ss = 0.f;
#pragma unroll
    for (int db = 0; db < 4; ++db)
#pragma unroll
        for (int i = 0; i < 16; ++i) { o[db][i] *= inv; ss += o[db][i] * o[db][i]; }
    ss += __shfl_xor(ss, 32);
    const float rn = 1.f / sqrtf(ss * (1.f / 128.f) + LN_EPS);
    bf16_t* op = F.MIX() + (size_t)tq * D + head * 128 + 4 * h;
    const float* gp = F.g_attn() + layer * 1024 + head * 128 + 4 * h;
#pragma unroll
    for (int db = 0; db < 4; ++db)
#pragma unroll
        for (int g4 = 0; g4 < 4; ++g4) {
            const f32x4 gv = *(const f32x4*)(gp + 32 * db + 8 * g4);
            u32x2 w; w.x = pk2(o[db][4 * g4] * rn * gv.x, o[db][4 * g4 + 1] * rn * gv.y); w.y = pk2(o[db][4 * g4 + 2] * rn * gv.z, o[db][4 * g4 + 3] * rn * gv.w);
            *(u32x2*)(op + 32 * db + 8 * g4) = w;
        }
}

__device__ __forceinline__ void unpack8(const u32x4 v, float (&f)[8]) {
#pragma unroll
    for (int w = 0; w < 4; ++w) { f[2 * w] = bf_lo(v[w]); f[2 * w + 1] = bf_hi(v[w]); }
}
__device__ __forceinline__ void conv_row(Frame& F, int layer, int t) {
    bool first, last;
    if (t < TL) { const int pos = t & (SEQ - 1); first = pos == 0; last = pos == SEQ - 1; } else { const int pc = (t - TL) & (CTXL - 1); first = pc == 0; last = pc == CTXL - 1; }
    const bf16_t* p = F.PROJ() + (size_t)t * INC;
    const float* cw = F.conv_w() + (size_t)layer * 3 * 1024;
#pragma unroll
    for (int jc = 0; jc < 2; ++jc) {
        const int c = 8 * F.lane + 512 * jc;
        float gb[8], a[8], bq[8], um[8], ut[8], up[8];
        unpack8(*(const u32x4*)(p + c), gb);
        unpack8(*(const u32x4*)(p + OFF_C + c), a); unpack8(*(const u32x4*)(p + OFF_X + c), bq);
#pragma unroll
        for (int e = 0; e < 8; ++e) ut[e] = a[e] * bq[e];
        if (!first) { unpack8(*(const u32x4*)(p - INC + OFF_C + c), a); unpack8(*(const u32x4*)(p - INC + OFF_X + c), bq);
#pragma unroll
            for (int e = 0; e < 8; ++e) um[e] = a[e] * bq[e]; }
        else {
#pragma unroll
            for (int e = 0; e < 8; ++e) um[e] = 0.f; }
        if (!last) { unpack8(*(const u32x4*)(p + INC + OFF_C + c), a); unpack8(*(const u32x4*)(p + INC + OFF_X + c), bq);
#pragma unroll
            for (int e = 0; e < 8; ++e) up[e] = a[e] * bq[e]; }
        else {
#pragma unroll
            for (int e = 0; e < 8; ++e) up[e] = 0.f; }
        float y[8], ss = 0.f;
#pragma unroll
        for (int e = 0; e < 8; ++e) { y[e] = gb[e] * (cw[c + e] * um[e] + cw[1024 + c + e] * ut[e] + cw[2048 + c + e] * up[e]); ss += y[e] * y[e]; }
        ss += __shfl_xor(ss, 1); ss += __shfl_xor(ss, 2); ss += __shfl_xor(ss, 4); ss += __shfl_xor(ss, 8);
        const float rn = 1.f / sqrtf(ss * (1.f / 128.f) + LN_EPS);
        const float* gc = F.g_conv() + layer * 1024 + c;
        u32x4 w;
#pragma unroll
        for (int q = 0; q < 4; ++q) w[q] = pk2(y[2 * q] * rn * gc[2 * q], y[2 * q + 1] * rn * gc[2 * q + 1]);
        *(u32x4*)(F.MIX() + (size_t)t * D + 1024 + c) = w;
    }
}

__device__ __forceinline__ void ln_phase(Frame& F, int layer, int rows) {
    for (int t = F.gw; t < rows; t += F.NGW) {
        float* xr = F.X() + (size_t)t * D;
        f32x4 v[8];
#pragma unroll
        for (int j = 0; j < 8; ++j) v[j] = *((const f32x4*)xr + F.lane + 64 * j);
        float mean, rstd; row_stats(v, mean, rstd);
        const float* g1 = F.ln1_g() + layer * D; const float* b1 = F.ln1_b() + layer * D;
#pragma unroll
        for (int j = 0; j < 8; ++j) { const f32x4 gg = *((const f32x4*)g1 + F.lane + 64 * j), bb = *((const f32x4*)b1 + F.lane + 64 * j);
            v[j] = (v[j] - mean) * rstd * gg + bb; *((f32x4*)xr + F.lane + 64 * j) = v[j]; }
        const float* mp = F.MODS() + ((size_t)layer * 3 + modrow(t)) * 12288;
        modulate_store(v, mp + 3 * D, mp + 4 * D, F.H() + (size_t)t * D, F.lane);
    }
}

__device__ __forceinline__ unsigned ordkey(float f) { const unsigned u = __float_as_uint(f); return u ^ ((u >> 31) ? 0xFFFFFFFFu : 0x80000000u); }
__device__ __forceinline__ float gelu_erf(float a) { return 0.5f * a * (1.f + erff(a * 0.70710678118654752f)); }

template <int CTRL> __device__ __forceinline__ int dpp_i(int v) { return __builtin_amdgcn_update_dpp(0, v, CTRL, 0xf, 0xf, true); }
template <int CTRL> __device__ __forceinline__ float dpp_f(float v) { return __int_as_float(dpp_i<CTRL>(__float_as_int(v))); }
constexpr int DPP_XOR1 = 0xB1, DPP_XOR2 = 0x4E, DPP_HMIRROR = 0x141, DPP_ROR4 = 0x124, DPP_ROR8 = 0x128;
__device__ __forceinline__ float wave_sum_u(float v) {
    v += dpp_f<DPP_XOR1>(v); v += dpp_f<DPP_XOR2>(v); v += dpp_f<DPP_ROR4>(v); v += dpp_f<DPP_ROR8>(v);
    const float r0 = __int_as_float(__builtin_amdgcn_readlane(__float_as_int(v), 0)), r1 = __int_as_float(__builtin_amdgcn_readlane(__float_as_int(v), 16));
    const float r2 = __int_as_float(__builtin_amdgcn_readlane(__float_as_int(v), 32)), r3 = __int_as_float(__builtin_amdgcn_readlane(__float_as_int(v), 48));
    return (r0 + r1) + (r2 + r3);
}
__device__ __forceinline__ float unordkey(unsigned k) { return __uint_as_float(k ^ ((k >> 31) ? 0x80000000u : 0xFFFFFFFFu)); }
__device__ __forceinline__ float gelu_as(float v) {
    const float av = fabsf(v), t = __builtin_amdgcn_rcpf(av * 0.2316418882f + 1.0f);
    float q = t * 0.5307027145f + (-0.7265760135f); q = q * t + 0.7107068705f; q = q * t + (-0.142248368f); q = q * t + 0.127414796f; q = q * t;
    const float e = __builtin_amdgcn_exp2f((v * v) * (-0.72134752044f));
    const float m = v * (q * e);
    return v < 0.f ? m : v - m;
}

template <class O> struct QuadNet {
    typedef typename O::V V; typedef typename O::B B;
    template <bool ASC> static __device__ __forceinline__ void ce_reg(V& a, V& b) { const V lo = O::vmin(a, b), hi = O::vmax(a, b); a = ASC ? lo : hi; b = ASC ? hi : lo; }
    template <bool ASC> static __device__ __forceinline__ void ce_l1(V& x, B low1) { const V p = O::x1(x); const V mn = O::vmin(p, x), mx = O::vmax(p, x); x = ASC ? O::vsel(low1, mn, mx) : O::vsel(low1, mx, mn); }
    template <bool ASC> static __device__ __forceinline__ void ce_l2(V& x, B low2) { const V p = O::x2(x); const V mn = O::vmin(p, x), mx = O::vmax(p, x); x = ASC ? O::vsel(low2, mn, mx) : O::vsel(low2, mx, mn); }
    template <int NR> static __device__ __forceinline__ void sort_blocks(V (&R)[NR], B low1, B low2, B eq12) {
#pragma unroll
        for (int r = 0; r < NR; ++r) { const V p = O::x1(R[r]); const V mn = O::vmin(p, R[r]), mx = O::vmax(p, R[r]); R[r] = O::vsel(eq12, mn, mx); }
#pragma unroll
        for (int r = 0; r < NR; ++r) { if ((r & 1) == 0) ce_l2<true>(R[r], low2); else ce_l2<false>(R[r], low2); }
#pragma unroll
        for (int r = 0; r < NR; ++r) { if ((r & 1) == 0) ce_l1<true>(R[r], low1); else ce_l1<false>(R[r], low1); }
#pragma unroll
        for (int r = 0; r < NR; r += 2) { if ((r & 2) == 0) ce_reg<true>(R[r], R[r + 1]); else ce_reg<false>(R[r], R[r + 1]); }
#pragma unroll
        for (int r = 0; r < NR; ++r) { if ((r & 2) == 0) ce_l2<true>(R[r], low2); else ce_l2<false>(R[r], low2); }
#pragma unroll
        for (int r = 0; r < NR; ++r) { if ((r & 2) == 0) ce_l1<true>(R[r], low1); else ce_l1<false>(R[r], low1); }
#pragma unroll
        for (int r = 0; r < NR; ++r) { if ((r & 2) == 0) { if ((r & 4) == 0) ce_reg<true>(R[r], R[r + 2]); else ce_reg<false>(R[r], R[r + 2]); } }
#pragma unroll
        for (int r = 0; r < NR; r += 2) { if ((r & 4) == 0) ce_reg<true>(R[r], R[r + 1]); else ce_reg<false>(R[r], R[r + 1]); }
#pragma unroll
        for (int r = 0; r < NR; ++r) { if ((r & 4) == 0) ce_l2<true>(R[r], low2); else ce_l2<false>(R[r], low2); }
#pragma unroll
        for (int r = 0; r < NR; ++r) { if ((r & 4) == 0) ce_l1<true>(R[r], low1); else ce_l1<false>(R[r], low1); }
    }
    template <int NR> static __device__ __forceinline__ void halve_merge(const V (&R)[NR], V (&Q)[NR / 2], B low1, B low2) {
#pragma unroll
        for (int m = 0; m < NR / 8; ++m)
#pragma unroll
            for (int i = 0; i < 4; ++i) Q[4 * m + i] = O::vmax(R[8 * m + i], R[8 * m + 4 + i]);
#pragma unroll
        for (int r = 0; r < NR / 2; ++r) { if ((r & 2) == 0) { if ((r & 4) == 0) ce_reg<false>(Q[r], Q[r + 2]); else ce_reg<true>(Q[r], Q[r + 2]); } }
#pragma unroll
        for (int r = 0; r < NR / 2; r += 2) { if ((r & 4) == 0) ce_reg<false>(Q[r], Q[r + 1]); else ce_reg<true>(Q[r], Q[r + 1]); }
#pragma unroll
        for (int r = 0; r < NR / 2; ++r) { if ((r & 4) == 0) ce_l2<false>(Q[r], low2); else ce_l2<true>(Q[r], low2); }
#pragma unroll
        for (int r = 0; r < NR / 2; ++r) { if ((r & 4) == 0) ce_l1<false>(Q[r], low1); else ce_l1<true>(Q[r], low1); }
    }
    static __device__ __forceinline__ void top16_of_128(V (&R)[32], V (&T)[4], B low1, B low2, B eq12) {
        sort_blocks<32>(R, low1, low2, eq12);
        V A[16]; halve_merge<32>(R, A, low1, low2);
        V Bq[8]; halve_merge<16>(A, Bq, low1, low2);
        halve_merge<8>(Bq, T, low1, low2);
    }
    static __device__ __forceinline__ void top16_of_64(V (&R)[16], V (&T)[4], B low1, B low2, B eq12) {
        sort_blocks<16>(R, low1, low2, eq12);
        V A[8]; halve_merge<16>(R, A, low1, low2);
        halve_merge<8>(A, T, low1, low2);
    }
};

struct DevOps {
    typedef unsigned V; typedef bool B;
    static __device__ __forceinline__ V vmin(V a, V b) { return a < b ? a : b; }
    static __device__ __forceinline__ V vmax(V a, V b) { return a > b ? a : b; }
    static __device__ __forceinline__ V vsel(B m, V a, V b) { return m ? a : b; }
    static __device__ __forceinline__ V x1(V a) { return (V)dpp_i<DPP_XOR1>((int)a); }
    static __device__ __forceinline__ V x2(V a) { return (V)dpp_i<DPP_XOR2>((int)a); }
};
__device__ __forceinline__ void stair_ab(int c, int& a, int& b) {
    if (c < 16) { a = 0; b = c; } else if (c < 24) { a = 1; b = c - 16; } else if (c < 28) { a = 2; b = c - 24; } else if (c < 32) { a = 3; b = c - 28; }
    else if (c < 36) { a = 4; b = c - 32; } else if (c < 40) { a = 5 + ((c - 36) >> 1); b = (c - 36) & 1; } else if (c < 44) { a = 7 + ((c - 40) >> 1); b = (c - 40) & 1; }
    else if (c < 48) { a = 9 + (c - 44); b = 0; } else if (c < 51) { a = 13 + (c - 48); b = 0; } else { a = 2; b = 4; }
}
constexpr int PE_WS = 5120, PE_TAB = 8 * PE_WS;
__device__ __forceinline__ void peer_topk(Frame& F, LAS unsigned char* ws, int t) {
    const int lane = F.lane, sub = lane & 3;
    const bool low1 = (sub & 1) == 0, low2 = (sub & 2) == 0, eq12 = low1 == low2;
    LAS unsigned* S1K = (LAS unsigned*)ws; LAS int* EL = (LAS int*)(ws + 3328); LAS float* GL = (LAS float*)(ws + 3840);
    const LAS unsigned short* TAB = (const LAS unsigned short*)(F.lds + PE_TAB);
    {
        const int L = lane >> 2;
        const float* sp = F.SC() + (size_t)t * D + L * 128 + sub * 4;
        unsigned R[32];
#pragma unroll
        for (int q = 0; q < 8; ++q) { const f32x4 v = *(const f32x4*)(sp + 16 * q);
#pragma unroll
            for (int e = 0; e < 4; ++e) R[4 * q + e] = (ordkey(v[e]) & ~127u) | (unsigned)(127 - (4 * sub + 16 * q + e)); }
        unsigned T[4];
        QuadNet<DevOps>::top16_of_128(R, T, low1, low2, eq12);
#pragma unroll
        for (int r = 0; r < 4; ++r) S1K[L * 16 + 4 * r + sub] = T[r];
    }
    LDS_WAIT(); __builtin_amdgcn_wave_barrier();
    {
        const int hd = (lane >> 2) & 7;
        const LAS unsigned char* la = (const LAS unsigned char*)(S1K + (2 * hd) * 16); const LAS unsigned char* lb = (const LAS unsigned char*)(S1K + (2 * hd + 1) * 16);
        unsigned C[16];
#pragma unroll
        for (int r = 0; r < 13; ++r) { const unsigned ab = TAB[4 * r + sub];
            const unsigned ka = *(const LAS unsigned*)(la + (ab & 255u)), kb = *(const LAS unsigned*)(lb + (ab >> 8));
            const float sum = unordkey(ka & ~127u) + unordkey(kb & ~127u);
            C[r] = (ordkey(sum) & ~63u) | (unsigned)(63 - (4 * r + sub)); }
        C[13] = 0u; C[14] = 0u; C[15] = 0u;
        unsigned W[4];
        QuadNet<DevOps>::top16_of_64(C, W, low1, low2, eq12);
        float sv[4]; int ex[4];
#pragma unroll
        for (int r = 0; r < 4; ++r) { const unsigned ab = TAB[63 - (W[r] & 63u)];
            const unsigned ka = *(const LAS unsigned*)(la + (ab & 255u)), kb = *(const LAS unsigned*)(lb + (ab >> 8));
            ex[r] = (int)(127u - (ka & 127u)) * 128 + (int)(127u - (kb & 127u)); sv[r] = unordkey(W[r] & ~63u); }
        const float mx = dpp_f<0x00>(sv[0]);
        float e4[4], es = 0.f;
#pragma unroll
        for (int r = 0; r < 4; ++r) { e4[r] = __expf(sv[r] - mx); es += e4[r]; }
        es += dpp_f<DPP_XOR1>(es); es += dpp_f<DPP_XOR2>(es);
        const float rd = 1.f / es;
#pragma unroll
        for (int r = 0; r < 4; ++r) { GL[hd * 16 + 4 * r + sub] = e4[r] * rd; EL[hd * 16 + 4 * r + sub] = ex[r]; }
    }
    LDS_WAIT(); __builtin_amdgcn_wave_barrier();
}

#ifndef PROBE_PHASE
#define PROBE_PHASE -1
#endif
#ifndef PROBE_MULT
#define PROBE_MULT 1
#endif
constexpr int EB = 4;
constexpr int CW_TICKET = 20480;

struct GBuf { LpRow<U_FMT> u[EB]; LpRow<V_FMT> v[EB]; float su[EB], sv[EB], g[EB]; };
__device__ __forceinline__ void gather_issue(GBuf& B, const LAS int* EL, const LAS float* GL, int i0, const unsigned char* UTl, const unsigned char* VTl, const float* USl, const float* VSl, int lane) {
#pragma unroll
    for (int q = 0; q < EB; ++q) {
        const int ex = __builtin_amdgcn_readfirstlane(EL[i0 + q]);
        B.g[q] = __uint_as_float(__builtin_amdgcn_readfirstlane(__float_as_uint(GL[i0 + q])));
        B.u[q].load(UTl + (size_t)ex * UROW, lane); B.v[q].load(VTl + (size_t)ex * VROW, lane); B.su[q] = USl[ex]; B.sv[q] = VSl[ex];
    }
}
__device__ __forceinline__ void gather_compute(const GBuf& B, const f32x2 (&hv)[16], f32x2 (&acc)[16]) {
    float dot[EB];
#pragma unroll
    for (int q = 0; q < EB; ++q) { f32x2 s = {0.f, 0.f};
        B.u[q].each([&](int i, float x0, float x1) { const f32x2 x = {x0, x1}; s = __builtin_elementwise_fma(x, hv[i >> 1], s); });
        dot[q] = s.x + s.y; }
#pragma unroll
    for (int q = 0; q < EB; ++q) dot[q] = wave_sum_u(dot[q]);
#pragma unroll
    for (int q = 0; q < EB; ++q) { const float cf = B.g[q] * gelu_as(dot[q] * B.su[q]) * B.sv[q]; const f32x2 c2 = {cf, cf};
        B.v[q].each([&](int i, float x0, float x1) { const f32x2 x = {x0, x1}; acc[i >> 1] = __builtin_elementwise_fma(x, c2, acc[i >> 1]); }); }
}

__device__ __forceinline__ void peer_phase(Frame& F, int layer, int rows, unsigned* ctl, unsigned long long& pr_acc) {
    unsigned long long pt0 = 0ull;
#define SUB_BEGIN(ty) do { if (PROBE_PHASE == (ty)) pt0 = __builtin_amdgcn_s_memrealtime(); } while (0)
#define SUB_END(ty) do { if (PROBE_PHASE == (ty)) pr_acc += __builtin_amdgcn_s_memrealtime() - pt0; } while (0)
    if (F.tid < 64) { int a = 0, b = 0; stair_ab(F.tid < 52 ? F.tid : 0, a, b); *(LAS unsigned short*)(F.lds + PE_TAB + 2 * F.tid) = (unsigned short)((4 * a) | ((4 * b) << 8)); }
    __syncthreads();
    LAS unsigned char* ws = F.lds + F.wave * PE_WS;
    LAS int* EL = (LAS int*)(ws + 3328); LAS float* GL = (LAS float*)(ws + 3840);
    const int lane = F.lane;
    const unsigned char* UTl = F.UT() + (size_t)layer * NEXP * UROW;
    const unsigned char* VTl = F.VT() + (size_t)layer * NEXP * VROW;
    const float* USl = F.US() + (size_t)layer * NEXP; const float* VSl = F.VS() + (size_t)layer * NEXP;
    unsigned* ticket = ctl + CW_TICKET + 64 * layer;
    unsigned tk = 0u;
    if (lane == 0) tk = __hip_atomic_fetch_add(ticket, 1u, __ATOMIC_RELAXED, __HIP_MEMORY_SCOPE_AGENT);
    int t = (int)__builtin_amdgcn_readfirstlane(tk);
    while (t < rows) {
        unsigned tkn = 0u;
        if (lane == 0) tkn = __hip_atomic_fetch_add(ticket, 1u, __ATOMIC_RELAXED, __HIP_MEMORY_SCOPE_AGENT);
        SUB_BEGIN(8); peer_topk(F, ws, t); SUB_END(8);
        SUB_BEGIN(9);
        f32x2 hv[16], acc[16];
#pragma unroll
        for (int q = 0; q < 4; ++q) { const u32x4 w = *(const u32x4*)(F.H() + (size_t)t * D + 32 * lane + 8 * q);
#pragma unroll
            for (int e = 0; e < 4; ++e) { hv[4 * q + e] = (f32x2){bf_lo(w[e]), bf_hi(w[e])}; acc[4 * q + e] = (f32x2){0.f, 0.f}; } }
        {
            GBuf A, B;
            gather_issue(A, EL, GL, 0, UTl, VTl, USl, VSl, lane);
            for (int i0 = 0; i0 < 128; i0 += 2 * EB) {
                gather_issue(B, EL, GL, i0 + EB, UTl, VTl, USl, VSl, lane);
                gather_compute(A, hv, acc);
                if (i0 + 2 * EB < 128) gather_issue(A, EL, GL, i0 + 2 * EB, UTl, VTl, USl, VSl, lane);
                gather_compute(B, hv, acc);
            }
        }
        SUB_END(9); SUB_BEGIN(10);
        const int mr = modrow(t);
        const float* mp = F.MODS() + ((size_t)layer * 3 + mr) * 12288;
        float* xr = F.X() + (size_t)t * D;
        float rr[32]; float s = 0.f;
#pragma unroll
        for (int q = 0; q < 8; ++q) { const int c = 32 * lane + 4 * q; const f32x4 xv = *(const f32x4*)(xr + c), gv = *(const f32x4*)(mp + 5 * D + c);
            const f32x4 av = {acc[2 * q].x, acc[2 * q].y, acc[2 * q + 1].x, acc[2 * q + 1].y};
#pragma unroll
            for (int e = 0; e < 4; ++e) { const float v = DN_ALPHA * xv[e] + gv[e] * av[e]; rr[4 * q + e] = v; s += v; } }
        const float mean = wave_sum_u(s) * (1.f / D);
        float s2 = 0.f;
#pragma unroll
        for (int i = 0; i < 32; ++i) { rr[i] -= mean; s2 += rr[i] * rr[i]; }
        const float rstd = 1.f / sqrtf(wave_sum_u(s2) * (1.f / D) + LN_EPS);
        const float* g2 = F.ln2_g() + layer * D; const float* b2 = F.ln2_b() + layer * D;
        float s3 = 0.f;
#pragma unroll
        for (int q = 0; q < 8; ++q) { const int c = 32 * lane + 4 * q; const f32x4 gg = *(const f32x4*)(g2 + c), bb = *(const f32x4*)(b2 + c);
            f32x4 xo;
#pragma unroll
            for (int e = 0; e < 4; ++e) { xo[e] = rr[4 * q + e] * rstd * gg[e] + bb[e]; rr[4 * q + e] = xo[e]; s3 += xo[e]; }
            if (layer < NLAYER - 1) *(f32x4*)(xr + c) = xo; else if (t < TL) *(f32x4*)(F.out() + (size_t)t * D + c) = xo; }
        if (layer < NLAYER - 1) {
            const float mean2 = wave_sum_u(s3) * (1.f / D);
            float s4 = 0.f;
#pragma unroll
            for (int i = 0; i < 32; ++i) { rr[i] -= mean2; s4 += rr[i] * rr[i]; }
            const float rstd2 = 1.f / sqrtf(wave_sum_u(s4) * (1.f / D) + LN_EPS);
            const float* np = F.MODS() + ((size_t)(layer + 1) * 3 + mr) * 12288;
#pragma unroll
            for (int q2 = 0; q2 < 4; ++q2) { const int c = 32 * lane + 8 * q2; u32x4 w;
#pragma unroll
                for (int q = 0; q < 2; ++q) { const f32x4 sh = *(const f32x4*)(np + c + 4 * q), sc = *(const f32x4*)(np + D + c + 4 * q); const int ri = 8 * q2 + 4 * q;
                    const float y0 = rr[ri] * rstd2 * (1.f + sc[0]) + sh[0], y1 = rr[ri + 1] * rstd2 * (1.f + sc[1]) + sh[1];
                    const float y2 = rr[ri + 2] * rstd2 * (1.f + sc[2]) + sh[2], y3 = rr[ri + 3] * rstd2 * (1.f + sc[3]) + sh[3];
                    w[2 * q] = pk2(y0, y1); w[2 * q + 1] = pk2(y2, y3); }
                *(u32x4*)(F.H() + (size_t)t * D + c) = w; }
        }
        SUB_END(10);
        t = (int)__builtin_amdgcn_readfirstlane(tkn);
    }
#undef SUB_BEGIN
#undef SUB_END
}

__global__ void __launch_bounds__(NWAVES * 64, 2) skel_fwd(Args args) {
    extern __shared__ __attribute__((aligned(16))) unsigned char lds[];
    Frame F;
    F.lds = (LAS unsigned char*)lds;
    F.tid = threadIdx.x; F.lane = F.tid & 63; F.wave = __builtin_amdgcn_readfirstlane(F.tid >> 6);
    F.G = gridDim.x; F.gw = blockIdx.x * NWAVES + F.wave; F.NGW = F.G * NWAVES;
    unsigned char* ws = args.ws;
    F.ka = (const CAS unsigned char*)__builtin_amdgcn_kernarg_segment_ptr();
    for (int u = F.tid; u < (LDS_BYTES - LDSCTL_OFF) / 4; u += NWAVES * 64) ((LAS unsigned*)(F.lds + LDSCTL_OFF))[u] = 0u;
    __syncthreads();
    unsigned* ctl = (unsigned*)(ws + WS_CTL);
    const int lo = args.ph_lo, hi = args.ph_hi;
    XcdBarrier bar; bar.bar = ctl + CW_BAR + args.li * XCD_BAR_WORDS; bar.x = 0; bar.st = nullptr;
    if (hi - lo > 1) bar = xcd_barrier_post(ctl + CW_BAR + args.li * XCD_BAR_WORDS, (volatile LAS unsigned*)(F.lds + MISC_OFF) + 8);
#define IN(k) (lo <= (k) && (k) < hi)
    unsigned long long pr_acc = 0ull, pr_t0 = 0ull;
#define PR_BEGIN(ty) do { if (PROBE_PHASE == (ty)) pr_t0 = __builtin_amdgcn_s_memrealtime(); } while (0)
#define PR_END(ty) do { if (PROBE_PHASE == (ty)) pr_acc += __builtin_amdgcn_s_memrealtime() - pr_t0; } while (0)
#define BOTH(k) (IN(k) && IN((k) + 1))
#define SEAM(k) do { if (BOTH(k)) xcd_barrier(bar); } while (0)

    if (IN(0)) { PR_BEGIN(0); frame_ids(F); p0a_prologue(F); SEAM(0); PR_END(0); }
    if (IN(1)) {
        PR_BEGIN(1); frame_ids(F);
        { pg8::Gemm g{F.KBD(), F.WQR(), 32 * 256, 2048, 256}; pg8::BatchOrder S{F.G, (int)blockIdx.x}; pg8::EpiBf16 E{F.WEFFT(), D};
          pg8::gemm_phase<pg8::EpiBf16, pg8::BatchOrder, false, true>(F.lds, g, S, E); }
        p0b_mod0(F);
        SEAM(1); PR_END(1);
    }
    for (int layer = 0; layer < NLAYER; ++layer) {
        const int pb = 2 + 6 * layer;
        const bool lastl = layer == NLAYER - 1;
        const int rows = lastl ? TL : TT;
        if (IN(pb + 0)) {
            PR_BEGIN(2); frame_ids(F);
            pg8::Gemm g{F.H(), F.WINT() + (size_t)layer * INC * D, TT, INC, D}; pg8::StaticOrder S; S.init(TT, INC, F.G, (int)blockIdx.x);
            pg8::EpiBf16 E{F.PROJ(), INC};
            pg8::gemm_phase<pg8::EpiBf16, pg8::StaticOrder, true, true>(F.lds, g, S, E);
            SEAM(pb + 0); PR_END(2);
        }
        if (IN(pb + 1)) {
            PR_BEGIN(3); frame_ids(F);
            const int nunits = lastl ? 512 : 528;
            for (int u = blockIdx.x; u < nunits; u += F.G) attn_unit(F, layer, u);
            for (int t = F.gw; t < rows; t += F.NGW) conv_row(F, layer, t);
            SEAM(pb + 1); PR_END(3);
        }
        if (IN(pb + 2)) {
            PR_BEGIN(4); frame_ids(F);
            pg8::Gemm g{F.MIX(), F.WOUTT() + (size_t)layer * D * D, rows, D, D}; pg8::StaticOrder S; S.init(rows, D, F.G, (int)blockIdx.x);
            pg8::EpiResid E{layer == 0 ? F.x() : F.X(), layer == 0 ? F.ctx() : F.X() + (size_t)TL * D, F.X(), F.MODS() + (size_t)layer * 3 * 12288 + 2 * D};
            pg8::gemm_phase<pg8::EpiResid, pg8::StaticOrder, true, true>(F.lds, g, S, E);
            SEAM(pb + 2); PR_END(4);
        }
        if (IN(pb + 3)) { PR_BEGIN(5); frame_ids(F); ln_phase(F, layer, rows); SEAM(pb + 3); PR_END(5); }
        if (IN(pb + 4)) {
            PR_BEGIN(6); frame_ids(F);
            pg8::Gemm g{F.H(), F.WEFFT() + (size_t)layer * D * D, rows, D, D}; pg8::StaticOrder S; S.init(rows, D, F.G, (int)blockIdx.x);
            pg8::EpiF32 E{F.SC(), D};
            pg8::gemm_phase<pg8::EpiF32, pg8::StaticOrder, true, true>(F.lds, g, S, E);
            SEAM(pb + 4); PR_END(6);
        }
        if (IN(pb + 5)) { PR_BEGIN(7); frame_ids(F); peer_phase(F, layer, rows, ctl, pr_acc); SEAM(pb + 5); PR_END(7); }
    }
    if (PROBE_PHASE >= 0 && hi - lo > 1) xcd_barrier(bar);
    if (PROBE_PHASE >= 0 && blockIdx.x == 0 && threadIdx.x == 0) { const unsigned long long t1 = __builtin_amdgcn_s_memrealtime() + (unsigned long long)PROBE_MULT * pr_acc; while (__builtin_amdgcn_s_memrealtime() < t1) __builtin_amdgcn_s_sleep(8); }
#undef IN
#undef BOTH
#undef SEAM
}

extern "C" void kernel_launch(void* const* d_in, const int* in_sizes, int n_in, void* d_out, int out_size, void* d_ws, size_t ws_size, hipStream_t stream) {
    static int grid = 0;
    if (grid == 0) {
        if (n_in != 20 || in_sizes[0] != TL * D || out_size != TL * D || ws_size < WS_END) {
            fprintf(stderr, "kernel_launch: unexpected problem shape (n_in %d, in0 %d, out %d, ws %zu, need %zu)\n", n_in, n_in > 0 ? in_sizes[0] : -1, out_size, ws_size, (size_t)WS_END); grid = -1; return; }
        int dev = 0, cus = 0, per_cu = 0;
        if (hipGetDevice(&dev) != hipSuccess || hipDeviceGetAttribute(&cus, hipDeviceAttributeMultiprocessorCount, dev) != hipSuccess) { grid = -1; return; }
        if (hipFuncSetAttribute((const void*)skel_fwd, hipFuncAttributeMaxDynamicSharedMemorySize, LDS_BYTES) != hipSuccess) { fprintf(stderr, "kernel_launch: hipFuncSetAttribute failed\n"); grid = -1; return; }
        if (hipOccupancyMaxActiveBlocksPerMultiprocessor(&per_cu, (const void*)skel_fwd, NWAVES * 64, LDS_BYTES) != hipSuccess || per_cu < 1)
            fprintf(stderr, "kernel_launch: occupancy query reports %d workgroups per CU\n", per_cu);
        (void)hipGetLastError();
        grid = cus;
    }
    if (grid < 0) return;
    if (hipMemsetAsync((char*)d_ws + WS_CTL, 0, CTL_ZERO_BYTES, stream) != hipSuccess) return;
    Args a{};
    for (int i = 0; i < 20; ++i) a.in[i] = (const float*)d_in[i];
    a.out = (float*)d_out; a.ws = (unsigned char*)d_ws; a.pad = 0;
#if MK_N_LAUNCHES == 1
    a.ph_lo = 0; a.ph_hi = NPHASE; a.li = 0;
    hipLaunchKernelGGL(skel_fwd, dim3(grid), dim3(NWAVES * 64), LDS_BYTES, stream, a);
#else
    for (int ph = 0; ph < NPHASE; ++ph) { a.ph_lo = ph; a.ph_hi = ph + 1; a.li = 0;
        hipLaunchKernelGGL(skel_fwd, dim3(grid), dim3(NWAVES * 64), LDS_BYTES, stream, a); }
#endif
}
```

```cpp
#include <hip/hip_runtime.h>
#include <cstdio>
#include <cstdint>

#ifndef MK_N_LAUNCHES
#define MK_N_LAUNCHES 1
#endif

#define LAS __attribute__((address_space(3)))
typedef unsigned short bf16_t;
typedef short bf16x8 __attribute__((ext_vector_type(8)));
typedef short s16x4 __attribute__((ext_vector_type(4)));
typedef float f32x2 __attribute__((ext_vector_type(2)));
typedef float f32x4 __attribute__((ext_vector_type(4)));
typedef float f32x16 __attribute__((ext_vector_type(16)));
typedef unsigned u32x2 __attribute__((ext_vector_type(2)));
typedef unsigned u32x4 __attribute__((ext_vector_type(4)));
typedef __bf16 bf16x2_t __attribute__((ext_vector_type(2)));

constexpr int D = 2048, NB = 2, SEQ = 8192, CTXL = 256, NLAYER = 4;
constexpr int TL = NB * SEQ, TC = NB * CTXL, TT = TL + TC;
constexpr int INC = 4608, OFF_C = 1024, OFF_X = 2048, OFF_Q = 3072, OFF_K = 4096, OFF_V = 4352;
constexpr int NEXP = 16384;
#ifndef U_FMT
#define U_FMT 4
#endif
#ifndef V_FMT
#define V_FMT 4
#endif
constexpr int UROW = D * U_FMT / 8, VROW = D * V_FMT / 8;
constexpr float LN_EPS = 1e-6f;
constexpr float DN_ALPHA = 1.681792830507429f;
constexpr float QSCALE = 0.08838834764831845f * 1.4426950408889634f;
constexpr float LOG2E = 1.4426950408889634f;

constexpr size_t MiB = 1u << 20;
constexpr size_t WS_CTL = 0, CTL_ZERO_BYTES = 1 * MiB;
constexpr size_t WS_MODS = 1 * MiB;
constexpr size_t WS_ROPE = 2 * MiB;
constexpr size_t WS_KBD = 3 * MiB;
constexpr size_t WS_WQR = 8 * MiB;
constexpr size_t WS_WINT = 40 * MiB;
constexpr size_t WS_WOUTT = 112 * MiB;
constexpr size_t WS_WEFFT = 144 * MiB;
constexpr size_t WS_X = 176 * MiB;
constexpr size_t WS_H = 308 * MiB;
constexpr size_t WS_PROJ = 374 * MiB;
constexpr size_t WS_MIX = 523 * MiB;
constexpr size_t WS_SC = 589 * MiB;
constexpr size_t WS_UT = 721 * MiB;
constexpr size_t WS_VT = 849 * MiB;
constexpr size_t WS_US = 977 * MiB;
constexpr size_t WS_VS = 978 * MiB;
constexpr size_t WS_END = 979 * MiB;

constexpr int CW_BAR = 4096;

namespace pg8 {
constexpr int BM = 256, BK = 64, HALF = 128, HTB = HALF * BK * 2, STAGE_BYTES = 8 * HTB, NXCD = 8, WGM = 8;
__host__ __device__ __forceinline__ int lds_byte(int r, int c) { const int st = (r >> 4) * 2 + (c >> 5), rr = r & 15, cc = c & 31, ob = rr * 64 + cc * 2; return st * 1024 + (ob ^ (((ob >> 9) & 1) << 5)); }
__host__ __device__ __forceinline__ void stage_rc(int b, int& R, int& C) { const int st = b / 1024, sb = b % 1024, swz = sb ^ (((sb >> 9) & 1) << 5); R = (st >> 1) * 16 + swz / 64; C = (st & 1) * 32 + (swz % 64) / 2; }
__host__ __device__ __forceinline__ int perm32(int rho) { const int n = rho >> 4, i = rho & 15; return 8 * (i >> 2) + 4 * n + (i & 3); }

struct Unit { int pm, pn; };
struct Gemm { const bf16_t* A; const bf16_t* Bt; int M, N, K; };

struct StaticOrder {
    int nM, nN, nwg, G, c;
    __host__ __device__ void init(int M, int N, int G_, int c_) { nM = M / BM; nN = N / BM; nwg = nM * nN; G = G_; c = c_; }
    __host__ __device__ bool next(int i, Unit& u) const {
        const long L = (long)i * G + c; if (L >= nwg) return false;
        int wgid = (int)L; { const int q = nwg / NXCD, r = nwg % NXCD, xcd = wgid % NXCD, off = wgid / NXCD; wgid = (xcd < r ? xcd * (q + 1) : r * (q + 1) + (xcd - r) * q) + off; }
        const int nig = WGM * nN, gid = wgid / nig, fm = gid * WGM, gsz = (nM - fm) < WGM ? (nM - fm) : WGM;
        u.pm = fm + ((wgid % nig) % gsz); u.pn = (wgid % nig) / gsz; return true;
    }
    __device__ __forceinline__ int btile(const Unit& u) const { return u.pn; }
    __device__ __forceinline__ void a_ready(const Unit&) const {}
    __device__ __forceinline__ void done(const Unit&) const {}
};
struct BatchOrder {
    int G, c;
    __device__ bool next(int i, Unit& u) const { const int L = i * G + c; if (L >= 256) return false; u.pm = L >> 3; u.pn = L & 7; return true; }
    __device__ __forceinline__ int btile(const Unit& u) const { return u.pm * 8 + u.pn; }
    __device__ __forceinline__ void a_ready(const Unit&) const {}
    __device__ __forceinline__ void done(const Unit&) const {}
};

__device__ __forceinline__ unsigned cvt_pk_bf16(float lo, float hi) { f32x2 x = {lo, hi}; bf16x2_t y = __builtin_convertvector(x, bf16x2_t); return __builtin_bit_cast(unsigned, y); }

struct EpiBf16 {
    static constexpr bool PERM = true;
    bf16_t* O; int ldc;
    __device__ __forceinline__ void operator()(const f32x4 (&acc)[2][2][4][2], const Unit& u, int wr, int wc, int fr, int fq) const {
        const int row0 = u.pm * BM + wr * 64 + fr, col0 = u.pn * BM + wc * 32 + 8 * fq;
#pragma unroll
        for (int ai = 0; ai < 2; ++ai)
#pragma unroll
            for (int m = 0; m < 4; ++m) { bf16_t* rowp = O + (size_t)(row0 + ai * HALF + m * 16) * ldc + col0;
#pragma unroll
                for (int bj = 0; bj < 2; ++bj) { const f32x4 v0 = acc[ai][bj][m][0], v1 = acc[ai][bj][m][1];
                    u32x4 w; w.x = cvt_pk_bf16(v0[0], v0[1]); w.y = cvt_pk_bf16(v0[2], v0[3]); w.z = cvt_pk_bf16(v1[0], v1[1]); w.w = cvt_pk_bf16(v1[2], v1[3]);
                    *(u32x4*)(rowp + bj * HALF) = w; } }
    }
};
struct EpiF32 {
    static constexpr bool PERM = false;
    float* C; int ldc;
    __device__ __forceinline__ void operator()(const f32x4 (&acc)[2][2][4][2], const Unit& u, int wr, int wc, int fr, int fq) const {
        const int row0 = u.pm * BM + wr * 64 + fr, col0 = u.pn * BM + wc * 32 + 4 * fq;
#pragma unroll
        for (int ai = 0; ai < 2; ++ai)
#pragma unroll
            for (int m = 0; m < 4; ++m) { float* rowp = C + (size_t)(row0 + ai * HALF + m * 16) * ldc + col0;
#pragma unroll
                for (int bj = 0; bj < 2; ++bj)
#pragma unroll
                    for (int n = 0; n < 2; ++n) *(f32x4*)(rowp + bj * HALF + n * 16) = acc[ai][bj][m][n]; }
    }
};
struct EpiResid {
    static constexpr bool PERM = true;
    const float* x32_lat; const float* x32_ctx;
    bf16_t* X; const float* gate;
    __device__ __forceinline__ void operator()(const f32x4 (&acc)[2][2][4][2], const Unit& u, int wr, int wc, int fr, int fq) const {
        const int rt = u.pm * BM;
        const int mr = rt < TL ? rt / SEQ : 2;
        const int row0 = rt + wr * 64 + fr, col0 = u.pn * BM + wc * 32 + 8 * fq;
        f32x4 gv[2][2];
#pragma unroll
        for (int bj = 0; bj < 2; ++bj)
#pragma unroll
            for (int n = 0; n < 2; ++n) gv[bj][n] = *(const f32x4*)(gate + (size_t)mr * 12288 + col0 + bj * HALF + 4 * n);
#pragma unroll
        for (int ai = 0; ai < 2; ++ai)
#pragma unroll
            for (int m = 0; m < 4; ++m) { const int row = row0 + ai * HALF + m * 16;
#pragma unroll
                for (int bj = 0; bj < 2; ++bj) {
                    f32x4 x0, x1;
                    if (x32_lat) { const float* xp = (row < TL ? x32_lat + (size_t)row * D : x32_ctx + (size_t)(row - TL) * D) + col0 + bj * HALF; x0 = *(const f32x4*)xp; x1 = *(const f32x4*)(xp + 4); }
                    else { const u32x4 w = *(const u32x4*)(X + (size_t)row * D + col0 + bj * HALF);
                        x0 = (f32x4){__uint_as_float(w.x << 16), __uint_as_float(w.x & 0xffff0000u), __uint_as_float(w.y << 16), __uint_as_float(w.y & 0xffff0000u)};
                        x1 = (f32x4){__uint_as_float(w.z << 16), __uint_as_float(w.z & 0xffff0000u), __uint_as_float(w.w << 16), __uint_as_float(w.w & 0xffff0000u)}; }
                    const f32x4 r0 = x0 * DN_ALPHA + gv[bj][0] * acc[ai][bj][m][0], r1 = x1 * DN_ALPHA + gv[bj][1] * acc[ai][bj][m][1];
                    u32x4 o; o.x = cvt_pk_bf16(r0[0], r0[1]); o.y = cvt_pk_bf16(r0[2], r0[3]); o.z = cvt_pk_bf16(r1[0], r1[1]); o.w = cvt_pk_bf16(r1[2], r1[3]);
                    *(u32x4*)(X + (size_t)row * D + col0 + bj * HALF) = o; } }
    }
};

template <class Epi, class Sched, bool ALIGN_EPI = false, bool SP2 = false>
__device__ __forceinline__ void gemm_phase(LAS unsigned char* lds, const Gemm g, const Sched& S, const Epi& E) {
    int tid = threadIdx.x; asm volatile("" : "+v"(tid));
    const int wid = __builtin_amdgcn_readfirstlane(tid >> 6), lane = tid & 63, wr = wid >> 2, wc = wid & 3, fr = lane & 15, fq = lane >> 4;
    const int K = g.K, nt = K / BK;
    unsigned voffA[2], voffB[2];
#pragma unroll
    for (int i = 0; i < 2; ++i) { int R, C; stage_rc(tid * 16 + i * 8192, R, C); const int Rb = Epi::PERM ? ((R & ~31) + perm32(R & 31)) : R;
        voffA[i] = (unsigned)(R * K + C) * 2u; voffB[i] = (unsigned)(Rb * K + C) * 2u; }
    const size_t kstep = (size_t)(BK * 2);
    const size_t hstep = (size_t)HALF * K * 2;
    const size_t tstep = 2 * hstep;
    const unsigned ldsw = (unsigned)wid * 1024u;
    const int aoff = lds_byte(wr * 64 + fr, fq * 8), boff = lds_byte(wc * 32 + fr, fq * 8);
#define PG8_SA(b, h) (((b) * 2 + (h)) * HTB)
#define PG8_SB(b, h) ((4 + (b) * 2 + (h)) * HTB)
#define PG8_STAGE(bufoff, gbase, voff) do { _Pragma("unroll") for (int _i = 0; _i < 2; ++_i) \
        __builtin_amdgcn_global_load_lds((const unsigned*)((const char*)(gbase) + (voff)[_i]), (LAS unsigned*)(lds + (bufoff) + ldsw + _i * 8192), 16, 0, 0); } while (0)
#define PG8_LDA(dst, b, h) do { _Pragma("unroll") for (int m = 0; m < 4; ++m) _Pragma("unroll") for (int k = 0; k < 2; ++k) dst[m][k] = *(const LAS bf16x8*)(lds + PG8_SA(b, h) + aoff + m * 2048 + k * 1024); } while (0)
#define PG8_LDB(dst, b, h) do { _Pragma("unroll") for (int n = 0; n < 2; ++n) _Pragma("unroll") for (int k = 0; k < 2; ++k) dst[n][k] = *(const LAS bf16x8*)(lds + PG8_SB(b, h) + boff + n * 2048 + k * 1024); } while (0)
#define PG8_MMA(ai, bj, At, Bt) do { __builtin_amdgcn_s_setprio(1); _Pragma("unroll") for (int m = 0; m < 4; ++m) _Pragma("unroll") for (int n = 0; n < 2; ++n) _Pragma("unroll") for (int k = 0; k < 2; ++k) \
        acc[ai][bj][m][n] = __builtin_amdgcn_mfma_f32_16x16x32_bf16(Bt[n][k], At[m][k], acc[ai][bj][m][n], 0, 0, 0); __builtin_amdgcn_s_setprio(0); } while (0)
#define PG8_WAIT_V(n) asm volatile("s_waitcnt vmcnt(" #n ")" ::: "memory")
#define PG8_WAIT_L(n) asm volatile("s_waitcnt lgkmcnt(" #n ")" ::: "memory")
#define PG8_BAR __builtin_amdgcn_s_barrier()
#define PG8_SCHED __builtin_amdgcn_sched_barrier(0)
    Unit cur, nxt; int ui = 0;
    if (!S.next(0, cur)) return;
    f32x4 acc[2][2][4][2];
#pragma unroll
    for (int a = 0; a < 2; ++a)
#pragma unroll
        for (int b = 0; b < 2; ++b)
#pragma unroll
            for (int m = 0; m < 4; ++m)
#pragma unroll
                for (int n = 0; n < 2; ++n) acc[a][b][m][n] = (f32x4){0.f, 0.f, 0.f, 0.f};
    bf16x8 At[4][2], B0[2][2], B1[2][2];
    const char* cA = (const char*)g.A + (size_t)cur.pm * tstep; const char* cB = (const char*)g.Bt + (size_t)S.btile(cur) * tstep;
    S.a_ready(cur);
    if constexpr (SP2) {
        PG8_STAGE(PG8_SB(0, 0), cB, voffB); PG8_STAGE(PG8_SB(0, 1), cB + hstep, voffB); PG8_STAGE(PG8_SA(0, 0), cA, voffA); PG8_STAGE(PG8_SA(0, 1), cA + hstep, voffA);
        if (wr == 1) PG8_BAR;
        PG8_WAIT_V(2); PG8_BAR;
        PG8_STAGE(PG8_SB(1, 0), cB + kstep, voffB); PG8_STAGE(PG8_SA(1, 0), cA + kstep, voffA); PG8_STAGE(PG8_SB(1, 1), cB + hstep + kstep, voffB);
        PG8_WAIT_V(6); PG8_BAR;
    } else {
        PG8_STAGE(PG8_SB(0, 0), cB, voffB); PG8_STAGE(PG8_SA(0, 0), cA, voffA); PG8_STAGE(PG8_SB(0, 1), cB + hstep, voffB); PG8_STAGE(PG8_SA(0, 1), cA + hstep, voffA);
        if (wr == 1) PG8_BAR;
        PG8_WAIT_V(4); PG8_BAR;
        PG8_STAGE(PG8_SB(1, 0), cB + kstep, voffB); PG8_STAGE(PG8_SA(1, 0), cA + kstep, voffA); PG8_STAGE(PG8_SB(1, 1), cB + hstep + kstep, voffB);
        PG8_WAIT_V(6); PG8_BAR;
    }
    for (;;) {
        const bool has_next = S.next(ui + 1, nxt);
        const char* nA = has_next ? (const char*)g.A + (size_t)nxt.pm * tstep : cA; const char* nB = has_next ? (const char*)g.Bt + (size_t)S.btile(nxt) * tstep : cB;
        for (int t = 0; t < nt; t += 2) {
            const bool last = (t == nt - 2);
            const char* a1 = cA + (size_t)(t + 1) * kstep;
            const char* a2 = last ? nA : cA + (size_t)(t + 2) * kstep; const char* b2 = last ? nB : cB + (size_t)(t + 2) * kstep;
            const char* a3 = a2 + kstep; const char* b3 = b2 + kstep;
            if (last && has_next) S.a_ready(nxt);
            if constexpr (SP2) {
            PG8_LDB(B0, 0, 0); PG8_LDB(B1, 0, 1); PG8_SCHED; PG8_LDA(At, 0, 0); PG8_STAGE(PG8_SA(1, 1), a1 + hstep, voffA);
            PG8_WAIT_V(8); PG8_WAIT_L(0); PG8_BAR; PG8_MMA(0, 0, At, B0); PG8_MMA(0, 1, At, B1); PG8_BAR; PG8_SCHED;
            PG8_LDA(At, 0, 1); PG8_STAGE(PG8_SB(0, 0), b2, voffB); PG8_STAGE(PG8_SB(0, 1), b2 + hstep, voffB); PG8_STAGE(PG8_SA(0, 0), a2, voffA);
            PG8_WAIT_V(8); PG8_WAIT_L(0); PG8_BAR; PG8_MMA(1, 0, At, B0); PG8_MMA(1, 1, At, B1); PG8_BAR; PG8_SCHED;
            PG8_LDB(B0, 1, 0); PG8_LDB(B1, 1, 1); PG8_SCHED; PG8_LDA(At, 1, 0); PG8_STAGE(PG8_SA(0, 1), a2 + hstep, voffA);
            PG8_WAIT_V(8); PG8_WAIT_L(0); PG8_BAR; PG8_MMA(0, 0, At, B0); PG8_MMA(0, 1, At, B1); PG8_BAR; PG8_SCHED;
            PG8_LDA(At, 1, 1); PG8_STAGE(PG8_SB(1, 0), b3, voffB); PG8_STAGE(PG8_SB(1, 1), b3 + hstep, voffB); PG8_STAGE(PG8_SA(1, 0), a3, voffA);
            PG8_WAIT_V(8); PG8_WAIT_L(0); PG8_BAR; PG8_MMA(1, 0, At, B0); PG8_MMA(1, 1, At, B1); PG8_BAR; PG8_SCHED;
            } else {
            PG8_LDB(B0, 0, 0); PG8_SCHED; PG8_LDA(At, 0, 0); PG8_STAGE(PG8_SA(1, 1), a1 + hstep, voffA);
            PG8_WAIT_L(8); PG8_BAR; PG8_WAIT_L(0); PG8_MMA(0, 0, At, B0); PG8_BAR; PG8_SCHED;
            PG8_LDB(B1, 0, 1); PG8_STAGE(PG8_SB(0, 0), b2, voffB);
            PG8_BAR; PG8_WAIT_L(0); PG8_MMA(0, 1, At, B1); PG8_BAR;
            PG8_LDA(At, 0, 1); PG8_STAGE(PG8_SA(0, 0), a2, voffA);
            PG8_BAR; PG8_WAIT_L(0); PG8_MMA(1, 0, At, B0); PG8_BAR; PG8_SCHED;
            PG8_STAGE(PG8_SB(0, 1), b2 + hstep, voffB);
            PG8_WAIT_V(6); PG8_BAR; PG8_MMA(1, 1, At, B1); PG8_BAR;
            PG8_LDB(B0, 1, 0); PG8_SCHED; PG8_LDA(At, 1, 0); PG8_STAGE(PG8_SA(0, 1), a2 + hstep, voffA);
            PG8_WAIT_L(8); PG8_BAR; PG8_WAIT_L(0); PG8_MMA(0, 0, At, B0); PG8_BAR; PG8_SCHED;
            PG8_LDB(B1, 1, 1); PG8_STAGE(PG8_SB(1, 0), b3, voffB);
            PG8_BAR; PG8_WAIT_L(0); PG8_MMA(0, 1, At, B1); PG8_BAR;
            PG8_LDA(At, 1, 1); PG8_STAGE(PG8_SA(1, 0), a3, voffA);
            PG8_BAR; PG8_WAIT_L(0); PG8_MMA(1, 0, At, B0); PG8_BAR; PG8_SCHED;
            PG8_STAGE(PG8_SB(1, 1), b3 + hstep, voffB);
            PG8_WAIT_V(6); PG8_BAR; PG8_MMA(1, 1, At, B1); PG8_BAR;
            }
        }
        if constexpr (ALIGN_EPI) { if (wr == 0) PG8_BAR; }
        E(acc, cur, wr, wc, fr, fq); S.done(cur);
        if (!has_next) break;
#pragma unroll
        for (int a = 0; a < 2; ++a)
#pragma unroll
            for (int b = 0; b < 2; ++b)
#pragma unroll
                for (int m = 0; m < 4; ++m)
#pragma unroll
                    for (int n = 0; n < 2; ++n) acc[a][b][m][n] = (f32x4){0.f, 0.f, 0.f, 0.f};
        cur = nxt; cA = nA; cB = nB; ++ui;
        if constexpr (ALIGN_EPI) { if (wr == 1) PG8_BAR; }
    }
    PG8_WAIT_V(0);
    if constexpr (!ALIGN_EPI) { if (wr == 0) PG8_BAR; }
    PG8_BAR;
#undef PG8_SA
#undef PG8_SB
#undef PG8_STAGE
#undef PG8_LDA
#undef PG8_LDB
#undef PG8_MMA
#undef PG8_WAIT_V
#undef PG8_WAIT_L
#undef PG8_BAR
#undef PG8_SCHED
}
}

#define XB_TMO      128
#define XB_XCNT(j)  (256  + 64 * (j))
#define XB_XSUB(j)  (1280 + 64 * (j))
#define XB_XGEN(j)  (2304 + 64 * (j))
#define XB_TOP      3328
#define XB_TOPGEN   3392
#define XCD_BAR_WORDS 3456
#define XB_SPIN_CAP (1u << 18)

__device__ __forceinline__ unsigned xb_ld(unsigned* p)              { return __hip_atomic_load(p, __ATOMIC_RELAXED, __HIP_MEMORY_SCOPE_AGENT); }
__device__ __forceinline__ unsigned xb_add(unsigned* p, unsigned v) { return __hip_atomic_fetch_add(p, v, __ATOMIC_RELAXED, __HIP_MEMORY_SCOPE_AGENT); }
__device__ __forceinline__ unsigned xb_xcc_id() { return (unsigned)__builtin_amdgcn_s_getreg((3 << 11) | 20) & 0xFu; }
#define XB_SPIN(cond, bar) do { unsigned _sp = 0; while (cond) { __builtin_amdgcn_s_sleep(1); \
    if ((++_sp & 255u) == 0u) { if (xb_ld(&(bar)[XB_TMO])) break; if (_sp > XB_SPIN_CAP) { atomicAdd(&(bar)[XB_TMO], 1u); break; } } } } while (0)

struct XcdBarrier { unsigned* bar; unsigned x; volatile LAS unsigned* st; };

__device__ __forceinline__ XcdBarrier xcd_barrier_post(unsigned* bar, volatile LAS unsigned* st) {
    XcdBarrier b; b.bar = bar; b.x = xb_xcc_id(); b.st = st;
    if (threadIdx.x == 0) (void)xb_add(&bar[XB_XCNT(b.x)], 1u);
    return b;
}
__device__ __forceinline__ void xcd_barrier_complete(unsigned* bar, unsigned x, unsigned& nloc, unsigned& nx) {
    const unsigned G = gridDim.x * gridDim.y * gridDim.z;
    unsigned sum, cnt, mine, sp = 0u;
    for (;;) {
        sum = 0u; cnt = 0u; mine = 0u;
#pragma unroll
        for (unsigned j = 0; j < 16; ++j) { const unsigned c = xb_ld(&bar[XB_XCNT(j)]); sum += c; cnt += (c > 0u) ? 1u : 0u; mine = (j == x) ? c : mine; }
        if (sum == G) break;
        __builtin_amdgcn_s_sleep(1);
        if ((++sp & 255u) == 0u) { if (xb_ld(&bar[XB_TMO])) break; if (sp > XB_SPIN_CAP) { atomicAdd(&bar[XB_TMO], 1u); break; } }
    }
    nloc = mine > 0u ? mine : 1u; nx = cnt > 0u ? cnt : 1u;
}
__device__ __forceinline__ void xcd_barrier(const XcdBarrier& b) {
    asm volatile("s_waitcnt vmcnt(0)" ::: "memory");
    __syncthreads();
    if (threadIdx.x == 0) {
        unsigned* bar = b.bar;
        __builtin_amdgcn_s_waitcnt(0);
        unsigned nloc = b.st[0], nx = b.st[1];
        if (nloc == 0u) { xcd_barrier_complete(bar, b.x, nloc, nx); b.st[0] = nloc; b.st[1] = nx; }
        const unsigned old = xb_add(&bar[XB_XSUB(b.x)], 1u);
        const unsigned gen = old / nloc;
        if (old + 1u == (gen + 1u) * nloc) {
            __builtin_amdgcn_fence(__ATOMIC_RELEASE, "agent");
            asm volatile("s_waitcnt vmcnt(0)" ::: "memory");
            const unsigned og = xb_add(&bar[XB_TOP], 1u);
            const unsigned tg = og / nx;
            if (og + 1u == (tg + 1u) * nx) xb_add(&bar[XB_TOPGEN], 1u);
            else XB_SPIN(xb_ld(&bar[XB_TOPGEN]) == tg, bar);
            __builtin_amdgcn_fence(__ATOMIC_ACQUIRE, "agent");
            xb_add(&bar[XB_XGEN(b.x)], 1u);
            asm volatile("s_waitcnt vmcnt(0)" ::: "memory");
        } else {
            XB_SPIN(xb_ld(&bar[XB_XGEN(b.x)]) == gen, bar);
            __builtin_amdgcn_fence(__ATOMIC_ACQUIRE, "agent");
            asm volatile("s_waitcnt vmcnt(0)" ::: "memory");
        }
    }
    __syncthreads();
}

constexpr int NWAVES = 8;
constexpr int RING_BYTES = 131072;
constexpr int LDSCTL_OFF = RING_BYTES, MISC_OFF = LDSCTL_OFF + 320;
constexpr int LDS_BYTES = 147456;
constexpr int NPHASE = 2 + 6 * NLAYER;

#define LDS_WAIT() asm volatile("s_waitcnt lgkmcnt(0)" ::: "memory")

struct Args { const float* in[20]; float* out; unsigned char* ws; int ph_lo, ph_hi, li, pad; };

#define CAS __attribute__((address_space(4)))
struct Frame {
    LAS unsigned char* lds;
    int tid, lane, wave, G, gw, NGW;
    const CAS unsigned char* ka;
    __device__ __forceinline__ const float* x() const { return *(const float* const CAS*)(ka + 0); }
    __device__ __forceinline__ const float* c() const { return *(const float* const CAS*)(ka + 8); }
    __device__ __forceinline__ const float* ctx() const { return *(const float* const CAS*)(ka + 16); }
    __device__ __forceinline__ const float* c_ctx() const { return *(const float* const CAS*)(ka + 24); }
    __device__ __forceinline__ const float* w_ada() const { return *(const float* const CAS*)(ka + 32); }
    __device__ __forceinline__ const float* b_ada() const { return *(const float* const CAS*)(ka + 40); }
    __device__ __forceinline__ const float* w_in() const { return *(const float* const CAS*)(ka + 48); }
    __device__ __forceinline__ const float* conv_w() const { return *(const float* const CAS*)(ka + 56); }
    __device__ __forceinline__ const float* sink() const { return *(const float* const CAS*)(ka + 64); }
    __device__ __forceinline__ const float* g_attn() const { return *(const float* const CAS*)(ka + 72); }
    __device__ __forceinline__ const float* g_conv() const { return *(const float* const CAS*)(ka + 80); }
    __device__ __forceinline__ const float* w_out() const { return *(const float* const CAS*)(ka + 88); }
    __device__ __forceinline__ const float* ln1_g() const { return *(const float* const CAS*)(ka + 96); }
    __device__ __forceinline__ const float* ln1_b() const { return *(const float* const CAS*)(ka + 104); }
    __device__ __forceinline__ const float* wq() const { return *(const float* const CAS*)(ka + 112); }
    __device__ __forceinline__ const float* keys() const { return *(const float* const CAS*)(ka + 120); }
    __device__ __forceinline__ const float* pu() const { return *(const float* const CAS*)(ka + 128); }
    __device__ __forceinline__ const float* pv() const { return *(const float* const CAS*)(ka + 136); }
    __device__ __forceinline__ const float* ln2_g() const { return *(const float* const CAS*)(ka + 144); }
    __device__ __forceinline__ const float* ln2_b() const { return *(const float* const CAS*)(ka + 152); }
    __device__ __forceinline__ float* out() const { return *(float* const CAS*)(ka + 160); }
    __device__ __forceinline__ unsigned char* ws() const { return *(unsigned char* const CAS*)(ka + 168); }
    __device__ __forceinline__ float* MODS() const { return (float*)(ws() + WS_MODS); }
    __device__ __forceinline__ float* ROPE() const { return (float*)(ws() + WS_ROPE); }
    __device__ __forceinline__ bf16_t* X() const { return (bf16_t*)(ws() + WS_X); }
    __device__ __forceinline__ float* SC() const { return (float*)(ws() + WS_SC); }
    __device__ __forceinline__ bf16_t* KBD() const { return (bf16_t*)(ws() + WS_KBD); }
    __device__ __forceinline__ bf16_t* WQR() const { return (bf16_t*)(ws() + WS_WQR); }
    __device__ __forceinline__ bf16_t* WINT() const { return (bf16_t*)(ws() + WS_WINT); }
    __device__ __forceinline__ bf16_t* WOUTT() const { return (bf16_t*)(ws() + WS_WOUTT); }
    __device__ __forceinline__ bf16_t* WEFFT() const { return (bf16_t*)(ws() + WS_WEFFT); }
    __device__ __forceinline__ bf16_t* H() const { return (bf16_t*)(ws() + WS_H); }
    __device__ __forceinline__ bf16_t* PROJ() const { return (bf16_t*)(ws() + WS_PROJ); }
    __device__ __forceinline__ bf16_t* MIX() const { return (bf16_t*)(ws() + WS_MIX); }
    __device__ __forceinline__ unsigned char* UT() const { return (unsigned char*)(ws() + WS_UT); }
    __device__ __forceinline__ unsigned char* VT() const { return (unsigned char*)(ws() + WS_VT); }
    __device__ __forceinline__ float* US() const { return (float*)(ws() + WS_US); }
    __device__ __forceinline__ float* VS() const { return (float*)(ws() + WS_VS); }
};

__device__ __forceinline__ void frame_ids(Frame& F) {
    int tz = threadIdx.x; asm volatile("" : "+v"(tz));
    F.tid = tz; F.lane = tz & 63; F.wave = __builtin_amdgcn_readfirstlane(tz >> 6);
    F.gw = blockIdx.x * NWAVES + F.wave;
    const CAS unsigned char* k = (const CAS unsigned char*)__builtin_amdgcn_kernarg_segment_ptr(); asm volatile("" : "+s"(k)); F.ka = k;
}
template <int CTRL> __device__ __forceinline__ int dpp_i(int v) { return __builtin_amdgcn_update_dpp(0, v, CTRL, 0xf, 0xf, true); }
template <int CTRL> __device__ __forceinline__ float dpp_f(float v) { return __int_as_float(dpp_i<CTRL>(__float_as_int(v))); }
constexpr int DPP_XOR1 = 0xB1, DPP_XOR2 = 0x4E, DPP_HMIRROR = 0x141, DPP_ROR4 = 0x124, DPP_ROR8 = 0x128;
__device__ __forceinline__ float wave_sum_u(float v) {
    v += dpp_f<DPP_XOR1>(v); v += dpp_f<DPP_XOR2>(v); v += dpp_f<DPP_ROR4>(v); v += dpp_f<DPP_ROR8>(v);
    const float r0 = __int_as_float(__builtin_amdgcn_readlane(__float_as_int(v), 0)), r1 = __int_as_float(__builtin_amdgcn_readlane(__float_as_int(v), 16));
    const float r2 = __int_as_float(__builtin_amdgcn_readlane(__float_as_int(v), 32)), r3 = __int_as_float(__builtin_amdgcn_readlane(__float_as_int(v), 48));
    return (r0 + r1) + (r2 + r3);
}
__device__ __forceinline__ float wave_max_u(float v) {
    v = fmaxf(v, dpp_f<DPP_XOR1>(v)); v = fmaxf(v, dpp_f<DPP_XOR2>(v)); v = fmaxf(v, dpp_f<DPP_ROR4>(v)); v = fmaxf(v, dpp_f<DPP_ROR8>(v));
    const float r0 = __int_as_float(__builtin_amdgcn_readlane(__float_as_int(v), 0)), r1 = __int_as_float(__builtin_amdgcn_readlane(__float_as_int(v), 16));
    const float r2 = __int_as_float(__builtin_amdgcn_readlane(__float_as_int(v), 32)), r3 = __int_as_float(__builtin_amdgcn_readlane(__float_as_int(v), 48));
    return fmaxf(fmaxf(r0, r1), fmaxf(r2, r3));
}
__device__ __forceinline__ float wave_sum(float v) { return wave_sum_u(v); }
__device__ __forceinline__ unsigned pk2(float lo, float hi) { return pg8::cvt_pk_bf16(lo, hi); }
__device__ __forceinline__ float bf_lo(unsigned u) { return __uint_as_float(u << 16); }
__device__ __forceinline__ float bf_hi(unsigned u) { return __uint_as_float(u & 0xffff0000u); }
__device__ __forceinline__ int modrow(int t) { return t < TL ? t / SEQ : 2; }

__device__ __forceinline__ void transpose_item(const float* W, int K, int N, bf16_t* WT, LAS float* scr, int item, int lane) {
    const int nblk = N / 32, kb = item / nblk, nb = item % nblk, k0 = 64 * kb, n0 = 32 * nb;
#pragma unroll 8
    for (int i = 0; i < 32; ++i) { const int kk = 2 * i + (lane >> 5); scr[kk * 33 + (lane & 31)] = W[(size_t)(k0 + kk) * N + n0 + (lane & 31)]; }
    LDS_WAIT(); asm volatile("" ::: "memory");
    const int c = lane & 7;
#pragma unroll
    for (int j = 0; j < 4; ++j) { const int n = (lane >> 3) + 8 * j; const LAS float* s = scr + (8 * c) * 33 + n;
        u32x4 o; o.x = pk2(s[0 * 33], s[1 * 33]); o.y = pk2(s[2 * 33], s[3 * 33]); o.z = pk2(s[4 * 33], s[5 * 33]); o.w = pk2(s[6 * 33], s[7 * 33]);
        *(u32x4*)(WT + (size_t)(n0 + n) * K + k0 + 8 * c) = o; }
    LDS_WAIT(); asm volatile("" ::: "memory");
}

__device__ __forceinline__ void cvt_row_bf16(const float* src, bf16_t* dst, int lane) {
    const f32x4* s = (const f32x4*)src + lane; u32x2* d = (u32x2*)dst + lane;
    f32x4 v[8];
#pragma unroll
    for (int j = 0; j < 8; ++j) v[j] = __builtin_nontemporal_load(s + 64 * j);
#pragma unroll
    for (int j = 0; j < 8; ++j) { u32x2 o; o.x = pk2(v[j].x, v[j].y); o.y = pk2(v[j].z, v[j].w); d[64 * j] = o; }
}

struct RowF32 { f32x4 v[4][2]; };
__device__ __forceinline__ void row_load_nt(RowF32& R, const float* src, int lane) {
    const f32x4* s = (const f32x4*)src + 2 * lane;
#pragma unroll
    for (int j = 0; j < 4; ++j) { R.v[j][0] = __builtin_nontemporal_load(s + 128 * j); R.v[j][1] = __builtin_nontemporal_load(s + 128 * j + 1); }
}
template <int FMT>
__device__ __forceinline__ void cvt_row_lp(const RowF32& R, unsigned char* dst, float* inv, int lane) {
    constexpr float QMAX = FMT == 8 ? 224.f : 6.f;
    float am = 0.f;
#pragma unroll
    for (int j = 0; j < 4; ++j)
#pragma unroll
        for (int q = 0; q < 2; ++q) am = fmaxf(fmaxf(am, fmaxf(fabsf(R.v[j][q].x), fabsf(R.v[j][q].y))), fmaxf(fabsf(R.v[j][q].z), fabsf(R.v[j][q].w)));
    am = wave_max_u(am);
    const float sc = am > 0.f ? QMAX / am : 1.f;
#pragma unroll
    for (int j = 0; j < 4; ++j) {
        if constexpr (FMT == 8) {
            u32x2 w;
#pragma unroll
            for (int q = 0; q < 2; ++q) { int t = __builtin_amdgcn_cvt_pk_fp8_f32(R.v[j][q].x * sc, R.v[j][q].y * sc, 0, false); t = __builtin_amdgcn_cvt_pk_fp8_f32(R.v[j][q].z * sc, R.v[j][q].w * sc, t, true); w[q] = (unsigned)t; }
            *((u32x2*)dst + lane + 64 * j) = w;
        } else {
            unsigned w = 0u;
            w = __builtin_amdgcn_cvt_scalef32_pk_fp4_f32(w, R.v[j][0].x * sc, R.v[j][0].y * sc, 1.0f, 0);
            w = __builtin_amdgcn_cvt_scalef32_pk_fp4_f32(w, R.v[j][0].z * sc, R.v[j][0].w * sc, 1.0f, 1);
            w = __builtin_amdgcn_cvt_scalef32_pk_fp4_f32(w, R.v[j][1].x * sc, R.v[j][1].y * sc, 1.0f, 2);
            w = __builtin_amdgcn_cvt_scalef32_pk_fp4_f32(w, R.v[j][1].z * sc, R.v[j][1].w * sc, 1.0f, 3);
            *((unsigned*)dst + lane + 64 * j) = w;
        }
    }
    if (lane == 0) *inv = am > 0.f ? am * (1.f / QMAX) : 1.f;
}
template <int FMT> struct LpRow;
template <> struct LpRow<8> { u32x4 a, b;
    __device__ __forceinline__ void load(const unsigned char* rowp, int lane) { a = *(const u32x4*)(rowp + 32 * lane); b = *(const u32x4*)(rowp + 32 * lane + 16); }
    template <class Fn> __device__ __forceinline__ void each(Fn&& f) const {
#pragma unroll
        for (int w = 0; w < 4; ++w) { const f32x2 l0 = __builtin_amdgcn_cvt_pk_f32_fp8((int)a[w], false), h0 = __builtin_amdgcn_cvt_pk_f32_fp8((int)a[w], true);
            f(4 * w, l0.x, l0.y); f(4 * w + 2, h0.x, h0.y); }
#pragma unroll
        for (int w = 0; w < 4; ++w) { const f32x2 l0 = __builtin_amdgcn_cvt_pk_f32_fp8((int)b[w], false), h0 = __builtin_amdgcn_cvt_pk_f32_fp8((int)b[w], true);
            f(16 + 4 * w, l0.x, l0.y); f(16 + 4 * w + 2, h0.x, h0.y); }
    } };
template <> struct LpRow<4> { u32x4 a;
    __device__ __forceinline__ void load(const unsigned char* rowp, int lane) { a = *(const u32x4*)(rowp + 16 * lane); }
    template <class Fn> __device__ __forceinline__ void each(Fn&& f) const {
#pragma unroll
        for (int w = 0; w < 4; ++w) {
            const f32x2 d0 = __builtin_amdgcn_cvt_scalef32_pk_f32_fp4(a[w], 1.0f, 0), d1 = __builtin_amdgcn_cvt_scalef32_pk_f32_fp4(a[w], 1.0f, 1);
            const f32x2 d2 = __builtin_amdgcn_cvt_scalef32_pk_f32_fp4(a[w], 1.0f, 2), d3 = __builtin_amdgcn_cvt_scalef32_pk_f32_fp4(a[w], 1.0f, 3);
            f(8 * w, d0.x, d0.y); f(8 * w + 2, d1.x, d1.y); f(8 * w + 4, d2.x, d2.y); f(8 * w + 6, d3.x, d3.y); }
    } };

__device__ __forceinline__ void row_stats(const f32x4 (&v)[8], float& mean, float& rstd) {
    float s = 0.f;
#pragma unroll
    for (int j = 0; j < 8; ++j) s += (v[j].x + v[j].y) + (v[j].z + v[j].w);
    mean = wave_sum(s) * (1.f / D);
    float s2 = 0.f;
#pragma unroll
    for (int j = 0; j < 8; ++j) { const f32x4 d = v[j] - mean; s2 += (d.x * d.x + d.y * d.y) + (d.z * d.z + d.w * d.w); }
    rstd = 1.f / sqrtf(wave_sum(s2) * (1.f / D) + LN_EPS);
}
__device__ __forceinline__ void modulate_store(const f32x4 (&v)[8], const float* shift, const float* scale, bf16_t* dst, int lane) {
    float mean, rstd; row_stats(v, mean, rstd);
    u32x2* d = (u32x2*)dst + lane;
#pragma unroll
    for (int j = 0; j < 8; ++j) { const f32x4 sc = *((const f32x4*)scale + lane + 64 * j), sh = *((const f32x4*)shift + lane + 64 * j);
        const f32x4 y = (v[j] - mean) * rstd * (sc + 1.f) + sh;
        u32x2 o; o.x = pk2(y.x, y.y); o.y = pk2(y.z, y.w); d[64 * j] = o; }
}

__device__ __forceinline__ void p0a_prologue(Frame& F) {
    LAS float* condL = (LAS float*)F.lds;
    LAS float* red = (LAS float*)(F.lds + 24576);
    for (int i = F.tid; i < 3 * D; i += NWAVES * 64) { const int r = i / D, k = i % D; const float v = r < 2 ? F.c()[r * D + k] : F.c_ctx()[k]; condL[i] = v / (1.f + __expf(-v)); }
    __syncthreads();
    for (int item = blockIdx.x; item < 384; item += F.G) {
        const int l = item / 96, n0 = (item % 96) * 128;
        const float* wp = F.w_ada() + ((size_t)l * D + F.wave * 256) * 12288 + n0 + 2 * F.lane;
        f32x2 a0 = {0.f, 0.f}, a1 = {0.f, 0.f}, a2 = {0.f, 0.f};
#pragma unroll 8
        for (int k = 0; k < 256; ++k) { const f32x2 w = __builtin_nontemporal_load((const f32x2*)(wp + (size_t)k * 12288)); const int kk = F.wave * 256 + k;
            a0 += w * condL[kk]; a1 += w * condL[D + kk]; a2 += w * condL[2 * D + kk]; }
        LAS float* rp = red + F.wave * 384 + 2 * F.lane;
        rp[0] = a0.x; rp[1] = a0.y; rp[128] = a1.x; rp[129] = a1.y; rp[256] = a2.x; rp[257] = a2.y;
        __syncthreads();
        if (F.tid < 384) { const int r = F.tid / 128, n = F.tid % 128; float s = 0.f;
#pragma unroll
            for (int w = 0; w < 8; ++w) s += red[w * 384 + r * 128 + n];
            F.MODS()[((size_t)l * 3 + r) * 12288 + n0 + n] = s + F.b_ada()[(size_t)l * 12288 + n0 + n]; }
        __syncthreads();
    }
    LAS float* scr = (LAS float*)(F.lds + 40960 + F.wave * 8448);
    constexpr int I_IN = (D / 64) * (INC / 32), I_OUT = (D / 64) * (D / 32);
    for (int it = F.gw; it < NLAYER * (I_IN + I_OUT); it += F.NGW) {
        const int l = it / (I_IN + I_OUT); int r = it % (I_IN + I_OUT);
        if (r < I_IN) transpose_item(F.w_in() + (size_t)l * D * INC, D, INC, F.WINT() + (size_t)l * INC * D, scr, r, F.lane);
        else transpose_item(F.w_out() + (size_t)l * D * D, D, D, F.WOUTT() + (size_t)l * D * D, scr, r - I_IN, F.lane);
    }
    for (int row = F.gw; row < NLAYER * D; row += F.NGW) {
        const int l = row / D, c = row % D; const f32x4* s = (const f32x4*)(F.wq() + (size_t)row * D) + F.lane;
#pragma unroll
        for (int j = 0; j < 8; ++j) { const f32x4 v = s[64 * j]; u32x2 o; o.x = pk2(v.x, v.y); o.y = pk2(v.z, v.w);
            *((u32x2*)(F.WQR() + ((size_t)(l * 8 + j) * D + c) * 256) + F.lane) = o; }
    }
    for (int row = F.gw; row < 32 * 256; row += F.NGW) {
        const int lh = row >> 8, pk = row & 255, p = pk >> 7;
        u32x2 o = {0u, 0u};
        if ((F.lane >> 5) == p) { const f32x4 v = *((const f32x4*)(F.keys() + ((size_t)lh * 256 + pk) * 128) + (F.lane & 31)); o.x = pk2(v.x, v.y); o.y = pk2(v.z, v.w); }
        *((u32x2*)(F.KBD() + (size_t)row * 256) + F.lane) = o;
    }
    {
        RowF32 ru, rv, nu, nv;
        int row = F.gw;
        if (row < NLAYER * NEXP) { row_load_nt(ru, F.pu() + (size_t)row * D, F.lane); row_load_nt(rv, F.pv() + (size_t)row * D, F.lane); }
        while (row < NLAYER * NEXP) {
            const int nrow = row + F.NGW;
            if (nrow < NLAYER * NEXP) { row_load_nt(nu, F.pu() + (size_t)nrow * D, F.lane); row_load_nt(nv, F.pv() + (size_t)nrow * D, F.lane); }
            cvt_row_lp<U_FMT>(ru, F.UT() + (size_t)row * UROW, F.US() + row, F.lane);
            cvt_row_lp<V_FMT>(rv, F.VT() + (size_t)row * VROW, F.VS() + row, F.lane);
            ru = nu; rv = nv; row = nrow;
        }
    }
    for (int i = blockIdx.x * (NWAVES * 64) + F.tid; i < 192 * 32; i += F.G * NWAVES * 64) {
        const int idx = i >> 5, f = i & 31; const float pos = (float)(idx < 128 ? idx : idx - 128);
        const float inv = powf(10000.f, -(float)(2 * f) / 64.f); const float ang = pos * inv;
        F.ROPE()[2 * i] = cosf(ang); F.ROPE()[2 * i + 1] = sinf(ang);
    }
}

__device__ __forceinline__ void p0b_mod0(Frame& F) {
    for (int t = F.gw; t < TT; t += F.NGW) {
        const float* src = t < TL ? F.x() + (size_t)t * D : F.ctx() + (size_t)(t - TL) * D;
        f32x4 v[8];
#pragma unroll
        for (int j = 0; j < 8; ++j) v[j] = *((const f32x4*)src + F.lane + 64 * j);
        const float* mp = F.MODS() + (size_t)modrow(t) * 12288;
        modulate_store(v, mp, mp + D, F.H() + (size_t)t * D, F.lane);
    }
}

constexpr int KP = 272, VP = 320, KS_BYTES = 64 * KP, VS_BYTES = 64 * VP;
struct KVRegs { u32x4 k1, k2, v1, v2; f32x4 cs[4]; };

__device__ __forceinline__ void attn_load_tile(Frame& F, KVRegs& R, int ti, int b, int n, int g) {
    const int key = F.tid >> 3, c8 = F.tid & 7;
    int row, pos = 0;
    if (ti < 6) { pos = (n - 1) * 128 + 64 * ti + key; row = b * SEQ + pos; } else row = TL + b * CTXL + 64 * (ti - 6) + key;
    const bf16_t* base = F.PROJ() + (size_t)row * INC;
    const int d1 = (c8 >> 2) * 64 + (c8 & 3) * 8;
    R.k1 = *(const u32x4*)(base + OFF_K + g * 128 + d1); R.k2 = *(const u32x4*)(base + OFF_K + g * 128 + d1 + 32);
    R.v1 = *(const u32x4*)(base + OFF_V + g * 128 + 8 * c8); R.v2 = *(const u32x4*)(base + OFF_V + g * 128 + 64 + 8 * c8);
    if (ti < 6) { const int tidx = (c8 >> 2) ? 128 + (pos & 63) : (pos >> 6); const f32x4* cp = (const f32x4*)(F.ROPE() + ((size_t)tidx * 32 + (c8 & 3) * 8) * 2);
#pragma unroll
        for (int m = 0; m < 4; ++m) R.cs[m] = cp[m]; }
}
__device__ __forceinline__ void rope8(u32x4& a, u32x4& bq, const f32x4 (&cs)[4], float scale) {
    u32x4 oa, ob;
#pragma unroll
    for (int w = 0; w < 4; ++w) {
        const float x1l = bf_lo(a[w]), x1h = bf_hi(a[w]), x2l = bf_lo(bq[w]), x2h = bf_hi(bq[w]);
        const float cl = cs[w].x, sl = cs[w].y, ch = cs[w].z, sh = cs[w].w;
        oa[w] = pk2((x1l * cl - x2l * sl) * scale, (x1h * ch - x2h * sh) * scale);
        ob[w] = pk2((x2l * cl + x1l * sl) * scale, (x2h * ch + x1h * sh) * scale);
    }
    a = oa; bq = ob;
}
__device__ __forceinline__ void attn_store_tile(Frame& F, KVRegs& R, int ti, int buf) {
    const int key = F.tid >> 3, c8 = F.tid & 7;
    if (ti < 6) rope8(R.k1, R.k2, R.cs, 1.f);
    const int d1 = (c8 >> 2) * 64 + (c8 & 3) * 8;
    LAS unsigned char* kp = F.lds + buf * KS_BYTES + key * KP;
    *(LAS u32x4*)(kp + d1 * 2) = R.k1; *(LAS u32x4*)(kp + (d1 + 32) * 2) = R.k2;
    LAS unsigned char* vp = F.lds + 2 * KS_BYTES + buf * VS_BYTES + key * VP;
    *(LAS u32x4*)(vp + 16 * c8) = R.v1; *(LAS u32x4*)(vp + 128 + 16 * c8) = R.v2;
}

#define MFMA32(a, b, c) __builtin_amdgcn_mfma_f32_32x32x16_bf16((a), (b), (c), 0, 0, 0)

__device__ __forceinline__ void attn_unit(Frame& F, int layer, int u) {
    const bool latent = u < 512;
    int b, n, g, hp;
    if (latent) { hp = u & 1; g = (u >> 1) & 1; n = (u >> 2) & 63; b = u >> 8; }
    else { const int v = u - 512; hp = v & 1; g = (v >> 1) & 1; n = (v >> 2) & 1; b = v >> 3; }
    const int lane = F.lane, r = lane & 31, h = lane >> 5, wave = F.wave;
    const int head = g * 4 + hp * 2 + (wave >> 2), qb = wave & 3;
    const int tq = latent ? b * SEQ + n * 128 + 32 * qb + r : TL + b * CTXL + n * 128 + 32 * qb + r;
    bf16x8 qf[8];
    {
        u32x4 raw[8];
        const bf16_t* qp = F.PROJ() + (size_t)tq * INC + OFF_Q + head * 128 + 8 * h;
#pragma unroll
        for (int ks = 0; ks < 8; ++ks) raw[ks] = *(const u32x4*)(qp + 16 * ks);
        if (latent) {
            const int pos = n * 128 + 32 * qb + r;
#pragma unroll
            for (int half = 0; half < 2; ++half) {
                const int tidx = half ? 128 + (pos & 63) : (pos >> 6);
#pragma unroll
                for (int kk = 0; kk < 2; ++kk) {
                    const f32x4* cp = (const f32x4*)(F.ROPE() + ((size_t)tidx * 32 + 16 * kk + 8 * h) * 2);
                    f32x4 cs[4];
#pragma unroll
                    for (int m = 0; m < 4; ++m) cs[m] = cp[m];
                    rope8(raw[4 * half + kk], raw[4 * half + kk + 2], cs, QSCALE);
                }
            }
        } else {
#pragma unroll
            for (int ks = 0; ks < 8; ++ks)
#pragma unroll
                for (int w = 0; w < 4; ++w) raw[ks][w] = pk2(bf_lo(raw[ks][w]) * QSCALE, bf_hi(raw[ks][w]) * QSCALE);
        }
#pragma unroll
        for (int ks = 0; ks < 8; ++ks) qf[ks] = __builtin_bit_cast(bf16x8, raw[ks]);
    }
    int tlo = 6, nw = 0;
    if (latent) { tlo = (n == 0) ? 2 : 0; const int thi = (n == 63) ? 3 : 5; nw = thi - tlo + 1; }
    const int ntiles = nw + 4;
    f32x16 o[4];
#pragma unroll
    for (int db = 0; db < 4; ++db)
#pragma unroll
        for (int i = 0; i < 16; ++i) o[db][i] = 0.f;
    float m_run = F.sink()[layer * 8 + head] * LOG2E;
    float lsum = h == 0 ? 1.f : 0.f;
    const int iq = 32 * qb + r;
    KVRegs R;
    __syncthreads();
    attn_load_tile(F, R, nw > 0 ? tlo : 6, b, n, g);
    attn_store_tile(F, R, nw > 0 ? tlo : 6, 0);
    __syncthreads();
    const int i16 = lane & 15, tq4 = i16 >> 2, tp = i16 & 3, blk = (lane >> 4) & 1;
    for (int j = 0; j < ntiles; ++j) {
        const int ti = j < nw ? tlo + j : 6 + (j - nw);
        const int buf = j & 1;
        const bool more = j + 1 < ntiles;
        const int tin = (j + 1) < nw ? tlo + j + 1 : 6 + (j + 1 - nw);
        if (more) attn_load_tile(F, R, tin, b, n, g);
        const bool part = ti >= 6 || (ti >= (qb >> 1) && ti <= (qb >> 1) + 4);
        if (part) {
            f32x16 s0, s1;
#pragma unroll
            for (int i = 0; i < 16; ++i) { s0[i] = 0.f; s1[i] = 0.f; }
            const LAS unsigned char* kb = F.lds + buf * KS_BYTES + r * KP + h * 16;
#pragma unroll
            for (int ks = 0; ks < 8; ++ks) {
                const bf16x8 a0 = *(const LAS bf16x8*)(kb + ks * 32), a1 = *(const LAS bf16x8*)(kb + 32 * KP + ks * 32);
                s0 = MFMA32(a0, qf[ks], s0); s1 = MFMA32(a1, qf[ks], s1);
            }
            float mx = -INFINITY;
            if (ti < 6) {
                const int jb = 64 * ti + 4 * h - iq;
#pragma unroll
                for (int i = 0; i < 16; ++i) { const int j0 = jb + (i & 3) + 8 * (i >> 2), j1 = j0 + 32;
                    s0[i] = (j0 >= 0 && j0 <= 256) ? s0[i] : -INFINITY; s1[i] = (j1 >= 0 && j1 <= 256) ? s1[i] : -INFINITY; }
            }
#pragma unroll
            for (int i = 0; i < 16; ++i) mx = fmaxf(mx, fmaxf(s0[i], s1[i]));
            mx = fmaxf(mx, __shfl_xor(mx, 32));
            const float m_new = fmaxf(m_run, mx), alpha = exp2f(m_run - m_new);
            m_run = m_new; lsum *= alpha;
#pragma unroll
            for (int i = 0; i < 16; ++i) { s0[i] = exp2f(s0[i] - m_new); s1[i] = exp2f(s1[i] - m_new); lsum += s0[i] + s1[i]; }
#pragma unroll
            for (int db = 0; db < 4; ++db)
#pragma unroll
                for (int i = 0; i < 16; ++i) o[db][i] *= alpha;
            bf16x8 pf[2][2];
#pragma unroll
            for (int s2 = 0; s2 < 2; ++s2) {
                u32x4 p0, p1;
#pragma unroll
                for (int w = 0; w < 4; ++w) { p0[w] = pk2(s0[8 * s2 + 2 * w], s0[8 * s2 + 2 * w + 1]); p1[w] = pk2(s1[8 * s2 + 2 * w], s1[8 * s2 + 2 * w + 1]); }
                pf[0][s2] = __builtin_bit_cast(bf16x8, p0); pf[1][s2] = __builtin_bit_cast(bf16x8, p1);
            }
            const LAS unsigned char* vb = F.lds + 2 * KS_BYTES + buf * VS_BYTES + (4 * h + tq4) * VP + 32 * blk + 8 * tp;
#pragma unroll
            for (int db = 0; db < 4; ++db)
#pragma unroll
                for (int kb2 = 0; kb2 < 2; ++kb2)
#pragma unroll
                    for (int s2 = 0; s2 < 2; ++s2) {
                        const int off = (32 * kb2 + 16 * s2) * VP + db * 64;
                        const s16x4 lo = __builtin_amdgcn_ds_read_tr16_b64_v4i16((LAS s16x4*)(vb + off));
                        const s16x4 hi = __builtin_amdgcn_ds_read_tr16_b64_v4i16((LAS s16x4*)(vb + off + 8 * VP));
                        const bf16x8 av = __builtin_shufflevector(lo, hi, 0, 1, 2, 3, 4, 5, 6, 7);
                        o[db] = MFMA32(av, pf[kb2][s2], o[db]);
                    }
        }
        if (more) attn_store_tile(F, R, tin, buf ^ 1);
        __syncthreads();
    }
    const float lt = lsum + __shfl_xor(lsum, 32);
    const float inv = 1.f / lt;
    float ss = 0.f;
#pragma unroll
    for (int db = 0; db < 4; ++db)
#pragma unroll
        for (int i = 0; i < 16; ++i) { o[db][i] *= inv; ss += o[db][i] * o[db][i]; }
    ss += __shfl_xor(ss, 32);
    const float rn = 1.f / sqrtf(ss * (1.f / 128.f) + LN_EPS);
    bf16_t* op = F.MIX() + (size_t)tq * D + head * 128 + 4 * h;
    const float* gp = F.g_attn() + layer * 1024 + head * 128 + 4 * h;
#pragma unroll
    for (int db = 0; db < 4; ++db)
#pragma unroll
        for (int g4 = 0; g4 < 4; ++g4) {
            const f32x4 gv = *(const f32x4*)(gp + 32 * db + 8 * g4);
            u32x2 w; w.x = pk2(o[db][4 * g4] * rn * gv.x, o[db][4 * g4 + 1] * rn * gv.y); w.y = pk2(o[db][4 * g4 + 2] * rn * gv.z, o[db][4 * g4 + 3] * rn * gv.w);
            *(u32x2*)(op + 32 * db + 8 * g4) = w;
        }
}

__device__ __forceinline__ void unpack8(const u32x4 v, float (&f)[8]) {
#pragma unroll
    for (int w = 0; w < 4; ++w) { f[2 * w] = bf_lo(v[w]); f[2 * w + 1] = bf_hi(v[w]); }
}
__device__ __forceinline__ void conv_row(Frame& F, int layer, int t) {
    bool first, last;
    if (t < TL) { const int pos = t & (SEQ - 1); first = pos == 0; last = pos == SEQ - 1; } else { const int pc = (t - TL) & (CTXL - 1); first = pc == 0; last = pc == CTXL - 1; }
    const bf16_t* p = F.PROJ() + (size_t)t * INC;
    const float* cw = F.conv_w() + (size_t)layer * 3 * 1024;
#pragma unroll
    for (int jc = 0; jc < 2; ++jc) {
        const int c = 8 * F.lane + 512 * jc;
        float gb[8], a[8], bq[8], um[8], ut[8], up[8];
        unpack8(*(const u32x4*)(p + c), gb);
        unpack8(*(const u32x4*)(p + OFF_C + c), a); unpack8(*(const u32x4*)(p + OFF_X + c), bq);
#pragma unroll
        for (int e = 0; e < 8; ++e) ut[e] = a[e] * bq[e];
        if (!first) { unpack8(*(const u32x4*)(p - INC + OFF_C + c), a); unpack8(*(const u32x4*)(p - INC + OFF_X + c), bq);
#pragma unroll
            for (int e = 0; e < 8; ++e) um[e] = a[e] * bq[e]; }
        else {
#pragma unroll
            for (int e = 0; e < 8; ++e) um[e] = 0.f; }
        if (!last) { unpack8(*(const u32x4*)(p + INC + OFF_C + c), a); unpack8(*(const u32x4*)(p + INC + OFF_X + c), bq);
#pragma unroll
            for (int e = 0; e < 8; ++e) up[e] = a[e] * bq[e]; }
        else {
#pragma unroll
            for (int e = 0; e < 8; ++e) up[e] = 0.f; }
        float y[8], ss = 0.f;
#pragma unroll
        for (int e = 0; e < 8; ++e) { y[e] = gb[e] * (cw[c + e] * um[e] + cw[1024 + c + e] * ut[e] + cw[2048 + c + e] * up[e]); ss += y[e] * y[e]; }
        ss += __shfl_xor(ss, 1); ss += __shfl_xor(ss, 2); ss += __shfl_xor(ss, 4); ss += __shfl_xor(ss, 8);
        const float rn = 1.f / sqrtf(ss * (1.f / 128.f) + LN_EPS);
        const float* gc = F.g_conv() + layer * 1024 + c;
        u32x4 w;
#pragma unroll
        for (int q = 0; q < 4; ++q) w[q] = pk2(y[2 * q] * rn * gc[2 * q], y[2 * q + 1] * rn * gc[2 * q + 1]);
        *(u32x4*)(F.MIX() + (size_t)t * D + 1024 + c) = w;
    }
}

__device__ __forceinline__ void ln_phase(Frame& F, int layer, int rows) {
    const int lane = F.lane;
    u32x4 w[4], wn[4];
    int t = F.gw;
    if (t < rows) {
#pragma unroll
        for (int j = 0; j < 4; ++j) w[j] = *(const u32x4*)(F.X() + (size_t)t * D + 8 * lane + 512 * j);
    }
    const float* g1 = F.ln1_g() + layer * D; const float* b1 = F.ln1_b() + layer * D;
    while (t < rows) {
        const int tn = t + F.NGW;
        if (tn < rows) {
#pragma unroll
            for (int j = 0; j < 4; ++j) wn[j] = *(const u32x4*)(F.X() + (size_t)tn * D + 8 * lane + 512 * j);
        }
        float v[32]; float s = 0.f;
#pragma unroll
        for (int j = 0; j < 4; ++j)
#pragma unroll
            for (int q = 0; q < 4; ++q) { v[8 * j + 2 * q] = bf_lo(w[j][q]); v[8 * j + 2 * q + 1] = bf_hi(w[j][q]); s += v[8 * j + 2 * q] + v[8 * j + 2 * q + 1]; }
        const float mean = wave_sum(s) * (1.f / D);
        float s2 = 0.f;
#pragma unroll
        for (int i = 0; i < 32; ++i) { v[i] -= mean; s2 += v[i] * v[i]; }
        const float rstd = 1.f / sqrtf(wave_sum(s2) * (1.f / D) + LN_EPS);
        float s3 = 0.f;
#pragma unroll
        for (int j = 0; j < 4; ++j) { const int c = 8 * lane + 512 * j; u32x4 o;
#pragma unroll
            for (int q = 0; q < 2; ++q) { const f32x4 gg = *(const f32x4*)(g1 + c + 4 * q), bb = *(const f32x4*)(b1 + c + 4 * q);
#pragma unroll
                for (int e = 0; e < 4; ++e) { const float y = v[8 * j + 4 * q + e] * rstd * gg[e] + bb[e]; v[8 * j + 4 * q + e] = y; s3 += y; }
                o[2 * q] = pk2(v[8 * j + 4 * q], v[8 * j + 4 * q + 1]); o[2 * q + 1] = pk2(v[8 * j + 4 * q + 2], v[8 * j + 4 * q + 3]); }
            *(u32x4*)(F.X() + (size_t)t * D + c) = o; }
        const float mean2 = wave_sum(s3) * (1.f / D);
        float s4 = 0.f;
#pragma unroll
        for (int i = 0; i < 32; ++i) { v[i] -= mean2; s4 += v[i] * v[i]; }
        const float rstd2 = 1.f / sqrtf(wave_sum(s4) * (1.f / D) + LN_EPS);
        const float* mp = F.MODS() + ((size_t)layer * 3 + modrow(t)) * 12288;
#pragma unroll
        for (int j = 0; j < 4; ++j) { const int c = 8 * lane + 512 * j; u32x4 o;
#pragma unroll
            for (int q = 0; q < 2; ++q) { const f32x4 sh = *(const f32x4*)(mp + 3 * D + c + 4 * q), sc = *(const f32x4*)(mp + 4 * D + c + 4 * q);
                const float y0 = v[8 * j + 4 * q] * rstd2 * (1.f + sc[0]) + sh[0], y1 = v[8 * j + 4 * q + 1] * rstd2 * (1.f + sc[1]) + sh[1];
                const float y2 = v[8 * j + 4 * q + 2] * rstd2 * (1.f + sc[2]) + sh[2], y3 = v[8 * j + 4 * q + 3] * rstd2 * (1.f + sc[3]) + sh[3];
                o[2 * q] = pk2(y0, y1); o[2 * q + 1] = pk2(y2, y3); }
            *(u32x4*)(F.H() + (size_t)t * D + c) = o; }
#pragma unroll
        for (int j = 0; j < 4; ++j) w[j] = wn[j];
        t = tn;
    }
}

__device__ __forceinline__ unsigned ordkey(float f) { const unsigned u = __float_as_uint(f); return u ^ ((u >> 31) ? 0xFFFFFFFFu : 0x80000000u); }
__device__ __forceinline__ float gelu_erf(float a) { return 0.5f * a * (1.f + erff(a * 0.70710678118654752f)); }

__device__ __forceinline__ float unordkey(unsigned k) { return __uint_as_float(k ^ ((k >> 31) ? 0x80000000u : 0xFFFFFFFFu)); }
__device__ __forceinline__ float gelu_as(float v) {
    const float av = fabsf(v), t = __builtin_amdgcn_rcpf(av * 0.2316418882f + 1.0f);
    float q = t * 0.5307027145f + (-0.7265760135f); q = q * t + 0.7107068705f; q = q * t + (-0.142248368f); q = q * t + 0.127414796f; q = q * t;
    const float e = __builtin_amdgcn_exp2f((v * v) * (-0.72134752044f));
    const float m = v * (q * e);
    return v < 0.f ? m : v - m;
}

template <class O> struct QuadNet {
    typedef typename O::V V; typedef typename O::B B;
    template <bool ASC> static __device__ __forceinline__ void ce_reg(V& a, V& b) { const V lo = O::vmin(a, b), hi = O::vmax(a, b); a = ASC ? lo : hi; b = ASC ? hi : lo; }
    template <bool ASC> static __device__ __forceinline__ void ce_l1(V& x, B low1) { const V p = O::x1(x); const V mn = O::vmin(p, x), mx = O::vmax(p, x); x = ASC ? O::vsel(low1, mn, mx) : O::vsel(low1, mx, mn); }
    template <bool ASC> static __device__ __forceinline__ void ce_l2(V& x, B low2) { const V p = O::x2(x); const V mn = O::vmin(p, x), mx = O::vmax(p, x); x = ASC ? O::vsel(low2, mn, mx) : O::vsel(low2, mx, mn); }
    template <int NR> static __device__ __forceinline__ void sort_blocks(V (&R)[NR], B low1, B low2, B eq12) {
#pragma unroll
        for (int r = 0; r < NR; ++r) { const V p = O::x1(R[r]); const V mn = O::vmin(p, R[r]), mx = O::vmax(p, R[r]); R[r] = O::vsel(eq12, mn, mx); }
#pragma unroll
        for (int r = 0; r < NR; ++r) { if ((r & 1) == 0) ce_l2<true>(R[r], low2); else ce_l2<false>(R[r], low2); }
#pragma unroll
        for (int r = 0; r < NR; ++r) { if ((r & 1) == 0) ce_l1<true>(R[r], low1); else ce_l1<false>(R[r], low1); }
#pragma unroll
        for (int r = 0; r < NR; r += 2) { if ((r & 2) == 0) ce_reg<true>(R[r], R[r + 1]); else ce_reg<false>(R[r], R[r + 1]); }
#pragma unroll
        for (int r = 0; r < NR; ++r) { if ((r & 2) == 0) ce_l2<true>(R[r], low2); else ce_l2<false>(R[r], low2); }
#pragma unroll
        for (int r = 0; r < NR; ++r) { if ((r & 2) == 0) ce_l1<true>(R[r], low1); else ce_l1<false>(R[r], low1); }
#pragma unroll
        for (int r = 0; r < NR; ++r) { if ((r & 2) == 0) { if ((r & 4) == 0) ce_reg<true>(R[r], R[r + 2]); else ce_reg<false>(R[r], R[r + 2]); } }
#pragma unroll
        for (int r = 0; r < NR; r += 2) { if ((r & 4) == 0) ce_reg<true>(R[r], R[r + 1]); else ce_reg<false>(R[r], R[r + 1]); }
#pragma unroll
        for (int r = 0; r < NR; ++r) { if ((r & 4) == 0) ce_l2<true>(R[r], low2); else ce_l2<false>(R[r], low2); }
#pragma unroll
        for (int r = 0; r < NR; ++r) { if ((r & 4) == 0) ce_l1<true>(R[r], low1); else ce_l1<false>(R[r], low1); }
    }
    template <int NR> static __device__ __forceinline__ void halve_merge(const V (&R)[NR], V (&Q)[NR / 2], B low1, B low2) {
#pragma unroll
        for (int m = 0; m < NR / 8; ++m)
#pragma unroll
            for (int i = 0; i < 4; ++i) Q[4 * m + i] = O::vmax(R[8 * m + i], R[8 * m + 4 + i]);
#pragma unroll
        for (int r = 0; r < NR / 2; ++r) { if ((r & 2) == 0) { if ((r & 4) == 0) ce_reg<false>(Q[r], Q[r + 2]); else ce_reg<true>(Q[r], Q[r + 2]); } }
#pragma unroll
        for (int r = 0; r < NR / 2; r += 2) { if ((r & 4) == 0) ce_reg<false>(Q[r], Q[r + 1]); else ce_reg<true>(Q[r], Q[r + 1]); }
#pragma unroll
        for (int r = 0; r < NR / 2; ++r) { if ((r & 4) == 0) ce_l2<false>(Q[r], low2); else ce_l2<true>(Q[r], low2); }
#pragma unroll
        for (int r = 0; r < NR / 2; ++r) { if ((r & 4) == 0) ce_l1<false>(Q[r], low1); else ce_l1<true>(Q[r], low1); }
    }
    static __device__ __forceinline__ void top16_of_128(V (&R)[32], V (&T)[4], B low1, B low2, B eq12) {
        sort_blocks<32>(R, low1, low2, eq12);
        V A[16]; halve_merge<32>(R, A, low1, low2);
        V Bq[8]; halve_merge<16>(A, Bq, low1, low2);
        halve_merge<8>(Bq, T, low1, low2);
    }
    static __device__ __forceinline__ void top16_of_64(V (&R)[16], V (&T)[4], B low1, B low2, B eq12) {
        sort_blocks<16>(R, low1, low2, eq12);
        V A[8]; halve_merge<16>(R, A, low1, low2);
        halve_merge<8>(A, T, low1, low2);
    }
};

struct DevOps {
    typedef unsigned V; typedef bool B;
    static __device__ __forceinline__ V vmin(V a, V b) { return a < b ? a : b; }
    static __device__ __forceinline__ V vmax(V a, V b) { return a > b ? a : b; }
    static __device__ __forceinline__ V vsel(B m, V a, V b) { return m ? a : b; }
    static __device__ __forceinline__ V x1(V a) { return (V)dpp_i<DPP_XOR1>((int)a); }
    static __device__ __forceinline__ V x2(V a) { return (V)dpp_i<DPP_XOR2>((int)a); }
};
__device__ __forceinline__ void stair_ab(int c, int& a, int& b) {
    if (c < 16) { a = 0; b = c; } else if (c < 24) { a = 1; b = c - 16; } else if (c < 28) { a = 2; b = c - 24; } else if (c < 32) { a = 3; b = c - 28; }
    else if (c < 36) { a = 4; b = c - 32; } else if (c < 40) { a = 5 + ((c - 36) >> 1); b = (c - 36) & 1; } else if (c < 44) { a = 7 + ((c - 40) >> 1); b = (c - 40) & 1; }
    else if (c < 48) { a = 9 + (c - 44); b = 0; } else if (c < 51) { a = 13 + (c - 48); b = 0; } else { a = 2; b = 4; }
}
constexpr int PE_WS = 5120, PE_TAB = 8 * PE_WS;
__device__ __forceinline__ void peer_topk(Frame& F, LAS unsigned char* ws, int t) {
    const int lane = F.lane, sub = lane & 3;
    const bool low1 = (sub & 1) == 0, low2 = (sub & 2) == 0, eq12 = low1 == low2;
    LAS unsigned* S1K = (LAS unsigned*)ws; LAS int* EL = (LAS int*)(ws + 3328); LAS float* GL = (LAS float*)(ws + 3840);
    const LAS unsigned short* TAB = (const LAS unsigned short*)(F.lds + PE_TAB);
    {
        const int L = lane >> 2;
        const float* sp = F.SC() + (size_t)t * D + L * 128 + sub * 4;
        unsigned R[32];
#pragma unroll
        for (int q = 0; q < 8; ++q) { const f32x4 v = *(const f32x4*)(sp + 16 * q);
#pragma unroll
            for (int e = 0; e < 4; ++e) R[4 * q + e] = (ordkey(v[e]) & ~127u) | (unsigned)(127 - (4 * sub + 16 * q + e)); }
        unsigned T[4];
        QuadNet<DevOps>::top16_of_128(R, T, low1, low2, eq12);
#pragma unroll
        for (int r = 0; r < 4; ++r) S1K[L * 16 + 4 * r + sub] = T[r];
    }
    LDS_WAIT(); __builtin_amdgcn_wave_barrier();
    {
        const int hd = (lane >> 2) & 7;
        const LAS unsigned char* la = (const LAS unsigned char*)(S1K + (2 * hd) * 16); const LAS unsigned char* lb = (const LAS unsigned char*)(S1K + (2 * hd + 1) * 16);
        unsigned C[16];
#pragma unroll
        for (int r = 0; r < 13; ++r) { const unsigned ab = TAB[4 * r + sub];
            const unsigned ka = *(const LAS unsigned*)(la + (ab & 255u)), kb = *(const LAS unsigned*)(lb + (ab >> 8));
            const float sum = unordkey(ka & ~127u) + unordkey(kb & ~127u);
            C[r] = (ordkey(sum) & ~63u) | (unsigned)(63 - (4 * r + sub)); }
        C[13] = 0u; C[14] = 0u; C[15] = 0u;
        unsigned W[4];
        QuadNet<DevOps>::top16_of_64(C, W, low1, low2, eq12);
        float sv[4]; int ex[4];
#pragma unroll
        for (int r = 0; r < 4; ++r) { const unsigned ab = TAB[63 - (W[r] & 63u)];
            const unsigned ka = *(const LAS unsigned*)(la + (ab & 255u)), kb = *(const LAS unsigned*)(lb + (ab >> 8));
            ex[r] = (int)(127u - (ka & 127u)) * 128 + (int)(127u - (kb & 127u)); sv[r] = unordkey(W[r] & ~63u); }
        const float mx = dpp_f<0x00>(sv[0]);
        float e4[4], es = 0.f;
#pragma unroll
        for (int r = 0; r < 4; ++r) { e4[r] = __expf(sv[r] - mx); es += e4[r]; }
        es += dpp_f<DPP_XOR1>(es); es += dpp_f<DPP_XOR2>(es);
        const float rd = 1.f / es;
#pragma unroll
        for (int r = 0; r < 4; ++r) { GL[hd * 16 + 4 * r + sub] = e4[r] * rd; EL[hd * 16 + 4 * r + sub] = ex[r]; }
    }
    LDS_WAIT(); __builtin_amdgcn_wave_barrier();
}

#ifndef PROBE_PHASE
#define PROBE_PHASE -1
#endif
#ifndef PROBE_MULT
#define PROBE_MULT 1
#endif
constexpr int EB = 4;
constexpr int CW_TICKET = 20480;

struct GBuf { LpRow<U_FMT> u[EB]; LpRow<V_FMT> v[EB]; float su[EB], sv[EB], g[EB]; };
__device__ __forceinline__ void gather_issue(GBuf& B, const LAS int* EL, const LAS float* GL, int i0, const unsigned char* UTl, const unsigned char* VTl, const float* USl, const float* VSl, int lane) {
#pragma unroll
    for (int q = 0; q < EB; ++q) {
        const int ex = __builtin_amdgcn_readfirstlane(EL[i0 + q]);
        B.g[q] = __uint_as_float(__builtin_amdgcn_readfirstlane(__float_as_uint(GL[i0 + q])));
        B.u[q].load(UTl + (size_t)ex * UROW, lane); B.v[q].load(VTl + (size_t)ex * VROW, lane); B.su[q] = USl[ex]; B.sv[q] = VSl[ex];
    }
}
__device__ __forceinline__ void gather_compute(const GBuf& B, const f32x2 (&hv)[16], f32x2 (&acc)[16]) {
    float dot[EB];
#pragma unroll
    for (int q = 0; q < EB; ++q) { f32x2 s = {0.f, 0.f};
        B.u[q].each([&](int i, float x0, float x1) { const f32x2 x = {x0, x1}; s = __builtin_elementwise_fma(x, hv[i >> 1], s); });
        dot[q] = s.x + s.y; }
#pragma unroll
    for (int q = 0; q < EB; ++q) dot[q] = wave_sum_u(dot[q]);
#pragma unroll
    for (int q = 0; q < EB; ++q) { const float cf = B.g[q] * gelu_as(dot[q] * B.su[q]) * B.sv[q]; const f32x2 c2 = {cf, cf};
        B.v[q].each([&](int i, float x0, float x1) { const f32x2 x = {x0, x1}; acc[i >> 1] = __builtin_elementwise_fma(x, c2, acc[i >> 1]); }); }
}

__device__ __forceinline__ void peer_phase(Frame& F, int layer, int rows, unsigned* ctl, unsigned long long& pr_acc) {
    unsigned long long pt0 = 0ull;
#define SUB_BEGIN(ty) do { if (PROBE_PHASE == (ty)) pt0 = __builtin_amdgcn_s_memrealtime(); } while (0)
#define SUB_END(ty) do { if (PROBE_PHASE == (ty)) pr_acc += __builtin_amdgcn_s_memrealtime() - pt0; } while (0)
    if (F.tid < 64) { int a = 0, b = 0; stair_ab(F.tid < 52 ? F.tid : 0, a, b); *(LAS unsigned short*)(F.lds + PE_TAB + 2 * F.tid) = (unsigned short)((4 * a) | ((4 * b) << 8)); }
    __syncthreads();
    LAS unsigned char* ws = F.lds + F.wave * PE_WS;
    LAS int* EL = (LAS int*)(ws + 3328); LAS float* GL = (LAS float*)(ws + 3840);
    const int lane = F.lane;
    const unsigned char* UTl = F.UT() + (size_t)layer * NEXP * UROW;
    const unsigned char* VTl = F.VT() + (size_t)layer * NEXP * VROW;
    const float* USl = F.US() + (size_t)layer * NEXP; const float* VSl = F.VS() + (size_t)layer * NEXP;
    unsigned* ticket = ctl + CW_TICKET + 64 * layer;
    unsigned tk = 0u;
    if (lane == 0) tk = __hip_atomic_fetch_add(ticket, 1u, __ATOMIC_RELAXED, __HIP_MEMORY_SCOPE_AGENT);
    int t = (int)__builtin_amdgcn_readfirstlane(tk);
    while (t < rows) {
        unsigned tkn = 0u;
        if (lane == 0) tkn = __hip_atomic_fetch_add(ticket, 1u, __ATOMIC_RELAXED, __HIP_MEMORY_SCOPE_AGENT);
        SUB_BEGIN(8); peer_topk(F, ws, t); SUB_END(8);
        SUB_BEGIN(9);
        f32x2 hv[16], acc[16];
#pragma unroll
        for (int q = 0; q < 4; ++q) { const u32x4 w = *(const u32x4*)(F.H() + (size_t)t * D + 32 * lane + 8 * q);
#pragma unroll
            for (int e = 0; e < 4; ++e) { hv[4 * q + e] = (f32x2){bf_lo(w[e]), bf_hi(w[e])}; acc[4 * q + e] = (f32x2){0.f, 0.f}; } }
        {
            GBuf A, B;
            gather_issue(A, EL, GL, 0, UTl, VTl, USl, VSl, lane);
            for (int i0 = 0; i0 < 128; i0 += 2 * EB) {
                gather_issue(B, EL, GL, i0 + EB, UTl, VTl, USl, VSl, lane);
                gather_compute(A, hv, acc);
                if (i0 + 2 * EB < 128) gather_issue(A, EL, GL, i0 + 2 * EB, UTl, VTl, USl, VSl, lane);
                gather_compute(B, hv, acc);
            }
        }
        SUB_END(9); SUB_BEGIN(10);
        const int mr = modrow(t);
        const float* mp = F.MODS() + ((size_t)layer * 3 + mr) * 12288;
        bf16_t* xr = F.X() + (size_t)t * D;
        float rr[32]; float s = 0.f;
#pragma unroll
        for (int q2 = 0; q2 < 4; ++q2) { const u32x4 xw = *(const u32x4*)(xr + 32 * lane + 8 * q2);
#pragma unroll
            for (int h2 = 0; h2 < 2; ++h2) { const int q = 2 * q2 + h2; const int c = 32 * lane + 4 * q; const f32x4 gv = *(const f32x4*)(mp + 5 * D + c);
                const f32x4 xv = {bf_lo(xw[2 * h2]), bf_hi(xw[2 * h2]), bf_lo(xw[2 * h2 + 1]), bf_hi(xw[2 * h2 + 1])};
                const f32x4 av = {acc[2 * q].x, acc[2 * q].y, acc[2 * q + 1].x, acc[2 * q + 1].y};
#pragma unroll
                for (int e = 0; e < 4; ++e) { const float v = DN_ALPHA * xv[e] + gv[e] * av[e]; rr[4 * q + e] = v; s += v; } } }
        const float mean = wave_sum_u(s) * (1.f / D);
        float s2 = 0.f;
#pragma unroll
        for (int i = 0; i < 32; ++i) { rr[i] -= mean; s2 += rr[i] * rr[i]; }
        const float rstd = 1.f / sqrtf(wave_sum_u(s2) * (1.f / D) + LN_EPS);
        const float* g2 = F.ln2_g() + layer * D; const float* b2 = F.ln2_b() + layer * D;
        float s3 = 0.f;
#pragma unroll
        for (int q = 0; q < 8; ++q) { const int c = 32 * lane + 4 * q; const f32x4 gg = *(const f32x4*)(g2 + c), bb = *(const f32x4*)(b2 + c);
            f32x4 xo;
#pragma unroll
            for (int e = 0; e < 4; ++e) { xo[e] = rr[4 * q + e] * rstd * gg[e] + bb[e]; rr[4 * q + e] = xo[e]; s3 += xo[e]; }
            if (layer < NLAYER - 1) { u32x2 o2; o2.x = pk2(xo[0], xo[1]); o2.y = pk2(xo[2], xo[3]); *(u32x2*)(xr + c) = o2; } else if (t < TL) *(f32x4*)(F.out() + (size_t)t * D + c) = xo; }
        if (layer < NLAYER - 1) {
            const float mean2 = wave_sum_u(s3) * (1.f / D);
            float s4 = 0.f;
#pragma unroll
            for (int i = 0; i < 32; ++i) { rr[i] -= mean2; s4 += rr[i] * rr[i]; }
            const float rstd2 = 1.f / sqrtf(wave_sum_u(s4) * (1.f / D) + LN_EPS);
            const float* np = F.MODS() + ((size_t)(layer + 1) * 3 + mr) * 12288;
#pragma unroll
            for (int q2 = 0; q2 < 4; ++q2) { const int c = 32 * lane + 8 * q2; u32x4 w;
#pragma unroll
                for (int q = 0; q < 2; ++q) { const f32x4 sh = *(const f32x4*)(np + c + 4 * q), sc = *(const f32x4*)(np + D + c + 4 * q); const int ri = 8 * q2 + 4 * q;
                    const float y0 = rr[ri] * rstd2 * (1.f + sc[0]) + sh[0], y1 = rr[ri + 1] * rstd2 * (1.f + sc[1]) + sh[1];
                    const float y2 = rr[ri + 2] * rstd2 * (1.f + sc[2]) + sh[2], y3 = rr[ri + 3] * rstd2 * (1.f + sc[3]) + sh[3];
                    w[2 * q] = pk2(y0, y1); w[2 * q + 1] = pk2(y2, y3); }
                *(u32x4*)(F.H() + (size_t)t * D + c) = w; }
        }
        SUB_END(10);
        t = (int)__builtin_amdgcn_readfirstlane(tkn);
    }
#undef SUB_BEGIN
#undef SUB_END
}

__global__ void __launch_bounds__(NWAVES * 64, 2) skel_fwd(Args args) {
    extern __shared__ __attribute__((aligned(16))) unsigned char lds[];
    Frame F;
    F.lds = (LAS unsigned char*)lds;
    F.tid = threadIdx.x; F.lane = F.tid & 63; F.wave = __builtin_amdgcn_readfirstlane(F.tid >> 6);
    F.G = gridDim.x; F.gw = blockIdx.x * NWAVES + F.wave; F.NGW = F.G * NWAVES;
    unsigned char* ws = args.ws;
    F.ka = (const CAS unsigned char*)__builtin_amdgcn_kernarg_segment_ptr();
    for (int u = F.tid; u < (LDS_BYTES - LDSCTL_OFF) / 4; u += NWAVES * 64) ((LAS unsigned*)(F.lds + LDSCTL_OFF))[u] = 0u;
    __syncthreads();
    unsigned* ctl = (unsigned*)(ws + WS_CTL);
    const int lo = args.ph_lo, hi = args.ph_hi;
    XcdBarrier bar; bar.bar = ctl + CW_BAR + args.li * XCD_BAR_WORDS; bar.x = 0; bar.st = nullptr;
    if (hi - lo > 1) bar = xcd_barrier_post(ctl + CW_BAR + args.li * XCD_BAR_WORDS, (volatile LAS unsigned*)(F.lds + MISC_OFF) + 8);
#define IN(k) (lo <= (k) && (k) < hi)
    unsigned long long pr_acc = 0ull, pr_t0 = 0ull;
#define PR_BEGIN(ty) do { if (PROBE_PHASE == (ty)) pr_t0 = __builtin_amdgcn_s_memrealtime(); } while (0)
#define PR_END(ty) do { if (PROBE_PHASE == (ty)) pr_acc += __builtin_amdgcn_s_memrealtime() - pr_t0; } while (0)
#define BOTH(k) (IN(k) && IN((k) + 1))
#define SEAM(k) do { if (BOTH(k)) xcd_barrier(bar); } while (0)

    if (IN(0)) { PR_BEGIN(0); frame_ids(F); p0a_prologue(F); SEAM(0); PR_END(0); }
    if (IN(1)) {
        PR_BEGIN(1); frame_ids(F);
        { pg8::Gemm g{F.KBD(), F.WQR(), 32 * 256, 2048, 256}; pg8::BatchOrder S{F.G, (int)blockIdx.x}; pg8::EpiBf16 E{F.WEFFT(), D};
          pg8::gemm_phase<pg8::EpiBf16, pg8::BatchOrder, false, true>(F.lds, g, S, E); }
        p0b_mod0(F);
        SEAM(1); PR_END(1);
    }
    for (int layer = 0; layer < NLAYER; ++layer) {
        const int pb = 2 + 6 * layer;
        const bool lastl = layer == NLAYER - 1;
        const int rows = lastl ? TL : TT;
        if (IN(pb + 0)) {
            PR_BEGIN(2); frame_ids(F);
            pg8::Gemm g{F.H(), F.WINT() + (size_t)layer * INC * D, TT, INC, D}; pg8::StaticOrder S; S.init(TT, INC, F.G, (int)blockIdx.x);
            pg8::EpiBf16 E{F.PROJ(), INC};
            pg8::gemm_phase<pg8::EpiBf16, pg8::StaticOrder, true, true>(F.lds, g, S, E);
            SEAM(pb + 0); PR_END(2);
        }
        if (IN(pb + 1)) {
            PR_BEGIN(3); frame_ids(F);
            const int nunits = lastl ? 512 : 528;
            for (int u = blockIdx.x; u < nunits; u += F.G) attn_unit(F, layer, u);
            for (int t = F.gw; t < rows; t += F.NGW) conv_row(F, layer, t);
            SEAM(pb + 1); PR_END(3);
        }
        if (IN(pb + 2)) {
            PR_BEGIN(4); frame_ids(F);
            pg8::Gemm g{F.MIX(), F.WOUTT() + (size_t)layer * D * D, rows, D, D}; pg8::StaticOrder S; S.init(rows, D, F.G, (int)blockIdx.x);
            pg8::EpiResid E{layer == 0 ? F.x() : nullptr, layer == 0 ? F.ctx() : nullptr, F.X(), F.MODS() + (size_t)layer * 3 * 12288 + 2 * D};
            pg8::gemm_phase<pg8::EpiResid, pg8::StaticOrder, true, true>(F.lds, g, S, E);
            SEAM(pb + 2); PR_END(4);
        }
        if (IN(pb + 3)) { PR_BEGIN(5); frame_ids(F); ln_phase(F, layer, rows); SEAM(pb + 3); PR_END(5); }
        if (IN(pb + 4)) {
            PR_BEGIN(6); frame_ids(F);
            pg8::Gemm g{F.H(), F.WEFFT() + (size_t)layer * D * D, rows, D, D}; pg8::StaticOrder S; S.init(rows, D, F.G, (int)blockIdx.x);
            pg8::EpiF32 E{F.SC(), D};
            pg8::gemm_phase<pg8::EpiF32, pg8::StaticOrder, true, true>(F.lds, g, S, E);
            SEAM(pb + 4); PR_END(6);
        }
        if (IN(pb + 5)) { PR_BEGIN(7); frame_ids(F); peer_phase(F, layer, rows, ctl, pr_acc); SEAM(pb + 5); PR_END(7); }
    }
    if (PROBE_PHASE >= 0 && hi - lo > 1) xcd_barrier(bar);
    if (PROBE_PHASE >= 0 && blockIdx.x == 0 && threadIdx.x == 0) { const unsigned long long t1 = __builtin_amdgcn_s_memrealtime() + (unsigned long long)PROBE_MULT * pr_acc; while (__builtin_amdgcn_s_memrealtime() < t1) __builtin_amdgcn_s_sleep(8); }
#undef IN
#undef BOTH
#undef SEAM
}

extern "C" void kernel_launch(void* const* d_in, const int* in_sizes, int n_in, void* d_out, int out_size, void* d_ws, size_t ws_size, hipStream_t stream) {
    static int grid = 0;
    if (grid == 0) {
        if (n_in != 20 || in_sizes[0] != TL * D || out_size != TL * D || ws_size < WS_END) {
            fprintf(stderr, "kernel_launch: unexpected problem shape (n_in %d, in0 %d, out %d, ws %zu, need %zu)\n", n_in, n_in > 0 ? in_sizes[0] : -1, out_size, ws_size, (size_t)WS_END); grid = -1; return; }
        int dev = 0, cus = 0, per_cu = 0;
        if (hipGetDevice(&dev) != hipSuccess || hipDeviceGetAttribute(&cus, hipDeviceAttributeMultiprocessorCount, dev) != hipSuccess) { grid = -1; return; }
        if (hipFuncSetAttribute((const void*)skel_fwd, hipFuncAttributeMaxDynamicSharedMemorySize, LDS_BYTES) != hipSuccess) { fprintf(stderr, "kernel_launch: hipFuncSetAttribute failed\n"); grid = -1; return; }
        if (hipOccupancyMaxActiveBlocksPerMultiprocessor(&per_cu, (const void*)skel_fwd, NWAVES * 64, LDS_BYTES) != hipSuccess || per_cu < 1)
            fprintf(stderr, "kernel_launch: occupancy query reports %d workgroups per CU\n", per_cu);
        (void)hipGetLastError();
        grid = cus;
    }
    if (grid < 0) return;
    if (hipMemsetAsync((char*)d_ws + WS_CTL, 0, CTL_ZERO_BYTES, stream) != hipSuccess) return;
    Args a{};
    for (int i = 0; i < 20; ++i) a.in[i] = (const float*)d_in[i];
    a.out = (float*)d_out; a.ws = (unsigned char*)d_ws; a.pad = 0;
#if MK_N_LAUNCHES == 1
    a.ph_lo = 0; a.ph_hi = NPHASE; a.li = 0;
    hipLaunchKernelGGL(skel_fwd, dim3(grid), dim3(NWAVES * 64), LDS_BYTES, stream, a);
#else
    for (int ph = 0; ph < NPHASE; ++ph) { a.ph_lo = ph; a.ph_hi = ph + 1; a.li = 0;
        hipLaunchKernelGGL(skel_fwd, dim3(grid), dim3(NWAVES * 64), LDS_BYTES, stream, a); }
#endif
}
```

```cpp
#include <hip/hip_runtime.h>
#include <cstdio>
#include <cstdint>

#ifndef MK_N_LAUNCHES
#define MK_N_LAUNCHES 1
#endif

#define LAS __attribute__((address_space(3)))
typedef unsigned short bf16_t;
typedef short bf16x8 __attribute__((ext_vector_type(8)));
typedef short s16x4 __attribute__((ext_vector_type(4)));
typedef float f32x2 __attribute__((ext_vector_type(2)));
typedef float f32x4 __attribute__((ext_vector_type(4)));
typedef float f32x16 __attribute__((ext_vector_type(16)));
typedef unsigned u32x2 __attribute__((ext_vector_type(2)));
typedef unsigned u32x4 __attribute__((ext_vector_type(4)));
typedef __bf16 bf16x2_t __attribute__((ext_vector_type(2)));

constexpr int D = 2048, NB = 2, SEQ = 8192, CTXL = 256, NLAYER = 4;
constexpr int TL = NB * SEQ, TC = NB * CTXL, TT = TL + TC;
constexpr int INC = 4608, OFF_C = 1024, OFF_X = 2048, OFF_Q = 3072, OFF_K = 4096, OFF_V = 4352;
constexpr int NEXP = 16384;
#ifndef U_FMT
#define U_FMT 4
#endif
#ifndef V_FMT
#define V_FMT 4
#endif
constexpr int UROW = D * U_FMT / 8, VROW = D * V_FMT / 8;
constexpr float LN_EPS = 1e-6f;
constexpr float DN_ALPHA = 1.681792830507429f;
constexpr float QSCALE = 0.08838834764831845f * 1.4426950408889634f;
constexpr float LOG2E = 1.4426950408889634f;

constexpr size_t MiB = 1u << 20;
constexpr size_t WS_CTL = 0, CTL_ZERO_BYTES = 1 * MiB;
constexpr size_t WS_MODS = 1 * MiB;
constexpr size_t WS_ROPE = 2 * MiB;
constexpr size_t WS_KBD = 3 * MiB;
constexpr size_t WS_WQR = 8 * MiB;
constexpr size_t WS_WINT = 40 * MiB;
constexpr size_t WS_WOUTT = 112 * MiB;
constexpr size_t WS_WEFFT = 144 * MiB;
constexpr size_t WS_X = 176 * MiB;
constexpr size_t WS_H = 308 * MiB;
constexpr size_t WS_PROJ = 374 * MiB;
constexpr size_t WS_MIX = 523 * MiB;
constexpr size_t WS_SC = 589 * MiB;
constexpr size_t WS_UT = 721 * MiB;
constexpr size_t WS_VT = 849 * MiB;
constexpr size_t WS_US = 977 * MiB;
constexpr size_t WS_VS = 978 * MiB;
constexpr size_t WS_END = 979 * MiB;

constexpr int CW_BAR = 4096;

namespace pg8 {
constexpr int BM = 256, BK = 64, HALF = 128, HTB = HALF * BK * 2, STAGE_BYTES = 8 * HTB, NXCD = 8, WGM = 8;
__host__ __device__ __forceinline__ int lds_byte(int r, int c) { const int st = (r >> 4) * 2 + (c >> 5), rr = r & 15, cc = c & 31, ob = rr * 64 + cc * 2; return st * 1024 + (ob ^ (((ob >> 9) & 1) << 5)); }
__host__ __device__ __forceinline__ void stage_rc(int b, int& R, int& C) { const int st = b / 1024, sb = b % 1024, swz = sb ^ (((sb >> 9) & 1) << 5); R = (st >> 1) * 16 + swz / 64; C = (st & 1) * 32 + (swz % 64) / 2; }
__host__ __device__ __forceinline__ int perm32(int rho) { const int n = rho >> 4, i = rho & 15; return 8 * (i >> 2) + 4 * n + (i & 3); }

struct Unit { int pm, pn; };
struct Gemm { const bf16_t* A; const bf16_t* Bt; int M, N, K; };

struct StaticOrder {
    int nM, nN, nwg, G, c;
    __host__ __device__ void init(int M, int N, int G_, int c_) { nM = M / BM; nN = N / BM; nwg = nM * nN; G = G_; c = c_; }
    __host__ __device__ bool next(int i, Unit& u) const {
        const long L = (long)i * G + c; if (L >= nwg) return false;
        int wgid = (int)L; { const int q = nwg / NXCD, r = nwg % NXCD, xcd = wgid % NXCD, off = wgid / NXCD; wgid = (xcd < r ? xcd * (q + 1) : r * (q + 1) + (xcd - r) * q) + off; }
        const int nig = WGM * nN, gid = wgid / nig, fm = gid * WGM, gsz = (nM - fm) < WGM ? (nM - fm) : WGM;
        u.pm = fm + ((wgid % nig) % gsz); u.pn = (wgid % nig) / gsz; return true;
    }
    __device__ __forceinline__ int btile(const Unit& u) const { return u.pn; }
    __device__ __forceinline__ void a_ready(const Unit&) const {}
    __device__ __forceinline__ void done(const Unit&) const {}
};
struct BatchOrder {
    int G, c;
    __device__ bool next(int i, Unit& u) const { const int L = i * G + c; if (L >= 256) return false; u.pm = L >> 3; u.pn = L & 7; return true; }
    __device__ __forceinline__ int btile(const Unit& u) const { return u.pm * 8 + u.pn; }
    __device__ __forceinline__ void a_ready(const Unit&) const {}
    __device__ __forceinline__ void done(const Unit&) const {}
};

__device__ __forceinline__ unsigned cvt_pk_bf16(float lo, float hi) { f32x2 x = {lo, hi}; bf16x2_t y = __builtin_convertvector(x, bf16x2_t); return __builtin_bit_cast(unsigned, y); }

struct EpiBf16 {
    static constexpr bool PERM = true;
    bf16_t* O; int ldc;
    __device__ __forceinline__ void operator()(const f32x4 (&acc)[2][2][4][2], const Unit& u, int wr, int wc, int fr, int fq) const {
        const int row0 = u.pm * BM + wr * 64 + fr, col0 = u.pn * BM + wc * 32 + 8 * fq;
#pragma unroll
        for (int ai = 0; ai < 2; ++ai)
#pragma unroll
            for (int m = 0; m < 4; ++m) { bf16_t* rowp = O + (size_t)(row0 + ai * HALF + m * 16) * ldc + col0;
#pragma unroll
                for (int bj = 0; bj < 2; ++bj) { const f32x4 v0 = acc[ai][bj][m][0], v1 = acc[ai][bj][m][1];
                    u32x4 w; w.x = cvt_pk_bf16(v0[0], v0[1]); w.y = cvt_pk_bf16(v0[2], v0[3]); w.z = cvt_pk_bf16(v1[0], v1[1]); w.w = cvt_pk_bf16(v1[2], v1[3]);
                    *(u32x4*)(rowp + bj * HALF) = w; } }
    }
};
struct EpiF32 {
    static constexpr bool PERM = false;
    float* C; int ldc;
    __device__ __forceinline__ void operator()(const f32x4 (&acc)[2][2][4][2], const Unit& u, int wr, int wc, int fr, int fq) const {
        const int row0 = u.pm * BM + wr * 64 + fr, col0 = u.pn * BM + wc * 32 + 4 * fq;
#pragma unroll
        for (int ai = 0; ai < 2; ++ai)
#pragma unroll
            for (int m = 0; m < 4; ++m) { float* rowp = C + (size_t)(row0 + ai * HALF + m * 16) * ldc + col0;
#pragma unroll
                for (int bj = 0; bj < 2; ++bj)
#pragma unroll
                    for (int n = 0; n < 2; ++n) *(f32x4*)(rowp + bj * HALF + n * 16) = acc[ai][bj][m][n]; }
    }
};
struct EpiResid {
    static constexpr bool PERM = true;
    const float* x32_lat; const float* x32_ctx;
    bf16_t* X; const float* gate;
    __device__ __forceinline__ void operator()(const f32x4 (&acc)[2][2][4][2], const Unit& u, int wr, int wc, int fr, int fq) const {
        const int rt = u.pm * BM;
        const int mr = rt < TL ? rt / SEQ : 2;
        const int row0 = rt + wr * 64 + fr, col0 = u.pn * BM + wc * 32 + 8 * fq;
        f32x4 gv[2][2];
#pragma unroll
        for (int bj = 0; bj < 2; ++bj)
#pragma unroll
            for (int n = 0; n < 2; ++n) gv[bj][n] = *(const f32x4*)(gate + (size_t)mr * 12288 + col0 + bj * HALF + 4 * n);
#pragma unroll
        for (int ai = 0; ai < 2; ++ai)
#pragma unroll
            for (int m = 0; m < 4; ++m) { const int row = row0 + ai * HALF + m * 16;
#pragma unroll
                for (int bj = 0; bj < 2; ++bj) {
                    f32x4 x0, x1;
                    if (x32_lat) { const float* xp = (row < TL ? x32_lat + (size_t)row * D : x32_ctx + (size_t)(row - TL) * D) + col0 + bj * HALF; x0 = *(const f32x4*)xp; x1 = *(const f32x4*)(xp + 4); }
                    else { const u32x4 w = *(const u32x4*)(X + (size_t)row * D + col0 + bj * HALF);
                        x0 = (f32x4){__uint_as_float(w.x << 16), __uint_as_float(w.x & 0xffff0000u), __uint_as_float(w.y << 16), __uint_as_float(w.y & 0xffff0000u)};
                        x1 = (f32x4){__uint_as_float(w.z << 16), __uint_as_float(w.z & 0xffff0000u), __uint_as_float(w.w << 16), __uint_as_float(w.w & 0xffff0000u)}; }
                    const f32x4 r0 = x0 * DN_ALPHA + gv[bj][0] * acc[ai][bj][m][0], r1 = x1 * DN_ALPHA + gv[bj][1] * acc[ai][bj][m][1];
                    u32x4 o; o.x = cvt_pk_bf16(r0[0], r0[1]); o.y = cvt_pk_bf16(r0[2], r0[3]); o.z = cvt_pk_bf16(r1[0], r1[1]); o.w = cvt_pk_bf16(r1[2], r1[3]);
                    *(u32x4*)(X + (size_t)row * D + col0 + bj * HALF) = o; } }
    }
};

template <class Epi, class Sched, bool ALIGN_EPI = false, bool SP2 = false>
__device__ __forceinline__ void gemm_phase(LAS unsigned char* lds, const Gemm g, const Sched& S, const Epi& E) {
    int tid = threadIdx.x; asm volatile("" : "+v"(tid));
    const int wid = __builtin_amdgcn_readfirstlane(tid >> 6), lane = tid & 63, wr = wid >> 2, wc = wid & 3, fr = lane & 15, fq = lane >> 4;
    const int K = g.K, nt = K / BK;
    unsigned voffA[2], voffB[2];
#pragma unroll
    for (int i = 0; i < 2; ++i) { int R, C; stage_rc(tid * 16 + i * 8192, R, C); const int Rb = Epi::PERM ? ((R & ~31) + perm32(R & 31)) : R;
        voffA[i] = (unsigned)(R * K + C) * 2u; voffB[i] = (unsigned)(Rb * K + C) * 2u; }
    const size_t kstep = (size_t)(BK * 2);
    const size_t hstep = (size_t)HALF * K * 2;
    const size_t tstep = 2 * hstep;
    const unsigned ldsw = (unsigned)wid * 1024u;
    const int aoff = lds_byte(wr * 64 + fr, fq * 8), boff = lds_byte(wc * 32 + fr, fq * 8);
#define PG8_SA(b, h) (((b) * 2 + (h)) * HTB)
#define PG8_SB(b, h) ((4 + (b) * 2 + (h)) * HTB)
#define PG8_STAGE(bufoff, gbase, voff) do { _Pragma("unroll") for (int _i = 0; _i < 2; ++_i) \
        __builtin_amdgcn_global_load_lds((const unsigned*)((const char*)(gbase) + (voff)[_i]), (LAS unsigned*)(lds + (bufoff) + ldsw + _i * 8192), 16, 0, 0); } while (0)
#define PG8_LDA(dst, b, h) do { _Pragma("unroll") for (int m = 0; m < 4; ++m) _Pragma("unroll") for (int k = 0; k < 2; ++k) dst[m][k] = *(const LAS bf16x8*)(lds + PG8_SA(b, h) + aoff + m * 2048 + k * 1024); } while (0)
#define PG8_LDB(dst, b, h) do { _Pragma("unroll") for (int n = 0; n < 2; ++n) _Pragma("unroll") for (int k = 0; k < 2; ++k) dst[n][k] = *(const LAS bf16x8*)(lds + PG8_SB(b, h) + boff + n * 2048 + k * 1024); } while (0)
#define PG8_MMA(ai, bj, At, Bt) do { __builtin_amdgcn_s_setprio(1); _Pragma("unroll") for (int m = 0; m < 4; ++m) _Pragma("unroll") for (int n = 0; n < 2; ++n) _Pragma("unroll") for (int k = 0; k < 2; ++k) \
        acc[ai][bj][m][n] = __builtin_amdgcn_mfma_f32_16x16x32_bf16(Bt[n][k], At[m][k], acc[ai][bj][m][n], 0, 0, 0); __builtin_amdgcn_s_setprio(0); } while (0)
#define PG8_WAIT_V(n) asm volatile("s_waitcnt vmcnt(" #n ")" ::: "memory")
#define PG8_WAIT_L(n) asm volatile("s_waitcnt lgkmcnt(" #n ")" ::: "memory")
#define PG8_BAR __builtin_amdgcn_s_barrier()
#define PG8_SCHED __builtin_amdgcn_sched_barrier(0)
    Unit cur, nxt; int ui = 0;
    if (!S.next(0, cur)) return;
    f32x4 acc[2][2][4][2];
#pragma unroll
    for (int a = 0; a < 2; ++a)
#pragma unroll
        for (int b = 0; b < 2; ++b)
#pragma unroll
            for (int m = 0; m < 4; ++m)
#pragma unroll
                for (int n = 0; n < 2; ++n) acc[a][b][m][n] = (f32x4){0.f, 0.f, 0.f, 0.f};
    bf16x8 At[4][2], B0[2][2], B1[2][2];
    const char* cA = (const char*)g.A + (size_t)cur.pm * tstep; const char* cB = (const char*)g.Bt + (size_t)S.btile(cur) * tstep;
    S.a_ready(cur);
    if constexpr (SP2) {
        PG8_STAGE(PG8_SB(0, 0), cB, voffB); PG8_STAGE(PG8_SB(0, 1), cB + hstep, voffB); PG8_STAGE(PG8_SA(0, 0), cA, voffA); PG8_STAGE(PG8_SA(0, 1), cA + hstep, voffA);
        if (wr == 1) PG8_BAR;
        PG8_WAIT_V(2); PG8_BAR;
        PG8_STAGE(PG8_SB(1, 0), cB + kstep, voffB); PG8_STAGE(PG8_SA(1, 0), cA + kstep, voffA); PG8_STAGE(PG8_SB(1, 1), cB + hstep + kstep, voffB);
        PG8_WAIT_V(6); PG8_BAR;
    } else {
        PG8_STAGE(PG8_SB(0, 0), cB, voffB); PG8_STAGE(PG8_SA(0, 0), cA, voffA); PG8_STAGE(PG8_SB(0, 1), cB + hstep, voffB); PG8_STAGE(PG8_SA(0, 1), cA + hstep, voffA);
        if (wr == 1) PG8_BAR;
        PG8_WAIT_V(4); PG8_BAR;
        PG8_STAGE(PG8_SB(1, 0), cB + kstep, voffB); PG8_STAGE(PG8_SA(1, 0), cA + kstep, voffA); PG8_STAGE(PG8_SB(1, 1), cB + hstep + kstep, voffB);
        PG8_WAIT_V(6); PG8_BAR;
    }
    for (;;) {
        const bool has_next = S.next(ui + 1, nxt);
        const char* nA = has_next ? (const char*)g.A + (size_t)nxt.pm * tstep : cA; const char* nB = has_next ? (const char*)g.Bt + (size_t)S.btile(nxt) * tstep : cB;
        for (int t = 0; t < nt; t += 2) {
            const bool last = (t == nt - 2);
            const char* a1 = cA + (size_t)(t + 1) * kstep;
            const char* a2 = last ? nA : cA + (size_t)(t + 2) * kstep; const char* b2 = last ? nB : cB + (size_t)(t + 2) * kstep;
            const char* a3 = a2 + kstep; const char* b3 = b2 + kstep;
            if (last && has_next) S.a_ready(nxt);
            if constexpr (SP2) {
            PG8_LDB(B0, 0, 0); PG8_LDB(B1, 0, 1); PG8_SCHED; PG8_LDA(At, 0, 0); PG8_STAGE(PG8_SA(1, 1), a1 + hstep, voffA);
            PG8_WAIT_V(8); PG8_WAIT_L(0); PG8_BAR; PG8_MMA(0, 0, At, B0); PG8_MMA(0, 1, At, B1); PG8_BAR; PG8_SCHED;
            PG8_LDA(At, 0, 1); PG8_STAGE(PG8_SB(0, 0), b2, voffB); PG8_STAGE(PG8_SB(0, 1), b2 + hstep, voffB); PG8_STAGE(PG8_SA(0, 0), a2, voffA);
            PG8_WAIT_V(8); PG8_WAIT_L(0); PG8_BAR; PG8_MMA(1, 0, At, B0); PG8_MMA(1, 1, At, B1); PG8_BAR; PG8_SCHED;
            PG8_LDB(B0, 1, 0); PG8_LDB(B1, 1, 1); PG8_SCHED; PG8_LDA(At, 1, 0); PG8_STAGE(PG8_SA(0, 1), a2 + hstep, voffA);
            PG8_WAIT_V(8); PG8_WAIT_L(0); PG8_BAR; PG8_MMA(0, 0, At, B0); PG8_MMA(0, 1, At, B1); PG8_BAR; PG8_SCHED;
            PG8_LDA(At, 1, 1); PG8_STAGE(PG8_SB(1, 0), b3, voffB); PG8_STAGE(PG8_SB(1, 1), b3 + hstep, voffB); PG8_STAGE(PG8_SA(1, 0), a3, voffA);
            PG8_WAIT_V(8); PG8_WAIT_L(0); PG8_BAR; PG8_MMA(1, 0, At, B0); PG8_MMA(1, 1, At, B1); PG8_BAR; PG8_SCHED;
            } else {
            PG8_LDB(B0, 0, 0); PG8_SCHED; PG8_LDA(At, 0, 0); PG8_STAGE(PG8_SA(1, 1), a1 + hstep, voffA);
            PG8_WAIT_L(8); PG8_BAR; PG8_WAIT_L(0); PG8_MMA(0, 0, At, B0); PG8_BAR; PG8_SCHED;
            PG8_LDB(B1, 0, 1); PG8_STAGE(PG8_SB(0, 0), b2, voffB);
            PG8_BAR; PG8_WAIT_L(0); PG8_MMA(0, 1, At, B1); PG8_BAR;
            PG8_LDA(At, 0, 1); PG8_STAGE(PG8_SA(0, 0), a2, voffA);
            PG8_BAR; PG8_WAIT_L(0); PG8_MMA(1, 0, At, B0); PG8_BAR; PG8_SCHED;
            PG8_STAGE(PG8_SB(0, 1), b2 + hstep, voffB);
            PG8_WAIT_V(6); PG8_BAR; PG8_MMA(1, 1, At, B1); PG8_BAR;
            PG8_LDB(B0, 1, 0); PG8_SCHED; PG8_LDA(At, 1, 0); PG8_STAGE(PG8_SA(0, 1), a2 + hstep, voffA);
            PG8_WAIT_L(8); PG8_BAR; PG8_WAIT_L(0); PG8_MMA(0, 0, At, B0); PG8_BAR; PG8_SCHED;
            PG8_LDB(B1, 1, 1); PG8_STAGE(PG8_SB(1, 0), b3, voffB);
            PG8_BAR; PG8_WAIT_L(0); PG8_MMA(0, 1, At, B1); PG8_BAR;
            PG8_LDA(At, 1, 1); PG8_STAGE(PG8_SA(1, 0), a3, voffA);
            PG8_BAR; PG8_WAIT_L(0); PG8_MMA(1, 0, At, B0); PG8_BAR; PG8_SCHED;
            PG8_STAGE(PG8_SB(1, 1), b3 + hstep, voffB);
            PG8_WAIT_V(6); PG8_BAR; PG8_MMA(1, 1, At, B1); PG8_BAR;
            }
        }
        if constexpr (ALIGN_EPI) { if (wr == 0) PG8_BAR; }
        E(acc, cur, wr, wc, fr, fq); S.done(cur);
        if (!has_next) break;
#pragma unroll
        for (int a = 0; a < 2; ++a)
#pragma unroll
            for (int b = 0; b < 2; ++b)
#pragma unroll
                for (int m = 0; m < 4; ++m)
#pragma unroll
                    for (int n = 0; n < 2; ++n) acc[a][b][m][n] = (f32x4){0.f, 0.f, 0.f, 0.f};
        cur = nxt; cA = nA; cB = nB; ++ui;
        if constexpr (ALIGN_EPI) { if (wr == 1) PG8_BAR; }
    }
    PG8_WAIT_V(0);
    if constexpr (!ALIGN_EPI) { if (wr == 0) PG8_BAR; }
    PG8_BAR;
#undef PG8_SA
#undef PG8_SB
#undef PG8_STAGE
#undef PG8_LDA
#undef PG8_LDB
#undef PG8_MMA
#undef PG8_WAIT_V
#undef PG8_WAIT_L
#undef PG8_BAR
#undef PG8_SCHED
}
}

#define XB_TMO      128
#define XB_XCNT(j)  (256  + 64 * (j))
#define XB_XSUB(j)  (1280 + 64 * (j))
#define XB_XGEN(j)  (2304 + 64 * (j))
#define XB_TOP      3328
#define XB_TOPGEN   3392
#define XCD_BAR_WORDS 3456
#define XB_SPIN_CAP (1u << 18)

__device__ __forceinline__ unsigned xb_ld(unsigned* p)              { return __hip_atomic_load(p, __ATOMIC_RELAXED, __HIP_MEMORY_SCOPE_AGENT); }
__device__ __forceinline__ unsigned xb_add(unsigned* p, unsigned v) { return __hip_atomic_fetch_add(p, v, __ATOMIC_RELAXED, __HIP_MEMORY_SCOPE_AGENT); }
__device__ __forceinline__ unsigned xb_xcc_id() { return (unsigned)__builtin_amdgcn_s_getreg((3 << 11) | 20) & 0xFu; }
#define XB_SPIN(cond, bar) do { unsigned _sp = 0; while (cond) { __builtin_amdgcn_s_sleep(1); \
    if ((++_sp & 255u) == 0u) { if (xb_ld(&(bar)[XB_TMO])) break; if (_sp > XB_SPIN_CAP) { atomicAdd(&(bar)[XB_TMO], 1u); break; } } } } while (0)

struct XcdBarrier { unsigned* bar; unsigned x; volatile LAS unsigned* st; };

__device__ __forceinline__ XcdBarrier xcd_barrier_post(unsigned* bar, volatile LAS unsigned* st) {
    XcdBarrier b; b.bar = bar; b.x = xb_xcc_id(); b.st = st;
    if (threadIdx.x == 0) (void)xb_add(&bar[XB_XCNT(b.x)], 1u);
    return b;
}
__device__ __forceinline__ void xcd_barrier_complete(unsigned* bar, unsigned x, unsigned& nloc, unsigned& nx) {
    const unsigned G = gridDim.x * gridDim.y * gridDim.z;
    unsigned sum, cnt, mine, sp = 0u;
    for (;;) {
        sum = 0u; cnt = 0u; mine = 0u;
#pragma unroll
        for (unsigned j = 0; j < 16; ++j) { const unsigned c = xb_ld(&bar[XB_XCNT(j)]); sum += c; cnt += (c > 0u) ? 1u : 0u; mine = (j == x) ? c : mine; }
        if (sum == G) break;
        __builtin_amdgcn_s_sleep(1);
        if ((++sp & 255u) == 0u) { if (xb_ld(&bar[XB_TMO])) break; if (sp > XB_SPIN_CAP) { atomicAdd(&bar[XB_TMO], 1u); break; } }
    }
    nloc = mine > 0u ? mine : 1u; nx = cnt > 0u ? cnt : 1u;
}
__device__ __forceinline__ void xcd_barrier(const XcdBarrier& b) {
    asm volatile("s_waitcnt vmcnt(0)" ::: "memory");
    __syncthreads();
    if (threadIdx.x == 0) {
        unsigned* bar = b.bar;
        __builtin_amdgcn_s_waitcnt(0);
        unsigned nloc = b.st[0], nx = b.st[1];
        if (nloc == 0u) { xcd_barrier_complete(bar, b.x, nloc, nx); b.st[0] = nloc; b.st[1] = nx; }
        const unsigned old = xb_add(&bar[XB_XSUB(b.x)], 1u);
        const unsigned gen = old / nloc;
        if (old + 1u == (gen + 1u) * nloc) {
            __builtin_amdgcn_fence(__ATOMIC_RELEASE, "agent");
            asm volatile("s_waitcnt vmcnt(0)" ::: "memory");
            const unsigned og = xb_add(&bar[XB_TOP], 1u);
            const unsigned tg = og / nx;
            if (og + 1u == (tg + 1u) * nx) xb_add(&bar[XB_TOPGEN], 1u);
            else XB_SPIN(xb_ld(&bar[XB_TOPGEN]) == tg, bar);
            __builtin_amdgcn_fence(__ATOMIC_ACQUIRE, "agent");
            xb_add(&bar[XB_XGEN(b.x)], 1u);
            asm volatile("s_waitcnt vmcnt(0)" ::: "memory");
        } else {
            XB_SPIN(xb_ld(&bar[XB_XGEN(b.x)]) == gen, bar);
            __builtin_amdgcn_fence(__ATOMIC_ACQUIRE, "agent");
            asm volatile("s_waitcnt vmcnt(0)" ::: "memory");
        }
    }
    __syncthreads();
}

constexpr int NWAVES = 8;
constexpr int RING_BYTES = 131072;
constexpr int LDSCTL_OFF = RING_BYTES, MISC_OFF = LDSCTL_OFF + 320;
constexpr int LDS_BYTES = 147456;
constexpr int NPHASE = 2 + 6 * NLAYER;

#define LDS_WAIT() asm volatile("s_waitcnt lgkmcnt(0)" ::: "memory")

struct Args { const float* in[20]; float* out; unsigned char* ws; int ph_lo, ph_hi, li, pad; };

#define CAS __attribute__((address_space(4)))
struct Frame {
    LAS unsigned char* lds;
    int tid, lane, wave, G, gw, NGW;
    const CAS unsigned char* ka;
    __device__ __forceinline__ const float* x() const { return *(const float* const CAS*)(ka + 0); }
    __device__ __forceinline__ const float* c() const { return *(const float* const CAS*)(ka + 8); }
    __device__ __forceinline__ const float* ctx() const { return *(const float* const CAS*)(ka + 16); }
    __device__ __forceinline__ const float* c_ctx() const { return *(const float* const CAS*)(ka + 24); }
    __device__ __forceinline__ const float* w_ada() const { return *(const float* const CAS*)(ka + 32); }
    __device__ __forceinline__ const float* b_ada() const { return *(const float* const CAS*)(ka + 40); }
    __device__ __forceinline__ const float* w_in() const { return *(const float* const CAS*)(ka + 48); }
    __device__ __forceinline__ const float* conv_w() const { return *(const float* const CAS*)(ka + 56); }
    __device__ __forceinline__ const float* sink() const { return *(const float* const CAS*)(ka + 64); }
    __device__ __forceinline__ const float* g_attn() const { return *(const float* const CAS*)(ka + 72); }
    __device__ __forceinline__ const float* g_conv() const { return *(const float* const CAS*)(ka + 80); }
    __device__ __forceinline__ const float* w_out() const { return *(const float* const CAS*)(ka + 88); }
    __device__ __forceinline__ const float* ln1_g() const { return *(const float* const CAS*)(ka + 96); }
    __device__ __forceinline__ const float* ln1_b() const { return *(const float* const CAS*)(ka + 104); }
    __device__ __forceinline__ const float* wq() const { return *(const float* const CAS*)(ka + 112); }
    __device__ __forceinline__ const float* keys() const { return *(const float* const CAS*)(ka + 120); }
    __device__ __forceinline__ const float* pu() const { return *(const float* const CAS*)(ka + 128); }
    __device__ __forceinline__ const float* pv() const { return *(const float* const CAS*)(ka + 136); }
    __device__ __forceinline__ const float* ln2_g() const { return *(const float* const CAS*)(ka + 144); }
    __device__ __forceinline__ const float* ln2_b() const { return *(const float* const CAS*)(ka + 152); }
    __device__ __forceinline__ float* out() const { return *(float* const CAS*)(ka + 160); }
    __device__ __forceinline__ unsigned char* ws() const { return *(unsigned char* const CAS*)(ka + 168); }
    __device__ __forceinline__ float* MODS() const { return (float*)(ws() + WS_MODS); }
    __device__ __forceinline__ float* ROPE() const { return (float*)(ws() + WS_ROPE); }
    __device__ __forceinline__ bf16_t* X() const { return (bf16_t*)(ws() + WS_X); }
    __device__ __forceinline__ float* SC() const { return (float*)(ws() + WS_SC); }
    __device__ __forceinline__ bf16_t* KBD() const { return (bf16_t*)(ws() + WS_KBD); }
    __device__ __forceinline__ bf16_t* WQR() const { return (bf16_t*)(ws() + WS_WQR); }
    __device__ __forceinline__ bf16_t* WINT() const { return (bf16_t*)(ws() + WS_WINT); }
    __device__ __forceinline__ bf16_t* WOUTT() const { return (bf16_t*)(ws() + WS_WOUTT); }
    __device__ __forceinline__ bf16_t* WEFFT() const { return (bf16_t*)(ws() + WS_WEFFT); }
    __device__ __forceinline__ bf16_t* H() const { return (bf16_t*)(ws() + WS_H); }
    __device__ __forceinline__ bf16_t* PROJ() const { return (bf16_t*)(ws() + WS_PROJ); }
    __device__ __forceinline__ bf16_t* MIX() const { return (bf16_t*)(ws() + WS_MIX); }
    __device__ __forceinline__ unsigned char* UT() const { return (unsigned char*)(ws() + WS_UT); }
    __device__ __forceinline__ unsigned char* VT() const { return (unsigned char*)(ws() + WS_VT); }
    __device__ __forceinline__ float* US() const { return (float*)(ws() + WS_US); }
    __device__ __forceinline__ float* VS() const { return (float*)(ws() + WS_VS); }
};

__device__ __forceinline__ void frame_ids(Frame& F) {
    int tz = threadIdx.x; asm volatile("" : "+v"(tz));
    F.tid = tz; F.lane = tz & 63; F.wave = __builtin_amdgcn_readfirstlane(tz >> 6);
    F.gw = blockIdx.x * NWAVES + F.wave;
    const CAS unsigned char* k = (const CAS unsigned char*)__builtin_amdgcn_kernarg_segment_ptr(); asm volatile("" : "+s"(k)); F.ka = k;
}
template <int CTRL> __device__ __forceinline__ int dpp_i(int v) { return __builtin_amdgcn_update_dpp(0, v, CTRL, 0xf, 0xf, true); }
template <int CTRL> __device__ __forceinline__ float dpp_f(float v) { return __int_as_float(dpp_i<CTRL>(__float_as_int(v))); }
constexpr int DPP_XOR1 = 0xB1, DPP_XOR2 = 0x4E, DPP_HMIRROR = 0x141, DPP_ROR4 = 0x124, DPP_ROR8 = 0x128;
__device__ __forceinline__ float wave_sum_u(float v) {
    v += dpp_f<DPP_XOR1>(v); v += dpp_f<DPP_XOR2>(v); v += dpp_f<DPP_ROR4>(v); v += dpp_f<DPP_ROR8>(v);
    const float r0 = __int_as_float(__builtin_amdgcn_readlane(__float_as_int(v), 0)), r1 = __int_as_float(__builtin_amdgcn_readlane(__float_as_int(v), 16));
    const float r2 = __int_as_float(__builtin_amdgcn_readlane(__float_as_int(v), 32)), r3 = __int_as_float(__builtin_amdgcn_readlane(__float_as_int(v), 48));
    return (r0 + r1) + (r2 + r3);
}
__device__ __forceinline__ float wave_max_u(float v) {
    v = fmaxf(v, dpp_f<DPP_XOR1>(v)); v = fmaxf(v, dpp_f<DPP_XOR2>(v)); v = fmaxf(v, dpp_f<DPP_ROR4>(v)); v = fmaxf(v, dpp_f<DPP_ROR8>(v));
    const float r0 = __int_as_float(__builtin_amdgcn_readlane(__float_as_int(v), 0)), r1 = __int_as_float(__builtin_amdgcn_readlane(__float_as_int(v), 16));
    const float r2 = __int_as_float(__builtin_amdgcn_readlane(__float_as_int(v), 32)), r3 = __int_as_float(__builtin_amdgcn_readlane(__float_as_int(v), 48));
    return fmaxf(fmaxf(r0, r1), fmaxf(r2, r3));
}
__device__ __forceinline__ float wave_sum(float v) { return wave_sum_u(v); }
__device__ __forceinline__ unsigned pk2(float lo, float hi) { return pg8::cvt_pk_bf16(lo, hi); }
__device__ __forceinline__ float bf_lo(unsigned u) { return __uint_as_float(u << 16); }
__device__ __forceinline__ float bf_hi(unsigned u) { return __uint_as_float(u & 0xffff0000u); }
__device__ __forceinline__ int modrow(int t) { return t < TL ? t / SEQ : 2; }

__device__ __forceinline__ void transpose_item(const float* W, int K, int N, bf16_t* WT, LAS float* scr, int item, int lane) {
    const int nblk = N / 32, kb = item / nblk, nb = item % nblk, k0 = 64 * kb, n0 = 32 * nb;
#pragma unroll 8
    for (int i = 0; i < 32; ++i) { const int kk = 2 * i + (lane >> 5); scr[kk * 33 + (lane & 31)] = W[(size_t)(k0 + kk) * N + n0 + (lane & 31)]; }
    LDS_WAIT(); asm volatile("" ::: "memory");
    const int c = lane & 7;
#pragma unroll
    for (int j = 0; j < 4; ++j) { const int n = (lane >> 3) + 8 * j; const LAS float* s = scr + (8 * c) * 33 + n;
        u32x4 o; o.x = pk2(s[0 * 33], s[1 * 33]); o.y = pk2(s[2 * 33], s[3 * 33]); o.z = pk2(s[4 * 33], s[5 * 33]); o.w = pk2(s[6 * 33], s[7 * 33]);
        *(u32x4*)(WT + (size_t)(n0 + n) * K + k0 + 8 * c) = o; }
    LDS_WAIT(); asm volatile("" ::: "memory");
}

__device__ __forceinline__ void cvt_row_bf16(const float* src, bf16_t* dst, int lane) {
    const f32x4* s = (const f32x4*)src + lane; u32x2* d = (u32x2*)dst + lane;
    f32x4 v[8];
#pragma unroll
    for (int j = 0; j < 8; ++j) v[j] = __builtin_nontemporal_load(s + 64 * j);
#pragma unroll
    for (int j = 0; j < 8; ++j) { u32x2 o; o.x = pk2(v[j].x, v[j].y); o.y = pk2(v[j].z, v[j].w); d[64 * j] = o; }
}

struct RowF32 { f32x4 v[4][2]; };
__device__ __forceinline__ void row_load_nt(RowF32& R, const float* src, int lane) {
    const f32x4* s = (const f32x4*)src + 2 * lane;
#pragma unroll
    for (int j = 0; j < 4; ++j) { R.v[j][0] = __builtin_nontemporal_load(s + 128 * j); R.v[j][1] = __builtin_nontemporal_load(s + 128 * j + 1); }
}
template <int FMT>
__device__ __forceinline__ void cvt_row_lp(const RowF32& R, unsigned char* dst, float* inv, int lane) {
    constexpr float QMAX = FMT == 8 ? 224.f : 6.f;
    float am = 0.f;
#pragma unroll
    for (int j = 0; j < 4; ++j)
#pragma unroll
        for (int q = 0; q < 2; ++q) am = fmaxf(fmaxf(am, fmaxf(fabsf(R.v[j][q].x), fabsf(R.v[j][q].y))), fmaxf(fabsf(R.v[j][q].z), fabsf(R.v[j][q].w)));
    am = wave_max_u(am);
    const float sc = am > 0.f ? QMAX / am : 1.f;
#pragma unroll
    for (int j = 0; j < 4; ++j) {
        if constexpr (FMT == 8) {
            u32x2 w;
#pragma unroll
            for (int q = 0; q < 2; ++q) { int t = __builtin_amdgcn_cvt_pk_fp8_f32(R.v[j][q].x * sc, R.v[j][q].y * sc, 0, false); t = __builtin_amdgcn_cvt_pk_fp8_f32(R.v[j][q].z * sc, R.v[j][q].w * sc, t, true); w[q] = (unsigned)t; }
            *((u32x2*)dst + lane + 64 * j) = w;
        } else {
            unsigned w = 0u;
            w = __builtin_amdgcn_cvt_scalef32_pk_fp4_f32(w, R.v[j][0].x * sc, R.v[j][0].y * sc, 1.0f, 0);
            w = __builtin_amdgcn_cvt_scalef32_pk_fp4_f32(w, R.v[j][0].z * sc, R.v[j][0].w * sc, 1.0f, 1);
            w = __builtin_amdgcn_cvt_scalef32_pk_fp4_f32(w, R.v[j][1].x * sc, R.v[j][1].y * sc, 1.0f, 2);
            w = __builtin_amdgcn_cvt_scalef32_pk_fp4_f32(w, R.v[j][1].z * sc, R.v[j][1].w * sc, 1.0f, 3);
            *((unsigned*)dst + lane + 64 * j) = w;
        }
    }
    if (lane == 0) *inv = am > 0.f ? am * (1.f / QMAX) : 1.f;
}
template <int FMT> struct LpRow;
template <> struct LpRow<8> { u32x4 a, b;
    __device__ __forceinline__ void load(const unsigned char* rowp, int lane) { a = *(const u32x4*)(rowp + 32 * lane); b = *(const u32x4*)(rowp + 32 * lane + 16); }
    template <class Fn> __device__ __forceinline__ void each(Fn&& f) const {
#pragma unroll
        for (int w = 0; w < 4; ++w) { const f32x2 l0 = __builtin_amdgcn_cvt_pk_f32_fp8((int)a[w], false), h0 = __builtin_amdgcn_cvt_pk_f32_fp8((int)a[w], true);
            f(4 * w, l0.x, l0.y); f(4 * w + 2, h0.x, h0.y); }
#pragma unroll
        for (int w = 0; w < 4; ++w) { const f32x2 l0 = __builtin_amdgcn_cvt_pk_f32_fp8((int)b[w], false), h0 = __builtin_amdgcn_cvt_pk_f32_fp8((int)b[w], true);
            f(16 + 4 * w, l0.x, l0.y); f(16 + 4 * w + 2, h0.x, h0.y); }
    } };
template <> struct LpRow<4> { u32x4 a;
    __device__ __forceinline__ void load(const unsigned char* rowp, int lane) { a = *(const u32x4*)(rowp + 16 * lane); }
    template <class Fn> __device__ __forceinline__ void each(Fn&& f) const {
#pragma unroll
        for (int w = 0; w < 4; ++w) {
            const f32x2 d0 = __builtin_amdgcn_cvt_scalef32_pk_f32_fp4(a[w], 1.0f, 0), d1 = __builtin_amdgcn_cvt_scalef32_pk_f32_fp4(a[w], 1.0f, 1);
            const f32x2 d2 = __builtin_amdgcn_cvt_scalef32_pk_f32_fp4(a[w], 1.0f, 2), d3 = __builtin_amdgcn_cvt_scalef32_pk_f32_fp4(a[w], 1.0f, 3);
            f(8 * w, d0.x, d0.y); f(8 * w + 2, d1.x, d1.y); f(8 * w + 4, d2.x, d2.y); f(8 * w + 6, d3.x, d3.y); }
    } };

__device__ __forceinline__ void row_stats(const f32x4 (&v)[8], float& mean, float& rstd) {
    float s = 0.f;
#pragma unroll
    for (int j = 0; j < 8; ++j) s += (v[j].x + v[j].y) + (v[j].z + v[j].w);
    mean = wave_sum(s) * (1.f / D);
    float s2 = 0.f;
#pragma unroll
    for (int j = 0; j < 8; ++j) { const f32x4 d = v[j] - mean; s2 += (d.x * d.x + d.y * d.y) + (d.z * d.z + d.w * d.w); }
    rstd = 1.f / sqrtf(wave_sum(s2) * (1.f / D) + LN_EPS);
}
__device__ __forceinline__ void modulate_store(const f32x4 (&v)[8], const float* shift, const float* scale, bf16_t* dst, int lane) {
    float mean, rstd; row_stats(v, mean, rstd);
    u32x2* d = (u32x2*)dst + lane;
#pragma unroll
    for (int j = 0; j < 8; ++j) { const f32x4 sc = *((const f32x4*)scale + lane + 64 * j), sh = *((const f32x4*)shift + lane + 64 * j);
        const f32x4 y = (v[j] - mean) * rstd * (sc + 1.f) + sh;
        u32x2 o; o.x = pk2(y.x, y.y); o.y = pk2(y.z, y.w); d[64 * j] = o; }
}

__device__ __forceinline__ void convert_tables(Frame& F, int row0, int row1, int w0, int wstride) {
    RowF32 ru, rv, nu, nv;
    int row = row0 + w0;
    if (row < row1) { row_load_nt(ru, F.pu() + (size_t)row * D, F.lane); row_load_nt(rv, F.pv() + (size_t)row * D, F.lane); }
    while (row < row1) {
        const int nrow = row + wstride;
        if (nrow < row1) { row_load_nt(nu, F.pu() + (size_t)nrow * D, F.lane); row_load_nt(nv, F.pv() + (size_t)nrow * D, F.lane); }
        cvt_row_lp<U_FMT>(ru, F.UT() + (size_t)row * UROW, F.US() + row, F.lane);
        cvt_row_lp<V_FMT>(rv, F.VT() + (size_t)row * VROW, F.VS() + row, F.lane);
        ru = nu; rv = nv; row = nrow;
    }
}
__device__ __forceinline__ void convert_in_tail(Frame& F, int layer, int nunits, int part) {
    if (layer + 1 >= NLAYER) return;
    const int G = F.G, rounds = (nunits + G - 1) / G, nlast = nunits - (rounds - 1) * G;
    const int c = (int)blockIdx.x;
    int nshort = G - nlast, sidx = c - nlast;
    if (nshort <= 0) { nshort = G; sidx = c; }
    else if (sidx < 0) return;
    const int r0 = (layer + 1) * NEXP + part * (NEXP / 2);
    convert_tables(F, r0, r0 + NEXP / 2, sidx * NWAVES + F.wave, nshort * NWAVES);
}
__device__ __forceinline__ void p0a_prologue(Frame& F) {
    LAS float* condL = (LAS float*)F.lds;
    LAS float* red = (LAS float*)(F.lds + 24576);
    for (int i = F.tid; i < 3 * D; i += NWAVES * 64) { const int r = i / D, k = i % D; const float v = r < 2 ? F.c()[r * D + k] : F.c_ctx()[k]; condL[i] = v / (1.f + __expf(-v)); }
    __syncthreads();
    for (int item = blockIdx.x; item < 384; item += F.G) {
        const int l = item / 96, n0 = (item % 96) * 128;
        const float* wp = F.w_ada() + ((size_t)l * D + F.wave * 256) * 12288 + n0 + 2 * F.lane;
        f32x2 a0 = {0.f, 0.f}, a1 = {0.f, 0.f}, a2 = {0.f, 0.f};
#pragma unroll 8
        for (int k = 0; k < 256; ++k) { const f32x2 w = __builtin_nontemporal_load((const f32x2*)(wp + (size_t)k * 12288)); const int kk = F.wave * 256 + k;
            a0 += w * condL[kk]; a1 += w * condL[D + kk]; a2 += w * condL[2 * D + kk]; }
        LAS float* rp = red + F.wave * 384 + 2 * F.lane;
        rp[0] = a0.x; rp[1] = a0.y; rp[128] = a1.x; rp[129] = a1.y; rp[256] = a2.x; rp[257] = a2.y;
        __syncthreads();
        if (F.tid < 384) { const int r = F.tid / 128, n = F.tid % 128; float s = 0.f;
#pragma unroll
            for (int w = 0; w < 8; ++w) s += red[w * 384 + r * 128 + n];
            F.MODS()[((size_t)l * 3 + r) * 12288 + n0 + n] = s + F.b_ada()[(size_t)l * 12288 + n0 + n]; }
        __syncthreads();
    }
    LAS float* scr = (LAS float*)(F.lds + 40960 + F.wave * 8448);
    constexpr int I_IN = (D / 64) * (INC / 32), I_OUT = (D / 64) * (D / 32);
    for (int it = F.gw; it < NLAYER * (I_IN + I_OUT); it += F.NGW) {
        const int l = it / (I_IN + I_OUT); int r = it % (I_IN + I_OUT);
        if (r < I_IN) transpose_item(F.w_in() + (size_t)l * D * INC, D, INC, F.WINT() + (size_t)l * INC * D, scr, r, F.lane);
        else transpose_item(F.w_out() + (size_t)l * D * D, D, D, F.WOUTT() + (size_t)l * D * D, scr, r - I_IN, F.lane);
    }
    for (int row = F.gw; row < NLAYER * D; row += F.NGW) {
        const int l = row / D, c = row % D; const f32x4* s = (const f32x4*)(F.wq() + (size_t)row * D) + F.lane;
#pragma unroll
        for (int j = 0; j < 8; ++j) { const f32x4 v = s[64 * j]; u32x2 o; o.x = pk2(v.x, v.y); o.y = pk2(v.z, v.w);
            *((u32x2*)(F.WQR() + ((size_t)(l * 8 + j) * D + c) * 256) + F.lane) = o; }
    }
    for (int row = F.gw; row < 32 * 256; row += F.NGW) {
        const int lh = row >> 8, pk = row & 255, p = pk >> 7;
        u32x2 o = {0u, 0u};
        if ((F.lane >> 5) == p) { const f32x4 v = *((const f32x4*)(F.keys() + ((size_t)lh * 256 + pk) * 128) + (F.lane & 31)); o.x = pk2(v.x, v.y); o.y = pk2(v.z, v.w); }
        *((u32x2*)(F.KBD() + (size_t)row * 256) + F.lane) = o;
    }
    convert_tables(F, 0, NEXP, F.gw, F.NGW);
    for (int i = blockIdx.x * (NWAVES * 64) + F.tid; i < 192 * 32; i += F.G * NWAVES * 64) {
        const int idx = i >> 5, f = i & 31; const float pos = (float)(idx < 128 ? idx : idx - 128);
        const float inv = powf(10000.f, -(float)(2 * f) / 64.f); const float ang = pos * inv;
        F.ROPE()[2 * i] = cosf(ang); F.ROPE()[2 * i + 1] = sinf(ang);
    }
}

__device__ __forceinline__ void p0b_mod0(Frame& F) {
    for (int t = F.gw; t < TT; t += F.NGW) {
        const float* src = t < TL ? F.x() + (size_t)t * D : F.ctx() + (size_t)(t - TL) * D;
        f32x4 v[8];
#pragma unroll
        for (int j = 0; j < 8; ++j) v[j] = *((const f32x4*)src + F.lane + 64 * j);
        const float* mp = F.MODS() + (size_t)modrow(t) * 12288;
        modulate_store(v, mp, mp + D, F.H() + (size_t)t * D, F.lane);
    }
}

constexpr int KP = 272, VP = 320, KS_BYTES = 64 * KP, VS_BYTES = 64 * VP;
struct KVRegs { u32x4 k1, k2, v1, v2; f32x4 cs[4]; };

__device__ __forceinline__ void attn_load_tile(Frame& F, KVRegs& R, int ti, int b, int n, int g) {
    const int key = F.tid >> 3, c8 = F.tid & 7;
    int row, pos = 0;
    if (ti < 6) { pos = (n - 1) * 128 + 64 * ti + key; row = b * SEQ + pos; } else row = TL + b * CTXL + 64 * (ti - 6) + key;
    const bf16_t* base = F.PROJ() + (size_t)row * INC;
    const int d1 = (c8 >> 2) * 64 + (c8 & 3) * 8;
    R.k1 = *(const u32x4*)(base + OFF_K + g * 128 + d1); R.k2 = *(const u32x4*)(base + OFF_K + g * 128 + d1 + 32);
    R.v1 = *(const u32x4*)(base + OFF_V + g * 128 + 8 * c8); R.v2 = *(const u32x4*)(base + OFF_V + g * 128 + 64 + 8 * c8);
    if (ti < 6) { const int tidx = (c8 >> 2) ? 128 + (pos & 63) : (pos >> 6); const f32x4* cp = (const f32x4*)(F.ROPE() + ((size_t)tidx * 32 + (c8 & 3) * 8) * 2);
#pragma unroll
        for (int m = 0; m < 4; ++m) R.cs[m] = cp[m]; }
}
__device__ __forceinline__ void rope8(u32x4& a, u32x4& bq, const f32x4 (&cs)[4], float scale) {
    u32x4 oa, ob;
#pragma unroll
    for (int w = 0; w < 4; ++w) {
        const float x1l = bf_lo(a[w]), x1h = bf_hi(a[w]), x2l = bf_lo(bq[w]), x2h = bf_hi(bq[w]);
        const float cl = cs[w].x, sl = cs[w].y, ch = cs[w].z, sh = cs[w].w;
        oa[w] = pk2((x1l * cl - x2l * sl) * scale, (x1h * ch - x2h * sh) * scale);
        ob[w] = pk2((x2l * cl + x1l * sl) * scale, (x2h * ch + x1h * sh) * scale);
    }
    a = oa; bq = ob;
}
__device__ __forceinline__ void attn_store_tile(Frame& F, KVRegs& R, int ti, int buf) {
    const int key = F.tid >> 3, c8 = F.tid & 7;
    if (ti < 6) rope8(R.k1, R.k2, R.cs, 1.f);
    const int d1 = (c8 >> 2) * 64 + (c8 & 3) * 8;
    LAS unsigned char* kp = F.lds + buf * KS_BYTES + key * KP;
    *(LAS u32x4*)(kp + d1 * 2) = R.k1; *(LAS u32x4*)(kp + (d1 + 32) * 2) = R.k2;
    LAS unsigned char* vp = F.lds + 2 * KS_BYTES + buf * VS_BYTES + key * VP;
    *(LAS u32x4*)(vp + 16 * c8) = R.v1; *(LAS u32x4*)(vp + 128 + 16 * c8) = R.v2;
}

#define MFMA32(a, b, c) __builtin_amdgcn_mfma_f32_32x32x16_bf16((a), (b), (c), 0, 0, 0)

__device__ __forceinline__ void attn_unit(Frame& F, int layer, int u) {
    const bool latent = u < 512;
    int b, n, g, hp;
    if (latent) { hp = u & 1; g = (u >> 1) & 1; n = (u >> 2) & 63; b = u >> 8; }
    else { const int v = u - 512; hp = v & 1; g = (v >> 1) & 1; n = (v >> 2) & 1; b = v >> 3; }
    const int lane = F.lane, r = lane & 31, h = lane >> 5, wave = F.wave;
    const int head = g * 4 + hp * 2 + (wave >> 2), qb = wave & 3;
    const int tq = latent ? b * SEQ + n * 128 + 32 * qb + r : TL + b * CTXL + n * 128 + 32 * qb + r;
    bf16x8 qf[8];
    {
        u32x4 raw[8];
        const bf16_t* qp = F.PROJ() + (size_t)tq * INC + OFF_Q + head * 128 + 8 * h;
#pragma unroll
        for (int ks = 0; ks < 8; ++ks) raw[ks] = *(const u32x4*)(qp + 16 * ks);
        if (latent) {
            const int pos = n * 128 + 32 * qb + r;
#pragma unroll
            for (int half = 0; half < 2; ++half) {
                const int tidx = half ? 128 + (pos & 63) : (pos >> 6);
#pragma unroll
                for (int kk = 0; kk < 2; ++kk) {
                    const f32x4* cp = (const f32x4*)(F.ROPE() + ((size_t)tidx * 32 + 16 * kk + 8 * h) * 2);
                    f32x4 cs[4];
#pragma unroll
                    for (int m = 0; m < 4; ++m) cs[m] = cp[m];
                    rope8(raw[4 * half + kk], raw[4 * half + kk + 2], cs, QSCALE);
                }
            }
        } else {
#pragma unroll
            for (int ks = 0; ks < 8; ++ks)
#pragma unroll
                for (int w = 0; w < 4; ++w) raw[ks][w] = pk2(bf_lo(raw[ks][w]) * QSCALE, bf_hi(raw[ks][w]) * QSCALE);
        }
#pragma unroll
        for (int ks = 0; ks < 8; ++ks) qf[ks] = __builtin_bit_cast(bf16x8, raw[ks]);
    }
    int tlo = 6, nw = 0;
    if (latent) { tlo = (n == 0) ? 2 : 0; const int thi = (n == 63) ? 3 : 5; nw = thi - tlo + 1; }
    const int ntiles = nw + 4;
    f32x16 o[4];
#pragma unroll
    for (int db = 0; db < 4; ++db)
#pragma unroll
        for (int i = 0; i < 16; ++i) o[db][i] = 0.f;
    float m_run = F.sink()[layer * 8 + head] * LOG2E;
    float lsum = h == 0 ? 1.f : 0.f;
    const int iq = 32 * qb + r;
    KVRegs R;
    __syncthreads();
    attn_load_tile(F, R, nw > 0 ? tlo : 6, b, n, g);
    attn_store_tile(F, R, nw > 0 ? tlo : 6, 0);
    __syncthreads();
    const int i16 = lane & 15, tq4 = i16 >> 2, tp = i16 & 3, blk = (lane >> 4) & 1;
    for (int j = 0; j < ntiles; ++j) {
        const int ti = j < nw ? tlo + j : 6 + (j - nw);
        const int buf = j & 1;
        const bool more = j + 1 < ntiles;
        const int tin = (j + 1) < nw ? tlo + j + 1 : 6 + (j + 1 - nw);
        if (more) attn_load_tile(F, R, tin, b, n, g);
        const bool part = ti >= 6 || (ti >= (qb >> 1) && ti <= (qb >> 1) + 4);
        if (part) {
            f32x16 s0, s1;
#pragma unroll
            for (int i = 0; i < 16; ++i) { s0[i] = 0.f; s1[i] = 0.f; }
            const LAS unsigned char* kb = F.lds + buf * KS_BYTES + r * KP + h * 16;
#pragma unroll
            for (int ks = 0; ks < 8; ++ks) {
                const bf16x8 a0 = *(const LAS bf16x8*)(kb + ks * 32), a1 = *(const LAS bf16x8*)(kb + 32 * KP + ks * 32);
                s0 = MFMA32(a0, qf[ks], s0); s1 = MFMA32(a1, qf[ks], s1);
            }
            float mx = -INFINITY;
            if (ti < 6) {
                const int jb = 64 * ti + 4 * h - iq;
#pragma unroll
                for (int i = 0; i < 16; ++i) { const int j0 = jb + (i & 3) + 8 * (i >> 2), j1 = j0 + 32;
                    s0[i] = (j0 >= 0 && j0 <= 256) ? s0[i] : -INFINITY; s1[i] = (j1 >= 0 && j1 <= 256) ? s1[i] : -INFINITY; }
            }
#pragma unroll
            for (int i = 0; i < 16; ++i) mx = fmaxf(mx, fmaxf(s0[i], s1[i]));
            mx = fmaxf(mx, __shfl_xor(mx, 32));
            const float m_new = fmaxf(m_run, mx), alpha = exp2f(m_run - m_new);
            m_run = m_new; lsum *= alpha;
#pragma unroll
            for (int i = 0; i < 16; ++i) { s0[i] = exp2f(s0[i] - m_new); s1[i] = exp2f(s1[i] - m_new); lsum += s0[i] + s1[i]; }
#pragma unroll
            for (int db = 0; db < 4; ++db)
#pragma unroll
                for (int i = 0; i < 16; ++i) o[db][i] *= alpha;
            bf16x8 pf[2][2];
#pragma unroll
            for (int s2 = 0; s2 < 2; ++s2) {
                u32x4 p0, p1;
#pragma unroll
                for (int w = 0; w < 4; ++w) { p0[w] = pk2(s0[8 * s2 + 2 * w], s0[8 * s2 + 2 * w + 1]); p1[w] = pk2(s1[8 * s2 + 2 * w], s1[8 * s2 + 2 * w + 1]); }
                pf[0][s2] = __builtin_bit_cast(bf16x8, p0); pf[1][s2] = __builtin_bit_cast(bf16x8, p1);
            }
            const LAS unsigned char* vb = F.lds + 2 * KS_BYTES + buf * VS_BYTES + (4 * h + tq4) * VP + 32 * blk + 8 * tp;
#pragma unroll
            for (int db = 0; db < 4; ++db)
#pragma unroll
                for (int kb2 = 0; kb2 < 2; ++kb2)
#pragma unroll
                    for (int s2 = 0; s2 < 2; ++s2) {
                        const int off = (32 * kb2 + 16 * s2) * VP + db * 64;
                        const s16x4 lo = __builtin_amdgcn_ds_read_tr16_b64_v4i16((LAS s16x4*)(vb + off));
                        const s16x4 hi = __builtin_amdgcn_ds_read_tr16_b64_v4i16((LAS s16x4*)(vb + off + 8 * VP));
                        const bf16x8 av = __builtin_shufflevector(lo, hi, 0, 1, 2, 3, 4, 5, 6, 7);
                        o[db] = MFMA32(av, pf[kb2][s2], o[db]);
                    }
        }
        if (more) attn_store_tile(F, R, tin, buf ^ 1);
        __syncthreads();
    }
    const float lt = lsum + __shfl_xor(lsum, 32);
    const float inv = 1.f / lt;
    float ss = 0.f;
#pragma unroll
    for (int db = 0; db < 4; ++db)
#pragma unroll
        for (int i = 0; i < 16; ++i) { o[db][i] *= inv; ss += o[db][i] * o[db][i]; }
    ss += __shfl_xor(ss, 32);
    const float rn = 1.f / sqrtf(ss * (1.f / 128.f) + LN_EPS);
    bf16_t* op = F.MIX() + (size_t)tq * D + head * 128 + 4 * h;
    const float* gp = F.g_attn() + layer * 1024 + head * 128 + 4 * h;
#pragma unroll
    for (int db = 0; db < 4; ++db)
#pragma unroll
        for (int g4 = 0; g4 < 4; ++g4) {
            const f32x4 gv = *(const f32x4*)(gp + 32 * db + 8 * g4);
            u32x2 w; w.x = pk2(o[db][4 * g4] * rn * gv.x, o[db][4 * g4 + 1] * rn * gv.y); w.y = pk2(o[db][4 * g4 + 2] * rn * gv.z, o[db][4 * g4 + 3] * rn * gv.w);
            *(u32x2*)(op + 32 * db + 8 * g4) = w;
        }
}

__device__ __forceinline__ void unpack8(const u32x4 v, float (&f)[8]) {
#pragma unroll
    for (int w = 0; w < 4; ++w) { f[2 * w] = bf_lo(v[w]); f[2 * w + 1] = bf_hi(v[w]); }
}
__device__ __forceinline__ void conv_row(Frame& F, int layer, int t) {
    bool first, last;
    if (t < TL) { const int pos = t & (SEQ - 1); first = pos == 0; last = pos == SEQ - 1; } else { const int pc = (t - TL) & (CTXL - 1); first = pc == 0; last = pc == CTXL - 1; }
    const bf16_t* p = F.PROJ() + (size_t)t * INC;
    const float* cw = F.conv_w() + (size_t)layer * 3 * 1024;
#pragma unroll
    for (int jc = 0; jc < 2; ++jc) {
        const int c = 8 * F.lane + 512 * jc;
        float gb[8], a[8], bq[8], um[8], ut[8], up[8];
        unpack8(*(const u32x4*)(p + c), gb);
        unpack8(*(const u32x4*)(p + OFF_C + c), a); unpack8(*(const u32x4*)(p + OFF_X + c), bq);
#pragma unroll
        for (int e = 0; e < 8; ++e) ut[e] = a[e] * bq[e];
        if (!first) { unpack8(*(const u32x4*)(p - INC + OFF_C + c), a); unpack8(*(const u32x4*)(p - INC + OFF_X + c), bq);
#pragma unroll
            for (int e = 0; e < 8; ++e) um[e] = a[e] * bq[e]; }
        else {
#pragma unroll
            for (int e = 0; e < 8; ++e) um[e] = 0.f; }
        if (!last) { unpack8(*(const u32x4*)(p + INC + OFF_C + c), a); unpack8(*(const u32x4*)(p + INC + OFF_X + c), bq);
#pragma unroll
            for (int e = 0; e < 8; ++e) up[e] = a[e] * bq[e]; }
        else {
#pragma unroll
            for (int e = 0; e < 8; ++e) up[e] = 0.f; }
        float y[8], ss = 0.f;
#pragma unroll
        for (int e = 0; e < 8; ++e) { y[e] = gb[e] * (cw[c + e] * um[e] + cw[1024 + c + e] * ut[e] + cw[2048 + c + e] * up[e]); ss += y[e] * y[e]; }
        ss += __shfl_xor(ss, 1); ss += __shfl_xor(ss, 2); ss += __shfl_xor(ss, 4); ss += __shfl_xor(ss, 8);
        const float rn = 1.f / sqrtf(ss * (1.f / 128.f) + LN_EPS);
        const float* gc = F.g_conv() + layer * 1024 + c;
        u32x4 w;
#pragma unroll
        for (int q = 0; q < 4; ++q) w[q] = pk2(y[2 * q] * rn * gc[2 * q], y[2 * q + 1] * rn * gc[2 * q + 1]);
        *(u32x4*)(F.MIX() + (size_t)t * D + 1024 + c) = w;
    }
}

__device__ __forceinline__ void ln_phase(Frame& F, int layer, int rows) {
    const int lane = F.lane;
    u32x4 w[4], wn[4];
    int t = F.gw;
    if (t < rows) {
#pragma unroll
        for (int j = 0; j < 4; ++j) w[j] = *(const u32x4*)(F.X() + (size_t)t * D + 8 * lane + 512 * j);
    }
    const float* g1 = F.ln1_g() + layer * D; const float* b1 = F.ln1_b() + layer * D;
    while (t < rows) {
        const int tn = t + F.NGW;
        if (tn < rows) {
#pragma unroll
            for (int j = 0; j < 4; ++j) wn[j] = *(const u32x4*)(F.X() + (size_t)tn * D + 8 * lane + 512 * j);
        }
        float v[32]; float s = 0.f;
#pragma unroll
        for (int j = 0; j < 4; ++j)
#pragma unroll
            for (int q = 0; q < 4; ++q) { v[8 * j + 2 * q] = bf_lo(w[j][q]); v[8 * j + 2 * q + 1] = bf_hi(w[j][q]); s += v[8 * j + 2 * q] + v[8 * j + 2 * q + 1]; }
        const float mean = wave_sum(s) * (1.f / D);
        float s2 = 0.f;
#pragma unroll
        for (int i = 0; i < 32; ++i) { v[i] -= mean; s2 += v[i] * v[i]; }
        const float rstd = 1.f / sqrtf(wave_sum(s2) * (1.f / D) + LN_EPS);
        float s3 = 0.f;
#pragma unroll
        for (int j = 0; j < 4; ++j) { const int c = 8 * lane + 512 * j; u32x4 o;
#pragma unroll
            for (int q = 0; q < 2; ++q) { const f32x4 gg = *(const f32x4*)(g1 + c + 4 * q), bb = *(const f32x4*)(b1 + c + 4 * q);
#pragma unroll
                for (int e = 0; e < 4; ++e) { const float y = v[8 * j + 4 * q + e] * rstd * gg[e] + bb[e]; v[8 * j + 4 * q + e] = y; s3 += y; }
                o[2 * q] = pk2(v[8 * j + 4 * q], v[8 * j + 4 * q + 1]); o[2 * q + 1] = pk2(v[8 * j + 4 * q + 2], v[8 * j + 4 * q + 3]); }
            *(u32x4*)(F.X() + (size_t)t * D + c) = o; }
        const float mean2 = wave_sum(s3) * (1.f / D);
        float s4 = 0.f;
#pragma unroll
        for (int i = 0; i < 32; ++i) { v[i] -= mean2; s4 += v[i] * v[i]; }
        const float rstd2 = 1.f / sqrtf(wave_sum(s4) * (1.f / D) + LN_EPS);
        const float* mp = F.MODS() + ((size_t)layer * 3 + modrow(t)) * 12288;
#pragma unroll
        for (int j = 0; j < 4; ++j) { const int c = 8 * lane + 512 * j; u32x4 o;
#pragma unroll
            for (int q = 0; q < 2; ++q) { const f32x4 sh = *(const f32x4*)(mp + 3 * D + c + 4 * q), sc = *(const f32x4*)(mp + 4 * D + c + 4 * q);
                const float y0 = v[8 * j + 4 * q] * rstd2 * (1.f + sc[0]) + sh[0], y1 = v[8 * j + 4 * q + 1] * rstd2 * (1.f + sc[1]) + sh[1];
                const float y2 = v[8 * j + 4 * q + 2] * rstd2 * (1.f + sc[2]) + sh[2], y3 = v[8 * j + 4 * q + 3] * rstd2 * (1.f + sc[3]) + sh[3];
                o[2 * q] = pk2(y0, y1); o[2 * q + 1] = pk2(y2, y3); }
            *(u32x4*)(F.H() + (size_t)t * D + c) = o; }
#pragma unroll
        for (int j = 0; j < 4; ++j) w[j] = wn[j];
        t = tn;
    }
}

__device__ __forceinline__ unsigned ordkey(float f) { const unsigned u = __float_as_uint(f); return u ^ ((u >> 31) ? 0xFFFFFFFFu : 0x80000000u); }
__device__ __forceinline__ float gelu_erf(float a) { return 0.5f * a * (1.f + erff(a * 0.70710678118654752f)); }

__device__ __forceinline__ float unordkey(unsigned k) { return __uint_as_float(k ^ ((k >> 31) ? 0x80000000u : 0xFFFFFFFFu)); }
__device__ __forceinline__ float gelu_as(float v) {
    const float av = fabsf(v), t = __builtin_amdgcn_rcpf(av * 0.2316418882f + 1.0f);
    float q = t * 0.5307027145f + (-0.7265760135f); q = q * t + 0.7107068705f; q = q * t + (-0.142248368f); q = q * t + 0.127414796f; q = q * t;
    const float e = __builtin_amdgcn_exp2f((v * v) * (-0.72134752044f));
    const float m = v * (q * e);
    return v < 0.f ? m : v - m;
}

template <class O> struct QuadNet {
    typedef typename O::V V; typedef typename O::B B;
    template <bool ASC> static __device__ __forceinline__ void ce_reg(V& a, V& b) { const V lo = O::vmin(a, b), hi = O::vmax(a, b); a = ASC ? lo : hi; b = ASC ? hi : lo; }
    template <bool ASC> static __device__ __forceinline__ void ce_l1(V& x, B low1) { const V p = O::x1(x); const V mn = O::vmin(p, x), mx = O::vmax(p, x); x = ASC ? O::vsel(low1, mn, mx) : O::vsel(low1, mx, mn); }
    template <bool ASC> static __device__ __forceinline__ void ce_l2(V& x, B low2) { const V p = O::x2(x); const V mn = O::vmin(p, x), mx = O::vmax(p, x); x = ASC ? O::vsel(low2, mn, mx) : O::vsel(low2, mx, mn); }
    template <int NR> static __device__ __forceinline__ void sort_blocks(V (&R)[NR], B low1, B low2, B eq12) {
#pragma unroll
        for (int r = 0; r < NR; ++r) { const V p = O::x1(R[r]); const V mn = O::vmin(p, R[r]), mx = O::vmax(p, R[r]); R[r] = O::vsel(eq12, mn, mx); }
#pragma unroll
        for (int r = 0; r < NR; ++r) { if ((r & 1) == 0) ce_l2<true>(R[r], low2); else ce_l2<false>(R[r], low2); }
#pragma unroll
        for (int r = 0; r < NR; ++r) { if ((r & 1) == 0) ce_l1<true>(R[r], low1); else ce_l1<false>(R[r], low1); }
#pragma unroll
        for (int r = 0; r < NR; r += 2) { if ((r & 2) == 0) ce_reg<true>(R[r], R[r + 1]); else ce_reg<false>(R[r], R[r + 1]); }
#pragma unroll
        for (int r = 0; r < NR; ++r) { if ((r & 2) == 0) ce_l2<true>(R[r], low2); else ce_l2<false>(R[r], low2); }
#pragma unroll
        for (int r = 0; r < NR; ++r) { if ((r & 2) == 0) ce_l1<true>(R[r], low1); else ce_l1<false>(R[r], low1); }
#pragma unroll
        for (int r = 0; r < NR; ++r) { if ((r & 2) == 0) { if ((r & 4) == 0) ce_reg<true>(R[r], R[r + 2]); else ce_reg<false>(R[r], R[r + 2]); } }
#pragma unroll
        for (int r = 0; r < NR; r += 2) { if ((r & 4) == 0) ce_reg<true>(R[r], R[r + 1]); else ce_reg<false>(R[r], R[r + 1]); }
#pragma unroll
        for (int r = 0; r < NR; ++r) { if ((r & 4) == 0) ce_l2<true>(R[r], low2); else ce_l2<false>(R[r], low2); }
#pragma unroll
        for (int r = 0; r < NR; ++r) { if ((r & 4) == 0) ce_l1<true>(R[r], low1); else ce_l1<false>(R[r], low1); }
    }
    template <int NR> static __device__ __forceinline__ void halve_merge(const V (&R)[NR], V (&Q)[NR / 2], B low1, B low2) {
#pragma unroll
        for (int m = 0; m < NR / 8; ++m)
#pragma unroll
            for (int i = 0; i < 4; ++i) Q[4 * m + i] = O::vmax(R[8 * m + i], R[8 * m + 4 + i]);
#pragma unroll
        for (int r = 0; r < NR / 2; ++r) { if ((r & 2) == 0) { if ((r & 4) == 0) ce_reg<false>(Q[r], Q[r + 2]); else ce_reg<true>(Q[r], Q[r + 2]); } }
#pragma unroll
        for (int r = 0; r < NR / 2; r += 2) { if ((r & 4) == 0) ce_reg<false>(Q[r], Q[r + 1]); else ce_reg<true>(Q[r], Q[r + 1]); }
#pragma unroll
        for (int r = 0; r < NR / 2; ++r) { if ((r & 4) == 0) ce_l2<false>(Q[r], low2); else ce_l2<true>(Q[r], low2); }
#pragma unroll
        for (int r = 0; r < NR / 2; ++r) { if ((r & 4) == 0) ce_l1<false>(Q[r], low1); else ce_l1<true>(Q[r], low1); }
    }
    static __device__ __forceinline__ void top16_of_128(V (&R)[32], V (&T)[4], B low1, B low2, B eq12) {
        sort_blocks<32>(R, low1, low2, eq12);
        V A[16]; halve_merge<32>(R, A, low1, low2);
        V Bq[8]; halve_merge<16>(A, Bq, low1, low2);
        halve_merge<8>(Bq, T, low1, low2);
    }
    static __device__ __forceinline__ void top16_of_64(V (&R)[16], V (&T)[4], B low1, B low2, B eq12) {
        sort_blocks<16>(R, low1, low2, eq12);
        V A[8]; halve_merge<16>(R, A, low1, low2);
        halve_merge<8>(A, T, low1, low2);
    }
};

struct DevOps {
    typedef unsigned V; typedef bool B;
    static __device__ __forceinline__ V vmin(V a, V b) { return a < b ? a : b; }
    static __device__ __forceinline__ V vmax(V a, V b) { return a > b ? a : b; }
    static __device__ __forceinline__ V vsel(B m, V a, V b) { return m ? a : b; }
    static __device__ __forceinline__ V x1(V a) { return (V)dpp_i<DPP_XOR1>((int)a); }
    static __device__ __forceinline__ V x2(V a) { return (V)dpp_i<DPP_XOR2>((int)a); }
};
__device__ __forceinline__ void stair_ab(int c, int& a, int& b) {
    if (c < 16) { a = 0; b = c; } else if (c < 24) { a = 1; b = c - 16; } else if (c < 28) { a = 2; b = c - 24; } else if (c < 32) { a = 3; b = c - 28; }
    else if (c < 36) { a = 4; b = c - 32; } else if (c < 40) { a = 5 + ((c - 36) >> 1); b = (c - 36) & 1; } else if (c < 44) { a = 7 + ((c - 40) >> 1); b = (c - 40) & 1; }
    else if (c < 48) { a = 9 + (c - 44); b = 0; } else if (c < 51) { a = 13 + (c - 48); b = 0; } else { a = 2; b = 4; }
}
constexpr int PE_WS = 5120, PE_TAB = 8 * PE_WS;
__device__ __forceinline__ void peer_topk(Frame& F, LAS unsigned char* ws, int t) {
    const int lane = F.lane, sub = lane & 3;
    const bool low1 = (sub & 1) == 0, low2 = (sub & 2) == 0, eq12 = low1 == low2;
    LAS unsigned* S1K = (LAS unsigned*)ws; LAS int* EL = (LAS int*)(ws + 3328); LAS float* GL = (LAS float*)(ws + 3840);
    const LAS unsigned short* TAB = (const LAS unsigned short*)(F.lds + PE_TAB);
    {
        const int L = lane >> 2;
        const float* sp = F.SC() + (size_t)t * D + L * 128 + sub * 4;
        unsigned R[32];
#pragma unroll
        for (int q = 0; q < 8; ++q) { const f32x4 v = *(const f32x4*)(sp + 16 * q);
#pragma unroll
            for (int e = 0; e < 4; ++e) R[4 * q + e] = (ordkey(v[e]) & ~127u) | (unsigned)(127 - (4 * sub + 16 * q + e)); }
        unsigned T[4];
        QuadNet<DevOps>::top16_of_128(R, T, low1, low2, eq12);
#pragma unroll
        for (int r = 0; r < 4; ++r) S1K[L * 16 + 4 * r + sub] = T[r];
    }
    LDS_WAIT(); __builtin_amdgcn_wave_barrier();
    {
        const int hd = (lane >> 2) & 7;
        const LAS unsigned char* la = (const LAS unsigned char*)(S1K + (2 * hd) * 16); const LAS unsigned char* lb = (const LAS unsigned char*)(S1K + (2 * hd + 1) * 16);
        unsigned C[16];
#pragma unroll
        for (int r = 0; r < 13; ++r) { const unsigned ab = TAB[4 * r + sub];
            const unsigned ka = *(const LAS unsigned*)(la + (ab & 255u)), kb = *(const LAS unsigned*)(lb + (ab >> 8));
            const float sum = unordkey(ka & ~127u) + unordkey(kb & ~127u);
            C[r] = (ordkey(sum) & ~63u) | (unsigned)(63 - (4 * r + sub)); }
        C[13] = 0u; C[14] = 0u; C[15] = 0u;
        unsigned W[4];
        QuadNet<DevOps>::top16_of_64(C, W, low1, low2, eq12);
        float sv[4]; int ex[4];
#pragma unroll
        for (int r = 0; r < 4; ++r) { const unsigned ab = TAB[63 - (W[r] & 63u)];
            const unsigned ka = *(const LAS unsigned*)(la + (ab & 255u)), kb = *(const LAS unsigned*)(lb + (ab >> 8));
            ex[r] = (int)(127u - (ka & 127u)) * 128 + (int)(127u - (kb & 127u)); sv[r] = unordkey(W[r] & ~63u); }
        const float mx = dpp_f<0x00>(sv[0]);
        float e4[4], es = 0.f;
#pragma unroll
        for (int r = 0; r < 4; ++r) { e4[r] = __expf(sv[r] - mx); es += e4[r]; }
        es += dpp_f<DPP_XOR1>(es); es += dpp_f<DPP_XOR2>(es);
        const float rd = 1.f / es;
#pragma unroll
        for (int r = 0; r < 4; ++r) { GL[hd * 16 + 4 * r + sub] = e4[r] * rd; EL[hd * 16 + 4 * r + sub] = ex[r]; }
    }
    LDS_WAIT(); __builtin_amdgcn_wave_barrier();
}

#ifndef PROBE_PHASE
#define PROBE_PHASE -1
#endif
#ifndef PROBE_MULT
#define PROBE_MULT 1
#endif
constexpr int EB = 4;
constexpr int CW_TICKET = 20480;

struct GBuf { LpRow<U_FMT> u[EB]; LpRow<V_FMT> v[EB]; float su[EB], sv[EB], g[EB]; };
__device__ __forceinline__ void gather_issue(GBuf& B, const LAS int* EL, const LAS float* GL, int i0, const unsigned char* UTl, const unsigned char* VTl, const float* USl, const float* VSl, int lane) {
#pragma unroll
    for (int q = 0; q < EB; ++q) {
        const int ex = __builtin_amdgcn_readfirstlane(EL[i0 + q]);
        B.g[q] = __uint_as_float(__builtin_amdgcn_readfirstlane(__float_as_uint(GL[i0 + q])));
        B.u[q].load(UTl + (size_t)ex * UROW, lane); B.v[q].load(VTl + (size_t)ex * VROW, lane); B.su[q] = USl[ex]; B.sv[q] = VSl[ex];
    }
}
__device__ __forceinline__ void gather_compute(const GBuf& B, const f32x2 (&hv)[16], f32x2 (&acc)[16]) {
    float dot[EB];
#pragma unroll
    for (int q = 0; q < EB; ++q) { f32x2 s = {0.f, 0.f};
        B.u[q].each([&](int i, float x0, float x1) { const f32x2 x = {x0, x1}; s = __builtin_elementwise_fma(x, hv[i >> 1], s); });
        dot[q] = s.x + s.y; }
#pragma unroll
    for (int q = 0; q < EB; ++q) dot[q] = wave_sum_u(dot[q]);
#pragma unroll
    for (int q = 0; q < EB; ++q) { const float cf = B.g[q] * gelu_as(dot[q] * B.su[q]) * B.sv[q]; const f32x2 c2 = {cf, cf};
        B.v[q].each([&](int i, float x0, float x1) { const f32x2 x = {x0, x1}; acc[i >> 1] = __builtin_elementwise_fma(x, c2, acc[i >> 1]); }); }
}

__device__ __forceinline__ void peer_phase(Frame& F, int layer, int rows, unsigned* ctl, unsigned long long& pr_acc) {
    unsigned long long pt0 = 0ull;
#define SUB_BEGIN(ty) do { if (PROBE_PHASE == (ty)) pt0 = __builtin_amdgcn_s_memrealtime(); } while (0)
#define SUB_END(ty) do { if (PROBE_PHASE == (ty)) pr_acc += __builtin_amdgcn_s_memrealtime() - pt0; } while (0)
    if (F.tid < 64) { int a = 0, b = 0; stair_ab(F.tid < 52 ? F.tid : 0, a, b); *(LAS unsigned short*)(F.lds + PE_TAB + 2 * F.tid) = (unsigned short)((4 * a) | ((4 * b) << 8)); }
    __syncthreads();
    LAS unsigned char* ws = F.lds + F.wave * PE_WS;
    LAS int* EL = (LAS int*)(ws + 3328); LAS float* GL = (LAS float*)(ws + 3840);
    const int lane = F.lane;
    const unsigned char* UTl = F.UT() + (size_t)layer * NEXP * UROW;
    const unsigned char* VTl = F.VT() + (size_t)layer * NEXP * VROW;
    const float* USl = F.US() + (size_t)layer * NEXP; const float* VSl = F.VS() + (size_t)layer * NEXP;
    unsigned* ticket = ctl + CW_TICKET + 64 * layer;
    unsigned tk = 0u;
    if (lane == 0) tk = __hip_atomic_fetch_add(ticket, 1u, __ATOMIC_RELAXED, __HIP_MEMORY_SCOPE_AGENT);
    int t = (int)__builtin_amdgcn_readfirstlane(tk);
    while (t < rows) {
        unsigned tkn = 0u;
        if (lane == 0) tkn = __hip_atomic_fetch_add(ticket, 1u, __ATOMIC_RELAXED, __HIP_MEMORY_SCOPE_AGENT);
        SUB_BEGIN(8); peer_topk(F, ws, t); SUB_END(8);
        SUB_BEGIN(9);
        f32x2 hv[16], acc[16];
#pragma unroll
        for (int q = 0; q < 4; ++q) { const u32x4 w = *(const u32x4*)(F.H() + (size_t)t * D + 32 * lane + 8 * q);
#pragma unroll
            for (int e = 0; e < 4; ++e) { hv[4 * q + e] = (f32x2){bf_lo(w[e]), bf_hi(w[e])}; acc[4 * q + e] = (f32x2){0.f, 0.f}; } }
        {
            GBuf A, B;
            gather_issue(A, EL, GL, 0, UTl, VTl, USl, VSl, lane);
            for (int i0 = 0; i0 < 128; i0 += 2 * EB) {
                gather_issue(B, EL, GL, i0 + EB, UTl, VTl, USl, VSl, lane);
                gather_compute(A, hv, acc);
                if (i0 + 2 * EB < 128) gather_issue(A, EL, GL, i0 + 2 * EB, UTl, VTl, USl, VSl, lane);
                gather_compute(B, hv, acc);
            }
        }
        SUB_END(9); SUB_BEGIN(10);
        const int mr = modrow(t);
        const float* mp = F.MODS() + ((size_t)layer * 3 + mr) * 12288;
        bf16_t* xr = F.X() + (size_t)t * D;
        float rr[32]; float s = 0.f;
#pragma unroll
        for (int q2 = 0; q2 < 4; ++q2) { const u32x4 xw = *(const u32x4*)(xr + 32 * lane + 8 * q2);
#pragma unroll
            for (int h2 = 0; h2 < 2; ++h2) { const int q = 2 * q2 + h2; const int c = 32 * lane + 4 * q; const f32x4 gv = *(const f32x4*)(mp + 5 * D + c);
                const f32x4 xv = {bf_lo(xw[2 * h2]), bf_hi(xw[2 * h2]), bf_lo(xw[2 * h2 + 1]), bf_hi(xw[2 * h2 + 1])};
                const f32x4 av = {acc[2 * q].x, acc[2 * q].y, acc[2 * q + 1].x, acc[2 * q + 1].y};
#pragma unroll
                for (int e = 0; e < 4; ++e) { const float v = DN_ALPHA * xv[e] + gv[e] * av[e]; rr[4 * q + e] = v; s += v; } } }
        const float mean = wave_sum_u(s) * (1.f / D);
        float s2 = 0.f;
#pragma unroll
        for (int i = 0; i < 32; ++i) { rr[i] -= mean; s2 += rr[i] * rr[i]; }
        const float rstd = 1.f / sqrtf(wave_sum_u(s2) * (1.f / D) + LN_EPS);
        const float* g2 = F.ln2_g() + layer * D; const float* b2 = F.ln2_b() + layer * D;
        float s3 = 0.f;
#pragma unroll
        for (int q = 0; q < 8; ++q) { const int c = 32 * lane + 4 * q; const f32x4 gg = *(const f32x4*)(g2 + c), bb = *(const f32x4*)(b2 + c);
            f32x4 xo;
#pragma unroll
            for (int e = 0; e < 4; ++e) { xo[e] = rr[4 * q + e] * rstd * gg[e] + bb[e]; rr[4 * q + e] = xo[e]; s3 += xo[e]; }
            if (layer < NLAYER - 1) { u32x2 o2; o2.x = pk2(xo[0], xo[1]); o2.y = pk2(xo[2], xo[3]); *(u32x2*)(xr + c) = o2; } else if (t < TL) *(f32x4*)(F.out() + (size_t)t * D + c) = xo; }
        if (layer < NLAYER - 1) {
            const float mean2 = wave_sum_u(s3) * (1.f / D);
            float s4 = 0.f;
#pragma unroll
            for (int i = 0; i < 32; ++i) { rr[i] -= mean2; s4 += rr[i] * rr[i]; }
            const float rstd2 = 1.f / sqrtf(wave_sum_u(s4) * (1.f / D) + LN_EPS);
            const float* np = F.MODS() + ((size_t)(layer + 1) * 3 + mr) * 12288;
#pragma unroll
            for (int q2 = 0; q2 < 4; ++q2) { const int c = 32 * lane + 8 * q2; u32x4 w;
#pragma unroll
                for (int q = 0; q < 2; ++q) { const f32x4 sh = *(const f32x4*)(np + c + 4 * q), sc = *(const f32x4*)(np + D + c + 4 * q); const int ri = 8 * q2 + 4 * q;
                    const float y0 = rr[ri] * rstd2 * (1.f + sc[0]) + sh[0], y1 = rr[ri + 1] * rstd2 * (1.f + sc[1]) + sh[1];
                    const float y2 = rr[ri + 2] * rstd2 * (1.f + sc[2]) + sh[2], y3 = rr[ri + 3] * rstd2 * (1.f + sc[3]) + sh[3];
                    w[2 * q] = pk2(y0, y1); w[2 * q + 1] = pk2(y2, y3); }
                *(u32x4*)(F.H() + (size_t)t * D + c) = w; }
        }
        SUB_END(10);
        t = (int)__builtin_amdgcn_readfirstlane(tkn);
    }
#undef SUB_BEGIN
#undef SUB_END
}

__global__ void __launch_bounds__(NWAVES * 64, 2) skel_fwd(Args args) {
    extern __shared__ __attribute__((aligned(16))) unsigned char lds[];
    Frame F;
    F.lds = (LAS unsigned char*)lds;
    F.tid = threadIdx.x; F.lane = F.tid & 63; F.wave = __builtin_amdgcn_readfirstlane(F.tid >> 6);
    F.G = gridDim.x; F.gw = blockIdx.x * NWAVES + F.wave; F.NGW = F.G * NWAVES;
    unsigned char* ws = args.ws;
    F.ka = (const CAS unsigned char*)__builtin_amdgcn_kernarg_segment_ptr();
    for (int u = F.tid; u < (LDS_BYTES - LDSCTL_OFF) / 4; u += NWAVES * 64) ((LAS unsigned*)(F.lds + LDSCTL_OFF))[u] = 0u;
    __syncthreads();
    unsigned* ctl = (unsigned*)(ws + WS_CTL);
    const int lo = args.ph_lo, hi = args.ph_hi;
    XcdBarrier bar; bar.bar = ctl + CW_BAR + args.li * XCD_BAR_WORDS; bar.x = 0; bar.st = nullptr;
    if (hi - lo > 1) bar = xcd_barrier_post(ctl + CW_BAR + args.li * XCD_BAR_WORDS, (volatile LAS unsigned*)(F.lds + MISC_OFF) + 8);
#define IN(k) (lo <= (k) && (k) < hi)
    unsigned long long pr_acc = 0ull, pr_t0 = 0ull;
#define PR_BEGIN(ty) do { if (PROBE_PHASE == (ty)) pr_t0 = __builtin_amdgcn_s_memrealtime(); } while (0)
#define PR_END(ty) do { if (PROBE_PHASE == (ty)) pr_acc += __builtin_amdgcn_s_memrealtime() - pr_t0; } while (0)
#define BOTH(k) (IN(k) && IN((k) + 1))
#define SEAM(k) do { if (BOTH(k)) xcd_barrier(bar); } while (0)

    if (IN(0)) { PR_BEGIN(0); frame_ids(F); p0a_prologue(F); SEAM(0); PR_END(0); }
    if (IN(1)) {
        PR_BEGIN(1); frame_ids(F);
        { pg8::Gemm g{F.KBD(), F.WQR(), 32 * 256, 2048, 256}; pg8::BatchOrder S{F.G, (int)blockIdx.x}; pg8::EpiBf16 E{F.WEFFT(), D};
          pg8::gemm_phase<pg8::EpiBf16, pg8::BatchOrder, false, true>(F.lds, g, S, E); }
        p0b_mod0(F);
        SEAM(1); PR_END(1);
    }
    for (int layer = 0; layer < NLAYER; ++layer) {
        const int pb = 2 + 6 * layer;
        const bool lastl = layer == NLAYER - 1;
        const int rows = lastl ? TL : TT;
        if (IN(pb + 0)) {
            PR_BEGIN(2); frame_ids(F);
            pg8::Gemm g{F.H(), F.WINT() + (size_t)layer * INC * D, TT, INC, D}; pg8::StaticOrder S; S.init(TT, INC, F.G, (int)blockIdx.x);
            pg8::EpiBf16 E{F.PROJ(), INC};
            pg8::gemm_phase<pg8::EpiBf16, pg8::StaticOrder, true, true>(F.lds, g, S, E);
            SEAM(pb + 0); PR_END(2);
        }
        if (IN(pb + 1)) {
            PR_BEGIN(3); frame_ids(F);
            const int nunits = lastl ? 512 : 528;
            { unsigned long long q0 = 0; if (PROBE_PHASE == 11) q0 = __builtin_amdgcn_s_memrealtime();
            for (int u = blockIdx.x; u < nunits; u += F.G) attn_unit(F, layer, u);
            if (PROBE_PHASE == 11) pr_acc += __builtin_amdgcn_s_memrealtime() - q0; if (PROBE_PHASE == 12) q0 = __builtin_amdgcn_s_memrealtime();
            for (int t = F.gw; t < rows; t += F.NGW) conv_row(F, layer, t);
            if (PROBE_PHASE == 12) pr_acc += __builtin_amdgcn_s_memrealtime() - q0; }
            SEAM(pb + 1); PR_END(3);
        }
        if (IN(pb + 2)) {
            PR_BEGIN(4); frame_ids(F);
            pg8::Gemm g{F.MIX(), F.WOUTT() + (size_t)layer * D * D, rows, D, D}; pg8::StaticOrder S; S.init(rows, D, F.G, (int)blockIdx.x);
            pg8::EpiResid E{layer == 0 ? F.x() : nullptr, layer == 0 ? F.ctx() : nullptr, F.X(), F.MODS() + (size_t)layer * 3 * 12288 + 2 * D};
            pg8::gemm_phase<pg8::EpiResid, pg8::StaticOrder, true, true>(F.lds, g, S, E);
            frame_ids(F); convert_in_tail(F, layer, (rows / 256) * (D / 256), 0);
            SEAM(pb + 2); PR_END(4);
        }
        if (IN(pb + 3)) { PR_BEGIN(5); frame_ids(F); ln_phase(F, layer, rows); SEAM(pb + 3); PR_END(5); }
        if (IN(pb + 4)) {
            PR_BEGIN(6); frame_ids(F);
            pg8::Gemm g{F.H(), F.WEFFT() + (size_t)layer * D * D, rows, D, D}; pg8::StaticOrder S; S.init(rows, D, F.G, (int)blockIdx.x);
            pg8::EpiF32 E{F.SC(), D};
            pg8::gemm_phase<pg8::EpiF32, pg8::StaticOrder, true, true>(F.lds, g, S, E);
            frame_ids(F); convert_in_tail(F, layer, (rows / 256) * (D / 256), 1);
            SEAM(pb + 4); PR_END(6);
        }
        if (IN(pb + 5)) { PR_BEGIN(7); frame_ids(F); peer_phase(F, layer, rows, ctl, pr_acc); SEAM(pb + 5); PR_END(7); }
    }
    if (PROBE_PHASE >= 0 && hi - lo > 1) xcd_barrier(bar);
    if (PROBE_PHASE >= 0 && blockIdx.x == 0 && threadIdx.x == 0) { const unsigned long long t1 = __builtin_amdgcn_s_memrealtime() + (unsigned long long)PROBE_MULT * pr_acc; while (__builtin_amdgcn_s_memrealtime() < t1) __builtin_amdgcn_s_sleep(8); }
#undef IN
#undef BOTH
#undef SEAM
}

extern "C" void kernel_launch(void* const* d_in, const int* in_sizes, int n_in, void* d_out, int out_size, void* d_ws, size_t ws_size, hipStream_t stream) {
    static int grid = 0;
    if (grid == 0) {
        if (n_in != 20 || in_sizes[0] != TL * D || out_size != TL * D || ws_size < WS_END) {
            fprintf(stderr, "kernel_launch: unexpected problem shape (n_in %d, in0 %d, out %d, ws %zu, need %zu)\n", n_in, n_in > 0 ? in_sizes[0] : -1, out_size, ws_size, (size_t)WS_END); grid = -1; return; }
        int dev = 0, cus = 0, per_cu = 0;
        if (hipGetDevice(&dev) != hipSuccess || hipDeviceGetAttribute(&cus, hipDeviceAttributeMultiprocessorCount, dev) != hipSuccess) { grid = -1; return; }
        if (hipFuncSetAttribute((const void*)skel_fwd, hipFuncAttributeMaxDynamicSharedMemorySize, LDS_BYTES) != hipSuccess) { fprintf(stderr, "kernel_launch: hipFuncSetAttribute failed\n"); grid = -1; return; }
        if (hipOccupancyMaxActiveBlocksPerMultiprocessor(&per_cu, (const void*)skel_fwd, NWAVES * 64, LDS_BYTES) != hipSuccess || per_cu < 1)
            fprintf(stderr, "kernel_launch: occupancy query reports %d workgroups per CU\n", per_cu);
        (void)hipGetLastError();
        grid = cus;
    }
    if (grid < 0) return;
    if (hipMemsetAsync((char*)d_ws + WS_CTL, 0, CTL_ZERO_BYTES, stream) != hipSuccess) return;
    Args a{};
    for (int i = 0; i < 20; ++i) a.in[i] = (const float*)d_in[i];
    a.out = (float*)d_out; a.ws = (unsigned char*)d_ws; a.pad = 0;
#if MK_N_LAUNCHES == 1
    a.ph_lo = 0; a.ph_hi = NPHASE; a.li = 0;
    hipLaunchKernelGGL(skel_fwd, dim3(grid), dim3(NWAVES * 64), LDS_BYTES, stream, a);
#else
    for (int ph = 0; ph < NPHASE; ++ph) { a.ph_lo = ph; a.ph_hi = ph + 1; a.li = 0;
        hipLaunchKernelGGL(skel_fwd, dim3(grid), dim3(NWAVES * 64), LDS_BYTES, stream, a); }
#endif
}
```

```cpp
#include <hip/hip_runtime.h>
#include <cstdio>
#include <cstdint>

#ifndef MK_N_LAUNCHES
#define MK_N_LAUNCHES 1
#endif

#define LAS __attribute__((address_space(3)))
typedef unsigned short bf16_t;
typedef short bf16x8 __attribute__((ext_vector_type(8)));
typedef short s16x4 __attribute__((ext_vector_type(4)));
typedef float f32x2 __attribute__((ext_vector_type(2)));
typedef float f32x4 __attribute__((ext_vector_type(4)));
typedef float f32x16 __attribute__((ext_vector_type(16)));
typedef unsigned u32x2 __attribute__((ext_vector_type(2)));
typedef unsigned u32x4 __attribute__((ext_vector_type(4)));
typedef __bf16 bf16x2_t __attribute__((ext_vector_type(2)));

constexpr int D = 2048, NB = 2, SEQ = 8192, CTXL = 256, NLAYER = 4;
constexpr int TL = NB * SEQ, TC = NB * CTXL, TT = TL + TC;
constexpr int INC = 4608, OFF_C = 1024, OFF_X = 2048, OFF_Q = 3072, OFF_K = 4096, OFF_V = 4352;
constexpr int NEXP = 16384;
#ifndef U_FMT
#define U_FMT 4
#endif
#ifndef V_FMT
#define V_FMT 4
#endif
constexpr int UROW = D * U_FMT / 8, VROW = D * V_FMT / 8;
constexpr float LN_EPS = 1e-6f;
constexpr float DN_ALPHA = 1.681792830507429f;
constexpr float QSCALE = 0.08838834764831845f * 1.4426950408889634f;
constexpr float LOG2E = 1.4426950408889634f;

constexpr size_t MiB = 1u << 20;
constexpr size_t WS_CTL = 0, CTL_ZERO_BYTES = 1 * MiB;
constexpr size_t WS_MODS = 1 * MiB;
constexpr size_t WS_ROPE = 2 * MiB;
constexpr size_t WS_KBD = 3 * MiB;
constexpr size_t WS_WQR = 8 * MiB;
constexpr size_t WS_WINT = 40 * MiB;
constexpr size_t WS_WOUTT = 112 * MiB;
constexpr size_t WS_WEFFT = 144 * MiB;
constexpr size_t WS_X = 176 * MiB;
constexpr size_t WS_H = 308 * MiB;
constexpr size_t WS_PROJ = 374 * MiB;
constexpr size_t WS_MIX = 523 * MiB;
constexpr size_t WS_SC = 589 * MiB;
constexpr size_t WS_UT = 721 * MiB;
constexpr size_t WS_VT = 849 * MiB;
constexpr size_t WS_US = 977 * MiB;
constexpr size_t WS_VS = 978 * MiB;
constexpr size_t WS_END = 979 * MiB;

constexpr int CW_BAR = 4096;

namespace pg8 {
constexpr int BM = 256, BK = 64, HALF = 128, HTB = HALF * BK * 2, STAGE_BYTES = 8 * HTB, NXCD = 8, WGM = 8;
__host__ __device__ __forceinline__ int lds_byte(int r, int c) { const int st = (r >> 4) * 2 + (c >> 5), rr = r & 15, cc = c & 31, ob = rr * 64 + cc * 2; return st * 1024 + (ob ^ (((ob >> 9) & 1) << 5)); }
__host__ __device__ __forceinline__ void stage_rc(int b, int& R, int& C) { const int st = b / 1024, sb = b % 1024, swz = sb ^ (((sb >> 9) & 1) << 5); R = (st >> 1) * 16 + swz / 64; C = (st & 1) * 32 + (swz % 64) / 2; }
__host__ __device__ __forceinline__ int perm32(int rho) { const int n = rho >> 4, i = rho & 15; return 8 * (i >> 2) + 4 * n + (i & 3); }

struct Unit { int pm, pn; };
struct Gemm { const bf16_t* A; const bf16_t* Bt; int M, N, K; };

struct StaticOrder {
    int nM, nN, nwg, G, c;
    __host__ __device__ void init(int M, int N, int G_, int c_) { nM = M / BM; nN = N / BM; nwg = nM * nN; G = G_; c = c_; }
    __host__ __device__ bool next(int i, Unit& u) const {
        const long L = (long)i * G + c; if (L >= nwg) return false;
        int wgid = (int)L; { const int q = nwg / NXCD, r = nwg % NXCD, xcd = wgid % NXCD, off = wgid / NXCD; wgid = (xcd < r ? xcd * (q + 1) : r * (q + 1) + (xcd - r) * q) + off; }
        const int nig = WGM * nN, gid = wgid / nig, fm = gid * WGM, gsz = (nM - fm) < WGM ? (nM - fm) : WGM;
        u.pm = fm + ((wgid % nig) % gsz); u.pn = (wgid % nig) / gsz; return true;
    }
    __device__ __forceinline__ int btile(const Unit& u) const { return u.pn; }
    __device__ __forceinline__ void a_ready(const Unit&) const {}
    __device__ __forceinline__ void done(const Unit&) const {}
};
struct BatchOrder {
    int G, c;
    __device__ bool next(int i, Unit& u) const { const int L = i * G + c; if (L >= 256) return false; u.pm = L >> 3; u.pn = L & 7; return true; }
    __device__ __forceinline__ int btile(const Unit& u) const { return u.pm * 8 + u.pn; }
    __device__ __forceinline__ void a_ready(const Unit&) const {}
    __device__ __forceinline__ void done(const Unit&) const {}
};

__device__ __forceinline__ unsigned cvt_pk_bf16(float lo, float hi) { f32x2 x = {lo, hi}; bf16x2_t y = __builtin_convertvector(x, bf16x2_t); return __builtin_bit_cast(unsigned, y); }

struct EpiBf16 {
    static constexpr bool PERM = true;
    bf16_t* O; int ldc;
    __device__ __forceinline__ void operator()(const f32x4 (&acc)[2][2][4][2], const Unit& u, int wr, int wc, int fr, int fq) const {
        const int row0 = u.pm * BM + wr * 64 + fr, col0 = u.pn * BM + wc * 32 + 8 * fq;
#pragma unroll
        for (int ai = 0; ai < 2; ++ai)
#pragma unroll
            for (int m = 0; m < 4; ++m) { bf16_t* rowp = O + (size_t)(row0 + ai * HALF + m * 16) * ldc + col0;
#pragma unroll
                for (int bj = 0; bj < 2; ++bj) { const f32x4 v0 = acc[ai][bj][m][0], v1 = acc[ai][bj][m][1];
                    u32x4 w; w.x = cvt_pk_bf16(v0[0], v0[1]); w.y = cvt_pk_bf16(v0[2], v0[3]); w.z = cvt_pk_bf16(v1[0], v1[1]); w.w = cvt_pk_bf16(v1[2], v1[3]);
                    *(u32x4*)(rowp + bj * HALF) = w; } }
    }
};
struct EpiF32 {
    static constexpr bool PERM = false;
    float* C; int ldc;
    __device__ __forceinline__ void operator()(const f32x4 (&acc)[2][2][4][2], const Unit& u, int wr, int wc, int fr, int fq) const {
        const int row0 = u.pm * BM + wr * 64 + fr, col0 = u.pn * BM + wc * 32 + 4 * fq;
#pragma unroll
        for (int ai = 0; ai < 2; ++ai)
#pragma unroll
            for (int m = 0; m < 4; ++m) { float* rowp = C + (size_t)(row0 + ai * HALF + m * 16) * ldc + col0;
#pragma unroll
                for (int bj = 0; bj < 2; ++bj)
#pragma unroll
                    for (int n = 0; n < 2; ++n) *(f32x4*)(rowp + bj * HALF + n * 16) = acc[ai][bj][m][n]; }
    }
};
struct EpiResid {
    static constexpr bool PERM = true;
    const float* x32_lat; const float* x32_ctx;
    bf16_t* X; const float* gate;
    __device__ __forceinline__ void operator()(const f32x4 (&acc)[2][2][4][2], const Unit& u, int wr, int wc, int fr, int fq) const {
        const int rt = u.pm * BM;
        const int mr = rt < TL ? rt / SEQ : 2;
        const int row0 = rt + wr * 64 + fr, col0 = u.pn * BM + wc * 32 + 8 * fq;
        f32x4 gv[2][2];
#pragma unroll
        for (int bj = 0; bj < 2; ++bj)
#pragma unroll
            for (int n = 0; n < 2; ++n) gv[bj][n] = *(const f32x4*)(gate + (size_t)mr * 12288 + col0 + bj * HALF + 4 * n);
#pragma unroll
        for (int ai = 0; ai < 2; ++ai)
#pragma unroll
            for (int m = 0; m < 4; ++m) { const int row = row0 + ai * HALF + m * 16;
#pragma unroll
                for (int bj = 0; bj < 2; ++bj) {
                    f32x4 x0, x1;
                    if (x32_lat) { const float* xp = (row < TL ? x32_lat + (size_t)row * D : x32_ctx + (size_t)(row - TL) * D) + col0 + bj * HALF; x0 = *(const f32x4*)xp; x1 = *(const f32x4*)(xp + 4); }
                    else { const u32x4 w = *(const u32x4*)(X + (size_t)row * D + col0 + bj * HALF);
                        x0 = (f32x4){__uint_as_float(w.x << 16), __uint_as_float(w.x & 0xffff0000u), __uint_as_float(w.y << 16), __uint_as_float(w.y & 0xffff0000u)};
                        x1 = (f32x4){__uint_as_float(w.z << 16), __uint_as_float(w.z & 0xffff0000u), __uint_as_float(w.w << 16), __uint_as_float(w.w & 0xffff0000u)}; }
                    const f32x4 r0 = x0 * DN_ALPHA + gv[bj][0] * acc[ai][bj][m][0], r1 = x1 * DN_ALPHA + gv[bj][1] * acc[ai][bj][m][1];
                    u32x4 o; o.x = cvt_pk_bf16(r0[0], r0[1]); o.y = cvt_pk_bf16(r0[2], r0[3]); o.z = cvt_pk_bf16(r1[0], r1[1]); o.w = cvt_pk_bf16(r1[2], r1[3]);
                    *(u32x4*)(X + (size_t)row * D + col0 + bj * HALF) = o; } }
    }
};

template <class Epi, class Sched, bool ALIGN_EPI = false, bool SP2 = false>
__device__ __forceinline__ void gemm_phase(LAS unsigned char* lds, const Gemm g, const Sched& S, const Epi& E) {
    int tid = threadIdx.x; asm volatile("" : "+v"(tid));
    const int wid = __builtin_amdgcn_readfirstlane(tid >> 6), lane = tid & 63, wr = wid >> 2, wc = wid & 3, fr = lane & 15, fq = lane >> 4;
    const int K = g.K, nt = K / BK;
    unsigned voffA[2], voffB[2];
#pragma unroll
    for (int i = 0; i < 2; ++i) { int R, C; stage_rc(tid * 16 + i * 8192, R, C); const int Rb = Epi::PERM ? ((R & ~31) + perm32(R & 31)) : R;
        voffA[i] = (unsigned)(R * K + C) * 2u; voffB[i] = (unsigned)(Rb * K + C) * 2u; }
    const size_t kstep = (size_t)(BK * 2);
    const size_t hstep = (size_t)HALF * K * 2;
    const size_t tstep = 2 * hstep;
    const unsigned ldsw = (unsigned)wid * 1024u;
    const int aoff = lds_byte(wr * 64 + fr, fq * 8), boff = lds_byte(wc * 32 + fr, fq * 8);
#define PG8_SA(b, h) (((b) * 2 + (h)) * HTB)
#define PG8_SB(b, h) ((4 + (b) * 2 + (h)) * HTB)
#define PG8_STAGE(bufoff, gbase, voff) do { _Pragma("unroll") for (int _i = 0; _i < 2; ++_i) \
        __builtin_amdgcn_global_load_lds((const unsigned*)((const char*)(gbase) + (voff)[_i]), (LAS unsigned*)(lds + (bufoff) + ldsw + _i * 8192), 16, 0, 0); } while (0)
#define PG8_LDA(dst, b, h) do { _Pragma("unroll") for (int m = 0; m < 4; ++m) _Pragma("unroll") for (int k = 0; k < 2; ++k) dst[m][k] = *(const LAS bf16x8*)(lds + PG8_SA(b, h) + aoff + m * 2048 + k * 1024); } while (0)
#define PG8_LDB(dst, b, h) do { _Pragma("unroll") for (int n = 0; n < 2; ++n) _Pragma("unroll") for (int k = 0; k < 2; ++k) dst[n][k] = *(const LAS bf16x8*)(lds + PG8_SB(b, h) + boff + n * 2048 + k * 1024); } while (0)
#define PG8_MMA(ai, bj, At, Bt) do { __builtin_amdgcn_s_setprio(1); _Pragma("unroll") for (int m = 0; m < 4; ++m) _Pragma("unroll") for (int n = 0; n < 2; ++n) _Pragma("unroll") for (int k = 0; k < 2; ++k) \
        acc[ai][bj][m][n] = __builtin_amdgcn_mfma_f32_16x16x32_bf16(Bt[n][k], At[m][k], acc[ai][bj][m][n], 0, 0, 0); __builtin_amdgcn_s_setprio(0); } while (0)
#define PG8_WAIT_V(n) asm volatile("s_waitcnt vmcnt(" #n ")" ::: "memory")
#define PG8_WAIT_L(n) asm volatile("s_waitcnt lgkmcnt(" #n ")" ::: "memory")
#define PG8_BAR __builtin_amdgcn_s_barrier()
#define PG8_SCHED __builtin_amdgcn_sched_barrier(0)
    Unit cur, nxt; int ui = 0;
    if (!S.next(0, cur)) return;
    f32x4 acc[2][2][4][2];
#pragma unroll
    for (int a = 0; a < 2; ++a)
#pragma unroll
        for (int b = 0; b < 2; ++b)
#pragma unroll
            for (int m = 0; m < 4; ++m)
#pragma unroll
                for (int n = 0; n < 2; ++n) acc[a][b][m][n] = (f32x4){0.f, 0.f, 0.f, 0.f};
    bf16x8 At[4][2], B0[2][2], B1[2][2];
    const char* cA = (const char*)g.A + (size_t)cur.pm * tstep; const char* cB = (const char*)g.Bt + (size_t)S.btile(cur) * tstep;
    S.a_ready(cur);
    if constexpr (SP2) {
        PG8_STAGE(PG8_SB(0, 0), cB, voffB); PG8_STAGE(PG8_SB(0, 1), cB + hstep, voffB); PG8_STAGE(PG8_SA(0, 0), cA, voffA); PG8_STAGE(PG8_SA(0, 1), cA + hstep, voffA);
        if (wr == 1) PG8_BAR;
        PG8_WAIT_V(2); PG8_BAR;
        PG8_STAGE(PG8_SB(1, 0), cB + kstep, voffB); PG8_STAGE(PG8_SA(1, 0), cA + kstep, voffA); PG8_STAGE(PG8_SB(1, 1), cB + hstep + kstep, voffB);
        PG8_WAIT_V(6); PG8_BAR;
    } else {
        PG8_STAGE(PG8_SB(0, 0), cB, voffB); PG8_STAGE(PG8_SA(0, 0), cA, voffA); PG8_STAGE(PG8_SB(0, 1), cB + hstep, voffB); PG8_STAGE(PG8_SA(0, 1), cA + hstep, voffA);
        if (wr == 1) PG8_BAR;
        PG8_WAIT_V(4); PG8_BAR;
        PG8_STAGE(PG8_SB(1, 0), cB + kstep, voffB); PG8_STAGE(PG8_SA(1, 0), cA + kstep, voffA); PG8_STAGE(PG8_SB(1, 1), cB + hstep + kstep, voffB);
        PG8_WAIT_V(6); PG8_BAR;
    }
    for (;;) {
        const bool has_next = S.next(ui + 1, nxt);
        const char* nA = has_next ? (const char*)g.A + (size_t)nxt.pm * tstep : cA; const char* nB = has_next ? (const char*)g.Bt + (size_t)S.btile(nxt) * tstep : cB;
        for (int t = 0; t < nt; t += 2) {
            const bool last = (t == nt - 2);
            const char* a1 = cA + (size_t)(t + 1) * kstep;
            const char* a2 = last ? nA : cA + (size_t)(t + 2) * kstep; const char* b2 = last ? nB : cB + (size_t)(t + 2) * kstep;
            const char* a3 = a2 + kstep; const char* b3 = b2 + kstep;
            if (last && has_next) S.a_ready(nxt);
            if constexpr (SP2) {
            PG8_LDB(B0, 0, 0); PG8_LDB(B1, 0, 1); PG8_SCHED; PG8_LDA(At, 0, 0); PG8_STAGE(PG8_SA(1, 1), a1 + hstep, voffA);
            PG8_WAIT_V(8); PG8_WAIT_L(0); PG8_BAR; PG8_MMA(0, 0, At, B0); PG8_MMA(0, 1, At, B1); PG8_BAR; PG8_SCHED;
            PG8_LDA(At, 0, 1); PG8_STAGE(PG8_SB(0, 0), b2, voffB); PG8_STAGE(PG8_SB(0, 1), b2 + hstep, voffB); PG8_STAGE(PG8_SA(0, 0), a2, voffA);
            PG8_WAIT_V(8); PG8_WAIT_L(0); PG8_BAR; PG8_MMA(1, 0, At, B0); PG8_MMA(1, 1, At, B1); PG8_BAR; PG8_SCHED;
            PG8_LDB(B0, 1, 0); PG8_LDB(B1, 1, 1); PG8_SCHED; PG8_LDA(At, 1, 0); PG8_STAGE(PG8_SA(0, 1), a2 + hstep, voffA);
            PG8_WAIT_V(8); PG8_WAIT_L(0); PG8_BAR; PG8_MMA(0, 0, At, B0); PG8_MMA(0, 1, At, B1); PG8_BAR; PG8_SCHED;
            PG8_LDA(At, 1, 1); PG8_STAGE(PG8_SB(1, 0), b3, voffB); PG8_STAGE(PG8_SB(1, 1), b3 + hstep, voffB); PG8_STAGE(PG8_SA(1, 0), a3, voffA);
            PG8_WAIT_V(8); PG8_WAIT_L(0); PG8_BAR; PG8_MMA(1, 0, At, B0); PG8_MMA(1, 1, At, B1); PG8_BAR; PG8_SCHED;
            } else {
            PG8_LDB(B0, 0, 0); PG8_SCHED; PG8_LDA(At, 0, 0); PG8_STAGE(PG8_SA(1, 1), a1 + hstep, voffA);
            PG8_WAIT_L(8); PG8_BAR; PG8_WAIT_L(0); PG8_MMA(0, 0, At, B0); PG8_BAR; PG8_SCHED;
            PG8_LDB(B1, 0, 1); PG8_STAGE(PG8_SB(0, 0), b2, voffB);
            PG8_BAR; PG8_WAIT_L(0); PG8_MMA(0, 1, At, B1); PG8_BAR;
            PG8_LDA(At, 0, 1); PG8_STAGE(PG8_SA(0, 0), a2, voffA);
            PG8_BAR; PG8_WAIT_L(0); PG8_MMA(1, 0, At, B0); PG8_BAR; PG8_SCHED;
            PG8_STAGE(PG8_SB(0, 1), b2 + hstep, voffB);
            PG8_WAIT_V(6); PG8_BAR; PG8_MMA(1, 1, At, B1); PG8_BAR;
            PG8_LDB(B0, 1, 0); PG8_SCHED; PG8_LDA(At, 1, 0); PG8_STAGE(PG8_SA(0, 1), a2 + hstep, voffA);
            PG8_WAIT_L(8); PG8_BAR; PG8_WAIT_L(0); PG8_MMA(0, 0, At, B0); PG8_BAR; PG8_SCHED;
            PG8_LDB(B1, 1, 1); PG8_STAGE(PG8_SB(1, 0), b3, voffB);
            PG8_BAR; PG8_WAIT_L(0); PG8_MMA(0, 1, At, B1); PG8_BAR;
            PG8_LDA(At, 1, 1); PG8_STAGE(PG8_SA(1, 0), a3, voffA);
            PG8_BAR; PG8_WAIT_L(0); PG8_MMA(1, 0, At, B0); PG8_BAR; PG8_SCHED;
            PG8_STAGE(PG8_SB(1, 1), b3 + hstep, voffB);
            PG8_WAIT_V(6); PG8_BAR; PG8_MMA(1, 1, At, B1); PG8_BAR;
            }
        }
        if constexpr (ALIGN_EPI) { if (wr == 0) PG8_BAR; }
        E(acc, cur, wr, wc, fr, fq); S.done(cur);
        if (!has_next) break;
#pragma unroll
        for (int a = 0; a < 2; ++a)
#pragma unroll
            for (int b = 0; b < 2; ++b)
#pragma unroll
                for (int m = 0; m < 4; ++m)
#pragma unroll
                    for (int n = 0; n < 2; ++n) acc[a][b][m][n] = (f32x4){0.f, 0.f, 0.f, 0.f};
        cur = nxt; cA = nA; cB = nB; ++ui;
        if constexpr (ALIGN_EPI) { if (wr == 1) PG8_BAR; }
    }
    PG8_WAIT_V(0);
    if constexpr (!ALIGN_EPI) { if (wr == 0) PG8_BAR; }
    PG8_BAR;
#undef PG8_SA
#undef PG8_SB
#undef PG8_STAGE
#undef PG8_LDA
#undef PG8_LDB
#undef PG8_MMA
#undef PG8_WAIT_V
#undef PG8_WAIT_L
#undef PG8_BAR
#undef PG8_SCHED
}
}

#define XB_TMO      128
#define XB_XCNT(j)  (256  + 64 * (j))
#define XB_XSUB(j)  (1280 + 64 * (j))
#define XB_XGEN(j)  (2304 + 64 * (j))
#define XB_TOP      3328
#define XB_TOPGEN   3392
#define XCD_BAR_WORDS 3456
#define XB_SPIN_CAP (1u << 18)

__device__ __forceinline__ unsigned xb_ld(unsigned* p)              { return __hip_atomic_load(p, __ATOMIC_RELAXED, __HIP_MEMORY_SCOPE_AGENT); }
__device__ __forceinline__ unsigned xb_add(unsigned* p, unsigned v) { return __hip_atomic_fetch_add(p, v, __ATOMIC_RELAXED, __HIP_MEMORY_SCOPE_AGENT); }
__device__ __forceinline__ unsigned xb_xcc_id() { return (unsigned)__builtin_amdgcn_s_getreg((3 << 11) | 20) & 0xFu; }
#define XB_SPIN(cond, bar) do { unsigned _sp = 0; while (cond) { __builtin_amdgcn_s_sleep(1); \
    if ((++_sp & 255u) == 0u) { if (xb_ld(&(bar)[XB_TMO])) break; if (_sp > XB_SPIN_CAP) { atomicAdd(&(bar)[XB_TMO], 1u); break; } } } } while (0)

struct XcdBarrier { unsigned* bar; unsigned x; volatile LAS unsigned* st; };

__device__ __forceinline__ XcdBarrier xcd_barrier_post(unsigned* bar, volatile LAS unsigned* st) {
    XcdBarrier b; b.bar = bar; b.x = xb_xcc_id(); b.st = st;
    if (threadIdx.x == 0) (void)xb_add(&bar[XB_XCNT(b.x)], 1u);
    return b;
}
__device__ __forceinline__ void xcd_barrier_complete(unsigned* bar, unsigned x, unsigned& nloc, unsigned& nx) {
    const unsigned G = gridDim.x * gridDim.y * gridDim.z;
    unsigned sum, cnt, mine, sp = 0u;
    for (;;) {
        sum = 0u; cnt = 0u; mine = 0u;
#pragma unroll
        for (unsigned j = 0; j < 16; ++j) { const unsigned c = xb_ld(&bar[XB_XCNT(j)]); sum += c; cnt += (c > 0u) ? 1u : 0u; mine = (j == x) ? c : mine; }
        if (sum == G) break;
        __builtin_amdgcn_s_sleep(1);
        if ((++sp & 255u) == 0u) { if (xb_ld(&bar[XB_TMO])) break; if (sp > XB_SPIN_CAP) { atomicAdd(&bar[XB_TMO], 1u); break; } }
    }
    nloc = mine > 0u ? mine : 1u; nx = cnt > 0u ? cnt : 1u;
}
__device__ __forceinline__ void xcd_barrier(const XcdBarrier& b) {
    asm volatile("s_waitcnt vmcnt(0)" ::: "memory");
    __syncthreads();
    if (threadIdx.x == 0) {
        unsigned* bar = b.bar;
        __builtin_amdgcn_s_waitcnt(0);
        unsigned nloc = b.st[0], nx = b.st[1];
        if (nloc == 0u) { xcd_barrier_complete(bar, b.x, nloc, nx); b.st[0] = nloc; b.st[1] = nx; }
        const unsigned old = xb_add(&bar[XB_XSUB(b.x)], 1u);
        const unsigned gen = old / nloc;
        if (old + 1u == (gen + 1u) * nloc) {
            __builtin_amdgcn_fence(__ATOMIC_RELEASE, "agent");
            asm volatile("s_waitcnt vmcnt(0)" ::: "memory");
            const unsigned og = xb_add(&bar[XB_TOP], 1u);
            const unsigned tg = og / nx;
            if (og + 1u == (tg + 1u) * nx) xb_add(&bar[XB_TOPGEN], 1u);
            else XB_SPIN(xb_ld(&bar[XB_TOPGEN]) == tg, bar);
            __builtin_amdgcn_fence(__ATOMIC_ACQUIRE, "agent");
            xb_add(&bar[XB_XGEN(b.x)], 1u);
            asm volatile("s_waitcnt vmcnt(0)" ::: "memory");
        } else {
            XB_SPIN(xb_ld(&bar[XB_XGEN(b.x)]) == gen, bar);
            __builtin_amdgcn_fence(__ATOMIC_ACQUIRE, "agent");
            asm volatile("s_waitcnt vmcnt(0)" ::: "memory");
        }
    }
    __syncthreads();
}

constexpr int NWAVES = 8;
constexpr int RING_BYTES = 131072;
constexpr int LDSCTL_OFF = RING_BYTES, MISC_OFF = LDSCTL_OFF + 320;
constexpr int LDS_BYTES = 147456;
constexpr int NPHASE = 2 + 6 * NLAYER;

#define LDS_WAIT() asm volatile("s_waitcnt lgkmcnt(0)" ::: "memory")

struct Args { const float* in[20]; float* out; unsigned char* ws; int ph_lo, ph_hi, li, pad; };

#define CAS __attribute__((address_space(4)))
struct Frame {
    LAS unsigned char* lds;
    int tid, lane, wave, G, gw, NGW;
    const CAS unsigned char* ka;
    __device__ __forceinline__ const float* x() const { return *(const float* const CAS*)(ka + 0); }
    __device__ __forceinline__ const float* c() const { return *(const float* const CAS*)(ka + 8); }
    __device__ __forceinline__ const float* ctx() const { return *(const float* const CAS*)(ka + 16); }
    __device__ __forceinline__ const float* c_ctx() const { return *(const float* const CAS*)(ka + 24); }
    __device__ __forceinline__ const float* w_ada() const { return *(const float* const CAS*)(ka + 32); }
    __device__ __forceinline__ const float* b_ada() const { return *(const float* const CAS*)(ka + 40); }
    __device__ __forceinline__ const float* w_in() const { return *(const float* const CAS*)(ka + 48); }
    __device__ __forceinline__ const float* conv_w() const { return *(const float* const CAS*)(ka + 56); }
    __device__ __forceinline__ const float* sink() const { return *(const float* const CAS*)(ka + 64); }
    __device__ __forceinline__ const float* g_attn() const { return *(const float* const CAS*)(ka + 72); }
    __device__ __forceinline__ const float* g_conv() const { return *(const float* const CAS*)(ka + 80); }
    __device__ __forceinline__ const float* w_out() const { return *(const float* const CAS*)(ka + 88); }
    __device__ __forceinline__ const float* ln1_g() const { return *(const float* const CAS*)(ka + 96); }
    __device__ __forceinline__ const float* ln1_b() const { return *(const float* const CAS*)(ka + 104); }
    __device__ __forceinline__ const float* wq() const { return *(const float* const CAS*)(ka + 112); }
    __device__ __forceinline__ const float* keys() const { return *(const float* const CAS*)(ka + 120); }
    __device__ __forceinline__ const float* pu() const { return *(const float* const CAS*)(ka + 128); }
    __device__ __forceinline__ const float* pv() const { return *(const float* const CAS*)(ka + 136); }
    __device__ __forceinline__ const float* ln2_g() const { return *(const float* const CAS*)(ka + 144); }
    __device__ __forceinline__ const float* ln2_b() const { return *(const float* const CAS*)(ka + 152); }
    __device__ __forceinline__ float* out() const { return *(float* const CAS*)(ka + 160); }
    __device__ __forceinline__ unsigned char* ws() const { return *(unsigned char* const CAS*)(ka + 168); }
    __device__ __forceinline__ float* MODS() const { return (float*)(ws() + WS_MODS); }
    __device__ __forceinline__ float* ROPE() const { return (float*)(ws() + WS_ROPE); }
    __device__ __forceinline__ bf16_t* X() const { return (bf16_t*)(ws() + WS_X); }
    __device__ __forceinline__ float* SC() const { return (float*)(ws() + WS_SC); }
    __device__ __forceinline__ bf16_t* KBD() const { return (bf16_t*)(ws() + WS_KBD); }
    __device__ __forceinline__ bf16_t* WQR() const { return (bf16_t*)(ws() + WS_WQR); }
    __device__ __forceinline__ bf16_t* WINT() const { return (bf16_t*)(ws() + WS_WINT); }
    __device__ __forceinline__ bf16_t* WOUTT() const { return (bf16_t*)(ws() + WS_WOUTT); }
    __device__ __forceinline__ bf16_t* WEFFT() const { return (bf16_t*)(ws() + WS_WEFFT); }
    __device__ __forceinline__ bf16_t* H() const { return (bf16_t*)(ws() + WS_H); }
    __device__ __forceinline__ bf16_t* PROJ() const { return (bf16_t*)(ws() + WS_PROJ); }
    __device__ __forceinline__ bf16_t* MIX() const { return (bf16_t*)(ws() + WS_MIX); }
    __device__ __forceinline__ unsigned char* UT() const { return (unsigned char*)(ws() + WS_UT); }
    __device__ __forceinline__ unsigned char* VT() const { return (unsigned char*)(ws() + WS_VT); }
    __device__ __forceinline__ float* US() const { return (float*)(ws() + WS_US); }
    __device__ __forceinline__ float* VS() const { return (float*)(ws() + WS_VS); }
};

__device__ __forceinline__ void frame_ids(Frame& F) {
    int tz = threadIdx.x; asm volatile("" : "+v"(tz));
    F.tid = tz; F.lane = tz & 63; F.wave = __builtin_amdgcn_readfirstlane(tz >> 6);
    F.gw = blockIdx.x * NWAVES + F.wave;
    const CAS unsigned char* k = (const CAS unsigned char*)__builtin_amdgcn_kernarg_segment_ptr(); asm volatile("" : "+s"(k)); F.ka = k;
}
template <int CTRL> __device__ __forceinline__ int dpp_i(int v) { return __builtin_amdgcn_update_dpp(0, v, CTRL, 0xf, 0xf, true); }
template <int CTRL> __device__ __forceinline__ float dpp_f(float v) { return __int_as_float(dpp_i<CTRL>(__float_as_int(v))); }
constexpr int DPP_XOR1 = 0xB1, DPP_XOR2 = 0x4E, DPP_HMIRROR = 0x141, DPP_ROR4 = 0x124, DPP_ROR8 = 0x128;
__device__ __forceinline__ float wave_sum_u(float v) {
    v += dpp_f<DPP_XOR1>(v); v += dpp_f<DPP_XOR2>(v); v += dpp_f<DPP_ROR4>(v); v += dpp_f<DPP_ROR8>(v);
    const float r0 = __int_as_float(__builtin_amdgcn_readlane(__float_as_int(v), 0)), r1 = __int_as_float(__builtin_amdgcn_readlane(__float_as_int(v), 16));
    const float r2 = __int_as_float(__builtin_amdgcn_readlane(__float_as_int(v), 32)), r3 = __int_as_float(__builtin_amdgcn_readlane(__float_as_int(v), 48));
    return (r0 + r1) + (r2 + r3);
}
__device__ __forceinline__ float wave_max_u(float v) {
    v = fmaxf(v, dpp_f<DPP_XOR1>(v)); v = fmaxf(v, dpp_f<DPP_XOR2>(v)); v = fmaxf(v, dpp_f<DPP_ROR4>(v)); v = fmaxf(v, dpp_f<DPP_ROR8>(v));
    const float r0 = __int_as_float(__builtin_amdgcn_readlane(__float_as_int(v), 0)), r1 = __int_as_float(__builtin_amdgcn_readlane(__float_as_int(v), 16));
    const float r2 = __int_as_float(__builtin_amdgcn_readlane(__float_as_int(v), 32)), r3 = __int_as_float(__builtin_amdgcn_readlane(__float_as_int(v), 48));
    return fmaxf(fmaxf(r0, r1), fmaxf(r2, r3));
}
__device__ __forceinline__ float wave_sum(float v) { return wave_sum_u(v); }
__device__ __forceinline__ unsigned pk2(float lo, float hi) { return pg8::cvt_pk_bf16(lo, hi); }
__device__ __forceinline__ float bf_lo(unsigned u) { return __uint_as_float(u << 16); }
__device__ __forceinline__ float bf_hi(unsigned u) { return __uint_as_float(u & 0xffff0000u); }
__device__ __forceinline__ int modrow(int t) { return t < TL ? t / SEQ : 2; }

__device__ __forceinline__ void transpose_item(const float* W, int K, int N, bf16_t* WT, LAS float* scr, int item, int lane) {
    const int nblk = N / 32, kb = item / nblk, nb = item % nblk, k0 = 64 * kb, n0 = 32 * nb;
#pragma unroll 8
    for (int i = 0; i < 32; ++i) { const int kk = 2 * i + (lane >> 5); scr[kk * 33 + (lane & 31)] = W[(size_t)(k0 + kk) * N + n0 + (lane & 31)]; }
    LDS_WAIT(); asm volatile("" ::: "memory");
    const int c = lane & 7;
#pragma unroll
    for (int j = 0; j < 4; ++j) { const int n = (lane >> 3) + 8 * j; const LAS float* s = scr + (8 * c) * 33 + n;
        u32x4 o; o.x = pk2(s[0 * 33], s[1 * 33]); o.y = pk2(s[2 * 33], s[3 * 33]); o.z = pk2(s[4 * 33], s[5 * 33]); o.w = pk2(s[6 * 33], s[7 * 33]);
        *(u32x4*)(WT + (size_t)(n0 + n) * K + k0 + 8 * c) = o; }
    LDS_WAIT(); asm volatile("" ::: "memory");
}

__device__ __forceinline__ void cvt_row_bf16(const float* src, bf16_t* dst, int lane) {
    const f32x4* s = (const f32x4*)src + lane; u32x2* d = (u32x2*)dst + lane;
    f32x4 v[8];
#pragma unroll
    for (int j = 0; j < 8; ++j) v[j] = __builtin_nontemporal_load(s + 64 * j);
#pragma unroll
    for (int j = 0; j < 8; ++j) { u32x2 o; o.x = pk2(v[j].x, v[j].y); o.y = pk2(v[j].z, v[j].w); d[64 * j] = o; }
}

struct RowF32 { f32x4 v[4][2]; };
__device__ __forceinline__ void row_load_nt(RowF32& R, const float* src, int lane) {
    const f32x4* s = (const f32x4*)src + 2 * lane;
#pragma unroll
    for (int j = 0; j < 4; ++j) { R.v[j][0] = __builtin_nontemporal_load(s + 128 * j); R.v[j][1] = __builtin_nontemporal_load(s + 128 * j + 1); }
}
template <int FMT>
__device__ __forceinline__ void cvt_row_lp(const RowF32& R, unsigned char* dst, float* inv, int lane) {
    constexpr float QMAX = FMT == 8 ? 224.f : 6.f;
    float am = 0.f;
#pragma unroll
    for (int j = 0; j < 4; ++j)
#pragma unroll
        for (int q = 0; q < 2; ++q) am = fmaxf(fmaxf(am, fmaxf(fabsf(R.v[j][q].x), fabsf(R.v[j][q].y))), fmaxf(fabsf(R.v[j][q].z), fabsf(R.v[j][q].w)));
    am = wave_max_u(am);
    const float sc = am > 0.f ? QMAX / am : 1.f;
#pragma unroll
    for (int j = 0; j < 4; ++j) {
        if constexpr (FMT == 8) {
            u32x2 w;
#pragma unroll
            for (int q = 0; q < 2; ++q) { int t = __builtin_amdgcn_cvt_pk_fp8_f32(R.v[j][q].x * sc, R.v[j][q].y * sc, 0, false); t = __builtin_amdgcn_cvt_pk_fp8_f32(R.v[j][q].z * sc, R.v[j][q].w * sc, t, true); w[q] = (unsigned)t; }
            *((u32x2*)dst + lane + 64 * j) = w;
        } else {
            unsigned w = 0u;
            w = __builtin_amdgcn_cvt_scalef32_pk_fp4_f32(w, R.v[j][0].x * sc, R.v[j][0].y * sc, 1.0f, 0);
            w = __builtin_amdgcn_cvt_scalef32_pk_fp4_f32(w, R.v[j][0].z * sc, R.v[j][0].w * sc, 1.0f, 1);
            w = __builtin_amdgcn_cvt_scalef32_pk_fp4_f32(w, R.v[j][1].x * sc, R.v[j][1].y * sc, 1.0f, 2);
            w = __builtin_amdgcn_cvt_scalef32_pk_fp4_f32(w, R.v[j][1].z * sc, R.v[j][1].w * sc, 1.0f, 3);
            *((unsigned*)dst + lane + 64 * j) = w;
        }
    }
    if (lane == 0) *inv = am > 0.f ? am * (1.f / QMAX) : 1.f;
}
template <int FMT> struct LpRow;
template <> struct LpRow<8> { u32x4 a, b;
    __device__ __forceinline__ void load(const unsigned char* rowp, int lane) { a = *(const u32x4*)(rowp + 32 * lane); b = *(const u32x4*)(rowp + 32 * lane + 16); }
    template <class Fn> __device__ __forceinline__ void each(Fn&& f) const {
#pragma unroll
        for (int w = 0; w < 4; ++w) { const f32x2 l0 = __builtin_amdgcn_cvt_pk_f32_fp8((int)a[w], false), h0 = __builtin_amdgcn_cvt_pk_f32_fp8((int)a[w], true);
            f(4 * w, l0.x, l0.y); f(4 * w + 2, h0.x, h0.y); }
#pragma unroll
        for (int w = 0; w < 4; ++w) { const f32x2 l0 = __builtin_amdgcn_cvt_pk_f32_fp8((int)b[w], false), h0 = __builtin_amdgcn_cvt_pk_f32_fp8((int)b[w], true);
            f(16 + 4 * w, l0.x, l0.y); f(16 + 4 * w + 2, h0.x, h0.y); }
    } };
template <> struct LpRow<4> { u32x4 a;
    __device__ __forceinline__ void load(const unsigned char* rowp, int lane) { a = *(const u32x4*)(rowp + 16 * lane); }
    template <class Fn> __device__ __forceinline__ void each(Fn&& f) const {
#pragma unroll
        for (int w = 0; w < 4; ++w) {
            const f32x2 d0 = __builtin_amdgcn_cvt_scalef32_pk_f32_fp4(a[w], 1.0f, 0), d1 = __builtin_amdgcn_cvt_scalef32_pk_f32_fp4(a[w], 1.0f, 1);
            const f32x2 d2 = __builtin_amdgcn_cvt_scalef32_pk_f32_fp4(a[w], 1.0f, 2), d3 = __builtin_amdgcn_cvt_scalef32_pk_f32_fp4(a[w], 1.0f, 3);
            f(8 * w, d0.x, d0.y); f(8 * w + 2, d1.x, d1.y); f(8 * w + 4, d2.x, d2.y); f(8 * w + 6, d3.x, d3.y); }
    } };

__device__ __forceinline__ void row_stats(const f32x4 (&v)[8], float& mean, float& rstd) {
    float s = 0.f;
#pragma unroll
    for (int j = 0; j < 8; ++j) s += (v[j].x + v[j].y) + (v[j].z + v[j].w);
    mean = wave_sum(s) * (1.f / D);
    float s2 = 0.f;
#pragma unroll
    for (int j = 0; j < 8; ++j) { const f32x4 d = v[j] - mean; s2 += (d.x * d.x + d.y * d.y) + (d.z * d.z + d.w * d.w); }
    rstd = 1.f / sqrtf(wave_sum(s2) * (1.f / D) + LN_EPS);
}
__device__ __forceinline__ void modulate_store(const f32x4 (&v)[8], const float* shift, const float* scale, bf16_t* dst, int lane) {
    float mean, rstd; row_stats(v, mean, rstd);
    u32x2* d = (u32x2*)dst + lane;
#pragma unroll
    for (int j = 0; j < 8; ++j) { const f32x4 sc = *((const f32x4*)scale + lane + 64 * j), sh = *((const f32x4*)shift + lane + 64 * j);
        const f32x4 y = (v[j] - mean) * rstd * (sc + 1.f) + sh;
        u32x2 o; o.x = pk2(y.x, y.y); o.y = pk2(y.z, y.w); d[64 * j] = o; }
}

__device__ __forceinline__ void convert_tables(Frame& F, int row0, int row1, int w0, int wstride) {
    RowF32 ru, rv, nu, nv;
    int row = row0 + w0;
    if (row < row1) { row_load_nt(ru, F.pu() + (size_t)row * D, F.lane); row_load_nt(rv, F.pv() + (size_t)row * D, F.lane); }
    while (row < row1) {
        const int nrow = row + wstride;
        if (nrow < row1) { row_load_nt(nu, F.pu() + (size_t)nrow * D, F.lane); row_load_nt(nv, F.pv() + (size_t)nrow * D, F.lane); }
        cvt_row_lp<U_FMT>(ru, F.UT() + (size_t)row * UROW, F.US() + row, F.lane);
        cvt_row_lp<V_FMT>(rv, F.VT() + (size_t)row * VROW, F.VS() + row, F.lane);
        ru = nu; rv = nv; row = nrow;
    }
}
__device__ __forceinline__ void convert_in_tail(Frame& F, int layer, int nunits, int part) {
    if (layer + 1 >= NLAYER) return;
    const int G = F.G, rounds = (nunits + G - 1) / G, nlast = nunits - (rounds - 1) * G;
    const int c = (int)blockIdx.x;
    int nshort = G - nlast, sidx = c - nlast;
    if (nshort <= 0) { nshort = G; sidx = c; }
    else if (sidx < 0) return;
    const int r0 = (layer + 1) * NEXP + part * (NEXP / 2);
    convert_tables(F, r0, r0 + NEXP / 2, sidx * NWAVES + F.wave, nshort * NWAVES);
}
__device__ __forceinline__ void p0a_prologue(Frame& F) {
    LAS float* condL = (LAS float*)F.lds;
    LAS float* red = (LAS float*)(F.lds + 24576);
    for (int i = F.tid; i < 3 * D; i += NWAVES * 64) { const int r = i / D, k = i % D; const float v = r < 2 ? F.c()[r * D + k] : F.c_ctx()[k]; condL[i] = v / (1.f + __expf(-v)); }
    __syncthreads();
    for (int item = blockIdx.x; item < 384; item += F.G) {
        const int l = item / 96, n0 = (item % 96) * 128;
        const float* wp = F.w_ada() + ((size_t)l * D + F.wave * 256) * 12288 + n0 + 2 * F.lane;
        f32x2 a0 = {0.f, 0.f}, a1 = {0.f, 0.f}, a2 = {0.f, 0.f};
#pragma unroll 8
        for (int k = 0; k < 256; ++k) { const f32x2 w = __builtin_nontemporal_load((const f32x2*)(wp + (size_t)k * 12288)); const int kk = F.wave * 256 + k;
            a0 += w * condL[kk]; a1 += w * condL[D + kk]; a2 += w * condL[2 * D + kk]; }
        LAS float* rp = red + F.wave * 384 + 2 * F.lane;
        rp[0] = a0.x; rp[1] = a0.y; rp[128] = a1.x; rp[129] = a1.y; rp[256] = a2.x; rp[257] = a2.y;
        __syncthreads();
        if (F.tid < 384) { const int r = F.tid / 128, n = F.tid % 128; float s = 0.f;
#pragma unroll
            for (int w = 0; w < 8; ++w) s += red[w * 384 + r * 128 + n];
            F.MODS()[((size_t)l * 3 + r) * 12288 + n0 + n] = s + F.b_ada()[(size_t)l * 12288 + n0 + n]; }
        __syncthreads();
    }
    LAS float* scr = (LAS float*)(F.lds + 40960 + F.wave * 8448);
    constexpr int I_IN = (D / 64) * (INC / 32), I_OUT = (D / 64) * (D / 32);
    for (int it = F.gw; it < NLAYER * (I_IN + I_OUT); it += F.NGW) {
        const int l = it / (I_IN + I_OUT); int r = it % (I_IN + I_OUT);
        if (r < I_IN) transpose_item(F.w_in() + (size_t)l * D * INC, D, INC, F.WINT() + (size_t)l * INC * D, scr, r, F.lane);
        else transpose_item(F.w_out() + (size_t)l * D * D, D, D, F.WOUTT() + (size_t)l * D * D, scr, r - I_IN, F.lane);
    }
    for (int row = F.gw; row < NLAYER * D; row += F.NGW) {
        const int l = row / D, c = row % D; const f32x4* s = (const f32x4*)(F.wq() + (size_t)row * D) + F.lane;
#pragma unroll
        for (int j = 0; j < 8; ++j) { const f32x4 v = s[64 * j]; u32x2 o; o.x = pk2(v.x, v.y); o.y = pk2(v.z, v.w);
            *((u32x2*)(F.WQR() + ((size_t)(l * 8 + j) * D + c) * 256) + F.lane) = o; }
    }
    for (int row = F.gw; row < 32 * 256; row += F.NGW) {
        const int lh = row >> 8, pk = row & 255, p = pk >> 7;
        u32x2 o = {0u, 0u};
        if ((F.lane >> 5) == p) { const f32x4 v = *((const f32x4*)(F.keys() + ((size_t)lh * 256 + pk) * 128) + (F.lane & 31)); o.x = pk2(v.x, v.y); o.y = pk2(v.z, v.w); }
        *((u32x2*)(F.KBD() + (size_t)row * 256) + F.lane) = o;
    }
    convert_tables(F, 0, NEXP, F.gw, F.NGW);
    for (int i = blockIdx.x * (NWAVES * 64) + F.tid; i < 192 * 32; i += F.G * NWAVES * 64) {
        const int idx = i >> 5, f = i & 31; const float pos = (float)(idx < 128 ? idx : idx - 128);
        const float inv = powf(10000.f, -(float)(2 * f) / 64.f); const float ang = pos * inv;
        F.ROPE()[2 * i] = cosf(ang); F.ROPE()[2 * i + 1] = sinf(ang);
    }
}

__device__ __forceinline__ void p0b_mod0(Frame& F) {
    for (int t = F.gw; t < TT; t += F.NGW) {
        const float* src = t < TL ? F.x() + (size_t)t * D : F.ctx() + (size_t)(t - TL) * D;
        f32x4 v[8];
#pragma unroll
        for (int j = 0; j < 8; ++j) v[j] = *((const f32x4*)src + F.lane + 64 * j);
        const float* mp = F.MODS() + (size_t)modrow(t) * 12288;
        modulate_store(v, mp, mp + D, F.H() + (size_t)t * D, F.lane);
    }
}

constexpr int KP = 272, VP = 320, KS_BYTES = 64 * KP, VS_BYTES = 64 * VP;
struct KVRegs { u32x4 k1, k2, v1, v2; f32x4 cs[4]; };

__device__ __forceinline__ void attn_load_tile(Frame& F, KVRegs& R, int ti, int b, int n, int g) {
    const int key = F.tid >> 3, c8 = F.tid & 7;
    int row, pos = 0;
    if (ti < 6) { pos = (n - 1) * 128 + 64 * ti + key; row = b * SEQ + pos; } else row = TL + b * CTXL + 64 * (ti - 6) + key;
    const bf16_t* base = F.PROJ() + (size_t)row * INC;
    const int d1 = (c8 >> 2) * 64 + (c8 & 3) * 8;
    R.k1 = *(const u32x4*)(base + OFF_K + g * 128 + d1); R.k2 = *(const u32x4*)(base + OFF_K + g * 128 + d1 + 32);
    R.v1 = *(const u32x4*)(base + OFF_V + g * 128 + 8 * c8); R.v2 = *(const u32x4*)(base + OFF_V + g * 128 + 64 + 8 * c8);
    if (ti < 6) { const int tidx = (c8 >> 2) ? 128 + (pos & 63) : (pos >> 6); const f32x4* cp = (const f32x4*)(F.ROPE() + ((size_t)tidx * 32 + (c8 & 3) * 8) * 2);
#pragma unroll
        for (int m = 0; m < 4; ++m) R.cs[m] = cp[m]; }
}
__device__ __forceinline__ void rope8(u32x4& a, u32x4& bq, const f32x4 (&cs)[4], float scale) {
    u32x4 oa, ob;
#pragma unroll
    for (int w = 0; w < 4; ++w) {
        const float x1l = bf_lo(a[w]), x1h = bf_hi(a[w]), x2l = bf_lo(bq[w]), x2h = bf_hi(bq[w]);
        const float cl = cs[w].x, sl = cs[w].y, ch = cs[w].z, sh = cs[w].w;
        oa[w] = pk2((x1l * cl - x2l * sl) * scale, (x1h * ch - x2h * sh) * scale);
        ob[w] = pk2((x2l * cl + x1l * sl) * scale, (x2h * ch + x1h * sh) * scale);
    }
    a = oa; bq = ob;
}
__device__ __forceinline__ void attn_store_tile(Frame& F, KVRegs& R, int ti, int buf) {
    const int key = F.tid >> 3, c8 = F.tid & 7;
    if (ti < 6) rope8(R.k1, R.k2, R.cs, 1.f);
    const int d1 = (c8 >> 2) * 64 + (c8 & 3) * 8;
    LAS unsigned char* kp = F.lds + buf * KS_BYTES + key * KP;
    *(LAS u32x4*)(kp + d1 * 2) = R.k1; *(LAS u32x4*)(kp + (d1 + 32) * 2) = R.k2;
    LAS unsigned char* vp = F.lds + 2 * KS_BYTES + buf * VS_BYTES + key * VP;
    *(LAS u32x4*)(vp + 16 * c8) = R.v1; *(LAS u32x4*)(vp + 128 + 16 * c8) = R.v2;
}

#define MFMA32(a, b, c) __builtin_amdgcn_mfma_f32_32x32x16_bf16((a), (b), (c), 0, 0, 0)

__device__ __forceinline__ void attn_unit(Frame& F, int layer, int u) {
    const bool latent = u < 512;
    int b, n, g, hp;
    if (latent) { hp = u & 1; g = (u >> 1) & 1; n = (u >> 2) & 63; b = u >> 8; }
    else { const int v = u - 512; hp = v & 1; g = (v >> 1) & 1; n = (v >> 2) & 1; b = v >> 3; }
    const int lane = F.lane, r = lane & 31, h = lane >> 5, wave = F.wave;
    const int head = g * 4 + hp * 2 + (wave >> 2), qb = wave & 3;
    const int tq = latent ? b * SEQ + n * 128 + 32 * qb + r : TL + b * CTXL + n * 128 + 32 * qb + r;
    bf16x8 qf[8];
    {
        u32x4 raw[8];
        const bf16_t* qp = F.PROJ() + (size_t)tq * INC + OFF_Q + head * 128 + 8 * h;
#pragma unroll
        for (int ks = 0; ks < 8; ++ks) raw[ks] = *(const u32x4*)(qp + 16 * ks);
        if (latent) {
            const int pos = n * 128 + 32 * qb + r;
#pragma unroll
            for (int half = 0; half < 2; ++half) {
                const int tidx = half ? 128 + (pos & 63) : (pos >> 6);
#pragma unroll
                for (int kk = 0; kk < 2; ++kk) {
                    const f32x4* cp = (const f32x4*)(F.ROPE() + ((size_t)tidx * 32 + 16 * kk + 8 * h) * 2);
                    f32x4 cs[4];
#pragma unroll
                    for (int m = 0; m < 4; ++m) cs[m] = cp[m];
                    rope8(raw[4 * half + kk], raw[4 * half + kk + 2], cs, QSCALE);
                }
            }
        } else {
#pragma unroll
            for (int ks = 0; ks < 8; ++ks)
#pragma unroll
                for (int w = 0; w < 4; ++w) raw[ks][w] = pk2(bf_lo(raw[ks][w]) * QSCALE, bf_hi(raw[ks][w]) * QSCALE);
        }
#pragma unroll
        for (int ks = 0; ks < 8; ++ks) qf[ks] = __builtin_bit_cast(bf16x8, raw[ks]);
    }
    int tlo = 6, nw = 0;
    if (latent) { tlo = (n == 0) ? 2 : 0; const int thi = (n == 63) ? 3 : 5; nw = thi - tlo + 1; }
    const int ntiles = nw + 4;
    f32x16 o[4];
#pragma unroll
    for (int db = 0; db < 4; ++db)
#pragma unroll
        for (int i = 0; i < 16; ++i) o[db][i] = 0.f;
    float m_run = F.sink()[layer * 8 + head] * LOG2E;
    float lsum = h == 0 ? 1.f : 0.f;
    const int iq = 32 * qb + r;
    KVRegs R;
    __syncthreads();
    attn_load_tile(F, R, nw > 0 ? tlo : 6, b, n, g);
    attn_store_tile(F, R, nw > 0 ? tlo : 6, 0);
    __syncthreads();
    const int i16 = lane & 15, tq4 = i16 >> 2, tp = i16 & 3, blk = (lane >> 4) & 1;
    for (int j = 0; j < ntiles; ++j) {
        const int ti = j < nw ? tlo + j : 6 + (j - nw);
        const int buf = j & 1;
        const bool more = j + 1 < ntiles;
        const int tin = (j + 1) < nw ? tlo + j + 1 : 6 + (j + 1 - nw);
        if (more) attn_load_tile(F, R, tin, b, n, g);
        const bool part = ti >= 6 || (ti >= (qb >> 1) && ti <= (qb >> 1) + 4);
        if (part) {
            f32x16 s0, s1;
#pragma unroll
            for (int i = 0; i < 16; ++i) { s0[i] = 0.f; s1[i] = 0.f; }
            const LAS unsigned char* kb = F.lds + buf * KS_BYTES + r * KP + h * 16;
#pragma unroll
            for (int ks = 0; ks < 8; ++ks) {
                const bf16x8 a0 = *(const LAS bf16x8*)(kb + ks * 32), a1 = *(const LAS bf16x8*)(kb + 32 * KP + ks * 32);
                s0 = MFMA32(a0, qf[ks], s0); s1 = MFMA32(a1, qf[ks], s1);
            }
            float mx = -INFINITY;
            if (ti < 6 && (ti == (qb >> 1) || ti == (qb >> 1) + 4)) {
                const int jb = 64 * ti + 4 * h - iq;
#pragma unroll
                for (int i = 0; i < 16; ++i) { const int j0 = jb + (i & 3) + 8 * (i >> 2), j1 = j0 + 32;
                    s0[i] = (j0 >= 0 && j0 <= 256) ? s0[i] : -INFINITY; s1[i] = (j1 >= 0 && j1 <= 256) ? s1[i] : -INFINITY; }
            }
#pragma unroll
            for (int i = 0; i < 16; ++i) mx = fmaxf(mx, fmaxf(s0[i], s1[i]));
            mx = fmaxf(mx, __shfl_xor(mx, 32));
            if (__any(mx > m_run + 8.f)) {
                const float m_new = mx > m_run + 8.f ? mx : m_run, alpha = __builtin_amdgcn_exp2f(m_run - m_new);
                m_run = m_new; lsum *= alpha;
#pragma unroll
                for (int db = 0; db < 4; ++db)
#pragma unroll
                    for (int i = 0; i < 16; ++i) o[db][i] *= alpha;
            }
#pragma unroll
            for (int i = 0; i < 16; ++i) { s0[i] = __builtin_amdgcn_exp2f(s0[i] - m_run); s1[i] = __builtin_amdgcn_exp2f(s1[i] - m_run); lsum += s0[i] + s1[i]; }
            bf16x8 pf[2][2];
#pragma unroll
            for (int s2 = 0; s2 < 2; ++s2) {
                u32x4 p0, p1;
#pragma unroll
                for (int w = 0; w < 4; ++w) { p0[w] = pk2(s0[8 * s2 + 2 * w], s0[8 * s2 + 2 * w + 1]); p1[w] = pk2(s1[8 * s2 + 2 * w], s1[8 * s2 + 2 * w + 1]); }
                pf[0][s2] = __builtin_bit_cast(bf16x8, p0); pf[1][s2] = __builtin_bit_cast(bf16x8, p1);
            }
            const LAS unsigned char* vb = F.lds + 2 * KS_BYTES + buf * VS_BYTES + (4 * h + tq4) * VP + 32 * blk + 8 * tp;
#pragma unroll
            for (int db = 0; db < 4; ++db)
#pragma unroll
                for (int kb2 = 0; kb2 < 2; ++kb2)
#pragma unroll
                    for (int s2 = 0; s2 < 2; ++s2) {
                        const int off = (32 * kb2 + 16 * s2) * VP + db * 64;
                        const s16x4 lo = __builtin_amdgcn_ds_read_tr16_b64_v4i16((LAS s16x4*)(vb + off));
                        const s16x4 hi = __builtin_amdgcn_ds_read_tr16_b64_v4i16((LAS s16x4*)(vb + off + 8 * VP));
                        const bf16x8 av = __builtin_shufflevector(lo, hi, 0, 1, 2, 3, 4, 5, 6, 7);
                        o[db] = MFMA32(av, pf[kb2][s2], o[db]);
                    }
        }
        if (more) attn_store_tile(F, R, tin, buf ^ 1);
        __syncthreads();
    }
    const float lt = lsum + __shfl_xor(lsum, 32);
    const float inv = 1.f / lt;
    float ss = 0.f;
#pragma unroll
    for (int db = 0; db < 4; ++db)
#pragma unroll
        for (int i = 0; i < 16; ++i) { o[db][i] *= inv; ss += o[db][i] * o[db][i]; }
    ss += __shfl_xor(ss, 32);
    const float rn = 1.f / sqrtf(ss * (1.f / 128.f) + LN_EPS);
    bf16_t* op = F.MIX() + (size_t)tq * D + head * 128 + 4 * h;
    const float* gp = F.g_attn() + layer * 1024 + head * 128 + 4 * h;
#pragma unroll
    for (int db = 0; db < 4; ++db)
#pragma unroll
        for (int g4 = 0; g4 < 4; ++g4) {
            const f32x4 gv = *(const f32x4*)(gp + 32 * db + 8 * g4);
            u32x2 w; w.x = pk2(o[db][4 * g4] * rn * gv.x, o[db][4 * g4 + 1] * rn * gv.y); w.y = pk2(o[db][4 * g4 + 2] * rn * gv.z, o[db][4 * g4 + 3] * rn * gv.w);
            *(u32x2*)(op + 32 * db + 8 * g4) = w;
        }
}

__device__ __forceinline__ void unpack8(const u32x4 v, float (&f)[8]) {
#pragma unroll
    for (int w = 0; w < 4; ++w) { f[2 * w] = bf_lo(v[w]); f[2 * w + 1] = bf_hi(v[w]); }
}
__device__ __forceinline__ void conv_row(Frame& F, int layer, int t) {
    bool first, last;
    if (t < TL) { const int pos = t & (SEQ - 1); first = pos == 0; last = pos == SEQ - 1; } else { const int pc = (t - TL) & (CTXL - 1); first = pc == 0; last = pc == CTXL - 1; }
    const bf16_t* p = F.PROJ() + (size_t)t * INC;
    const float* cw = F.conv_w() + (size_t)layer * 3 * 1024;
#pragma unroll
    for (int jc = 0; jc < 2; ++jc) {
        const int c = 8 * F.lane + 512 * jc;
        float gb[8], a[8], bq[8], um[8], ut[8], up[8];
        unpack8(*(const u32x4*)(p + c), gb);
        unpack8(*(const u32x4*)(p + OFF_C + c), a); unpack8(*(const u32x4*)(p + OFF_X + c), bq);
#pragma unroll
        for (int e = 0; e < 8; ++e) ut[e] = a[e] * bq[e];
        if (!first) { unpack8(*(const u32x4*)(p - INC + OFF_C + c), a); unpack8(*(const u32x4*)(p - INC + OFF_X + c), bq);
#pragma unroll
            for (int e = 0; e < 8; ++e) um[e] = a[e] * bq[e]; }
        else {
#pragma unroll
            for (int e = 0; e < 8; ++e) um[e] = 0.f; }
        if (!last) { unpack8(*(const u32x4*)(p + INC + OFF_C + c), a); unpack8(*(const u32x4*)(p + INC + OFF_X + c), bq);
#pragma unroll
            for (int e = 0; e < 8; ++e) up[e] = a[e] * bq[e]; }
        else {
#pragma unroll
            for (int e = 0; e < 8; ++e) up[e] = 0.f; }
        float y[8], ss = 0.f;
#pragma unroll
        for (int e = 0; e < 8; ++e) { y[e] = gb[e] * (cw[c + e] * um[e] + cw[1024 + c + e] * ut[e] + cw[2048 + c + e] * up[e]); ss += y[e] * y[e]; }
        ss += __shfl_xor(ss, 1); ss += __shfl_xor(ss, 2); ss += __shfl_xor(ss, 4); ss += __shfl_xor(ss, 8);
        const float rn = 1.f / sqrtf(ss * (1.f / 128.f) + LN_EPS);
        const float* gc = F.g_conv() + layer * 1024 + c;
        u32x4 w;
#pragma unroll
        for (int q = 0; q < 4; ++q) w[q] = pk2(y[2 * q] * rn * gc[2 * q], y[2 * q + 1] * rn * gc[2 * q + 1]);
        *(u32x4*)(F.MIX() + (size_t)t * D + 1024 + c) = w;
    }
}

__device__ __forceinline__ void ln_phase(Frame& F, int layer, int rows) {
    const int lane = F.lane;
    u32x4 w[4], wn[4];
    int t = F.gw;
    if (t < rows) {
#pragma unroll
        for (int j = 0; j < 4; ++j) w[j] = *(const u32x4*)(F.X() + (size_t)t * D + 8 * lane + 512 * j);
    }
    const float* g1 = F.ln1_g() + layer * D; const float* b1 = F.ln1_b() + layer * D;
    while (t < rows) {
        const int tn = t + F.NGW;
        if (tn < rows) {
#pragma unroll
            for (int j = 0; j < 4; ++j) wn[j] = *(const u32x4*)(F.X() + (size_t)tn * D + 8 * lane + 512 * j);
        }
        float v[32]; float s = 0.f;
#pragma unroll
        for (int j = 0; j < 4; ++j)
#pragma unroll
            for (int q = 0; q < 4; ++q) { v[8 * j + 2 * q] = bf_lo(w[j][q]); v[8 * j + 2 * q + 1] = bf_hi(w[j][q]); s += v[8 * j + 2 * q] + v[8 * j + 2 * q + 1]; }
        const float mean = wave_sum(s) * (1.f / D);
        float s2 = 0.f;
#pragma unroll
        for (int i = 0; i < 32; ++i) { v[i] -= mean; s2 += v[i] * v[i]; }
        const float rstd = 1.f / sqrtf(wave_sum(s2) * (1.f / D) + LN_EPS);
        float s3 = 0.f;
#pragma unroll
        for (int j = 0; j < 4; ++j) { const int c = 8 * lane + 512 * j; u32x4 o;
#pragma unroll
            for (int q = 0; q < 2; ++q) { const f32x4 gg = *(const f32x4*)(g1 + c + 4 * q), bb = *(const f32x4*)(b1 + c + 4 * q);
#pragma unroll
                for (int e = 0; e < 4; ++e) { const float y = v[8 * j + 4 * q + e] * rstd * gg[e] + bb[e]; v[8 * j + 4 * q + e] = y; s3 += y; }
                o[2 * q] = pk2(v[8 * j + 4 * q], v[8 * j + 4 * q + 1]); o[2 * q + 1] = pk2(v[8 * j + 4 * q + 2], v[8 * j + 4 * q + 3]); }
            *(u32x4*)(F.X() + (size_t)t * D + c) = o; }
        const float mean2 = wave_sum(s3) * (1.f / D);
        float s4 = 0.f;
#pragma unroll
        for (int i = 0; i < 32; ++i) { v[i] -= mean2; s4 += v[i] * v[i]; }
        const float rstd2 = 1.f / sqrtf(wave_sum(s4) * (1.f / D) + LN_EPS);
        const float* mp = F.MODS() + ((size_t)layer * 3 + modrow(t)) * 12288;
#pragma unroll
        for (int j = 0; j < 4; ++j) { const int c = 8 * lane + 512 * j; u32x4 o;
#pragma unroll
            for (int q = 0; q < 2; ++q) { const f32x4 sh = *(const f32x4*)(mp + 3 * D + c + 4 * q), sc = *(const f32x4*)(mp + 4 * D + c + 4 * q);
                const float y0 = v[8 * j + 4 * q] * rstd2 * (1.f + sc[0]) + sh[0], y1 = v[8 * j + 4 * q + 1] * rstd2 * (1.f + sc[1]) + sh[1];
                const float y2 = v[8 * j + 4 * q + 2] * rstd2 * (1.f + sc[2]) + sh[2], y3 = v[8 * j + 4 * q + 3] * rstd2 * (1.f + sc[3]) + sh[3];
                o[2 * q] = pk2(y0, y1); o[2 * q + 1] = pk2(y2, y3); }
            *(u32x4*)(F.H() + (size_t)t * D + c) = o; }
#pragma unroll
        for (int j = 0; j < 4; ++j) w[j] = wn[j];
        t = tn;
    }
}

__device__ __forceinline__ unsigned ordkey(float f) { const unsigned u = __float_as_uint(f); return u ^ ((u >> 31) ? 0xFFFFFFFFu : 0x80000000u); }
__device__ __forceinline__ float gelu_erf(float a) { return 0.5f * a * (1.f + erff(a * 0.70710678118654752f)); }

__device__ __forceinline__ float unordkey(unsigned k) { return __uint_as_float(k ^ ((k >> 31) ? 0x80000000u : 0xFFFFFFFFu)); }
__device__ __forceinline__ float gelu_as(float v) {
    const float av = fabsf(v), t = __builtin_amdgcn_rcpf(av * 0.2316418882f + 1.0f);
    float q = t * 0.5307027145f + (-0.7265760135f); q = q * t + 0.7107068705f; q = q * t + (-0.142248368f); q = q * t + 0.127414796f; q = q * t;
    const float e = __builtin_amdgcn_exp2f((v * v) * (-0.72134752044f));
    const float m = v * (q * e);
    return v < 0.f ? m : v - m;
}

template <class O> struct QuadNet {
    typedef typename O::V V; typedef typename O::B B;
    template <bool ASC> static __device__ __forceinline__ void ce_reg(V& a, V& b) { const V lo = O::vmin(a, b), hi = O::vmax(a, b); a = ASC ? lo : hi; b = ASC ? hi : lo; }
    template <bool ASC> static __device__ __forceinline__ void ce_l1(V& x, B low1) { const V p = O::x1(x); const V mn = O::vmin(p, x), mx = O::vmax(p, x); x = ASC ? O::vsel(low1, mn, mx) : O::vsel(low1, mx, mn); }
    template <bool ASC> static __device__ __forceinline__ void ce_l2(V& x, B low2) { const V p = O::x2(x); const V mn = O::vmin(p, x), mx = O::vmax(p, x); x = ASC ? O::vsel(low2, mn, mx) : O::vsel(low2, mx, mn); }
    template <int NR> static __device__ __forceinline__ void sort_blocks(V (&R)[NR], B low1, B low2, B eq12) {
#pragma unroll
        for (int r = 0; r < NR; ++r) { const V p = O::x1(R[r]); const V mn = O::vmin(p, R[r]), mx = O::vmax(p, R[r]); R[r] = O::vsel(eq12, mn, mx); }
#pragma unroll
        for (int r = 0; r < NR; ++r) { if ((r & 1) == 0) ce_l2<true>(R[r], low2); else ce_l2<false>(R[r], low2); }
#pragma unroll
        for (int r = 0; r < NR; ++r) { if ((r & 1) == 0) ce_l1<true>(R[r], low1); else ce_l1<false>(R[r], low1); }
#pragma unroll
        for (int r = 0; r < NR; r += 2) { if ((r & 2) == 0) ce_reg<true>(R[r], R[r + 1]); else ce_reg<false>(R[r], R[r + 1]); }
#pragma unroll
        for (int r = 0; r < NR; ++r) { if ((r & 2) == 0) ce_l2<true>(R[r], low2); else ce_l2<false>(R[r], low2); }
#pragma unroll
        for (int r = 0; r < NR; ++r) { if ((r & 2) == 0) ce_l1<true>(R[r], low1); else ce_l1<false>(R[r], low1); }
#pragma unroll
        for (int r = 0; r < NR; ++r) { if ((r & 2) == 0) { if ((r & 4) == 0) ce_reg<true>(R[r], R[r + 2]); else ce_reg<false>(R[r], R[r + 2]); } }
#pragma unroll
        for (int r = 0; r < NR; r += 2) { if ((r & 4) == 0) ce_reg<true>(R[r], R[r + 1]); else ce_reg<false>(R[r], R[r + 1]); }
#pragma unroll
        for (int r = 0; r < NR; ++r) { if ((r & 4) == 0) ce_l2<true>(R[r], low2); else ce_l2<false>(R[r], low2); }
#pragma unroll
        for (int r = 0; r < NR; ++r) { if ((r & 4) == 0) ce_l1<true>(R[r], low1); else ce_l1<false>(R[r], low1); }
    }
    template <int NR> static __device__ __forceinline__ void halve_merge(const V (&R)[NR], V (&Q)[NR / 2], B low1, B low2) {
#pragma unroll
        for (int m = 0; m < NR / 8; ++m)
#pragma unroll
            for (int i = 0; i < 4; ++i) Q[4 * m + i] = O::vmax(R[8 * m + i], R[8 * m + 4 + i]);
#pragma unroll
        for (int r = 0; r < NR / 2; ++r) { if ((r & 2) == 0) { if ((r & 4) == 0) ce_reg<false>(Q[r], Q[r + 2]); else ce_reg<true>(Q[r], Q[r + 2]); } }
#pragma unroll
        for (int r = 0; r < NR / 2; r += 2) { if ((r & 4) == 0) ce_reg<false>(Q[r], Q[r + 1]); else ce_reg<true>(Q[r], Q[r + 1]); }
#pragma unroll
        for (int r = 0; r < NR / 2; ++r) { if ((r & 4) == 0) ce_l2<false>(Q[r], low2); else ce_l2<true>(Q[r], low2); }
#pragma unroll
        for (int r = 0; r < NR / 2; ++r) { if ((r & 4) == 0) ce_l1<false>(Q[r], low1); else ce_l1<true>(Q[r], low1); }
    }
    static __device__ __forceinline__ void top16_of_128(V (&R)[32], V (&T)[4], B low1, B low2, B eq12) {
        sort_blocks<32>(R, low1, low2, eq12);
        V A[16]; halve_merge<32>(R, A, low1, low2);
        V Bq[8]; halve_merge<16>(A, Bq, low1, low2);
        halve_merge<8>(Bq, T, low1, low2);
    }
    static __device__ __forceinline__ void top16_of_64(V (&R)[16], V (&T)[4], B low1, B low2, B eq12) {
        sort_blocks<16>(R, low1, low2, eq12);
        V A[8]; halve_merge<16>(R, A, low1, low2);
        halve_merge<8>(A, T, low1, low2);
    }
};

struct DevOps {
    typedef unsigned V; typedef bool B;
    static __device__ __forceinline__ V vmin(V a, V b) { return a < b ? a : b; }
    static __device__ __forceinline__ V vmax(V a, V b) { return a > b ? a : b; }
    static __device__ __forceinline__ V vsel(B m, V a, V b) { return m ? a : b; }
    static __device__ __forceinline__ V x1(V a) { return (V)dpp_i<DPP_XOR1>((int)a); }
    static __device__ __forceinline__ V x2(V a) { return (V)dpp_i<DPP_XOR2>((int)a); }
};
__device__ __forceinline__ void stair_ab(int c, int& a, int& b) {
    if (c < 16) { a = 0; b = c; } else if (c < 24) { a = 1; b = c - 16; } else if (c < 28) { a = 2; b = c - 24; } else if (c < 32) { a = 3; b = c - 28; }
    else if (c < 36) { a = 4; b = c - 32; } else if (c < 40) { a = 5 + ((c - 36) >> 1); b = (c - 36) & 1; } else if (c < 44) { a = 7 + ((c - 40) >> 1); b = (c - 40) & 1; }
    else if (c < 48) { a = 9 + (c - 44); b = 0; } else if (c < 51) { a = 13 + (c - 48); b = 0; } else { a = 2; b = 4; }
}
constexpr int PE_WS = 5120, PE_TAB = 8 * PE_WS;
__device__ __forceinline__ void peer_topk(Frame& F, LAS unsigned char* ws, int t) {
    const int lane = F.lane, sub = lane & 3;
    const bool low1 = (sub & 1) == 0, low2 = (sub & 2) == 0, eq12 = low1 == low2;
    LAS unsigned* S1K = (LAS unsigned*)ws; LAS int* EL = (LAS int*)(ws + 3328); LAS float* GL = (LAS float*)(ws + 3840);
    const LAS unsigned short* TAB = (const LAS unsigned short*)(F.lds + PE_TAB);
    {
        const int L = lane >> 2;
        const float* sp = F.SC() + (size_t)t * D + L * 128 + sub * 4;
        unsigned R[32];
#pragma unroll
        for (int q = 0; q < 8; ++q) { const f32x4 v = *(const f32x4*)(sp + 16 * q);
#pragma unroll
            for (int e = 0; e < 4; ++e) R[4 * q + e] = (ordkey(v[e]) & ~127u) | (unsigned)(127 - (4 * sub + 16 * q + e)); }
        unsigned T[4];
        QuadNet<DevOps>::top16_of_128(R, T, low1, low2, eq12);
#pragma unroll
        for (int r = 0; r < 4; ++r) S1K[L * 16 + 4 * r + sub] = T[r];
    }
    LDS_WAIT(); __builtin_amdgcn_wave_barrier();
    {
        const int hd = (lane >> 2) & 7;
        const LAS unsigned char* la = (const LAS unsigned char*)(S1K + (2 * hd) * 16); const LAS unsigned char* lb = (const LAS unsigned char*)(S1K + (2 * hd + 1) * 16);
        unsigned C[16];
#pragma unroll
        for (int r = 0; r < 13; ++r) { const unsigned ab = TAB[4 * r + sub];
            const unsigned ka = *(const LAS unsigned*)(la + (ab & 255u)), kb = *(const LAS unsigned*)(lb + (ab >> 8));
            const float sum = unordkey(ka & ~127u) + unordkey(kb & ~127u);
            C[r] = (ordkey(sum) & ~63u) | (unsigned)(63 - (4 * r + sub)); }
        C[13] = 0u; C[14] = 0u; C[15] = 0u;
        unsigned W[4];
        QuadNet<DevOps>::top16_of_64(C, W, low1, low2, eq12);
        float sv[4]; int ex[4];
#pragma unroll
        for (int r = 0; r < 4; ++r) { const unsigned ab = TAB[63 - (W[r] & 63u)];
            const unsigned ka = *(const LAS unsigned*)(la + (ab & 255u)), kb = *(const LAS unsigned*)(lb + (ab >> 8));
            ex[r] = (int)(127u - (ka & 127u)) * 128 + (int)(127u - (kb & 127u)); sv[r] = unordkey(W[r] & ~63u); }
        const float mx = dpp_f<0x00>(sv[0]);
        float e4[4], es = 0.f;
#pragma unroll
        for (int r = 0; r < 4; ++r) { e4[r] = __expf(sv[r] - mx); es += e4[r]; }
        es += dpp_f<DPP_XOR1>(es); es += dpp_f<DPP_XOR2>(es);
        const float rd = 1.f / es;
#pragma unroll
        for (int r = 0; r < 4; ++r) { GL[hd * 16 + 4 * r + sub] = e4[r] * rd; EL[hd * 16 + 4 * r + sub] = ex[r]; }
    }
    LDS_WAIT(); __builtin_amdgcn_wave_barrier();
}

#ifndef PROBE_PHASE
#define PROBE_PHASE -1
#endif
#ifndef PROBE_MULT
#define PROBE_MULT 1
#endif
constexpr int EB = 4;
constexpr int CW_TICKET = 20480;

struct GBuf { LpRow<U_FMT> u[EB]; LpRow<V_FMT> v[EB]; float su[EB], sv[EB], g[EB]; };
__device__ __forceinline__ void gather_issue(GBuf& B, const LAS int* EL, const LAS float* GL, int i0, const unsigned char* UTl, const unsigned char* VTl, const float* USl, const float* VSl, int lane) {
#pragma unroll
    for (int q = 0; q < EB; ++q) {
        const int ex = __builtin_amdgcn_readfirstlane(EL[i0 + q]);
        B.g[q] = __uint_as_float(__builtin_amdgcn_readfirstlane(__float_as_uint(GL[i0 + q])));
        B.u[q].load(UTl + (size_t)ex * UROW, lane); B.v[q].load(VTl + (size_t)ex * VROW, lane); B.su[q] = USl[ex]; B.sv[q] = VSl[ex];
    }
}
__device__ __forceinline__ void gather_compute(const GBuf& B, const f32x2 (&hv)[16], f32x2 (&acc)[16]) {
    float dot[EB];
#pragma unroll
    for (int q = 0; q < EB; ++q) { f32x2 s = {0.f, 0.f};
        B.u[q].each([&](int i, float x0, float x1) { const f32x2 x = {x0, x1}; s = __builtin_elementwise_fma(x, hv[i >> 1], s); });
        dot[q] = s.x + s.y; }
#pragma unroll
    for (int q = 0; q < EB; ++q) dot[q] = wave_sum_u(dot[q]);
#pragma unroll
    for (int q = 0; q < EB; ++q) { const float cf = B.g[q] * gelu_as(dot[q] * B.su[q]) * B.sv[q]; const f32x2 c2 = {cf, cf};
        B.v[q].each([&](int i, float x0, float x1) { const f32x2 x = {x0, x1}; acc[i >> 1] = __builtin_elementwise_fma(x, c2, acc[i >> 1]); }); }
}

__device__ __forceinline__ void peer_phase(Frame& F, int layer, int rows, unsigned* ctl, unsigned long long& pr_acc) {
    unsigned long long pt0 = 0ull;
#define SUB_BEGIN(ty) do { if (PROBE_PHASE == (ty)) pt0 = __builtin_amdgcn_s_memrealtime(); } while (0)
#define SUB_END(ty) do { if (PROBE_PHASE == (ty)) pr_acc += __builtin_amdgcn_s_memrealtime() - pt0; } while (0)
    if (F.tid < 64) { int a = 0, b = 0; stair_ab(F.tid < 52 ? F.tid : 0, a, b); *(LAS unsigned short*)(F.lds + PE_TAB + 2 * F.tid) = (unsigned short)((4 * a) | ((4 * b) << 8)); }
    __syncthreads();
    LAS unsigned char* ws = F.lds + F.wave * PE_WS;
    LAS int* EL = (LAS int*)(ws + 3328); LAS float* GL = (LAS float*)(ws + 3840);
    const int lane = F.lane;
    const unsigned char* UTl = F.UT() + (size_t)layer * NEXP * UROW;
    const unsigned char* VTl = F.VT() + (size_t)layer * NEXP * VROW;
    const float* USl = F.US() + (size_t)layer * NEXP; const float* VSl = F.VS() + (size_t)layer * NEXP;
    unsigned* ticket = ctl + CW_TICKET + 64 * layer;
    unsigned tk = 0u;
    if (lane == 0) tk = __hip_atomic_fetch_add(ticket, 1u, __ATOMIC_RELAXED, __HIP_MEMORY_SCOPE_AGENT);
    int t = (int)__builtin_amdgcn_readfirstlane(tk);
    while (t < rows) {
        unsigned tkn = 0u;
        if (lane == 0) tkn = __hip_atomic_fetch_add(ticket, 1u, __ATOMIC_RELAXED, __HIP_MEMORY_SCOPE_AGENT);
        SUB_BEGIN(8); peer_topk(F, ws, t); SUB_END(8);
        SUB_BEGIN(9);
        f32x2 hv[16], acc[16];
#pragma unroll
        for (int q = 0; q < 4; ++q) { const u32x4 w = *(const u32x4*)(F.H() + (size_t)t * D + 32 * lane + 8 * q);
#pragma unroll
            for (int e = 0; e < 4; ++e) { hv[4 * q + e] = (f32x2){bf_lo(w[e]), bf_hi(w[e])}; acc[4 * q + e] = (f32x2){0.f, 0.f}; } }
        {
            GBuf A, B;
            gather_issue(A, EL, GL, 0, UTl, VTl, USl, VSl, lane);
            for (int i0 = 0; i0 < 128; i0 += 2 * EB) {
                gather_issue(B, EL, GL, i0 + EB, UTl, VTl, USl, VSl, lane);
                gather_compute(A, hv, acc);
                if (i0 + 2 * EB < 128) gather_issue(A, EL, GL, i0 + 2 * EB, UTl, VTl, USl, VSl, lane);
                gather_compute(B, hv, acc);
            }
        }
        SUB_END(9); SUB_BEGIN(10);
        const int mr = modrow(t);
        const float* mp = F.MODS() + ((size_t)layer * 3 + mr) * 12288;
        bf16_t* xr = F.X() + (size_t)t * D;
        float rr[32]; float s = 0.f;
#pragma unroll
        for (int q2 = 0; q2 < 4; ++q2) { const u32x4 xw = *(const u32x4*)(xr + 32 * lane + 8 * q2);
#pragma unroll
            for (int h2 = 0; h2 < 2; ++h2) { const int q = 2 * q2 + h2; const int c = 32 * lane + 4 * q; const f32x4 gv = *(const f32x4*)(mp + 5 * D + c);
                const f32x4 xv = {bf_lo(xw[2 * h2]), bf_hi(xw[2 * h2]), bf_lo(xw[2 * h2 + 1]), bf_hi(xw[2 * h2 + 1])};
                const f32x4 av = {acc[2 * q].x, acc[2 * q].y, acc[2 * q + 1].x, acc[2 * q + 1].y};
#pragma unroll
                for (int e = 0; e < 4; ++e) { const float v = DN_ALPHA * xv[e] + gv[e] * av[e]; rr[4 * q + e] = v; s += v; } } }
        const float mean = wave_sum_u(s) * (1.f / D);
        float s2 = 0.f;
#pragma unroll
        for (int i = 0; i < 32; ++i) { rr[i] -= mean; s2 += rr[i] * rr[i]; }
        const float rstd = 1.f / sqrtf(wave_sum_u(s2) * (1.f / D) + LN_EPS);
        const float* g2 = F.ln2_g() + layer * D; const float* b2 = F.ln2_b() + layer * D;
        float s3 = 0.f;
#pragma unroll
        for (int q = 0; q < 8; ++q) { const int c = 32 * lane + 4 * q; const f32x4 gg = *(const f32x4*)(g2 + c), bb = *(const f32x4*)(b2 + c);
            f32x4 xo;
#pragma unroll
            for (int e = 0; e < 4; ++e) { xo[e] = rr[4 * q + e] * rstd * gg[e] + bb[e]; rr[4 * q + e] = xo[e]; s3 += xo[e]; }
            if (layer < NLAYER - 1) { u32x2 o2; o2.x = pk2(xo[0], xo[1]); o2.y = pk2(xo[2], xo[3]); *(u32x2*)(xr + c) = o2; } else if (t < TL) *(f32x4*)(F.out() + (size_t)t * D + c) = xo; }
        if (layer < NLAYER - 1) {
            const float mean2 = wave_sum_u(s3) * (1.f / D);
            float s4 = 0.f;
#pragma unroll
            for (int i = 0; i < 32; ++i) { rr[i] -= mean2; s4 += rr[i] * rr[i]; }
            const float rstd2 = 1.f / sqrtf(wave_sum_u(s4) * (1.f / D) + LN_EPS);
            const float* np = F.MODS() + ((size_t)(layer + 1) * 3 + mr) * 12288;
#pragma unroll
            for (int q2 = 0; q2 < 4; ++q2) { const int c = 32 * lane + 8 * q2; u32x4 w;
#pragma unroll
                for (int q = 0; q < 2; ++q) { const f32x4 sh = *(const f32x4*)(np + c + 4 * q), sc = *(const f32x4*)(np + D + c + 4 * q); const int ri = 8 * q2 + 4 * q;
                    const float y0 = rr[ri] * rstd2 * (1.f + sc[0]) + sh[0], y1 = rr[ri + 1] * rstd2 * (1.f + sc[1]) + sh[1];
                    const float y2 = rr[ri + 2] * rstd2 * (1.f + sc[2]) + sh[2], y3 = rr[ri + 3] * rstd2 * (1.f + sc[3]) + sh[3];
                    w[2 * q] = pk2(y0, y1); w[2 * q + 1] = pk2(y2, y3); }
                *(u32x4*)(F.H() + (size_t)t * D + c) = w; }
        }
        SUB_END(10);
        t = (int)__builtin_amdgcn_readfirstlane(tkn);
    }
#undef SUB_BEGIN
#undef SUB_END
}

__global__ void __launch_bounds__(NWAVES * 64, 2) skel_fwd(Args args) {
    extern __shared__ __attribute__((aligned(16))) unsigned char lds[];
    Frame F;
    F.lds = (LAS unsigned char*)lds;
    F.tid = threadIdx.x; F.lane = F.tid & 63; F.wave = __builtin_amdgcn_readfirstlane(F.tid >> 6);
    F.G = gridDim.x; F.gw = blockIdx.x * NWAVES + F.wave; F.NGW = F.G * NWAVES;
    unsigned char* ws = args.ws;
    F.ka = (const CAS unsigned char*)__builtin_amdgcn_kernarg_segment_ptr();
    for (int u = F.tid; u < (LDS_BYTES - LDSCTL_OFF) / 4; u += NWAVES * 64) ((LAS unsigned*)(F.lds + LDSCTL_OFF))[u] = 0u;
    __syncthreads();
    unsigned* ctl = (unsigned*)(ws + WS_CTL);
    const int lo = args.ph_lo, hi = args.ph_hi;
    XcdBarrier bar; bar.bar = ctl + CW_BAR + args.li * XCD_BAR_WORDS; bar.x = 0; bar.st = nullptr;
    if (hi - lo > 1) bar = xcd_barrier_post(ctl + CW_BAR + args.li * XCD_BAR_WORDS, (volatile LAS unsigned*)(F.lds + MISC_OFF) + 8);
#define IN(k) (lo <= (k) && (k) < hi)
    unsigned long long pr_acc = 0ull, pr_t0 = 0ull;
#define PR_BEGIN(ty) do { if (PROBE_PHASE == (ty)) pr_t0 = __builtin_amdgcn_s_memrealtime(); } while (0)
#define PR_END(ty) do { if (PROBE_PHASE == (ty)) pr_acc += __builtin_amdgcn_s_memrealtime() - pr_t0; } while (0)
#define BOTH(k) (IN(k) && IN((k) + 1))
#define SEAM(k) do { if (BOTH(k)) xcd_barrier(bar); } while (0)

    if (IN(0)) { PR_BEGIN(0); frame_ids(F); p0a_prologue(F); SEAM(0); PR_END(0); }
    if (IN(1)) {
        PR_BEGIN(1); frame_ids(F);
        { pg8::Gemm g{F.KBD(), F.WQR(), 32 * 256, 2048, 256}; pg8::BatchOrder S{F.G, (int)blockIdx.x}; pg8::EpiBf16 E{F.WEFFT(), D};
          pg8::gemm_phase<pg8::EpiBf16, pg8::BatchOrder, false, true>(F.lds, g, S, E); }
        p0b_mod0(F);
        SEAM(1); PR_END(1);
    }
    for (int layer = 0; layer < NLAYER; ++layer) {
        const int pb = 2 + 6 * layer;
        const bool lastl = layer == NLAYER - 1;
        const int rows = lastl ? TL : TT;
        if (IN(pb + 0)) {
            PR_BEGIN(2); frame_ids(F);
            pg8::Gemm g{F.H(), F.WINT() + (size_t)layer * INC * D, TT, INC, D}; pg8::StaticOrder S; S.init(TT, INC, F.G, (int)blockIdx.x);
            pg8::EpiBf16 E{F.PROJ(), INC};
            pg8::gemm_phase<pg8::EpiBf16, pg8::StaticOrder, true, true>(F.lds, g, S, E);
            SEAM(pb + 0); PR_END(2);
        }
        if (IN(pb + 1)) {
            PR_BEGIN(3); frame_ids(F);
            const int nunits = lastl ? 512 : 528;
            { unsigned long long q0 = 0; if (PROBE_PHASE == 11) q0 = __builtin_amdgcn_s_memrealtime();
            for (int u = blockIdx.x; u < nunits; u += F.G) attn_unit(F, layer, u);
            if (PROBE_PHASE == 11) pr_acc += __builtin_amdgcn_s_memrealtime() - q0; if (PROBE_PHASE == 12) q0 = __builtin_amdgcn_s_memrealtime();
            {
              const int nx = nunits - 2 * F.G; const bool uneven = nx > 0 && nx < F.G;
              const int c0 = uneven ? (int)blockIdx.x - nx : (int)blockIdx.x, nb = uneven ? F.G - nx : F.G;
              if (c0 >= 0) for (int t = c0 * NWAVES + F.wave; t < rows; t += nb * NWAVES) conv_row(F, layer, t); }
            if (PROBE_PHASE == 12) pr_acc += __builtin_amdgcn_s_memrealtime() - q0; }
            SEAM(pb + 1); PR_END(3);
        }
        if (IN(pb + 2)) {
            PR_BEGIN(4); frame_ids(F);
            pg8::Gemm g{F.MIX(), F.WOUTT() + (size_t)layer * D * D, rows, D, D}; pg8::StaticOrder S; S.init(rows, D, F.G, (int)blockIdx.x);
            pg8::EpiResid E{layer == 0 ? F.x() : nullptr, layer == 0 ? F.ctx() : nullptr, F.X(), F.MODS() + (size_t)layer * 3 * 12288 + 2 * D};
            pg8::gemm_phase<pg8::EpiResid, pg8::StaticOrder, true, true>(F.lds, g, S, E);
            frame_ids(F); convert_in_tail(F, layer, (rows / 256) * (D / 256), 0);
            SEAM(pb + 2); PR_END(4);
        }
        if (IN(pb + 3)) { PR_BEGIN(5); frame_ids(F); ln_phase(F, layer, rows); SEAM(pb + 3); PR_END(5); }
        if (IN(pb + 4)) {
            PR_BEGIN(6); frame_ids(F);
            pg8::Gemm g{F.H(), F.WEFFT() + (size_t)layer * D * D, rows, D, D}; pg8::StaticOrder S; S.init(rows, D, F.G, (int)blockIdx.x);
            pg8::EpiF32 E{F.SC(), D};
            pg8::gemm_phase<pg8::EpiF32, pg8::StaticOrder, true, true>(F.lds, g, S, E);
            frame_ids(F); convert_in_tail(F, layer, (rows / 256) * (D / 256), 1);
            SEAM(pb + 4); PR_END(6);
        }
        if (IN(pb + 5)) { PR_BEGIN(7); frame_ids(F); peer_phase(F, layer, rows, ctl, pr_acc); SEAM(pb + 5); PR_END(7); }
    }
    if (PROBE_PHASE >= 0 && hi - lo > 1) xcd_barrier(bar);
    if (PROBE_PHASE >= 0 && blockIdx.x == 0 && threadIdx.x == 0) { const unsigned long long t1 = __builtin_amdgcn_s_memrealtime() + (unsigned long long)PROBE_MULT * pr_acc; while (__builtin_amdgcn_s_memrealtime() < t1) __builtin_amdgcn_s_sleep(8); }
#undef IN
#undef BOTH
#undef SEAM
}

extern "C" void kernel_launch(void* const* d_in, const int* in_sizes, int n_in, void* d_out, int out_size, void* d_ws, size_t ws_size, hipStream_t stream) {
    static int grid = 0;
    if (grid == 0) {
        if (n_in != 20 || in_sizes[0] != TL * D || out_size != TL * D || ws_size < WS_END) {
            fprintf(stderr, "kernel_launch: unexpected problem shape (n_in %d, in0 %d, out %d, ws %zu, need %zu)\n", n_in, n_in > 0 ? in_sizes[0] : -1, out_size, ws_size, (size_t)WS_END); grid = -1; return; }
        int dev = 0, cus = 0, per_cu = 0;
        if (hipGetDevice(&dev) != hipSuccess || hipDeviceGetAttribute(&cus, hipDeviceAttributeMultiprocessorCount, dev) != hipSuccess) { grid = -1; return; }
        if (hipFuncSetAttribute((const void*)skel_fwd, hipFuncAttributeMaxDynamicSharedMemorySize, LDS_BYTES) != hipSuccess) { fprintf(stderr, "kernel_launch: hipFuncSetAttribute failed\n"); grid = -1; return; }
        if (hipOccupancyMaxActiveBlocksPerMultiprocessor(&per_cu, (const void*)skel_fwd, NWAVES * 64, LDS_BYTES) != hipSuccess || per_cu < 1)
            fprintf(stderr, "kernel_launch: occupancy query reports %d workgroups per CU\n", per_cu);
        (void)hipGetLastError();
        grid = cus;
    }
    if (grid < 0) return;
    if (hipMemsetAsync((char*)d_ws + WS_CTL, 0, CTL_ZERO_BYTES, stream) != hipSuccess) return;
    Args a{};
    for (int i = 0; i < 20; ++i) a.in[i] = (const float*)d_in[i];
    a.out = (float*)d_out; a.ws = (unsigned char*)d_ws; a.pad = 0;
#if MK_N_LAUNCHES == 1
    a.ph_lo = 0; a.ph_hi = NPHASE; a.li = 0;
    hipLaunchKernelGGL(skel_fwd, dim3(grid), dim3(NWAVES * 64), LDS_BYTES, stream, a);
#else
    for (int ph = 0; ph < NPHASE; ++ph) { a.ph_lo = ph; a.ph_hi = ph + 1; a.li = 0;
        hipLaunchKernelGGL(skel_fwd, dim3(grid), dim3(NWAVES * 64), LDS_BYTES, stream, a); }
#endif
}
```

```cpp
#include <hip/hip_runtime.h>
#include <cstdio>
#include <cstdint>

#ifndef MK_N_LAUNCHES
#define MK_N_LAUNCHES 1
#endif

#define LAS __attribute__((address_space(3)))
typedef unsigned short bf16_t;
typedef short bf16x8 __attribute__((ext_vector_type(8)));
typedef short s16x4 __attribute__((ext_vector_type(4)));
typedef float f32x2 __attribute__((ext_vector_type(2)));
typedef float f32x4 __attribute__((ext_vector_type(4)));
typedef float f32x16 __attribute__((ext_vector_type(16)));
typedef unsigned u32x2 __attribute__((ext_vector_type(2)));
typedef unsigned u32x4 __attribute__((ext_vector_type(4)));
typedef __bf16 bf16x2_t __attribute__((ext_vector_type(2)));

constexpr int D = 2048, NB = 2, SEQ = 8192, CTXL = 256, NLAYER = 4;
constexpr int TL = NB * SEQ, TC = NB * CTXL, TT = TL + TC;
constexpr int INC = 4608, OFF_C = 1024, OFF_X = 2048, OFF_Q = 3072, OFF_K = 4096, OFF_V = 4352;
constexpr int NEXP = 16384;
#ifndef U_FMT
#define U_FMT 4
#endif
#ifndef V_FMT
#define V_FMT 4
#endif
constexpr int UROW = D * U_FMT / 8, VROW = D * V_FMT / 8;
constexpr float LN_EPS = 1e-6f;
constexpr float DN_ALPHA = 1.681792830507429f;
constexpr float QSCALE = 0.08838834764831845f * 1.4426950408889634f;
constexpr float LOG2E = 1.4426950408889634f;

constexpr size_t MiB = 1u << 20;
constexpr size_t WS_CTL = 0, CTL_ZERO_BYTES = 1 * MiB;
constexpr size_t WS_MODS = 1 * MiB;
constexpr size_t WS_ROPE = 2 * MiB;
constexpr size_t WS_KBD = 3 * MiB;
constexpr size_t WS_WQR = 8 * MiB;
constexpr size_t WS_WINT = 40 * MiB;
constexpr size_t WS_WOUTT = 112 * MiB;
constexpr size_t WS_WEFFT = 144 * MiB;
constexpr size_t WS_X = 176 * MiB;
constexpr size_t WS_H = 308 * MiB;
constexpr size_t WS_PROJ = 374 * MiB;
constexpr size_t WS_MIX = 523 * MiB;
constexpr size_t WS_SC = 589 * MiB;
constexpr size_t WS_UT = 721 * MiB;
constexpr size_t WS_VT = 849 * MiB;
constexpr size_t WS_US = 977 * MiB;
constexpr size_t WS_VS = 978 * MiB;
constexpr size_t WS_END = 979 * MiB;

constexpr int CW_BAR = 4096;

namespace pg8 {
constexpr int BM = 256, BK = 64, HALF = 128, HTB = HALF * BK * 2, STAGE_BYTES = 8 * HTB, NXCD = 8, WGM = 8;
__host__ __device__ __forceinline__ int lds_byte(int r, int c) { const int st = (r >> 4) * 2 + (c >> 5), rr = r & 15, cc = c & 31, ob = rr * 64 + cc * 2; return st * 1024 + (ob ^ (((ob >> 9) & 1) << 5)); }
__host__ __device__ __forceinline__ void stage_rc(int b, int& R, int& C) { const int st = b / 1024, sb = b % 1024, swz = sb ^ (((sb >> 9) & 1) << 5); R = (st >> 1) * 16 + swz / 64; C = (st & 1) * 32 + (swz % 64) / 2; }
__host__ __device__ __forceinline__ int perm32(int rho) { const int n = rho >> 4, i = rho & 15; return 8 * (i >> 2) + 4 * n + (i & 3); }

struct Unit { int pm, pn; };
struct Gemm { const bf16_t* A; const bf16_t* Bt; int M, N, K; };

struct StaticOrder {
    int nM, nN, nwg, G, c;
    __host__ __device__ void init(int M, int N, int G_, int c_) { nM = M / BM; nN = N / BM; nwg = nM * nN; G = G_; c = c_; }
    __host__ __device__ bool next(int i, Unit& u) const {
        const long L = (long)i * G + c; if (L >= nwg) return false;
        int wgid = (int)L; { const int q = nwg / NXCD, r = nwg % NXCD, xcd = wgid % NXCD, off = wgid / NXCD; wgid = (xcd < r ? xcd * (q + 1) : r * (q + 1) + (xcd - r) * q) + off; }
        const int nig = WGM * nN, gid = wgid / nig, fm = gid * WGM, gsz = (nM - fm) < WGM ? (nM - fm) : WGM;
        u.pm = fm + ((wgid % nig) % gsz); u.pn = (wgid % nig) / gsz; return true;
    }
    __device__ __forceinline__ int btile(const Unit& u) const { return u.pn; }
    __device__ __forceinline__ void a_ready(const Unit&) const {}
    __device__ __forceinline__ void done(const Unit&) const {}
};
struct BatchOrder {
    int G, c;
    __device__ bool next(int i, Unit& u) const { const int L = i * G + c; if (L >= 256) return false; u.pm = L >> 3; u.pn = L & 7; return true; }
    __device__ __forceinline__ int btile(const Unit& u) const { return u.pm * 8 + u.pn; }
    __device__ __forceinline__ void a_ready(const Unit&) const {}
    __device__ __forceinline__ void done(const Unit&) const {}
};

__device__ __forceinline__ unsigned cvt_pk_bf16(float lo, float hi) { f32x2 x = {lo, hi}; bf16x2_t y = __builtin_convertvector(x, bf16x2_t); return __builtin_bit_cast(unsigned, y); }

struct EpiBf16 {
    static constexpr bool PERM = true;
    bf16_t* O; int ldc;
    __device__ __forceinline__ void operator()(const f32x4 (&acc)[2][2][4][2], const Unit& u, int wr, int wc, int fr, int fq) const {
        const int row0 = u.pm * BM + wr * 64 + fr, col0 = u.pn * BM + wc * 32 + 8 * fq;
#pragma unroll
        for (int ai = 0; ai < 2; ++ai)
#pragma unroll
            for (int m = 0; m < 4; ++m) { bf16_t* rowp = O + (size_t)(row0 + ai * HALF + m * 16) * ldc + col0;
#pragma unroll
                for (int bj = 0; bj < 2; ++bj) { const f32x4 v0 = acc[ai][bj][m][0], v1 = acc[ai][bj][m][1];
                    u32x4 w; w.x = cvt_pk_bf16(v0[0], v0[1]); w.y = cvt_pk_bf16(v0[2], v0[3]); w.z = cvt_pk_bf16(v1[0], v1[1]); w.w = cvt_pk_bf16(v1[2], v1[3]);
                    *(u32x4*)(rowp + bj * HALF) = w; } }
    }
};
struct EpiF32 {
    static constexpr bool PERM = false;
    float* C; int ldc;
    __device__ __forceinline__ void operator()(const f32x4 (&acc)[2][2][4][2], const Unit& u, int wr, int wc, int fr, int fq) const {
        const int row0 = u.pm * BM + wr * 64 + fr, col0 = u.pn * BM + wc * 32 + 4 * fq;
#pragma unroll
        for (int ai = 0; ai < 2; ++ai)
#pragma unroll
            for (int m = 0; m < 4; ++m) { float* rowp = C + (size_t)(row0 + ai * HALF + m * 16) * ldc + col0;
#pragma unroll
                for (int bj = 0; bj < 2; ++bj)
#pragma unroll
                    for (int n = 0; n < 2; ++n) *(f32x4*)(rowp + bj * HALF + n * 16) = acc[ai][bj][m][n]; }
    }
};
struct EpiResid {
    static constexpr bool PERM = true;
    const float* x32_lat; const float* x32_ctx;
    bf16_t* X; const float* gate;
    __device__ __forceinline__ void operator()(const f32x4 (&acc)[2][2][4][2], const Unit& u, int wr, int wc, int fr, int fq) const {
        const int rt = u.pm * BM;
        const int mr = rt < TL ? rt / SEQ : 2;
        const int row0 = rt + wr * 64 + fr, col0 = u.pn * BM + wc * 32 + 8 * fq;
        f32x4 gv[2][2];
#pragma unroll
        for (int bj = 0; bj < 2; ++bj)
#pragma unroll
            for (int n = 0; n < 2; ++n) gv[bj][n] = *(const f32x4*)(gate + (size_t)mr * 12288 + col0 + bj * HALF + 4 * n);
#pragma unroll
        for (int ai = 0; ai < 2; ++ai)
#pragma unroll
            for (int m = 0; m < 4; ++m) { const int row = row0 + ai * HALF + m * 16;
#pragma unroll
                for (int bj = 0; bj < 2; ++bj) {
                    f32x4 x0, x1;
                    if (x32_lat) { const float* xp = (row < TL ? x32_lat + (size_t)row * D : x32_ctx + (size_t)(row - TL) * D) + col0 + bj * HALF; x0 = *(const f32x4*)xp; x1 = *(const f32x4*)(xp + 4); }
                    else { const u32x4 w = *(const u32x4*)(X + (size_t)row * D + col0 + bj * HALF);
                        x0 = (f32x4){__uint_as_float(w.x << 16), __uint_as_float(w.x & 0xffff0000u), __uint_as_float(w.y << 16), __uint_as_float(w.y & 0xffff0000u)};
                        x1 = (f32x4){__uint_as_float(w.z << 16), __uint_as_float(w.z & 0xffff0000u), __uint_as_float(w.w << 16), __uint_as_float(w.w & 0xffff0000u)}; }
                    const f32x4 r0 = x0 * DN_ALPHA + gv[bj][0] * acc[ai][bj][m][0], r1 = x1 * DN_ALPHA + gv[bj][1] * acc[ai][bj][m][1];
                    u32x4 o; o.x = cvt_pk_bf16(r0[0], r0[1]); o.y = cvt_pk_bf16(r0[2], r0[3]); o.z = cvt_pk_bf16(r1[0], r1[1]); o.w = cvt_pk_bf16(r1[2], r1[3]);
                    *(u32x4*)(X + (size_t)row * D + col0 + bj * HALF) = o; } }
    }
};

template <class Epi, class Sched, bool ALIGN_EPI = false, bool SP2 = false>
__device__ __forceinline__ void gemm_phase(LAS unsigned char* lds, const Gemm g, const Sched& S, const Epi& E) {
    int tid = threadIdx.x; asm volatile("" : "+v"(tid));
    const int wid = __builtin_amdgcn_readfirstlane(tid >> 6), lane = tid & 63, wr = wid >> 2, wc = wid & 3, fr = lane & 15, fq = lane >> 4;
    const int K = g.K, nt = K / BK;
    unsigned voffA[2], voffB[2];
#pragma unroll
    for (int i = 0; i < 2; ++i) { int R, C; stage_rc(tid * 16 + i * 8192, R, C); const int Rb = Epi::PERM ? ((R & ~31) + perm32(R & 31)) : R;
        voffA[i] = (unsigned)(R * K + C) * 2u; voffB[i] = (unsigned)(Rb * K + C) * 2u; }
    const size_t kstep = (size_t)(BK * 2);
    const size_t hstep = (size_t)HALF * K * 2;
    const size_t tstep = 2 * hstep;
    const unsigned ldsw = (unsigned)wid * 1024u;
    const int aoff = lds_byte(wr * 64 + fr, fq * 8), boff = lds_byte(wc * 32 + fr, fq * 8);
#define PG8_SA(b, h) (((b) * 2 + (h)) * HTB)
#define PG8_SB(b, h) ((4 + (b) * 2 + (h)) * HTB)
#define PG8_STAGE(bufoff, gbase, voff) do { _Pragma("unroll") for (int _i = 0; _i < 2; ++_i) \
        __builtin_amdgcn_global_load_lds((const unsigned*)((const char*)(gbase) + (voff)[_i]), (LAS unsigned*)(lds + (bufoff) + ldsw + _i * 8192), 16, 0, 0); } while (0)
#define PG8_LDA(dst, b, h) do { _Pragma("unroll") for (int m = 0; m < 4; ++m) _Pragma("unroll") for (int k = 0; k < 2; ++k) dst[m][k] = *(const LAS bf16x8*)(lds + PG8_SA(b, h) + aoff + m * 2048 + k * 1024); } while (0)
#define PG8_LDB(dst, b, h) do { _Pragma("unroll") for (int n = 0; n < 2; ++n) _Pragma("unroll") for (int k = 0; k < 2; ++k) dst[n][k] = *(const LAS bf16x8*)(lds + PG8_SB(b, h) + boff + n * 2048 + k * 1024); } while (0)
#define PG8_MMA(ai, bj, At, Bt) do { __builtin_amdgcn_s_setprio(1); _Pragma("unroll") for (int m = 0; m < 4; ++m) _Pragma("unroll") for (int n = 0; n < 2; ++n) _Pragma("unroll") for (int k = 0; k < 2; ++k) \
        acc[ai][bj][m][n] = __builtin_amdgcn_mfma_f32_16x16x32_bf16(Bt[n][k], At[m][k], acc[ai][bj][m][n], 0, 0, 0); __builtin_amdgcn_s_setprio(0); } while (0)
#define PG8_WAIT_V(n) asm volatile("s_waitcnt vmcnt(" #n ")" ::: "memory")
#define PG8_WAIT_L(n) asm volatile("s_waitcnt lgkmcnt(" #n ")" ::: "memory")
#define PG8_BAR __builtin_amdgcn_s_barrier()
#define PG8_SCHED __builtin_amdgcn_sched_barrier(0)
    Unit cur, nxt; int ui = 0;
    if (!S.next(0, cur)) return;
    f32x4 acc[2][2][4][2];
#pragma unroll
    for (int a = 0; a < 2; ++a)
#pragma unroll
        for (int b = 0; b < 2; ++b)
#pragma unroll
            for (int m = 0; m < 4; ++m)
#pragma unroll
                for (int n = 0; n < 2; ++n) acc[a][b][m][n] = (f32x4){0.f, 0.f, 0.f, 0.f};
    bf16x8 At[4][2], B0[2][2], B1[2][2];
    const char* cA = (const char*)g.A + (size_t)cur.pm * tstep; const char* cB = (const char*)g.Bt + (size_t)S.btile(cur) * tstep;
    S.a_ready(cur);
    if constexpr (SP2) {
        PG8_STAGE(PG8_SB(0, 0), cB, voffB); PG8_STAGE(PG8_SB(0, 1), cB + hstep, voffB); PG8_STAGE(PG8_SA(0, 0), cA, voffA); PG8_STAGE(PG8_SA(0, 1), cA + hstep, voffA);
        if (wr == 1) PG8_BAR;
        PG8_WAIT_V(2); PG8_BAR;
        PG8_STAGE(PG8_SB(1, 0), cB + kstep, voffB); PG8_STAGE(PG8_SA(1, 0), cA + kstep, voffA); PG8_STAGE(PG8_SB(1, 1), cB + hstep + kstep, voffB);
        PG8_WAIT_V(6); PG8_BAR;
    } else {
        PG8_STAGE(PG8_SB(0, 0), cB, voffB); PG8_STAGE(PG8_SA(0, 0), cA, voffA); PG8_STAGE(PG8_SB(0, 1), cB + hstep, voffB); PG8_STAGE(PG8_SA(0, 1), cA + hstep, voffA);
        if (wr == 1) PG8_BAR;
        PG8_WAIT_V(4); PG8_BAR;
        PG8_STAGE(PG8_SB(1, 0), cB + kstep, voffB); PG8_STAGE(PG8_SA(1, 0), cA + kstep, voffA); PG8_STAGE(PG8_SB(1, 1), cB + hstep + kstep, voffB);
        PG8_WAIT_V(6); PG8_BAR;
    }
    for (;;) {
        const bool has_next = S.next(ui + 1, nxt);
        const char* nA = has_next ? (const char*)g.A + (size_t)nxt.pm * tstep : cA; const char* nB = has_next ? (const char*)g.Bt + (size_t)S.btile(nxt) * tstep : cB;
        for (int t = 0; t < nt; t += 2) {
            const bool last = (t == nt - 2);
            const char* a1 = cA + (size_t)(t + 1) * kstep;
            const char* a2 = last ? nA : cA + (size_t)(t + 2) * kstep; const char* b2 = last ? nB : cB + (size_t)(t + 2) * kstep;
            const char* a3 = a2 + kstep; const char* b3 = b2 + kstep;
            if (last && has_next) S.a_ready(nxt);
            if constexpr (SP2) {
            PG8_LDB(B0, 0, 0); PG8_LDB(B1, 0, 1); PG8_SCHED; PG8_LDA(At, 0, 0); PG8_STAGE(PG8_SA(1, 1), a1 + hstep, voffA);
            PG8_WAIT_V(8); PG8_WAIT_L(0); PG8_BAR; PG8_MMA(0, 0, At, B0); PG8_MMA(0, 1, At, B1); PG8_BAR; PG8_SCHED;
            PG8_LDA(At, 0, 1); PG8_STAGE(PG8_SB(0, 0), b2, voffB); PG8_STAGE(PG8_SB(0, 1), b2 + hstep, voffB); PG8_STAGE(PG8_SA(0, 0), a2, voffA);
            PG8_WAIT_V(8); PG8_WAIT_L(0); PG8_BAR; PG8_MMA(1, 0, At, B0); PG8_MMA(1, 1, At, B1); PG8_BAR; PG8_SCHED;
            PG8_LDB(B0, 1, 0); PG8_LDB(B1, 1, 1); PG8_SCHED; PG8_LDA(At, 1, 0); PG8_STAGE(PG8_SA(0, 1), a2 + hstep, voffA);
            PG8_WAIT_V(8); PG8_WAIT_L(0); PG8_BAR; PG8_MMA(0, 0, At, B0); PG8_MMA(0, 1, At, B1); PG8_BAR; PG8_SCHED;
            PG8_LDA(At, 1, 1); PG8_STAGE(PG8_SB(1, 0), b3, voffB); PG8_STAGE(PG8_SB(1, 1), b3 + hstep, voffB); PG8_STAGE(PG8_SA(1, 0), a3, voffA);
            PG8_WAIT_V(8); PG8_WAIT_L(0); PG8_BAR; PG8_MMA(1, 0, At, B0); PG8_MMA(1, 1, At, B1); PG8_BAR; PG8_SCHED;
            } else {
            PG8_LDB(B0, 0, 0); PG8_SCHED; PG8_LDA(At, 0, 0); PG8_STAGE(PG8_SA(1, 1), a1 + hstep, voffA);
            PG8_WAIT_L(8); PG8_BAR; PG8_WAIT_L(0); PG8_MMA(0, 0, At, B0); PG8_BAR; PG8_SCHED;
            PG8_LDB(B1, 0, 1); PG8_STAGE(PG8_SB(0, 0), b2, voffB);
            PG8_BAR; PG8_WAIT_L(0); PG8_MMA(0, 1, At, B1); PG8_BAR;
            PG8_LDA(At, 0, 1); PG8_STAGE(PG8_SA(0, 0), a2, voffA);
            PG8_BAR; PG8_WAIT_L(0); PG8_MMA(1, 0, At, B0); PG8_BAR; PG8_SCHED;
            PG8_STAGE(PG8_SB(0, 1), b2 + hstep, voffB);
            PG8_WAIT_V(6); PG8_BAR; PG8_MMA(1, 1, At, B1); PG8_BAR;
            PG8_LDB(B0, 1, 0); PG8_SCHED; PG8_LDA(At, 1, 0); PG8_STAGE(PG8_SA(0, 1), a2 + hstep, voffA);
            PG8_WAIT_L(8); PG8_BAR; PG8_WAIT_L(0); PG8_MMA(0, 0, At, B0); PG8_BAR; PG8_SCHED;
            PG8_LDB(B1, 1, 1); PG8_STAGE(PG8_SB(1, 0), b3, voffB);
            PG8_BAR; PG8_WAIT_L(0); PG8_MMA(0, 1, At, B1); PG8_BAR;
            PG8_LDA(At, 1, 1); PG8_STAGE(PG8_SA(1, 0), a3, voffA);
            PG8_BAR; PG8_WAIT_L(0); PG8_MMA(1, 0, At, B0); PG8_BAR; PG8_SCHED;
            PG8_STAGE(PG8_SB(1, 1), b3 + hstep, voffB);
            PG8_WAIT_V(6); PG8_BAR; PG8_MMA(1, 1, At, B1); PG8_BAR;
            }
        }
        if constexpr (ALIGN_EPI) { if (wr == 0) PG8_BAR; }
        E(acc, cur, wr, wc, fr, fq); S.done(cur);
        if (!has_next) break;
#pragma unroll
        for (int a = 0; a < 2; ++a)
#pragma unroll
            for (int b = 0; b < 2; ++b)
#pragma unroll
                for (int m = 0; m < 4; ++m)
#pragma unroll
                    for (int n = 0; n < 2; ++n) acc[a][b][m][n] = (f32x4){0.f, 0.f, 0.f, 0.f};
        cur = nxt; cA = nA; cB = nB; ++ui;
        if constexpr (ALIGN_EPI) { if (wr == 1) PG8_BAR; }
    }
    PG8_WAIT_V(0);
    if constexpr (!ALIGN_EPI) { if (wr == 0) PG8_BAR; }
    PG8_BAR;
#undef PG8_SA
#undef PG8_SB
#undef PG8_STAGE
#undef PG8_LDA
#undef PG8_LDB
#undef PG8_MMA
#undef PG8_WAIT_V
#undef PG8_WAIT_L
#undef PG8_BAR
#undef PG8_SCHED
}
}

#define XB_TMO      128
#define XB_XCNT(j)  (256  + 64 * (j))
#define XB_XSUB(j)  (1280 + 64 * (j))
#define XB_XGEN(j)  (2304 + 64 * (j))
#define XB_TOP      3328
#define XB_TOPGEN   3392
#define XCD_BAR_WORDS 3456
#define XB_SPIN_CAP (1u << 18)

__device__ __forceinline__ unsigned xb_ld(unsigned* p)              { return __hip_atomic_load(p, __ATOMIC_RELAXED, __HIP_MEMORY_SCOPE_AGENT); }
__device__ __forceinline__ unsigned xb_add(unsigned* p, unsigned v) { return __hip_atomic_fetch_add(p, v, __ATOMIC_RELAXED, __HIP_MEMORY_SCOPE_AGENT); }
__device__ __forceinline__ unsigned xb_xcc_id() { return (unsigned)__builtin_amdgcn_s_getreg((3 << 11) | 20) & 0xFu; }
#define XB_SPIN(cond, bar) do { unsigned _sp = 0; while (cond) { __builtin_amdgcn_s_sleep(1); \
    if ((++_sp & 255u) == 0u) { if (xb_ld(&(bar)[XB_TMO])) break; if (_sp > XB_SPIN_CAP) { atomicAdd(&(bar)[XB_TMO], 1u); break; } } } } while (0)

struct XcdBarrier { unsigned* bar; unsigned x; volatile LAS unsigned* st; };

__device__ __forceinline__ XcdBarrier xcd_barrier_post(unsigned* bar, volatile LAS unsigned* st) {
    XcdBarrier b; b.bar = bar; b.x = xb_xcc_id(); b.st = st;
    if (threadIdx.x == 0) (void)xb_add(&bar[XB_XCNT(b.x)], 1u);
    return b;
}
__device__ __forceinline__ void xcd_barrier_complete(unsigned* bar, unsigned x, unsigned& nloc, unsigned& nx) {
    const unsigned G = gridDim.x * gridDim.y * gridDim.z;
    unsigned sum, cnt, mine, sp = 0u;
    for (;;) {
        sum = 0u; cnt = 0u; mine = 0u;
#pragma unroll
        for (unsigned j = 0; j < 16; ++j) { const unsigned c = xb_ld(&bar[XB_XCNT(j)]); sum += c; cnt += (c > 0u) ? 1u : 0u; mine = (j == x) ? c : mine; }
        if (sum == G) break;
        __builtin_amdgcn_s_sleep(1);
        if ((++sp & 255u) == 0u) { if (xb_ld(&bar[XB_TMO])) break; if (sp > XB_SPIN_CAP) { atomicAdd(&bar[XB_TMO], 1u); break; } }
    }
    nloc = mine > 0u ? mine : 1u; nx = cnt > 0u ? cnt : 1u;
}
__device__ __forceinline__ void xcd_barrier(const XcdBarrier& b) {
    asm volatile("s_waitcnt vmcnt(0)" ::: "memory");
    __syncthreads();
    if (threadIdx.x == 0) {
        unsigned* bar = b.bar;
        __builtin_amdgcn_s_waitcnt(0);
        unsigned nloc = b.st[0], nx = b.st[1];
        if (nloc == 0u) { xcd_barrier_complete(bar, b.x, nloc, nx); b.st[0] = nloc; b.st[1] = nx; }
        const unsigned old = xb_add(&bar[XB_XSUB(b.x)], 1u);
        const unsigned gen = old / nloc;
        if (old + 1u == (gen + 1u) * nloc) {
            __builtin_amdgcn_fence(__ATOMIC_RELEASE, "agent");
            asm volatile("s_waitcnt vmcnt(0)" ::: "memory");
            const unsigned og = xb_add(&bar[XB_TOP], 1u);
            const unsigned tg = og / nx;
            if (og + 1u == (tg + 1u) * nx) xb_add(&bar[XB_TOPGEN], 1u);
            else XB_SPIN(xb_ld(&bar[XB_TOPGEN]) == tg, bar);
            __builtin_amdgcn_fence(__ATOMIC_ACQUIRE, "agent");
            xb_add(&bar[XB_XGEN(b.x)], 1u);
            asm volatile("s_waitcnt vmcnt(0)" ::: "memory");
        } else {
            XB_SPIN(xb_ld(&bar[XB_XGEN(b.x)]) == gen, bar);
            __builtin_amdgcn_fence(__ATOMIC_ACQUIRE, "agent");
            asm volatile("s_waitcnt vmcnt(0)" ::: "memory");
        }
    }
    __syncthreads();
}

constexpr int NWAVES = 8;
constexpr int RING_BYTES = 131072;
constexpr int LDSCTL_OFF = RING_BYTES, MISC_OFF = LDSCTL_OFF + 320;
constexpr int LDS_BYTES = 147456;
constexpr int NPHASE = 2 + 6 * NLAYER;

#define LDS_WAIT() asm volatile("s_waitcnt lgkmcnt(0)" ::: "memory")

struct Args { const float* in[20]; float* out; unsigned char* ws; int ph_lo, ph_hi, li, pad; };

#define CAS __attribute__((address_space(4)))
struct Frame {
    LAS unsigned char* lds;
    int tid, lane, wave, G, gw, NGW;
    const CAS unsigned char* ka;
    __device__ __forceinline__ const float* x() const { return *(const float* const CAS*)(ka + 0); }
    __device__ __forceinline__ const float* c() const { return *(const float* const CAS*)(ka + 8); }
    __device__ __forceinline__ const float* ctx() const { return *(const float* const CAS*)(ka + 16); }
    __device__ __forceinline__ const float* c_ctx() const { return *(const float* const CAS*)(ka + 24); }
    __device__ __forceinline__ const float* w_ada() const { return *(const float* const CAS*)(ka + 32); }
    __device__ __forceinline__ const float* b_ada() const { return *(const float* const CAS*)(ka + 40); }
    __device__ __forceinline__ const float* w_in() const { return *(const float* const CAS*)(ka + 48); }
    __device__ __forceinline__ const float* conv_w() const { return *(const float* const CAS*)(ka + 56); }
    __device__ __forceinline__ const float* sink() const { return *(const float* const CAS*)(ka + 64); }
    __device__ __forceinline__ const float* g_attn() const { return *(const float* const CAS*)(ka + 72); }
    __device__ __forceinline__ const float* g_conv() const { return *(const float* const CAS*)(ka + 80); }
    __device__ __forceinline__ const float* w_out() const { return *(const float* const CAS*)(ka + 88); }
    __device__ __forceinline__ const float* ln1_g() const { return *(const float* const CAS*)(ka + 96); }
    __device__ __forceinline__ const float* ln1_b() const { return *(const float* const CAS*)(ka + 104); }
    __device__ __forceinline__ const float* wq() const { return *(const float* const CAS*)(ka + 112); }
    __device__ __forceinline__ const float* keys() const { return *(const float* const CAS*)(ka + 120); }
    __device__ __forceinline__ const float* pu() const { return *(const float* const CAS*)(ka + 128); }
    __device__ __forceinline__ const float* pv() const { return *(const float* const CAS*)(ka + 136); }
    __device__ __forceinline__ const float* ln2_g() const { return *(const float* const CAS*)(ka + 144); }
    __device__ __forceinline__ const float* ln2_b() const { return *(const float* const CAS*)(ka + 152); }
    __device__ __forceinline__ float* out() const { return *(float* const CAS*)(ka + 160); }
    __device__ __forceinline__ unsigned char* ws() const { return *(unsigned char* const CAS*)(ka + 168); }
    __device__ __forceinline__ float* MODS() const { return (float*)(ws() + WS_MODS); }
    __device__ __forceinline__ float* ROPE() const { return (float*)(ws() + WS_ROPE); }
    __device__ __forceinline__ bf16_t* X() const { return (bf16_t*)(ws() + WS_X); }
    __device__ __forceinline__ float* SC() const { return (float*)(ws() + WS_SC); }
    __device__ __forceinline__ bf16_t* KBD() const { return (bf16_t*)(ws() + WS_KBD); }
    __device__ __forceinline__ bf16_t* WQR() const { return (bf16_t*)(ws() + WS_WQR); }
    __device__ __forceinline__ bf16_t* WINT() const { return (bf16_t*)(ws() + WS_WINT); }
    __device__ __forceinline__ bf16_t* WOUTT() const { return (bf16_t*)(ws() + WS_WOUTT); }
    __device__ __forceinline__ bf16_t* WEFFT() const { return (bf16_t*)(ws() + WS_WEFFT); }
    __device__ __forceinline__ bf16_t* H() const { return (bf16_t*)(ws() + WS_H); }
    __device__ __forceinline__ bf16_t* PROJ() const { return (bf16_t*)(ws() + WS_PROJ); }
    __device__ __forceinline__ bf16_t* MIX() const { return (bf16_t*)(ws() + WS_MIX); }
    __device__ __forceinline__ unsigned char* UT() const { return (unsigned char*)(ws() + WS_UT); }
    __device__ __forceinline__ unsigned char* VT() const { return (unsigned char*)(ws() + WS_VT); }
    __device__ __forceinline__ float* US() const { return (float*)(ws() + WS_US); }
    __device__ __forceinline__ float* VS() const { return (float*)(ws() + WS_VS); }
};

__device__ __forceinline__ void frame_ids(Frame& F) {
    int tz = threadIdx.x; asm volatile("" : "+v"(tz));
    F.tid = tz; F.lane = tz & 63; F.wave = __builtin_amdgcn_readfirstlane(tz >> 6);
    F.gw = blockIdx.x * NWAVES + F.wave;
    const CAS unsigned char* k = (const CAS unsigned char*)__builtin_amdgcn_kernarg_segment_ptr(); asm volatile("" : "+s"(k)); F.ka = k;
}
template <int CTRL> __device__ __forceinline__ int dpp_i(int v) { return __builtin_amdgcn_update_dpp(0, v, CTRL, 0xf, 0xf, true); }
template <int CTRL> __device__ __forceinline__ float dpp_f(float v) { return __int_as_float(dpp_i<CTRL>(__float_as_int(v))); }
constexpr int DPP_XOR1 = 0xB1, DPP_XOR2 = 0x4E, DPP_HMIRROR = 0x141, DPP_ROR4 = 0x124, DPP_ROR8 = 0x128;
__device__ __forceinline__ float wave_sum_u(float v) {
    v += dpp_f<DPP_XOR1>(v); v += dpp_f<DPP_XOR2>(v); v += dpp_f<DPP_ROR4>(v); v += dpp_f<DPP_ROR8>(v);
    const float r0 = __int_as_float(__builtin_amdgcn_readlane(__float_as_int(v), 0)), r1 = __int_as_float(__builtin_amdgcn_readlane(__float_as_int(v), 16));
    const float r2 = __int_as_float(__builtin_amdgcn_readlane(__float_as_int(v), 32)), r3 = __int_as_float(__builtin_amdgcn_readlane(__float_as_int(v), 48));
    return (r0 + r1) + (r2 + r3);
}
__device__ __forceinline__ float wave_max_u(float v) {
    v = fmaxf(v, dpp_f<DPP_XOR1>(v)); v = fmaxf(v, dpp_f<DPP_XOR2>(v)); v = fmaxf(v, dpp_f<DPP_ROR4>(v)); v = fmaxf(v, dpp_f<DPP_ROR8>(v));
    const float r0 = __int_as_float(__builtin_amdgcn_readlane(__float_as_int(v), 0)), r1 = __int_as_float(__builtin_amdgcn_readlane(__float_as_int(v), 16));
    const float r2 = __int_as_float(__builtin_amdgcn_readlane(__float_as_int(v), 32)), r3 = __int_as_float(__builtin_amdgcn_readlane(__float_as_int(v), 48));
    return fmaxf(fmaxf(r0, r1), fmaxf(r2, r3));
}
__device__ __forceinline__ float wave_sum(float v) { return wave_sum_u(v); }
__device__ __forceinline__ unsigned pk2(float lo, float hi) { return pg8::cvt_pk_bf16(lo, hi); }
__device__ __forceinline__ float bf_lo(unsigned u) { return __uint_as_float(u << 16); }
__device__ __forceinline__ float bf_hi(unsigned u) { return __uint_as_float(u & 0xffff0000u); }
__device__ __forceinline__ int modrow(int t) { return t < TL ? t / SEQ : 2; }

__device__ __forceinline__ void transpose_item(const float* W, int K, int N, bf16_t* WT, LAS float* scr, int item, int lane) {
    const int nblk = N / 32, kb = item / nblk, nb = item % nblk, k0 = 64 * kb, n0 = 32 * nb;
#pragma unroll 8
    for (int i = 0; i < 32; ++i) { const int kk = 2 * i + (lane >> 5); scr[kk * 33 + (lane & 31)] = W[(size_t)(k0 + kk) * N + n0 + (lane & 31)]; }
    LDS_WAIT(); asm volatile("" ::: "memory");
    const int c = lane & 7;
#pragma unroll
    for (int j = 0; j < 4; ++j) { const int n = (lane >> 3) + 8 * j; const LAS float* s = scr + (8 * c) * 33 + n;
        u32x4 o; o.x = pk2(s[0 * 33], s[1 * 33]); o.y = pk2(s[2 * 33], s[3 * 33]); o.z = pk2(s[4 * 33], s[5 * 33]); o.w = pk2(s[6 * 33], s[7 * 33]);
        *(u32x4*)(WT + (size_t)(n0 + n) * K + k0 + 8 * c) = o; }
    LDS_WAIT(); asm volatile("" ::: "memory");
}

__device__ __forceinline__ void cvt_row_bf16(const float* src, bf16_t* dst, int lane) {
    const f32x4* s = (const f32x4*)src + lane; u32x2* d = (u32x2*)dst + lane;
    f32x4 v[8];
#pragma unroll
    for (int j = 0; j < 8; ++j) v[j] = __builtin_nontemporal_load(s + 64 * j);
#pragma unroll
    for (int j = 0; j < 8; ++j) { u32x2 o; o.x = pk2(v[j].x, v[j].y); o.y = pk2(v[j].z, v[j].w); d[64 * j] = o; }
}

struct RowF32 { f32x4 v[4][2]; };
__device__ __forceinline__ void row_load_nt(RowF32& R, const float* src, int lane) {
    const f32x4* s = (const f32x4*)src + 2 * lane;
#pragma unroll
    for (int j = 0; j < 4; ++j) { R.v[j][0] = __builtin_nontemporal_load(s + 128 * j); R.v[j][1] = __builtin_nontemporal_load(s + 128 * j + 1); }
}
template <int FMT>
__device__ __forceinline__ void cvt_row_lp(const RowF32& R, unsigned char* dst, float* inv, int lane) {
    constexpr float QMAX = FMT == 8 ? 224.f : 6.f;
    float am = 0.f;
#pragma unroll
    for (int j = 0; j < 4; ++j)
#pragma unroll
        for (int q = 0; q < 2; ++q) am = fmaxf(fmaxf(am, fmaxf(fabsf(R.v[j][q].x), fabsf(R.v[j][q].y))), fmaxf(fabsf(R.v[j][q].z), fabsf(R.v[j][q].w)));
    am = wave_max_u(am);
    const float sc = am > 0.f ? QMAX / am : 1.f;
#pragma unroll
    for (int j = 0; j < 4; ++j) {
        if constexpr (FMT == 8) {
            u32x2 w;
#pragma unroll
            for (int q = 0; q < 2; ++q) { int t = __builtin_amdgcn_cvt_pk_fp8_f32(R.v[j][q].x * sc, R.v[j][q].y * sc, 0, false); t = __builtin_amdgcn_cvt_pk_fp8_f32(R.v[j][q].z * sc, R.v[j][q].w * sc, t, true); w[q] = (unsigned)t; }
            *((u32x2*)dst + lane + 64 * j) = w;
        } else {
            unsigned w = 0u;
            w = __builtin_amdgcn_cvt_scalef32_pk_fp4_f32(w, R.v[j][0].x * sc, R.v[j][0].y * sc, 1.0f, 0);
            w = __builtin_amdgcn_cvt_scalef32_pk_fp4_f32(w, R.v[j][0].z * sc, R.v[j][0].w * sc, 1.0f, 1);
            w = __builtin_amdgcn_cvt_scalef32_pk_fp4_f32(w, R.v[j][1].x * sc, R.v[j][1].y * sc, 1.0f, 2);
            w = __builtin_amdgcn_cvt_scalef32_pk_fp4_f32(w, R.v[j][1].z * sc, R.v[j][1].w * sc, 1.0f, 3);
            *((unsigned*)dst + lane + 64 * j) = w;
        }
    }
    if (lane == 0) *inv = am > 0.f ? am * (1.f / QMAX) : 1.f;
}
template <int FMT> struct LpRow;
template <> struct LpRow<8> { u32x4 a, b;
    __device__ __forceinline__ void load(const unsigned char* rowp, int lane) { a = *(const u32x4*)(rowp + 32 * lane); b = *(const u32x4*)(rowp + 32 * lane + 16); }
    template <class Fn> __device__ __forceinline__ void each(Fn&& f) const {
#pragma unroll
        for (int w = 0; w < 4; ++w) { const f32x2 l0 = __builtin_amdgcn_cvt_pk_f32_fp8((int)a[w], false), h0 = __builtin_amdgcn_cvt_pk_f32_fp8((int)a[w], true);
            f(4 * w, l0.x, l0.y); f(4 * w + 2, h0.x, h0.y); }
#pragma unroll
        for (int w = 0; w < 4; ++w) { const f32x2 l0 = __builtin_amdgcn_cvt_pk_f32_fp8((int)b[w], false), h0 = __builtin_amdgcn_cvt_pk_f32_fp8((int)b[w], true);
            f(16 + 4 * w, l0.x, l0.y); f(16 + 4 * w + 2, h0.x, h0.y); }
    } };
template <> struct LpRow<4> { u32x4 a;
    __device__ __forceinline__ void load(const unsigned char* rowp, int lane) { a = *(const u32x4*)(rowp + 16 * lane); }
    template <class Fn> __device__ __forceinline__ void each(Fn&& f) const {
#pragma unroll
        for (int w = 0; w < 4; ++w) {
            const f32x2 d0 = __builtin_amdgcn_cvt_scalef32_pk_f32_fp4(a[w], 1.0f, 0), d1 = __builtin_amdgcn_cvt_scalef32_pk_f32_fp4(a[w], 1.0f, 1);
            const f32x2 d2 = __builtin_amdgcn_cvt_scalef32_pk_f32_fp4(a[w], 1.0f, 2), d3 = __builtin_amdgcn_cvt_scalef32_pk_f32_fp4(a[w], 1.0f, 3);
            f(8 * w, d0.x, d0.y); f(8 * w + 2, d1.x, d1.y); f(8 * w + 4, d2.x, d2.y); f(8 * w + 6, d3.x, d3.y); }
    } };

__device__ __forceinline__ void row_stats(const f32x4 (&v)[8], float& mean, float& rstd) {
    float s = 0.f;
#pragma unroll
    for (int j = 0; j < 8; ++j) s += (v[j].x + v[j].y) + (v[j].z + v[j].w);
    mean = wave_sum(s) * (1.f / D);
    float s2 = 0.f;
#pragma unroll
    for (int j = 0; j < 8; ++j) { const f32x4 d = v[j] - mean; s2 += (d.x * d.x + d.y * d.y) + (d.z * d.z + d.w * d.w); }
    rstd = 1.f / sqrtf(wave_sum(s2) * (1.f / D) + LN_EPS);
}
__device__ __forceinline__ void modulate_store(const f32x4 (&v)[8], const float* shift, const float* scale, bf16_t* dst, int lane) {
    float mean, rstd; row_stats(v, mean, rstd);
    u32x2* d = (u32x2*)dst + lane;
#pragma unroll
    for (int j = 0; j < 8; ++j) { const f32x4 sc = *((const f32x4*)scale + lane + 64 * j), sh = *((const f32x4*)shift + lane + 64 * j);
        const f32x4 y = (v[j] - mean) * rstd * (sc + 1.f) + sh;
        u32x2 o; o.x = pk2(y.x, y.y); o.y = pk2(y.z, y.w); d[64 * j] = o; }
}

__device__ __forceinline__ void convert_tables(Frame& F, int row0, int row1, int w0, int wstride) {
    RowF32 ru, rv, nu, nv;
    int row = row0 + w0;
    if (row < row1) { row_load_nt(ru, F.pu() + (size_t)row * D, F.lane); row_load_nt(rv, F.pv() + (size_t)row * D, F.lane); }
    while (row < row1) {
        const int nrow = row + wstride;
        if (nrow < row1) { row_load_nt(nu, F.pu() + (size_t)nrow * D, F.lane); row_load_nt(nv, F.pv() + (size_t)nrow * D, F.lane); }
        cvt_row_lp<U_FMT>(ru, F.UT() + (size_t)row * UROW, F.US() + row, F.lane);
        cvt_row_lp<V_FMT>(rv, F.VT() + (size_t)row * VROW, F.VS() + row, F.lane);
        ru = nu; rv = nv; row = nrow;
    }
}
__device__ __forceinline__ void convert_in_tail(Frame& F, int layer, int nunits, int part) {
    if (layer + 1 >= NLAYER) return;
    const int G = F.G, rounds = (nunits + G - 1) / G, nlast = nunits - (rounds - 1) * G;
    const int c = (int)blockIdx.x;
    int nshort = G - nlast, sidx = c - nlast;
    if (nshort <= 0) { nshort = G; sidx = c; }
    else if (sidx < 0) return;
    const int r0 = (layer + 1) * NEXP + part * (NEXP / 2);
    convert_tables(F, r0, r0 + NEXP / 2, sidx * NWAVES + F.wave, nshort * NWAVES);
}
__device__ __forceinline__ void p0a_prologue(Frame& F) {
    LAS float* condL = (LAS float*)F.lds;
    LAS float* red = (LAS float*)(F.lds + 24576);
    for (int i = F.tid; i < 3 * D; i += NWAVES * 64) { const int r = i / D, k = i % D; const float v = r < 2 ? F.c()[r * D + k] : F.c_ctx()[k]; condL[i] = v / (1.f + __expf(-v)); }
    __syncthreads();
    for (int item = blockIdx.x; item < 384; item += F.G) {
        const int l = item / 96, n0 = (item % 96) * 128;
        const float* wp = F.w_ada() + ((size_t)l * D + F.wave * 256) * 12288 + n0 + 2 * F.lane;
        f32x2 a0 = {0.f, 0.f}, a1 = {0.f, 0.f}, a2 = {0.f, 0.f};
#pragma unroll 8
        for (int k = 0; k < 256; ++k) { const f32x2 w = __builtin_nontemporal_load((const f32x2*)(wp + (size_t)k * 12288)); const int kk = F.wave * 256 + k;
            a0 += w * condL[kk]; a1 += w * condL[D + kk]; a2 += w * condL[2 * D + kk]; }
        LAS float* rp = red + F.wave * 384 + 2 * F.lane;
        rp[0] = a0.x; rp[1] = a0.y; rp[128] = a1.x; rp[129] = a1.y; rp[256] = a2.x; rp[257] = a2.y;
        __syncthreads();
        if (F.tid < 384) { const int r = F.tid / 128, n = F.tid % 128; float s = 0.f;
#pragma unroll
            for (int w = 0; w < 8; ++w) s += red[w * 384 + r * 128 + n];
            F.MODS()[((size_t)l * 3 + r) * 12288 + n0 + n] = s + F.b_ada()[(size_t)l * 12288 + n0 + n]; }
        __syncthreads();
    }
    LAS float* scr = (LAS float*)(F.lds + 40960 + F.wave * 8448);
    constexpr int I_IN = (D / 64) * (INC / 32), I_OUT = (D / 64) * (D / 32);
    for (int it = F.gw; it < NLAYER * (I_IN + I_OUT); it += F.NGW) {
        const int l = it / (I_IN + I_OUT); int r = it % (I_IN + I_OUT);
        if (r < I_IN) transpose_item(F.w_in() + (size_t)l * D * INC, D, INC, F.WINT() + (size_t)l * INC * D, scr, r, F.lane);
        else transpose_item(F.w_out() + (size_t)l * D * D, D, D, F.WOUTT() + (size_t)l * D * D, scr, r - I_IN, F.lane);
    }
    for (int row = F.gw; row < NLAYER * D; row += F.NGW) {
        const int l = row / D, c = row % D; const f32x4* s = (const f32x4*)(F.wq() + (size_t)row * D) + F.lane;
#pragma unroll
        for (int j = 0; j < 8; ++j) { const f32x4 v = s[64 * j]; u32x2 o; o.x = pk2(v.x, v.y); o.y = pk2(v.z, v.w);
            *((u32x2*)(F.WQR() + ((size_t)(l * 8 + j) * D + c) * 256) + F.lane) = o; }
    }
    for (int row = F.gw; row < 32 * 256; row += F.NGW) {
        const int lh = row >> 8, pk = row & 255, p = pk >> 7;
        u32x2 o = {0u, 0u};
        if ((F.lane >> 5) == p) { const f32x4 v = *((const f32x4*)(F.keys() + ((size_t)lh * 256 + pk) * 128) + (F.lane & 31)); o.x = pk2(v.x, v.y); o.y = pk2(v.z, v.w); }
        *((u32x2*)(F.KBD() + (size_t)row * 256) + F.lane) = o;
    }
    convert_tables(F, 0, NEXP, F.gw, F.NGW);
    for (int i = blockIdx.x * (NWAVES * 64) + F.tid; i < 192 * 32; i += F.G * NWAVES * 64) {
        const int idx = i >> 5, f = i & 31; const float pos = (float)(idx < 128 ? idx : idx - 128);
        const float inv = powf(10000.f, -(float)(2 * f) / 64.f); const float ang = pos * inv;
        F.ROPE()[2 * i] = cosf(ang); F.ROPE()[2 * i + 1] = sinf(ang);
    }
}

__device__ __forceinline__ void p0b_mod0(Frame& F) {
    for (int t = F.gw; t < TT; t += F.NGW) {
        const float* src = t < TL ? F.x() + (size_t)t * D : F.ctx() + (size_t)(t - TL) * D;
        f32x4 v[8];
#pragma unroll
        for (int j = 0; j < 8; ++j) v[j] = *((const f32x4*)src + F.lane + 64 * j);
        const float* mp = F.MODS() + (size_t)modrow(t) * 12288;
        modulate_store(v, mp, mp + D, F.H() + (size_t)t * D, F.lane);
    }
}

constexpr int KP = 272, VP = 320, KS_BYTES = 64 * KP, VS_BYTES = 64 * VP;
struct KVRegs { u32x4 k1, k2, v1, v2; f32x4 cs[4]; };

__device__ __forceinline__ void attn_load_tile(Frame& F, KVRegs& R, int ti, int b, int n, int g) {
    const int key = F.tid >> 3, c8 = F.tid & 7;
    int row, pos = 0;
    if (ti < 6) { pos = (n - 1) * 128 + 64 * ti + key; row = b * SEQ + pos; } else row = TL + b * CTXL + 64 * (ti - 6) + key;
    const bf16_t* base = F.PROJ() + (size_t)row * INC;
    const int d1 = (c8 >> 2) * 64 + (c8 & 3) * 8;
    R.k1 = *(const u32x4*)(base + OFF_K + g * 128 + d1); R.k2 = *(const u32x4*)(base + OFF_K + g * 128 + d1 + 32);
    R.v1 = *(const u32x4*)(base + OFF_V + g * 128 + 8 * c8); R.v2 = *(const u32x4*)(base + OFF_V + g * 128 + 64 + 8 * c8);
    if (ti < 6) { const int tidx = (c8 >> 2) ? 128 + (pos & 63) : (pos >> 6); const f32x4* cp = (const f32x4*)(F.ROPE() + ((size_t)tidx * 32 + (c8 & 3) * 8) * 2);
#pragma unroll
        for (int m = 0; m < 4; ++m) R.cs[m] = cp[m]; }
}
__device__ __forceinline__ void rope8(u32x4& a, u32x4& bq, const f32x4 (&cs)[4], float scale) {
    u32x4 oa, ob;
#pragma unroll
    for (int w = 0; w < 4; ++w) {
        const float x1l = bf_lo(a[w]), x1h = bf_hi(a[w]), x2l = bf_lo(bq[w]), x2h = bf_hi(bq[w]);
        const float cl = cs[w].x, sl = cs[w].y, ch = cs[w].z, sh = cs[w].w;
        oa[w] = pk2((x1l * cl - x2l * sl) * scale, (x1h * ch - x2h * sh) * scale);
        ob[w] = pk2((x2l * cl + x1l * sl) * scale, (x2h * ch + x1h * sh) * scale);
    }
    a = oa; bq = ob;
}
__device__ __forceinline__ void attn_store_tile(Frame& F, KVRegs& R, int ti, int buf) {
    const int key = F.tid >> 3, c8 = F.tid & 7;
    if (ti < 6) rope8(R.k1, R.k2, R.cs, 1.f);
    const int d1 = (c8 >> 2) * 64 + (c8 & 3) * 8;
    LAS unsigned char* kp = F.lds + buf * KS_BYTES + key * KP;
    *(LAS u32x4*)(kp + d1 * 2) = R.k1; *(LAS u32x4*)(kp + (d1 + 32) * 2) = R.k2;
    LAS unsigned char* vp = F.lds + 2 * KS_BYTES + buf * VS_BYTES + key * VP;
    *(LAS u32x4*)(vp + 16 * c8) = R.v1; *(LAS u32x4*)(vp + 128 + 16 * c8) = R.v2;
}

#define MFMA32(a, b, c) __builtin_amdgcn_mfma_f32_32x32x16_bf16((a), (b), (c), 0, 0, 0)

__device__ __forceinline__ void attn_unit(Frame& F, int layer, int u) {
    const bool latent = u < 512;
    int b, n, g, hp;
    if (latent) { hp = u & 1; g = (u >> 1) & 1; n = (u >> 2) & 63; b = u >> 8; }
    else { const int v = u - 512; hp = v & 1; g = (v >> 1) & 1; n = (v >> 2) & 1; b = v >> 3; }
    const int lane = F.lane, r = lane & 31, h = lane >> 5, wave = F.wave;
    const int head = g * 4 + hp * 2 + (wave >> 2), qb = wave & 3;
    const int tq = latent ? b * SEQ + n * 128 + 32 * qb + r : TL + b * CTXL + n * 128 + 32 * qb + r;
    bf16x8 qf[8];
    {
        u32x4 raw[8];
        const bf16_t* qp = F.PROJ() + (size_t)tq * INC + OFF_Q + head * 128 + 8 * h;
#pragma unroll
        for (int ks = 0; ks < 8; ++ks) raw[ks] = *(const u32x4*)(qp + 16 * ks);
        if (latent) {
            const int pos = n * 128 + 32 * qb + r;
#pragma unroll
            for (int half = 0; half < 2; ++half) {
                const int tidx = half ? 128 + (pos & 63) : (pos >> 6);
#pragma unroll
                for (int kk = 0; kk < 2; ++kk) {
                    const f32x4* cp = (const f32x4*)(F.ROPE() + ((size_t)tidx * 32 + 16 * kk + 8 * h) * 2);
                    f32x4 cs[4];
#pragma unroll
                    for (int m = 0; m < 4; ++m) cs[m] = cp[m];
                    rope8(raw[4 * half + kk], raw[4 * half + kk + 2], cs, QSCALE);
                }
            }
        } else {
#pragma unroll
            for (int ks = 0; ks < 8; ++ks)
#pragma unroll
                for (int w = 0; w < 4; ++w) raw[ks][w] = pk2(bf_lo(raw[ks][w]) * QSCALE, bf_hi(raw[ks][w]) * QSCALE);
        }
#pragma unroll
        for (int ks = 0; ks < 8; ++ks) qf[ks] = __builtin_bit_cast(bf16x8, raw[ks]);
    }
    int tlo = 6, nw = 0;
    if (latent) { tlo = (n == 0) ? 2 : 0; const int thi = (n == 63) ? 3 : 5; nw = thi - tlo + 1; }
    const int ntiles = nw + 4;
    f32x16 o[4];
#pragma unroll
    for (int db = 0; db < 4; ++db)
#pragma unroll
        for (int i = 0; i < 16; ++i) o[db][i] = 0.f;
    float m_run = F.sink()[layer * 8 + head] * LOG2E;
    float lsum = h == 0 ? 1.f : 0.f;
    const int iq = 32 * qb + r;
    KVRegs R;
    __syncthreads();
    attn_load_tile(F, R, nw > 0 ? tlo : 6, b, n, g);
    attn_store_tile(F, R, nw > 0 ? tlo : 6, 0);
    __syncthreads();
    const int i16 = lane & 15, tq4 = i16 >> 2, tp = i16 & 3, blk = (lane >> 4) & 1;
    for (int j = 0; j < ntiles; ++j) {
        const int ti = j < nw ? tlo + j : 6 + (j - nw);
        const int buf = j & 1;
        const bool more = j + 1 < ntiles;
        const int tin = (j + 1) < nw ? tlo + j + 1 : 6 + (j + 1 - nw);
        if (more) attn_load_tile(F, R, tin, b, n, g);
        const bool part = ti >= 6 || (ti >= (qb >> 1) && ti <= (qb >> 1) + 4);
        if (part) {
            f32x16 s0, s1;
#pragma unroll
            for (int i = 0; i < 16; ++i) { s0[i] = 0.f; s1[i] = 0.f; }
            const LAS unsigned char* kb = F.lds + buf * KS_BYTES + r * KP + h * 16;
#pragma unroll
            for (int ks = 0; ks < 8; ++ks) {
                const bf16x8 a0 = *(const LAS bf16x8*)(kb + ks * 32), a1 = *(const LAS bf16x8*)(kb + 32 * KP + ks * 32);
                s0 = MFMA32(a0, qf[ks], s0); s1 = MFMA32(a1, qf[ks], s1);
            }
            float mx = -INFINITY;
            if (ti < 6 && (ti == (qb >> 1) || ti == (qb >> 1) + 4)) {
                const int jb = 64 * ti + 4 * h - iq;
#pragma unroll
                for (int i = 0; i < 16; ++i) { const int j0 = jb + (i & 3) + 8 * (i >> 2), j1 = j0 + 32;
                    s0[i] = (j0 >= 0 && j0 <= 256) ? s0[i] : -INFINITY; s1[i] = (j1 >= 0 && j1 <= 256) ? s1[i] : -INFINITY; }
            }
#pragma unroll
            for (int i = 0; i < 16; ++i) mx = fmaxf(mx, fmaxf(s0[i], s1[i]));
            mx = fmaxf(mx, __shfl_xor(mx, 32));
            if (__any(mx > m_run + 8.f)) {
                const float m_new = mx > m_run + 8.f ? mx : m_run, alpha = __builtin_amdgcn_exp2f(m_run - m_new);
                m_run = m_new; lsum *= alpha;
#pragma unroll
                for (int db = 0; db < 4; ++db)
#pragma unroll
                    for (int i = 0; i < 16; ++i) o[db][i] *= alpha;
            }
#pragma unroll
            for (int i = 0; i < 16; ++i) { s0[i] = __builtin_amdgcn_exp2f(s0[i] - m_run); s1[i] = __builtin_amdgcn_exp2f(s1[i] - m_run); lsum += s0[i] + s1[i]; }
            bf16x8 pf[2][2];
#pragma unroll
            for (int s2 = 0; s2 < 2; ++s2) {
                u32x4 p0, p1;
#pragma unroll
                for (int w = 0; w < 4; ++w) { p0[w] = pk2(s0[8 * s2 + 2 * w], s0[8 * s2 + 2 * w + 1]); p1[w] = pk2(s1[8 * s2 + 2 * w], s1[8 * s2 + 2 * w + 1]); }
                pf[0][s2] = __builtin_bit_cast(bf16x8, p0); pf[1][s2] = __builtin_bit_cast(bf16x8, p1);
            }
            const LAS unsigned char* vb = F.lds + 2 * KS_BYTES + buf * VS_BYTES + (4 * h + tq4) * VP + 32 * blk + 8 * tp;
#pragma unroll
            for (int db = 0; db < 4; ++db)
#pragma unroll
                for (int kb2 = 0; kb2 < 2; ++kb2)
#pragma unroll
                    for (int s2 = 0; s2 < 2; ++s2) {
                        const int off = (32 * kb2 + 16 * s2) * VP + db * 64;
                        const s16x4 lo = __builtin_amdgcn_ds_read_tr16_b64_v4i16((LAS s16x4*)(vb + off));
                        const s16x4 hi = __builtin_amdgcn_ds_read_tr16_b64_v4i16((LAS s16x4*)(vb + off + 8 * VP));
                        const bf16x8 av = __builtin_shufflevector(lo, hi, 0, 1, 2, 3, 4, 5, 6, 7);
                        o[db] = MFMA32(av, pf[kb2][s2], o[db]);
                    }
        }
        if (more) attn_store_tile(F, R, tin, buf ^ 1);
        __syncthreads();
    }
    const float lt = lsum + __shfl_xor(lsum, 32);
    const float inv = 1.f / lt;
    float ss = 0.f;
#pragma unroll
    for (int db = 0; db < 4; ++db)
#pragma unroll
        for (int i = 0; i < 16; ++i) { o[db][i] *= inv; ss += o[db][i] * o[db][i]; }
    ss += __shfl_xor(ss, 32);
    const float rn = 1.f / sqrtf(ss * (1.f / 128.f) + LN_EPS);
    bf16_t* op = F.MIX() + (size_t)tq * D + head * 128 + 4 * h;
    const float* gp = F.g_attn() + layer * 1024 + head * 128 + 4 * h;
#pragma unroll
    for (int db = 0; db < 4; ++db)
#pragma unroll
        for (int g4 = 0; g4 < 4; ++g4) {
            const f32x4 gv = *(const f32x4*)(gp + 32 * db + 8 * g4);
            u32x2 w; w.x = pk2(o[db][4 * g4] * rn * gv.x, o[db][4 * g4 + 1] * rn * gv.y); w.y = pk2(o[db][4 * g4 + 2] * rn * gv.z, o[db][4 * g4 + 3] * rn * gv.w);
            *(u32x2*)(op + 32 * db + 8 * g4) = w;
        }
}

__device__ __forceinline__ void unpack8(const u32x4 v, float (&f)[8]) {
#pragma unroll
    for (int w = 0; w < 4; ++w) { f[2 * w] = bf_lo(v[w]); f[2 * w + 1] = bf_hi(v[w]); }
}
__device__ __forceinline__ void conv_row(Frame& F, int layer, int t) {
    bool first, last;
    if (t < TL) { const int pos = t & (SEQ - 1); first = pos == 0; last = pos == SEQ - 1; } else { const int pc = (t - TL) & (CTXL - 1); first = pc == 0; last = pc == CTXL - 1; }
    const bf16_t* p = F.PROJ() + (size_t)t * INC;
    const float* cw = F.conv_w() + (size_t)layer * 3 * 1024;
#pragma unroll
    for (int jc = 0; jc < 2; ++jc) {
        const int c = 8 * F.lane + 512 * jc;
        float gb[8], a[8], bq[8], um[8], ut[8], up[8];
        unpack8(*(const u32x4*)(p + c), gb);
        unpack8(*(const u32x4*)(p + OFF_C + c), a); unpack8(*(const u32x4*)(p + OFF_X + c), bq);
#pragma unroll
        for (int e = 0; e < 8; ++e) ut[e] = a[e] * bq[e];
        if (!first) { unpack8(*(const u32x4*)(p - INC + OFF_C + c), a); unpack8(*(const u32x4*)(p - INC + OFF_X + c), bq);
#pragma unroll
            for (int e = 0; e < 8; ++e) um[e] = a[e] * bq[e]; }
        else {
#pragma unroll
            for (int e = 0; e < 8; ++e) um[e] = 0.f; }
        if (!last) { unpack8(*(const u32x4*)(p + INC + OFF_C + c), a); unpack8(*(const u32x4*)(p + INC + OFF_X + c), bq);
#pragma unroll
            for (int e = 0; e < 8; ++e) up[e] = a[e] * bq[e]; }
        else {
#pragma unroll
            for (int e = 0; e < 8; ++e) up[e] = 0.f; }
        float y[8], ss = 0.f;
#pragma unroll
        for (int e = 0; e < 8; ++e) { y[e] = gb[e] * (cw[c + e] * um[e] + cw[1024 + c + e] * ut[e] + cw[2048 + c + e] * up[e]); ss += y[e] * y[e]; }
        ss += __shfl_xor(ss, 1); ss += __shfl_xor(ss, 2); ss += __shfl_xor(ss, 4); ss += __shfl_xor(ss, 8);
        const float rn = 1.f / sqrtf(ss * (1.f / 128.f) + LN_EPS);
        const float* gc = F.g_conv() + layer * 1024 + c;
        u32x4 w;
#pragma unroll
        for (int q = 0; q < 4; ++q) w[q] = pk2(y[2 * q] * rn * gc[2 * q], y[2 * q + 1] * rn * gc[2 * q + 1]);
        *(u32x4*)(F.MIX() + (size_t)t * D + 1024 + c) = w;
    }
}

__device__ __forceinline__ void ln_phase(Frame& F, int layer, int rows) {
    const int lane = F.lane;
    u32x4 w[4], wn[4];
    int t = F.gw;
    if (t < rows) {
#pragma unroll
        for (int j = 0; j < 4; ++j) w[j] = *(const u32x4*)(F.X() + (size_t)t * D + 8 * lane + 512 * j);
    }
    const float* g1 = F.ln1_g() + layer * D; const float* b1 = F.ln1_b() + layer * D;
    while (t < rows) {
        const int tn = t + F.NGW;
        if (tn < rows) {
#pragma unroll
            for (int j = 0; j < 4; ++j) wn[j] = *(const u32x4*)(F.X() + (size_t)tn * D + 8 * lane + 512 * j);
        }
        float v[32]; float s = 0.f;
#pragma unroll
        for (int j = 0; j < 4; ++j)
#pragma unroll
            for (int q = 0; q < 4; ++q) { v[8 * j + 2 * q] = bf_lo(w[j][q]); v[8 * j + 2 * q + 1] = bf_hi(w[j][q]); s += v[8 * j + 2 * q] + v[8 * j + 2 * q + 1]; }
        const float mean = wave_sum(s) * (1.f / D);
        float s2 = 0.f;
#pragma unroll
        for (int i = 0; i < 32; ++i) { v[i] -= mean; s2 += v[i] * v[i]; }
        const float rstd = 1.f / sqrtf(wave_sum(s2) * (1.f / D) + LN_EPS);
        float s3 = 0.f;
#pragma unroll
        for (int j = 0; j < 4; ++j) { const int c = 8 * lane + 512 * j; u32x4 o;
#pragma unroll
            for (int q = 0; q < 2; ++q) { const f32x4 gg = *(const f32x4*)(g1 + c + 4 * q), bb = *(const f32x4*)(b1 + c + 4 * q);
#pragma unroll
                for (int e = 0; e < 4; ++e) { const float y = v[8 * j + 4 * q + e] * rstd * gg[e] + bb[e]; v[8 * j + 4 * q + e] = y; s3 += y; }
                o[2 * q] = pk2(v[8 * j + 4 * q], v[8 * j + 4 * q + 1]); o[2 * q + 1] = pk2(v[8 * j + 4 * q + 2], v[8 * j + 4 * q + 3]); }
            *(u32x4*)(F.X() + (size_t)t * D + c) = o; }
        const float mean2 = wave_sum(s3) * (1.f / D);
        float s4 = 0.f;
#pragma unroll
        for (int i = 0; i < 32; ++i) { v[i] -= mean2; s4 += v[i] * v[i]; }
        const float rstd2 = 1.f / sqrtf(wave_sum(s4) * (1.f / D) + LN_EPS);
        const float* mp = F.MODS() + ((size_t)layer * 3 + modrow(t)) * 12288;
#pragma unroll
        for (int j = 0; j < 4; ++j) { const int c = 8 * lane + 512 * j; u32x4 o;
#pragma unroll
            for (int q = 0; q < 2; ++q) { const f32x4 sh = *(const f32x4*)(mp + 3 * D + c + 4 * q), sc = *(const f32x4*)(mp + 4 * D + c + 4 * q);
                const float y0 = v[8 * j + 4 * q] * rstd2 * (1.f + sc[0]) + sh[0], y1 = v[8 * j + 4 * q + 1] * rstd2 * (1.f + sc[1]) + sh[1];
                const float y2 = v[8 * j + 4 * q + 2] * rstd2 * (1.f + sc[2]) + sh[2], y3 = v[8 * j + 4 * q + 3] * rstd2 * (1.f + sc[3]) + sh[3];
                o[2 * q] = pk2(y0, y1); o[2 * q + 1] = pk2(y2, y3); }
            *(u32x4*)(F.H() + (size_t)t * D + c) = o; }
#pragma unroll
        for (int j = 0; j < 4; ++j) w[j] = wn[j];
        t = tn;
    }
}

__device__ __forceinline__ unsigned ordkey(float f) { const unsigned u = __float_as_uint(f); return u ^ ((u >> 31) ? 0xFFFFFFFFu : 0x80000000u); }
__device__ __forceinline__ float gelu_erf(float a) { return 0.5f * a * (1.f + erff(a * 0.70710678118654752f)); }

__device__ __forceinline__ float unordkey(unsigned k) { return __uint_as_float(k ^ ((k >> 31) ? 0x80000000u : 0xFFFFFFFFu)); }
__device__ __forceinline__ float gelu_as(float v) {
    const float av = fabsf(v), t = __builtin_amdgcn_rcpf(av * 0.2316418882f + 1.0f);
    float q = t * 0.5307027145f + (-0.7265760135f); q = q * t + 0.7107068705f; q = q * t + (-0.142248368f); q = q * t + 0.127414796f; q = q * t;
    const float e = __builtin_amdgcn_exp2f((v * v) * (-0.72134752044f));
    const float m = v * (q * e);
    return v < 0.f ? m : v - m;
}

template <class O> struct QuadNet {
    typedef typename O::V V; typedef typename O::B B;
    template <bool ASC> static __device__ __forceinline__ void ce_reg(V& a, V& b) { const V lo = O::vmin(a, b), hi = O::vmax(a, b); a = ASC ? lo : hi; b = ASC ? hi : lo; }
    template <bool ASC> static __device__ __forceinline__ void ce_l1(V& x, B low1) { const V p = O::x1(x); const V mn = O::vmin(p, x), mx = O::vmax(p, x); x = ASC ? O::vsel(low1, mn, mx) : O::vsel(low1, mx, mn); }
    template <bool ASC> static __device__ __forceinline__ void ce_l2(V& x, B low2) { const V p = O::x2(x); const V mn = O::vmin(p, x), mx = O::vmax(p, x); x = ASC ? O::vsel(low2, mn, mx) : O::vsel(low2, mx, mn); }
    template <int NR> static __device__ __forceinline__ void sort_blocks(V (&R)[NR], B low1, B low2, B eq12) {
#pragma unroll
        for (int r = 0; r < NR; ++r) { const V p = O::x1(R[r]); const V mn = O::vmin(p, R[r]), mx = O::vmax(p, R[r]); R[r] = O::vsel(eq12, mn, mx); }
#pragma unroll
        for (int r = 0; r < NR; ++r) { if ((r & 1) == 0) ce_l2<true>(R[r], low2); else ce_l2<false>(R[r], low2); }
#pragma unroll
        for (int r = 0; r < NR; ++r) { if ((r & 1) == 0) ce_l1<true>(R[r], low1); else ce_l1<false>(R[r], low1); }
#pragma unroll
        for (int r = 0; r < NR; r += 2) { if ((r & 2) == 0) ce_reg<true>(R[r], R[r + 1]); else ce_reg<false>(R[r], R[r + 1]); }
#pragma unroll
        for (int r = 0; r < NR; ++r) { if ((r & 2) == 0) ce_l2<true>(R[r], low2); else ce_l2<false>(R[r], low2); }
#pragma unroll
        for (int r = 0; r < NR; ++r) { if ((r & 2) == 0) ce_l1<true>(R[r], low1); else ce_l1<false>(R[r], low1); }
#pragma unroll
        for (int r = 0; r < NR; ++r) { if ((r & 2) == 0) { if ((r & 4) == 0) ce_reg<true>(R[r], R[r + 2]); else ce_reg<false>(R[r], R[r + 2]); } }
#pragma unroll
        for (int r = 0; r < NR; r += 2) { if ((r & 4) == 0) ce_reg<true>(R[r], R[r + 1]); else ce_reg<false>(R[r], R[r + 1]); }
#pragma unroll
        for (int r = 0; r < NR; ++r) { if ((r & 4) == 0) ce_l2<true>(R[r], low2); else ce_l2<false>(R[r], low2); }
#pragma unroll
        for (int r = 0; r < NR; ++r) { if ((r & 4) == 0) ce_l1<true>(R[r], low1); else ce_l1<false>(R[r], low1); }
    }
    template <int NR> static __device__ __forceinline__ void halve_merge(const V (&R)[NR], V (&Q)[NR / 2], B low1, B low2) {
#pragma unroll
        for (int m = 0; m < NR / 8; ++m)
#pragma unroll
            for (int i = 0; i < 4; ++i) Q[4 * m + i] = O::vmax(R[8 * m + i], R[8 * m + 4 + i]);
#pragma unroll
        for (int r = 0; r < NR / 2; ++r) { if ((r & 2) == 0) { if ((r & 4) == 0) ce_reg<false>(Q[r], Q[r + 2]); else ce_reg<true>(Q[r], Q[r + 2]); } }
#pragma unroll
        for (int r = 0; r < NR / 2; r += 2) { if ((r & 4) == 0) ce_reg<false>(Q[r], Q[r + 1]); else ce_reg<true>(Q[r], Q[r + 1]); }
#pragma unroll
        for (int r = 0; r < NR / 2; ++r) { if ((r & 4) == 0) ce_l2<false>(Q[r], low2); else ce_l2<true>(Q[r], low2); }
#pragma unroll
        for (int r = 0; r < NR / 2; ++r) { if ((r & 4) == 0) ce_l1<false>(Q[r], low1); else ce_l1<true>(Q[r], low1); }
    }
    static __device__ __forceinline__ void top16_of_128(V (&R)[32], V (&T)[4], B low1, B low2, B eq12) {
        sort_blocks<32>(R, low1, low2, eq12);
        V A[16]; halve_merge<32>(R, A, low1, low2);
        V Bq[8]; halve_merge<16>(A, Bq, low1, low2);
        halve_merge<8>(Bq, T, low1, low2);
    }
    static __device__ __forceinline__ void top16_of_64(V (&R)[16], V (&T)[4], B low1, B low2, B eq12) {
        sort_blocks<16>(R, low1, low2, eq12);
        V A[8]; halve_merge<16>(R, A, low1, low2);
        halve_merge<8>(A, T, low1, low2);
    }
};

struct DevOps {
    typedef unsigned V; typedef bool B;
    static __device__ __forceinline__ V vmin(V a, V b) { return a < b ? a : b; }
    static __device__ __forceinline__ V vmax(V a, V b) { return a > b ? a : b; }
    static __device__ __forceinline__ V vsel(B m, V a, V b) { return m ? a : b; }
    static __device__ __forceinline__ V x1(V a) { return (V)dpp_i<DPP_XOR1>((int)a); }
    static __device__ __forceinline__ V x2(V a) { return (V)dpp_i<DPP_XOR2>((int)a); }
};
__device__ __forceinline__ void stair_ab(int c, int& a, int& b) {
    if (c < 16) { a = 0; b = c; } else if (c < 24) { a = 1; b = c - 16; } else if (c < 28) { a = 2; b = c - 24; } else if (c < 32) { a = 3; b = c - 28; }
    else if (c < 36) { a = 4; b = c - 32; } else if (c < 40) { a = 5 + ((c - 36) >> 1); b = (c - 36) & 1; } else if (c < 44) { a = 7 + ((c - 40) >> 1); b = (c - 40) & 1; }
    else if (c < 48) { a = 9 + (c - 44); b = 0; } else if (c < 51) { a = 13 + (c - 48); b = 0; } else { a = 2; b = 4; }
}
constexpr int PE_WS = 5120, PE_TAB = 8 * PE_WS;
__device__ __forceinline__ void peer_topk(Frame& F, LAS unsigned char* ws, int t) {
    const int lane = F.lane, sub = lane & 3;
    const bool low1 = (sub & 1) == 0, low2 = (sub & 2) == 0, eq12 = low1 == low2;
    LAS unsigned* S1K = (LAS unsigned*)ws; LAS int* EL = (LAS int*)(ws + 3328); LAS float* GL = (LAS float*)(ws + 3840);
    const LAS unsigned short* TAB = (const LAS unsigned short*)(F.lds + PE_TAB);
    {
        const int L = lane >> 2;
        const float* sp = F.SC() + (size_t)t * D + L * 128 + sub * 4;
        unsigned R[32];
#pragma unroll
        for (int q = 0; q < 8; ++q) { const f32x4 v = *(const f32x4*)(sp + 16 * q);
#pragma unroll
            for (int e = 0; e < 4; ++e) R[4 * q + e] = (ordkey(v[e]) & ~127u) | (unsigned)(127 - (4 * sub + 16 * q + e)); }
        unsigned T[4];
        QuadNet<DevOps>::top16_of_128(R, T, low1, low2, eq12);
#pragma unroll
        for (int r = 0; r < 4; ++r) S1K[L * 16 + 4 * r + sub] = T[r];
    }
    LDS_WAIT(); __builtin_amdgcn_wave_barrier();
    {
        const int hd = (lane >> 2) & 7;
        const LAS unsigned char* la = (const LAS unsigned char*)(S1K + (2 * hd) * 16); const LAS unsigned char* lb = (const LAS unsigned char*)(S1K + (2 * hd + 1) * 16);
        unsigned C[16];
#pragma unroll
        for (int r = 0; r < 13; ++r) { const unsigned ab = TAB[4 * r + sub];
            const unsigned ka = *(const LAS unsigned*)(la + (ab & 255u)), kb = *(const LAS unsigned*)(lb + (ab >> 8));
            const float sum = unordkey(ka & ~127u) + unordkey(kb & ~127u);
            C[r] = (ordkey(sum) & ~63u) | (unsigned)(63 - (4 * r + sub)); }
        C[13] = 0u; C[14] = 0u; C[15] = 0u;
        unsigned W[4];
        QuadNet<DevOps>::top16_of_64(C, W, low1, low2, eq12);
        float sv[4]; int ex[4];
#pragma unroll
        for (int r = 0; r < 4; ++r) { const unsigned ab = TAB[63 - (W[r] & 63u)];
            const unsigned ka = *(const LAS unsigned*)(la + (ab & 255u)), kb = *(const LAS unsigned*)(lb + (ab >> 8));
            ex[r] = (int)(127u - (ka & 127u)) * 128 + (int)(127u - (kb & 127u)); sv[r] = unordkey(W[r] & ~63u); }
        const float mx = dpp_f<0x00>(sv[0]);
        float e4[4], es = 0.f;
#pragma unroll
        for (int r = 0; r < 4; ++r) { e4[r] = __expf(sv[r] - mx); es += e4[r]; }
        es += dpp_f<DPP_XOR1>(es); es += dpp_f<DPP_XOR2>(es);
        const float rd = 1.f / es;
#pragma unroll
        for (int r = 0; r < 4; ++r) { GL[hd * 16 + 4 * r + sub] = e4[r] * rd; EL[hd * 16 + 4 * r + sub] = ex[r]; }
    }
    LDS_WAIT(); __builtin_amdgcn_wave_barrier();
}

#ifndef PROBE_PHASE
#define PROBE_PHASE -1
#endif
#ifndef PROBE_MULT
#define PROBE_MULT 1
#endif
constexpr int EB = 4;
constexpr int CW_TICKET = 20480;

struct GBuf { LpRow<U_FMT> u[EB]; LpRow<V_FMT> v[EB]; float su[EB], sv[EB], g[EB]; };
__device__ __forceinline__ void gather_issue(GBuf& B, const LAS int* EL, const LAS float* GL, int i0, const unsigned char* UTl, const unsigned char* VTl, const float* USl, const float* VSl, int lane) {
#pragma unroll
    for (int q = 0; q < EB; ++q) {
        const int ex = __builtin_amdgcn_readfirstlane(EL[i0 + q]);
        B.g[q] = __uint_as_float(__builtin_amdgcn_readfirstlane(__float_as_uint(GL[i0 + q])));
        B.u[q].load(UTl + (size_t)ex * UROW, lane); B.v[q].load(VTl + (size_t)ex * VROW, lane); B.su[q] = USl[ex]; B.sv[q] = VSl[ex];
    }
}
__device__ __forceinline__ void gather_compute(const GBuf& B, const f32x2 (&hv)[16], f32x2 (&acc)[16]) {
    float dot[EB];
#pragma unroll
    for (int q = 0; q < EB; ++q) { f32x2 s = {0.f, 0.f};
        B.u[q].each([&](int i, float x0, float x1) { const f32x2 x = {x0, x1}; s = __builtin_elementwise_fma(x, hv[i >> 1], s); });
        dot[q] = s.x + s.y; }
#pragma unroll
    for (int q = 0; q < EB; ++q) dot[q] = wave_sum_u(dot[q]);
#pragma unroll
    for (int q = 0; q < EB; ++q) { const float cf = B.g[q] * gelu_as(dot[q] * B.su[q]) * B.sv[q]; const f32x2 c2 = {cf, cf};
        B.v[q].each([&](int i, float x0, float x1) { const f32x2 x = {x0, x1}; acc[i >> 1] = __builtin_elementwise_fma(x, c2, acc[i >> 1]); }); }
}

__device__ __forceinline__ void peer_phase(Frame& F, int layer, int rows, unsigned* ctl, unsigned long long& pr_acc) {
    unsigned long long pt0 = 0ull;
#define SUB_BEGIN(ty) do { if (PROBE_PHASE == (ty)) pt0 = __builtin_amdgcn_s_memrealtime(); } while (0)
#define SUB_END(ty) do { if (PROBE_PHASE == (ty)) pr_acc += __builtin_amdgcn_s_memrealtime() - pt0; } while (0)
    if (F.tid < 64) { int a = 0, b = 0; stair_ab(F.tid < 52 ? F.tid : 0, a, b); *(LAS unsigned short*)(F.lds + PE_TAB + 2 * F.tid) = (unsigned short)((4 * a) | ((4 * b) << 8)); }
    __syncthreads();
    LAS unsigned char* ws = F.lds + F.wave * PE_WS;
    LAS int* EL = (LAS int*)(ws + 3328); LAS float* GL = (LAS float*)(ws + 3840);
    const int lane = F.lane;
    const unsigned char* UTl = F.UT() + (size_t)layer * NEXP * UROW;
    const unsigned char* VTl = F.VT() + (size_t)layer * NEXP * VROW;
    const float* USl = F.US() + (size_t)layer * NEXP; const float* VSl = F.VS() + (size_t)layer * NEXP;
    unsigned* ticket = ctl + CW_TICKET + 64 * layer;
    unsigned tk = 0u;
    if (lane == 0) tk = __hip_atomic_fetch_add(ticket, 1u, __ATOMIC_RELAXED, __HIP_MEMORY_SCOPE_AGENT);
    int t = (int)__builtin_amdgcn_readfirstlane(tk);
    while (t < rows) {
        unsigned tkn = 0u;
        if (lane == 0) tkn = __hip_atomic_fetch_add(ticket, 1u, __ATOMIC_RELAXED, __HIP_MEMORY_SCOPE_AGENT);
        SUB_BEGIN(8); peer_topk(F, ws, t); SUB_END(8);
        SUB_BEGIN(9);
        f32x2 hv[16], acc[16];
#pragma unroll
        for (int q = 0; q < 4; ++q) { const u32x4 w = *(const u32x4*)(F.H() + (size_t)t * D + 32 * lane + 8 * q);
#pragma unroll
            for (int e = 0; e < 4; ++e) { hv[4 * q + e] = (f32x2){bf_lo(w[e]), bf_hi(w[e])}; acc[4 * q + e] = (f32x2){0.f, 0.f}; } }
        {
            GBuf A, B;
            gather_issue(A, EL, GL, 0, UTl, VTl, USl, VSl, lane);
            for (int i0 = 0; i0 < 128; i0 += 2 * EB) {
                gather_issue(B, EL, GL, i0 + EB, UTl, VTl, USl, VSl, lane);
                gather_compute(A, hv, acc);
                if (i0 + 2 * EB < 128) gather_issue(A, EL, GL, i0 + 2 * EB, UTl, VTl, USl, VSl, lane);
                gather_compute(B, hv, acc);
            }
        }
        SUB_END(9); SUB_BEGIN(10);
        const int mr = modrow(t);
        const float* mp = F.MODS() + ((size_t)layer * 3 + mr) * 12288;
        bf16_t* xr = F.X() + (size_t)t * D;
        float rr[32]; float s = 0.f;
#pragma unroll
        for (int q2 = 0; q2 < 4; ++q2) { const u32x4 xw = *(const u32x4*)(xr + 32 * lane + 8 * q2);
#pragma unroll
            for (int h2 = 0; h2 < 2; ++h2) { const int q = 2 * q2 + h2; const int c = 32 * lane + 4 * q; const f32x4 gv = *(const f32x4*)(mp + 5 * D + c);
                const f32x4 xv = {bf_lo(xw[2 * h2]), bf_hi(xw[2 * h2]), bf_lo(xw[2 * h2 + 1]), bf_hi(xw[2 * h2 + 1])};
                const f32x4 av = {acc[2 * q].x, acc[2 * q].y, acc[2 * q + 1].x, acc[2 * q + 1].y};
#pragma unroll
                for (int e = 0; e < 4; ++e) { const float v = DN_ALPHA * xv[e] + gv[e] * av[e]; rr[4 * q + e] = v; s += v; } } }
        const float mean = wave_sum_u(s) * (1.f / D);
        float s2 = 0.f;
#pragma unroll
        for (int i = 0; i < 32; ++i) { rr[i] -= mean; s2 += rr[i] * rr[i]; }
        const float rstd = 1.f / sqrtf(wave_sum_u(s2) * (1.f / D) + LN_EPS);
        const float* g2 = F.ln2_g() + layer * D; const float* b2 = F.ln2_b() + layer * D;
        float s3 = 0.f;
#pragma unroll
        for (int q = 0; q < 8; ++q) { const int c = 32 * lane + 4 * q; const f32x4 gg = *(const f32x4*)(g2 + c), bb = *(const f32x4*)(b2 + c);
            f32x4 xo;
#pragma unroll
            for (int e = 0; e < 4; ++e) { xo[e] = rr[4 * q + e] * rstd * gg[e] + bb[e]; rr[4 * q + e] = xo[e]; s3 += xo[e]; }
            if (layer < NLAYER - 1) { u32x2 o2; o2.x = pk2(xo[0], xo[1]); o2.y = pk2(xo[2], xo[3]); *(u32x2*)(xr + c) = o2; } else if (t < TL) *(f32x4*)(F.out() + (size_t)t * D + c) = xo; }
        if (layer < NLAYER - 1) {
            const float mean2 = wave_sum_u(s3) * (1.f / D);
            float s4 = 0.f;
#pragma unroll
            for (int i = 0; i < 32; ++i) { rr[i] -= mean2; s4 += rr[i] * rr[i]; }
            const float rstd2 = 1.f / sqrtf(wave_sum_u(s4) * (1.f / D) + LN_EPS);
            const float* np = F.MODS() + ((size_t)(layer + 1) * 3 + mr) * 12288;
#pragma unroll
            for (int q2 = 0; q2 < 4; ++q2) { const int c = 32 * lane + 8 * q2; u32x4 w;
#pragma unroll
                for (int q = 0; q < 2; ++q) { const f32x4 sh = *(const f32x4*)(np + c + 4 * q), sc = *(const f32x4*)(np + D + c + 4 * q); const int ri = 8 * q2 + 4 * q;
                    const float y0 = rr[ri] * rstd2 * (1.f + sc[0]) + sh[0], y1 = rr[ri + 1] * rstd2 * (1.f + sc[1]) + sh[1];
                    const float y2 = rr[ri + 2] * rstd2 * (1.f + sc[2]) + sh[2], y3 = rr[ri + 3] * rstd2 * (1.f + sc[3]) + sh[3];
                    w[2 * q] = pk2(y0, y1); w[2 * q + 1] = pk2(y2, y3); }
                *(u32x4*)(F.H() + (size_t)t * D + c) = w; }
        }
        SUB_END(10);
        t = (int)__builtin_amdgcn_readfirstlane(tkn);
    }
#undef SUB_BEGIN
#undef SUB_END
}

__global__ void __launch_bounds__(NWAVES * 64, 2) skel_fwd(Args args) {
    extern __shared__ __attribute__((aligned(16))) unsigned char lds[];
    Frame F;
    F.lds = (LAS unsigned char*)lds;
    F.tid = threadIdx.x; F.lane = F.tid & 63; F.wave = __builtin_amdgcn_readfirstlane(F.tid >> 6);
    F.G = gridDim.x; F.gw = blockIdx.x * NWAVES + F.wave; F.NGW = F.G * NWAVES;
    unsigned char* ws = args.ws;
    F.ka = (const CAS unsigned char*)__builtin_amdgcn_kernarg_segment_ptr();
    for (int u = F.tid; u < (LDS_BYTES - LDSCTL_OFF) / 4; u += NWAVES * 64) ((LAS unsigned*)(F.lds + LDSCTL_OFF))[u] = 0u;
    __syncthreads();
    unsigned* ctl = (unsigned*)(ws + WS_CTL);
    const int lo = args.ph_lo, hi = args.ph_hi;
    XcdBarrier bar; bar.bar = ctl + CW_BAR + args.li * XCD_BAR_WORDS; bar.x = 0; bar.st = nullptr;
    if (hi - lo > 1) bar = xcd_barrier_post(ctl + CW_BAR + args.li * XCD_BAR_WORDS, (volatile LAS unsigned*)(F.lds + MISC_OFF) + 8);
#define IN(k) (lo <= (k) && (k) < hi)
    unsigned long long pr_acc = 0ull, pr_t0 = 0ull;
#define PR_BEGIN(ty) do { if (PROBE_PHASE == (ty)) pr_t0 = __builtin_amdgcn_s_memrealtime(); } while (0)
#define PR_END(ty) do { if (PROBE_PHASE == (ty)) pr_acc += __builtin_amdgcn_s_memrealtime() - pr_t0; } while (0)
#define BOTH(k) (IN(k) && IN((k) + 1))
#define SEAM(k) do { if (BOTH(k)) xcd_barrier(bar); } while (0)

    if (IN(0)) { PR_BEGIN(0); frame_ids(F); p0a_prologue(F); SEAM(0); PR_END(0); }
    if (IN(1)) {
        PR_BEGIN(1); frame_ids(F);
        { pg8::Gemm g{F.KBD(), F.WQR(), 32 * 256, 2048, 256}; pg8::BatchOrder S{F.G, (int)blockIdx.x}; pg8::EpiBf16 E{F.WEFFT(), D};
          pg8::gemm_phase<pg8::EpiBf16, pg8::BatchOrder, false, true>(F.lds, g, S, E); }
        p0b_mod0(F);
        SEAM(1); PR_END(1);
    }
    for (int layer = 0; layer < NLAYER; ++layer) {
        const int pb = 2 + 6 * layer;
        const bool lastl = layer == NLAYER - 1;
        const int rows = lastl ? TL : TT;
        if (IN(pb + 0)) {
            PR_BEGIN(2); frame_ids(F);
            pg8::Gemm g{F.H(), F.WINT() + (size_t)layer * INC * D, TT, INC, D}; pg8::StaticOrder S; S.init(TT, INC, F.G, (int)blockIdx.x);
            pg8::EpiBf16 E{F.PROJ(), INC};
            pg8::gemm_phase<pg8::EpiBf16, pg8::StaticOrder, true, true>(F.lds, g, S, E);
            SEAM(pb + 0); PR_END(2);
        }
        if (IN(pb + 1)) {
            PR_BEGIN(3); frame_ids(F);
            const int nunits = lastl ? 512 : 528;
            { unsigned long long q0 = 0; if (PROBE_PHASE == 11) q0 = __builtin_amdgcn_s_memrealtime();
            { const int bx = (int)blockIdx.x, vcu = (F.G % 8 == 0) ? (bx % 8) * (F.G / 8) + bx / 8 : bx;
              for (int u = vcu; u < nunits; u += F.G) attn_unit(F, layer, u); }
            if (PROBE_PHASE == 11) pr_acc += __builtin_amdgcn_s_memrealtime() - q0; if (PROBE_PHASE == 12) q0 = __builtin_amdgcn_s_memrealtime();
            {
              const int nx = nunits - 2 * F.G; const bool uneven = nx > 0 && nx < F.G;
              const int bx2 = (int)blockIdx.x, vc2 = (F.G % 8 == 0) ? (bx2 % 8) * (F.G / 8) + bx2 / 8 : bx2;
              const int c0 = uneven ? vc2 - nx : vc2, nb = uneven ? F.G - nx : F.G;
              if (c0 >= 0) for (int t = c0 * NWAVES + F.wave; t < rows; t += nb * NWAVES) conv_row(F, layer, t); }
            if (PROBE_PHASE == 12) pr_acc += __builtin_amdgcn_s_memrealtime() - q0; }
            SEAM(pb + 1); PR_END(3);
        }
        if (IN(pb + 2)) {
            PR_BEGIN(4); frame_ids(F);
            pg8::Gemm g{F.MIX(), F.WOUTT() + (size_t)layer * D * D, rows, D, D}; pg8::StaticOrder S; S.init(rows, D, F.G, (int)blockIdx.x);
            pg8::EpiResid E{layer == 0 ? F.x() : nullptr, layer == 0 ? F.ctx() : nullptr, F.X(), F.MODS() + (size_t)layer * 3 * 12288 + 2 * D};
            pg8::gemm_phase<pg8::EpiResid, pg8::StaticOrder, true, true>(F.lds, g, S, E);
            frame_ids(F); convert_in_tail(F, layer, (rows / 256) * (D / 256), 0);
            SEAM(pb + 2); PR_END(4);
        }
        if (IN(pb + 3)) { PR_BEGIN(5); frame_ids(F); ln_phase(F, layer, rows); SEAM(pb + 3); PR_END(5); }
        if (IN(pb + 4)) {
            PR_BEGIN(6); frame_ids(F);
            pg8::Gemm g{F.H(), F.WEFFT() + (size_t)layer * D * D, rows, D, D}; pg8::StaticOrder S; S.init(rows, D, F.G, (int)blockIdx.x);
            pg8::EpiF32 E{F.SC(), D};
            pg8::gemm_phase<pg8::EpiF32, pg8::StaticOrder, true, true>(F.lds, g, S, E);
            frame_ids(F); convert_in_tail(F, layer, (rows / 256) * (D / 256), 1);
            SEAM(pb + 4); PR_END(6);
        }
        if (IN(pb + 5)) { PR_BEGIN(7); frame_ids(F); peer_phase(F, layer, rows, ctl, pr_acc); SEAM(pb + 5); PR_END(7); }
    }
    if (PROBE_PHASE >= 0 && hi - lo > 1) xcd_barrier(bar);
    if (PROBE_PHASE >= 0 && blockIdx.x == 0 && threadIdx.x == 0) { const unsigned long long t1 = __builtin_amdgcn_s_memrealtime() + (unsigned long long)PROBE_MULT * pr_acc; while (__builtin_amdgcn_s_memrealtime() < t1) __builtin_amdgcn_s_sleep(8); }
#undef IN
#undef BOTH
#undef SEAM
}

extern "C" void kernel_launch(void* const* d_in, const int* in_sizes, int n_in, void* d_out, int out_size, void* d_ws, size_t ws_size, hipStream_t stream) {
    static int grid = 0;
    if (grid == 0) {
        if (n_in != 20 || in_sizes[0] != TL * D || out_size != TL * D || ws_size < WS_END) {
            fprintf(stderr, "kernel_launch: unexpected problem shape (n_in %d, in0 %d, out %d, ws %zu, need %zu)\n", n_in, n_in > 0 ? in_sizes[0] : -1, out_size, ws_size, (size_t)WS_END); grid = -1; return; }
        int dev = 0, cus = 0, per_cu = 0;
        if (hipGetDevice(&dev) != hipSuccess || hipDeviceGetAttribute(&cus, hipDeviceAttributeMultiprocessorCount, dev) != hipSuccess) { grid = -1; return; }
        if (hipFuncSetAttribute((const void*)skel_fwd, hipFuncAttributeMaxDynamicSharedMemorySize, LDS_BYTES) != hipSuccess) { fprintf(stderr, "kernel_launch: hipFuncSetAttribute failed\n"); grid = -1; return; }
        if (hipOccupancyMaxActiveBlocksPerMultiprocessor(&per_cu, (const void*)skel_fwd, NWAVES * 64, LDS_BYTES) != hipSuccess || per_cu < 1)
            fprintf(stderr, "kernel_launch: occupancy query reports %d workgroups per CU\n", per_cu);
        (void)hipGetLastError();
        grid = cus;
    }
    if (grid < 0) return;
    if (hipMemsetAsync((char*)d_ws + WS_CTL, 0, CTL_ZERO_BYTES, stream) != hipSuccess) return;
    Args a{};
    for (int i = 0; i < 20; ++i) a.in[i] = (const float*)d_in[i];
    a.out = (float*)d_out; a.ws = (unsigned char*)d_ws; a.pad = 0;
#if MK_N_LAUNCHES == 1
    a.ph_lo = 0; a.ph_hi = NPHASE; a.li = 0;
    hipLaunchKernelGGL(skel_fwd, dim3(grid), dim3(NWAVES * 64), LDS_BYTES, stream, a);
#else
    for (int ph = 0; ph < NPHASE; ++ph) { a.ph_lo = ph; a.ph_hi = ph + 1; a.li = 0;
        hipLaunchKernelGGL(skel_fwd, dim3(grid), dim3(NWAVES * 64), LDS_BYTES, stream, a); }
#endif
}
```

```cpp
#include <hip/hip_runtime.h>
#include <cstdio>
#include <cstdint>

#ifndef MK_N_LAUNCHES
#define MK_N_LAUNCHES 1
#endif

#define LAS __attribute__((address_space(3)))
typedef unsigned short bf16_t;
typedef short bf16x8 __attribute__((ext_vector_type(8)));
typedef short s16x4 __attribute__((ext_vector_type(4)));
typedef float f32x2 __attribute__((ext_vector_type(2)));
typedef float f32x4 __attribute__((ext_vector_type(4)));
typedef float f32x16 __attribute__((ext_vector_type(16)));
typedef unsigned u32x2 __attribute__((ext_vector_type(2)));
typedef unsigned u32x4 __attribute__((ext_vector_type(4)));
typedef __bf16 bf16x2_t __attribute__((ext_vector_type(2)));

constexpr int D = 2048, NB = 2, SEQ = 8192, CTXL = 256, NLAYER = 4;
constexpr int TL = NB * SEQ, TC = NB * CTXL, TT = TL + TC;
constexpr int INC = 4608, OFF_C = 1024, OFF_X = 2048, OFF_Q = 3072, OFF_K = 4096, OFF_V = 4352;
constexpr int NEXP = 16384;
#ifndef U_FMT
#define U_FMT 4
#endif
#ifndef V_FMT
#define V_FMT 4
#endif
constexpr int UROW = D * U_FMT / 8, VROW = D * V_FMT / 8;
constexpr float LN_EPS = 1e-6f;
constexpr float DN_ALPHA = 1.681792830507429f;
constexpr float QSCALE = 0.08838834764831845f * 1.4426950408889634f;
constexpr float LOG2E = 1.4426950408889634f;

constexpr size_t MiB = 1u << 20;
constexpr size_t WS_CTL = 0, CTL_ZERO_BYTES = 1 * MiB;
constexpr size_t WS_MODS = 1 * MiB;
constexpr size_t WS_ROPE = 2 * MiB;
constexpr size_t WS_KBD = 3 * MiB;
constexpr size_t WS_WQR = 8 * MiB;
constexpr size_t WS_WINT = 40 * MiB;
constexpr size_t WS_WOUTT = 112 * MiB;
constexpr size_t WS_WEFFT = 144 * MiB;
constexpr size_t WS_X = 176 * MiB;
constexpr size_t WS_H = 308 * MiB;
constexpr size_t WS_PROJ = 374 * MiB;
constexpr size_t WS_MIX = 523 * MiB;
constexpr size_t WS_SC = 589 * MiB;
constexpr size_t WS_UT = 721 * MiB;
constexpr size_t WS_VT = 849 * MiB;
constexpr size_t WS_US = 977 * MiB;
constexpr size_t WS_VS = 978 * MiB;
constexpr size_t WS_END = 979 * MiB;

constexpr int CW_BAR = 4096;

namespace pg8 {
constexpr int BM = 256, BK = 64, HALF = 128, HTB = HALF * BK * 2, STAGE_BYTES = 8 * HTB, NXCD = 8, WGM = 8;
__host__ __device__ __forceinline__ int lds_byte(int r, int c) { const int st = (r >> 4) * 2 + (c >> 5), rr = r & 15, cc = c & 31, ob = rr * 64 + cc * 2; return st * 1024 + (ob ^ (((ob >> 9) & 1) << 5)); }
__host__ __device__ __forceinline__ void stage_rc(int b, int& R, int& C) { const int st = b / 1024, sb = b % 1024, swz = sb ^ (((sb >> 9) & 1) << 5); R = (st >> 1) * 16 + swz / 64; C = (st & 1) * 32 + (swz % 64) / 2; }
__host__ __device__ __forceinline__ int perm32(int rho) { const int n = rho >> 4, i = rho & 15; return 8 * (i >> 2) + 4 * n + (i & 3); }

struct Unit { int pm, pn; };
struct Gemm { const bf16_t* A; const bf16_t* Bt; int M, N, K; };

struct StaticOrder {
    int nM, nN, nwg, G, c;
    __host__ __device__ void init(int M, int N, int G_, int c_) { nM = M / BM; nN = N / BM; nwg = nM * nN; G = G_; c = c_; }
    __host__ __device__ bool next(int i, Unit& u) const {
        const long L = (long)i * G + c; if (L >= nwg) return false;
        int wgid = (int)L; { const int q = nwg / NXCD, r = nwg % NXCD, xcd = wgid % NXCD, off = wgid / NXCD; wgid = (xcd < r ? xcd * (q + 1) : r * (q + 1) + (xcd - r) * q) + off; }
        const int nig = WGM * nN, gid = wgid / nig, fm = gid * WGM, gsz = (nM - fm) < WGM ? (nM - fm) : WGM;
        u.pm = fm + ((wgid % nig) % gsz); u.pn = (wgid % nig) / gsz; return true;
    }
    __device__ __forceinline__ int btile(const Unit& u) const { return u.pn; }
    __device__ __forceinline__ void a_ready(const Unit&) const {}
    __device__ __forceinline__ void done(const Unit&) const {}
};
struct BatchOrder {
    int G, c;
    __device__ bool next(int i, Unit& u) const { const int L = i * G + c; if (L >= 256) return false; u.pm = L >> 3; u.pn = L & 7; return true; }
    __device__ __forceinline__ int btile(const Unit& u) const { return u.pm * 8 + u.pn; }
    __device__ __forceinline__ void a_ready(const Unit&) const {}
    __device__ __forceinline__ void done(const Unit&) const {}
};

__device__ __forceinline__ unsigned cvt_pk_bf16(float lo, float hi) { f32x2 x = {lo, hi}; bf16x2_t y = __builtin_convertvector(x, bf16x2_t); return __builtin_bit_cast(unsigned, y); }

struct EpiBf16 {
    static constexpr bool PERM = true;
    bf16_t* O; int ldc;
    __device__ __forceinline__ void operator()(const f32x4 (&acc)[2][2][4][2], const Unit& u, int wr, int wc, int fr, int fq) const {
        const int row0 = u.pm * BM + wr * 64 + fr, col0 = u.pn * BM + wc * 32 + 8 * fq;
#pragma unroll
        for (int ai = 0; ai < 2; ++ai)
#pragma unroll
            for (int m = 0; m < 4; ++m) { bf16_t* rowp = O + (size_t)(row0 + ai * HALF + m * 16) * ldc + col0;
#pragma unroll
                for (int bj = 0; bj < 2; ++bj) { const f32x4 v0 = acc[ai][bj][m][0], v1 = acc[ai][bj][m][1];
                    u32x4 w; w.x = cvt_pk_bf16(v0[0], v0[1]); w.y = cvt_pk_bf16(v0[2], v0[3]); w.z = cvt_pk_bf16(v1[0], v1[1]); w.w = cvt_pk_bf16(v1[2], v1[3]);
                    *(u32x4*)(rowp + bj * HALF) = w; } }
    }
};
struct EpiF32 {
    static constexpr bool PERM = false;
    float* C; int ldc;
    __device__ __forceinline__ void operator()(const f32x4 (&acc)[2][2][4][2], const Unit& u, int wr, int wc, int fr, int fq) const {
        const int row0 = u.pm * BM + wr * 64 + fr, col0 = u.pn * BM + wc * 32 + 4 * fq;
#pragma unroll
        for (int ai = 0; ai < 2; ++ai)
#pragma unroll
            for (int m = 0; m < 4; ++m) { float* rowp = C + (size_t)(row0 + ai * HALF + m * 16) * ldc + col0;
#pragma unroll
                for (int bj = 0; bj < 2; ++bj)
#pragma unroll
                    for (int n = 0; n < 2; ++n) *(f32x4*)(rowp + bj * HALF + n * 16) = acc[ai][bj][m][n]; }
    }
};
struct EpiResid {
    static constexpr bool PERM = true;
    const float* x32_lat; const float* x32_ctx;
    bf16_t* X; const float* gate;
    __device__ __forceinline__ void operator()(const f32x4 (&acc)[2][2][4][2], const Unit& u, int wr, int wc, int fr, int fq) const {
        const int rt = u.pm * BM;
        const int mr = rt < TL ? rt / SEQ : 2;
        const int row0 = rt + wr * 64 + fr, col0 = u.pn * BM + wc * 32 + 8 * fq;
        f32x4 gv[2][2];
#pragma unroll
        for (int bj = 0; bj < 2; ++bj)
#pragma unroll
            for (int n = 0; n < 2; ++n) gv[bj][n] = *(const f32x4*)(gate + (size_t)mr * 12288 + col0 + bj * HALF + 4 * n);
#pragma unroll
        for (int ai = 0; ai < 2; ++ai)
#pragma unroll
            for (int m = 0; m < 4; ++m) { const int row = row0 + ai * HALF + m * 16;
#pragma unroll
                for (int bj = 0; bj < 2; ++bj) {
                    f32x4 x0, x1;
                    if (x32_lat) { const float* xp = (row < TL ? x32_lat + (size_t)row * D : x32_ctx + (size_t)(row - TL) * D) + col0 + bj * HALF; x0 = *(const f32x4*)xp; x1 = *(const f32x4*)(xp + 4); }
                    else { const u32x4 w = *(const u32x4*)(X + (size_t)row * D + col0 + bj * HALF);
                        x0 = (f32x4){__uint_as_float(w.x << 16), __uint_as_float(w.x & 0xffff0000u), __uint_as_float(w.y << 16), __uint_as_float(w.y & 0xffff0000u)};
                        x1 = (f32x4){__uint_as_float(w.z << 16), __uint_as_float(w.z & 0xffff0000u), __uint_as_float(w.w << 16), __uint_as_float(w.w & 0xffff0000u)}; }
                    const f32x4 r0 = x0 * DN_ALPHA + gv[bj][0] * acc[ai][bj][m][0], r1 = x1 * DN_ALPHA + gv[bj][1] * acc[ai][bj][m][1];
                    u32x4 o; o.x = cvt_pk_bf16(r0[0], r0[1]); o.y = cvt_pk_bf16(r0[2], r0[3]); o.z = cvt_pk_bf16(r1[0], r1[1]); o.w = cvt_pk_bf16(r1[2], r1[3]);
                    *(u32x4*)(X + (size_t)row * D + col0 + bj * HALF) = o; } }
    }
};

template <class Epi, class Sched, bool ALIGN_EPI = false, bool SP2 = false>
__device__ __forceinline__ void gemm_phase(LAS unsigned char* lds, const Gemm g, const Sched& S, const Epi& E) {
    int tid = threadIdx.x; asm volatile("" : "+v"(tid));
    const int wid = __builtin_amdgcn_readfirstlane(tid >> 6), lane = tid & 63, wr = wid >> 2, wc = wid & 3, fr = lane & 15, fq = lane >> 4;
    const int K = g.K, nt = K / BK;
    unsigned voffA[2], voffB[2];
#pragma unroll
    for (int i = 0; i < 2; ++i) { int R, C; stage_rc(tid * 16 + i * 8192, R, C); const int Rb = Epi::PERM ? ((R & ~31) + perm32(R & 31)) : R;
        voffA[i] = (unsigned)(R * K + C) * 2u; voffB[i] = (unsigned)(Rb * K + C) * 2u; }
    const size_t kstep = (size_t)(BK * 2);
    const size_t hstep = (size_t)HALF * K * 2;
    const size_t tstep = 2 * hstep;
    const unsigned ldsw = (unsigned)wid * 1024u;
    const int aoff = lds_byte(wr * 64 + fr, fq * 8), boff = lds_byte(wc * 32 + fr, fq * 8);
#define PG8_SA(b, h) (((b) * 2 + (h)) * HTB)
#define PG8_SB(b, h) ((4 + (b) * 2 + (h)) * HTB)
#define PG8_STAGE(bufoff, gbase, voff) do { _Pragma("unroll") for (int _i = 0; _i < 2; ++_i) \
        __builtin_amdgcn_global_load_lds((const unsigned*)((const char*)(gbase) + (voff)[_i]), (LAS unsigned*)(lds + (bufoff) + ldsw + _i * 8192), 16, 0, 0); } while (0)
#define PG8_LDA(dst, b, h) do { _Pragma("unroll") for (int m = 0; m < 4; ++m) _Pragma("unroll") for (int k = 0; k < 2; ++k) dst[m][k] = *(const LAS bf16x8*)(lds + PG8_SA(b, h) + aoff + m * 2048 + k * 1024); } while (0)
#define PG8_LDB(dst, b, h) do { _Pragma("unroll") for (int n = 0; n < 2; ++n) _Pragma("unroll") for (int k = 0; k < 2; ++k) dst[n][k] = *(const LAS bf16x8*)(lds + PG8_SB(b, h) + boff + n * 2048 + k * 1024); } while (0)
#define PG8_MMA(ai, bj, At, Bt) do { __builtin_amdgcn_s_setprio(1); _Pragma("unroll") for (int m = 0; m < 4; ++m) _Pragma("unroll") for (int n = 0; n < 2; ++n) _Pragma("unroll") for (int k = 0; k < 2; ++k) \
        acc[ai][bj][m][n] = __builtin_amdgcn_mfma_f32_16x16x32_bf16(Bt[n][k], At[m][k], acc[ai][bj][m][n], 0, 0, 0); __builtin_amdgcn_s_setprio(0); } while (0)
#define PG8_WAIT_V(n) asm volatile("s_waitcnt vmcnt(" #n ")" ::: "memory")
#define PG8_WAIT_L(n) asm volatile("s_waitcnt lgkmcnt(" #n ")" ::: "memory")
#define PG8_BAR __builtin_amdgcn_s_barrier()
#define PG8_SCHED __builtin_amdgcn_sched_barrier(0)
    Unit cur, nxt; int ui = 0;
    if (!S.next(0, cur)) return;
    f32x4 acc[2][2][4][2];
#pragma unroll
    for (int a = 0; a < 2; ++a)
#pragma unroll
        for (int b = 0; b < 2; ++b)
#pragma unroll
            for (int m = 0; m < 4; ++m)
#pragma unroll
                for (int n = 0; n < 2; ++n) acc[a][b][m][n] = (f32x4){0.f, 0.f, 0.f, 0.f};
    bf16x8 At[4][2], B0[2][2], B1[2][2];
    const char* cA = (const char*)g.A + (size_t)cur.pm * tstep; const char* cB = (const char*)g.Bt + (size_t)S.btile(cur) * tstep;
    S.a_ready(cur);
    if constexpr (SP2) {
        PG8_STAGE(PG8_SB(0, 0), cB, voffB); PG8_STAGE(PG8_SB(0, 1), cB + hstep, voffB); PG8_STAGE(PG8_SA(0, 0), cA, voffA); PG8_STAGE(PG8_SA(0, 1), cA + hstep, voffA);
        if (wr == 1) PG8_BAR;
        PG8_WAIT_V(2); PG8_BAR;
        PG8_STAGE(PG8_SB(1, 0), cB + kstep, voffB); PG8_STAGE(PG8_SA(1, 0), cA + kstep, voffA); PG8_STAGE(PG8_SB(1, 1), cB + hstep + kstep, voffB);
        PG8_WAIT_V(6); PG8_BAR;
    } else {
        PG8_STAGE(PG8_SB(0, 0), cB, voffB); PG8_STAGE(PG8_SA(0, 0), cA, voffA); PG8_STAGE(PG8_SB(0, 1), cB + hstep, voffB); PG8_STAGE(PG8_SA(0, 1), cA + hstep, voffA);
        if (wr == 1) PG8_BAR;
        PG8_WAIT_V(4); PG8_BAR;
        PG8_STAGE(PG8_SB(1, 0), cB + kstep, voffB); PG8_STAGE(PG8_SA(1, 0), cA + kstep, voffA); PG8_STAGE(PG8_SB(1, 1), cB + hstep + kstep, voffB);
        PG8_WAIT_V(6); PG8_BAR;
    }
    for (;;) {
        const bool has_next = S.next(ui + 1, nxt);
        const char* nA = has_next ? (const char*)g.A + (size_t)nxt.pm * tstep : cA; const char* nB = has_next ? (const char*)g.Bt + (size_t)S.btile(nxt) * tstep : cB;
        for (int t = 0; t < nt; t += 2) {
            const bool last = (t == nt - 2);
            const char* a1 = cA + (size_t)(t + 1) * kstep;
            const char* a2 = last ? nA : cA + (size_t)(t + 2) * kstep; const char* b2 = last ? nB : cB + (size_t)(t + 2) * kstep;
            const char* a3 = a2 + kstep; const char* b3 = b2 + kstep;
            if (last && has_next) S.a_ready(nxt);
            if constexpr (SP2) {
            PG8_LDB(B0, 0, 0); PG8_LDB(B1, 0, 1); PG8_SCHED; PG8_LDA(At, 0, 0); PG8_STAGE(PG8_SA(1, 1), a1 + hstep, voffA);
            PG8_WAIT_V(8); PG8_WAIT_L(0); PG8_BAR; PG8_MMA(0, 0, At, B0); PG8_MMA(0, 1, At, B1); PG8_BAR; PG8_SCHED;
            PG8_LDA(At, 0, 1); PG8_STAGE(PG8_SB(0, 0), b2, voffB); PG8_STAGE(PG8_SB(0, 1), b2 + hstep, voffB); PG8_STAGE(PG8_SA(0, 0), a2, voffA);
            PG8_WAIT_V(8); PG8_WAIT_L(0); PG8_BAR; PG8_MMA(1, 0, At, B0); PG8_MMA(1, 1, At, B1); PG8_BAR; PG8_SCHED;
            PG8_LDB(B0, 1, 0); PG8_LDB(B1, 1, 1); PG8_SCHED; PG8_LDA(At, 1, 0); PG8_STAGE(PG8_SA(0, 1), a2 + hstep, voffA);
            PG8_WAIT_V(8); PG8_WAIT_L(0); PG8_BAR; PG8_MMA(0, 0, At, B0); PG8_MMA(0, 1, At, B1); PG8_BAR; PG8_SCHED;
            PG8_LDA(At, 1, 1); PG8_STAGE(PG8_SB(1, 0), b3, voffB); PG8_STAGE(PG8_SB(1, 1), b3 + hstep, voffB); PG8_STAGE(PG8_SA(1, 0), a3, voffA);
            PG8_WAIT_V(8); PG8_WAIT_L(0); PG8_BAR; PG8_MMA(1, 0, At, B0); PG8_MMA(1, 1, At, B1); PG8_BAR; PG8_SCHED;
            } else {
            PG8_LDB(B0, 0, 0); PG8_SCHED; PG8_LDA(At, 0, 0); PG8_STAGE(PG8_SA(1, 1), a1 + hstep, voffA);
            PG8_WAIT_L(8); PG8_BAR; PG8_WAIT_L(0); PG8_MMA(0, 0, At, B0); PG8_BAR; PG8_SCHED;
            PG8_LDB(B1, 0, 1); PG8_STAGE(PG8_SB(0, 0), b2, voffB);
            PG8_BAR; PG8_WAIT_L(0); PG8_MMA(0, 1, At, B1); PG8_BAR;
            PG8_LDA(At, 0, 1); PG8_STAGE(PG8_SA(0, 0), a2, voffA);
            PG8_BAR; PG8_WAIT_L(0); PG8_MMA(1, 0, At, B0); PG8_BAR; PG8_SCHED;
            PG8_STAGE(PG8_SB(0, 1), b2 + hstep, voffB);
            PG8_WAIT_V(6); PG8_BAR; PG8_MMA(1, 1, At, B1); PG8_BAR;
            PG8_LDB(B0, 1, 0); PG8_SCHED; PG8_LDA(At, 1, 0); PG8_STAGE(PG8_SA(0, 1), a2 + hstep, voffA);
            PG8_WAIT_L(8); PG8_BAR; PG8_WAIT_L(0); PG8_MMA(0, 0, At, B0); PG8_BAR; PG8_SCHED;
            PG8_LDB(B1, 1, 1); PG8_STAGE(PG8_SB(1, 0), b3, voffB);
            PG8_BAR; PG8_WAIT_L(0); PG8_MMA(0, 1, At, B1); PG8_BAR;
            PG8_LDA(At, 1, 1); PG8_STAGE(PG8_SA(1, 0), a3, voffA);
            PG8_BAR; PG8_WAIT_L(0); PG8_MMA(1, 0, At, B0); PG8_BAR; PG8_SCHED;
            PG8_STAGE(PG8_SB(1, 1), b3 + hstep, voffB);
            PG8_WAIT_V(6); PG8_BAR; PG8_MMA(1, 1, At, B1); PG8_BAR;
            }
        }
        if constexpr (ALIGN_EPI) { if (wr == 0) PG8_BAR; }
        E(acc, cur, wr, wc, fr, fq); S.done(cur);
        if (!has_next) break;
#pragma unroll
        for (int a = 0; a < 2; ++a)
#pragma unroll
            for (int b = 0; b < 2; ++b)
#pragma unroll
                for (int m = 0; m < 4; ++m)
#pragma unroll
                    for (int n = 0; n < 2; ++n) acc[a][b][m][n] = (f32x4){0.f, 0.f, 0.f, 0.f};
        cur = nxt; cA = nA; cB = nB; ++ui;
        if constexpr (ALIGN_EPI) { if (wr == 1) PG8_BAR; }
    }
    PG8_WAIT_V(0);
    if constexpr (!ALIGN_EPI) { if (wr == 0) PG8_BAR; }
    PG8_BAR;
#undef PG8_SA
#undef PG8_SB
#undef PG8_STAGE
#undef PG8_LDA
#undef PG8_LDB
#undef PG8_MMA
#undef PG8_WAIT_V
#undef PG8_WAIT_L
#undef PG8_BAR
#undef PG8_SCHED
}
}

#define XB_TMO      128
#define XB_XCNT(j)  (256  + 64 * (j))
#define XB_XSUB(j)  (1280 + 64 * (j))
#define XB_XGEN(j)  (2304 + 64 * (j))
#define XB_TOP      3328
#define XB_TOPGEN   3392
#define XCD_BAR_WORDS 3456
#define XB_SPIN_CAP (1u << 18)

__device__ __forceinline__ unsigned xb_ld(unsigned* p)              { return __hip_atomic_load(p, __ATOMIC_RELAXED, __HIP_MEMORY_SCOPE_AGENT); }
__device__ __forceinline__ unsigned xb_add(unsigned* p, unsigned v) { return __hip_atomic_fetch_add(p, v, __ATOMIC_RELAXED, __HIP_MEMORY_SCOPE_AGENT); }
__device__ __forceinline__ unsigned xb_xcc_id() { return (unsigned)__builtin_amdgcn_s_getreg((3 << 11) | 20) & 0xFu; }
#define XB_SPIN(cond, bar) do { unsigned _sp = 0; while (cond) { __builtin_amdgcn_s_sleep(1); \
    if ((++_sp & 255u) == 0u) { if (xb_ld(&(bar)[XB_TMO])) break; if (_sp > XB_SPIN_CAP) { atomicAdd(&(bar)[XB_TMO], 1u); break; } } } } while (0)

struct XcdBarrier { unsigned* bar; unsigned x; volatile LAS unsigned* st; };

__device__ __forceinline__ XcdBarrier xcd_barrier_post(unsigned* bar, volatile LAS unsigned* st) {
    XcdBarrier b; b.bar = bar; b.x = xb_xcc_id(); b.st = st;
    if (threadIdx.x == 0) (void)xb_add(&bar[XB_XCNT(b.x)], 1u);
    return b;
}
__device__ __forceinline__ void xcd_barrier_complete(unsigned* bar, unsigned x, unsigned& nloc, unsigned& nx) {
    const unsigned G = gridDim.x * gridDim.y * gridDim.z;
    unsigned sum, cnt, mine, sp = 0u;
    for (;;) {
        sum = 0u; cnt = 0u; mine = 0u;
#pragma unroll
        for (unsigned j = 0; j < 16; ++j) { const unsigned c = xb_ld(&bar[XB_XCNT(j)]); sum += c; cnt += (c > 0u) ? 1u : 0u; mine = (j == x) ? c : mine; }
        if (sum == G) break;
        __builtin_amdgcn_s_sleep(1);
        if ((++sp & 255u) == 0u) { if (xb_ld(&bar[XB_TMO])) break; if (sp > XB_SPIN_CAP) { atomicAdd(&bar[XB_TMO], 1u); break; } }
    }
    nloc = mine > 0u ? mine : 1u; nx = cnt > 0u ? cnt : 1u;
}
__device__ __forceinline__ void xcd_barrier(const XcdBarrier& b) {
    asm volatile("s_waitcnt vmcnt(0)" ::: "memory");
    __syncthreads();
    if (threadIdx.x == 0) {
        unsigned* bar = b.bar;
        __builtin_amdgcn_s_waitcnt(0);
        unsigned nloc = b.st[0], nx = b.st[1];
        if (nloc == 0u) { xcd_barrier_complete(bar, b.x, nloc, nx); b.st[0] = nloc; b.st[1] = nx; }
        const unsigned old = xb_add(&bar[XB_XSUB(b.x)], 1u);
        const unsigned gen = old / nloc;
        if (old + 1u == (gen + 1u) * nloc) {
            __builtin_amdgcn_fence(__ATOMIC_RELEASE, "agent");
            asm volatile("s_waitcnt vmcnt(0)" ::: "memory");
            const unsigned og = xb_add(&bar[XB_TOP], 1u);
            const unsigned tg = og / nx;
            if (og + 1u == (tg + 1u) * nx) xb_add(&bar[XB_TOPGEN], 1u);
            else XB_SPIN(xb_ld(&bar[XB_TOPGEN]) == tg, bar);
            __builtin_amdgcn_fence(__ATOMIC_ACQUIRE, "agent");
            xb_add(&bar[XB_XGEN(b.x)], 1u);
            asm volatile("s_waitcnt vmcnt(0)" ::: "memory");
        } else {
            XB_SPIN(xb_ld(&bar[XB_XGEN(b.x)]) == gen, bar);
            __builtin_amdgcn_fence(__ATOMIC_ACQUIRE, "agent");
            asm volatile("s_waitcnt vmcnt(0)" ::: "memory");
        }
    }
    __syncthreads();
}

constexpr int NWAVES = 8;
constexpr int RING_BYTES = 131072;
constexpr int LDSCTL_OFF = RING_BYTES, MISC_OFF = LDSCTL_OFF + 320;
constexpr int LDS_BYTES = 147456;
constexpr int NPHASE = 2 + 6 * NLAYER;

#define LDS_WAIT() asm volatile("s_waitcnt lgkmcnt(0)" ::: "memory")

struct Args { const float* in[20]; float* out; unsigned char* ws; int ph_lo, ph_hi, li, pad; };

#define CAS __attribute__((address_space(4)))
struct Frame {
    LAS unsigned char* lds;
    int tid, lane, wave, G, gw, NGW;
    const CAS unsigned char* ka;
    __device__ __forceinline__ const float* x() const { return *(const float* const CAS*)(ka + 0); }
    __device__ __forceinline__ const float* c() const { return *(const float* const CAS*)(ka + 8); }
    __device__ __forceinline__ const float* ctx() const { return *(const float* const CAS*)(ka + 16); }
    __device__ __forceinline__ const float* c_ctx() const { return *(const float* const CAS*)(ka + 24); }
    __device__ __forceinline__ const float* w_ada() const { return *(const float* const CAS*)(ka + 32); }
    __device__ __forceinline__ const float* b_ada() const { return *(const float* const CAS*)(ka + 40); }
    __device__ __forceinline__ const float* w_in() const { return *(const float* const CAS*)(ka + 48); }
    __device__ __forceinline__ const float* conv_w() const { return *(const float* const CAS*)(ka + 56); }
    __device__ __forceinline__ const float* sink() const { return *(const float* const CAS*)(ka + 64); }
    __device__ __forceinline__ const float* g_attn() const { return *(const float* const CAS*)(ka + 72); }
    __device__ __forceinline__ const float* g_conv() const { return *(const float* const CAS*)(ka + 80); }
    __device__ __forceinline__ const float* w_out() const { return *(const float* const CAS*)(ka + 88); }
    __device__ __forceinline__ const float* ln1_g() const { return *(const float* const CAS*)(ka + 96); }
    __device__ __forceinline__ const float* ln1_b() const { return *(const float* const CAS*)(ka + 104); }
    __device__ __forceinline__ const float* wq() const { return *(const float* const CAS*)(ka + 112); }
    __device__ __forceinline__ const float* keys() const { return *(const float* const CAS*)(ka + 120); }
    __device__ __forceinline__ const float* pu() const { return *(const float* const CAS*)(ka + 128); }
    __device__ __forceinline__ const float* pv() const { return *(const float* const CAS*)(ka + 136); }
    __device__ __forceinline__ const float* ln2_g() const { return *(const float* const CAS*)(ka + 144); }
    __device__ __forceinline__ const float* ln2_b() const { return *(const float* const CAS*)(ka + 152); }
    __device__ __forceinline__ float* out() const { return *(float* const CAS*)(ka + 160); }
    __device__ __forceinline__ unsigned char* ws() const { return *(unsigned char* const CAS*)(ka + 168); }
    __device__ __forceinline__ float* MODS() const { return (float*)(ws() + WS_MODS); }
    __device__ __forceinline__ float* ROPE() const { return (float*)(ws() + WS_ROPE); }
    __device__ __forceinline__ bf16_t* X() const { return (bf16_t*)(ws() + WS_X); }
    __device__ __forceinline__ float* SC() const { return (float*)(ws() + WS_SC); }
    __device__ __forceinline__ bf16_t* KBD() const { return (bf16_t*)(ws() + WS_KBD); }
    __device__ __forceinline__ bf16_t* WQR() const { return (bf16_t*)(ws() + WS_WQR); }
    __device__ __forceinline__ bf16_t* WINT() const { return (bf16_t*)(ws() + WS_WINT); }
    __device__ __forceinline__ bf16_t* WOUTT() const { return (bf16_t*)(ws() + WS_WOUTT); }
    __device__ __forceinline__ bf16_t* WEFFT() const { return (bf16_t*)(ws() + WS_WEFFT); }
    __device__ __forceinline__ bf16_t* H() const { return (bf16_t*)(ws() + WS_H); }
    __device__ __forceinline__ bf16_t* PROJ() const { return (bf16_t*)(ws() + WS_PROJ); }
    __device__ __forceinline__ bf16_t* MIX() const { return (bf16_t*)(ws() + WS_MIX); }
    __device__ __forceinline__ unsigned char* UT() const { return (unsigned char*)(ws() + WS_UT); }
    __device__ __forceinline__ unsigned char* VT() const { return (unsigned char*)(ws() + WS_VT); }
    __device__ __forceinline__ float* US() const { return (float*)(ws() + WS_US); }
    __device__ __forceinline__ float* VS() const { return (float*)(ws() + WS_VS); }
};

__device__ __forceinline__ void frame_ids(Frame& F) {
    int tz = threadIdx.x; asm volatile("" : "+v"(tz));
    F.tid = tz; F.lane = tz & 63; F.wave = __builtin_amdgcn_readfirstlane(tz >> 6);
    F.gw = blockIdx.x * NWAVES + F.wave;
    const CAS unsigned char* k = (const CAS unsigned char*)__builtin_amdgcn_kernarg_segment_ptr(); asm volatile("" : "+s"(k)); F.ka = k;
}
template <int CTRL> __device__ __forceinline__ int dpp_i(int v) { return __builtin_amdgcn_update_dpp(0, v, CTRL, 0xf, 0xf, true); }
template <int CTRL> __device__ __forceinline__ float dpp_f(float v) { return __int_as_float(dpp_i<CTRL>(__float_as_int(v))); }
constexpr int DPP_XOR1 = 0xB1, DPP_XOR2 = 0x4E, DPP_HMIRROR = 0x141, DPP_ROR4 = 0x124, DPP_ROR8 = 0x128;
__device__ __forceinline__ float wave_sum_u(float v) {
    v += dpp_f<DPP_XOR1>(v); v += dpp_f<DPP_XOR2>(v); v += dpp_f<DPP_ROR4>(v); v += dpp_f<DPP_ROR8>(v);
    const float r0 = __int_as_float(__builtin_amdgcn_readlane(__float_as_int(v), 0)), r1 = __int_as_float(__builtin_amdgcn_readlane(__float_as_int(v), 16));
    const float r2 = __int_as_float(__builtin_amdgcn_readlane(__float_as_int(v), 32)), r3 = __int_as_float(__builtin_amdgcn_readlane(__float_as_int(v), 48));
    return (r0 + r1) + (r2 + r3);
}
__device__ __forceinline__ float wave_max_u(float v) {
    v = fmaxf(v, dpp_f<DPP_XOR1>(v)); v = fmaxf(v, dpp_f<DPP_XOR2>(v)); v = fmaxf(v, dpp_f<DPP_ROR4>(v)); v = fmaxf(v, dpp_f<DPP_ROR8>(v));
    const float r0 = __int_as_float(__builtin_amdgcn_readlane(__float_as_int(v), 0)), r1 = __int_as_float(__builtin_amdgcn_readlane(__float_as_int(v), 16));
    const float r2 = __int_as_float(__builtin_amdgcn_readlane(__float_as_int(v), 32)), r3 = __int_as_float(__builtin_amdgcn_readlane(__float_as_int(v), 48));
    return fmaxf(fmaxf(r0, r1), fmaxf(r2, r3));
}
__device__ __forceinline__ float xor32_f(float v, int lane) { return __int_as_float(__builtin_amdgcn_ds_bpermute((lane ^ 32) << 2, __float_as_int(v))); }
__device__ __forceinline__ float wave_sum(float v) { return wave_sum_u(v); }
__device__ __forceinline__ unsigned pk2(float lo, float hi) { return pg8::cvt_pk_bf16(lo, hi); }
__device__ __forceinline__ float bf_lo(unsigned u) { return __uint_as_float(u << 16); }
__device__ __forceinline__ float bf_hi(unsigned u) { return __uint_as_float(u & 0xffff0000u); }
__device__ __forceinline__ int modrow(int t) { return t < TL ? t / SEQ : 2; }

__device__ __forceinline__ void transpose_item(const float* W, int K, int N, bf16_t* WT, LAS float* scr, int item, int lane) {
    const int nblk = N / 32, kb = item / nblk, nb = item % nblk, k0 = 64 * kb, n0 = 32 * nb;
#pragma unroll 8
    for (int i = 0; i < 32; ++i) { const int kk = 2 * i + (lane >> 5); scr[kk * 33 + (lane & 31)] = W[(size_t)(k0 + kk) * N + n0 + (lane & 31)]; }
    LDS_WAIT(); asm volatile("" ::: "memory");
    const int c = lane & 7;
#pragma unroll
    for (int j = 0; j < 4; ++j) { const int n = (lane >> 3) + 8 * j; const LAS float* s = scr + (8 * c) * 33 + n;
        u32x4 o; o.x = pk2(s[0 * 33], s[1 * 33]); o.y = pk2(s[2 * 33], s[3 * 33]); o.z = pk2(s[4 * 33], s[5 * 33]); o.w = pk2(s[6 * 33], s[7 * 33]);
        *(u32x4*)(WT + (size_t)(n0 + n) * K + k0 + 8 * c) = o; }
    LDS_WAIT(); asm volatile("" ::: "memory");
}

__device__ __forceinline__ void cvt_row_bf16(const float* src, bf16_t* dst, int lane) {
    const f32x4* s = (const f32x4*)src + lane; u32x2* d = (u32x2*)dst + lane;
    f32x4 v[8];
#pragma unroll
    for (int j = 0; j < 8; ++j) v[j] = __builtin_nontemporal_load(s + 64 * j);
#pragma unroll
    for (int j = 0; j < 8; ++j) { u32x2 o; o.x = pk2(v[j].x, v[j].y); o.y = pk2(v[j].z, v[j].w); d[64 * j] = o; }
}

struct RowF32 { f32x4 v[4][2]; };
__device__ __forceinline__ void row_load_nt(RowF32& R, const float* src, int lane) {
    const f32x4* s = (const f32x4*)src + 2 * lane;
#pragma unroll
    for (int j = 0; j < 4; ++j) { R.v[j][0] = __builtin_nontemporal_load(s + 128 * j); R.v[j][1] = __builtin_nontemporal_load(s + 128 * j + 1); }
}
template <int FMT>
__device__ __forceinline__ void cvt_row_lp(const RowF32& R, unsigned char* dst, float* inv, int lane) {
    constexpr float QMAX = FMT == 8 ? 224.f : 6.f;
    float am = 0.f;
#pragma unroll
    for (int j = 0; j < 4; ++j)
#pragma unroll
        for (int q = 0; q < 2; ++q) am = fmaxf(fmaxf(am, fmaxf(fabsf(R.v[j][q].x), fabsf(R.v[j][q].y))), fmaxf(fabsf(R.v[j][q].z), fabsf(R.v[j][q].w)));
    am = wave_max_u(am);
    const float sc = am > 0.f ? QMAX / am : 1.f;
#pragma unroll
    for (int j = 0; j < 4; ++j) {
        if constexpr (FMT == 8) {
            u32x2 w;
#pragma unroll
            for (int q = 0; q < 2; ++q) { int t = __builtin_amdgcn_cvt_pk_fp8_f32(R.v[j][q].x * sc, R.v[j][q].y * sc, 0, false); t = __builtin_amdgcn_cvt_pk_fp8_f32(R.v[j][q].z * sc, R.v[j][q].w * sc, t, true); w[q] = (unsigned)t; }
            *((u32x2*)dst + lane + 64 * j) = w;
        } else {
            unsigned w = 0u;
            w = __builtin_amdgcn_cvt_scalef32_pk_fp4_f32(w, R.v[j][0].x * sc, R.v[j][0].y * sc, 1.0f, 0);
            w = __builtin_amdgcn_cvt_scalef32_pk_fp4_f32(w, R.v[j][0].z * sc, R.v[j][0].w * sc, 1.0f, 1);
            w = __builtin_amdgcn_cvt_scalef32_pk_fp4_f32(w, R.v[j][1].x * sc, R.v[j][1].y * sc, 1.0f, 2);
            w = __builtin_amdgcn_cvt_scalef32_pk_fp4_f32(w, R.v[j][1].z * sc, R.v[j][1].w * sc, 1.0f, 3);
            *((unsigned*)dst + lane + 64 * j) = w;
        }
    }
    if (lane == 0) *inv = am > 0.f ? am * (1.f / QMAX) : 1.f;
}
template <int FMT> struct LpRow;
template <> struct LpRow<8> { u32x4 a, b;
    __device__ __forceinline__ void load(const unsigned char* rowp, int lane) { a = *(const u32x4*)(rowp + 32 * lane); b = *(const u32x4*)(rowp + 32 * lane + 16); }
    template <class Fn> __device__ __forceinline__ void each(Fn&& f) const {
#pragma unroll
        for (int w = 0; w < 4; ++w) { const f32x2 l0 = __builtin_amdgcn_cvt_pk_f32_fp8((int)a[w], false), h0 = __builtin_amdgcn_cvt_pk_f32_fp8((int)a[w], true);
            f(4 * w, l0.x, l0.y); f(4 * w + 2, h0.x, h0.y); }
#pragma unroll
        for (int w = 0; w < 4; ++w) { const f32x2 l0 = __builtin_amdgcn_cvt_pk_f32_fp8((int)b[w], false), h0 = __builtin_amdgcn_cvt_pk_f32_fp8((int)b[w], true);
            f(16 + 4 * w, l0.x, l0.y); f(16 + 4 * w + 2, h0.x, h0.y); }
    } };
template <> struct LpRow<4> { u32x4 a;
    __device__ __forceinline__ void load(const unsigned char* rowp, int lane) { a = *(const u32x4*)(rowp + 16 * lane); }
    template <class Fn> __device__ __forceinline__ void each(Fn&& f) const {
#pragma unroll
        for (int w = 0; w < 4; ++w) {
            const f32x2 d0 = __builtin_amdgcn_cvt_scalef32_pk_f32_fp4(a[w], 1.0f, 0), d1 = __builtin_amdgcn_cvt_scalef32_pk_f32_fp4(a[w], 1.0f, 1);
            const f32x2 d2 = __builtin_amdgcn_cvt_scalef32_pk_f32_fp4(a[w], 1.0f, 2), d3 = __builtin_amdgcn_cvt_scalef32_pk_f32_fp4(a[w], 1.0f, 3);
            f(8 * w, d0.x, d0.y); f(8 * w + 2, d1.x, d1.y); f(8 * w + 4, d2.x, d2.y); f(8 * w + 6, d3.x, d3.y); }
    }
    template <class Fn> __device__ __forceinline__ void each_bf(Fn&& f) const {
#pragma unroll
        for (int w = 0; w < 4; ++w) {
            f(4 * w, __builtin_amdgcn_cvt_scalef32_pk_bf16_fp4(a[w], 1.0f, 0)); f(4 * w + 1, __builtin_amdgcn_cvt_scalef32_pk_bf16_fp4(a[w], 1.0f, 1));
            f(4 * w + 2, __builtin_amdgcn_cvt_scalef32_pk_bf16_fp4(a[w], 1.0f, 2)); f(4 * w + 3, __builtin_amdgcn_cvt_scalef32_pk_bf16_fp4(a[w], 1.0f, 3)); }
    } };

__device__ __forceinline__ void row_stats(const f32x4 (&v)[8], float& mean, float& rstd) {
    float s = 0.f;
#pragma unroll
    for (int j = 0; j < 8; ++j) s += (v[j].x + v[j].y) + (v[j].z + v[j].w);
    mean = wave_sum(s) * (1.f / D);
    float s2 = 0.f;
#pragma unroll
    for (int j = 0; j < 8; ++j) { const f32x4 d = v[j] - mean; s2 += (d.x * d.x + d.y * d.y) + (d.z * d.z + d.w * d.w); }
    rstd = 1.f / sqrtf(wave_sum(s2) * (1.f / D) + LN_EPS);
}
__device__ __forceinline__ void modulate_store(const f32x4 (&v)[8], const float* shift, const float* scale, bf16_t* dst, int lane) {
    float mean, rstd; row_stats(v, mean, rstd);
    u32x2* d = (u32x2*)dst + lane;
#pragma unroll
    for (int j = 0; j < 8; ++j) { const f32x4 sc = *((const f32x4*)scale + lane + 64 * j), sh = *((const f32x4*)shift + lane + 64 * j);
        const f32x4 y = (v[j] - mean) * rstd * (sc + 1.f) + sh;
        u32x2 o; o.x = pk2(y.x, y.y); o.y = pk2(y.z, y.w); d[64 * j] = o; }
}

__device__ __forceinline__ void convert_tables(Frame& F, int row0, int row1, int w0, int wstride) {
    RowF32 ru, rv, nu, nv;
    int row = row0 + w0;
    if (row < row1) { row_load_nt(ru, F.pu() + (size_t)row * D, F.lane); row_load_nt(rv, F.pv() + (size_t)row * D, F.lane); }
    while (row < row1) {
        const int nrow = row + wstride;
        if (nrow < row1) { row_load_nt(nu, F.pu() + (size_t)nrow * D, F.lane); row_load_nt(nv, F.pv() + (size_t)nrow * D, F.lane); }
        cvt_row_lp<U_FMT>(ru, F.UT() + (size_t)row * UROW, F.US() + row, F.lane);
        cvt_row_lp<V_FMT>(rv, F.VT() + (size_t)row * VROW, F.VS() + row, F.lane);
        ru = nu; rv = nv; row = nrow;
    }
}
__device__ __forceinline__ void convert_in_tail(Frame& F, int layer, int nunits, int part) {
    if (layer + 1 >= NLAYER) return;
    const int G = F.G, rounds = (nunits + G - 1) / G, nlast = nunits - (rounds - 1) * G;
    const int c = (int)blockIdx.x;
    int nshort = G - nlast, sidx = c - nlast;
    if (nshort <= 0) { nshort = G; sidx = c; }
    else if (sidx < 0) return;
    const int r0 = (layer + 1) * NEXP + part * (NEXP / 2);
    convert_tables(F, r0, r0 + NEXP / 2, sidx * NWAVES + F.wave, nshort * NWAVES);
}
__device__ __forceinline__ void p0a_prologue(Frame& F) {
    LAS float* condL = (LAS float*)F.lds;
    LAS float* red = (LAS float*)(F.lds + 24576);
    for (int i = F.tid; i < 3 * D; i += NWAVES * 64) { const int r = i / D, k = i % D; const float v = r < 2 ? F.c()[r * D + k] : F.c_ctx()[k]; condL[i] = v / (1.f + __expf(-v)); }
    __syncthreads();
    for (int item = blockIdx.x; item < 384; item += F.G) {
        const int l = item / 96, n0 = (item % 96) * 128;
        const float* wp = F.w_ada() + ((size_t)l * D + F.wave * 256) * 12288 + n0 + 2 * F.lane;
        f32x2 a0 = {0.f, 0.f}, a1 = {0.f, 0.f}, a2 = {0.f, 0.f};
#pragma unroll 8
        for (int k = 0; k < 256; ++k) { const f32x2 w = __builtin_nontemporal_load((const f32x2*)(wp + (size_t)k * 12288)); const int kk = F.wave * 256 + k;
            a0 += w * condL[kk]; a1 += w * condL[D + kk]; a2 += w * condL[2 * D + kk]; }
        LAS float* rp = red + F.wave * 384 + 2 * F.lane;
        rp[0] = a0.x; rp[1] = a0.y; rp[128] = a1.x; rp[129] = a1.y; rp[256] = a2.x; rp[257] = a2.y;
        __syncthreads();
        if (F.tid < 384) { const int r = F.tid / 128, n = F.tid % 128; float s = 0.f;
#pragma unroll
            for (int w = 0; w < 8; ++w) s += red[w * 384 + r * 128 + n];
            F.MODS()[((size_t)l * 3 + r) * 12288 + n0 + n] = s + F.b_ada()[(size_t)l * 12288 + n0 + n]; }
        __syncthreads();
    }
    LAS float* scr = (LAS float*)(F.lds + 40960 + F.wave * 8448);
    constexpr int I_IN = (D / 64) * (INC / 32), I_OUT = (D / 64) * (D / 32);
    for (int it = F.gw; it < NLAYER * (I_IN + I_OUT); it += F.NGW) {
        const int l = it / (I_IN + I_OUT); int r = it % (I_IN + I_OUT);
        if (r < I_IN) transpose_item(F.w_in() + (size_t)l * D * INC, D, INC, F.WINT() + (size_t)l * INC * D, scr, r, F.lane);
        else transpose_item(F.w_out() + (size_t)l * D * D, D, D, F.WOUTT() + (size_t)l * D * D, scr, r - I_IN, F.lane);
    }
    for (int row = F.gw; row < NLAYER * D; row += F.NGW) {
        const int l = row / D, c = row % D; const f32x4* s = (const f32x4*)(F.wq() + (size_t)row * D) + F.lane;
#pragma unroll
        for (int j = 0; j < 8; ++j) { const f32x4 v = s[64 * j]; u32x2 o; o.x = pk2(v.x, v.y); o.y = pk2(v.z, v.w);
            *((u32x2*)(F.WQR() + ((size_t)(l * 8 + j) * D + c) * 256) + F.lane) = o; }
    }
    for (int row = F.gw; row < 32 * 256; row += F.NGW) {
        const int lh = row >> 8, pk = row & 255, p = pk >> 7;
        u32x2 o = {0u, 0u};
        if ((F.lane >> 5) == p) { const f32x4 v = *((const f32x4*)(F.keys() + ((size_t)lh * 256 + pk) * 128) + (F.lane & 31)); o.x = pk2(v.x, v.y); o.y = pk2(v.z, v.w); }
        *((u32x2*)(F.KBD() + (size_t)row * 256) + F.lane) = o;
    }
    convert_tables(F, 0, NEXP, F.gw, F.NGW);
    for (int i = blockIdx.x * (NWAVES * 64) + F.tid; i < 192 * 32; i += F.G * NWAVES * 64) {
        const int idx = i >> 5, f = i & 31; const float pos = (float)(idx < 128 ? idx : idx - 128);
        const float inv = powf(10000.f, -(float)(2 * f) / 64.f); const float ang = pos * inv;
        F.ROPE()[2 * i] = cosf(ang); F.ROPE()[2 * i + 1] = sinf(ang);
    }
}

__device__ __forceinline__ void p0b_mod0(Frame& F) {
    for (int t = F.gw; t < TT; t += F.NGW) {
        const float* src = t < TL ? F.x() + (size_t)t * D : F.ctx() + (size_t)(t - TL) * D;
        f32x4 v[8];
#pragma unroll
        for (int j = 0; j < 8; ++j) v[j] = *((const f32x4*)src + F.lane + 64 * j);
        const float* mp = F.MODS() + (size_t)modrow(t) * 12288;
        modulate_store(v, mp, mp + D, F.H() + (size_t)t * D, F.lane);
    }
}

constexpr int KP = 272, VP = 320, KS_BYTES = 64 * KP, VS_BYTES = 64 * VP;
struct KVRegs { u32x4 k1, k2, v1, v2; f32x4 cs[4]; };

__device__ __forceinline__ void attn_load_tile(Frame& F, KVRegs& R, int ti, int b, int n, int g) {
    const int key = F.tid >> 3, c8 = F.tid & 7;
    int row, pos = 0;
    if (ti < 6) { pos = (n - 1) * 128 + 64 * ti + key; row = b * SEQ + pos; } else row = TL + b * CTXL + 64 * (ti - 6) + key;
    const bf16_t* base = F.PROJ() + (size_t)row * INC;
    const int d1 = (c8 >> 2) * 64 + (c8 & 3) * 8;
    R.k1 = *(const u32x4*)(base + OFF_K + g * 128 + d1); R.k2 = *(const u32x4*)(base + OFF_K + g * 128 + d1 + 32);
    R.v1 = *(const u32x4*)(base + OFF_V + g * 128 + 8 * c8); R.v2 = *(const u32x4*)(base + OFF_V + g * 128 + 64 + 8 * c8);
    if (ti < 6) { const int tidx = (c8 >> 2) ? 128 + (pos & 63) : (pos >> 6); const f32x4* cp = (const f32x4*)(F.ROPE() + ((size_t)tidx * 32 + (c8 & 3) * 8) * 2);
#pragma unroll
        for (int m = 0; m < 4; ++m) R.cs[m] = cp[m]; }
}
__device__ __forceinline__ void rope8(u32x4& a, u32x4& bq, const f32x4 (&cs)[4], float scale) {
    u32x4 oa, ob;
#pragma unroll
    for (int w = 0; w < 4; ++w) {
        const float x1l = bf_lo(a[w]), x1h = bf_hi(a[w]), x2l = bf_lo(bq[w]), x2h = bf_hi(bq[w]);
        const float cl = cs[w].x, sl = cs[w].y, ch = cs[w].z, sh = cs[w].w;
        oa[w] = pk2((x1l * cl - x2l * sl) * scale, (x1h * ch - x2h * sh) * scale);
        ob[w] = pk2((x2l * cl + x1l * sl) * scale, (x2h * ch + x1h * sh) * scale);
    }
    a = oa; bq = ob;
}
__device__ __forceinline__ void attn_store_tile(Frame& F, KVRegs& R, int ti, int buf) {
    const int key = F.tid >> 3, c8 = F.tid & 7;
    if (ti < 6) rope8(R.k1, R.k2, R.cs, 1.f);
    const int d1 = (c8 >> 2) * 64 + (c8 & 3) * 8;
    LAS unsigned char* kp = F.lds + buf * KS_BYTES + key * KP;
    *(LAS u32x4*)(kp + d1 * 2) = R.k1; *(LAS u32x4*)(kp + (d1 + 32) * 2) = R.k2;
    LAS unsigned char* vp = F.lds + 2 * KS_BYTES + buf * VS_BYTES + key * VP;
    *(LAS u32x4*)(vp + 16 * c8) = R.v1; *(LAS u32x4*)(vp + 128 + 16 * c8) = R.v2;
}

#define MFMA32(a, b, c) __builtin_amdgcn_mfma_f32_32x32x16_bf16((a), (b), (c), 0, 0, 0)

__device__ __forceinline__ void attn_unit(Frame& F, int layer, int u) {
    const bool latent = u < 512;
    int b, n, g, hp;
    if (latent) { hp = u & 1; g = (u >> 1) & 1; n = (u >> 2) & 63; b = u >> 8; }
    else { const int v = u - 512; hp = v & 1; g = (v >> 1) & 1; n = (v >> 2) & 1; b = v >> 3; }
    const int lane = F.lane, r = lane & 31, h = lane >> 5, wave = F.wave;
    const int head = g * 4 + hp * 2 + (wave >> 2), qb = wave & 3;
    const int tq = latent ? b * SEQ + n * 128 + 32 * qb + r : TL + b * CTXL + n * 128 + 32 * qb + r;
    bf16x8 qf[8];
    {
        u32x4 raw[8];
        const bf16_t* qp = F.PROJ() + (size_t)tq * INC + OFF_Q + head * 128 + 8 * h;
#pragma unroll
        for (int ks = 0; ks < 8; ++ks) raw[ks] = *(const u32x4*)(qp + 16 * ks);
        if (latent) {
            const int pos = n * 128 + 32 * qb + r;
#pragma unroll
            for (int half = 0; half < 2; ++half) {
                const int tidx = half ? 128 + (pos & 63) : (pos >> 6);
#pragma unroll
                for (int kk = 0; kk < 2; ++kk) {
                    const f32x4* cp = (const f32x4*)(F.ROPE() + ((size_t)tidx * 32 + 16 * kk + 8 * h) * 2);
                    f32x4 cs[4];
#pragma unroll
                    for (int m = 0; m < 4; ++m) cs[m] = cp[m];
                    rope8(raw[4 * half + kk], raw[4 * half + kk + 2], cs, QSCALE);
                }
            }
        } else {
#pragma unroll
            for (int ks = 0; ks < 8; ++ks)
#pragma unroll
                for (int w = 0; w < 4; ++w) raw[ks][w] = pk2(bf_lo(raw[ks][w]) * QSCALE, bf_hi(raw[ks][w]) * QSCALE);
        }
#pragma unroll
        for (int ks = 0; ks < 8; ++ks) qf[ks] = __builtin_bit_cast(bf16x8, raw[ks]);
    }
    int tlo = 6, nw = 0;
    if (latent) { tlo = (n == 0) ? 2 : 0; const int thi = (n == 63) ? 3 : 5; nw = thi - tlo + 1; }
    const int ntiles = nw + 4;
    f32x16 o[4];
#pragma unroll
    for (int db = 0; db < 4; ++db)
#pragma unroll
        for (int i = 0; i < 16; ++i) o[db][i] = 0.f;
    float m_run = F.sink()[layer * 8 + head] * LOG2E;
    float lsum = h == 0 ? 1.f : 0.f;
    const int iq = 32 * qb + r;
    KVRegs R;
    __syncthreads();
    attn_load_tile(F, R, nw > 0 ? tlo : 6, b, n, g);
    attn_store_tile(F, R, nw > 0 ? tlo : 6, 0);
    __syncthreads();
    const int i16 = lane & 15, tq4 = i16 >> 2, tp = i16 & 3, blk = (lane >> 4) & 1;
    for (int j = 0; j < ntiles; ++j) {
        const int ti = j < nw ? tlo + j : 6 + (j - nw);
        const int buf = j & 1;
        const bool more = j + 1 < ntiles;
        const int tin = (j + 1) < nw ? tlo + j + 1 : 6 + (j + 1 - nw);
        if (more) attn_load_tile(F, R, tin, b, n, g);
        const bool part = ti >= 6 || (ti >= (qb >> 1) && ti <= (qb >> 1) + 4);
        if (part) {
            f32x16 s0, s1;
#pragma unroll
            for (int i = 0; i < 16; ++i) { s0[i] = 0.f; s1[i] = 0.f; }
            const LAS unsigned char* kb = F.lds + buf * KS_BYTES + r * KP + h * 16;
#pragma unroll
            for (int ks = 0; ks < 8; ++ks) {
                const bf16x8 a0 = *(const LAS bf16x8*)(kb + ks * 32), a1 = *(const LAS bf16x8*)(kb + 32 * KP + ks * 32);
                s0 = MFMA32(a0, qf[ks], s0); s1 = MFMA32(a1, qf[ks], s1);
            }
            float mx = -INFINITY;
            if (ti < 6 && (ti == (qb >> 1) || ti == (qb >> 1) + 4)) {
                const int jb = 64 * ti + 4 * h - iq;
#pragma unroll
                for (int i = 0; i < 16; ++i) { const int j0 = jb + (i & 3) + 8 * (i >> 2), j1 = j0 + 32;
                    s0[i] = (j0 >= 0 && j0 <= 256) ? s0[i] : -INFINITY; s1[i] = (j1 >= 0 && j1 <= 256) ? s1[i] : -INFINITY; }
            }
#pragma unroll
            for (int i = 0; i < 16; ++i) mx = fmaxf(mx, fmaxf(s0[i], s1[i]));
            mx = fmaxf(mx, xor32_f(mx, lane));
            if (__any(mx > m_run + 8.f)) {
                const float m_new = mx > m_run + 8.f ? mx : m_run, alpha = __builtin_amdgcn_exp2f(m_run - m_new);
                m_run = m_new; lsum *= alpha;
#pragma unroll
                for (int db = 0; db < 4; ++db)
#pragma unroll
                    for (int i = 0; i < 16; ++i) o[db][i] *= alpha;
            }
#pragma unroll
            for (int i = 0; i < 16; ++i) { s0[i] = __builtin_amdgcn_exp2f(s0[i] - m_run); s1[i] = __builtin_amdgcn_exp2f(s1[i] - m_run); lsum += s0[i] + s1[i]; }
            bf16x8 pf[2][2];
#pragma unroll
            for (int s2 = 0; s2 < 2; ++s2) {
                u32x4 p0, p1;
#pragma unroll
                for (int w = 0; w < 4; ++w) { p0[w] = pk2(s0[8 * s2 + 2 * w], s0[8 * s2 + 2 * w + 1]); p1[w] = pk2(s1[8 * s2 + 2 * w], s1[8 * s2 + 2 * w + 1]); }
                pf[0][s2] = __builtin_bit_cast(bf16x8, p0); pf[1][s2] = __builtin_bit_cast(bf16x8, p1);
            }
            const LAS unsigned char* vb = F.lds + 2 * KS_BYTES + buf * VS_BYTES + (4 * h + tq4) * VP + 32 * blk + 8 * tp;
#pragma unroll
            for (int db = 0; db < 4; ++db)
#pragma unroll
                for (int kb2 = 0; kb2 < 2; ++kb2)
#pragma unroll
                    for (int s2 = 0; s2 < 2; ++s2) {
                        const int off = (32 * kb2 + 16 * s2) * VP + db * 64;
                        const s16x4 lo = __builtin_amdgcn_ds_read_tr16_b64_v4i16((LAS s16x4*)(vb + off));
                        const s16x4 hi = __builtin_amdgcn_ds_read_tr16_b64_v4i16((LAS s16x4*)(vb + off + 8 * VP));
                        const bf16x8 av = __builtin_shufflevector(lo, hi, 0, 1, 2, 3, 4, 5, 6, 7);
                        o[db] = MFMA32(av, pf[kb2][s2], o[db]);
                    }
        }
        if (more) attn_store_tile(F, R, tin, buf ^ 1);
        __syncthreads();
    }
    const float lt = lsum + xor32_f(lsum, lane);
    const float inv = 1.f / lt;
    float ss = 0.f;
#pragma unroll
    for (int db = 0; db < 4; ++db)
#pragma unroll
        for (int i = 0; i < 16; ++i) { o[db][i] *= inv; ss += o[db][i] * o[db][i]; }
    ss += xor32_f(ss, lane);
    const float rn = 1.f / sqrtf(ss * (1.f / 128.f) + LN_EPS);
    bf16_t* op = F.MIX() + (size_t)tq * D + head * 128 + 4 * h;
    const float* gp = F.g_attn() + layer * 1024 + head * 128 + 4 * h;
#pragma unroll
    for (int db = 0; db < 4; ++db)
#pragma unroll
        for (int g4 = 0; g4 < 4; ++g4) {
            const f32x4 gv = *(const f32x4*)(gp + 32 * db + 8 * g4);
            u32x2 w; w.x = pk2(o[db][4 * g4] * rn * gv.x, o[db][4 * g4 + 1] * rn * gv.y); w.y = pk2(o[db][4 * g4 + 2] * rn * gv.z, o[db][4 * g4 + 3] * rn * gv.w);
            *(u32x2*)(op + 32 * db + 8 * g4) = w;
        }
}

__device__ __forceinline__ void unpack8(const u32x4 v, float (&f)[8]) {
#pragma unroll
    for (int w = 0; w < 4; ++w) { f[2 * w] = bf_lo(v[w]); f[2 * w + 1] = bf_hi(v[w]); }
}
__device__ __forceinline__ void conv_row(Frame& F, int layer, int t) {
    bool first, last;
    if (t < TL) { const int pos = t & (SEQ - 1); first = pos == 0; last = pos == SEQ - 1; } else { const int pc = (t - TL) & (CTXL - 1); first = pc == 0; last = pc == CTXL - 1; }
    const bf16_t* p = F.PROJ() + (size_t)t * INC;
    const float* cw = F.conv_w() + (size_t)layer * 3 * 1024;
#pragma unroll
    for (int jc = 0; jc < 2; ++jc) {
        const int c = 8 * F.lane + 512 * jc;
        float gb[8], a[8], bq[8], um[8], ut[8], up[8];
        unpack8(*(const u32x4*)(p + c), gb);
        unpack8(*(const u32x4*)(p + OFF_C + c), a); unpack8(*(const u32x4*)(p + OFF_X + c), bq);
#pragma unroll
        for (int e = 0; e < 8; ++e) ut[e] = a[e] * bq[e];
        if (!first) { unpack8(*(const u32x4*)(p - INC + OFF_C + c), a); unpack8(*(const u32x4*)(p - INC + OFF_X + c), bq);
#pragma unroll
            for (int e = 0; e < 8; ++e) um[e] = a[e] * bq[e]; }
        else {
#pragma unroll
            for (int e = 0; e < 8; ++e) um[e] = 0.f; }
        if (!last) { unpack8(*(const u32x4*)(p + INC + OFF_C + c), a); unpack8(*(const u32x4*)(p + INC + OFF_X + c), bq);
#pragma unroll
            for (int e = 0; e < 8; ++e) up[e] = a[e] * bq[e]; }
        else {
#pragma unroll
            for (int e = 0; e < 8; ++e) up[e] = 0.f; }
        float y[8], ss = 0.f;
#pragma unroll
        for (int e = 0; e < 8; ++e) { y[e] = gb[e] * (cw[c + e] * um[e] + cw[1024 + c + e] * ut[e] + cw[2048 + c + e] * up[e]); ss += y[e] * y[e]; }
        ss += dpp_f<DPP_XOR1>(ss); ss += dpp_f<DPP_XOR2>(ss); ss += dpp_f<DPP_ROR4>(ss); ss += dpp_f<DPP_ROR8>(ss);
        const float rn = 1.f / sqrtf(ss * (1.f / 128.f) + LN_EPS);
        const float* gc = F.g_conv() + layer * 1024 + c;
        u32x4 w;
#pragma unroll
        for (int q = 0; q < 4; ++q) w[q] = pk2(y[2 * q] * rn * gc[2 * q], y[2 * q + 1] * rn * gc[2 * q + 1]);
        *(u32x4*)(F.MIX() + (size_t)t * D + 1024 + c) = w;
    }
}

__device__ __forceinline__ void ln_phase(Frame& F, int layer, int rows) {
    const int lane = F.lane;
    u32x4 w[4], wn[4];
    int t = F.gw;
    if (t < rows) {
#pragma unroll
        for (int j = 0; j < 4; ++j) w[j] = *(const u32x4*)(F.X() + (size_t)t * D + 8 * lane + 512 * j);
    }
    const float* g1 = F.ln1_g() + layer * D; const float* b1 = F.ln1_b() + layer * D;
    while (t < rows) {
        const int tn = t + F.NGW;
        if (tn < rows) {
#pragma unroll
            for (int j = 0; j < 4; ++j) wn[j] = *(const u32x4*)(F.X() + (size_t)tn * D + 8 * lane + 512 * j);
        }
        float v[32]; float s = 0.f;
#pragma unroll
        for (int j = 0; j < 4; ++j)
#pragma unroll
            for (int q = 0; q < 4; ++q) { v[8 * j + 2 * q] = bf_lo(w[j][q]); v[8 * j + 2 * q + 1] = bf_hi(w[j][q]); s += v[8 * j + 2 * q] + v[8 * j + 2 * q + 1]; }
        const float mean = wave_sum(s) * (1.f / D);
        float s2 = 0.f;
#pragma unroll
        for (int i = 0; i < 32; ++i) { v[i] -= mean; s2 += v[i] * v[i]; }
        const float rstd = 1.f / sqrtf(wave_sum(s2) * (1.f / D) + LN_EPS);
        float s3 = 0.f;
#pragma unroll
        for (int j = 0; j < 4; ++j) { const int c = 8 * lane + 512 * j; u32x4 o;
#pragma unroll
            for (int q = 0; q < 2; ++q) { const f32x4 gg = *(const f32x4*)(g1 + c + 4 * q), bb = *(const f32x4*)(b1 + c + 4 * q);
#pragma unroll
                for (int e = 0; e < 4; ++e) { const float y = v[8 * j + 4 * q + e] * rstd * gg[e] + bb[e]; v[8 * j + 4 * q + e] = y; s3 += y; }
                o[2 * q] = pk2(v[8 * j + 4 * q], v[8 * j + 4 * q + 1]); o[2 * q + 1] = pk2(v[8 * j + 4 * q + 2], v[8 * j + 4 * q + 3]); }
            *(u32x4*)(F.X() + (size_t)t * D + c) = o; }
        const float mean2 = wave_sum(s3) * (1.f / D);
        float s4 = 0.f;
#pragma unroll
        for (int i = 0; i < 32; ++i) { v[i] -= mean2; s4 += v[i] * v[i]; }
        const float rstd2 = 1.f / sqrtf(wave_sum(s4) * (1.f / D) + LN_EPS);
        const float* mp = F.MODS() + ((size_t)layer * 3 + modrow(t)) * 12288;
#pragma unroll
        for (int j = 0; j < 4; ++j) { const int c = 8 * lane + 512 * j; u32x4 o;
#pragma unroll
            for (int q = 0; q < 2; ++q) { const f32x4 sh = *(const f32x4*)(mp + 3 * D + c + 4 * q), sc = *(const f32x4*)(mp + 4 * D + c + 4 * q);
                const float y0 = v[8 * j + 4 * q] * rstd2 * (1.f + sc[0]) + sh[0], y1 = v[8 * j + 4 * q + 1] * rstd2 * (1.f + sc[1]) + sh[1];
                const float y2 = v[8 * j + 4 * q + 2] * rstd2 * (1.f + sc[2]) + sh[2], y3 = v[8 * j + 4 * q + 3] * rstd2 * (1.f + sc[3]) + sh[3];
                o[2 * q] = pk2(y0, y1); o[2 * q + 1] = pk2(y2, y3); }
            *(u32x4*)(F.H() + (size_t)t * D + c) = o; }
#pragma unroll
        for (int j = 0; j < 4; ++j) w[j] = wn[j];
        t = tn;
    }
}

__device__ __forceinline__ unsigned ordkey(float f) { const unsigned u = __float_as_uint(f); return u ^ ((u >> 31) ? 0xFFFFFFFFu : 0x80000000u); }
__device__ __forceinline__ float gelu_erf(float a) { return 0.5f * a * (1.f + erff(a * 0.70710678118654752f)); }

__device__ __forceinline__ float unordkey(unsigned k) { return __uint_as_float(k ^ ((k >> 31) ? 0x80000000u : 0xFFFFFFFFu)); }
__device__ __forceinline__ float gelu_as(float v) {
    const float av = fabsf(v), t = __builtin_amdgcn_rcpf(av * 0.2316418882f + 1.0f);
    float q = t * 0.5307027145f + (-0.7265760135f); q = q * t + 0.7107068705f; q = q * t + (-0.142248368f); q = q * t + 0.127414796f; q = q * t;
    const float e = __builtin_amdgcn_exp2f((v * v) * (-0.72134752044f));
    const float m = v * (q * e);
    return v < 0.f ? m : v - m;
}

template <class O> struct QuadNet {
    typedef typename O::V V; typedef typename O::B B;
    template <bool ASC> static __device__ __forceinline__ void ce_reg(V& a, V& b) { const V lo = O::vmin(a, b), hi = O::vmax(a, b); a = ASC ? lo : hi; b = ASC ? hi : lo; }
    template <bool ASC> static __device__ __forceinline__ void ce_l1(V& x, B low1) { const V p = O::x1(x); const V mn = O::vmin(p, x), mx = O::vmax(p, x); x = ASC ? O::vsel(low1, mn, mx) : O::vsel(low1, mx, mn); }
    template <bool ASC> static __device__ __forceinline__ void ce_l2(V& x, B low2) { const V p = O::x2(x); const V mn = O::vmin(p, x), mx = O::vmax(p, x); x = ASC ? O::vsel(low2, mn, mx) : O::vsel(low2, mx, mn); }
    template <int NR> static __device__ __forceinline__ void sort_blocks(V (&R)[NR], B low1, B low2, B eq12) {
#pragma unroll
        for (int r = 0; r < NR; ++r) { const V p = O::x1(R[r]); const V mn = O::vmin(p, R[r]), mx = O::vmax(p, R[r]); R[r] = O::vsel(eq12, mn, mx); }
#pragma unroll
        for (int r = 0; r < NR; ++r) { if ((r & 1) == 0) ce_l2<true>(R[r], low2); else ce_l2<false>(R[r], low2); }
#pragma unroll
        for (int r = 0; r < NR; ++r) { if ((r & 1) == 0) ce_l1<true>(R[r], low1); else ce_l1<false>(R[r], low1); }
#pragma unroll
        for (int r = 0; r < NR; r += 2) { if ((r & 2) == 0) ce_reg<true>(R[r], R[r + 1]); else ce_reg<false>(R[r], R[r + 1]); }
#pragma unroll
        for (int r = 0; r < NR; ++r) { if ((r & 2) == 0) ce_l2<true>(R[r], low2); else ce_l2<false>(R[r], low2); }
#pragma unroll
        for (int r = 0; r < NR; ++r) { if ((r & 2) == 0) ce_l1<true>(R[r], low1); else ce_l1<false>(R[r], low1); }
#pragma unroll
        for (int r = 0; r < NR; ++r) { if ((r & 2) == 0) { if ((r & 4) == 0) ce_reg<true>(R[r], R[r + 2]); else ce_reg<false>(R[r], R[r + 2]); } }
#pragma unroll
        for (int r = 0; r < NR; r += 2) { if ((r & 4) == 0) ce_reg<true>(R[r], R[r + 1]); else ce_reg<false>(R[r], R[r + 1]); }
#pragma unroll
        for (int r = 0; r < NR; ++r) { if ((r & 4) == 0) ce_l2<true>(R[r], low2); else ce_l2<false>(R[r], low2); }
#pragma unroll
        for (int r = 0; r < NR; ++r) { if ((r & 4) == 0) ce_l1<true>(R[r], low1); else ce_l1<false>(R[r], low1); }
    }
    template <int NR> static __device__ __forceinline__ void halve_merge(const V (&R)[NR], V (&Q)[NR / 2], B low1, B low2) {
#pragma unroll
        for (int m = 0; m < NR / 8; ++m)
#pragma unroll
            for (int i = 0; i < 4; ++i) Q[4 * m + i] = O::vmax(R[8 * m + i], R[8 * m + 4 + i]);
#pragma unroll
        for (int r = 0; r < NR / 2; ++r) { if ((r & 2) == 0) { if ((r & 4) == 0) ce_reg<false>(Q[r], Q[r + 2]); else ce_reg<true>(Q[r], Q[r + 2]); } }
#pragma unroll
        for (int r = 0; r < NR / 2; r += 2) { if ((r & 4) == 0) ce_reg<false>(Q[r], Q[r + 1]); else ce_reg<true>(Q[r], Q[r + 1]); }
#pragma unroll
        for (int r = 0; r < NR / 2; ++r) { if ((r & 4) == 0) ce_l2<false>(Q[r], low2); else ce_l2<true>(Q[r], low2); }
#pragma unroll
        for (int r = 0; r < NR / 2; ++r) { if ((r & 4) == 0) ce_l1<false>(Q[r], low1); else ce_l1<true>(Q[r], low1); }
    }
    static __device__ __forceinline__ void top16_of_128(V (&R)[32], V (&T)[4], B low1, B low2, B eq12) {
        sort_blocks<32>(R, low1, low2, eq12);
        V A[16]; halve_merge<32>(R, A, low1, low2);
        V Bq[8]; halve_merge<16>(A, Bq, low1, low2);
        halve_merge<8>(Bq, T, low1, low2);
    }
    static __device__ __forceinline__ void top16_of_64(V (&R)[16], V (&T)[4], B low1, B low2, B eq12) {
        sort_blocks<16>(R, low1, low2, eq12);
        V A[8]; halve_merge<16>(R, A, low1, low2);
        halve_merge<8>(A, T, low1, low2);
    }
};

struct DevOps {
    typedef unsigned V; typedef bool B;
    static __device__ __forceinline__ V vmin(V a, V b) { return a < b ? a : b; }
    static __device__ __forceinline__ V vmax(V a, V b) { return a > b ? a : b; }
    static __device__ __forceinline__ V vsel(B m, V a, V b) { return m ? a : b; }
    static __device__ __forceinline__ V x1(V a) { return (V)dpp_i<DPP_XOR1>((int)a); }
    static __device__ __forceinline__ V x2(V a) { return (V)dpp_i<DPP_XOR2>((int)a); }
};
__device__ __forceinline__ void stair_ab(int c, int& a, int& b) {
    if (c < 16) { a = 0; b = c; } else if (c < 24) { a = 1; b = c - 16; } else if (c < 28) { a = 2; b = c - 24; } else if (c < 32) { a = 3; b = c - 28; }
    else if (c < 36) { a = 4; b = c - 32; } else if (c < 40) { a = 5 + ((c - 36) >> 1); b = (c - 36) & 1; } else if (c < 44) { a = 7 + ((c - 40) >> 1); b = (c - 40) & 1; }
    else if (c < 48) { a = 9 + (c - 44); b = 0; } else if (c < 51) { a = 13 + (c - 48); b = 0; } else { a = 2; b = 4; }
}
constexpr int PE_WS = 5120, PE_TAB = 8 * PE_WS;
__device__ __forceinline__ void peer_topk(Frame& F, LAS unsigned char* ws, int t) {
    const int lane = F.lane, sub = lane & 3;
    const bool low1 = (sub & 1) == 0, low2 = (sub & 2) == 0, eq12 = low1 == low2;
    LAS unsigned* S1K = (LAS unsigned*)ws; LAS int* EL = (LAS int*)(ws + 3328); LAS float* GL = (LAS float*)(ws + 3840);
    const LAS unsigned short* TAB = (const LAS unsigned short*)(F.lds + PE_TAB);
    {
        const int L = lane >> 2;
        const float* sp = F.SC() + (size_t)t * D + L * 128 + sub * 4;
        unsigned R[32];
#pragma unroll
        for (int q = 0; q < 8; ++q) { const f32x4 v = *(const f32x4*)(sp + 16 * q);
#pragma unroll
            for (int e = 0; e < 4; ++e) R[4 * q + e] = (ordkey(v[e]) & ~127u) | (unsigned)(127 - (4 * sub + 16 * q + e)); }
        unsigned T[4];
        QuadNet<DevOps>::top16_of_128(R, T, low1, low2, eq12);
#pragma unroll
        for (int r = 0; r < 4; ++r) S1K[L * 16 + 4 * r + sub] = T[r];
    }
    LDS_WAIT(); __builtin_amdgcn_wave_barrier();
    {
        const int hd = (lane >> 2) & 7;
        const LAS unsigned char* la = (const LAS unsigned char*)(S1K + (2 * hd) * 16); const LAS unsigned char* lb = (const LAS unsigned char*)(S1K + (2 * hd + 1) * 16);
        unsigned C[16];
#pragma unroll
        for (int r = 0; r < 13; ++r) { const unsigned ab = TAB[4 * r + sub];
            const unsigned ka = *(const LAS unsigned*)(la + (ab & 255u)), kb = *(const LAS unsigned*)(lb + (ab >> 8));
            const float sum = unordkey(ka & ~127u) + unordkey(kb & ~127u);
            C[r] = (ordkey(sum) & ~63u) | (unsigned)(63 - (4 * r + sub)); }
        C[13] = 0u; C[14] = 0u; C[15] = 0u;
        unsigned W[4];
        QuadNet<DevOps>::top16_of_64(C, W, low1, low2, eq12);
        float sv[4]; int ex[4];
#pragma unroll
        for (int r = 0; r < 4; ++r) { const unsigned ab = TAB[63 - (W[r] & 63u)];
            const unsigned ka = *(const LAS unsigned*)(la + (ab & 255u)), kb = *(const LAS unsigned*)(lb + (ab >> 8));
            ex[r] = (int)(127u - (ka & 127u)) * 128 + (int)(127u - (kb & 127u)); sv[r] = unordkey(W[r] & ~63u); }
        const float mx = dpp_f<0x00>(sv[0]);
        float e4[4], es = 0.f;
#pragma unroll
        for (int r = 0; r < 4; ++r) { e4[r] = __expf(sv[r] - mx); es += e4[r]; }
        es += dpp_f<DPP_XOR1>(es); es += dpp_f<DPP_XOR2>(es);
        const float rd = 1.f / es;
#pragma unroll
        for (int r = 0; r < 4; ++r) { GL[hd * 16 + 4 * r + sub] = e4[r] * rd; EL[hd * 16 + 4 * r + sub] = ex[r]; }
    }
    LDS_WAIT(); __builtin_amdgcn_wave_barrier();
}

#ifndef PROBE_PHASE
#define PROBE_PHASE -1
#endif
#ifndef PROBE_MULT
#define PROBE_MULT 1
#endif
constexpr int EB = 4;
constexpr int CW_TICKET = 20480;

struct GBuf { LpRow<U_FMT> u[EB]; LpRow<V_FMT> v[EB]; };
__device__ __forceinline__ void gather_issue(GBuf& B, const LAS int* EL, int i0, const unsigned char* UTl, const unsigned char* VTl, int lane) {
#pragma unroll
    for (int q = 0; q < EB; ++q) {
        const int ex = __builtin_amdgcn_readfirstlane(EL[i0 + q]);
        B.u[q].load(UTl + (size_t)ex * UROW, lane); B.v[q].load(VTl + (size_t)ex * VROW, lane);
    }
}
__device__ __forceinline__ void gather_compute(const GBuf& B, const LAS int* EL, const LAS float* GL, int i0, const float* USl, const float* VSl, const unsigned (&hv)[16], f32x2 (&acc)[16]) {
    float dot[EB], su[EB], sv[EB], g[EB];
#pragma unroll
    for (int q = 0; q < EB; ++q) { const int ex = __builtin_amdgcn_readfirstlane(EL[i0 + q]); su[q] = USl[ex]; sv[q] = VSl[ex];
        g[q] = __uint_as_float(__builtin_amdgcn_readfirstlane(__float_as_uint(GL[i0 + q]))); }
#pragma unroll
    for (int q = 0; q < EB; ++q) { float s0 = 0.f, s1 = 0.f;
        B.u[q].each_bf([&](int i, bf16x2_t x) { if (i & 1) s1 = __builtin_amdgcn_fdot2_f32_bf16(x, __builtin_bit_cast(bf16x2_t, hv[i]), s1, false); else s0 = __builtin_amdgcn_fdot2_f32_bf16(x, __builtin_bit_cast(bf16x2_t, hv[i]), s0, false); });
        dot[q] = s0 + s1; }
#pragma unroll
    for (int q = 0; q < EB; ++q) dot[q] = wave_sum_u(dot[q]);
#pragma unroll
    for (int q = 0; q < EB; ++q) { const float cf = g[q] * gelu_as(dot[q] * su[q]) * sv[q]; const f32x2 c2 = {cf, cf};
        B.v[q].each([&](int i, float x0, float x1) { const f32x2 x = {x0, x1}; acc[i >> 1] = __builtin_elementwise_fma(x, c2, acc[i >> 1]); }); }
}

__device__ __forceinline__ void peer_phase(Frame& F, int layer, int rows, unsigned* ctl, unsigned long long& pr_acc) {
    unsigned long long pt0 = 0ull;
#define SUB_BEGIN(ty) do { if (PROBE_PHASE == (ty)) pt0 = __builtin_amdgcn_s_memrealtime(); } while (0)
#define SUB_END(ty) do { if (PROBE_PHASE == (ty)) pr_acc += __builtin_amdgcn_s_memrealtime() - pt0; } while (0)
    if (F.tid < 64) { int a = 0, b = 0; stair_ab(F.tid < 52 ? F.tid : 0, a, b); *(LAS unsigned short*)(F.lds + PE_TAB + 2 * F.tid) = (unsigned short)((4 * a) | ((4 * b) << 8)); }
    __syncthreads();
    LAS unsigned char* ws = F.lds + F.wave * PE_WS;
    LAS int* EL = (LAS int*)(ws + 3328); LAS float* GL = (LAS float*)(ws + 3840);
    const int lane = F.lane;
    const unsigned char* UTl = F.UT() + (size_t)layer * NEXP * UROW;
    const unsigned char* VTl = F.VT() + (size_t)layer * NEXP * VROW;
    const float* USl = F.US() + (size_t)layer * NEXP; const float* VSl = F.VS() + (size_t)layer * NEXP;
    unsigned* ticket = ctl + CW_TICKET + 64 * layer;
    unsigned tk = 0u;
    if (lane == 0) tk = __hip_atomic_fetch_add(ticket, 1u, __ATOMIC_RELAXED, __HIP_MEMORY_SCOPE_AGENT);
    int t = (int)__builtin_amdgcn_readfirstlane(tk);
    while (t < rows) {
        unsigned tkn = 0u;
        if (lane == 0) tkn = __hip_atomic_fetch_add(ticket, 1u, __ATOMIC_RELAXED, __HIP_MEMORY_SCOPE_AGENT);
        SUB_BEGIN(8); peer_topk(F, ws, t); SUB_END(8);
        SUB_BEGIN(9);
        unsigned hv[16]; f32x2 acc[16];
#pragma unroll
        for (int q = 0; q < 4; ++q) { const u32x4 w = *(const u32x4*)(F.H() + (size_t)t * D + 32 * lane + 8 * q);
#pragma unroll
            for (int e = 0; e < 4; ++e) { hv[4 * q + e] = w[e]; acc[4 * q + e] = (f32x2){0.f, 0.f}; } }
        {
            GBuf A, B, C;
            gather_issue(A, EL, 0, UTl, VTl, lane);
            gather_issue(B, EL, EB, UTl, VTl, lane);
            for (int i0 = 0; i0 < 30 * EB; i0 += 3 * EB) {
                gather_issue(C, EL, i0 + 2 * EB, UTl, VTl, lane);
                gather_compute(A, EL, GL, i0, USl, VSl, hv, acc);
                gather_issue(A, EL, i0 + 3 * EB, UTl, VTl, lane);
                gather_compute(B, EL, GL, i0 + EB, USl, VSl, hv, acc);
                gather_issue(B, EL, i0 + 4 * EB, UTl, VTl, lane);
                gather_compute(C, EL, GL, i0 + 2 * EB, USl, VSl, hv, acc);
            }
            gather_compute(A, EL, GL, 30 * EB, USl, VSl, hv, acc);
            gather_compute(B, EL, GL, 31 * EB, USl, VSl, hv, acc);
        }
        SUB_END(9); SUB_BEGIN(10);
        const int mr = modrow(t);
        const float* mp = F.MODS() + ((size_t)layer * 3 + mr) * 12288;
        bf16_t* xr = F.X() + (size_t)t * D;
        float rr[32]; float s = 0.f;
#pragma unroll
        for (int q2 = 0; q2 < 4; ++q2) { const u32x4 xw = *(const u32x4*)(xr + 32 * lane + 8 * q2);
#pragma unroll
            for (int h2 = 0; h2 < 2; ++h2) { const int q = 2 * q2 + h2; const int c = 32 * lane + 4 * q; const f32x4 gv = *(const f32x4*)(mp + 5 * D + c);
                const f32x4 xv = {bf_lo(xw[2 * h2]), bf_hi(xw[2 * h2]), bf_lo(xw[2 * h2 + 1]), bf_hi(xw[2 * h2 + 1])};
                const f32x4 av = {acc[2 * q].x, acc[2 * q].y, acc[2 * q + 1].x, acc[2 * q + 1].y};
#pragma unroll
                for (int e = 0; e < 4; ++e) { const float v = DN_ALPHA * xv[e] + gv[e] * av[e]; rr[4 * q + e] = v; s += v; } } }
        const float mean = wave_sum_u(s) * (1.f / D);
        float s2 = 0.f;
#pragma unroll
        for (int i = 0; i < 32; ++i) { rr[i] -= mean; s2 += rr[i] * rr[i]; }
        const float rstd = 1.f / sqrtf(wave_sum_u(s2) * (1.f / D) + LN_EPS);
        const float* g2 = F.ln2_g() + layer * D; const float* b2 = F.ln2_b() + layer * D;
        float s3 = 0.f;
#pragma unroll
        for (int q = 0; q < 8; ++q) { const int c = 32 * lane + 4 * q; const f32x4 gg = *(const f32x4*)(g2 + c), bb = *(const f32x4*)(b2 + c);
            f32x4 xo;
#pragma unroll
            for (int e = 0; e < 4; ++e) { xo[e] = rr[4 * q + e] * rstd * gg[e] + bb[e]; rr[4 * q + e] = xo[e]; s3 += xo[e]; }
            if (layer < NLAYER - 1) { u32x2 o2; o2.x = pk2(xo[0], xo[1]); o2.y = pk2(xo[2], xo[3]); *(u32x2*)(xr + c) = o2; } else if (t < TL) *(f32x4*)(F.out() + (size_t)t * D + c) = xo; }
        if (layer < NLAYER - 1) {
            const float mean2 = wave_sum_u(s3) * (1.f / D);
            float s4 = 0.f;
#pragma unroll
            for (int i = 0; i < 32; ++i) { rr[i] -= mean2; s4 += rr[i] * rr[i]; }
            const float rstd2 = 1.f / sqrtf(wave_sum_u(s4) * (1.f / D) + LN_EPS);
            const float* np = F.MODS() + ((size_t)(layer + 1) * 3 + mr) * 12288;
#pragma unroll
            for (int q2 = 0; q2 < 4; ++q2) { const int c = 32 * lane + 8 * q2; u32x4 w;
#pragma unroll
                for (int q = 0; q < 2; ++q) { const f32x4 sh = *(const f32x4*)(np + c + 4 * q), sc = *(const f32x4*)(np + D + c + 4 * q); const int ri = 8 * q2 + 4 * q;
                    const float y0 = rr[ri] * rstd2 * (1.f + sc[0]) + sh[0], y1 = rr[ri + 1] * rstd2 * (1.f + sc[1]) + sh[1];
                    const float y2 = rr[ri + 2] * rstd2 * (1.f + sc[2]) + sh[2], y3 = rr[ri + 3] * rstd2 * (1.f + sc[3]) + sh[3];
                    w[2 * q] = pk2(y0, y1); w[2 * q + 1] = pk2(y2, y3); }
                *(u32x4*)(F.H() + (size_t)t * D + c) = w; }
        }
        SUB_END(10);
        t = (int)__builtin_amdgcn_readfirstlane(tkn);
    }
#undef SUB_BEGIN
#undef SUB_END
}

__global__ void __launch_bounds__(NWAVES * 64, 2) skel_fwd(Args args) {
    extern __shared__ __attribute__((aligned(16))) unsigned char lds[];
    Frame F;
    F.lds = (LAS unsigned char*)lds;
    F.tid = threadIdx.x; F.lane = F.tid & 63; F.wave = __builtin_amdgcn_readfirstlane(F.tid >> 6);
    F.G = gridDim.x; F.gw = blockIdx.x * NWAVES + F.wave; F.NGW = F.G * NWAVES;
    unsigned char* ws = args.ws;
    F.ka = (const CAS unsigned char*)__builtin_amdgcn_kernarg_segment_ptr();
    for (int u = F.tid; u < (LDS_BYTES - LDSCTL_OFF) / 4; u += NWAVES * 64) ((LAS unsigned*)(F.lds + LDSCTL_OFF))[u] = 0u;
    __syncthreads();
    unsigned* ctl = (unsigned*)(ws + WS_CTL);
    const int lo = args.ph_lo, hi = args.ph_hi;
    XcdBarrier bar; bar.bar = ctl + CW_BAR + args.li * XCD_BAR_WORDS; bar.x = 0; bar.st = nullptr;
    if (hi - lo > 1) bar = xcd_barrier_post(ctl + CW_BAR + args.li * XCD_BAR_WORDS, (volatile LAS unsigned*)(F.lds + MISC_OFF) + 8);
#define IN(k) (lo <= (k) && (k) < hi)
    unsigned long long pr_acc = 0ull, pr_t0 = 0ull;
#define PR_BEGIN(ty) do { if (PROBE_PHASE == (ty)) pr_t0 = __builtin_amdgcn_s_memrealtime(); } while (0)
#define PR_END(ty) do { if (PROBE_PHASE == (ty)) pr_acc += __builtin_amdgcn_s_memrealtime() - pr_t0; } while (0)
#define BOTH(k) (IN(k) && IN((k) + 1))
#define SEAM(k) do { if (BOTH(k)) xcd_barrier(bar); } while (0)

    if (IN(0)) { PR_BEGIN(0); frame_ids(F); p0a_prologue(F); SEAM(0); PR_END(0); }
    if (IN(1)) {
        PR_BEGIN(1); frame_ids(F);
        { pg8::Gemm g{F.KBD(), F.WQR(), 32 * 256, 2048, 256}; pg8::BatchOrder S{F.G, (int)blockIdx.x}; pg8::EpiBf16 E{F.WEFFT(), D};
          pg8::gemm_phase<pg8::EpiBf16, pg8::BatchOrder, false, true>(F.lds, g, S, E); }
        p0b_mod0(F);
        SEAM(1); PR_END(1);
    }
    for (int layer = 0; layer < NLAYER; ++layer) {
        const int pb = 2 + 6 * layer;
        const bool lastl = layer == NLAYER - 1;
        const int rows = lastl ? TL : TT;
        if (IN(pb + 0)) {
            PR_BEGIN(2); frame_ids(F);
            pg8::Gemm g{F.H(), F.WINT() + (size_t)layer * INC * D, TT, INC, D}; pg8::StaticOrder S; S.init(TT, INC, F.G, (int)blockIdx.x);
            pg8::EpiBf16 E{F.PROJ(), INC};
            pg8::gemm_phase<pg8::EpiBf16, pg8::StaticOrder, true, true>(F.lds, g, S, E);
            SEAM(pb + 0); PR_END(2);
        }
        if (IN(pb + 1)) {
            PR_BEGIN(3); frame_ids(F);
            const int nunits = lastl ? 512 : 528;
            { unsigned long long q0 = 0; if (PROBE_PHASE == 11) q0 = __builtin_amdgcn_s_memrealtime();
            { const int bx = (int)blockIdx.x, vcu = (F.G % 8 == 0) ? (bx % 8) * (F.G / 8) + bx / 8 : bx;
              for (int u = vcu; u < nunits; u += F.G) attn_unit(F, layer, u); }
            if (PROBE_PHASE == 11) pr_acc += __builtin_amdgcn_s_memrealtime() - q0; if (PROBE_PHASE == 12) q0 = __builtin_amdgcn_s_memrealtime();
            {
              const int nx = nunits - 2 * F.G; const bool uneven = nx > 0 && nx < F.G;
              const int bx2 = (int)blockIdx.x, vc2 = (F.G % 8 == 0) ? (bx2 % 8) * (F.G / 8) + bx2 / 8 : bx2;
              const int c0 = uneven ? vc2 - nx : vc2, nb = uneven ? F.G - nx : F.G;
              if (c0 >= 0) for (int t = c0 * NWAVES + F.wave; t < rows; t += nb * NWAVES) conv_row(F, layer, t); }
            if (PROBE_PHASE == 12) pr_acc += __builtin_amdgcn_s_memrealtime() - q0; }
            SEAM(pb + 1); PR_END(3);
        }
        if (IN(pb + 2)) {
            PR_BEGIN(4); frame_ids(F);
            pg8::Gemm g{F.MIX(), F.WOUTT() + (size_t)layer * D * D, rows, D, D}; pg8::StaticOrder S; S.init(rows, D, F.G, (int)blockIdx.x);
            pg8::EpiResid E{layer == 0 ? F.x() : nullptr, layer == 0 ? F.ctx() : nullptr, F.X(), F.MODS() + (size_t)layer * 3 * 12288 + 2 * D};
            pg8::gemm_phase<pg8::EpiResid, pg8::StaticOrder, true, true>(F.lds, g, S, E);
            frame_ids(F); convert_in_tail(F, layer, (rows / 256) * (D / 256), 0);
            SEAM(pb + 2); PR_END(4);
        }
        if (IN(pb + 3)) { PR_BEGIN(5); frame_ids(F); ln_phase(F, layer, rows); SEAM(pb + 3); PR_END(5); }
        if (IN(pb + 4)) {
            PR_BEGIN(6); frame_ids(F);
            pg8::Gemm g{F.H(), F.WEFFT() + (size_t)layer * D * D, rows, D, D}; pg8::StaticOrder S; S.init(rows, D, F.G, (int)blockIdx.x);
            pg8::EpiF32 E{F.SC(), D};
            pg8::gemm_phase<pg8::EpiF32, pg8::StaticOrder, true, true>(F.lds, g, S, E);
            frame_ids(F); convert_in_tail(F, layer, (rows / 256) * (D / 256), 1);
            SEAM(pb + 4); PR_END(6);
        }
        if (IN(pb + 5)) { PR_BEGIN(7); frame_ids(F); peer_phase(F, layer, rows, ctl, pr_acc); SEAM(pb + 5); PR_END(7); }
    }
    if (PROBE_PHASE >= 0 && hi - lo > 1) xcd_barrier(bar);
    if (PROBE_PHASE >= 0 && blockIdx.x == 0 && threadIdx.x == 0) { const unsigned long long t1 = __builtin_amdgcn_s_memrealtime() + (unsigned long long)PROBE_MULT * pr_acc; while (__builtin_amdgcn_s_memrealtime() < t1) __builtin_amdgcn_s_sleep(8); }
#undef IN
#undef BOTH
#undef SEAM
}

extern "C" void kernel_launch(void* const* d_in, const int* in_sizes, int n_in, void* d_out, int out_size, void* d_ws, size_t ws_size, hipStream_t stream) {
    static int grid = 0;
    if (grid == 0) {
        if (n_in != 20 || in_sizes[0] != TL * D || out_size != TL * D || ws_size < WS_END) {
            fprintf(stderr, "kernel_launch: unexpected problem shape (n_in %d, in0 %d, out %d, ws %zu, need %zu)\n", n_in, n_in > 0 ? in_sizes[0] : -1, out_size, ws_size, (size_t)WS_END); grid = -1; return; }
        int dev = 0, cus = 0, per_cu = 0;
        if (hipGetDevice(&dev) != hipSuccess || hipDeviceGetAttribute(&cus, hipDeviceAttributeMultiprocessorCount, dev) != hipSuccess) { grid = -1; return; }
        if (hipFuncSetAttribute((const void*)skel_fwd, hipFuncAttributeMaxDynamicSharedMemorySize, LDS_BYTES) != hipSuccess) { fprintf(stderr, "kernel_launch: hipFuncSetAttribute failed\n"); grid = -1; return; }
        if (hipOccupancyMaxActiveBlocksPerMultiprocessor(&per_cu, (const void*)skel_fwd, NWAVES * 64, LDS_BYTES) != hipSuccess || per_cu < 1)
            fprintf(stderr, "kernel_launch: occupancy query reports %d workgroups per CU\n", per_cu);
        (void)hipGetLastError();
        grid = cus;
    }
    if (grid < 0) return;
    if (hipMemsetAsync((char*)d_ws + WS_CTL, 0, CTL_ZERO_BYTES, stream) != hipSuccess) return;
    Args a{};
    for (int i = 0; i < 20; ++i) a.in[i] = (const float*)d_in[i];
    a.out = (float*)d_out; a.ws = (unsigned char*)d_ws; a.pad = 0;
#if MK_N_LAUNCHES == 1
    a.ph_lo = 0; a.ph_hi = NPHASE; a.li = 0;
    hipLaunchKernelGGL(skel_fwd, dim3(grid), dim3(NWAVES * 64), LDS_BYTES, stream, a);
#else
    for (int ph = 0; ph < NPHASE; ++ph) { a.ph_lo = ph; a.ph_hi = ph + 1; a.li = 0;
        hipLaunchKernelGGL(skel_fwd, dim3(grid), dim3(NWAVES * 64), LDS_BYTES, stream, a); }
#endif
}
```

```cpp
#include <hip/hip_runtime.h>
#include <cstdio>
#include <cstdint>

#ifndef MK_N_LAUNCHES
#define MK_N_LAUNCHES 1
#endif

#define LAS __attribute__((address_space(3)))
typedef unsigned short bf16_t;
typedef short bf16x8 __attribute__((ext_vector_type(8)));
typedef short s16x4 __attribute__((ext_vector_type(4)));
typedef float f32x2 __attribute__((ext_vector_type(2)));
typedef float f32x4 __attribute__((ext_vector_type(4)));
typedef float f32x16 __attribute__((ext_vector_type(16)));
typedef unsigned u32x2 __attribute__((ext_vector_type(2)));
typedef unsigned u32x4 __attribute__((ext_vector_type(4)));
typedef __bf16 bf16x2_t __attribute__((ext_vector_type(2)));

constexpr int D = 2048, NB = 2, SEQ = 8192, CTXL = 256, NLAYER = 4;
constexpr int TL = NB * SEQ, TC = NB * CTXL, TT = TL + TC;
constexpr int INC = 4608, OFF_C = 1024, OFF_X = 2048, OFF_Q = 3072, OFF_K = 4096, OFF_V = 4352;
constexpr int NEXP = 16384;
#ifndef U_FMT
#define U_FMT 4
#endif
#ifndef V_FMT
#define V_FMT 4
#endif
constexpr int UROW = D * U_FMT / 8, VROW = D * V_FMT / 8;
constexpr float LN_EPS = 1e-6f;
constexpr float DN_ALPHA = 1.681792830507429f;
constexpr float QSCALE = 0.08838834764831845f * 1.4426950408889634f;
constexpr float LOG2E = 1.4426950408889634f;

constexpr size_t MiB = 1u << 20;
constexpr size_t WS_CTL = 0, CTL_ZERO_BYTES = 1 * MiB;
constexpr size_t WS_MODS = 1 * MiB;
constexpr size_t WS_ROPE = 2 * MiB;
constexpr size_t WS_KBD = 3 * MiB;
constexpr size_t WS_WQR = 8 * MiB;
constexpr size_t WS_WINT = 40 * MiB;
constexpr size_t WS_WOUTT = 112 * MiB;
constexpr size_t WS_WEFFT = 144 * MiB;
constexpr size_t WS_X = 176 * MiB;
constexpr size_t WS_H = 308 * MiB;
constexpr size_t WS_PROJ = 374 * MiB;
constexpr size_t WS_MIX = 523 * MiB;
constexpr size_t WS_SC = 589 * MiB;
constexpr size_t WS_UT = 721 * MiB;
constexpr size_t WS_VT = 849 * MiB;
constexpr size_t WS_US = 977 * MiB;
constexpr size_t WS_VS = 978 * MiB;
constexpr size_t WS_END = 979 * MiB;

constexpr int CW_BAR = 4096;

namespace pg8 {
constexpr int BM = 256, BK = 64, HALF = 128, HTB = HALF * BK * 2, STAGE_BYTES = 8 * HTB, NXCD = 8, WGM = 8;
__host__ __device__ __forceinline__ int lds_byte(int r, int c) { const int st = (r >> 4) * 2 + (c >> 5), rr = r & 15, cc = c & 31, ob = rr * 64 + cc * 2; return st * 1024 + (ob ^ (((ob >> 9) & 1) << 5)); }
__host__ __device__ __forceinline__ void stage_rc(int b, int& R, int& C) { const int st = b / 1024, sb = b % 1024, swz = sb ^ (((sb >> 9) & 1) << 5); R = (st >> 1) * 16 + swz / 64; C = (st & 1) * 32 + (swz % 64) / 2; }
__host__ __device__ __forceinline__ int perm32(int rho) { const int n = rho >> 4, i = rho & 15; return 8 * (i >> 2) + 4 * n + (i & 3); }

struct Unit { int pm, pn; };
struct Gemm { const bf16_t* A; const bf16_t* Bt; int M, N, K; };

struct StaticOrder {
    int nM, nN, nwg, G, c;
    __host__ __device__ void init(int M, int N, int G_, int c_) { nM = M / BM; nN = N / BM; nwg = nM * nN; G = G_; c = c_; }
    __host__ __device__ bool next(int i, Unit& u) const {
        const long L = (long)i * G + c; if (L >= nwg) return false;
        int wgid = (int)L; { const int q = nwg / NXCD, r = nwg % NXCD, xcd = wgid % NXCD, off = wgid / NXCD; wgid = (xcd < r ? xcd * (q + 1) : r * (q + 1) + (xcd - r) * q) + off; }
        const int nig = WGM * nN, gid = wgid / nig, fm = gid * WGM, gsz = (nM - fm) < WGM ? (nM - fm) : WGM;
        u.pm = fm + ((wgid % nig) % gsz); u.pn = (wgid % nig) / gsz; return true;
    }
    __device__ __forceinline__ int btile(const Unit& u) const { return u.pn; }
    __device__ __forceinline__ void a_ready(const Unit&) const {}
    __device__ __forceinline__ void done(const Unit&) const {}
};
struct BatchOrder {
    int G, c;
    __device__ bool next(int i, Unit& u) const { const int L = i * G + c; if (L >= 256) return false; u.pm = L >> 3; u.pn = L & 7; return true; }
    __device__ __forceinline__ int btile(const Unit& u) const { return u.pm * 8 + u.pn; }
    __device__ __forceinline__ void a_ready(const Unit&) const {}
    __device__ __forceinline__ void done(const Unit&) const {}
};

__device__ __forceinline__ unsigned cvt_pk_bf16(float lo, float hi) { f32x2 x = {lo, hi}; bf16x2_t y = __builtin_convertvector(x, bf16x2_t); return __builtin_bit_cast(unsigned, y); }

struct EpiBf16 {
    static constexpr bool PERM = true;
    bf16_t* O; int ldc;
    __device__ __forceinline__ void operator()(const f32x4 (&acc)[2][2][4][2], const Unit& u, int wr, int wc, int fr, int fq) const {
        const int row0 = u.pm * BM + wr * 64 + fr, col0 = u.pn * BM + wc * 32 + 8 * fq;
#pragma unroll
        for (int ai = 0; ai < 2; ++ai)
#pragma unroll
            for (int m = 0; m < 4; ++m) { bf16_t* rowp = O + (size_t)(row0 + ai * HALF + m * 16) * ldc + col0;
#pragma unroll
                for (int bj = 0; bj < 2; ++bj) { const f32x4 v0 = acc[ai][bj][m][0], v1 = acc[ai][bj][m][1];
                    u32x4 w; w.x = cvt_pk_bf16(v0[0], v0[1]); w.y = cvt_pk_bf16(v0[2], v0[3]); w.z = cvt_pk_bf16(v1[0], v1[1]); w.w = cvt_pk_bf16(v1[2], v1[3]);
                    *(u32x4*)(rowp + bj * HALF) = w; } }
    }
};
struct EpiF32 {
    static constexpr bool PERM = false;
    float* C; int ldc;
    __device__ __forceinline__ void operator()(const f32x4 (&acc)[2][2][4][2], const Unit& u, int wr, int wc, int fr, int fq) const {
        const int row0 = u.pm * BM + wr * 64 + fr, col0 = u.pn * BM + wc * 32 + 4 * fq;
#pragma unroll
        for (int ai = 0; ai < 2; ++ai)
#pragma unroll
            for (int m = 0; m < 4; ++m) { float* rowp = C + (size_t)(row0 + ai * HALF + m * 16) * ldc + col0;
#pragma unroll
                for (int bj = 0; bj < 2; ++bj)
#pragma unroll
                    for (int n = 0; n < 2; ++n) *(f32x4*)(rowp + bj * HALF + n * 16) = acc[ai][bj][m][n]; }
    }
};
struct EpiResid {
    static constexpr bool PERM = true;
    const float* x32_lat; const float* x32_ctx;
    bf16_t* X; const float* gate;
    __device__ __forceinline__ void operator()(const f32x4 (&acc)[2][2][4][2], const Unit& u, int wr, int wc, int fr, int fq) const {
        const int rt = u.pm * BM;
        const int mr = rt < TL ? rt / SEQ : 2;
        const int row0 = rt + wr * 64 + fr, col0 = u.pn * BM + wc * 32 + 8 * fq;
        f32x4 gv[2][2];
#pragma unroll
        for (int bj = 0; bj < 2; ++bj)
#pragma unroll
            for (int n = 0; n < 2; ++n) gv[bj][n] = *(const f32x4*)(gate + (size_t)mr * 12288 + col0 + bj * HALF + 4 * n);
#pragma unroll
        for (int ai = 0; ai < 2; ++ai)
#pragma unroll
            for (int m = 0; m < 4; ++m) { const int row = row0 + ai * HALF + m * 16;
#pragma unroll
                for (int bj = 0; bj < 2; ++bj) {
                    f32x4 x0, x1;
                    if (x32_lat) { const float* xp = (row < TL ? x32_lat + (size_t)row * D : x32_ctx + (size_t)(row - TL) * D) + col0 + bj * HALF; x0 = *(const f32x4*)xp; x1 = *(const f32x4*)(xp + 4); }
                    else { const u32x4 w = *(const u32x4*)(X + (size_t)row * D + col0 + bj * HALF);
                        x0 = (f32x4){__uint_as_float(w.x << 16), __uint_as_float(w.x & 0xffff0000u), __uint_as_float(w.y << 16), __uint_as_float(w.y & 0xffff0000u)};
                        x1 = (f32x4){__uint_as_float(w.z << 16), __uint_as_float(w.z & 0xffff0000u), __uint_as_float(w.w << 16), __uint_as_float(w.w & 0xffff0000u)}; }
                    const f32x4 r0 = x0 * DN_ALPHA + gv[bj][0] * acc[ai][bj][m][0], r1 = x1 * DN_ALPHA + gv[bj][1] * acc[ai][bj][m][1];
                    u32x4 o; o.x = cvt_pk_bf16(r0[0], r0[1]); o.y = cvt_pk_bf16(r0[2], r0[3]); o.z = cvt_pk_bf16(r1[0], r1[1]); o.w = cvt_pk_bf16(r1[2], r1[3]);
                    *(u32x4*)(X + (size_t)row * D + col0 + bj * HALF) = o; } }
    }
};

template <class Epi, class Sched, bool ALIGN_EPI = false, bool SP2 = false>
__device__ __forceinline__ void gemm_phase(LAS unsigned char* lds, const Gemm g, const Sched& S, const Epi& E) {
    int tid = threadIdx.x; asm volatile("" : "+v"(tid));
    const int wid = __builtin_amdgcn_readfirstlane(tid >> 6), lane = tid & 63, wr = wid >> 2, wc = wid & 3, fr = lane & 15, fq = lane >> 4;
    const int K = g.K, nt = K / BK;
    unsigned voffA[2], voffB[2];
#pragma unroll
    for (int i = 0; i < 2; ++i) { int R, C; stage_rc(tid * 16 + i * 8192, R, C); const int Rb = Epi::PERM ? ((R & ~31) + perm32(R & 31)) : R;
        voffA[i] = (unsigned)(R * K + C) * 2u; voffB[i] = (unsigned)(Rb * K + C) * 2u; }
    const size_t kstep = (size_t)(BK * 2);
    const size_t hstep = (size_t)HALF * K * 2;
    const size_t tstep = 2 * hstep;
    const unsigned ldsw = (unsigned)wid * 1024u;
    const int aoff = lds_byte(wr * 64 + fr, fq * 8), boff = lds_byte(wc * 32 + fr, fq * 8);
#define PG8_SA(b, h) (((b) * 2 + (h)) * HTB)
#define PG8_SB(b, h) ((4 + (b) * 2 + (h)) * HTB)
#define PG8_STAGE(bufoff, gbase, voff) do { _Pragma("unroll") for (int _i = 0; _i < 2; ++_i) \
        __builtin_amdgcn_global_load_lds((const unsigned*)((const char*)(gbase) + (voff)[_i]), (LAS unsigned*)(lds + (bufoff) + ldsw + _i * 8192), 16, 0, 0); } while (0)
#define PG8_LDA(dst, b, h) do { _Pragma("unroll") for (int m = 0; m < 4; ++m) _Pragma("unroll") for (int k = 0; k < 2; ++k) dst[m][k] = *(const LAS bf16x8*)(lds + PG8_SA(b, h) + aoff + m * 2048 + k * 1024); } while (0)
#define PG8_LDB(dst, b, h) do { _Pragma("unroll") for (int n = 0; n < 2; ++n) _Pragma("unroll") for (int k = 0; k < 2; ++k) dst[n][k] = *(const LAS bf16x8*)(lds + PG8_SB(b, h) + boff + n * 2048 + k * 1024); } while (0)
#define PG8_MMA(ai, bj, At, Bt) do { __builtin_amdgcn_s_setprio(1); _Pragma("unroll") for (int m = 0; m < 4; ++m) _Pragma("unroll") for (int n = 0; n < 2; ++n) _Pragma("unroll") for (int k = 0; k < 2; ++k) \
        acc[ai][bj][m][n] = __builtin_amdgcn_mfma_f32_16x16x32_bf16(Bt[n][k], At[m][k], acc[ai][bj][m][n], 0, 0, 0); __builtin_amdgcn_s_setprio(0); } while (0)
#define PG8_WAIT_V(n) asm volatile("s_waitcnt vmcnt(" #n ")" ::: "memory")
#define PG8_WAIT_L(n) asm volatile("s_waitcnt lgkmcnt(" #n ")" ::: "memory")
#define PG8_BAR __builtin_amdgcn_s_barrier()
#define PG8_SCHED __builtin_amdgcn_sched_barrier(0)
    Unit cur, nxt; int ui = 0;
    if (!S.next(0, cur)) return;
    f32x4 acc[2][2][4][2];
#pragma unroll
    for (int a = 0; a < 2; ++a)
#pragma unroll
        for (int b = 0; b < 2; ++b)
#pragma unroll
            for (int m = 0; m < 4; ++m)
#pragma unroll
                for (int n = 0; n < 2; ++n) acc[a][b][m][n] = (f32x4){0.f, 0.f, 0.f, 0.f};
    bf16x8 At[4][2], B0[2][2], B1[2][2];
    const char* cA = (const char*)g.A + (size_t)cur.pm * tstep; const char* cB = (const char*)g.Bt + (size_t)S.btile(cur) * tstep;
    S.a_ready(cur);
    if constexpr (SP2) {
        PG8_STAGE(PG8_SB(0, 0), cB, voffB); PG8_STAGE(PG8_SB(0, 1), cB + hstep, voffB); PG8_STAGE(PG8_SA(0, 0), cA, voffA); PG8_STAGE(PG8_SA(0, 1), cA + hstep, voffA);
        if (wr == 1) PG8_BAR;
        PG8_WAIT_V(2); PG8_BAR;
        PG8_STAGE(PG8_SB(1, 0), cB + kstep, voffB); PG8_STAGE(PG8_SA(1, 0), cA + kstep, voffA); PG8_STAGE(PG8_SB(1, 1), cB + hstep + kstep, voffB);
        PG8_WAIT_V(6); PG8_BAR;
    } else {
        PG8_STAGE(PG8_SB(0, 0), cB, voffB); PG8_STAGE(PG8_SA(0, 0), cA, voffA); PG8_STAGE(PG8_SB(0, 1), cB + hstep, voffB); PG8_STAGE(PG8_SA(0, 1), cA + hstep, voffA);
        if (wr == 1) PG8_BAR;
        PG8_WAIT_V(4); PG8_BAR;
        PG8_STAGE(PG8_SB(1, 0), cB + kstep, voffB); PG8_STAGE(PG8_SA(1, 0), cA + kstep, voffA); PG8_STAGE(PG8_SB(1, 1), cB + hstep + kstep, voffB);
        PG8_WAIT_V(6); PG8_BAR;
    }
    for (;;) {
        const bool has_next = S.next(ui + 1, nxt);
        const char* nA = has_next ? (const char*)g.A + (size_t)nxt.pm * tstep : cA; const char* nB = has_next ? (const char*)g.Bt + (size_t)S.btile(nxt) * tstep : cB;
        for (int t = 0; t < nt; t += 2) {
            const bool last = (t == nt - 2);
            const char* a1 = cA + (size_t)(t + 1) * kstep;
            const char* a2 = last ? nA : cA + (size_t)(t + 2) * kstep; const char* b2 = last ? nB : cB + (size_t)(t + 2) * kstep;
            const char* a3 = a2 + kstep; const char* b3 = b2 + kstep;
            if (last && has_next) S.a_ready(nxt);
            if constexpr (SP2) {
            PG8_LDB(B0, 0, 0); PG8_LDB(B1, 0, 1); PG8_SCHED; PG8_LDA(At, 0, 0); PG8_STAGE(PG8_SA(1, 1), a1 + hstep, voffA);
            PG8_WAIT_V(8); PG8_WAIT_L(0); PG8_BAR; PG8_MMA(0, 0, At, B0); PG8_MMA(0, 1, At, B1); PG8_BAR; PG8_SCHED;
            PG8_LDA(At, 0, 1); PG8_STAGE(PG8_SB(0, 0), b2, voffB); PG8_STAGE(PG8_SB(0, 1), b2 + hstep, voffB); PG8_STAGE(PG8_SA(0, 0), a2, voffA);
            PG8_WAIT_V(8); PG8_WAIT_L(0); PG8_BAR; PG8_MMA(1, 0, At, B0); PG8_MMA(1, 1, At, B1); PG8_BAR; PG8_SCHED;
            PG8_LDB(B0, 1, 0); PG8_LDB(B1, 1, 1); PG8_SCHED; PG8_LDA(At, 1, 0); PG8_STAGE(PG8_SA(0, 1), a2 + hstep, voffA);
            PG8_WAIT_V(8); PG8_WAIT_L(0); PG8_BAR; PG8_MMA(0, 0, At, B0); PG8_MMA(0, 1, At, B1); PG8_BAR; PG8_SCHED;
            PG8_LDA(At, 1, 1); PG8_STAGE(PG8_SB(1, 0), b3, voffB); PG8_STAGE(PG8_SB(1, 1), b3 + hstep, voffB); PG8_STAGE(PG8_SA(1, 0), a3, voffA);
            PG8_WAIT_V(8); PG8_WAIT_L(0); PG8_BAR; PG8_MMA(1, 0, At, B0); PG8_MMA(1, 1, At, B1); PG8_BAR; PG8_SCHED;
            } else {
            PG8_LDB(B0, 0, 0); PG8_SCHED; PG8_LDA(At, 0, 0); PG8_STAGE(PG8_SA(1, 1), a1 + hstep, voffA);
            PG8_WAIT_L(8); PG8_BAR; PG8_WAIT_L(0); PG8_MMA(0, 0, At, B0); PG8_BAR; PG8_SCHED;
            PG8_LDB(B1, 0, 1); PG8_STAGE(PG8_SB(0, 0), b2, voffB);
            PG8_BAR; PG8_WAIT_L(0); PG8_MMA(0, 1, At, B1); PG8_BAR;
            PG8_LDA(At, 0, 1); PG8_STAGE(PG8_SA(0, 0), a2, voffA);
            PG8_BAR; PG8_WAIT_L(0); PG8_MMA(1, 0, At, B0); PG8_BAR; PG8_SCHED;
            PG8_STAGE(PG8_SB(0, 1), b2 + hstep, voffB);
            PG8_WAIT_V(6); PG8_BAR; PG8_MMA(1, 1, At, B1); PG8_BAR;
            PG8_LDB(B0, 1, 0); PG8_SCHED; PG8_LDA(At, 1, 0); PG8_STAGE(PG8_SA(0, 1), a2 + hstep, voffA);
            PG8_WAIT_L(8); PG8_BAR; PG8_WAIT_L(0); PG8_MMA(0, 0, At, B0); PG8_BAR; PG8_SCHED;
            PG8_LDB(B1, 1, 1); PG8_STAGE(PG8_SB(1, 0), b3, voffB);
            PG8_BAR; PG8_WAIT_L(0); PG8_MMA(0, 1, At, B1); PG8_BAR;
            PG8_LDA(At, 1, 1); PG8_STAGE(PG8_SA(1, 0), a3, voffA);
            PG8_BAR; PG8_WAIT_L(0); PG8_MMA(1, 0, At, B0); PG8_BAR; PG8_SCHED;
            PG8_STAGE(PG8_SB(1, 1), b3 + hstep, voffB);
            PG8_WAIT_V(6); PG8_BAR; PG8_MMA(1, 1, At, B1); PG8_BAR;
            }
        }
        if constexpr (ALIGN_EPI) { if (wr == 0) PG8_BAR; }
        E(acc, cur, wr, wc, fr, fq); S.done(cur);
        if (!has_next) break;
#pragma unroll
        for (int a = 0; a < 2; ++a)
#pragma unroll
            for (int b = 0; b < 2; ++b)
#pragma unroll
                for (int m = 0; m < 4; ++m)
#pragma unroll
                    for (int n = 0; n < 2; ++n) acc[a][b][m][n] = (f32x4){0.f, 0.f, 0.f, 0.f};
        cur = nxt; cA = nA; cB = nB; ++ui;
        if constexpr (ALIGN_EPI) { if (wr == 1) PG8_BAR; }
    }
    PG8_WAIT_V(0);
    if constexpr (!ALIGN_EPI) { if (wr == 0) PG8_BAR; }
    PG8_BAR;
#undef PG8_SA
#undef PG8_SB
#undef PG8_STAGE
#undef PG8_LDA
#undef PG8_LDB
#undef PG8_MMA
#undef PG8_WAIT_V
#undef PG8_WAIT_L
#undef PG8_BAR
#undef PG8_SCHED
}
}

#define XB_TMO      128
#define XB_XCNT(j)  (256  + 64 * (j))
#define XB_XSUB(j)  (1280 + 64 * (j))
#define XB_XGEN(j)  (2304 + 64 * (j))
#define XB_TOP      3328
#define XB_TOPGEN   3392
#define XCD_BAR_WORDS 3456
#define XB_SPIN_CAP (1u << 18)

__device__ __forceinline__ unsigned xb_ld(unsigned* p)              { return __hip_atomic_load(p, __ATOMIC_RELAXED, __HIP_MEMORY_SCOPE_AGENT); }
__device__ __forceinline__ unsigned xb_add(unsigned* p, unsigned v) { return __hip_atomic_fetch_add(p, v, __ATOMIC_RELAXED, __HIP_MEMORY_SCOPE_AGENT); }
__device__ __forceinline__ unsigned xb_xcc_id() { return (unsigned)__builtin_amdgcn_s_getreg((3 << 11) | 20) & 0xFu; }
#define XB_SPIN(cond, bar) do { unsigned _sp = 0; while (cond) { __builtin_amdgcn_s_sleep(1); \
    if ((++_sp & 255u) == 0u) { if (xb_ld(&(bar)[XB_TMO])) break; if (_sp > XB_SPIN_CAP) { atomicAdd(&(bar)[XB_TMO], 1u); break; } } } } while (0)

struct XcdBarrier { unsigned* bar; unsigned x; volatile LAS unsigned* st; };

__device__ __forceinline__ XcdBarrier xcd_barrier_post(unsigned* bar, volatile LAS unsigned* st) {
    XcdBarrier b; b.bar = bar; b.x = xb_xcc_id(); b.st = st;
    if (threadIdx.x == 0) (void)xb_add(&bar[XB_XCNT(b.x)], 1u);
    return b;
}
__device__ __forceinline__ void xcd_barrier_complete(unsigned* bar, unsigned x, unsigned& nloc, unsigned& nx) {
    const unsigned G = gridDim.x * gridDim.y * gridDim.z;
    unsigned sum, cnt, mine, sp = 0u;
    for (;;) {
        sum = 0u; cnt = 0u; mine = 0u;
#pragma unroll
        for (unsigned j = 0; j < 16; ++j) { const unsigned c = xb_ld(&bar[XB_XCNT(j)]); sum += c; cnt += (c > 0u) ? 1u : 0u; mine = (j == x) ? c : mine; }
        if (sum == G) break;
        __builtin_amdgcn_s_sleep(1);
        if ((++sp & 255u) == 0u) { if (xb_ld(&bar[XB_TMO])) break; if (sp > XB_SPIN_CAP) { atomicAdd(&bar[XB_TMO], 1u); break; } }
    }
    nloc = mine > 0u ? mine : 1u; nx = cnt > 0u ? cnt : 1u;
}
__device__ __forceinline__ void xcd_barrier(const XcdBarrier& b) {
    asm volatile("s_waitcnt vmcnt(0)" ::: "memory");
    __syncthreads();
    if (threadIdx.x == 0) {
        unsigned* bar = b.bar;
        __builtin_amdgcn_s_waitcnt(0);
        unsigned nloc = b.st[0], nx = b.st[1];
        if (nloc == 0u) { xcd_barrier_complete(bar, b.x, nloc, nx); b.st[0] = nloc; b.st[1] = nx; }
        const unsigned old = xb_add(&bar[XB_XSUB(b.x)], 1u);
        const unsigned gen = old / nloc;
        if (old + 1u == (gen + 1u) * nloc) {
            __builtin_amdgcn_fence(__ATOMIC_RELEASE, "agent");
            asm volatile("s_waitcnt vmcnt(0)" ::: "memory");
            const unsigned og = xb_add(&bar[XB_TOP], 1u);
            const unsigned tg = og / nx;
            if (og + 1u == (tg + 1u) * nx) xb_add(&bar[XB_TOPGEN], 1u);
            else XB_SPIN(xb_ld(&bar[XB_TOPGEN]) == tg, bar);
            __builtin_amdgcn_fence(__ATOMIC_ACQUIRE, "agent");
            xb_add(&bar[XB_XGEN(b.x)], 1u);
            asm volatile("s_waitcnt vmcnt(0)" ::: "memory");
        } else {
            XB_SPIN(xb_ld(&bar[XB_XGEN(b.x)]) == gen, bar);
            __builtin_amdgcn_fence(__ATOMIC_ACQUIRE, "agent");
            asm volatile("s_waitcnt vmcnt(0)" ::: "memory");
        }
    }
    __syncthreads();
}

constexpr int NWAVES = 8;
constexpr int LDS_BYTES = 163840;
constexpr int LDSCTL_OFF = LDS_BYTES - 512, MISC_OFF = LDSCTL_OFF + 320;
constexpr int NPHASE = 2 + 6 * NLAYER;

#define LDS_WAIT() asm volatile("s_waitcnt lgkmcnt(0)" ::: "memory")

struct Args { const float* in[20]; float* out; unsigned char* ws; int ph_lo, ph_hi, li, pad; };

#define CAS __attribute__((address_space(4)))
struct Frame {
    LAS unsigned char* lds;
    int tid, lane, wave, G, gw, NGW;
    const CAS unsigned char* ka;
    __device__ __forceinline__ const float* x() const { return *(const float* const CAS*)(ka + 0); }
    __device__ __forceinline__ const float* c() const { return *(const float* const CAS*)(ka + 8); }
    __device__ __forceinline__ const float* ctx() const { return *(const float* const CAS*)(ka + 16); }
    __device__ __forceinline__ const float* c_ctx() const { return *(const float* const CAS*)(ka + 24); }
    __device__ __forceinline__ const float* w_ada() const { return *(const float* const CAS*)(ka + 32); }
    __device__ __forceinline__ const float* b_ada() const { return *(const float* const CAS*)(ka + 40); }
    __device__ __forceinline__ const float* w_in() const { return *(const float* const CAS*)(ka + 48); }
    __device__ __forceinline__ const float* conv_w() const { return *(const float* const CAS*)(ka + 56); }
    __device__ __forceinline__ const float* sink() const { return *(const float* const CAS*)(ka + 64); }
    __device__ __forceinline__ const float* g_attn() const { return *(const float* const CAS*)(ka + 72); }
    __device__ __forceinline__ const float* g_conv() const { return *(const float* const CAS*)(ka + 80); }
    __device__ __forceinline__ const float* w_out() const { return *(const float* const CAS*)(ka + 88); }
    __device__ __forceinline__ const float* ln1_g() const { return *(const float* const CAS*)(ka + 96); }
    __device__ __forceinline__ const float* ln1_b() const { return *(const float* const CAS*)(ka + 104); }
    __device__ __forceinline__ const float* wq() const { return *(const float* const CAS*)(ka + 112); }
    __device__ __forceinline__ const float* keys() const { return *(const float* const CAS*)(ka + 120); }
    __device__ __forceinline__ const float* pu() const { return *(const float* const CAS*)(ka + 128); }
    __device__ __forceinline__ const float* pv() const { return *(const float* const CAS*)(ka + 136); }
    __device__ __forceinline__ const float* ln2_g() const { return *(const float* const CAS*)(ka + 144); }
    __device__ __forceinline__ const float* ln2_b() const { return *(const float* const CAS*)(ka + 152); }
    __device__ __forceinline__ float* out() const { return *(float* const CAS*)(ka + 160); }
    __device__ __forceinline__ unsigned char* ws() const { return *(unsigned char* const CAS*)(ka + 168); }
    __device__ __forceinline__ float* MODS() const { return (float*)(ws() + WS_MODS); }
    __device__ __forceinline__ float* ROPE() const { return (float*)(ws() + WS_ROPE); }
    __device__ __forceinline__ bf16_t* X() const { return (bf16_t*)(ws() + WS_X); }
    __device__ __forceinline__ float* SC() const { return (float*)(ws() + WS_SC); }
    __device__ __forceinline__ bf16_t* KBD() const { return (bf16_t*)(ws() + WS_KBD); }
    __device__ __forceinline__ bf16_t* WQR() const { return (bf16_t*)(ws() + WS_WQR); }
    __device__ __forceinline__ bf16_t* WINT() const { return (bf16_t*)(ws() + WS_WINT); }
    __device__ __forceinline__ bf16_t* WOUTT() const { return (bf16_t*)(ws() + WS_WOUTT); }
    __device__ __forceinline__ bf16_t* WEFFT() const { return (bf16_t*)(ws() + WS_WEFFT); }
    __device__ __forceinline__ bf16_t* H() const { return (bf16_t*)(ws() + WS_H); }
    __device__ __forceinline__ bf16_t* PROJ() const { return (bf16_t*)(ws() + WS_PROJ); }
    __device__ __forceinline__ bf16_t* MIX() const { return (bf16_t*)(ws() + WS_MIX); }
    __device__ __forceinline__ unsigned char* UT() const { return (unsigned char*)(ws() + WS_UT); }
    __device__ __forceinline__ unsigned char* VT() const { return (unsigned char*)(ws() + WS_VT); }
    __device__ __forceinline__ float* US() const { return (float*)(ws() + WS_US); }
    __device__ __forceinline__ float* VS() const { return (float*)(ws() + WS_VS); }
};

__device__ __forceinline__ void frame_ids(Frame& F) {
    int tz = threadIdx.x; asm volatile("" : "+v"(tz));
    F.tid = tz; F.lane = tz & 63; F.wave = __builtin_amdgcn_readfirstlane(tz >> 6);
    F.gw = blockIdx.x * NWAVES + F.wave;
    const CAS unsigned char* k = (const CAS unsigned char*)__builtin_amdgcn_kernarg_segment_ptr(); asm volatile("" : "+s"(k)); F.ka = k;
}
template <int CTRL> __device__ __forceinline__ int dpp_i(int v) { return __builtin_amdgcn_update_dpp(0, v, CTRL, 0xf, 0xf, true); }
template <int CTRL> __device__ __forceinline__ float dpp_f(float v) { return __int_as_float(dpp_i<CTRL>(__float_as_int(v))); }
constexpr int DPP_XOR1 = 0xB1, DPP_XOR2 = 0x4E, DPP_HMIRROR = 0x141, DPP_ROR4 = 0x124, DPP_ROR8 = 0x128;
__device__ __forceinline__ float wave_sum_u(float v) {
    v += dpp_f<DPP_XOR1>(v); v += dpp_f<DPP_XOR2>(v); v += dpp_f<DPP_ROR4>(v); v += dpp_f<DPP_ROR8>(v);
    const float r0 = __int_as_float(__builtin_amdgcn_readlane(__float_as_int(v), 0)), r1 = __int_as_float(__builtin_amdgcn_readlane(__float_as_int(v), 16));
    const float r2 = __int_as_float(__builtin_amdgcn_readlane(__float_as_int(v), 32)), r3 = __int_as_float(__builtin_amdgcn_readlane(__float_as_int(v), 48));
    return (r0 + r1) + (r2 + r3);
}
__device__ __forceinline__ float wave_max_u(float v) {
    v = fmaxf(v, dpp_f<DPP_XOR1>(v)); v = fmaxf(v, dpp_f<DPP_XOR2>(v)); v = fmaxf(v, dpp_f<DPP_ROR4>(v)); v = fmaxf(v, dpp_f<DPP_ROR8>(v));
    const float r0 = __int_as_float(__builtin_amdgcn_readlane(__float_as_int(v), 0)), r1 = __int_as_float(__builtin_amdgcn_readlane(__float_as_int(v), 16));
    const float r2 = __int_as_float(__builtin_amdgcn_readlane(__float_as_int(v), 32)), r3 = __int_as_float(__builtin_amdgcn_readlane(__float_as_int(v), 48));
    return fmaxf(fmaxf(r0, r1), fmaxf(r2, r3));
}
__device__ __forceinline__ float xor32_f(float v, int lane) { return __int_as_float(__builtin_amdgcn_ds_bpermute((lane ^ 32) << 2, __float_as_int(v))); }
__device__ __forceinline__ float wave_sum(float v) { return wave_sum_u(v); }
__device__ __forceinline__ unsigned pk2(float lo, float hi) { return pg8::cvt_pk_bf16(lo, hi); }
__device__ __forceinline__ float bf_lo(unsigned u) { return __uint_as_float(u << 16); }
__device__ __forceinline__ float bf_hi(unsigned u) { return __uint_as_float(u & 0xffff0000u); }
__device__ __forceinline__ int modrow(int t) { return t < TL ? t / SEQ : 2; }

__device__ __forceinline__ void transpose_item(const float* W, int K, int N, bf16_t* WT, LAS float* scr, int item, int lane) {
    const int nblk = N / 32, kb = item / nblk, nb = item % nblk, k0 = 64 * kb, n0 = 32 * nb;
#pragma unroll 8
    for (int i = 0; i < 32; ++i) { const int kk = 2 * i + (lane >> 5); scr[kk * 33 + (lane & 31)] = W[(size_t)(k0 + kk) * N + n0 + (lane & 31)]; }
    LDS_WAIT(); asm volatile("" ::: "memory");
    const int c = lane & 7;
#pragma unroll
    for (int j = 0; j < 4; ++j) { const int n = (lane >> 3) + 8 * j; const LAS float* s = scr + (8 * c) * 33 + n;
        u32x4 o; o.x = pk2(s[0 * 33], s[1 * 33]); o.y = pk2(s[2 * 33], s[3 * 33]); o.z = pk2(s[4 * 33], s[5 * 33]); o.w = pk2(s[6 * 33], s[7 * 33]);
        *(u32x4*)(WT + (size_t)(n0 + n) * K + k0 + 8 * c) = o; }
    LDS_WAIT(); asm volatile("" ::: "memory");
}

__device__ __forceinline__ void cvt_row_bf16(const float* src, bf16_t* dst, int lane) {
    const f32x4* s = (const f32x4*)src + lane; u32x2* d = (u32x2*)dst + lane;
    f32x4 v[8];
#pragma unroll
    for (int j = 0; j < 8; ++j) v[j] = __builtin_nontemporal_load(s + 64 * j);
#pragma unroll
    for (int j = 0; j < 8; ++j) { u32x2 o; o.x = pk2(v[j].x, v[j].y); o.y = pk2(v[j].z, v[j].w); d[64 * j] = o; }
}

struct RowF32 { f32x4 v[4][2]; };
__device__ __forceinline__ void row_load_nt(RowF32& R, const float* src, int lane) {
    const f32x4* s = (const f32x4*)src + 2 * lane;
#pragma unroll
    for (int j = 0; j < 4; ++j) { R.v[j][0] = __builtin_nontemporal_load(s + 128 * j); R.v[j][1] = __builtin_nontemporal_load(s + 128 * j + 1); }
}
template <int FMT>
__device__ __forceinline__ void cvt_row_lp(const RowF32& R, unsigned char* dst, float* inv, int lane) {
    constexpr float QMAX = FMT == 8 ? 224.f : 6.f;
    float am = 0.f;
#pragma unroll
    for (int j = 0; j < 4; ++j)
#pragma unroll
        for (int q = 0; q < 2; ++q) am = fmaxf(fmaxf(am, fmaxf(fabsf(R.v[j][q].x), fabsf(R.v[j][q].y))), fmaxf(fabsf(R.v[j][q].z), fabsf(R.v[j][q].w)));
    am = wave_max_u(am);
    const float sc = am > 0.f ? QMAX / am : 1.f;
#pragma unroll
    for (int j = 0; j < 4; ++j) {
        if constexpr (FMT == 8) {
            u32x2 w;
#pragma unroll
            for (int q = 0; q < 2; ++q) { int t = __builtin_amdgcn_cvt_pk_fp8_f32(R.v[j][q].x * sc, R.v[j][q].y * sc, 0, false); t = __builtin_amdgcn_cvt_pk_fp8_f32(R.v[j][q].z * sc, R.v[j][q].w * sc, t, true); w[q] = (unsigned)t; }
            *((u32x2*)dst + lane + 64 * j) = w;
        } else {
            unsigned w = 0u;
            w = __builtin_amdgcn_cvt_scalef32_pk_fp4_f32(w, R.v[j][0].x * sc, R.v[j][0].y * sc, 1.0f, 0);
            w = __builtin_amdgcn_cvt_scalef32_pk_fp4_f32(w, R.v[j][0].z * sc, R.v[j][0].w * sc, 1.0f, 1);
            w = __builtin_amdgcn_cvt_scalef32_pk_fp4_f32(w, R.v[j][1].x * sc, R.v[j][1].y * sc, 1.0f, 2);
            w = __builtin_amdgcn_cvt_scalef32_pk_fp4_f32(w, R.v[j][1].z * sc, R.v[j][1].w * sc, 1.0f, 3);
            *((unsigned*)dst + lane + 64 * j) = w;
        }
    }
    if (lane == 0) *inv = am > 0.f ? am * (1.f / QMAX) : 1.f;
}
template <int FMT> struct LpRow;
template <> struct LpRow<8> { u32x4 a, b;
    __device__ __forceinline__ void load(const unsigned char* rowp, int lane) { a = *(const u32x4*)(rowp + 32 * lane); b = *(const u32x4*)(rowp + 32 * lane + 16); }
    template <class Fn> __device__ __forceinline__ void each(Fn&& f) const {
#pragma unroll
        for (int w = 0; w < 4; ++w) { const f32x2 l0 = __builtin_amdgcn_cvt_pk_f32_fp8((int)a[w], false), h0 = __builtin_amdgcn_cvt_pk_f32_fp8((int)a[w], true);
            f(4 * w, l0.x, l0.y); f(4 * w + 2, h0.x, h0.y); }
#pragma unroll
        for (int w = 0; w < 4; ++w) { const f32x2 l0 = __builtin_amdgcn_cvt_pk_f32_fp8((int)b[w], false), h0 = __builtin_amdgcn_cvt_pk_f32_fp8((int)b[w], true);
            f(16 + 4 * w, l0.x, l0.y); f(16 + 4 * w + 2, h0.x, h0.y); }
    } };
template <> struct LpRow<4> { u32x4 a;
    __device__ __forceinline__ void load(const unsigned char* rowp, int lane) { a = *(const u32x4*)(rowp + 16 * lane); }
    template <class Fn> __device__ __forceinline__ void each(Fn&& f) const {
#pragma unroll
        for (int w = 0; w < 4; ++w) {
            const f32x2 d0 = __builtin_amdgcn_cvt_scalef32_pk_f32_fp4(a[w], 1.0f, 0), d1 = __builtin_amdgcn_cvt_scalef32_pk_f32_fp4(a[w], 1.0f, 1);
            const f32x2 d2 = __builtin_amdgcn_cvt_scalef32_pk_f32_fp4(a[w], 1.0f, 2), d3 = __builtin_amdgcn_cvt_scalef32_pk_f32_fp4(a[w], 1.0f, 3);
            f(8 * w, d0.x, d0.y); f(8 * w + 2, d1.x, d1.y); f(8 * w + 4, d2.x, d2.y); f(8 * w + 6, d3.x, d3.y); }
    }
    template <class Fn> __device__ __forceinline__ void each_bf(Fn&& f) const {
#pragma unroll
        for (int w = 0; w < 4; ++w) {
            f(4 * w, __builtin_amdgcn_cvt_scalef32_pk_bf16_fp4(a[w], 1.0f, 0)); f(4 * w + 1, __builtin_amdgcn_cvt_scalef32_pk_bf16_fp4(a[w], 1.0f, 1));
            f(4 * w + 2, __builtin_amdgcn_cvt_scalef32_pk_bf16_fp4(a[w], 1.0f, 2)); f(4 * w + 3, __builtin_amdgcn_cvt_scalef32_pk_bf16_fp4(a[w], 1.0f, 3)); }
    } };

__device__ __forceinline__ void row_stats(const f32x4 (&v)[8], float& mean, float& rstd) {
    float s = 0.f;
#pragma unroll
    for (int j = 0; j < 8; ++j) s += (v[j].x + v[j].y) + (v[j].z + v[j].w);
    mean = wave_sum(s) * (1.f / D);
    float s2 = 0.f;
#pragma unroll
    for (int j = 0; j < 8; ++j) { const f32x4 d = v[j] - mean; s2 += (d.x * d.x + d.y * d.y) + (d.z * d.z + d.w * d.w); }
    rstd = 1.f / sqrtf(wave_sum(s2) * (1.f / D) + LN_EPS);
}
__device__ __forceinline__ void modulate_store(const f32x4 (&v)[8], const float* shift, const float* scale, bf16_t* dst, int lane) {
    float mean, rstd; row_stats(v, mean, rstd);
    u32x2* d = (u32x2*)dst + lane;
#pragma unroll
    for (int j = 0; j < 8; ++j) { const f32x4 sc = *((const f32x4*)scale + lane + 64 * j), sh = *((const f32x4*)shift + lane + 64 * j);
        const f32x4 y = (v[j] - mean) * rstd * (sc + 1.f) + sh;
        u32x2 o; o.x = pk2(y.x, y.y); o.y = pk2(y.z, y.w); d[64 * j] = o; }
}

__device__ __forceinline__ void convert_tables(Frame& F, int row0, int row1, int w0, int wstride) {
    RowF32 ru, rv, nu, nv;
    int row = row0 + w0;
    if (row < row1) { row_load_nt(ru, F.pu() + (size_t)row * D, F.lane); row_load_nt(rv, F.pv() + (size_t)row * D, F.lane); }
    while (row < row1) {
        const int nrow = row + wstride;
        if (nrow < row1) { row_load_nt(nu, F.pu() + (size_t)nrow * D, F.lane); row_load_nt(nv, F.pv() + (size_t)nrow * D, F.lane); }
        cvt_row_lp<U_FMT>(ru, F.UT() + (size_t)row * UROW, F.US() + row, F.lane);
        cvt_row_lp<V_FMT>(rv, F.VT() + (size_t)row * VROW, F.VS() + row, F.lane);
        ru = nu; rv = nv; row = nrow;
    }
}
__device__ __forceinline__ void convert_in_tail(Frame& F, int layer, int nunits, int part) {
    if (layer + 1 >= NLAYER) return;
    const int G = F.G, rounds = (nunits + G - 1) / G, nlast = nunits - (rounds - 1) * G;
    const int c = (int)blockIdx.x;
    int nshort = G - nlast, sidx = c - nlast;
    if (nshort <= 0) { nshort = G; sidx = c; }
    else if (sidx < 0) return;
    const int r0 = (layer + 1) * NEXP + part * (NEXP / 2);
    convert_tables(F, r0, r0 + NEXP / 2, sidx * NWAVES + F.wave, nshort * NWAVES);
}
__device__ __forceinline__ void p0a_prologue(Frame& F) {
    LAS float* condL = (LAS float*)F.lds;
    LAS float* red = (LAS float*)(F.lds + 24576);
    for (int i = F.tid; i < 3 * D; i += NWAVES * 64) { const int r = i / D, k = i % D; const float v = r < 2 ? F.c()[r * D + k] : F.c_ctx()[k]; condL[i] = v / (1.f + __expf(-v)); }
    __syncthreads();
    for (int item = blockIdx.x; item < 384; item += F.G) {
        const int l = item / 96, n0 = (item % 96) * 128;
        const float* wp = F.w_ada() + ((size_t)l * D + F.wave * 256) * 12288 + n0 + 2 * F.lane;
        f32x2 a0 = {0.f, 0.f}, a1 = {0.f, 0.f}, a2 = {0.f, 0.f};
#pragma unroll 8
        for (int k = 0; k < 256; ++k) { const f32x2 w = __builtin_nontemporal_load((const f32x2*)(wp + (size_t)k * 12288)); const int kk = F.wave * 256 + k;
            a0 += w * condL[kk]; a1 += w * condL[D + kk]; a2 += w * condL[2 * D + kk]; }
        LAS float* rp = red + F.wave * 384 + 2 * F.lane;
        rp[0] = a0.x; rp[1] = a0.y; rp[128] = a1.x; rp[129] = a1.y; rp[256] = a2.x; rp[257] = a2.y;
        __syncthreads();
        if (F.tid < 384) { const int r = F.tid / 128, n = F.tid % 128; float s = 0.f;
#pragma unroll
            for (int w = 0; w < 8; ++w) s += red[w * 384 + r * 128 + n];
            F.MODS()[((size_t)l * 3 + r) * 12288 + n0 + n] = s + F.b_ada()[(size_t)l * 12288 + n0 + n]; }
        __syncthreads();
    }
    LAS float* scr = (LAS float*)(F.lds + 40960 + F.wave * 8448);
    constexpr int I_IN = (D / 64) * (INC / 32), I_OUT = (D / 64) * (D / 32);
    for (int it = F.gw; it < NLAYER * (I_IN + I_OUT); it += F.NGW) {
        const int l = it / (I_IN + I_OUT); int r = it % (I_IN + I_OUT);
        if (r < I_IN) transpose_item(F.w_in() + (size_t)l * D * INC, D, INC, F.WINT() + (size_t)l * INC * D, scr, r, F.lane);
        else transpose_item(F.w_out() + (size_t)l * D * D, D, D, F.WOUTT() + (size_t)l * D * D, scr, r - I_IN, F.lane);
    }
    for (int row = F.gw; row < NLAYER * D; row += F.NGW) {
        const int l = row / D, c = row % D; const f32x4* s = (const f32x4*)(F.wq() + (size_t)row * D) + F.lane;
#pragma unroll
        for (int j = 0; j < 8; ++j) { const f32x4 v = s[64 * j]; u32x2 o; o.x = pk2(v.x, v.y); o.y = pk2(v.z, v.w);
            *((u32x2*)(F.WQR() + ((size_t)(l * 8 + j) * D + c) * 256) + F.lane) = o; }
    }
    for (int row = F.gw; row < 32 * 256; row += F.NGW) {
        const int lh = row >> 8, pk = row & 255, p = pk >> 7;
        u32x2 o = {0u, 0u};
        if ((F.lane >> 5) == p) { const f32x4 v = *((const f32x4*)(F.keys() + ((size_t)lh * 256 + pk) * 128) + (F.lane & 31)); o.x = pk2(v.x, v.y); o.y = pk2(v.z, v.w); }
        *((u32x2*)(F.KBD() + (size_t)row * 256) + F.lane) = o;
    }
    convert_tables(F, 0, NEXP, F.gw, F.NGW);
    for (int i = blockIdx.x * (NWAVES * 64) + F.tid; i < 192 * 32; i += F.G * NWAVES * 64) {
        const int idx = i >> 5, f = i & 31; const float pos = (float)(idx < 128 ? idx : idx - 128);
        const float inv = powf(10000.f, -(float)(2 * f) / 64.f); const float ang = pos * inv;
        F.ROPE()[2 * i] = cosf(ang); F.ROPE()[2 * i + 1] = sinf(ang);
    }
}

__device__ __forceinline__ void p0b_mod0(Frame& F) {
    for (int t = F.gw; t < TT; t += F.NGW) {
        const float* src = t < TL ? F.x() + (size_t)t * D : F.ctx() + (size_t)(t - TL) * D;
        f32x4 v[8];
#pragma unroll
        for (int j = 0; j < 8; ++j) v[j] = *((const f32x4*)src + F.lane + 64 * j);
        const float* mp = F.MODS() + (size_t)modrow(t) * 12288;
        modulate_store(v, mp, mp + D, F.H() + (size_t)t * D, F.lane);
    }
}

constexpr int KP = 272, VP = 320, KS_BYTES = 64 * KP, VS_BYTES = 64 * VP;
struct KVRegs { u32x4 k1, k2, v1, v2; f32x4 cs[4]; };

__device__ __forceinline__ void attn_load_tile(Frame& F, KVRegs& R, int ti, int b, int n, int g) {
    const int key = F.tid >> 3, c8 = F.tid & 7;
    int row, pos = 0;
    if (ti < 6) { pos = (n - 1) * 128 + 64 * ti + key; row = b * SEQ + pos; } else row = TL + b * CTXL + 64 * (ti - 6) + key;
    const bf16_t* base = F.PROJ() + (size_t)row * INC;
    const int d1 = (c8 >> 2) * 64 + (c8 & 3) * 8;
    R.k1 = *(const u32x4*)(base + OFF_K + g * 128 + d1); R.k2 = *(const u32x4*)(base + OFF_K + g * 128 + d1 + 32);
    R.v1 = *(const u32x4*)(base + OFF_V + g * 128 + 8 * c8); R.v2 = *(const u32x4*)(base + OFF_V + g * 128 + 64 + 8 * c8);
    if (ti < 6) { const int tidx = (c8 >> 2) ? 128 + (pos & 63) : (pos >> 6); const f32x4* cp = (const f32x4*)(F.ROPE() + ((size_t)tidx * 32 + (c8 & 3) * 8) * 2);
#pragma unroll
        for (int m = 0; m < 4; ++m) R.cs[m] = cp[m]; }
}
__device__ __forceinline__ void rope8(u32x4& a, u32x4& bq, const f32x4 (&cs)[4], float scale) {
    u32x4 oa, ob;
#pragma unroll
    for (int w = 0; w < 4; ++w) {
        const float x1l = bf_lo(a[w]), x1h = bf_hi(a[w]), x2l = bf_lo(bq[w]), x2h = bf_hi(bq[w]);
        const float cl = cs[w].x, sl = cs[w].y, ch = cs[w].z, sh = cs[w].w;
        oa[w] = pk2((x1l * cl - x2l * sl) * scale, (x1h * ch - x2h * sh) * scale);
        ob[w] = pk2((x2l * cl + x1l * sl) * scale, (x2h * ch + x1h * sh) * scale);
    }
    a = oa; bq = ob;
}
__device__ __forceinline__ void attn_store_tile(Frame& F, KVRegs& R, int ti, int buf) {
    const int key = F.tid >> 3, c8 = F.tid & 7;
    if (ti < 6) rope8(R.k1, R.k2, R.cs, 1.f);
    const int d1 = (c8 >> 2) * 64 + (c8 & 3) * 8;
    LAS unsigned char* kp = F.lds + buf * KS_BYTES + key * KP;
    *(LAS u32x4*)(kp + d1 * 2) = R.k1; *(LAS u32x4*)(kp + (d1 + 32) * 2) = R.k2;
    LAS unsigned char* vp = F.lds + 2 * KS_BYTES + buf * VS_BYTES + key * VP;
    *(LAS u32x4*)(vp + 16 * c8) = R.v1; *(LAS u32x4*)(vp + 128 + 16 * c8) = R.v2;
}

#define MFMA32(a, b, c) __builtin_amdgcn_mfma_f32_32x32x16_bf16((a), (b), (c), 0, 0, 0)

__device__ __forceinline__ void attn_unit(Frame& F, int layer, int u) {
    const bool latent = u < 512;
    int b, n, g, hp;
    if (latent) { hp = u & 1; g = (u >> 1) & 1; n = (u >> 2) & 63; b = u >> 8; }
    else { const int v = u - 512; hp = v & 1; g = (v >> 1) & 1; n = (v >> 2) & 1; b = v >> 3; }
    const int lane = F.lane, r = lane & 31, h = lane >> 5, wave = F.wave;
    const int head = g * 4 + hp * 2 + (wave >> 2), qb = wave & 3;
    const int tq = latent ? b * SEQ + n * 128 + 32 * qb + r : TL + b * CTXL + n * 128 + 32 * qb + r;
    bf16x8 qf[8];
    {
        u32x4 raw[8];
        const bf16_t* qp = F.PROJ() + (size_t)tq * INC + OFF_Q + head * 128 + 8 * h;
#pragma unroll
        for (int ks = 0; ks < 8; ++ks) raw[ks] = *(const u32x4*)(qp + 16 * ks);
        if (latent) {
            const int pos = n * 128 + 32 * qb + r;
#pragma unroll
            for (int half = 0; half < 2; ++half) {
                const int tidx = half ? 128 + (pos & 63) : (pos >> 6);
#pragma unroll
                for (int kk = 0; kk < 2; ++kk) {
                    const f32x4* cp = (const f32x4*)(F.ROPE() + ((size_t)tidx * 32 + 16 * kk + 8 * h) * 2);
                    f32x4 cs[4];
#pragma unroll
                    for (int m = 0; m < 4; ++m) cs[m] = cp[m];
                    rope8(raw[4 * half + kk], raw[4 * half + kk + 2], cs, QSCALE);
                }
            }
        } else {
#pragma unroll
            for (int ks = 0; ks < 8; ++ks)
#pragma unroll
                for (int w = 0; w < 4; ++w) raw[ks][w] = pk2(bf_lo(raw[ks][w]) * QSCALE, bf_hi(raw[ks][w]) * QSCALE);
        }
#pragma unroll
        for (int ks = 0; ks < 8; ++ks) qf[ks] = __builtin_bit_cast(bf16x8, raw[ks]);
    }
    int tlo = 6, nw = 0;
    if (latent) { tlo = (n == 0) ? 2 : 0; const int thi = (n == 63) ? 3 : 5; nw = thi - tlo + 1; }
    const int ntiles = nw + 4;
    f32x16 o[4];
#pragma unroll
    for (int db = 0; db < 4; ++db)
#pragma unroll
        for (int i = 0; i < 16; ++i) o[db][i] = 0.f;
    float m_run = F.sink()[layer * 8 + head] * LOG2E;
    float lsum = h == 0 ? 1.f : 0.f;
    const int iq = 32 * qb + r;
    KVRegs R;
    __syncthreads();
    attn_load_tile(F, R, nw > 0 ? tlo : 6, b, n, g);
    attn_store_tile(F, R, nw > 0 ? tlo : 6, 0);
    __syncthreads();
    const int i16 = lane & 15, tq4 = i16 >> 2, tp = i16 & 3, blk = (lane >> 4) & 1;
    for (int j = 0; j < ntiles; ++j) {
        const int ti = j < nw ? tlo + j : 6 + (j - nw);
        const int buf = j & 1;
        const bool more = j + 1 < ntiles;
        const int tin = (j + 1) < nw ? tlo + j + 1 : 6 + (j + 1 - nw);
        if (more) attn_load_tile(F, R, tin, b, n, g);
        const bool part = ti >= 6 || (ti >= (qb >> 1) && ti <= (qb >> 1) + 4);
        if (part) {
            f32x16 s0, s1;
#pragma unroll
            for (int i = 0; i < 16; ++i) { s0[i] = 0.f; s1[i] = 0.f; }
            const LAS unsigned char* kb = F.lds + buf * KS_BYTES + r * KP + h * 16;
#pragma unroll
            for (int ks = 0; ks < 8; ++ks) {
                const bf16x8 a0 = *(const LAS bf16x8*)(kb + ks * 32), a1 = *(const LAS bf16x8*)(kb + 32 * KP + ks * 32);
                s0 = MFMA32(a0, qf[ks], s0); s1 = MFMA32(a1, qf[ks], s1);
            }
            float mx = -INFINITY;
            if (ti < 6 && (ti == (qb >> 1) || ti == (qb >> 1) + 4)) {
                const int jb = 64 * ti + 4 * h - iq;
#pragma unroll
                for (int i = 0; i < 16; ++i) { const int j0 = jb + (i & 3) + 8 * (i >> 2), j1 = j0 + 32;
                    s0[i] = (j0 >= 0 && j0 <= 256) ? s0[i] : -INFINITY; s1[i] = (j1 >= 0 && j1 <= 256) ? s1[i] : -INFINITY; }
            }
#pragma unroll
            for (int i = 0; i < 16; ++i) mx = fmaxf(mx, fmaxf(s0[i], s1[i]));
            mx = fmaxf(mx, xor32_f(mx, lane));
            if (__any(mx > m_run + 8.f)) {
                const float m_new = mx > m_run + 8.f ? mx : m_run, alpha = __builtin_amdgcn_exp2f(m_run - m_new);
                m_run = m_new; lsum *= alpha;
#pragma unroll
                for (int db = 0; db < 4; ++db)
#pragma unroll
                    for (int i = 0; i < 16; ++i) o[db][i] *= alpha;
            }
#pragma unroll
            for (int i = 0; i < 16; ++i) { s0[i] = __builtin_amdgcn_exp2f(s0[i] - m_run); s1[i] = __builtin_amdgcn_exp2f(s1[i] - m_run); lsum += s0[i] + s1[i]; }
            bf16x8 pf[2][2];
#pragma unroll
            for (int s2 = 0; s2 < 2; ++s2) {
                u32x4 p0, p1;
#pragma unroll
                for (int w = 0; w < 4; ++w) { p0[w] = pk2(s0[8 * s2 + 2 * w], s0[8 * s2 + 2 * w + 1]); p1[w] = pk2(s1[8 * s2 + 2 * w], s1[8 * s2 + 2 * w + 1]); }
                pf[0][s2] = __builtin_bit_cast(bf16x8, p0); pf[1][s2] = __builtin_bit_cast(bf16x8, p1);
            }
            const LAS unsigned char* vb = F.lds + 2 * KS_BYTES + buf * VS_BYTES + (4 * h + tq4) * VP + 32 * blk + 8 * tp;
#pragma unroll
            for (int db = 0; db < 4; ++db)
#pragma unroll
                for (int kb2 = 0; kb2 < 2; ++kb2)
#pragma unroll
                    for (int s2 = 0; s2 < 2; ++s2) {
                        const int off = (32 * kb2 + 16 * s2) * VP + db * 64;
                        const s16x4 lo = __builtin_amdgcn_ds_read_tr16_b64_v4i16((LAS s16x4*)(vb + off));
                        const s16x4 hi = __builtin_amdgcn_ds_read_tr16_b64_v4i16((LAS s16x4*)(vb + off + 8 * VP));
                        const bf16x8 av = __builtin_shufflevector(lo, hi, 0, 1, 2, 3, 4, 5, 6, 7);
                        o[db] = MFMA32(av, pf[kb2][s2], o[db]);
                    }
        }
        if (more) attn_store_tile(F, R, tin, buf ^ 1);
        __syncthreads();
    }
    const float lt = lsum + xor32_f(lsum, lane);
    const float inv = 1.f / lt;
    float ss = 0.f;
#pragma unroll
    for (int db = 0; db < 4; ++db)
#pragma unroll
        for (int i = 0; i < 16; ++i) { o[db][i] *= inv; ss += o[db][i] * o[db][i]; }
    ss += xor32_f(ss, lane);
    const float rn = 1.f / sqrtf(ss * (1.f / 128.f) + LN_EPS);
    bf16_t* op = F.MIX() + (size_t)tq * D + head * 128 + 4 * h;
    const float* gp = F.g_attn() + layer * 1024 + head * 128 + 4 * h;
#pragma unroll
    for (int db = 0; db < 4; ++db)
#pragma unroll
        for (int g4 = 0; g4 < 4; ++g4) {
            const f32x4 gv = *(const f32x4*)(gp + 32 * db + 8 * g4);
            u32x2 w; w.x = pk2(o[db][4 * g4] * rn * gv.x, o[db][4 * g4 + 1] * rn * gv.y); w.y = pk2(o[db][4 * g4 + 2] * rn * gv.z, o[db][4 * g4 + 3] * rn * gv.w);
            *(u32x2*)(op + 32 * db + 8 * g4) = w;
        }
}

__device__ __forceinline__ void unpack8(const u32x4 v, float (&f)[8]) {
#pragma unroll
    for (int w = 0; w < 4; ++w) { f[2 * w] = bf_lo(v[w]); f[2 * w + 1] = bf_hi(v[w]); }
}
__device__ __forceinline__ void conv_row(Frame& F, int layer, int t) {
    bool first, last;
    if (t < TL) { const int pos = t & (SEQ - 1); first = pos == 0; last = pos == SEQ - 1; } else { const int pc = (t - TL) & (CTXL - 1); first = pc == 0; last = pc == CTXL - 1; }
    const bf16_t* p = F.PROJ() + (size_t)t * INC;
    const float* cw = F.conv_w() + (size_t)layer * 3 * 1024;
#pragma unroll
    for (int jc = 0; jc < 2; ++jc) {
        const int c = 8 * F.lane + 512 * jc;
        float gb[8], a[8], bq[8], um[8], ut[8], up[8];
        unpack8(*(const u32x4*)(p + c), gb);
        unpack8(*(const u32x4*)(p + OFF_C + c), a); unpack8(*(const u32x4*)(p + OFF_X + c), bq);
#pragma unroll
        for (int e = 0; e < 8; ++e) ut[e] = a[e] * bq[e];
        if (!first) { unpack8(*(const u32x4*)(p - INC + OFF_C + c), a); unpack8(*(const u32x4*)(p - INC + OFF_X + c), bq);
#pragma unroll
            for (int e = 0; e < 8; ++e) um[e] = a[e] * bq[e]; }
        else {
#pragma unroll
            for (int e = 0; e < 8; ++e) um[e] = 0.f; }
        if (!last) { unpack8(*(const u32x4*)(p + INC + OFF_C + c), a); unpack8(*(const u32x4*)(p + INC + OFF_X + c), bq);
#pragma unroll
            for (int e = 0; e < 8; ++e) up[e] = a[e] * bq[e]; }
        else {
#pragma unroll
            for (int e = 0; e < 8; ++e) up[e] = 0.f; }
        float y[8], ss = 0.f;
#pragma unroll
        for (int e = 0; e < 8; ++e) { y[e] = gb[e] * (cw[c + e] * um[e] + cw[1024 + c + e] * ut[e] + cw[2048 + c + e] * up[e]); ss += y[e] * y[e]; }
        ss += dpp_f<DPP_XOR1>(ss); ss += dpp_f<DPP_XOR2>(ss); ss += dpp_f<DPP_ROR4>(ss); ss += dpp_f<DPP_ROR8>(ss);
        const float rn = 1.f / sqrtf(ss * (1.f / 128.f) + LN_EPS);
        const float* gc = F.g_conv() + layer * 1024 + c;
        u32x4 w;
#pragma unroll
        for (int q = 0; q < 4; ++q) w[q] = pk2(y[2 * q] * rn * gc[2 * q], y[2 * q + 1] * rn * gc[2 * q + 1]);
        *(u32x4*)(F.MIX() + (size_t)t * D + 1024 + c) = w;
    }
}

__device__ __forceinline__ void ln_phase(Frame& F, int layer, int rows) {
    const int lane = F.lane;
    u32x4 w[4], wn[4];
    int t = F.gw;
    if (t < rows) {
#pragma unroll
        for (int j = 0; j < 4; ++j) w[j] = *(const u32x4*)(F.X() + (size_t)t * D + 8 * lane + 512 * j);
    }
    const float* g1 = F.ln1_g() + layer * D; const float* b1 = F.ln1_b() + layer * D;
    while (t < rows) {
        const int tn = t + F.NGW;
        if (tn < rows) {
#pragma unroll
            for (int j = 0; j < 4; ++j) wn[j] = *(const u32x4*)(F.X() + (size_t)tn * D + 8 * lane + 512 * j);
        }
        float v[32]; float s = 0.f;
#pragma unroll
        for (int j = 0; j < 4; ++j)
#pragma unroll
            for (int q = 0; q < 4; ++q) { v[8 * j + 2 * q] = bf_lo(w[j][q]); v[8 * j + 2 * q + 1] = bf_hi(w[j][q]); s += v[8 * j + 2 * q] + v[8 * j + 2 * q + 1]; }
        const float mean = wave_sum(s) * (1.f / D);
        float s2 = 0.f;
#pragma unroll
        for (int i = 0; i < 32; ++i) { v[i] -= mean; s2 += v[i] * v[i]; }
        const float rstd = 1.f / sqrtf(wave_sum(s2) * (1.f / D) + LN_EPS);
        float s3 = 0.f;
#pragma unroll
        for (int j = 0; j < 4; ++j) { const int c = 8 * lane + 512 * j; u32x4 o;
#pragma unroll
            for (int q = 0; q < 2; ++q) { const f32x4 gg = *(const f32x4*)(g1 + c + 4 * q), bb = *(const f32x4*)(b1 + c + 4 * q);
#pragma unroll
                for (int e = 0; e < 4; ++e) { const float y = v[8 * j + 4 * q + e] * rstd * gg[e] + bb[e]; v[8 * j + 4 * q + e] = y; s3 += y; }
                o[2 * q] = pk2(v[8 * j + 4 * q], v[8 * j + 4 * q + 1]); o[2 * q + 1] = pk2(v[8 * j + 4 * q + 2], v[8 * j + 4 * q + 3]); }
            *(u32x4*)(F.X() + (size_t)t * D + c) = o; }
        const float mean2 = wave_sum(s3) * (1.f / D);
        float s4 = 0.f;
#pragma unroll
        for (int i = 0; i < 32; ++i) { v[i] -= mean2; s4 += v[i] * v[i]; }
        const float rstd2 = 1.f / sqrtf(wave_sum(s4) * (1.f / D) + LN_EPS);
        const float* mp = F.MODS() + ((size_t)layer * 3 + modrow(t)) * 12288;
#pragma unroll
        for (int j = 0; j < 4; ++j) { const int c = 8 * lane + 512 * j; u32x4 o;
#pragma unroll
            for (int q = 0; q < 2; ++q) { const f32x4 sh = *(const f32x4*)(mp + 3 * D + c + 4 * q), sc = *(const f32x4*)(mp + 4 * D + c + 4 * q);
                const float y0 = v[8 * j + 4 * q] * rstd2 * (1.f + sc[0]) + sh[0], y1 = v[8 * j + 4 * q + 1] * rstd2 * (1.f + sc[1]) + sh[1];
                const float y2 = v[8 * j + 4 * q + 2] * rstd2 * (1.f + sc[2]) + sh[2], y3 = v[8 * j + 4 * q + 3] * rstd2 * (1.f + sc[3]) + sh[3];
                o[2 * q] = pk2(y0, y1); o[2 * q + 1] = pk2(y2, y3); }
            *(u32x4*)(F.H() + (size_t)t * D + c) = o; }
#pragma unroll
        for (int j = 0; j < 4; ++j) w[j] = wn[j];
        t = tn;
    }
}

__device__ __forceinline__ unsigned ordkey(float f) { const unsigned u = __float_as_uint(f); return u ^ ((u >> 31) ? 0xFFFFFFFFu : 0x80000000u); }
__device__ __forceinline__ float gelu_erf(float a) { return 0.5f * a * (1.f + erff(a * 0.70710678118654752f)); }

__device__ __forceinline__ float unordkey(unsigned k) { return __uint_as_float(k ^ ((k >> 31) ? 0x80000000u : 0xFFFFFFFFu)); }
__device__ __forceinline__ float gelu_as(float v) {
    const float av = fabsf(v), t = __builtin_amdgcn_rcpf(av * 0.2316418882f + 1.0f);
    float q = t * 0.5307027145f + (-0.7265760135f); q = q * t + 0.7107068705f; q = q * t + (-0.142248368f); q = q * t + 0.127414796f; q = q * t;
    const float e = __builtin_amdgcn_exp2f((v * v) * (-0.72134752044f));
    const float m = v * (q * e);
    return v < 0.f ? m : v - m;
}

template <class O> struct QuadNet {
    typedef typename O::V V; typedef typename O::B B;
    template <bool ASC> static __device__ __forceinline__ void ce_reg(V& a, V& b) { const V lo = O::vmin(a, b), hi = O::vmax(a, b); a = ASC ? lo : hi; b = ASC ? hi : lo; }
    template <bool ASC> static __device__ __forceinline__ void ce_l1(V& x, B low1) { const V p = O::x1(x); const V mn = O::vmin(p, x), mx = O::vmax(p, x); x = ASC ? O::vsel(low1, mn, mx) : O::vsel(low1, mx, mn); }
    template <bool ASC> static __device__ __forceinline__ void ce_l2(V& x, B low2) { const V p = O::x2(x); const V mn = O::vmin(p, x), mx = O::vmax(p, x); x = ASC ? O::vsel(low2, mn, mx) : O::vsel(low2, mx, mn); }
    template <int NR> static __device__ __forceinline__ void sort_blocks(V (&R)[NR], B low1, B low2, B eq12) {
#pragma unroll
        for (int r = 0; r < NR; ++r) { const V p = O::x1(R[r]); const V mn = O::vmin(p, R[r]), mx = O::vmax(p, R[r]); R[r] = O::vsel(eq12, mn, mx); }
#pragma unroll
        for (int r = 0; r < NR; ++r) { if ((r & 1) == 0) ce_l2<true>(R[r], low2); else ce_l2<false>(R[r], low2); }
#pragma unroll
        for (int r = 0; r < NR; ++r) { if ((r & 1) == 0) ce_l1<true>(R[r], low1); else ce_l1<false>(R[r], low1); }
#pragma unroll
        for (int r = 0; r < NR; r += 2) { if ((r & 2) == 0) ce_reg<true>(R[r], R[r + 1]); else ce_reg<false>(R[r], R[r + 1]); }
#pragma unroll
        for (int r = 0; r < NR; ++r) { if ((r & 2) == 0) ce_l2<true>(R[r], low2); else ce_l2<false>(R[r], low2); }
#pragma unroll
        for (int r = 0; r < NR; ++r) { if ((r & 2) == 0) ce_l1<true>(R[r], low1); else ce_l1<false>(R[r], low1); }
#pragma unroll
        for (int r = 0; r < NR; ++r) { if ((r & 2) == 0) { if ((r & 4) == 0) ce_reg<true>(R[r], R[r + 2]); else ce_reg<false>(R[r], R[r + 2]); } }
#pragma unroll
        for (int r = 0; r < NR; r += 2) { if ((r & 4) == 0) ce_reg<true>(R[r], R[r + 1]); else ce_reg<false>(R[r], R[r + 1]); }
#pragma unroll
        for (int r = 0; r < NR; ++r) { if ((r & 4) == 0) ce_l2<true>(R[r], low2); else ce_l2<false>(R[r], low2); }
#pragma unroll
        for (int r = 0; r < NR; ++r) { if ((r & 4) == 0) ce_l1<true>(R[r], low1); else ce_l1<false>(R[r], low1); }
    }
    template <int NR> static __device__ __forceinline__ void halve_merge(const V (&R)[NR], V (&Q)[NR / 2], B low1, B low2) {
#pragma unroll
        for (int m = 0; m < NR / 8; ++m)
#pragma unroll
            for (int i = 0; i < 4; ++i) Q[4 * m + i] = O::vmax(R[8 * m + i], R[8 * m + 4 + i]);
#pragma unroll
        for (int r = 0; r < NR / 2; ++r) { if ((r & 2) == 0) { if ((r & 4) == 0) ce_reg<false>(Q[r], Q[r + 2]); else ce_reg<true>(Q[r], Q[r + 2]); } }
#pragma unroll
        for (int r = 0; r < NR / 2; r += 2) { if ((r & 4) == 0) ce_reg<false>(Q[r], Q[r + 1]); else ce_reg<true>(Q[r], Q[r + 1]); }
#pragma unroll
        for (int r = 0; r < NR / 2; ++r) { if ((r & 4) == 0) ce_l2<false>(Q[r], low2); else ce_l2<true>(Q[r], low2); }
#pragma unroll
        for (int r = 0; r < NR / 2; ++r) { if ((r & 4) == 0) ce_l1<false>(Q[r], low1); else ce_l1<true>(Q[r], low1); }
    }
    static __device__ __forceinline__ void top16_of_128(V (&R)[32], V (&T)[4], B low1, B low2, B eq12) {
        sort_blocks<32>(R, low1, low2, eq12);
        V A[16]; halve_merge<32>(R, A, low1, low2);
        V Bq[8]; halve_merge<16>(A, Bq, low1, low2);
        halve_merge<8>(Bq, T, low1, low2);
    }
    static __device__ __forceinline__ void top16_of_64(V (&R)[16], V (&T)[4], B low1, B low2, B eq12) {
        sort_blocks<16>(R, low1, low2, eq12);
        V A[8]; halve_merge<16>(R, A, low1, low2);
        halve_merge<8>(A, T, low1, low2);
    }
};

struct DevOps {
    typedef unsigned V; typedef bool B;
    static __device__ __forceinline__ V vmin(V a, V b) { return a < b ? a : b; }
    static __device__ __forceinline__ V vmax(V a, V b) { return a > b ? a : b; }
    static __device__ __forceinline__ V vsel(B m, V a, V b) { return m ? a : b; }
    static __device__ __forceinline__ V x1(V a) { return (V)dpp_i<DPP_XOR1>((int)a); }
    static __device__ __forceinline__ V x2(V a) { return (V)dpp_i<DPP_XOR2>((int)a); }
};
__device__ __forceinline__ void stair_ab(int c, int& a, int& b) {
    if (c < 16) { a = 0; b = c; } else if (c < 24) { a = 1; b = c - 16; } else if (c < 28) { a = 2; b = c - 24; } else if (c < 32) { a = 3; b = c - 28; }
    else if (c < 36) { a = 4; b = c - 32; } else if (c < 40) { a = 5 + ((c - 36) >> 1); b = (c - 36) & 1; } else if (c < 44) { a = 7 + ((c - 40) >> 1); b = (c - 40) & 1; }
    else if (c < 48) { a = 9 + (c - 44); b = 0; } else if (c < 51) { a = 13 + (c - 48); b = 0; } else { a = 2; b = 4; }
}
constexpr int PE_WS = 5120, PE_TAB = 8 * PE_WS;
constexpr int PE_VEC = PE_TAB + 512;
static_assert(PE_VEC + 11 * 8192 <= LDSCTL_OFF, "PE vector cache");
__device__ __forceinline__ void peer_topk(Frame& F, LAS unsigned char* ws, int t) {
    const int lane = F.lane, sub = lane & 3;
    const bool low1 = (sub & 1) == 0, low2 = (sub & 2) == 0, eq12 = low1 == low2;
    LAS unsigned* S1K = (LAS unsigned*)ws; LAS int* EL = (LAS int*)(ws + 3328); LAS float* GL = (LAS float*)(ws + 3840);
    const LAS unsigned short* TAB = (const LAS unsigned short*)(F.lds + PE_TAB);
    {
        const int L = lane >> 2;
        const float* sp = F.SC() + (size_t)t * D + L * 128 + sub * 4;
        unsigned R[32];
#pragma unroll
        for (int q = 0; q < 8; ++q) { const f32x4 v = *(const f32x4*)(sp + 16 * q);
#pragma unroll
            for (int e = 0; e < 4; ++e) R[4 * q + e] = (ordkey(v[e]) & ~127u) | (unsigned)(127 - (4 * sub + 16 * q + e)); }
        unsigned T[4];
        QuadNet<DevOps>::top16_of_128(R, T, low1, low2, eq12);
#pragma unroll
        for (int r = 0; r < 4; ++r) S1K[L * 16 + 4 * r + sub] = T[r];
    }
    LDS_WAIT(); __builtin_amdgcn_wave_barrier();
    {
        const int hd = (lane >> 2) & 7;
        const LAS unsigned char* la = (const LAS unsigned char*)(S1K + (2 * hd) * 16); const LAS unsigned char* lb = (const LAS unsigned char*)(S1K + (2 * hd + 1) * 16);
        unsigned C[16];
#pragma unroll
        for (int r = 0; r < 13; ++r) { const unsigned ab = TAB[4 * r + sub];
            const unsigned ka = *(const LAS unsigned*)(la + (ab & 255u)), kb = *(const LAS unsigned*)(lb + (ab >> 8));
            const float sum = unordkey(ka & ~127u) + unordkey(kb & ~127u);
            C[r] = (ordkey(sum) & ~63u) | (unsigned)(63 - (4 * r + sub)); }
        C[13] = 0u; C[14] = 0u; C[15] = 0u;
        unsigned W[4];
        QuadNet<DevOps>::top16_of_64(C, W, low1, low2, eq12);
        float sv[4]; int ex[4];
#pragma unroll
        for (int r = 0; r < 4; ++r) { const unsigned ab = TAB[63 - (W[r] & 63u)];
            const unsigned ka = *(const LAS unsigned*)(la + (ab & 255u)), kb = *(const LAS unsigned*)(lb + (ab >> 8));
            ex[r] = (int)(127u - (ka & 127u)) * 128 + (int)(127u - (kb & 127u)); sv[r] = unordkey(W[r] & ~63u); }
        const float mx = dpp_f<0x00>(sv[0]);
        float e4[4], es = 0.f;
#pragma unroll
        for (int r = 0; r < 4; ++r) { e4[r] = __expf(sv[r] - mx); es += e4[r]; }
        es += dpp_f<DPP_XOR1>(es); es += dpp_f<DPP_XOR2>(es);
        const float rd = 1.f / es;
#pragma unroll
        for (int r = 0; r < 4; ++r) { GL[hd * 16 + 4 * r + sub] = e4[r] * rd; EL[hd * 16 + 4 * r + sub] = ex[r]; }
    }
    LDS_WAIT(); __builtin_amdgcn_wave_barrier();
}

#ifndef PROBE_PHASE
#define PROBE_PHASE -1
#endif
#ifndef PROBE_MULT
#define PROBE_MULT 1
#endif
constexpr int EB = 4;
constexpr int CW_TICKET = 20480;

struct GBuf { LpRow<U_FMT> u[EB]; LpRow<V_FMT> v[EB]; };
__device__ __forceinline__ void gather_issue(GBuf& B, const LAS int* EL, int i0, const unsigned char* UTl, const unsigned char* VTl, int lane) {
#pragma unroll
    for (int q = 0; q < EB; ++q) {
        const int ex = __builtin_amdgcn_readfirstlane(EL[i0 + q]);
        B.u[q].load(UTl + (size_t)ex * UROW, lane); B.v[q].load(VTl + (size_t)ex * VROW, lane);
    }
}
__device__ __forceinline__ void gather_compute(const GBuf& B, const LAS int* EL, const LAS float* GL, int i0, const float* USl, const float* VSl, const unsigned (&hv)[16], f32x2 (&acc)[16]) {
    float dot[EB], su[EB], sv[EB], g[EB];
#pragma unroll
    for (int q = 0; q < EB; ++q) { const int ex = __builtin_amdgcn_readfirstlane(EL[i0 + q]); su[q] = USl[ex]; sv[q] = VSl[ex];
        g[q] = __uint_as_float(__builtin_amdgcn_readfirstlane(__float_as_uint(GL[i0 + q]))); }
#pragma unroll
    for (int q = 0; q < EB; ++q) { float s0 = 0.f, s1 = 0.f;
        B.u[q].each_bf([&](int i, bf16x2_t x) { if (i & 1) s1 = __builtin_amdgcn_fdot2_f32_bf16(x, __builtin_bit_cast(bf16x2_t, hv[i]), s1, false); else s0 = __builtin_amdgcn_fdot2_f32_bf16(x, __builtin_bit_cast(bf16x2_t, hv[i]), s0, false); });
        dot[q] = s0 + s1; __builtin_amdgcn_sched_barrier(0); }
#pragma unroll
    for (int q = 0; q < EB; ++q) dot[q] = wave_sum_u(dot[q]);
#pragma unroll
    for (int q = 0; q < EB; ++q) { const float cf = g[q] * gelu_as(dot[q] * su[q]) * sv[q]; const f32x2 c2 = {cf, cf};
        B.v[q].each([&](int i, float x0, float x1) { const f32x2 x = {x0, x1}; acc[i >> 1] = __builtin_elementwise_fma(x, c2, acc[i >> 1]); }); __builtin_amdgcn_sched_barrier(0); }
}

__device__ __forceinline__ void peer_phase(Frame& F, int layer, int rows, unsigned* ctl, unsigned long long& pr_acc) {
    unsigned long long pt0 = 0ull;
#define SUB_BEGIN(ty) do { if (PROBE_PHASE == (ty)) pt0 = __builtin_amdgcn_s_memrealtime(); } while (0)
#define SUB_END(ty) do { if (PROBE_PHASE == (ty)) pr_acc += __builtin_amdgcn_s_memrealtime() - pt0; } while (0)
    if (F.tid < 64) { int a = 0, b = 0; stair_ab(F.tid < 52 ? F.tid : 0, a, b); *(LAS unsigned short*)(F.lds + PE_TAB + 2 * F.tid) = (unsigned short)((4 * a) | ((4 * b) << 8)); }
    {
        const int ch = F.tid, ll = ch >> 3, q = ch & 7;
        LAS unsigned char* dst = F.lds + PE_VEC + (q * 64 + ll) * 16;
        const int nl = layer < NLAYER - 1 ? layer + 1 : layer;
#pragma unroll 1
        for (int v = 0; v < 9; ++v) {
            const int g3 = v / 3, mrv = v - 3 * g3;
            const size_t off = ((size_t)(g3 == 0 ? layer : nl) * 3 + mrv) * 12288 + (g3 == 0 ? 5 * D : (g3 == 1 ? 0 : D));
            *(LAS f32x4*)(dst + v * 8192) = *(const f32x4*)(F.MODS() + off + 4 * ch);
        }
        *(LAS f32x4*)(dst + 9 * 8192) = *(const f32x4*)(F.ln2_g() + layer * D + 4 * ch);
        *(LAS f32x4*)(dst + 10 * 8192) = *(const f32x4*)(F.ln2_b() + layer * D + 4 * ch);
    }
    __syncthreads();
    LAS unsigned char* ws = F.lds + F.wave * PE_WS;
    LAS int* EL = (LAS int*)(ws + 3328); LAS float* GL = (LAS float*)(ws + 3840);
    const int lane = F.lane;
    const LAS unsigned char* vcache = F.lds + PE_VEC + lane * 16;
    const unsigned char* UTl = F.UT() + (size_t)layer * NEXP * UROW;
    const unsigned char* VTl = F.VT() + (size_t)layer * NEXP * VROW;
    const float* USl = F.US() + (size_t)layer * NEXP; const float* VSl = F.VS() + (size_t)layer * NEXP;
    unsigned* ticket = ctl + CW_TICKET + 64 * layer;
    unsigned tk = 0u;
    if (lane == 0) tk = __hip_atomic_fetch_add(ticket, 1u, __ATOMIC_RELAXED, __HIP_MEMORY_SCOPE_AGENT);
    int t = (int)__builtin_amdgcn_readfirstlane(tk);
    while (t < rows) {
        unsigned tkn = 0u;
        if (lane == 0) tkn = __hip_atomic_fetch_add(ticket, 1u, __ATOMIC_RELAXED, __HIP_MEMORY_SCOPE_AGENT);
        SUB_BEGIN(8); peer_topk(F, ws, t); SUB_END(8);
        SUB_BEGIN(9);
        unsigned hv[16]; f32x2 acc[16];
#pragma unroll
        for (int q = 0; q < 4; ++q) { const u32x4 w = *(const u32x4*)(F.H() + (size_t)t * D + 32 * lane + 8 * q);
#pragma unroll
            for (int e = 0; e < 4; ++e) { hv[4 * q + e] = w[e]; acc[4 * q + e] = (f32x2){0.f, 0.f}; } }
        {
            GBuf A, B, C;
            gather_issue(A, EL, 0, UTl, VTl, lane);
            gather_issue(B, EL, EB, UTl, VTl, lane);
            for (int i0 = 0; i0 < 30 * EB; i0 += 3 * EB) {
                gather_issue(C, EL, i0 + 2 * EB, UTl, VTl, lane);
                gather_compute(A, EL, GL, i0, USl, VSl, hv, acc);
                gather_issue(A, EL, i0 + 3 * EB, UTl, VTl, lane);
                gather_compute(B, EL, GL, i0 + EB, USl, VSl, hv, acc);
                gather_issue(B, EL, i0 + 4 * EB, UTl, VTl, lane);
                gather_compute(C, EL, GL, i0 + 2 * EB, USl, VSl, hv, acc);
            }
            gather_compute(A, EL, GL, 30 * EB, USl, VSl, hv, acc);
            gather_compute(B, EL, GL, 31 * EB, USl, VSl, hv, acc);
        }
        SUB_END(9); SUB_BEGIN(10);
        const int mr = modrow(t);
        const float* mp = F.MODS() + ((size_t)layer * 3 + mr) * 12288;
        bf16_t* xr = F.X() + (size_t)t * D;
        float rr[32]; float s = 0.f;
#pragma unroll
        for (int q2 = 0; q2 < 4; ++q2) { const u32x4 xw = *(const u32x4*)(xr + 32 * lane + 8 * q2);
#pragma unroll
            for (int h2 = 0; h2 < 2; ++h2) { const int q = 2 * q2 + h2; const f32x4 gv = *(const LAS f32x4*)(vcache + mr * 8192 + q * 1024);
                const f32x4 xv = {bf_lo(xw[2 * h2]), bf_hi(xw[2 * h2]), bf_lo(xw[2 * h2 + 1]), bf_hi(xw[2 * h2 + 1])};
                const f32x4 av = {acc[2 * q].x, acc[2 * q].y, acc[2 * q + 1].x, acc[2 * q + 1].y};
#pragma unroll
                for (int e = 0; e < 4; ++e) { const float v = DN_ALPHA * xv[e] + gv[e] * av[e]; rr[4 * q + e] = v; s += v; } } }
        const float mean = wave_sum_u(s) * (1.f / D);
        float s2 = 0.f;
#pragma unroll
        for (int i = 0; i < 32; ++i) { rr[i] -= mean; s2 += rr[i] * rr[i]; }
        const float rstd = 1.f / sqrtf(wave_sum_u(s2) * (1.f / D) + LN_EPS);
        const float* g2 = F.ln2_g() + layer * D; const float* b2 = F.ln2_b() + layer * D;
        float s3 = 0.f;
#pragma unroll
        for (int q = 0; q < 8; ++q) { const int c = 32 * lane + 4 * q; const f32x4 gg = *(const LAS f32x4*)(vcache + 9 * 8192 + q * 1024), bb = *(const LAS f32x4*)(vcache + 10 * 8192 + q * 1024);
            f32x4 xo;
#pragma unroll
            for (int e = 0; e < 4; ++e) { xo[e] = rr[4 * q + e] * rstd * gg[e] + bb[e]; rr[4 * q + e] = xo[e]; s3 += xo[e]; }
            if (layer < NLAYER - 1) { u32x2 o2; o2.x = pk2(xo[0], xo[1]); o2.y = pk2(xo[2], xo[3]); *(u32x2*)(xr + c) = o2; } else if (t < TL) *(f32x4*)(F.out() + (size_t)t * D + c) = xo; }
        if (layer < NLAYER - 1) {
            const float mean2 = wave_sum_u(s3) * (1.f / D);
            float s4 = 0.f;
#pragma unroll
            for (int i = 0; i < 32; ++i) { rr[i] -= mean2; s4 += rr[i] * rr[i]; }
            const float rstd2 = 1.f / sqrtf(wave_sum_u(s4) * (1.f / D) + LN_EPS);
            const float* np = F.MODS() + ((size_t)(layer + 1) * 3 + mr) * 12288;
#pragma unroll
            for (int q2 = 0; q2 < 4; ++q2) { const int c = 32 * lane + 8 * q2; u32x4 w;
#pragma unroll
                for (int q = 0; q < 2; ++q) { const f32x4 sh = *(const LAS f32x4*)(vcache + (3 + mr) * 8192 + (2 * q2 + q) * 1024), sc = *(const LAS f32x4*)(vcache + (6 + mr) * 8192 + (2 * q2 + q) * 1024); const int ri = 8 * q2 + 4 * q;
                    const float y0 = rr[ri] * rstd2 * (1.f + sc[0]) + sh[0], y1 = rr[ri + 1] * rstd2 * (1.f + sc[1]) + sh[1];
                    const float y2 = rr[ri + 2] * rstd2 * (1.f + sc[2]) + sh[2], y3 = rr[ri + 3] * rstd2 * (1.f + sc[3]) + sh[3];
                    w[2 * q] = pk2(y0, y1); w[2 * q + 1] = pk2(y2, y3); }
                *(u32x4*)(F.H() + (size_t)t * D + c) = w; }
        }
        SUB_END(10);
        t = (int)__builtin_amdgcn_readfirstlane(tkn);
    }
#undef SUB_BEGIN
#undef SUB_END
}

__global__ void __launch_bounds__(NWAVES * 64, 2) skel_fwd(Args args) {
    extern __shared__ __attribute__((aligned(16))) unsigned char lds[];
    Frame F;
    F.lds = (LAS unsigned char*)lds;
    F.tid = threadIdx.x; F.lane = F.tid & 63; F.wave = __builtin_amdgcn_readfirstlane(F.tid >> 6);
    F.G = gridDim.x; F.gw = blockIdx.x * NWAVES + F.wave; F.NGW = F.G * NWAVES;
    unsigned char* ws = args.ws;
    F.ka = (const CAS unsigned char*)__builtin_amdgcn_kernarg_segment_ptr();
    for (int u = F.tid; u < (LDS_BYTES - LDSCTL_OFF) / 4; u += NWAVES * 64) ((LAS unsigned*)(F.lds + LDSCTL_OFF))[u] = 0u;
    __syncthreads();
    unsigned* ctl = (unsigned*)(ws + WS_CTL);
    const int lo = args.ph_lo, hi = args.ph_hi;
    XcdBarrier bar; bar.bar = ctl + CW_BAR + args.li * XCD_BAR_WORDS; bar.x = 0; bar.st = nullptr;
    if (hi - lo > 1) bar = xcd_barrier_post(ctl + CW_BAR + args.li * XCD_BAR_WORDS, (volatile LAS unsigned*)(F.lds + MISC_OFF) + 8);
#define IN(k) (lo <= (k) && (k) < hi)
    unsigned long long pr_acc = 0ull, pr_t0 = 0ull;
#define PR_BEGIN(ty) do { if (PROBE_PHASE == (ty)) pr_t0 = __builtin_amdgcn_s_memrealtime(); } while (0)
#define PR_END(ty) do { if (PROBE_PHASE == (ty)) pr_acc += __builtin_amdgcn_s_memrealtime() - pr_t0; } while (0)
#define BOTH(k) (IN(k) && IN((k) + 1))
#define SEAM(k) do { if (BOTH(k)) xcd_barrier(bar); } while (0)

    if (IN(0)) { PR_BEGIN(0); frame_ids(F); p0a_prologue(F); SEAM(0); PR_END(0); }
    if (IN(1)) {
        PR_BEGIN(1); frame_ids(F);
        { pg8::Gemm g{F.KBD(), F.WQR(), 32 * 256, 2048, 256}; pg8::BatchOrder S{F.G, (int)blockIdx.x}; pg8::EpiBf16 E{F.WEFFT(), D};
          pg8::gemm_phase<pg8::EpiBf16, pg8::BatchOrder, false, true>(F.lds, g, S, E); }
        p0b_mod0(F);
        SEAM(1); PR_END(1);
    }
    for (int layer = 0; layer < NLAYER; ++layer) {
        const int pb = 2 + 6 * layer;
        const bool lastl = layer == NLAYER - 1;
        const int rows = lastl ? TL : TT;
        if (IN(pb + 0)) {
            PR_BEGIN(2); frame_ids(F);
            pg8::Gemm g{F.H(), F.WINT() + (size_t)layer * INC * D, TT, INC, D}; pg8::StaticOrder S; S.init(TT, INC, F.G, (int)blockIdx.x);
            pg8::EpiBf16 E{F.PROJ(), INC};
            pg8::gemm_phase<pg8::EpiBf16, pg8::StaticOrder, true, true>(F.lds, g, S, E);
            SEAM(pb + 0); PR_END(2);
        }
        if (IN(pb + 1)) {
            PR_BEGIN(3); frame_ids(F);
            const int nunits = lastl ? 512 : 528;
            { unsigned long long q0 = 0; if (PROBE_PHASE == 11) q0 = __builtin_amdgcn_s_memrealtime();
            { const int bx = (int)blockIdx.x, vcu = (F.G % 8 == 0) ? (bx % 8) * (F.G / 8) + bx / 8 : bx;
              for (int u = vcu; u < nunits; u += F.G) attn_unit(F, layer, u); }
            if (PROBE_PHASE == 11) pr_acc += __builtin_amdgcn_s_memrealtime() - q0; if (PROBE_PHASE == 12) q0 = __builtin_amdgcn_s_memrealtime();
            {
              const int nx = nunits - 2 * F.G; const bool uneven = nx > 0 && nx < F.G;
              const int bx2 = (int)blockIdx.x, vc2 = (F.G % 8 == 0) ? (bx2 % 8) * (F.G / 8) + bx2 / 8 : bx2;
              const int c0 = uneven ? vc2 - nx : vc2, nb = uneven ? F.G - nx : F.G;
              if (c0 >= 0) for (int t = c0 * NWAVES + F.wave; t < rows; t += nb * NWAVES) conv_row(F, layer, t); }
            if (PROBE_PHASE == 12) pr_acc += __builtin_amdgcn_s_memrealtime() - q0; }
            SEAM(pb + 1); PR_END(3);
        }
        if (IN(pb + 2)) {
            PR_BEGIN(4); frame_ids(F);
            pg8::Gemm g{F.MIX(), F.WOUTT() + (size_t)layer * D * D, rows, D, D}; pg8::StaticOrder S; S.init(rows, D, F.G, (int)blockIdx.x);
            pg8::EpiResid E{layer == 0 ? F.x() : nullptr, layer == 0 ? F.ctx() : nullptr, F.X(), F.MODS() + (size_t)layer * 3 * 12288 + 2 * D};
            pg8::gemm_phase<pg8::EpiResid, pg8::StaticOrder, true, true>(F.lds, g, S, E);
            frame_ids(F); convert_in_tail(F, layer, (rows / 256) * (D / 256), 0);
            SEAM(pb + 2); PR_END(4);
        }
        if (IN(pb + 3)) { PR_BEGIN(5); frame_ids(F); ln_phase(F, layer, rows); SEAM(pb + 3); PR_END(5); }
        if (IN(pb + 4)) {
            PR_BEGIN(6); frame_ids(F);
            pg8::Gemm g{F.H(), F.WEFFT() + (size_t)layer * D * D, rows, D, D}; pg8::StaticOrder S; S.init(rows, D, F.G, (int)blockIdx.x);
            pg8::EpiF32 E{F.SC(), D};
            pg8::gemm_phase<pg8::EpiF32, pg8::StaticOrder, true, true>(F.lds, g, S, E);
            frame_ids(F); convert_in_tail(F, layer, (rows / 256) * (D / 256), 1);
            SEAM(pb + 4); PR_END(6);
        }
        if (IN(pb + 5)) { PR_BEGIN(7); frame_ids(F); peer_phase(F, layer, rows, ctl, pr_acc); SEAM(pb + 5); PR_END(7); }
    }
    if (PROBE_PHASE >= 0 && hi - lo > 1) xcd_barrier(bar);
    if (PROBE_PHASE >= 0 && blockIdx.x == 0 && threadIdx.x == 0) { const unsigned long long t1 = __builtin_amdgcn_s_memrealtime() + (unsigned long long)PROBE_MULT * pr_acc; while (__builtin_amdgcn_s_memrealtime() < t1) __builtin_amdgcn_s_sleep(8); }
#undef IN
#undef BOTH
#undef SEAM
}

extern "C" void kernel_launch(void* const* d_in, const int* in_sizes, int n_in, void* d_out, int out_size, void* d_ws, size_t ws_size, hipStream_t stream) {
    static int grid = 0;
    if (grid == 0) {
        if (n_in != 20 || in_sizes[0] != TL * D || out_size != TL * D || ws_size < WS_END) {
            fprintf(stderr, "kernel_launch: unexpected problem shape (n_in %d, in0 %d, out %d, ws %zu, need %zu)\n", n_in, n_in > 0 ? in_sizes[0] : -1, out_size, ws_size, (size_t)WS_END); grid = -1; return; }
        int dev = 0, cus = 0, per_cu = 0;
        if (hipGetDevice(&dev) != hipSuccess || hipDeviceGetAttribute(&cus, hipDeviceAttributeMultiprocessorCount, dev) != hipSuccess) { grid = -1; return; }
        if (hipFuncSetAttribute((const void*)skel_fwd, hipFuncAttributeMaxDynamicSharedMemorySize, LDS_BYTES) != hipSuccess) { fprintf(stderr, "kernel_launch: hipFuncSetAttribute failed\n"); grid = -1; return; }
        if (hipOccupancyMaxActiveBlocksPerMultiprocessor(&per_cu, (const void*)skel_fwd, NWAVES * 64, LDS_BYTES) != hipSuccess || per_cu < 1)
            fprintf(stderr, "kernel_launch: occupancy query reports %d workgroups per CU\n", per_cu);
        (void)hipGetLastError();
        grid = cus;
    }
    if (grid < 0) return;
    if (hipMemsetAsync((char*)d_ws + WS_CTL, 0, CTL_ZERO_BYTES, stream) != hipSuccess) return;
    Args a{};
    for (int i = 0; i < 20; ++i) a.in[i] = (const float*)d_in[i];
    a.out = (float*)d_out; a.ws = (unsigned char*)d_ws; a.pad = 0;
#if MK_N_LAUNCHES == 1
    a.ph_lo = 0; a.ph_hi = NPHASE; a.li = 0;
    hipLaunchKernelGGL(skel_fwd, dim3(grid), dim3(NWAVES * 64), LDS_BYTES, stream, a);
#else
    for (int ph = 0; ph < NPHASE; ++ph) { a.ph_lo = ph; a.ph_hi = ph + 1; a.li = 0;
        hipLaunchKernelGGL(skel_fwd, dim3(grid), dim3(NWAVES * 64), LDS_BYTES, stream, a); }
#endif
}
```

```cpp
#include <hip/hip_runtime.h>
#include <cstdio>
#include <cstdint>

#ifndef MK_N_LAUNCHES
#define MK_N_LAUNCHES 1
#endif

#define LAS __attribute__((address_space(3)))
typedef unsigned short bf16_t;
typedef short bf16x8 __attribute__((ext_vector_type(8)));
typedef short s16x4 __attribute__((ext_vector_type(4)));
typedef float f32x2 __attribute__((ext_vector_type(2)));
typedef float f32x4 __attribute__((ext_vector_type(4)));
typedef float f32x16 __attribute__((ext_vector_type(16)));
typedef unsigned u32x2 __attribute__((ext_vector_type(2)));
typedef unsigned u32x4 __attribute__((ext_vector_type(4)));
typedef __bf16 bf16x2_t __attribute__((ext_vector_type(2)));

constexpr int D = 2048, NB = 2, SEQ = 8192, CTXL = 256, NLAYER = 4;
constexpr int TL = NB * SEQ, TC = NB * CTXL, TT = TL + TC;
constexpr int INC = 4608, OFF_C = 1024, OFF_X = 2048, OFF_Q = 3072, OFF_K = 4096, OFF_V = 4352;
constexpr int NEXP = 16384;
#ifndef U_FMT
#define U_FMT 4
#endif
#ifndef V_FMT
#define V_FMT 4
#endif
constexpr int UROW = D * U_FMT / 8, VROW = D * V_FMT / 8;
constexpr float LN_EPS = 1e-6f;
constexpr float DN_ALPHA = 1.681792830507429f;
constexpr float QSCALE = 0.08838834764831845f * 1.4426950408889634f;
constexpr float LOG2E = 1.4426950408889634f;

constexpr size_t MiB = 1u << 20;
constexpr size_t WS_CTL = 0, CTL_ZERO_BYTES = 1 * MiB;
constexpr size_t WS_MODS = 1 * MiB;
constexpr size_t WS_ROPE = 2 * MiB;
constexpr size_t WS_KBD = 3 * MiB;
constexpr size_t WS_WQR = 8 * MiB;
constexpr size_t WS_WINT = 40 * MiB;
constexpr size_t WS_WOUTT = 112 * MiB;
constexpr size_t WS_WEFFT = 144 * MiB;
constexpr size_t WS_X = 176 * MiB;
constexpr size_t WS_H = 308 * MiB;
constexpr size_t WS_PROJ = 374 * MiB;
constexpr size_t WS_MIX = 523 * MiB;
constexpr size_t WS_SC = 589 * MiB;
constexpr size_t WS_UT = 721 * MiB;
constexpr size_t WS_VT = 849 * MiB;
constexpr size_t WS_US = 977 * MiB;
constexpr size_t WS_VS = 978 * MiB;
constexpr size_t WS_END = 979 * MiB;

constexpr int CW_BAR = 4096;

namespace pg8 {
constexpr int BM = 256, BK = 64, HALF = 128, HTB = HALF * BK * 2, STAGE_BYTES = 8 * HTB, NXCD = 8, WGM = 8;
__host__ __device__ __forceinline__ int lds_byte(int r, int c) { const int st = (r >> 4) * 2 + (c >> 5), rr = r & 15, cc = c & 31, ob = rr * 64 + cc * 2; return st * 1024 + (ob ^ (((ob >> 9) & 1) << 5)); }
__host__ __device__ __forceinline__ void stage_rc(int b, int& R, int& C) { const int st = b / 1024, sb = b % 1024, swz = sb ^ (((sb >> 9) & 1) << 5); R = (st >> 1) * 16 + swz / 64; C = (st & 1) * 32 + (swz % 64) / 2; }
__host__ __device__ __forceinline__ int perm32(int rho) { const int n = rho >> 4, i = rho & 15; return 8 * (i >> 2) + 4 * n + (i & 3); }

struct Unit { int pm, pn; };
struct Gemm { const bf16_t* A; const bf16_t* Bt; int M, N, K; };

struct StaticOrder {
    int nM, nN, nwg, G, c;
    __host__ __device__ void init(int M, int N, int G_, int c_) { nM = M / BM; nN = N / BM; nwg = nM * nN; G = G_; c = c_; }
    __host__ __device__ bool next(int i, Unit& u) const {
        const long L = (long)i * G + c; if (L >= nwg) return false;
        int wgid = (int)L; { const int q = nwg / NXCD, r = nwg % NXCD, xcd = wgid % NXCD, off = wgid / NXCD; wgid = (xcd < r ? xcd * (q + 1) : r * (q + 1) + (xcd - r) * q) + off; }
        const int nig = WGM * nN, gid = wgid / nig, fm = gid * WGM, gsz = (nM - fm) < WGM ? (nM - fm) : WGM;
        u.pm = fm + ((wgid % nig) % gsz); u.pn = (wgid % nig) / gsz; return true;
    }
    __device__ __forceinline__ int btile(const Unit& u) const { return u.pn; }
    __device__ __forceinline__ void a_ready(const Unit&) const {}
    __device__ __forceinline__ void done(const Unit&) const {}
};
struct BatchOrder {
    int G, c;
    __device__ bool next(int i, Unit& u) const { const int L = i * G + c; if (L >= 256) return false; u.pm = L >> 3; u.pn = L & 7; return true; }
    __device__ __forceinline__ int btile(const Unit& u) const { return u.pm * 8 + u.pn; }
    __device__ __forceinline__ void a_ready(const Unit&) const {}
    __device__ __forceinline__ void done(const Unit&) const {}
};

__device__ __forceinline__ unsigned cvt_pk_bf16(float lo, float hi) { f32x2 x = {lo, hi}; bf16x2_t y = __builtin_convertvector(x, bf16x2_t); return __builtin_bit_cast(unsigned, y); }

struct EpiBf16 {
    static constexpr bool PERM = true;
    bf16_t* O; int ldc;
    __device__ __forceinline__ void operator()(const f32x4 (&acc)[2][2][4][2], const Unit& u, int wr, int wc, int fr, int fq) const {
        const int row0 = u.pm * BM + wr * 64 + fr, col0 = u.pn * BM + wc * 32 + 8 * fq;
#pragma unroll
        for (int ai = 0; ai < 2; ++ai)
#pragma unroll
            for (int m = 0; m < 4; ++m) { bf16_t* rowp = O + (size_t)(row0 + ai * HALF + m * 16) * ldc + col0;
#pragma unroll
                for (int bj = 0; bj < 2; ++bj) { const f32x4 v0 = acc[ai][bj][m][0], v1 = acc[ai][bj][m][1];
                    u32x4 w; w.x = cvt_pk_bf16(v0[0], v0[1]); w.y = cvt_pk_bf16(v0[2], v0[3]); w.z = cvt_pk_bf16(v1[0], v1[1]); w.w = cvt_pk_bf16(v1[2], v1[3]);
                    *(u32x4*)(rowp + bj * HALF) = w; } }
    }
};
struct EpiF32 {
    static constexpr bool PERM = false;
    float* C; int ldc;
    __device__ __forceinline__ void operator()(const f32x4 (&acc)[2][2][4][2], const Unit& u, int wr, int wc, int fr, int fq) const {
        const int row0 = u.pm * BM + wr * 64 + fr, col0 = u.pn * BM + wc * 32 + 4 * fq;
#pragma unroll
        for (int ai = 0; ai < 2; ++ai)
#pragma unroll
            for (int m = 0; m < 4; ++m) { float* rowp = C + (size_t)(row0 + ai * HALF + m * 16) * ldc + col0;
#pragma unroll
                for (int bj = 0; bj < 2; ++bj)
#pragma unroll
                    for (int n = 0; n < 2; ++n) *(f32x4*)(rowp + bj * HALF + n * 16) = acc[ai][bj][m][n]; }
    }
};
struct EpiResid {
    static constexpr bool PERM = true;
    const float* x32_lat; const float* x32_ctx;
    bf16_t* X; const float* gate;
    __device__ __forceinline__ void operator()(const f32x4 (&acc)[2][2][4][2], const Unit& u, int wr, int wc, int fr, int fq) const {
        const int rt = u.pm * BM;
        const int mr = rt < TL ? rt / SEQ : 2;
        const int row0 = rt + wr * 64 + fr, col0 = u.pn * BM + wc * 32 + 8 * fq;
        f32x4 gv[2][2];
#pragma unroll
        for (int bj = 0; bj < 2; ++bj)
#pragma unroll
            for (int n = 0; n < 2; ++n) gv[bj][n] = *(const f32x4*)(gate + (size_t)mr * 12288 + col0 + bj * HALF + 4 * n);
#pragma unroll
        for (int ai = 0; ai < 2; ++ai)
#pragma unroll
            for (int m = 0; m < 4; ++m) { const int row = row0 + ai * HALF + m * 16;
#pragma unroll
                for (int bj = 0; bj < 2; ++bj) {
                    f32x4 x0, x1;
                    if (x32_lat) { const float* xp = (row < TL ? x32_lat + (size_t)row * D : x32_ctx + (size_t)(row - TL) * D) + col0 + bj * HALF; x0 = *(const f32x4*)xp; x1 = *(const f32x4*)(xp + 4); }
                    else { const u32x4 w = *(const u32x4*)(X + (size_t)row * D + col0 + bj * HALF);
                        x0 = (f32x4){__uint_as_float(w.x << 16), __uint_as_float(w.x & 0xffff0000u), __uint_as_float(w.y << 16), __uint_as_float(w.y & 0xffff0000u)};
                        x1 = (f32x4){__uint_as_float(w.z << 16), __uint_as_float(w.z & 0xffff0000u), __uint_as_float(w.w << 16), __uint_as_float(w.w & 0xffff0000u)}; }
                    const f32x4 r0 = x0 * DN_ALPHA + gv[bj][0] * acc[ai][bj][m][0], r1 = x1 * DN_ALPHA + gv[bj][1] * acc[ai][bj][m][1];
                    u32x4 o; o.x = cvt_pk_bf16(r0[0], r0[1]); o.y = cvt_pk_bf16(r0[2], r0[3]); o.z = cvt_pk_bf16(r1[0], r1[1]); o.w = cvt_pk_bf16(r1[2], r1[3]);
                    *(u32x4*)(X + (size_t)row * D + col0 + bj * HALF) = o; } }
    }
};

template <class Epi, class Sched, bool ALIGN_EPI = false, bool SP2 = false>
__device__ __forceinline__ void gemm_phase(LAS unsigned char* lds, const Gemm g, const Sched& S, const Epi& E) {
    int tid = threadIdx.x; asm volatile("" : "+v"(tid));
    const int wid = __builtin_amdgcn_readfirstlane(tid >> 6), lane = tid & 63, wr = wid >> 2, wc = wid & 3, fr = lane & 15, fq = lane >> 4;
    const int K = g.K, nt = K / BK;
    unsigned voffA[2], voffB[2];
#pragma unroll
    for (int i = 0; i < 2; ++i) { int R, C; stage_rc(tid * 16 + i * 8192, R, C); const int Rb = Epi::PERM ? ((R & ~31) + perm32(R & 31)) : R;
        voffA[i] = (unsigned)(R * K + C) * 2u; voffB[i] = (unsigned)(Rb * K + C) * 2u; }
    const size_t kstep = (size_t)(BK * 2);
    const size_t hstep = (size_t)HALF * K * 2;
    const size_t tstep = 2 * hstep;
    const unsigned ldsw = (unsigned)wid * 1024u;
    const int aoff = lds_byte(wr * 64 + fr, fq * 8), boff = lds_byte(wc * 32 + fr, fq * 8);
#define PG8_SA(b, h) (((b) * 2 + (h)) * HTB)
#define PG8_SB(b, h) ((4 + (b) * 2 + (h)) * HTB)
#define PG8_STAGE(bufoff, gbase, voff) do { _Pragma("unroll") for (int _i = 0; _i < 2; ++_i) \
        __builtin_amdgcn_global_load_lds((const unsigned*)((const char*)(gbase) + (voff)[_i]), (LAS unsigned*)(lds + (bufoff) + ldsw + _i * 8192), 16, 0, 0); } while (0)
#define PG8_LDA(dst, b, h) do { _Pragma("unroll") for (int m = 0; m < 4; ++m) _Pragma("unroll") for (int k = 0; k < 2; ++k) dst[m][k] = *(const LAS bf16x8*)(lds + PG8_SA(b, h) + aoff + m * 2048 + k * 1024); } while (0)
#define PG8_LDB(dst, b, h) do { _Pragma("unroll") for (int n = 0; n < 2; ++n) _Pragma("unroll") for (int k = 0; k < 2; ++k) dst[n][k] = *(const LAS bf16x8*)(lds + PG8_SB(b, h) + boff + n * 2048 + k * 1024); } while (0)
#define PG8_MMA(ai, bj, At, Bt) do { __builtin_amdgcn_s_setprio(1); _Pragma("unroll") for (int m = 0; m < 4; ++m) _Pragma("unroll") for (int n = 0; n < 2; ++n) _Pragma("unroll") for (int k = 0; k < 2; ++k) \
        acc[ai][bj][m][n] = __builtin_amdgcn_mfma_f32_16x16x32_bf16(Bt[n][k], At[m][k], acc[ai][bj][m][n], 0, 0, 0); __builtin_amdgcn_s_setprio(0); } while (0)
#define PG8_WAIT_V(n) asm volatile("s_waitcnt vmcnt(" #n ")" ::: "memory")
#define PG8_WAIT_L(n) asm volatile("s_waitcnt lgkmcnt(" #n ")" ::: "memory")
#define PG8_BAR __builtin_amdgcn_s_barrier()
#define PG8_SCHED __builtin_amdgcn_sched_barrier(0)
    Unit cur, nxt; int ui = 0;
    if (!S.next(0, cur)) return;
    f32x4 acc[2][2][4][2];
#pragma unroll
    for (int a = 0; a < 2; ++a)
#pragma unroll
        for (int b = 0; b < 2; ++b)
#pragma unroll
            for (int m = 0; m < 4; ++m)
#pragma unroll
                for (int n = 0; n < 2; ++n) acc[a][b][m][n] = (f32x4){0.f, 0.f, 0.f, 0.f};
    bf16x8 At[4][2], B0[2][2], B1[2][2];
    const char* cA = (const char*)g.A + (size_t)cur.pm * tstep; const char* cB = (const char*)g.Bt + (size_t)S.btile(cur) * tstep;
    S.a_ready(cur);
    if constexpr (SP2) {
        PG8_STAGE(PG8_SB(0, 0), cB, voffB); PG8_STAGE(PG8_SB(0, 1), cB + hstep, voffB); PG8_STAGE(PG8_SA(0, 0), cA, voffA); PG8_STAGE(PG8_SA(0, 1), cA + hstep, voffA);
        if (wr == 1) PG8_BAR;
        PG8_WAIT_V(2); PG8_BAR;
        PG8_STAGE(PG8_SB(1, 0), cB + kstep, voffB); PG8_STAGE(PG8_SA(1, 0), cA + kstep, voffA); PG8_STAGE(PG8_SB(1, 1), cB + hstep + kstep, voffB);
        PG8_WAIT_V(6); PG8_BAR;
    } else {
        PG8_STAGE(PG8_SB(0, 0), cB, voffB); PG8_STAGE(PG8_SA(0, 0), cA, voffA); PG8_STAGE(PG8_SB(0, 1), cB + hstep, voffB); PG8_STAGE(PG8_SA(0, 1), cA + hstep, voffA);
        if (wr == 1) PG8_BAR;
        PG8_WAIT_V(4); PG8_BAR;
        PG8_STAGE(PG8_SB(1, 0), cB + kstep, voffB); PG8_STAGE(PG8_SA(1, 0), cA + kstep, voffA); PG8_STAGE(PG8_SB(1, 1), cB + hstep + kstep, voffB);
        PG8_WAIT_V(6); PG8_BAR;
    }
    for (;;) {
        const bool has_next = S.next(ui + 1, nxt);
        const char* nA = has_next ? (const char*)g.A + (size_t)nxt.pm * tstep : cA; const char* nB = has_next ? (const char*)g.Bt + (size_t)S.btile(nxt) * tstep : cB;
        for (int t = 0; t < nt; t += 2) {
            const bool last = (t == nt - 2);
            const char* a1 = cA + (size_t)(t + 1) * kstep;
            const char* a2 = last ? nA : cA + (size_t)(t + 2) * kstep; const char* b2 = last ? nB : cB + (size_t)(t + 2) * kstep;
            const char* a3 = a2 + kstep; const char* b3 = b2 + kstep;
            if (last && has_next) S.a_ready(nxt);
            if constexpr (SP2) {
            PG8_LDB(B0, 0, 0); PG8_LDB(B1, 0, 1); PG8_SCHED; PG8_LDA(At, 0, 0); PG8_STAGE(PG8_SA(1, 1), a1 + hstep, voffA);
            PG8_WAIT_V(8); PG8_WAIT_L(0); PG8_BAR; PG8_MMA(0, 0, At, B0); PG8_MMA(0, 1, At, B1); PG8_BAR; PG8_SCHED;
            PG8_LDA(At, 0, 1); PG8_STAGE(PG8_SB(0, 0), b2, voffB); PG8_STAGE(PG8_SB(0, 1), b2 + hstep, voffB); PG8_STAGE(PG8_SA(0, 0), a2, voffA);
            PG8_WAIT_V(8); PG8_WAIT_L(0); PG8_BAR; PG8_MMA(1, 0, At, B0); PG8_MMA(1, 1, At, B1); PG8_BAR; PG8_SCHED;
            PG8_LDB(B0, 1, 0); PG8_LDB(B1, 1, 1); PG8_SCHED; PG8_LDA(At, 1, 0); PG8_STAGE(PG8_SA(0, 1), a2 + hstep, voffA);
            PG8_WAIT_V(8); PG8_WAIT_L(0); PG8_BAR; PG8_MMA(0, 0, At, B0); PG8_MMA(0, 1, At, B1); PG8_BAR; PG8_SCHED;
            PG8_LDA(At, 1, 1); PG8_STAGE(PG8_SB(1, 0), b3, voffB); PG8_STAGE(PG8_SB(1, 1), b3 + hstep, voffB); PG8_STAGE(PG8_SA(1, 0), a3, voffA);
            PG8_WAIT_V(8); PG8_WAIT_L(0); PG8_BAR; PG8_MMA(1, 0, At, B0); PG8_MMA(1, 1, At, B1); PG8_BAR; PG8_SCHED;
            } else {
            PG8_LDB(B0, 0, 0); PG8_SCHED; PG8_LDA(At, 0, 0); PG8_STAGE(PG8_SA(1, 1), a1 + hstep, voffA);
            PG8_WAIT_L(8); PG8_BAR; PG8_WAIT_L(0); PG8_MMA(0, 0, At, B0); PG8_BAR; PG8_SCHED;
            PG8_LDB(B1, 0, 1); PG8_STAGE(PG8_SB(0, 0), b2, voffB);
            PG8_BAR; PG8_WAIT_L(0); PG8_MMA(0, 1, At, B1); PG8_BAR;
            PG8_LDA(At, 0, 1); PG8_STAGE(PG8_SA(0, 0), a2, voffA);
            PG8_BAR; PG8_WAIT_L(0); PG8_MMA(1, 0, At, B0); PG8_BAR; PG8_SCHED;
            PG8_STAGE(PG8_SB(0, 1), b2 + hstep, voffB);
            PG8_WAIT_V(6); PG8_BAR; PG8_MMA(1, 1, At, B1); PG8_BAR;
            PG8_LDB(B0, 1, 0); PG8_SCHED; PG8_LDA(At, 1, 0); PG8_STAGE(PG8_SA(0, 1), a2 + hstep, voffA);
            PG8_WAIT_L(8); PG8_BAR; PG8_WAIT_L(0); PG8_MMA(0, 0, At, B0); PG8_BAR; PG8_SCHED;
            PG8_LDB(B1, 1, 1); PG8_STAGE(PG8_SB(1, 0), b3, voffB);
            PG8_BAR; PG8_WAIT_L(0); PG8_MMA(0, 1, At, B1); PG8_BAR;
            PG8_LDA(At, 1, 1); PG8_STAGE(PG8_SA(1, 0), a3, voffA);
            PG8_BAR; PG8_WAIT_L(0); PG8_MMA(1, 0, At, B0); PG8_BAR; PG8_SCHED;
            PG8_STAGE(PG8_SB(1, 1), b3 + hstep, voffB);
            PG8_WAIT_V(6); PG8_BAR; PG8_MMA(1, 1, At, B1); PG8_BAR;
            }
        }
        if constexpr (ALIGN_EPI) { if (wr == 0) PG8_BAR; }
        E(acc, cur, wr, wc, fr, fq); S.done(cur);
        if (!has_next) break;
#pragma unroll
        for (int a = 0; a < 2; ++a)
#pragma unroll
            for (int b = 0; b < 2; ++b)
#pragma unroll
                for (int m = 0; m < 4; ++m)
#pragma unroll
                    for (int n = 0; n < 2; ++n) acc[a][b][m][n] = (f32x4){0.f, 0.f, 0.f, 0.f};
        cur = nxt; cA = nA; cB = nB; ++ui;
        if constexpr (ALIGN_EPI) { if (wr == 1) PG8_BAR; }
    }
    PG8_WAIT_V(0);
    if constexpr (!ALIGN_EPI) { if (wr == 0) PG8_BAR; }
    PG8_BAR;
#undef PG8_SA
#undef PG8_SB
#undef PG8_STAGE
#undef PG8_LDA
#undef PG8_LDB
#undef PG8_MMA
#undef PG8_WAIT_V
#undef PG8_WAIT_L
#undef PG8_BAR
#undef PG8_SCHED
}
}

#define XB_TMO      128
#define XB_XCNT(j)  (256  + 64 * (j))
#define XB_XSUB(j)  (1280 + 64 * (j))
#define XB_XGEN(j)  (2304 + 64 * (j))
#define XB_TOP      3328
#define XB_TOPGEN   3392
#define XCD_BAR_WORDS 3456
#define XB_SPIN_CAP (1u << 18)

__device__ __forceinline__ unsigned xb_ld(unsigned* p)              { return __hip_atomic_load(p, __ATOMIC_RELAXED, __HIP_MEMORY_SCOPE_AGENT); }
__device__ __forceinline__ unsigned xb_add(unsigned* p, unsigned v) { return __hip_atomic_fetch_add(p, v, __ATOMIC_RELAXED, __HIP_MEMORY_SCOPE_AGENT); }
__device__ __forceinline__ unsigned xb_xcc_id() { return (unsigned)__builtin_amdgcn_s_getreg((3 << 11) | 20) & 0xFu; }
#define XB_SPIN(cond, bar) do { unsigned _sp = 0; while (cond) { __builtin_amdgcn_s_sleep(1); \
    if ((++_sp & 255u) == 0u) { if (xb_ld(&(bar)[XB_TMO])) break; if (_sp > XB_SPIN_CAP) { atomicAdd(&(bar)[XB_TMO], 1u); break; } } } } while (0)

struct XcdBarrier { unsigned* bar; unsigned x; volatile LAS unsigned* st; };

__device__ __forceinline__ XcdBarrier xcd_barrier_post(unsigned* bar, volatile LAS unsigned* st) {
    XcdBarrier b; b.bar = bar; b.x = xb_xcc_id(); b.st = st;
    if (threadIdx.x == 0) (void)xb_add(&bar[XB_XCNT(b.x)], 1u);
    return b;
}
__device__ __forceinline__ void xcd_barrier_complete(unsigned* bar, unsigned x, unsigned& nloc, unsigned& nx) {
    const unsigned G = gridDim.x * gridDim.y * gridDim.z;
    unsigned sum, cnt, mine, sp = 0u;
    for (;;) {
        sum = 0u; cnt = 0u; mine = 0u;
#pragma unroll
        for (unsigned j = 0; j < 16; ++j) { const unsigned c = xb_ld(&bar[XB_XCNT(j)]); sum += c; cnt += (c > 0u) ? 1u : 0u; mine = (j == x) ? c : mine; }
        if (sum == G) break;
        __builtin_amdgcn_s_sleep(1);
        if ((++sp & 255u) == 0u) { if (xb_ld(&bar[XB_TMO])) break; if (sp > XB_SPIN_CAP) { atomicAdd(&bar[XB_TMO], 1u); break; } }
    }
    nloc = mine > 0u ? mine : 1u; nx = cnt > 0u ? cnt : 1u;
}
__device__ __forceinline__ void xcd_barrier(const XcdBarrier& b) {
    asm volatile("s_waitcnt vmcnt(0)" ::: "memory");
    __syncthreads();
    if (threadIdx.x == 0) {
        unsigned* bar = b.bar;
        __builtin_amdgcn_s_waitcnt(0);
        unsigned nloc = b.st[0], nx = b.st[1];
        if (nloc == 0u) { xcd_barrier_complete(bar, b.x, nloc, nx); b.st[0] = nloc; b.st[1] = nx; }
        const unsigned old = xb_add(&bar[XB_XSUB(b.x)], 1u);
        const unsigned gen = old / nloc;
        if (old + 1u == (gen + 1u) * nloc) {
            __builtin_amdgcn_fence(__ATOMIC_RELEASE, "agent");
            asm volatile("s_waitcnt vmcnt(0)" ::: "memory");
            const unsigned og = xb_add(&bar[XB_TOP], 1u);
            const unsigned tg = og / nx;
            if (og + 1u == (tg + 1u) * nx) xb_add(&bar[XB_TOPGEN], 1u);
            else XB_SPIN(xb_ld(&bar[XB_TOPGEN]) == tg, bar);
            __builtin_amdgcn_fence(__ATOMIC_ACQUIRE, "agent");
            xb_add(&bar[XB_XGEN(b.x)], 1u);
            asm volatile("s_waitcnt vmcnt(0)" ::: "memory");
        } else {
            XB_SPIN(xb_ld(&bar[XB_XGEN(b.x)]) == gen, bar);
            __builtin_amdgcn_fence(__ATOMIC_ACQUIRE, "agent");
            asm volatile("s_waitcnt vmcnt(0)" ::: "memory");
        }
    }
    __syncthreads();
}

constexpr int NWAVES = 8;
constexpr int LDS_BYTES = 163840;
constexpr int LDSCTL_OFF = LDS_BYTES - 512, MISC_OFF = LDSCTL_OFF + 320;
constexpr int NPHASE = 2 + 6 * NLAYER;

#define LDS_WAIT() asm volatile("s_waitcnt lgkmcnt(0)" ::: "memory")

struct Args { const float* in[20]; float* out; unsigned char* ws; int ph_lo, ph_hi, li, pad; };

#define CAS __attribute__((address_space(4)))
struct Frame {
    LAS unsigned char* lds;
    int tid, lane, wave, G, gw, NGW;
    const CAS unsigned char* ka;
    __device__ __forceinline__ const float* x() const { return *(const float* const CAS*)(ka + 0); }
    __device__ __forceinline__ const float* c() const { return *(const float* const CAS*)(ka + 8); }
    __device__ __forceinline__ const float* ctx() const { return *(const float* const CAS*)(ka + 16); }
    __device__ __forceinline__ const float* c_ctx() const { return *(const float* const CAS*)(ka + 24); }
    __device__ __forceinline__ const float* w_ada() const { return *(const float* const CAS*)(ka + 32); }
    __device__ __forceinline__ const float* b_ada() const { return *(const float* const CAS*)(ka + 40); }
    __device__ __forceinline__ const float* w_in() const { return *(const float* const CAS*)(ka + 48); }
    __device__ __forceinline__ const float* conv_w() const { return *(const float* const CAS*)(ka + 56); }
    __device__ __forceinline__ const float* sink() const { return *(const float* const CAS*)(ka + 64); }
    __device__ __forceinline__ const float* g_attn() const { return *(const float* const CAS*)(ka + 72); }
    __device__ __forceinline__ const float* g_conv() const { return *(const float* const CAS*)(ka + 80); }
    __device__ __forceinline__ const float* w_out() const { return *(const float* const CAS*)(ka + 88); }
    __device__ __forceinline__ const float* ln1_g() const { return *(const float* const CAS*)(ka + 96); }
    __device__ __forceinline__ const float* ln1_b() const { return *(const float* const CAS*)(ka + 104); }
    __device__ __forceinline__ const float* wq() const { return *(const float* const CAS*)(ka + 112); }
    __device__ __forceinline__ const float* keys() const { return *(const float* const CAS*)(ka + 120); }
    __device__ __forceinline__ const float* pu() const { return *(const float* const CAS*)(ka + 128); }
    __device__ __forceinline__ const float* pv() const { return *(const float* const CAS*)(ka + 136); }
    __device__ __forceinline__ const float* ln2_g() const { return *(const float* const CAS*)(ka + 144); }
    __device__ __forceinline__ const float* ln2_b() const { return *(const float* const CAS*)(ka + 152); }
    __device__ __forceinline__ float* out() const { return *(float* const CAS*)(ka + 160); }
    __device__ __forceinline__ unsigned char* ws() const { return *(unsigned char* const CAS*)(ka + 168); }
    __device__ __forceinline__ float* MODS() const { return (float*)(ws() + WS_MODS); }
    __device__ __forceinline__ float* ROPE() const { return (float*)(ws() + WS_ROPE); }
    __device__ __forceinline__ bf16_t* X() const { return (bf16_t*)(ws() + WS_X); }
    __device__ __forceinline__ float* SC() const { return (float*)(ws() + WS_SC); }
    __device__ __forceinline__ bf16_t* KBD() const { return (bf16_t*)(ws() + WS_KBD); }
    __device__ __forceinline__ bf16_t* WQR() const { return (bf16_t*)(ws() + WS_WQR); }
    __device__ __forceinline__ bf16_t* WINT() const { return (bf16_t*)(ws() + WS_WINT); }
    __device__ __forceinline__ bf16_t* WOUTT() const { return (bf16_t*)(ws() + WS_WOUTT); }
    __device__ __forceinline__ bf16_t* WEFFT() const { return (bf16_t*)(ws() + WS_WEFFT); }
    __device__ __forceinline__ bf16_t* H() const { return (bf16_t*)(ws() + WS_H); }
    __device__ __forceinline__ bf16_t* PROJ() const { return (bf16_t*)(ws() + WS_PROJ); }
    __device__ __forceinline__ bf16_t* MIX() const { return (bf16_t*)(ws() + WS_MIX); }
    __device__ __forceinline__ unsigned char* UT() const { return (unsigned char*)(ws() + WS_UT); }
    __device__ __forceinline__ unsigned char* VT() const { return (unsigned char*)(ws() + WS_VT); }
    __device__ __forceinline__ float* US() const { return (float*)(ws() + WS_US); }
    __device__ __forceinline__ float* VS() const { return (float*)(ws() + WS_VS); }
};

__device__ __forceinline__ void frame_ids(Frame& F) {
    int tz = threadIdx.x; asm volatile("" : "+v"(tz));
    F.tid = tz; F.lane = tz & 63; F.wave = __builtin_amdgcn_readfirstlane(tz >> 6);
    F.gw = blockIdx.x * NWAVES + F.wave;
    const CAS unsigned char* k = (const CAS unsigned char*)__builtin_amdgcn_kernarg_segment_ptr(); asm volatile("" : "+s"(k)); F.ka = k;
}
template <int CTRL> __device__ __forceinline__ int dpp_i(int v) { return __builtin_amdgcn_update_dpp(0, v, CTRL, 0xf, 0xf, true); }
template <int CTRL> __device__ __forceinline__ float dpp_f(float v) { return __int_as_float(dpp_i<CTRL>(__float_as_int(v))); }
constexpr int DPP_XOR1 = 0xB1, DPP_XOR2 = 0x4E, DPP_HMIRROR = 0x141, DPP_ROR4 = 0x124, DPP_ROR8 = 0x128;
__device__ __forceinline__ float wave_sum_u(float v) {
    v += dpp_f<DPP_XOR1>(v); v += dpp_f<DPP_XOR2>(v); v += dpp_f<DPP_ROR4>(v); v += dpp_f<DPP_ROR8>(v);
    const float r0 = __int_as_float(__builtin_amdgcn_readlane(__float_as_int(v), 0)), r1 = __int_as_float(__builtin_amdgcn_readlane(__float_as_int(v), 16));
    const float r2 = __int_as_float(__builtin_amdgcn_readlane(__float_as_int(v), 32)), r3 = __int_as_float(__builtin_amdgcn_readlane(__float_as_int(v), 48));
    return (r0 + r1) + (r2 + r3);
}
__device__ __forceinline__ float wave_max_u(float v) {
    v = fmaxf(v, dpp_f<DPP_XOR1>(v)); v = fmaxf(v, dpp_f<DPP_XOR2>(v)); v = fmaxf(v, dpp_f<DPP_ROR4>(v)); v = fmaxf(v, dpp_f<DPP_ROR8>(v));
    const float r0 = __int_as_float(__builtin_amdgcn_readlane(__float_as_int(v), 0)), r1 = __int_as_float(__builtin_amdgcn_readlane(__float_as_int(v), 16));
    const float r2 = __int_as_float(__builtin_amdgcn_readlane(__float_as_int(v), 32)), r3 = __int_as_float(__builtin_amdgcn_readlane(__float_as_int(v), 48));
    return fmaxf(fmaxf(r0, r1), fmaxf(r2, r3));
}
__device__ __forceinline__ float xor32_f(float v, int lane) { return __int_as_float(__builtin_amdgcn_ds_bpermute((lane ^ 32) << 2, __float_as_int(v))); }
__device__ __forceinline__ float wave_sum(float v) { return wave_sum_u(v); }
__device__ __forceinline__ unsigned pk2(float lo, float hi) { return pg8::cvt_pk_bf16(lo, hi); }
__device__ __forceinline__ float bf_lo(unsigned u) { return __uint_as_float(u << 16); }
__device__ __forceinline__ float bf_hi(unsigned u) { return __uint_as_float(u & 0xffff0000u); }
__device__ __forceinline__ int modrow(int t) { return t < TL ? t / SEQ : 2; }

__device__ __forceinline__ void transpose_item(const float* W, int K, int N, bf16_t* WT, LAS float* scr, int item, int lane) {
    const int nblk = N / 32, kb = item / nblk, nb = item % nblk, k0 = 64 * kb, n0 = 32 * nb;
#pragma unroll 8
    for (int i = 0; i < 32; ++i) { const int kk = 2 * i + (lane >> 5); scr[kk * 33 + (lane & 31)] = W[(size_t)(k0 + kk) * N + n0 + (lane & 31)]; }
    LDS_WAIT(); asm volatile("" ::: "memory");
    const int c = lane & 7;
#pragma unroll
    for (int j = 0; j < 4; ++j) { const int n = (lane >> 3) + 8 * j; const LAS float* s = scr + (8 * c) * 33 + n;
        u32x4 o; o.x = pk2(s[0 * 33], s[1 * 33]); o.y = pk2(s[2 * 33], s[3 * 33]); o.z = pk2(s[4 * 33], s[5 * 33]); o.w = pk2(s[6 * 33], s[7 * 33]);
        *(u32x4*)(WT + (size_t)(n0 + n) * K + k0 + 8 * c) = o; }
    LDS_WAIT(); asm volatile("" ::: "memory");
}

__device__ __forceinline__ void cvt_row_bf16(const float* src, bf16_t* dst, int lane) {
    const f32x4* s = (const f32x4*)src + lane; u32x2* d = (u32x2*)dst + lane;
    f32x4 v[8];
#pragma unroll
    for (int j = 0; j < 8; ++j) v[j] = __builtin_nontemporal_load(s + 64 * j);
#pragma unroll
    for (int j = 0; j < 8; ++j) { u32x2 o; o.x = pk2(v[j].x, v[j].y); o.y = pk2(v[j].z, v[j].w); d[64 * j] = o; }
}

struct RowF32 { f32x4 v[4][2]; };
__device__ __forceinline__ void row_load_nt(RowF32& R, const float* src, int lane) {
    const f32x4* s = (const f32x4*)src + 2 * lane;
#pragma unroll
    for (int j = 0; j < 4; ++j) { R.v[j][0] = __builtin_nontemporal_load(s + 128 * j); R.v[j][1] = __builtin_nontemporal_load(s + 128 * j + 1); }
}
template <int FMT>
__device__ __forceinline__ void cvt_row_lp(const RowF32& R, unsigned char* dst, float* inv, int lane) {
    constexpr float QMAX = FMT == 8 ? 224.f : 6.f;
    float am = 0.f;
#pragma unroll
    for (int j = 0; j < 4; ++j)
#pragma unroll
        for (int q = 0; q < 2; ++q) am = fmaxf(fmaxf(am, fmaxf(fabsf(R.v[j][q].x), fabsf(R.v[j][q].y))), fmaxf(fabsf(R.v[j][q].z), fabsf(R.v[j][q].w)));
    am = wave_max_u(am);
    const float sc = am > 0.f ? QMAX / am : 1.f;
#pragma unroll
    for (int j = 0; j < 4; ++j) {
        if constexpr (FMT == 8) {
            u32x2 w;
#pragma unroll
            for (int q = 0; q < 2; ++q) { int t = __builtin_amdgcn_cvt_pk_fp8_f32(R.v[j][q].x * sc, R.v[j][q].y * sc, 0, false); t = __builtin_amdgcn_cvt_pk_fp8_f32(R.v[j][q].z * sc, R.v[j][q].w * sc, t, true); w[q] = (unsigned)t; }
            *((u32x2*)dst + lane + 64 * j) = w;
        } else {
            unsigned w = 0u;
            w = __builtin_amdgcn_cvt_scalef32_pk_fp4_f32(w, R.v[j][0].x * sc, R.v[j][0].y * sc, 1.0f, 0);
            w = __builtin_amdgcn_cvt_scalef32_pk_fp4_f32(w, R.v[j][0].z * sc, R.v[j][0].w * sc, 1.0f, 1);
            w = __builtin_amdgcn_cvt_scalef32_pk_fp4_f32(w, R.v[j][1].x * sc, R.v[j][1].y * sc, 1.0f, 2);
            w = __builtin_amdgcn_cvt_scalef32_pk_fp4_f32(w, R.v[j][1].z * sc, R.v[j][1].w * sc, 1.0f, 3);
            *((unsigned*)dst + lane + 64 * j) = w;
        }
    }
    if (lane == 0) *inv = am > 0.f ? am * (1.f / QMAX) : 1.f;
}
template <int FMT> struct LpRow;
template <> struct LpRow<8> { u32x4 a, b;
    __device__ __forceinline__ void load(const unsigned char* rowp, int lane) { a = *(const u32x4*)(rowp + 32 * lane); b = *(const u32x4*)(rowp + 32 * lane + 16); }
    template <class Fn> __device__ __forceinline__ void each(Fn&& f) const {
#pragma unroll
        for (int w = 0; w < 4; ++w) { const f32x2 l0 = __builtin_amdgcn_cvt_pk_f32_fp8((int)a[w], false), h0 = __builtin_amdgcn_cvt_pk_f32_fp8((int)a[w], true);
            f(4 * w, l0.x, l0.y); f(4 * w + 2, h0.x, h0.y); }
#pragma unroll
        for (int w = 0; w < 4; ++w) { const f32x2 l0 = __builtin_amdgcn_cvt_pk_f32_fp8((int)b[w], false), h0 = __builtin_amdgcn_cvt_pk_f32_fp8((int)b[w], true);
            f(16 + 4 * w, l0.x, l0.y); f(16 + 4 * w + 2, h0.x, h0.y); }
    } };
template <> struct LpRow<4> { u32x4 a;
    __device__ __forceinline__ void load(const unsigned char* rowp, int lane) { a = *(const u32x4*)(rowp + 16 * lane); }
    template <class Fn> __device__ __forceinline__ void each(Fn&& f) const {
#pragma unroll
        for (int w = 0; w < 4; ++w) {
            const f32x2 d0 = __builtin_amdgcn_cvt_scalef32_pk_f32_fp4(a[w], 1.0f, 0), d1 = __builtin_amdgcn_cvt_scalef32_pk_f32_fp4(a[w], 1.0f, 1);
            const f32x2 d2 = __builtin_amdgcn_cvt_scalef32_pk_f32_fp4(a[w], 1.0f, 2), d3 = __builtin_amdgcn_cvt_scalef32_pk_f32_fp4(a[w], 1.0f, 3);
            f(8 * w, d0.x, d0.y); f(8 * w + 2, d1.x, d1.y); f(8 * w + 4, d2.x, d2.y); f(8 * w + 6, d3.x, d3.y); }
    }
    template <class Fn> __device__ __forceinline__ void each_bf(Fn&& f) const {
#pragma unroll
        for (int w = 0; w < 4; ++w) {
            f(4 * w, __builtin_amdgcn_cvt_scalef32_pk_bf16_fp4(a[w], 1.0f, 0)); f(4 * w + 1, __builtin_amdgcn_cvt_scalef32_pk_bf16_fp4(a[w], 1.0f, 1));
            f(4 * w + 2, __builtin_amdgcn_cvt_scalef32_pk_bf16_fp4(a[w], 1.0f, 2)); f(4 * w + 3, __builtin_amdgcn_cvt_scalef32_pk_bf16_fp4(a[w], 1.0f, 3)); }
    } };

__device__ __forceinline__ void row_stats(const f32x4 (&v)[8], float& mean, float& rstd) {
    float s = 0.f;
#pragma unroll
    for (int j = 0; j < 8; ++j) s += (v[j].x + v[j].y) + (v[j].z + v[j].w);
    mean = wave_sum(s) * (1.f / D);
    float s2 = 0.f;
#pragma unroll
    for (int j = 0; j < 8; ++j) { const f32x4 d = v[j] - mean; s2 += (d.x * d.x + d.y * d.y) + (d.z * d.z + d.w * d.w); }
    rstd = 1.f / sqrtf(wave_sum(s2) * (1.f / D) + LN_EPS);
}
__device__ __forceinline__ void modulate_store(const f32x4 (&v)[8], const float* shift, const float* scale, bf16_t* dst, int lane) {
    float mean, rstd; row_stats(v, mean, rstd);
    u32x2* d = (u32x2*)dst + lane;
#pragma unroll
    for (int j = 0; j < 8; ++j) { const f32x4 sc = *((const f32x4*)scale + lane + 64 * j), sh = *((const f32x4*)shift + lane + 64 * j);
        const f32x4 y = (v[j] - mean) * rstd * (sc + 1.f) + sh;
        u32x2 o; o.x = pk2(y.x, y.y); o.y = pk2(y.z, y.w); d[64 * j] = o; }
}

__device__ __forceinline__ void convert_tables(Frame& F, int row0, int row1, int w0, int wstride) {
    RowF32 ru, rv, nu, nv;
    int row = row0 + w0;
    if (row < row1) { row_load_nt(ru, F.pu() + (size_t)row * D, F.lane); row_load_nt(rv, F.pv() + (size_t)row * D, F.lane); }
    while (row < row1) {
        const int nrow = row + wstride;
        if (nrow < row1) { row_load_nt(nu, F.pu() + (size_t)nrow * D, F.lane); row_load_nt(nv, F.pv() + (size_t)nrow * D, F.lane); }
        cvt_row_lp<U_FMT>(ru, F.UT() + (size_t)row * UROW, F.US() + row, F.lane);
        cvt_row_lp<V_FMT>(rv, F.VT() + (size_t)row * VROW, F.VS() + row, F.lane);
        ru = nu; rv = nv; row = nrow;
    }
}
__device__ __forceinline__ void convert_in_tail(Frame& F, int layer, int nunits, int part) {
    if (layer + 1 >= NLAYER) return;
    const int G = F.G, rounds = (nunits + G - 1) / G, nlast = nunits - (rounds - 1) * G;
    const int c = (int)blockIdx.x;
    int nshort = G - nlast, sidx = c - nlast;
    if (nshort <= 0) { nshort = G; sidx = c; }
    else if (sidx < 0) return;
    const int r0 = (layer + 1) * NEXP + part * (NEXP / 2);
    convert_tables(F, r0, r0 + NEXP / 2, sidx * NWAVES + F.wave, nshort * NWAVES);
}
__device__ __forceinline__ void p0a_prologue(Frame& F) {
    LAS float* condL = (LAS float*)F.lds;
    LAS float* red = (LAS float*)(F.lds + 24576);
    for (int i = F.tid; i < 3 * D; i += NWAVES * 64) { const int r = i / D, k = i % D; const float v = r < 2 ? F.c()[r * D + k] : F.c_ctx()[k]; condL[i] = v / (1.f + __expf(-v)); }
    __syncthreads();
    for (int item = blockIdx.x; item < 384; item += F.G) {
        const int l = item / 96, n0 = (item % 96) * 128;
        const float* wp = F.w_ada() + ((size_t)l * D + F.wave * 256) * 12288 + n0 + 2 * F.lane;
        f32x2 a0 = {0.f, 0.f}, a1 = {0.f, 0.f}, a2 = {0.f, 0.f};
#pragma unroll 8
        for (int k = 0; k < 256; ++k) { const f32x2 w = __builtin_nontemporal_load((const f32x2*)(wp + (size_t)k * 12288)); const int kk = F.wave * 256 + k;
            a0 += w * condL[kk]; a1 += w * condL[D + kk]; a2 += w * condL[2 * D + kk]; }
        LAS float* rp = red + F.wave * 384 + 2 * F.lane;
        rp[0] = a0.x; rp[1] = a0.y; rp[128] = a1.x; rp[129] = a1.y; rp[256] = a2.x; rp[257] = a2.y;
        __syncthreads();
        if (F.tid < 384) { const int r = F.tid / 128, n = F.tid % 128; float s = 0.f;
#pragma unroll
            for (int w = 0; w < 8; ++w) s += red[w * 384 + r * 128 + n];
            F.MODS()[((size_t)l * 3 + r) * 12288 + n0 + n] = s + F.b_ada()[(size_t)l * 12288 + n0 + n]; }
        __syncthreads();
    }
    LAS float* scr = (LAS float*)(F.lds + 40960 + F.wave * 8448);
    constexpr int I_IN = (D / 64) * (INC / 32), I_OUT = (D / 64) * (D / 32);
    for (int it = F.gw; it < NLAYER * (I_IN + I_OUT); it += F.NGW) {
        const int l = it / (I_IN + I_OUT); int r = it % (I_IN + I_OUT);
        if (r < I_IN) transpose_item(F.w_in() + (size_t)l * D * INC, D, INC, F.WINT() + (size_t)l * INC * D, scr, r, F.lane);
        else transpose_item(F.w_out() + (size_t)l * D * D, D, D, F.WOUTT() + (size_t)l * D * D, scr, r - I_IN, F.lane);
    }
    for (int row = F.gw; row < NLAYER * D; row += F.NGW) {
        const int l = row / D, c = row % D; const f32x4* s = (const f32x4*)(F.wq() + (size_t)row * D) + F.lane;
#pragma unroll
        for (int j = 0; j < 8; ++j) { const f32x4 v = s[64 * j]; u32x2 o; o.x = pk2(v.x, v.y); o.y = pk2(v.z, v.w);
            *((u32x2*)(F.WQR() + ((size_t)(l * 8 + j) * D + c) * 256) + F.lane) = o; }
    }
    for (int row = F.gw; row < 32 * 256; row += F.NGW) {
        const int lh = row >> 8, pk = row & 255, p = pk >> 7;
        u32x2 o = {0u, 0u};
        if ((F.lane >> 5) == p) { const f32x4 v = *((const f32x4*)(F.keys() + ((size_t)lh * 256 + pk) * 128) + (F.lane & 31)); o.x = pk2(v.x, v.y); o.y = pk2(v.z, v.w); }
        *((u32x2*)(F.KBD() + (size_t)row * 256) + F.lane) = o;
    }
    convert_tables(F, 0, NEXP, F.gw, F.NGW);
    for (int i = blockIdx.x * (NWAVES * 64) + F.tid; i < 192 * 32; i += F.G * NWAVES * 64) {
        const int idx = i >> 5, f = i & 31; const float pos = (float)(idx < 128 ? idx : idx - 128);
        const float inv = powf(10000.f, -(float)(2 * f) / 64.f); const float ang = pos * inv;
        F.ROPE()[2 * i] = cosf(ang); F.ROPE()[2 * i + 1] = sinf(ang);
    }
}

__device__ __forceinline__ void p0b_mod0(Frame& F) {
    __syncthreads();
#pragma unroll 1
    for (int v = 0; v < 6; ++v)
        *(LAS f32x4*)(F.lds + v * 8192 + F.tid * 16) = *(const f32x4*)(F.MODS() + (size_t)(v % 3) * 12288 + (v < 3 ? 0 : D) + 4 * F.tid);
    __syncthreads();
    for (int t = F.gw; t < TT; t += F.NGW) {
        const float* src = t < TL ? F.x() + (size_t)t * D : F.ctx() + (size_t)(t - TL) * D;
        f32x4 v[8];
#pragma unroll
        for (int j = 0; j < 8; ++j) v[j] = *((const f32x4*)src + F.lane + 64 * j);
        const int mr = modrow(t);
        float mean, rstd; row_stats(v, mean, rstd);
        u32x2* d = (u32x2*)(F.H() + (size_t)t * D) + F.lane;
#pragma unroll
        for (int j = 0; j < 8; ++j) { const f32x4 sh = *(const LAS f32x4*)(F.lds + mr * 8192 + (64 * j + F.lane) * 16), sc = *(const LAS f32x4*)(F.lds + (3 + mr) * 8192 + (64 * j + F.lane) * 16);
            const f32x4 y = (v[j] - mean) * rstd * (sc + 1.f) + sh;
            u32x2 o; o.x = pk2(y.x, y.y); o.y = pk2(y.z, y.w); d[64 * j] = o; }
    }
}

constexpr int CONV_LDS = 81920;
constexpr int KP = 272, VP = 320, KS_BYTES = 64 * KP, VS_BYTES = 64 * VP;
struct KVRegs { u32x4 k1, k2, v1, v2; f32x4 cs[4]; };

__device__ __forceinline__ void attn_load_tile(Frame& F, KVRegs& R, int ti, int b, int n, int g) {
    const int key = F.tid >> 3, c8 = F.tid & 7;
    int row, pos = 0;
    if (ti < 6) { pos = (n - 1) * 128 + 64 * ti + key; row = b * SEQ + pos; } else row = TL + b * CTXL + 64 * (ti - 6) + key;
    const bf16_t* base = F.PROJ() + (size_t)row * INC;
    const int d1 = (c8 >> 2) * 64 + (c8 & 3) * 8;
    R.k1 = *(const u32x4*)(base + OFF_K + g * 128 + d1); R.k2 = *(const u32x4*)(base + OFF_K + g * 128 + d1 + 32);
    R.v1 = *(const u32x4*)(base + OFF_V + g * 128 + 8 * c8); R.v2 = *(const u32x4*)(base + OFF_V + g * 128 + 64 + 8 * c8);
    if (ti < 6) { const int tidx = (c8 >> 2) ? 128 + (pos & 63) : (pos >> 6); const f32x4* cp = (const f32x4*)(F.ROPE() + ((size_t)tidx * 32 + (c8 & 3) * 8) * 2);
#pragma unroll
        for (int m = 0; m < 4; ++m) R.cs[m] = cp[m]; }
}
__device__ __forceinline__ void rope8(u32x4& a, u32x4& bq, const f32x4 (&cs)[4], float scale) {
    u32x4 oa, ob;
#pragma unroll
    for (int w = 0; w < 4; ++w) {
        const float x1l = bf_lo(a[w]), x1h = bf_hi(a[w]), x2l = bf_lo(bq[w]), x2h = bf_hi(bq[w]);
        const float cl = cs[w].x, sl = cs[w].y, ch = cs[w].z, sh = cs[w].w;
        oa[w] = pk2((x1l * cl - x2l * sl) * scale, (x1h * ch - x2h * sh) * scale);
        ob[w] = pk2((x2l * cl + x1l * sl) * scale, (x2h * ch + x1h * sh) * scale);
    }
    a = oa; bq = ob;
}
__device__ __forceinline__ void attn_store_tile(Frame& F, KVRegs& R, int ti, int buf) {
    const int key = F.tid >> 3, c8 = F.tid & 7;
    if (ti < 6) rope8(R.k1, R.k2, R.cs, 1.f);
    const int d1 = (c8 >> 2) * 64 + (c8 & 3) * 8;
    LAS unsigned char* kp = F.lds + buf * KS_BYTES + key * KP;
    *(LAS u32x4*)(kp + d1 * 2) = R.k1; *(LAS u32x4*)(kp + (d1 + 32) * 2) = R.k2;
    LAS unsigned char* vp = F.lds + 2 * KS_BYTES + buf * VS_BYTES + key * VP;
    *(LAS u32x4*)(vp + 16 * c8) = R.v1; *(LAS u32x4*)(vp + 128 + 16 * c8) = R.v2;
}

#define MFMA32(a, b, c) __builtin_amdgcn_mfma_f32_32x32x16_bf16((a), (b), (c), 0, 0, 0)

__device__ __forceinline__ void attn_unit(Frame& F, int layer, int u) {
    const bool latent = u < 512;
    int b, n, g, hp;
    if (latent) { hp = u & 1; g = (u >> 1) & 1; n = (u >> 2) & 63; b = u >> 8; }
    else { const int v = u - 512; hp = v & 1; g = (v >> 1) & 1; n = (v >> 2) & 1; b = v >> 3; }
    const int lane = F.lane, r = lane & 31, h = lane >> 5, wave = F.wave;
    const int head = g * 4 + hp * 2 + (wave >> 2), qb = wave & 3;
    const int tq = latent ? b * SEQ + n * 128 + 32 * qb + r : TL + b * CTXL + n * 128 + 32 * qb + r;
    bf16x8 qf[8];
    {
        u32x4 raw[8];
        const bf16_t* qp = F.PROJ() + (size_t)tq * INC + OFF_Q + head * 128 + 8 * h;
#pragma unroll
        for (int ks = 0; ks < 8; ++ks) raw[ks] = *(const u32x4*)(qp + 16 * ks);
        if (latent) {
            const int pos = n * 128 + 32 * qb + r;
#pragma unroll
            for (int half = 0; half < 2; ++half) {
                const int tidx = half ? 128 + (pos & 63) : (pos >> 6);
#pragma unroll
                for (int kk = 0; kk < 2; ++kk) {
                    const f32x4* cp = (const f32x4*)(F.ROPE() + ((size_t)tidx * 32 + 16 * kk + 8 * h) * 2);
                    f32x4 cs[4];
#pragma unroll
                    for (int m = 0; m < 4; ++m) cs[m] = cp[m];
                    rope8(raw[4 * half + kk], raw[4 * half + kk + 2], cs, QSCALE);
                }
            }
        } else {
#pragma unroll
            for (int ks = 0; ks < 8; ++ks)
#pragma unroll
                for (int w = 0; w < 4; ++w) raw[ks][w] = pk2(bf_lo(raw[ks][w]) * QSCALE, bf_hi(raw[ks][w]) * QSCALE);
        }
#pragma unroll
        for (int ks = 0; ks < 8; ++ks) qf[ks] = __builtin_bit_cast(bf16x8, raw[ks]);
    }
    int tlo = 6, nw = 0;
    if (latent) { tlo = (n == 0) ? 2 : 0; const int thi = (n == 63) ? 3 : 5; nw = thi - tlo + 1; }
    const int ntiles = nw + 4;
    f32x16 o[4];
#pragma unroll
    for (int db = 0; db < 4; ++db)
#pragma unroll
        for (int i = 0; i < 16; ++i) o[db][i] = 0.f;
    float m_run = F.sink()[layer * 8 + head] * LOG2E;
    float lsum = h == 0 ? 1.f : 0.f;
    const int iq = 32 * qb + r;
    KVRegs R;
    __syncthreads();
    attn_load_tile(F, R, nw > 0 ? tlo : 6, b, n, g);
    attn_store_tile(F, R, nw > 0 ? tlo : 6, 0);
    __syncthreads();
    const int i16 = lane & 15, tq4 = i16 >> 2, tp = i16 & 3, blk = (lane >> 4) & 1;
    for (int j = 0; j < ntiles; ++j) {
        const int ti = j < nw ? tlo + j : 6 + (j - nw);
        const int buf = j & 1;
        const bool more = j + 1 < ntiles;
        const int tin = (j + 1) < nw ? tlo + j + 1 : 6 + (j + 1 - nw);
        if (more) attn_load_tile(F, R, tin, b, n, g);
        const bool part = ti >= 6 || (ti >= (qb >> 1) && ti <= (qb >> 1) + 4);
        if (part) {
            f32x16 s0, s1;
#pragma unroll
            for (int i = 0; i < 16; ++i) { s0[i] = 0.f; s1[i] = 0.f; }
            const LAS unsigned char* kb = F.lds + buf * KS_BYTES + r * KP + h * 16;
#pragma unroll
            for (int ks = 0; ks < 8; ++ks) {
                const bf16x8 a0 = *(const LAS bf16x8*)(kb + ks * 32), a1 = *(const LAS bf16x8*)(kb + 32 * KP + ks * 32);
                s0 = MFMA32(a0, qf[ks], s0); s1 = MFMA32(a1, qf[ks], s1);
            }
            float mx = -INFINITY;
            if (ti < 6 && (ti == (qb >> 1) || ti == (qb >> 1) + 4)) {
                const int jb = 64 * ti + 4 * h - iq;
#pragma unroll
                for (int i = 0; i < 16; ++i) { const int j0 = jb + (i & 3) + 8 * (i >> 2), j1 = j0 + 32;
                    s0[i] = (j0 >= 0 && j0 <= 256) ? s0[i] : -INFINITY; s1[i] = (j1 >= 0 && j1 <= 256) ? s1[i] : -INFINITY; }
            }
#pragma unroll
            for (int i = 0; i < 16; ++i) mx = fmaxf(mx, fmaxf(s0[i], s1[i]));
            mx = fmaxf(mx, xor32_f(mx, lane));
            if (__any(mx > m_run + 8.f)) {
                const float m_new = mx > m_run + 8.f ? mx : m_run, alpha = __builtin_amdgcn_exp2f(m_run - m_new);
                m_run = m_new; lsum *= alpha;
#pragma unroll
                for (int db = 0; db < 4; ++db)
#pragma unroll
                    for (int i = 0; i < 16; ++i) o[db][i] *= alpha;
            }
#pragma unroll
            for (int i = 0; i < 16; ++i) { s0[i] = __builtin_amdgcn_exp2f(s0[i] - m_run); s1[i] = __builtin_amdgcn_exp2f(s1[i] - m_run); lsum += s0[i] + s1[i]; }
            bf16x8 pf[2][2];
#pragma unroll
            for (int s2 = 0; s2 < 2; ++s2) {
                u32x4 p0, p1;
#pragma unroll
                for (int w = 0; w < 4; ++w) { p0[w] = pk2(s0[8 * s2 + 2 * w], s0[8 * s2 + 2 * w + 1]); p1[w] = pk2(s1[8 * s2 + 2 * w], s1[8 * s2 + 2 * w + 1]); }
                pf[0][s2] = __builtin_bit_cast(bf16x8, p0); pf[1][s2] = __builtin_bit_cast(bf16x8, p1);
            }
            const LAS unsigned char* vb = F.lds + 2 * KS_BYTES + buf * VS_BYTES + (4 * h + tq4) * VP + 32 * blk + 8 * tp;
#pragma unroll
            for (int db = 0; db < 4; ++db)
#pragma unroll
                for (int kb2 = 0; kb2 < 2; ++kb2)
#pragma unroll
                    for (int s2 = 0; s2 < 2; ++s2) {
                        const int off = (32 * kb2 + 16 * s2) * VP + db * 64;
                        const s16x4 lo = __builtin_amdgcn_ds_read_tr16_b64_v4i16((LAS s16x4*)(vb + off));
                        const s16x4 hi = __builtin_amdgcn_ds_read_tr16_b64_v4i16((LAS s16x4*)(vb + off + 8 * VP));
                        const bf16x8 av = __builtin_shufflevector(lo, hi, 0, 1, 2, 3, 4, 5, 6, 7);
                        o[db] = MFMA32(av, pf[kb2][s2], o[db]);
                    }
        }
        if (more) attn_store_tile(F, R, tin, buf ^ 1);
        __syncthreads();
    }
    const float lt = lsum + xor32_f(lsum, lane);
    const float inv = 1.f / lt;
    float ss = 0.f;
#pragma unroll
    for (int db = 0; db < 4; ++db)
#pragma unroll
        for (int i = 0; i < 16; ++i) { o[db][i] *= inv; ss += o[db][i] * o[db][i]; }
    ss += xor32_f(ss, lane);
    const float rn = 1.f / sqrtf(ss * (1.f / 128.f) + LN_EPS);
    bf16_t* op = F.MIX() + (size_t)tq * D + head * 128 + 4 * h;
    const float* gp = F.g_attn() + layer * 1024 + head * 128 + 4 * h;
#pragma unroll
    for (int db = 0; db < 4; ++db)
#pragma unroll
        for (int g4 = 0; g4 < 4; ++g4) {
            const f32x4 gv = *(const f32x4*)(gp + 32 * db + 8 * g4);
            u32x2 w; w.x = pk2(o[db][4 * g4] * rn * gv.x, o[db][4 * g4 + 1] * rn * gv.y); w.y = pk2(o[db][4 * g4 + 2] * rn * gv.z, o[db][4 * g4 + 3] * rn * gv.w);
            *(u32x2*)(op + 32 * db + 8 * g4) = w;
        }
}

__device__ __forceinline__ void unpack8(const u32x4 v, float (&f)[8]) {
#pragma unroll
    for (int w = 0; w < 4; ++w) { f[2 * w] = bf_lo(v[w]); f[2 * w + 1] = bf_hi(v[w]); }
}
__device__ __forceinline__ void conv_row(Frame& F, int layer, int t) {
    bool first, last;
    if (t < TL) { const int pos = t & (SEQ - 1); first = pos == 0; last = pos == SEQ - 1; } else { const int pc = (t - TL) & (CTXL - 1); first = pc == 0; last = pc == CTXL - 1; }
    const bf16_t* p = F.PROJ() + (size_t)t * INC;
    const LAS unsigned char* cvc = F.lds + CONV_LDS + F.lane * 16;
#pragma unroll
    for (int jc = 0; jc < 2; ++jc) {
        const int c = 8 * F.lane + 512 * jc;
        float gb[8], a[8], bq[8], um[8], ut[8], up[8];
        unpack8(*(const u32x4*)(p + c), gb);
        unpack8(*(const u32x4*)(p + OFF_C + c), a); unpack8(*(const u32x4*)(p + OFF_X + c), bq);
#pragma unroll
        for (int e = 0; e < 8; ++e) ut[e] = a[e] * bq[e];
        if (!first) { unpack8(*(const u32x4*)(p - INC + OFF_C + c), a); unpack8(*(const u32x4*)(p - INC + OFF_X + c), bq);
#pragma unroll
            for (int e = 0; e < 8; ++e) um[e] = a[e] * bq[e]; }
        else {
#pragma unroll
            for (int e = 0; e < 8; ++e) um[e] = 0.f; }
        if (!last) { unpack8(*(const u32x4*)(p + INC + OFF_C + c), a); unpack8(*(const u32x4*)(p + INC + OFF_X + c), bq);
#pragma unroll
            for (int e = 0; e < 8; ++e) up[e] = a[e] * bq[e]; }
        else {
#pragma unroll
            for (int e = 0; e < 8; ++e) up[e] = 0.f; }
        float y[8], ss = 0.f;
#pragma unroll
        for (int q = 0; q < 2; ++q) { const f32x4 w0 = *(const LAS f32x4*)(cvc + (2 * jc + q) * 1024), w1 = *(const LAS f32x4*)(cvc + 4096 + (2 * jc + q) * 1024), w2 = *(const LAS f32x4*)(cvc + 8192 + (2 * jc + q) * 1024);
#pragma unroll
            for (int e = 0; e < 4; ++e) { const int i = 4 * q + e; y[i] = gb[i] * (w0[e] * um[i] + w1[e] * ut[i] + w2[e] * up[i]); ss += y[i] * y[i]; } }
        ss += dpp_f<DPP_XOR1>(ss); ss += dpp_f<DPP_XOR2>(ss); ss += dpp_f<DPP_ROR4>(ss); ss += dpp_f<DPP_ROR8>(ss);
        const float rn = 1.f / sqrtf(ss * (1.f / 128.f) + LN_EPS);
        u32x4 w;
#pragma unroll
        for (int q = 0; q < 2; ++q) { const f32x4 gcv = *(const LAS f32x4*)(cvc + 12288 + (2 * jc + q) * 1024); w[2 * q] = pk2(y[4 * q] * rn * gcv[0], y[4 * q + 1] * rn * gcv[1]); w[2 * q + 1] = pk2(y[4 * q + 2] * rn * gcv[2], y[4 * q + 3] * rn * gcv[3]); }
        *(u32x4*)(F.MIX() + (size_t)t * D + 1024 + c) = w;
    }
}

__device__ __forceinline__ void ln_phase(Frame& F, int layer, int rows) {
    const int lane = F.lane;
    u32x4 w[4], wn[4];
    int t = F.gw;
    if (t < rows) {
#pragma unroll
        for (int j = 0; j < 4; ++j) w[j] = *(const u32x4*)(F.X() + (size_t)t * D + 8 * lane + 512 * j);
    }
    {
        const int ch = F.tid, jj = ch >> 7, rem = ch & 127, ll = rem >> 1, qq = rem & 1;
        LAS unsigned char* dst = F.lds + ((2 * jj + qq) * 64 + ll) * 16;
        *(LAS f32x4*)(dst) = *(const f32x4*)(F.ln1_g() + layer * D + 4 * ch);
        *(LAS f32x4*)(dst + 8192) = *(const f32x4*)(F.ln1_b() + layer * D + 4 * ch);
#pragma unroll 1
        for (int v = 0; v < 6; ++v) { const int mrv = v % 3; const size_t off = ((size_t)layer * 3 + mrv) * 12288 + (v < 3 ? 3 * D : 4 * D);
            *(LAS f32x4*)(dst + (2 + v) * 8192) = *(const f32x4*)(F.MODS() + off + 4 * ch); }
    }
    __syncthreads();
    const LAS unsigned char* vc = F.lds + lane * 16;
    while (t < rows) {
        const int tn = t + F.NGW;
        if (tn < rows) {
#pragma unroll
            for (int j = 0; j < 4; ++j) wn[j] = *(const u32x4*)(F.X() + (size_t)tn * D + 8 * lane + 512 * j);
        }
        float v[32]; float s = 0.f;
#pragma unroll
        for (int j = 0; j < 4; ++j)
#pragma unroll
            for (int q = 0; q < 4; ++q) { v[8 * j + 2 * q] = bf_lo(w[j][q]); v[8 * j + 2 * q + 1] = bf_hi(w[j][q]); s += v[8 * j + 2 * q] + v[8 * j + 2 * q + 1]; }
        const float mean = wave_sum(s) * (1.f / D);
        float s2 = 0.f;
#pragma unroll
        for (int i = 0; i < 32; ++i) { v[i] -= mean; s2 += v[i] * v[i]; }
        const float rstd = 1.f / sqrtf(wave_sum(s2) * (1.f / D) + LN_EPS);
        float s3 = 0.f;
#pragma unroll
        for (int j = 0; j < 4; ++j) { const int c = 8 * lane + 512 * j; u32x4 o;
#pragma unroll
            for (int q = 0; q < 2; ++q) { const f32x4 gg = *(const LAS f32x4*)(vc + (2 * j + q) * 1024), bb = *(const LAS f32x4*)(vc + 8192 + (2 * j + q) * 1024);
#pragma unroll
                for (int e = 0; e < 4; ++e) { const float y = v[8 * j + 4 * q + e] * rstd * gg[e] + bb[e]; v[8 * j + 4 * q + e] = y; s3 += y; }
                o[2 * q] = pk2(v[8 * j + 4 * q], v[8 * j + 4 * q + 1]); o[2 * q + 1] = pk2(v[8 * j + 4 * q + 2], v[8 * j + 4 * q + 3]); }
            *(u32x4*)(F.X() + (size_t)t * D + c) = o; }
        const float mean2 = wave_sum(s3) * (1.f / D);
        float s4 = 0.f;
#pragma unroll
        for (int i = 0; i < 32; ++i) { v[i] -= mean2; s4 += v[i] * v[i]; }
        const float rstd2 = 1.f / sqrtf(wave_sum(s4) * (1.f / D) + LN_EPS);
        const int mrl = modrow(t);
#pragma unroll
        for (int j = 0; j < 4; ++j) { const int c = 8 * lane + 512 * j; u32x4 o;
#pragma unroll
            for (int q = 0; q < 2; ++q) { const f32x4 sh = *(const LAS f32x4*)(vc + (2 + mrl) * 8192 + (2 * j + q) * 1024), sc = *(const LAS f32x4*)(vc + (5 + mrl) * 8192 + (2 * j + q) * 1024);
                const float y0 = v[8 * j + 4 * q] * rstd2 * (1.f + sc[0]) + sh[0], y1 = v[8 * j + 4 * q + 1] * rstd2 * (1.f + sc[1]) + sh[1];
                const float y2 = v[8 * j + 4 * q + 2] * rstd2 * (1.f + sc[2]) + sh[2], y3 = v[8 * j + 4 * q + 3] * rstd2 * (1.f + sc[3]) + sh[3];
                o[2 * q] = pk2(y0, y1); o[2 * q + 1] = pk2(y2, y3); }
            *(u32x4*)(F.H() + (size_t)t * D + c) = o; }
#pragma unroll
        for (int j = 0; j < 4; ++j) w[j] = wn[j];
        t = tn;
    }
}

__device__ __forceinline__ unsigned ordkey(float f) { const unsigned u = __float_as_uint(f); return u ^ ((u >> 31) ? 0xFFFFFFFFu : 0x80000000u); }
__device__ __forceinline__ float gelu_erf(float a) { return 0.5f * a * (1.f + erff(a * 0.70710678118654752f)); }

__device__ __forceinline__ float unordkey(unsigned k) { return __uint_as_float(k ^ ((k >> 31) ? 0x80000000u : 0xFFFFFFFFu)); }
__device__ __forceinline__ float gelu_as(float v) {
    const float av = fabsf(v), t = __builtin_amdgcn_rcpf(av * 0.2316418882f + 1.0f);
    float q = t * 0.5307027145f + (-0.7265760135f); q = q * t + 0.7107068705f; q = q * t + (-0.142248368f); q = q * t + 0.127414796f; q = q * t;
    const float e = __builtin_amdgcn_exp2f((v * v) * (-0.72134752044f));
    const float m = v * (q * e);
    return v < 0.f ? m : v - m;
}

template <class O> struct QuadNet {
    typedef typename O::V V; typedef typename O::B B;
    template <bool ASC> static __device__ __forceinline__ void ce_reg(V& a, V& b) { const V lo = O::vmin(a, b), hi = O::vmax(a, b); a = ASC ? lo : hi; b = ASC ? hi : lo; }
    template <bool ASC> static __device__ __forceinline__ void ce_l1(V& x, B low1) { const V p = O::x1(x); const V mn = O::vmin(p, x), mx = O::vmax(p, x); x = ASC ? O::vsel(low1, mn, mx) : O::vsel(low1, mx, mn); }
    template <bool ASC> static __device__ __forceinline__ void ce_l2(V& x, B low2) { const V p = O::x2(x); const V mn = O::vmin(p, x), mx = O::vmax(p, x); x = ASC ? O::vsel(low2, mn, mx) : O::vsel(low2, mx, mn); }
    template <int NR> static __device__ __forceinline__ void sort_blocks(V (&R)[NR], B low1, B low2, B eq12) {
#pragma unroll
        for (int r = 0; r < NR; ++r) { const V p = O::x1(R[r]); const V mn = O::vmin(p, R[r]), mx = O::vmax(p, R[r]); R[r] = O::vsel(eq12, mn, mx); }
#pragma unroll
        for (int r = 0; r < NR; ++r) { if ((r & 1) == 0) ce_l2<true>(R[r], low2); else ce_l2<false>(R[r], low2); }
#pragma unroll
        for (int r = 0; r < NR; ++r) { if ((r & 1) == 0) ce_l1<true>(R[r], low1); else ce_l1<false>(R[r], low1); }
#pragma unroll
        for (int r = 0; r < NR; r += 2) { if ((r & 2) == 0) ce_reg<true>(R[r], R[r + 1]); else ce_reg<false>(R[r], R[r + 1]); }
#pragma unroll
        for (int r = 0; r < NR; ++r) { if ((r & 2) == 0) ce_l2<true>(R[r], low2); else ce_l2<false>(R[r], low2); }
#pragma unroll
        for (int r = 0; r < NR; ++r) { if ((r & 2) == 0) ce_l1<true>(R[r], low1); else ce_l1<false>(R[r], low1); }
#pragma unroll
        for (int r = 0; r < NR; ++r) { if ((r & 2) == 0) { if ((r & 4) == 0) ce_reg<true>(R[r], R[r + 2]); else ce_reg<false>(R[r], R[r + 2]); } }
#pragma unroll
        for (int r = 0; r < NR; r += 2) { if ((r & 4) == 0) ce_reg<true>(R[r], R[r + 1]); else ce_reg<false>(R[r], R[r + 1]); }
#pragma unroll
        for (int r = 0; r < NR; ++r) { if ((r & 4) == 0) ce_l2<true>(R[r], low2); else ce_l2<false>(R[r], low2); }
#pragma unroll
        for (int r = 0; r < NR; ++r) { if ((r & 4) == 0) ce_l1<true>(R[r], low1); else ce_l1<false>(R[r], low1); }
    }
    template <int NR> static __device__ __forceinline__ void halve_merge(const V (&R)[NR], V (&Q)[NR / 2], B low1, B low2) {
#pragma unroll
        for (int m = 0; m < NR / 8; ++m)
#pragma unroll
            for (int i = 0; i < 4; ++i) Q[4 * m + i] = O::vmax(R[8 * m + i], R[8 * m + 4 + i]);
#pragma unroll
        for (int r = 0; r < NR / 2; ++r) { if ((r & 2) == 0) { if ((r & 4) == 0) ce_reg<false>(Q[r], Q[r + 2]); else ce_reg<true>(Q[r], Q[r + 2]); } }
#pragma unroll
        for (int r = 0; r < NR / 2; r += 2) { if ((r & 4) == 0) ce_reg<false>(Q[r], Q[r + 1]); else ce_reg<true>(Q[r], Q[r + 1]); }
#pragma unroll
        for (int r = 0; r < NR / 2; ++r) { if ((r & 4) == 0) ce_l2<false>(Q[r], low2); else ce_l2<true>(Q[r], low2); }
#pragma unroll
        for (int r = 0; r < NR / 2; ++r) { if ((r & 4) == 0) ce_l1<false>(Q[r], low1); else ce_l1<true>(Q[r], low1); }
    }
    static __device__ __forceinline__ void top16_of_128(V (&R)[32], V (&T)[4], B low1, B low2, B eq12) {
        sort_blocks<32>(R, low1, low2, eq12);
        V A[16]; halve_merge<32>(R, A, low1, low2);
        V Bq[8]; halve_merge<16>(A, Bq, low1, low2);
        halve_merge<8>(Bq, T, low1, low2);
    }
    static __device__ __forceinline__ void top16_of_64(V (&R)[16], V (&T)[4], B low1, B low2, B eq12) {
        sort_blocks<16>(R, low1, low2, eq12);
        V A[8]; halve_merge<16>(R, A, low1, low2);
        halve_merge<8>(A, T, low1, low2);
    }
};

struct DevOps {
    typedef unsigned V; typedef bool B;
    static __device__ __forceinline__ V vmin(V a, V b) { return a < b ? a : b; }
    static __device__ __forceinline__ V vmax(V a, V b) { return a > b ? a : b; }
    static __device__ __forceinline__ V vsel(B m, V a, V b) { return m ? a : b; }
    static __device__ __forceinline__ V x1(V a) { return (V)dpp_i<DPP_XOR1>((int)a); }
    static __device__ __forceinline__ V x2(V a) { return (V)dpp_i<DPP_XOR2>((int)a); }
};
__device__ __forceinline__ void stair_ab(int c, int& a, int& b) {
    if (c < 16) { a = 0; b = c; } else if (c < 24) { a = 1; b = c - 16; } else if (c < 28) { a = 2; b = c - 24; } else if (c < 32) { a = 3; b = c - 28; }
    else if (c < 36) { a = 4; b = c - 32; } else if (c < 40) { a = 5 + ((c - 36) >> 1); b = (c - 36) & 1; } else if (c < 44) { a = 7 + ((c - 40) >> 1); b = (c - 40) & 1; }
    else if (c < 48) { a = 9 + (c - 44); b = 0; } else if (c < 51) { a = 13 + (c - 48); b = 0; } else { a = 2; b = 4; }
}
constexpr int PE_WS = 5120, PE_TAB = 8 * PE_WS;
constexpr int PE_VEC = PE_TAB + 512;
static_assert(PE_VEC + 11 * 8192 <= LDSCTL_OFF, "PE vector cache");
__device__ __forceinline__ void peer_topk(Frame& F, LAS unsigned char* ws, int t) {
    const int lane = F.lane, sub = lane & 3;
    const bool low1 = (sub & 1) == 0, low2 = (sub & 2) == 0, eq12 = low1 == low2;
    LAS unsigned* S1K = (LAS unsigned*)ws; LAS int* EL = (LAS int*)(ws + 3328); LAS float* GL = (LAS float*)(ws + 3840);
    const LAS unsigned short* TAB = (const LAS unsigned short*)(F.lds + PE_TAB);
    {
        const int L = lane >> 2;
        const float* sp = F.SC() + (size_t)t * D + L * 128 + sub * 4;
        unsigned R[32];
#pragma unroll
        for (int q = 0; q < 8; ++q) { const f32x4 v = *(const f32x4*)(sp + 16 * q);
#pragma unroll
            for (int e = 0; e < 4; ++e) R[4 * q + e] = (ordkey(v[e]) & ~127u) | (unsigned)(127 - (4 * sub + 16 * q + e)); }
        unsigned T[4];
        QuadNet<DevOps>::top16_of_128(R, T, low1, low2, eq12);
#pragma unroll
        for (int r = 0; r < 4; ++r) S1K[L * 16 + 4 * r + sub] = T[r];
    }
    LDS_WAIT(); __builtin_amdgcn_wave_barrier();
    {
        const int hd = (lane >> 2) & 7;
        const LAS unsigned char* la = (const LAS unsigned char*)(S1K + (2 * hd) * 16); const LAS unsigned char* lb = (const LAS unsigned char*)(S1K + (2 * hd + 1) * 16);
        unsigned C[16];
#pragma unroll
        for (int r = 0; r < 13; ++r) { const unsigned ab = TAB[4 * r + sub];
            const unsigned ka = *(const LAS unsigned*)(la + (ab & 255u)), kb = *(const LAS unsigned*)(lb + (ab >> 8));
            const float sum = unordkey(ka & ~127u) + unordkey(kb & ~127u);
            C[r] = (ordkey(sum) & ~63u) | (unsigned)(63 - (4 * r + sub)); }
        C[13] = 0u; C[14] = 0u; C[15] = 0u;
        unsigned W[4];
        QuadNet<DevOps>::top16_of_64(C, W, low1, low2, eq12);
        float sv[4]; int ex[4];
#pragma unroll
        for (int r = 0; r < 4; ++r) { const unsigned ab = TAB[63 - (W[r] & 63u)];
            const unsigned ka = *(const LAS unsigned*)(la + (ab & 255u)), kb = *(const LAS unsigned*)(lb + (ab >> 8));
            ex[r] = (int)(127u - (ka & 127u)) * 128 + (int)(127u - (kb & 127u)); sv[r] = unordkey(W[r] & ~63u); }
        const float mx = dpp_f<0x00>(sv[0]);
        float e4[4], es = 0.f;
#pragma unroll
        for (int r = 0; r < 4; ++r) { e4[r] = __expf(sv[r] - mx); es += e4[r]; }
        es += dpp_f<DPP_XOR1>(es); es += dpp_f<DPP_XOR2>(es);
        const float rd = 1.f / es;
#pragma unroll
        for (int r = 0; r < 4; ++r) { GL[hd * 16 + 4 * r + sub] = e4[r] * rd; EL[hd * 16 + 4 * r + sub] = ex[r]; }
    }
    LDS_WAIT(); __builtin_amdgcn_wave_barrier();
}

#ifndef PROBE_PHASE
#define PROBE_PHASE -1
#endif
#ifndef PROBE_MULT
#define PROBE_MULT 1
#endif
constexpr int EB = 4;
constexpr int CW_TICKET = 20480;

struct GBuf { LpRow<U_FMT> u[EB]; LpRow<V_FMT> v[EB]; };
__device__ __forceinline__ void gather_issue(GBuf& B, const LAS int* EL, int i0, const unsigned char* UTl, const unsigned char* VTl, int lane) {
#pragma unroll
    for (int q = 0; q < EB; ++q) {
        const int ex = __builtin_amdgcn_readfirstlane(EL[i0 + q]);
        B.u[q].load(UTl + (size_t)ex * UROW, lane); B.v[q].load(VTl + (size_t)ex * VROW, lane);
    }
}
__device__ __forceinline__ void gather_compute(const GBuf& B, const LAS int* EL, const LAS float* GL, int i0, const float* USl, const float* VSl, const unsigned (&hv)[16], f32x2 (&acc)[16]) {
    float dot[EB], su[EB], sv[EB], g[EB];
#pragma unroll
    for (int q = 0; q < EB; ++q) { const int ex = __builtin_amdgcn_readfirstlane(EL[i0 + q]); su[q] = USl[ex]; sv[q] = VSl[ex];
        g[q] = __uint_as_float(__builtin_amdgcn_readfirstlane(__float_as_uint(GL[i0 + q]))); }
#pragma unroll
    for (int q = 0; q < EB; ++q) { float s0 = 0.f, s1 = 0.f;
        B.u[q].each_bf([&](int i, bf16x2_t x) { if (i & 1) s1 = __builtin_amdgcn_fdot2_f32_bf16(x, __builtin_bit_cast(bf16x2_t, hv[i]), s1, false); else s0 = __builtin_amdgcn_fdot2_f32_bf16(x, __builtin_bit_cast(bf16x2_t, hv[i]), s0, false); });
        dot[q] = s0 + s1; __builtin_amdgcn_sched_barrier(0); }
#pragma unroll
    for (int q = 0; q < EB; ++q) dot[q] = wave_sum_u(dot[q]);
#pragma unroll
    for (int q = 0; q < EB; ++q) { const float cf = g[q] * gelu_as(dot[q] * su[q]) * sv[q]; const f32x2 c2 = {cf, cf};
        B.v[q].each([&](int i, float x0, float x1) { const f32x2 x = {x0, x1}; acc[i >> 1] = __builtin_elementwise_fma(x, c2, acc[i >> 1]); }); __builtin_amdgcn_sched_barrier(0); }
}

__device__ __forceinline__ void peer_phase(Frame& F, int layer, int rows, unsigned* ctl, unsigned long long& pr_acc) {
    unsigned long long pt0 = 0ull;
#define SUB_BEGIN(ty) do { if (PROBE_PHASE == (ty)) pt0 = __builtin_amdgcn_s_memrealtime(); } while (0)
#define SUB_END(ty) do { if (PROBE_PHASE == (ty)) pr_acc += __builtin_amdgcn_s_memrealtime() - pt0; } while (0)
    if (F.tid < 64) { int a = 0, b = 0; stair_ab(F.tid < 52 ? F.tid : 0, a, b); *(LAS unsigned short*)(F.lds + PE_TAB + 2 * F.tid) = (unsigned short)((4 * a) | ((4 * b) << 8)); }
    {
        const int ch = F.tid, ll = ch >> 3, q = ch & 7;
        LAS unsigned char* dst = F.lds + PE_VEC + (q * 64 + ll) * 16;
        const int nl = layer < NLAYER - 1 ? layer + 1 : layer;
#pragma unroll 1
        for (int v = 0; v < 9; ++v) {
            const int g3 = v / 3, mrv = v - 3 * g3;
            const size_t off = ((size_t)(g3 == 0 ? layer : nl) * 3 + mrv) * 12288 + (g3 == 0 ? 5 * D : (g3 == 1 ? 0 : D));
            *(LAS f32x4*)(dst + v * 8192) = *(const f32x4*)(F.MODS() + off + 4 * ch);
        }
        *(LAS f32x4*)(dst + 9 * 8192) = *(const f32x4*)(F.ln2_g() + layer * D + 4 * ch);
        *(LAS f32x4*)(dst + 10 * 8192) = *(const f32x4*)(F.ln2_b() + layer * D + 4 * ch);
    }
    __syncthreads();
    LAS unsigned char* ws = F.lds + F.wave * PE_WS;
    LAS int* EL = (LAS int*)(ws + 3328); LAS float* GL = (LAS float*)(ws + 3840);
    const int lane = F.lane;
    const LAS unsigned char* vcache = F.lds + PE_VEC + lane * 16;
    const unsigned char* UTl = F.UT() + (size_t)layer * NEXP * UROW;
    const unsigned char* VTl = F.VT() + (size_t)layer * NEXP * VROW;
    const float* USl = F.US() + (size_t)layer * NEXP; const float* VSl = F.VS() + (size_t)layer * NEXP;
    unsigned* ticket = ctl + CW_TICKET + 64 * layer;
    unsigned tk = 0u;
    if (lane == 0) tk = __hip_atomic_fetch_add(ticket, 1u, __ATOMIC_RELAXED, __HIP_MEMORY_SCOPE_AGENT);
    int t = (int)__builtin_amdgcn_readfirstlane(tk);
    while (t < rows) {
        unsigned tkn = 0u;
        if (lane == 0) tkn = __hip_atomic_fetch_add(ticket, 1u, __ATOMIC_RELAXED, __HIP_MEMORY_SCOPE_AGENT);
        SUB_BEGIN(8); peer_topk(F, ws, t); SUB_END(8);
        SUB_BEGIN(9);
        unsigned hv[16]; f32x2 acc[16];
#pragma unroll
        for (int q = 0; q < 4; ++q) { const u32x4 w = *(const u32x4*)(F.H() + (size_t)t * D + 32 * lane + 8 * q);
#pragma unroll
            for (int e = 0; e < 4; ++e) { hv[4 * q + e] = w[e]; acc[4 * q + e] = (f32x2){0.f, 0.f}; } }
        {
            GBuf A, B, C;
            gather_issue(A, EL, 0, UTl, VTl, lane);
            gather_issue(B, EL, EB, UTl, VTl, lane);
            for (int i0 = 0; i0 < 30 * EB; i0 += 3 * EB) {
                gather_issue(C, EL, i0 + 2 * EB, UTl, VTl, lane);
                gather_compute(A, EL, GL, i0, USl, VSl, hv, acc);
                gather_issue(A, EL, i0 + 3 * EB, UTl, VTl, lane);
                gather_compute(B, EL, GL, i0 + EB, USl, VSl, hv, acc);
                gather_issue(B, EL, i0 + 4 * EB, UTl, VTl, lane);
                gather_compute(C, EL, GL, i0 + 2 * EB, USl, VSl, hv, acc);
            }
            gather_compute(A, EL, GL, 30 * EB, USl, VSl, hv, acc);
            gather_compute(B, EL, GL, 31 * EB, USl, VSl, hv, acc);
        }
        SUB_END(9); SUB_BEGIN(10);
        const int mr = modrow(t);
        const float* mp = F.MODS() + ((size_t)layer * 3 + mr) * 12288;
        bf16_t* xr = F.X() + (size_t)t * D;
        float rr[32]; float s = 0.f;
#pragma unroll
        for (int q2 = 0; q2 < 4; ++q2) { const u32x4 xw = *(const u32x4*)(xr + 32 * lane + 8 * q2);
#pragma unroll
            for (int h2 = 0; h2 < 2; ++h2) { const int q = 2 * q2 + h2; const f32x4 gv = *(const LAS f32x4*)(vcache + mr * 8192 + q * 1024);
                const f32x4 xv = {bf_lo(xw[2 * h2]), bf_hi(xw[2 * h2]), bf_lo(xw[2 * h2 + 1]), bf_hi(xw[2 * h2 + 1])};
                const f32x4 av = {acc[2 * q].x, acc[2 * q].y, acc[2 * q + 1].x, acc[2 * q + 1].y};
#pragma unroll
                for (int e = 0; e < 4; ++e) { const float v = DN_ALPHA * xv[e] + gv[e] * av[e]; rr[4 * q + e] = v; s += v; } } }
        const float mean = wave_sum_u(s) * (1.f / D);
        float s2 = 0.f;
#pragma unroll
        for (int i = 0; i < 32; ++i) { rr[i] -= mean; s2 += rr[i] * rr[i]; }
        const float rstd = 1.f / sqrtf(wave_sum_u(s2) * (1.f / D) + LN_EPS);
        const float* g2 = F.ln2_g() + layer * D; const float* b2 = F.ln2_b() + layer * D;
        float s3 = 0.f;
#pragma unroll
        for (int q = 0; q < 8; ++q) { const int c = 32 * lane + 4 * q; const f32x4 gg = *(const LAS f32x4*)(vcache + 9 * 8192 + q * 1024), bb = *(const LAS f32x4*)(vcache + 10 * 8192 + q * 1024);
            f32x4 xo;
#pragma unroll
            for (int e = 0; e < 4; ++e) { xo[e] = rr[4 * q + e] * rstd * gg[e] + bb[e]; rr[4 * q + e] = xo[e]; s3 += xo[e]; }
            if (layer < NLAYER - 1) { u32x2 o2; o2.x = pk2(xo[0], xo[1]); o2.y = pk2(xo[2], xo[3]); *(u32x2*)(xr + c) = o2; } else if (t < TL) *(f32x4*)(F.out() + (size_t)t * D + c) = xo; }
        if (layer < NLAYER - 1) {
            const float mean2 = wave_sum_u(s3) * (1.f / D);
            float s4 = 0.f;
#pragma unroll
            for (int i = 0; i < 32; ++i) { rr[i] -= mean2; s4 += rr[i] * rr[i]; }
            const float rstd2 = 1.f / sqrtf(wave_sum_u(s4) * (1.f / D) + LN_EPS);
            const float* np = F.MODS() + ((size_t)(layer + 1) * 3 + mr) * 12288;
#pragma unroll
            for (int q2 = 0; q2 < 4; ++q2) { const int c = 32 * lane + 8 * q2; u32x4 w;
#pragma unroll
                for (int q = 0; q < 2; ++q) { const f32x4 sh = *(const LAS f32x4*)(vcache + (3 + mr) * 8192 + (2 * q2 + q) * 1024), sc = *(const LAS f32x4*)(vcache + (6 + mr) * 8192 + (2 * q2 + q) * 1024); const int ri = 8 * q2 + 4 * q;
                    const float y0 = rr[ri] * rstd2 * (1.f + sc[0]) + sh[0], y1 = rr[ri + 1] * rstd2 * (1.f + sc[1]) + sh[1];
                    const float y2 = rr[ri + 2] * rstd2 * (1.f + sc[2]) + sh[2], y3 = rr[ri + 3] * rstd2 * (1.f + sc[3]) + sh[3];
                    w[2 * q] = pk2(y0, y1); w[2 * q + 1] = pk2(y2, y3); }
                *(u32x4*)(F.H() + (size_t)t * D + c) = w; }
        }
        SUB_END(10);
        t = (int)__builtin_amdgcn_readfirstlane(tkn);
    }
#undef SUB_BEGIN
#undef SUB_END
}

__global__ void __launch_bounds__(NWAVES * 64, 2) skel_fwd(Args args) {
    extern __shared__ __attribute__((aligned(16))) unsigned char lds[];
    Frame F;
    F.lds = (LAS unsigned char*)lds;
    F.tid = threadIdx.x; F.lane = F.tid & 63; F.wave = __builtin_amdgcn_readfirstlane(F.tid >> 6);
    F.G = gridDim.x; F.gw = blockIdx.x * NWAVES + F.wave; F.NGW = F.G * NWAVES;
    unsigned char* ws = args.ws;
    F.ka = (const CAS unsigned char*)__builtin_amdgcn_kernarg_segment_ptr();
    for (int u = F.tid; u < (LDS_BYTES - LDSCTL_OFF) / 4; u += NWAVES * 64) ((LAS unsigned*)(F.lds + LDSCTL_OFF))[u] = 0u;
    __syncthreads();
    unsigned* ctl = (unsigned*)(ws + WS_CTL);
    const int lo = args.ph_lo, hi = args.ph_hi;
    XcdBarrier bar; bar.bar = ctl + CW_BAR + args.li * XCD_BAR_WORDS; bar.x = 0; bar.st = nullptr;
    if (hi - lo > 1) bar = xcd_barrier_post(ctl + CW_BAR + args.li * XCD_BAR_WORDS, (volatile LAS unsigned*)(F.lds + MISC_OFF) + 8);
#define IN(k) (lo <= (k) && (k) < hi)
    unsigned long long pr_acc = 0ull, pr_t0 = 0ull;
#define PR_BEGIN(ty) do { if (PROBE_PHASE == (ty)) pr_t0 = __builtin_amdgcn_s_memrealtime(); } while (0)
#define PR_END(ty) do { if (PROBE_PHASE == (ty)) pr_acc += __builtin_amdgcn_s_memrealtime() - pr_t0; } while (0)
#define BOTH(k) (IN(k) && IN((k) + 1))
#define SEAM(k) do { if (BOTH(k)) xcd_barrier(bar); } while (0)

    if (IN(0)) { PR_BEGIN(0); frame_ids(F); p0a_prologue(F); SEAM(0); PR_END(0); }
    if (IN(1)) {
        PR_BEGIN(1); frame_ids(F);
        { pg8::Gemm g{F.KBD(), F.WQR(), 32 * 256, 2048, 256}; pg8::BatchOrder S{F.G, (int)blockIdx.x}; pg8::EpiBf16 E{F.WEFFT(), D};
          pg8::gemm_phase<pg8::EpiBf16, pg8::BatchOrder, false, true>(F.lds, g, S, E); }
        p0b_mod0(F);
        SEAM(1); PR_END(1);
    }
    for (int layer = 0; layer < NLAYER; ++layer) {
        const int pb = 2 + 6 * layer;
        const bool lastl = layer == NLAYER - 1;
        const int rows = lastl ? TL : TT;
        if (IN(pb + 0)) {
            PR_BEGIN(2); frame_ids(F);
            pg8::Gemm g{F.H(), F.WINT() + (size_t)layer * INC * D, TT, INC, D}; pg8::StaticOrder S; S.init(TT, INC, F.G, (int)blockIdx.x);
            pg8::EpiBf16 E{F.PROJ(), INC};
            pg8::gemm_phase<pg8::EpiBf16, pg8::StaticOrder, true, true>(F.lds, g, S, E);
            SEAM(pb + 0); PR_END(2);
        }
        if (IN(pb + 1)) {
            PR_BEGIN(3); frame_ids(F);
            const int nunits = lastl ? 512 : 528;
            {
                const int ch = F.tid & 255, vsel = F.tid >> 8;
                LAS unsigned char* dst = F.lds + CONV_LDS + ((2 * (ch >> 7) + (ch & 1)) * 64 + ((ch & 127) >> 1)) * 16;
                *(LAS f32x4*)(dst + vsel * 4096) = *(const f32x4*)(F.conv_w() + (size_t)layer * 3 * 1024 + vsel * 1024 + 4 * ch);
                *(LAS f32x4*)(dst + (2 + vsel) * 4096) = vsel == 0 ? *(const f32x4*)(F.conv_w() + (size_t)layer * 3 * 1024 + 2048 + 4 * ch) : *(const f32x4*)(F.g_conv() + layer * 1024 + 4 * ch);
            }
            __syncthreads();
            { unsigned long long q0 = 0; if (PROBE_PHASE == 11) q0 = __builtin_amdgcn_s_memrealtime();
            { const int bx = (int)blockIdx.x, vcu = (F.G % 8 == 0) ? (bx % 8) * (F.G / 8) + bx / 8 : bx;
              for (int u = vcu; u < nunits; u += F.G) attn_unit(F, layer, u); }
            if (PROBE_PHASE == 11) pr_acc += __builtin_amdgcn_s_memrealtime() - q0; if (PROBE_PHASE == 12) q0 = __builtin_amdgcn_s_memrealtime();
            {
              const int nx = nunits - 2 * F.G; const bool uneven = nx > 0 && nx < F.G;
              const int bx2 = (int)blockIdx.x, vc2 = (F.G % 8 == 0) ? (bx2 % 8) * (F.G / 8) + bx2 / 8 : bx2;
              const int c0 = uneven ? vc2 - nx : vc2, nb = uneven ? F.G - nx : F.G;
              if (c0 >= 0) for (int t = c0 * NWAVES + F.wave; t < rows; t += nb * NWAVES) conv_row(F, layer, t); }
            if (PROBE_PHASE == 12) pr_acc += __builtin_amdgcn_s_memrealtime() - q0; }
            SEAM(pb + 1); PR_END(3);
        }
        if (IN(pb + 2)) {
            PR_BEGIN(4); frame_ids(F);
            pg8::Gemm g{F.MIX(), F.WOUTT() + (size_t)layer * D * D, rows, D, D}; pg8::StaticOrder S; S.init(rows, D, F.G, (int)blockIdx.x);
            pg8::EpiResid E{layer == 0 ? F.x() : nullptr, layer == 0 ? F.ctx() : nullptr, F.X(), F.MODS() + (size_t)layer * 3 * 12288 + 2 * D};
            pg8::gemm_phase<pg8::EpiResid, pg8::StaticOrder, true, true>(F.lds, g, S, E);
            frame_ids(F); convert_in_tail(F, layer, (rows / 256) * (D / 256), 0);
            SEAM(pb + 2); PR_END(4);
        }
        if (IN(pb + 3)) { PR_BEGIN(5); frame_ids(F); ln_phase(F, layer, rows); SEAM(pb + 3); PR_END(5); }
        if (IN(pb + 4)) {
            PR_BEGIN(6); frame_ids(F);
            pg8::Gemm g{F.H(), F.WEFFT() + (size_t)layer * D * D, rows, D, D}; pg8::StaticOrder S; S.init(rows, D, F.G, (int)blockIdx.x);
            pg8::EpiF32 E{F.SC(), D};
            pg8::gemm_phase<pg8::EpiF32, pg8::StaticOrder, true, true>(F.lds, g, S, E);
            frame_ids(F); convert_in_tail(F, layer, (rows / 256) * (D / 256), 1);
            SEAM(pb + 4); PR_END(6);
        }
        if (IN(pb + 5)) { PR_BEGIN(7); frame_ids(F); peer_phase(F, layer, rows, ctl, pr_acc); SEAM(pb + 5); PR_END(7); }
    }
    if (PROBE_PHASE >= 0 && hi - lo > 1) xcd_barrier(bar);
    if (PROBE_PHASE >= 0 && blockIdx.x == 0 && threadIdx.x == 0) { const unsigned long long t1 = __builtin_amdgcn_s_memrealtime() + (unsigned long long)PROBE_MULT * pr_acc; while (__builtin_amdgcn_s_memrealtime() < t1) __builtin_amdgcn_s_sleep(8); }
#undef IN
#undef BOTH
#undef SEAM
}

extern "C" void kernel_launch(void* const* d_in, const int* in_sizes, int n_in, void* d_out, int out_size, void* d_ws, size_t ws_size, hipStream_t stream) {
    static int grid = 0;
    if (grid == 0) {
        if (n_in != 20 || in_sizes[0] != TL * D || out_size != TL * D || ws_size < WS_END) {
            fprintf(stderr, "kernel_launch: unexpected problem shape (n_in %d, in0 %d, out %d, ws %zu, need %zu)\n", n_in, n_in > 0 ? in_sizes[0] : -1, out_size, ws_size, (size_t)WS_END); grid = -1; return; }
        int dev = 0, cus = 0, per_cu = 0;
        if (hipGetDevice(&dev) != hipSuccess || hipDeviceGetAttribute(&cus, hipDeviceAttributeMultiprocessorCount, dev) != hipSuccess) { grid = -1; return; }
        if (hipFuncSetAttribute((const void*)skel_fwd, hipFuncAttributeMaxDynamicSharedMemorySize, LDS_BYTES) != hipSuccess) { fprintf(stderr, "kernel_launch: hipFuncSetAttribute failed\n"); grid = -1; return; }
        if (hipOccupancyMaxActiveBlocksPerMultiprocessor(&per_cu, (const void*)skel_fwd, NWAVES * 64, LDS_BYTES) != hipSuccess || per_cu < 1)
            fprintf(stderr, "kernel_launch: occupancy query reports %d workgroups per CU\n", per_cu);
        (void)hipGetLastError();
        grid = cus;
    }
    if (grid < 0) return;
    if (hipMemsetAsync((char*)d_ws + WS_CTL, 0, CTL_ZERO_BYTES, stream) != hipSuccess) return;
    Args a{};
    for (int i = 0; i < 20; ++i) a.in[i] = (const float*)d_in[i];
    a.out = (float*)d_out; a.ws = (unsigned char*)d_ws; a.pad = 0;
#if MK_N_LAUNCHES == 1
    a.ph_lo = 0; a.ph_hi = NPHASE; a.li = 0;
    hipLaunchKernelGGL(skel_fwd, dim3(grid), dim3(NWAVES * 64), LDS_BYTES, stream, a);
#else
    for (int ph = 0; ph < NPHASE; ++ph) { a.ph_lo = ph; a.ph_hi = ph + 1; a.li = 0;
        hipLaunchKernelGGL(skel_fwd, dim3(grid), dim3(NWAVES * 64), LDS_BYTES, stream, a); }
#endif
}
```

```cpp
#include <hip/hip_runtime.h>
#include <cstdio>
#include <cstdint>

#ifndef MK_N_LAUNCHES
#define MK_N_LAUNCHES 1
#endif

#define LAS __attribute__((address_space(3)))
typedef unsigned short bf16_t;
typedef short bf16x8 __attribute__((ext_vector_type(8)));
typedef short s16x4 __attribute__((ext_vector_type(4)));
typedef float f32x2 __attribute__((ext_vector_type(2)));
typedef float f32x4 __attribute__((ext_vector_type(4)));
typedef float f32x16 __attribute__((ext_vector_type(16)));
typedef unsigned u32x2 __attribute__((ext_vector_type(2)));
typedef unsigned u32x4 __attribute__((ext_vector_type(4)));
typedef __bf16 bf16x2_t __attribute__((ext_vector_type(2)));

constexpr int D = 2048, NB = 2, SEQ = 8192, CTXL = 256, NLAYER = 4;
constexpr int TL = NB * SEQ, TC = NB * CTXL, TT = TL + TC;
constexpr int INC = 4608, OFF_C = 1024, OFF_X = 2048, OFF_Q = 3072, OFF_K = 4096, OFF_V = 4352;
constexpr int NEXP = 16384;
#ifndef U_FMT
#define U_FMT 4
#endif
#ifndef V_FMT
#define V_FMT 4
#endif
constexpr int UROW = D * U_FMT / 8, VROW = D * V_FMT / 8;
constexpr float LN_EPS = 1e-6f;
constexpr float DN_ALPHA = 1.681792830507429f;
constexpr float QSCALE = 0.08838834764831845f * 1.4426950408889634f;
constexpr float LOG2E = 1.4426950408889634f;

constexpr size_t MiB = 1u << 20;
constexpr size_t WS_CTL = 0, CTL_ZERO_BYTES = 1 * MiB;
constexpr size_t WS_MODS = 1 * MiB;
constexpr size_t WS_ROPE = 2 * MiB;
constexpr size_t WS_KBD = 3 * MiB;
constexpr size_t WS_WQR = 8 * MiB;
constexpr size_t WS_WINT = 40 * MiB;
constexpr size_t WS_WOUTT = 112 * MiB;
constexpr size_t WS_WEFFT = 144 * MiB;
constexpr size_t WS_X = 176 * MiB;
constexpr size_t WS_H = 308 * MiB;
constexpr size_t WS_PROJ = 374 * MiB;
constexpr size_t WS_MIX = 523 * MiB;
constexpr size_t WS_SC = 589 * MiB;
constexpr size_t WS_UT = 721 * MiB;
constexpr size_t WS_VT = 849 * MiB;
constexpr size_t WS_US = 977 * MiB;
constexpr size_t WS_VS = 978 * MiB;
constexpr size_t WS_END = 979 * MiB;

constexpr int CW_BAR = 4096;

namespace pg8 {
constexpr int BM = 256, BK = 64, HALF = 128, HTB = HALF * BK * 2, STAGE_BYTES = 8 * HTB, NXCD = 8, WGM = 8;
__host__ __device__ __forceinline__ int lds_byte(int r, int c) { const int st = (r >> 4) * 2 + (c >> 5), rr = r & 15, cc = c & 31, ob = rr * 64 + cc * 2; return st * 1024 + (ob ^ (((ob >> 9) & 1) << 5)); }
__host__ __device__ __forceinline__ void stage_rc(int b, int& R, int& C) { const int st = b / 1024, sb = b % 1024, swz = sb ^ (((sb >> 9) & 1) << 5); R = (st >> 1) * 16 + swz / 64; C = (st & 1) * 32 + (swz % 64) / 2; }
__host__ __device__ __forceinline__ int perm32(int rho) { const int n = rho >> 4, i = rho & 15; return 8 * (i >> 2) + 4 * n + (i & 3); }

struct Unit { int pm, pn; };
struct Gemm { const bf16_t* A; const bf16_t* Bt; int M, N, K; };

struct StaticOrder {
    int nM, nN, nwg, G, c;
    __host__ __device__ void init(int M, int N, int G_, int c_) { nM = M / BM; nN = N / BM; nwg = nM * nN; G = G_; c = c_; }
    __host__ __device__ bool next(int i, Unit& u) const {
        const long L = (long)i * G + c; if (L >= nwg) return false;
        int wgid = (int)L; { const int q = nwg / NXCD, r = nwg % NXCD, xcd = wgid % NXCD, off = wgid / NXCD; wgid = (xcd < r ? xcd * (q + 1) : r * (q + 1) + (xcd - r) * q) + off; }
        const int nig = WGM * nN, gid = wgid / nig, fm = gid * WGM, gsz = (nM - fm) < WGM ? (nM - fm) : WGM;
        u.pm = fm + ((wgid % nig) % gsz); u.pn = (wgid % nig) / gsz; return true;
    }
    __device__ __forceinline__ int btile(const Unit& u) const { return u.pn; }
    __device__ __forceinline__ void a_ready(const Unit&) const {}
    __device__ __forceinline__ void done(const Unit&) const {}
};
struct BatchOrder {
    int G, c;
    __device__ bool next(int i, Unit& u) const { const int L = i * G + c; if (L >= 256) return false; u.pm = L >> 3; u.pn = L & 7; return true; }
    __device__ __forceinline__ int btile(const Unit& u) const { return u.pm * 8 + u.pn; }
    __device__ __forceinline__ void a_ready(const Unit&) const {}
    __device__ __forceinline__ void done(const Unit&) const {}
};

__device__ __forceinline__ unsigned cvt_pk_bf16(float lo, float hi) { f32x2 x = {lo, hi}; bf16x2_t y = __builtin_convertvector(x, bf16x2_t); return __builtin_bit_cast(unsigned, y); }

struct EpiBf16 {
    static constexpr bool PERM = true;
    bf16_t* O; int ldc;
    __device__ __forceinline__ void operator()(const f32x4 (&acc)[2][2][4][2], const Unit& u, int wr, int wc, int fr, int fq) const {
        const int row0 = u.pm * BM + wr * 64 + fr, col0 = u.pn * BM + wc * 32 + 8 * fq;
#pragma unroll
        for (int ai = 0; ai < 2; ++ai)
#pragma unroll
            for (int m = 0; m < 4; ++m) { bf16_t* rowp = O + (size_t)(row0 + ai * HALF + m * 16) * ldc + col0;
#pragma unroll
                for (int bj = 0; bj < 2; ++bj) { const f32x4 v0 = acc[ai][bj][m][0], v1 = acc[ai][bj][m][1];
                    u32x4 w; w.x = cvt_pk_bf16(v0[0], v0[1]); w.y = cvt_pk_bf16(v0[2], v0[3]); w.z = cvt_pk_bf16(v1[0], v1[1]); w.w = cvt_pk_bf16(v1[2], v1[3]);
                    *(u32x4*)(rowp + bj * HALF) = w; } }
    }
};
struct EpiF32 {
    static constexpr bool PERM = false;
    float* C; int ldc;
    __device__ __forceinline__ void operator()(const f32x4 (&acc)[2][2][4][2], const Unit& u, int wr, int wc, int fr, int fq) const {
        const int row0 = u.pm * BM + wr * 64 + fr, col0 = u.pn * BM + wc * 32 + 4 * fq;
#pragma unroll
        for (int ai = 0; ai < 2; ++ai)
#pragma unroll
            for (int m = 0; m < 4; ++m) { float* rowp = C + (size_t)(row0 + ai * HALF + m * 16) * ldc + col0;
#pragma unroll
                for (int bj = 0; bj < 2; ++bj)
#pragma unroll
                    for (int n = 0; n < 2; ++n) *(f32x4*)(rowp + bj * HALF + n * 16) = acc[ai][bj][m][n]; }
    }
};
struct EpiResid {
    static constexpr bool PERM = true;
    const float* x32_lat; const float* x32_ctx;
    bf16_t* X; const float* gate;
    __device__ __forceinline__ void operator()(const f32x4 (&acc)[2][2][4][2], const Unit& u, int wr, int wc, int fr, int fq) const {
        const int rt = u.pm * BM;
        const int mr = rt < TL ? rt / SEQ : 2;
        const int row0 = rt + wr * 64 + fr, col0 = u.pn * BM + wc * 32 + 8 * fq;
        f32x4 gv[2][2];
#pragma unroll
        for (int bj = 0; bj < 2; ++bj)
#pragma unroll
            for (int n = 0; n < 2; ++n) gv[bj][n] = *(const f32x4*)(gate + (size_t)mr * 12288 + col0 + bj * HALF + 4 * n);
#pragma unroll
        for (int ai = 0; ai < 2; ++ai)
#pragma unroll
            for (int m = 0; m < 4; ++m) { const int row = row0 + ai * HALF + m * 16;
#pragma unroll
                for (int bj = 0; bj < 2; ++bj) {
                    f32x4 x0, x1;
                    if (x32_lat) { const float* xp = (row < TL ? x32_lat + (size_t)row * D : x32_ctx + (size_t)(row - TL) * D) + col0 + bj * HALF; x0 = *(const f32x4*)xp; x1 = *(const f32x4*)(xp + 4); }
                    else { const u32x4 w = *(const u32x4*)(X + (size_t)row * D + col0 + bj * HALF);
                        x0 = (f32x4){__uint_as_float(w.x << 16), __uint_as_float(w.x & 0xffff0000u), __uint_as_float(w.y << 16), __uint_as_float(w.y & 0xffff0000u)};
                        x1 = (f32x4){__uint_as_float(w.z << 16), __uint_as_float(w.z & 0xffff0000u), __uint_as_float(w.w << 16), __uint_as_float(w.w & 0xffff0000u)}; }
                    const f32x4 r0 = x0 * DN_ALPHA + gv[bj][0] * acc[ai][bj][m][0], r1 = x1 * DN_ALPHA + gv[bj][1] * acc[ai][bj][m][1];
                    u32x4 o; o.x = cvt_pk_bf16(r0[0], r0[1]); o.y = cvt_pk_bf16(r0[2], r0[3]); o.z = cvt_pk_bf16(r1[0], r1[1]); o.w = cvt_pk_bf16(r1[2], r1[3]);
                    *(u32x4*)(X + (size_t)row * D + col0 + bj * HALF) = o; } }
    }
};

template <class Epi, class Sched, bool ALIGN_EPI = false, bool SP2 = false>
__device__ __forceinline__ void gemm_phase(LAS unsigned char* lds, const Gemm g, const Sched& S, const Epi& E) {
    int tid = threadIdx.x; asm volatile("" : "+v"(tid));
    const int wid = __builtin_amdgcn_readfirstlane(tid >> 6), lane = tid & 63, wr = wid >> 2, wc = wid & 3, fr = lane & 15, fq = lane >> 4;
    const int K = g.K, nt = K / BK;
    unsigned voffA[2], voffB[2];
#pragma unroll
    for (int i = 0; i < 2; ++i) { int R, C; stage_rc(tid * 16 + i * 8192, R, C); const int Rb = Epi::PERM ? ((R & ~31) + perm32(R & 31)) : R;
        voffA[i] = (unsigned)(R * K + C) * 2u; voffB[i] = (unsigned)(Rb * K + C) * 2u; }
    const size_t kstep = (size_t)(BK * 2);
    const size_t hstep = (size_t)HALF * K * 2;
    const size_t tstep = 2 * hstep;
    const unsigned ldsw = (unsigned)wid * 1024u;
    const int aoff = lds_byte(wr * 64 + fr, fq * 8), boff = lds_byte(wc * 32 + fr, fq * 8);
#define PG8_SA(b, h) (((b) * 2 + (h)) * HTB)
#define PG8_SB(b, h) ((4 + (b) * 2 + (h)) * HTB)
#define PG8_STAGE(bufoff, gbase, voff) do { _Pragma("unroll") for (int _i = 0; _i < 2; ++_i) \
        __builtin_amdgcn_global_load_lds((const unsigned*)((const char*)(gbase) + (voff)[_i]), (LAS unsigned*)(lds + (bufoff) + ldsw + _i * 8192), 16, 0, 0); } while (0)
#define PG8_LDA(dst, b, h) do { _Pragma("unroll") for (int m = 0; m < 4; ++m) _Pragma("unroll") for (int k = 0; k < 2; ++k) dst[m][k] = *(const LAS bf16x8*)(lds + PG8_SA(b, h) + aoff + m * 2048 + k * 1024); } while (0)
#define PG8_LDB(dst, b, h) do { _Pragma("unroll") for (int n = 0; n < 2; ++n) _Pragma("unroll") for (int k = 0; k < 2; ++k) dst[n][k] = *(const LAS bf16x8*)(lds + PG8_SB(b, h) + boff + n * 2048 + k * 1024); } while (0)
#define PG8_MMA(ai, bj, At, Bt) do { __builtin_amdgcn_s_setprio(1); _Pragma("unroll") for (int m = 0; m < 4; ++m) _Pragma("unroll") for (int n = 0; n < 2; ++n) _Pragma("unroll") for (int k = 0; k < 2; ++k) \
        acc[ai][bj][m][n] = __builtin_amdgcn_mfma_f32_16x16x32_bf16(Bt[n][k], At[m][k], acc[ai][bj][m][n], 0, 0, 0); __builtin_amdgcn_s_setprio(0); } while (0)
#define PG8_WAIT_V(n) asm volatile("s_waitcnt vmcnt(" #n ")" ::: "memory")
#define PG8_WAIT_L(n) asm volatile("s_waitcnt lgkmcnt(" #n ")" ::: "memory")
#define PG8_BAR __builtin_amdgcn_s_barrier()
#define PG8_SCHED __builtin_amdgcn_sched_barrier(0)
    Unit cur, nxt; int ui = 0;
    if (!S.next(0, cur)) return;
    f32x4 acc[2][2][4][2];
#pragma unroll
    for (int a = 0; a < 2; ++a)
#pragma unroll
        for (int b = 0; b < 2; ++b)
#pragma unroll
            for (int m = 0; m < 4; ++m)
#pragma unroll
                for (int n = 0; n < 2; ++n) acc[a][b][m][n] = (f32x4){0.f, 0.f, 0.f, 0.f};
    bf16x8 At[4][2], B0[2][2], B1[2][2];
    const char* cA = (const char*)g.A + (size_t)cur.pm * tstep; const char* cB = (const char*)g.Bt + (size_t)S.btile(cur) * tstep;
    S.a_ready(cur);
    if constexpr (SP2) {
        PG8_STAGE(PG8_SB(0, 0), cB, voffB); PG8_STAGE(PG8_SB(0, 1), cB + hstep, voffB); PG8_STAGE(PG8_SA(0, 0), cA, voffA); PG8_STAGE(PG8_SA(0, 1), cA + hstep, voffA);
        if (wr == 1) PG8_BAR;
        PG8_WAIT_V(2); PG8_BAR;
        PG8_STAGE(PG8_SB(1, 0), cB + kstep, voffB); PG8_STAGE(PG8_SA(1, 0), cA + kstep, voffA); PG8_STAGE(PG8_SB(1, 1), cB + hstep + kstep, voffB);
        PG8_WAIT_V(6); PG8_BAR;
    } else {
        PG8_STAGE(PG8_SB(0, 0), cB, voffB); PG8_STAGE(PG8_SA(0, 0), cA, voffA); PG8_STAGE(PG8_SB(0, 1), cB + hstep, voffB); PG8_STAGE(PG8_SA(0, 1), cA + hstep, voffA);
        if (wr == 1) PG8_BAR;
        PG8_WAIT_V(4); PG8_BAR;
        PG8_STAGE(PG8_SB(1, 0), cB + kstep, voffB); PG8_STAGE(PG8_SA(1, 0), cA + kstep, voffA); PG8_STAGE(PG8_SB(1, 1), cB + hstep + kstep, voffB);
        PG8_WAIT_V(6); PG8_BAR;
    }
    for (;;) {
        const bool has_next = S.next(ui + 1, nxt);
        const char* nA = has_next ? (const char*)g.A + (size_t)nxt.pm * tstep : cA; const char* nB = has_next ? (const char*)g.Bt + (size_t)S.btile(nxt) * tstep : cB;
        for (int t = 0; t < nt; t += 2) {
            const bool last = (t == nt - 2);
            const char* a1 = cA + (size_t)(t + 1) * kstep;
            const char* a2 = last ? nA : cA + (size_t)(t + 2) * kstep; const char* b2 = last ? nB : cB + (size_t)(t + 2) * kstep;
            const char* a3 = a2 + kstep; const char* b3 = b2 + kstep;
            if (last && has_next) S.a_ready(nxt);
            if constexpr (SP2) {
            PG8_LDB(B0, 0, 0); PG8_LDB(B1, 0, 1); PG8_SCHED; PG8_LDA(At, 0, 0); PG8_STAGE(PG8_SA(1, 1), a1 + hstep, voffA);
            PG8_WAIT_V(8); PG8_WAIT_L(0); PG8_BAR; PG8_MMA(0, 0, At, B0); PG8_MMA(0, 1, At, B1); PG8_BAR; PG8_SCHED;
            PG8_LDA(At, 0, 1); PG8_STAGE(PG8_SB(0, 0), b2, voffB); PG8_STAGE(PG8_SB(0, 1), b2 + hstep, voffB); PG8_STAGE(PG8_SA(0, 0), a2, voffA);
            PG8_WAIT_V(8); PG8_WAIT_L(0); PG8_BAR; PG8_MMA(1, 0, At, B0); PG8_MMA(1, 1, At, B1); PG8_BAR; PG8_SCHED;
            PG8_LDB(B0, 1, 0); PG8_LDB(B1, 1, 1); PG8_SCHED; PG8_LDA(At, 1, 0); PG8_STAGE(PG8_SA(0, 1), a2 + hstep, voffA);
            PG8_WAIT_V(8); PG8_WAIT_L(0); PG8_BAR; PG8_MMA(0, 0, At, B0); PG8_MMA(0, 1, At, B1); PG8_BAR; PG8_SCHED;
            PG8_LDA(At, 1, 1); PG8_STAGE(PG8_SB(1, 0), b3, voffB); PG8_STAGE(PG8_SB(1, 1), b3 + hstep, voffB); PG8_STAGE(PG8_SA(1, 0), a3, voffA);
            PG8_WAIT_V(8); PG8_WAIT_L(0); PG8_BAR; PG8_MMA(1, 0, At, B0); PG8_MMA(1, 1, At, B1); PG8_BAR; PG8_SCHED;
            } else {
            PG8_LDB(B0, 0, 0); PG8_SCHED; PG8_LDA(At, 0, 0); PG8_STAGE(PG8_SA(1, 1), a1 + hstep, voffA);
            PG8_WAIT_L(8); PG8_BAR; PG8_WAIT_L(0); PG8_MMA(0, 0, At, B0); PG8_BAR; PG8_SCHED;
            PG8_LDB(B1, 0, 1); PG8_STAGE(PG8_SB(0, 0), b2, voffB);
            PG8_BAR; PG8_WAIT_L(0); PG8_MMA(0, 1, At, B1); PG8_BAR;
            PG8_LDA(At, 0, 1); PG8_STAGE(PG8_SA(0, 0), a2, voffA);
            PG8_BAR; PG8_WAIT_L(0); PG8_MMA(1, 0, At, B0); PG8_BAR; PG8_SCHED;
            PG8_STAGE(PG8_SB(0, 1), b2 + hstep, voffB);
            PG8_WAIT_V(6); PG8_BAR; PG8_MMA(1, 1, At, B1); PG8_BAR;
            PG8_LDB(B0, 1, 0); PG8_SCHED; PG8_LDA(At, 1, 0); PG8_STAGE(PG8_SA(0, 1), a2 + hstep, voffA);
            PG8_WAIT_L(8); PG8_BAR; PG8_WAIT_L(0); PG8_MMA(0, 0, At, B0); PG8_BAR; PG8_SCHED;
            PG8_LDB(B1, 1, 1); PG8_STAGE(PG8_SB(1, 0), b3, voffB);
            PG8_BAR; PG8_WAIT_L(0); PG8_MMA(0, 1, At, B1); PG8_BAR;
            PG8_LDA(At, 1, 1); PG8_STAGE(PG8_SA(1, 0), a3, voffA);
            PG8_BAR; PG8_WAIT_L(0); PG8_MMA(1, 0, At, B0); PG8_BAR; PG8_SCHED;
            PG8_STAGE(PG8_SB(1, 1), b3 + hstep, voffB);
            PG8_WAIT_V(6); PG8_BAR; PG8_MMA(1, 1, At, B1); PG8_BAR;
            }
        }
        if constexpr (ALIGN_EPI) { if (wr == 0) PG8_BAR; }
        E(acc, cur, wr, wc, fr, fq); S.done(cur);
        if (!has_next) break;
#pragma unroll
        for (int a = 0; a < 2; ++a)
#pragma unroll
            for (int b = 0; b < 2; ++b)
#pragma unroll
                for (int m = 0; m < 4; ++m)
#pragma unroll
                    for (int n = 0; n < 2; ++n) acc[a][b][m][n] = (f32x4){0.f, 0.f, 0.f, 0.f};
        cur = nxt; cA = nA; cB = nB; ++ui;
        if constexpr (ALIGN_EPI) { if (wr == 1) PG8_BAR; }
    }
    PG8_WAIT_V(0);
    if constexpr (!ALIGN_EPI) { if (wr == 0) PG8_BAR; }
    PG8_BAR;
#undef PG8_SA
#undef PG8_SB
#undef PG8_STAGE
#undef PG8_LDA
#undef PG8_LDB
#undef PG8_MMA
#undef PG8_WAIT_V
#undef PG8_WAIT_L
#undef PG8_BAR
#undef PG8_SCHED
}
}

#define XB_TMO      128
#define XB_XCNT(j)  (256  + 64 * (j))
#define XB_XSUB(j)  (1280 + 64 * (j))
#define XB_XGEN(j)  (2304 + 64 * (j))
#define XB_TOP      3328
#define XB_TOPGEN   3392
#define XCD_BAR_WORDS 3456
#define XB_SPIN_CAP (1u << 18)

__device__ __forceinline__ unsigned xb_ld(unsigned* p)              { return __hip_atomic_load(p, __ATOMIC_RELAXED, __HIP_MEMORY_SCOPE_AGENT); }
__device__ __forceinline__ unsigned xb_add(unsigned* p, unsigned v) { return __hip_atomic_fetch_add(p, v, __ATOMIC_RELAXED, __HIP_MEMORY_SCOPE_AGENT); }
__device__ __forceinline__ unsigned xb_xcc_id() { return (unsigned)__builtin_amdgcn_s_getreg((3 << 11) | 20) & 0xFu; }
#define XB_SPIN(cond, bar) do { unsigned _sp = 0; while (cond) { __builtin_amdgcn_s_sleep(1); \
    if ((++_sp & 255u) == 0u) { if (xb_ld(&(bar)[XB_TMO])) break; if (_sp > XB_SPIN_CAP) { atomicAdd(&(bar)[XB_TMO], 1u); break; } } } } while (0)

struct XcdBarrier { unsigned* bar; unsigned x; volatile LAS unsigned* st; };

__device__ __forceinline__ XcdBarrier xcd_barrier_post(unsigned* bar, volatile LAS unsigned* st) {
    XcdBarrier b; b.bar = bar; b.x = xb_xcc_id(); b.st = st;
    if (threadIdx.x == 0) (void)xb_add(&bar[XB_XCNT(b.x)], 1u);
    return b;
}
__device__ __forceinline__ void xcd_barrier_complete(unsigned* bar, unsigned x, unsigned& nloc, unsigned& nx) {
    const unsigned G = gridDim.x * gridDim.y * gridDim.z;
    unsigned sum, cnt, mine, sp = 0u;
    for (;;) {
        sum = 0u; cnt = 0u; mine = 0u;
#pragma unroll
        for (unsigned j = 0; j < 16; ++j) { const unsigned c = xb_ld(&bar[XB_XCNT(j)]); sum += c; cnt += (c > 0u) ? 1u : 0u; mine = (j == x) ? c : mine; }
        if (sum == G) break;
        __builtin_amdgcn_s_sleep(1);
        if ((++sp & 255u) == 0u) { if (xb_ld(&bar[XB_TMO])) break; if (sp > XB_SPIN_CAP) { atomicAdd(&bar[XB_TMO], 1u); break; } }
    }
    nloc = mine > 0u ? mine : 1u; nx = cnt > 0u ? cnt : 1u;
}
__device__ __forceinline__ void xcd_barrier(const XcdBarrier& b) {
    asm volatile("s_waitcnt vmcnt(0)" ::: "memory");
    __syncthreads();
    if (threadIdx.x == 0) {
        unsigned* bar = b.bar;
        __builtin_amdgcn_s_waitcnt(0);
        unsigned nloc = b.st[0], nx = b.st[1];
        if (nloc == 0u) { xcd_barrier_complete(bar, b.x, nloc, nx); b.st[0] = nloc; b.st[1] = nx; }
        const unsigned old = xb_add(&bar[XB_XSUB(b.x)], 1u);
        const unsigned gen = old / nloc;
        if (old + 1u == (gen + 1u) * nloc) {
            __builtin_amdgcn_fence(__ATOMIC_RELEASE, "agent");
            asm volatile("s_waitcnt vmcnt(0)" ::: "memory");
            const unsigned og = xb_add(&bar[XB_TOP], 1u);
            const unsigned tg = og / nx;
            if (og + 1u == (tg + 1u) * nx) xb_add(&bar[XB_TOPGEN], 1u);
            else XB_SPIN(xb_ld(&bar[XB_TOPGEN]) == tg, bar);
            __builtin_amdgcn_fence(__ATOMIC_ACQUIRE, "agent");
            xb_add(&bar[XB_XGEN(b.x)], 1u);
            asm volatile("s_waitcnt vmcnt(0)" ::: "memory");
        } else {
            XB_SPIN(xb_ld(&bar[XB_XGEN(b.x)]) == gen, bar);
            __builtin_amdgcn_fence(__ATOMIC_ACQUIRE, "agent");
            asm volatile("s_waitcnt vmcnt(0)" ::: "memory");
        }
    }
    __syncthreads();
}

constexpr int NWAVES = 8;
constexpr int LDS_BYTES = 163840;
constexpr int LDSCTL_OFF = LDS_BYTES - 512, MISC_OFF = LDSCTL_OFF + 320;
constexpr int NPHASE = 2 + 6 * NLAYER;

#define LDS_WAIT() asm volatile("s_waitcnt lgkmcnt(0)" ::: "memory")

struct Args { const float* in[20]; float* out; unsigned char* ws; int ph_lo, ph_hi, li, pad; };

#define CAS __attribute__((address_space(4)))
struct Frame {
    LAS unsigned char* lds;
    int tid, lane, wave, G, gw, NGW;
    const CAS unsigned char* ka;
    __device__ __forceinline__ const float* x() const { return *(const float* const CAS*)(ka + 0); }
    __device__ __forceinline__ const float* c() const { return *(const float* const CAS*)(ka + 8); }
    __device__ __forceinline__ const float* ctx() const { return *(const float* const CAS*)(ka + 16); }
    __device__ __forceinline__ const float* c_ctx() const { return *(const float* const CAS*)(ka + 24); }
    __device__ __forceinline__ const float* w_ada() const { return *(const float* const CAS*)(ka + 32); }
    __device__ __forceinline__ const float* b_ada() const { return *(const float* const CAS*)(ka + 40); }
    __device__ __forceinline__ const float* w_in() const { return *(const float* const CAS*)(ka + 48); }
    __device__ __forceinline__ const float* conv_w() const { return *(const float* const CAS*)(ka + 56); }
    __device__ __forceinline__ const float* sink() const { return *(const float* const CAS*)(ka + 64); }
    __device__ __forceinline__ const float* g_attn() const { return *(const float* const CAS*)(ka + 72); }
    __device__ __forceinline__ const float* g_conv() const { return *(const float* const CAS*)(ka + 80); }
    __device__ __forceinline__ const float* w_out() const { return *(const float* const CAS*)(ka + 88); }
    __device__ __forceinline__ const float* ln1_g() const { return *(const float* const CAS*)(ka + 96); }
    __device__ __forceinline__ const float* ln1_b() const { return *(const float* const CAS*)(ka + 104); }
    __device__ __forceinline__ const float* wq() const { return *(const float* const CAS*)(ka + 112); }
    __device__ __forceinline__ const float* keys() const { return *(const float* const CAS*)(ka + 120); }
    __device__ __forceinline__ const float* pu() const { return *(const float* const CAS*)(ka + 128); }
    __device__ __forceinline__ const float* pv() const { return *(const float* const CAS*)(ka + 136); }
    __device__ __forceinline__ const float* ln2_g() const { return *(const float* const CAS*)(ka + 144); }
    __device__ __forceinline__ const float* ln2_b() const { return *(const float* const CAS*)(ka + 152); }
    __device__ __forceinline__ float* out() const { return *(float* const CAS*)(ka + 160); }
    __device__ __forceinline__ unsigned char* ws() const { return *(unsigned char* const CAS*)(ka + 168); }
    __device__ __forceinline__ float* MODS() const { return (float*)(ws() + WS_MODS); }
    __device__ __forceinline__ float* ROPE() const { return (float*)(ws() + WS_ROPE); }
    __device__ __forceinline__ bf16_t* X() const { return (bf16_t*)(ws() + WS_X); }
    __device__ __forceinline__ bf16_t* SC() const { return (bf16_t*)(ws() + WS_SC); }
    __device__ __forceinline__ bf16_t* KBD() const { return (bf16_t*)(ws() + WS_KBD); }
    __device__ __forceinline__ bf16_t* WQR() const { return (bf16_t*)(ws() + WS_WQR); }
    __device__ __forceinline__ bf16_t* WINT() const { return (bf16_t*)(ws() + WS_WINT); }
    __device__ __forceinline__ bf16_t* WOUTT() const { return (bf16_t*)(ws() + WS_WOUTT); }
    __device__ __forceinline__ bf16_t* WEFFT() const { return (bf16_t*)(ws() + WS_WEFFT); }
    __device__ __forceinline__ bf16_t* H() const { return (bf16_t*)(ws() + WS_H); }
    __device__ __forceinline__ bf16_t* PROJ() const { return (bf16_t*)(ws() + WS_PROJ); }
    __device__ __forceinline__ bf16_t* MIX() const { return (bf16_t*)(ws() + WS_MIX); }
    __device__ __forceinline__ unsigned char* UT() const { return (unsigned char*)(ws() + WS_UT); }
    __device__ __forceinline__ unsigned char* VT() const { return (unsigned char*)(ws() + WS_VT); }
    __device__ __forceinline__ float* US() const { return (float*)(ws() + WS_US); }
    __device__ __forceinline__ float* VS() const { return (float*)(ws() + WS_VS); }
};

__device__ __forceinline__ void frame_ids(Frame& F) {
    int tz = threadIdx.x; asm volatile("" : "+v"(tz));
    F.tid = tz; F.lane = tz & 63; F.wave = __builtin_amdgcn_readfirstlane(tz >> 6);
    F.gw = blockIdx.x * NWAVES + F.wave;
    const CAS unsigned char* k = (const CAS unsigned char*)__builtin_amdgcn_kernarg_segment_ptr(); asm volatile("" : "+s"(k)); F.ka = k;
}
template <int CTRL> __device__ __forceinline__ int dpp_i(int v) { return __builtin_amdgcn_update_dpp(0, v, CTRL, 0xf, 0xf, true); }
template <int CTRL> __device__ __forceinline__ float dpp_f(float v) { return __int_as_float(dpp_i<CTRL>(__float_as_int(v))); }
constexpr int DPP_XOR1 = 0xB1, DPP_XOR2 = 0x4E, DPP_HMIRROR = 0x141, DPP_ROR4 = 0x124, DPP_ROR8 = 0x128;
__device__ __forceinline__ float wave_sum_u(float v) {
    v += dpp_f<DPP_XOR1>(v); v += dpp_f<DPP_XOR2>(v); v += dpp_f<DPP_ROR4>(v); v += dpp_f<DPP_ROR8>(v);
    const float r0 = __int_as_float(__builtin_amdgcn_readlane(__float_as_int(v), 0)), r1 = __int_as_float(__builtin_amdgcn_readlane(__float_as_int(v), 16));
    const float r2 = __int_as_float(__builtin_amdgcn_readlane(__float_as_int(v), 32)), r3 = __int_as_float(__builtin_amdgcn_readlane(__float_as_int(v), 48));
    return (r0 + r1) + (r2 + r3);
}
__device__ __forceinline__ float wave_max_u(float v) {
    v = fmaxf(v, dpp_f<DPP_XOR1>(v)); v = fmaxf(v, dpp_f<DPP_XOR2>(v)); v = fmaxf(v, dpp_f<DPP_ROR4>(v)); v = fmaxf(v, dpp_f<DPP_ROR8>(v));
    const float r0 = __int_as_float(__builtin_amdgcn_readlane(__float_as_int(v), 0)), r1 = __int_as_float(__builtin_amdgcn_readlane(__float_as_int(v), 16));
    const float r2 = __int_as_float(__builtin_amdgcn_readlane(__float_as_int(v), 32)), r3 = __int_as_float(__builtin_amdgcn_readlane(__float_as_int(v), 48));
    return fmaxf(fmaxf(r0, r1), fmaxf(r2, r3));
}
__device__ __forceinline__ float xor32_f(float v, int lane) { return __int_as_float(__builtin_amdgcn_ds_bpermute((lane ^ 32) << 2, __float_as_int(v))); }
__device__ __forceinline__ float wave_sum(float v) { return wave_sum_u(v); }
__device__ __forceinline__ unsigned pk2(float lo, float hi) { return pg8::cvt_pk_bf16(lo, hi); }
__device__ __forceinline__ float bf_lo(unsigned u) { return __uint_as_float(u << 16); }
__device__ __forceinline__ float bf_hi(unsigned u) { return __uint_as_float(u & 0xffff0000u); }
__device__ __forceinline__ int modrow(int t) { return t < TL ? t / SEQ : 2; }

__device__ __forceinline__ void transpose_item(const float* W, int K, int N, bf16_t* WT, LAS float* scr, int item, int lane) {
    const int nblk = N / 32, kb = item / nblk, nb = item % nblk, k0 = 64 * kb, n0 = 32 * nb;
#pragma unroll 8
    for (int i = 0; i < 32; ++i) { const int kk = 2 * i + (lane >> 5); scr[kk * 33 + (lane & 31)] = W[(size_t)(k0 + kk) * N + n0 + (lane & 31)]; }
    LDS_WAIT(); asm volatile("" ::: "memory");
    const int c = lane & 7;
#pragma unroll
    for (int j = 0; j < 4; ++j) { const int n = (lane >> 3) + 8 * j; const LAS float* s = scr + (8 * c) * 33 + n;
        u32x4 o; o.x = pk2(s[0 * 33], s[1 * 33]); o.y = pk2(s[2 * 33], s[3 * 33]); o.z = pk2(s[4 * 33], s[5 * 33]); o.w = pk2(s[6 * 33], s[7 * 33]);
        *(u32x4*)(WT + (size_t)(n0 + n) * K + k0 + 8 * c) = o; }
    LDS_WAIT(); asm volatile("" ::: "memory");
}

__device__ __forceinline__ void cvt_row_bf16(const float* src, bf16_t* dst, int lane) {
    const f32x4* s = (const f32x4*)src + lane; u32x2* d = (u32x2*)dst + lane;
    f32x4 v[8];
#pragma unroll
    for (int j = 0; j < 8; ++j) v[j] = __builtin_nontemporal_load(s + 64 * j);
#pragma unroll
    for (int j = 0; j < 8; ++j) { u32x2 o; o.x = pk2(v[j].x, v[j].y); o.y = pk2(v[j].z, v[j].w); d[64 * j] = o; }
}

struct RowF32 { f32x4 v[4][2]; };
__device__ __forceinline__ void row_load_nt(RowF32& R, const float* src, int lane) {
    const f32x4* s = (const f32x4*)src + 2 * lane;
#pragma unroll
    for (int j = 0; j < 4; ++j) { R.v[j][0] = __builtin_nontemporal_load(s + 128 * j); R.v[j][1] = __builtin_nontemporal_load(s + 128 * j + 1); }
}
template <int FMT>
__device__ __forceinline__ void cvt_row_lp(const RowF32& R, unsigned char* dst, float* inv, int lane) {
    constexpr float QMAX = FMT == 8 ? 224.f : 6.f;
    float am = 0.f;
#pragma unroll
    for (int j = 0; j < 4; ++j)
#pragma unroll
        for (int q = 0; q < 2; ++q) am = fmaxf(fmaxf(am, fmaxf(fabsf(R.v[j][q].x), fabsf(R.v[j][q].y))), fmaxf(fabsf(R.v[j][q].z), fabsf(R.v[j][q].w)));
    am = wave_max_u(am);
    const float sc = am > 0.f ? QMAX / am : 1.f;
#pragma unroll
    for (int j = 0; j < 4; ++j) {
        if constexpr (FMT == 8) {
            u32x2 w;
#pragma unroll
            for (int q = 0; q < 2; ++q) { int t = __builtin_amdgcn_cvt_pk_fp8_f32(R.v[j][q].x * sc, R.v[j][q].y * sc, 0, false); t = __builtin_amdgcn_cvt_pk_fp8_f32(R.v[j][q].z * sc, R.v[j][q].w * sc, t, true); w[q] = (unsigned)t; }
            *((u32x2*)dst + lane + 64 * j) = w;
        } else {
            unsigned w = 0u;
            w = __builtin_amdgcn_cvt_scalef32_pk_fp4_f32(w, R.v[j][0].x * sc, R.v[j][0].y * sc, 1.0f, 0);
            w = __builtin_amdgcn_cvt_scalef32_pk_fp4_f32(w, R.v[j][0].z * sc, R.v[j][0].w * sc, 1.0f, 1);
            w = __builtin_amdgcn_cvt_scalef32_pk_fp4_f32(w, R.v[j][1].x * sc, R.v[j][1].y * sc, 1.0f, 2);
            w = __builtin_amdgcn_cvt_scalef32_pk_fp4_f32(w, R.v[j][1].z * sc, R.v[j][1].w * sc, 1.0f, 3);
            *((unsigned*)dst + lane + 64 * j) = w;
        }
    }
    if (lane == 0) *inv = am > 0.f ? am * (1.f / QMAX) : 1.f;
}
template <int FMT> struct LpRow;
template <> struct LpRow<8> { u32x4 a, b;
    __device__ __forceinline__ void load(const unsigned char* rowp, int lane) { a = *(const u32x4*)(rowp + 32 * lane); b = *(const u32x4*)(rowp + 32 * lane + 16); }
    template <class Fn> __device__ __forceinline__ void each(Fn&& f) const {
#pragma unroll
        for (int w = 0; w < 4; ++w) { const f32x2 l0 = __builtin_amdgcn_cvt_pk_f32_fp8((int)a[w], false), h0 = __builtin_amdgcn_cvt_pk_f32_fp8((int)a[w], true);
            f(4 * w, l0.x, l0.y); f(4 * w + 2, h0.x, h0.y); }
#pragma unroll
        for (int w = 0; w < 4; ++w) { const f32x2 l0 = __builtin_amdgcn_cvt_pk_f32_fp8((int)b[w], false), h0 = __builtin_amdgcn_cvt_pk_f32_fp8((int)b[w], true);
            f(16 + 4 * w, l0.x, l0.y); f(16 + 4 * w + 2, h0.x, h0.y); }
    } };
template <> struct LpRow<4> { u32x4 a;
    __device__ __forceinline__ void load(const unsigned char* rowp, int lane) { a = *(const u32x4*)(rowp + 16 * lane); }
    template <class Fn> __device__ __forceinline__ void each(Fn&& f) const {
#pragma unroll
        for (int w = 0; w < 4; ++w) {
            const f32x2 d0 = __builtin_amdgcn_cvt_scalef32_pk_f32_fp4(a[w], 1.0f, 0), d1 = __builtin_amdgcn_cvt_scalef32_pk_f32_fp4(a[w], 1.0f, 1);
            const f32x2 d2 = __builtin_amdgcn_cvt_scalef32_pk_f32_fp4(a[w], 1.0f, 2), d3 = __builtin_amdgcn_cvt_scalef32_pk_f32_fp4(a[w], 1.0f, 3);
            f(8 * w, d0.x, d0.y); f(8 * w + 2, d1.x, d1.y); f(8 * w + 4, d2.x, d2.y); f(8 * w + 6, d3.x, d3.y); }
    }
    template <class Fn> __device__ __forceinline__ void each_bf(Fn&& f) const {
#pragma unroll
        for (int w = 0; w < 4; ++w) {
            f(4 * w, __builtin_amdgcn_cvt_scalef32_pk_bf16_fp4(a[w], 1.0f, 0)); f(4 * w + 1, __builtin_amdgcn_cvt_scalef32_pk_bf16_fp4(a[w], 1.0f, 1));
            f(4 * w + 2, __builtin_amdgcn_cvt_scalef32_pk_bf16_fp4(a[w], 1.0f, 2)); f(4 * w + 3, __builtin_amdgcn_cvt_scalef32_pk_bf16_fp4(a[w], 1.0f, 3)); }
    } };

__device__ __forceinline__ void row_stats(const f32x4 (&v)[8], float& mean, float& rstd) {
    float s = 0.f;
#pragma unroll
    for (int j = 0; j < 8; ++j) s += (v[j].x + v[j].y) + (v[j].z + v[j].w);
    mean = wave_sum(s) * (1.f / D);
    float s2 = 0.f;
#pragma unroll
    for (int j = 0; j < 8; ++j) { const f32x4 d = v[j] - mean; s2 += (d.x * d.x + d.y * d.y) + (d.z * d.z + d.w * d.w); }
    rstd = 1.f / sqrtf(wave_sum(s2) * (1.f / D) + LN_EPS);
}
__device__ __forceinline__ void modulate_store(const f32x4 (&v)[8], const float* shift, const float* scale, bf16_t* dst, int lane) {
    float mean, rstd; row_stats(v, mean, rstd);
    u32x2* d = (u32x2*)dst + lane;
#pragma unroll
    for (int j = 0; j < 8; ++j) { const f32x4 sc = *((const f32x4*)scale + lane + 64 * j), sh = *((const f32x4*)shift + lane + 64 * j);
        const f32x4 y = (v[j] - mean) * rstd * (sc + 1.f) + sh;
        u32x2 o; o.x = pk2(y.x, y.y); o.y = pk2(y.z, y.w); d[64 * j] = o; }
}

__device__ __forceinline__ void convert_tables(Frame& F, int row0, int row1, int w0, int wstride) {
    RowF32 ru, rv, nu, nv;
    int row = row0 + w0;
    if (row < row1) { row_load_nt(ru, F.pu() + (size_t)row * D, F.lane); row_load_nt(rv, F.pv() + (size_t)row * D, F.lane); }
    while (row < row1) {
        const int nrow = row + wstride;
        if (nrow < row1) { row_load_nt(nu, F.pu() + (size_t)nrow * D, F.lane); row_load_nt(nv, F.pv() + (size_t)nrow * D, F.lane); }
        cvt_row_lp<U_FMT>(ru, F.UT() + (size_t)row * UROW, F.US() + row, F.lane);
        cvt_row_lp<V_FMT>(rv, F.VT() + (size_t)row * VROW, F.VS() + row, F.lane);
        ru = nu; rv = nv; row = nrow;
    }
}
__device__ __forceinline__ void convert_in_tail(Frame& F, int layer, int nunits, int part) {
    if (layer + 1 >= NLAYER) return;
    const int G = F.G, rounds = (nunits + G - 1) / G, nlast = nunits - (rounds - 1) * G;
    const int c = (int)blockIdx.x;
    int nshort = G - nlast, sidx = c - nlast;
    if (nshort <= 0) { nshort = G; sidx = c; }
    else if (sidx < 0) return;
    const int r0 = (layer + 1) * NEXP + part * (NEXP / 2);
    convert_tables(F, r0, r0 + NEXP / 2, sidx * NWAVES + F.wave, nshort * NWAVES);
}
__device__ __forceinline__ void p0a_prologue(Frame& F) {
    LAS float* condL = (LAS float*)F.lds;
    LAS float* red = (LAS float*)(F.lds + 24576);
    for (int i = F.tid; i < 3 * D; i += NWAVES * 64) { const int r = i / D, k = i % D; const float v = r < 2 ? F.c()[r * D + k] : F.c_ctx()[k]; condL[i] = v / (1.f + __expf(-v)); }
    __syncthreads();
    for (int item = blockIdx.x; item < 384; item += F.G) {
        const int l = item / 96, n0 = (item % 96) * 128;
        const float* wp = F.w_ada() + ((size_t)l * D + F.wave * 256) * 12288 + n0 + 2 * F.lane;
        f32x2 a0 = {0.f, 0.f}, a1 = {0.f, 0.f}, a2 = {0.f, 0.f};
#pragma unroll 8
        for (int k = 0; k < 256; ++k) { const f32x2 w = __builtin_nontemporal_load((const f32x2*)(wp + (size_t)k * 12288)); const int kk = F.wave * 256 + k;
            a0 += w * condL[kk]; a1 += w * condL[D + kk]; a2 += w * condL[2 * D + kk]; }
        LAS float* rp = red + F.wave * 384 + 2 * F.lane;
        rp[0] = a0.x; rp[1] = a0.y; rp[128] = a1.x; rp[129] = a1.y; rp[256] = a2.x; rp[257] = a2.y;
        __syncthreads();
        if (F.tid < 384) { const int r = F.tid / 128, n = F.tid % 128; float s = 0.f;
#pragma unroll
            for (int w = 0; w < 8; ++w) s += red[w * 384 + r * 128 + n];
            F.MODS()[((size_t)l * 3 + r) * 12288 + n0 + n] = s + F.b_ada()[(size_t)l * 12288 + n0 + n]; }
        __syncthreads();
    }
    LAS float* scr = (LAS float*)(F.lds + 40960 + F.wave * 8448);
    constexpr int I_IN = (D / 64) * (INC / 32), I_OUT = (D / 64) * (D / 32);
    for (int it = F.gw; it < NLAYER * (I_IN + I_OUT); it += F.NGW) {
        const int l = it / (I_IN + I_OUT); int r = it % (I_IN + I_OUT);
        if (r < I_IN) transpose_item(F.w_in() + (size_t)l * D * INC, D, INC, F.WINT() + (size_t)l * INC * D, scr, r, F.lane);
        else transpose_item(F.w_out() + (size_t)l * D * D, D, D, F.WOUTT() + (size_t)l * D * D, scr, r - I_IN, F.lane);
    }
    for (int row = F.gw; row < NLAYER * D; row += F.NGW) {
        const int l = row / D, c = row % D; const f32x4* s = (const f32x4*)(F.wq() + (size_t)row * D) + F.lane;
#pragma unroll
        for (int j = 0; j < 8; ++j) { const f32x4 v = s[64 * j]; u32x2 o; o.x = pk2(v.x, v.y); o.y = pk2(v.z, v.w);
            *((u32x2*)(F.WQR() + ((size_t)(l * 8 + j) * D + c) * 256) + F.lane) = o; }
    }
    for (int row = F.gw; row < 32 * 256; row += F.NGW) {
        const int lh = row >> 8, pk = row & 255, p = pk >> 7;
        u32x2 o = {0u, 0u};
        if ((F.lane >> 5) == p) { const f32x4 v = *((const f32x4*)(F.keys() + ((size_t)lh * 256 + pk) * 128) + (F.lane & 31)); o.x = pk2(v.x, v.y); o.y = pk2(v.z, v.w); }
        *((u32x2*)(F.KBD() + (size_t)row * 256) + F.lane) = o;
    }
    convert_tables(F, 0, NEXP, F.gw, F.NGW);
    for (int i = blockIdx.x * (NWAVES * 64) + F.tid; i < 192 * 32; i += F.G * NWAVES * 64) {
        const int idx = i >> 5, f = i & 31; const float pos = (float)(idx < 128 ? idx : idx - 128);
        const float inv = powf(10000.f, -(float)(2 * f) / 64.f); const float ang = pos * inv;
        F.ROPE()[2 * i] = cosf(ang); F.ROPE()[2 * i + 1] = sinf(ang);
    }
}

__device__ __forceinline__ void p0b_mod0(Frame& F) {
    __syncthreads();
#pragma unroll 1
    for (int v = 0; v < 6; ++v)
        *(LAS f32x4*)(F.lds + v * 8192 + F.tid * 16) = *(const f32x4*)(F.MODS() + (size_t)(v % 3) * 12288 + (v < 3 ? 0 : D) + 4 * F.tid);
    __syncthreads();
    for (int t = F.gw; t < TT; t += F.NGW) {
        const float* src = t < TL ? F.x() + (size_t)t * D : F.ctx() + (size_t)(t - TL) * D;
        f32x4 v[8];
#pragma unroll
        for (int j = 0; j < 8; ++j) v[j] = *((const f32x4*)src + F.lane + 64 * j);
        const int mr = modrow(t);
        float mean, rstd; row_stats(v, mean, rstd);
        u32x2* d = (u32x2*)(F.H() + (size_t)t * D) + F.lane;
#pragma unroll
        for (int j = 0; j < 8; ++j) { const f32x4 sh = *(const LAS f32x4*)(F.lds + mr * 8192 + (64 * j + F.lane) * 16), sc = *(const LAS f32x4*)(F.lds + (3 + mr) * 8192 + (64 * j + F.lane) * 16);
            const f32x4 y = (v[j] - mean) * rstd * (sc + 1.f) + sh;
            u32x2 o; o.x = pk2(y.x, y.y); o.y = pk2(y.z, y.w); d[64 * j] = o; }
    }
}

constexpr int CONV_LDS = 81920;
constexpr int KP = 272, VP = 320, KS_BYTES = 64 * KP, VS_BYTES = 64 * VP;
struct KVRegs { u32x4 k1, k2, v1, v2; f32x4 cs[4]; };

__device__ __forceinline__ void attn_load_tile(Frame& F, KVRegs& R, int ti, int b, int n, int g) {
    const int key = F.tid >> 3, c8 = F.tid & 7;
    int row, pos = 0;
    if (ti < 6) { pos = (n - 1) * 128 + 64 * ti + key; row = b * SEQ + pos; } else row = TL + b * CTXL + 64 * (ti - 6) + key;
    const bf16_t* base = F.PROJ() + (size_t)row * INC;
    const int d1 = (c8 >> 2) * 64 + (c8 & 3) * 8;
    R.k1 = *(const u32x4*)(base + OFF_K + g * 128 + d1); R.k2 = *(const u32x4*)(base + OFF_K + g * 128 + d1 + 32);
    R.v1 = *(const u32x4*)(base + OFF_V + g * 128 + 8 * c8); R.v2 = *(const u32x4*)(base + OFF_V + g * 128 + 64 + 8 * c8);
    if (ti < 6) { const int tidx = (c8 >> 2) ? 128 + (pos & 63) : (pos >> 6); const f32x4* cp = (const f32x4*)(F.ROPE() + ((size_t)tidx * 32 + (c8 & 3) * 8) * 2);
#pragma unroll
        for (int m = 0; m < 4; ++m) R.cs[m] = cp[m]; }
}
__device__ __forceinline__ void rope8(u32x4& a, u32x4& bq, const f32x4 (&cs)[4], float scale) {
    u32x4 oa, ob;
#pragma unroll
    for (int w = 0; w < 4; ++w) {
        const float x1l = bf_lo(a[w]), x1h = bf_hi(a[w]), x2l = bf_lo(bq[w]), x2h = bf_hi(bq[w]);
        const float cl = cs[w].x, sl = cs[w].y, ch = cs[w].z, sh = cs[w].w;
        oa[w] = pk2((x1l * cl - x2l * sl) * scale, (x1h * ch - x2h * sh) * scale);
        ob[w] = pk2((x2l * cl + x1l * sl) * scale, (x2h * ch + x1h * sh) * scale);
    }
    a = oa; bq = ob;
}
__device__ __forceinline__ void attn_store_tile(Frame& F, KVRegs& R, int ti, int buf) {
    const int key = F.tid >> 3, c8 = F.tid & 7;
    if (ti < 6) rope8(R.k1, R.k2, R.cs, 1.f);
    const int d1 = (c8 >> 2) * 64 + (c8 & 3) * 8;
    LAS unsigned char* kp = F.lds + buf * KS_BYTES + key * KP;
    *(LAS u32x4*)(kp + d1 * 2) = R.k1; *(LAS u32x4*)(kp + (d1 + 32) * 2) = R.k2;
    LAS unsigned char* vp = F.lds + 2 * KS_BYTES + buf * VS_BYTES + key * VP;
    *(LAS u32x4*)(vp + 16 * c8) = R.v1; *(LAS u32x4*)(vp + 128 + 16 * c8) = R.v2;
}

#define MFMA32(a, b, c) __builtin_amdgcn_mfma_f32_32x32x16_bf16((a), (b), (c), 0, 0, 0)

__device__ __forceinline__ void attn_unit(Frame& F, int layer, int u) {
    const bool latent = u < 512;
    int b, n, g, hp;
    if (latent) { hp = u & 1; g = (u >> 1) & 1; n = (u >> 2) & 63; b = u >> 8; }
    else { const int v = u - 512; hp = v & 1; g = (v >> 1) & 1; n = (v >> 2) & 1; b = v >> 3; }
    const int lane = F.lane, r = lane & 31, h = lane >> 5, wave = F.wave;
    const int head = g * 4 + hp * 2 + (wave >> 2), qb = wave & 3;
    const int tq = latent ? b * SEQ + n * 128 + 32 * qb + r : TL + b * CTXL + n * 128 + 32 * qb + r;
    bf16x8 qf[8];
    {
        u32x4 raw[8];
        const bf16_t* qp = F.PROJ() + (size_t)tq * INC + OFF_Q + head * 128 + 8 * h;
#pragma unroll
        for (int ks = 0; ks < 8; ++ks) raw[ks] = *(const u32x4*)(qp + 16 * ks);
        if (latent) {
            const int pos = n * 128 + 32 * qb + r;
#pragma unroll
            for (int half = 0; half < 2; ++half) {
                const int tidx = half ? 128 + (pos & 63) : (pos >> 6);
#pragma unroll
                for (int kk = 0; kk < 2; ++kk) {
                    const f32x4* cp = (const f32x4*)(F.ROPE() + ((size_t)tidx * 32 + 16 * kk + 8 * h) * 2);
                    f32x4 cs[4];
#pragma unroll
                    for (int m = 0; m < 4; ++m) cs[m] = cp[m];
                    rope8(raw[4 * half + kk], raw[4 * half + kk + 2], cs, QSCALE);
                }
            }
        } else {
#pragma unroll
            for (int ks = 0; ks < 8; ++ks)
#pragma unroll
                for (int w = 0; w < 4; ++w) raw[ks][w] = pk2(bf_lo(raw[ks][w]) * QSCALE, bf_hi(raw[ks][w]) * QSCALE);
        }
#pragma unroll
        for (int ks = 0; ks < 8; ++ks) qf[ks] = __builtin_bit_cast(bf16x8, raw[ks]);
    }
    int tlo = 6, nw = 0;
    if (latent) { tlo = (n == 0) ? 2 : 0; const int thi = (n == 63) ? 3 : 5; nw = thi - tlo + 1; }
    const int ntiles = nw + 4;
    f32x16 o[4];
#pragma unroll
    for (int db = 0; db < 4; ++db)
#pragma unroll
        for (int i = 0; i < 16; ++i) o[db][i] = 0.f;
    float m_run = F.sink()[layer * 8 + head] * LOG2E;
    float lsum = h == 0 ? 1.f : 0.f;
    const int iq = 32 * qb + r;
    KVRegs R;
    __syncthreads();
    attn_load_tile(F, R, nw > 0 ? tlo : 6, b, n, g);
    attn_store_tile(F, R, nw > 0 ? tlo : 6, 0);
    __syncthreads();
    const int i16 = lane & 15, tq4 = i16 >> 2, tp = i16 & 3, blk = (lane >> 4) & 1;
    for (int j = 0; j < ntiles; ++j) {
        const int ti = j < nw ? tlo + j : 6 + (j - nw);
        const int buf = j & 1;
        const bool more = j + 1 < ntiles;
        const int tin = (j + 1) < nw ? tlo + j + 1 : 6 + (j + 1 - nw);
        if (more) attn_load_tile(F, R, tin, b, n, g);
        const bool part = ti >= 6 || (ti >= (qb >> 1) && ti <= (qb >> 1) + 4);
        if (part) {
            f32x16 s0, s1;
#pragma unroll
            for (int i = 0; i < 16; ++i) { s0[i] = 0.f; s1[i] = 0.f; }
            const LAS unsigned char* kb = F.lds + buf * KS_BYTES + r * KP + h * 16;
#pragma unroll
            for (int ks = 0; ks < 8; ++ks) {
                const bf16x8 a0 = *(const LAS bf16x8*)(kb + ks * 32), a1 = *(const LAS bf16x8*)(kb + 32 * KP + ks * 32);
                s0 = MFMA32(a0, qf[ks], s0); s1 = MFMA32(a1, qf[ks], s1);
            }
            float mx = -INFINITY;
            if (ti < 6 && (ti == (qb >> 1) || ti == (qb >> 1) + 4)) {
                const int jb = 64 * ti + 4 * h - iq;
#pragma unroll
                for (int i = 0; i < 16; ++i) { const int j0 = jb + (i & 3) + 8 * (i >> 2), j1 = j0 + 32;
                    s0[i] = (j0 >= 0 && j0 <= 256) ? s0[i] : -INFINITY; s1[i] = (j1 >= 0 && j1 <= 256) ? s1[i] : -INFINITY; }
            }
#pragma unroll
            for (int i = 0; i < 16; ++i) mx = fmaxf(mx, fmaxf(s0[i], s1[i]));
            mx = fmaxf(mx, xor32_f(mx, lane));
            if (__any(mx > m_run + 8.f)) {
                const float m_new = mx > m_run + 8.f ? mx : m_run, alpha = __builtin_amdgcn_exp2f(m_run - m_new);
                m_run = m_new; lsum *= alpha;
#pragma unroll
                for (int db = 0; db < 4; ++db)
#pragma unroll
                    for (int i = 0; i < 16; ++i) o[db][i] *= alpha;
            }
#pragma unroll
            for (int i = 0; i < 16; ++i) { s0[i] = __builtin_amdgcn_exp2f(s0[i] - m_run); s1[i] = __builtin_amdgcn_exp2f(s1[i] - m_run); lsum += s0[i] + s1[i]; }
            bf16x8 pf[2][2];
#pragma unroll
            for (int s2 = 0; s2 < 2; ++s2) {
                u32x4 p0, p1;
#pragma unroll
                for (int w = 0; w < 4; ++w) { p0[w] = pk2(s0[8 * s2 + 2 * w], s0[8 * s2 + 2 * w + 1]); p1[w] = pk2(s1[8 * s2 + 2 * w], s1[8 * s2 + 2 * w + 1]); }
                pf[0][s2] = __builtin_bit_cast(bf16x8, p0); pf[1][s2] = __builtin_bit_cast(bf16x8, p1);
            }
            const LAS unsigned char* vb = F.lds + 2 * KS_BYTES + buf * VS_BYTES + (4 * h + tq4) * VP + 32 * blk + 8 * tp;
#pragma unroll
            for (int db = 0; db < 4; ++db)
#pragma unroll
                for (int kb2 = 0; kb2 < 2; ++kb2)
#pragma unroll
                    for (int s2 = 0; s2 < 2; ++s2) {
                        const int off = (32 * kb2 + 16 * s2) * VP + db * 64;
                        const s16x4 lo = __builtin_amdgcn_ds_read_tr16_b64_v4i16((LAS s16x4*)(vb + off));
                        const s16x4 hi = __builtin_amdgcn_ds_read_tr16_b64_v4i16((LAS s16x4*)(vb + off + 8 * VP));
                        const bf16x8 av = __builtin_shufflevector(lo, hi, 0, 1, 2, 3, 4, 5, 6, 7);
                        o[db] = MFMA32(av, pf[kb2][s2], o[db]);
                    }
        }
        if (more) attn_store_tile(F, R, tin, buf ^ 1);
        __syncthreads();
    }
    const float lt = lsum + xor32_f(lsum, lane);
    const float inv = 1.f / lt;
    float ss = 0.f;
#pragma unroll
    for (int db = 0; db < 4; ++db)
#pragma unroll
        for (int i = 0; i < 16; ++i) { o[db][i] *= inv; ss += o[db][i] * o[db][i]; }
    ss += xor32_f(ss, lane);
    const float rn = 1.f / sqrtf(ss * (1.f / 128.f) + LN_EPS);
    bf16_t* op = F.MIX() + (size_t)tq * D + head * 128 + 4 * h;
    const float* gp = F.g_attn() + layer * 1024 + head * 128 + 4 * h;
#pragma unroll
    for (int db = 0; db < 4; ++db)
#pragma unroll
        for (int g4 = 0; g4 < 4; ++g4) {
            const f32x4 gv = *(const f32x4*)(gp + 32 * db + 8 * g4);
            u32x2 w; w.x = pk2(o[db][4 * g4] * rn * gv.x, o[db][4 * g4 + 1] * rn * gv.y); w.y = pk2(o[db][4 * g4 + 2] * rn * gv.z, o[db][4 * g4 + 3] * rn * gv.w);
            *(u32x2*)(op + 32 * db + 8 * g4) = w;
        }
}

__device__ __forceinline__ void unpack8(const u32x4 v, float (&f)[8]) {
#pragma unroll
    for (int w = 0; w < 4; ++w) { f[2 * w] = bf_lo(v[w]); f[2 * w + 1] = bf_hi(v[w]); }
}
__device__ __forceinline__ void conv_row(Frame& F, int layer, int t) {
    bool first, last;
    if (t < TL) { const int pos = t & (SEQ - 1); first = pos == 0; last = pos == SEQ - 1; } else { const int pc = (t - TL) & (CTXL - 1); first = pc == 0; last = pc == CTXL - 1; }
    const bf16_t* p = F.PROJ() + (size_t)t * INC;
    const LAS unsigned char* cvc = F.lds + CONV_LDS + F.lane * 16;
#pragma unroll
    for (int jc = 0; jc < 2; ++jc) {
        const int c = 8 * F.lane + 512 * jc;
        float gb[8], a[8], bq[8], um[8], ut[8], up[8];
        unpack8(*(const u32x4*)(p + c), gb);
        unpack8(*(const u32x4*)(p + OFF_C + c), a); unpack8(*(const u32x4*)(p + OFF_X + c), bq);
#pragma unroll
        for (int e = 0; e < 8; ++e) ut[e] = a[e] * bq[e];
        if (!first) { unpack8(*(const u32x4*)(p - INC + OFF_C + c), a); unpack8(*(const u32x4*)(p - INC + OFF_X + c), bq);
#pragma unroll
            for (int e = 0; e < 8; ++e) um[e] = a[e] * bq[e]; }
        else {
#pragma unroll
            for (int e = 0; e < 8; ++e) um[e] = 0.f; }
        if (!last) { unpack8(*(const u32x4*)(p + INC + OFF_C + c), a); unpack8(*(const u32x4*)(p + INC + OFF_X + c), bq);
#pragma unroll
            for (int e = 0; e < 8; ++e) up[e] = a[e] * bq[e]; }
        else {
#pragma unroll
            for (int e = 0; e < 8; ++e) up[e] = 0.f; }
        float y[8], ss = 0.f;
#pragma unroll
        for (int q = 0; q < 2; ++q) { const f32x4 w0 = *(const LAS f32x4*)(cvc + (2 * jc + q) * 1024), w1 = *(const LAS f32x4*)(cvc + 4096 + (2 * jc + q) * 1024), w2 = *(const LAS f32x4*)(cvc + 8192 + (2 * jc + q) * 1024);
#pragma unroll
            for (int e = 0; e < 4; ++e) { const int i = 4 * q + e; y[i] = gb[i] * (w0[e] * um[i] + w1[e] * ut[i] + w2[e] * up[i]); ss += y[i] * y[i]; } }
        ss += dpp_f<DPP_XOR1>(ss); ss += dpp_f<DPP_XOR2>(ss); ss += dpp_f<DPP_ROR4>(ss); ss += dpp_f<DPP_ROR8>(ss);
        const float rn = 1.f / sqrtf(ss * (1.f / 128.f) + LN_EPS);
        u32x4 w;
#pragma unroll
        for (int q = 0; q < 2; ++q) { const f32x4 gcv = *(const LAS f32x4*)(cvc + 12288 + (2 * jc + q) * 1024); w[2 * q] = pk2(y[4 * q] * rn * gcv[0], y[4 * q + 1] * rn * gcv[1]); w[2 * q + 1] = pk2(y[4 * q + 2] * rn * gcv[2], y[4 * q + 3] * rn * gcv[3]); }
        *(u32x4*)(F.MIX() + (size_t)t * D + 1024 + c) = w;
    }
}

__device__ __forceinline__ void ln_phase(Frame& F, int layer, int rows) {
    const int lane = F.lane;
    u32x4 w[4], wn[4];
    int t = F.gw;
    if (t < rows) {
#pragma unroll
        for (int j = 0; j < 4; ++j) w[j] = *(const u32x4*)(F.X() + (size_t)t * D + 8 * lane + 512 * j);
    }
    {
        const int ch = F.tid, jj = ch >> 7, rem = ch & 127, ll = rem >> 1, qq = rem & 1;
        LAS unsigned char* dst = F.lds + ((2 * jj + qq) * 64 + ll) * 16;
        *(LAS f32x4*)(dst) = *(const f32x4*)(F.ln1_g() + layer * D + 4 * ch);
        *(LAS f32x4*)(dst + 8192) = *(const f32x4*)(F.ln1_b() + layer * D + 4 * ch);
#pragma unroll 1
        for (int v = 0; v < 6; ++v) { const int mrv = v % 3; const size_t off = ((size_t)layer * 3 + mrv) * 12288 + (v < 3 ? 3 * D : 4 * D);
            *(LAS f32x4*)(dst + (2 + v) * 8192) = *(const f32x4*)(F.MODS() + off + 4 * ch); }
    }
    __syncthreads();
    const LAS unsigned char* vc = F.lds + lane * 16;
    while (t < rows) {
        const int tn = t + F.NGW;
        if (tn < rows) {
#pragma unroll
            for (int j = 0; j < 4; ++j) wn[j] = *(const u32x4*)(F.X() + (size_t)tn * D + 8 * lane + 512 * j);
        }
        float v[32]; float s = 0.f;
#pragma unroll
        for (int j = 0; j < 4; ++j)
#pragma unroll
            for (int q = 0; q < 4; ++q) { v[8 * j + 2 * q] = bf_lo(w[j][q]); v[8 * j + 2 * q + 1] = bf_hi(w[j][q]); s += v[8 * j + 2 * q] + v[8 * j + 2 * q + 1]; }
        const float mean = wave_sum(s) * (1.f / D);
        float s2 = 0.f;
#pragma unroll
        for (int i = 0; i < 32; ++i) { v[i] -= mean; s2 += v[i] * v[i]; }
        const float rstd = 1.f / sqrtf(wave_sum(s2) * (1.f / D) + LN_EPS);
        float s3 = 0.f;
#pragma unroll
        for (int j = 0; j < 4; ++j) { const int c = 8 * lane + 512 * j; u32x4 o;
#pragma unroll
            for (int q = 0; q < 2; ++q) { const f32x4 gg = *(const LAS f32x4*)(vc + (2 * j + q) * 1024), bb = *(const LAS f32x4*)(vc + 8192 + (2 * j + q) * 1024);
#pragma unroll
                for (int e = 0; e < 4; ++e) { const float y = v[8 * j + 4 * q + e] * rstd * gg[e] + bb[e]; v[8 * j + 4 * q + e] = y; s3 += y; }
                o[2 * q] = pk2(v[8 * j + 4 * q], v[8 * j + 4 * q + 1]); o[2 * q + 1] = pk2(v[8 * j + 4 * q + 2], v[8 * j + 4 * q + 3]); }
            *(u32x4*)(F.X() + (size_t)t * D + c) = o; }
        const float mean2 = wave_sum(s3) * (1.f / D);
        float s4 = 0.f;
#pragma unroll
        for (int i = 0; i < 32; ++i) { v[i] -= mean2; s4 += v[i] * v[i]; }
        const float rstd2 = 1.f / sqrtf(wave_sum(s4) * (1.f / D) + LN_EPS);
        const int mrl = modrow(t);
#pragma unroll
        for (int j = 0; j < 4; ++j) { const int c = 8 * lane + 512 * j; u32x4 o;
#pragma unroll
            for (int q = 0; q < 2; ++q) { const f32x4 sh = *(const LAS f32x4*)(vc + (2 + mrl) * 8192 + (2 * j + q) * 1024), sc = *(const LAS f32x4*)(vc + (5 + mrl) * 8192 + (2 * j + q) * 1024);
                const float y0 = v[8 * j + 4 * q] * rstd2 * (1.f + sc[0]) + sh[0], y1 = v[8 * j + 4 * q + 1] * rstd2 * (1.f + sc[1]) + sh[1];
                const float y2 = v[8 * j + 4 * q + 2] * rstd2 * (1.f + sc[2]) + sh[2], y3 = v[8 * j + 4 * q + 3] * rstd2 * (1.f + sc[3]) + sh[3];
                o[2 * q] = pk2(y0, y1); o[2 * q + 1] = pk2(y2, y3); }
            *(u32x4*)(F.H() + (size_t)t * D + c) = o; }
#pragma unroll
        for (int j = 0; j < 4; ++j) w[j] = wn[j];
        t = tn;
    }
}

__device__ __forceinline__ unsigned ordkey(float f) { const unsigned u = __float_as_uint(f); return u ^ ((u >> 31) ? 0xFFFFFFFFu : 0x80000000u); }
__device__ __forceinline__ float gelu_erf(float a) { return 0.5f * a * (1.f + erff(a * 0.70710678118654752f)); }

__device__ __forceinline__ float unordkey(unsigned k) { return __uint_as_float(k ^ ((k >> 31) ? 0x80000000u : 0xFFFFFFFFu)); }
__device__ __forceinline__ float gelu_as(float v) {
    const float av = fabsf(v), t = __builtin_amdgcn_rcpf(av * 0.2316418882f + 1.0f);
    float q = t * 0.5307027145f + (-0.7265760135f); q = q * t + 0.7107068705f; q = q * t + (-0.142248368f); q = q * t + 0.127414796f; q = q * t;
    const float e = __builtin_amdgcn_exp2f((v * v) * (-0.72134752044f));
    const float m = v * (q * e);
    return v < 0.f ? m : v - m;
}

template <class O> struct QuadNet {
    typedef typename O::V V; typedef typename O::B B;
    template <bool ASC> static __device__ __forceinline__ void ce_reg(V& a, V& b) { const V lo = O::vmin(a, b), hi = O::vmax(a, b); a = ASC ? lo : hi; b = ASC ? hi : lo; }
    template <bool ASC> static __device__ __forceinline__ void ce_l1(V& x, B low1) { const V p = O::x1(x); const V mn = O::vmin(p, x), mx = O::vmax(p, x); x = ASC ? O::vsel(low1, mn, mx) : O::vsel(low1, mx, mn); }
    template <bool ASC> static __device__ __forceinline__ void ce_l2(V& x, B low2) { const V p = O::x2(x); const V mn = O::vmin(p, x), mx = O::vmax(p, x); x = ASC ? O::vsel(low2, mn, mx) : O::vsel(low2, mx, mn); }
    template <int NR> static __device__ __forceinline__ void sort_blocks(V (&R)[NR], B low1, B low2, B eq12) {
#pragma unroll
        for (int r = 0; r < NR; ++r) { const V p = O::x1(R[r]); const V mn = O::vmin(p, R[r]), mx = O::vmax(p, R[r]); R[r] = O::vsel(eq12, mn, mx); }
#pragma unroll
        for (int r = 0; r < NR; ++r) { if ((r & 1) == 0) ce_l2<true>(R[r], low2); else ce_l2<false>(R[r], low2); }
#pragma unroll
        for (int r = 0; r < NR; ++r) { if ((r & 1) == 0) ce_l1<true>(R[r], low1); else ce_l1<false>(R[r], low1); }
#pragma unroll
        for (int r = 0; r < NR; r += 2) { if ((r & 2) == 0) ce_reg<true>(R[r], R[r + 1]); else ce_reg<false>(R[r], R[r + 1]); }
#pragma unroll
        for (int r = 0; r < NR; ++r) { if ((r & 2) == 0) ce_l2<true>(R[r], low2); else ce_l2<false>(R[r], low2); }
#pragma unroll
        for (int r = 0; r < NR; ++r) { if ((r & 2) == 0) ce_l1<true>(R[r], low1); else ce_l1<false>(R[r], low1); }
#pragma unroll
        for (int r = 0; r < NR; ++r) { if ((r & 2) == 0) { if ((r & 4) == 0) ce_reg<true>(R[r], R[r + 2]); else ce_reg<false>(R[r], R[r + 2]); } }
#pragma unroll
        for (int r = 0; r < NR; r += 2) { if ((r & 4) == 0) ce_reg<true>(R[r], R[r + 1]); else ce_reg<false>(R[r], R[r + 1]); }
#pragma unroll
        for (int r = 0; r < NR; ++r) { if ((r & 4) == 0) ce_l2<true>(R[r], low2); else ce_l2<false>(R[r], low2); }
#pragma unroll
        for (int r = 0; r < NR; ++r) { if ((r & 4) == 0) ce_l1<true>(R[r], low1); else ce_l1<false>(R[r], low1); }
    }
    template <int NR> static __device__ __forceinline__ void halve_merge(const V (&R)[NR], V (&Q)[NR / 2], B low1, B low2) {
#pragma unroll
        for (int m = 0; m < NR / 8; ++m)
#pragma unroll
            for (int i = 0; i < 4; ++i) Q[4 * m + i] = O::vmax(R[8 * m + i], R[8 * m + 4 + i]);
#pragma unroll
        for (int r = 0; r < NR / 2; ++r) { if ((r & 2) == 0) { if ((r & 4) == 0) ce_reg<false>(Q[r], Q[r + 2]); else ce_reg<true>(Q[r], Q[r + 2]); } }
#pragma unroll
        for (int r = 0; r < NR / 2; r += 2) { if ((r & 4) == 0) ce_reg<false>(Q[r], Q[r + 1]); else ce_reg<true>(Q[r], Q[r + 1]); }
#pragma unroll
        for (int r = 0; r < NR / 2; ++r) { if ((r & 4) == 0) ce_l2<false>(Q[r], low2); else ce_l2<true>(Q[r], low2); }
#pragma unroll
        for (int r = 0; r < NR / 2; ++r) { if ((r & 4) == 0) ce_l1<false>(Q[r], low1); else ce_l1<true>(Q[r], low1); }
    }
    static __device__ __forceinline__ void top16_of_128(V (&R)[32], V (&T)[4], B low1, B low2, B eq12) {
        sort_blocks<32>(R, low1, low2, eq12);
        V A[16]; halve_merge<32>(R, A, low1, low2);
        V Bq[8]; halve_merge<16>(A, Bq, low1, low2);
        halve_merge<8>(Bq, T, low1, low2);
    }
    static __device__ __forceinline__ void top16_of_64(V (&R)[16], V (&T)[4], B low1, B low2, B eq12) {
        sort_blocks<16>(R, low1, low2, eq12);
        V A[8]; halve_merge<16>(R, A, low1, low2);
        halve_merge<8>(A, T, low1, low2);
    }
};

struct DevOps {
    typedef unsigned V; typedef bool B;
    static __device__ __forceinline__ V vmin(V a, V b) { return a < b ? a : b; }
    static __device__ __forceinline__ V vmax(V a, V b) { return a > b ? a : b; }
    static __device__ __forceinline__ V vsel(B m, V a, V b) { return m ? a : b; }
    static __device__ __forceinline__ V x1(V a) { return (V)dpp_i<DPP_XOR1>((int)a); }
    static __device__ __forceinline__ V x2(V a) { return (V)dpp_i<DPP_XOR2>((int)a); }
};
__device__ __forceinline__ void stair_ab(int c, int& a, int& b) {
    if (c < 16) { a = 0; b = c; } else if (c < 24) { a = 1; b = c - 16; } else if (c < 28) { a = 2; b = c - 24; } else if (c < 32) { a = 3; b = c - 28; }
    else if (c < 36) { a = 4; b = c - 32; } else if (c < 40) { a = 5 + ((c - 36) >> 1); b = (c - 36) & 1; } else if (c < 44) { a = 7 + ((c - 40) >> 1); b = (c - 40) & 1; }
    else if (c < 48) { a = 9 + (c - 44); b = 0; } else if (c < 51) { a = 13 + (c - 48); b = 0; } else { a = 2; b = 4; }
}
constexpr int PE_WS = 5120, PE_TAB = 8 * PE_WS;
constexpr int PE_VEC = PE_TAB + 512;
static_assert(PE_VEC + 11 * 8192 <= LDSCTL_OFF, "PE vector cache");
__device__ __forceinline__ void peer_topk(Frame& F, LAS unsigned char* ws, int t) {
    const int lane = F.lane, sub = lane & 3;
    const bool low1 = (sub & 1) == 0, low2 = (sub & 2) == 0, eq12 = low1 == low2;
    LAS unsigned* S1K = (LAS unsigned*)ws; LAS int* EL = (LAS int*)(ws + 3328); LAS float* GL = (LAS float*)(ws + 3840);
    const LAS unsigned short* TAB = (const LAS unsigned short*)(F.lds + PE_TAB);
    {
        const int L = lane >> 2;
        const bf16_t* sp = F.SC() + (size_t)t * D + L * 128 + sub * 32;
        unsigned R[32];
#pragma unroll
        for (int q = 0; q < 4; ++q) { const u32x4 v = *(const u32x4*)(sp + 8 * q);
#pragma unroll
            for (int e = 0; e < 4; ++e) {
                R[8 * q + 2 * e] = (ordkey(bf_lo(v[e])) & ~127u) | (unsigned)(127 - (32 * sub + 8 * q + 2 * e));
                R[8 * q + 2 * e + 1] = (ordkey(bf_hi(v[e])) & ~127u) | (unsigned)(127 - (32 * sub + 8 * q + 2 * e + 1)); } }
        unsigned T[4];
        QuadNet<DevOps>::top16_of_128(R, T, low1, low2, eq12);
#pragma unroll
        for (int r = 0; r < 4; ++r) S1K[L * 16 + 4 * r + sub] = T[r];
    }
    LDS_WAIT(); __builtin_amdgcn_wave_barrier();
    {
        const int hd = (lane >> 2) & 7;
        const LAS unsigned char* la = (const LAS unsigned char*)(S1K + (2 * hd) * 16); const LAS unsigned char* lb = (const LAS unsigned char*)(S1K + (2 * hd + 1) * 16);
        unsigned C[16];
#pragma unroll
        for (int r = 0; r < 13; ++r) { const unsigned ab = TAB[4 * r + sub];
            const unsigned ka = *(const LAS unsigned*)(la + (ab & 255u)), kb = *(const LAS unsigned*)(lb + (ab >> 8));
            const float sum = unordkey(ka & ~127u) + unordkey(kb & ~127u);
            C[r] = (ordkey(sum) & ~63u) | (unsigned)(63 - (4 * r + sub)); }
        C[13] = 0u; C[14] = 0u; C[15] = 0u;
        unsigned W[4];
        QuadNet<DevOps>::top16_of_64(C, W, low1, low2, eq12);
        float sv[4]; int ex[4];
#pragma unroll
        for (int r = 0; r < 4; ++r) { const unsigned ab = TAB[63 - (W[r] & 63u)];
            const unsigned ka = *(const LAS unsigned*)(la + (ab & 255u)), kb = *(const LAS unsigned*)(lb + (ab >> 8));
            ex[r] = (int)(127u - (ka & 127u)) * 128 + (int)(127u - (kb & 127u)); sv[r] = unordkey(W[r] & ~63u); }
        const float mx = dpp_f<0x00>(sv[0]);
        float e4[4], es = 0.f;
#pragma unroll
        for (int r = 0; r < 4; ++r) { e4[r] = __expf(sv[r] - mx); es += e4[r]; }
        es += dpp_f<DPP_XOR1>(es); es += dpp_f<DPP_XOR2>(es);
        const float rd = 1.f / es;
#pragma unroll
        for (int r = 0; r < 4; ++r) { GL[hd * 16 + 4 * r + sub] = e4[r] * rd; EL[hd * 16 + 4 * r + sub] = ex[r]; }
    }
    LDS_WAIT(); __builtin_amdgcn_wave_barrier();
}

#ifndef PROBE_PHASE
#define PROBE_PHASE -1
#endif
#ifndef PROBE_MULT
#define PROBE_MULT 1
#endif
constexpr int EB = 4;
constexpr int CW_TICKET = 20480;

struct GBuf { LpRow<U_FMT> u[EB]; LpRow<V_FMT> v[EB]; };
__device__ __forceinline__ void gather_issue(GBuf& B, const LAS int* EL, int i0, const unsigned char* UTl, const unsigned char* VTl, int lane) {
#pragma unroll
    for (int q = 0; q < EB; ++q) {
        const int ex = __builtin_amdgcn_readfirstlane(EL[i0 + q]);
        B.u[q].load(UTl + (size_t)ex * UROW, lane); B.v[q].load(VTl + (size_t)ex * VROW, lane);
    }
}
__device__ __forceinline__ void gather_compute(const GBuf& B, const LAS int* EL, const LAS float* GL, int i0, const float* USl, const float* VSl, const unsigned (&hv)[16], f32x2 (&acc)[16]) {
    float dot[EB], su[EB], sv[EB], g[EB];
#pragma unroll
    for (int q = 0; q < EB; ++q) { const int ex = __builtin_amdgcn_readfirstlane(EL[i0 + q]); su[q] = USl[ex]; sv[q] = VSl[ex];
        g[q] = __uint_as_float(__builtin_amdgcn_readfirstlane(__float_as_uint(GL[i0 + q]))); }
#pragma unroll
    for (int q = 0; q < EB; ++q) { float s0 = 0.f, s1 = 0.f;
        B.u[q].each_bf([&](int i, bf16x2_t x) { if (i & 1) s1 = __builtin_amdgcn_fdot2_f32_bf16(x, __builtin_bit_cast(bf16x2_t, hv[i]), s1, false); else s0 = __builtin_amdgcn_fdot2_f32_bf16(x, __builtin_bit_cast(bf16x2_t, hv[i]), s0, false); });
        dot[q] = s0 + s1; __builtin_amdgcn_sched_barrier(0); }
#pragma unroll
    for (int q = 0; q < EB; ++q) dot[q] = wave_sum_u(dot[q]);
#pragma unroll
    for (int q = 0; q < EB; ++q) { const float cf = g[q] * gelu_as(dot[q] * su[q]) * sv[q]; const f32x2 c2 = {cf, cf};
        B.v[q].each([&](int i, float x0, float x1) { const f32x2 x = {x0, x1}; acc[i >> 1] = __builtin_elementwise_fma(x, c2, acc[i >> 1]); }); __builtin_amdgcn_sched_barrier(0); }
}

__device__ __forceinline__ void peer_phase(Frame& F, int layer, int rows, unsigned* ctl, unsigned long long& pr_acc) {
    unsigned long long pt0 = 0ull;
#define SUB_BEGIN(ty) do { if (PROBE_PHASE == (ty)) pt0 = __builtin_amdgcn_s_memrealtime(); } while (0)
#define SUB_END(ty) do { if (PROBE_PHASE == (ty)) pr_acc += __builtin_amdgcn_s_memrealtime() - pt0; } while (0)
    if (F.tid < 64) { int a = 0, b = 0; stair_ab(F.tid < 52 ? F.tid : 0, a, b); *(LAS unsigned short*)(F.lds + PE_TAB + 2 * F.tid) = (unsigned short)((4 * a) | ((4 * b) << 8)); }
    {
        const int ch = F.tid, ll = ch >> 3, q = ch & 7;
        LAS unsigned char* dst = F.lds + PE_VEC + (q * 64 + ll) * 16;
        const int nl = layer < NLAYER - 1 ? layer + 1 : layer;
#pragma unroll 1
        for (int v = 0; v < 9; ++v) {
            const int g3 = v / 3, mrv = v - 3 * g3;
            const size_t off = ((size_t)(g3 == 0 ? layer : nl) * 3 + mrv) * 12288 + (g3 == 0 ? 5 * D : (g3 == 1 ? 0 : D));
            *(LAS f32x4*)(dst + v * 8192) = *(const f32x4*)(F.MODS() + off + 4 * ch);
        }
        *(LAS f32x4*)(dst + 9 * 8192) = *(const f32x4*)(F.ln2_g() + layer * D + 4 * ch);
        *(LAS f32x4*)(dst + 10 * 8192) = *(const f32x4*)(F.ln2_b() + layer * D + 4 * ch);
    }
    __syncthreads();
    LAS unsigned char* ws = F.lds + F.wave * PE_WS;
    LAS int* EL = (LAS int*)(ws + 3328); LAS float* GL = (LAS float*)(ws + 3840);
    const int lane = F.lane;
    const LAS unsigned char* vcache = F.lds + PE_VEC + lane * 16;
    const unsigned char* UTl = F.UT() + (size_t)layer * NEXP * UROW;
    const unsigned char* VTl = F.VT() + (size_t)layer * NEXP * VROW;
    const float* USl = F.US() + (size_t)layer * NEXP; const float* VSl = F.VS() + (size_t)layer * NEXP;
    unsigned* ticket = ctl + CW_TICKET + 64 * layer;
    unsigned tk = 0u;
    if (lane == 0) tk = __hip_atomic_fetch_add(ticket, 1u, __ATOMIC_RELAXED, __HIP_MEMORY_SCOPE_AGENT);
    int t = (int)__builtin_amdgcn_readfirstlane(tk);
    while (t < rows) {
        unsigned tkn = 0u;
        if (lane == 0) tkn = __hip_atomic_fetch_add(ticket, 1u, __ATOMIC_RELAXED, __HIP_MEMORY_SCOPE_AGENT);
        SUB_BEGIN(8); peer_topk(F, ws, t); SUB_END(8);
        SUB_BEGIN(9);
        unsigned hv[16]; f32x2 acc[16];
#pragma unroll
        for (int q = 0; q < 4; ++q) { const u32x4 w = *(const u32x4*)(F.H() + (size_t)t * D + 32 * lane + 8 * q);
#pragma unroll
            for (int e = 0; e < 4; ++e) { hv[4 * q + e] = w[e]; acc[4 * q + e] = (f32x2){0.f, 0.f}; } }
        {
            GBuf A, B, C;
            gather_issue(A, EL, 0, UTl, VTl, lane);
            gather_issue(B, EL, EB, UTl, VTl, lane);
            for (int i0 = 0; i0 < 30 * EB; i0 += 3 * EB) {
                gather_issue(C, EL, i0 + 2 * EB, UTl, VTl, lane);
                gather_compute(A, EL, GL, i0, USl, VSl, hv, acc);
                gather_issue(A, EL, i0 + 3 * EB, UTl, VTl, lane);
                gather_compute(B, EL, GL, i0 + EB, USl, VSl, hv, acc);
                gather_issue(B, EL, i0 + 4 * EB, UTl, VTl, lane);
                gather_compute(C, EL, GL, i0 + 2 * EB, USl, VSl, hv, acc);
            }
            gather_compute(A, EL, GL, 30 * EB, USl, VSl, hv, acc);
            gather_compute(B, EL, GL, 31 * EB, USl, VSl, hv, acc);
        }
        SUB_END(9); SUB_BEGIN(10);
        const int mr = modrow(t);
        const float* mp = F.MODS() + ((size_t)layer * 3 + mr) * 12288;
        bf16_t* xr = F.X() + (size_t)t * D;
        float rr[32]; float s = 0.f;
#pragma unroll
        for (int q2 = 0; q2 < 4; ++q2) { const u32x4 xw = *(const u32x4*)(xr + 32 * lane + 8 * q2);
#pragma unroll
            for (int h2 = 0; h2 < 2; ++h2) { const int q = 2 * q2 + h2; const f32x4 gv = *(const LAS f32x4*)(vcache + mr * 8192 + q * 1024);
                const f32x4 xv = {bf_lo(xw[2 * h2]), bf_hi(xw[2 * h2]), bf_lo(xw[2 * h2 + 1]), bf_hi(xw[2 * h2 + 1])};
                const f32x4 av = {acc[2 * q].x, acc[2 * q].y, acc[2 * q + 1].x, acc[2 * q + 1].y};
#pragma unroll
                for (int e = 0; e < 4; ++e) { const float v = DN_ALPHA * xv[e] + gv[e] * av[e]; rr[4 * q + e] = v; s += v; } } }
        const float mean = wave_sum_u(s) * (1.f / D);
        float s2 = 0.f;
#pragma unroll
        for (int i = 0; i < 32; ++i) { rr[i] -= mean; s2 += rr[i] * rr[i]; }
        const float rstd = 1.f / sqrtf(wave_sum_u(s2) * (1.f / D) + LN_EPS);
        const float* g2 = F.ln2_g() + layer * D; const float* b2 = F.ln2_b() + layer * D;
        float s3 = 0.f;
#pragma unroll
        for (int q = 0; q < 8; ++q) { const int c = 32 * lane + 4 * q; const f32x4 gg = *(const LAS f32x4*)(vcache + 9 * 8192 + q * 1024), bb = *(const LAS f32x4*)(vcache + 10 * 8192 + q * 1024);
            f32x4 xo;
#pragma unroll
            for (int e = 0; e < 4; ++e) { xo[e] = rr[4 * q + e] * rstd * gg[e] + bb[e]; rr[4 * q + e] = xo[e]; s3 += xo[e]; }
            if (layer < NLAYER - 1) { u32x2 o2; o2.x = pk2(xo[0], xo[1]); o2.y = pk2(xo[2], xo[3]); *(u32x2*)(xr + c) = o2; } else if (t < TL) *(f32x4*)(F.out() + (size_t)t * D + c) = xo; }
        if (layer < NLAYER - 1) {
            const float mean2 = wave_sum_u(s3) * (1.f / D);
            float s4 = 0.f;
#pragma unroll
            for (int i = 0; i < 32; ++i) { rr[i] -= mean2; s4 += rr[i] * rr[i]; }
            const float rstd2 = 1.f / sqrtf(wave_sum_u(s4) * (1.f / D) + LN_EPS);
            const float* np = F.MODS() + ((size_t)(layer + 1) * 3 + mr) * 12288;
#pragma unroll
            for (int q2 = 0; q2 < 4; ++q2) { const int c = 32 * lane + 8 * q2; u32x4 w;
#pragma unroll
                for (int q = 0; q < 2; ++q) { const f32x4 sh = *(const LAS f32x4*)(vcache + (3 + mr) * 8192 + (2 * q2 + q) * 1024), sc = *(const LAS f32x4*)(vcache + (6 + mr) * 8192 + (2 * q2 + q) * 1024); const int ri = 8 * q2 + 4 * q;
                    const float y0 = rr[ri] * rstd2 * (1.f + sc[0]) + sh[0], y1 = rr[ri + 1] * rstd2 * (1.f + sc[1]) + sh[1];
                    const float y2 = rr[ri + 2] * rstd2 * (1.f + sc[2]) + sh[2], y3 = rr[ri + 3] * rstd2 * (1.f + sc[3]) + sh[3];
                    w[2 * q] = pk2(y0, y1); w[2 * q + 1] = pk2(y2, y3); }
                *(u32x4*)(F.H() + (size_t)t * D + c) = w; }
        }
        SUB_END(10);
        t = (int)__builtin_amdgcn_readfirstlane(tkn);
    }
#undef SUB_BEGIN
#undef SUB_END
}

__global__ void __launch_bounds__(NWAVES * 64, 2) skel_fwd(Args args) {
    extern __shared__ __attribute__((aligned(16))) unsigned char lds[];
    Frame F;
    F.lds = (LAS unsigned char*)lds;
    F.tid = threadIdx.x; F.lane = F.tid & 63; F.wave = __builtin_amdgcn_readfirstlane(F.tid >> 6);
    F.G = gridDim.x; F.gw = blockIdx.x * NWAVES + F.wave; F.NGW = F.G * NWAVES;
    unsigned char* ws = args.ws;
    F.ka = (const CAS unsigned char*)__builtin_amdgcn_kernarg_segment_ptr();
    for (int u = F.tid; u < (LDS_BYTES - LDSCTL_OFF) / 4; u += NWAVES * 64) ((LAS unsigned*)(F.lds + LDSCTL_OFF))[u] = 0u;
    __syncthreads();
    unsigned* ctl = (unsigned*)(ws + WS_CTL);
    const int lo = args.ph_lo, hi = args.ph_hi;
    XcdBarrier bar; bar.bar = ctl + CW_BAR + args.li * XCD_BAR_WORDS; bar.x = 0; bar.st = nullptr;
    if (hi - lo > 1) bar = xcd_barrier_post(ctl + CW_BAR + args.li * XCD_BAR_WORDS, (volatile LAS unsigned*)(F.lds + MISC_OFF) + 8);
#define IN(k) (lo <= (k) && (k) < hi)
    unsigned long long pr_acc = 0ull, pr_t0 = 0ull;
#define PR_BEGIN(ty) do { if (PROBE_PHASE == (ty)) pr_t0 = __builtin_amdgcn_s_memrealtime(); } while (0)
#define PR_END(ty) do { if (PROBE_PHASE == (ty)) pr_acc += __builtin_amdgcn_s_memrealtime() - pr_t0; } while (0)
#define BOTH(k) (IN(k) && IN((k) + 1))
#define SEAM(k) do { if (BOTH(k)) xcd_barrier(bar); } while (0)

    if (IN(0)) { PR_BEGIN(0); frame_ids(F); p0a_prologue(F); SEAM(0); PR_END(0); }
    if (IN(1)) {
        PR_BEGIN(1); frame_ids(F);
        { pg8::Gemm g{F.KBD(), F.WQR(), 32 * 256, 2048, 256}; pg8::BatchOrder S{F.G, (int)blockIdx.x}; pg8::EpiBf16 E{F.WEFFT(), D};
          pg8::gemm_phase<pg8::EpiBf16, pg8::BatchOrder, false, true>(F.lds, g, S, E); }
        p0b_mod0(F);
        SEAM(1); PR_END(1);
    }
    for (int layer = 0; layer < NLAYER; ++layer) {
        const int pb = 2 + 6 * layer;
        const bool lastl = layer == NLAYER - 1;
        const int rows = lastl ? TL : TT;
        if (IN(pb + 0)) {
            PR_BEGIN(2); frame_ids(F);
            pg8::Gemm g{F.H(), F.WINT() + (size_t)layer * INC * D, TT, INC, D}; pg8::StaticOrder S; S.init(TT, INC, F.G, (int)blockIdx.x);
            pg8::EpiBf16 E{F.PROJ(), INC};
            pg8::gemm_phase<pg8::EpiBf16, pg8::StaticOrder, true, true>(F.lds, g, S, E);
            SEAM(pb + 0); PR_END(2);
        }
        if (IN(pb + 1)) {
            PR_BEGIN(3); frame_ids(F);
            const int nunits = lastl ? 512 : 528;
            {
                const int ch = F.tid & 255, vsel = F.tid >> 8;
                LAS unsigned char* dst = F.lds + CONV_LDS + ((2 * (ch >> 7) + (ch & 1)) * 64 + ((ch & 127) >> 1)) * 16;
                *(LAS f32x4*)(dst + vsel * 4096) = *(const f32x4*)(F.conv_w() + (size_t)layer * 3 * 1024 + vsel * 1024 + 4 * ch);
                *(LAS f32x4*)(dst + (2 + vsel) * 4096) = vsel == 0 ? *(const f32x4*)(F.conv_w() + (size_t)layer * 3 * 1024 + 2048 + 4 * ch) : *(const f32x4*)(F.g_conv() + layer * 1024 + 4 * ch);
            }
            __syncthreads();
            { unsigned long long q0 = 0; if (PROBE_PHASE == 11) q0 = __builtin_amdgcn_s_memrealtime();
            { const int bx = (int)blockIdx.x, vcu = (F.G % 8 == 0) ? (bx % 8) * (F.G / 8) + bx / 8 : bx;
              for (int u = vcu; u < nunits; u += F.G) attn_unit(F, layer, u); }
            if (PROBE_PHASE == 11) pr_acc += __builtin_amdgcn_s_memrealtime() - q0; if (PROBE_PHASE == 12) q0 = __builtin_amdgcn_s_memrealtime();
            {
              const int nx = nunits - 2 * F.G; const bool uneven = nx > 0 && nx < F.G;
              const int bx2 = (int)blockIdx.x, vc2 = (F.G % 8 == 0) ? (bx2 % 8) * (F.G / 8) + bx2 / 8 : bx2;
              const int c0 = uneven ? vc2 - nx : vc2, nb = uneven ? F.G - nx : F.G;
              if (c0 >= 0) for (int t = c0 * NWAVES + F.wave; t < rows; t += nb * NWAVES) conv_row(F, layer, t); }
            if (PROBE_PHASE == 12) pr_acc += __builtin_amdgcn_s_memrealtime() - q0; }
            SEAM(pb + 1); PR_END(3);
        }
        if (IN(pb + 2)) {
            PR_BEGIN(4); frame_ids(F);
            pg8::Gemm g{F.MIX(), F.WOUTT() + (size_t)layer * D * D, rows, D, D}; pg8::StaticOrder S; S.init(rows, D, F.G, (int)blockIdx.x);
            pg8::EpiResid E{layer == 0 ? F.x() : nullptr, layer == 0 ? F.ctx() : nullptr, F.X(), F.MODS() + (size_t)layer * 3 * 12288 + 2 * D};
            pg8::gemm_phase<pg8::EpiResid, pg8::StaticOrder, true, true>(F.lds, g, S, E);
            frame_ids(F); convert_in_tail(F, layer, (rows / 256) * (D / 256), 0);
            SEAM(pb + 2); PR_END(4);
        }
        if (IN(pb + 3)) { PR_BEGIN(5); frame_ids(F); ln_phase(F, layer, rows); SEAM(pb + 3); PR_END(5); }
        if (IN(pb + 4)) {
            PR_BEGIN(6); frame_ids(F);
            pg8::Gemm g{F.H(), F.WEFFT() + (size_t)layer * D * D, rows, D, D}; pg8::StaticOrder S; S.init(rows, D, F.G, (int)blockIdx.x);
            pg8::EpiBf16 E{F.SC(), D};
            pg8::gemm_phase<pg8::EpiBf16, pg8::StaticOrder, true, true>(F.lds, g, S, E);
            frame_ids(F); convert_in_tail(F, layer, (rows / 256) * (D / 256), 1);
            SEAM(pb + 4); PR_END(6);
        }
        if (IN(pb + 5)) { PR_BEGIN(7); frame_ids(F); peer_phase(F, layer, rows, ctl, pr_acc); SEAM(pb + 5); PR_END(7); }
    }
    if (PROBE_PHASE >= 0 && hi - lo > 1) xcd_barrier(bar);
    if (PROBE_PHASE >= 0 && blockIdx.x == 0 && threadIdx.x == 0) { const unsigned long long t1 = __builtin_amdgcn_s_memrealtime() + (unsigned long long)PROBE_MULT * pr_acc; while (__builtin_amdgcn_s_memrealtime() < t1) __builtin_amdgcn_s_sleep(8); }
#undef IN
#undef BOTH
#undef SEAM
}

extern "C" void kernel_launch(void* const* d_in, const int* in_sizes, int n_in, void* d_out, int out_size, void* d_ws, size_t ws_size, hipStream_t stream) {
    static int grid = 0;
    if (grid == 0) {
        if (n_in != 20 || in_sizes[0] != TL * D || out_size != TL * D || ws_size < WS_END) {
            fprintf(stderr, "kernel_launch: unexpected problem shape (n_in %d, in0 %d, out %d, ws %zu, need %zu)\n", n_in, n_in > 0 ? in_sizes[0] : -1, out_size, ws_size, (size_t)WS_END); grid = -1; return; }
        int dev = 0, cus = 0, per_cu = 0;
        if (hipGetDevice(&dev) != hipSuccess || hipDeviceGetAttribute(&cus, hipDeviceAttributeMultiprocessorCount, dev) != hipSuccess) { grid = -1; return; }
        if (hipFuncSetAttribute((const void*)skel_fwd, hipFuncAttributeMaxDynamicSharedMemorySize, LDS_BYTES) != hipSuccess) { fprintf(stderr, "kernel_launch: hipFuncSetAttribute failed\n"); grid = -1; return; }
        if (hipOccupancyMaxActiveBlocksPerMultiprocessor(&per_cu, (const void*)skel_fwd, NWAVES * 64, LDS_BYTES) != hipSuccess || per_cu < 1)
            fprintf(stderr, "kernel_launch: occupancy query reports %d workgroups per CU\n", per_cu);
        (void)hipGetLastError();
        grid = cus;
    }
    if (grid < 0) return;
    if (hipMemsetAsync((char*)d_ws + WS_CTL, 0, CTL_ZERO_BYTES, stream) != hipSuccess) return;
    Args a{};
    for (int i = 0; i < 20; ++i) a.in[i] = (const float*)d_in[i];
    a.out = (float*)d_out; a.ws = (unsigned char*)d_ws; a.pad = 0;
#if MK_N_LAUNCHES == 1
    a.ph_lo = 0; a.ph_hi = NPHASE; a.li = 0;
    hipLaunchKernelGGL(skel_fwd, dim3(grid), dim3(NWAVES * 64), LDS_BYTES, stream, a);
#else
    for (int ph = 0; ph < NPHASE; ++ph) { a.ph_lo = ph; a.ph_hi = ph + 1; a.li = 0;
        hipLaunchKernelGGL(skel_fwd, dim3(grid), dim3(NWAVES * 64), LDS_BYTES, stream, a); }
#endif
}
```

```cpp
#include <hip/hip_runtime.h>
#include <cstdio>
#include <cstdint>

#ifndef MK_N_LAUNCHES
#define MK_N_LAUNCHES 1
#endif

#define LAS __attribute__((address_space(3)))
typedef unsigned short bf16_t;
typedef short bf16x8 __attribute__((ext_vector_type(8)));
typedef short s16x4 __attribute__((ext_vector_type(4)));
typedef float f32x2 __attribute__((ext_vector_type(2)));
typedef float f32x4 __attribute__((ext_vector_type(4)));
typedef float f32x16 __attribute__((ext_vector_type(16)));
typedef unsigned u32x2 __attribute__((ext_vector_type(2)));
typedef unsigned u32x4 __attribute__((ext_vector_type(4)));
typedef __bf16 bf16x2_t __attribute__((ext_vector_type(2)));

constexpr int D = 2048, NB = 2, SEQ = 8192, CTXL = 256, NLAYER = 4;
constexpr int TL = NB * SEQ, TC = NB * CTXL, TT = TL + TC;
constexpr int INC = 4608, OFF_C = 1024, OFF_X = 2048, OFF_Q = 3072, OFF_K = 4096, OFF_V = 4352;
constexpr int NEXP = 16384;
#ifndef U_FMT
#define U_FMT 4
#endif
#ifndef V_FMT
#define V_FMT 4
#endif
constexpr int UROW = D * U_FMT / 8, VROW = D * V_FMT / 8;
constexpr float LN_EPS = 1e-6f;
constexpr float DN_ALPHA = 1.681792830507429f;
constexpr float QSCALE = 0.08838834764831845f * 1.4426950408889634f;
constexpr float LOG2E = 1.4426950408889634f;

constexpr size_t MiB = 1u << 20;
constexpr size_t WS_CTL = 0, CTL_ZERO_BYTES = 1 * MiB;
constexpr size_t WS_MODS = 1 * MiB;
constexpr size_t WS_ROPE = 2 * MiB;
constexpr size_t WS_KBD = 3 * MiB;
constexpr size_t WS_WQR = 8 * MiB;
constexpr size_t WS_WINT = 40 * MiB;
constexpr size_t WS_WOUTT = 112 * MiB;
constexpr size_t WS_WEFFT = 144 * MiB;
constexpr size_t WS_X = 176 * MiB;
constexpr size_t WS_H = 308 * MiB;
constexpr size_t WS_PROJ = 374 * MiB;
constexpr size_t WS_MIX = 523 * MiB;
constexpr size_t WS_SC = 589 * MiB;
constexpr size_t WS_UT = 721 * MiB;
constexpr size_t WS_VT = 849 * MiB;
constexpr size_t WS_US = 977 * MiB;
constexpr size_t WS_VS = 978 * MiB;
constexpr size_t WS_END = 979 * MiB;

constexpr int CW_BAR = 4096;

namespace pg8 {
constexpr int BM = 256, BK = 64, HALF = 128, HTB = HALF * BK * 2, STAGE_BYTES = 8 * HTB, NXCD = 8, WGM = 8;
__host__ __device__ __forceinline__ int lds_byte(int r, int c) { const int st = (r >> 4) * 2 + (c >> 5), rr = r & 15, cc = c & 31, ob = rr * 64 + cc * 2; return st * 1024 + (ob ^ (((ob >> 9) & 1) << 5)); }
__host__ __device__ __forceinline__ void stage_rc(int b, int& R, int& C) { const int st = b / 1024, sb = b % 1024, swz = sb ^ (((sb >> 9) & 1) << 5); R = (st >> 1) * 16 + swz / 64; C = (st & 1) * 32 + (swz % 64) / 2; }
__host__ __device__ __forceinline__ int perm32(int rho) { const int n = rho >> 4, i = rho & 15; return 8 * (i >> 2) + 4 * n + (i & 3); }

struct Unit { int pm, pn; };
struct Gemm { const bf16_t* A; const bf16_t* Bt; int M, N, K; };

struct StaticOrder {
    int nM, nN, nwg, G, c;
    __host__ __device__ void init(int M, int N, int G_, int c_) { nM = M / BM; nN = N / BM; nwg = nM * nN; G = G_; c = c_; }
    __host__ __device__ bool next(int i, Unit& u) const {
        const long L = (long)i * G + c; if (L >= nwg) return false;
        int wgid = (int)L; { const int q = nwg / NXCD, r = nwg % NXCD, xcd = wgid % NXCD, off = wgid / NXCD; wgid = (xcd < r ? xcd * (q + 1) : r * (q + 1) + (xcd - r) * q) + off; }
        const int nig = WGM * nN, gid = wgid / nig, fm = gid * WGM, gsz = (nM - fm) < WGM ? (nM - fm) : WGM;
        u.pm = fm + ((wgid % nig) % gsz); u.pn = (wgid % nig) / gsz; return true;
    }
    __device__ __forceinline__ int btile(const Unit& u) const { return u.pn; }
    __device__ __forceinline__ void a_ready(const Unit&) const {}
    __device__ __forceinline__ void done(const Unit&) const {}
};
struct BatchOrder {
    int G, c;
    __device__ bool next(int i, Unit& u) const { const int L = i * G + c; if (L >= 256) return false; u.pm = L >> 3; u.pn = L & 7; return true; }
    __device__ __forceinline__ int btile(const Unit& u) const { return u.pm * 8 + u.pn; }
    __device__ __forceinline__ void a_ready(const Unit&) const {}
    __device__ __forceinline__ void done(const Unit&) const {}
};

__device__ __forceinline__ unsigned cvt_pk_bf16(float lo, float hi) { f32x2 x = {lo, hi}; bf16x2_t y = __builtin_convertvector(x, bf16x2_t); return __builtin_bit_cast(unsigned, y); }

struct EpiBf16 {
    static constexpr bool PERM = true;
    bf16_t* O; int ldc;
    __device__ __forceinline__ void operator()(const f32x4 (&acc)[2][2][4][2], const Unit& u, int wr, int wc, int fr, int fq) const {
        const int row0 = u.pm * BM + wr * 64 + fr, col0 = u.pn * BM + wc * 32 + 8 * fq;
#pragma unroll
        for (int ai = 0; ai < 2; ++ai)
#pragma unroll
            for (int m = 0; m < 4; ++m) { bf16_t* rowp = O + (size_t)(row0 + ai * HALF + m * 16) * ldc + col0;
#pragma unroll
                for (int bj = 0; bj < 2; ++bj) { const f32x4 v0 = acc[ai][bj][m][0], v1 = acc[ai][bj][m][1];
                    u32x4 w; w.x = cvt_pk_bf16(v0[0], v0[1]); w.y = cvt_pk_bf16(v0[2], v0[3]); w.z = cvt_pk_bf16(v1[0], v1[1]); w.w = cvt_pk_bf16(v1[2], v1[3]);
                    *(u32x4*)(rowp + bj * HALF) = w; } }
    }
};
struct EpiF32 {
    static constexpr bool PERM = false;
    float* C; int ldc;
    __device__ __forceinline__ void operator()(const f32x4 (&acc)[2][2][4][2], const Unit& u, int wr, int wc, int fr, int fq) const {
        const int row0 = u.pm * BM + wr * 64 + fr, col0 = u.pn * BM + wc * 32 + 4 * fq;
#pragma unroll
        for (int ai = 0; ai < 2; ++ai)
#pragma unroll
            for (int m = 0; m < 4; ++m) { float* rowp = C + (size_t)(row0 + ai * HALF + m * 16) * ldc + col0;
#pragma unroll
                for (int bj = 0; bj < 2; ++bj)
#pragma unroll
                    for (int n = 0; n < 2; ++n) *(f32x4*)(rowp + bj * HALF + n * 16) = acc[ai][bj][m][n]; }
    }
};
struct EpiResid {
    static constexpr bool PERM = true;
    const float* x32_lat; const float* x32_ctx;
    bf16_t* X; const float* gate;
    __device__ __forceinline__ void operator()(const f32x4 (&acc)[2][2][4][2], const Unit& u, int wr, int wc, int fr, int fq) const {
        const int rt = u.pm * BM;
        const int mr = rt < TL ? rt / SEQ : 2;
        const int row0 = rt + wr * 64 + fr, col0 = u.pn * BM + wc * 32 + 8 * fq;
        f32x4 gv[2][2];
#pragma unroll
        for (int bj = 0; bj < 2; ++bj)
#pragma unroll
            for (int n = 0; n < 2; ++n) gv[bj][n] = *(const f32x4*)(gate + (size_t)mr * 12288 + col0 + bj * HALF + 4 * n);
#pragma unroll
        for (int ai = 0; ai < 2; ++ai)
#pragma unroll
            for (int m = 0; m < 4; ++m) { const int row = row0 + ai * HALF + m * 16;
#pragma unroll
                for (int bj = 0; bj < 2; ++bj) {
                    f32x4 x0, x1;
                    if (x32_lat) { const float* xp = (row < TL ? x32_lat + (size_t)row * D : x32_ctx + (size_t)(row - TL) * D) + col0 + bj * HALF; x0 = *(const f32x4*)xp; x1 = *(const f32x4*)(xp + 4); }
                    else { const u32x4 w = *(const u32x4*)(X + (size_t)row * D + col0 + bj * HALF);
                        x0 = (f32x4){__uint_as_float(w.x << 16), __uint_as_float(w.x & 0xffff0000u), __uint_as_float(w.y << 16), __uint_as_float(w.y & 0xffff0000u)};
                        x1 = (f32x4){__uint_as_float(w.z << 16), __uint_as_float(w.z & 0xffff0000u), __uint_as_float(w.w << 16), __uint_as_float(w.w & 0xffff0000u)}; }
                    const f32x4 r0 = x0 * DN_ALPHA + gv[bj][0] * acc[ai][bj][m][0], r1 = x1 * DN_ALPHA + gv[bj][1] * acc[ai][bj][m][1];
                    u32x4 o; o.x = cvt_pk_bf16(r0[0], r0[1]); o.y = cvt_pk_bf16(r0[2], r0[3]); o.z = cvt_pk_bf16(r1[0], r1[1]); o.w = cvt_pk_bf16(r1[2], r1[3]);
                    *(u32x4*)(X + (size_t)row * D + col0 + bj * HALF) = o; } }
    }
};

template <class Epi, class Sched, bool ALIGN_EPI = false, bool SP2 = false>
__device__ __forceinline__ void gemm_phase(LAS unsigned char* lds, const Gemm g, const Sched& S, const Epi& E) {
    int tid = threadIdx.x; asm volatile("" : "+v"(tid));
    const int wid = __builtin_amdgcn_readfirstlane(tid >> 6), lane = tid & 63, wr = wid >> 2, wc = wid & 3, fr = lane & 15, fq = lane >> 4;
    const int K = g.K, nt = K / BK;
    unsigned voffA[2], voffB[2];
#pragma unroll
    for (int i = 0; i < 2; ++i) { int R, C; stage_rc(tid * 16 + i * 8192, R, C); const int Rb = Epi::PERM ? ((R & ~31) + perm32(R & 31)) : R;
        voffA[i] = (unsigned)(R * K + C) * 2u; voffB[i] = (unsigned)(Rb * K + C) * 2u; }
    const size_t kstep = (size_t)(BK * 2);
    const size_t hstep = (size_t)HALF * K * 2;
    const size_t tstep = 2 * hstep;
    const unsigned ldsw = (unsigned)wid * 1024u;
    const int aoff = lds_byte(wr * 64 + fr, fq * 8), boff = lds_byte(wc * 32 + fr, fq * 8);
#define PG8_SA(b, h) (((b) * 2 + (h)) * HTB)
#define PG8_SB(b, h) ((4 + (b) * 2 + (h)) * HTB)
#define PG8_STAGE(bufoff, gbase, voff) do { _Pragma("unroll") for (int _i = 0; _i < 2; ++_i) \
        __builtin_amdgcn_global_load_lds((const unsigned*)((const char*)(gbase) + (voff)[_i]), (LAS unsigned*)(lds + (bufoff) + ldsw + _i * 8192), 16, 0, 0); } while (0)
#define PG8_LDA(dst, b, h) do { _Pragma("unroll") for (int m = 0; m < 4; ++m) _Pragma("unroll") for (int k = 0; k < 2; ++k) dst[m][k] = *(const LAS bf16x8*)(lds + PG8_SA(b, h) + aoff + m * 2048 + k * 1024); } while (0)
#define PG8_LDB(dst, b, h) do { _Pragma("unroll") for (int n = 0; n < 2; ++n) _Pragma("unroll") for (int k = 0; k < 2; ++k) dst[n][k] = *(const LAS bf16x8*)(lds + PG8_SB(b, h) + boff + n * 2048 + k * 1024); } while (0)
#define PG8_MMA(ai, bj, At, Bt) do { __builtin_amdgcn_s_setprio(1); _Pragma("unroll") for (int m = 0; m < 4; ++m) _Pragma("unroll") for (int n = 0; n < 2; ++n) _Pragma("unroll") for (int k = 0; k < 2; ++k) \
        acc[ai][bj][m][n] = __builtin_amdgcn_mfma_f32_16x16x32_bf16(Bt[n][k], At[m][k], acc[ai][bj][m][n], 0, 0, 0); __builtin_amdgcn_s_setprio(0); } while (0)
#define PG8_WAIT_V(n) asm volatile("s_waitcnt vmcnt(" #n ")" ::: "memory")
#define PG8_WAIT_L(n) asm volatile("s_waitcnt lgkmcnt(" #n ")" ::: "memory")
#define PG8_BAR __builtin_amdgcn_s_barrier()
#define PG8_SCHED __builtin_amdgcn_sched_barrier(0)
    Unit cur, nxt; int ui = 0;
    if (!S.next(0, cur)) return;
    f32x4 acc[2][2][4][2];
#pragma unroll
    for (int a = 0; a < 2; ++a)
#pragma unroll
        for (int b = 0; b < 2; ++b)
#pragma unroll
            for (int m = 0; m < 4; ++m)
#pragma unroll
                for (int n = 0; n < 2; ++n) acc[a][b][m][n] = (f32x4){0.f, 0.f, 0.f, 0.f};
    bf16x8 At[4][2], B0[2][2], B1[2][2];
    const char* cA = (const char*)g.A + (size_t)cur.pm * tstep; const char* cB = (const char*)g.Bt + (size_t)S.btile(cur) * tstep;
    S.a_ready(cur);
    if constexpr (SP2) {
        PG8_STAGE(PG8_SB(0, 0), cB, voffB); PG8_STAGE(PG8_SB(0, 1), cB + hstep, voffB); PG8_STAGE(PG8_SA(0, 0), cA, voffA); PG8_STAGE(PG8_SA(0, 1), cA + hstep, voffA);
        if (wr == 1) PG8_BAR;
        PG8_WAIT_V(2); PG8_BAR;
        PG8_STAGE(PG8_SB(1, 0), cB + kstep, voffB); PG8_STAGE(PG8_SA(1, 0), cA + kstep, voffA); PG8_STAGE(PG8_SB(1, 1), cB + hstep + kstep, voffB);
        PG8_WAIT_V(6); PG8_BAR;
    } else {
        PG8_STAGE(PG8_SB(0, 0), cB, voffB); PG8_STAGE(PG8_SA(0, 0), cA, voffA); PG8_STAGE(PG8_SB(0, 1), cB + hstep, voffB); PG8_STAGE(PG8_SA(0, 1), cA + hstep, voffA);
        if (wr == 1) PG8_BAR;
        PG8_WAIT_V(4); PG8_BAR;
        PG8_STAGE(PG8_SB(1, 0), cB + kstep, voffB); PG8_STAGE(PG8_SA(1, 0), cA + kstep, voffA); PG8_STAGE(PG8_SB(1, 1), cB + hstep + kstep, voffB);
        PG8_WAIT_V(6); PG8_BAR;
    }
    for (;;) {
        const bool has_next = S.next(ui + 1, nxt);
        const char* nA = has_next ? (const char*)g.A + (size_t)nxt.pm * tstep : cA; const char* nB = has_next ? (const char*)g.Bt + (size_t)S.btile(nxt) * tstep : cB;
        for (int t = 0; t < nt; t += 2) {
            const bool last = (t == nt - 2);
            const char* a1 = cA + (size_t)(t + 1) * kstep;
            const char* a2 = last ? nA : cA + (size_t)(t + 2) * kstep; const char* b2 = last ? nB : cB + (size_t)(t + 2) * kstep;
            const char* a3 = a2 + kstep; const char* b3 = b2 + kstep;
            if (last && has_next) S.a_ready(nxt);
            if constexpr (SP2) {
            PG8_LDB(B0, 0, 0); PG8_LDB(B1, 0, 1); PG8_SCHED; PG8_LDA(At, 0, 0); PG8_STAGE(PG8_SA(1, 1), a1 + hstep, voffA);
            PG8_WAIT_V(8); PG8_WAIT_L(0); PG8_BAR; PG8_MMA(0, 0, At, B0); PG8_MMA(0, 1, At, B1); PG8_BAR; PG8_SCHED;
            PG8_LDA(At, 0, 1); PG8_STAGE(PG8_SB(0, 0), b2, voffB); PG8_STAGE(PG8_SB(0, 1), b2 + hstep, voffB); PG8_STAGE(PG8_SA(0, 0), a2, voffA);
            PG8_WAIT_V(8); PG8_WAIT_L(0); PG8_BAR; PG8_MMA(1, 0, At, B0); PG8_MMA(1, 1, At, B1); PG8_BAR; PG8_SCHED;
            PG8_LDB(B0, 1, 0); PG8_LDB(B1, 1, 1); PG8_SCHED; PG8_LDA(At, 1, 0); PG8_STAGE(PG8_SA(0, 1), a2 + hstep, voffA);
            PG8_WAIT_V(8); PG8_WAIT_L(0); PG8_BAR; PG8_MMA(0, 0, At, B0); PG8_MMA(0, 1, At, B1); PG8_BAR; PG8_SCHED;
            PG8_LDA(At, 1, 1); PG8_STAGE(PG8_SB(1, 0), b3, voffB); PG8_STAGE(PG8_SB(1, 1), b3 + hstep, voffB); PG8_STAGE(PG8_SA(1, 0), a3, voffA);
            PG8_WAIT_V(8); PG8_WAIT_L(0); PG8_BAR; PG8_MMA(1, 0, At, B0); PG8_MMA(1, 1, At, B1); PG8_BAR; PG8_SCHED;
            } else {
            PG8_LDB(B0, 0, 0); PG8_SCHED; PG8_LDA(At, 0, 0); PG8_STAGE(PG8_SA(1, 1), a1 + hstep, voffA);
            PG8_WAIT_L(8); PG8_BAR; PG8_WAIT_L(0); PG8_MMA(0, 0, At, B0); PG8_BAR; PG8_SCHED;
            PG8_LDB(B1, 0, 1); PG8_STAGE(PG8_SB(0, 0), b2, voffB);
            PG8_BAR; PG8_WAIT_L(0); PG8_MMA(0, 1, At, B1); PG8_BAR;
            PG8_LDA(At, 0, 1); PG8_STAGE(PG8_SA(0, 0), a2, voffA);
            PG8_BAR; PG8_WAIT_L(0); PG8_MMA(1, 0, At, B0); PG8_BAR; PG8_SCHED;
            PG8_STAGE(PG8_SB(0, 1), b2 + hstep, voffB);
            PG8_WAIT_V(6); PG8_BAR; PG8_MMA(1, 1, At, B1); PG8_BAR;
            PG8_LDB(B0, 1, 0); PG8_SCHED; PG8_LDA(At, 1, 0); PG8_STAGE(PG8_SA(0, 1), a2 + hstep, voffA);
            PG8_WAIT_L(8); PG8_BAR; PG8_WAIT_L(0); PG8_MMA(0, 0, At, B0); PG8_BAR; PG8_SCHED;
            PG8_LDB(B1, 1, 1); PG8_STAGE(PG8_SB(1, 0), b3, voffB);
            PG8_BAR; PG8_WAIT_L(0); PG8_MMA(0, 1, At, B1); PG8_BAR;
            PG8_LDA(At, 1, 1); PG8_STAGE(PG8_SA(1, 0), a3, voffA);
            PG8_BAR; PG8_WAIT_L(0); PG8_MMA(1, 0, At, B0); PG8_BAR; PG8_SCHED;
            PG8_STAGE(PG8_SB(1, 1), b3 + hstep, voffB);
            PG8_WAIT_V(6); PG8_BAR; PG8_MMA(1, 1, At, B1); PG8_BAR;
            }
        }
        if constexpr (ALIGN_EPI) { if (wr == 0) PG8_BAR; }
        E(acc, cur, wr, wc, fr, fq); S.done(cur);
        if (!has_next) break;
#pragma unroll
        for (int a = 0; a < 2; ++a)
#pragma unroll
            for (int b = 0; b < 2; ++b)
#pragma unroll
                for (int m = 0; m < 4; ++m)
#pragma unroll
                    for (int n = 0; n < 2; ++n) acc[a][b][m][n] = (f32x4){0.f, 0.f, 0.f, 0.f};
        cur = nxt; cA = nA; cB = nB; ++ui;
        if constexpr (ALIGN_EPI) { if (wr == 1) PG8_BAR; }
    }
    PG8_WAIT_V(0);
    if constexpr (!ALIGN_EPI) { if (wr == 0) PG8_BAR; }
    PG8_BAR;
#undef PG8_SA
#undef PG8_SB
#undef PG8_STAGE
#undef PG8_LDA
#undef PG8_LDB
#undef PG8_MMA
#undef PG8_WAIT_V
#undef PG8_WAIT_L
#undef PG8_BAR
#undef PG8_SCHED
}
}

#define XB_TMO      128
#define XB_XCNT(j)  (256  + 64 * (j))
#define XB_XSUB(j)  (1280 + 64 * (j))
#define XB_XGEN(j)  (2304 + 64 * (j))
#define XB_TOP      3328
#define XB_TOPGEN   3392
#define XCD_BAR_WORDS 3456
#define XB_SPIN_CAP (1u << 18)

__device__ __forceinline__ unsigned xb_ld(unsigned* p)              { return __hip_atomic_load(p, __ATOMIC_RELAXED, __HIP_MEMORY_SCOPE_AGENT); }
__device__ __forceinline__ unsigned xb_add(unsigned* p, unsigned v) { return __hip_atomic_fetch_add(p, v, __ATOMIC_RELAXED, __HIP_MEMORY_SCOPE_AGENT); }
__device__ __forceinline__ unsigned xb_xcc_id() { return (unsigned)__builtin_amdgcn_s_getreg((3 << 11) | 20) & 0xFu; }
#define XB_SPIN(cond, bar) do { unsigned _sp = 0; while (cond) { __builtin_amdgcn_s_sleep(1); \
    if ((++_sp & 255u) == 0u) { if (xb_ld(&(bar)[XB_TMO])) break; if (_sp > XB_SPIN_CAP) { atomicAdd(&(bar)[XB_TMO], 1u); break; } } } } while (0)

struct XcdBarrier { unsigned* bar; unsigned x; volatile LAS unsigned* st; };

__device__ __forceinline__ XcdBarrier xcd_barrier_post(unsigned* bar, volatile LAS unsigned* st) {
    XcdBarrier b; b.bar = bar; b.x = xb_xcc_id(); b.st = st;
    if (threadIdx.x == 0) (void)xb_add(&bar[XB_XCNT(b.x)], 1u);
    return b;
}
__device__ __forceinline__ void xcd_barrier_complete(unsigned* bar, unsigned x, unsigned& nloc, unsigned& nx) {
    const unsigned G = gridDim.x * gridDim.y * gridDim.z;
    unsigned sum, cnt, mine, sp = 0u;
    for (;;) {
        sum = 0u; cnt = 0u; mine = 0u;
#pragma unroll
        for (unsigned j = 0; j < 16; ++j) { const unsigned c = xb_ld(&bar[XB_XCNT(j)]); sum += c; cnt += (c > 0u) ? 1u : 0u; mine = (j == x) ? c : mine; }
        if (sum == G) break;
        __builtin_amdgcn_s_sleep(1);
        if ((++sp & 255u) == 0u) { if (xb_ld(&bar[XB_TMO])) break; if (sp > XB_SPIN_CAP) { atomicAdd(&bar[XB_TMO], 1u); break; } }
    }
    nloc = mine > 0u ? mine : 1u; nx = cnt > 0u ? cnt : 1u;
}
__device__ __forceinline__ void xcd_barrier(const XcdBarrier& b) {
    asm volatile("s_waitcnt vmcnt(0)" ::: "memory");
    __syncthreads();
    if (threadIdx.x == 0) {
        unsigned* bar = b.bar;
        __builtin_amdgcn_s_waitcnt(0);
        unsigned nloc = b.st[0], nx = b.st[1];
        if (nloc == 0u) { xcd_barrier_complete(bar, b.x, nloc, nx); b.st[0] = nloc; b.st[1] = nx; }
        const unsigned old = xb_add(&bar[XB_XSUB(b.x)], 1u);
        const unsigned gen = old / nloc;
        if (old + 1u == (gen + 1u) * nloc) {
            __builtin_amdgcn_fence(__ATOMIC_RELEASE, "agent");
            asm volatile("s_waitcnt vmcnt(0)" ::: "memory");
            const unsigned og = xb_add(&bar[XB_TOP], 1u);
            const unsigned tg = og / nx;
            if (og + 1u == (tg + 1u) * nx) xb_add(&bar[XB_TOPGEN], 1u);
            else XB_SPIN(xb_ld(&bar[XB_TOPGEN]) == tg, bar);
            __builtin_amdgcn_fence(__ATOMIC_ACQUIRE, "agent");
            xb_add(&bar[XB_XGEN(b.x)], 1u);
            asm volatile("s_waitcnt vmcnt(0)" ::: "memory");
        } else {
            XB_SPIN(xb_ld(&bar[XB_XGEN(b.x)]) == gen, bar);
            __builtin_amdgcn_fence(__ATOMIC_ACQUIRE, "agent");
            asm volatile("s_waitcnt vmcnt(0)" ::: "memory");
        }
    }
    __syncthreads();
}

constexpr int NWAVES = 8;
constexpr int LDS_BYTES = 163840;
constexpr int LDSCTL_OFF = LDS_BYTES - 512, MISC_OFF = LDSCTL_OFF + 320;
constexpr int NPHASE = 2 + 6 * NLAYER;

#define LDS_WAIT() asm volatile("s_waitcnt lgkmcnt(0)" ::: "memory")

struct Args { const float* in[20]; float* out; unsigned char* ws; int ph_lo, ph_hi, li, pad; };

#define CAS __attribute__((address_space(4)))
struct Frame {
    LAS unsigned char* lds;
    int tid, lane, wave, G, gw, NGW;
    const CAS unsigned char* ka;
    __device__ __forceinline__ const float* x() const { return *(const float* const CAS*)(ka + 0); }
    __device__ __forceinline__ const float* c() const { return *(const float* const CAS*)(ka + 8); }
    __device__ __forceinline__ const float* ctx() const { return *(const float* const CAS*)(ka + 16); }
    __device__ __forceinline__ const float* c_ctx() const { return *(const float* const CAS*)(ka + 24); }
    __device__ __forceinline__ const float* w_ada() const { return *(const float* const CAS*)(ka + 32); }
    __device__ __forceinline__ const float* b_ada() const { return *(const float* const CAS*)(ka + 40); }
    __device__ __forceinline__ const float* w_in() const { return *(const float* const CAS*)(ka + 48); }
    __device__ __forceinline__ const float* conv_w() const { return *(const float* const CAS*)(ka + 56); }
    __device__ __forceinline__ const float* sink() const { return *(const float* const CAS*)(ka + 64); }
    __device__ __forceinline__ const float* g_attn() const { return *(const float* const CAS*)(ka + 72); }
    __device__ __forceinline__ const float* g_conv() const { return *(const float* const CAS*)(ka + 80); }
    __device__ __forceinline__ const float* w_out() const { return *(const float* const CAS*)(ka + 88); }
    __device__ __forceinline__ const float* ln1_g() const { return *(const float* const CAS*)(ka + 96); }
    __device__ __forceinline__ const float* ln1_b() const { return *(const float* const CAS*)(ka + 104); }
    __device__ __forceinline__ const float* wq() const { return *(const float* const CAS*)(ka + 112); }
    __device__ __forceinline__ const float* keys() const { return *(const float* const CAS*)(ka + 120); }
    __device__ __forceinline__ const float* pu() const { return *(const float* const CAS*)(ka + 128); }
    __device__ __forceinline__ const float* pv() const { return *(const float* const CAS*)(ka + 136); }
    __device__ __forceinline__ const float* ln2_g() const { return *(const float* const CAS*)(ka + 144); }
    __device__ __forceinline__ const float* ln2_b() const { return *(const float* const CAS*)(ka + 152); }
    __device__ __forceinline__ float* out() const { return *(float* const CAS*)(ka + 160); }
    __device__ __forceinline__ unsigned char* ws() const { return *(unsigned char* const CAS*)(ka + 168); }
    __device__ __forceinline__ float* MODS() const { return (float*)(ws() + WS_MODS); }
    __device__ __forceinline__ float* ROPE() const { return (float*)(ws() + WS_ROPE); }
    __device__ __forceinline__ bf16_t* X() const { return (bf16_t*)(ws() + WS_X); }
    __device__ __forceinline__ bf16_t* SC() const { return (bf16_t*)(ws() + WS_SC); }
    __device__ __forceinline__ bf16_t* KBD() const { return (bf16_t*)(ws() + WS_KBD); }
    __device__ __forceinline__ bf16_t* WQR() const { return (bf16_t*)(ws() + WS_WQR); }
    __device__ __forceinline__ bf16_t* WINT() const { return (bf16_t*)(ws() + WS_WINT); }
    __device__ __forceinline__ bf16_t* WOUTT() const { return (bf16_t*)(ws() + WS_WOUTT); }
    __device__ __forceinline__ bf16_t* WEFFT() const { return (bf16_t*)(ws() + WS_WEFFT); }
    __device__ __forceinline__ bf16_t* H() const { return (bf16_t*)(ws() + WS_H); }
    __device__ __forceinline__ bf16_t* PROJ() const { return (bf16_t*)(ws() + WS_PROJ); }
    __device__ __forceinline__ bf16_t* MIX() const { return (bf16_t*)(ws() + WS_MIX); }
    __device__ __forceinline__ unsigned char* UT() const { return (unsigned char*)(ws() + WS_UT); }
    __device__ __forceinline__ unsigned char* VT() const { return (unsigned char*)(ws() + WS_VT); }
    __device__ __forceinline__ float* US() const { return (float*)(ws() + WS_US); }
    __device__ __forceinline__ float* VS() const { return (float*)(ws() + WS_VS); }
};

__device__ __forceinline__ void frame_ids(Frame& F) {
    int tz = threadIdx.x; asm volatile("" : "+v"(tz));
    F.tid = tz; F.lane = tz & 63; F.wave = __builtin_amdgcn_readfirstlane(tz >> 6);
    F.gw = blockIdx.x * NWAVES + F.wave;
    const CAS unsigned char* k = (const CAS unsigned char*)__builtin_amdgcn_kernarg_segment_ptr(); asm volatile("" : "+s"(k)); F.ka = k;
}
template <int CTRL> __device__ __forceinline__ int dpp_i(int v) { return __builtin_amdgcn_update_dpp(0, v, CTRL, 0xf, 0xf, true); }
template <int CTRL> __device__ __forceinline__ float dpp_f(float v) { return __int_as_float(dpp_i<CTRL>(__float_as_int(v))); }
constexpr int DPP_XOR1 = 0xB1, DPP_XOR2 = 0x4E, DPP_HMIRROR = 0x141, DPP_ROR4 = 0x124, DPP_ROR8 = 0x128;
__device__ __forceinline__ float wave_sum_u(float v) {
    v += dpp_f<DPP_XOR1>(v); v += dpp_f<DPP_XOR2>(v); v += dpp_f<DPP_ROR4>(v); v += dpp_f<DPP_ROR8>(v);
    const float r0 = __int_as_float(__builtin_amdgcn_readlane(__float_as_int(v), 0)), r1 = __int_as_float(__builtin_amdgcn_readlane(__float_as_int(v), 16));
    const float r2 = __int_as_float(__builtin_amdgcn_readlane(__float_as_int(v), 32)), r3 = __int_as_float(__builtin_amdgcn_readlane(__float_as_int(v), 48));
    return (r0 + r1) + (r2 + r3);
}
__device__ __forceinline__ float wave_max_u(float v) {
    v = fmaxf(v, dpp_f<DPP_XOR1>(v)); v = fmaxf(v, dpp_f<DPP_XOR2>(v)); v = fmaxf(v, dpp_f<DPP_ROR4>(v)); v = fmaxf(v, dpp_f<DPP_ROR8>(v));
    const float r0 = __int_as_float(__builtin_amdgcn_readlane(__float_as_int(v), 0)), r1 = __int_as_float(__builtin_amdgcn_readlane(__float_as_int(v), 16));
    const float r2 = __int_as_float(__builtin_amdgcn_readlane(__float_as_int(v), 32)), r3 = __int_as_float(__builtin_amdgcn_readlane(__float_as_int(v), 48));
    return fmaxf(fmaxf(r0, r1), fmaxf(r2, r3));
}
__device__ __forceinline__ float xor32_f(float v, int lane) { return __int_as_float(__builtin_amdgcn_ds_bpermute((lane ^ 32) << 2, __float_as_int(v))); }
__device__ __forceinline__ float wave_sum(float v) { return wave_sum_u(v); }
__device__ __forceinline__ unsigned pk2(float lo, float hi) { return pg8::cvt_pk_bf16(lo, hi); }
__device__ __forceinline__ float bf_lo(unsigned u) { return __uint_as_float(u << 16); }
__device__ __forceinline__ float bf_hi(unsigned u) { return __uint_as_float(u & 0xffff0000u); }
__device__ __forceinline__ int modrow(int t) { return t < TL ? t / SEQ : 2; }

__device__ __forceinline__ void transpose_item(const float* W, int K, int N, bf16_t* WT, LAS float* scr, int item, int lane) {
    const int nblk = N / 32, kb = item / nblk, nb = item % nblk, k0 = 64 * kb, n0 = 32 * nb;
#pragma unroll 8
    for (int i = 0; i < 32; ++i) { const int kk = 2 * i + (lane >> 5); scr[kk * 33 + (lane & 31)] = W[(size_t)(k0 + kk) * N + n0 + (lane & 31)]; }
    LDS_WAIT(); asm volatile("" ::: "memory");
    const int c = lane & 7;
#pragma unroll
    for (int j = 0; j < 4; ++j) { const int n = (lane >> 3) + 8 * j; const LAS float* s = scr + (8 * c) * 33 + n;
        u32x4 o; o.x = pk2(s[0 * 33], s[1 * 33]); o.y = pk2(s[2 * 33], s[3 * 33]); o.z = pk2(s[4 * 33], s[5 * 33]); o.w = pk2(s[6 * 33], s[7 * 33]);
        *(u32x4*)(WT + (size_t)(n0 + n) * K + k0 + 8 * c) = o; }
    LDS_WAIT(); asm volatile("" ::: "memory");
}

__device__ __forceinline__ void cvt_row_bf16(const float* src, bf16_t* dst, int lane) {
    const f32x4* s = (const f32x4*)src + lane; u32x2* d = (u32x2*)dst + lane;
    f32x4 v[8];
#pragma unroll
    for (int j = 0; j < 8; ++j) v[j] = __builtin_nontemporal_load(s + 64 * j);
#pragma unroll
    for (int j = 0; j < 8; ++j) { u32x2 o; o.x = pk2(v[j].x, v[j].y); o.y = pk2(v[j].z, v[j].w); d[64 * j] = o; }
}

struct RowF32 { f32x4 v[4][2]; };
__device__ __forceinline__ void row_load_nt(RowF32& R, const float* src, int lane) {
    const f32x4* s = (const f32x4*)src + 2 * lane;
#pragma unroll
    for (int j = 0; j < 4; ++j) { R.v[j][0] = __builtin_nontemporal_load(s + 128 * j); R.v[j][1] = __builtin_nontemporal_load(s + 128 * j + 1); }
}
template <int FMT>
__device__ __forceinline__ void cvt_row_lp(const RowF32& R, unsigned char* dst, float* inv, int lane) {
    constexpr float QMAX = FMT == 8 ? 224.f : 6.f;
    float am = 0.f;
#pragma unroll
    for (int j = 0; j < 4; ++j)
#pragma unroll
        for (int q = 0; q < 2; ++q) am = fmaxf(fmaxf(am, fmaxf(fabsf(R.v[j][q].x), fabsf(R.v[j][q].y))), fmaxf(fabsf(R.v[j][q].z), fabsf(R.v[j][q].w)));
    am = wave_max_u(am);
    const float sc = am > 0.f ? QMAX / am : 1.f;
#pragma unroll
    for (int j = 0; j < 4; ++j) {
        if constexpr (FMT == 8) {
            u32x2 w;
#pragma unroll
            for (int q = 0; q < 2; ++q) { int t = __builtin_amdgcn_cvt_pk_fp8_f32(R.v[j][q].x * sc, R.v[j][q].y * sc, 0, false); t = __builtin_amdgcn_cvt_pk_fp8_f32(R.v[j][q].z * sc, R.v[j][q].w * sc, t, true); w[q] = (unsigned)t; }
            *((u32x2*)dst + lane + 64 * j) = w;
        } else {
            unsigned w = 0u;
            w = __builtin_amdgcn_cvt_scalef32_pk_fp4_f32(w, R.v[j][0].x * sc, R.v[j][0].y * sc, 1.0f, 0);
            w = __builtin_amdgcn_cvt_scalef32_pk_fp4_f32(w, R.v[j][0].z * sc, R.v[j][0].w * sc, 1.0f, 1);
            w = __builtin_amdgcn_cvt_scalef32_pk_fp4_f32(w, R.v[j][1].x * sc, R.v[j][1].y * sc, 1.0f, 2);
            w = __builtin_amdgcn_cvt_scalef32_pk_fp4_f32(w, R.v[j][1].z * sc, R.v[j][1].w * sc, 1.0f, 3);
            *((unsigned*)dst + lane + 64 * j) = w;
        }
    }
    if (lane == 0) *inv = am > 0.f ? am * (1.f / QMAX) : 1.f;
}
template <int FMT> struct LpRow;
template <> struct LpRow<8> { u32x4 a, b;
    __device__ __forceinline__ void load(const unsigned char* rowp, int lane) { a = *(const u32x4*)(rowp + 32 * lane); b = *(const u32x4*)(rowp + 32 * lane + 16); }
    template <class Fn> __device__ __forceinline__ void each(Fn&& f) const {
#pragma unroll
        for (int w = 0; w < 4; ++w) { const f32x2 l0 = __builtin_amdgcn_cvt_pk_f32_fp8((int)a[w], false), h0 = __builtin_amdgcn_cvt_pk_f32_fp8((int)a[w], true);
            f(4 * w, l0.x, l0.y); f(4 * w + 2, h0.x, h0.y); }
#pragma unroll
        for (int w = 0; w < 4; ++w) { const f32x2 l0 = __builtin_amdgcn_cvt_pk_f32_fp8((int)b[w], false), h0 = __builtin_amdgcn_cvt_pk_f32_fp8((int)b[w], true);
            f(16 + 4 * w, l0.x, l0.y); f(16 + 4 * w + 2, h0.x, h0.y); }
    } };
template <> struct LpRow<4> { u32x4 a;
    __device__ __forceinline__ void load(const unsigned char* rowp, int lane) { a = *(const u32x4*)(rowp + 16 * lane); }
    template <class Fn> __device__ __forceinline__ void each(Fn&& f) const {
#pragma unroll
        for (int w = 0; w < 4; ++w) {
            const f32x2 d0 = __builtin_amdgcn_cvt_scalef32_pk_f32_fp4(a[w], 1.0f, 0), d1 = __builtin_amdgcn_cvt_scalef32_pk_f32_fp4(a[w], 1.0f, 1);
            const f32x2 d2 = __builtin_amdgcn_cvt_scalef32_pk_f32_fp4(a[w], 1.0f, 2), d3 = __builtin_amdgcn_cvt_scalef32_pk_f32_fp4(a[w], 1.0f, 3);
            f(8 * w, d0.x, d0.y); f(8 * w + 2, d1.x, d1.y); f(8 * w + 4, d2.x, d2.y); f(8 * w + 6, d3.x, d3.y); }
    }
    template <class Fn> __device__ __forceinline__ void each_bf(Fn&& f) const {
#pragma unroll
        for (int w = 0; w < 4; ++w) {
            f(4 * w, __builtin_amdgcn_cvt_scalef32_pk_bf16_fp4(a[w], 1.0f, 0)); f(4 * w + 1, __builtin_amdgcn_cvt_scalef32_pk_bf16_fp4(a[w], 1.0f, 1));
            f(4 * w + 2, __builtin_amdgcn_cvt_scalef32_pk_bf16_fp4(a[w], 1.0f, 2)); f(4 * w + 3, __builtin_amdgcn_cvt_scalef32_pk_bf16_fp4(a[w], 1.0f, 3)); }
    } };

__device__ __forceinline__ void row_stats(const f32x4 (&v)[8], float& mean, float& rstd) {
    float s = 0.f;
#pragma unroll
    for (int j = 0; j < 8; ++j) s += (v[j].x + v[j].y) + (v[j].z + v[j].w);
    mean = wave_sum(s) * (1.f / D);
    float s2 = 0.f;
#pragma unroll
    for (int j = 0; j < 8; ++j) { const f32x4 d = v[j] - mean; s2 += (d.x * d.x + d.y * d.y) + (d.z * d.z + d.w * d.w); }
    rstd = 1.f / sqrtf(wave_sum(s2) * (1.f / D) + LN_EPS);
}
__device__ __forceinline__ void modulate_store(const f32x4 (&v)[8], const float* shift, const float* scale, bf16_t* dst, int lane) {
    float mean, rstd; row_stats(v, mean, rstd);
    u32x2* d = (u32x2*)dst + lane;
#pragma unroll
    for (int j = 0; j < 8; ++j) { const f32x4 sc = *((const f32x4*)scale + lane + 64 * j), sh = *((const f32x4*)shift + lane + 64 * j);
        const f32x4 y = (v[j] - mean) * rstd * (sc + 1.f) + sh;
        u32x2 o; o.x = pk2(y.x, y.y); o.y = pk2(y.z, y.w); d[64 * j] = o; }
}

__device__ __forceinline__ void convert_tables(Frame& F, int row0, int row1, int w0, int wstride) {
    RowF32 ru, rv, nu, nv;
    int row = row0 + w0;
    if (row < row1) { row_load_nt(ru, F.pu() + (size_t)row * D, F.lane); row_load_nt(rv, F.pv() + (size_t)row * D, F.lane); }
    while (row < row1) {
        const int nrow = row + wstride;
        if (nrow < row1) { row_load_nt(nu, F.pu() + (size_t)nrow * D, F.lane); row_load_nt(nv, F.pv() + (size_t)nrow * D, F.lane); }
        cvt_row_lp<U_FMT>(ru, F.UT() + (size_t)row * UROW, F.US() + 2 * (size_t)row, F.lane);
        cvt_row_lp<V_FMT>(rv, F.VT() + (size_t)row * VROW, F.US() + 2 * (size_t)row + 1, F.lane);
        ru = nu; rv = nv; row = nrow;
    }
}
__device__ __forceinline__ void convert_in_tail(Frame& F, int layer, int nunits, int part) {
    if (layer + 1 >= NLAYER) return;
    const int G = F.G, rounds = (nunits + G - 1) / G, nlast = nunits - (rounds - 1) * G;
    const int c = (int)blockIdx.x;
    int nshort = G - nlast, sidx = c - nlast;
    if (nshort <= 0) { nshort = G; sidx = c; }
    else if (sidx < 0) return;
    const int r0 = (layer + 1) * NEXP + part * (NEXP / 2);
    convert_tables(F, r0, r0 + NEXP / 2, sidx * NWAVES + F.wave, nshort * NWAVES);
}
__device__ __forceinline__ void p0a_prologue(Frame& F) {
    LAS float* condL = (LAS float*)F.lds;
    LAS float* red = (LAS float*)(F.lds + 24576);
    for (int i = F.tid; i < 3 * D; i += NWAVES * 64) { const int r = i / D, k = i % D; const float v = r < 2 ? F.c()[r * D + k] : F.c_ctx()[k]; condL[i] = v / (1.f + __expf(-v)); }
    __syncthreads();
    for (int item = blockIdx.x; item < 384; item += F.G) {
        const int l = item / 96, n0 = (item % 96) * 128;
        const float* wp = F.w_ada() + ((size_t)l * D + F.wave * 256) * 12288 + n0 + 2 * F.lane;
        f32x2 a0 = {0.f, 0.f}, a1 = {0.f, 0.f}, a2 = {0.f, 0.f};
#pragma unroll 8
        for (int k = 0; k < 256; ++k) { const f32x2 w = __builtin_nontemporal_load((const f32x2*)(wp + (size_t)k * 12288)); const int kk = F.wave * 256 + k;
            a0 += w * condL[kk]; a1 += w * condL[D + kk]; a2 += w * condL[2 * D + kk]; }
        LAS float* rp = red + F.wave * 384 + 2 * F.lane;
        rp[0] = a0.x; rp[1] = a0.y; rp[128] = a1.x; rp[129] = a1.y; rp[256] = a2.x; rp[257] = a2.y;
        __syncthreads();
        if (F.tid < 384) { const int r = F.tid / 128, n = F.tid % 128; float s = 0.f;
#pragma unroll
            for (int w = 0; w < 8; ++w) s += red[w * 384 + r * 128 + n];
            F.MODS()[((size_t)l * 3 + r) * 12288 + n0 + n] = s + F.b_ada()[(size_t)l * 12288 + n0 + n]; }
        __syncthreads();
    }
    LAS float* scr = (LAS float*)(F.lds + 40960 + F.wave * 8448);
    constexpr int I_IN = (D / 64) * (INC / 32), I_OUT = (D / 64) * (D / 32);
    for (int it = F.gw; it < NLAYER * (I_IN + I_OUT); it += F.NGW) {
        const int l = it / (I_IN + I_OUT); int r = it % (I_IN + I_OUT);
        if (r < I_IN) transpose_item(F.w_in() + (size_t)l * D * INC, D, INC, F.WINT() + (size_t)l * INC * D, scr, r, F.lane);
        else transpose_item(F.w_out() + (size_t)l * D * D, D, D, F.WOUTT() + (size_t)l * D * D, scr, r - I_IN, F.lane);
    }
    for (int row = F.gw; row < NLAYER * D; row += F.NGW) {
        const int l = row / D, c = row % D; const f32x4* s = (const f32x4*)(F.wq() + (size_t)row * D) + F.lane;
#pragma unroll
        for (int j = 0; j < 8; ++j) { const f32x4 v = s[64 * j]; u32x2 o; o.x = pk2(v.x, v.y); o.y = pk2(v.z, v.w);
            *((u32x2*)(F.WQR() + ((size_t)(l * 8 + j) * D + c) * 256) + F.lane) = o; }
    }
    for (int row = F.gw; row < 32 * 256; row += F.NGW) {
        const int lh = row >> 8, pk = row & 255, p = pk >> 7;
        u32x2 o = {0u, 0u};
        if ((F.lane >> 5) == p) { const f32x4 v = *((const f32x4*)(F.keys() + ((size_t)lh * 256 + pk) * 128) + (F.lane & 31)); o.x = pk2(v.x, v.y); o.y = pk2(v.z, v.w); }
        *((u32x2*)(F.KBD() + (size_t)row * 256) + F.lane) = o;
    }
    convert_tables(F, 0, NEXP, F.gw, F.NGW);
    for (int i = blockIdx.x * (NWAVES * 64) + F.tid; i < 192 * 32; i += F.G * NWAVES * 64) {
        const int idx = i >> 5, f = i & 31; const float pos = (float)(idx < 128 ? idx : idx - 128);
        const float inv = powf(10000.f, -(float)(2 * f) / 64.f); const float ang = pos * inv;
        F.ROPE()[2 * i] = cosf(ang); F.ROPE()[2 * i + 1] = sinf(ang);
    }
}

__device__ __forceinline__ void p0b_mod0(Frame& F) {
    __syncthreads();
#pragma unroll 1
    for (int v = 0; v < 6; ++v)
        *(LAS f32x4*)(F.lds + v * 8192 + F.tid * 16) = *(const f32x4*)(F.MODS() + (size_t)(v % 3) * 12288 + (v < 3 ? 0 : D) + 4 * F.tid);
    __syncthreads();
    for (int t = F.gw; t < TT; t += F.NGW) {
        const float* src = t < TL ? F.x() + (size_t)t * D : F.ctx() + (size_t)(t - TL) * D;
        f32x4 v[8];
#pragma unroll
        for (int j = 0; j < 8; ++j) v[j] = *((const f32x4*)src + F.lane + 64 * j);
        const int mr = modrow(t);
        float mean, rstd; row_stats(v, mean, rstd);
        u32x2* d = (u32x2*)(F.H() + (size_t)t * D) + F.lane;
#pragma unroll
        for (int j = 0; j < 8; ++j) { const f32x4 sh = *(const LAS f32x4*)(F.lds + mr * 8192 + (64 * j + F.lane) * 16), sc = *(const LAS f32x4*)(F.lds + (3 + mr) * 8192 + (64 * j + F.lane) * 16);
            const f32x4 y = (v[j] - mean) * rstd * (sc + 1.f) + sh;
            u32x2 o; o.x = pk2(y.x, y.y); o.y = pk2(y.z, y.w); d[64 * j] = o; }
    }
}

constexpr int CONV_LDS = 81920;
constexpr int KP = 272, VP = 320, KS_BYTES = 64 * KP, VS_BYTES = 64 * VP;
struct KVRegs { u32x4 k1, k2, v1, v2; f32x4 cs[4]; };

__device__ __forceinline__ void attn_load_tile(Frame& F, KVRegs& R, int ti, int b, int n, int g) {
    const int key = F.tid >> 3, c8 = F.tid & 7;
    int row, pos = 0;
    if (ti < 6) { pos = (n - 1) * 128 + 64 * ti + key; row = b * SEQ + pos; } else row = TL + b * CTXL + 64 * (ti - 6) + key;
    const bf16_t* base = F.PROJ() + (size_t)row * INC;
    const int d1 = (c8 >> 2) * 64 + (c8 & 3) * 8;
    R.k1 = *(const u32x4*)(base + OFF_K + g * 128 + d1); R.k2 = *(const u32x4*)(base + OFF_K + g * 128 + d1 + 32);
    R.v1 = *(const u32x4*)(base + OFF_V + g * 128 + 8 * c8); R.v2 = *(const u32x4*)(base + OFF_V + g * 128 + 64 + 8 * c8);
    if (ti < 6) { const int tidx = (c8 >> 2) ? 128 + (pos & 63) : (pos >> 6); const f32x4* cp = (const f32x4*)(F.ROPE() + ((size_t)tidx * 32 + (c8 & 3) * 8) * 2);
#pragma unroll
        for (int m = 0; m < 4; ++m) R.cs[m] = cp[m]; }
}
__device__ __forceinline__ void rope8(u32x4& a, u32x4& bq, const f32x4 (&cs)[4], float scale) {
    u32x4 oa, ob;
#pragma unroll
    for (int w = 0; w < 4; ++w) {
        const float x1l = bf_lo(a[w]), x1h = bf_hi(a[w]), x2l = bf_lo(bq[w]), x2h = bf_hi(bq[w]);
        const float cl = cs[w].x, sl = cs[w].y, ch = cs[w].z, sh = cs[w].w;
        oa[w] = pk2((x1l * cl - x2l * sl) * scale, (x1h * ch - x2h * sh) * scale);
        ob[w] = pk2((x2l * cl + x1l * sl) * scale, (x2h * ch + x1h * sh) * scale);
    }
    a = oa; bq = ob;
}
__device__ __forceinline__ void attn_store_tile(Frame& F, KVRegs& R, int ti, int buf) {
    const int key = F.tid >> 3, c8 = F.tid & 7;
    if (ti < 6) rope8(R.k1, R.k2, R.cs, 1.f);
    const int d1 = (c8 >> 2) * 64 + (c8 & 3) * 8;
    LAS unsigned char* kp = F.lds + buf * KS_BYTES + key * KP;
    *(LAS u32x4*)(kp + d1 * 2) = R.k1; *(LAS u32x4*)(kp + (d1 + 32) * 2) = R.k2;
    LAS unsigned char* vp = F.lds + 2 * KS_BYTES + buf * VS_BYTES + key * VP;
    *(LAS u32x4*)(vp + 16 * c8) = R.v1; *(LAS u32x4*)(vp + 128 + 16 * c8) = R.v2;
}

#define MFMA32(a, b, c) __builtin_amdgcn_mfma_f32_32x32x16_bf16((a), (b), (c), 0, 0, 0)

__device__ __forceinline__ void attn_unit(Frame& F, int layer, int u) {
    const bool latent = u < 512;
    int b, n, g, hp;
    if (latent) { hp = u & 1; g = (u >> 1) & 1; n = (u >> 2) & 63; b = u >> 8; }
    else { const int v = u - 512; hp = v & 1; g = (v >> 1) & 1; n = (v >> 2) & 1; b = v >> 3; }
    const int lane = F.lane, r = lane & 31, h = lane >> 5, wave = F.wave;
    const int head = g * 4 + hp * 2 + (wave >> 2), qb = wave & 3;
    const int tq = latent ? b * SEQ + n * 128 + 32 * qb + r : TL + b * CTXL + n * 128 + 32 * qb + r;
    bf16x8 qf[8];
    {
        u32x4 raw[8];
        const bf16_t* qp = F.PROJ() + (size_t)tq * INC + OFF_Q + head * 128 + 8 * h;
#pragma unroll
        for (int ks = 0; ks < 8; ++ks) raw[ks] = *(const u32x4*)(qp + 16 * ks);
        if (latent) {
            const int pos = n * 128 + 32 * qb + r;
#pragma unroll
            for (int half = 0; half < 2; ++half) {
                const int tidx = half ? 128 + (pos & 63) : (pos >> 6);
#pragma unroll
                for (int kk = 0; kk < 2; ++kk) {
                    const f32x4* cp = (const f32x4*)(F.ROPE() + ((size_t)tidx * 32 + 16 * kk + 8 * h) * 2);
                    f32x4 cs[4];
#pragma unroll
                    for (int m = 0; m < 4; ++m) cs[m] = cp[m];
                    rope8(raw[4 * half + kk], raw[4 * half + kk + 2], cs, QSCALE);
                }
            }
        } else {
#pragma unroll
            for (int ks = 0; ks < 8; ++ks)
#pragma unroll
                for (int w = 0; w < 4; ++w) raw[ks][w] = pk2(bf_lo(raw[ks][w]) * QSCALE, bf_hi(raw[ks][w]) * QSCALE);
        }
#pragma unroll
        for (int ks = 0; ks < 8; ++ks) qf[ks] = __builtin_bit_cast(bf16x8, raw[ks]);
    }
    int tlo = 6, nw = 0;
    if (latent) { tlo = (n == 0) ? 2 : 0; const int thi = (n == 63) ? 3 : 5; nw = thi - tlo + 1; }
    const int ntiles = nw + 4;
    f32x16 o[4];
#pragma unroll
    for (int db = 0; db < 4; ++db)
#pragma unroll
        for (int i = 0; i < 16; ++i) o[db][i] = 0.f;
    float m_run = F.sink()[layer * 8 + head] * LOG2E;
    float lsum = h == 0 ? 1.f : 0.f;
    const int iq = 32 * qb + r;
    KVRegs R;
    __syncthreads();
    attn_load_tile(F, R, nw > 0 ? tlo : 6, b, n, g);
    attn_store_tile(F, R, nw > 0 ? tlo : 6, 0);
    __syncthreads();
    const int i16 = lane & 15, tq4 = i16 >> 2, tp = i16 & 3, blk = (lane >> 4) & 1;
    for (int j = 0; j < ntiles; ++j) {
        const int ti = j < nw ? tlo + j : 6 + (j - nw);
        const int buf = j & 1;
        const bool more = j + 1 < ntiles;
        const int tin = (j + 1) < nw ? tlo + j + 1 : 6 + (j + 1 - nw);
        if (more) attn_load_tile(F, R, tin, b, n, g);
        const bool part = ti >= 6 || (ti >= (qb >> 1) && ti <= (qb >> 1) + 4);
        if (part) {
            f32x16 s0, s1;
#pragma unroll
            for (int i = 0; i < 16; ++i) { s0[i] = 0.f; s1[i] = 0.f; }
            const LAS unsigned char* kb = F.lds + buf * KS_BYTES + r * KP + h * 16;
#pragma unroll
            for (int ks = 0; ks < 8; ++ks) {
                const bf16x8 a0 = *(const LAS bf16x8*)(kb + ks * 32), a1 = *(const LAS bf16x8*)(kb + 32 * KP + ks * 32);
                s0 = MFMA32(a0, qf[ks], s0); s1 = MFMA32(a1, qf[ks], s1);
            }
            float mx = -INFINITY;
            if (ti < 6 && (ti == (qb >> 1) || ti == (qb >> 1) + 4)) {
                const int jb = 64 * ti + 4 * h - iq;
#pragma unroll
                for (int i = 0; i < 16; ++i) { const int j0 = jb + (i & 3) + 8 * (i >> 2), j1 = j0 + 32;
                    s0[i] = (j0 >= 0 && j0 <= 256) ? s0[i] : -INFINITY; s1[i] = (j1 >= 0 && j1 <= 256) ? s1[i] : -INFINITY; }
            }
#pragma unroll
            for (int i = 0; i < 16; ++i) mx = fmaxf(mx, fmaxf(s0[i], s1[i]));
            mx = fmaxf(mx, xor32_f(mx, lane));
            if (__any(mx > m_run + 8.f)) {
                const float m_new = mx > m_run + 8.f ? mx : m_run, alpha = __builtin_amdgcn_exp2f(m_run - m_new);
                m_run = m_new; lsum *= alpha;
#pragma unroll
                for (int db = 0; db < 4; ++db)
#pragma unroll
                    for (int i = 0; i < 16; ++i) o[db][i] *= alpha;
            }
#pragma unroll
            for (int i = 0; i < 16; ++i) { s0[i] = __builtin_amdgcn_exp2f(s0[i] - m_run); s1[i] = __builtin_amdgcn_exp2f(s1[i] - m_run); lsum += s0[i] + s1[i]; }
            bf16x8 pf[2][2];
#pragma unroll
            for (int s2 = 0; s2 < 2; ++s2) {
                u32x4 p0, p1;
#pragma unroll
                for (int w = 0; w < 4; ++w) { p0[w] = pk2(s0[8 * s2 + 2 * w], s0[8 * s2 + 2 * w + 1]); p1[w] = pk2(s1[8 * s2 + 2 * w], s1[8 * s2 + 2 * w + 1]); }
                pf[0][s2] = __builtin_bit_cast(bf16x8, p0); pf[1][s2] = __builtin_bit_cast(bf16x8, p1);
            }
            const LAS unsigned char* vb = F.lds + 2 * KS_BYTES + buf * VS_BYTES + (4 * h + tq4) * VP + 32 * blk + 8 * tp;
#pragma unroll
            for (int db = 0; db < 4; ++db)
#pragma unroll
                for (int kb2 = 0; kb2 < 2; ++kb2)
#pragma unroll
                    for (int s2 = 0; s2 < 2; ++s2) {
                        const int off = (32 * kb2 + 16 * s2) * VP + db * 64;
                        const s16x4 lo = __builtin_amdgcn_ds_read_tr16_b64_v4i16((LAS s16x4*)(vb + off));
                        const s16x4 hi = __builtin_amdgcn_ds_read_tr16_b64_v4i16((LAS s16x4*)(vb + off + 8 * VP));
                        const bf16x8 av = __builtin_shufflevector(lo, hi, 0, 1, 2, 3, 4, 5, 6, 7);
                        o[db] = MFMA32(av, pf[kb2][s2], o[db]);
                    }
        }
        if (more) attn_store_tile(F, R, tin, buf ^ 1);
        __syncthreads();
    }
    const float lt = lsum + xor32_f(lsum, lane);
    const float inv = 1.f / lt;
    float ss = 0.f;
#pragma unroll
    for (int db = 0; db < 4; ++db)
#pragma unroll
        for (int i = 0; i < 16; ++i) { o[db][i] *= inv; ss += o[db][i] * o[db][i]; }
    ss += xor32_f(ss, lane);
    const float rn = 1.f / sqrtf(ss * (1.f / 128.f) + LN_EPS);
    bf16_t* op = F.MIX() + (size_t)tq * D + head * 128 + 4 * h;
    const float* gp = F.g_attn() + layer * 1024 + head * 128 + 4 * h;
#pragma unroll
    for (int db = 0; db < 4; ++db)
#pragma unroll
        for (int g4 = 0; g4 < 4; ++g4) {
            const f32x4 gv = *(const f32x4*)(gp + 32 * db + 8 * g4);
            u32x2 w; w.x = pk2(o[db][4 * g4] * rn * gv.x, o[db][4 * g4 + 1] * rn * gv.y); w.y = pk2(o[db][4 * g4 + 2] * rn * gv.z, o[db][4 * g4 + 3] * rn * gv.w);
            *(u32x2*)(op + 32 * db + 8 * g4) = w;
        }
}

__device__ __forceinline__ void unpack8(const u32x4 v, float (&f)[8]) {
#pragma unroll
    for (int w = 0; w < 4; ++w) { f[2 * w] = bf_lo(v[w]); f[2 * w + 1] = bf_hi(v[w]); }
}
__device__ __forceinline__ void conv_row(Frame& F, int layer, int t) {
    bool first, last;
    if (t < TL) { const int pos = t & (SEQ - 1); first = pos == 0; last = pos == SEQ - 1; } else { const int pc = (t - TL) & (CTXL - 1); first = pc == 0; last = pc == CTXL - 1; }
    const bf16_t* p = F.PROJ() + (size_t)t * INC;
    const LAS unsigned char* cvc = F.lds + CONV_LDS + F.lane * 16;
#pragma unroll
    for (int jc = 0; jc < 2; ++jc) {
        const int c = 8 * F.lane + 512 * jc;
        float gb[8], a[8], bq[8], um[8], ut[8], up[8];
        unpack8(*(const u32x4*)(p + c), gb);
        unpack8(*(const u32x4*)(p + OFF_C + c), a); unpack8(*(const u32x4*)(p + OFF_X + c), bq);
#pragma unroll
        for (int e = 0; e < 8; ++e) ut[e] = a[e] * bq[e];
        if (!first) { unpack8(*(const u32x4*)(p - INC + OFF_C + c), a); unpack8(*(const u32x4*)(p - INC + OFF_X + c), bq);
#pragma unroll
            for (int e = 0; e < 8; ++e) um[e] = a[e] * bq[e]; }
        else {
#pragma unroll
            for (int e = 0; e < 8; ++e) um[e] = 0.f; }
        if (!last) { unpack8(*(const u32x4*)(p + INC + OFF_C + c), a); unpack8(*(const u32x4*)(p + INC + OFF_X + c), bq);
#pragma unroll
            for (int e = 0; e < 8; ++e) up[e] = a[e] * bq[e]; }
        else {
#pragma unroll
            for (int e = 0; e < 8; ++e) up[e] = 0.f; }
        float y[8], ss = 0.f;
#pragma unroll
        for (int q = 0; q < 2; ++q) { const f32x4 w0 = *(const LAS f32x4*)(cvc + (2 * jc + q) * 1024), w1 = *(const LAS f32x4*)(cvc + 4096 + (2 * jc + q) * 1024), w2 = *(const LAS f32x4*)(cvc + 8192 + (2 * jc + q) * 1024);
#pragma unroll
            for (int e = 0; e < 4; ++e) { const int i = 4 * q + e; y[i] = gb[i] * (w0[e] * um[i] + w1[e] * ut[i] + w2[e] * up[i]); ss += y[i] * y[i]; } }
        ss += dpp_f<DPP_XOR1>(ss); ss += dpp_f<DPP_XOR2>(ss); ss += dpp_f<DPP_ROR4>(ss); ss += dpp_f<DPP_ROR8>(ss);
        const float rn = 1.f / sqrtf(ss * (1.f / 128.f) + LN_EPS);
        u32x4 w;
#pragma unroll
        for (int q = 0; q < 2; ++q) { const f32x4 gcv = *(const LAS f32x4*)(cvc + 12288 + (2 * jc + q) * 1024); w[2 * q] = pk2(y[4 * q] * rn * gcv[0], y[4 * q + 1] * rn * gcv[1]); w[2 * q + 1] = pk2(y[4 * q + 2] * rn * gcv[2], y[4 * q + 3] * rn * gcv[3]); }
        *(u32x4*)(F.MIX() + (size_t)t * D + 1024 + c) = w;
    }
}

__device__ __forceinline__ void ln_phase(Frame& F, int layer, int rows) {
    const int lane = F.lane;
    u32x4 w[4], wn[4];
    int t = F.gw;
    if (t < rows) {
#pragma unroll
        for (int j = 0; j < 4; ++j) w[j] = *(const u32x4*)(F.X() + (size_t)t * D + 8 * lane + 512 * j);
    }
    {
        const int ch = F.tid, jj = ch >> 7, rem = ch & 127, ll = rem >> 1, qq = rem & 1;
        LAS unsigned char* dst = F.lds + ((2 * jj + qq) * 64 + ll) * 16;
        *(LAS f32x4*)(dst) = *(const f32x4*)(F.ln1_g() + layer * D + 4 * ch);
        *(LAS f32x4*)(dst + 8192) = *(const f32x4*)(F.ln1_b() + layer * D + 4 * ch);
#pragma unroll 1
        for (int v = 0; v < 6; ++v) { const int mrv = v % 3; const size_t off = ((size_t)layer * 3 + mrv) * 12288 + (v < 3 ? 3 * D : 4 * D);
            *(LAS f32x4*)(dst + (2 + v) * 8192) = *(const f32x4*)(F.MODS() + off + 4 * ch); }
    }
    __syncthreads();
    const LAS unsigned char* vc = F.lds + lane * 16;
    while (t < rows) {
        const int tn = t + F.NGW;
        if (tn < rows) {
#pragma unroll
            for (int j = 0; j < 4; ++j) wn[j] = *(const u32x4*)(F.X() + (size_t)tn * D + 8 * lane + 512 * j);
        }
        float v[32]; float s = 0.f;
#pragma unroll
        for (int j = 0; j < 4; ++j)
#pragma unroll
            for (int q = 0; q < 4; ++q) { v[8 * j + 2 * q] = bf_lo(w[j][q]); v[8 * j + 2 * q + 1] = bf_hi(w[j][q]); s += v[8 * j + 2 * q] + v[8 * j + 2 * q + 1]; }
        const float mean = wave_sum(s) * (1.f / D);
        float s2 = 0.f;
#pragma unroll
        for (int i = 0; i < 32; ++i) { v[i] -= mean; s2 += v[i] * v[i]; }
        const float rstd = 1.f / sqrtf(wave_sum(s2) * (1.f / D) + LN_EPS);
        float s3 = 0.f;
#pragma unroll
        for (int j = 0; j < 4; ++j) { const int c = 8 * lane + 512 * j; u32x4 o;
#pragma unroll
            for (int q = 0; q < 2; ++q) { const f32x4 gg = *(const LAS f32x4*)(vc + (2 * j + q) * 1024), bb = *(const LAS f32x4*)(vc + 8192 + (2 * j + q) * 1024);
#pragma unroll
                for (int e = 0; e < 4; ++e) { const float y = v[8 * j + 4 * q + e] * rstd * gg[e] + bb[e]; v[8 * j + 4 * q + e] = y; s3 += y; }
                o[2 * q] = pk2(v[8 * j + 4 * q], v[8 * j + 4 * q + 1]); o[2 * q + 1] = pk2(v[8 * j + 4 * q + 2], v[8 * j + 4 * q + 3]); }
            *(u32x4*)(F.X() + (size_t)t * D + c) = o; }
        const float mean2 = wave_sum(s3) * (1.f / D);
        float s4 = 0.f;
#pragma unroll
        for (int i = 0; i < 32; ++i) { v[i] -= mean2; s4 += v[i] * v[i]; }
        const float rstd2 = 1.f / sqrtf(wave_sum(s4) * (1.f / D) + LN_EPS);
        const int mrl = modrow(t);
#pragma unroll
        for (int j = 0; j < 4; ++j) { const int c = 8 * lane + 512 * j; u32x4 o;
#pragma unroll
            for (int q = 0; q < 2; ++q) { const f32x4 sh = *(const LAS f32x4*)(vc + (2 + mrl) * 8192 + (2 * j + q) * 1024), sc = *(const LAS f32x4*)(vc + (5 + mrl) * 8192 + (2 * j + q) * 1024);
                const float y0 = v[8 * j + 4 * q] * rstd2 * (1.f + sc[0]) + sh[0], y1 = v[8 * j + 4 * q + 1] * rstd2 * (1.f + sc[1]) + sh[1];
                const float y2 = v[8 * j + 4 * q + 2] * rstd2 * (1.f + sc[2]) + sh[2], y3 = v[8 * j + 4 * q + 3] * rstd2 * (1.f + sc[3]) + sh[3];
                o[2 * q] = pk2(y0, y1); o[2 * q + 1] = pk2(y2, y3); }
            *(u32x4*)(F.H() + (size_t)t * D + c) = o; }
#pragma unroll
        for (int j = 0; j < 4; ++j) w[j] = wn[j];
        t = tn;
    }
}

__device__ __forceinline__ unsigned ordkey(float f) { const unsigned u = __float_as_uint(f); return u ^ ((u >> 31) ? 0xFFFFFFFFu : 0x80000000u); }
__device__ __forceinline__ float gelu_erf(float a) { return 0.5f * a * (1.f + erff(a * 0.70710678118654752f)); }

__device__ __forceinline__ float unordkey(unsigned k) { return __uint_as_float(k ^ ((k >> 31) ? 0x80000000u : 0xFFFFFFFFu)); }
__device__ __forceinline__ float gelu_as(float v) {
    const float av = fabsf(v), t = __builtin_amdgcn_rcpf(av * 0.2316418882f + 1.0f);
    float q = t * 0.5307027145f + (-0.7265760135f); q = q * t + 0.7107068705f; q = q * t + (-0.142248368f); q = q * t + 0.127414796f; q = q * t;
    const float e = __builtin_amdgcn_exp2f((v * v) * (-0.72134752044f));
    const float m = v * (q * e);
    return v < 0.f ? m : v - m;
}

template <class O> struct QuadNet {
    typedef typename O::V V; typedef typename O::B B;
    template <bool ASC> static __device__ __forceinline__ void ce_reg(V& a, V& b) { const V lo = O::vmin(a, b), hi = O::vmax(a, b); a = ASC ? lo : hi; b = ASC ? hi : lo; }
    template <bool ASC> static __device__ __forceinline__ void ce_l1(V& x, B low1) { const V p = O::x1(x); const V mn = O::vmin(p, x), mx = O::vmax(p, x); x = ASC ? O::vsel(low1, mn, mx) : O::vsel(low1, mx, mn); }
    template <bool ASC> static __device__ __forceinline__ void ce_l2(V& x, B low2) { const V p = O::x2(x); const V mn = O::vmin(p, x), mx = O::vmax(p, x); x = ASC ? O::vsel(low2, mn, mx) : O::vsel(low2, mx, mn); }
    template <int NR> static __device__ __forceinline__ void sort_blocks(V (&R)[NR], B low1, B low2, B eq12) {
#pragma unroll
        for (int r = 0; r < NR; ++r) { const V p = O::x1(R[r]); const V mn = O::vmin(p, R[r]), mx = O::vmax(p, R[r]); R[r] = O::vsel(eq12, mn, mx); }
#pragma unroll
        for (int r = 0; r < NR; ++r) { if ((r & 1) == 0) ce_l2<true>(R[r], low2); else ce_l2<false>(R[r], low2); }
#pragma unroll
        for (int r = 0; r < NR; ++r) { if ((r & 1) == 0) ce_l1<true>(R[r], low1); else ce_l1<false>(R[r], low1); }
#pragma unroll
        for (int r = 0; r < NR; r += 2) { if ((r & 2) == 0) ce_reg<true>(R[r], R[r + 1]); else ce_reg<false>(R[r], R[r + 1]); }
#pragma unroll
        for (int r = 0; r < NR; ++r) { if ((r & 2) == 0) ce_l2<true>(R[r], low2); else ce_l2<false>(R[r], low2); }
#pragma unroll
        for (int r = 0; r < NR; ++r) { if ((r & 2) == 0) ce_l1<true>(R[r], low1); else ce_l1<false>(R[r], low1); }
#pragma unroll
        for (int r = 0; r < NR; ++r) { if ((r & 2) == 0) { if ((r & 4) == 0) ce_reg<true>(R[r], R[r + 2]); else ce_reg<false>(R[r], R[r + 2]); } }
#pragma unroll
        for (int r = 0; r < NR; r += 2) { if ((r & 4) == 0) ce_reg<true>(R[r], R[r + 1]); else ce_reg<false>(R[r], R[r + 1]); }
#pragma unroll
        for (int r = 0; r < NR; ++r) { if ((r & 4) == 0) ce_l2<true>(R[r], low2); else ce_l2<false>(R[r], low2); }
#pragma unroll
        for (int r = 0; r < NR; ++r) { if ((r & 4) == 0) ce_l1<true>(R[r], low1); else ce_l1<false>(R[r], low1); }
    }
    template <int NR> static __device__ __forceinline__ void halve_merge(const V (&R)[NR], V (&Q)[NR / 2], B low1, B low2) {
#pragma unroll
        for (int m = 0; m < NR / 8; ++m)
#pragma unroll
            for (int i = 0; i < 4; ++i) Q[4 * m + i] = O::vmax(R[8 * m + i], R[8 * m + 4 + i]);
#pragma unroll
        for (int r = 0; r < NR / 2; ++r) { if ((r & 2) == 0) { if ((r & 4) == 0) ce_reg<false>(Q[r], Q[r + 2]); else ce_reg<true>(Q[r], Q[r + 2]); } }
#pragma unroll
        for (int r = 0; r < NR / 2; r += 2) { if ((r & 4) == 0) ce_reg<false>(Q[r], Q[r + 1]); else ce_reg<true>(Q[r], Q[r + 1]); }
#pragma unroll
        for (int r = 0; r < NR / 2; ++r) { if ((r & 4) == 0) ce_l2<false>(Q[r], low2); else ce_l2<true>(Q[r], low2); }
#pragma unroll
        for (int r = 0; r < NR / 2; ++r) { if ((r & 4) == 0) ce_l1<false>(Q[r], low1); else ce_l1<true>(Q[r], low1); }
    }
    static __device__ __forceinline__ void top16_of_128(V (&R)[32], V (&T)[4], B low1, B low2, B eq12) {
        sort_blocks<32>(R, low1, low2, eq12);
        V A[16]; halve_merge<32>(R, A, low1, low2);
        V Bq[8]; halve_merge<16>(A, Bq, low1, low2);
        halve_merge<8>(Bq, T, low1, low2);
    }
    static __device__ __forceinline__ void top16_of_64(V (&R)[16], V (&T)[4], B low1, B low2, B eq12) {
        sort_blocks<16>(R, low1, low2, eq12);
        V A[8]; halve_merge<16>(R, A, low1, low2);
        halve_merge<8>(A, T, low1, low2);
    }
};

struct DevOps {
    typedef unsigned V; typedef bool B;
    static __device__ __forceinline__ V vmin(V a, V b) { return a < b ? a : b; }
    static __device__ __forceinline__ V vmax(V a, V b) { return a > b ? a : b; }
    static __device__ __forceinline__ V vsel(B m, V a, V b) { return m ? a : b; }
    static __device__ __forceinline__ V x1(V a) { return (V)dpp_i<DPP_XOR1>((int)a); }
    static __device__ __forceinline__ V x2(V a) { return (V)dpp_i<DPP_XOR2>((int)a); }
};
__device__ __forceinline__ void stair_ab(int c, int& a, int& b) {
    if (c < 16) { a = 0; b = c; } else if (c < 24) { a = 1; b = c - 16; } else if (c < 28) { a = 2; b = c - 24; } else if (c < 32) { a = 3; b = c - 28; }
    else if (c < 36) { a = 4; b = c - 32; } else if (c < 40) { a = 5 + ((c - 36) >> 1); b = (c - 36) & 1; } else if (c < 44) { a = 7 + ((c - 40) >> 1); b = (c - 40) & 1; }
    else if (c < 48) { a = 9 + (c - 44); b = 0; } else if (c < 51) { a = 13 + (c - 48); b = 0; } else { a = 2; b = 4; }
}
constexpr int PE_WS = 5120, PE_TAB = 8 * PE_WS;
constexpr int PE_VEC = PE_TAB + 512;
static_assert(PE_VEC + 11 * 8192 <= LDSCTL_OFF, "PE vector cache");
__device__ __forceinline__ void peer_topk(Frame& F, LAS unsigned char* ws, int t) {
    const int lane = F.lane, sub = lane & 3;
    const bool low1 = (sub & 1) == 0, low2 = (sub & 2) == 0, eq12 = low1 == low2;
    LAS unsigned* S1K = (LAS unsigned*)ws; LAS int* EL = (LAS int*)(ws + 3328); LAS float* GL = (LAS float*)(ws + 3840);
    const LAS unsigned short* TAB = (const LAS unsigned short*)(F.lds + PE_TAB);
    {
        const int L = lane >> 2;
        const bf16_t* sp = F.SC() + (size_t)t * D + L * 128 + sub * 32;
        unsigned R[32];
#pragma unroll
        for (int q = 0; q < 4; ++q) { const u32x4 v = *(const u32x4*)(sp + 8 * q);
#pragma unroll
            for (int e = 0; e < 4; ++e) {
                R[8 * q + 2 * e] = (ordkey(bf_lo(v[e])) & ~127u) | (unsigned)(127 - (32 * sub + 8 * q + 2 * e));
                R[8 * q + 2 * e + 1] = (ordkey(bf_hi(v[e])) & ~127u) | (unsigned)(127 - (32 * sub + 8 * q + 2 * e + 1)); } }
        unsigned T[4];
        QuadNet<DevOps>::top16_of_128(R, T, low1, low2, eq12);
#pragma unroll
        for (int r = 0; r < 4; ++r) S1K[L * 16 + 4 * r + sub] = T[r];
    }
    LDS_WAIT(); __builtin_amdgcn_wave_barrier();
    {
        const int hd = (lane >> 2) & 7;
        const LAS unsigned char* la = (const LAS unsigned char*)(S1K + (2 * hd) * 16); const LAS unsigned char* lb = (const LAS unsigned char*)(S1K + (2 * hd + 1) * 16);
        unsigned C[16];
#pragma unroll
        for (int r = 0; r < 13; ++r) { const unsigned ab = TAB[4 * r + sub];
            const unsigned ka = *(const LAS unsigned*)(la + (ab & 255u)), kb = *(const LAS unsigned*)(lb + (ab >> 8));
            const float sum = unordkey(ka & ~127u) + unordkey(kb & ~127u);
            C[r] = (ordkey(sum) & ~63u) | (unsigned)(63 - (4 * r + sub)); }
        C[13] = 0u; C[14] = 0u; C[15] = 0u;
        unsigned W[4];
        QuadNet<DevOps>::top16_of_64(C, W, low1, low2, eq12);
        float sv[4]; int ex[4];
#pragma unroll
        for (int r = 0; r < 4; ++r) { const unsigned ab = TAB[63 - (W[r] & 63u)];
            const unsigned ka = *(const LAS unsigned*)(la + (ab & 255u)), kb = *(const LAS unsigned*)(lb + (ab >> 8));
            ex[r] = (int)(127u - (ka & 127u)) * 128 + (int)(127u - (kb & 127u)); sv[r] = unordkey(W[r] & ~63u); }
        const float mx = dpp_f<0x00>(sv[0]);
        float e4[4], es = 0.f;
#pragma unroll
        for (int r = 0; r < 4; ++r) { e4[r] = __expf(sv[r] - mx); es += e4[r]; }
        es += dpp_f<DPP_XOR1>(es); es += dpp_f<DPP_XOR2>(es);
        const float rd = 1.f / es;
#pragma unroll
        for (int r = 0; r < 4; ++r) { GL[hd * 16 + 4 * r + sub] = e4[r] * rd; EL[hd * 16 + 4 * r + sub] = ex[r]; }
    }
    LDS_WAIT(); __builtin_amdgcn_wave_barrier();
}

#ifndef PROBE_PHASE
#define PROBE_PHASE -1
#endif
#ifndef PROBE_MULT
#define PROBE_MULT 1
#endif
constexpr int EB = 4;
constexpr int CW_TICKET = 20480;

struct GBuf { LpRow<U_FMT> u[EB]; LpRow<V_FMT> v[EB]; };
__device__ __forceinline__ void gather_issue(GBuf& B, const LAS int* EL, int i0, const unsigned char* UTl, const unsigned char* VTl, int lane) {
#pragma unroll
    for (int q = 0; q < EB; ++q) {
        const int ex = __builtin_amdgcn_readfirstlane(EL[i0 + q]);
        B.u[q].load(UTl + (size_t)ex * UROW, lane); B.v[q].load(VTl + (size_t)ex * VROW, lane);
    }
}
__device__ __forceinline__ void gather_compute(const GBuf& B, const LAS int* EL, const LAS float* GL, int i0, const float* USl, const float* VSl, const unsigned (&hv)[16], f32x2 (&acc)[16]) {
    float dot[EB], su[EB], sv[EB], g[EB];
#pragma unroll
    for (int q = 0; q < EB; ++q) { const int ex = __builtin_amdgcn_readfirstlane(EL[i0 + q]); { const f32x2 s2 = *(const f32x2*)(USl + 2 * ex); su[q] = s2.x; sv[q] = s2.y; }
        g[q] = __uint_as_float(__builtin_amdgcn_readfirstlane(__float_as_uint(GL[i0 + q]))); }
#pragma unroll
    for (int q = 0; q < EB; ++q) { float s0 = 0.f, s1 = 0.f;
        B.u[q].each_bf([&](int i, bf16x2_t x) { if (i & 1) s1 = __builtin_amdgcn_fdot2_f32_bf16(x, __builtin_bit_cast(bf16x2_t, hv[i]), s1, false); else s0 = __builtin_amdgcn_fdot2_f32_bf16(x, __builtin_bit_cast(bf16x2_t, hv[i]), s0, false); });
        dot[q] = s0 + s1; __builtin_amdgcn_sched_barrier(0); }
#pragma unroll
    for (int q = 0; q < EB; ++q) dot[q] = wave_sum_u(dot[q]);
#pragma unroll
    for (int q = 0; q < EB; ++q) { const float cf = g[q] * gelu_as(dot[q] * su[q]) * sv[q]; const f32x2 c2 = {cf, cf};
        B.v[q].each([&](int i, float x0, float x1) { const f32x2 x = {x0, x1}; acc[i >> 1] = __builtin_elementwise_fma(x, c2, acc[i >> 1]); }); __builtin_amdgcn_sched_barrier(0); }
}

__device__ __forceinline__ void peer_phase(Frame& F, int layer, int rows, unsigned* ctl, unsigned long long& pr_acc) {
    unsigned long long pt0 = 0ull;
#define SUB_BEGIN(ty) do { if (PROBE_PHASE == (ty)) pt0 = __builtin_amdgcn_s_memrealtime(); } while (0)
#define SUB_END(ty) do { if (PROBE_PHASE == (ty)) pr_acc += __builtin_amdgcn_s_memrealtime() - pt0; } while (0)
    if (F.tid < 64) { int a = 0, b = 0; stair_ab(F.tid < 52 ? F.tid : 0, a, b); *(LAS unsigned short*)(F.lds + PE_TAB + 2 * F.tid) = (unsigned short)((4 * a) | ((4 * b) << 8)); }
    {
        const int ch = F.tid, ll = ch >> 3, q = ch & 7;
        LAS unsigned char* dst = F.lds + PE_VEC + (q * 64 + ll) * 16;
        const int nl = layer < NLAYER - 1 ? layer + 1 : layer;
#pragma unroll 1
        for (int v = 0; v < 9; ++v) {
            const int g3 = v / 3, mrv = v - 3 * g3;
            const size_t off = ((size_t)(g3 == 0 ? layer : nl) * 3 + mrv) * 12288 + (g3 == 0 ? 5 * D : (g3 == 1 ? 0 : D));
            *(LAS f32x4*)(dst + v * 8192) = *(const f32x4*)(F.MODS() + off + 4 * ch);
        }
        *(LAS f32x4*)(dst + 9 * 8192) = *(const f32x4*)(F.ln2_g() + layer * D + 4 * ch);
        *(LAS f32x4*)(dst + 10 * 8192) = *(const f32x4*)(F.ln2_b() + layer * D + 4 * ch);
    }
    __syncthreads();
    LAS unsigned char* ws = F.lds + F.wave * PE_WS;
    LAS int* EL = (LAS int*)(ws + 3328); LAS float* GL = (LAS float*)(ws + 3840);
    const int lane = F.lane;
    const LAS unsigned char* vcache = F.lds + PE_VEC + lane * 16;
    const unsigned char* UTl = F.UT() + (size_t)layer * NEXP * UROW;
    const unsigned char* VTl = F.VT() + (size_t)layer * NEXP * VROW;
    const float* USl = F.US() + 2 * (size_t)layer * NEXP; const float* VSl = nullptr;
    unsigned* ticket = ctl + CW_TICKET + 64 * layer;
    unsigned tk = 0u;
    if (lane == 0) tk = __hip_atomic_fetch_add(ticket, 1u, __ATOMIC_RELAXED, __HIP_MEMORY_SCOPE_AGENT);
    int t = (int)__builtin_amdgcn_readfirstlane(tk);
    while (t < rows) {
        unsigned tkn = 0u;
        if (lane == 0) tkn = __hip_atomic_fetch_add(ticket, 1u, __ATOMIC_RELAXED, __HIP_MEMORY_SCOPE_AGENT);
        SUB_BEGIN(8); peer_topk(F, ws, t); SUB_END(8);
        SUB_BEGIN(9);
        unsigned hv[16]; f32x2 acc[16];
#pragma unroll
        for (int q = 0; q < 4; ++q) { const u32x4 w = *(const u32x4*)(F.H() + (size_t)t * D + 32 * lane + 8 * q);
#pragma unroll
            for (int e = 0; e < 4; ++e) { hv[4 * q + e] = w[e]; acc[4 * q + e] = (f32x2){0.f, 0.f}; } }
        {
            GBuf A, B, C;
            gather_issue(A, EL, 0, UTl, VTl, lane);
            gather_issue(B, EL, EB, UTl, VTl, lane);
            for (int i0 = 0; i0 < 30 * EB; i0 += 3 * EB) {
                gather_issue(C, EL, i0 + 2 * EB, UTl, VTl, lane);
                gather_compute(A, EL, GL, i0, USl, VSl, hv, acc);
                gather_issue(A, EL, i0 + 3 * EB, UTl, VTl, lane);
                gather_compute(B, EL, GL, i0 + EB, USl, VSl, hv, acc);
                gather_issue(B, EL, i0 + 4 * EB, UTl, VTl, lane);
                gather_compute(C, EL, GL, i0 + 2 * EB, USl, VSl, hv, acc);
            }
            gather_compute(A, EL, GL, 30 * EB, USl, VSl, hv, acc);
            gather_compute(B, EL, GL, 31 * EB, USl, VSl, hv, acc);
        }
        SUB_END(9); SUB_BEGIN(10);
        const int mr = modrow(t);
        const float* mp = F.MODS() + ((size_t)layer * 3 + mr) * 12288;
        bf16_t* xr = F.X() + (size_t)t * D;
        float rr[32]; float s = 0.f;
#pragma unroll
        for (int q2 = 0; q2 < 4; ++q2) { const u32x4 xw = *(const u32x4*)(xr + 32 * lane + 8 * q2);
#pragma unroll
            for (int h2 = 0; h2 < 2; ++h2) { const int q = 2 * q2 + h2; const f32x4 gv = *(const LAS f32x4*)(vcache + mr * 8192 + q * 1024);
                const f32x4 xv = {bf_lo(xw[2 * h2]), bf_hi(xw[2 * h2]), bf_lo(xw[2 * h2 + 1]), bf_hi(xw[2 * h2 + 1])};
                const f32x4 av = {acc[2 * q].x, acc[2 * q].y, acc[2 * q + 1].x, acc[2 * q + 1].y};
#pragma unroll
                for (int e = 0; e < 4; ++e) { const float v = DN_ALPHA * xv[e] + gv[e] * av[e]; rr[4 * q + e] = v; s += v; } } }
        const float mean = wave_sum_u(s) * (1.f / D);
        float s2 = 0.f;
#pragma unroll
        for (int i = 0; i < 32; ++i) { rr[i] -= mean; s2 += rr[i] * rr[i]; }
        const float rstd = 1.f / sqrtf(wave_sum_u(s2) * (1.f / D) + LN_EPS);
        const float* g2 = F.ln2_g() + layer * D; const float* b2 = F.ln2_b() + layer * D;
        float s3 = 0.f;
#pragma unroll
        for (int q = 0; q < 8; ++q) { const int c = 32 * lane + 4 * q; const f32x4 gg = *(const LAS f32x4*)(vcache + 9 * 8192 + q * 1024), bb = *(const LAS f32x4*)(vcache + 10 * 8192 + q * 1024);
            f32x4 xo;
#pragma unroll
            for (int e = 0; e < 4; ++e) { xo[e] = rr[4 * q + e] * rstd * gg[e] + bb[e]; rr[4 * q + e] = xo[e]; s3 += xo[e]; }
            if (layer < NLAYER - 1) { u32x2 o2; o2.x = pk2(xo[0], xo[1]); o2.y = pk2(xo[2], xo[3]); *(u32x2*)(xr + c) = o2; } else if (t < TL) *(f32x4*)(F.out() + (size_t)t * D + c) = xo; }
        if (layer < NLAYER - 1) {
            const float mean2 = wave_sum_u(s3) * (1.f / D);
            float s4 = 0.f;
#pragma unroll
            for (int i = 0; i < 32; ++i) { rr[i] -= mean2; s4 += rr[i] * rr[i]; }
            const float rstd2 = 1.f / sqrtf(wave_sum_u(s4) * (1.f / D) + LN_EPS);
            const float* np = F.MODS() + ((size_t)(layer + 1) * 3 + mr) * 12288;
#pragma unroll
            for (int q2 = 0; q2 < 4; ++q2) { const int c = 32 * lane + 8 * q2; u32x4 w;
#pragma unroll
                for (int q = 0; q < 2; ++q) { const f32x4 sh = *(const LAS f32x4*)(vcache + (3 + mr) * 8192 + (2 * q2 + q) * 1024), sc = *(const LAS f32x4*)(vcache + (6 + mr) * 8192 + (2 * q2 + q) * 1024); const int ri = 8 * q2 + 4 * q;
                    const float y0 = rr[ri] * rstd2 * (1.f + sc[0]) + sh[0], y1 = rr[ri + 1] * rstd2 * (1.f + sc[1]) + sh[1];
                    const float y2 = rr[ri + 2] * rstd2 * (1.f + sc[2]) + sh[2], y3 = rr[ri + 3] * rstd2 * (1.f + sc[3]) + sh[3];
                    w[2 * q] = pk2(y0, y1); w[2 * q + 1] = pk2(y2, y3); }
                *(u32x4*)(F.H() + (size_t)t * D + c) = w; }
        }
        SUB_END(10);
        t = (int)__builtin_amdgcn_readfirstlane(tkn);
    }
#undef SUB_BEGIN
#undef SUB_END
}

__global__ void __launch_bounds__(NWAVES * 64, 2) skel_fwd(Args args) {
    extern __shared__ __attribute__((aligned(16))) unsigned char lds[];
    Frame F;
    F.lds = (LAS unsigned char*)lds;
    F.tid = threadIdx.x; F.lane = F.tid & 63; F.wave = __builtin_amdgcn_readfirstlane(F.tid >> 6);
    F.G = gridDim.x; F.gw = blockIdx.x * NWAVES + F.wave; F.NGW = F.G * NWAVES;
    unsigned char* ws = args.ws;
    F.ka = (const CAS unsigned char*)__builtin_amdgcn_kernarg_segment_ptr();
    for (int u = F.tid; u < (LDS_BYTES - LDSCTL_OFF) / 4; u += NWAVES * 64) ((LAS unsigned*)(F.lds + LDSCTL_OFF))[u] = 0u;
    __syncthreads();
    unsigned* ctl = (unsigned*)(ws + WS_CTL);
    const int lo = args.ph_lo, hi = args.ph_hi;
    XcdBarrier bar; bar.bar = ctl + CW_BAR + args.li * XCD_BAR_WORDS; bar.x = 0; bar.st = nullptr;
    if (hi - lo > 1) bar = xcd_barrier_post(ctl + CW_BAR + args.li * XCD_BAR_WORDS, (volatile LAS unsigned*)(F.lds + MISC_OFF) + 8);
#define IN(k) (lo <= (k) && (k) < hi)
    unsigned long long pr_acc = 0ull, pr_t0 = 0ull;
#define PR_BEGIN(ty) do { if (PROBE_PHASE == (ty)) pr_t0 = __builtin_amdgcn_s_memrealtime(); } while (0)
#define PR_END(ty) do { if (PROBE_PHASE == (ty)) pr_acc += __builtin_amdgcn_s_memrealtime() - pr_t0; } while (0)
#define BOTH(k) (IN(k) && IN((k) + 1))
#define SEAM(k) do { if (BOTH(k)) xcd_barrier(bar); } while (0)

    if (IN(0)) { PR_BEGIN(0); frame_ids(F); p0a_prologue(F); SEAM(0); PR_END(0); }
    if (IN(1)) {
        PR_BEGIN(1); frame_ids(F);
        { pg8::Gemm g{F.KBD(), F.WQR(), 32 * 256, 2048, 256}; pg8::BatchOrder S{F.G, (int)blockIdx.x}; pg8::EpiBf16 E{F.WEFFT(), D};
          pg8::gemm_phase<pg8::EpiBf16, pg8::BatchOrder, false, true>(F.lds, g, S, E); }
        p0b_mod0(F);
        SEAM(1); PR_END(1);
    }
    for (int layer = 0; layer < NLAYER; ++layer) {
        const int pb = 2 + 6 * layer;
        const bool lastl = layer == NLAYER - 1;
        const int rows = lastl ? TL : TT;
        if (IN(pb + 0)) {
            PR_BEGIN(2); frame_ids(F);
            pg8::Gemm g{F.H(), F.WINT() + (size_t)layer * INC * D, TT, INC, D}; pg8::StaticOrder S; S.init(TT, INC, F.G, (int)blockIdx.x);
            pg8::EpiBf16 E{F.PROJ(), INC};
            pg8::gemm_phase<pg8::EpiBf16, pg8::StaticOrder, true, true>(F.lds, g, S, E);
            SEAM(pb + 0); PR_END(2);
        }
        if (IN(pb + 1)) {
            PR_BEGIN(3); frame_ids(F);
            const int nunits = lastl ? 512 : 528;
            {
                const int ch = F.tid & 255, vsel = F.tid >> 8;
                LAS unsigned char* dst = F.lds + CONV_LDS + ((2 * (ch >> 7) + (ch & 1)) * 64 + ((ch & 127) >> 1)) * 16;
                *(LAS f32x4*)(dst + vsel * 4096) = *(const f32x4*)(F.conv_w() + (size_t)layer * 3 * 1024 + vsel * 1024 + 4 * ch);
                *(LAS f32x4*)(dst + (2 + vsel) * 4096) = vsel == 0 ? *(const f32x4*)(F.conv_w() + (size_t)layer * 3 * 1024 + 2048 + 4 * ch) : *(const f32x4*)(F.g_conv() + layer * 1024 + 4 * ch);
            }
            __syncthreads();
            { unsigned long long q0 = 0; if (PROBE_PHASE == 11) q0 = __builtin_amdgcn_s_memrealtime();
            { const int bx = (int)blockIdx.x, vcu = (F.G % 8 == 0) ? (bx % 8) * (F.G / 8) + bx / 8 : bx;
              for (int u = vcu; u < nunits; u += F.G) attn_unit(F, layer, u); }
            if (PROBE_PHASE == 11) pr_acc += __builtin_amdgcn_s_memrealtime() - q0; if (PROBE_PHASE == 12) q0 = __builtin_amdgcn_s_memrealtime();
            {
              const int nx = nunits - 2 * F.G; const bool uneven = nx > 0 && nx < F.G;
              const int bx2 = (int)blockIdx.x, vc2 = (F.G % 8 == 0) ? (bx2 % 8) * (F.G / 8) + bx2 / 8 : bx2;
              const int c0 = uneven ? vc2 - nx : vc2, nb = uneven ? F.G - nx : F.G;
              if (c0 >= 0) for (int t = c0 * NWAVES + F.wave; t < rows; t += nb * NWAVES) conv_row(F, layer, t); }
            if (PROBE_PHASE == 12) pr_acc += __builtin_amdgcn_s_memrealtime() - q0; }
            SEAM(pb + 1); PR_END(3);
        }
        if (IN(pb + 2)) {
            PR_BEGIN(4); frame_ids(F);
            pg8::Gemm g{F.MIX(), F.WOUTT() + (size_t)layer * D * D, rows, D, D}; pg8::StaticOrder S; S.init(rows, D, F.G, (int)blockIdx.x);
            pg8::EpiResid E{layer == 0 ? F.x() : nullptr, layer == 0 ? F.ctx() : nullptr, F.X(), F.MODS() + (size_t)layer * 3 * 12288 + 2 * D};
            pg8::gemm_phase<pg8::EpiResid, pg8::StaticOrder, true, true>(F.lds, g, S, E);
            frame_ids(F); convert_in_tail(F, layer, (rows / 256) * (D / 256), 0);
            SEAM(pb + 2); PR_END(4);
        }
        if (IN(pb + 3)) { PR_BEGIN(5); frame_ids(F); ln_phase(F, layer, rows); SEAM(pb + 3); PR_END(5); }
        if (IN(pb + 4)) {
            PR_BEGIN(6); frame_ids(F);
            pg8::Gemm g{F.H(), F.WEFFT() + (size_t)layer * D * D, rows, D, D}; pg8::StaticOrder S; S.init(rows, D, F.G, (int)blockIdx.x);
            pg8::EpiBf16 E{F.SC(), D};
            pg8::gemm_phase<pg8::EpiBf16, pg8::StaticOrder, true, true>(F.lds, g, S, E);
            frame_ids(F); convert_in_tail(F, layer, (rows / 256) * (D / 256), 1);
            SEAM(pb + 4); PR_END(6);
        }
        if (IN(pb + 5)) { PR_BEGIN(7); frame_ids(F); peer_phase(F, layer, rows, ctl, pr_acc); SEAM(pb + 5); PR_END(7); }
    }
    if (PROBE_PHASE >= 0 && hi - lo > 1) xcd_barrier(bar);
    if (PROBE_PHASE >= 0 && blockIdx.x == 0 && threadIdx.x == 0) { const unsigned long long t1 = __builtin_amdgcn_s_memrealtime() + (unsigned long long)PROBE_MULT * pr_acc; while (__builtin_amdgcn_s_memrealtime() < t1) __builtin_amdgcn_s_sleep(8); }
#undef IN
#undef BOTH
#undef SEAM
}

extern "C" void kernel_launch(void* const* d_in, const int* in_sizes, int n_in, void* d_out, int out_size, void* d_ws, size_t ws_size, hipStream_t stream) {
    static int grid = 0;
    if (grid == 0) {
        if (n_in != 20 || in_sizes[0] != TL * D || out_size != TL * D || ws_size < WS_END) {
            fprintf(stderr, "kernel_launch: unexpected problem shape (n_in %d, in0 %d, out %d, ws %zu, need %zu)\n", n_in, n_in > 0 ? in_sizes[0] : -1, out_size, ws_size, (size_t)WS_END); grid = -1; return; }
        int dev = 0, cus = 0, per_cu = 0;
        if (hipGetDevice(&dev) != hipSuccess || hipDeviceGetAttribute(&cus, hipDeviceAttributeMultiprocessorCount, dev) != hipSuccess) { grid = -1; return; }
        if (hipFuncSetAttribute((const void*)skel_fwd, hipFuncAttributeMaxDynamicSharedMemorySize, LDS_BYTES) != hipSuccess) { fprintf(stderr, "kernel_launch: hipFuncSetAttribute failed\n"); grid = -1; return; }
        if (hipOccupancyMaxActiveBlocksPerMultiprocessor(&per_cu, (const void*)skel_fwd, NWAVES * 64, LDS_BYTES) != hipSuccess || per_cu < 1)
            fprintf(stderr, "kernel_launch: occupancy query reports %d workgroups per CU\n", per_cu);
        (void)hipGetLastError();
        grid = cus;
    }
    if (grid < 0) return;
    if (hipMemsetAsync((char*)d_ws + WS_CTL, 0, CTL_ZERO_BYTES, stream) != hipSuccess) return;
    Args a{};
    for (int i = 0; i < 20; ++i) a.in[i] = (const float*)d_in[i];
    a.out = (float*)d_out; a.ws = (unsigned char*)d_ws; a.pad = 0;
#if MK_N_LAUNCHES == 1
    a.ph_lo = 0; a.ph_hi = NPHASE; a.li = 0;
    hipLaunchKernelGGL(skel_fwd, dim3(grid), dim3(NWAVES * 64), LDS_BYTES, stream, a);
#else
    for (int ph = 0; ph < NPHASE; ++ph) { a.ph_lo = ph; a.ph_hi = ph + 1; a.li = 0;
        hipLaunchKernelGGL(skel_fwd, dim3(grid), dim3(NWAVES * 64), LDS_BYTES, stream, a); }
#endif
}
```

```cpp
#include <hip/hip_runtime.h>
#include <cstdio>
#include <cstdint>

#ifndef MK_N_LAUNCHES
#define MK_N_LAUNCHES 1
#endif

#define LAS __attribute__((address_space(3)))
typedef unsigned short bf16_t;
typedef short bf16x8 __attribute__((ext_vector_type(8)));
typedef short s16x4 __attribute__((ext_vector_type(4)));
typedef float f32x2 __attribute__((ext_vector_type(2)));
typedef float f32x4 __attribute__((ext_vector_type(4)));
typedef float f32x16 __attribute__((ext_vector_type(16)));
typedef unsigned u32x2 __attribute__((ext_vector_type(2)));
typedef unsigned u32x4 __attribute__((ext_vector_type(4)));
typedef __bf16 bf16x2_t __attribute__((ext_vector_type(2)));

constexpr int D = 2048, NB = 2, SEQ = 8192, CTXL = 256, NLAYER = 4;
constexpr int TL = NB * SEQ, TC = NB * CTXL, TT = TL + TC;
constexpr int INC = 4608, OFF_C = 1024, OFF_X = 2048, OFF_Q = 3072, OFF_K = 4096, OFF_V = 4352;
constexpr int NEXP = 16384;
#ifndef U_FMT
#define U_FMT 4
#endif
#ifndef V_FMT
#define V_FMT 4
#endif
constexpr int UROW = D * U_FMT / 8, VROW = D * V_FMT / 8;
constexpr float LN_EPS = 1e-6f;
constexpr float DN_ALPHA = 1.681792830507429f;
constexpr float QSCALE = 0.08838834764831845f * 1.4426950408889634f;
constexpr float LOG2E = 1.4426950408889634f;

constexpr size_t MiB = 1u << 20;
constexpr size_t WS_CTL = 0, CTL_ZERO_BYTES = 1 * MiB;
constexpr size_t WS_MODS = 1 * MiB;
constexpr size_t WS_ROPE = 2 * MiB;
constexpr size_t WS_KBD = 3 * MiB;
constexpr size_t WS_WQR = 8 * MiB;
constexpr size_t WS_WINT = 40 * MiB;
constexpr size_t WS_WOUTT = 112 * MiB;
constexpr size_t WS_WEFFT = 144 * MiB;
constexpr size_t WS_X = 176 * MiB;
constexpr size_t WS_H = 308 * MiB;
constexpr size_t WS_PROJ = 374 * MiB;
constexpr size_t WS_MIX = 523 * MiB;
constexpr size_t WS_SC = 589 * MiB;
constexpr size_t WS_UT = 721 * MiB;
constexpr size_t WS_VT = 849 * MiB;
constexpr size_t WS_US = 977 * MiB;
constexpr size_t WS_VS = 978 * MiB;
constexpr size_t WS_END = 979 * MiB;

constexpr int CW_BAR = 4096;

namespace pg8 {
constexpr int BM = 256, BK = 64, HALF = 128, HTB = HALF * BK * 2, STAGE_BYTES = 8 * HTB, NXCD = 8, WGM = 8;
__host__ __device__ __forceinline__ int lds_byte(int r, int c) { const int st = (r >> 4) * 2 + (c >> 5), rr = r & 15, cc = c & 31, ob = rr * 64 + cc * 2; return st * 1024 + (ob ^ (((ob >> 9) & 1) << 5)); }
__host__ __device__ __forceinline__ void stage_rc(int b, int& R, int& C) { const int st = b / 1024, sb = b % 1024, swz = sb ^ (((sb >> 9) & 1) << 5); R = (st >> 1) * 16 + swz / 64; C = (st & 1) * 32 + (swz % 64) / 2; }
__host__ __device__ __forceinline__ int perm32(int rho) { const int n = rho >> 4, i = rho & 15; return 8 * (i >> 2) + 4 * n + (i & 3); }

struct Unit { int pm, pn; };
struct Gemm { const bf16_t* A; const bf16_t* Bt; int M, N, K; };

struct StaticOrder {
    int nM, nN, nwg, G, c;
    __host__ __device__ void init(int M, int N, int G_, int c_) { nM = M / BM; nN = N / BM; nwg = nM * nN; G = G_; c = c_; }
    __host__ __device__ bool next(int i, Unit& u) const {
        const long L = (long)i * G + c; if (L >= nwg) return false;
        int wgid = (int)L; { const int q = nwg / NXCD, r = nwg % NXCD, xcd = wgid % NXCD, off = wgid / NXCD; wgid = (xcd < r ? xcd * (q + 1) : r * (q + 1) + (xcd - r) * q) + off; }
        const int nig = WGM * nN, gid = wgid / nig, fm = gid * WGM, gsz = (nM - fm) < WGM ? (nM - fm) : WGM;
        u.pm = fm + ((wgid % nig) % gsz); u.pn = (wgid % nig) / gsz; return true;
    }
    __device__ __forceinline__ int btile(const Unit& u) const { return u.pn; }
    __device__ __forceinline__ void a_ready(const Unit&) const {}
    __device__ __forceinline__ void done(const Unit&) const {}
};
struct BatchOrder {
    int G, c;
    __device__ bool next(int i, Unit& u) const { const int L = i * G + c; if (L >= 256) return false; u.pm = L >> 3; u.pn = L & 7; return true; }
    __device__ __forceinline__ int btile(const Unit& u) const { return u.pm * 8 + u.pn; }
    __device__ __forceinline__ void a_ready(const Unit&) const {}
    __device__ __forceinline__ void done(const Unit&) const {}
};

__device__ __forceinline__ unsigned cvt_pk_bf16(float lo, float hi) { f32x2 x = {lo, hi}; bf16x2_t y = __builtin_convertvector(x, bf16x2_t); return __builtin_bit_cast(unsigned, y); }

struct EpiBf16 {
    static constexpr bool PERM = true;
    bf16_t* O; int ldc;
    __device__ __forceinline__ void operator()(const f32x4 (&acc)[2][2][4][2], const Unit& u, int wr, int wc, int fr, int fq) const {
        const int row0 = u.pm * BM + wr * 64 + fr, col0 = u.pn * BM + wc * 32 + 8 * fq;
#pragma unroll
        for (int ai = 0; ai < 2; ++ai)
#pragma unroll
            for (int m = 0; m < 4; ++m) { bf16_t* rowp = O + (size_t)(row0 + ai * HALF + m * 16) * ldc + col0;
#pragma unroll
                for (int bj = 0; bj < 2; ++bj) { const f32x4 v0 = acc[ai][bj][m][0], v1 = acc[ai][bj][m][1];
                    u32x4 w; w.x = cvt_pk_bf16(v0[0], v0[1]); w.y = cvt_pk_bf16(v0[2], v0[3]); w.z = cvt_pk_bf16(v1[0], v1[1]); w.w = cvt_pk_bf16(v1[2], v1[3]);
                    *(u32x4*)(rowp + bj * HALF) = w; } }
    }
};
struct EpiF32 {
    static constexpr bool PERM = false;
    float* C; int ldc;
    __device__ __forceinline__ void operator()(const f32x4 (&acc)[2][2][4][2], const Unit& u, int wr, int wc, int fr, int fq) const {
        const int row0 = u.pm * BM + wr * 64 + fr, col0 = u.pn * BM + wc * 32 + 4 * fq;
#pragma unroll
        for (int ai = 0; ai < 2; ++ai)
#pragma unroll
            for (int m = 0; m < 4; ++m) { float* rowp = C + (size_t)(row0 + ai * HALF + m * 16) * ldc + col0;
#pragma unroll
                for (int bj = 0; bj < 2; ++bj)
#pragma unroll
                    for (int n = 0; n < 2; ++n) *(f32x4*)(rowp + bj * HALF + n * 16) = acc[ai][bj][m][n]; }
    }
};
struct EpiResid {
    static constexpr bool PERM = true;
    const float* x32_lat; const float* x32_ctx;
    bf16_t* X; const float* gate;
    __device__ __forceinline__ void operator()(const f32x4 (&acc)[2][2][4][2], const Unit& u, int wr, int wc, int fr, int fq) const {
        const int rt = u.pm * BM;
        const int mr = rt < TL ? rt / SEQ : 2;
        const int row0 = rt + wr * 64 + fr, col0 = u.pn * BM + wc * 32 + 8 * fq;
        f32x4 gv[2][2];
#pragma unroll
        for (int bj = 0; bj < 2; ++bj)
#pragma unroll
            for (int n = 0; n < 2; ++n) gv[bj][n] = *(const f32x4*)(gate + (size_t)mr * 12288 + col0 + bj * HALF + 4 * n);
#pragma unroll
        for (int ai = 0; ai < 2; ++ai)
#pragma unroll
            for (int m = 0; m < 4; ++m) { const int row = row0 + ai * HALF + m * 16;
#pragma unroll
                for (int bj = 0; bj < 2; ++bj) {
                    f32x4 x0, x1;
                    if (x32_lat) { const float* xp = (row < TL ? x32_lat + (size_t)row * D : x32_ctx + (size_t)(row - TL) * D) + col0 + bj * HALF; x0 = *(const f32x4*)xp; x1 = *(const f32x4*)(xp + 4); }
                    else { const u32x4 w = *(const u32x4*)(X + (size_t)row * D + col0 + bj * HALF);
                        x0 = (f32x4){__uint_as_float(w.x << 16), __uint_as_float(w.x & 0xffff0000u), __uint_as_float(w.y << 16), __uint_as_float(w.y & 0xffff0000u)};
                        x1 = (f32x4){__uint_as_float(w.z << 16), __uint_as_float(w.z & 0xffff0000u), __uint_as_float(w.w << 16), __uint_as_float(w.w & 0xffff0000u)}; }
                    const f32x4 r0 = x0 * DN_ALPHA + gv[bj][0] * acc[ai][bj][m][0], r1 = x1 * DN_ALPHA + gv[bj][1] * acc[ai][bj][m][1];
                    u32x4 o; o.x = cvt_pk_bf16(r0[0], r0[1]); o.y = cvt_pk_bf16(r0[2], r0[3]); o.z = cvt_pk_bf16(r1[0], r1[1]); o.w = cvt_pk_bf16(r1[2], r1[3]);
                    *(u32x4*)(X + (size_t)row * D + col0 + bj * HALF) = o; } }
    }
};

template <class Epi, class Sched, bool ALIGN_EPI = false, bool SP2 = false>
__device__ __forceinline__ void gemm_phase(LAS unsigned char* lds, const Gemm g, const Sched& S, const Epi& E) {
    int tid = threadIdx.x; asm volatile("" : "+v"(tid));
    const int wid = __builtin_amdgcn_readfirstlane(tid >> 6), lane = tid & 63, wr = wid >> 2, wc = wid & 3, fr = lane & 15, fq = lane >> 4;
    const int K = g.K, nt = K / BK;
    unsigned voffA[2], voffB[2];
#pragma unroll
    for (int i = 0; i < 2; ++i) { int R, C; stage_rc(tid * 16 + i * 8192, R, C); const int Rb = Epi::PERM ? ((R & ~31) + perm32(R & 31)) : R;
        voffA[i] = (unsigned)(R * K + C) * 2u; voffB[i] = (unsigned)(Rb * K + C) * 2u; }
    const size_t kstep = (size_t)(BK * 2);
    const size_t hstep = (size_t)HALF * K * 2;
    const size_t tstep = 2 * hstep;
    const unsigned ldsw = (unsigned)wid * 1024u;
    const int aoff = lds_byte(wr * 64 + fr, fq * 8), boff = lds_byte(wc * 32 + fr, fq * 8);
#define PG8_SA(b, h) (((b) * 2 + (h)) * HTB)
#define PG8_SB(b, h) ((4 + (b) * 2 + (h)) * HTB)
#define PG8_STAGE(bufoff, gbase, voff) do { _Pragma("unroll") for (int _i = 0; _i < 2; ++_i) \
        __builtin_amdgcn_global_load_lds((const unsigned*)((const char*)(gbase) + (voff)[_i]), (LAS unsigned*)(lds + (bufoff) + ldsw + _i * 8192), 16, 0, 0); } while (0)
#define PG8_LDA(dst, b, h) do { _Pragma("unroll") for (int m = 0; m < 4; ++m) _Pragma("unroll") for (int k = 0; k < 2; ++k) dst[m][k] = *(const LAS bf16x8*)(lds + PG8_SA(b, h) + aoff + m * 2048 + k * 1024); } while (0)
#define PG8_LDB(dst, b, h) do { _Pragma("unroll") for (int n = 0; n < 2; ++n) _Pragma("unroll") for (int k = 0; k < 2; ++k) dst[n][k] = *(const LAS bf16x8*)(lds + PG8_SB(b, h) + boff + n * 2048 + k * 1024); } while (0)
#define PG8_MMA(ai, bj, At, Bt) do { __builtin_amdgcn_s_setprio(1); _Pragma("unroll") for (int m = 0; m < 4; ++m) _Pragma("unroll") for (int n = 0; n < 2; ++n) _Pragma("unroll") for (int k = 0; k < 2; ++k) \
        acc[ai][bj][m][n] = __builtin_amdgcn_mfma_f32_16x16x32_bf16(Bt[n][k], At[m][k], acc[ai][bj][m][n], 0, 0, 0); __builtin_amdgcn_s_setprio(0); } while (0)
#define PG8_WAIT_V(n) asm volatile("s_waitcnt vmcnt(" #n ")" ::: "memory")
#define PG8_WAIT_L(n) asm volatile("s_waitcnt lgkmcnt(" #n ")" ::: "memory")
#define PG8_BAR __builtin_amdgcn_s_barrier()
#define PG8_SCHED __builtin_amdgcn_sched_barrier(0)
    Unit cur, nxt; int ui = 0;
    if (!S.next(0, cur)) return;
    f32x4 acc[2][2][4][2];
#pragma unroll
    for (int a = 0; a < 2; ++a)
#pragma unroll
        for (int b = 0; b < 2; ++b)
#pragma unroll
            for (int m = 0; m < 4; ++m)
#pragma unroll
                for (int n = 0; n < 2; ++n) acc[a][b][m][n] = (f32x4){0.f, 0.f, 0.f, 0.f};
    bf16x8 At[4][2], B0[2][2], B1[2][2];
    const char* cA = (const char*)g.A + (size_t)cur.pm * tstep; const char* cB = (const char*)g.Bt + (size_t)S.btile(cur) * tstep;
    S.a_ready(cur);
    if constexpr (SP2) {
        PG8_STAGE(PG8_SB(0, 0), cB, voffB); PG8_STAGE(PG8_SB(0, 1), cB + hstep, voffB); PG8_STAGE(PG8_SA(0, 0), cA, voffA); PG8_STAGE(PG8_SA(0, 1), cA + hstep, voffA);
        if (wr == 1) PG8_BAR;
        PG8_WAIT_V(2); PG8_BAR;
        PG8_STAGE(PG8_SB(1, 0), cB + kstep, voffB); PG8_STAGE(PG8_SA(1, 0), cA + kstep, voffA); PG8_STAGE(PG8_SB(1, 1), cB + hstep + kstep, voffB);
        PG8_WAIT_V(6); PG8_BAR;
    } else {
        PG8_STAGE(PG8_SB(0, 0), cB, voffB); PG8_STAGE(PG8_SA(0, 0), cA, voffA); PG8_STAGE(PG8_SB(0, 1), cB + hstep, voffB); PG8_STAGE(PG8_SA(0, 1), cA + hstep, voffA);
        if (wr == 1) PG8_BAR;
        PG8_WAIT_V(4); PG8_BAR;
        PG8_STAGE(PG8_SB(1, 0), cB + kstep, voffB); PG8_STAGE(PG8_SA(1, 0), cA + kstep, voffA); PG8_STAGE(PG8_SB(1, 1), cB + hstep + kstep, voffB);
        PG8_WAIT_V(6); PG8_BAR;
    }
    for (;;) {
        const bool has_next = S.next(ui + 1, nxt);
        const char* nA = has_next ? (const char*)g.A + (size_t)nxt.pm * tstep : cA; const char* nB = has_next ? (const char*)g.Bt + (size_t)S.btile(nxt) * tstep : cB;
        for (int t = 0; t < nt; t += 2) {
            const bool last = (t == nt - 2);
            const char* a1 = cA + (size_t)(t + 1) * kstep;
            const char* a2 = last ? nA : cA + (size_t)(t + 2) * kstep; const char* b2 = last ? nB : cB + (size_t)(t + 2) * kstep;
            const char* a3 = a2 + kstep; const char* b3 = b2 + kstep;
            if (last && has_next) S.a_ready(nxt);
            if constexpr (SP2) {
            PG8_LDB(B0, 0, 0); PG8_LDB(B1, 0, 1); PG8_SCHED; PG8_LDA(At, 0, 0); PG8_STAGE(PG8_SA(1, 1), a1 + hstep, voffA);
            PG8_WAIT_V(8); PG8_WAIT_L(0); PG8_BAR; PG8_MMA(0, 0, At, B0); PG8_MMA(0, 1, At, B1); PG8_BAR; PG8_SCHED;
            PG8_LDA(At, 0, 1); PG8_STAGE(PG8_SB(0, 0), b2, voffB); PG8_STAGE(PG8_SB(0, 1), b2 + hstep, voffB); PG8_STAGE(PG8_SA(0, 0), a2, voffA);
            PG8_WAIT_V(8); PG8_WAIT_L(0); PG8_BAR; PG8_MMA(1, 0, At, B0); PG8_MMA(1, 1, At, B1); PG8_BAR; PG8_SCHED;
            PG8_LDB(B0, 1, 0); PG8_LDB(B1, 1, 1); PG8_SCHED; PG8_LDA(At, 1, 0); PG8_STAGE(PG8_SA(0, 1), a2 + hstep, voffA);
            PG8_WAIT_V(8); PG8_WAIT_L(0); PG8_BAR; PG8_MMA(0, 0, At, B0); PG8_MMA(0, 1, At, B1); PG8_BAR; PG8_SCHED;
            PG8_LDA(At, 1, 1); PG8_STAGE(PG8_SB(1, 0), b3, voffB); PG8_STAGE(PG8_SB(1, 1), b3 + hstep, voffB); PG8_STAGE(PG8_SA(1, 0), a3, voffA);
            PG8_WAIT_V(8); PG8_WAIT_L(0); PG8_BAR; PG8_MMA(1, 0, At, B0); PG8_MMA(1, 1, At, B1); PG8_BAR; PG8_SCHED;
            } else {
            PG8_LDB(B0, 0, 0); PG8_SCHED; PG8_LDA(At, 0, 0); PG8_STAGE(PG8_SA(1, 1), a1 + hstep, voffA);
            PG8_WAIT_L(8); PG8_BAR; PG8_WAIT_L(0); PG8_MMA(0, 0, At, B0); PG8_BAR; PG8_SCHED;
            PG8_LDB(B1, 0, 1); PG8_STAGE(PG8_SB(0, 0), b2, voffB);
            PG8_BAR; PG8_WAIT_L(0); PG8_MMA(0, 1, At, B1); PG8_BAR;
            PG8_LDA(At, 0, 1); PG8_STAGE(PG8_SA(0, 0), a2, voffA);
            PG8_BAR; PG8_WAIT_L(0); PG8_MMA(1, 0, At, B0); PG8_BAR; PG8_SCHED;
            PG8_STAGE(PG8_SB(0, 1), b2 + hstep, voffB);
            PG8_WAIT_V(6); PG8_BAR; PG8_MMA(1, 1, At, B1); PG8_BAR;
            PG8_LDB(B0, 1, 0); PG8_SCHED; PG8_LDA(At, 1, 0); PG8_STAGE(PG8_SA(0, 1), a2 + hstep, voffA);
            PG8_WAIT_L(8); PG8_BAR; PG8_WAIT_L(0); PG8_MMA(0, 0, At, B0); PG8_BAR; PG8_SCHED;
            PG8_LDB(B1, 1, 1); PG8_STAGE(PG8_SB(1, 0), b3, voffB);
            PG8_BAR; PG8_WAIT_L(0); PG8_MMA(0, 1, At, B1); PG8_BAR;
            PG8_LDA(At, 1, 1); PG8_STAGE(PG8_SA(1, 0), a3, voffA);
            PG8_BAR; PG8_WAIT_L(0); PG8_MMA(1, 0, At, B0); PG8_BAR; PG8_SCHED;
            PG8_STAGE(PG8_SB(1, 1), b3 + hstep, voffB);
            PG8_WAIT_V(6); PG8_BAR; PG8_MMA(1, 1, At, B1); PG8_BAR;
            }
        }
        if constexpr (ALIGN_EPI) { if (wr == 0) PG8_BAR; }
        E(acc, cur, wr, wc, fr, fq); S.done(cur);
        if (!has_next) break;
#pragma unroll
        for (int a = 0; a < 2; ++a)
#pragma unroll
            for (int b = 0; b < 2; ++b)
#pragma unroll
                for (int m = 0; m < 4; ++m)
#pragma unroll
                    for (int n = 0; n < 2; ++n) acc[a][b][m][n] = (f32x4){0.f, 0.f, 0.f, 0.f};
        cur = nxt; cA = nA; cB = nB; ++ui;
        if constexpr (ALIGN_EPI) { if (wr == 1) PG8_BAR; }
    }
    PG8_WAIT_V(0);
    if constexpr (!ALIGN_EPI) { if (wr == 0) PG8_BAR; }
    PG8_BAR;
#undef PG8_SA
#undef PG8_SB
#undef PG8_STAGE
#undef PG8_LDA
#undef PG8_LDB
#undef PG8_MMA
#undef PG8_WAIT_V
#undef PG8_WAIT_L
#undef PG8_BAR
#undef PG8_SCHED
}
}

#define XB_TMO      128
#define XB_XCNT(j)  (256  + 64 * (j))
#define XB_XSUB(j)  (1280 + 64 * (j))
#define XB_XGEN(j)  (2304 + 64 * (j))
#define XB_TOP      3328
#define XB_TOPGEN   3392
#define XCD_BAR_WORDS 3456
#define XB_SPIN_CAP (1u << 18)

__device__ __forceinline__ unsigned xb_ld(unsigned* p)              { return __hip_atomic_load(p, __ATOMIC_RELAXED, __HIP_MEMORY_SCOPE_AGENT); }
__device__ __forceinline__ unsigned xb_add(unsigned* p, unsigned v) { return __hip_atomic_fetch_add(p, v, __ATOMIC_RELAXED, __HIP_MEMORY_SCOPE_AGENT); }
__device__ __forceinline__ unsigned xb_xcc_id() { return (unsigned)__builtin_amdgcn_s_getreg((3 << 11) | 20) & 0xFu; }
#define XB_SPIN(cond, bar) do { unsigned _sp = 0; while (cond) { __builtin_amdgcn_s_sleep(1); \
    if ((++_sp & 255u) == 0u) { if (xb_ld(&(bar)[XB_TMO])) break; if (_sp > XB_SPIN_CAP) { atomicAdd(&(bar)[XB_TMO], 1u); break; } } } } while (0)

struct XcdBarrier { unsigned* bar; unsigned x; volatile LAS unsigned* st; };

__device__ __forceinline__ XcdBarrier xcd_barrier_post(unsigned* bar, volatile LAS unsigned* st) {
    XcdBarrier b; b.bar = bar; b.x = xb_xcc_id(); b.st = st;
    if (threadIdx.x == 0) (void)xb_add(&bar[XB_XCNT(b.x)], 1u);
    return b;
}
__device__ __forceinline__ void xcd_barrier_complete(unsigned* bar, unsigned x, unsigned& nloc, unsigned& nx) {
    const unsigned G = gridDim.x * gridDim.y * gridDim.z;
    unsigned sum, cnt, mine, sp = 0u;
    for (;;) {
        sum = 0u; cnt = 0u; mine = 0u;
#pragma unroll
        for (unsigned j = 0; j < 16; ++j) { const unsigned c = xb_ld(&bar[XB_XCNT(j)]); sum += c; cnt += (c > 0u) ? 1u : 0u; mine = (j == x) ? c : mine; }
        if (sum == G) break;
        __builtin_amdgcn_s_sleep(1);
        if ((++sp & 255u) == 0u) { if (xb_ld(&bar[XB_TMO])) break; if (sp > XB_SPIN_CAP) { atomicAdd(&bar[XB_TMO], 1u); break; } }
    }
    nloc = mine > 0u ? mine : 1u; nx = cnt > 0u ? cnt : 1u;
}
__device__ __forceinline__ void xcd_barrier(const XcdBarrier& b) {
    asm volatile("s_waitcnt vmcnt(0)" ::: "memory");
    __syncthreads();
    if (threadIdx.x == 0) {
        unsigned* bar = b.bar;
        __builtin_amdgcn_s_waitcnt(0);
        unsigned nloc = b.st[0], nx = b.st[1];
        if (nloc == 0u) { xcd_barrier_complete(bar, b.x, nloc, nx); b.st[0] = nloc; b.st[1] = nx; }
        const unsigned old = xb_add(&bar[XB_XSUB(b.x)], 1u);
        const unsigned gen = old / nloc;
        if (old + 1u == (gen + 1u) * nloc) {
            __builtin_amdgcn_fence(__ATOMIC_RELEASE, "agent");
            asm volatile("s_waitcnt vmcnt(0)" ::: "memory");
            const unsigned og = xb_add(&bar[XB_TOP], 1u);
            const unsigned tg = og / nx;
            if (og + 1u == (tg + 1u) * nx) xb_add(&bar[XB_TOPGEN], 1u);
            else XB_SPIN(xb_ld(&bar[XB_TOPGEN]) == tg, bar);
            __builtin_amdgcn_fence(__ATOMIC_ACQUIRE, "agent");
            xb_add(&bar[XB_XGEN(b.x)], 1u);
            asm volatile("s_waitcnt vmcnt(0)" ::: "memory");
        } else {
            XB_SPIN(xb_ld(&bar[XB_XGEN(b.x)]) == gen, bar);
            __builtin_amdgcn_fence(__ATOMIC_ACQUIRE, "agent");
            asm volatile("s_waitcnt vmcnt(0)" ::: "memory");
        }
    }
    __syncthreads();
}

constexpr int NWAVES = 8;
constexpr int LDS_BYTES = 163840;
constexpr int LDSCTL_OFF = LDS_BYTES - 512, MISC_OFF = LDSCTL_OFF + 320;
constexpr int NPHASE = 2 + 6 * NLAYER;

#define LDS_WAIT() asm volatile("s_waitcnt lgkmcnt(0)" ::: "memory")

struct Args { const float* in[20]; float* out; unsigned char* ws; int ph_lo, ph_hi, li, pad; };

#define CAS __attribute__((address_space(4)))
struct Frame {
    LAS unsigned char* lds;
    int tid, lane, wave, G, gw, NGW;
    const CAS unsigned char* ka;
    __device__ __forceinline__ const float* x() const { return *(const float* const CAS*)(ka + 0); }
    __device__ __forceinline__ const float* c() const { return *(const float* const CAS*)(ka + 8); }
    __device__ __forceinline__ const float* ctx() const { return *(const float* const CAS*)(ka + 16); }
    __device__ __forceinline__ const float* c_ctx() const { return *(const float* const CAS*)(ka + 24); }
    __device__ __forceinline__ const float* w_ada() const { return *(const float* const CAS*)(ka + 32); }
    __device__ __forceinline__ const float* b_ada() const { return *(const float* const CAS*)(ka + 40); }
    __device__ __forceinline__ const float* w_in() const { return *(const float* const CAS*)(ka + 48); }
    __device__ __forceinline__ const float* conv_w() const { return *(const float* const CAS*)(ka + 56); }
    __device__ __forceinline__ const float* sink() const { return *(const float* const CAS*)(ka + 64); }
    __device__ __forceinline__ const float* g_attn() const { return *(const float* const CAS*)(ka + 72); }
    __device__ __forceinline__ const float* g_conv() const { return *(const float* const CAS*)(ka + 80); }
    __device__ __forceinline__ const float* w_out() const { return *(const float* const CAS*)(ka + 88); }
    __device__ __forceinline__ const float* ln1_g() const { return *(const float* const CAS*)(ka + 96); }
    __device__ __forceinline__ const float* ln1_b() const { return *(const float* const CAS*)(ka + 104); }
    __device__ __forceinline__ const float* wq() const { return *(const float* const CAS*)(ka + 112); }
    __device__ __forceinline__ const float* keys() const { return *(const float* const CAS*)(ka + 120); }
    __device__ __forceinline__ const float* pu() const { return *(const float* const CAS*)(ka + 128); }
    __device__ __forceinline__ const float* pv() const { return *(const float* const CAS*)(ka + 136); }
    __device__ __forceinline__ const float* ln2_g() const { return *(const float* const CAS*)(ka + 144); }
    __device__ __forceinline__ const float* ln2_b() const { return *(const float* const CAS*)(ka + 152); }
    __device__ __forceinline__ float* out() const { return *(float* const CAS*)(ka + 160); }
    __device__ __forceinline__ unsigned char* ws() const { return *(unsigned char* const CAS*)(ka + 168); }
    __device__ __forceinline__ float* MODS() const { return (float*)(ws() + WS_MODS); }
    __device__ __forceinline__ float* ROPE() const { return (float*)(ws() + WS_ROPE); }
    __device__ __forceinline__ bf16_t* X() const { return (bf16_t*)(ws() + WS_X); }
    __device__ __forceinline__ bf16_t* SC() const { return (bf16_t*)(ws() + WS_SC); }
    __device__ __forceinline__ bf16_t* KBD() const { return (bf16_t*)(ws() + WS_KBD); }
    __device__ __forceinline__ bf16_t* WQR() const { return (bf16_t*)(ws() + WS_WQR); }
    __device__ __forceinline__ bf16_t* WINT() const { return (bf16_t*)(ws() + WS_WINT); }
    __device__ __forceinline__ bf16_t* WOUTT() const { return (bf16_t*)(ws() + WS_WOUTT); }
    __device__ __forceinline__ bf16_t* WEFFT() const { return (bf16_t*)(ws() + WS_WEFFT); }
    __device__ __forceinline__ bf16_t* H() const { return (bf16_t*)(ws() + WS_H); }
    __device__ __forceinline__ bf16_t* PROJ() const { return (bf16_t*)(ws() + WS_PROJ); }
    __device__ __forceinline__ bf16_t* MIX() const { return (bf16_t*)(ws() + WS_MIX); }
    __device__ __forceinline__ unsigned char* UT() const { return (unsigned char*)(ws() + WS_UT); }
    __device__ __forceinline__ unsigned char* VT() const { return (unsigned char*)(ws() + WS_VT); }
    __device__ __forceinline__ float* US() const { return (float*)(ws() + WS_US); }
    __device__ __forceinline__ float* VS() const { return (float*)(ws() + WS_VS); }
};

__device__ __forceinline__ void frame_ids(Frame& F) {
    int tz = threadIdx.x; asm volatile("" : "+v"(tz));
    F.tid = tz; F.lane = tz & 63; F.wave = __builtin_amdgcn_readfirstlane(tz >> 6);
    F.gw = blockIdx.x * NWAVES + F.wave;
    const CAS unsigned char* k = (const CAS unsigned char*)__builtin_amdgcn_kernarg_segment_ptr(); asm volatile("" : "+s"(k)); F.ka = k;
}
template <int CTRL> __device__ __forceinline__ int dpp_i(int v) { return __builtin_amdgcn_update_dpp(0, v, CTRL, 0xf, 0xf, true); }
template <int CTRL> __device__ __forceinline__ float dpp_f(float v) { return __int_as_float(dpp_i<CTRL>(__float_as_int(v))); }
constexpr int DPP_XOR1 = 0xB1, DPP_XOR2 = 0x4E, DPP_HMIRROR = 0x141, DPP_ROR4 = 0x124, DPP_ROR8 = 0x128;
__device__ __forceinline__ float wave_sum_u(float v) {
    v += dpp_f<DPP_XOR1>(v); v += dpp_f<DPP_XOR2>(v); v += dpp_f<DPP_ROR4>(v); v += dpp_f<DPP_ROR8>(v);
    const float r0 = __int_as_float(__builtin_amdgcn_readlane(__float_as_int(v), 0)), r1 = __int_as_float(__builtin_amdgcn_readlane(__float_as_int(v), 16));
    const float r2 = __int_as_float(__builtin_amdgcn_readlane(__float_as_int(v), 32)), r3 = __int_as_float(__builtin_amdgcn_readlane(__float_as_int(v), 48));
    return (r0 + r1) + (r2 + r3);
}
__device__ __forceinline__ float wave_max_u(float v) {
    v = fmaxf(v, dpp_f<DPP_XOR1>(v)); v = fmaxf(v, dpp_f<DPP_XOR2>(v)); v = fmaxf(v, dpp_f<DPP_ROR4>(v)); v = fmaxf(v, dpp_f<DPP_ROR8>(v));
    const float r0 = __int_as_float(__builtin_amdgcn_readlane(__float_as_int(v), 0)), r1 = __int_as_float(__builtin_amdgcn_readlane(__float_as_int(v), 16));
    const float r2 = __int_as_float(__builtin_amdgcn_readlane(__float_as_int(v), 32)), r3 = __int_as_float(__builtin_amdgcn_readlane(__float_as_int(v), 48));
    return fmaxf(fmaxf(r0, r1), fmaxf(r2, r3));
}
__device__ __forceinline__ float xor32_f(float v, int lane) { return __int_as_float(__builtin_amdgcn_ds_bpermute((lane ^ 32) << 2, __float_as_int(v))); }
__device__ __forceinline__ float wave_sum(float v) { return wave_sum_u(v); }
__device__ __forceinline__ unsigned pk2(float lo, float hi) { return pg8::cvt_pk_bf16(lo, hi); }
__device__ __forceinline__ float bf_lo(unsigned u) { return __uint_as_float(u << 16); }
__device__ __forceinline__ float bf_hi(unsigned u) { return __uint_as_float(u & 0xffff0000u); }
__device__ __forceinline__ int modrow(int t) { return t < TL ? t / SEQ : 2; }

__device__ __forceinline__ void transpose_item(const float* W, int K, int N, bf16_t* WT, LAS float* scr, int item, int lane) {
    const int nblk = N / 32, kb = item / nblk, nb = item % nblk, k0 = 64 * kb, n0 = 32 * nb;
#pragma unroll 8
    for (int i = 0; i < 32; ++i) { const int kk = 2 * i + (lane >> 5); scr[kk * 33 + (lane & 31)] = W[(size_t)(k0 + kk) * N + n0 + (lane & 31)]; }
    LDS_WAIT(); asm volatile("" ::: "memory");
    const int c = lane & 7;
#pragma unroll
    for (int j = 0; j < 4; ++j) { const int n = (lane >> 3) + 8 * j; const LAS float* s = scr + (8 * c) * 33 + n;
        u32x4 o; o.x = pk2(s[0 * 33], s[1 * 33]); o.y = pk2(s[2 * 33], s[3 * 33]); o.z = pk2(s[4 * 33], s[5 * 33]); o.w = pk2(s[6 * 33], s[7 * 33]);
        *(u32x4*)(WT + (size_t)(n0 + n) * K + k0 + 8 * c) = o; }
    LDS_WAIT(); asm volatile("" ::: "memory");
}

__device__ __forceinline__ void cvt_row_bf16(const float* src, bf16_t* dst, int lane) {
    const f32x4* s = (const f32x4*)src + lane; u32x2* d = (u32x2*)dst + lane;
    f32x4 v[8];
#pragma unroll
    for (int j = 0; j < 8; ++j) v[j] = __builtin_nontemporal_load(s + 64 * j);
#pragma unroll
    for (int j = 0; j < 8; ++j) { u32x2 o; o.x = pk2(v[j].x, v[j].y); o.y = pk2(v[j].z, v[j].w); d[64 * j] = o; }
}

struct RowF32 { f32x4 v[4][2]; };
__device__ __forceinline__ void row_load_nt(RowF32& R, const float* src, int lane) {
    const f32x4* s = (const f32x4*)src + 2 * lane;
#pragma unroll
    for (int j = 0; j < 4; ++j) { R.v[j][0] = __builtin_nontemporal_load(s + 128 * j); R.v[j][1] = __builtin_nontemporal_load(s + 128 * j + 1); }
}
template <int FMT>
__device__ __forceinline__ void cvt_row_lp(const RowF32& R, unsigned char* dst, float* inv, int lane) {
    constexpr float QMAX = FMT == 8 ? 224.f : 6.f;
    float am = 0.f;
#pragma unroll
    for (int j = 0; j < 4; ++j)
#pragma unroll
        for (int q = 0; q < 2; ++q) am = fmaxf(fmaxf(am, fmaxf(fabsf(R.v[j][q].x), fabsf(R.v[j][q].y))), fmaxf(fabsf(R.v[j][q].z), fabsf(R.v[j][q].w)));
    am = wave_max_u(am);
    const float sc = am > 0.f ? QMAX / am : 1.f;
#pragma unroll
    for (int j = 0; j < 4; ++j) {
        if constexpr (FMT == 8) {
            u32x2 w;
#pragma unroll
            for (int q = 0; q < 2; ++q) { int t = __builtin_amdgcn_cvt_pk_fp8_f32(R.v[j][q].x * sc, R.v[j][q].y * sc, 0, false); t = __builtin_amdgcn_cvt_pk_fp8_f32(R.v[j][q].z * sc, R.v[j][q].w * sc, t, true); w[q] = (unsigned)t; }
            *((u32x2*)dst + lane + 64 * j) = w;
        } else {
            unsigned w = 0u;
            w = __builtin_amdgcn_cvt_scalef32_pk_fp4_f32(w, R.v[j][0].x * sc, R.v[j][0].y * sc, 1.0f, 0);
            w = __builtin_amdgcn_cvt_scalef32_pk_fp4_f32(w, R.v[j][0].z * sc, R.v[j][0].w * sc, 1.0f, 1);
            w = __builtin_amdgcn_cvt_scalef32_pk_fp4_f32(w, R.v[j][1].x * sc, R.v[j][1].y * sc, 1.0f, 2);
            w = __builtin_amdgcn_cvt_scalef32_pk_fp4_f32(w, R.v[j][1].z * sc, R.v[j][1].w * sc, 1.0f, 3);
            *((unsigned*)dst + lane + 64 * j) = w;
        }
    }
    if (lane == 0) *inv = am > 0.f ? am * (1.f / QMAX) : 1.f;
}
template <int FMT> struct LpRow;
template <> struct LpRow<8> { u32x4 a, b;
    __device__ __forceinline__ void load(const unsigned char* rowp, int lane) { a = *(const u32x4*)(rowp + 32 * lane); b = *(const u32x4*)(rowp + 32 * lane + 16); }
    template <class Fn> __device__ __forceinline__ void each(Fn&& f) const {
#pragma unroll
        for (int w = 0; w < 4; ++w) { const f32x2 l0 = __builtin_amdgcn_cvt_pk_f32_fp8((int)a[w], false), h0 = __builtin_amdgcn_cvt_pk_f32_fp8((int)a[w], true);
            f(4 * w, l0.x, l0.y); f(4 * w + 2, h0.x, h0.y); }
#pragma unroll
        for (int w = 0; w < 4; ++w) { const f32x2 l0 = __builtin_amdgcn_cvt_pk_f32_fp8((int)b[w], false), h0 = __builtin_amdgcn_cvt_pk_f32_fp8((int)b[w], true);
            f(16 + 4 * w, l0.x, l0.y); f(16 + 4 * w + 2, h0.x, h0.y); }
    } };
template <> struct LpRow<4> { u32x4 a;
    __device__ __forceinline__ void load(const unsigned char* rowp, int lane) { a = *(const u32x4*)(rowp + 16 * lane); }
    template <class Fn> __device__ __forceinline__ void each(Fn&& f) const {
#pragma unroll
        for (int w = 0; w < 4; ++w) {
            const f32x2 d0 = __builtin_amdgcn_cvt_scalef32_pk_f32_fp4(a[w], 1.0f, 0), d1 = __builtin_amdgcn_cvt_scalef32_pk_f32_fp4(a[w], 1.0f, 1);
            const f32x2 d2 = __builtin_amdgcn_cvt_scalef32_pk_f32_fp4(a[w], 1.0f, 2), d3 = __builtin_amdgcn_cvt_scalef32_pk_f32_fp4(a[w], 1.0f, 3);
            f(8 * w, d0.x, d0.y); f(8 * w + 2, d1.x, d1.y); f(8 * w + 4, d2.x, d2.y); f(8 * w + 6, d3.x, d3.y); }
    }
    template <class Fn> __device__ __forceinline__ void each_bf(Fn&& f) const {
#pragma unroll
        for (int w = 0; w < 4; ++w) {
            f(4 * w, __builtin_amdgcn_cvt_scalef32_pk_bf16_fp4(a[w], 1.0f, 0)); f(4 * w + 1, __builtin_amdgcn_cvt_scalef32_pk_bf16_fp4(a[w], 1.0f, 1));
            f(4 * w + 2, __builtin_amdgcn_cvt_scalef32_pk_bf16_fp4(a[w], 1.0f, 2)); f(4 * w + 3, __builtin_amdgcn_cvt_scalef32_pk_bf16_fp4(a[w], 1.0f, 3)); }
    } };

__device__ __forceinline__ void row_stats(const f32x4 (&v)[8], float& mean, float& rstd) {
    float s = 0.f;
#pragma unroll
    for (int j = 0; j < 8; ++j) s += (v[j].x + v[j].y) + (v[j].z + v[j].w);
    mean = wave_sum(s) * (1.f / D);
    float s2 = 0.f;
#pragma unroll
    for (int j = 0; j < 8; ++j) { const f32x4 d = v[j] - mean; s2 += (d.x * d.x + d.y * d.y) + (d.z * d.z + d.w * d.w); }
    rstd = 1.f / sqrtf(wave_sum(s2) * (1.f / D) + LN_EPS);
}
__device__ __forceinline__ void modulate_store(const f32x4 (&v)[8], const float* shift, const float* scale, bf16_t* dst, int lane) {
    float mean, rstd; row_stats(v, mean, rstd);
    u32x2* d = (u32x2*)dst + lane;
#pragma unroll
    for (int j = 0; j < 8; ++j) { const f32x4 sc = *((const f32x4*)scale + lane + 64 * j), sh = *((const f32x4*)shift + lane + 64 * j);
        const f32x4 y = (v[j] - mean) * rstd * (sc + 1.f) + sh;
        u32x2 o; o.x = pk2(y.x, y.y); o.y = pk2(y.z, y.w); d[64 * j] = o; }
}

__device__ __forceinline__ void convert_tables(Frame& F, int row0, int row1, int w0, int wstride) {
    RowF32 ru, rv, nu, nv;
    int row = row0 + w0;
    if (row < row1) { row_load_nt(ru, F.pu() + (size_t)row * D, F.lane); row_load_nt(rv, F.pv() + (size_t)row * D, F.lane); }
    while (row < row1) {
        const int nrow = row + wstride;
        if (nrow < row1) { row_load_nt(nu, F.pu() + (size_t)nrow * D, F.lane); row_load_nt(nv, F.pv() + (size_t)nrow * D, F.lane); }
        cvt_row_lp<U_FMT>(ru, F.UT() + (size_t)row * UROW, F.US() + 2 * (size_t)row, F.lane);
        cvt_row_lp<V_FMT>(rv, F.VT() + (size_t)row * VROW, F.US() + 2 * (size_t)row + 1, F.lane);
        ru = nu; rv = nv; row = nrow;
    }
}
__device__ __forceinline__ void convert_in_tail(Frame& F, int layer, int nunits, int part) {
    if (layer + 1 >= NLAYER) return;
    const int G = F.G, rounds = (nunits + G - 1) / G, nlast = nunits - (rounds - 1) * G;
    const int c = (int)blockIdx.x;
    int nshort = G - nlast, sidx = c - nlast;
    if (nshort <= 0) { nshort = G; sidx = c; }
    else if (sidx < 0) return;
    const int r0 = (layer + 1) * NEXP + part * (NEXP / 2);
    convert_tables(F, r0, r0 + NEXP / 2, sidx * NWAVES + F.wave, nshort * NWAVES);
}
__device__ __forceinline__ void p0a_prologue(Frame& F) {
    LAS float* condL = (LAS float*)F.lds;
    LAS float* red = (LAS float*)(F.lds + 24576);
    for (int i = F.tid; i < 3 * D; i += NWAVES * 64) { const int r = i / D, k = i % D; const float v = r < 2 ? F.c()[r * D + k] : F.c_ctx()[k]; condL[i] = v / (1.f + __expf(-v)); }
    __syncthreads();
    for (int item = blockIdx.x; item < 384; item += F.G) {
        const int l = item / 96, n0 = (item % 96) * 128;
        const float* wp = F.w_ada() + ((size_t)l * D + F.wave * 256) * 12288 + n0 + 2 * F.lane;
        f32x2 a0 = {0.f, 0.f}, a1 = {0.f, 0.f}, a2 = {0.f, 0.f};
#pragma unroll 8
        for (int k = 0; k < 256; ++k) { const f32x2 w = __builtin_nontemporal_load((const f32x2*)(wp + (size_t)k * 12288)); const int kk = F.wave * 256 + k;
            a0 += w * condL[kk]; a1 += w * condL[D + kk]; a2 += w * condL[2 * D + kk]; }
        LAS float* rp = red + F.wave * 384 + 2 * F.lane;
        rp[0] = a0.x; rp[1] = a0.y; rp[128] = a1.x; rp[129] = a1.y; rp[256] = a2.x; rp[257] = a2.y;
        __syncthreads();
        if (F.tid < 384) { const int r = F.tid / 128, n = F.tid % 128; float s = 0.f;
#pragma unroll
            for (int w = 0; w < 8; ++w) s += red[w * 384 + r * 128 + n];
            F.MODS()[((size_t)l * 3 + r) * 12288 + n0 + n] = s + F.b_ada()[(size_t)l * 12288 + n0 + n]; }
        __syncthreads();
    }
    LAS float* scr = (LAS float*)(F.lds + 40960 + F.wave * 8448);
    constexpr int I_IN = (D / 64) * (INC / 32), I_OUT = (D / 64) * (D / 32);
    for (int it = F.gw; it < NLAYER * (I_IN + I_OUT); it += F.NGW) {
        const int l = it / (I_IN + I_OUT); int r = it % (I_IN + I_OUT);
        if (r < I_IN) transpose_item(F.w_in() + (size_t)l * D * INC, D, INC, F.WINT() + (size_t)l * INC * D, scr, r, F.lane);
        else transpose_item(F.w_out() + (size_t)l * D * D, D, D, F.WOUTT() + (size_t)l * D * D, scr, r - I_IN, F.lane);
    }
    for (int row = F.gw; row < NLAYER * D; row += F.NGW) {
        const int l = row / D, c = row % D; const f32x4* s = (const f32x4*)(F.wq() + (size_t)row * D) + F.lane;
#pragma unroll
        for (int j = 0; j < 8; ++j) { const f32x4 v = s[64 * j]; u32x2 o; o.x = pk2(v.x, v.y); o.y = pk2(v.z, v.w);
            *((u32x2*)(F.WQR() + ((size_t)(l * 8 + j) * D + c) * 256) + F.lane) = o; }
    }
    for (int row = F.gw; row < 32 * 256; row += F.NGW) {
        const int lh = row >> 8, pk = row & 255, p = pk >> 7;
        u32x2 o = {0u, 0u};
        if ((F.lane >> 5) == p) { const f32x4 v = *((const f32x4*)(F.keys() + ((size_t)lh * 256 + pk) * 128) + (F.lane & 31)); o.x = pk2(v.x, v.y); o.y = pk2(v.z, v.w); }
        *((u32x2*)(F.KBD() + (size_t)row * 256) + F.lane) = o;
    }
    convert_tables(F, 0, NEXP, F.gw, F.NGW);
    for (int i = blockIdx.x * (NWAVES * 64) + F.tid; i < 192 * 32; i += F.G * NWAVES * 64) {
        const int idx = i >> 5, f = i & 31; const float pos = (float)(idx < 128 ? idx : idx - 128);
        const float inv = powf(10000.f, -(float)(2 * f) / 64.f); const float ang = pos * inv;
        F.ROPE()[2 * i] = cosf(ang); F.ROPE()[2 * i + 1] = sinf(ang);
    }
}

__device__ __forceinline__ void p0b_mod0(Frame& F) {
    __syncthreads();
#pragma unroll 1
    for (int v = 0; v < 6; ++v)
        *(LAS f32x4*)(F.lds + v * 8192 + F.tid * 16) = *(const f32x4*)(F.MODS() + (size_t)(v % 3) * 12288 + (v < 3 ? 0 : D) + 4 * F.tid);
    __syncthreads();
    for (int t = F.gw; t < TT; t += F.NGW) {
        const float* src = t < TL ? F.x() + (size_t)t * D : F.ctx() + (size_t)(t - TL) * D;
        f32x4 v[8];
#pragma unroll
        for (int j = 0; j < 8; ++j) v[j] = *((const f32x4*)src + F.lane + 64 * j);
        const int mr = modrow(t);
        float mean, rstd; row_stats(v, mean, rstd);
        u32x2* d = (u32x2*)(F.H() + (size_t)t * D) + F.lane;
#pragma unroll
        for (int j = 0; j < 8; ++j) { const f32x4 sh = *(const LAS f32x4*)(F.lds + mr * 8192 + (64 * j + F.lane) * 16), sc = *(const LAS f32x4*)(F.lds + (3 + mr) * 8192 + (64 * j + F.lane) * 16);
            const f32x4 y = (v[j] - mean) * rstd * (sc + 1.f) + sh;
            u32x2 o; o.x = pk2(y.x, y.y); o.y = pk2(y.z, y.w); d[64 * j] = o; }
    }
}

constexpr int ROPE_LDS = 98304;
constexpr int CONV_LDS = 81920;
constexpr int KP = 272, VP = 320, KS_BYTES = 64 * KP, VS_BYTES = 64 * VP;
struct KVRegs { u32x4 k1, k2, v1, v2; f32x4 cs[4]; };

__device__ __forceinline__ void attn_load_tile(Frame& F, KVRegs& R, int ti, int b, int n, int g) {
    const int key = F.tid >> 3, c8 = F.tid & 7;
    int row, pos = 0;
    if (ti < 6) { pos = (n - 1) * 128 + 64 * ti + key; row = b * SEQ + pos; } else row = TL + b * CTXL + 64 * (ti - 6) + key;
    const bf16_t* base = F.PROJ() + (size_t)row * INC;
    const int d1 = (c8 >> 2) * 64 + (c8 & 3) * 8;
    R.k1 = *(const u32x4*)(base + OFF_K + g * 128 + d1); R.k2 = *(const u32x4*)(base + OFF_K + g * 128 + d1 + 32);
    R.v1 = *(const u32x4*)(base + OFF_V + g * 128 + 8 * c8); R.v2 = *(const u32x4*)(base + OFF_V + g * 128 + 64 + 8 * c8);
    if (ti < 6) { const int tidx = (c8 >> 2) ? 128 + (pos & 63) : (pos >> 6); const LAS f32x4* cp = (const LAS f32x4*)(F.lds + ROPE_LDS + (tidx * 32 + (c8 & 3) * 8) * 8);
#pragma unroll
        for (int m = 0; m < 4; ++m) R.cs[m] = cp[m]; }
}
__device__ __forceinline__ void rope8(u32x4& a, u32x4& bq, const f32x4 (&cs)[4], float scale) {
    u32x4 oa, ob;
#pragma unroll
    for (int w = 0; w < 4; ++w) {
        const float x1l = bf_lo(a[w]), x1h = bf_hi(a[w]), x2l = bf_lo(bq[w]), x2h = bf_hi(bq[w]);
        const float cl = cs[w].x, sl = cs[w].y, ch = cs[w].z, sh = cs[w].w;
        oa[w] = pk2((x1l * cl - x2l * sl) * scale, (x1h * ch - x2h * sh) * scale);
        ob[w] = pk2((x2l * cl + x1l * sl) * scale, (x2h * ch + x1h * sh) * scale);
    }
    a = oa; bq = ob;
}
__device__ __forceinline__ void attn_store_tile(Frame& F, KVRegs& R, int ti, int buf) {
    const int key = F.tid >> 3, c8 = F.tid & 7;
    if (ti < 6) rope8(R.k1, R.k2, R.cs, 1.f);
    const int d1 = (c8 >> 2) * 64 + (c8 & 3) * 8;
    LAS unsigned char* kp = F.lds + buf * KS_BYTES + key * KP;
    *(LAS u32x4*)(kp + d1 * 2) = R.k1; *(LAS u32x4*)(kp + (d1 + 32) * 2) = R.k2;
    LAS unsigned char* vp = F.lds + 2 * KS_BYTES + buf * VS_BYTES + key * VP;
    *(LAS u32x4*)(vp + 16 * c8) = R.v1; *(LAS u32x4*)(vp + 128 + 16 * c8) = R.v2;
}

#define MFMA32(a, b, c) __builtin_amdgcn_mfma_f32_32x32x16_bf16((a), (b), (c), 0, 0, 0)

__device__ __forceinline__ void attn_unit(Frame& F, int layer, int u) {
    const bool latent = u < 512;
    int b, n, g, hp;
    if (latent) { hp = u & 1; g = (u >> 1) & 1; n = (u >> 2) & 63; b = u >> 8; }
    else { const int v = u - 512; hp = v & 1; g = (v >> 1) & 1; n = (v >> 2) & 1; b = v >> 3; }
    const int lane = F.lane, r = lane & 31, h = lane >> 5, wave = F.wave;
    const int head = g * 4 + hp * 2 + (wave >> 2), qb = wave & 3;
    const int tq = latent ? b * SEQ + n * 128 + 32 * qb + r : TL + b * CTXL + n * 128 + 32 * qb + r;
    bf16x8 qf[8];
    {
        u32x4 raw[8];
        const bf16_t* qp = F.PROJ() + (size_t)tq * INC + OFF_Q + head * 128 + 8 * h;
#pragma unroll
        for (int ks = 0; ks < 8; ++ks) raw[ks] = *(const u32x4*)(qp + 16 * ks);
        if (latent) {
            const int pos = n * 128 + 32 * qb + r;
#pragma unroll
            for (int half = 0; half < 2; ++half) {
                const int tidx = half ? 128 + (pos & 63) : (pos >> 6);
#pragma unroll
                for (int kk = 0; kk < 2; ++kk) {
                    const LAS f32x4* cp = (const LAS f32x4*)(F.lds + ROPE_LDS + (tidx * 32 + 16 * kk + 8 * h) * 8);
                    f32x4 cs[4];
#pragma unroll
                    for (int m = 0; m < 4; ++m) cs[m] = cp[m];
                    rope8(raw[4 * half + kk], raw[4 * half + kk + 2], cs, QSCALE);
                }
            }
        } else {
#pragma unroll
            for (int ks = 0; ks < 8; ++ks)
#pragma unroll
                for (int w = 0; w < 4; ++w) raw[ks][w] = pk2(bf_lo(raw[ks][w]) * QSCALE, bf_hi(raw[ks][w]) * QSCALE);
        }
#pragma unroll
        for (int ks = 0; ks < 8; ++ks) qf[ks] = __builtin_bit_cast(bf16x8, raw[ks]);
    }
    int tlo = 6, nw = 0;
    if (latent) { tlo = (n == 0) ? 2 : 0; const int thi = (n == 63) ? 3 : 5; nw = thi - tlo + 1; }
    const int ntiles = nw + 4;
    f32x16 o[4];
#pragma unroll
    for (int db = 0; db < 4; ++db)
#pragma unroll
        for (int i = 0; i < 16; ++i) o[db][i] = 0.f;
    float m_run = F.sink()[layer * 8 + head] * LOG2E;
    float lsum = h == 0 ? 1.f : 0.f;
    const int iq = 32 * qb + r;
    KVRegs R;
    __syncthreads();
    attn_load_tile(F, R, nw > 0 ? tlo : 6, b, n, g);
    attn_store_tile(F, R, nw > 0 ? tlo : 6, 0);
    __syncthreads();
    const int i16 = lane & 15, tq4 = i16 >> 2, tp = i16 & 3, blk = (lane >> 4) & 1;
    for (int j = 0; j < ntiles; ++j) {
        const int ti = j < nw ? tlo + j : 6 + (j - nw);
        const int buf = j & 1;
        const bool more = j + 1 < ntiles;
        const int tin = (j + 1) < nw ? tlo + j + 1 : 6 + (j + 1 - nw);
        if (more) attn_load_tile(F, R, tin, b, n, g);
        const bool part = ti >= 6 || (ti >= (qb >> 1) && ti <= (qb >> 1) + 4);
        if (part) {
            f32x16 s0, s1;
#pragma unroll
            for (int i = 0; i < 16; ++i) { s0[i] = 0.f; s1[i] = 0.f; }
            const LAS unsigned char* kb = F.lds + buf * KS_BYTES + r * KP + h * 16;
#pragma unroll
            for (int ks = 0; ks < 8; ++ks) {
                const bf16x8 a0 = *(const LAS bf16x8*)(kb + ks * 32), a1 = *(const LAS bf16x8*)(kb + 32 * KP + ks * 32);
                s0 = MFMA32(a0, qf[ks], s0); s1 = MFMA32(a1, qf[ks], s1);
            }
            float mx = -INFINITY;
            if (ti < 6 && (ti == (qb >> 1) || ti == (qb >> 1) + 4)) {
                const int jb = 64 * ti + 4 * h - iq;
#pragma unroll
                for (int i = 0; i < 16; ++i) { const int j0 = jb + (i & 3) + 8 * (i >> 2), j1 = j0 + 32;
                    s0[i] = (j0 >= 0 && j0 <= 256) ? s0[i] : -INFINITY; s1[i] = (j1 >= 0 && j1 <= 256) ? s1[i] : -INFINITY; }
            }
#pragma unroll
            for (int i = 0; i < 16; ++i) mx = fmaxf(mx, fmaxf(s0[i], s1[i]));
            mx = fmaxf(mx, xor32_f(mx, lane));
            if (__any(mx > m_run + 8.f)) {
                const float m_new = mx > m_run + 8.f ? mx : m_run, alpha = __builtin_amdgcn_exp2f(m_run - m_new);
                m_run = m_new; lsum *= alpha;
#pragma unroll
                for (int db = 0; db < 4; ++db)
#pragma unroll
                    for (int i = 0; i < 16; ++i) o[db][i] *= alpha;
            }
#pragma unroll
            for (int i = 0; i < 16; ++i) { s0[i] = __builtin_amdgcn_exp2f(s0[i] - m_run); s1[i] = __builtin_amdgcn_exp2f(s1[i] - m_run); lsum += s0[i] + s1[i]; }
            bf16x8 pf[2][2];
#pragma unroll
            for (int s2 = 0; s2 < 2; ++s2) {
                u32x4 p0, p1;
#pragma unroll
                for (int w = 0; w < 4; ++w) { p0[w] = pk2(s0[8 * s2 + 2 * w], s0[8 * s2 + 2 * w + 1]); p1[w] = pk2(s1[8 * s2 + 2 * w], s1[8 * s2 + 2 * w + 1]); }
                pf[0][s2] = __builtin_bit_cast(bf16x8, p0); pf[1][s2] = __builtin_bit_cast(bf16x8, p1);
            }
            const LAS unsigned char* vb = F.lds + 2 * KS_BYTES + buf * VS_BYTES + (4 * h + tq4) * VP + 32 * blk + 8 * tp;
#pragma unroll
            for (int db = 0; db < 4; ++db)
#pragma unroll
                for (int kb2 = 0; kb2 < 2; ++kb2)
#pragma unroll
                    for (int s2 = 0; s2 < 2; ++s2) {
                        const int off = (32 * kb2 + 16 * s2) * VP + db * 64;
                        const s16x4 lo = __builtin_amdgcn_ds_read_tr16_b64_v4i16((LAS s16x4*)(vb + off));
                        const s16x4 hi = __builtin_amdgcn_ds_read_tr16_b64_v4i16((LAS s16x4*)(vb + off + 8 * VP));
                        const bf16x8 av = __builtin_shufflevector(lo, hi, 0, 1, 2, 3, 4, 5, 6, 7);
                        o[db] = MFMA32(av, pf[kb2][s2], o[db]);
                    }
        }
        if (more) attn_store_tile(F, R, tin, buf ^ 1);
        __syncthreads();
    }
    const float lt = lsum + xor32_f(lsum, lane);
    const float inv = 1.f / lt;
    float ss = 0.f;
#pragma unroll
    for (int db = 0; db < 4; ++db)
#pragma unroll
        for (int i = 0; i < 16; ++i) { o[db][i] *= inv; ss += o[db][i] * o[db][i]; }
    ss += xor32_f(ss, lane);
    const float rn = 1.f / sqrtf(ss * (1.f / 128.f) + LN_EPS);
    bf16_t* op = F.MIX() + (size_t)tq * D + head * 128 + 4 * h;
    const float* gp = F.g_attn() + layer * 1024 + head * 128 + 4 * h;
#pragma unroll
    for (int db = 0; db < 4; ++db)
#pragma unroll
        for (int g4 = 0; g4 < 4; ++g4) {
            const f32x4 gv = *(const f32x4*)(gp + 32 * db + 8 * g4);
            u32x2 w; w.x = pk2(o[db][4 * g4] * rn * gv.x, o[db][4 * g4 + 1] * rn * gv.y); w.y = pk2(o[db][4 * g4 + 2] * rn * gv.z, o[db][4 * g4 + 3] * rn * gv.w);
            *(u32x2*)(op + 32 * db + 8 * g4) = w;
        }
}

__device__ __forceinline__ void unpack8(const u32x4 v, float (&f)[8]) {
#pragma unroll
    for (int w = 0; w < 4; ++w) { f[2 * w] = bf_lo(v[w]); f[2 * w + 1] = bf_hi(v[w]); }
}
__device__ __forceinline__ void conv_row(Frame& F, int layer, int t) {
    bool first, last;
    if (t < TL) { const int pos = t & (SEQ - 1); first = pos == 0; last = pos == SEQ - 1; } else { const int pc = (t - TL) & (CTXL - 1); first = pc == 0; last = pc == CTXL - 1; }
    const bf16_t* p = F.PROJ() + (size_t)t * INC;
    const LAS unsigned char* cvc = F.lds + CONV_LDS + F.lane * 16;
#pragma unroll
    for (int jc = 0; jc < 2; ++jc) {
        const int c = 8 * F.lane + 512 * jc;
        float gb[8], a[8], bq[8], um[8], ut[8], up[8];
        unpack8(*(const u32x4*)(p + c), gb);
        unpack8(*(const u32x4*)(p + OFF_C + c), a); unpack8(*(const u32x4*)(p + OFF_X + c), bq);
#pragma unroll
        for (int e = 0; e < 8; ++e) ut[e] = a[e] * bq[e];
        if (!first) { unpack8(*(const u32x4*)(p - INC + OFF_C + c), a); unpack8(*(const u32x4*)(p - INC + OFF_X + c), bq);
#pragma unroll
            for (int e = 0; e < 8; ++e) um[e] = a[e] * bq[e]; }
        else {
#pragma unroll
            for (int e = 0; e < 8; ++e) um[e] = 0.f; }
        if (!last) { unpack8(*(const u32x4*)(p + INC + OFF_C + c), a); unpack8(*(const u32x4*)(p + INC + OFF_X + c), bq);
#pragma unroll
            for (int e = 0; e < 8; ++e) up[e] = a[e] * bq[e]; }
        else {
#pragma unroll
            for (int e = 0; e < 8; ++e) up[e] = 0.f; }
        float y[8], ss = 0.f;
#pragma unroll
        for (int q = 0; q < 2; ++q) { const f32x4 w0 = *(const LAS f32x4*)(cvc + (2 * jc + q) * 1024), w1 = *(const LAS f32x4*)(cvc + 4096 + (2 * jc + q) * 1024), w2 = *(const LAS f32x4*)(cvc + 8192 + (2 * jc + q) * 1024);
#pragma unroll
            for (int e = 0; e < 4; ++e) { const int i = 4 * q + e; y[i] = gb[i] * (w0[e] * um[i] + w1[e] * ut[i] + w2[e] * up[i]); ss += y[i] * y[i]; } }
        ss += dpp_f<DPP_XOR1>(ss); ss += dpp_f<DPP_XOR2>(ss); ss += dpp_f<DPP_ROR4>(ss); ss += dpp_f<DPP_ROR8>(ss);
        const float rn = 1.f / sqrtf(ss * (1.f / 128.f) + LN_EPS);
        u32x4 w;
#pragma unroll
        for (int q = 0; q < 2; ++q) { const f32x4 gcv = *(const LAS f32x4*)(cvc + 12288 + (2 * jc + q) * 1024); w[2 * q] = pk2(y[4 * q] * rn * gcv[0], y[4 * q + 1] * rn * gcv[1]); w[2 * q + 1] = pk2(y[4 * q + 2] * rn * gcv[2], y[4 * q + 3] * rn * gcv[3]); }
        *(u32x4*)(F.MIX() + (size_t)t * D + 1024 + c) = w;
    }
}

__device__ __forceinline__ void ln_phase(Frame& F, int layer, int rows) {
    const int lane = F.lane;
    u32x4 w[4], wn[4];
    int t = F.gw;
    if (t < rows) {
#pragma unroll
        for (int j = 0; j < 4; ++j) w[j] = *(const u32x4*)(F.X() + (size_t)t * D + 8 * lane + 512 * j);
    }
    {
        const int ch = F.tid, jj = ch >> 7, rem = ch & 127, ll = rem >> 1, qq = rem & 1;
        LAS unsigned char* dst = F.lds + ((2 * jj + qq) * 64 + ll) * 16;
        *(LAS f32x4*)(dst) = *(const f32x4*)(F.ln1_g() + layer * D + 4 * ch);
        *(LAS f32x4*)(dst + 8192) = *(const f32x4*)(F.ln1_b() + layer * D + 4 * ch);
#pragma unroll 1
        for (int v = 0; v < 6; ++v) { const int mrv = v % 3; const size_t off = ((size_t)layer * 3 + mrv) * 12288 + (v < 3 ? 3 * D : 4 * D);
            *(LAS f32x4*)(dst + (2 + v) * 8192) = *(const f32x4*)(F.MODS() + off + 4 * ch); }
    }
    __syncthreads();
    const LAS unsigned char* vc = F.lds + lane * 16;
    while (t < rows) {
        const int tn = t + F.NGW;
        if (tn < rows) {
#pragma unroll
            for (int j = 0; j < 4; ++j) wn[j] = *(const u32x4*)(F.X() + (size_t)tn * D + 8 * lane + 512 * j);
        }
        float v[32]; float s = 0.f;
#pragma unroll
        for (int j = 0; j < 4; ++j)
#pragma unroll
            for (int q = 0; q < 4; ++q) { v[8 * j + 2 * q] = bf_lo(w[j][q]); v[8 * j + 2 * q + 1] = bf_hi(w[j][q]); s += v[8 * j + 2 * q] + v[8 * j + 2 * q + 1]; }
        const float mean = wave_sum(s) * (1.f / D);
        float s2 = 0.f;
#pragma unroll
        for (int i = 0; i < 32; ++i) { v[i] -= mean; s2 += v[i] * v[i]; }
        const float rstd = 1.f / sqrtf(wave_sum(s2) * (1.f / D) + LN_EPS);
        float s3 = 0.f;
#pragma unroll
        for (int j = 0; j < 4; ++j) { const int c = 8 * lane + 512 * j; u32x4 o;
#pragma unroll
            for (int q = 0; q < 2; ++q) { const f32x4 gg = *(const LAS f32x4*)(vc + (2 * j + q) * 1024), bb = *(const LAS f32x4*)(vc + 8192 + (2 * j + q) * 1024);
#pragma unroll
                for (int e = 0; e < 4; ++e) { const float y = v[8 * j + 4 * q + e] * rstd * gg[e] + bb[e]; v[8 * j + 4 * q + e] = y; s3 += y; }
                o[2 * q] = pk2(v[8 * j + 4 * q], v[8 * j + 4 * q + 1]); o[2 * q + 1] = pk2(v[8 * j + 4 * q + 2], v[8 * j + 4 * q + 3]); }
            *(u32x4*)(F.X() + (size_t)t * D + c) = o; }
        const float mean2 = wave_sum(s3) * (1.f / D);
        float s4 = 0.f;
#pragma unroll
        for (int i = 0; i < 32; ++i) { v[i] -= mean2; s4 += v[i] * v[i]; }
        const float rstd2 = 1.f / sqrtf(wave_sum(s4) * (1.f / D) + LN_EPS);
        const int mrl = modrow(t);
#pragma unroll
        for (int j = 0; j < 4; ++j) { const int c = 8 * lane + 512 * j; u32x4 o;
#pragma unroll
            for (int q = 0; q < 2; ++q) { const f32x4 sh = *(const LAS f32x4*)(vc + (2 + mrl) * 8192 + (2 * j + q) * 1024), sc = *(const LAS f32x4*)(vc + (5 + mrl) * 8192 + (2 * j + q) * 1024);
                const float y0 = v[8 * j + 4 * q] * rstd2 * (1.f + sc[0]) + sh[0], y1 = v[8 * j + 4 * q + 1] * rstd2 * (1.f + sc[1]) + sh[1];
                const float y2 = v[8 * j + 4 * q + 2] * rstd2 * (1.f + sc[2]) + sh[2], y3 = v[8 * j + 4 * q + 3] * rstd2 * (1.f + sc[3]) + sh[3];
                o[2 * q] = pk2(y0, y1); o[2 * q + 1] = pk2(y2, y3); }
            *(u32x4*)(F.H() + (size_t)t * D + c) = o; }
#pragma unroll
        for (int j = 0; j < 4; ++j) w[j] = wn[j];
        t = tn;
    }
}

__device__ __forceinline__ unsigned ordkey(float f) { const unsigned u = __float_as_uint(f); return u ^ ((u >> 31) ? 0xFFFFFFFFu : 0x80000000u); }
__device__ __forceinline__ float gelu_erf(float a) { return 0.5f * a * (1.f + erff(a * 0.70710678118654752f)); }

__device__ __forceinline__ float unordkey(unsigned k) { return __uint_as_float(k ^ ((k >> 31) ? 0x80000000u : 0xFFFFFFFFu)); }
__device__ __forceinline__ float gelu_as(float v) {
    const float av = fabsf(v), t = __builtin_amdgcn_rcpf(av * 0.2316418882f + 1.0f);
    float q = t * 0.5307027145f + (-0.7265760135f); q = q * t + 0.7107068705f; q = q * t + (-0.142248368f); q = q * t + 0.127414796f; q = q * t;
    const float e = __builtin_amdgcn_exp2f((v * v) * (-0.72134752044f));
    const float m = v * (q * e);
    return v < 0.f ? m : v - m;
}

template <class O> struct QuadNet {
    typedef typename O::V V; typedef typename O::B B;
    template <bool ASC> static __device__ __forceinline__ void ce_reg(V& a, V& b) { const V lo = O::vmin(a, b), hi = O::vmax(a, b); a = ASC ? lo : hi; b = ASC ? hi : lo; }
    template <bool ASC> static __device__ __forceinline__ void ce_l1(V& x, B low1) { const V p = O::x1(x); const V mn = O::vmin(p, x), mx = O::vmax(p, x); x = ASC ? O::vsel(low1, mn, mx) : O::vsel(low1, mx, mn); }
    template <bool ASC> static __device__ __forceinline__ void ce_l2(V& x, B low2) { const V p = O::x2(x); const V mn = O::vmin(p, x), mx = O::vmax(p, x); x = ASC ? O::vsel(low2, mn, mx) : O::vsel(low2, mx, mn); }
    template <int NR> static __device__ __forceinline__ void sort_blocks(V (&R)[NR], B low1, B low2, B eq12) {
#pragma unroll
        for (int r = 0; r < NR; ++r) { const V p = O::x1(R[r]); const V mn = O::vmin(p, R[r]), mx = O::vmax(p, R[r]); R[r] = O::vsel(eq12, mn, mx); }
#pragma unroll
        for (int r = 0; r < NR; ++r) { if ((r & 1) == 0) ce_l2<true>(R[r], low2); else ce_l2<false>(R[r], low2); }
#pragma unroll
        for (int r = 0; r < NR; ++r) { if ((r & 1) == 0) ce_l1<true>(R[r], low1); else ce_l1<false>(R[r], low1); }
#pragma unroll
        for (int r = 0; r < NR; r += 2) { if ((r & 2) == 0) ce_reg<true>(R[r], R[r + 1]); else ce_reg<false>(R[r], R[r + 1]); }
#pragma unroll
        for (int r = 0; r < NR; ++r) { if ((r & 2) == 0) ce_l2<true>(R[r], low2); else ce_l2<false>(R[r], low2); }
#pragma unroll
        for (int r = 0; r < NR; ++r) { if ((r & 2) == 0) ce_l1<true>(R[r], low1); else ce_l1<false>(R[r], low1); }
#pragma unroll
        for (int r = 0; r < NR; ++r) { if ((r & 2) == 0) { if ((r & 4) == 0) ce_reg<true>(R[r], R[r + 2]); else ce_reg<false>(R[r], R[r + 2]); } }
#pragma unroll
        for (int r = 0; r < NR; r += 2) { if ((r & 4) == 0) ce_reg<true>(R[r], R[r + 1]); else ce_reg<false>(R[r], R[r + 1]); }
#pragma unroll
        for (int r = 0; r < NR; ++r) { if ((r & 4) == 0) ce_l2<true>(R[r], low2); else ce_l2<false>(R[r], low2); }
#pragma unroll
        for (int r = 0; r < NR; ++r) { if ((r & 4) == 0) ce_l1<true>(R[r], low1); else ce_l1<false>(R[r], low1); }
    }
    template <int NR> static __device__ __forceinline__ void halve_merge(const V (&R)[NR], V (&Q)[NR / 2], B low1, B low2) {
#pragma unroll
        for (int m = 0; m < NR / 8; ++m)
#pragma unroll
            for (int i = 0; i < 4; ++i) Q[4 * m + i] = O::vmax(R[8 * m + i], R[8 * m + 4 + i]);
#pragma unroll
        for (int r = 0; r < NR / 2; ++r) { if ((r & 2) == 0) { if ((r & 4) == 0) ce_reg<false>(Q[r], Q[r + 2]); else ce_reg<true>(Q[r], Q[r + 2]); } }
#pragma unroll
        for (int r = 0; r < NR / 2; r += 2) { if ((r & 4) == 0) ce_reg<false>(Q[r], Q[r + 1]); else ce_reg<true>(Q[r], Q[r + 1]); }
#pragma unroll
        for (int r = 0; r < NR / 2; ++r) { if ((r & 4) == 0) ce_l2<false>(Q[r], low2); else ce_l2<true>(Q[r], low2); }
#pragma unroll
        for (int r = 0; r < NR / 2; ++r) { if ((r & 4) == 0) ce_l1<false>(Q[r], low1); else ce_l1<true>(Q[r], low1); }
    }
    static __device__ __forceinline__ void top16_of_128(V (&R)[32], V (&T)[4], B low1, B low2, B eq12) {
        sort_blocks<32>(R, low1, low2, eq12);
        V A[16]; halve_merge<32>(R, A, low1, low2);
        V Bq[8]; halve_merge<16>(A, Bq, low1, low2);
        halve_merge<8>(Bq, T, low1, low2);
    }
    static __device__ __forceinline__ void top16_of_64(V (&R)[16], V (&T)[4], B low1, B low2, B eq12) {
        sort_blocks<16>(R, low1, low2, eq12);
        V A[8]; halve_merge<16>(R, A, low1, low2);
        halve_merge<8>(A, T, low1, low2);
    }
};

struct DevOps {
    typedef unsigned V; typedef bool B;
    static __device__ __forceinline__ V vmin(V a, V b) { return a < b ? a : b; }
    static __device__ __forceinline__ V vmax(V a, V b) { return a > b ? a : b; }
    static __device__ __forceinline__ V vsel(B m, V a, V b) { return m ? a : b; }
    static __device__ __forceinline__ V x1(V a) { return (V)dpp_i<DPP_XOR1>((int)a); }
    static __device__ __forceinline__ V x2(V a) { return (V)dpp_i<DPP_XOR2>((int)a); }
};
__device__ __forceinline__ void stair_ab(int c, int& a, int& b) {
    if (c < 16) { a = 0; b = c; } else if (c < 24) { a = 1; b = c - 16; } else if (c < 28) { a = 2; b = c - 24; } else if (c < 32) { a = 3; b = c - 28; }
    else if (c < 36) { a = 4; b = c - 32; } else if (c < 40) { a = 5 + ((c - 36) >> 1); b = (c - 36) & 1; } else if (c < 44) { a = 7 + ((c - 40) >> 1); b = (c - 40) & 1; }
    else if (c < 48) { a = 9 + (c - 44); b = 0; } else if (c < 51) { a = 13 + (c - 48); b = 0; } else { a = 2; b = 4; }
}
constexpr int PE_WS = 5120, PE_TAB = 8 * PE_WS;
constexpr int PE_VEC = PE_TAB + 512;
static_assert(PE_VEC + 11 * 8192 <= LDSCTL_OFF, "PE vector cache");
__device__ __forceinline__ void peer_topk(Frame& F, LAS unsigned char* ws, int t) {
    const int lane = F.lane, sub = lane & 3;
    const bool low1 = (sub & 1) == 0, low2 = (sub & 2) == 0, eq12 = low1 == low2;
    LAS unsigned* S1K = (LAS unsigned*)ws; LAS int* EL = (LAS int*)(ws + 3328); LAS float* GL = (LAS float*)(ws + 3840);
    const LAS unsigned short* TAB = (const LAS unsigned short*)(F.lds + PE_TAB);
    {
        const int L = lane >> 2;
        const bf16_t* sp = F.SC() + (size_t)t * D + L * 128 + sub * 32;
        unsigned R[32];
#pragma unroll
        for (int q = 0; q < 4; ++q) { const u32x4 v = *(const u32x4*)(sp + 8 * q);
#pragma unroll
            for (int e = 0; e < 4; ++e) {
                R[8 * q + 2 * e] = (ordkey(bf_lo(v[e])) & ~127u) | (unsigned)(127 - (32 * sub + 8 * q + 2 * e));
                R[8 * q + 2 * e + 1] = (ordkey(bf_hi(v[e])) & ~127u) | (unsigned)(127 - (32 * sub + 8 * q + 2 * e + 1)); } }
        unsigned T[4];
        QuadNet<DevOps>::top16_of_128(R, T, low1, low2, eq12);
#pragma unroll
        for (int r = 0; r < 4; ++r) S1K[L * 16 + 4 * r + sub] = T[r];
    }
    LDS_WAIT(); __builtin_amdgcn_wave_barrier();
    {
        const int hd = (lane >> 2) & 7;
        const LAS unsigned char* la = (const LAS unsigned char*)(S1K + (2 * hd) * 16); const LAS unsigned char* lb = (const LAS unsigned char*)(S1K + (2 * hd + 1) * 16);
        unsigned C[16];
#pragma unroll
        for (int r = 0; r < 13; ++r) { const unsigned ab = TAB[4 * r + sub];
            const unsigned ka = *(const LAS unsigned*)(la + (ab & 255u)), kb = *(const LAS unsigned*)(lb + (ab >> 8));
            const float sum = unordkey(ka & ~127u) + unordkey(kb & ~127u);
            C[r] = (ordkey(sum) & ~63u) | (unsigned)(63 - (4 * r + sub)); }
        C[13] = 0u; C[14] = 0u; C[15] = 0u;
        unsigned W[4];
        QuadNet<DevOps>::top16_of_64(C, W, low1, low2, eq12);
        float sv[4]; int ex[4];
#pragma unroll
        for (int r = 0; r < 4; ++r) { const unsigned ab = TAB[63 - (W[r] & 63u)];
            const unsigned ka = *(const LAS unsigned*)(la + (ab & 255u)), kb = *(const LAS unsigned*)(lb + (ab >> 8));
            ex[r] = (int)(127u - (ka & 127u)) * 128 + (int)(127u - (kb & 127u)); sv[r] = unordkey(W[r] & ~63u); }
        const float mx = dpp_f<0x00>(sv[0]);
        float e4[4], es = 0.f;
#pragma unroll
        for (int r = 0; r < 4; ++r) { e4[r] = __expf(sv[r] - mx); es += e4[r]; }
        es += dpp_f<DPP_XOR1>(es); es += dpp_f<DPP_XOR2>(es);
        const float rd = 1.f / es;
#pragma unroll
        for (int r = 0; r < 4; ++r) { GL[hd * 16 + 4 * r + sub] = e4[r] * rd; EL[hd * 16 + 4 * r + sub] = ex[r]; }
    }
    LDS_WAIT(); __builtin_amdgcn_wave_barrier();
}

#ifndef PROBE_PHASE
#define PROBE_PHASE -1
#endif
#ifndef PROBE_MULT
#define PROBE_MULT 1
#endif
constexpr int EB = 4;
constexpr int CW_TICKET = 20480;

struct GBuf { LpRow<U_FMT> u[EB]; LpRow<V_FMT> v[EB]; };
__device__ __forceinline__ void gather_issue(GBuf& B, const LAS int* EL, int i0, const unsigned char* UTl, const unsigned char* VTl, int lane) {
#pragma unroll
    for (int q = 0; q < EB; ++q) {
        const int ex = __builtin_amdgcn_readfirstlane(EL[i0 + q]);
        B.u[q].load(UTl + (size_t)ex * UROW, lane); B.v[q].load(VTl + (size_t)ex * VROW, lane);
    }
}
__device__ __forceinline__ void gather_compute(const GBuf& B, const LAS int* EL, const LAS float* GL, int i0, const float* USl, const float* VSl, const unsigned (&hv)[16], f32x2 (&acc)[16]) {
    float dot[EB], su[EB], sv[EB], g[EB];
#pragma unroll
    for (int q = 0; q < EB; ++q) { const int ex = __builtin_amdgcn_readfirstlane(EL[i0 + q]); { const f32x2 s2 = *(const f32x2*)(USl + 2 * ex); su[q] = s2.x; sv[q] = s2.y; }
        g[q] = __uint_as_float(__builtin_amdgcn_readfirstlane(__float_as_uint(GL[i0 + q]))); }
#pragma unroll
    for (int q = 0; q < EB; ++q) { float s0 = 0.f, s1 = 0.f;
        B.u[q].each_bf([&](int i, bf16x2_t x) { if (i & 1) s1 = __builtin_amdgcn_fdot2_f32_bf16(x, __builtin_bit_cast(bf16x2_t, hv[i]), s1, false); else s0 = __builtin_amdgcn_fdot2_f32_bf16(x, __builtin_bit_cast(bf16x2_t, hv[i]), s0, false); });
        dot[q] = s0 + s1; __builtin_amdgcn_sched_barrier(0); }
#pragma unroll
    for (int q = 0; q < EB; ++q) dot[q] = wave_sum_u(dot[q]);
#pragma unroll
    for (int q = 0; q < EB; ++q) { const float cf = g[q] * gelu_as(dot[q] * su[q]) * sv[q]; const f32x2 c2 = {cf, cf};
        B.v[q].each([&](int i, float x0, float x1) { const f32x2 x = {x0, x1}; acc[i >> 1] = __builtin_elementwise_fma(x, c2, acc[i >> 1]); }); __builtin_amdgcn_sched_barrier(0); }
}

__device__ __forceinline__ void peer_phase(Frame& F, int layer, int rows, unsigned* ctl, unsigned long long& pr_acc) {
    unsigned long long pt0 = 0ull;
#define SUB_BEGIN(ty) do { if (PROBE_PHASE == (ty)) pt0 = __builtin_amdgcn_s_memrealtime(); } while (0)
#define SUB_END(ty) do { if (PROBE_PHASE == (ty)) pr_acc += __builtin_amdgcn_s_memrealtime() - pt0; } while (0)
    if (F.tid < 64) { int a = 0, b = 0; stair_ab(F.tid < 52 ? F.tid : 0, a, b); *(LAS unsigned short*)(F.lds + PE_TAB + 2 * F.tid) = (unsigned short)((4 * a) | ((4 * b) << 8)); }
    {
        const int ch = F.tid, ll = ch >> 3, q = ch & 7;
        LAS unsigned char* dst = F.lds + PE_VEC + (q * 64 + ll) * 16;
        const int nl = layer < NLAYER - 1 ? layer + 1 : layer;
#pragma unroll 1
        for (int v = 0; v < 9; ++v) {
            const int g3 = v / 3, mrv = v - 3 * g3;
            const size_t off = ((size_t)(g3 == 0 ? layer : nl) * 3 + mrv) * 12288 + (g3 == 0 ? 5 * D : (g3 == 1 ? 0 : D));
            *(LAS f32x4*)(dst + v * 8192) = *(const f32x4*)(F.MODS() + off + 4 * ch);
        }
        *(LAS f32x4*)(dst + 9 * 8192) = *(const f32x4*)(F.ln2_g() + layer * D + 4 * ch);
        *(LAS f32x4*)(dst + 10 * 8192) = *(const f32x4*)(F.ln2_b() + layer * D + 4 * ch);
    }
    __syncthreads();
    LAS unsigned char* ws = F.lds + F.wave * PE_WS;
    LAS int* EL = (LAS int*)(ws + 3328); LAS float* GL = (LAS float*)(ws + 3840);
    const int lane = F.lane;
    const LAS unsigned char* vcache = F.lds + PE_VEC + lane * 16;
    const unsigned char* UTl = F.UT() + (size_t)layer * NEXP * UROW;
    const unsigned char* VTl = F.VT() + (size_t)layer * NEXP * VROW;
    const float* USl = F.US() + 2 * (size_t)layer * NEXP; const float* VSl = nullptr;
    unsigned* ticket = ctl + CW_TICKET + 64 * layer;
    unsigned tk = 0u;
    if (lane == 0) tk = __hip_atomic_fetch_add(ticket, 1u, __ATOMIC_RELAXED, __HIP_MEMORY_SCOPE_AGENT);
    int t = (int)__builtin_amdgcn_readfirstlane(tk);
    while (t < rows) {
        unsigned tkn = 0u;
        if (lane == 0) tkn = __hip_atomic_fetch_add(ticket, 1u, __ATOMIC_RELAXED, __HIP_MEMORY_SCOPE_AGENT);
        SUB_BEGIN(8); peer_topk(F, ws, t); SUB_END(8);
        SUB_BEGIN(9);
        unsigned hv[16]; f32x2 acc[16];
#pragma unroll
        for (int q = 0; q < 4; ++q) { const u32x4 w = *(const u32x4*)(F.H() + (size_t)t * D + 32 * lane + 8 * q);
#pragma unroll
            for (int e = 0; e < 4; ++e) { hv[4 * q + e] = w[e]; acc[4 * q + e] = (f32x2){0.f, 0.f}; } }
        {
            GBuf A, B, C;
            gather_issue(A, EL, 0, UTl, VTl, lane);
            gather_issue(B, EL, EB, UTl, VTl, lane);
            for (int i0 = 0; i0 < 30 * EB; i0 += 3 * EB) {
                gather_issue(C, EL, i0 + 2 * EB, UTl, VTl, lane);
                gather_compute(A, EL, GL, i0, USl, VSl, hv, acc);
                gather_issue(A, EL, i0 + 3 * EB, UTl, VTl, lane);
                gather_compute(B, EL, GL, i0 + EB, USl, VSl, hv, acc);
                gather_issue(B, EL, i0 + 4 * EB, UTl, VTl, lane);
                gather_compute(C, EL, GL, i0 + 2 * EB, USl, VSl, hv, acc);
            }
            gather_compute(A, EL, GL, 30 * EB, USl, VSl, hv, acc);
            gather_compute(B, EL, GL, 31 * EB, USl, VSl, hv, acc);
        }
        SUB_END(9); SUB_BEGIN(10);
        const int mr = modrow(t);
        const float* mp = F.MODS() + ((size_t)layer * 3 + mr) * 12288;
        bf16_t* xr = F.X() + (size_t)t * D;
        float rr[32]; float s = 0.f;
#pragma unroll
        for (int q2 = 0; q2 < 4; ++q2) { const u32x4 xw = *(const u32x4*)(xr + 32 * lane + 8 * q2);
#pragma unroll
            for (int h2 = 0; h2 < 2; ++h2) { const int q = 2 * q2 + h2; const f32x4 gv = *(const LAS f32x4*)(vcache + mr * 8192 + q * 1024);
                const f32x4 xv = {bf_lo(xw[2 * h2]), bf_hi(xw[2 * h2]), bf_lo(xw[2 * h2 + 1]), bf_hi(xw[2 * h2 + 1])};
                const f32x4 av = {acc[2 * q].x, acc[2 * q].y, acc[2 * q + 1].x, acc[2 * q + 1].y};
#pragma unroll
                for (int e = 0; e < 4; ++e) { const float v = DN_ALPHA * xv[e] + gv[e] * av[e]; rr[4 * q + e] = v; s += v; } } }
        const float mean = wave_sum_u(s) * (1.f / D);
        float s2 = 0.f;
#pragma unroll
        for (int i = 0; i < 32; ++i) { rr[i] -= mean; s2 += rr[i] * rr[i]; }
        const float rstd = 1.f / sqrtf(wave_sum_u(s2) * (1.f / D) + LN_EPS);
        const float* g2 = F.ln2_g() + layer * D; const float* b2 = F.ln2_b() + layer * D;
        float s3 = 0.f;
#pragma unroll
        for (int q = 0; q < 8; ++q) { const int c = 32 * lane + 4 * q; const f32x4 gg = *(const LAS f32x4*)(vcache + 9 * 8192 + q * 1024), bb = *(const LAS f32x4*)(vcache + 10 * 8192 + q * 1024);
            f32x4 xo;
#pragma unroll
            for (int e = 0; e < 4; ++e) { xo[e] = rr[4 * q + e] * rstd * gg[e] + bb[e]; rr[4 * q + e] = xo[e]; s3 += xo[e]; }
            if (layer < NLAYER - 1) { u32x2 o2; o2.x = pk2(xo[0], xo[1]); o2.y = pk2(xo[2], xo[3]); *(u32x2*)(xr + c) = o2; } else if (t < TL) *(f32x4*)(F.out() + (size_t)t * D + c) = xo; }
        if (layer < NLAYER - 1) {
            const float mean2 = wave_sum_u(s3) * (1.f / D);
            float s4 = 0.f;
#pragma unroll
            for (int i = 0; i < 32; ++i) { rr[i] -= mean2; s4 += rr[i] * rr[i]; }
            const float rstd2 = 1.f / sqrtf(wave_sum_u(s4) * (1.f / D) + LN_EPS);
            const float* np = F.MODS() + ((size_t)(layer + 1) * 3 + mr) * 12288;
#pragma unroll
            for (int q2 = 0; q2 < 4; ++q2) { const int c = 32 * lane + 8 * q2; u32x4 w;
#pragma unroll
                for (int q = 0; q < 2; ++q) { const f32x4 sh = *(const LAS f32x4*)(vcache + (3 + mr) * 8192 + (2 * q2 + q) * 1024), sc = *(const LAS f32x4*)(vcache + (6 + mr) * 8192 + (2 * q2 + q) * 1024); const int ri = 8 * q2 + 4 * q;
                    const float y0 = rr[ri] * rstd2 * (1.f + sc[0]) + sh[0], y1 = rr[ri + 1] * rstd2 * (1.f + sc[1]) + sh[1];
                    const float y2 = rr[ri + 2] * rstd2 * (1.f + sc[2]) + sh[2], y3 = rr[ri + 3] * rstd2 * (1.f + sc[3]) + sh[3];
                    w[2 * q] = pk2(y0, y1); w[2 * q + 1] = pk2(y2, y3); }
                *(u32x4*)(F.H() + (size_t)t * D + c) = w; }
        }
        SUB_END(10);
        t = (int)__builtin_amdgcn_readfirstlane(tkn);
    }
#undef SUB_BEGIN
#undef SUB_END
}

__global__ void __launch_bounds__(NWAVES * 64, 2) skel_fwd(Args args) {
    extern __shared__ __attribute__((aligned(16))) unsigned char lds[];
    Frame F;
    F.lds = (LAS unsigned char*)lds;
    F.tid = threadIdx.x; F.lane = F.tid & 63; F.wave = __builtin_amdgcn_readfirstlane(F.tid >> 6);
    F.G = gridDim.x; F.gw = blockIdx.x * NWAVES + F.wave; F.NGW = F.G * NWAVES;
    unsigned char* ws = args.ws;
    F.ka = (const CAS unsigned char*)__builtin_amdgcn_kernarg_segment_ptr();
    for (int u = F.tid; u < (LDS_BYTES - LDSCTL_OFF) / 4; u += NWAVES * 64) ((LAS unsigned*)(F.lds + LDSCTL_OFF))[u] = 0u;
    __syncthreads();
    unsigned* ctl = (unsigned*)(ws + WS_CTL);
    const int lo = args.ph_lo, hi = args.ph_hi;
    XcdBarrier bar; bar.bar = ctl + CW_BAR + args.li * XCD_BAR_WORDS; bar.x = 0; bar.st = nullptr;
    if (hi - lo > 1) bar = xcd_barrier_post(ctl + CW_BAR + args.li * XCD_BAR_WORDS, (volatile LAS unsigned*)(F.lds + MISC_OFF) + 8);
#define IN(k) (lo <= (k) && (k) < hi)
    unsigned long long pr_acc = 0ull, pr_t0 = 0ull;
#define PR_BEGIN(ty) do { if (PROBE_PHASE == (ty)) pr_t0 = __builtin_amdgcn_s_memrealtime(); } while (0)
#define PR_END(ty) do { if (PROBE_PHASE == (ty)) pr_acc += __builtin_amdgcn_s_memrealtime() - pr_t0; } while (0)
#define BOTH(k) (IN(k) && IN((k) + 1))
#define SEAM(k) do { if (BOTH(k)) xcd_barrier(bar); } while (0)

    if (IN(0)) { PR_BEGIN(0); frame_ids(F); p0a_prologue(F); SEAM(0); PR_END(0); }
    if (IN(1)) {
        PR_BEGIN(1); frame_ids(F);
        { pg8::Gemm g{F.KBD(), F.WQR(), 32 * 256, 2048, 256}; pg8::BatchOrder S{F.G, (int)blockIdx.x}; pg8::EpiBf16 E{F.WEFFT(), D};
          pg8::gemm_phase<pg8::EpiBf16, pg8::BatchOrder, false, true>(F.lds, g, S, E); }
        p0b_mod0(F);
        SEAM(1); PR_END(1);
    }
    for (int layer = 0; layer < NLAYER; ++layer) {
        const int pb = 2 + 6 * layer;
        const bool lastl = layer == NLAYER - 1;
        const int rows = lastl ? TL : TT;
        if (IN(pb + 0)) {
            PR_BEGIN(2); frame_ids(F);
            pg8::Gemm g{F.H(), F.WINT() + (size_t)layer * INC * D, TT, INC, D}; pg8::StaticOrder S; S.init(TT, INC, F.G, (int)blockIdx.x);
            pg8::EpiBf16 E{F.PROJ(), INC};
            pg8::gemm_phase<pg8::EpiBf16, pg8::StaticOrder, true, true>(F.lds, g, S, E);
            SEAM(pb + 0); PR_END(2);
        }
        if (IN(pb + 1)) {
            PR_BEGIN(3); frame_ids(F);
            const int nunits = lastl ? 512 : 528;
            {
                const int ch = F.tid & 255, vsel = F.tid >> 8;
                LAS unsigned char* dst = F.lds + CONV_LDS + ((2 * (ch >> 7) + (ch & 1)) * 64 + ((ch & 127) >> 1)) * 16;
                *(LAS f32x4*)(dst + vsel * 4096) = *(const f32x4*)(F.conv_w() + (size_t)layer * 3 * 1024 + vsel * 1024 + 4 * ch);
                *(LAS f32x4*)(dst + (2 + vsel) * 4096) = vsel == 0 ? *(const f32x4*)(F.conv_w() + (size_t)layer * 3 * 1024 + 2048 + 4 * ch) : *(const f32x4*)(F.g_conv() + layer * 1024 + 4 * ch);
            }
            for (int i = F.tid; i < 192 * 32 * 2 / 4; i += NWAVES * 64) *(LAS f32x4*)(F.lds + ROPE_LDS + i * 16) = *(const f32x4*)(F.ROPE() + 4 * i);
            __syncthreads();
            { unsigned long long q0 = 0; if (PROBE_PHASE == 11) q0 = __builtin_amdgcn_s_memrealtime();
            { const int bx = (int)blockIdx.x, vcu = (F.G % 8 == 0) ? (bx % 8) * (F.G / 8) + bx / 8 : bx;
              for (int u = vcu; u < nunits; u += F.G) attn_unit(F, layer, u); }
            if (PROBE_PHASE == 11) pr_acc += __builtin_amdgcn_s_memrealtime() - q0; if (PROBE_PHASE == 12) q0 = __builtin_amdgcn_s_memrealtime();
            {
              const int nx = nunits - 2 * F.G; const bool uneven = nx > 0 && nx < F.G;
              const int bx2 = (int)blockIdx.x, vc2 = (F.G % 8 == 0) ? (bx2 % 8) * (F.G / 8) + bx2 / 8 : bx2;
              const int c0 = uneven ? vc2 - nx : vc2, nb = uneven ? F.G - nx : F.G;
              if (c0 >= 0) for (int t = c0 * NWAVES + F.wave; t < rows; t += nb * NWAVES) conv_row(F, layer, t); }
            if (PROBE_PHASE == 12) pr_acc += __builtin_amdgcn_s_memrealtime() - q0; }
            SEAM(pb + 1); PR_END(3);
        }
        if (IN(pb + 2)) {
            PR_BEGIN(4); frame_ids(F);
            pg8::Gemm g{F.MIX(), F.WOUTT() + (size_t)layer * D * D, rows, D, D}; pg8::StaticOrder S; S.init(rows, D, F.G, (int)blockIdx.x);
            pg8::EpiResid E{layer == 0 ? F.x() : nullptr, layer == 0 ? F.ctx() : nullptr, F.X(), F.MODS() + (size_t)layer * 3 * 12288 + 2 * D};
            pg8::gemm_phase<pg8::EpiResid, pg8::StaticOrder, true, true>(F.lds, g, S, E);
            frame_ids(F); convert_in_tail(F, layer, (rows / 256) * (D / 256), 0);
            SEAM(pb + 2); PR_END(4);
        }
        if (IN(pb + 3)) { PR_BEGIN(5); frame_ids(F); ln_phase(F, layer, rows); SEAM(pb + 3); PR_END(5); }
        if (IN(pb + 4)) {
            PR_BEGIN(6); frame_ids(F);
            pg8::Gemm g{F.H(), F.WEFFT() + (size_t)layer * D * D, rows, D, D}; pg8::StaticOrder S; S.init(rows, D, F.G, (int)blockIdx.x);
            pg8::EpiBf16 E{F.SC(), D};
            pg8::gemm_phase<pg8::EpiBf16, pg8::StaticOrder, true, true>(F.lds, g, S, E);
            frame_ids(F); convert_in_tail(F, layer, (rows / 256) * (D / 256), 1);
            SEAM(pb + 4); PR_END(6);
        }
        if (IN(pb + 5)) { PR_BEGIN(7); frame_ids(F); peer_phase(F, layer, rows, ctl, pr_acc); SEAM(pb + 5); PR_END(7); }
    }
    if (PROBE_PHASE >= 0 && hi - lo > 1) xcd_barrier(bar);
    if (PROBE_PHASE >= 0 && blockIdx.x == 0 && threadIdx.x == 0) { const unsigned long long t1 = __builtin_amdgcn_s_memrealtime() + (unsigned long long)PROBE_MULT * pr_acc; while (__builtin_amdgcn_s_memrealtime() < t1) __builtin_amdgcn_s_sleep(8); }
#undef IN
#undef BOTH
#undef SEAM
}

extern "C" void kernel_launch(void* const* d_in, const int* in_sizes, int n_in, void* d_out, int out_size, void* d_ws, size_t ws_size, hipStream_t stream) {
    static int grid = 0;
    if (grid == 0) {
        if (n_in != 20 || in_sizes[0] != TL * D || out_size != TL * D || ws_size < WS_END) {
            fprintf(stderr, "kernel_launch: unexpected problem shape (n_in %d, in0 %d, out %d, ws %zu, need %zu)\n", n_in, n_in > 0 ? in_sizes[0] : -1, out_size, ws_size, (size_t)WS_END); grid = -1; return; }
        int dev = 0, cus = 0, per_cu = 0;
        if (hipGetDevice(&dev) != hipSuccess || hipDeviceGetAttribute(&cus, hipDeviceAttributeMultiprocessorCount, dev) != hipSuccess) { grid = -1; return; }
        if (hipFuncSetAttribute((const void*)skel_fwd, hipFuncAttributeMaxDynamicSharedMemorySize, LDS_BYTES) != hipSuccess) { fprintf(stderr, "kernel_launch: hipFuncSetAttribute failed\n"); grid = -1; return; }
        if (hipOccupancyMaxActiveBlocksPerMultiprocessor(&per_cu, (const void*)skel_fwd, NWAVES * 64, LDS_BYTES) != hipSuccess || per_cu < 1)
            fprintf(stderr, "kernel_launch: occupancy query reports %d workgroups per CU\n", per_cu);
        (void)hipGetLastError();
        grid = cus;
    }
    if (grid < 0) return;
    if (hipMemsetAsync((char*)d_ws + WS_CTL, 0, CTL_ZERO_BYTES, stream) != hipSuccess) return;
    Args a{};
    for (int i = 0; i < 20; ++i) a.in[i] = (const float*)d_in[i];
    a.out = (float*)d_out; a.ws = (unsigned char*)d_ws; a.pad = 0;
#if MK_N_LAUNCHES == 1
    a.ph_lo = 0; a.ph_hi = NPHASE; a.li = 0;
    hipLaunchKernelGGL(skel_fwd, dim3(grid), dim3(NWAVES * 64), LDS_BYTES, stream, a);
#else
    for (int ph = 0; ph < NPHASE; ++ph) { a.ph_lo = ph; a.ph_hi = ph + 1; a.li = 0;
        hipLaunchKernelGGL(skel_fwd, dim3(grid), dim3(NWAVES * 64), LDS_BYTES, stream, a); }
#endif
}
```

```cpp
#include <hip/hip_runtime.h>
#include <cstdio>
#include <cstdint>

#ifndef MK_N_LAUNCHES
#define MK_N_LAUNCHES 1
#endif

#define LAS __attribute__((address_space(3)))
typedef unsigned short bf16_t;
typedef short bf16x8 __attribute__((ext_vector_type(8)));
typedef short s16x4 __attribute__((ext_vector_type(4)));
typedef float f32x2 __attribute__((ext_vector_type(2)));
typedef float f32x4 __attribute__((ext_vector_type(4)));
typedef float f32x16 __attribute__((ext_vector_type(16)));
typedef unsigned u32x2 __attribute__((ext_vector_type(2)));
typedef unsigned u32x4 __attribute__((ext_vector_type(4)));
typedef __bf16 bf16x2_t __attribute__((ext_vector_type(2)));

constexpr int D = 2048, NB = 2, SEQ = 8192, CTXL = 256, NLAYER = 4;
constexpr int TL = NB * SEQ, TC = NB * CTXL, TT = TL + TC;
constexpr int INC = 4608, OFF_C = 1024, OFF_X = 2048, OFF_Q = 3072, OFF_K = 4096, OFF_V = 4352;
constexpr int NEXP = 16384;
#ifndef U_FMT
#define U_FMT 4
#endif
#ifndef V_FMT
#define V_FMT 4
#endif
constexpr int UROW = D * U_FMT / 8, VROW = D * V_FMT / 8;
constexpr float LN_EPS = 1e-6f;
constexpr float DN_ALPHA = 1.681792830507429f;
constexpr float QSCALE = 0.08838834764831845f * 1.4426950408889634f;
constexpr float LOG2E = 1.4426950408889634f;

constexpr size_t MiB = 1u << 20;
constexpr size_t WS_CTL = 0, CTL_ZERO_BYTES = 1 * MiB;
constexpr size_t WS_MODS = 1 * MiB;
constexpr size_t WS_ROPE = 2 * MiB;
constexpr size_t WS_KBD = 3 * MiB;
constexpr size_t WS_WQR = 8 * MiB;
constexpr size_t WS_WINT = 40 * MiB;
constexpr size_t WS_WOUTT = 112 * MiB;
constexpr size_t WS_WEFFT = 144 * MiB;
constexpr size_t WS_X = 176 * MiB;
constexpr size_t WS_H = 308 * MiB;
constexpr size_t WS_PROJ = 374 * MiB;
constexpr size_t WS_MIX = 523 * MiB;
constexpr size_t WS_SC = 589 * MiB;
constexpr size_t WS_UT = 721 * MiB;
constexpr size_t WS_VT = 849 * MiB;
constexpr size_t WS_US = 977 * MiB;
constexpr size_t WS_VS = 978 * MiB;
constexpr size_t WS_END = 979 * MiB;

constexpr int CW_BAR = 4096;

namespace pg8 {
constexpr int BM = 256, BK = 64, HALF = 128, HTB = HALF * BK * 2, STAGE_BYTES = 8 * HTB, NXCD = 8, WGM = 8;
__host__ __device__ __forceinline__ int lds_byte(int r, int c) { const int st = (r >> 4) * 2 + (c >> 5), rr = r & 15, cc = c & 31, ob = rr * 64 + cc * 2; return st * 1024 + (ob ^ (((ob >> 9) & 1) << 5)); }
__host__ __device__ __forceinline__ void stage_rc(int b, int& R, int& C) { const int st = b / 1024, sb = b % 1024, swz = sb ^ (((sb >> 9) & 1) << 5); R = (st >> 1) * 16 + swz / 64; C = (st & 1) * 32 + (swz % 64) / 2; }
__host__ __device__ __forceinline__ int perm32(int rho) { const int n = rho >> 4, i = rho & 15; return 8 * (i >> 2) + 4 * n + (i & 3); }

struct Unit { int pm, pn; };
struct Gemm { const bf16_t* A; const bf16_t* Bt; int M, N, K; };

struct StaticOrder {
    int nM, nN, nwg, G, c;
    __host__ __device__ void init(int M, int N, int G_, int c_) { nM = M / BM; nN = N / BM; nwg = nM * nN; G = G_; c = c_; }
    __host__ __device__ bool next(int i, Unit& u) const {
        const long L = (long)i * G + c; if (L >= nwg) return false;
        int wgid = (int)L; { const int q = nwg / NXCD, r = nwg % NXCD, xcd = wgid % NXCD, off = wgid / NXCD; wgid = (xcd < r ? xcd * (q + 1) : r * (q + 1) + (xcd - r) * q) + off; }
        const int nig = WGM * nN, gid = wgid / nig, fm = gid * WGM, gsz = (nM - fm) < WGM ? (nM - fm) : WGM;
        u.pm = fm + ((wgid % nig) % gsz); u.pn = (wgid % nig) / gsz; return true;
    }
    __device__ __forceinline__ int btile(const Unit& u) const { return u.pn; }
    __device__ __forceinline__ void a_ready(const Unit&) const {}
    __device__ __forceinline__ void done(const Unit&) const {}
};
struct BatchOrder {
    int G, c;
    __device__ bool next(int i, Unit& u) const { const int L = i * G + c; if (L >= 256) return false; u.pm = L >> 3; u.pn = L & 7; return true; }
    __device__ __forceinline__ int btile(const Unit& u) const { return u.pm * 8 + u.pn; }
    __device__ __forceinline__ void a_ready(const Unit&) const {}
    __device__ __forceinline__ void done(const Unit&) const {}
};

__device__ __forceinline__ unsigned cvt_pk_bf16(float lo, float hi) { f32x2 x = {lo, hi}; bf16x2_t y = __builtin_convertvector(x, bf16x2_t); return __builtin_bit_cast(unsigned, y); }

struct EpiBf16 {
    static constexpr bool PERM = true;
    bf16_t* O; int ldc;
    __device__ __forceinline__ void operator()(const f32x4 (&acc)[2][2][4][2], const Unit& u, int wr, int wc, int fr, int fq) const {
        const int row0 = u.pm * BM + wr * 64 + fr, col0 = u.pn * BM + wc * 32 + 8 * fq;
#pragma unroll
        for (int ai = 0; ai < 2; ++ai)
#pragma unroll
            for (int m = 0; m < 4; ++m) { bf16_t* rowp = O + (size_t)(row0 + ai * HALF + m * 16) * ldc + col0;
#pragma unroll
                for (int bj = 0; bj < 2; ++bj) { const f32x4 v0 = acc[ai][bj][m][0], v1 = acc[ai][bj][m][1];
                    u32x4 w; w.x = cvt_pk_bf16(v0[0], v0[1]); w.y = cvt_pk_bf16(v0[2], v0[3]); w.z = cvt_pk_bf16(v1[0], v1[1]); w.w = cvt_pk_bf16(v1[2], v1[3]);
                    *(u32x4*)(rowp + bj * HALF) = w; } }
    }
};
struct EpiF32 {
    static constexpr bool PERM = false;
    float* C; int ldc;
    __device__ __forceinline__ void operator()(const f32x4 (&acc)[2][2][4][2], const Unit& u, int wr, int wc, int fr, int fq) const {
        const int row0 = u.pm * BM + wr * 64 + fr, col0 = u.pn * BM + wc * 32 + 4 * fq;
#pragma unroll
        for (int ai = 0; ai < 2; ++ai)
#pragma unroll
            for (int m = 0; m < 4; ++m) { float* rowp = C + (size_t)(row0 + ai * HALF + m * 16) * ldc + col0;
#pragma unroll
                for (int bj = 0; bj < 2; ++bj)
#pragma unroll
                    for (int n = 0; n < 2; ++n) *(f32x4*)(rowp + bj * HALF + n * 16) = acc[ai][bj][m][n]; }
    }
};
struct EpiResid {
    static constexpr bool PERM = true;
    const float* x32_lat; const float* x32_ctx;
    bf16_t* X; const float* gate;
    __device__ __forceinline__ void operator()(const f32x4 (&acc)[2][2][4][2], const Unit& u, int wr, int wc, int fr, int fq) const {
        const int rt = u.pm * BM;
        const int mr = rt < TL ? rt / SEQ : 2;
        const int row0 = rt + wr * 64 + fr, col0 = u.pn * BM + wc * 32 + 8 * fq;
        f32x4 gv[2][2];
#pragma unroll
        for (int bj = 0; bj < 2; ++bj)
#pragma unroll
            for (int n = 0; n < 2; ++n) gv[bj][n] = *(const f32x4*)(gate + (size_t)mr * 12288 + col0 + bj * HALF + 4 * n);
#pragma unroll
        for (int ai = 0; ai < 2; ++ai)
#pragma unroll
            for (int m = 0; m < 4; ++m) { const int row = row0 + ai * HALF + m * 16;
#pragma unroll
                for (int bj = 0; bj < 2; ++bj) {
                    f32x4 x0, x1;
                    if (x32_lat) { const float* xp = (row < TL ? x32_lat + (size_t)row * D : x32_ctx + (size_t)(row - TL) * D) + col0 + bj * HALF; x0 = *(const f32x4*)xp; x1 = *(const f32x4*)(xp + 4); }
                    else { const u32x4 w = *(const u32x4*)(X + (size_t)row * D + col0 + bj * HALF);
                        x0 = (f32x4){__uint_as_float(w.x << 16), __uint_as_float(w.x & 0xffff0000u), __uint_as_float(w.y << 16), __uint_as_float(w.y & 0xffff0000u)};
                        x1 = (f32x4){__uint_as_float(w.z << 16), __uint_as_float(w.z & 0xffff0000u), __uint_as_float(w.w << 16), __uint_as_float(w.w & 0xffff0000u)}; }
                    const f32x4 r0 = x0 * DN_ALPHA + gv[bj][0] * acc[ai][bj][m][0], r1 = x1 * DN_ALPHA + gv[bj][1] * acc[ai][bj][m][1];
                    u32x4 o; o.x = cvt_pk_bf16(r0[0], r0[1]); o.y = cvt_pk_bf16(r0[2], r0[3]); o.z = cvt_pk_bf16(r1[0], r1[1]); o.w = cvt_pk_bf16(r1[2], r1[3]);
                    *(u32x4*)(X + (size_t)row * D + col0 + bj * HALF) = o; } }
    }
};

template <class Epi, class Sched, bool ALIGN_EPI = false, bool SP2 = false>
__device__ __forceinline__ void gemm_phase(LAS unsigned char* lds, const Gemm g, const Sched& S, const Epi& E) {
    int tid = threadIdx.x; asm volatile("" : "+v"(tid));
    const int wid = __builtin_amdgcn_readfirstlane(tid >> 6), lane = tid & 63, wr = wid >> 2, wc = wid & 3, fr = lane & 15, fq = lane >> 4;
    const int K = g.K, nt = K / BK;
    unsigned voffA[2], voffB[2];
#pragma unroll
    for (int i = 0; i < 2; ++i) { int R, C; stage_rc(tid * 16 + i * 8192, R, C); const int Rb = Epi::PERM ? ((R & ~31) + perm32(R & 31)) : R;
        voffA[i] = (unsigned)(R * K + C) * 2u; voffB[i] = (unsigned)(Rb * K + C) * 2u; }
    const size_t kstep = (size_t)(BK * 2);
    const size_t hstep = (size_t)HALF * K * 2;
    const size_t tstep = 2 * hstep;
    const unsigned ldsw = (unsigned)wid * 1024u;
    const int aoff = lds_byte(wr * 64 + fr, fq * 8), boff = lds_byte(wc * 32 + fr, fq * 8);
#define PG8_SA(b, h) (((b) * 2 + (h)) * HTB)
#define PG8_SB(b, h) ((4 + (b) * 2 + (h)) * HTB)
#define PG8_STAGE(bufoff, gbase, voff) do { _Pragma("unroll") for (int _i = 0; _i < 2; ++_i) \
        __builtin_amdgcn_global_load_lds((const unsigned*)((const char*)(gbase) + (voff)[_i]), (LAS unsigned*)(lds + (bufoff) + ldsw + _i * 8192), 16, 0, 0); } while (0)
#define PG8_LDA(dst, b, h) do { _Pragma("unroll") for (int m = 0; m < 4; ++m) _Pragma("unroll") for (int k = 0; k < 2; ++k) dst[m][k] = *(const LAS bf16x8*)(lds + PG8_SA(b, h) + aoff + m * 2048 + k * 1024); } while (0)
#define PG8_LDB(dst, b, h) do { _Pragma("unroll") for (int n = 0; n < 2; ++n) _Pragma("unroll") for (int k = 0; k < 2; ++k) dst[n][k] = *(const LAS bf16x8*)(lds + PG8_SB(b, h) + boff + n * 2048 + k * 1024); } while (0)
#define PG8_MMA(ai, bj, At, Bt) do { __builtin_amdgcn_s_setprio(1); _Pragma("unroll") for (int m = 0; m < 4; ++m) _Pragma("unroll") for (int n = 0; n < 2; ++n) _Pragma("unroll") for (int k = 0; k < 2; ++k) \
        acc[ai][bj][m][n] = __builtin_amdgcn_mfma_f32_16x16x32_bf16(Bt[n][k], At[m][k], acc[ai][bj][m][n], 0, 0, 0); __builtin_amdgcn_s_setprio(0); } while (0)
#define PG8_WAIT_V(n) asm volatile("s_waitcnt vmcnt(" #n ")" ::: "memory")
#define PG8_WAIT_L(n) asm volatile("s_waitcnt lgkmcnt(" #n ")" ::: "memory")
#define PG8_BAR __builtin_amdgcn_s_barrier()
#define PG8_SCHED __builtin_amdgcn_sched_barrier(0)
    Unit cur, nxt; int ui = 0;
    if (!S.next(0, cur)) return;
    f32x4 acc[2][2][4][2];
#pragma unroll
    for (int a = 0; a < 2; ++a)
#pragma unroll
        for (int b = 0; b < 2; ++b)
#pragma unroll
            for (int m = 0; m < 4; ++m)
#pragma unroll
                for (int n = 0; n < 2; ++n) acc[a][b][m][n] = (f32x4){0.f, 0.f, 0.f, 0.f};
    bf16x8 At[4][2], B0[2][2], B1[2][2];
    const char* cA = (const char*)g.A + (size_t)cur.pm * tstep; const char* cB = (const char*)g.Bt + (size_t)S.btile(cur) * tstep;
    S.a_ready(cur);
    if constexpr (SP2) {
        PG8_STAGE(PG8_SB(0, 0), cB, voffB); PG8_STAGE(PG8_SB(0, 1), cB + hstep, voffB); PG8_STAGE(PG8_SA(0, 0), cA, voffA); PG8_STAGE(PG8_SA(0, 1), cA + hstep, voffA);
        if (wr == 1) PG8_BAR;
        PG8_WAIT_V(2); PG8_BAR;
        PG8_STAGE(PG8_SB(1, 0), cB + kstep, voffB); PG8_STAGE(PG8_SA(1, 0), cA + kstep, voffA); PG8_STAGE(PG8_SB(1, 1), cB + hstep + kstep, voffB);
        PG8_WAIT_V(6); PG8_BAR;
    } else {
        PG8_STAGE(PG8_SB(0, 0), cB, voffB); PG8_STAGE(PG8_SA(0, 0), cA, voffA); PG8_STAGE(PG8_SB(0, 1), cB + hstep, voffB); PG8_STAGE(PG8_SA(0, 1), cA + hstep, voffA);
        if (wr == 1) PG8_BAR;
        PG8_WAIT_V(4); PG8_BAR;
        PG8_STAGE(PG8_SB(1, 0), cB + kstep, voffB); PG8_STAGE(PG8_SA(1, 0), cA + kstep, voffA); PG8_STAGE(PG8_SB(1, 1), cB + hstep + kstep, voffB);
        PG8_WAIT_V(6); PG8_BAR;
    }
    for (;;) {
        const bool has_next = S.next(ui + 1, nxt);
        const char* nA = has_next ? (const char*)g.A + (size_t)nxt.pm * tstep : cA; const char* nB = has_next ? (const char*)g.Bt + (size_t)S.btile(nxt) * tstep : cB;
        for (int t = 0; t < nt; t += 2) {
            const bool last = (t == nt - 2);
            const char* a1 = cA + (size_t)(t + 1) * kstep;
            const char* a2 = last ? nA : cA + (size_t)(t + 2) * kstep; const char* b2 = last ? nB : cB + (size_t)(t + 2) * kstep;
            const char* a3 = a2 + kstep; const char* b3 = b2 + kstep;
            if (last && has_next) S.a_ready(nxt);
            if constexpr (SP2) {
            PG8_LDB(B0, 0, 0); PG8_LDB(B1, 0, 1); PG8_SCHED; PG8_LDA(At, 0, 0); PG8_STAGE(PG8_SA(1, 1), a1 + hstep, voffA);
            PG8_WAIT_V(8); PG8_WAIT_L(0); PG8_BAR; PG8_MMA(0, 0, At, B0); PG8_MMA(0, 1, At, B1); PG8_BAR; PG8_SCHED;
            PG8_LDA(At, 0, 1); PG8_STAGE(PG8_SB(0, 0), b2, voffB); PG8_STAGE(PG8_SB(0, 1), b2 + hstep, voffB); PG8_STAGE(PG8_SA(0, 0), a2, voffA);
            PG8_WAIT_V(8); PG8_WAIT_L(0); PG8_BAR; PG8_MMA(1, 0, At, B0); PG8_MMA(1, 1, At, B1); PG8_BAR; PG8_SCHED;
            PG8_LDB(B0, 1, 0); PG8_LDB(B1, 1, 1); PG8_SCHED; PG8_LDA(At, 1, 0); PG8_STAGE(PG8_SA(0, 1), a2 + hstep, voffA);
            PG8_WAIT_V(8); PG8_WAIT_L(0); PG8_BAR; PG8_MMA(0, 0, At, B0); PG8_MMA(0, 1, At, B1); PG8_BAR; PG8_SCHED;
            PG8_LDA(At, 1, 1); PG8_STAGE(PG8_SB(1, 0), b3, voffB); PG8_STAGE(PG8_SB(1, 1), b3 + hstep, voffB); PG8_STAGE(PG8_SA(1, 0), a3, voffA);
            PG8_WAIT_V(8); PG8_WAIT_L(0); PG8_BAR; PG8_MMA(1, 0, At, B0); PG8_MMA(1, 1, At, B1); PG8_BAR; PG8_SCHED;
            } else {
            PG8_LDB(B0, 0, 0); PG8_SCHED; PG8_LDA(At, 0, 0); PG8_STAGE(PG8_SA(1, 1), a1 + hstep, voffA);
            PG8_WAIT_L(8); PG8_BAR; PG8_WAIT_L(0); PG8_MMA(0, 0, At, B0); PG8_BAR; PG8_SCHED;
            PG8_LDB(B1, 0, 1); PG8_STAGE(PG8_SB(0, 0), b2, voffB);
            PG8_BAR; PG8_WAIT_L(0); PG8_MMA(0, 1, At, B1); PG8_BAR;
            PG8_LDA(At, 0, 1); PG8_STAGE(PG8_SA(0, 0), a2, voffA);
            PG8_BAR; PG8_WAIT_L(0); PG8_MMA(1, 0, At, B0); PG8_BAR; PG8_SCHED;
            PG8_STAGE(PG8_SB(0, 1), b2 + hstep, voffB);
            PG8_WAIT_V(6); PG8_BAR; PG8_MMA(1, 1, At, B1); PG8_BAR;
            PG8_LDB(B0, 1, 0); PG8_SCHED; PG8_LDA(At, 1, 0); PG8_STAGE(PG8_SA(0, 1), a2 + hstep, voffA);
            PG8_WAIT_L(8); PG8_BAR; PG8_WAIT_L(0); PG8_MMA(0, 0, At, B0); PG8_BAR; PG8_SCHED;
            PG8_LDB(B1, 1, 1); PG8_STAGE(PG8_SB(1, 0), b3, voffB);
            PG8_BAR; PG8_WAIT_L(0); PG8_MMA(0, 1, At, B1); PG8_BAR;
            PG8_LDA(At, 1, 1); PG8_STAGE(PG8_SA(1, 0), a3, voffA);
            PG8_BAR; PG8_WAIT_L(0); PG8_MMA(1, 0, At, B0); PG8_BAR; PG8_SCHED;
            PG8_STAGE(PG8_SB(1, 1), b3 + hstep, voffB);
            PG8_WAIT_V(6); PG8_BAR; PG8_MMA(1, 1, At, B1); PG8_BAR;
            }
        }
        if constexpr (ALIGN_EPI) { if (wr == 0) PG8_BAR; }
        E(acc, cur, wr, wc, fr, fq); S.done(cur);
        if (!has_next) break;
#pragma unroll
        for (int a = 0; a < 2; ++a)
#pragma unroll
            for (int b = 0; b < 2; ++b)
#pragma unroll
                for (int m = 0; m < 4; ++m)
#pragma unroll
                    for (int n = 0; n < 2; ++n) acc[a][b][m][n] = (f32x4){0.f, 0.f, 0.f, 0.f};
        cur = nxt; cA = nA; cB = nB; ++ui;
        if constexpr (ALIGN_EPI) { if (wr == 1) PG8_BAR; }
    }
    PG8_WAIT_V(0);
    if constexpr (!ALIGN_EPI) { if (wr == 0) PG8_BAR; }
    PG8_BAR;
#undef PG8_SA
#undef PG8_SB
#undef PG8_STAGE
#undef PG8_LDA
#undef PG8_LDB
#undef PG8_MMA
#undef PG8_WAIT_V
#undef PG8_WAIT_L
#undef PG8_BAR
#undef PG8_SCHED
}
}

#define XB_TMO      128
#define XB_XCNT(j)  (256  + 64 * (j))
#define XB_XSUB(j)  (1280 + 64 * (j))
#define XB_XGEN(j)  (2304 + 64 * (j))
#define XB_TOP      3328
#define XB_TOPGEN   3392
#define XCD_BAR_WORDS 3456
#define XB_SPIN_CAP (1u << 18)

__device__ __forceinline__ unsigned xb_ld(unsigned* p)              { return __hip_atomic_load(p, __ATOMIC_RELAXED, __HIP_MEMORY_SCOPE_AGENT); }
__device__ __forceinline__ unsigned xb_add(unsigned* p, unsigned v) { return __hip_atomic_fetch_add(p, v, __ATOMIC_RELAXED, __HIP_MEMORY_SCOPE_AGENT); }
__device__ __forceinline__ unsigned xb_xcc_id() { return (unsigned)__builtin_amdgcn_s_getreg((3 << 11) | 20) & 0xFu; }
#define XB_SPIN(cond, bar) do { unsigned _sp = 0; while (cond) { __builtin_amdgcn_s_sleep(1); \
    if ((++_sp & 255u) == 0u) { if (xb_ld(&(bar)[XB_TMO])) break; if (_sp > XB_SPIN_CAP) { atomicAdd(&(bar)[XB_TMO], 1u); break; } } } } while (0)

struct XcdBarrier { unsigned* bar; unsigned x; volatile LAS unsigned* st; };

__device__ __forceinline__ XcdBarrier xcd_barrier_post(unsigned* bar, volatile LAS unsigned* st) {
    XcdBarrier b; b.bar = bar; b.x = xb_xcc_id(); b.st = st;
    if (threadIdx.x == 0) (void)xb_add(&bar[XB_XCNT(b.x)], 1u);
    return b;
}
__device__ __forceinline__ void xcd_barrier_complete(unsigned* bar, unsigned x, unsigned& nloc, unsigned& nx) {
    const unsigned G = gridDim.x * gridDim.y * gridDim.z;
    unsigned sum, cnt, mine, sp = 0u;
    for (;;) {
        sum = 0u; cnt = 0u; mine = 0u;
#pragma unroll
        for (unsigned j = 0; j < 16; ++j) { const unsigned c = xb_ld(&bar[XB_XCNT(j)]); sum += c; cnt += (c > 0u) ? 1u : 0u; mine = (j == x) ? c : mine; }
        if (sum == G) break;
        __builtin_amdgcn_s_sleep(1);
        if ((++sp & 255u) == 0u) { if (xb_ld(&bar[XB_TMO])) break; if (sp > XB_SPIN_CAP) { atomicAdd(&bar[XB_TMO], 1u); break; } }
    }
    nloc = mine > 0u ? mine : 1u; nx = cnt > 0u ? cnt : 1u;
}
__device__ __forceinline__ void xcd_barrier(const XcdBarrier& b) {
    asm volatile("s_waitcnt vmcnt(0)" ::: "memory");
    __syncthreads();
    if (threadIdx.x == 0) {
        unsigned* bar = b.bar;
        __builtin_amdgcn_s_waitcnt(0);
        unsigned nloc = b.st[0], nx = b.st[1];
        if (nloc == 0u) { xcd_barrier_complete(bar, b.x, nloc, nx); b.st[0] = nloc; b.st[1] = nx; }
        const unsigned old = xb_add(&bar[XB_XSUB(b.x)], 1u);
        const unsigned gen = old / nloc;
        if (old + 1u == (gen + 1u) * nloc) {
            __builtin_amdgcn_fence(__ATOMIC_RELEASE, "agent");
            asm volatile("s_waitcnt vmcnt(0)" ::: "memory");
            const unsigned og = xb_add(&bar[XB_TOP], 1u);
            const unsigned tg = og / nx;
            if (og + 1u == (tg + 1u) * nx) xb_add(&bar[XB_TOPGEN], 1u);
            else XB_SPIN(xb_ld(&bar[XB_TOPGEN]) == tg, bar);
            __builtin_amdgcn_fence(__ATOMIC_ACQUIRE, "agent");
            xb_add(&bar[XB_XGEN(b.x)], 1u);
            asm volatile("s_waitcnt vmcnt(0)" ::: "memory");
        } else {
            XB_SPIN(xb_ld(&bar[XB_XGEN(b.x)]) == gen, bar);
            __builtin_amdgcn_fence(__ATOMIC_ACQUIRE, "agent");
            asm volatile("s_waitcnt vmcnt(0)" ::: "memory");
        }
    }
    __syncthreads();
}

constexpr int NWAVES = 8;
constexpr int LDS_BYTES = 163840;
constexpr int LDSCTL_OFF = LDS_BYTES - 512, MISC_OFF = LDSCTL_OFF + 320;
constexpr int NPHASE = 2 + 6 * NLAYER;

#define LDS_WAIT() asm volatile("s_waitcnt lgkmcnt(0)" ::: "memory")

struct Args { const float* in[20]; float* out; unsigned char* ws; int ph_lo, ph_hi, li, pad; };

#define CAS __attribute__((address_space(4)))
struct Frame {
    LAS unsigned char* lds;
    int tid, lane, wave, G, gw, NGW;
    const CAS unsigned char* ka;
    __device__ __forceinline__ const float* x() const { return *(const float* const CAS*)(ka + 0); }
    __device__ __forceinline__ const float* c() const { return *(const float* const CAS*)(ka + 8); }
    __device__ __forceinline__ const float* ctx() const { return *(const float* const CAS*)(ka + 16); }
    __device__ __forceinline__ const float* c_ctx() const { return *(const float* const CAS*)(ka + 24); }
    __device__ __forceinline__ const float* w_ada() const { return *(const float* const CAS*)(ka + 32); }
    __device__ __forceinline__ const float* b_ada() const { return *(const float* const CAS*)(ka + 40); }
    __device__ __forceinline__ const float* w_in() const { return *(const float* const CAS*)(ka + 48); }
    __device__ __forceinline__ const float* conv_w() const { return *(const float* const CAS*)(ka + 56); }
    __device__ __forceinline__ const float* sink() const { return *(const float* const CAS*)(ka + 64); }
    __device__ __forceinline__ const float* g_attn() const { return *(const float* const CAS*)(ka + 72); }
    __device__ __forceinline__ const float* g_conv() const { return *(const float* const CAS*)(ka + 80); }
    __device__ __forceinline__ const float* w_out() const { return *(const float* const CAS*)(ka + 88); }
    __device__ __forceinline__ const float* ln1_g() const { return *(const float* const CAS*)(ka + 96); }
    __device__ __forceinline__ const float* ln1_b() const { return *(const float* const CAS*)(ka + 104); }
    __device__ __forceinline__ const float* wq() const { return *(const float* const CAS*)(ka + 112); }
    __device__ __forceinline__ const float* keys() const { return *(const float* const CAS*)(ka + 120); }
    __device__ __forceinline__ const float* pu() const { return *(const float* const CAS*)(ka + 128); }
    __device__ __forceinline__ const float* pv() const { return *(const float* const CAS*)(ka + 136); }
    __device__ __forceinline__ const float* ln2_g() const { return *(const float* const CAS*)(ka + 144); }
    __device__ __forceinline__ const float* ln2_b() const { return *(const float* const CAS*)(ka + 152); }
    __device__ __forceinline__ float* out() const { return *(float* const CAS*)(ka + 160); }
    __device__ __forceinline__ unsigned char* ws() const { return *(unsigned char* const CAS*)(ka + 168); }
    __device__ __forceinline__ float* MODS() const { return (float*)(ws() + WS_MODS); }
    __device__ __forceinline__ float* ROPE() const { return (float*)(ws() + WS_ROPE); }
    __device__ __forceinline__ bf16_t* X() const { return (bf16_t*)(ws() + WS_X); }
    __device__ __forceinline__ bf16_t* SC() const { return (bf16_t*)(ws() + WS_SC); }
    __device__ __forceinline__ bf16_t* KBD() const { return (bf16_t*)(ws() + WS_KBD); }
    __device__ __forceinline__ bf16_t* WQR() const { return (bf16_t*)(ws() + WS_WQR); }
    __device__ __forceinline__ bf16_t* WINT() const { return (bf16_t*)(ws() + WS_WINT); }
    __device__ __forceinline__ bf16_t* WOUTT() const { return (bf16_t*)(ws() + WS_WOUTT); }
    __device__ __forceinline__ bf16_t* WEFFT() const { return (bf16_t*)(ws() + WS_WEFFT); }
    __device__ __forceinline__ bf16_t* H() const { return (bf16_t*)(ws() + WS_H); }
    __device__ __forceinline__ bf16_t* PROJ() const { return (bf16_t*)(ws() + WS_PROJ); }
    __device__ __forceinline__ bf16_t* MIX() const { return (bf16_t*)(ws() + WS_MIX); }
    __device__ __forceinline__ unsigned char* UT() const { return (unsigned char*)(ws() + WS_UT); }
    __device__ __forceinline__ unsigned char* VT() const { return (unsigned char*)(ws() + WS_VT); }
    __device__ __forceinline__ float* US() const { return (float*)(ws() + WS_US); }
    __device__ __forceinline__ float* VS() const { return (float*)(ws() + WS_VS); }
};

__device__ __forceinline__ void frame_ids(Frame& F) {
    int tz = threadIdx.x; asm volatile("" : "+v"(tz));
    F.tid = tz; F.lane = tz & 63; F.wave = __builtin_amdgcn_readfirstlane(tz >> 6);
    F.gw = blockIdx.x * NWAVES + F.wave;
    const CAS unsigned char* k = (const CAS unsigned char*)__builtin_amdgcn_kernarg_segment_ptr(); asm volatile("" : "+s"(k)); F.ka = k;
}
template <int CTRL> __device__ __forceinline__ int dpp_i(int v) { return __builtin_amdgcn_update_dpp(0, v, CTRL, 0xf, 0xf, true); }
template <int CTRL> __device__ __forceinline__ float dpp_f(float v) { return __int_as_float(dpp_i<CTRL>(__float_as_int(v))); }
constexpr int DPP_XOR1 = 0xB1, DPP_XOR2 = 0x4E, DPP_HMIRROR = 0x141, DPP_ROR4 = 0x124, DPP_ROR8 = 0x128;
__device__ __forceinline__ float wave_sum_u(float v) {
    v += dpp_f<DPP_XOR1>(v); v += dpp_f<DPP_XOR2>(v); v += dpp_f<DPP_ROR4>(v); v += dpp_f<DPP_ROR8>(v);
    const float r0 = __int_as_float(__builtin_amdgcn_readlane(__float_as_int(v), 0)), r1 = __int_as_float(__builtin_amdgcn_readlane(__float_as_int(v), 16));
    const float r2 = __int_as_float(__builtin_amdgcn_readlane(__float_as_int(v), 32)), r3 = __int_as_float(__builtin_amdgcn_readlane(__float_as_int(v), 48));
    return (r0 + r1) + (r2 + r3);
}
__device__ __forceinline__ float wave_max_u(float v) {
    v = fmaxf(v, dpp_f<DPP_XOR1>(v)); v = fmaxf(v, dpp_f<DPP_XOR2>(v)); v = fmaxf(v, dpp_f<DPP_ROR4>(v)); v = fmaxf(v, dpp_f<DPP_ROR8>(v));
    const float r0 = __int_as_float(__builtin_amdgcn_readlane(__float_as_int(v), 0)), r1 = __int_as_float(__builtin_amdgcn_readlane(__float_as_int(v), 16));
    const float r2 = __int_as_float(__builtin_amdgcn_readlane(__float_as_int(v), 32)), r3 = __int_as_float(__builtin_amdgcn_readlane(__float_as_int(v), 48));
    return fmaxf(fmaxf(r0, r1), fmaxf(r2, r3));
}
__device__ __forceinline__ float xor32_f(float v, int lane) { return __int_as_float(__builtin_amdgcn_ds_bpermute((lane ^ 32) << 2, __float_as_int(v))); }
__device__ __forceinline__ float wave_sum(float v) { return wave_sum_u(v); }
__device__ __forceinline__ unsigned pk2(float lo, float hi) { return pg8::cvt_pk_bf16(lo, hi); }
__device__ __forceinline__ float bf_lo(unsigned u) { return __uint_as_float(u << 16); }
__device__ __forceinline__ float bf_hi(unsigned u) { return __uint_as_float(u & 0xffff0000u); }
__device__ __forceinline__ int modrow(int t) { return t < TL ? t / SEQ : 2; }

__device__ __forceinline__ void transpose_item(const float* W, int K, int N, bf16_t* WT, LAS float* scr, int item, int lane) {
    const int nblk = N / 32, kb = item / nblk, nb = item % nblk, k0 = 64 * kb, n0 = 32 * nb;
#pragma unroll 8
    for (int i = 0; i < 32; ++i) { const int kk = 2 * i + (lane >> 5); scr[kk * 33 + (lane & 31)] = W[(size_t)(k0 + kk) * N + n0 + (lane & 31)]; }
    LDS_WAIT(); asm volatile("" ::: "memory");
    const int c = lane & 7;
#pragma unroll
    for (int j = 0; j < 4; ++j) { const int n = (lane >> 3) + 8 * j; const LAS float* s = scr + (8 * c) * 33 + n;
        u32x4 o; o.x = pk2(s[0 * 33], s[1 * 33]); o.y = pk2(s[2 * 33], s[3 * 33]); o.z = pk2(s[4 * 33], s[5 * 33]); o.w = pk2(s[6 * 33], s[7 * 33]);
        *(u32x4*)(WT + (size_t)(n0 + n) * K + k0 + 8 * c) = o; }
    LDS_WAIT(); asm volatile("" ::: "memory");
}

__device__ __forceinline__ void cvt_row_bf16(const float* src, bf16_t* dst, int lane) {
    const f32x4* s = (const f32x4*)src + lane; u32x2* d = (u32x2*)dst + lane;
    f32x4 v[8];
#pragma unroll
    for (int j = 0; j < 8; ++j) v[j] = __builtin_nontemporal_load(s + 64 * j);
#pragma unroll
    for (int j = 0; j < 8; ++j) { u32x2 o; o.x = pk2(v[j].x, v[j].y); o.y = pk2(v[j].z, v[j].w); d[64 * j] = o; }
}

struct RowF32 { f32x4 v[4][2]; };
__device__ __forceinline__ void row_load_nt(RowF32& R, const float* src, int lane) {
    const f32x4* s = (const f32x4*)src + 2 * lane;
#pragma unroll
    for (int j = 0; j < 4; ++j) { R.v[j][0] = __builtin_nontemporal_load(s + 128 * j); R.v[j][1] = __builtin_nontemporal_load(s + 128 * j + 1); }
}
template <int FMT>
__device__ __forceinline__ void cvt_row_lp(const RowF32& R, unsigned char* dst, float* inv, int lane) {
    constexpr float QMAX = FMT == 8 ? 224.f : 6.f;
    float am = 0.f;
#pragma unroll
    for (int j = 0; j < 4; ++j)
#pragma unroll
        for (int q = 0; q < 2; ++q) am = fmaxf(fmaxf(am, fmaxf(fabsf(R.v[j][q].x), fabsf(R.v[j][q].y))), fmaxf(fabsf(R.v[j][q].z), fabsf(R.v[j][q].w)));
    am = wave_max_u(am);
    const float sc = am > 0.f ? QMAX / am : 1.f;
#pragma unroll
    for (int j = 0; j < 4; ++j) {
        if constexpr (FMT == 8) {
            u32x2 w;
#pragma unroll
            for (int q = 0; q < 2; ++q) { int t = __builtin_amdgcn_cvt_pk_fp8_f32(R.v[j][q].x * sc, R.v[j][q].y * sc, 0, false); t = __builtin_amdgcn_cvt_pk_fp8_f32(R.v[j][q].z * sc, R.v[j][q].w * sc, t, true); w[q] = (unsigned)t; }
            *((u32x2*)dst + lane + 64 * j) = w;
        } else {
            unsigned w = 0u;
            w = __builtin_amdgcn_cvt_scalef32_pk_fp4_f32(w, R.v[j][0].x * sc, R.v[j][0].y * sc, 1.0f, 0);
            w = __builtin_amdgcn_cvt_scalef32_pk_fp4_f32(w, R.v[j][0].z * sc, R.v[j][0].w * sc, 1.0f, 1);
            w = __builtin_amdgcn_cvt_scalef32_pk_fp4_f32(w, R.v[j][1].x * sc, R.v[j][1].y * sc, 1.0f, 2);
            w = __builtin_amdgcn_cvt_scalef32_pk_fp4_f32(w, R.v[j][1].z * sc, R.v[j][1].w * sc, 1.0f, 3);
            *((unsigned*)dst + lane + 64 * j) = w;
        }
    }
    if (lane == 0) *inv = am > 0.f ? am * (1.f / QMAX) : 1.f;
}
template <int FMT> struct LpRow;
template <> struct LpRow<8> { u32x4 a, b;
    __device__ __forceinline__ void load(const unsigned char* rowp, int lane) { a = *(const u32x4*)(rowp + 32 * lane); b = *(const u32x4*)(rowp + 32 * lane + 16); }
    template <class Fn> __device__ __forceinline__ void each(Fn&& f) const {
#pragma unroll
        for (int w = 0; w < 4; ++w) { const f32x2 l0 = __builtin_amdgcn_cvt_pk_f32_fp8((int)a[w], false), h0 = __builtin_amdgcn_cvt_pk_f32_fp8((int)a[w], true);
            f(4 * w, l0.x, l0.y); f(4 * w + 2, h0.x, h0.y); }
#pragma unroll
        for (int w = 0; w < 4; ++w) { const f32x2 l0 = __builtin_amdgcn_cvt_pk_f32_fp8((int)b[w], false), h0 = __builtin_amdgcn_cvt_pk_f32_fp8((int)b[w], true);
            f(16 + 4 * w, l0.x, l0.y); f(16 + 4 * w + 2, h0.x, h0.y); }
    } };
template <> struct LpRow<4> { u32x4 a;
    __device__ __forceinline__ void load(const unsigned char* rowp, int lane) { a = *(const u32x4*)(rowp + 16 * lane); }
    template <class Fn> __device__ __forceinline__ void each(Fn&& f) const {
#pragma unroll
        for (int w = 0; w < 4; ++w) {
            const f32x2 d0 = __builtin_amdgcn_cvt_scalef32_pk_f32_fp4(a[w], 1.0f, 0), d1 = __builtin_amdgcn_cvt_scalef32_pk_f32_fp4(a[w], 1.0f, 1);
            const f32x2 d2 = __builtin_amdgcn_cvt_scalef32_pk_f32_fp4(a[w], 1.0f, 2), d3 = __builtin_amdgcn_cvt_scalef32_pk_f32_fp4(a[w], 1.0f, 3);
            f(8 * w, d0.x, d0.y); f(8 * w + 2, d1.x, d1.y); f(8 * w + 4, d2.x, d2.y); f(8 * w + 6, d3.x, d3.y); }
    }
    template <class Fn> __device__ __forceinline__ void each_bf(Fn&& f) const {
#pragma unroll
        for (int w = 0; w < 4; ++w) {
            f(4 * w, __builtin_amdgcn_cvt_scalef32_pk_bf16_fp4(a[w], 1.0f, 0)); f(4 * w + 1, __builtin_amdgcn_cvt_scalef32_pk_bf16_fp4(a[w], 1.0f, 1));
            f(4 * w + 2, __builtin_amdgcn_cvt_scalef32_pk_bf16_fp4(a[w], 1.0f, 2)); f(4 * w + 3, __builtin_amdgcn_cvt_scalef32_pk_bf16_fp4(a[w], 1.0f, 3)); }
    } };

__device__ __forceinline__ void row_stats(const f32x4 (&v)[8], float& mean, float& rstd) {
    float s = 0.f;
#pragma unroll
    for (int j = 0; j < 8; ++j) s += (v[j].x + v[j].y) + (v[j].z + v[j].w);
    mean = wave_sum(s) * (1.f / D);
    float s2 = 0.f;
#pragma unroll
    for (int j = 0; j < 8; ++j) { const f32x4 d = v[j] - mean; s2 += (d.x * d.x + d.y * d.y) + (d.z * d.z + d.w * d.w); }
    rstd = 1.f / sqrtf(wave_sum(s2) * (1.f / D) + LN_EPS);
}
__device__ __forceinline__ void modulate_store(const f32x4 (&v)[8], const float* shift, const float* scale, bf16_t* dst, int lane) {
    float mean, rstd; row_stats(v, mean, rstd);
    u32x2* d = (u32x2*)dst + lane;
#pragma unroll
    for (int j = 0; j < 8; ++j) { const f32x4 sc = *((const f32x4*)scale + lane + 64 * j), sh = *((const f32x4*)shift + lane + 64 * j);
        const f32x4 y = (v[j] - mean) * rstd * (sc + 1.f) + sh;
        u32x2 o; o.x = pk2(y.x, y.y); o.y = pk2(y.z, y.w); d[64 * j] = o; }
}

__device__ __forceinline__ void convert_tables(Frame& F, int row0, int row1, int w0, int wstride) {
    RowF32 ru, rv, nu, nv;
    int row = row0 + w0;
    if (row < row1) { row_load_nt(ru, F.pu() + (size_t)row * D, F.lane); row_load_nt(rv, F.pv() + (size_t)row * D, F.lane); }
    while (row < row1) {
        const int nrow = row + wstride;
        if (nrow < row1) { row_load_nt(nu, F.pu() + (size_t)nrow * D, F.lane); row_load_nt(nv, F.pv() + (size_t)nrow * D, F.lane); }
        cvt_row_lp<U_FMT>(ru, F.UT() + (size_t)row * UROW, F.US() + 2 * (size_t)row, F.lane);
        cvt_row_lp<V_FMT>(rv, F.VT() + (size_t)row * VROW, F.US() + 2 * (size_t)row + 1, F.lane);
        ru = nu; rv = nv; row = nrow;
    }
}
__device__ __forceinline__ void convert_in_tail(Frame& F, int layer, int nunits, int part) {
    if (layer + 1 >= NLAYER) return;
    const int G = F.G, rounds = (nunits + G - 1) / G, nlast = nunits - (rounds - 1) * G;
    const int c = (int)blockIdx.x;
    int nshort = G - nlast, sidx = c - nlast;
    if (nshort <= 0) { nshort = G; sidx = c; }
    else if (sidx < 0) return;
    const int r0 = (layer + 1) * NEXP + part * (NEXP / 2);
    convert_tables(F, r0, r0 + NEXP / 2, sidx * NWAVES + F.wave, nshort * NWAVES);
}
__device__ __forceinline__ void p0a_prologue(Frame& F) {
    LAS float* condL = (LAS float*)F.lds;
    LAS float* red = (LAS float*)(F.lds + 24576);
    for (int i = F.tid; i < 3 * D; i += NWAVES * 64) { const int r = i / D, k = i % D; const float v = r < 2 ? F.c()[r * D + k] : F.c_ctx()[k]; condL[i] = v / (1.f + __expf(-v)); }
    __syncthreads();
    for (int item = blockIdx.x; item < 384; item += F.G) {
        const int l = item / 96, n0 = (item % 96) * 128;
        const float* wp = F.w_ada() + ((size_t)l * D + F.wave * 256) * 12288 + n0 + 2 * F.lane;
        f32x2 a0 = {0.f, 0.f}, a1 = {0.f, 0.f}, a2 = {0.f, 0.f};
#pragma unroll 8
        for (int k = 0; k < 256; ++k) { const f32x2 w = __builtin_nontemporal_load((const f32x2*)(wp + (size_t)k * 12288)); const int kk = F.wave * 256 + k;
            a0 += w * condL[kk]; a1 += w * condL[D + kk]; a2 += w * condL[2 * D + kk]; }
        LAS float* rp = red + F.wave * 384 + 2 * F.lane;
        rp[0] = a0.x; rp[1] = a0.y; rp[128] = a1.x; rp[129] = a1.y; rp[256] = a2.x; rp[257] = a2.y;
        __syncthreads();
        if (F.tid < 384) { const int r = F.tid / 128, n = F.tid % 128; float s = 0.f;
#pragma unroll
            for (int w = 0; w < 8; ++w) s += red[w * 384 + r * 128 + n];
            F.MODS()[((size_t)l * 3 + r) * 12288 + n0 + n] = s + F.b_ada()[(size_t)l * 12288 + n0 + n]; }
        __syncthreads();
    }
    LAS float* scr = (LAS float*)(F.lds + 40960 + F.wave * 8448);
    constexpr int I_IN = (D / 64) * (INC / 32), I_OUT = (D / 64) * (D / 32);
    for (int it = F.gw; it < NLAYER * (I_IN + I_OUT); it += F.NGW) {
        const int l = it / (I_IN + I_OUT); int r = it % (I_IN + I_OUT);
        if (r < I_IN) transpose_item(F.w_in() + (size_t)l * D * INC, D, INC, F.WINT() + (size_t)l * INC * D, scr, r, F.lane);
        else transpose_item(F.w_out() + (size_t)l * D * D, D, D, F.WOUTT() + (size_t)l * D * D, scr, r - I_IN, F.lane);
    }
    for (int row = F.gw; row < NLAYER * D; row += F.NGW) {
        const int l = row / D, c = row % D; const f32x4* s = (const f32x4*)(F.wq() + (size_t)row * D) + F.lane;
#pragma unroll
        for (int j = 0; j < 8; ++j) { const f32x4 v = s[64 * j]; u32x2 o; o.x = pk2(v.x, v.y); o.y = pk2(v.z, v.w);
            *((u32x2*)(F.WQR() + ((size_t)(l * 8 + j) * D + c) * 256) + F.lane) = o; }
    }
    for (int row = F.gw; row < 32 * 256; row += F.NGW) {
        const int lh = row >> 8, pk = row & 255, p = pk >> 7;
        u32x2 o = {0u, 0u};
        if ((F.lane >> 5) == p) { const f32x4 v = *((const f32x4*)(F.keys() + ((size_t)lh * 256 + pk) * 128) + (F.lane & 31)); o.x = pk2(v.x, v.y); o.y = pk2(v.z, v.w); }
        *((u32x2*)(F.KBD() + (size_t)row * 256) + F.lane) = o;
    }
    convert_tables(F, 0, NEXP, F.gw, F.NGW);
    for (int i = blockIdx.x * (NWAVES * 64) + F.tid; i < 192 * 32; i += F.G * NWAVES * 64) {
        const int idx = i >> 5, f = i & 31; const float pos = (float)(idx < 128 ? idx : idx - 128);
        const float inv = powf(10000.f, -(float)(2 * f) / 64.f); const float ang = pos * inv;
        F.ROPE()[2 * i] = cosf(ang); F.ROPE()[2 * i + 1] = sinf(ang);
    }
}

__device__ __forceinline__ void p0b_mod0(Frame& F) {
    __syncthreads();
#pragma unroll 1
    for (int v = 0; v < 6; ++v)
        *(LAS f32x4*)(F.lds + v * 8192 + F.tid * 16) = *(const f32x4*)(F.MODS() + (size_t)(v % 3) * 12288 + (v < 3 ? 0 : D) + 4 * F.tid);
    __syncthreads();
    for (int t = F.gw; t < TT; t += F.NGW) {
        const float* src = t < TL ? F.x() + (size_t)t * D : F.ctx() + (size_t)(t - TL) * D;
        f32x4 v[8];
#pragma unroll
        for (int j = 0; j < 8; ++j) v[j] = *((const f32x4*)src + F.lane + 64 * j);
        const int mr = modrow(t);
        float mean, rstd; row_stats(v, mean, rstd);
        u32x2* d = (u32x2*)(F.H() + (size_t)t * D) + F.lane;
#pragma unroll
        for (int j = 0; j < 8; ++j) { const f32x4 sh = *(const LAS f32x4*)(F.lds + mr * 8192 + (64 * j + F.lane) * 16), sc = *(const LAS f32x4*)(F.lds + (3 + mr) * 8192 + (64 * j + F.lane) * 16);
            const f32x4 y = (v[j] - mean) * rstd * (sc + 1.f) + sh;
            u32x2 o; o.x = pk2(y.x, y.y); o.y = pk2(y.z, y.w); d[64 * j] = o; }
    }
}

constexpr int ROPE_LDS = 98304;
constexpr int CONV_LDS = 81920;
constexpr int KP = 272, VP = 320, KS_BYTES = 64 * KP, VS_BYTES = 64 * VP;
struct KVRegs { u32x4 k1, k2, v1, v2; f32x4 cs[4]; };

__device__ __forceinline__ void attn_load_tile(Frame& F, KVRegs& R, int ti, int b, int n, int g) {
    const int key = F.tid >> 3, c8 = F.tid & 7;
    int row, pos = 0;
    if (ti < 6) { pos = (n - 1) * 128 + 64 * ti + key; row = b * SEQ + pos; } else row = TL + b * CTXL + 64 * (ti - 6) + key;
    const bf16_t* base = F.PROJ() + (size_t)row * INC;
    const int d1 = (c8 >> 2) * 64 + (c8 & 3) * 8;
    R.k1 = *(const u32x4*)(base + OFF_K + g * 128 + d1); R.k2 = *(const u32x4*)(base + OFF_K + g * 128 + d1 + 32);
    R.v1 = *(const u32x4*)(base + OFF_V + g * 128 + 8 * c8); R.v2 = *(const u32x4*)(base + OFF_V + g * 128 + 64 + 8 * c8);
    if (ti < 6) { const int tidx = (c8 >> 2) ? 128 + (pos & 63) : (pos >> 6); const LAS f32x4* cp = (const LAS f32x4*)(F.lds + ROPE_LDS + (tidx * 32 + (c8 & 3) * 8) * 8);
#pragma unroll
        for (int m = 0; m < 4; ++m) R.cs[m] = cp[m]; }
}
__device__ __forceinline__ void rope8(u32x4& a, u32x4& bq, const f32x4 (&cs)[4], float scale) {
    u32x4 oa, ob;
#pragma unroll
    for (int w = 0; w < 4; ++w) {
        const float x1l = bf_lo(a[w]), x1h = bf_hi(a[w]), x2l = bf_lo(bq[w]), x2h = bf_hi(bq[w]);
        const float cl = cs[w].x, sl = cs[w].y, ch = cs[w].z, sh = cs[w].w;
        oa[w] = pk2((x1l * cl - x2l * sl) * scale, (x1h * ch - x2h * sh) * scale);
        ob[w] = pk2((x2l * cl + x1l * sl) * scale, (x2h * ch + x1h * sh) * scale);
    }
    a = oa; bq = ob;
}
__device__ __forceinline__ void attn_store_tile(Frame& F, KVRegs& R, int ti, int buf) {
    const int key = F.tid >> 3, c8 = F.tid & 7;
    if (ti < 6) rope8(R.k1, R.k2, R.cs, 1.f);
    const int d1 = (c8 >> 2) * 64 + (c8 & 3) * 8;
    LAS unsigned char* kp = F.lds + buf * KS_BYTES + key * KP;
    *(LAS u32x4*)(kp + d1 * 2) = R.k1; *(LAS u32x4*)(kp + (d1 + 32) * 2) = R.k2;
    LAS unsigned char* vp = F.lds + 2 * KS_BYTES + buf * VS_BYTES + key * VP;
    *(LAS u32x4*)(vp + 16 * c8) = R.v1; *(LAS u32x4*)(vp + 128 + 16 * c8) = R.v2;
}

#define MFMA32(a, b, c) __builtin_amdgcn_mfma_f32_32x32x16_bf16((a), (b), (c), 0, 0, 0)

__device__ __forceinline__ void attn_unit(Frame& F, int layer, int u) {
    const bool latent = u < 512;
    int b, n, g, hp;
    if (latent) { hp = u & 1; g = (u >> 1) & 1; n = (u >> 2) & 63; b = u >> 8; }
    else { const int v = u - 512; hp = v & 1; g = (v >> 1) & 1; n = (v >> 2) & 1; b = v >> 3; }
    const int lane = F.lane, r = lane & 31, h = lane >> 5, wave = F.wave;
    const int head = g * 4 + hp * 2 + (wave >> 2), qb = wave & 3;
    const int tq = latent ? b * SEQ + n * 128 + 32 * qb + r : TL + b * CTXL + n * 128 + 32 * qb + r;
    bf16x8 qf[8];
    {
        u32x4 raw[8];
        const bf16_t* qp = F.PROJ() + (size_t)tq * INC + OFF_Q + head * 128 + 8 * h;
#pragma unroll
        for (int ks = 0; ks < 8; ++ks) raw[ks] = *(const u32x4*)(qp + 16 * ks);
        if (latent) {
            const int pos = n * 128 + 32 * qb + r;
#pragma unroll
            for (int half = 0; half < 2; ++half) {
                const int tidx = half ? 128 + (pos & 63) : (pos >> 6);
#pragma unroll
                for (int kk = 0; kk < 2; ++kk) {
                    const LAS f32x4* cp = (const LAS f32x4*)(F.lds + ROPE_LDS + (tidx * 32 + 16 * kk + 8 * h) * 8);
                    f32x4 cs[4];
#pragma unroll
                    for (int m = 0; m < 4; ++m) cs[m] = cp[m];
                    rope8(raw[4 * half + kk], raw[4 * half + kk + 2], cs, QSCALE);
                }
            }
        } else {
#pragma unroll
            for (int ks = 0; ks < 8; ++ks)
#pragma unroll
                for (int w = 0; w < 4; ++w) raw[ks][w] = pk2(bf_lo(raw[ks][w]) * QSCALE, bf_hi(raw[ks][w]) * QSCALE);
        }
#pragma unroll
        for (int ks = 0; ks < 8; ++ks) qf[ks] = __builtin_bit_cast(bf16x8, raw[ks]);
    }
    int tlo = 6, nw = 0;
    if (latent) { tlo = (n == 0) ? 2 : 0; const int thi = (n == 63) ? 3 : 5; nw = thi - tlo + 1; }
    const int ntiles = nw + 4;
    f32x16 o[4];
#pragma unroll
    for (int db = 0; db < 4; ++db)
#pragma unroll
        for (int i = 0; i < 16; ++i) o[db][i] = 0.f;
    float m_run = F.sink()[layer * 8 + head] * LOG2E;
    float lsum = h == 0 ? 1.f : 0.f;
    const int iq = 32 * qb + r;
    KVRegs R;
    __syncthreads();
    attn_load_tile(F, R, nw > 0 ? tlo : 6, b, n, g);
    attn_store_tile(F, R, nw > 0 ? tlo : 6, 0);
    __syncthreads();
    const int i16 = lane & 15, tq4 = i16 >> 2, tp = i16 & 3, blk = (lane >> 4) & 1;
    for (int j = 0; j < ntiles; ++j) {
        const int ti = j < nw ? tlo + j : 6 + (j - nw);
        const int buf = j & 1;
        const bool more = j + 1 < ntiles;
        const int tin = (j + 1) < nw ? tlo + j + 1 : 6 + (j + 1 - nw);
        if (more) attn_load_tile(F, R, tin, b, n, g);
        const bool part = ti >= 6 || (ti >= (qb >> 1) && ti <= (qb >> 1) + 4);
        if (part) {
            f32x16 s0, s1;
#pragma unroll
            for (int i = 0; i < 16; ++i) { s0[i] = 0.f; s1[i] = 0.f; }
            const LAS unsigned char* kb = F.lds + buf * KS_BYTES + r * KP + h * 16;
#pragma unroll
            for (int ks = 0; ks < 8; ++ks) {
                const bf16x8 a0 = *(const LAS bf16x8*)(kb + ks * 32), a1 = *(const LAS bf16x8*)(kb + 32 * KP + ks * 32);
                s0 = MFMA32(a0, qf[ks], s0); s1 = MFMA32(a1, qf[ks], s1);
            }
            float mx = -INFINITY;
            if (ti < 6 && (ti == (qb >> 1) || ti == (qb >> 1) + 4)) {
                const int jb = 64 * ti + 4 * h - iq;
#pragma unroll
                for (int i = 0; i < 16; ++i) { const int j0 = jb + (i & 3) + 8 * (i >> 2), j1 = j0 + 32;
                    s0[i] = (j0 >= 0 && j0 <= 256) ? s0[i] : -INFINITY; s1[i] = (j1 >= 0 && j1 <= 256) ? s1[i] : -INFINITY; }
            }
#pragma unroll
            for (int i = 0; i < 16; ++i) mx = fmaxf(mx, fmaxf(s0[i], s1[i]));
            mx = fmaxf(mx, xor32_f(mx, lane));
            if (__any(mx > m_run + 8.f)) {
                const float m_new = mx > m_run + 8.f ? mx : m_run, alpha = __builtin_amdgcn_exp2f(m_run - m_new);
                m_run = m_new; lsum *= alpha;
#pragma unroll
                for (int db = 0; db < 4; ++db)
#pragma unroll
                    for (int i = 0; i < 16; ++i) o[db][i] *= alpha;
            }
#pragma unroll
            for (int i = 0; i < 16; ++i) { s0[i] = __builtin_amdgcn_exp2f(s0[i] - m_run); s1[i] = __builtin_amdgcn_exp2f(s1[i] - m_run); lsum += s0[i] + s1[i]; }
            bf16x8 pf[2][2];
#pragma unroll
            for (int s2 = 0; s2 < 2; ++s2) {
                u32x4 p0, p1;
#pragma unroll
                for (int w = 0; w < 4; ++w) { p0[w] = pk2(s0[8 * s2 + 2 * w], s0[8 * s2 + 2 * w + 1]); p1[w] = pk2(s1[8 * s2 + 2 * w], s1[8 * s2 + 2 * w + 1]); }
                pf[0][s2] = __builtin_bit_cast(bf16x8, p0); pf[1][s2] = __builtin_bit_cast(bf16x8, p1);
            }
            const LAS unsigned char* vb = F.lds + 2 * KS_BYTES + buf * VS_BYTES + (4 * h + tq4) * VP + 32 * blk + 8 * tp;
#pragma unroll
            for (int db = 0; db < 4; ++db)
#pragma unroll
                for (int kb2 = 0; kb2 < 2; ++kb2)
#pragma unroll
                    for (int s2 = 0; s2 < 2; ++s2) {
                        const int off = (32 * kb2 + 16 * s2) * VP + db * 64;
                        const s16x4 lo = __builtin_amdgcn_ds_read_tr16_b64_v4i16((LAS s16x4*)(vb + off));
                        const s16x4 hi = __builtin_amdgcn_ds_read_tr16_b64_v4i16((LAS s16x4*)(vb + off + 8 * VP));
                        const bf16x8 av = __builtin_shufflevector(lo, hi, 0, 1, 2, 3, 4, 5, 6, 7);
                        o[db] = MFMA32(av, pf[kb2][s2], o[db]);
                    }
        }
        if (more) attn_store_tile(F, R, tin, buf ^ 1);
        __syncthreads();
    }
    const float lt = lsum + xor32_f(lsum, lane);
    const float inv = 1.f / lt;
    float ss = 0.f;
#pragma unroll
    for (int db = 0; db < 4; ++db)
#pragma unroll
        for (int i = 0; i < 16; ++i) { o[db][i] *= inv; ss += o[db][i] * o[db][i]; }
    ss += xor32_f(ss, lane);
    const float rn = 1.f / sqrtf(ss * (1.f / 128.f) + LN_EPS);
    bf16_t* op = F.MIX() + (size_t)tq * D + head * 128 + 4 * h;
    const float* gp = F.g_attn() + layer * 1024 + head * 128 + 4 * h;
#pragma unroll
    for (int db = 0; db < 4; ++db)
#pragma unroll
        for (int g4 = 0; g4 < 4; ++g4) {
            const f32x4 gv = *(const f32x4*)(gp + 32 * db + 8 * g4);
            u32x2 w; w.x = pk2(o[db][4 * g4] * rn * gv.x, o[db][4 * g4 + 1] * rn * gv.y); w.y = pk2(o[db][4 * g4 + 2] * rn * gv.z, o[db][4 * g4 + 3] * rn * gv.w);
            *(u32x2*)(op + 32 * db + 8 * g4) = w;
        }
}

__device__ __forceinline__ void unpack8(const u32x4 v, float (&f)[8]) {
#pragma unroll
    for (int w = 0; w < 4; ++w) { f[2 * w] = bf_lo(v[w]); f[2 * w + 1] = bf_hi(v[w]); }
}
__device__ __forceinline__ void conv_row(Frame& F, int layer, int t) {
    bool first, last;
    if (t < TL) { const int pos = t & (SEQ - 1); first = pos == 0; last = pos == SEQ - 1; } else { const int pc = (t - TL) & (CTXL - 1); first = pc == 0; last = pc == CTXL - 1; }
    const bf16_t* p = F.PROJ() + (size_t)t * INC;
    const LAS unsigned char* cvc = F.lds + CONV_LDS + F.lane * 16;
#pragma unroll
    for (int jc = 0; jc < 2; ++jc) {
        const int c = 8 * F.lane + 512 * jc;
        float gb[8], a[8], bq[8], um[8], ut[8], up[8];
        unpack8(*(const u32x4*)(p + c), gb);
        unpack8(*(const u32x4*)(p + OFF_C + c), a); unpack8(*(const u32x4*)(p + OFF_X + c), bq);
#pragma unroll
        for (int e = 0; e < 8; ++e) ut[e] = a[e] * bq[e];
        if (!first) { unpack8(*(const u32x4*)(p - INC + OFF_C + c), a); unpack8(*(const u32x4*)(p - INC + OFF_X + c), bq);
#pragma unroll
            for (int e = 0; e < 8; ++e) um[e] = a[e] * bq[e]; }
        else {
#pragma unroll
            for (int e = 0; e < 8; ++e) um[e] = 0.f; }
        if (!last) { unpack8(*(const u32x4*)(p + INC + OFF_C + c), a); unpack8(*(const u32x4*)(p + INC + OFF_X + c), bq);
#pragma unroll
            for (int e = 0; e < 8; ++e) up[e] = a[e] * bq[e]; }
        else {
#pragma unroll
            for (int e = 0; e < 8; ++e) up[e] = 0.f; }
        float y[8], ss = 0.f;
#pragma unroll
        for (int q = 0; q < 2; ++q) { const f32x4 w0 = *(const LAS f32x4*)(cvc + (2 * jc + q) * 1024), w1 = *(const LAS f32x4*)(cvc + 4096 + (2 * jc + q) * 1024), w2 = *(const LAS f32x4*)(cvc + 8192 + (2 * jc + q) * 1024);
#pragma unroll
            for (int e = 0; e < 4; ++e) { const int i = 4 * q + e; y[i] = gb[i] * (w0[e] * um[i] + w1[e] * ut[i] + w2[e] * up[i]); ss += y[i] * y[i]; } }
        ss += dpp_f<DPP_XOR1>(ss); ss += dpp_f<DPP_XOR2>(ss); ss += dpp_f<DPP_ROR4>(ss); ss += dpp_f<DPP_ROR8>(ss);
        const float rn = 1.f / sqrtf(ss * (1.f / 128.f) + LN_EPS);
        u32x4 w;
#pragma unroll
        for (int q = 0; q < 2; ++q) { const f32x4 gcv = *(const LAS f32x4*)(cvc + 12288 + (2 * jc + q) * 1024); w[2 * q] = pk2(y[4 * q] * rn * gcv[0], y[4 * q + 1] * rn * gcv[1]); w[2 * q + 1] = pk2(y[4 * q + 2] * rn * gcv[2], y[4 * q + 3] * rn * gcv[3]); }
        *(u32x4*)(F.MIX() + (size_t)t * D + 1024 + c) = w;
    }
}

__device__ __forceinline__ void ln_phase(Frame& F, int layer, int rows) {
    const int lane = F.lane;
    u32x4 w[4], wn[4];
    int t = F.gw;
    if (t < rows) {
#pragma unroll
        for (int j = 0; j < 4; ++j) w[j] = *(const u32x4*)(F.X() + (size_t)t * D + 8 * lane + 512 * j);
    }
    {
        const int ch = F.tid, jj = ch >> 7, rem = ch & 127, ll = rem >> 1, qq = rem & 1;
        LAS unsigned char* dst = F.lds + ((2 * jj + qq) * 64 + ll) * 16;
        *(LAS f32x4*)(dst) = *(const f32x4*)(F.ln1_g() + layer * D + 4 * ch);
        *(LAS f32x4*)(dst + 8192) = *(const f32x4*)(F.ln1_b() + layer * D + 4 * ch);
#pragma unroll 1
        for (int v = 0; v < 6; ++v) { const int mrv = v % 3; const size_t off = ((size_t)layer * 3 + mrv) * 12288 + (v < 3 ? 3 * D : 4 * D);
            *(LAS f32x4*)(dst + (2 + v) * 8192) = *(const f32x4*)(F.MODS() + off + 4 * ch); }
    }
    __syncthreads();
    const LAS unsigned char* vc = F.lds + lane * 16;
    while (t < rows) {
        const int tn = t + F.NGW;
        if (tn < rows) {
#pragma unroll
            for (int j = 0; j < 4; ++j) wn[j] = *(const u32x4*)(F.X() + (size_t)tn * D + 8 * lane + 512 * j);
        }
        float v[32]; float s = 0.f;
#pragma unroll
        for (int j = 0; j < 4; ++j)
#pragma unroll
            for (int q = 0; q < 4; ++q) { v[8 * j + 2 * q] = bf_lo(w[j][q]); v[8 * j + 2 * q + 1] = bf_hi(w[j][q]); s += v[8 * j + 2 * q] + v[8 * j + 2 * q + 1]; }
        const float mean = wave_sum(s) * (1.f / D);
        float s2 = 0.f;
#pragma unroll
        for (int i = 0; i < 32; ++i) { v[i] -= mean; s2 += v[i] * v[i]; }
        const float rstd = 1.f / sqrtf(wave_sum(s2) * (1.f / D) + LN_EPS);
        float s3 = 0.f;
#pragma unroll
        for (int j = 0; j < 4; ++j) { const int c = 8 * lane + 512 * j; u32x4 o;
#pragma unroll
            for (int q = 0; q < 2; ++q) { const f32x4 gg = *(const LAS f32x4*)(vc + (2 * j + q) * 1024), bb = *(const LAS f32x4*)(vc + 8192 + (2 * j + q) * 1024);
#pragma unroll
                for (int e = 0; e < 4; ++e) { const float y = v[8 * j + 4 * q + e] * rstd * gg[e] + bb[e]; v[8 * j + 4 * q + e] = y; s3 += y; }
                o[2 * q] = pk2(v[8 * j + 4 * q], v[8 * j + 4 * q + 1]); o[2 * q + 1] = pk2(v[8 * j + 4 * q + 2], v[8 * j + 4 * q + 3]); }
            *(u32x4*)(F.X() + (size_t)t * D + c) = o; }
        const float mean2 = wave_sum(s3) * (1.f / D);
        float s4 = 0.f;
#pragma unroll
        for (int i = 0; i < 32; ++i) { v[i] -= mean2; s4 += v[i] * v[i]; }
        const float rstd2 = 1.f / sqrtf(wave_sum(s4) * (1.f / D) + LN_EPS);
        const int mrl = modrow(t);
#pragma unroll
        for (int j = 0; j < 4; ++j) { const int c = 8 * lane + 512 * j; u32x4 o;
#pragma unroll
            for (int q = 0; q < 2; ++q) { const f32x4 sh = *(const LAS f32x4*)(vc + (2 + mrl) * 8192 + (2 * j + q) * 1024), sc = *(const LAS f32x4*)(vc + (5 + mrl) * 8192 + (2 * j + q) * 1024);
                const float y0 = v[8 * j + 4 * q] * rstd2 * (1.f + sc[0]) + sh[0], y1 = v[8 * j + 4 * q + 1] * rstd2 * (1.f + sc[1]) + sh[1];
                const float y2 = v[8 * j + 4 * q + 2] * rstd2 * (1.f + sc[2]) + sh[2], y3 = v[8 * j + 4 * q + 3] * rstd2 * (1.f + sc[3]) + sh[3];
                o[2 * q] = pk2(y0, y1); o[2 * q + 1] = pk2(y2, y3); }
            *(u32x4*)(F.H() + (size_t)t * D + c) = o; }
#pragma unroll
        for (int j = 0; j < 4; ++j) w[j] = wn[j];
        t = tn;
    }
}

__device__ __forceinline__ unsigned ordkey(float f) { const unsigned u = __float_as_uint(f); return u ^ ((u >> 31) ? 0xFFFFFFFFu : 0x80000000u); }
__device__ __forceinline__ float gelu_erf(float a) { return 0.5f * a * (1.f + erff(a * 0.70710678118654752f)); }

__device__ __forceinline__ float unordkey(unsigned k) { return __uint_as_float(k ^ ((k >> 31) ? 0x80000000u : 0xFFFFFFFFu)); }
__device__ __forceinline__ float gelu_as(float v) {
    const float av = fabsf(v), t = __builtin_amdgcn_rcpf(av * 0.2316418882f + 1.0f);
    float q = t * 0.5307027145f + (-0.7265760135f); q = q * t + 0.7107068705f; q = q * t + (-0.142248368f); q = q * t + 0.127414796f; q = q * t;
    const float e = __builtin_amdgcn_exp2f((v * v) * (-0.72134752044f));
    const float m = v * (q * e);
    return v < 0.f ? m : v - m;
}

template <class O> struct QuadNet {
    typedef typename O::V V; typedef typename O::B B;
    template <bool ASC> static __device__ __forceinline__ void ce_reg(V& a, V& b) { const V lo = O::vmin(a, b), hi = O::vmax(a, b); a = ASC ? lo : hi; b = ASC ? hi : lo; }
    template <bool ASC> static __device__ __forceinline__ void ce_l1(V& x, B low1) { const V p = O::x1(x); const V mn = O::vmin(p, x), mx = O::vmax(p, x); x = ASC ? O::vsel(low1, mn, mx) : O::vsel(low1, mx, mn); }
    template <bool ASC> static __device__ __forceinline__ void ce_l2(V& x, B low2) { const V p = O::x2(x); const V mn = O::vmin(p, x), mx = O::vmax(p, x); x = ASC ? O::vsel(low2, mn, mx) : O::vsel(low2, mx, mn); }
    template <int NR> static __device__ __forceinline__ void sort_blocks(V (&R)[NR], B low1, B low2, B eq12) {
#pragma unroll
        for (int r = 0; r < NR; ++r) { const V p = O::x1(R[r]); const V mn = O::vmin(p, R[r]), mx = O::vmax(p, R[r]); R[r] = O::vsel(eq12, mn, mx); }
#pragma unroll
        for (int r = 0; r < NR; ++r) { if ((r & 1) == 0) ce_l2<true>(R[r], low2); else ce_l2<false>(R[r], low2); }
#pragma unroll
        for (int r = 0; r < NR; ++r) { if ((r & 1) == 0) ce_l1<true>(R[r], low1); else ce_l1<false>(R[r], low1); }
#pragma unroll
        for (int r = 0; r < NR; r += 2) { if ((r & 2) == 0) ce_reg<true>(R[r], R[r + 1]); else ce_reg<false>(R[r], R[r + 1]); }
#pragma unroll
        for (int r = 0; r < NR; ++r) { if ((r & 2) == 0) ce_l2<true>(R[r], low2); else ce_l2<false>(R[r], low2); }
#pragma unroll
        for (int r = 0; r < NR; ++r) { if ((r & 2) == 0) ce_l1<true>(R[r], low1); else ce_l1<false>(R[r], low1); }
#pragma unroll
        for (int r = 0; r < NR; ++r) { if ((r & 2) == 0) { if ((r & 4) == 0) ce_reg<true>(R[r], R[r + 2]); else ce_reg<false>(R[r], R[r + 2]); } }
#pragma unroll
        for (int r = 0; r < NR; r += 2) { if ((r & 4) == 0) ce_reg<true>(R[r], R[r + 1]); else ce_reg<false>(R[r], R[r + 1]); }
#pragma unroll
        for (int r = 0; r < NR; ++r) { if ((r & 4) == 0) ce_l2<true>(R[r], low2); else ce_l2<false>(R[r], low2); }
#pragma unroll
        for (int r = 0; r < NR; ++r) { if ((r & 4) == 0) ce_l1<true>(R[r], low1); else ce_l1<false>(R[r], low1); }
    }
    template <int NR> static __device__ __forceinline__ void halve_merge(const V (&R)[NR], V (&Q)[NR / 2], B low1, B low2) {
#pragma unroll
        for (int m = 0; m < NR / 8; ++m)
#pragma unroll
            for (int i = 0; i < 4; ++i) Q[4 * m + i] = O::vmax(R[8 * m + i], R[8 * m + 4 + i]);
#pragma unroll
        for (int r = 0; r < NR / 2; ++r) { if ((r & 2) == 0) { if ((r & 4) == 0) ce_reg<false>(Q[r], Q[r + 2]); else ce_reg<true>(Q[r], Q[r + 2]); } }
#pragma unroll
        for (int r = 0; r < NR / 2; r += 2) { if ((r & 4) == 0) ce_reg<false>(Q[r], Q[r + 1]); else ce_reg<true>(Q[r], Q[r + 1]); }
#pragma unroll
        for (int r = 0; r < NR / 2; ++r) { if ((r & 4) == 0) ce_l2<false>(Q[r], low2); else ce_l2<true>(Q[r], low2); }
#pragma unroll
        for (int r = 0; r < NR / 2; ++r) { if ((r & 4) == 0) ce_l1<false>(Q[r], low1); else ce_l1<true>(Q[r], low1); }
    }
    static __device__ __forceinline__ void top16_of_128(V (&R)[32], V (&T)[4], B low1, B low2, B eq12) {
        sort_blocks<32>(R, low1, low2, eq12);
        V A[16]; halve_merge<32>(R, A, low1, low2);
        V Bq[8]; halve_merge<16>(A, Bq, low1, low2);
        halve_merge<8>(Bq, T, low1, low2);
    }
    static __device__ __forceinline__ void top16_of_64(V (&R)[16], V (&T)[4], B low1, B low2, B eq12) {
        sort_blocks<16>(R, low1, low2, eq12);
        V A[8]; halve_merge<16>(R, A, low1, low2);
        halve_merge<8>(A, T, low1, low2);
    }
};

struct DevOps {
    typedef unsigned V; typedef bool B;
    static __device__ __forceinline__ V vmin(V a, V b) { return a < b ? a : b; }
    static __device__ __forceinline__ V vmax(V a, V b) { return a > b ? a : b; }
    static __device__ __forceinline__ V vsel(B m, V a, V b) { return m ? a : b; }
    static __device__ __forceinline__ V x1(V a) { return (V)dpp_i<DPP_XOR1>((int)a); }
    static __device__ __forceinline__ V x2(V a) { return (V)dpp_i<DPP_XOR2>((int)a); }
};
__device__ __forceinline__ void stair_ab(int c, int& a, int& b) {
    if (c < 16) { a = 0; b = c; } else if (c < 24) { a = 1; b = c - 16; } else if (c < 28) { a = 2; b = c - 24; } else if (c < 32) { a = 3; b = c - 28; }
    else if (c < 36) { a = 4; b = c - 32; } else if (c < 40) { a = 5 + ((c - 36) >> 1); b = (c - 36) & 1; } else if (c < 44) { a = 7 + ((c - 40) >> 1); b = (c - 40) & 1; }
    else if (c < 48) { a = 9 + (c - 44); b = 0; } else if (c < 51) { a = 13 + (c - 48); b = 0; } else { a = 2; b = 4; }
}
constexpr int PE_WS = 5120, PE_TAB = 8 * PE_WS;
constexpr int PE_VEC = PE_TAB + 512;
static_assert(PE_VEC + 11 * 8192 <= LDSCTL_OFF, "PE vector cache");
__device__ __forceinline__ void peer_topk(Frame& F, LAS unsigned char* ws, int t) {
    const int lane = F.lane, sub = lane & 3;
    const bool low1 = (sub & 1) == 0, low2 = (sub & 2) == 0, eq12 = low1 == low2;
    LAS unsigned* S1K = (LAS unsigned*)ws; LAS int* EL = (LAS int*)(ws + 3328); LAS float* GL = (LAS float*)(ws + 3840);
    const LAS unsigned short* TAB = (const LAS unsigned short*)(F.lds + PE_TAB);
    {
        const int L = lane >> 2;
        const bf16_t* sp = F.SC() + (size_t)t * D + L * 128 + sub * 32;
        unsigned R[32];
#pragma unroll
        for (int q = 0; q < 4; ++q) { const u32x4 v = *(const u32x4*)(sp + 8 * q);
#pragma unroll
            for (int e = 0; e < 4; ++e) {
                R[8 * q + 2 * e] = (ordkey(bf_lo(v[e])) & ~127u) | (unsigned)(127 - (32 * sub + 8 * q + 2 * e));
                R[8 * q + 2 * e + 1] = (ordkey(bf_hi(v[e])) & ~127u) | (unsigned)(127 - (32 * sub + 8 * q + 2 * e + 1)); } }
        unsigned T[4];
        QuadNet<DevOps>::top16_of_128(R, T, low1, low2, eq12);
#pragma unroll
        for (int r = 0; r < 4; ++r) S1K[L * 16 + 4 * r + sub] = T[r];
    }
    LDS_WAIT(); __builtin_amdgcn_wave_barrier();
    {
        const int hd = (lane >> 2) & 7;
        const LAS unsigned char* la = (const LAS unsigned char*)(S1K + (2 * hd) * 16); const LAS unsigned char* lb = (const LAS unsigned char*)(S1K + (2 * hd + 1) * 16);
        unsigned C[16];
#pragma unroll
        for (int r = 0; r < 13; ++r) { const unsigned ab = TAB[4 * r + sub];
            const unsigned ka = *(const LAS unsigned*)(la + (ab & 255u)), kb = *(const LAS unsigned*)(lb + (ab >> 8));
            const float sum = unordkey(ka & ~127u) + unordkey(kb & ~127u);
            C[r] = (ordkey(sum) & ~63u) | (unsigned)(63 - (4 * r + sub)); }
        C[13] = 0u; C[14] = 0u; C[15] = 0u;
        unsigned W[4];
        QuadNet<DevOps>::top16_of_64(C, W, low1, low2, eq12);
        float sv[4]; int ex[4];
#pragma unroll
        for (int r = 0; r < 4; ++r) { const unsigned ab = TAB[63 - (W[r] & 63u)];
            const unsigned ka = *(const LAS unsigned*)(la + (ab & 255u)), kb = *(const LAS unsigned*)(lb + (ab >> 8));
            ex[r] = (int)(127u - (ka & 127u)) * 128 + (int)(127u - (kb & 127u)); sv[r] = unordkey(W[r] & ~63u); }
        const float mx = dpp_f<0x00>(sv[0]);
        float e4[4], es = 0.f;
#pragma unroll
        for (int r = 0; r < 4; ++r) { e4[r] = __expf(sv[r] - mx); es += e4[r]; }
        es += dpp_f<DPP_XOR1>(es); es += dpp_f<DPP_XOR2>(es);
        const float rd = 1.f / es;
#pragma unroll
        for (int r = 0; r < 4; ++r) { GL[hd * 16 + 4 * r + sub] = e4[r] * rd; EL[hd * 16 + 4 * r + sub] = ex[r]; }
    }
    LDS_WAIT(); __builtin_amdgcn_wave_barrier();
}

#ifndef PROBE_PHASE
#define PROBE_PHASE -1
#endif
#ifndef PROBE_MULT
#define PROBE_MULT 1
#endif
constexpr int EB = 4;
constexpr int CW_TICKET = 20480;

struct GBuf { LpRow<U_FMT> u[EB]; LpRow<V_FMT> v[EB]; };
__device__ __forceinline__ void gather_issue(GBuf& B, const LAS int* EL, int i0, const unsigned char* UTl, const unsigned char* VTl, int lane) {
#pragma unroll
    for (int q = 0; q < EB; ++q) {
        const int ex = __builtin_amdgcn_readfirstlane(EL[i0 + q]);
        B.u[q].load(UTl + (size_t)ex * UROW, lane); B.v[q].load(VTl + (size_t)ex * VROW, lane);
    }
}
__device__ __forceinline__ void gather_compute(const GBuf& B, const LAS int* EL, const LAS float* GL, int i0, const float* USl, const float* VSl, const unsigned (&hv)[16], f32x2 (&acc)[16]) {
    float dot[EB], su[EB], sv[EB], g[EB];
#pragma unroll
    for (int q = 0; q < EB; ++q) { const int ex = __builtin_amdgcn_readfirstlane(EL[i0 + q]); { const f32x2 s2 = *(const f32x2*)(USl + 2 * ex); su[q] = s2.x; sv[q] = s2.y; }
        g[q] = __uint_as_float(__builtin_amdgcn_readfirstlane(__float_as_uint(GL[i0 + q]))); }
#pragma unroll
    for (int q = 0; q < EB; ++q) { float s0 = 0.f, s1 = 0.f;
        B.u[q].each_bf([&](int i, bf16x2_t x) { if (i & 1) s1 = __builtin_amdgcn_fdot2_f32_bf16(x, __builtin_bit_cast(bf16x2_t, hv[i]), s1, false); else s0 = __builtin_amdgcn_fdot2_f32_bf16(x, __builtin_bit_cast(bf16x2_t, hv[i]), s0, false); });
        dot[q] = s0 + s1; __builtin_amdgcn_sched_barrier(0); }
#pragma unroll
    for (int q = 0; q < EB; ++q) dot[q] = wave_sum_u(dot[q]);
#pragma unroll
    for (int q = 0; q < EB; ++q) { const float cf = g[q] * gelu_as(dot[q] * su[q]) * sv[q]; const f32x2 c2 = {cf, cf};
        B.v[q].each([&](int i, float x0, float x1) { const f32x2 x = {x0, x1}; acc[i >> 1] = __builtin_elementwise_fma(x, c2, acc[i >> 1]); }); __builtin_amdgcn_sched_barrier(0); }
}

__device__ __forceinline__ void peer_phase(Frame& F, int layer, int rows, unsigned* ctl, unsigned long long& pr_acc) {
    unsigned long long pt0 = 0ull;
#define SUB_BEGIN(ty) do { if (PROBE_PHASE == (ty)) pt0 = __builtin_amdgcn_s_memrealtime(); } while (0)
#define SUB_END(ty) do { if (PROBE_PHASE == (ty)) pr_acc += __builtin_amdgcn_s_memrealtime() - pt0; } while (0)
    if (F.tid < 64) { int a = 0, b = 0; stair_ab(F.tid < 52 ? F.tid : 0, a, b); *(LAS unsigned short*)(F.lds + PE_TAB + 2 * F.tid) = (unsigned short)((4 * a) | ((4 * b) << 8)); }
    {
        const int ch = F.tid, ll = ch >> 3, q = ch & 7;
        LAS unsigned char* dst = F.lds + PE_VEC + (q * 64 + ll) * 16;
        const int nl = layer < NLAYER - 1 ? layer + 1 : layer;
#pragma unroll 1
        for (int v = 0; v < 9; ++v) {
            const int g3 = v / 3, mrv = v - 3 * g3;
            const size_t off = ((size_t)(g3 == 0 ? layer : nl) * 3 + mrv) * 12288 + (g3 == 0 ? 5 * D : (g3 == 1 ? 0 : D));
            *(LAS f32x4*)(dst + v * 8192) = *(const f32x4*)(F.MODS() + off + 4 * ch);
        }
        *(LAS f32x4*)(dst + 9 * 8192) = *(const f32x4*)(F.ln2_g() + layer * D + 4 * ch);
        *(LAS f32x4*)(dst + 10 * 8192) = *(const f32x4*)(F.ln2_b() + layer * D + 4 * ch);
    }
    __syncthreads();
    LAS unsigned char* ws = F.lds + F.wave * PE_WS;
    LAS int* EL = (LAS int*)(ws + 3328); LAS float* GL = (LAS float*)(ws + 3840);
    const int lane = F.lane;
    const LAS unsigned char* vcache = F.lds + PE_VEC + lane * 16;
    const unsigned char* UTl = F.UT() + (size_t)layer * NEXP * UROW;
    const unsigned char* VTl = F.VT() + (size_t)layer * NEXP * VROW;
    const float* USl = F.US() + 2 * (size_t)layer * NEXP; const float* VSl = nullptr;
    unsigned* ticket = ctl + CW_TICKET + 64 * layer;
    unsigned tk = 0u;
    if (lane == 0) tk = __hip_atomic_fetch_add(ticket, 1u, __ATOMIC_RELAXED, __HIP_MEMORY_SCOPE_AGENT);
    int t = (int)__builtin_amdgcn_readfirstlane(tk);
    while (t < rows) {
        unsigned tkn = 0u;
        if (lane == 0) tkn = __hip_atomic_fetch_add(ticket, 1u, __ATOMIC_RELAXED, __HIP_MEMORY_SCOPE_AGENT);
        SUB_BEGIN(8); peer_topk(F, ws, t); SUB_END(8);
        SUB_BEGIN(9);
        unsigned hv[16]; f32x2 acc[16];
#pragma unroll
        for (int q = 0; q < 4; ++q) { const u32x4 w = *(const u32x4*)(F.H() + (size_t)t * D + 32 * lane + 8 * q);
#pragma unroll
            for (int e = 0; e < 4; ++e) { hv[4 * q + e] = w[e]; acc[4 * q + e] = (f32x2){0.f, 0.f}; } }
        {
            GBuf A, B, C;
            gather_issue(A, EL, 0, UTl, VTl, lane);
            gather_issue(B, EL, EB, UTl, VTl, lane);
            for (int i0 = 0; i0 < 30 * EB; i0 += 3 * EB) {
                gather_issue(C, EL, i0 + 2 * EB, UTl, VTl, lane);
                gather_compute(A, EL, GL, i0, USl, VSl, hv, acc);
                gather_issue(A, EL, i0 + 3 * EB, UTl, VTl, lane);
                gather_compute(B, EL, GL, i0 + EB, USl, VSl, hv, acc);
                gather_issue(B, EL, i0 + 4 * EB, UTl, VTl, lane);
                gather_compute(C, EL, GL, i0 + 2 * EB, USl, VSl, hv, acc);
            }
            gather_compute(A, EL, GL, 30 * EB, USl, VSl, hv, acc);
            gather_compute(B, EL, GL, 31 * EB, USl, VSl, hv, acc);
        }
        SUB_END(9); SUB_BEGIN(10);
        const int mr = modrow(t);
        const float* mp = F.MODS() + ((size_t)layer * 3 + mr) * 12288;
        bf16_t* xr = F.X() + (size_t)t * D;
        float rr[32]; float s = 0.f;
#pragma unroll
        for (int q2 = 0; q2 < 4; ++q2) { const u32x4 xw = *(const u32x4*)(xr + 32 * lane + 8 * q2);
#pragma unroll
            for (int h2 = 0; h2 < 2; ++h2) { const int q = 2 * q2 + h2; const f32x4 gv = *(const LAS f32x4*)(vcache + mr * 8192 + q * 1024);
                const f32x4 xv = {bf_lo(xw[2 * h2]), bf_hi(xw[2 * h2]), bf_lo(xw[2 * h2 + 1]), bf_hi(xw[2 * h2 + 1])};
                const f32x4 av = {acc[2 * q].x, acc[2 * q].y, acc[2 * q + 1].x, acc[2 * q + 1].y};
#pragma unroll
                for (int e = 0; e < 4; ++e) { const float v = DN_ALPHA * xv[e] + gv[e] * av[e]; rr[4 * q + e] = v; s += v; } } }
        const float mean = wave_sum_u(s) * (1.f / D);
        float s2 = 0.f;
#pragma unroll
        for (int i = 0; i < 32; ++i) { rr[i] -= mean; s2 += rr[i] * rr[i]; }
        const float rstd = 1.f / sqrtf(wave_sum_u(s2) * (1.f / D) + LN_EPS);
        const float* g2 = F.ln2_g() + layer * D; const float* b2 = F.ln2_b() + layer * D;
        float s3 = 0.f;
#pragma unroll
        for (int q = 0; q < 8; ++q) { const int c = 32 * lane + 4 * q; const f32x4 gg = *(const LAS f32x4*)(vcache + 9 * 8192 + q * 1024), bb = *(const LAS f32x4*)(vcache + 10 * 8192 + q * 1024);
            f32x4 xo;
#pragma unroll
            for (int e = 0; e < 4; ++e) { xo[e] = rr[4 * q + e] * rstd * gg[e] + bb[e]; rr[4 * q + e] = xo[e]; s3 += xo[e]; }
            if (layer == NLAYER - 1 && t < TL) *(f32x4*)(F.out() + (size_t)t * D + c) = xo; }
        if (layer < NLAYER - 1) {
#pragma unroll
            for (int q2 = 0; q2 < 4; ++q2) { u32x4 o4; o4.x = pk2(rr[8 * q2], rr[8 * q2 + 1]); o4.y = pk2(rr[8 * q2 + 2], rr[8 * q2 + 3]); o4.z = pk2(rr[8 * q2 + 4], rr[8 * q2 + 5]); o4.w = pk2(rr[8 * q2 + 6], rr[8 * q2 + 7]);
                *(u32x4*)(xr + 32 * lane + 8 * q2) = o4; }
            const float mean2 = wave_sum_u(s3) * (1.f / D);
            float s4 = 0.f;
#pragma unroll
            for (int i = 0; i < 32; ++i) { rr[i] -= mean2; s4 += rr[i] * rr[i]; }
            const float rstd2 = 1.f / sqrtf(wave_sum_u(s4) * (1.f / D) + LN_EPS);
            const float* np = F.MODS() + ((size_t)(layer + 1) * 3 + mr) * 12288;
#pragma unroll
            for (int q2 = 0; q2 < 4; ++q2) { const int c = 32 * lane + 8 * q2; u32x4 w;
#pragma unroll
                for (int q = 0; q < 2; ++q) { const f32x4 sh = *(const LAS f32x4*)(vcache + (3 + mr) * 8192 + (2 * q2 + q) * 1024), sc = *(const LAS f32x4*)(vcache + (6 + mr) * 8192 + (2 * q2 + q) * 1024); const int ri = 8 * q2 + 4 * q;
                    const float y0 = rr[ri] * rstd2 * (1.f + sc[0]) + sh[0], y1 = rr[ri + 1] * rstd2 * (1.f + sc[1]) + sh[1];
                    const float y2 = rr[ri + 2] * rstd2 * (1.f + sc[2]) + sh[2], y3 = rr[ri + 3] * rstd2 * (1.f + sc[3]) + sh[3];
                    w[2 * q] = pk2(y0, y1); w[2 * q + 1] = pk2(y2, y3); }
                *(u32x4*)(F.H() + (size_t)t * D + c) = w; }
        }
        SUB_END(10);
        t = (int)__builtin_amdgcn_readfirstlane(tkn);
    }
#undef SUB_BEGIN
#undef SUB_END
}

__global__ void __launch_bounds__(NWAVES * 64, 2) skel_fwd(Args args) {
    extern __shared__ __attribute__((aligned(16))) unsigned char lds[];
    Frame F;
    F.lds = (LAS unsigned char*)lds;
    F.tid = threadIdx.x; F.lane = F.tid & 63; F.wave = __builtin_amdgcn_readfirstlane(F.tid >> 6);
    F.G = gridDim.x; F.gw = blockIdx.x * NWAVES + F.wave; F.NGW = F.G * NWAVES;
    unsigned char* ws = args.ws;
    F.ka = (const CAS unsigned char*)__builtin_amdgcn_kernarg_segment_ptr();
    for (int u = F.tid; u < (LDS_BYTES - LDSCTL_OFF) / 4; u += NWAVES * 64) ((LAS unsigned*)(F.lds + LDSCTL_OFF))[u] = 0u;
    __syncthreads();
    unsigned* ctl = (unsigned*)(ws + WS_CTL);
    const int lo = args.ph_lo, hi = args.ph_hi;
    XcdBarrier bar; bar.bar = ctl + CW_BAR + args.li * XCD_BAR_WORDS; bar.x = 0; bar.st = nullptr;
    if (hi - lo > 1) bar = xcd_barrier_post(ctl + CW_BAR + args.li * XCD_BAR_WORDS, (volatile LAS unsigned*)(F.lds + MISC_OFF) + 8);
#define IN(k) (lo <= (k) && (k) < hi)
    unsigned long long pr_acc = 0ull, pr_t0 = 0ull;
#define PR_BEGIN(ty) do { if (PROBE_PHASE == (ty)) pr_t0 = __builtin_amdgcn_s_memrealtime(); } while (0)
#define PR_END(ty) do { if (PROBE_PHASE == (ty)) pr_acc += __builtin_amdgcn_s_memrealtime() - pr_t0; } while (0)
#define BOTH(k) (IN(k) && IN((k) + 1))
#define SEAM(k) do { if (BOTH(k)) xcd_barrier(bar); } while (0)

    if (IN(0)) { PR_BEGIN(0); frame_ids(F); p0a_prologue(F); SEAM(0); PR_END(0); }
    if (IN(1)) {
        PR_BEGIN(1); frame_ids(F);
        { pg8::Gemm g{F.KBD(), F.WQR(), 32 * 256, 2048, 256}; pg8::BatchOrder S{F.G, (int)blockIdx.x}; pg8::EpiBf16 E{F.WEFFT(), D};
          pg8::gemm_phase<pg8::EpiBf16, pg8::BatchOrder, false, true>(F.lds, g, S, E); }
        p0b_mod0(F);
        SEAM(1); PR_END(1);
    }
    for (int layer = 0; layer < NLAYER; ++layer) {
        const int pb = 2 + 6 * layer;
        const bool lastl = layer == NLAYER - 1;
        const int rows = lastl ? TL : TT;
        if (IN(pb + 0)) {
            PR_BEGIN(2); frame_ids(F);
            pg8::Gemm g{F.H(), F.WINT() + (size_t)layer * INC * D, TT, INC, D}; pg8::StaticOrder S; S.init(TT, INC, F.G, (int)blockIdx.x);
            pg8::EpiBf16 E{F.PROJ(), INC};
            pg8::gemm_phase<pg8::EpiBf16, pg8::StaticOrder, true, true>(F.lds, g, S, E);
            SEAM(pb + 0); PR_END(2);
        }
        if (IN(pb + 1)) {
            PR_BEGIN(3); frame_ids(F);
            const int nunits = lastl ? 512 : 528;
            {
                const int ch = F.tid & 255, vsel = F.tid >> 8;
                LAS unsigned char* dst = F.lds + CONV_LDS + ((2 * (ch >> 7) + (ch & 1)) * 64 + ((ch & 127) >> 1)) * 16;
                *(LAS f32x4*)(dst + vsel * 4096) = *(const f32x4*)(F.conv_w() + (size_t)layer * 3 * 1024 + vsel * 1024 + 4 * ch);
                *(LAS f32x4*)(dst + (2 + vsel) * 4096) = vsel == 0 ? *(const f32x4*)(F.conv_w() + (size_t)layer * 3 * 1024 + 2048 + 4 * ch) : *(const f32x4*)(F.g_conv() + layer * 1024 + 4 * ch);
            }
            for (int i = F.tid; i < 192 * 32 * 2 / 4; i += NWAVES * 64) *(LAS f32x4*)(F.lds + ROPE_LDS + i * 16) = *(const f32x4*)(F.ROPE() + 4 * i);
            __syncthreads();
            { unsigned long long q0 = 0; if (PROBE_PHASE == 11) q0 = __builtin_amdgcn_s_memrealtime();
            { const int bx = (int)blockIdx.x, vcu = (F.G % 8 == 0) ? (bx % 8) * (F.G / 8) + bx / 8 : bx;
              for (int u = vcu; u < nunits; u += F.G) attn_unit(F, layer, u); }
            if (PROBE_PHASE == 11) pr_acc += __builtin_amdgcn_s_memrealtime() - q0; if (PROBE_PHASE == 12) q0 = __builtin_amdgcn_s_memrealtime();
            {
              const int nx = nunits - 2 * F.G; const bool uneven = nx > 0 && nx < F.G;
              const int bx2 = (int)blockIdx.x, vc2 = (F.G % 8 == 0) ? (bx2 % 8) * (F.G / 8) + bx2 / 8 : bx2;
              const int c0 = uneven ? vc2 - nx : vc2, nb = uneven ? F.G - nx : F.G;
              if (c0 >= 0) for (int t = c0 * NWAVES + F.wave; t < rows; t += nb * NWAVES) conv_row(F, layer, t); }
            if (PROBE_PHASE == 12) pr_acc += __builtin_amdgcn_s_memrealtime() - q0; }
            SEAM(pb + 1); PR_END(3);
        }
        if (IN(pb + 2)) {
            PR_BEGIN(4); frame_ids(F);
            pg8::Gemm g{F.MIX(), F.WOUTT() + (size_t)layer * D * D, rows, D, D}; pg8::StaticOrder S; S.init(rows, D, F.G, (int)blockIdx.x);
            pg8::EpiResid E{layer == 0 ? F.x() : nullptr, layer == 0 ? F.ctx() : nullptr, F.X(), F.MODS() + (size_t)layer * 3 * 12288 + 2 * D};
            pg8::gemm_phase<pg8::EpiResid, pg8::StaticOrder, true, true>(F.lds, g, S, E);
            frame_ids(F); convert_in_tail(F, layer, (rows / 256) * (D / 256), 0);
            SEAM(pb + 2); PR_END(4);
        }
        if (IN(pb + 3)) { PR_BEGIN(5); frame_ids(F); ln_phase(F, layer, rows); SEAM(pb + 3); PR_END(5); }
        if (IN(pb + 4)) {
            PR_BEGIN(6); frame_ids(F);
            pg8::Gemm g{F.H(), F.WEFFT() + (size_t)layer * D * D, rows, D, D}; pg8::StaticOrder S; S.init(rows, D, F.G, (int)blockIdx.x);
            pg8::EpiBf16 E{F.SC(), D};
            pg8::gemm_phase<pg8::EpiBf16, pg8::StaticOrder, true, true>(F.lds, g, S, E);
            frame_ids(F); convert_in_tail(F, layer, (rows / 256) * (D / 256), 1);
            SEAM(pb + 4); PR_END(6);
        }
        if (IN(pb + 5)) { PR_BEGIN(7); frame_ids(F); peer_phase(F, layer, rows, ctl, pr_acc); SEAM(pb + 5); PR_END(7); }
    }
    if (PROBE_PHASE >= 0 && hi - lo > 1) xcd_barrier(bar);
    if (PROBE_PHASE >= 0 && blockIdx.x == 0 && threadIdx.x == 0) { const unsigned long long t1 = __builtin_amdgcn_s_memrealtime() + (unsigned long long)PROBE_MULT * pr_acc; while (__builtin_amdgcn_s_memrealtime() < t1) __builtin_amdgcn_s_sleep(8); }
#undef IN
#undef BOTH
#undef SEAM
}

extern "C" void kernel_launch(void* const* d_in, const int* in_sizes, int n_in, void* d_out, int out_size, void* d_ws, size_t ws_size, hipStream_t stream) {
    static int grid = 0;
    if (grid == 0) {
        if (n_in != 20 || in_sizes[0] != TL * D || out_size != TL * D || ws_size < WS_END) {
            fprintf(stderr, "kernel_launch: unexpected problem shape (n_in %d, in0 %d, out %d, ws %zu, need %zu)\n", n_in, n_in > 0 ? in_sizes[0] : -1, out_size, ws_size, (size_t)WS_END); grid = -1; return; }
        int dev = 0, cus = 0, per_cu = 0;
        if (hipGetDevice(&dev) != hipSuccess || hipDeviceGetAttribute(&cus, hipDeviceAttributeMultiprocessorCount, dev) != hipSuccess) { grid = -1; return; }
        if (hipFuncSetAttribute((const void*)skel_fwd, hipFuncAttributeMaxDynamicSharedMemorySize, LDS_BYTES) != hipSuccess) { fprintf(stderr, "kernel_launch: hipFuncSetAttribute failed\n"); grid = -1; return; }
        if (hipOccupancyMaxActiveBlocksPerMultiprocessor(&per_cu, (const void*)skel_fwd, NWAVES * 64, LDS_BYTES) != hipSuccess || per_cu < 1)
            fprintf(stderr, "kernel_launch: occupancy query reports %d workgroups per CU\n", per_cu);
        (void)hipGetLastError();
        grid = cus;
    }
    if (grid < 0) return;
    if (hipMemsetAsync((char*)d_ws + WS_CTL, 0, CTL_ZERO_BYTES, stream) != hipSuccess) return;
    Args a{};
    for (int i = 0; i < 20; ++i) a.in[i] = (const float*)d_in[i];
    a.out = (float*)d_out; a.ws = (unsigned char*)d_ws; a.pad = 0;
#if MK_N_LAUNCHES == 1
    a.ph_lo = 0; a.ph_hi = NPHASE; a.li = 0;
    hipLaunchKernelGGL(skel_fwd, dim3(grid), dim3(NWAVES * 64), LDS_BYTES, stream, a);
#else
    for (int ph = 0; ph < NPHASE; ++ph) { a.ph_lo = ph; a.ph_hi = ph + 1; a.li = 0;
        hipLaunchKernelGGL(skel_fwd, dim3(grid), dim3(NWAVES * 64), LDS_BYTES, stream, a); }
#endif
}
```

```cpp
#include <hip/hip_runtime.h>
#include <cstdio>
#include <cstdint>

#ifndef MK_N_LAUNCHES
#define MK_N_LAUNCHES 1
#endif

#define LAS __attribute__((address_space(3)))
typedef unsigned short bf16_t;
typedef short bf16x8 __attribute__((ext_vector_type(8)));
typedef short s16x4 __attribute__((ext_vector_type(4)));
typedef float f32x2 __attribute__((ext_vector_type(2)));
typedef float f32x4 __attribute__((ext_vector_type(4)));
typedef float f32x16 __attribute__((ext_vector_type(16)));
typedef unsigned u32x2 __attribute__((ext_vector_type(2)));
typedef unsigned u32x4 __attribute__((ext_vector_type(4)));
typedef __bf16 bf16x2_t __attribute__((ext_vector_type(2)));
typedef int i32x8 __attribute__((ext_vector_type(8)));

constexpr int D = 2048, NB = 2, SEQ = 8192, CTXL = 256, NLAYER = 4;
constexpr int TL = NB * SEQ, TC = NB * CTXL, TT = TL + TC;
constexpr int INC = 4608, OFF_C = 1024, OFF_X = 2048, OFF_Q = 3072, OFF_K = 4096, OFF_V = 4352;
constexpr float WIN_SCALE = 64.f;
constexpr int NEXP = 16384;
#ifndef U_FMT
#define U_FMT 4
#endif
#ifndef V_FMT
#define V_FMT 4
#endif
constexpr int UROW = D * U_FMT / 8, VROW = D * V_FMT / 8;
constexpr float LN_EPS = 1e-6f;
constexpr float DN_ALPHA = 1.681792830507429f;
constexpr float QSCALE = 0.08838834764831845f * 1.4426950408889634f;
constexpr float LOG2E = 1.4426950408889634f;

constexpr size_t MiB = 1u << 20;
constexpr size_t WS_CTL = 0, CTL_ZERO_BYTES = 1 * MiB;
constexpr size_t WS_MODS = 1 * MiB;
constexpr size_t WS_ROPE = 2 * MiB;
constexpr size_t WS_KBD = 3 * MiB;
constexpr size_t WS_WQR = 8 * MiB;
constexpr size_t WS_WINT = 40 * MiB;
constexpr size_t WS_WOUTT = 112 * MiB;
constexpr size_t WS_WEFFT = 144 * MiB;
constexpr size_t WS_X = 176 * MiB;
constexpr size_t WS_H = 308 * MiB;
constexpr size_t WS_PROJ = 374 * MiB;
constexpr size_t WS_MIX = 523 * MiB;
constexpr size_t WS_SC = 589 * MiB;
constexpr size_t WS_UT = 721 * MiB;
constexpr size_t WS_VT = 849 * MiB;
constexpr size_t WS_US = 977 * MiB;
constexpr size_t WS_VS = 978 * MiB;
constexpr size_t WS_H8 = 979 * MiB;
constexpr size_t WS_END = 1013 * MiB;

constexpr int CW_BAR = 4096;

namespace pg8 {
constexpr int BM = 256, BK = 64, HALF = 128, HTB = HALF * BK * 2, STAGE_BYTES = 8 * HTB, NXCD = 8, WGM = 8;
__host__ __device__ __forceinline__ int lds_byte(int r, int c) { const int st = (r >> 4) * 2 + (c >> 5), rr = r & 15, cc = c & 31, ob = rr * 64 + cc * 2; return st * 1024 + (ob ^ (((ob >> 9) & 1) << 5)); }
__host__ __device__ __forceinline__ void stage_rc(int b, int& R, int& C) { const int st = b / 1024, sb = b % 1024, swz = sb ^ (((sb >> 9) & 1) << 5); R = (st >> 1) * 16 + swz / 64; C = (st & 1) * 32 + (swz % 64) / 2; }
__host__ __device__ __forceinline__ int perm32(int rho) { const int n = rho >> 4, i = rho & 15; return 8 * (i >> 2) + 4 * n + (i & 3); }

struct Unit { int pm, pn; };
struct Gemm { const bf16_t* A; const bf16_t* Bt; int M, N, K; };

struct StaticOrder {
    int nM, nN, nwg, G, c;
    __host__ __device__ void init(int M, int N, int G_, int c_) { nM = M / BM; nN = N / BM; nwg = nM * nN; G = G_; c = c_; }
    __host__ __device__ bool next(int i, Unit& u) const {
        const long L = (long)i * G + c; if (L >= nwg) return false;
        int wgid = (int)L; { const int q = nwg / NXCD, r = nwg % NXCD, xcd = wgid % NXCD, off = wgid / NXCD; wgid = (xcd < r ? xcd * (q + 1) : r * (q + 1) + (xcd - r) * q) + off; }
        const int nig = WGM * nN, gid = wgid / nig, fm = gid * WGM, gsz = (nM - fm) < WGM ? (nM - fm) : WGM;
        u.pm = fm + ((wgid % nig) % gsz); u.pn = (wgid % nig) / gsz; return true;
    }
    __device__ __forceinline__ int btile(const Unit& u) const { return u.pn; }
    __device__ __forceinline__ void a_ready(const Unit&) const {}
    __device__ __forceinline__ void done(const Unit&) const {}
};
struct BatchOrder {
    int G, c;
    __device__ bool next(int i, Unit& u) const { const int L = i * G + c; if (L >= 256) return false; u.pm = L >> 3; u.pn = L & 7; return true; }
    __device__ __forceinline__ int btile(const Unit& u) const { return u.pm * 8 + u.pn; }
    __device__ __forceinline__ void a_ready(const Unit&) const {}
    __device__ __forceinline__ void done(const Unit&) const {}
};

__device__ __forceinline__ unsigned cvt_pk_bf16(float lo, float hi) { f32x2 x = {lo, hi}; bf16x2_t y = __builtin_convertvector(x, bf16x2_t); return __builtin_bit_cast(unsigned, y); }

struct EpiBf16 {
    static constexpr bool PERM = true;
    bf16_t* O; int ldc; float scale;
    __device__ __forceinline__ void operator()(const f32x4 (&acc)[2][2][4][2], const Unit& u, int wr, int wc, int fr, int fq) const {
        const int row0 = u.pm * BM + wr * 64 + fr, col0 = u.pn * BM + wc * 32 + 8 * fq;
#pragma unroll
        for (int ai = 0; ai < 2; ++ai)
#pragma unroll
            for (int m = 0; m < 4; ++m) { bf16_t* rowp = O + (size_t)(row0 + ai * HALF + m * 16) * ldc + col0;
#pragma unroll
                for (int bj = 0; bj < 2; ++bj) { const f32x4 v0 = acc[ai][bj][m][0] * scale, v1 = acc[ai][bj][m][1] * scale;
                    u32x4 w; w.x = cvt_pk_bf16(v0[0], v0[1]); w.y = cvt_pk_bf16(v0[2], v0[3]); w.z = cvt_pk_bf16(v1[0], v1[1]); w.w = cvt_pk_bf16(v1[2], v1[3]);
                    *(u32x4*)(rowp + bj * HALF) = w; } }
    }
};
struct EpiBf16H {
    static constexpr bool PERM = true;
    bf16_t* O; int ldc; float scale;
    __device__ __forceinline__ void operator()(const f32x4 (&acc)[2][2][4][2], const Unit& u, int wr, int wc, int fr, int fq) const {
        const int row0 = u.pm * BM + wr * 64 + fr, col0 = u.pn * HALF + wc * 32 + 8 * fq;
#pragma unroll
        for (int ai = 0; ai < 2; ++ai)
#pragma unroll
            for (int m = 0; m < 4; ++m) { const f32x4 v0 = acc[ai][0][m][0] * scale, v1 = acc[ai][0][m][1] * scale;
                u32x4 w; w.x = cvt_pk_bf16(v0[0], v0[1]); w.y = cvt_pk_bf16(v0[2], v0[3]); w.z = cvt_pk_bf16(v1[0], v1[1]); w.w = cvt_pk_bf16(v1[2], v1[3]);
                *(u32x4*)(O + (size_t)(row0 + ai * HALF + m * 16) * ldc + col0) = w; }
    }
};
struct EpiF32 {
    static constexpr bool PERM = false;
    float* C; int ldc;
    __device__ __forceinline__ void operator()(const f32x4 (&acc)[2][2][4][2], const Unit& u, int wr, int wc, int fr, int fq) const {
        const int row0 = u.pm * BM + wr * 64 + fr, col0 = u.pn * BM + wc * 32 + 4 * fq;
#pragma unroll
        for (int ai = 0; ai < 2; ++ai)
#pragma unroll
            for (int m = 0; m < 4; ++m) { float* rowp = C + (size_t)(row0 + ai * HALF + m * 16) * ldc + col0;
#pragma unroll
                for (int bj = 0; bj < 2; ++bj)
#pragma unroll
                    for (int n = 0; n < 2; ++n) *(f32x4*)(rowp + bj * HALF + n * 16) = acc[ai][bj][m][n]; }
    }
};
struct EpiResid {
    static constexpr bool PERM = true;
    const float* x32_lat; const float* x32_ctx;
    bf16_t* X; const float* gate;
    __device__ __forceinline__ void operator()(const f32x4 (&acc)[2][2][4][2], const Unit& u, int wr, int wc, int fr, int fq) const {
        const int rt = u.pm * BM;
        const int mr = rt < TL ? rt / SEQ : 2;
        const int row0 = rt + wr * 64 + fr, col0 = u.pn * BM + wc * 32 + 8 * fq;
        f32x4 gv[2][2];
#pragma unroll
        for (int bj = 0; bj < 2; ++bj)
#pragma unroll
            for (int n = 0; n < 2; ++n) gv[bj][n] = *(const f32x4*)(gate + (size_t)mr * 12288 + col0 + bj * HALF + 4 * n);
#pragma unroll
        for (int ai = 0; ai < 2; ++ai)
#pragma unroll
            for (int m = 0; m < 4; ++m) { const int row = row0 + ai * HALF + m * 16;
#pragma unroll
                for (int bj = 0; bj < 2; ++bj) {
                    f32x4 x0, x1;
                    if (x32_lat) { const float* xp = (row < TL ? x32_lat + (size_t)row * D : x32_ctx + (size_t)(row - TL) * D) + col0 + bj * HALF; x0 = *(const f32x4*)xp; x1 = *(const f32x4*)(xp + 4); }
                    else { const u32x4 w = *(const u32x4*)(X + (size_t)row * D + col0 + bj * HALF);
                        x0 = (f32x4){__uint_as_float(w.x << 16), __uint_as_float(w.x & 0xffff0000u), __uint_as_float(w.y << 16), __uint_as_float(w.y & 0xffff0000u)};
                        x1 = (f32x4){__uint_as_float(w.z << 16), __uint_as_float(w.z & 0xffff0000u), __uint_as_float(w.w << 16), __uint_as_float(w.w & 0xffff0000u)}; }
                    const f32x4 r0 = x0 * DN_ALPHA + gv[bj][0] * acc[ai][bj][m][0], r1 = x1 * DN_ALPHA + gv[bj][1] * acc[ai][bj][m][1];
                    u32x4 o; o.x = cvt_pk_bf16(r0[0], r0[1]); o.y = cvt_pk_bf16(r0[2], r0[3]); o.z = cvt_pk_bf16(r1[0], r1[1]); o.w = cvt_pk_bf16(r1[2], r1[3]);
                    *(u32x4*)(X + (size_t)row * D + col0 + bj * HALF) = o; } }
    }
};

template <class Epi, class Sched, bool ALIGN_EPI = false, bool SP2 = false, bool FP8 = false, bool HN = false>
__device__ __forceinline__ void gemm_phase(LAS unsigned char* lds, const Gemm g, const Sched& S, const Epi& E) {
    int tid = threadIdx.x; asm volatile("" : "+v"(tid));
    const int wid = __builtin_amdgcn_readfirstlane(tid >> 6), lane = tid & 63, wr = wid >> 2, wc = wid & 3, fr = lane & 15, fq = lane >> 4;
    const int K = g.K, nt = K / BK;
    unsigned voffA[2], voffB[2];
#pragma unroll
    for (int i = 0; i < 2; ++i) { int R, C; stage_rc(tid * 16 + i * 8192, R, C); const int Rb = Epi::PERM ? ((R & ~31) + perm32(R & 31)) : R;
        voffA[i] = (unsigned)(R * K + C) * 2u; voffB[i] = (unsigned)(Rb * K + C) * 2u; }
    const size_t kstep = (size_t)(BK * 2);
    const size_t hstep = (size_t)HALF * K * 2;
    const size_t tstep = 2 * hstep;
    const unsigned ldsw = (unsigned)wid * 1024u;
    const int aoff = lds_byte(wr * 64 + fr, fq * 8), boff = lds_byte(wc * 32 + fr, fq * 8);
    const int aoff8a = lds_byte(wr * 64 + fr, fq * 16), boff8a = lds_byte(wc * 32 + fr, fq * 16);
#define PG8_SA(b, h) (((b) * 2 + (h)) * HTB)
#define PG8_SB(b, h) ((4 + (b) * 2 + (h)) * HTB)
#define PG8_STAGE(bufoff, gbase, voff) do { _Pragma("unroll") for (int _i = 0; _i < 2; ++_i) \
        __builtin_amdgcn_global_load_lds((const unsigned*)((const char*)(gbase) + (voff)[_i]), (LAS unsigned*)(lds + (bufoff) + ldsw + _i * 8192), 16, 0, 0); } while (0)
#define PG8_LDA(dst, b, h) do { if constexpr (FP8) { _Pragma("unroll") for (int m = 0; m < 4; ++m) { const u32x4 _x = *(const LAS u32x4*)(lds + PG8_SA(b, h) + aoff8a + m * 2048), _y = *(const LAS u32x4*)(lds + PG8_SA(b, h) + aoff8a + 16 + m * 2048); \
            dst##8[m] = (i32x8){(int)_x.x, (int)_x.y, (int)_x.z, (int)_x.w, (int)_y.x, (int)_y.y, (int)_y.z, (int)_y.w}; } } \
        else { _Pragma("unroll") for (int m = 0; m < 4; ++m) _Pragma("unroll") for (int k = 0; k < 2; ++k) dst[m][k] = *(const LAS bf16x8*)(lds + PG8_SA(b, h) + aoff + m * 2048 + k * 1024); } } while (0)
#define PG8_LDB(dst, b, h) do { if constexpr (FP8) { _Pragma("unroll") for (int n = 0; n < 2; ++n) { const u32x4 _x = *(const LAS u32x4*)(lds + PG8_SB(b, h) + boff8a + n * 2048), _y = *(const LAS u32x4*)(lds + PG8_SB(b, h) + boff8a + 16 + n * 2048); \
            dst##8[n] = (i32x8){(int)_x.x, (int)_x.y, (int)_x.z, (int)_x.w, (int)_y.x, (int)_y.y, (int)_y.z, (int)_y.w}; } } \
        else { _Pragma("unroll") for (int n = 0; n < 2; ++n) _Pragma("unroll") for (int k = 0; k < 2; ++k) dst[n][k] = *(const LAS bf16x8*)(lds + PG8_SB(b, h) + boff + n * 2048 + k * 1024); } } while (0)
#define PG8_MMA(ai, bj, At, Bt) do { __builtin_amdgcn_s_setprio(1); if constexpr (FP8) { _Pragma("unroll") for (int m = 0; m < 4; ++m) _Pragma("unroll") for (int n = 0; n < 2; ++n) \
            acc[ai][bj][m][n] = __builtin_amdgcn_mfma_scale_f32_16x16x128_f8f6f4(Bt##8[n], At##8[m], acc[ai][bj][m][n], 0, 0, 0, 0x7F7F7F7F, 0, 0x7F7F7F7F); } \
        else { _Pragma("unroll") for (int m = 0; m < 4; ++m) _Pragma("unroll") for (int n = 0; n < 2; ++n) _Pragma("unroll") for (int k = 0; k < 2; ++k) \
            acc[ai][bj][m][n] = __builtin_amdgcn_mfma_f32_16x16x32_bf16(Bt[n][k], At[m][k], acc[ai][bj][m][n], 0, 0, 0); } __builtin_amdgcn_s_setprio(0); } while (0)
#define PG8_WAIT_V(n) asm volatile("s_waitcnt vmcnt(" #n ")" ::: "memory")
#define PG8_WAIT_L(n) asm volatile("s_waitcnt lgkmcnt(" #n ")" ::: "memory")
#define PG8_BAR __builtin_amdgcn_s_barrier()
#define PG8_SCHED __builtin_amdgcn_sched_barrier(0)
    Unit cur, nxt; int ui = 0;
    if (!S.next(0, cur)) return;
    f32x4 acc[2][2][4][2];
#pragma unroll
    for (int a = 0; a < 2; ++a)
#pragma unroll
        for (int b = 0; b < 2; ++b)
#pragma unroll
            for (int m = 0; m < 4; ++m)
#pragma unroll
                for (int n = 0; n < 2; ++n) acc[a][b][m][n] = (f32x4){0.f, 0.f, 0.f, 0.f};
    bf16x8 At[4][2], B0[2][2], B1[2][2];
    i32x8 At8[4], B08[2], B18[2];
    const size_t bstep = HN ? hstep : tstep;
    const char* cA = (const char*)g.A + (size_t)cur.pm * tstep; const char* cB = (const char*)g.Bt + (size_t)S.btile(cur) * bstep;
    S.a_ready(cur);
    if constexpr (HN) {
        static_assert(!HN || SP2, "HN needs the SP2 loop");
        PG8_STAGE(PG8_SB(0, 0), cB, voffB); PG8_STAGE(PG8_SA(0, 0), cA, voffA); PG8_STAGE(PG8_SA(0, 1), cA + hstep, voffA);
        if (wr == 1) PG8_BAR;
        PG8_WAIT_V(2); PG8_BAR;
        PG8_STAGE(PG8_SB(1, 0), cB + kstep, voffB); PG8_STAGE(PG8_SA(1, 0), cA + kstep, voffA);
        PG8_WAIT_V(4); PG8_BAR;
    } else if constexpr (SP2) {
        PG8_STAGE(PG8_SB(0, 0), cB, voffB); PG8_STAGE(PG8_SB(0, 1), cB + hstep, voffB); PG8_STAGE(PG8_SA(0, 0), cA, voffA); PG8_STAGE(PG8_SA(0, 1), cA + hstep, voffA);
        if (wr == 1) PG8_BAR;
        PG8_WAIT_V(2); PG8_BAR;
        PG8_STAGE(PG8_SB(1, 0), cB + kstep, voffB); PG8_STAGE(PG8_SA(1, 0), cA + kstep, voffA); PG8_STAGE(PG8_SB(1, 1), cB + hstep + kstep, voffB);
        PG8_WAIT_V(6); PG8_BAR;
    } else {
        PG8_STAGE(PG8_SB(0, 0), cB, voffB); PG8_STAGE(PG8_SA(0, 0), cA, voffA); PG8_STAGE(PG8_SB(0, 1), cB + hstep, voffB); PG8_STAGE(PG8_SA(0, 1), cA + hstep, voffA);
        if (wr == 1) PG8_BAR;
        PG8_WAIT_V(4); PG8_BAR;
        PG8_STAGE(PG8_SB(1, 0), cB + kstep, voffB); PG8_STAGE(PG8_SA(1, 0), cA + kstep, voffA); PG8_STAGE(PG8_SB(1, 1), cB + hstep + kstep, voffB);
        PG8_WAIT_V(6); PG8_BAR;
    }
    for (;;) {
        const bool has_next = S.next(ui + 1, nxt);
        const char* nA = has_next ? (const char*)g.A + (size_t)nxt.pm * tstep : cA; const char* nB = has_next ? (const char*)g.Bt + (size_t)S.btile(nxt) * bstep : cB;
        for (int t = 0; t < nt; t += 2) {
            const bool last = (t == nt - 2);
            const char* a1 = cA + (size_t)(t + 1) * kstep;
            const char* a2 = last ? nA : cA + (size_t)(t + 2) * kstep; const char* b2 = last ? nB : cB + (size_t)(t + 2) * kstep;
            const char* a3 = a2 + kstep; const char* b3 = b2 + kstep;
            if (last && has_next) S.a_ready(nxt);
            if constexpr (HN) {
            PG8_LDB(B0, 0, 0); PG8_SCHED; PG8_LDA(At, 0, 0); PG8_STAGE(PG8_SA(1, 1), a1 + hstep, voffA);
            PG8_WAIT_V(6); PG8_WAIT_L(0); PG8_BAR; PG8_MMA(0, 0, At, B0); PG8_BAR; PG8_SCHED;
            PG8_LDA(At, 0, 1); PG8_STAGE(PG8_SB(0, 0), b2, voffB); PG8_STAGE(PG8_SA(0, 0), a2, voffA);
            PG8_WAIT_V(6); PG8_WAIT_L(0); PG8_BAR; PG8_MMA(1, 0, At, B0); PG8_BAR; PG8_SCHED;
            PG8_LDB(B0, 1, 0); PG8_SCHED; PG8_LDA(At, 1, 0); PG8_STAGE(PG8_SA(0, 1), a2 + hstep, voffA);
            PG8_WAIT_V(6); PG8_WAIT_L(0); PG8_BAR; PG8_MMA(0, 0, At, B0); PG8_BAR; PG8_SCHED;
            PG8_LDA(At, 1, 1); PG8_STAGE(PG8_SB(1, 0), b3, voffB); PG8_STAGE(PG8_SA(1, 0), a3, voffA);
            PG8_WAIT_V(6); PG8_WAIT_L(0); PG8_BAR; PG8_MMA(1, 0, At, B0); PG8_BAR; PG8_SCHED;
            } else if constexpr (SP2) {
            PG8_LDB(B0, 0, 0); PG8_LDB(B1, 0, 1); PG8_SCHED; PG8_LDA(At, 0, 0); PG8_STAGE(PG8_SA(1, 1), a1 + hstep, voffA);
            PG8_WAIT_V(8); PG8_WAIT_L(0); PG8_BAR; PG8_MMA(0, 0, At, B0); PG8_MMA(0, 1, At, B1); PG8_BAR; PG8_SCHED;
            PG8_LDA(At, 0, 1); PG8_STAGE(PG8_SB(0, 0), b2, voffB); PG8_STAGE(PG8_SB(0, 1), b2 + hstep, voffB); PG8_STAGE(PG8_SA(0, 0), a2, voffA);
            PG8_WAIT_V(8); PG8_WAIT_L(0); PG8_BAR; PG8_MMA(1, 0, At, B0); PG8_MMA(1, 1, At, B1); PG8_BAR; PG8_SCHED;
            PG8_LDB(B0, 1, 0); PG8_LDB(B1, 1, 1); PG8_SCHED; PG8_LDA(At, 1, 0); PG8_STAGE(PG8_SA(0, 1), a2 + hstep, voffA);
            PG8_WAIT_V(8); PG8_WAIT_L(0); PG8_BAR; PG8_MMA(0, 0, At, B0); PG8_MMA(0, 1, At, B1); PG8_BAR; PG8_SCHED;
            PG8_LDA(At, 1, 1); PG8_STAGE(PG8_SB(1, 0), b3, voffB); PG8_STAGE(PG8_SB(1, 1), b3 + hstep, voffB); PG8_STAGE(PG8_SA(1, 0), a3, voffA);
            PG8_WAIT_V(8); PG8_WAIT_L(0); PG8_BAR; PG8_MMA(1, 0, At, B0); PG8_MMA(1, 1, At, B1); PG8_BAR; PG8_SCHED;
            } else {
            PG8_LDB(B0, 0, 0); PG8_SCHED; PG8_LDA(At, 0, 0); PG8_STAGE(PG8_SA(1, 1), a1 + hstep, voffA);
            PG8_WAIT_L(8); PG8_BAR; PG8_WAIT_L(0); PG8_MMA(0, 0, At, B0); PG8_BAR; PG8_SCHED;
            PG8_LDB(B1, 0, 1); PG8_STAGE(PG8_SB(0, 0), b2, voffB);
            PG8_BAR; PG8_WAIT_L(0); PG8_MMA(0, 1, At, B1); PG8_BAR;
            PG8_LDA(At, 0, 1); PG8_STAGE(PG8_SA(0, 0), a2, voffA);
            PG8_BAR; PG8_WAIT_L(0); PG8_MMA(1, 0, At, B0); PG8_BAR; PG8_SCHED;
            PG8_STAGE(PG8_SB(0, 1), b2 + hstep, voffB);
            PG8_WAIT_V(6); PG8_BAR; PG8_MMA(1, 1, At, B1); PG8_BAR;
            PG8_LDB(B0, 1, 0); PG8_SCHED; PG8_LDA(At, 1, 0); PG8_STAGE(PG8_SA(0, 1), a2 + hstep, voffA);
            PG8_WAIT_L(8); PG8_BAR; PG8_WAIT_L(0); PG8_MMA(0, 0, At, B0); PG8_BAR; PG8_SCHED;
            PG8_LDB(B1, 1, 1); PG8_STAGE(PG8_SB(1, 0), b3, voffB);
            PG8_BAR; PG8_WAIT_L(0); PG8_MMA(0, 1, At, B1); PG8_BAR;
            PG8_LDA(At, 1, 1); PG8_STAGE(PG8_SA(1, 0), a3, voffA);
            PG8_BAR; PG8_WAIT_L(0); PG8_MMA(1, 0, At, B0); PG8_BAR; PG8_SCHED;
            PG8_STAGE(PG8_SB(1, 1), b3 + hstep, voffB);
            PG8_WAIT_V(6); PG8_BAR; PG8_MMA(1, 1, At, B1); PG8_BAR;
            }
        }
        if constexpr (ALIGN_EPI) { if (wr == 0) PG8_BAR; }
        E(acc, cur, wr, wc, fr, fq); S.done(cur);
        if (!has_next) break;
#pragma unroll
        for (int a = 0; a < 2; ++a)
#pragma unroll
            for (int b = 0; b < 2; ++b)
#pragma unroll
                for (int m = 0; m < 4; ++m)
#pragma unroll
                    for (int n = 0; n < 2; ++n) acc[a][b][m][n] = (f32x4){0.f, 0.f, 0.f, 0.f};
        cur = nxt; cA = nA; cB = nB; ++ui;
        if constexpr (ALIGN_EPI) { if (wr == 1) PG8_BAR; }
    }
    PG8_WAIT_V(0);
    if constexpr (!ALIGN_EPI) { if (wr == 0) PG8_BAR; }
    PG8_BAR;
#undef PG8_SA
#undef PG8_SB
#undef PG8_STAGE
#undef PG8_LDA
#undef PG8_LDB
#undef PG8_MMA
#undef PG8_WAIT_V
#undef PG8_WAIT_L
#undef PG8_BAR
#undef PG8_SCHED
}
}

#define XB_TMO      128
#define XB_XCNT(j)  (256  + 64 * (j))
#define XB_XSUB(j)  (1280 + 64 * (j))
#define XB_XGEN(j)  (2304 + 64 * (j))
#define XB_TOP      3328
#define XB_TOPGEN   3392
#define XCD_BAR_WORDS 3456
#define XB_SPIN_CAP (1u << 18)

__device__ __forceinline__ unsigned xb_ld(unsigned* p)              { return __hip_atomic_load(p, __ATOMIC_RELAXED, __HIP_MEMORY_SCOPE_AGENT); }
__device__ __forceinline__ unsigned xb_add(unsigned* p, unsigned v) { return __hip_atomic_fetch_add(p, v, __ATOMIC_RELAXED, __HIP_MEMORY_SCOPE_AGENT); }
__device__ __forceinline__ unsigned xb_xcc_id() { return (unsigned)__builtin_amdgcn_s_getreg((3 << 11) | 20) & 0xFu; }
#define XB_SPIN(cond, bar) do { unsigned _sp = 0; while (cond) { __builtin_amdgcn_s_sleep(1); \
    if ((++_sp & 255u) == 0u) { if (xb_ld(&(bar)[XB_TMO])) break; if (_sp > XB_SPIN_CAP) { atomicAdd(&(bar)[XB_TMO], 1u); break; } } } } while (0)

struct XcdBarrier { unsigned* bar; unsigned x; volatile LAS unsigned* st; };

__device__ __forceinline__ XcdBarrier xcd_barrier_post(unsigned* bar, volatile LAS unsigned* st) {
    XcdBarrier b; b.bar = bar; b.x = xb_xcc_id(); b.st = st;
    if (threadIdx.x == 0) (void)xb_add(&bar[XB_XCNT(b.x)], 1u);
    return b;
}
__device__ __forceinline__ void xcd_barrier_complete(unsigned* bar, unsigned x, unsigned& nloc, unsigned& nx) {
    const unsigned G = gridDim.x * gridDim.y * gridDim.z;
    unsigned sum, cnt, mine, sp = 0u;
    for (;;) {
        sum = 0u; cnt = 0u; mine = 0u;
#pragma unroll
        for (unsigned j = 0; j < 16; ++j) { const unsigned c = xb_ld(&bar[XB_XCNT(j)]); sum += c; cnt += (c > 0u) ? 1u : 0u; mine = (j == x) ? c : mine; }
        if (sum == G) break;
        __builtin_amdgcn_s_sleep(1);
        if ((++sp & 255u) == 0u) { if (xb_ld(&bar[XB_TMO])) break; if (sp > XB_SPIN_CAP) { atomicAdd(&bar[XB_TMO], 1u); break; } }
    }
    nloc = mine > 0u ? mine : 1u; nx = cnt > 0u ? cnt : 1u;
}
__device__ __forceinline__ void xcd_barrier(const XcdBarrier& b) {
    asm volatile("s_waitcnt vmcnt(0)" ::: "memory");
    __syncthreads();
    if (threadIdx.x == 0) {
        unsigned* bar = b.bar;
        __builtin_amdgcn_s_waitcnt(0);
        unsigned nloc = b.st[0], nx = b.st[1];
        if (nloc == 0u) { xcd_barrier_complete(bar, b.x, nloc, nx); b.st[0] = nloc; b.st[1] = nx; }
        const unsigned old = xb_add(&bar[XB_XSUB(b.x)], 1u);
        const unsigned gen = old / nloc;
        if (old + 1u == (gen + 1u) * nloc) {
            __builtin_amdgcn_fence(__ATOMIC_RELEASE, "agent");
            asm volatile("s_waitcnt vmcnt(0)" ::: "memory");
            const unsigned og = xb_add(&bar[XB_TOP], 1u);
            const unsigned tg = og / nx;
            if (og + 1u == (tg + 1u) * nx) xb_add(&bar[XB_TOPGEN], 1u);
            else XB_SPIN(xb_ld(&bar[XB_TOPGEN]) == tg, bar);
            __builtin_amdgcn_fence(__ATOMIC_ACQUIRE, "agent");
            xb_add(&bar[XB_XGEN(b.x)], 1u);
            asm volatile("s_waitcnt vmcnt(0)" ::: "memory");
        } else {
            XB_SPIN(xb_ld(&bar[XB_XGEN(b.x)]) == gen, bar);
            __builtin_amdgcn_fence(__ATOMIC_ACQUIRE, "agent");
            asm volatile("s_waitcnt vmcnt(0)" ::: "memory");
        }
    }
    __syncthreads();
}

constexpr int NWAVES = 8;
constexpr int LDS_BYTES = 163840;
constexpr int LDSCTL_OFF = LDS_BYTES - 512, MISC_OFF = LDSCTL_OFF + 320;
constexpr int NPHASE = 2 + 6 * NLAYER;

#define LDS_WAIT() asm volatile("s_waitcnt lgkmcnt(0)" ::: "memory")

struct Args { const float* in[20]; float* out; unsigned char* ws; int ph_lo, ph_hi, li, pad; };

#define CAS __attribute__((address_space(4)))
struct Frame {
    LAS unsigned char* lds;
    int tid, lane, wave, G, gw, NGW;
    const CAS unsigned char* ka;
    __device__ __forceinline__ const float* x() const { return *(const float* const CAS*)(ka + 0); }
    __device__ __forceinline__ const float* c() const { return *(const float* const CAS*)(ka + 8); }
    __device__ __forceinline__ const float* ctx() const { return *(const float* const CAS*)(ka + 16); }
    __device__ __forceinline__ const float* c_ctx() const { return *(const float* const CAS*)(ka + 24); }
    __device__ __forceinline__ const float* w_ada() const { return *(const float* const CAS*)(ka + 32); }
    __device__ __forceinline__ const float* b_ada() const { return *(const float* const CAS*)(ka + 40); }
    __device__ __forceinline__ const float* w_in() const { return *(const float* const CAS*)(ka + 48); }
    __device__ __forceinline__ const float* conv_w() const { return *(const float* const CAS*)(ka + 56); }
    __device__ __forceinline__ const float* sink() const { return *(const float* const CAS*)(ka + 64); }
    __device__ __forceinline__ const float* g_attn() const { return *(const float* const CAS*)(ka + 72); }
    __device__ __forceinline__ const float* g_conv() const { return *(const float* const CAS*)(ka + 80); }
    __device__ __forceinline__ const float* w_out() const { return *(const float* const CAS*)(ka + 88); }
    __device__ __forceinline__ const float* ln1_g() const { return *(const float* const CAS*)(ka + 96); }
    __device__ __forceinline__ const float* ln1_b() const { return *(const float* const CAS*)(ka + 104); }
    __device__ __forceinline__ const float* wq() const { return *(const float* const CAS*)(ka + 112); }
    __device__ __forceinline__ const float* keys() const { return *(const float* const CAS*)(ka + 120); }
    __device__ __forceinline__ const float* pu() const { return *(const float* const CAS*)(ka + 128); }
    __device__ __forceinline__ const float* pv() const { return *(const float* const CAS*)(ka + 136); }
    __device__ __forceinline__ const float* ln2_g() const { return *(const float* const CAS*)(ka + 144); }
    __device__ __forceinline__ const float* ln2_b() const { return *(const float* const CAS*)(ka + 152); }
    __device__ __forceinline__ float* out() const { return *(float* const CAS*)(ka + 160); }
    __device__ __forceinline__ unsigned char* ws() const { return *(unsigned char* const CAS*)(ka + 168); }
    __device__ __forceinline__ float* MODS() const { return (float*)(ws() + WS_MODS); }
    __device__ __forceinline__ float* ROPE() const { return (float*)(ws() + WS_ROPE); }
    __device__ __forceinline__ bf16_t* X() const { return (bf16_t*)(ws() + WS_X); }
    __device__ __forceinline__ bf16_t* SC() const { return (bf16_t*)(ws() + WS_SC); }
    __device__ __forceinline__ bf16_t* KBD() const { return (bf16_t*)(ws() + WS_KBD); }
    __device__ __forceinline__ bf16_t* WQR() const { return (bf16_t*)(ws() + WS_WQR); }
    __device__ __forceinline__ unsigned char* WINT() const { return ws() + WS_WINT; }
    __device__ __forceinline__ unsigned char* H8() const { return ws() + WS_H8; }
    __device__ __forceinline__ bf16_t* WOUTT() const { return (bf16_t*)(ws() + WS_WOUTT); }
    __device__ __forceinline__ bf16_t* WEFFT() const { return (bf16_t*)(ws() + WS_WEFFT); }
    __device__ __forceinline__ bf16_t* H() const { return (bf16_t*)(ws() + WS_H); }
    __device__ __forceinline__ bf16_t* PROJ() const { return (bf16_t*)(ws() + WS_PROJ); }
    __device__ __forceinline__ bf16_t* MIX() const { return (bf16_t*)(ws() + WS_MIX); }
    __device__ __forceinline__ unsigned char* UT() const { return (unsigned char*)(ws() + WS_UT); }
    __device__ __forceinline__ unsigned char* VT() const { return (unsigned char*)(ws() + WS_VT); }
    __device__ __forceinline__ float* US() const { return (float*)(ws() + WS_US); }
    __device__ __forceinline__ float* VS() const { return (float*)(ws() + WS_VS); }
};

__device__ __forceinline__ void frame_ids(Frame& F) {
    int tz = threadIdx.x; asm volatile("" : "+v"(tz));
    F.tid = tz; F.lane = tz & 63; F.wave = __builtin_amdgcn_readfirstlane(tz >> 6);
    F.gw = blockIdx.x * NWAVES + F.wave;
    const CAS unsigned char* k = (const CAS unsigned char*)__builtin_amdgcn_kernarg_segment_ptr(); asm volatile("" : "+s"(k)); F.ka = k;
}
template <int CTRL> __device__ __forceinline__ int dpp_i(int v) { return __builtin_amdgcn_update_dpp(0, v, CTRL, 0xf, 0xf, true); }
template <int CTRL> __device__ __forceinline__ float dpp_f(float v) { return __int_as_float(dpp_i<CTRL>(__float_as_int(v))); }
constexpr int DPP_XOR1 = 0xB1, DPP_XOR2 = 0x4E, DPP_HMIRROR = 0x141, DPP_ROR4 = 0x124, DPP_ROR8 = 0x128;
__device__ __forceinline__ float wave_sum_u(float v) {
    v += dpp_f<DPP_XOR1>(v); v += dpp_f<DPP_XOR2>(v); v += dpp_f<DPP_ROR4>(v); v += dpp_f<DPP_ROR8>(v);
    const float r0 = __int_as_float(__builtin_amdgcn_readlane(__float_as_int(v), 0)), r1 = __int_as_float(__builtin_amdgcn_readlane(__float_as_int(v), 16));
    const float r2 = __int_as_float(__builtin_amdgcn_readlane(__float_as_int(v), 32)), r3 = __int_as_float(__builtin_amdgcn_readlane(__float_as_int(v), 48));
    return (r0 + r1) + (r2 + r3);
}
__device__ __forceinline__ float wave_max_u(float v) {
    v = fmaxf(v, dpp_f<DPP_XOR1>(v)); v = fmaxf(v, dpp_f<DPP_XOR2>(v)); v = fmaxf(v, dpp_f<DPP_ROR4>(v)); v = fmaxf(v, dpp_f<DPP_ROR8>(v));
    const float r0 = __int_as_float(__builtin_amdgcn_readlane(__float_as_int(v), 0)), r1 = __int_as_float(__builtin_amdgcn_readlane(__float_as_int(v), 16));
    const float r2 = __int_as_float(__builtin_amdgcn_readlane(__float_as_int(v), 32)), r3 = __int_as_float(__builtin_amdgcn_readlane(__float_as_int(v), 48));
    return fmaxf(fmaxf(r0, r1), fmaxf(r2, r3));
}
__device__ __forceinline__ float xor32_f(float v, int lane) { return __int_as_float(__builtin_amdgcn_ds_bpermute((lane ^ 32) << 2, __float_as_int(v))); }
__device__ __forceinline__ float wave_sum(float v) { return wave_sum_u(v); }
__device__ __forceinline__ unsigned pk2(float lo, float hi) { return pg8::cvt_pk_bf16(lo, hi); }
__device__ __forceinline__ float bf_lo(unsigned u) { return __uint_as_float(u << 16); }
__device__ __forceinline__ float bf_hi(unsigned u) { return __uint_as_float(u & 0xffff0000u); }
__device__ __forceinline__ int modrow(int t) { return t < TL ? t / SEQ : 2; }

__device__ __forceinline__ void transpose_item(const float* W, int K, int N, bf16_t* WT, LAS float* scr, int item, int lane) {
    const int nblk = N / 32, kb = item / nblk, nb = item % nblk, k0 = 64 * kb, n0 = 32 * nb;
#pragma unroll 8
    for (int i = 0; i < 32; ++i) { const int kk = 2 * i + (lane >> 5); scr[kk * 33 + (lane & 31)] = W[(size_t)(k0 + kk) * N + n0 + (lane & 31)]; }
    LDS_WAIT(); asm volatile("" ::: "memory");
    const int c = lane & 7;
#pragma unroll
    for (int j = 0; j < 4; ++j) { const int n = (lane >> 3) + 8 * j; const LAS float* s = scr + (8 * c) * 33 + n;
        u32x4 o; o.x = pk2(s[0 * 33], s[1 * 33]); o.y = pk2(s[2 * 33], s[3 * 33]); o.z = pk2(s[4 * 33], s[5 * 33]); o.w = pk2(s[6 * 33], s[7 * 33]);
        *(u32x4*)(WT + (size_t)(n0 + n) * K + k0 + 8 * c) = o; }
    LDS_WAIT(); asm volatile("" ::: "memory");
}

__device__ __forceinline__ void transpose_item8(const float* W, int K, int N, unsigned char* WT, LAS float* scr, int item, int lane, float wscale) {
    const int nblk = N / 32, kb = item / nblk, nb = item % nblk, k0 = 64 * kb, n0 = 32 * nb;
#pragma unroll 8
    for (int i = 0; i < 32; ++i) { const int kk = 2 * i + (lane >> 5); scr[kk * 33 + (lane & 31)] = W[(size_t)(k0 + kk) * N + n0 + (lane & 31)]; }
    LDS_WAIT(); asm volatile("" ::: "memory");
    const int c = lane & 7;
#pragma unroll
    for (int j = 0; j < 4; ++j) { const int n = (lane >> 3) + 8 * j; const LAS float* s = scr + (8 * c) * 33 + n;
        u32x2 o; int t0 = __builtin_amdgcn_cvt_pk_fp8_f32(s[0 * 33] * wscale, s[1 * 33] * wscale, 0, false); t0 = __builtin_amdgcn_cvt_pk_fp8_f32(s[2 * 33] * wscale, s[3 * 33] * wscale, t0, true);
        int t1 = __builtin_amdgcn_cvt_pk_fp8_f32(s[4 * 33] * wscale, s[5 * 33] * wscale, 0, false); t1 = __builtin_amdgcn_cvt_pk_fp8_f32(s[6 * 33] * wscale, s[7 * 33] * wscale, t1, true);
        o.x = (unsigned)t0; o.y = (unsigned)t1;
        *(u32x2*)(WT + (size_t)(n0 + n) * K + k0 + 8 * c) = o; }
    LDS_WAIT(); asm volatile("" ::: "memory");
}
__device__ __forceinline__ void cvt_row_bf16(const float* src, bf16_t* dst, int lane) {
    const f32x4* s = (const f32x4*)src + lane; u32x2* d = (u32x2*)dst + lane;
    f32x4 v[8];
#pragma unroll
    for (int j = 0; j < 8; ++j) v[j] = __builtin_nontemporal_load(s + 64 * j);
#pragma unroll
    for (int j = 0; j < 8; ++j) { u32x2 o; o.x = pk2(v[j].x, v[j].y); o.y = pk2(v[j].z, v[j].w); d[64 * j] = o; }
}

struct RowF32 { f32x4 v[4][2]; };
__device__ __forceinline__ void row_load_nt(RowF32& R, const float* src, int lane) {
    const f32x4* s = (const f32x4*)src + 2 * lane;
#pragma unroll
    for (int j = 0; j < 4; ++j) { R.v[j][0] = __builtin_nontemporal_load(s + 128 * j); R.v[j][1] = __builtin_nontemporal_load(s + 128 * j + 1); }
}
template <int FMT>
__device__ __forceinline__ void cvt_row_lp(const RowF32& R, unsigned char* dst, float* inv, int lane) {
    constexpr float QMAX = FMT == 8 ? 224.f : 6.f;
    float am = 0.f;
#pragma unroll
    for (int j = 0; j < 4; ++j)
#pragma unroll
        for (int q = 0; q < 2; ++q) am = fmaxf(fmaxf(am, fmaxf(fabsf(R.v[j][q].x), fabsf(R.v[j][q].y))), fmaxf(fabsf(R.v[j][q].z), fabsf(R.v[j][q].w)));
    am = wave_max_u(am);
    const float sc = am > 0.f ? QMAX / am : 1.f;
#pragma unroll
    for (int j = 0; j < 4; ++j) {
        if constexpr (FMT == 8) {
            u32x2 w;
#pragma unroll
            for (int q = 0; q < 2; ++q) { int t = __builtin_amdgcn_cvt_pk_fp8_f32(R.v[j][q].x * sc, R.v[j][q].y * sc, 0, false); t = __builtin_amdgcn_cvt_pk_fp8_f32(R.v[j][q].z * sc, R.v[j][q].w * sc, t, true); w[q] = (unsigned)t; }
            *((u32x2*)dst + lane + 64 * j) = w;
        } else {
            unsigned w = 0u;
            w = __builtin_amdgcn_cvt_scalef32_pk_fp4_f32(w, R.v[j][0].x * sc, R.v[j][0].y * sc, 1.0f, 0);
            w = __builtin_amdgcn_cvt_scalef32_pk_fp4_f32(w, R.v[j][0].z * sc, R.v[j][0].w * sc, 1.0f, 1);
            w = __builtin_amdgcn_cvt_scalef32_pk_fp4_f32(w, R.v[j][1].x * sc, R.v[j][1].y * sc, 1.0f, 2);
            w = __builtin_amdgcn_cvt_scalef32_pk_fp4_f32(w, R.v[j][1].z * sc, R.v[j][1].w * sc, 1.0f, 3);
            *((unsigned*)dst + lane + 64 * j) = w;
        }
    }
    if (lane == 0) *inv = am > 0.f ? am * (1.f / QMAX) : 1.f;
}
template <int FMT> struct LpRow;
template <> struct LpRow<8> { u32x4 a, b;
    __device__ __forceinline__ void load(const unsigned char* rowp, int lane) { a = *(const u32x4*)(rowp + 32 * lane); b = *(const u32x4*)(rowp + 32 * lane + 16); }
    template <class Fn> __device__ __forceinline__ void each(Fn&& f) const {
#pragma unroll
        for (int w = 0; w < 4; ++w) { const f32x2 l0 = __builtin_amdgcn_cvt_pk_f32_fp8((int)a[w], false), h0 = __builtin_amdgcn_cvt_pk_f32_fp8((int)a[w], true);
            f(4 * w, l0.x, l0.y); f(4 * w + 2, h0.x, h0.y); }
#pragma unroll
        for (int w = 0; w < 4; ++w) { const f32x2 l0 = __builtin_amdgcn_cvt_pk_f32_fp8((int)b[w], false), h0 = __builtin_amdgcn_cvt_pk_f32_fp8((int)b[w], true);
            f(16 + 4 * w, l0.x, l0.y); f(16 + 4 * w + 2, h0.x, h0.y); }
    } };
template <> struct LpRow<4> { u32x4 a;
    __device__ __forceinline__ void load(const unsigned char* rowp, int lane) { a = *(const u32x4*)(rowp + 16 * lane); }
    template <class Fn> __device__ __forceinline__ void each(Fn&& f) const {
#pragma unroll
        for (int w = 0; w < 4; ++w) {
            const f32x2 d0 = __builtin_amdgcn_cvt_scalef32_pk_f32_fp4(a[w], 1.0f, 0), d1 = __builtin_amdgcn_cvt_scalef32_pk_f32_fp4(a[w], 1.0f, 1);
            const f32x2 d2 = __builtin_amdgcn_cvt_scalef32_pk_f32_fp4(a[w], 1.0f, 2), d3 = __builtin_amdgcn_cvt_scalef32_pk_f32_fp4(a[w], 1.0f, 3);
            f(8 * w, d0.x, d0.y); f(8 * w + 2, d1.x, d1.y); f(8 * w + 4, d2.x, d2.y); f(8 * w + 6, d3.x, d3.y); }
    }
    template <class Fn> __device__ __forceinline__ void each_bf(Fn&& f) const {
#pragma unroll
        for (int w = 0; w < 4; ++w) {
            f(4 * w, __builtin_amdgcn_cvt_scalef32_pk_bf16_fp4(a[w], 1.0f, 0)); f(4 * w + 1, __builtin_amdgcn_cvt_scalef32_pk_bf16_fp4(a[w], 1.0f, 1));
            f(4 * w + 2, __builtin_amdgcn_cvt_scalef32_pk_bf16_fp4(a[w], 1.0f, 2)); f(4 * w + 3, __builtin_amdgcn_cvt_scalef32_pk_bf16_fp4(a[w], 1.0f, 3)); }
    } };

__device__ __forceinline__ void row_stats(const f32x4 (&v)[8], float& mean, float& rstd) {
    float s = 0.f;
#pragma unroll
    for (int j = 0; j < 8; ++j) s += (v[j].x + v[j].y) + (v[j].z + v[j].w);
    mean = wave_sum(s) * (1.f / D);
    float s2 = 0.f;
#pragma unroll
    for (int j = 0; j < 8; ++j) { const f32x4 d = v[j] - mean; s2 += (d.x * d.x + d.y * d.y) + (d.z * d.z + d.w * d.w); }
    rstd = 1.f / sqrtf(wave_sum(s2) * (1.f / D) + LN_EPS);
}
__device__ __forceinline__ void modulate_store(const f32x4 (&v)[8], const float* shift, const float* scale, bf16_t* dst, int lane) {
    float mean, rstd; row_stats(v, mean, rstd);
    u32x2* d = (u32x2*)dst + lane;
#pragma unroll
    for (int j = 0; j < 8; ++j) { const f32x4 sc = *((const f32x4*)scale + lane + 64 * j), sh = *((const f32x4*)shift + lane + 64 * j);
        const f32x4 y = (v[j] - mean) * rstd * (sc + 1.f) + sh;
        u32x2 o; o.x = pk2(y.x, y.y); o.y = pk2(y.z, y.w); d[64 * j] = o; }
}

__device__ __forceinline__ void convert_tables(Frame& F, int row0, int row1, int w0, int wstride) {
    RowF32 ru, rv, nu, nv;
    int row = row0 + w0;
    if (row < row1) { row_load_nt(ru, F.pu() + (size_t)row * D, F.lane); row_load_nt(rv, F.pv() + (size_t)row * D, F.lane); }
    while (row < row1) {
        const int nrow = row + wstride;
        if (nrow < row1) { row_load_nt(nu, F.pu() + (size_t)nrow * D, F.lane); row_load_nt(nv, F.pv() + (size_t)nrow * D, F.lane); }
        cvt_row_lp<U_FMT>(ru, F.UT() + (size_t)row * UROW, F.US() + 2 * (size_t)row, F.lane);
        cvt_row_lp<V_FMT>(rv, F.VT() + (size_t)row * VROW, F.US() + 2 * (size_t)row + 1, F.lane);
        ru = nu; rv = nv; row = nrow;
    }
}
__device__ __forceinline__ void convert_in_tail(Frame& F, int layer, int nunits, int part) {
    if (layer + 1 >= NLAYER) return;
    const int G = F.G, rounds = (nunits + G - 1) / G, nlast = nunits - (rounds - 1) * G;
    const int c = (int)blockIdx.x;
    int nshort = G - nlast, sidx = c - nlast;
    if (nshort <= 0) { nshort = G; sidx = c; }
    else if (sidx < 0) return;
    const int r0 = (layer + 1) * NEXP + part * (NEXP / 2);
    convert_tables(F, r0, r0 + NEXP / 2, sidx * NWAVES + F.wave, nshort * NWAVES);
}
__device__ __forceinline__ void p0a_prologue(Frame& F) {
    LAS float* condL = (LAS float*)F.lds;
    LAS float* red = (LAS float*)(F.lds + 24576);
    for (int i = F.tid; i < 3 * D; i += NWAVES * 64) { const int r = i / D, k = i % D; const float v = r < 2 ? F.c()[r * D + k] : F.c_ctx()[k]; condL[i] = v / (1.f + __expf(-v)); }
    __syncthreads();
    for (int item = blockIdx.x; item < 384; item += F.G) {
        const int l = item / 96, n0 = (item % 96) * 128;
        const float* wp = F.w_ada() + ((size_t)l * D + F.wave * 256) * 12288 + n0 + 2 * F.lane;
        f32x2 a0 = {0.f, 0.f}, a1 = {0.f, 0.f}, a2 = {0.f, 0.f};
#pragma unroll 8
        for (int k = 0; k < 256; ++k) { const f32x2 w = __builtin_nontemporal_load((const f32x2*)(wp + (size_t)k * 12288)); const int kk = F.wave * 256 + k;
            a0 += w * condL[kk]; a1 += w * condL[D + kk]; a2 += w * condL[2 * D + kk]; }
        LAS float* rp = red + F.wave * 384 + 2 * F.lane;
        rp[0] = a0.x; rp[1] = a0.y; rp[128] = a1.x; rp[129] = a1.y; rp[256] = a2.x; rp[257] = a2.y;
        __syncthreads();
        if (F.tid < 384) { const int r = F.tid / 128, n = F.tid % 128; float s = 0.f;
#pragma unroll
            for (int w = 0; w < 8; ++w) s += red[w * 384 + r * 128 + n];
            F.MODS()[((size_t)l * 3 + r) * 12288 + n0 + n] = s + F.b_ada()[(size_t)l * 12288 + n0 + n]; }
        __syncthreads();
    }
    LAS float* scr = (LAS float*)(F.lds + 40960 + F.wave * 8448);
    constexpr int I_IN = (D / 64) * (INC / 32), I_OUT = (D / 64) * (D / 32);
    for (int it = F.gw; it < NLAYER * (I_IN + I_OUT); it += F.NGW) {
        const int l = it / (I_IN + I_OUT); int r = it % (I_IN + I_OUT);
        if (r < I_IN) transpose_item8(F.w_in() + (size_t)l * D * INC, D, INC, F.WINT() + (size_t)l * INC * D, scr, r, F.lane, WIN_SCALE);
        else transpose_item(F.w_out() + (size_t)l * D * D, D, D, F.WOUTT() + (size_t)l * D * D, scr, r - I_IN, F.lane);
    }
    for (int row = F.gw; row < NLAYER * D; row += F.NGW) {
        const int l = row / D, c = row % D; const f32x4* s = (const f32x4*)(F.wq() + (size_t)row * D) + F.lane;
#pragma unroll
        for (int j = 0; j < 8; ++j) { const f32x4 v = s[64 * j]; u32x2 o; o.x = pk2(v.x, v.y); o.y = pk2(v.z, v.w);
            *((u32x2*)(F.WQR() + ((size_t)(l * 8 + j) * D + c) * 256) + F.lane) = o; }
    }
    for (int row = F.gw; row < 32 * 256; row += F.NGW) {
        const int lh = row >> 8, pk = row & 255, p = pk >> 7;
        u32x2 o = {0u, 0u};
        if ((F.lane >> 5) == p) { const f32x4 v = *((const f32x4*)(F.keys() + ((size_t)lh * 256 + pk) * 128) + (F.lane & 31)); o.x = pk2(v.x, v.y); o.y = pk2(v.z, v.w); }
        *((u32x2*)(F.KBD() + (size_t)row * 256) + F.lane) = o;
    }
    convert_tables(F, 0, NEXP, F.gw, F.NGW);
    for (int i = blockIdx.x * (NWAVES * 64) + F.tid; i < 192 * 32; i += F.G * NWAVES * 64) {
        const int idx = i >> 5, f = i & 31; const float pos = (float)(idx < 128 ? idx : idx - 128);
        const float inv = powf(10000.f, -(float)(2 * f) / 64.f); const float ang = pos * inv;
        F.ROPE()[2 * i] = cosf(ang); F.ROPE()[2 * i + 1] = sinf(ang);
    }
}

__device__ __forceinline__ void p0b_mod0(Frame& F) {
    __syncthreads();
#pragma unroll 1
    for (int v = 0; v < 6; ++v)
        *(LAS f32x4*)(F.lds + v * 8192 + F.tid * 16) = *(const f32x4*)(F.MODS() + (size_t)(v % 3) * 12288 + (v < 3 ? 0 : D) + 4 * F.tid);
    __syncthreads();
    for (int t = F.gw; t < TT; t += F.NGW) {
        const float* src = t < TL ? F.x() + (size_t)t * D : F.ctx() + (size_t)(t - TL) * D;
        f32x4 v[8];
#pragma unroll
        for (int j = 0; j < 8; ++j) v[j] = *((const f32x4*)src + F.lane + 64 * j);
        const int mr = modrow(t);
        float mean, rstd; row_stats(v, mean, rstd);
        unsigned* d = (unsigned*)(F.H8() + (size_t)t * D) + F.lane;
#pragma unroll
        for (int j = 0; j < 8; ++j) { const f32x4 sh = *(const LAS f32x4*)(F.lds + mr * 8192 + (64 * j + F.lane) * 16), sc = *(const LAS f32x4*)(F.lds + (3 + mr) * 8192 + (64 * j + F.lane) * 16);
            const f32x4 y = (v[j] - mean) * rstd * (sc + 1.f) + sh;
            int o = __builtin_amdgcn_cvt_pk_fp8_f32(y.x, y.y, 0, false); o = __builtin_amdgcn_cvt_pk_fp8_f32(y.z, y.w, o, true); d[64 * j] = (unsigned)o; }
    }
}

constexpr int ROPE_LDS = 98304;
constexpr int CONV_LDS = 81920;
constexpr int KP = 272, VP = 320, KS_BYTES = 64 * KP, VS_BYTES = 64 * VP;
struct KVRegs { u32x4 k1, k2, v1, v2; f32x4 cs[4]; };

__device__ __forceinline__ void attn_load_tile(Frame& F, KVRegs& R, int ti, int b, int n, int g) {
    const int key = F.tid >> 3, c8 = F.tid & 7;
    int row, pos = 0;
    if (ti < 6) { pos = (n - 1) * 128 + 64 * ti + key; row = b * SEQ + pos; } else row = TL + b * CTXL + 64 * (ti - 6) + key;
    const bf16_t* base = F.PROJ() + (size_t)row * INC;
    const int d1 = (c8 >> 2) * 64 + (c8 & 3) * 8;
    R.k1 = *(const u32x4*)(base + OFF_K + g * 128 + d1); R.k2 = *(const u32x4*)(base + OFF_K + g * 128 + d1 + 32);
    R.v1 = *(const u32x4*)(base + OFF_V + g * 128 + 8 * c8); R.v2 = *(const u32x4*)(base + OFF_V + g * 128 + 64 + 8 * c8);
    if (ti < 6) { const int tidx = (c8 >> 2) ? 128 + (pos & 63) : (pos >> 6); const LAS f32x4* cp = (const LAS f32x4*)(F.lds + ROPE_LDS + (tidx * 32 + (c8 & 3) * 8) * 8);
#pragma unroll
        for (int m = 0; m < 4; ++m) R.cs[m] = cp[m]; }
}
__device__ __forceinline__ void rope8(u32x4& a, u32x4& bq, const f32x4 (&cs)[4], float scale) {
    u32x4 oa, ob;
#pragma unroll
    for (int w = 0; w < 4; ++w) {
        const float x1l = bf_lo(a[w]), x1h = bf_hi(a[w]), x2l = bf_lo(bq[w]), x2h = bf_hi(bq[w]);
        const float cl = cs[w].x, sl = cs[w].y, ch = cs[w].z, sh = cs[w].w;
        oa[w] = pk2((x1l * cl - x2l * sl) * scale, (x1h * ch - x2h * sh) * scale);
        ob[w] = pk2((x2l * cl + x1l * sl) * scale, (x2h * ch + x1h * sh) * scale);
    }
    a = oa; bq = ob;
}
__device__ __forceinline__ void attn_store_tile(Frame& F, KVRegs& R, int ti, int buf) {
    const int key = F.tid >> 3, c8 = F.tid & 7;
    if (ti < 6) rope8(R.k1, R.k2, R.cs, 1.f);
    const int d1 = (c8 >> 2) * 64 + (c8 & 3) * 8;
    LAS unsigned char* kp = F.lds + buf * KS_BYTES + key * KP;
    *(LAS u32x4*)(kp + d1 * 2) = R.k1; *(LAS u32x4*)(kp + (d1 + 32) * 2) = R.k2;
    LAS unsigned char* vp = F.lds + 2 * KS_BYTES + buf * VS_BYTES + key * VP;
    *(LAS u32x4*)(vp + 16 * c8) = R.v1; *(LAS u32x4*)(vp + 128 + 16 * c8) = R.v2;
}

#define MFMA32(a, b, c) __builtin_amdgcn_mfma_f32_32x32x16_bf16((a), (b), (c), 0, 0, 0)

__device__ __forceinline__ void attn_unit(Frame& F, int layer, int u) {
    const bool latent = u < 512;
    int b, n, g, hp;
    if (latent) { hp = u & 1; g = (u >> 1) & 1; n = (u >> 2) & 63; b = u >> 8; }
    else { const int v = u - 512; hp = v & 1; g = (v >> 1) & 1; n = (v >> 2) & 1; b = v >> 3; }
    const int lane = F.lane, r = lane & 31, h = lane >> 5, wave = F.wave;
    const int head = g * 4 + hp * 2 + (wave >> 2), qb = wave & 3;
    const int tq = latent ? b * SEQ + n * 128 + 32 * qb + r : TL + b * CTXL + n * 128 + 32 * qb + r;
    bf16x8 qf[8];
    {
        u32x4 raw[8];
        const bf16_t* qp = F.PROJ() + (size_t)tq * INC + OFF_Q + head * 128 + 8 * h;
#pragma unroll
        for (int ks = 0; ks < 8; ++ks) raw[ks] = *(const u32x4*)(qp + 16 * ks);
        if (latent) {
            const int pos = n * 128 + 32 * qb + r;
#pragma unroll
            for (int half = 0; half < 2; ++half) {
                const int tidx = half ? 128 + (pos & 63) : (pos >> 6);
#pragma unroll
                for (int kk = 0; kk < 2; ++kk) {
                    const LAS f32x4* cp = (const LAS f32x4*)(F.lds + ROPE_LDS + (tidx * 32 + 16 * kk + 8 * h) * 8);
                    f32x4 cs[4];
#pragma unroll
                    for (int m = 0; m < 4; ++m) cs[m] = cp[m];
                    rope8(raw[4 * half + kk], raw[4 * half + kk + 2], cs, QSCALE);
                }
            }
        } else {
#pragma unroll
            for (int ks = 0; ks < 8; ++ks)
#pragma unroll
                for (int w = 0; w < 4; ++w) raw[ks][w] = pk2(bf_lo(raw[ks][w]) * QSCALE, bf_hi(raw[ks][w]) * QSCALE);
        }
#pragma unroll
        for (int ks = 0; ks < 8; ++ks) qf[ks] = __builtin_bit_cast(bf16x8, raw[ks]);
    }
    int tlo = 6, nw = 0;
    if (latent) { tlo = (n == 0) ? 2 : 0; const int thi = (n == 63) ? 3 : 5; nw = thi - tlo + 1; }
    const int ntiles = nw + 4;
    f32x16 o[4];
#pragma unroll
    for (int db = 0; db < 4; ++db)
#pragma unroll
        for (int i = 0; i < 16; ++i) o[db][i] = 0.f;
    float m_run = F.sink()[layer * 8 + head] * LOG2E;
    float lsum = h == 0 ? 1.f : 0.f;
    const int iq = 32 * qb + r;
    KVRegs R;
    __syncthreads();
    attn_load_tile(F, R, nw > 0 ? tlo : 6, b, n, g);
    attn_store_tile(F, R, nw > 0 ? tlo : 6, 0);
    __syncthreads();
    const int i16 = lane & 15, tq4 = i16 >> 2, tp = i16 & 3, blk = (lane >> 4) & 1;
    for (int j = 0; j < ntiles; ++j) {
        const int ti = j < nw ? tlo + j : 6 + (j - nw);
        const int buf = j & 1;
        const bool more = j + 1 < ntiles;
        const int tin = (j + 1) < nw ? tlo + j + 1 : 6 + (j + 1 - nw);
        if (more) attn_load_tile(F, R, tin, b, n, g);
        const bool part = ti >= 6 || (ti >= (qb >> 1) && ti <= (qb >> 1) + 4);
        if (part) {
            f32x16 s0, s1;
#pragma unroll
            for (int i = 0; i < 16; ++i) { s0[i] = 0.f; s1[i] = 0.f; }
            const LAS unsigned char* kb = F.lds + buf * KS_BYTES + r * KP + h * 16;
#pragma unroll
            for (int ks = 0; ks < 8; ++ks) {
                const bf16x8 a0 = *(const LAS bf16x8*)(kb + ks * 32), a1 = *(const LAS bf16x8*)(kb + 32 * KP + ks * 32);
                s0 = MFMA32(a0, qf[ks], s0); s1 = MFMA32(a1, qf[ks], s1);
            }
            float mx = -INFINITY;
            if (ti < 6 && (ti == (qb >> 1) || ti == (qb >> 1) + 4)) {
                const int jb = 64 * ti + 4 * h - iq;
#pragma unroll
                for (int i = 0; i < 16; ++i) { const int j0 = jb + (i & 3) + 8 * (i >> 2), j1 = j0 + 32;
                    s0[i] = (j0 >= 0 && j0 <= 256) ? s0[i] : -INFINITY; s1[i] = (j1 >= 0 && j1 <= 256) ? s1[i] : -INFINITY; }
            }
#pragma unroll
            for (int i = 0; i < 16; ++i) mx = fmaxf(mx, fmaxf(s0[i], s1[i]));
            mx = fmaxf(mx, xor32_f(mx, lane));
            if (__any(mx > m_run + 8.f)) {
                const float m_new = mx > m_run + 8.f ? mx : m_run, alpha = __builtin_amdgcn_exp2f(m_run - m_new);
                m_run = m_new; lsum *= alpha;
#pragma unroll
                for (int db = 0; db < 4; ++db)
#pragma unroll
                    for (int i = 0; i < 16; ++i) o[db][i] *= alpha;
            }
#pragma unroll
            for (int i = 0; i < 16; ++i) { s0[i] = __builtin_amdgcn_exp2f(s0[i] - m_run); s1[i] = __builtin_amdgcn_exp2f(s1[i] - m_run); lsum += s0[i] + s1[i]; }
            bf16x8 pf[2][2];
#pragma unroll
            for (int s2 = 0; s2 < 2; ++s2) {
                u32x4 p0, p1;
#pragma unroll
                for (int w = 0; w < 4; ++w) { p0[w] = pk2(s0[8 * s2 + 2 * w], s0[8 * s2 + 2 * w + 1]); p1[w] = pk2(s1[8 * s2 + 2 * w], s1[8 * s2 + 2 * w + 1]); }
                pf[0][s2] = __builtin_bit_cast(bf16x8, p0); pf[1][s2] = __builtin_bit_cast(bf16x8, p1);
            }
            const LAS unsigned char* vb = F.lds + 2 * KS_BYTES + buf * VS_BYTES + (4 * h + tq4) * VP + 32 * blk + 8 * tp;
#pragma unroll
            for (int db = 0; db < 4; ++db)
#pragma unroll
                for (int kb2 = 0; kb2 < 2; ++kb2)
#pragma unroll
                    for (int s2 = 0; s2 < 2; ++s2) {
                        const int off = (32 * kb2 + 16 * s2) * VP + db * 64;
                        const s16x4 lo = __builtin_amdgcn_ds_read_tr16_b64_v4i16((LAS s16x4*)(vb + off));
                        const s16x4 hi = __builtin_amdgcn_ds_read_tr16_b64_v4i16((LAS s16x4*)(vb + off + 8 * VP));
                        const bf16x8 av = __builtin_shufflevector(lo, hi, 0, 1, 2, 3, 4, 5, 6, 7);
                        o[db] = MFMA32(av, pf[kb2][s2], o[db]);
                    }
        }
        if (more) attn_store_tile(F, R, tin, buf ^ 1);
        __syncthreads();
    }
    const float lt = lsum + xor32_f(lsum, lane);
    const float inv = 1.f / lt;
    float ss = 0.f;
#pragma unroll
    for (int db = 0; db < 4; ++db)
#pragma unroll
        for (int i = 0; i < 16; ++i) { o[db][i] *= inv; ss += o[db][i] * o[db][i]; }
    ss += xor32_f(ss, lane);
    const float rn = 1.f / sqrtf(ss * (1.f / 128.f) + LN_EPS);
    bf16_t* op = F.MIX() + (size_t)tq * D + head * 128 + 4 * h;
    const float* gp = F.g_attn() + layer * 1024 + head * 128 + 4 * h;
#pragma unroll
    for (int db = 0; db < 4; ++db)
#pragma unroll
        for (int g4 = 0; g4 < 4; ++g4) {
            const f32x4 gv = *(const f32x4*)(gp + 32 * db + 8 * g4);
            u32x2 w; w.x = pk2(o[db][4 * g4] * rn * gv.x, o[db][4 * g4 + 1] * rn * gv.y); w.y = pk2(o[db][4 * g4 + 2] * rn * gv.z, o[db][4 * g4 + 3] * rn * gv.w);
            *(u32x2*)(op + 32 * db + 8 * g4) = w;
        }
}

__device__ __forceinline__ void unpack8(const u32x4 v, float (&f)[8]) {
#pragma unroll
    for (int w = 0; w < 4; ++w) { f[2 * w] = bf_lo(v[w]); f[2 * w + 1] = bf_hi(v[w]); }
}
__device__ __forceinline__ void conv_row(Frame& F, int layer, int t) {
    bool first, last;
    if (t < TL) { const int pos = t & (SEQ - 1); first = pos == 0; last = pos == SEQ - 1; } else { const int pc = (t - TL) & (CTXL - 1); first = pc == 0; last = pc == CTXL - 1; }
    const bf16_t* p = F.PROJ() + (size_t)t * INC;
    const LAS unsigned char* cvc = F.lds + CONV_LDS + F.lane * 16;
#pragma unroll
    for (int jc = 0; jc < 2; ++jc) {
        const int c = 8 * F.lane + 512 * jc;
        float gb[8], a[8], bq[8], um[8], ut[8], up[8];
        unpack8(*(const u32x4*)(p + c), gb);
        unpack8(*(const u32x4*)(p + OFF_C + c), a); unpack8(*(const u32x4*)(p + OFF_X + c), bq);
#pragma unroll
        for (int e = 0; e < 8; ++e) ut[e] = a[e] * bq[e];
        if (!first) { unpack8(*(const u32x4*)(p - INC + OFF_C + c), a); unpack8(*(const u32x4*)(p - INC + OFF_X + c), bq);
#pragma unroll
            for (int e = 0; e < 8; ++e) um[e] = a[e] * bq[e]; }
        else {
#pragma unroll
            for (int e = 0; e < 8; ++e) um[e] = 0.f; }
        if (!last) { unpack8(*(const u32x4*)(p + INC + OFF_C + c), a); unpack8(*(const u32x4*)(p + INC + OFF_X + c), bq);
#pragma unroll
            for (int e = 0; e < 8; ++e) up[e] = a[e] * bq[e]; }
        else {
#pragma unroll
            for (int e = 0; e < 8; ++e) up[e] = 0.f; }
        float y[8], ss = 0.f;
#pragma unroll
        for (int q = 0; q < 2; ++q) { const f32x4 w0 = *(const LAS f32x4*)(cvc + (2 * jc + q) * 1024), w1 = *(const LAS f32x4*)(cvc + 4096 + (2 * jc + q) * 1024), w2 = *(const LAS f32x4*)(cvc + 8192 + (2 * jc + q) * 1024);
#pragma unroll
            for (int e = 0; e < 4; ++e) { const int i = 4 * q + e; y[i] = gb[i] * (w0[e] * um[i] + w1[e] * ut[i] + w2[e] * up[i]); ss += y[i] * y[i]; } }
        ss += dpp_f<DPP_XOR1>(ss); ss += dpp_f<DPP_XOR2>(ss); ss += dpp_f<DPP_ROR4>(ss); ss += dpp_f<DPP_ROR8>(ss);
        const float rn = 1.f / sqrtf(ss * (1.f / 128.f) + LN_EPS);
        u32x4 w;
#pragma unroll
        for (int q = 0; q < 2; ++q) { const f32x4 gcv = *(const LAS f32x4*)(cvc + 12288 + (2 * jc + q) * 1024); w[2 * q] = pk2(y[4 * q] * rn * gcv[0], y[4 * q + 1] * rn * gcv[1]); w[2 * q + 1] = pk2(y[4 * q + 2] * rn * gcv[2], y[4 * q + 3] * rn * gcv[3]); }
        *(u32x4*)(F.MIX() + (size_t)t * D + 1024 + c) = w;
    }
}

__device__ __forceinline__ void ln_phase(Frame& F, int layer, int rows) {
    const int lane = F.lane;
    u32x4 w[4], wn[4];
    int t = F.gw;
    if (t < rows) {
#pragma unroll
        for (int j = 0; j < 4; ++j) w[j] = *(const u32x4*)(F.X() + (size_t)t * D + 8 * lane + 512 * j);
    }
    {
        const int ch = F.tid, jj = ch >> 7, rem = ch & 127, ll = rem >> 1, qq = rem & 1;
        LAS unsigned char* dst = F.lds + ((2 * jj + qq) * 64 + ll) * 16;
        *(LAS f32x4*)(dst) = *(const f32x4*)(F.ln1_g() + layer * D + 4 * ch);
        *(LAS f32x4*)(dst + 8192) = *(const f32x4*)(F.ln1_b() + layer * D + 4 * ch);
#pragma unroll 1
        for (int v = 0; v < 6; ++v) { const int mrv = v % 3; const size_t off = ((size_t)layer * 3 + mrv) * 12288 + (v < 3 ? 3 * D : 4 * D);
            *(LAS f32x4*)(dst + (2 + v) * 8192) = *(const f32x4*)(F.MODS() + off + 4 * ch); }
    }
    __syncthreads();
    const LAS unsigned char* vc = F.lds + lane * 16;
    while (t < rows) {
        const int tn = t + F.NGW;
        if (tn < rows) {
#pragma unroll
            for (int j = 0; j < 4; ++j) wn[j] = *(const u32x4*)(F.X() + (size_t)tn * D + 8 * lane + 512 * j);
        }
        float v[32]; float s = 0.f;
#pragma unroll
        for (int j = 0; j < 4; ++j)
#pragma unroll
            for (int q = 0; q < 4; ++q) { v[8 * j + 2 * q] = bf_lo(w[j][q]); v[8 * j + 2 * q + 1] = bf_hi(w[j][q]); s += v[8 * j + 2 * q] + v[8 * j + 2 * q + 1]; }
        const float mean = wave_sum(s) * (1.f / D);
        float s2 = 0.f;
#pragma unroll
        for (int i = 0; i < 32; ++i) { v[i] -= mean; s2 += v[i] * v[i]; }
        const float rstd = 1.f / sqrtf(wave_sum(s2) * (1.f / D) + LN_EPS);
        float s3 = 0.f;
#pragma unroll
        for (int j = 0; j < 4; ++j) { const int c = 8 * lane + 512 * j; u32x4 o;
#pragma unroll
            for (int q = 0; q < 2; ++q) { const f32x4 gg = *(const LAS f32x4*)(vc + (2 * j + q) * 1024), bb = *(const LAS f32x4*)(vc + 8192 + (2 * j + q) * 1024);
#pragma unroll
                for (int e = 0; e < 4; ++e) { const float y = v[8 * j + 4 * q + e] * rstd * gg[e] + bb[e]; v[8 * j + 4 * q + e] = y; s3 += y; }
                o[2 * q] = pk2(v[8 * j + 4 * q], v[8 * j + 4 * q + 1]); o[2 * q + 1] = pk2(v[8 * j + 4 * q + 2], v[8 * j + 4 * q + 3]); }
            *(u32x4*)(F.X() + (size_t)t * D + c) = o; }
        const float mean2 = wave_sum(s3) * (1.f / D);
        float s4 = 0.f;
#pragma unroll
        for (int i = 0; i < 32; ++i) { v[i] -= mean2; s4 += v[i] * v[i]; }
        const float rstd2 = 1.f / sqrtf(wave_sum(s4) * (1.f / D) + LN_EPS);
        const int mrl = modrow(t);
#pragma unroll
        for (int j = 0; j < 4; ++j) { const int c = 8 * lane + 512 * j; u32x4 o;
#pragma unroll
            for (int q = 0; q < 2; ++q) { const f32x4 sh = *(const LAS f32x4*)(vc + (2 + mrl) * 8192 + (2 * j + q) * 1024), sc = *(const LAS f32x4*)(vc + (5 + mrl) * 8192 + (2 * j + q) * 1024);
                const float y0 = v[8 * j + 4 * q] * rstd2 * (1.f + sc[0]) + sh[0], y1 = v[8 * j + 4 * q + 1] * rstd2 * (1.f + sc[1]) + sh[1];
                const float y2 = v[8 * j + 4 * q + 2] * rstd2 * (1.f + sc[2]) + sh[2], y3 = v[8 * j + 4 * q + 3] * rstd2 * (1.f + sc[3]) + sh[3];
                o[2 * q] = pk2(y0, y1); o[2 * q + 1] = pk2(y2, y3); }
            *(u32x4*)(F.H() + (size_t)t * D + c) = o; }
#pragma unroll
        for (int j = 0; j < 4; ++j) w[j] = wn[j];
        t = tn;
    }
}

__device__ __forceinline__ unsigned ordkey(float f) { const unsigned u = __float_as_uint(f); return u ^ ((u >> 31) ? 0xFFFFFFFFu : 0x80000000u); }
__device__ __forceinline__ float gelu_erf(float a) { return 0.5f * a * (1.f + erff(a * 0.70710678118654752f)); }

__device__ __forceinline__ float unordkey(unsigned k) { return __uint_as_float(k ^ ((k >> 31) ? 0x80000000u : 0xFFFFFFFFu)); }
__device__ __forceinline__ float gelu_as(float v) {
    const float av = fabsf(v), t = __builtin_amdgcn_rcpf(av * 0.2316418882f + 1.0f);
    float q = t * 0.5307027145f + (-0.7265760135f); q = q * t + 0.7107068705f; q = q * t + (-0.142248368f); q = q * t + 0.127414796f; q = q * t;
    const float e = __builtin_amdgcn_exp2f((v * v) * (-0.72134752044f));
    const float m = v * (q * e);
    return v < 0.f ? m : v - m;
}

template <class O> struct QuadNet {
    typedef typename O::V V; typedef typename O::B B;
    template <bool ASC> static __device__ __forceinline__ void ce_reg(V& a, V& b) { const V lo = O::vmin(a, b), hi = O::vmax(a, b); a = ASC ? lo : hi; b = ASC ? hi : lo; }
    template <bool ASC> static __device__ __forceinline__ void ce_l1(V& x, B low1) { const V p = O::x1(x); const V mn = O::vmin(p, x), mx = O::vmax(p, x); x = ASC ? O::vsel(low1, mn, mx) : O::vsel(low1, mx, mn); }
    template <bool ASC> static __device__ __forceinline__ void ce_l2(V& x, B low2) { const V p = O::x2(x); const V mn = O::vmin(p, x), mx = O::vmax(p, x); x = ASC ? O::vsel(low2, mn, mx) : O::vsel(low2, mx, mn); }
    template <int NR> static __device__ __forceinline__ void sort_blocks(V (&R)[NR], B low1, B low2, B eq12) {
#pragma unroll
        for (int r = 0; r < NR; ++r) { const V p = O::x1(R[r]); const V mn = O::vmin(p, R[r]), mx = O::vmax(p, R[r]); R[r] = O::vsel(eq12, mn, mx); }
#pragma unroll
        for (int r = 0; r < NR; ++r) { if ((r & 1) == 0) ce_l2<true>(R[r], low2); else ce_l2<false>(R[r], low2); }
#pragma unroll
        for (int r = 0; r < NR; ++r) { if ((r & 1) == 0) ce_l1<true>(R[r], low1); else ce_l1<false>(R[r], low1); }
#pragma unroll
        for (int r = 0; r < NR; r += 2) { if ((r & 2) == 0) ce_reg<true>(R[r], R[r + 1]); else ce_reg<false>(R[r], R[r + 1]); }
#pragma unroll
        for (int r = 0; r < NR; ++r) { if ((r & 2) == 0) ce_l2<true>(R[r], low2); else ce_l2<false>(R[r], low2); }
#pragma unroll
        for (int r = 0; r < NR; ++r) { if ((r & 2) == 0) ce_l1<true>(R[r], low1); else ce_l1<false>(R[r], low1); }
#pragma unroll
        for (int r = 0; r < NR; ++r) { if ((r & 2) == 0) { if ((r & 4) == 0) ce_reg<true>(R[r], R[r + 2]); else ce_reg<false>(R[r], R[r + 2]); } }
#pragma unroll
        for (int r = 0; r < NR; r += 2) { if ((r & 4) == 0) ce_reg<true>(R[r], R[r + 1]); else ce_reg<false>(R[r], R[r + 1]); }
#pragma unroll
        for (int r = 0; r < NR; ++r) { if ((r & 4) == 0) ce_l2<true>(R[r], low2); else ce_l2<false>(R[r], low2); }
#pragma unroll
        for (int r = 0; r < NR; ++r) { if ((r & 4) == 0) ce_l1<true>(R[r], low1); else ce_l1<false>(R[r], low1); }
    }
    template <int NR> static __device__ __forceinline__ void halve_merge(const V (&R)[NR], V (&Q)[NR / 2], B low1, B low2) {
#pragma unroll
        for (int m = 0; m < NR / 8; ++m)
#pragma unroll
            for (int i = 0; i < 4; ++i) Q[4 * m + i] = O::vmax(R[8 * m + i], R[8 * m + 4 + i]);
#pragma unroll
        for (int r = 0; r < NR / 2; ++r) { if ((r & 2) == 0) { if ((r & 4) == 0) ce_reg<false>(Q[r], Q[r + 2]); else ce_reg<true>(Q[r], Q[r + 2]); } }
#pragma unroll
        for (int r = 0; r < NR / 2; r += 2) { if ((r & 4) == 0) ce_reg<false>(Q[r], Q[r + 1]); else ce_reg<true>(Q[r], Q[r + 1]); }
#pragma unroll
        for (int r = 0; r < NR / 2; ++r) { if ((r & 4) == 0) ce_l2<false>(Q[r], low2); else ce_l2<true>(Q[r], low2); }
#pragma unroll
        for (int r = 0; r < NR / 2; ++r) { if ((r & 4) == 0) ce_l1<false>(Q[r], low1); else ce_l1<true>(Q[r], low1); }
    }
    static __device__ __forceinline__ void top16_of_128(V (&R)[32], V (&T)[4], B low1, B low2, B eq12) {
        sort_blocks<32>(R, low1, low2, eq12);
        V A[16]; halve_merge<32>(R, A, low1, low2);
        V Bq[8]; halve_merge<16>(A, Bq, low1, low2);
        halve_merge<8>(Bq, T, low1, low2);
    }
    static __device__ __forceinline__ void top16_of_64(V (&R)[16], V (&T)[4], B low1, B low2, B eq12) {
        sort_blocks<16>(R, low1, low2, eq12);
        V A[8]; halve_merge<16>(R, A, low1, low2);
        halve_merge<8>(A, T, low1, low2);
    }
};

struct DevOps {
    typedef unsigned V; typedef bool B;
    static __device__ __forceinline__ V vmin(V a, V b) { return a < b ? a : b; }
    static __device__ __forceinline__ V vmax(V a, V b) { return a > b ? a : b; }
    static __device__ __forceinline__ V vsel(B m, V a, V b) { return m ? a : b; }
    static __device__ __forceinline__ V x1(V a) { return (V)dpp_i<DPP_XOR1>((int)a); }
    static __device__ __forceinline__ V x2(V a) { return (V)dpp_i<DPP_XOR2>((int)a); }
};
__device__ __forceinline__ void stair_ab(int c, int& a, int& b) {
    if (c < 16) { a = 0; b = c; } else if (c < 24) { a = 1; b = c - 16; } else if (c < 28) { a = 2; b = c - 24; } else if (c < 32) { a = 3; b = c - 28; }
    else if (c < 36) { a = 4; b = c - 32; } else if (c < 40) { a = 5 + ((c - 36) >> 1); b = (c - 36) & 1; } else if (c < 44) { a = 7 + ((c - 40) >> 1); b = (c - 40) & 1; }
    else if (c < 48) { a = 9 + (c - 44); b = 0; } else if (c < 51) { a = 13 + (c - 48); b = 0; } else { a = 2; b = 4; }
}
constexpr int PE_WS = 5120, PE_TAB = 8 * PE_WS;
constexpr int PE_VEC = PE_TAB + 512;
static_assert(PE_VEC + 11 * 8192 <= LDSCTL_OFF, "PE vector cache");
__device__ __forceinline__ void peer_topk(Frame& F, LAS unsigned char* ws, int t) {
    const int lane = F.lane, sub = lane & 3;
    const bool low1 = (sub & 1) == 0, low2 = (sub & 2) == 0, eq12 = low1 == low2;
    LAS unsigned* S1K = (LAS unsigned*)ws; LAS int* EL = (LAS int*)(ws + 3328); LAS float* GL = (LAS float*)(ws + 3840);
    const LAS unsigned short* TAB = (const LAS unsigned short*)(F.lds + PE_TAB);
    {
        const int L = lane >> 2;
        const bf16_t* sp = F.SC() + (size_t)t * D + L * 128 + sub * 32;
        unsigned R[32];
#pragma unroll
        for (int q = 0; q < 4; ++q) { const u32x4 v = *(const u32x4*)(sp + 8 * q);
#pragma unroll
            for (int e = 0; e < 4; ++e) {
                R[8 * q + 2 * e] = (ordkey(bf_lo(v[e])) & ~127u) | (unsigned)(127 - (32 * sub + 8 * q + 2 * e));
                R[8 * q + 2 * e + 1] = (ordkey(bf_hi(v[e])) & ~127u) | (unsigned)(127 - (32 * sub + 8 * q + 2 * e + 1)); } }
        unsigned T[4];
        QuadNet<DevOps>::top16_of_128(R, T, low1, low2, eq12);
#pragma unroll
        for (int r = 0; r < 4; ++r) S1K[L * 16 + 4 * r + sub] = T[r];
    }
    LDS_WAIT(); __builtin_amdgcn_wave_barrier();
    {
        const int hd = (lane >> 2) & 7;
        const LAS unsigned char* la = (const LAS unsigned char*)(S1K + (2 * hd) * 16); const LAS unsigned char* lb = (const LAS unsigned char*)(S1K + (2 * hd + 1) * 16);
        unsigned C[16];
#pragma unroll
        for (int r = 0; r < 13; ++r) { const unsigned ab = TAB[4 * r + sub];
            const unsigned ka = *(const LAS unsigned*)(la + (ab & 255u)), kb = *(const LAS unsigned*)(lb + (ab >> 8));
            const float sum = unordkey(ka & ~127u) + unordkey(kb & ~127u);
            C[r] = (ordkey(sum) & ~63u) | (unsigned)(63 - (4 * r + sub)); }
        C[13] = 0u; C[14] = 0u; C[15] = 0u;
        unsigned W[4];
        QuadNet<DevOps>::top16_of_64(C, W, low1, low2, eq12);
        float sv[4]; int ex[4];
#pragma unroll
        for (int r = 0; r < 4; ++r) { const unsigned ab = TAB[63 - (W[r] & 63u)];
            const unsigned ka = *(const LAS unsigned*)(la + (ab & 255u)), kb = *(const LAS unsigned*)(lb + (ab >> 8));
            ex[r] = (int)(127u - (ka & 127u)) * 128 + (int)(127u - (kb & 127u)); sv[r] = unordkey(W[r] & ~63u); }
        const float mx = dpp_f<0x00>(sv[0]);
        float e4[4], es = 0.f;
#pragma unroll
        for (int r = 0; r < 4; ++r) { e4[r] = __expf(sv[r] - mx); es += e4[r]; }
        es += dpp_f<DPP_XOR1>(es); es += dpp_f<DPP_XOR2>(es);
        const float rd = 1.f / es;
#pragma unroll
        for (int r = 0; r < 4; ++r) { GL[hd * 16 + 4 * r + sub] = e4[r] * rd; EL[hd * 16 + 4 * r + sub] = ex[r]; }
    }
    LDS_WAIT(); __builtin_amdgcn_wave_barrier();
}

#ifndef PROBE_PHASE
#define PROBE_PHASE -1
#endif
#ifndef PROBE_MULT
#define PROBE_MULT 1
#endif
constexpr int EB = 4;
constexpr int CW_TICKET = 20480;

struct GBuf { LpRow<U_FMT> u[EB]; LpRow<V_FMT> v[EB]; };
__device__ __forceinline__ void gather_issue(GBuf& B, const LAS int* EL, int i0, const unsigned char* UTl, const unsigned char* VTl, int lane) {
#pragma unroll
    for (int q = 0; q < EB; ++q) {
        const int ex = __builtin_amdgcn_readfirstlane(EL[i0 + q]);
        B.u[q].load(UTl + (size_t)ex * UROW, lane); B.v[q].load(VTl + (size_t)ex * VROW, lane);
    }
}
__device__ __forceinline__ void gather_compute(const GBuf& B, const LAS int* EL, const LAS float* GL, int i0, const float* USl, const float* VSl, const unsigned (&hv)[16], f32x2 (&acc)[16]) {
    float dot[EB], su[EB], sv[EB], g[EB];
#pragma unroll
    for (int q = 0; q < EB; ++q) { const int ex = __builtin_amdgcn_readfirstlane(EL[i0 + q]); { const f32x2 s2 = *(const f32x2*)(USl + 2 * ex); su[q] = s2.x; sv[q] = s2.y; }
        g[q] = __uint_as_float(__builtin_amdgcn_readfirstlane(__float_as_uint(GL[i0 + q]))); }
#pragma unroll
    for (int q = 0; q < EB; ++q) { float s0 = 0.f, s1 = 0.f;
        B.u[q].each_bf([&](int i, bf16x2_t x) { if (i & 1) s1 = __builtin_amdgcn_fdot2_f32_bf16(x, __builtin_bit_cast(bf16x2_t, hv[i]), s1, false); else s0 = __builtin_amdgcn_fdot2_f32_bf16(x, __builtin_bit_cast(bf16x2_t, hv[i]), s0, false); });
        dot[q] = s0 + s1; __builtin_amdgcn_sched_barrier(0); }
#pragma unroll
    for (int q = 0; q < EB; ++q) dot[q] = wave_sum_u(dot[q]);
#pragma unroll
    for (int q = 0; q < EB; ++q) { const float cf = g[q] * gelu_as(dot[q] * su[q]) * sv[q]; const f32x2 c2 = {cf, cf};
        B.v[q].each([&](int i, float x0, float x1) { const f32x2 x = {x0, x1}; acc[i >> 1] = __builtin_elementwise_fma(x, c2, acc[i >> 1]); }); __builtin_amdgcn_sched_barrier(0); }
}

__device__ __forceinline__ void peer_phase(Frame& F, int layer, int rows, unsigned* ctl, unsigned long long& pr_acc) {
    unsigned long long pt0 = 0ull;
#define SUB_BEGIN(ty) do { if (PROBE_PHASE == (ty)) pt0 = __builtin_amdgcn_s_memrealtime(); } while (0)
#define SUB_END(ty) do { if (PROBE_PHASE == (ty)) pr_acc += __builtin_amdgcn_s_memrealtime() - pt0; } while (0)
    if (F.tid < 64) { int a = 0, b = 0; stair_ab(F.tid < 52 ? F.tid : 0, a, b); *(LAS unsigned short*)(F.lds + PE_TAB + 2 * F.tid) = (unsigned short)((4 * a) | ((4 * b) << 8)); }
    {
        const int ch = F.tid, ll = ch >> 3, q = ch & 7;
        LAS unsigned char* dst = F.lds + PE_VEC + (q * 64 + ll) * 16;
        const int nl = layer < NLAYER - 1 ? layer + 1 : layer;
#pragma unroll 1
        for (int v = 0; v < 9; ++v) {
            const int g3 = v / 3, mrv = v - 3 * g3;
            const size_t off = ((size_t)(g3 == 0 ? layer : nl) * 3 + mrv) * 12288 + (g3 == 0 ? 5 * D : (g3 == 1 ? 0 : D));
            *(LAS f32x4*)(dst + v * 8192) = *(const f32x4*)(F.MODS() + off + 4 * ch);
        }
        *(LAS f32x4*)(dst + 9 * 8192) = *(const f32x4*)(F.ln2_g() + layer * D + 4 * ch);
        *(LAS f32x4*)(dst + 10 * 8192) = *(const f32x4*)(F.ln2_b() + layer * D + 4 * ch);
    }
    __syncthreads();
    LAS unsigned char* ws = F.lds + F.wave * PE_WS;
    LAS int* EL = (LAS int*)(ws + 3328); LAS float* GL = (LAS float*)(ws + 3840);
    const int lane = F.lane;
    const LAS unsigned char* vcache = F.lds + PE_VEC + lane * 16;
    const unsigned char* UTl = F.UT() + (size_t)layer * NEXP * UROW;
    const unsigned char* VTl = F.VT() + (size_t)layer * NEXP * VROW;
    const float* USl = F.US() + 2 * (size_t)layer * NEXP; const float* VSl = nullptr;
    unsigned* ticket = ctl + CW_TICKET + 64 * layer;
    unsigned tk = 0u;
    if (lane == 0) tk = __hip_atomic_fetch_add(ticket, 1u, __ATOMIC_RELAXED, __HIP_MEMORY_SCOPE_AGENT);
    int t = (int)__builtin_amdgcn_readfirstlane(tk);
    while (t < rows) {
        unsigned tkn = 0u;
        if (lane == 0) tkn = __hip_atomic_fetch_add(ticket, 1u, __ATOMIC_RELAXED, __HIP_MEMORY_SCOPE_AGENT);
        SUB_BEGIN(8); peer_topk(F, ws, t); SUB_END(8);
        SUB_BEGIN(9);
        unsigned hv[16]; f32x2 acc[16];
#pragma unroll
        for (int q = 0; q < 4; ++q) { const u32x4 w = *(const u32x4*)(F.H() + (size_t)t * D + 32 * lane + 8 * q);
#pragma unroll
            for (int e = 0; e < 4; ++e) { hv[4 * q + e] = w[e]; acc[4 * q + e] = (f32x2){0.f, 0.f}; } }
        {
            GBuf A, B, C;
            gather_issue(A, EL, 0, UTl, VTl, lane);
            gather_issue(B, EL, EB, UTl, VTl, lane);
            for (int i0 = 0; i0 < 30 * EB; i0 += 3 * EB) {
                gather_issue(C, EL, i0 + 2 * EB, UTl, VTl, lane);
                gather_compute(A, EL, GL, i0, USl, VSl, hv, acc);
                gather_issue(A, EL, i0 + 3 * EB, UTl, VTl, lane);
                gather_compute(B, EL, GL, i0 + EB, USl, VSl, hv, acc);
                gather_issue(B, EL, i0 + 4 * EB, UTl, VTl, lane);
                gather_compute(C, EL, GL, i0 + 2 * EB, USl, VSl, hv, acc);
            }
            gather_compute(A, EL, GL, 30 * EB, USl, VSl, hv, acc);
            gather_compute(B, EL, GL, 31 * EB, USl, VSl, hv, acc);
        }
        SUB_END(9); SUB_BEGIN(10);
        const int mr = modrow(t);
        const float* mp = F.MODS() + ((size_t)layer * 3 + mr) * 12288;
        bf16_t* xr = F.X() + (size_t)t * D;
        float rr[32]; float s = 0.f;
#pragma unroll
        for (int q2 = 0; q2 < 4; ++q2) { const u32x4 xw = *(const u32x4*)(xr + 32 * lane + 8 * q2);
#pragma unroll
            for (int h2 = 0; h2 < 2; ++h2) { const int q = 2 * q2 + h2; const f32x4 gv = *(const LAS f32x4*)(vcache + mr * 8192 + q * 1024);
                const f32x4 xv = {bf_lo(xw[2 * h2]), bf_hi(xw[2 * h2]), bf_lo(xw[2 * h2 + 1]), bf_hi(xw[2 * h2 + 1])};
                const f32x4 av = {acc[2 * q].x, acc[2 * q].y, acc[2 * q + 1].x, acc[2 * q + 1].y};
#pragma unroll
                for (int e = 0; e < 4; ++e) { const float v = DN_ALPHA * xv[e] + gv[e] * av[e]; rr[4 * q + e] = v; s += v; } } }
        const float mean = wave_sum_u(s) * (1.f / D);
        float s2 = 0.f;
#pragma unroll
        for (int i = 0; i < 32; ++i) { rr[i] -= mean; s2 += rr[i] * rr[i]; }
        const float rstd = 1.f / sqrtf(wave_sum_u(s2) * (1.f / D) + LN_EPS);
        const float* g2 = F.ln2_g() + layer * D; const float* b2 = F.ln2_b() + layer * D;
        float s3 = 0.f;
#pragma unroll
        for (int q = 0; q < 8; ++q) { const int c = 32 * lane + 4 * q; const f32x4 gg = *(const LAS f32x4*)(vcache + 9 * 8192 + q * 1024), bb = *(const LAS f32x4*)(vcache + 10 * 8192 + q * 1024);
            f32x4 xo;
#pragma unroll
            for (int e = 0; e < 4; ++e) { xo[e] = rr[4 * q + e] * rstd * gg[e] + bb[e]; rr[4 * q + e] = xo[e]; s3 += xo[e]; }
            if (layer == NLAYER - 1 && t < TL) *(f32x4*)(F.out() + (size_t)t * D + c) = xo; }
        if (layer < NLAYER - 1) {
#pragma unroll
            for (int q2 = 0; q2 < 4; ++q2) { u32x4 o4; o4.x = pk2(rr[8 * q2], rr[8 * q2 + 1]); o4.y = pk2(rr[8 * q2 + 2], rr[8 * q2 + 3]); o4.z = pk2(rr[8 * q2 + 4], rr[8 * q2 + 5]); o4.w = pk2(rr[8 * q2 + 6], rr[8 * q2 + 7]);
                *(u32x4*)(xr + 32 * lane + 8 * q2) = o4; }
            const float mean2 = wave_sum_u(s3) * (1.f / D);
            float s4 = 0.f;
#pragma unroll
            for (int i = 0; i < 32; ++i) { rr[i] -= mean2; s4 += rr[i] * rr[i]; }
            const float rstd2 = 1.f / sqrtf(wave_sum_u(s4) * (1.f / D) + LN_EPS);
            const float* np = F.MODS() + ((size_t)(layer + 1) * 3 + mr) * 12288;
#pragma unroll
            for (int q4 = 0; q4 < 2; ++q4) { u32x4 w;
#pragma unroll
                for (int q = 0; q < 4; ++q) { const int qq = 4 * q4 + q; const f32x4 sh = *(const LAS f32x4*)(vcache + (3 + mr) * 8192 + qq * 1024), sc = *(const LAS f32x4*)(vcache + (6 + mr) * 8192 + qq * 1024); const int ri = 4 * qq;
                    const float y0 = rr[ri] * rstd2 * (1.f + sc[0]) + sh[0], y1 = rr[ri + 1] * rstd2 * (1.f + sc[1]) + sh[1];
                    const float y2 = rr[ri + 2] * rstd2 * (1.f + sc[2]) + sh[2], y3 = rr[ri + 3] * rstd2 * (1.f + sc[3]) + sh[3];
                    int o = __builtin_amdgcn_cvt_pk_fp8_f32(y0, y1, 0, false); o = __builtin_amdgcn_cvt_pk_fp8_f32(y2, y3, o, true); w[q] = (unsigned)o; }
                *(u32x4*)(F.H8() + (size_t)t * D + 32 * lane + 16 * q4) = w; }
        }
        SUB_END(10);
        t = (int)__builtin_amdgcn_readfirstlane(tkn);
    }
#undef SUB_BEGIN
#undef SUB_END
}

__global__ void __launch_bounds__(NWAVES * 64, 2) skel_fwd(Args args) {
    extern __shared__ __attribute__((aligned(16))) unsigned char lds[];
    Frame F;
    F.lds = (LAS unsigned char*)lds;
    F.tid = threadIdx.x; F.lane = F.tid & 63; F.wave = __builtin_amdgcn_readfirstlane(F.tid >> 6);
    F.G = gridDim.x; F.gw = blockIdx.x * NWAVES + F.wave; F.NGW = F.G * NWAVES;
    unsigned char* ws = args.ws;
    F.ka = (const CAS unsigned char*)__builtin_amdgcn_kernarg_segment_ptr();
    for (int u = F.tid; u < (LDS_BYTES - LDSCTL_OFF) / 4; u += NWAVES * 64) ((LAS unsigned*)(F.lds + LDSCTL_OFF))[u] = 0u;
    __syncthreads();
    unsigned* ctl = (unsigned*)(ws + WS_CTL);
    const int lo = args.ph_lo, hi = args.ph_hi;
    XcdBarrier bar; bar.bar = ctl + CW_BAR + args.li * XCD_BAR_WORDS; bar.x = 0; bar.st = nullptr;
    if (hi - lo > 1) bar = xcd_barrier_post(ctl + CW_BAR + args.li * XCD_BAR_WORDS, (volatile LAS unsigned*)(F.lds + MISC_OFF) + 8);
#define IN(k) (lo <= (k) && (k) < hi)
    unsigned long long pr_acc = 0ull, pr_t0 = 0ull;
#define PR_BEGIN(ty) do { if (PROBE_PHASE == (ty)) pr_t0 = __builtin_amdgcn_s_memrealtime(); } while (0)
#define PR_END(ty) do { if (PROBE_PHASE == (ty)) pr_acc += __builtin_amdgcn_s_memrealtime() - pr_t0; } while (0)
#define BOTH(k) (IN(k) && IN((k) + 1))
#define SEAM(k) do { if (BOTH(k)) xcd_barrier(bar); } while (0)

    if (IN(0)) { PR_BEGIN(0); frame_ids(F); p0a_prologue(F); SEAM(0); PR_END(0); }
    if (IN(1)) {
        PR_BEGIN(1); frame_ids(F);
        { pg8::Gemm g{F.KBD(), F.WQR(), 32 * 256, 2048, 256}; pg8::BatchOrder S{F.G, (int)blockIdx.x}; pg8::EpiBf16 E{F.WEFFT(), D, 1.f};
          pg8::gemm_phase<pg8::EpiBf16, pg8::BatchOrder, false, true>(F.lds, g, S, E); }
        p0b_mod0(F);
        SEAM(1); PR_END(1);
    }
    for (int layer = 0; layer < NLAYER; ++layer) {
        const int pb = 2 + 6 * layer;
        const bool lastl = layer == NLAYER - 1;
        const int rows = lastl ? TL : TT;
        if (IN(pb + 0)) {
            PR_BEGIN(2); frame_ids(F);
            pg8::Gemm g{(const bf16_t*)F.H8(), (const bf16_t*)(F.WINT() + (size_t)layer * INC * D), TT, INC, D / 2}; pg8::StaticOrder S; S.init(TT, 2 * INC, F.G, (int)blockIdx.x);
            pg8::EpiBf16H E{F.PROJ(), INC, 1.f / WIN_SCALE};
            pg8::gemm_phase<pg8::EpiBf16H, pg8::StaticOrder, false, true, true, true>(F.lds, g, S, E);
            SEAM(pb + 0); PR_END(2);
        }
        if (IN(pb + 1)) {
            PR_BEGIN(3); frame_ids(F);
            const int nunits = lastl ? 512 : 528;
            {
                const int ch = F.tid & 255, vsel = F.tid >> 8;
                LAS unsigned char* dst = F.lds + CONV_LDS + ((2 * (ch >> 7) + (ch & 1)) * 64 + ((ch & 127) >> 1)) * 16;
                *(LAS f32x4*)(dst + vsel * 4096) = *(const f32x4*)(F.conv_w() + (size_t)layer * 3 * 1024 + vsel * 1024 + 4 * ch);
                *(LAS f32x4*)(dst + (2 + vsel) * 4096) = vsel == 0 ? *(const f32x4*)(F.conv_w() + (size_t)layer * 3 * 1024 + 2048 + 4 * ch) : *(const f32x4*)(F.g_conv() + layer * 1024 + 4 * ch);
            }
            for (int i = F.tid; i < 192 * 32 * 2 / 4; i += NWAVES * 64) *(LAS f32x4*)(F.lds + ROPE_LDS + i * 16) = *(const f32x4*)(F.ROPE() + 4 * i);
            __syncthreads();
            { unsigned long long q0 = 0; if (PROBE_PHASE == 11) q0 = __builtin_amdgcn_s_memrealtime();
            { const int bx = (int)blockIdx.x, vcu = (F.G % 8 == 0) ? (bx % 8) * (F.G / 8) + bx / 8 : bx;
              for (int u = vcu; u < nunits; u += F.G) attn_unit(F, layer, u); }
            if (PROBE_PHASE == 11) pr_acc += __builtin_amdgcn_s_memrealtime() - q0; if (PROBE_PHASE == 12) q0 = __builtin_amdgcn_s_memrealtime();
            {
              const int nx = nunits - 2 * F.G; const bool uneven = nx > 0 && nx < F.G;
              const int bx2 = (int)blockIdx.x, vc2 = (F.G % 8 == 0) ? (bx2 % 8) * (F.G / 8) + bx2 / 8 : bx2;
              const int c0 = uneven ? vc2 - nx : vc2, nb = uneven ? F.G - nx : F.G;
              if (c0 >= 0) for (int t = c0 * NWAVES + F.wave; t < rows; t += nb * NWAVES) conv_row(F, layer, t); }
            if (PROBE_PHASE == 12) pr_acc += __builtin_amdgcn_s_memrealtime() - q0; }
            SEAM(pb + 1); PR_END(3);
        }
        if (IN(pb + 2)) {
            PR_BEGIN(4); frame_ids(F);
            pg8::Gemm g{F.MIX(), F.WOUTT() + (size_t)layer * D * D, rows, D, D}; pg8::StaticOrder S; S.init(rows, D, F.G, (int)blockIdx.x);
            pg8::EpiResid E{layer == 0 ? F.x() : nullptr, layer == 0 ? F.ctx() : nullptr, F.X(), F.MODS() + (size_t)layer * 3 * 12288 + 2 * D};
            pg8::gemm_phase<pg8::EpiResid, pg8::StaticOrder, true, true>(F.lds, g, S, E);
            frame_ids(F); convert_in_tail(F, layer, (rows / 256) * (D / 256), 0);
            SEAM(pb + 2); PR_END(4);
        }
        if (IN(pb + 3)) { PR_BEGIN(5); frame_ids(F); ln_phase(F, layer, rows); SEAM(pb + 3); PR_END(5); }
        if (IN(pb + 4)) {
            PR_BEGIN(6); frame_ids(F);
            pg8::Gemm g{F.H(), F.WEFFT() + (size_t)layer * D * D, rows, D, D}; pg8::StaticOrder S; S.init(rows, D, F.G, (int)blockIdx.x);
            pg8::EpiBf16 E{F.SC(), D, 1.f};
            pg8::gemm_phase<pg8::EpiBf16, pg8::StaticOrder, true, true>(F.lds, g, S, E);
            frame_ids(F); convert_in_tail(F, layer, (rows / 256) * (D / 256), 1);
            SEAM(pb + 4); PR_END(6);
        }
        if (IN(pb + 5)) { PR_BEGIN(7); frame_ids(F); peer_phase(F, layer, rows, ctl, pr_acc); SEAM(pb + 5); PR_END(7); }
    }
    if (PROBE_PHASE >= 0 && hi - lo > 1) xcd_barrier(bar);
    if (PROBE_PHASE >= 0 && blockIdx.x == 0 && threadIdx.x == 0) { const unsigned long long t1 = __builtin_amdgcn_s_memrealtime() + (unsigned long long)PROBE_MULT * pr_acc; while (__builtin_amdgcn_s_memrealtime() < t1) __builtin_amdgcn_s_sleep(8); }
#undef IN
#undef BOTH
#undef SEAM
}

extern "C" void kernel_launch(void* const* d_in, const int* in_sizes, int n_in, void* d_out, int out_size, void* d_ws, size_t ws_size, hipStream_t stream) {
    static int grid = 0;
    if (grid == 0) {
        if (n_in != 20 || in_sizes[0] != TL * D || out_size != TL * D || ws_size < WS_END) {
            fprintf(stderr, "kernel_launch: unexpected problem shape (n_in %d, in0 %d, out %d, ws %zu, need %zu)\n", n_in, n_in > 0 ? in_sizes[0] : -1, out_size, ws_size, (size_t)WS_END); grid = -1; return; }
        int dev = 0, cus = 0, per_cu = 0;
        if (hipGetDevice(&dev) != hipSuccess || hipDeviceGetAttribute(&cus, hipDeviceAttributeMultiprocessorCount, dev) != hipSuccess) { grid = -1; return; }
        if (hipFuncSetAttribute((const void*)skel_fwd, hipFuncAttributeMaxDynamicSharedMemorySize, LDS_BYTES) != hipSuccess) { fprintf(stderr, "kernel_launch: hipFuncSetAttribute failed\n"); grid = -1; return; }
        if (hipOccupancyMaxActiveBlocksPerMultiprocessor(&per_cu, (const void*)skel_fwd, NWAVES * 64, LDS_BYTES) != hipSuccess || per_cu < 1)
            fprintf(stderr, "kernel_launch: occupancy query reports %d workgroups per CU\n", per_cu);
        (void)hipGetLastError();
        grid = cus;
    }
    if (grid < 0) return;
    if (hipMemsetAsync((char*)d_ws + WS_CTL, 0, CTL_ZERO_BYTES, stream) != hipSuccess) return;
    Args a{};
    for (int i = 0; i < 20; ++i) a.in[i] = (const float*)d_in[i];
    a.out = (float*)d_out; a.ws = (unsigned char*)d_ws; a.pad = 0;
#if MK_N_LAUNCHES == 1
    a.ph_lo = 0; a.ph_hi = NPHASE; a.li = 0;
    hipLaunchKernelGGL(skel_fwd, dim3(grid), dim3(NWAVES * 64), LDS_BYTES, stream, a);
#else
    for (int ph = 0; ph < NPHASE; ++ph) { a.ph_lo = ph; a.ph_hi = ph + 1; a.li = 0;
        hipLaunchKernelGGL(skel_fwd, dim3(grid), dim3(NWAVES * 64), LDS_BYTES, stream, a); }
#endif
}
```

```cpp
#include <hip/hip_runtime.h>
#include <cstdio>
#include <cstdint>

#ifndef MK_N_LAUNCHES
#define MK_N_LAUNCHES 1
#endif

#define LAS __attribute__((address_space(3)))
typedef unsigned short bf16_t;
typedef short bf16x8 __attribute__((ext_vector_type(8)));
typedef short s16x4 __attribute__((ext_vector_type(4)));
typedef float f32x2 __attribute__((ext_vector_type(2)));
typedef float f32x4 __attribute__((ext_vector_type(4)));
typedef float f32x16 __attribute__((ext_vector_type(16)));
typedef unsigned u32x2 __attribute__((ext_vector_type(2)));
typedef unsigned u32x4 __attribute__((ext_vector_type(4)));
typedef __bf16 bf16x2_t __attribute__((ext_vector_type(2)));
typedef int i32x8 __attribute__((ext_vector_type(8)));

constexpr int D = 2048, NB = 2, SEQ = 8192, CTXL = 256, NLAYER = 4;
constexpr int TL = NB * SEQ, TC = NB * CTXL, TT = TL + TC;
constexpr int INC = 4608, OFF_C = 1024, OFF_X = 2048, OFF_Q = 3072, OFF_K = 4096, OFF_V = 4352;
constexpr float WOUT_SCALE = 128.f;
constexpr float WIN_SCALE = 64.f;
constexpr int NEXP = 16384;
#ifndef U_FMT
#define U_FMT 4
#endif
#ifndef V_FMT
#define V_FMT 4
#endif
constexpr int UROW = D * U_FMT / 8, VROW = D * V_FMT / 8;
constexpr float LN_EPS = 1e-6f;
constexpr float DN_ALPHA = 1.681792830507429f;
constexpr float QSCALE = 0.08838834764831845f * 1.4426950408889634f;
constexpr float LOG2E = 1.4426950408889634f;

constexpr size_t MiB = 1u << 20;
constexpr size_t WS_CTL = 0, CTL_ZERO_BYTES = 1 * MiB;
constexpr size_t WS_MODS = 1 * MiB;
constexpr size_t WS_ROPE = 2 * MiB;
constexpr size_t WS_KBD = 3 * MiB;
constexpr size_t WS_WQR = 8 * MiB;
constexpr size_t WS_WINT = 40 * MiB;
constexpr size_t WS_WOUTT = 112 * MiB;
constexpr size_t WS_WEFFT = 144 * MiB;
constexpr size_t WS_X = 176 * MiB;
constexpr size_t WS_H = 308 * MiB;
constexpr size_t WS_PROJ = 374 * MiB;
constexpr size_t WS_MIX = 523 * MiB;
constexpr size_t WS_SC = 589 * MiB;
constexpr size_t WS_UT = 721 * MiB;
constexpr size_t WS_VT = 849 * MiB;
constexpr size_t WS_US = 977 * MiB;
constexpr size_t WS_VS = 978 * MiB;
constexpr size_t WS_H8 = 979 * MiB;
constexpr size_t WS_END = 1013 * MiB;

constexpr int CW_BAR = 4096;

namespace pg8 {
constexpr int BM = 256, BK = 64, HALF = 128, HTB = HALF * BK * 2, STAGE_BYTES = 8 * HTB, NXCD = 8, WGM = 8;
__host__ __device__ __forceinline__ int lds_byte(int r, int c) { const int st = (r >> 4) * 2 + (c >> 5), rr = r & 15, cc = c & 31, ob = rr * 64 + cc * 2; return st * 1024 + (ob ^ (((ob >> 9) & 1) << 5)); }
__host__ __device__ __forceinline__ void stage_rc(int b, int& R, int& C) { const int st = b / 1024, sb = b % 1024, swz = sb ^ (((sb >> 9) & 1) << 5); R = (st >> 1) * 16 + swz / 64; C = (st & 1) * 32 + (swz % 64) / 2; }
__host__ __device__ __forceinline__ int perm32(int rho) { const int n = rho >> 4, i = rho & 15; return 8 * (i >> 2) + 4 * n + (i & 3); }

struct Unit { int pm, pn; };
struct Gemm { const bf16_t* A; const bf16_t* Bt; int M, N, K; };

struct StaticOrder {
    int nM, nN, nwg, G, c;
    __host__ __device__ void init(int M, int N, int G_, int c_) { nM = M / BM; nN = N / BM; nwg = nM * nN; G = G_; c = c_; }
    __host__ __device__ bool next(int i, Unit& u) const {
        const long L = (long)i * G + c; if (L >= nwg) return false;
        int wgid = (int)L; { const int q = nwg / NXCD, r = nwg % NXCD, xcd = wgid % NXCD, off = wgid / NXCD; wgid = (xcd < r ? xcd * (q + 1) : r * (q + 1) + (xcd - r) * q) + off; }
        const int nig = WGM * nN, gid = wgid / nig, fm = gid * WGM, gsz = (nM - fm) < WGM ? (nM - fm) : WGM;
        u.pm = fm + ((wgid % nig) % gsz); u.pn = (wgid % nig) / gsz; return true;
    }
    __device__ __forceinline__ int btile(const Unit& u) const { return u.pn; }
    __device__ __forceinline__ void a_ready(const Unit&) const {}
    __device__ __forceinline__ void done(const Unit&) const {}
};
struct BatchOrder {
    int G, c;
    __device__ bool next(int i, Unit& u) const { const int L = i * G + c; if (L >= 256) return false; u.pm = L >> 3; u.pn = L & 7; return true; }
    __device__ __forceinline__ int btile(const Unit& u) const { return u.pm * 8 + u.pn; }
    __device__ __forceinline__ void a_ready(const Unit&) const {}
    __device__ __forceinline__ void done(const Unit&) const {}
};

__device__ __forceinline__ unsigned cvt_pk_bf16(float lo, float hi) { f32x2 x = {lo, hi}; bf16x2_t y = __builtin_convertvector(x, bf16x2_t); return __builtin_bit_cast(unsigned, y); }

struct EpiBf16 {
    static constexpr bool PERM = true;
    bf16_t* O; int ldc; float scale;
    __device__ __forceinline__ void operator()(const f32x4 (&acc)[2][2][4][2], const Unit& u, int wr, int wc, int fr, int fq) const {
        const int row0 = u.pm * BM + wr * 64 + fr, col0 = u.pn * BM + wc * 32 + 8 * fq;
#pragma unroll
        for (int ai = 0; ai < 2; ++ai)
#pragma unroll
            for (int m = 0; m < 4; ++m) { bf16_t* rowp = O + (size_t)(row0 + ai * HALF + m * 16) * ldc + col0;
#pragma unroll
                for (int bj = 0; bj < 2; ++bj) { const f32x4 v0 = acc[ai][bj][m][0] * scale, v1 = acc[ai][bj][m][1] * scale;
                    u32x4 w; w.x = cvt_pk_bf16(v0[0], v0[1]); w.y = cvt_pk_bf16(v0[2], v0[3]); w.z = cvt_pk_bf16(v1[0], v1[1]); w.w = cvt_pk_bf16(v1[2], v1[3]);
                    *(u32x4*)(rowp + bj * HALF) = w; } }
    }
};
struct EpiBf16H {
    static constexpr bool PERM = true;
    bf16_t* O; int ldc; float scale;
    __device__ __forceinline__ void operator()(const f32x4 (&acc)[2][2][4][2], const Unit& u, int wr, int wc, int fr, int fq) const {
        const int row0 = u.pm * BM + wr * 64 + fr, col0 = u.pn * HALF + wc * 32 + 8 * fq;
#pragma unroll
        for (int ai = 0; ai < 2; ++ai)
#pragma unroll
            for (int m = 0; m < 4; ++m) { const f32x4 v0 = acc[ai][0][m][0] * scale, v1 = acc[ai][0][m][1] * scale;
                u32x4 w; w.x = cvt_pk_bf16(v0[0], v0[1]); w.y = cvt_pk_bf16(v0[2], v0[3]); w.z = cvt_pk_bf16(v1[0], v1[1]); w.w = cvt_pk_bf16(v1[2], v1[3]);
                *(u32x4*)(O + (size_t)(row0 + ai * HALF + m * 16) * ldc + col0) = w; }
    }
};
struct EpiF32 {
    static constexpr bool PERM = false;
    float* C; int ldc;
    __device__ __forceinline__ void operator()(const f32x4 (&acc)[2][2][4][2], const Unit& u, int wr, int wc, int fr, int fq) const {
        const int row0 = u.pm * BM + wr * 64 + fr, col0 = u.pn * BM + wc * 32 + 4 * fq;
#pragma unroll
        for (int ai = 0; ai < 2; ++ai)
#pragma unroll
            for (int m = 0; m < 4; ++m) { float* rowp = C + (size_t)(row0 + ai * HALF + m * 16) * ldc + col0;
#pragma unroll
                for (int bj = 0; bj < 2; ++bj)
#pragma unroll
                    for (int n = 0; n < 2; ++n) *(f32x4*)(rowp + bj * HALF + n * 16) = acc[ai][bj][m][n]; }
    }
};
struct EpiResid {
    static constexpr bool PERM = true;
    const float* x32_lat; const float* x32_ctx;
    bf16_t* X; const float* gate;
    __device__ __forceinline__ void operator()(const f32x4 (&acc)[2][2][4][2], const Unit& u, int wr, int wc, int fr, int fq) const {
        const int rt = u.pm * BM;
        const int mr = rt < TL ? rt / SEQ : 2;
        const int row0 = rt + wr * 64 + fr, col0 = u.pn * BM + wc * 32 + 8 * fq;
        f32x4 gv[2][2];
#pragma unroll
        for (int bj = 0; bj < 2; ++bj)
#pragma unroll
            for (int n = 0; n < 2; ++n) gv[bj][n] = *(const f32x4*)(gate + (size_t)mr * 12288 + col0 + bj * HALF + 4 * n);
#pragma unroll
        for (int ai = 0; ai < 2; ++ai)
#pragma unroll
            for (int m = 0; m < 4; ++m) { const int row = row0 + ai * HALF + m * 16;
#pragma unroll
                for (int bj = 0; bj < 2; ++bj) {
                    f32x4 x0, x1;
                    if (x32_lat) { const float* xp = (row < TL ? x32_lat + (size_t)row * D : x32_ctx + (size_t)(row - TL) * D) + col0 + bj * HALF; x0 = *(const f32x4*)xp; x1 = *(const f32x4*)(xp + 4); }
                    else { const u32x4 w = *(const u32x4*)(X + (size_t)row * D + col0 + bj * HALF);
                        x0 = (f32x4){__uint_as_float(w.x << 16), __uint_as_float(w.x & 0xffff0000u), __uint_as_float(w.y << 16), __uint_as_float(w.y & 0xffff0000u)};
                        x1 = (f32x4){__uint_as_float(w.z << 16), __uint_as_float(w.z & 0xffff0000u), __uint_as_float(w.w << 16), __uint_as_float(w.w & 0xffff0000u)}; }
                    const f32x4 r0 = x0 * DN_ALPHA + gv[bj][0] * acc[ai][bj][m][0], r1 = x1 * DN_ALPHA + gv[bj][1] * acc[ai][bj][m][1];
                    u32x4 o; o.x = cvt_pk_bf16(r0[0], r0[1]); o.y = cvt_pk_bf16(r0[2], r0[3]); o.z = cvt_pk_bf16(r1[0], r1[1]); o.w = cvt_pk_bf16(r1[2], r1[3]);
                    *(u32x4*)(X + (size_t)row * D + col0 + bj * HALF) = o; } }
    }
};

template <class Epi, class Sched, bool ALIGN_EPI = false, bool SP2 = false, bool FP8 = false, bool HN = false>
__device__ __forceinline__ void gemm_phase(LAS unsigned char* lds, const Gemm g, const Sched& S, const Epi& E) {
    int tid = threadIdx.x; asm volatile("" : "+v"(tid));
    const int wid = __builtin_amdgcn_readfirstlane(tid >> 6), lane = tid & 63, wr = wid >> 2, wc = wid & 3, fr = lane & 15, fq = lane >> 4;
    const int K = g.K, nt = K / BK;
    unsigned voffA[2], voffB[2];
#pragma unroll
    for (int i = 0; i < 2; ++i) { int R, C; stage_rc(tid * 16 + i * 8192, R, C); const int Rb = Epi::PERM ? ((R & ~31) + perm32(R & 31)) : R;
        voffA[i] = (unsigned)(R * K + C) * 2u; voffB[i] = (unsigned)(Rb * K + C) * 2u; }
    const size_t kstep = (size_t)(BK * 2);
    const size_t hstep = (size_t)HALF * K * 2;
    const size_t tstep = 2 * hstep;
    const unsigned ldsw = (unsigned)wid * 1024u;
    const int aoff = lds_byte(wr * 64 + fr, fq * 8), boff = lds_byte(wc * 32 + fr, fq * 8);
    const int aoff8a = lds_byte(wr * 64 + fr, fq * 16), boff8a = lds_byte(wc * 32 + fr, fq * 16);
#define PG8_SA(b, h) (((b) * 2 + (h)) * HTB)
#define PG8_SB(b, h) ((4 + (b) * 2 + (h)) * HTB)
#define PG8_STAGE(bufoff, gbase, voff) do { _Pragma("unroll") for (int _i = 0; _i < 2; ++_i) \
        __builtin_amdgcn_global_load_lds((const unsigned*)((const char*)(gbase) + (voff)[_i]), (LAS unsigned*)(lds + (bufoff) + ldsw + _i * 8192), 16, 0, 0); } while (0)
#define PG8_LDA(dst, b, h) do { if constexpr (FP8) { _Pragma("unroll") for (int m = 0; m < 4; ++m) { const u32x4 _x = *(const LAS u32x4*)(lds + PG8_SA(b, h) + aoff8a + m * 2048), _y = *(const LAS u32x4*)(lds + PG8_SA(b, h) + aoff8a + 16 + m * 2048); \
            dst##8[m] = (i32x8){(int)_x.x, (int)_x.y, (int)_x.z, (int)_x.w, (int)_y.x, (int)_y.y, (int)_y.z, (int)_y.w}; } } \
        else { _Pragma("unroll") for (int m = 0; m < 4; ++m) _Pragma("unroll") for (int k = 0; k < 2; ++k) dst[m][k] = *(const LAS bf16x8*)(lds + PG8_SA(b, h) + aoff + m * 2048 + k * 1024); } } while (0)
#define PG8_LDB(dst, b, h) do { if constexpr (FP8) { _Pragma("unroll") for (int n = 0; n < 2; ++n) { const u32x4 _x = *(const LAS u32x4*)(lds + PG8_SB(b, h) + boff8a + n * 2048), _y = *(const LAS u32x4*)(lds + PG8_SB(b, h) + boff8a + 16 + n * 2048); \
            dst##8[n] = (i32x8){(int)_x.x, (int)_x.y, (int)_x.z, (int)_x.w, (int)_y.x, (int)_y.y, (int)_y.z, (int)_y.w}; } } \
        else { _Pragma("unroll") for (int n = 0; n < 2; ++n) _Pragma("unroll") for (int k = 0; k < 2; ++k) dst[n][k] = *(const LAS bf16x8*)(lds + PG8_SB(b, h) + boff + n * 2048 + k * 1024); } } while (0)
#define PG8_MMA(ai, bj, At, Bt) do { __builtin_amdgcn_s_setprio(1); if constexpr (FP8) { _Pragma("unroll") for (int m = 0; m < 4; ++m) _Pragma("unroll") for (int n = 0; n < 2; ++n) \
            acc[ai][bj][m][n] = __builtin_amdgcn_mfma_scale_f32_16x16x128_f8f6f4(Bt##8[n], At##8[m], acc[ai][bj][m][n], 0, 0, 0, 0x7F7F7F7F, 0, 0x7F7F7F7F); } \
        else { _Pragma("unroll") for (int m = 0; m < 4; ++m) _Pragma("unroll") for (int n = 0; n < 2; ++n) _Pragma("unroll") for (int k = 0; k < 2; ++k) \
            acc[ai][bj][m][n] = __builtin_amdgcn_mfma_f32_16x16x32_bf16(Bt[n][k], At[m][k], acc[ai][bj][m][n], 0, 0, 0); } __builtin_amdgcn_s_setprio(0); } while (0)
#define PG8_WAIT_V(n) asm volatile("s_waitcnt vmcnt(" #n ")" ::: "memory")
#define PG8_WAIT_L(n) asm volatile("s_waitcnt lgkmcnt(" #n ")" ::: "memory")
#define PG8_BAR __builtin_amdgcn_s_barrier()
#define PG8_SCHED __builtin_amdgcn_sched_barrier(0)
    Unit cur, nxt; int ui = 0;
    if (!S.next(0, cur)) return;
    f32x4 acc[2][2][4][2];
#pragma unroll
    for (int a = 0; a < 2; ++a)
#pragma unroll
        for (int b = 0; b < 2; ++b)
#pragma unroll
            for (int m = 0; m < 4; ++m)
#pragma unroll
                for (int n = 0; n < 2; ++n) acc[a][b][m][n] = (f32x4){0.f, 0.f, 0.f, 0.f};
    bf16x8 At[4][2], B0[2][2], B1[2][2];
    i32x8 At8[4], B08[2], B18[2];
    const size_t bstep = HN ? hstep : tstep;
    const char* cA = (const char*)g.A + (size_t)cur.pm * tstep; const char* cB = (const char*)g.Bt + (size_t)S.btile(cur) * bstep;
    S.a_ready(cur);
    if constexpr (HN) {
        static_assert(!HN || SP2, "HN needs the SP2 loop");
        PG8_STAGE(PG8_SB(0, 0), cB, voffB); PG8_STAGE(PG8_SA(0, 0), cA, voffA); PG8_STAGE(PG8_SA(0, 1), cA + hstep, voffA);
        if (wr == 1) PG8_BAR;
        PG8_WAIT_V(2); PG8_BAR;
        PG8_STAGE(PG8_SB(1, 0), cB + kstep, voffB); PG8_STAGE(PG8_SA(1, 0), cA + kstep, voffA);
        PG8_WAIT_V(4); PG8_BAR;
    } else if constexpr (SP2) {
        PG8_STAGE(PG8_SB(0, 0), cB, voffB); PG8_STAGE(PG8_SB(0, 1), cB + hstep, voffB); PG8_STAGE(PG8_SA(0, 0), cA, voffA); PG8_STAGE(PG8_SA(0, 1), cA + hstep, voffA);
        if (wr == 1) PG8_BAR;
        PG8_WAIT_V(2); PG8_BAR;
        PG8_STAGE(PG8_SB(1, 0), cB + kstep, voffB); PG8_STAGE(PG8_SA(1, 0), cA + kstep, voffA); PG8_STAGE(PG8_SB(1, 1), cB + hstep + kstep, voffB);
        PG8_WAIT_V(6); PG8_BAR;
    } else {
        PG8_STAGE(PG8_SB(0, 0), cB, voffB); PG8_STAGE(PG8_SA(0, 0), cA, voffA); PG8_STAGE(PG8_SB(0, 1), cB + hstep, voffB); PG8_STAGE(PG8_SA(0, 1), cA + hstep, voffA);
        if (wr == 1) PG8_BAR;
        PG8_WAIT_V(4); PG8_BAR;
        PG8_STAGE(PG8_SB(1, 0), cB + kstep, voffB); PG8_STAGE(PG8_SA(1, 0), cA + kstep, voffA); PG8_STAGE(PG8_SB(1, 1), cB + hstep + kstep, voffB);
        PG8_WAIT_V(6); PG8_BAR;
    }
    for (;;) {
        const bool has_next = S.next(ui + 1, nxt);
        const char* nA = has_next ? (const char*)g.A + (size_t)nxt.pm * tstep : cA; const char* nB = has_next ? (const char*)g.Bt + (size_t)S.btile(nxt) * bstep : cB;
        for (int t = 0; t < nt; t += 2) {
            const bool last = (t == nt - 2);
            const char* a1 = cA + (size_t)(t + 1) * kstep;
            const char* a2 = last ? nA : cA + (size_t)(t + 2) * kstep; const char* b2 = last ? nB : cB + (size_t)(t + 2) * kstep;
            const char* a3 = a2 + kstep; const char* b3 = b2 + kstep;
            if (last && has_next) S.a_ready(nxt);
            if constexpr (HN) {
            PG8_LDB(B0, 0, 0); PG8_SCHED; PG8_LDA(At, 0, 0); PG8_STAGE(PG8_SA(1, 1), a1 + hstep, voffA);
            PG8_WAIT_V(6); PG8_WAIT_L(0); PG8_BAR; PG8_MMA(0, 0, At, B0); PG8_BAR; PG8_SCHED;
            PG8_LDA(At, 0, 1); PG8_STAGE(PG8_SB(0, 0), b2, voffB); PG8_STAGE(PG8_SA(0, 0), a2, voffA);
            PG8_WAIT_V(6); PG8_WAIT_L(0); PG8_BAR; PG8_MMA(1, 0, At, B0); PG8_BAR; PG8_SCHED;
            PG8_LDB(B0, 1, 0); PG8_SCHED; PG8_LDA(At, 1, 0); PG8_STAGE(PG8_SA(0, 1), a2 + hstep, voffA);
            PG8_WAIT_V(6); PG8_WAIT_L(0); PG8_BAR; PG8_MMA(0, 0, At, B0); PG8_BAR; PG8_SCHED;
            PG8_LDA(At, 1, 1); PG8_STAGE(PG8_SB(1, 0), b3, voffB); PG8_STAGE(PG8_SA(1, 0), a3, voffA);
            PG8_WAIT_V(6); PG8_WAIT_L(0); PG8_BAR; PG8_MMA(1, 0, At, B0); PG8_BAR; PG8_SCHED;
            } else if constexpr (SP2) {
            PG8_LDB(B0, 0, 0); PG8_LDB(B1, 0, 1); PG8_SCHED; PG8_LDA(At, 0, 0); PG8_STAGE(PG8_SA(1, 1), a1 + hstep, voffA);
            PG8_WAIT_V(8); PG8_WAIT_L(0); PG8_BAR; PG8_MMA(0, 0, At, B0); PG8_MMA(0, 1, At, B1); PG8_BAR; PG8_SCHED;
            PG8_LDA(At, 0, 1); PG8_STAGE(PG8_SB(0, 0), b2, voffB); PG8_STAGE(PG8_SB(0, 1), b2 + hstep, voffB); PG8_STAGE(PG8_SA(0, 0), a2, voffA);
            PG8_WAIT_V(8); PG8_WAIT_L(0); PG8_BAR; PG8_MMA(1, 0, At, B0); PG8_MMA(1, 1, At, B1); PG8_BAR; PG8_SCHED;
            PG8_LDB(B0, 1, 0); PG8_LDB(B1, 1, 1); PG8_SCHED; PG8_LDA(At, 1, 0); PG8_STAGE(PG8_SA(0, 1), a2 + hstep, voffA);
            PG8_WAIT_V(8); PG8_WAIT_L(0); PG8_BAR; PG8_MMA(0, 0, At, B0); PG8_MMA(0, 1, At, B1); PG8_BAR; PG8_SCHED;
            PG8_LDA(At, 1, 1); PG8_STAGE(PG8_SB(1, 0), b3, voffB); PG8_STAGE(PG8_SB(1, 1), b3 + hstep, voffB); PG8_STAGE(PG8_SA(1, 0), a3, voffA);
            PG8_WAIT_V(8); PG8_WAIT_L(0); PG8_BAR; PG8_MMA(1, 0, At, B0); PG8_MMA(1, 1, At, B1); PG8_BAR; PG8_SCHED;
            } else {
            PG8_LDB(B0, 0, 0); PG8_SCHED; PG8_LDA(At, 0, 0); PG8_STAGE(PG8_SA(1, 1), a1 + hstep, voffA);
            PG8_WAIT_L(8); PG8_BAR; PG8_WAIT_L(0); PG8_MMA(0, 0, At, B0); PG8_BAR; PG8_SCHED;
            PG8_LDB(B1, 0, 1); PG8_STAGE(PG8_SB(0, 0), b2, voffB);
            PG8_BAR; PG8_WAIT_L(0); PG8_MMA(0, 1, At, B1); PG8_BAR;
            PG8_LDA(At, 0, 1); PG8_STAGE(PG8_SA(0, 0), a2, voffA);
            PG8_BAR; PG8_WAIT_L(0); PG8_MMA(1, 0, At, B0); PG8_BAR; PG8_SCHED;
            PG8_STAGE(PG8_SB(0, 1), b2 + hstep, voffB);
            PG8_WAIT_V(6); PG8_BAR; PG8_MMA(1, 1, At, B1); PG8_BAR;
            PG8_LDB(B0, 1, 0); PG8_SCHED; PG8_LDA(At, 1, 0); PG8_STAGE(PG8_SA(0, 1), a2 + hstep, voffA);
            PG8_WAIT_L(8); PG8_BAR; PG8_WAIT_L(0); PG8_MMA(0, 0, At, B0); PG8_BAR; PG8_SCHED;
            PG8_LDB(B1, 1, 1); PG8_STAGE(PG8_SB(1, 0), b3, voffB);
            PG8_BAR; PG8_WAIT_L(0); PG8_MMA(0, 1, At, B1); PG8_BAR;
            PG8_LDA(At, 1, 1); PG8_STAGE(PG8_SA(1, 0), a3, voffA);
            PG8_BAR; PG8_WAIT_L(0); PG8_MMA(1, 0, At, B0); PG8_BAR; PG8_SCHED;
            PG8_STAGE(PG8_SB(1, 1), b3 + hstep, voffB);
            PG8_WAIT_V(6); PG8_BAR; PG8_MMA(1, 1, At, B1); PG8_BAR;
            }
        }
        if constexpr (ALIGN_EPI) { if (wr == 0) PG8_BAR; }
        E(acc, cur, wr, wc, fr, fq); S.done(cur);
        if (!has_next) break;
#pragma unroll
        for (int a = 0; a < 2; ++a)
#pragma unroll
            for (int b = 0; b < 2; ++b)
#pragma unroll
                for (int m = 0; m < 4; ++m)
#pragma unroll
                    for (int n = 0; n < 2; ++n) acc[a][b][m][n] = (f32x4){0.f, 0.f, 0.f, 0.f};
        cur = nxt; cA = nA; cB = nB; ++ui;
        if constexpr (ALIGN_EPI) { if (wr == 1) PG8_BAR; }
    }
    PG8_WAIT_V(0);
    if constexpr (!ALIGN_EPI) { if (wr == 0) PG8_BAR; }
    PG8_BAR;
#undef PG8_SA
#undef PG8_SB
#undef PG8_STAGE
#undef PG8_LDA
#undef PG8_LDB
#undef PG8_MMA
#undef PG8_WAIT_V
#undef PG8_WAIT_L
#undef PG8_BAR
#undef PG8_SCHED
}
}

#define XB_TMO      128
#define XB_XCNT(j)  (256  + 64 * (j))
#define XB_XSUB(j)  (1280 + 64 * (j))
#define XB_XGEN(j)  (2304 + 64 * (j))
#define XB_TOP      3328
#define XB_TOPGEN   3392
#define XCD_BAR_WORDS 3456
#define XB_SPIN_CAP (1u << 18)

__device__ __forceinline__ unsigned xb_ld(unsigned* p)              { return __hip_atomic_load(p, __ATOMIC_RELAXED, __HIP_MEMORY_SCOPE_AGENT); }
__device__ __forceinline__ unsigned xb_add(unsigned* p, unsigned v) { return __hip_atomic_fetch_add(p, v, __ATOMIC_RELAXED, __HIP_MEMORY_SCOPE_AGENT); }
__device__ __forceinline__ unsigned xb_xcc_id() { return (unsigned)__builtin_amdgcn_s_getreg((3 << 11) | 20) & 0xFu; }
#define XB_SPIN(cond, bar) do { unsigned _sp = 0; while (cond) { __builtin_amdgcn_s_sleep(1); \
    if ((++_sp & 255u) == 0u) { if (xb_ld(&(bar)[XB_TMO])) break; if (_sp > XB_SPIN_CAP) { atomicAdd(&(bar)[XB_TMO], 1u); break; } } } } while (0)

struct XcdBarrier { unsigned* bar; unsigned x; volatile LAS unsigned* st; };

__device__ __forceinline__ XcdBarrier xcd_barrier_post(unsigned* bar, volatile LAS unsigned* st) {
    XcdBarrier b; b.bar = bar; b.x = xb_xcc_id(); b.st = st;
    if (threadIdx.x == 0) (void)xb_add(&bar[XB_XCNT(b.x)], 1u);
    return b;
}
__device__ __forceinline__ void xcd_barrier_complete(unsigned* bar, unsigned x, unsigned& nloc, unsigned& nx) {
    const unsigned G = gridDim.x * gridDim.y * gridDim.z;
    unsigned sum, cnt, mine, sp = 0u;
    for (;;) {
        sum = 0u; cnt = 0u; mine = 0u;
#pragma unroll
        for (unsigned j = 0; j < 16; ++j) { const unsigned c = xb_ld(&bar[XB_XCNT(j)]); sum += c; cnt += (c > 0u) ? 1u : 0u; mine = (j == x) ? c : mine; }
        if (sum == G) break;
        __builtin_amdgcn_s_sleep(1);
        if ((++sp & 255u) == 0u) { if (xb_ld(&bar[XB_TMO])) break; if (sp > XB_SPIN_CAP) { atomicAdd(&bar[XB_TMO], 1u); break; } }
    }
    nloc = mine > 0u ? mine : 1u; nx = cnt > 0u ? cnt : 1u;
}
__device__ __forceinline__ void xcd_barrier(const XcdBarrier& b) {
    asm volatile("s_waitcnt vmcnt(0)" ::: "memory");
    __syncthreads();
    if (threadIdx.x == 0) {
        unsigned* bar = b.bar;
        __builtin_amdgcn_s_waitcnt(0);
        unsigned nloc = b.st[0], nx = b.st[1];
        if (nloc == 0u) { xcd_barrier_complete(bar, b.x, nloc, nx); b.st[0] = nloc; b.st[1] = nx; }
        const unsigned old = xb_add(&bar[XB_XSUB(b.x)], 1u);
        const unsigned gen = old / nloc;
        if (old + 1u == (gen + 1u) * nloc) {
            __builtin_amdgcn_fence(__ATOMIC_RELEASE, "agent");
            asm volatile("s_waitcnt vmcnt(0)" ::: "memory");
            const unsigned og = xb_add(&bar[XB_TOP], 1u);
            const unsigned tg = og / nx;
            if (og + 1u == (tg + 1u) * nx) xb_add(&bar[XB_TOPGEN], 1u);
            else XB_SPIN(xb_ld(&bar[XB_TOPGEN]) == tg, bar);
            __builtin_amdgcn_fence(__ATOMIC_ACQUIRE, "agent");
            xb_add(&bar[XB_XGEN(b.x)], 1u);
            asm volatile("s_waitcnt vmcnt(0)" ::: "memory");
        } else {
            XB_SPIN(xb_ld(&bar[XB_XGEN(b.x)]) == gen, bar);
            __builtin_amdgcn_fence(__ATOMIC_ACQUIRE, "agent");
            asm volatile("s_waitcnt vmcnt(0)" ::: "memory");
        }
    }
    __syncthreads();
}

constexpr int NWAVES = 8;
constexpr int LDS_BYTES = 163840;
constexpr int LDSCTL_OFF = LDS_BYTES - 512, MISC_OFF = LDSCTL_OFF + 320;
constexpr int NPHASE = 2 + 6 * NLAYER;

#define LDS_WAIT() asm volatile("s_waitcnt lgkmcnt(0)" ::: "memory")

struct Args { const float* in[20]; float* out; unsigned char* ws; int ph_lo, ph_hi, li, pad; };

#define CAS __attribute__((address_space(4)))
struct Frame {
    LAS unsigned char* lds;
    int tid, lane, wave, G, gw, NGW;
    const CAS unsigned char* ka;
    __device__ __forceinline__ const float* x() const { return *(const float* const CAS*)(ka + 0); }
    __device__ __forceinline__ const float* c() const { return *(const float* const CAS*)(ka + 8); }
    __device__ __forceinline__ const float* ctx() const { return *(const float* const CAS*)(ka + 16); }
    __device__ __forceinline__ const float* c_ctx() const { return *(const float* const CAS*)(ka + 24); }
    __device__ __forceinline__ const float* w_ada() const { return *(const float* const CAS*)(ka + 32); }
    __device__ __forceinline__ const float* b_ada() const { return *(const float* const CAS*)(ka + 40); }
    __device__ __forceinline__ const float* w_in() const { return *(const float* const CAS*)(ka + 48); }
    __device__ __forceinline__ const float* conv_w() const { return *(const float* const CAS*)(ka + 56); }
    __device__ __forceinline__ const float* sink() const { return *(const float* const CAS*)(ka + 64); }
    __device__ __forceinline__ const float* g_attn() const { return *(const float* const CAS*)(ka + 72); }
    __device__ __forceinline__ const float* g_conv() const { return *(const float* const CAS*)(ka + 80); }
    __device__ __forceinline__ const float* w_out() const { return *(const float* const CAS*)(ka + 88); }
    __device__ __forceinline__ const float* ln1_g() const { return *(const float* const CAS*)(ka + 96); }
    __device__ __forceinline__ const float* ln1_b() const { return *(const float* const CAS*)(ka + 104); }
    __device__ __forceinline__ const float* wq() const { return *(const float* const CAS*)(ka + 112); }
    __device__ __forceinline__ const float* keys() const { return *(const float* const CAS*)(ka + 120); }
    __device__ __forceinline__ const float* pu() const { return *(const float* const CAS*)(ka + 128); }
    __device__ __forceinline__ const float* pv() const { return *(const float* const CAS*)(ka + 136); }
    __device__ __forceinline__ const float* ln2_g() const { return *(const float* const CAS*)(ka + 144); }
    __device__ __forceinline__ const float* ln2_b() const { return *(const float* const CAS*)(ka + 152); }
    __device__ __forceinline__ float* out() const { return *(float* const CAS*)(ka + 160); }
    __device__ __forceinline__ unsigned char* ws() const { return *(unsigned char* const CAS*)(ka + 168); }
    __device__ __forceinline__ float* MODS() const { return (float*)(ws() + WS_MODS); }
    __device__ __forceinline__ float* ROPE() const { return (float*)(ws() + WS_ROPE); }
    __device__ __forceinline__ bf16_t* X() const { return (bf16_t*)(ws() + WS_X); }
    __device__ __forceinline__ bf16_t* SC() const { return (bf16_t*)(ws() + WS_SC); }
    __device__ __forceinline__ bf16_t* KBD() const { return (bf16_t*)(ws() + WS_KBD); }
    __device__ __forceinline__ bf16_t* WQR() const { return (bf16_t*)(ws() + WS_WQR); }
    __device__ __forceinline__ unsigned char* WINT() const { return ws() + WS_WINT; }
    __device__ __forceinline__ unsigned char* H8() const { return ws() + WS_H8; }
    __device__ __forceinline__ unsigned char* WOUTT() const { return ws() + WS_WOUTT; }
    __device__ __forceinline__ bf16_t* WEFFT() const { return (bf16_t*)(ws() + WS_WEFFT); }
    __device__ __forceinline__ bf16_t* H() const { return (bf16_t*)(ws() + WS_H); }
    __device__ __forceinline__ bf16_t* PROJ() const { return (bf16_t*)(ws() + WS_PROJ); }
    __device__ __forceinline__ unsigned char* MIX() const { return ws() + WS_MIX; }
    __device__ __forceinline__ unsigned char* UT() const { return (unsigned char*)(ws() + WS_UT); }
    __device__ __forceinline__ unsigned char* VT() const { return (unsigned char*)(ws() + WS_VT); }
    __device__ __forceinline__ float* US() const { return (float*)(ws() + WS_US); }
    __device__ __forceinline__ float* VS() const { return (float*)(ws() + WS_VS); }
};

__device__ __forceinline__ void frame_ids(Frame& F) {
    int tz = threadIdx.x; asm volatile("" : "+v"(tz));
    F.tid = tz; F.lane = tz & 63; F.wave = __builtin_amdgcn_readfirstlane(tz >> 6);
    F.gw = blockIdx.x * NWAVES + F.wave;
    const CAS unsigned char* k = (const CAS unsigned char*)__builtin_amdgcn_kernarg_segment_ptr(); asm volatile("" : "+s"(k)); F.ka = k;
}
template <int CTRL> __device__ __forceinline__ int dpp_i(int v) { return __builtin_amdgcn_update_dpp(0, v, CTRL, 0xf, 0xf, true); }
template <int CTRL> __device__ __forceinline__ float dpp_f(float v) { return __int_as_float(dpp_i<CTRL>(__float_as_int(v))); }
constexpr int DPP_XOR1 = 0xB1, DPP_XOR2 = 0x4E, DPP_HMIRROR = 0x141, DPP_ROR4 = 0x124, DPP_ROR8 = 0x128;
__device__ __forceinline__ float wave_sum_u(float v) {
    v += dpp_f<DPP_XOR1>(v); v += dpp_f<DPP_XOR2>(v); v += dpp_f<DPP_ROR4>(v); v += dpp_f<DPP_ROR8>(v);
    const float r0 = __int_as_float(__builtin_amdgcn_readlane(__float_as_int(v), 0)), r1 = __int_as_float(__builtin_amdgcn_readlane(__float_as_int(v), 16));
    const float r2 = __int_as_float(__builtin_amdgcn_readlane(__float_as_int(v), 32)), r3 = __int_as_float(__builtin_amdgcn_readlane(__float_as_int(v), 48));
    return (r0 + r1) + (r2 + r3);
}
__device__ __forceinline__ float wave_max_u(float v) {
    v = fmaxf(v, dpp_f<DPP_XOR1>(v)); v = fmaxf(v, dpp_f<DPP_XOR2>(v)); v = fmaxf(v, dpp_f<DPP_ROR4>(v)); v = fmaxf(v, dpp_f<DPP_ROR8>(v));
    const float r0 = __int_as_float(__builtin_amdgcn_readlane(__float_as_int(v), 0)), r1 = __int_as_float(__builtin_amdgcn_readlane(__float_as_int(v), 16));
    const float r2 = __int_as_float(__builtin_amdgcn_readlane(__float_as_int(v), 32)), r3 = __int_as_float(__builtin_amdgcn_readlane(__float_as_int(v), 48));
    return fmaxf(fmaxf(r0, r1), fmaxf(r2, r3));
}
__device__ __forceinline__ float xor32_f(float v, int lane) { return __int_as_float(__builtin_amdgcn_ds_bpermute((lane ^ 32) << 2, __float_as_int(v))); }
__device__ __forceinline__ float wave_sum(float v) { return wave_sum_u(v); }
__device__ __forceinline__ unsigned pk2(float lo, float hi) { return pg8::cvt_pk_bf16(lo, hi); }
__device__ __forceinline__ float bf_lo(unsigned u) { return __uint_as_float(u << 16); }
__device__ __forceinline__ float bf_hi(unsigned u) { return __uint_as_float(u & 0xffff0000u); }
__device__ __forceinline__ int modrow(int t) { return t < TL ? t / SEQ : 2; }

__device__ __forceinline__ void transpose_item(const float* W, int K, int N, bf16_t* WT, LAS float* scr, int item, int lane) {
    const int nblk = N / 32, kb = item / nblk, nb = item % nblk, k0 = 64 * kb, n0 = 32 * nb;
#pragma unroll 8
    for (int i = 0; i < 32; ++i) { const int kk = 2 * i + (lane >> 5); scr[kk * 33 + (lane & 31)] = W[(size_t)(k0 + kk) * N + n0 + (lane & 31)]; }
    LDS_WAIT(); asm volatile("" ::: "memory");
    const int c = lane & 7;
#pragma unroll
    for (int j = 0; j < 4; ++j) { const int n = (lane >> 3) + 8 * j; const LAS float* s = scr + (8 * c) * 33 + n;
        u32x4 o; o.x = pk2(s[0 * 33], s[1 * 33]); o.y = pk2(s[2 * 33], s[3 * 33]); o.z = pk2(s[4 * 33], s[5 * 33]); o.w = pk2(s[6 * 33], s[7 * 33]);
        *(u32x4*)(WT + (size_t)(n0 + n) * K + k0 + 8 * c) = o; }
    LDS_WAIT(); asm volatile("" ::: "memory");
}

__device__ __forceinline__ void transpose_item8(const float* W, int K, int N, unsigned char* WT, LAS float* scr, int item, int lane, float wscale) {
    const int nblk = N / 32, kb = item / nblk, nb = item % nblk, k0 = 64 * kb, n0 = 32 * nb;
#pragma unroll 8
    for (int i = 0; i < 32; ++i) { const int kk = 2 * i + (lane >> 5); scr[kk * 33 + (lane & 31)] = W[(size_t)(k0 + kk) * N + n0 + (lane & 31)]; }
    LDS_WAIT(); asm volatile("" ::: "memory");
    const int c = lane & 7;
#pragma unroll
    for (int j = 0; j < 4; ++j) { const int n = (lane >> 3) + 8 * j; const LAS float* s = scr + (8 * c) * 33 + n;
        u32x2 o; int t0 = __builtin_amdgcn_cvt_pk_fp8_f32(s[0 * 33] * wscale, s[1 * 33] * wscale, 0, false); t0 = __builtin_amdgcn_cvt_pk_fp8_f32(s[2 * 33] * wscale, s[3 * 33] * wscale, t0, true);
        int t1 = __builtin_amdgcn_cvt_pk_fp8_f32(s[4 * 33] * wscale, s[5 * 33] * wscale, 0, false); t1 = __builtin_amdgcn_cvt_pk_fp8_f32(s[6 * 33] * wscale, s[7 * 33] * wscale, t1, true);
        o.x = (unsigned)t0; o.y = (unsigned)t1;
        *(u32x2*)(WT + (size_t)(n0 + n) * K + k0 + 8 * c) = o; }
    LDS_WAIT(); asm volatile("" ::: "memory");
}
__device__ __forceinline__ void cvt_row_bf16(const float* src, bf16_t* dst, int lane) {
    const f32x4* s = (const f32x4*)src + lane; u32x2* d = (u32x2*)dst + lane;
    f32x4 v[8];
#pragma unroll
    for (int j = 0; j < 8; ++j) v[j] = __builtin_nontemporal_load(s + 64 * j);
#pragma unroll
    for (int j = 0; j < 8; ++j) { u32x2 o; o.x = pk2(v[j].x, v[j].y); o.y = pk2(v[j].z, v[j].w); d[64 * j] = o; }
}

struct RowF32 { f32x4 v[4][2]; };
__device__ __forceinline__ void row_load_nt(RowF32& R, const float* src, int lane) {
    const f32x4* s = (const f32x4*)src + 2 * lane;
#pragma unroll
    for (int j = 0; j < 4; ++j) { R.v[j][0] = __builtin_nontemporal_load(s + 128 * j); R.v[j][1] = __builtin_nontemporal_load(s + 128 * j + 1); }
}
template <int FMT>
__device__ __forceinline__ void cvt_row_lp(const RowF32& R, unsigned char* dst, float* inv, int lane) {
    constexpr float QMAX = FMT == 8 ? 224.f : 6.f;
    float am = 0.f;
#pragma unroll
    for (int j = 0; j < 4; ++j)
#pragma unroll
        for (int q = 0; q < 2; ++q) am = fmaxf(fmaxf(am, fmaxf(fabsf(R.v[j][q].x), fabsf(R.v[j][q].y))), fmaxf(fabsf(R.v[j][q].z), fabsf(R.v[j][q].w)));
    am = wave_max_u(am);
    const float sc = am > 0.f ? QMAX / am : 1.f;
#pragma unroll
    for (int j = 0; j < 4; ++j) {
        if constexpr (FMT == 8) {
            u32x2 w;
#pragma unroll
            for (int q = 0; q < 2; ++q) { int t = __builtin_amdgcn_cvt_pk_fp8_f32(R.v[j][q].x * sc, R.v[j][q].y * sc, 0, false); t = __builtin_amdgcn_cvt_pk_fp8_f32(R.v[j][q].z * sc, R.v[j][q].w * sc, t, true); w[q] = (unsigned)t; }
            *((u32x2*)dst + lane + 64 * j) = w;
        } else {
            unsigned w = 0u;
            w = __builtin_amdgcn_cvt_scalef32_pk_fp4_f32(w, R.v[j][0].x * sc, R.v[j][0].y * sc, 1.0f, 0);
            w = __builtin_amdgcn_cvt_scalef32_pk_fp4_f32(w, R.v[j][0].z * sc, R.v[j][0].w * sc, 1.0f, 1);
            w = __builtin_amdgcn_cvt_scalef32_pk_fp4_f32(w, R.v[j][1].x * sc, R.v[j][1].y * sc, 1.0f, 2);
            w = __builtin_amdgcn_cvt_scalef32_pk_fp4_f32(w, R.v[j][1].z * sc, R.v[j][1].w * sc, 1.0f, 3);
            *((unsigned*)dst + lane + 64 * j) = w;
        }
    }
    if (lane == 0) *inv = am > 0.f ? am * (1.f / QMAX) : 1.f;
}
template <int FMT> struct LpRow;
template <> struct LpRow<8> { u32x4 a, b;
    __device__ __forceinline__ void load(const unsigned char* rowp, int lane) { a = *(const u32x4*)(rowp + 32 * lane); b = *(const u32x4*)(rowp + 32 * lane + 16); }
    template <class Fn> __device__ __forceinline__ void each(Fn&& f) const {
#pragma unroll
        for (int w = 0; w < 4; ++w) { const f32x2 l0 = __builtin_amdgcn_cvt_pk_f32_fp8((int)a[w], false), h0 = __builtin_amdgcn_cvt_pk_f32_fp8((int)a[w], true);
            f(4 * w, l0.x, l0.y); f(4 * w + 2, h0.x, h0.y); }
#pragma unroll
        for (int w = 0; w < 4; ++w) { const f32x2 l0 = __builtin_amdgcn_cvt_pk_f32_fp8((int)b[w], false), h0 = __builtin_amdgcn_cvt_pk_f32_fp8((int)b[w], true);
            f(16 + 4 * w, l0.x, l0.y); f(16 + 4 * w + 2, h0.x, h0.y); }
    } };
template <> struct LpRow<4> { u32x4 a;
    __device__ __forceinline__ void load(const unsigned char* rowp, int lane) { a = *(const u32x4*)(rowp + 16 * lane); }
    template <class Fn> __device__ __forceinline__ void each(Fn&& f) const {
#pragma unroll
        for (int w = 0; w < 4; ++w) {
            const f32x2 d0 = __builtin_amdgcn_cvt_scalef32_pk_f32_fp4(a[w], 1.0f, 0), d1 = __builtin_amdgcn_cvt_scalef32_pk_f32_fp4(a[w], 1.0f, 1);
            const f32x2 d2 = __builtin_amdgcn_cvt_scalef32_pk_f32_fp4(a[w], 1.0f, 2), d3 = __builtin_amdgcn_cvt_scalef32_pk_f32_fp4(a[w], 1.0f, 3);
            f(8 * w, d0.x, d0.y); f(8 * w + 2, d1.x, d1.y); f(8 * w + 4, d2.x, d2.y); f(8 * w + 6, d3.x, d3.y); }
    }
    template <class Fn> __device__ __forceinline__ void each_bf(Fn&& f) const {
#pragma unroll
        for (int w = 0; w < 4; ++w) {
            f(4 * w, __builtin_amdgcn_cvt_scalef32_pk_bf16_fp4(a[w], 1.0f, 0)); f(4 * w + 1, __builtin_amdgcn_cvt_scalef32_pk_bf16_fp4(a[w], 1.0f, 1));
            f(4 * w + 2, __builtin_amdgcn_cvt_scalef32_pk_bf16_fp4(a[w], 1.0f, 2)); f(4 * w + 3, __builtin_amdgcn_cvt_scalef32_pk_bf16_fp4(a[w], 1.0f, 3)); }
    } };

__device__ __forceinline__ void row_stats(const f32x4 (&v)[8], float& mean, float& rstd) {
    float s = 0.f;
#pragma unroll
    for (int j = 0; j < 8; ++j) s += (v[j].x + v[j].y) + (v[j].z + v[j].w);
    mean = wave_sum(s) * (1.f / D);
    float s2 = 0.f;
#pragma unroll
    for (int j = 0; j < 8; ++j) { const f32x4 d = v[j] - mean; s2 += (d.x * d.x + d.y * d.y) + (d.z * d.z + d.w * d.w); }
    rstd = 1.f / sqrtf(wave_sum(s2) * (1.f / D) + LN_EPS);
}
__device__ __forceinline__ void modulate_store(const f32x4 (&v)[8], const float* shift, const float* scale, bf16_t* dst, int lane) {
    float mean, rstd; row_stats(v, mean, rstd);
    u32x2* d = (u32x2*)dst + lane;
#pragma unroll
    for (int j = 0; j < 8; ++j) { const f32x4 sc = *((const f32x4*)scale + lane + 64 * j), sh = *((const f32x4*)shift + lane + 64 * j);
        const f32x4 y = (v[j] - mean) * rstd * (sc + 1.f) + sh;
        u32x2 o; o.x = pk2(y.x, y.y); o.y = pk2(y.z, y.w); d[64 * j] = o; }
}

__device__ __forceinline__ void convert_tables(Frame& F, int row0, int row1, int w0, int wstride) {
    RowF32 ru, rv, nu, nv;
    int row = row0 + w0;
    if (row < row1) { row_load_nt(ru, F.pu() + (size_t)row * D, F.lane); row_load_nt(rv, F.pv() + (size_t)row * D, F.lane); }
    while (row < row1) {
        const int nrow = row + wstride;
        if (nrow < row1) { row_load_nt(nu, F.pu() + (size_t)nrow * D, F.lane); row_load_nt(nv, F.pv() + (size_t)nrow * D, F.lane); }
        cvt_row_lp<U_FMT>(ru, F.UT() + (size_t)row * UROW, F.US() + 2 * (size_t)row, F.lane);
        cvt_row_lp<V_FMT>(rv, F.VT() + (size_t)row * VROW, F.US() + 2 * (size_t)row + 1, F.lane);
        ru = nu; rv = nv; row = nrow;
    }
}
__device__ __forceinline__ void convert_in_tail(Frame& F, int layer, int nunits, int part) {
    if (layer + 1 >= NLAYER) return;
    const int G = F.G, rounds = (nunits + G - 1) / G, nlast = nunits - (rounds - 1) * G;
    const int c = (int)blockIdx.x;
    int nshort = G - nlast, sidx = c - nlast;
    if (nshort <= 0) { nshort = G; sidx = c; }
    else if (sidx < 0) return;
    const int r0 = (layer + 1) * NEXP + part * (NEXP / 2);
    convert_tables(F, r0, r0 + NEXP / 2, sidx * NWAVES + F.wave, nshort * NWAVES);
}
__device__ __forceinline__ void p0a_prologue(Frame& F) {
    LAS float* condL = (LAS float*)F.lds;
    LAS float* red = (LAS float*)(F.lds + 24576);
    for (int i = F.tid; i < 3 * D; i += NWAVES * 64) { const int r = i / D, k = i % D; const float v = r < 2 ? F.c()[r * D + k] : F.c_ctx()[k]; condL[i] = v / (1.f + __expf(-v)); }
    __syncthreads();
    for (int item = blockIdx.x; item < 384; item += F.G) {
        const int l = item / 96, n0 = (item % 96) * 128;
        const float* wp = F.w_ada() + ((size_t)l * D + F.wave * 256) * 12288 + n0 + 2 * F.lane;
        f32x2 a0 = {0.f, 0.f}, a1 = {0.f, 0.f}, a2 = {0.f, 0.f};
#pragma unroll 8
        for (int k = 0; k < 256; ++k) { const f32x2 w = __builtin_nontemporal_load((const f32x2*)(wp + (size_t)k * 12288)); const int kk = F.wave * 256 + k;
            a0 += w * condL[kk]; a1 += w * condL[D + kk]; a2 += w * condL[2 * D + kk]; }
        LAS float* rp = red + F.wave * 384 + 2 * F.lane;
        rp[0] = a0.x; rp[1] = a0.y; rp[128] = a1.x; rp[129] = a1.y; rp[256] = a2.x; rp[257] = a2.y;
        __syncthreads();
        if (F.tid < 384) { const int r = F.tid / 128, n = F.tid % 128; float s = 0.f;
#pragma unroll
            for (int w = 0; w < 8; ++w) s += red[w * 384 + r * 128 + n];
            F.MODS()[((size_t)l * 3 + r) * 12288 + n0 + n] = s + F.b_ada()[(size_t)l * 12288 + n0 + n]; }
        __syncthreads();
    }
    LAS float* scr = (LAS float*)(F.lds + 40960 + F.wave * 8448);
    constexpr int I_IN = (D / 64) * (INC / 32), I_OUT = (D / 64) * (D / 32);
    for (int it = F.gw; it < NLAYER * (I_IN + I_OUT); it += F.NGW) {
        const int l = it / (I_IN + I_OUT); int r = it % (I_IN + I_OUT);
        if (r < I_IN) transpose_item8(F.w_in() + (size_t)l * D * INC, D, INC, F.WINT() + (size_t)l * INC * D, scr, r, F.lane, WIN_SCALE);
        else transpose_item8(F.w_out() + (size_t)l * D * D, D, D, F.WOUTT() + (size_t)l * D * D, scr, r - I_IN, F.lane, WOUT_SCALE);
    }
    for (int row = F.gw; row < NLAYER * D; row += F.NGW) {
        const int l = row / D, c = row % D; const f32x4* s = (const f32x4*)(F.wq() + (size_t)row * D) + F.lane;
#pragma unroll
        for (int j = 0; j < 8; ++j) { const f32x4 v = s[64 * j]; u32x2 o; o.x = pk2(v.x, v.y); o.y = pk2(v.z, v.w);
            *((u32x2*)(F.WQR() + ((size_t)(l * 8 + j) * D + c) * 256) + F.lane) = o; }
    }
    for (int row = F.gw; row < 32 * 256; row += F.NGW) {
        const int lh = row >> 8, pk = row & 255, p = pk >> 7;
        u32x2 o = {0u, 0u};
        if ((F.lane >> 5) == p) { const f32x4 v = *((const f32x4*)(F.keys() + ((size_t)lh * 256 + pk) * 128) + (F.lane & 31)); o.x = pk2(v.x, v.y); o.y = pk2(v.z, v.w); }
        *((u32x2*)(F.KBD() + (size_t)row * 256) + F.lane) = o;
    }
    convert_tables(F, 0, NEXP, F.gw, F.NGW);
    for (int i = blockIdx.x * (NWAVES * 64) + F.tid; i < 192 * 32; i += F.G * NWAVES * 64) {
        const int idx = i >> 5, f = i & 31; const float pos = (float)(idx < 128 ? idx : idx - 128);
        const float inv = powf(10000.f, -(float)(2 * f) / 64.f); const float ang = pos * inv;
        F.ROPE()[2 * i] = cosf(ang); F.ROPE()[2 * i + 1] = sinf(ang);
    }
}

__device__ __forceinline__ void p0b_mod0(Frame& F) {
    __syncthreads();
#pragma unroll 1
    for (int v = 0; v < 6; ++v)
        *(LAS f32x4*)(F.lds + v * 8192 + F.tid * 16) = *(const f32x4*)(F.MODS() + (size_t)(v % 3) * 12288 + (v < 3 ? 0 : D) + 4 * F.tid);
    __syncthreads();
    for (int t = F.gw; t < TT; t += F.NGW) {
        const float* src = t < TL ? F.x() + (size_t)t * D : F.ctx() + (size_t)(t - TL) * D;
        f32x4 v[8];
#pragma unroll
        for (int j = 0; j < 8; ++j) v[j] = *((const f32x4*)src + F.lane + 64 * j);
        const int mr = modrow(t);
        float mean, rstd; row_stats(v, mean, rstd);
        unsigned* d = (unsigned*)(F.H8() + (size_t)t * D) + F.lane;
#pragma unroll
        for (int j = 0; j < 8; ++j) { const f32x4 sh = *(const LAS f32x4*)(F.lds + mr * 8192 + (64 * j + F.lane) * 16), sc = *(const LAS f32x4*)(F.lds + (3 + mr) * 8192 + (64 * j + F.lane) * 16);
            const f32x4 y = (v[j] - mean) * rstd * (sc + 1.f) + sh;
            int o = __builtin_amdgcn_cvt_pk_fp8_f32(y.x, y.y, 0, false); o = __builtin_amdgcn_cvt_pk_fp8_f32(y.z, y.w, o, true); d[64 * j] = (unsigned)o; }
    }
}

constexpr int ROPE_LDS = 98304;
constexpr int CONV_LDS = 81920;
constexpr int KP = 272, VP = 320, KS_BYTES = 64 * KP, VS_BYTES = 64 * VP;
struct KVRegs { u32x4 k1, k2, v1, v2; f32x4 cs[4]; };

__device__ __forceinline__ void attn_load_tile(Frame& F, KVRegs& R, int ti, int b, int n, int g) {
    const int key = F.tid >> 3, c8 = F.tid & 7;
    int row, pos = 0;
    if (ti < 6) { pos = (n - 1) * 128 + 64 * ti + key; row = b * SEQ + pos; } else row = TL + b * CTXL + 64 * (ti - 6) + key;
    const bf16_t* base = F.PROJ() + (size_t)row * INC;
    const int d1 = (c8 >> 2) * 64 + (c8 & 3) * 8;
    R.k1 = *(const u32x4*)(base + OFF_K + g * 128 + d1); R.k2 = *(const u32x4*)(base + OFF_K + g * 128 + d1 + 32);
    R.v1 = *(const u32x4*)(base + OFF_V + g * 128 + 8 * c8); R.v2 = *(const u32x4*)(base + OFF_V + g * 128 + 64 + 8 * c8);
    if (ti < 6) { const int tidx = (c8 >> 2) ? 128 + (pos & 63) : (pos >> 6); const LAS f32x4* cp = (const LAS f32x4*)(F.lds + ROPE_LDS + (tidx * 32 + (c8 & 3) * 8) * 8);
#pragma unroll
        for (int m = 0; m < 4; ++m) R.cs[m] = cp[m]; }
}
__device__ __forceinline__ void rope8(u32x4& a, u32x4& bq, const f32x4 (&cs)[4], float scale) {
    u32x4 oa, ob;
#pragma unroll
    for (int w = 0; w < 4; ++w) {
        const float x1l = bf_lo(a[w]), x1h = bf_hi(a[w]), x2l = bf_lo(bq[w]), x2h = bf_hi(bq[w]);
        const float cl = cs[w].x, sl = cs[w].y, ch = cs[w].z, sh = cs[w].w;
        oa[w] = pk2((x1l * cl - x2l * sl) * scale, (x1h * ch - x2h * sh) * scale);
        ob[w] = pk2((x2l * cl + x1l * sl) * scale, (x2h * ch + x1h * sh) * scale);
    }
    a = oa; bq = ob;
}
__device__ __forceinline__ void attn_store_tile(Frame& F, KVRegs& R, int ti, int buf) {
    const int key = F.tid >> 3, c8 = F.tid & 7;
    if (ti < 6) rope8(R.k1, R.k2, R.cs, 1.f);
    const int d1 = (c8 >> 2) * 64 + (c8 & 3) * 8;
    LAS unsigned char* kp = F.lds + buf * KS_BYTES + key * KP;
    *(LAS u32x4*)(kp + d1 * 2) = R.k1; *(LAS u32x4*)(kp + (d1 + 32) * 2) = R.k2;
    LAS unsigned char* vp = F.lds + 2 * KS_BYTES + buf * VS_BYTES + key * VP;
    *(LAS u32x4*)(vp + 16 * c8) = R.v1; *(LAS u32x4*)(vp + 128 + 16 * c8) = R.v2;
}

#define MFMA32(a, b, c) __builtin_amdgcn_mfma_f32_32x32x16_bf16((a), (b), (c), 0, 0, 0)

__device__ __forceinline__ void attn_unit(Frame& F, int layer, int u) {
    const bool latent = u < 512;
    int b, n, g, hp;
    if (latent) { hp = u & 1; g = (u >> 1) & 1; n = (u >> 2) & 63; b = u >> 8; }
    else { const int v = u - 512; hp = v & 1; g = (v >> 1) & 1; n = (v >> 2) & 1; b = v >> 3; }
    const int lane = F.lane, r = lane & 31, h = lane >> 5, wave = F.wave;
    const int head = g * 4 + hp * 2 + (wave >> 2), qb = wave & 3;
    const int tq = latent ? b * SEQ + n * 128 + 32 * qb + r : TL + b * CTXL + n * 128 + 32 * qb + r;
    bf16x8 qf[8];
    {
        u32x4 raw[8];
        const bf16_t* qp = F.PROJ() + (size_t)tq * INC + OFF_Q + head * 128 + 8 * h;
#pragma unroll
        for (int ks = 0; ks < 8; ++ks) raw[ks] = *(const u32x4*)(qp + 16 * ks);
        if (latent) {
            const int pos = n * 128 + 32 * qb + r;
#pragma unroll
            for (int half = 0; half < 2; ++half) {
                const int tidx = half ? 128 + (pos & 63) : (pos >> 6);
#pragma unroll
                for (int kk = 0; kk < 2; ++kk) {
                    const LAS f32x4* cp = (const LAS f32x4*)(F.lds + ROPE_LDS + (tidx * 32 + 16 * kk + 8 * h) * 8);
                    f32x4 cs[4];
#pragma unroll
                    for (int m = 0; m < 4; ++m) cs[m] = cp[m];
                    rope8(raw[4 * half + kk], raw[4 * half + kk + 2], cs, QSCALE);
                }
            }
        } else {
#pragma unroll
            for (int ks = 0; ks < 8; ++ks)
#pragma unroll
                for (int w = 0; w < 4; ++w) raw[ks][w] = pk2(bf_lo(raw[ks][w]) * QSCALE, bf_hi(raw[ks][w]) * QSCALE);
        }
#pragma unroll
        for (int ks = 0; ks < 8; ++ks) qf[ks] = __builtin_bit_cast(bf16x8, raw[ks]);
    }
    int tlo = 6, nw = 0;
    if (latent) { tlo = (n == 0) ? 2 : 0; const int thi = (n == 63) ? 3 : 5; nw = thi - tlo + 1; }
    const int ntiles = nw + 4;
    f32x16 o[4];
#pragma unroll
    for (int db = 0; db < 4; ++db)
#pragma unroll
        for (int i = 0; i < 16; ++i) o[db][i] = 0.f;
    float m_run = F.sink()[layer * 8 + head] * LOG2E;
    float lsum = h == 0 ? 1.f : 0.f;
    const int iq = 32 * qb + r;
    KVRegs R;
    __syncthreads();
    attn_load_tile(F, R, nw > 0 ? tlo : 6, b, n, g);
    attn_store_tile(F, R, nw > 0 ? tlo : 6, 0);
    __syncthreads();
    const int i16 = lane & 15, tq4 = i16 >> 2, tp = i16 & 3, blk = (lane >> 4) & 1;
    for (int j = 0; j < ntiles; ++j) {
        const int ti = j < nw ? tlo + j : 6 + (j - nw);
        const int buf = j & 1;
        const bool more = j + 1 < ntiles;
        const int tin = (j + 1) < nw ? tlo + j + 1 : 6 + (j + 1 - nw);
        if (more) attn_load_tile(F, R, tin, b, n, g);
        const bool part = ti >= 6 || (ti >= (qb >> 1) && ti <= (qb >> 1) + 4);
        if (part) {
            f32x16 s0, s1;
#pragma unroll
            for (int i = 0; i < 16; ++i) { s0[i] = 0.f; s1[i] = 0.f; }
            const LAS unsigned char* kb = F.lds + buf * KS_BYTES + r * KP + h * 16;
#pragma unroll
            for (int ks = 0; ks < 8; ++ks) {
                const bf16x8 a0 = *(const LAS bf16x8*)(kb + ks * 32), a1 = *(const LAS bf16x8*)(kb + 32 * KP + ks * 32);
                s0 = MFMA32(a0, qf[ks], s0); s1 = MFMA32(a1, qf[ks], s1);
            }
            float mx = -INFINITY;
            if (ti < 6 && (ti == (qb >> 1) || ti == (qb >> 1) + 4)) {
                const int jb = 64 * ti + 4 * h - iq;
#pragma unroll
                for (int i = 0; i < 16; ++i) { const int j0 = jb + (i & 3) + 8 * (i >> 2), j1 = j0 + 32;
                    s0[i] = (j0 >= 0 && j0 <= 256) ? s0[i] : -INFINITY; s1[i] = (j1 >= 0 && j1 <= 256) ? s1[i] : -INFINITY; }
            }
#pragma unroll
            for (int i = 0; i < 16; ++i) mx = fmaxf(mx, fmaxf(s0[i], s1[i]));
            mx = fmaxf(mx, xor32_f(mx, lane));
            if (__any(mx > m_run + 8.f)) {
                const float m_new = mx > m_run + 8.f ? mx : m_run, alpha = __builtin_amdgcn_exp2f(m_run - m_new);
                m_run = m_new; lsum *= alpha;
#pragma unroll
                for (int db = 0; db < 4; ++db)
#pragma unroll
                    for (int i = 0; i < 16; ++i) o[db][i] *= alpha;
            }
#pragma unroll
            for (int i = 0; i < 16; ++i) { s0[i] = __builtin_amdgcn_exp2f(s0[i] - m_run); s1[i] = __builtin_amdgcn_exp2f(s1[i] - m_run); lsum += s0[i] + s1[i]; }
            bf16x8 pf[2][2];
#pragma unroll
            for (int s2 = 0; s2 < 2; ++s2) {
                u32x4 p0, p1;
#pragma unroll
                for (int w = 0; w < 4; ++w) { p0[w] = pk2(s0[8 * s2 + 2 * w], s0[8 * s2 + 2 * w + 1]); p1[w] = pk2(s1[8 * s2 + 2 * w], s1[8 * s2 + 2 * w + 1]); }
                pf[0][s2] = __builtin_bit_cast(bf16x8, p0); pf[1][s2] = __builtin_bit_cast(bf16x8, p1);
            }
            const LAS unsigned char* vb = F.lds + 2 * KS_BYTES + buf * VS_BYTES + (4 * h + tq4) * VP + 32 * blk + 8 * tp;
#pragma unroll
            for (int db = 0; db < 4; ++db)
#pragma unroll
                for (int kb2 = 0; kb2 < 2; ++kb2)
#pragma unroll
                    for (int s2 = 0; s2 < 2; ++s2) {
                        const int off = (32 * kb2 + 16 * s2) * VP + db * 64;
                        const s16x4 lo = __builtin_amdgcn_ds_read_tr16_b64_v4i16((LAS s16x4*)(vb + off));
                        const s16x4 hi = __builtin_amdgcn_ds_read_tr16_b64_v4i16((LAS s16x4*)(vb + off + 8 * VP));
                        const bf16x8 av = __builtin_shufflevector(lo, hi, 0, 1, 2, 3, 4, 5, 6, 7);
                        o[db] = MFMA32(av, pf[kb2][s2], o[db]);
                    }
        }
        if (more) attn_store_tile(F, R, tin, buf ^ 1);
        __syncthreads();
    }
    const float lt = lsum + xor32_f(lsum, lane);
    const float inv = 1.f / lt;
    float ss = 0.f;
#pragma unroll
    for (int db = 0; db < 4; ++db)
#pragma unroll
        for (int i = 0; i < 16; ++i) { o[db][i] *= inv; ss += o[db][i] * o[db][i]; }
    ss += xor32_f(ss, lane);
    const float rn = 1.f / sqrtf(ss * (1.f / 128.f) + LN_EPS);
    unsigned char* op = F.MIX() + (size_t)tq * D + head * 128 + 4 * h;
    const float* gp = F.g_attn() + layer * 1024 + head * 128 + 4 * h;
#pragma unroll
    for (int db = 0; db < 4; ++db)
#pragma unroll
        for (int g4 = 0; g4 < 4; ++g4) {
            const f32x4 gv = *(const f32x4*)(gp + 32 * db + 8 * g4);
            int w = __builtin_amdgcn_cvt_pk_fp8_f32(o[db][4 * g4] * rn * gv.x, o[db][4 * g4 + 1] * rn * gv.y, 0, false);
            w = __builtin_amdgcn_cvt_pk_fp8_f32(o[db][4 * g4 + 2] * rn * gv.z, o[db][4 * g4 + 3] * rn * gv.w, w, true);
            *(unsigned*)(op + 32 * db + 8 * g4) = (unsigned)w;
        }
}

__device__ __forceinline__ void unpack8(const u32x4 v, float (&f)[8]) {
#pragma unroll
    for (int w = 0; w < 4; ++w) { f[2 * w] = bf_lo(v[w]); f[2 * w + 1] = bf_hi(v[w]); }
}
__device__ __forceinline__ void conv_row(Frame& F, int layer, int t) {
    bool first, last;
    if (t < TL) { const int pos = t & (SEQ - 1); first = pos == 0; last = pos == SEQ - 1; } else { const int pc = (t - TL) & (CTXL - 1); first = pc == 0; last = pc == CTXL - 1; }
    const bf16_t* p = F.PROJ() + (size_t)t * INC;
    const LAS unsigned char* cvc = F.lds + CONV_LDS + F.lane * 16;
#pragma unroll
    for (int jc = 0; jc < 2; ++jc) {
        const int c = 8 * F.lane + 512 * jc;
        float gb[8], a[8], bq[8], um[8], ut[8], up[8];
        unpack8(*(const u32x4*)(p + c), gb);
        unpack8(*(const u32x4*)(p + OFF_C + c), a); unpack8(*(const u32x4*)(p + OFF_X + c), bq);
#pragma unroll
        for (int e = 0; e < 8; ++e) ut[e] = a[e] * bq[e];
        if (!first) { unpack8(*(const u32x4*)(p - INC + OFF_C + c), a); unpack8(*(const u32x4*)(p - INC + OFF_X + c), bq);
#pragma unroll
            for (int e = 0; e < 8; ++e) um[e] = a[e] * bq[e]; }
        else {
#pragma unroll
            for (int e = 0; e < 8; ++e) um[e] = 0.f; }
        if (!last) { unpack8(*(const u32x4*)(p + INC + OFF_C + c), a); unpack8(*(const u32x4*)(p + INC + OFF_X + c), bq);
#pragma unroll
            for (int e = 0; e < 8; ++e) up[e] = a[e] * bq[e]; }
        else {
#pragma unroll
            for (int e = 0; e < 8; ++e) up[e] = 0.f; }
        float y[8], ss = 0.f;
#pragma unroll
        for (int q = 0; q < 2; ++q) { const f32x4 w0 = *(const LAS f32x4*)(cvc + (2 * jc + q) * 1024), w1 = *(const LAS f32x4*)(cvc + 4096 + (2 * jc + q) * 1024), w2 = *(const LAS f32x4*)(cvc + 8192 + (2 * jc + q) * 1024);
#pragma unroll
            for (int e = 0; e < 4; ++e) { const int i = 4 * q + e; y[i] = gb[i] * (w0[e] * um[i] + w1[e] * ut[i] + w2[e] * up[i]); ss += y[i] * y[i]; } }
        ss += dpp_f<DPP_XOR1>(ss); ss += dpp_f<DPP_XOR2>(ss); ss += dpp_f<DPP_ROR4>(ss); ss += dpp_f<DPP_ROR8>(ss);
        const float rn = 1.f / sqrtf(ss * (1.f / 128.f) + LN_EPS);
        u32x2 w;
#pragma unroll
        for (int q = 0; q < 2; ++q) { const f32x4 gcv = *(const LAS f32x4*)(cvc + 12288 + (2 * jc + q) * 1024);
            int t8 = __builtin_amdgcn_cvt_pk_fp8_f32(y[4 * q] * rn * gcv[0], y[4 * q + 1] * rn * gcv[1], 0, false); t8 = __builtin_amdgcn_cvt_pk_fp8_f32(y[4 * q + 2] * rn * gcv[2], y[4 * q + 3] * rn * gcv[3], t8, true); w[q] = (unsigned)t8; }
        *(u32x2*)(F.MIX() + (size_t)t * D + 1024 + c) = w;
    }
}

__device__ __forceinline__ void ln_phase(Frame& F, int layer, int rows) {
    const int lane = F.lane;
    const bf16_t* Y = F.PROJ();
    u32x4 w[4], wn[4], yw[4], yn[4];
    int t = F.gw;
    if (t < rows) {
#pragma unroll
        for (int j = 0; j < 4; ++j) { yw[j] = *(const u32x4*)(Y + (size_t)t * D + 8 * lane + 512 * j); if (layer > 0) w[j] = *(const u32x4*)(F.X() + (size_t)t * D + 8 * lane + 512 * j); }
    }
    {
        const int ch = F.tid, jj = ch >> 7, rem = ch & 127, ll = rem >> 1, qq = rem & 1;
        LAS unsigned char* dst = F.lds + ((2 * jj + qq) * 64 + ll) * 16;
        *(LAS f32x4*)(dst) = *(const f32x4*)(F.ln1_g() + layer * D + 4 * ch);
        *(LAS f32x4*)(dst + 8192) = *(const f32x4*)(F.ln1_b() + layer * D + 4 * ch);
#pragma unroll 1
        for (int v = 0; v < 9; ++v) { const int mrv = v % 3; const size_t off = ((size_t)layer * 3 + mrv) * 12288 + (v < 3 ? 3 * D : (v < 6 ? 4 * D : 2 * D));
            *(LAS f32x4*)(dst + (2 + v) * 8192) = *(const f32x4*)(F.MODS() + off + 4 * ch); }
    }
    __syncthreads();
    const LAS unsigned char* vc = F.lds + lane * 16;
    while (t < rows) {
        const int tn = t + F.NGW;
        if (tn < rows) {
#pragma unroll
            for (int j = 0; j < 4; ++j) { yn[j] = *(const u32x4*)(Y + (size_t)tn * D + 8 * lane + 512 * j); if (layer > 0) wn[j] = *(const u32x4*)(F.X() + (size_t)tn * D + 8 * lane + 512 * j); }
        }
        const int mrl = modrow(t);
        float v[32]; float s = 0.f;
#pragma unroll
        for (int j = 0; j < 4; ++j) {
            float xin[8], yv[8];
            unpack8(yw[j], yv);
            if (layer > 0) unpack8(w[j], xin);
            else { const float* xp = (t < TL ? F.x() + (size_t)t * D : F.ctx() + (size_t)(t - TL) * D) + 8 * lane + 512 * j; const f32x4 a0 = *(const f32x4*)xp, a1 = *(const f32x4*)(xp + 4);
                xin[0] = a0[0]; xin[1] = a0[1]; xin[2] = a0[2]; xin[3] = a0[3]; xin[4] = a1[0]; xin[5] = a1[1]; xin[6] = a1[2]; xin[7] = a1[3]; }
#pragma unroll
            for (int q = 0; q < 2; ++q) { const f32x4 ga = *(const LAS f32x4*)(vc + (8 + mrl) * 8192 + (2 * j + q) * 1024);
#pragma unroll
                for (int e = 0; e < 4; ++e) { const float r = DN_ALPHA * xin[4 * q + e] + ga[e] * yv[4 * q + e]; v[8 * j + 4 * q + e] = r; s += r; } } }
        const float mean = wave_sum(s) * (1.f / D);
        float s2 = 0.f;
#pragma unroll
        for (int i = 0; i < 32; ++i) { v[i] -= mean; s2 += v[i] * v[i]; }
        const float rstd = 1.f / sqrtf(wave_sum(s2) * (1.f / D) + LN_EPS);
        float s3 = 0.f;
#pragma unroll
        for (int j = 0; j < 4; ++j) { const int c = 8 * lane + 512 * j; u32x4 o;
#pragma unroll
            for (int q = 0; q < 2; ++q) { const f32x4 gg = *(const LAS f32x4*)(vc + (2 * j + q) * 1024), bb = *(const LAS f32x4*)(vc + 8192 + (2 * j + q) * 1024);
#pragma unroll
                for (int e = 0; e < 4; ++e) { const float y = v[8 * j + 4 * q + e] * rstd * gg[e] + bb[e]; v[8 * j + 4 * q + e] = y; s3 += y; }
                o[2 * q] = pk2(v[8 * j + 4 * q], v[8 * j + 4 * q + 1]); o[2 * q + 1] = pk2(v[8 * j + 4 * q + 2], v[8 * j + 4 * q + 3]); }
            *(u32x4*)(F.X() + (size_t)t * D + c) = o; }
        const float mean2 = wave_sum(s3) * (1.f / D);
        float s4 = 0.f;
#pragma unroll
        for (int i = 0; i < 32; ++i) { v[i] -= mean2; s4 += v[i] * v[i]; }
        const float rstd2 = 1.f / sqrtf(wave_sum(s4) * (1.f / D) + LN_EPS);
#pragma unroll
        for (int j = 0; j < 4; ++j) { const int c = 8 * lane + 512 * j; u32x4 o;
#pragma unroll
            for (int q = 0; q < 2; ++q) { const f32x4 sh = *(const LAS f32x4*)(vc + (2 + mrl) * 8192 + (2 * j + q) * 1024), sc = *(const LAS f32x4*)(vc + (5 + mrl) * 8192 + (2 * j + q) * 1024);
                const float y0 = v[8 * j + 4 * q] * rstd2 * (1.f + sc[0]) + sh[0], y1 = v[8 * j + 4 * q + 1] * rstd2 * (1.f + sc[1]) + sh[1];
                const float y2 = v[8 * j + 4 * q + 2] * rstd2 * (1.f + sc[2]) + sh[2], y3 = v[8 * j + 4 * q + 3] * rstd2 * (1.f + sc[3]) + sh[3];
                o[2 * q] = pk2(y0, y1); o[2 * q + 1] = pk2(y2, y3); }
            *(u32x4*)(F.H() + (size_t)t * D + c) = o; }
#pragma unroll
        for (int j = 0; j < 4; ++j) { w[j] = wn[j]; yw[j] = yn[j]; }
        t = tn;
    }
}

__device__ __forceinline__ unsigned ordkey(float f) { const unsigned u = __float_as_uint(f); return u ^ ((u >> 31) ? 0xFFFFFFFFu : 0x80000000u); }
__device__ __forceinline__ float gelu_erf(float a) { return 0.5f * a * (1.f + erff(a * 0.70710678118654752f)); }

__device__ __forceinline__ float unordkey(unsigned k) { return __uint_as_float(k ^ ((k >> 31) ? 0x80000000u : 0xFFFFFFFFu)); }
__device__ __forceinline__ float gelu_as(float v) {
    const float av = fabsf(v), t = __builtin_amdgcn_rcpf(av * 0.2316418882f + 1.0f);
    float q = t * 0.5307027145f + (-0.7265760135f); q = q * t + 0.7107068705f; q = q * t + (-0.142248368f); q = q * t + 0.127414796f; q = q * t;
    const float e = __builtin_amdgcn_exp2f((v * v) * (-0.72134752044f));
    const float m = v * (q * e);
    return v < 0.f ? m : v - m;
}

template <class O> struct QuadNet {
    typedef typename O::V V; typedef typename O::B B;
    template <bool ASC> static __device__ __forceinline__ void ce_reg(V& a, V& b) { const V lo = O::vmin(a, b), hi = O::vmax(a, b); a = ASC ? lo : hi; b = ASC ? hi : lo; }
    template <bool ASC> static __device__ __forceinline__ void ce_l1(V& x, B low1) { const V p = O::x1(x); const V mn = O::vmin(p, x), mx = O::vmax(p, x); x = ASC ? O::vsel(low1, mn, mx) : O::vsel(low1, mx, mn); }
    template <bool ASC> static __device__ __forceinline__ void ce_l2(V& x, B low2) { const V p = O::x2(x); const V mn = O::vmin(p, x), mx = O::vmax(p, x); x = ASC ? O::vsel(low2, mn, mx) : O::vsel(low2, mx, mn); }
    template <int NR> static __device__ __forceinline__ void sort_blocks(V (&R)[NR], B low1, B low2, B eq12) {
#pragma unroll
        for (int r = 0; r < NR; ++r) { const V p = O::x1(R[r]); const V mn = O::vmin(p, R[r]), mx = O::vmax(p, R[r]); R[r] = O::vsel(eq12, mn, mx); }
#pragma unroll
        for (int r = 0; r < NR; ++r) { if ((r & 1) == 0) ce_l2<true>(R[r], low2); else ce_l2<false>(R[r], low2); }
#pragma unroll
        for (int r = 0; r < NR; ++r) { if ((r & 1) == 0) ce_l1<true>(R[r], low1); else ce_l1<false>(R[r], low1); }
#pragma unroll
        for (int r = 0; r < NR; r += 2) { if ((r & 2) == 0) ce_reg<true>(R[r], R[r + 1]); else ce_reg<false>(R[r], R[r + 1]); }
#pragma unroll
        for (int r = 0; r < NR; ++r) { if ((r & 2) == 0) ce_l2<true>(R[r], low2); else ce_l2<false>(R[r], low2); }
#pragma unroll
        for (int r = 0; r < NR; ++r) { if ((r & 2) == 0) ce_l1<true>(R[r], low1); else ce_l1<false>(R[r], low1); }
#pragma unroll
        for (int r = 0; r < NR; ++r) { if ((r & 2) == 0) { if ((r & 4) == 0) ce_reg<true>(R[r], R[r + 2]); else ce_reg<false>(R[r], R[r + 2]); } }
#pragma unroll
        for (int r = 0; r < NR; r += 2) { if ((r & 4) == 0) ce_reg<true>(R[r], R[r + 1]); else ce_reg<false>(R[r], R[r + 1]); }
#pragma unroll
        for (int r = 0; r < NR; ++r) { if ((r & 4) == 0) ce_l2<true>(R[r], low2); else ce_l2<false>(R[r], low2); }
#pragma unroll
        for (int r = 0; r < NR; ++r) { if ((r & 4) == 0) ce_l1<true>(R[r], low1); else ce_l1<false>(R[r], low1); }
    }
    template <int NR> static __device__ __forceinline__ void halve_merge(const V (&R)[NR], V (&Q)[NR / 2], B low1, B low2) {
#pragma unroll
        for (int m = 0; m < NR / 8; ++m)
#pragma unroll
            for (int i = 0; i < 4; ++i) Q[4 * m + i] = O::vmax(R[8 * m + i], R[8 * m + 4 + i]);
#pragma unroll
        for (int r = 0; r < NR / 2; ++r) { if ((r & 2) == 0) { if ((r & 4) == 0) ce_reg<false>(Q[r], Q[r + 2]); else ce_reg<true>(Q[r], Q[r + 2]); } }
#pragma unroll
        for (int r = 0; r < NR / 2; r += 2) { if ((r & 4) == 0) ce_reg<false>(Q[r], Q[r + 1]); else ce_reg<true>(Q[r], Q[r + 1]); }
#pragma unroll
        for (int r = 0; r < NR / 2; ++r) { if ((r & 4) == 0) ce_l2<false>(Q[r], low2); else ce_l2<true>(Q[r], low2); }
#pragma unroll
        for (int r = 0; r < NR / 2; ++r) { if ((r & 4) == 0) ce_l1<false>(Q[r], low1); else ce_l1<true>(Q[r], low1); }
    }
    static __device__ __forceinline__ void top16_of_128(V (&R)[32], V (&T)[4], B low1, B low2, B eq12) {
        sort_blocks<32>(R, low1, low2, eq12);
        V A[16]; halve_merge<32>(R, A, low1, low2);
        V Bq[8]; halve_merge<16>(A, Bq, low1, low2);
        halve_merge<8>(Bq, T, low1, low2);
    }
    static __device__ __forceinline__ void top16_of_64(V (&R)[16], V (&T)[4], B low1, B low2, B eq12) {
        sort_blocks<16>(R, low1, low2, eq12);
        V A[8]; halve_merge<16>(R, A, low1, low2);
        halve_merge<8>(A, T, low1, low2);
    }
};

struct DevOps {
    typedef unsigned V; typedef bool B;
    static __device__ __forceinline__ V vmin(V a, V b) { return a < b ? a : b; }
    static __device__ __forceinline__ V vmax(V a, V b) { return a > b ? a : b; }
    static __device__ __forceinline__ V vsel(B m, V a, V b) { return m ? a : b; }
    static __device__ __forceinline__ V x1(V a) { return (V)dpp_i<DPP_XOR1>((int)a); }
    static __device__ __forceinline__ V x2(V a) { return (V)dpp_i<DPP_XOR2>((int)a); }
};
__device__ __forceinline__ void stair_ab(int c, int& a, int& b) {
    if (c < 16) { a = 0; b = c; } else if (c < 24) { a = 1; b = c - 16; } else if (c < 28) { a = 2; b = c - 24; } else if (c < 32) { a = 3; b = c - 28; }
    else if (c < 36) { a = 4; b = c - 32; } else if (c < 40) { a = 5 + ((c - 36) >> 1); b = (c - 36) & 1; } else if (c < 44) { a = 7 + ((c - 40) >> 1); b = (c - 40) & 1; }
    else if (c < 48) { a = 9 + (c - 44); b = 0; } else if (c < 51) { a = 13 + (c - 48); b = 0; } else { a = 2; b = 4; }
}
constexpr int PE_WS = 5120, PE_TAB = 8 * PE_WS;
constexpr int PE_VEC = PE_TAB + 512;
static_assert(PE_VEC + 11 * 8192 <= LDSCTL_OFF, "PE vector cache");
__device__ __forceinline__ void peer_topk(Frame& F, LAS unsigned char* ws, int t) {
    const int lane = F.lane, sub = lane & 3;
    const bool low1 = (sub & 1) == 0, low2 = (sub & 2) == 0, eq12 = low1 == low2;
    LAS unsigned* S1K = (LAS unsigned*)ws; LAS int* EL = (LAS int*)(ws + 3328); LAS float* GL = (LAS float*)(ws + 3840);
    const LAS unsigned short* TAB = (const LAS unsigned short*)(F.lds + PE_TAB);
    {
        const int L = lane >> 2;
        const bf16_t* sp = F.SC() + (size_t)t * D + L * 128 + sub * 32;
        unsigned R[32];
#pragma unroll
        for (int q = 0; q < 4; ++q) { const u32x4 v = *(const u32x4*)(sp + 8 * q);
#pragma unroll
            for (int e = 0; e < 4; ++e) {
                R[8 * q + 2 * e] = (ordkey(bf_lo(v[e])) & ~127u) | (unsigned)(127 - (32 * sub + 8 * q + 2 * e));
                R[8 * q + 2 * e + 1] = (ordkey(bf_hi(v[e])) & ~127u) | (unsigned)(127 - (32 * sub + 8 * q + 2 * e + 1)); } }
        unsigned T[4];
        QuadNet<DevOps>::top16_of_128(R, T, low1, low2, eq12);
#pragma unroll
        for (int r = 0; r < 4; ++r) S1K[L * 16 + 4 * r + sub] = T[r];
    }
    LDS_WAIT(); __builtin_amdgcn_wave_barrier();
    {
        const int hd = (lane >> 2) & 7;
        const LAS unsigned char* la = (const LAS unsigned char*)(S1K + (2 * hd) * 16); const LAS unsigned char* lb = (const LAS unsigned char*)(S1K + (2 * hd + 1) * 16);
        unsigned C[16];
#pragma unroll
        for (int r = 0; r < 13; ++r) { const unsigned ab = TAB[4 * r + sub];
            const unsigned ka = *(const LAS unsigned*)(la + (ab & 255u)), kb = *(const LAS unsigned*)(lb + (ab >> 8));
            const float sum = unordkey(ka & ~127u) + unordkey(kb & ~127u);
            C[r] = (ordkey(sum) & ~63u) | (unsigned)(63 - (4 * r + sub)); }
        C[13] = 0u; C[14] = 0u; C[15] = 0u;
        unsigned W[4];
        QuadNet<DevOps>::top16_of_64(C, W, low1, low2, eq12);
        float sv[4]; int ex[4];
#pragma unroll
        for (int r = 0; r < 4; ++r) { const unsigned ab = TAB[63 - (W[r] & 63u)];
            const unsigned ka = *(const LAS unsigned*)(la + (ab & 255u)), kb = *(const LAS unsigned*)(lb + (ab >> 8));
            ex[r] = (int)(127u - (ka & 127u)) * 128 + (int)(127u - (kb & 127u)); sv[r] = unordkey(W[r] & ~63u); }
        const float mx = dpp_f<0x00>(sv[0]);
        float e4[4], es = 0.f;
#pragma unroll
        for (int r = 0; r < 4; ++r) { e4[r] = __expf(sv[r] - mx); es += e4[r]; }
        es += dpp_f<DPP_XOR1>(es); es += dpp_f<DPP_XOR2>(es);
        const float rd = 1.f / es;
#pragma unroll
        for (int r = 0; r < 4; ++r) { GL[hd * 16 + 4 * r + sub] = e4[r] * rd; EL[hd * 16 + 4 * r + sub] = ex[r]; }
    }
    LDS_WAIT(); __builtin_amdgcn_wave_barrier();
}

#ifndef PROBE_PHASE
#define PROBE_PHASE -1
#endif
#ifndef PROBE_MULT
#define PROBE_MULT 1
#endif
constexpr int EB = 4;
constexpr int CW_TICKET = 20480;

struct GBuf { LpRow<U_FMT> u[EB]; LpRow<V_FMT> v[EB]; };
__device__ __forceinline__ void gather_issue(GBuf& B, const LAS int* EL, int i0, const unsigned char* UTl, const unsigned char* VTl, int lane) {
#pragma unroll
    for (int q = 0; q < EB; ++q) {
        const int ex = __builtin_amdgcn_readfirstlane(EL[i0 + q]);
        B.u[q].load(UTl + (size_t)ex * UROW, lane); B.v[q].load(VTl + (size_t)ex * VROW, lane);
    }
}
__device__ __forceinline__ void gather_compute(const GBuf& B, const LAS int* EL, const LAS float* GL, int i0, const float* USl, const float* VSl, const unsigned (&hv)[16], f32x2 (&acc)[16]) {
    float dot[EB], su[EB], sv[EB], g[EB];
#pragma unroll
    for (int q = 0; q < EB; ++q) { const int ex = __builtin_amdgcn_readfirstlane(EL[i0 + q]); { const f32x2 s2 = *(const f32x2*)(USl + 2 * ex); su[q] = s2.x; sv[q] = s2.y; }
        g[q] = __uint_as_float(__builtin_amdgcn_readfirstlane(__float_as_uint(GL[i0 + q]))); }
#pragma unroll
    for (int q = 0; q < EB; ++q) { float s0 = 0.f, s1 = 0.f;
        B.u[q].each_bf([&](int i, bf16x2_t x) { if (i & 1) s1 = __builtin_amdgcn_fdot2_f32_bf16(x, __builtin_bit_cast(bf16x2_t, hv[i]), s1, false); else s0 = __builtin_amdgcn_fdot2_f32_bf16(x, __builtin_bit_cast(bf16x2_t, hv[i]), s0, false); });
        dot[q] = s0 + s1; __builtin_amdgcn_sched_barrier(0); }
#pragma unroll
    for (int q = 0; q < EB; ++q) dot[q] = wave_sum_u(dot[q]);
#pragma unroll
    for (int q = 0; q < EB; ++q) { const float cf = g[q] * gelu_as(dot[q] * su[q]) * sv[q]; const f32x2 c2 = {cf, cf};
        B.v[q].each([&](int i, float x0, float x1) { const f32x2 x = {x0, x1}; acc[i >> 1] = __builtin_elementwise_fma(x, c2, acc[i >> 1]); }); __builtin_amdgcn_sched_barrier(0); }
}

__device__ __forceinline__ void peer_phase(Frame& F, int layer, int rows, unsigned* ctl, unsigned long long& pr_acc) {
    unsigned long long pt0 = 0ull;
#define SUB_BEGIN(ty) do { if (PROBE_PHASE == (ty)) pt0 = __builtin_amdgcn_s_memrealtime(); } while (0)
#define SUB_END(ty) do { if (PROBE_PHASE == (ty)) pr_acc += __builtin_amdgcn_s_memrealtime() - pt0; } while (0)
    if (F.tid < 64) { int a = 0, b = 0; stair_ab(F.tid < 52 ? F.tid : 0, a, b); *(LAS unsigned short*)(F.lds + PE_TAB + 2 * F.tid) = (unsigned short)((4 * a) | ((4 * b) << 8)); }
    {
        const int ch = F.tid, ll = ch >> 3, q = ch & 7;
        LAS unsigned char* dst = F.lds + PE_VEC + (q * 64 + ll) * 16;
        const int nl = layer < NLAYER - 1 ? layer + 1 : layer;
#pragma unroll 1
        for (int v = 0; v < 9; ++v) {
            const int g3 = v / 3, mrv = v - 3 * g3;
            const size_t off = ((size_t)(g3 == 0 ? layer : nl) * 3 + mrv) * 12288 + (g3 == 0 ? 5 * D : (g3 == 1 ? 0 : D));
            *(LAS f32x4*)(dst + v * 8192) = *(const f32x4*)(F.MODS() + off + 4 * ch);
        }
        *(LAS f32x4*)(dst + 9 * 8192) = *(const f32x4*)(F.ln2_g() + layer * D + 4 * ch);
        *(LAS f32x4*)(dst + 10 * 8192) = *(const f32x4*)(F.ln2_b() + layer * D + 4 * ch);
    }
    __syncthreads();
    LAS unsigned char* ws = F.lds + F.wave * PE_WS;
    LAS int* EL = (LAS int*)(ws + 3328); LAS float* GL = (LAS float*)(ws + 3840);
    const int lane = F.lane;
    const LAS unsigned char* vcache = F.lds + PE_VEC + lane * 16;
    const unsigned char* UTl = F.UT() + (size_t)layer * NEXP * UROW;
    const unsigned char* VTl = F.VT() + (size_t)layer * NEXP * VROW;
    const float* USl = F.US() + 2 * (size_t)layer * NEXP; const float* VSl = nullptr;
    unsigned* ticket = ctl + CW_TICKET + 64 * layer;
    unsigned tk = 0u;
    if (lane == 0) tk = __hip_atomic_fetch_add(ticket, 1u, __ATOMIC_RELAXED, __HIP_MEMORY_SCOPE_AGENT);
    int t = (int)__builtin_amdgcn_readfirstlane(tk);
    while (t < rows) {
        unsigned tkn = 0u;
        if (lane == 0) tkn = __hip_atomic_fetch_add(ticket, 1u, __ATOMIC_RELAXED, __HIP_MEMORY_SCOPE_AGENT);
        SUB_BEGIN(8); peer_topk(F, ws, t); SUB_END(8);
        SUB_BEGIN(9);
        unsigned hv[16]; f32x2 acc[16];
#pragma unroll
        for (int q = 0; q < 4; ++q) { const u32x4 w = *(const u32x4*)(F.H() + (size_t)t * D + 32 * lane + 8 * q);
#pragma unroll
            for (int e = 0; e < 4; ++e) { hv[4 * q + e] = w[e]; acc[4 * q + e] = (f32x2){0.f, 0.f}; } }
        {
            GBuf A, B, C;
            gather_issue(A, EL, 0, UTl, VTl, lane);
            gather_issue(B, EL, EB, UTl, VTl, lane);
            for (int i0 = 0; i0 < 30 * EB; i0 += 3 * EB) {
                gather_issue(C, EL, i0 + 2 * EB, UTl, VTl, lane);
                gather_compute(A, EL, GL, i0, USl, VSl, hv, acc);
                gather_issue(A, EL, i0 + 3 * EB, UTl, VTl, lane);
                gather_compute(B, EL, GL, i0 + EB, USl, VSl, hv, acc);
                gather_issue(B, EL, i0 + 4 * EB, UTl, VTl, lane);
                gather_compute(C, EL, GL, i0 + 2 * EB, USl, VSl, hv, acc);
            }
            gather_compute(A, EL, GL, 30 * EB, USl, VSl, hv, acc);
            gather_compute(B, EL, GL, 31 * EB, USl, VSl, hv, acc);
        }
        SUB_END(9); SUB_BEGIN(10);
        const int mr = modrow(t);
        const float* mp = F.MODS() + ((size_t)layer * 3 + mr) * 12288;
        bf16_t* xr = F.X() + (size_t)t * D;
        float rr[32]; float s = 0.f;
#pragma unroll
        for (int q2 = 0; q2 < 4; ++q2) { const u32x4 xw = *(const u32x4*)(xr + 32 * lane + 8 * q2);
#pragma unroll
            for (int h2 = 0; h2 < 2; ++h2) { const int q = 2 * q2 + h2; const f32x4 gv = *(const LAS f32x4*)(vcache + mr * 8192 + q * 1024);
                const f32x4 xv = {bf_lo(xw[2 * h2]), bf_hi(xw[2 * h2]), bf_lo(xw[2 * h2 + 1]), bf_hi(xw[2 * h2 + 1])};
                const f32x4 av = {acc[2 * q].x, acc[2 * q].y, acc[2 * q + 1].x, acc[2 * q + 1].y};
#pragma unroll
                for (int e = 0; e < 4; ++e) { const float v = DN_ALPHA * xv[e] + gv[e] * av[e]; rr[4 * q + e] = v; s += v; } } }
        const float mean = wave_sum_u(s) * (1.f / D);
        float s2 = 0.f;
#pragma unroll
        for (int i = 0; i < 32; ++i) { rr[i] -= mean; s2 += rr[i] * rr[i]; }
        const float rstd = 1.f / sqrtf(wave_sum_u(s2) * (1.f / D) + LN_EPS);
        const float* g2 = F.ln2_g() + layer * D; const float* b2 = F.ln2_b() + layer * D;
        float s3 = 0.f;
#pragma unroll
        for (int q = 0; q < 8; ++q) { const int c = 32 * lane + 4 * q; const f32x4 gg = *(const LAS f32x4*)(vcache + 9 * 8192 + q * 1024), bb = *(const LAS f32x4*)(vcache + 10 * 8192 + q * 1024);
            f32x4 xo;
#pragma unroll
            for (int e = 0; e < 4; ++e) { xo[e] = rr[4 * q + e] * rstd * gg[e] + bb[e]; rr[4 * q + e] = xo[e]; s3 += xo[e]; }
            if (layer == NLAYER - 1 && t < TL) *(f32x4*)(F.out() + (size_t)t * D + c) = xo; }
        if (layer < NLAYER - 1) {
#pragma unroll
            for (int q2 = 0; q2 < 4; ++q2) { u32x4 o4; o4.x = pk2(rr[8 * q2], rr[8 * q2 + 1]); o4.y = pk2(rr[8 * q2 + 2], rr[8 * q2 + 3]); o4.z = pk2(rr[8 * q2 + 4], rr[8 * q2 + 5]); o4.w = pk2(rr[8 * q2 + 6], rr[8 * q2 + 7]);
                *(u32x4*)(xr + 32 * lane + 8 * q2) = o4; }
            const float mean2 = wave_sum_u(s3) * (1.f / D);
            float s4 = 0.f;
#pragma unroll
            for (int i = 0; i < 32; ++i) { rr[i] -= mean2; s4 += rr[i] * rr[i]; }
            const float rstd2 = 1.f / sqrtf(wave_sum_u(s4) * (1.f / D) + LN_EPS);
            const float* np = F.MODS() + ((size_t)(layer + 1) * 3 + mr) * 12288;
#pragma unroll
            for (int q4 = 0; q4 < 2; ++q4) { u32x4 w;
#pragma unroll
                for (int q = 0; q < 4; ++q) { const int qq = 4 * q4 + q; const f32x4 sh = *(const LAS f32x4*)(vcache + (3 + mr) * 8192 + qq * 1024), sc = *(const LAS f32x4*)(vcache + (6 + mr) * 8192 + qq * 1024); const int ri = 4 * qq;
                    const float y0 = rr[ri] * rstd2 * (1.f + sc[0]) + sh[0], y1 = rr[ri + 1] * rstd2 * (1.f + sc[1]) + sh[1];
                    const float y2 = rr[ri + 2] * rstd2 * (1.f + sc[2]) + sh[2], y3 = rr[ri + 3] * rstd2 * (1.f + sc[3]) + sh[3];
                    int o = __builtin_amdgcn_cvt_pk_fp8_f32(y0, y1, 0, false); o = __builtin_amdgcn_cvt_pk_fp8_f32(y2, y3, o, true); w[q] = (unsigned)o; }
                *(u32x4*)(F.H8() + (size_t)t * D + 32 * lane + 16 * q4) = w; }
        }
        SUB_END(10);
        t = (int)__builtin_amdgcn_readfirstlane(tkn);
    }
#undef SUB_BEGIN
#undef SUB_END
}

__global__ void __launch_bounds__(NWAVES * 64, 2) skel_fwd(Args args) {
    extern __shared__ __attribute__((aligned(16))) unsigned char lds[];
    Frame F;
    F.lds = (LAS unsigned char*)lds;
    F.tid = threadIdx.x; F.lane = F.tid & 63; F.wave = __builtin_amdgcn_readfirstlane(F.tid >> 6);
    F.G = gridDim.x; F.gw = blockIdx.x * NWAVES + F.wave; F.NGW = F.G * NWAVES;
    unsigned char* ws = args.ws;
    F.ka = (const CAS unsigned char*)__builtin_amdgcn_kernarg_segment_ptr();
    for (int u = F.tid; u < (LDS_BYTES - LDSCTL_OFF) / 4; u += NWAVES * 64) ((LAS unsigned*)(F.lds + LDSCTL_OFF))[u] = 0u;
    __syncthreads();
    unsigned* ctl = (unsigned*)(ws + WS_CTL);
    const int lo = args.ph_lo, hi = args.ph_hi;
    XcdBarrier bar; bar.bar = ctl + CW_BAR + args.li * XCD_BAR_WORDS; bar.x = 0; bar.st = nullptr;
    if (hi - lo > 1) bar = xcd_barrier_post(ctl + CW_BAR + args.li * XCD_BAR_WORDS, (volatile LAS unsigned*)(F.lds + MISC_OFF) + 8);
#define IN(k) (lo <= (k) && (k) < hi)
    unsigned long long pr_acc = 0ull, pr_t0 = 0ull;
#define PR_BEGIN(ty) do { if (PROBE_PHASE == (ty)) pr_t0 = __builtin_amdgcn_s_memrealtime(); } while (0)
#define PR_END(ty) do { if (PROBE_PHASE == (ty)) pr_acc += __builtin_amdgcn_s_memrealtime() - pr_t0; } while (0)
#define BOTH(k) (IN(k) && IN((k) + 1))
#define SEAM(k) do { if (BOTH(k)) xcd_barrier(bar); } while (0)

    if (IN(0)) { PR_BEGIN(0); frame_ids(F); p0a_prologue(F); SEAM(0); PR_END(0); }
    if (IN(1)) {
        PR_BEGIN(1); frame_ids(F);
        { pg8::Gemm g{F.KBD(), F.WQR(), 32 * 256, 2048, 256}; pg8::BatchOrder S{F.G, (int)blockIdx.x}; pg8::EpiBf16 E{F.WEFFT(), D, 1.f};
          pg8::gemm_phase<pg8::EpiBf16, pg8::BatchOrder, false, true>(F.lds, g, S, E); }
        p0b_mod0(F);
        SEAM(1); PR_END(1);
    }
    for (int layer = 0; layer < NLAYER; ++layer) {
        const int pb = 2 + 6 * layer;
        const bool lastl = layer == NLAYER - 1;
        const int rows = lastl ? TL : TT;
        if (IN(pb + 0)) {
            PR_BEGIN(2); frame_ids(F);
            pg8::Gemm g{(const bf16_t*)F.H8(), (const bf16_t*)(F.WINT() + (size_t)layer * INC * D), TT, INC, D / 2}; pg8::StaticOrder S; S.init(TT, 2 * INC, F.G, (int)blockIdx.x);
            pg8::EpiBf16H E{F.PROJ(), INC, 1.f / WIN_SCALE};
            pg8::gemm_phase<pg8::EpiBf16H, pg8::StaticOrder, false, true, true, true>(F.lds, g, S, E);
            SEAM(pb + 0); PR_END(2);
        }
        if (IN(pb + 1)) {
            PR_BEGIN(3); frame_ids(F);
            const int nunits = lastl ? 512 : 528;
            {
                const int ch = F.tid & 255, vsel = F.tid >> 8;
                LAS unsigned char* dst = F.lds + CONV_LDS + ((2 * (ch >> 7) + (ch & 1)) * 64 + ((ch & 127) >> 1)) * 16;
                *(LAS f32x4*)(dst + vsel * 4096) = *(const f32x4*)(F.conv_w() + (size_t)layer * 3 * 1024 + vsel * 1024 + 4 * ch);
                *(LAS f32x4*)(dst + (2 + vsel) * 4096) = vsel == 0 ? *(const f32x4*)(F.conv_w() + (size_t)layer * 3 * 1024 + 2048 + 4 * ch) : *(const f32x4*)(F.g_conv() + layer * 1024 + 4 * ch);
            }
            for (int i = F.tid; i < 192 * 32 * 2 / 4; i += NWAVES * 64) *(LAS f32x4*)(F.lds + ROPE_LDS + i * 16) = *(const f32x4*)(F.ROPE() + 4 * i);
            __syncthreads();
            { unsigned long long q0 = 0; if (PROBE_PHASE == 11) q0 = __builtin_amdgcn_s_memrealtime();
            { const int bx = (int)blockIdx.x, vcu = (F.G % 8 == 0) ? (bx % 8) * (F.G / 8) + bx / 8 : bx;
              for (int u = vcu; u < nunits; u += F.G) attn_unit(F, layer, u); }
            if (PROBE_PHASE == 11) pr_acc += __builtin_amdgcn_s_memrealtime() - q0; if (PROBE_PHASE == 12) q0 = __builtin_amdgcn_s_memrealtime();
            {
              const int nx = nunits - 2 * F.G; const bool uneven = nx > 0 && nx < F.G;
              const int bx2 = (int)blockIdx.x, vc2 = (F.G % 8 == 0) ? (bx2 % 8) * (F.G / 8) + bx2 / 8 : bx2;
              const int c0 = uneven ? vc2 - nx : vc2, nb = uneven ? F.G - nx : F.G;
              if (c0 >= 0) for (int t = c0 * NWAVES + F.wave; t < rows; t += nb * NWAVES) conv_row(F, layer, t); }
            if (PROBE_PHASE == 12) pr_acc += __builtin_amdgcn_s_memrealtime() - q0; }
            SEAM(pb + 1); PR_END(3);
        }
        if (IN(pb + 2)) {
            PR_BEGIN(4); frame_ids(F);
            pg8::Gemm g{(const bf16_t*)F.MIX(), (const bf16_t*)(F.WOUTT() + (size_t)layer * D * D), rows, D, D / 2}; pg8::StaticOrder S; S.init(rows, 2 * D, F.G, (int)blockIdx.x);
            pg8::EpiBf16H E{F.PROJ(), D, 1.f / WOUT_SCALE};
            pg8::gemm_phase<pg8::EpiBf16H, pg8::StaticOrder, false, true, true, true>(F.lds, g, S, E);
            frame_ids(F); convert_in_tail(F, layer, (rows / 256) * (D / 128), 0);
            SEAM(pb + 2); PR_END(4);
        }
        if (IN(pb + 3)) { PR_BEGIN(5); frame_ids(F); ln_phase(F, layer, rows); SEAM(pb + 3); PR_END(5); }
        if (IN(pb + 4)) {
            PR_BEGIN(6); frame_ids(F);
            pg8::Gemm g{F.H(), F.WEFFT() + (size_t)layer * D * D, rows, D, D}; pg8::StaticOrder S; S.init(rows, D, F.G, (int)blockIdx.x);
            pg8::EpiBf16 E{F.SC(), D, 1.f};
            pg8::gemm_phase<pg8::EpiBf16, pg8::StaticOrder, true, true>(F.lds, g, S, E);
            frame_ids(F); convert_in_tail(F, layer, (rows / 256) * (D / 256), 1);
            SEAM(pb + 4); PR_END(6);
        }
        if (IN(pb + 5)) { PR_BEGIN(7); frame_ids(F); peer_phase(F, layer, rows, ctl, pr_acc); SEAM(pb + 5); PR_END(7); }
    }
    if (PROBE_PHASE >= 0 && hi - lo > 1) xcd_barrier(bar);
    if (PROBE_PHASE >= 0 && blockIdx.x == 0 && threadIdx.x == 0) { const unsigned long long t1 = __builtin_amdgcn_s_memrealtime() + (unsigned long long)PROBE_MULT * pr_acc; while (__builtin_amdgcn_s_memrealtime() < t1) __builtin_amdgcn_s_sleep(8); }
#undef IN
#undef BOTH
#undef SEAM
}

extern "C" void kernel_launch(void* const* d_in, const int* in_sizes, int n_in, void* d_out, int out_size, void* d_ws, size_t ws_size, hipStream_t stream) {
    static int grid = 0;
    if (grid == 0) {
        if (n_in != 20 || in_sizes[0] != TL * D || out_size != TL * D || ws_size < WS_END) {
            fprintf(stderr, "kernel_launch: unexpected problem shape (n_in %d, in0 %d, out %d, ws %zu, need %zu)\n", n_in, n_in > 0 ? in_sizes[0] : -1, out_size, ws_size, (size_t)WS_END); grid = -1; return; }
        int dev = 0, cus = 0, per_cu = 0;
        if (hipGetDevice(&dev) != hipSuccess || hipDeviceGetAttribute(&cus, hipDeviceAttributeMultiprocessorCount, dev) != hipSuccess) { grid = -1; return; }
        if (hipFuncSetAttribute((const void*)skel_fwd, hipFuncAttributeMaxDynamicSharedMemorySize, LDS_BYTES) != hipSuccess) { fprintf(stderr, "kernel_launch: hipFuncSetAttribute failed\n"); grid = -1; return; }
        if (hipOccupancyMaxActiveBlocksPerMultiprocessor(&per_cu, (const void*)skel_fwd, NWAVES * 64, LDS_BYTES) != hipSuccess || per_cu < 1)
            fprintf(stderr, "kernel_launch: occupancy query reports %d workgroups per CU\n", per_cu);
        (void)hipGetLastError();
        grid = cus;
    }
    if (grid < 0) return;
    if (hipMemsetAsync((char*)d_ws + WS_CTL, 0, CTL_ZERO_BYTES, stream) != hipSuccess) return;
    Args a{};
    for (int i = 0; i < 20; ++i) a.in[i] = (const float*)d_in[i];
    a.out = (float*)d_out; a.ws = (unsigned char*)d_ws; a.pad = 0;
#if MK_N_LAUNCHES == 1
    a.ph_lo = 0; a.ph_hi = NPHASE; a.li = 0;
    hipLaunchKernelGGL(skel_fwd, dim3(grid), dim3(NWAVES * 64), LDS_BYTES, stream, a);
#else
    for (int ph = 0; ph < NPHASE; ++ph) { a.ph_lo = ph; a.ph_hi = ph + 1; a.li = 0;
        hipLaunchKernelGGL(skel_fwd, dim3(grid), dim3(NWAVES * 64), LDS_BYTES, stream, a); }
#endif
}
```

```cpp
#include <hip/hip_runtime.h>
#include <cstdio>
#include <cstdint>

#ifndef MK_N_LAUNCHES
#define MK_N_LAUNCHES 1
#endif

#define LAS __attribute__((address_space(3)))
typedef unsigned short bf16_t;
typedef short bf16x8 __attribute__((ext_vector_type(8)));
typedef short s16x4 __attribute__((ext_vector_type(4)));
typedef float f32x2 __attribute__((ext_vector_type(2)));
typedef float f32x4 __attribute__((ext_vector_type(4)));
typedef float f32x16 __attribute__((ext_vector_type(16)));
typedef unsigned u32x2 __attribute__((ext_vector_type(2)));
typedef unsigned u32x4 __attribute__((ext_vector_type(4)));
typedef __bf16 bf16x2_t __attribute__((ext_vector_type(2)));
typedef int i32x8 __attribute__((ext_vector_type(8)));

constexpr int D = 2048, NB = 2, SEQ = 8192, CTXL = 256, NLAYER = 4;
constexpr int TL = NB * SEQ, TC = NB * CTXL, TT = TL + TC;
constexpr int INC = 4608, OFF_C = 1024, OFF_X = 2048, OFF_Q = 3072, OFF_K = 4096, OFF_V = 4352;
constexpr float WOUT_SCALE = 128.f;
constexpr float WIN_SCALE = 64.f;
constexpr int NEXP = 16384;
#ifndef U_FMT
#define U_FMT 4
#endif
#ifndef V_FMT
#define V_FMT 4
#endif
constexpr int UROW = D * U_FMT / 8, VROW = D * V_FMT / 8;
constexpr float LN_EPS = 1e-6f;
constexpr float DN_ALPHA = 1.681792830507429f;
constexpr float QSCALE = 0.08838834764831845f * 1.4426950408889634f;
constexpr float LOG2E = 1.4426950408889634f;

constexpr size_t MiB = 1u << 20;
constexpr size_t WS_CTL = 0, CTL_ZERO_BYTES = 2 * MiB;
constexpr size_t WS_MODS = 1 * MiB;
constexpr size_t WS_ROPE = 2 * MiB;
constexpr size_t WS_KBD = 3 * MiB;
constexpr size_t WS_WQR = 8 * MiB;
constexpr size_t WS_WINT = 40 * MiB;
constexpr size_t WS_WOUTT = 112 * MiB;
constexpr size_t WS_WEFFT = 144 * MiB;
constexpr size_t WS_X = 176 * MiB;
constexpr size_t WS_H = 308 * MiB;
constexpr size_t WS_PROJ = 374 * MiB;
constexpr size_t WS_MIX = 523 * MiB;
constexpr size_t WS_SC = 589 * MiB;
constexpr size_t WS_UT = 721 * MiB;
constexpr size_t WS_VT = 849 * MiB;
constexpr size_t WS_US = 977 * MiB;
constexpr size_t WS_VS = 978 * MiB;
constexpr size_t WS_H8 = 979 * MiB;
constexpr size_t WS_END = 1013 * MiB;

constexpr int CW_BAR = 4096;

namespace pg8 {
constexpr int BM = 256, BK = 64, HALF = 128, HTB = HALF * BK * 2, STAGE_BYTES = 8 * HTB, NXCD = 8, WGM = 8;
__host__ __device__ __forceinline__ int lds_byte(int r, int c) { const int st = (r >> 4) * 2 + (c >> 5), rr = r & 15, cc = c & 31, ob = rr * 64 + cc * 2; return st * 1024 + (ob ^ (((ob >> 9) & 1) << 5)); }
__host__ __device__ __forceinline__ void stage_rc(int b, int& R, int& C) { const int st = b / 1024, sb = b % 1024, swz = sb ^ (((sb >> 9) & 1) << 5); R = (st >> 1) * 16 + swz / 64; C = (st & 1) * 32 + (swz % 64) / 2; }
__host__ __device__ __forceinline__ int perm32(int rho) { const int n = rho >> 4, i = rho & 15; return 8 * (i >> 2) + 4 * n + (i & 3); }

struct Unit { int pm, pn; };
struct Gemm { const bf16_t* A; const bf16_t* Bt; int M, N, K; };

struct StaticOrder {
    int nM, nN, nwg, G, c;
    __host__ __device__ void init(int M, int N, int G_, int c_) { nM = M / BM; nN = N / BM; nwg = nM * nN; G = G_; c = c_; }
    __host__ __device__ bool next(int i, Unit& u) const {
        const long L = (long)i * G + c; if (L >= nwg) return false;
        int wgid = (int)L; { const int q = nwg / NXCD, r = nwg % NXCD, xcd = wgid % NXCD, off = wgid / NXCD; wgid = (xcd < r ? xcd * (q + 1) : r * (q + 1) + (xcd - r) * q) + off; }
        const int nig = WGM * nN, gid = wgid / nig, fm = gid * WGM, gsz = (nM - fm) < WGM ? (nM - fm) : WGM;
        u.pm = fm + ((wgid % nig) % gsz); u.pn = (wgid % nig) / gsz; return true;
    }
    __device__ __forceinline__ int btile(const Unit& u) const { return u.pn; }
    __device__ __forceinline__ void a_ready(const Unit&) const {}
    __device__ __forceinline__ void done(const Unit&) const {}
};
struct BatchOrder {
    int G, c;
    __device__ bool next(int i, Unit& u) const { const int L = i * G + c; if (L >= 256) return false; u.pm = L >> 3; u.pn = L & 7; return true; }
    __device__ __forceinline__ int btile(const Unit& u) const { return u.pm * 8 + u.pn; }
    __device__ __forceinline__ void a_ready(const Unit&) const {}
    __device__ __forceinline__ void done(const Unit&) const {}
};

__device__ __forceinline__ unsigned cvt_pk_bf16(float lo, float hi) { f32x2 x = {lo, hi}; bf16x2_t y = __builtin_convertvector(x, bf16x2_t); return __builtin_bit_cast(unsigned, y); }

struct EpiBf16 {
    static constexpr bool PERM = true;
    bf16_t* O; int ldc; float scale;
    __device__ __forceinline__ void operator()(const f32x4 (&acc)[2][2][4][2], const Unit& u, int wr, int wc, int fr, int fq) const {
        const int row0 = u.pm * BM + wr * 64 + fr, col0 = u.pn * BM + wc * 32 + 8 * fq;
#pragma unroll
        for (int ai = 0; ai < 2; ++ai)
#pragma unroll
            for (int m = 0; m < 4; ++m) { bf16_t* rowp = O + (size_t)(row0 + ai * HALF + m * 16) * ldc + col0;
#pragma unroll
                for (int bj = 0; bj < 2; ++bj) { const f32x4 v0 = acc[ai][bj][m][0] * scale, v1 = acc[ai][bj][m][1] * scale;
                    u32x4 w; w.x = cvt_pk_bf16(v0[0], v0[1]); w.y = cvt_pk_bf16(v0[2], v0[3]); w.z = cvt_pk_bf16(v1[0], v1[1]); w.w = cvt_pk_bf16(v1[2], v1[3]);
                    *(u32x4*)(rowp + bj * HALF) = w; } }
    }
};
struct EpiBf16H {
    static constexpr bool PERM = true;
    bf16_t* O; int ldc; float scale;
    __device__ __forceinline__ void operator()(const f32x4 (&acc)[2][2][4][2], const Unit& u, int wr, int wc, int fr, int fq) const {
        const int row0 = u.pm * BM + wr * 64 + fr, col0 = u.pn * HALF + wc * 32 + 8 * fq;
#pragma unroll
        for (int ai = 0; ai < 2; ++ai)
#pragma unroll
            for (int m = 0; m < 4; ++m) { const f32x4 v0 = acc[ai][0][m][0] * scale, v1 = acc[ai][0][m][1] * scale;
                u32x4 w; w.x = cvt_pk_bf16(v0[0], v0[1]); w.y = cvt_pk_bf16(v0[2], v0[3]); w.z = cvt_pk_bf16(v1[0], v1[1]); w.w = cvt_pk_bf16(v1[2], v1[3]);
                *(u32x4*)(O + (size_t)(row0 + ai * HALF + m * 16) * ldc + col0) = w; }
    }
};
struct EpiF32 {
    static constexpr bool PERM = false;
    float* C; int ldc;
    __device__ __forceinline__ void operator()(const f32x4 (&acc)[2][2][4][2], const Unit& u, int wr, int wc, int fr, int fq) const {
        const int row0 = u.pm * BM + wr * 64 + fr, col0 = u.pn * BM + wc * 32 + 4 * fq;
#pragma unroll
        for (int ai = 0; ai < 2; ++ai)
#pragma unroll
            for (int m = 0; m < 4; ++m) { float* rowp = C + (size_t)(row0 + ai * HALF + m * 16) * ldc + col0;
#pragma unroll
                for (int bj = 0; bj < 2; ++bj)
#pragma unroll
                    for (int n = 0; n < 2; ++n) *(f32x4*)(rowp + bj * HALF + n * 16) = acc[ai][bj][m][n]; }
    }
};
struct EpiResid {
    static constexpr bool PERM = true;
    const float* x32_lat; const float* x32_ctx;
    bf16_t* X; const float* gate;
    __device__ __forceinline__ void operator()(const f32x4 (&acc)[2][2][4][2], const Unit& u, int wr, int wc, int fr, int fq) const {
        const int rt = u.pm * BM;
        const int mr = rt < TL ? rt / SEQ : 2;
        const int row0 = rt + wr * 64 + fr, col0 = u.pn * BM + wc * 32 + 8 * fq;
        f32x4 gv[2][2];
#pragma unroll
        for (int bj = 0; bj < 2; ++bj)
#pragma unroll
            for (int n = 0; n < 2; ++n) gv[bj][n] = *(const f32x4*)(gate + (size_t)mr * 12288 + col0 + bj * HALF + 4 * n);
#pragma unroll
        for (int ai = 0; ai < 2; ++ai)
#pragma unroll
            for (int m = 0; m < 4; ++m) { const int row = row0 + ai * HALF + m * 16;
#pragma unroll
                for (int bj = 0; bj < 2; ++bj) {
                    f32x4 x0, x1;
                    if (x32_lat) { const float* xp = (row < TL ? x32_lat + (size_t)row * D : x32_ctx + (size_t)(row - TL) * D) + col0 + bj * HALF; x0 = *(const f32x4*)xp; x1 = *(const f32x4*)(xp + 4); }
                    else { const u32x4 w = *(const u32x4*)(X + (size_t)row * D + col0 + bj * HALF);
                        x0 = (f32x4){__uint_as_float(w.x << 16), __uint_as_float(w.x & 0xffff0000u), __uint_as_float(w.y << 16), __uint_as_float(w.y & 0xffff0000u)};
                        x1 = (f32x4){__uint_as_float(w.z << 16), __uint_as_float(w.z & 0xffff0000u), __uint_as_float(w.w << 16), __uint_as_float(w.w & 0xffff0000u)}; }
                    const f32x4 r0 = x0 * DN_ALPHA + gv[bj][0] * acc[ai][bj][m][0], r1 = x1 * DN_ALPHA + gv[bj][1] * acc[ai][bj][m][1];
                    u32x4 o; o.x = cvt_pk_bf16(r0[0], r0[1]); o.y = cvt_pk_bf16(r0[2], r0[3]); o.z = cvt_pk_bf16(r1[0], r1[1]); o.w = cvt_pk_bf16(r1[2], r1[3]);
                    *(u32x4*)(X + (size_t)row * D + col0 + bj * HALF) = o; } }
    }
};

template <class Epi, class Sched, bool ALIGN_EPI = false, bool SP2 = false, bool FP8 = false, bool HN = false>
__device__ __forceinline__ void gemm_phase(LAS unsigned char* lds, const Gemm g, const Sched& S, const Epi& E) {
    int tid = threadIdx.x; asm volatile("" : "+v"(tid));
    const int wid = __builtin_amdgcn_readfirstlane(tid >> 6), lane = tid & 63, wr = wid >> 2, wc = wid & 3, fr = lane & 15, fq = lane >> 4;
    const int K = g.K, nt = K / BK;
    unsigned voffA[2], voffB[2];
#pragma unroll
    for (int i = 0; i < 2; ++i) { int R, C; stage_rc(tid * 16 + i * 8192, R, C); const int Rb = Epi::PERM ? ((R & ~31) + perm32(R & 31)) : R;
        voffA[i] = (unsigned)(R * K + C) * 2u; voffB[i] = (unsigned)(Rb * K + C) * 2u; }
    const size_t kstep = (size_t)(BK * 2);
    const size_t hstep = (size_t)HALF * K * 2;
    const size_t tstep = 2 * hstep;
    const unsigned ldsw = (unsigned)wid * 1024u;
    const int aoff = lds_byte(wr * 64 + fr, fq * 8), boff = lds_byte(wc * 32 + fr, fq * 8);
    const int aoff8a = lds_byte(wr * 64 + fr, fq * 16), boff8a = lds_byte(wc * 32 + fr, fq * 16);
#define PG8_SA(b, h) (((b) * 2 + (h)) * HTB)
#define PG8_SB(b, h) ((4 + (b) * 2 + (h)) * HTB)
#define PG8_STAGE(bufoff, gbase, voff) do { _Pragma("unroll") for (int _i = 0; _i < 2; ++_i) \
        __builtin_amdgcn_global_load_lds((const unsigned*)((const char*)(gbase) + (voff)[_i]), (LAS unsigned*)(lds + (bufoff) + ldsw + _i * 8192), 16, 0, 0); } while (0)
#define PG8_LDA(dst, b, h) do { if constexpr (FP8) { _Pragma("unroll") for (int m = 0; m < 4; ++m) { const u32x4 _x = *(const LAS u32x4*)(lds + PG8_SA(b, h) + aoff8a + m * 2048), _y = *(const LAS u32x4*)(lds + PG8_SA(b, h) + aoff8a + 16 + m * 2048); \
            dst##8[m] = (i32x8){(int)_x.x, (int)_x.y, (int)_x.z, (int)_x.w, (int)_y.x, (int)_y.y, (int)_y.z, (int)_y.w}; } } \
        else { _Pragma("unroll") for (int m = 0; m < 4; ++m) _Pragma("unroll") for (int k = 0; k < 2; ++k) dst[m][k] = *(const LAS bf16x8*)(lds + PG8_SA(b, h) + aoff + m * 2048 + k * 1024); } } while (0)
#define PG8_LDB(dst, b, h) do { if constexpr (FP8) { _Pragma("unroll") for (int n = 0; n < 2; ++n) { const u32x4 _x = *(const LAS u32x4*)(lds + PG8_SB(b, h) + boff8a + n * 2048), _y = *(const LAS u32x4*)(lds + PG8_SB(b, h) + boff8a + 16 + n * 2048); \
            dst##8[n] = (i32x8){(int)_x.x, (int)_x.y, (int)_x.z, (int)_x.w, (int)_y.x, (int)_y.y, (int)_y.z, (int)_y.w}; } } \
        else { _Pragma("unroll") for (int n = 0; n < 2; ++n) _Pragma("unroll") for (int k = 0; k < 2; ++k) dst[n][k] = *(const LAS bf16x8*)(lds + PG8_SB(b, h) + boff + n * 2048 + k * 1024); } } while (0)
#define PG8_MMA(ai, bj, At, Bt) do { __builtin_amdgcn_s_setprio(1); if constexpr (FP8) { _Pragma("unroll") for (int m = 0; m < 4; ++m) _Pragma("unroll") for (int n = 0; n < 2; ++n) \
            acc[ai][bj][m][n] = __builtin_amdgcn_mfma_scale_f32_16x16x128_f8f6f4(Bt##8[n], At##8[m], acc[ai][bj][m][n], 0, 0, 0, 0x7F7F7F7F, 0, 0x7F7F7F7F); } \
        else { _Pragma("unroll") for (int m = 0; m < 4; ++m) _Pragma("unroll") for (int n = 0; n < 2; ++n) _Pragma("unroll") for (int k = 0; k < 2; ++k) \
            acc[ai][bj][m][n] = __builtin_amdgcn_mfma_f32_16x16x32_bf16(Bt[n][k], At[m][k], acc[ai][bj][m][n], 0, 0, 0); } __builtin_amdgcn_s_setprio(0); } while (0)
#define PG8_WAIT_V(n) asm volatile("s_waitcnt vmcnt(" #n ")" ::: "memory")
#define PG8_WAIT_L(n) asm volatile("s_waitcnt lgkmcnt(" #n ")" ::: "memory")
#define PG8_BAR __builtin_amdgcn_s_barrier()
#define PG8_SCHED __builtin_amdgcn_sched_barrier(0)
    Unit cur, nxt; int ui = 0;
    if (!S.next(0, cur)) return;
    f32x4 acc[2][2][4][2];
#pragma unroll
    for (int a = 0; a < 2; ++a)
#pragma unroll
        for (int b = 0; b < 2; ++b)
#pragma unroll
            for (int m = 0; m < 4; ++m)
#pragma unroll
                for (int n = 0; n < 2; ++n) acc[a][b][m][n] = (f32x4){0.f, 0.f, 0.f, 0.f};
    bf16x8 At[4][2], B0[2][2], B1[2][2];
    i32x8 At8[4], B08[2], B18[2];
    const size_t bstep = HN ? hstep : tstep;
    const char* cA = (const char*)g.A + (size_t)cur.pm * tstep; const char* cB = (const char*)g.Bt + (size_t)S.btile(cur) * bstep;
    S.a_ready(cur);
    if constexpr (HN) {
        static_assert(!HN || SP2, "HN needs the SP2 loop");
        PG8_STAGE(PG8_SB(0, 0), cB, voffB); PG8_STAGE(PG8_SA(0, 0), cA, voffA); PG8_STAGE(PG8_SA(0, 1), cA + hstep, voffA);
        if (wr == 1) PG8_BAR;
        PG8_WAIT_V(2); PG8_BAR;
        PG8_STAGE(PG8_SB(1, 0), cB + kstep, voffB); PG8_STAGE(PG8_SA(1, 0), cA + kstep, voffA);
        PG8_WAIT_V(4); PG8_BAR;
    } else if constexpr (SP2) {
        PG8_STAGE(PG8_SB(0, 0), cB, voffB); PG8_STAGE(PG8_SB(0, 1), cB + hstep, voffB); PG8_STAGE(PG8_SA(0, 0), cA, voffA); PG8_STAGE(PG8_SA(0, 1), cA + hstep, voffA);
        if (wr == 1) PG8_BAR;
        PG8_WAIT_V(2); PG8_BAR;
        PG8_STAGE(PG8_SB(1, 0), cB + kstep, voffB); PG8_STAGE(PG8_SA(1, 0), cA + kstep, voffA); PG8_STAGE(PG8_SB(1, 1), cB + hstep + kstep, voffB);
        PG8_WAIT_V(6); PG8_BAR;
    } else {
        PG8_STAGE(PG8_SB(0, 0), cB, voffB); PG8_STAGE(PG8_SA(0, 0), cA, voffA); PG8_STAGE(PG8_SB(0, 1), cB + hstep, voffB); PG8_STAGE(PG8_SA(0, 1), cA + hstep, voffA);
        if (wr == 1) PG8_BAR;
        PG8_WAIT_V(4); PG8_BAR;
        PG8_STAGE(PG8_SB(1, 0), cB + kstep, voffB); PG8_STAGE(PG8_SA(1, 0), cA + kstep, voffA); PG8_STAGE(PG8_SB(1, 1), cB + hstep + kstep, voffB);
        PG8_WAIT_V(6); PG8_BAR;
    }
    for (;;) {
        const bool has_next = S.next(ui + 1, nxt);
        const char* nA = has_next ? (const char*)g.A + (size_t)nxt.pm * tstep : cA; const char* nB = has_next ? (const char*)g.Bt + (size_t)S.btile(nxt) * bstep : cB;
        for (int t = 0; t < nt; t += 2) {
            const bool last = (t == nt - 2);
            const char* a1 = cA + (size_t)(t + 1) * kstep;
            const char* a2 = last ? nA : cA + (size_t)(t + 2) * kstep; const char* b2 = last ? nB : cB + (size_t)(t + 2) * kstep;
            const char* a3 = a2 + kstep; const char* b3 = b2 + kstep;
            if (last && has_next) S.a_ready(nxt);
            if constexpr (HN) {
            PG8_LDB(B0, 0, 0); PG8_SCHED; PG8_LDA(At, 0, 0); PG8_STAGE(PG8_SA(1, 1), a1 + hstep, voffA);
            PG8_WAIT_V(6); PG8_WAIT_L(0); PG8_BAR; PG8_MMA(0, 0, At, B0); PG8_BAR; PG8_SCHED;
            PG8_LDA(At, 0, 1); PG8_STAGE(PG8_SB(0, 0), b2, voffB); PG8_STAGE(PG8_SA(0, 0), a2, voffA);
            PG8_WAIT_V(6); PG8_WAIT_L(0); PG8_BAR; PG8_MMA(1, 0, At, B0); PG8_BAR; PG8_SCHED;
            PG8_LDB(B0, 1, 0); PG8_SCHED; PG8_LDA(At, 1, 0); PG8_STAGE(PG8_SA(0, 1), a2 + hstep, voffA);
            PG8_WAIT_V(6); PG8_WAIT_L(0); PG8_BAR; PG8_MMA(0, 0, At, B0); PG8_BAR; PG8_SCHED;
            PG8_LDA(At, 1, 1); PG8_STAGE(PG8_SB(1, 0), b3, voffB); PG8_STAGE(PG8_SA(1, 0), a3, voffA);
            PG8_WAIT_V(6); PG8_WAIT_L(0); PG8_BAR; PG8_MMA(1, 0, At, B0); PG8_BAR; PG8_SCHED;
            } else if constexpr (SP2) {
            PG8_LDB(B0, 0, 0); PG8_LDB(B1, 0, 1); PG8_SCHED; PG8_LDA(At, 0, 0); PG8_STAGE(PG8_SA(1, 1), a1 + hstep, voffA);
            PG8_WAIT_V(8); PG8_WAIT_L(0); PG8_BAR; PG8_MMA(0, 0, At, B0); PG8_MMA(0, 1, At, B1); PG8_BAR; PG8_SCHED;
            PG8_LDA(At, 0, 1); PG8_STAGE(PG8_SB(0, 0), b2, voffB); PG8_STAGE(PG8_SB(0, 1), b2 + hstep, voffB); PG8_STAGE(PG8_SA(0, 0), a2, voffA);
            PG8_WAIT_V(8); PG8_WAIT_L(0); PG8_BAR; PG8_MMA(1, 0, At, B0); PG8_MMA(1, 1, At, B1); PG8_BAR; PG8_SCHED;
            PG8_LDB(B0, 1, 0); PG8_LDB(B1, 1, 1); PG8_SCHED; PG8_LDA(At, 1, 0); PG8_STAGE(PG8_SA(0, 1), a2 + hstep, voffA);
            PG8_WAIT_V(8); PG8_WAIT_L(0); PG8_BAR; PG8_MMA(0, 0, At, B0); PG8_MMA(0, 1, At, B1); PG8_BAR; PG8_SCHED;
            PG8_LDA(At, 1, 1); PG8_STAGE(PG8_SB(1, 0), b3, voffB); PG8_STAGE(PG8_SB(1, 1), b3 + hstep, voffB); PG8_STAGE(PG8_SA(1, 0), a3, voffA);
            PG8_WAIT_V(8); PG8_WAIT_L(0); PG8_BAR; PG8_MMA(1, 0, At, B0); PG8_MMA(1, 1, At, B1); PG8_BAR; PG8_SCHED;
            } else {
            PG8_LDB(B0, 0, 0); PG8_SCHED; PG8_LDA(At, 0, 0); PG8_STAGE(PG8_SA(1, 1), a1 + hstep, voffA);
            PG8_WAIT_L(8); PG8_BAR; PG8_WAIT_L(0); PG8_MMA(0, 0, At, B0); PG8_BAR; PG8_SCHED;
            PG8_LDB(B1, 0, 1); PG8_STAGE(PG8_SB(0, 0), b2, voffB);
            PG8_BAR; PG8_WAIT_L(0); PG8_MMA(0, 1, At, B1); PG8_BAR;
            PG8_LDA(At, 0, 1); PG8_STAGE(PG8_SA(0, 0), a2, voffA);
            PG8_BAR; PG8_WAIT_L(0); PG8_MMA(1, 0, At, B0); PG8_BAR; PG8_SCHED;
            PG8_STAGE(PG8_SB(0, 1), b2 + hstep, voffB);
            PG8_WAIT_V(6); PG8_BAR; PG8_MMA(1, 1, At, B1); PG8_BAR;
            PG8_LDB(B0, 1, 0); PG8_SCHED; PG8_LDA(At, 1, 0); PG8_STAGE(PG8_SA(0, 1), a2 + hstep, voffA);
            PG8_WAIT_L(8); PG8_BAR; PG8_WAIT_L(0); PG8_MMA(0, 0, At, B0); PG8_BAR; PG8_SCHED;
            PG8_LDB(B1, 1, 1); PG8_STAGE(PG8_SB(1, 0), b3, voffB);
            PG8_BAR; PG8_WAIT_L(0); PG8_MMA(0, 1, At, B1); PG8_BAR;
            PG8_LDA(At, 1, 1); PG8_STAGE(PG8_SA(1, 0), a3, voffA);
            PG8_BAR; PG8_WAIT_L(0); PG8_MMA(1, 0, At, B0); PG8_BAR; PG8_SCHED;
            PG8_STAGE(PG8_SB(1, 1), b3 + hstep, voffB);
            PG8_WAIT_V(6); PG8_BAR; PG8_MMA(1, 1, At, B1); PG8_BAR;
            }
        }
        if constexpr (ALIGN_EPI) { if (wr == 0) PG8_BAR; }
        E(acc, cur, wr, wc, fr, fq); S.done(cur);
        if (!has_next) break;
#pragma unroll
        for (int a = 0; a < 2; ++a)
#pragma unroll
            for (int b = 0; b < 2; ++b)
#pragma unroll
                for (int m = 0; m < 4; ++m)
#pragma unroll
                    for (int n = 0; n < 2; ++n) acc[a][b][m][n] = (f32x4){0.f, 0.f, 0.f, 0.f};
        cur = nxt; cA = nA; cB = nB; ++ui;
        if constexpr (ALIGN_EPI) { if (wr == 1) PG8_BAR; }
    }
    PG8_WAIT_V(0);
    if constexpr (!ALIGN_EPI) { if (wr == 0) PG8_BAR; }
    PG8_BAR;
#undef PG8_SA
#undef PG8_SB
#undef PG8_STAGE
#undef PG8_LDA
#undef PG8_LDB
#undef PG8_MMA
#undef PG8_WAIT_V
#undef PG8_WAIT_L
#undef PG8_BAR
#undef PG8_SCHED
}
}

#define XB_TMO      128
#define XB_XCNT(j)  (256  + 64 * (j))
#define XB_XSUB(j)  (1280 + 64 * (j))
#define XB_XGEN(j)  (2304 + 64 * (j))
#define XB_TOP      3328
#define XB_TOPGEN   3392
#define XCD_BAR_WORDS 3456
#define XB_SPIN_CAP (1u << 18)

__device__ __forceinline__ unsigned xb_ld(unsigned* p)              { return __hip_atomic_load(p, __ATOMIC_RELAXED, __HIP_MEMORY_SCOPE_AGENT); }
__device__ __forceinline__ unsigned xb_add(unsigned* p, unsigned v) { return __hip_atomic_fetch_add(p, v, __ATOMIC_RELAXED, __HIP_MEMORY_SCOPE_AGENT); }
__device__ __forceinline__ unsigned xb_xcc_id() { return (unsigned)__builtin_amdgcn_s_getreg((3 << 11) | 20) & 0xFu; }
#define XB_SPIN(cond, bar) do { unsigned _sp = 0; while (cond) { __builtin_amdgcn_s_sleep(1); \
    if ((++_sp & 255u) == 0u) { if (xb_ld(&(bar)[XB_TMO])) break; if (_sp > XB_SPIN_CAP) { atomicAdd(&(bar)[XB_TMO], 1u); break; } } } } while (0)

struct XcdBarrier { unsigned* bar; unsigned x; volatile LAS unsigned* st; };

__device__ __forceinline__ XcdBarrier xcd_barrier_post(unsigned* bar, volatile LAS unsigned* st) {
    XcdBarrier b; b.bar = bar; b.x = xb_xcc_id(); b.st = st;
    if (threadIdx.x == 0) (void)xb_add(&bar[XB_XCNT(b.x)], 1u);
    return b;
}
__device__ __forceinline__ void xcd_barrier_complete(unsigned* bar, unsigned x, unsigned& nloc, unsigned& nx) {
    const unsigned G = gridDim.x * gridDim.y * gridDim.z;
    unsigned sum, cnt, mine, sp = 0u;
    for (;;) {
        sum = 0u; cnt = 0u; mine = 0u;
#pragma unroll
        for (unsigned j = 0; j < 16; ++j) { const unsigned c = xb_ld(&bar[XB_XCNT(j)]); sum += c; cnt += (c > 0u) ? 1u : 0u; mine = (j == x) ? c : mine; }
        if (sum == G) break;
        __builtin_amdgcn_s_sleep(1);
        if ((++sp & 255u) == 0u) { if (xb_ld(&bar[XB_TMO])) break; if (sp > XB_SPIN_CAP) { atomicAdd(&bar[XB_TMO], 1u); break; } }
    }
    nloc = mine > 0u ? mine : 1u; nx = cnt > 0u ? cnt : 1u;
}
__device__ __forceinline__ void xcd_barrier(const XcdBarrier& b) {
    asm volatile("s_waitcnt vmcnt(0)" ::: "memory");
    __syncthreads();
    if (threadIdx.x == 0) {
        unsigned* bar = b.bar;
        __builtin_amdgcn_s_waitcnt(0);
        unsigned nloc = b.st[0], nx = b.st[1];
        if (nloc == 0u) { xcd_barrier_complete(bar, b.x, nloc, nx); b.st[0] = nloc; b.st[1] = nx; }
        const unsigned old = xb_add(&bar[XB_XSUB(b.x)], 1u);
        const unsigned gen = old / nloc;
        if (old + 1u == (gen + 1u) * nloc) {
            __builtin_amdgcn_fence(__ATOMIC_RELEASE, "agent");
            asm volatile("s_waitcnt vmcnt(0)" ::: "memory");
            const unsigned og = xb_add(&bar[XB_TOP], 1u);
            const unsigned tg = og / nx;
            if (og + 1u == (tg + 1u) * nx) xb_add(&bar[XB_TOPGEN], 1u);
            else XB_SPIN(xb_ld(&bar[XB_TOPGEN]) == tg, bar);
            __builtin_amdgcn_fence(__ATOMIC_ACQUIRE, "agent");
            xb_add(&bar[XB_XGEN(b.x)], 1u);
            asm volatile("s_waitcnt vmcnt(0)" ::: "memory");
        } else {
            XB_SPIN(xb_ld(&bar[XB_XGEN(b.x)]) == gen, bar);
            __builtin_amdgcn_fence(__ATOMIC_ACQUIRE, "agent");
            asm volatile("s_waitcnt vmcnt(0)" ::: "memory");
        }
    }
    __syncthreads();
}

constexpr int NWAVES = 8;
constexpr int LDS_BYTES = 163840;
constexpr int LDSCTL_OFF = LDS_BYTES - 512, MISC_OFF = LDSCTL_OFF + 320;
constexpr int NPHASE = 2 + 6 * NLAYER;

#define LDS_WAIT() asm volatile("s_waitcnt lgkmcnt(0)" ::: "memory")

struct Args { const float* in[20]; float* out; unsigned char* ws; int ph_lo, ph_hi, li, pad; };

#define CAS __attribute__((address_space(4)))
struct Frame {
    LAS unsigned char* lds;
    int tid, lane, wave, G, gw, NGW;
    const CAS unsigned char* ka;
    __device__ __forceinline__ const float* x() const { return *(const float* const CAS*)(ka + 0); }
    __device__ __forceinline__ const float* c() const { return *(const float* const CAS*)(ka + 8); }
    __device__ __forceinline__ const float* ctx() const { return *(const float* const CAS*)(ka + 16); }
    __device__ __forceinline__ const float* c_ctx() const { return *(const float* const CAS*)(ka + 24); }
    __device__ __forceinline__ const float* w_ada() const { return *(const float* const CAS*)(ka + 32); }
    __device__ __forceinline__ const float* b_ada() const { return *(const float* const CAS*)(ka + 40); }
    __device__ __forceinline__ const float* w_in() const { return *(const float* const CAS*)(ka + 48); }
    __device__ __forceinline__ const float* conv_w() const { return *(const float* const CAS*)(ka + 56); }
    __device__ __forceinline__ const float* sink() const { return *(const float* const CAS*)(ka + 64); }
    __device__ __forceinline__ const float* g_attn() const { return *(const float* const CAS*)(ka + 72); }
    __device__ __forceinline__ const float* g_conv() const { return *(const float* const CAS*)(ka + 80); }
    __device__ __forceinline__ const float* w_out() const { return *(const float* const CAS*)(ka + 88); }
    __device__ __forceinline__ const float* ln1_g() const { return *(const float* const CAS*)(ka + 96); }
    __device__ __forceinline__ const float* ln1_b() const { return *(const float* const CAS*)(ka + 104); }
    __device__ __forceinline__ const float* wq() const { return *(const float* const CAS*)(ka + 112); }
    __device__ __forceinline__ const float* keys() const { return *(const float* const CAS*)(ka + 120); }
    __device__ __forceinline__ const float* pu() const { return *(const float* const CAS*)(ka + 128); }
    __device__ __forceinline__ const float* pv() const { return *(const float* const CAS*)(ka + 136); }
    __device__ __forceinline__ const float* ln2_g() const { return *(const float* const CAS*)(ka + 144); }
    __device__ __forceinline__ const float* ln2_b() const { return *(const float* const CAS*)(ka + 152); }
    __device__ __forceinline__ float* out() const { return *(float* const CAS*)(ka + 160); }
    __device__ __forceinline__ unsigned char* ws() const { return *(unsigned char* const CAS*)(ka + 168); }
    __device__ __forceinline__ float* MODS() const { return (float*)(ws() + WS_MODS); }
    __device__ __forceinline__ float* ROPE() const { return (float*)(ws() + WS_ROPE); }
    __device__ __forceinline__ bf16_t* X() const { return (bf16_t*)(ws() + WS_X); }
    __device__ __forceinline__ bf16_t* SC() const { return (bf16_t*)(ws() + WS_SC); }
    __device__ __forceinline__ bf16_t* KBD() const { return (bf16_t*)(ws() + WS_KBD); }
    __device__ __forceinline__ bf16_t* WQR() const { return (bf16_t*)(ws() + WS_WQR); }
    __device__ __forceinline__ unsigned char* WINT() const { return ws() + WS_WINT; }
    __device__ __forceinline__ unsigned char* H8() const { return ws() + WS_H8; }
    __device__ __forceinline__ unsigned char* WOUTT() const { return ws() + WS_WOUTT; }
    __device__ __forceinline__ bf16_t* WEFFT() const { return (bf16_t*)(ws() + WS_WEFFT); }
    __device__ __forceinline__ bf16_t* H() const { return (bf16_t*)(ws() + WS_H); }
    __device__ __forceinline__ bf16_t* PROJ() const { return (bf16_t*)(ws() + WS_PROJ); }
    __device__ __forceinline__ unsigned char* MIX() const { return ws() + WS_MIX; }
    __device__ __forceinline__ unsigned char* UT() const { return (unsigned char*)(ws() + WS_UT); }
    __device__ __forceinline__ unsigned char* VT() const { return (unsigned char*)(ws() + WS_VT); }
    __device__ __forceinline__ float* US() const { return (float*)(ws() + WS_US); }
    __device__ __forceinline__ float* VS() const { return (float*)(ws() + WS_VS); }
};

__device__ __forceinline__ void frame_ids(Frame& F) {
    int tz = threadIdx.x; asm volatile("" : "+v"(tz));
    F.tid = tz; F.lane = tz & 63; F.wave = __builtin_amdgcn_readfirstlane(tz >> 6);
    F.gw = blockIdx.x * NWAVES + F.wave;
    const CAS unsigned char* k = (const CAS unsigned char*)__builtin_amdgcn_kernarg_segment_ptr(); asm volatile("" : "+s"(k)); F.ka = k;
}
template <int CTRL> __device__ __forceinline__ int dpp_i(int v) { return __builtin_amdgcn_update_dpp(0, v, CTRL, 0xf, 0xf, true); }
template <int CTRL> __device__ __forceinline__ float dpp_f(float v) { return __int_as_float(dpp_i<CTRL>(__float_as_int(v))); }
constexpr int DPP_XOR1 = 0xB1, DPP_XOR2 = 0x4E, DPP_HMIRROR = 0x141, DPP_ROR4 = 0x124, DPP_ROR8 = 0x128;
__device__ __forceinline__ float wave_sum_u(float v) {
    v += dpp_f<DPP_XOR1>(v); v += dpp_f<DPP_XOR2>(v); v += dpp_f<DPP_ROR4>(v); v += dpp_f<DPP_ROR8>(v);
    const float r0 = __int_as_float(__builtin_amdgcn_readlane(__float_as_int(v), 0)), r1 = __int_as_float(__builtin_amdgcn_readlane(__float_as_int(v), 16));
    const float r2 = __int_as_float(__builtin_amdgcn_readlane(__float_as_int(v), 32)), r3 = __int_as_float(__builtin_amdgcn_readlane(__float_as_int(v), 48));
    return (r0 + r1) + (r2 + r3);
}
__device__ __forceinline__ float wave_max_u(float v) {
    v = fmaxf(v, dpp_f<DPP_XOR1>(v)); v = fmaxf(v, dpp_f<DPP_XOR2>(v)); v = fmaxf(v, dpp_f<DPP_ROR4>(v)); v = fmaxf(v, dpp_f<DPP_ROR8>(v));
    const float r0 = __int_as_float(__builtin_amdgcn_readlane(__float_as_int(v), 0)), r1 = __int_as_float(__builtin_amdgcn_readlane(__float_as_int(v), 16));
    const float r2 = __int_as_float(__builtin_amdgcn_readlane(__float_as_int(v), 32)), r3 = __int_as_float(__builtin_amdgcn_readlane(__float_as_int(v), 48));
    return fmaxf(fmaxf(r0, r1), fmaxf(r2, r3));
}
__device__ __forceinline__ float xor32_f(float v, int lane) { return __int_as_float(__builtin_amdgcn_ds_bpermute((lane ^ 32) << 2, __float_as_int(v))); }
__device__ __forceinline__ float wave_sum(float v) { return wave_sum_u(v); }
__device__ __forceinline__ unsigned pk2(float lo, float hi) { return pg8::cvt_pk_bf16(lo, hi); }
__device__ __forceinline__ float bf_lo(unsigned u) { return __uint_as_float(u << 16); }
__device__ __forceinline__ float bf_hi(unsigned u) { return __uint_as_float(u & 0xffff0000u); }
__device__ __forceinline__ int modrow(int t) { return t < TL ? t / SEQ : 2; }

__device__ __forceinline__ void transpose_item(const float* W, int K, int N, bf16_t* WT, LAS float* scr, int item, int lane) {
    const int nblk = N / 32, kb = item / nblk, nb = item % nblk, k0 = 64 * kb, n0 = 32 * nb;
#pragma unroll 8
    for (int i = 0; i < 32; ++i) { const int kk = 2 * i + (lane >> 5); scr[kk * 33 + (lane & 31)] = W[(size_t)(k0 + kk) * N + n0 + (lane & 31)]; }
    LDS_WAIT(); asm volatile("" ::: "memory");
    const int c = lane & 7;
#pragma unroll
    for (int j = 0; j < 4; ++j) { const int n = (lane >> 3) + 8 * j; const LAS float* s = scr + (8 * c) * 33 + n;
        u32x4 o; o.x = pk2(s[0 * 33], s[1 * 33]); o.y = pk2(s[2 * 33], s[3 * 33]); o.z = pk2(s[4 * 33], s[5 * 33]); o.w = pk2(s[6 * 33], s[7 * 33]);
        *(u32x4*)(WT + (size_t)(n0 + n) * K + k0 + 8 * c) = o; }
    LDS_WAIT(); asm volatile("" ::: "memory");
}

__device__ __forceinline__ void transpose_item8(const float* W, int K, int N, unsigned char* WT, LAS float* scr, int item, int lane, float wscale) {
    const int nblk = N / 32, kb = item / nblk, nb = item % nblk, k0 = 64 * kb, n0 = 32 * nb;
    float wv[32];
#pragma unroll
    for (int i = 0; i < 32; ++i) wv[i] = __builtin_nontemporal_load(W + (size_t)(k0 + 2 * i + (lane >> 5)) * N + n0 + (lane & 31));
#pragma unroll
    for (int i = 0; i < 32; ++i) scr[(2 * i + (lane >> 5)) * 33 + (lane & 31)] = wv[i];
    LDS_WAIT(); asm volatile("" ::: "memory");
    const int c = lane & 7;
#pragma unroll
    for (int j = 0; j < 4; ++j) { const int n = (lane >> 3) + 8 * j; const LAS float* s = scr + (8 * c) * 33 + n;
        u32x2 o; int t0 = __builtin_amdgcn_cvt_pk_fp8_f32(s[0 * 33] * wscale, s[1 * 33] * wscale, 0, false); t0 = __builtin_amdgcn_cvt_pk_fp8_f32(s[2 * 33] * wscale, s[3 * 33] * wscale, t0, true);
        int t1 = __builtin_amdgcn_cvt_pk_fp8_f32(s[4 * 33] * wscale, s[5 * 33] * wscale, 0, false); t1 = __builtin_amdgcn_cvt_pk_fp8_f32(s[6 * 33] * wscale, s[7 * 33] * wscale, t1, true);
        o.x = (unsigned)t0; o.y = (unsigned)t1;
        *(u32x2*)(WT + (size_t)(n0 + n) * K + k0 + 8 * c) = o; }
    LDS_WAIT(); asm volatile("" ::: "memory");
}
__device__ __forceinline__ void cvt_row_bf16(const float* src, bf16_t* dst, int lane) {
    const f32x4* s = (const f32x4*)src + lane; u32x2* d = (u32x2*)dst + lane;
    f32x4 v[8];
#pragma unroll
    for (int j = 0; j < 8; ++j) v[j] = __builtin_nontemporal_load(s + 64 * j);
#pragma unroll
    for (int j = 0; j < 8; ++j) { u32x2 o; o.x = pk2(v[j].x, v[j].y); o.y = pk2(v[j].z, v[j].w); d[64 * j] = o; }
}

struct RowF32 { f32x4 v[4][2]; };
__device__ __forceinline__ void row_load_nt(RowF32& R, const float* src, int lane) {
    const f32x4* s = (const f32x4*)src + 2 * lane;
#pragma unroll
    for (int j = 0; j < 4; ++j) { R.v[j][0] = __builtin_nontemporal_load(s + 128 * j); R.v[j][1] = __builtin_nontemporal_load(s + 128 * j + 1); }
}
template <int FMT>
__device__ __forceinline__ void cvt_row_lp(const RowF32& R, unsigned char* dst, float* inv, int lane) {
    constexpr float QMAX = FMT == 8 ? 224.f : 6.f;
    float am = 0.f;
#pragma unroll
    for (int j = 0; j < 4; ++j)
#pragma unroll
        for (int q = 0; q < 2; ++q) am = fmaxf(fmaxf(am, fmaxf(fabsf(R.v[j][q].x), fabsf(R.v[j][q].y))), fmaxf(fabsf(R.v[j][q].z), fabsf(R.v[j][q].w)));
    am = wave_max_u(am);
    const float sc = am > 0.f ? QMAX / am : 1.f;
#pragma unroll
    for (int j = 0; j < 4; ++j) {
        if constexpr (FMT == 8) {
            u32x2 w;
#pragma unroll
            for (int q = 0; q < 2; ++q) { int t = __builtin_amdgcn_cvt_pk_fp8_f32(R.v[j][q].x * sc, R.v[j][q].y * sc, 0, false); t = __builtin_amdgcn_cvt_pk_fp8_f32(R.v[j][q].z * sc, R.v[j][q].w * sc, t, true); w[q] = (unsigned)t; }
            *((u32x2*)dst + lane + 64 * j) = w;
        } else {
            unsigned w = 0u;
            w = __builtin_amdgcn_cvt_scalef32_pk_fp4_f32(w, R.v[j][0].x * sc, R.v[j][0].y * sc, 1.0f, 0);
            w = __builtin_amdgcn_cvt_scalef32_pk_fp4_f32(w, R.v[j][0].z * sc, R.v[j][0].w * sc, 1.0f, 1);
            w = __builtin_amdgcn_cvt_scalef32_pk_fp4_f32(w, R.v[j][1].x * sc, R.v[j][1].y * sc, 1.0f, 2);
            w = __builtin_amdgcn_cvt_scalef32_pk_fp4_f32(w, R.v[j][1].z * sc, R.v[j][1].w * sc, 1.0f, 3);
            *((unsigned*)dst + lane + 64 * j) = w;
        }
    }
    if (lane == 0) *inv = am > 0.f ? am * (1.f / QMAX) : 1.f;
}
template <int FMT> struct LpRow;
template <> struct LpRow<8> { u32x4 a, b;
    __device__ __forceinline__ void load(const unsigned char* rowp, int lane) { a = *(const u32x4*)(rowp + 32 * lane); b = *(const u32x4*)(rowp + 32 * lane + 16); }
    template <class Fn> __device__ __forceinline__ void each(Fn&& f) const {
#pragma unroll
        for (int w = 0; w < 4; ++w) { const f32x2 l0 = __builtin_amdgcn_cvt_pk_f32_fp8((int)a[w], false), h0 = __builtin_amdgcn_cvt_pk_f32_fp8((int)a[w], true);
            f(4 * w, l0.x, l0.y); f(4 * w + 2, h0.x, h0.y); }
#pragma unroll
        for (int w = 0; w < 4; ++w) { const f32x2 l0 = __builtin_amdgcn_cvt_pk_f32_fp8((int)b[w], false), h0 = __builtin_amdgcn_cvt_pk_f32_fp8((int)b[w], true);
            f(16 + 4 * w, l0.x, l0.y); f(16 + 4 * w + 2, h0.x, h0.y); }
    } };
template <> struct LpRow<4> { u32x4 a;
    __device__ __forceinline__ void load(const unsigned char* rowp, int lane) { a = *(const u32x4*)(rowp + 16 * lane); }
    template <class Fn> __device__ __forceinline__ void each(Fn&& f) const {
#pragma unroll
        for (int w = 0; w < 4; ++w) {
            const f32x2 d0 = __builtin_amdgcn_cvt_scalef32_pk_f32_fp4(a[w], 1.0f, 0), d1 = __builtin_amdgcn_cvt_scalef32_pk_f32_fp4(a[w], 1.0f, 1);
            const f32x2 d2 = __builtin_amdgcn_cvt_scalef32_pk_f32_fp4(a[w], 1.0f, 2), d3 = __builtin_amdgcn_cvt_scalef32_pk_f32_fp4(a[w], 1.0f, 3);
            f(8 * w, d0.x, d0.y); f(8 * w + 2, d1.x, d1.y); f(8 * w + 4, d2.x, d2.y); f(8 * w + 6, d3.x, d3.y); }
    }
    template <class Fn> __device__ __forceinline__ void each_bf(Fn&& f) const {
#pragma unroll
        for (int w = 0; w < 4; ++w) {
            f(4 * w, __builtin_amdgcn_cvt_scalef32_pk_bf16_fp4(a[w], 1.0f, 0)); f(4 * w + 1, __builtin_amdgcn_cvt_scalef32_pk_bf16_fp4(a[w], 1.0f, 1));
            f(4 * w + 2, __builtin_amdgcn_cvt_scalef32_pk_bf16_fp4(a[w], 1.0f, 2)); f(4 * w + 3, __builtin_amdgcn_cvt_scalef32_pk_bf16_fp4(a[w], 1.0f, 3)); }
    } };

__device__ __forceinline__ void row_stats(const f32x4 (&v)[8], float& mean, float& rstd) {
    float s = 0.f;
#pragma unroll
    for (int j = 0; j < 8; ++j) s += (v[j].x + v[j].y) + (v[j].z + v[j].w);
    mean = wave_sum(s) * (1.f / D);
    float s2 = 0.f;
#pragma unroll
    for (int j = 0; j < 8; ++j) { const f32x4 d = v[j] - mean; s2 += (d.x * d.x + d.y * d.y) + (d.z * d.z + d.w * d.w); }
    rstd = 1.f / sqrtf(wave_sum(s2) * (1.f / D) + LN_EPS);
}
__device__ __forceinline__ void modulate_store(const f32x4 (&v)[8], const float* shift, const float* scale, bf16_t* dst, int lane) {
    float mean, rstd; row_stats(v, mean, rstd);
    u32x2* d = (u32x2*)dst + lane;
#pragma unroll
    for (int j = 0; j < 8; ++j) { const f32x4 sc = *((const f32x4*)scale + lane + 64 * j), sh = *((const f32x4*)shift + lane + 64 * j);
        const f32x4 y = (v[j] - mean) * rstd * (sc + 1.f) + sh;
        u32x2 o; o.x = pk2(y.x, y.y); o.y = pk2(y.z, y.w); d[64 * j] = o; }
}

__device__ __forceinline__ void convert_tables(Frame& F, int row0, int row1, int w0, int wstride) {
    RowF32 ru, rv, nu, nv;
    int row = row0 + w0;
    if (row < row1) { row_load_nt(ru, F.pu() + (size_t)row * D, F.lane); row_load_nt(rv, F.pv() + (size_t)row * D, F.lane); }
    while (row < row1) {
        const int nrow = row + wstride;
        if (nrow < row1) { row_load_nt(nu, F.pu() + (size_t)nrow * D, F.lane); row_load_nt(nv, F.pv() + (size_t)nrow * D, F.lane); }
        cvt_row_lp<U_FMT>(ru, F.UT() + (size_t)row * UROW, F.US() + 2 * (size_t)row, F.lane);
        cvt_row_lp<V_FMT>(rv, F.VT() + (size_t)row * VROW, F.US() + 2 * (size_t)row + 1, F.lane);
        ru = nu; rv = nv; row = nrow;
    }
}
__device__ __forceinline__ void convert_in_tail(Frame& F, int layer, int nunits, int part) {
    if (layer + 1 >= NLAYER) return;
    const int G = F.G, rounds = (nunits + G - 1) / G, nlast = nunits - (rounds - 1) * G;
    const int c = (int)blockIdx.x;
    int nshort = G - nlast, sidx = c - nlast;
    if (nshort <= 0) { nshort = G; sidx = c; }
    else if (sidx < 0) return;
    const int r0 = (layer + 1) * NEXP + part * (NEXP / 2);
    convert_tables(F, r0, r0 + NEXP / 2, sidx * NWAVES + F.wave, nshort * NWAVES);
}
__device__ __forceinline__ void p0a_prologue(Frame& F) {
    LAS float* condL = (LAS float*)F.lds;
    LAS float* red = (LAS float*)(F.lds + 24576);
    for (int i = F.tid; i < 3 * D; i += NWAVES * 64) { const int r = i / D, k = i % D; const float v = r < 2 ? F.c()[r * D + k] : F.c_ctx()[k]; condL[i] = v / (1.f + __expf(-v)); }
    __syncthreads();
    const bool bal = (F.G == 256);
    for (int pass = 0; pass < (bal ? 2 : 384); ++pass) {
        int item, kw, kbase;
        if (bal) { item = pass == 0 ? (int)blockIdx.x : 256 + ((int)blockIdx.x >> 1); kw = pass == 0 ? 256 : 128; kbase = pass == 0 ? F.wave * 256 : ((int)blockIdx.x & 1) * 1024 + F.wave * 128; }
        else { item = (int)blockIdx.x + pass * F.G; kw = 256; kbase = F.wave * 256; if (item >= 384) break; }
        const int l = item / 96, n0 = (item % 96) * 128;
        const float* wp = F.w_ada() + ((size_t)l * D + kbase) * 12288 + n0 + 2 * F.lane;
        f32x2 a0 = {0.f, 0.f}, a1 = {0.f, 0.f}, a2 = {0.f, 0.f};
#pragma unroll 8
        for (int k = 0; k < kw; ++k) { const f32x2 w = __builtin_nontemporal_load((const f32x2*)(wp + (size_t)k * 12288)); const int kk = kbase + k;
            a0 += w * condL[kk]; a1 += w * condL[D + kk]; a2 += w * condL[2 * D + kk]; }
        LAS float* rp = red + F.wave * 384 + 2 * F.lane;
        rp[0] = a0.x; rp[1] = a0.y; rp[128] = a1.x; rp[129] = a1.y; rp[256] = a2.x; rp[257] = a2.y;
        __syncthreads();
        if (F.tid < 384) { const int r = F.tid / 128, n = F.tid % 128; float s = 0.f;
#pragma unroll
            for (int w = 0; w < 8; ++w) s += red[w * 384 + r * 128 + n];
            if (!(bal && pass == 1 && (blockIdx.x & 1))) s += F.b_ada()[(size_t)l * 12288 + n0 + n];
            atomicAdd(F.MODS() + ((size_t)l * 3 + r) * 12288 + n0 + n, s); }
        __syncthreads();
    }
    LAS float* scr = (LAS float*)(F.lds + 40960 + F.wave * 8448);
    constexpr int I_IN = (D / 64) * (INC / 32), I_OUT = (D / 64) * (D / 32);
    for (int it = F.gw; it < NLAYER * (I_IN + I_OUT); it += F.NGW) {
        const int l = it / (I_IN + I_OUT); int r = it % (I_IN + I_OUT);
        if (r < I_IN) transpose_item8(F.w_in() + (size_t)l * D * INC, D, INC, F.WINT() + (size_t)l * INC * D, scr, r, F.lane, WIN_SCALE);
        else transpose_item8(F.w_out() + (size_t)l * D * D, D, D, F.WOUTT() + (size_t)l * D * D, scr, r - I_IN, F.lane, WOUT_SCALE);
    }
    for (int row = F.gw; row < NLAYER * D; row += F.NGW) {
        const int l = row / D, c = row % D; const f32x4* s = (const f32x4*)(F.wq() + (size_t)row * D) + F.lane;
#pragma unroll
        for (int j = 0; j < 8; ++j) { const f32x4 v = s[64 * j]; u32x2 o; o.x = pk2(v.x, v.y); o.y = pk2(v.z, v.w);
            *((u32x2*)(F.WQR() + ((size_t)(l * 8 + j) * D + c) * 256) + F.lane) = o; }
    }
    for (int row = F.gw; row < 32 * 256; row += F.NGW) {
        const int lh = row >> 8, pk = row & 255, p = pk >> 7;
        u32x2 o = {0u, 0u};
        if ((F.lane >> 5) == p) { const f32x4 v = *((const f32x4*)(F.keys() + ((size_t)lh * 256 + pk) * 128) + (F.lane & 31)); o.x = pk2(v.x, v.y); o.y = pk2(v.z, v.w); }
        *((u32x2*)(F.KBD() + (size_t)row * 256) + F.lane) = o;
    }
    convert_tables(F, 0, NEXP, F.gw, F.NGW);
    for (int i = blockIdx.x * (NWAVES * 64) + F.tid; i < 192 * 32; i += F.G * NWAVES * 64) {
        const int idx = i >> 5, f = i & 31; const float pos = (float)(idx < 128 ? idx : idx - 128);
        const float inv = powf(10000.f, -(float)(2 * f) / 64.f); const float ang = pos * inv;
        F.ROPE()[2 * i] = cosf(ang); F.ROPE()[2 * i + 1] = sinf(ang);
    }
}

__device__ __forceinline__ void p0b_mod0(Frame& F) {
    __syncthreads();
#pragma unroll 1
    for (int v = 0; v < 6; ++v)
        *(LAS f32x4*)(F.lds + v * 8192 + F.tid * 16) = *(const f32x4*)(F.MODS() + (size_t)(v % 3) * 12288 + (v < 3 ? 0 : D) + 4 * F.tid);
    __syncthreads();
    for (int t = F.gw; t < TT; t += F.NGW) {
        const float* src = t < TL ? F.x() + (size_t)t * D : F.ctx() + (size_t)(t - TL) * D;
        f32x4 v[8];
#pragma unroll
        for (int j = 0; j < 8; ++j) v[j] = *((const f32x4*)src + F.lane + 64 * j);
        const int mr = modrow(t);
        float mean, rstd; row_stats(v, mean, rstd);
        unsigned* d = (unsigned*)(F.H8() + (size_t)t * D) + F.lane;
#pragma unroll
        for (int j = 0; j < 8; ++j) { const f32x4 sh = *(const LAS f32x4*)(F.lds + mr * 8192 + (64 * j + F.lane) * 16), sc = *(const LAS f32x4*)(F.lds + (3 + mr) * 8192 + (64 * j + F.lane) * 16);
            const f32x4 y = (v[j] - mean) * rstd * (sc + 1.f) + sh;
            int o = __builtin_amdgcn_cvt_pk_fp8_f32(y.x, y.y, 0, false); o = __builtin_amdgcn_cvt_pk_fp8_f32(y.z, y.w, o, true); d[64 * j] = (unsigned)o; }
    }
}

constexpr int ROPE_LDS = 98304;
constexpr int CONV_LDS = 81920;
constexpr int KP = 272, VP = 320, KS_BYTES = 64 * KP, VS_BYTES = 64 * VP;
struct KVRegs { u32x4 k1, k2, v1, v2; f32x4 cs[4]; };

__device__ __forceinline__ void attn_load_tile(Frame& F, KVRegs& R, int ti, int b, int n, int g) {
    const int key = F.tid >> 3, c8 = F.tid & 7;
    int row, pos = 0;
    if (ti < 6) { pos = (n - 1) * 128 + 64 * ti + key; row = b * SEQ + pos; } else row = TL + b * CTXL + 64 * (ti - 6) + key;
    const bf16_t* base = F.PROJ() + (size_t)row * INC;
    const int d1 = (c8 >> 2) * 64 + (c8 & 3) * 8;
    R.k1 = *(const u32x4*)(base + OFF_K + g * 128 + d1); R.k2 = *(const u32x4*)(base + OFF_K + g * 128 + d1 + 32);
    R.v1 = *(const u32x4*)(base + OFF_V + g * 128 + 8 * c8); R.v2 = *(const u32x4*)(base + OFF_V + g * 128 + 64 + 8 * c8);
    if (ti < 6) { const int tidx = (c8 >> 2) ? 128 + (pos & 63) : (pos >> 6); const LAS f32x4* cp = (const LAS f32x4*)(F.lds + ROPE_LDS + (tidx * 32 + (c8 & 3) * 8) * 8);
#pragma unroll
        for (int m = 0; m < 4; ++m) R.cs[m] = cp[m]; }
}
__device__ __forceinline__ void rope8(u32x4& a, u32x4& bq, const f32x4 (&cs)[4], float scale) {
    u32x4 oa, ob;
#pragma unroll
    for (int w = 0; w < 4; ++w) {
        const float x1l = bf_lo(a[w]), x1h = bf_hi(a[w]), x2l = bf_lo(bq[w]), x2h = bf_hi(bq[w]);
        const float cl = cs[w].x, sl = cs[w].y, ch = cs[w].z, sh = cs[w].w;
        oa[w] = pk2((x1l * cl - x2l * sl) * scale, (x1h * ch - x2h * sh) * scale);
        ob[w] = pk2((x2l * cl + x1l * sl) * scale, (x2h * ch + x1h * sh) * scale);
    }
    a = oa; bq = ob;
}
__device__ __forceinline__ void attn_store_tile(Frame& F, KVRegs& R, int ti, int buf) {
    const int key = F.tid >> 3, c8 = F.tid & 7;
    if (ti < 6) rope8(R.k1, R.k2, R.cs, 1.f);
    const int d1 = (c8 >> 2) * 64 + (c8 & 3) * 8;
    LAS unsigned char* kp = F.lds + buf * KS_BYTES + key * KP;
    *(LAS u32x4*)(kp + d1 * 2) = R.k1; *(LAS u32x4*)(kp + (d1 + 32) * 2) = R.k2;
    LAS unsigned char* vp = F.lds + 2 * KS_BYTES + buf * VS_BYTES + key * VP;
    *(LAS u32x4*)(vp + 16 * c8) = R.v1; *(LAS u32x4*)(vp + 128 + 16 * c8) = R.v2;
}

#define MFMA32(a, b, c) __builtin_amdgcn_mfma_f32_32x32x16_bf16((a), (b), (c), 0, 0, 0)

__device__ __forceinline__ void attn_unit(Frame& F, int layer, int u) {
    const bool latent = u < 512;
    int b, n, g, hp;
    if (latent) { hp = u & 1; g = (u >> 1) & 1; n = (u >> 2) & 63; b = u >> 8; }
    else { const int v = u - 512; hp = v & 1; g = (v >> 1) & 1; n = (v >> 2) & 1; b = v >> 3; }
    const int lane = F.lane, r = lane & 31, h = lane >> 5, wave = F.wave;
    const int head = g * 4 + hp * 2 + (wave >> 2), qb = wave & 3;
    const int tq = latent ? b * SEQ + n * 128 + 32 * qb + r : TL + b * CTXL + n * 128 + 32 * qb + r;
    bf16x8 qf[8];
    {
        u32x4 raw[8];
        const bf16_t* qp = F.PROJ() + (size_t)tq * INC + OFF_Q + head * 128 + 8 * h;
#pragma unroll
        for (int ks = 0; ks < 8; ++ks) raw[ks] = *(const u32x4*)(qp + 16 * ks);
        if (latent) {
            const int pos = n * 128 + 32 * qb + r;
#pragma unroll
            for (int half = 0; half < 2; ++half) {
                const int tidx = half ? 128 + (pos & 63) : (pos >> 6);
#pragma unroll
                for (int kk = 0; kk < 2; ++kk) {
                    const LAS f32x4* cp = (const LAS f32x4*)(F.lds + ROPE_LDS + (tidx * 32 + 16 * kk + 8 * h) * 8);
                    f32x4 cs[4];
#pragma unroll
                    for (int m = 0; m < 4; ++m) cs[m] = cp[m];
                    rope8(raw[4 * half + kk], raw[4 * half + kk + 2], cs, QSCALE);
                }
            }
        } else {
#pragma unroll
            for (int ks = 0; ks < 8; ++ks)
#pragma unroll
                for (int w = 0; w < 4; ++w) raw[ks][w] = pk2(bf_lo(raw[ks][w]) * QSCALE, bf_hi(raw[ks][w]) * QSCALE);
        }
#pragma unroll
        for (int ks = 0; ks < 8; ++ks) qf[ks] = __builtin_bit_cast(bf16x8, raw[ks]);
    }
    int tlo = 6, nw = 0;
    if (latent) { tlo = (n == 0) ? 2 : 0; const int thi = (n == 63) ? 3 : 5; nw = thi - tlo + 1; }
    const int ntiles = nw + 4;
    f32x16 o[4];
#pragma unroll
    for (int db = 0; db < 4; ++db)
#pragma unroll
        for (int i = 0; i < 16; ++i) o[db][i] = 0.f;
    float m_run = F.sink()[layer * 8 + head] * LOG2E;
    float lsum = h == 0 ? 1.f : 0.f;
    const int iq = 32 * qb + r;
    KVRegs R;
    __syncthreads();
    attn_load_tile(F, R, nw > 0 ? tlo : 6, b, n, g);
    attn_store_tile(F, R, nw > 0 ? tlo : 6, 0);
    __syncthreads();
    const int i16 = lane & 15, tq4 = i16 >> 2, tp = i16 & 3, blk = (lane >> 4) & 1;
    for (int j = 0; j < ntiles; ++j) {
        const int ti = j < nw ? tlo + j : 6 + (j - nw);
        const int buf = j & 1;
        const bool more = j + 1 < ntiles;
        const int tin = (j + 1) < nw ? tlo + j + 1 : 6 + (j + 1 - nw);
        if (more) attn_load_tile(F, R, tin, b, n, g);
        const bool part = ti >= 6 || (ti >= (qb >> 1) && ti <= (qb >> 1) + 4);
        if (part) {
            f32x16 s0, s1;
#pragma unroll
            for (int i = 0; i < 16; ++i) { s0[i] = 0.f; s1[i] = 0.f; }
            const LAS unsigned char* kb = F.lds + buf * KS_BYTES + r * KP + h * 16;
#pragma unroll
            for (int ks = 0; ks < 8; ++ks) {
                const bf16x8 a0 = *(const LAS bf16x8*)(kb + ks * 32), a1 = *(const LAS bf16x8*)(kb + 32 * KP + ks * 32);
                s0 = MFMA32(a0, qf[ks], s0); s1 = MFMA32(a1, qf[ks], s1);
            }
            float mx = -INFINITY;
            if (ti < 6 && (ti == (qb >> 1) || ti == (qb >> 1) + 4)) {
                const int jb = 64 * ti + 4 * h - iq;
#pragma unroll
                for (int i = 0; i < 16; ++i) { const int j0 = jb + (i & 3) + 8 * (i >> 2), j1 = j0 + 32;
                    s0[i] = (j0 >= 0 && j0 <= 256) ? s0[i] : -INFINITY; s1[i] = (j1 >= 0 && j1 <= 256) ? s1[i] : -INFINITY; }
            }
#pragma unroll
            for (int i = 0; i < 16; ++i) mx = fmaxf(mx, fmaxf(s0[i], s1[i]));
            mx = fmaxf(mx, xor32_f(mx, lane));
            if (__any(mx > m_run + 8.f)) {
                const float m_new = mx > m_run + 8.f ? mx : m_run, alpha = __builtin_amdgcn_exp2f(m_run - m_new);
                m_run = m_new; lsum *= alpha;
#pragma unroll
                for (int db = 0; db < 4; ++db)
#pragma unroll
                    for (int i = 0; i < 16; ++i) o[db][i] *= alpha;
            }
#pragma unroll
            for (int i = 0; i < 16; ++i) { s0[i] = __builtin_amdgcn_exp2f(s0[i] - m_run); s1[i] = __builtin_amdgcn_exp2f(s1[i] - m_run); lsum += s0[i] + s1[i]; }
            bf16x8 pf[2][2];
#pragma unroll
            for (int s2 = 0; s2 < 2; ++s2) {
                u32x4 p0, p1;
#pragma unroll
                for (int w = 0; w < 4; ++w) { p0[w] = pk2(s0[8 * s2 + 2 * w], s0[8 * s2 + 2 * w + 1]); p1[w] = pk2(s1[8 * s2 + 2 * w], s1[8 * s2 + 2 * w + 1]); }
                pf[0][s2] = __builtin_bit_cast(bf16x8, p0); pf[1][s2] = __builtin_bit_cast(bf16x8, p1);
            }
            const LAS unsigned char* vb = F.lds + 2 * KS_BYTES + buf * VS_BYTES + (4 * h + tq4) * VP + 32 * blk + 8 * tp;
#pragma unroll
            for (int db = 0; db < 4; ++db)
#pragma unroll
                for (int kb2 = 0; kb2 < 2; ++kb2)
#pragma unroll
                    for (int s2 = 0; s2 < 2; ++s2) {
                        const int off = (32 * kb2 + 16 * s2) * VP + db * 64;
                        const s16x4 lo = __builtin_amdgcn_ds_read_tr16_b64_v4i16((LAS s16x4*)(vb + off));
                        const s16x4 hi = __builtin_amdgcn_ds_read_tr16_b64_v4i16((LAS s16x4*)(vb + off + 8 * VP));
                        const bf16x8 av = __builtin_shufflevector(lo, hi, 0, 1, 2, 3, 4, 5, 6, 7);
                        o[db] = MFMA32(av, pf[kb2][s2], o[db]);
                    }
        }
        if (more) attn_store_tile(F, R, tin, buf ^ 1);
        __syncthreads();
    }
    const float lt = lsum + xor32_f(lsum, lane);
    const float inv = 1.f / lt;
    float ss = 0.f;
#pragma unroll
    for (int db = 0; db < 4; ++db)
#pragma unroll
        for (int i = 0; i < 16; ++i) { o[db][i] *= inv; ss += o[db][i] * o[db][i]; }
    ss += xor32_f(ss, lane);
    const float rn = 1.f / sqrtf(ss * (1.f / 128.f) + LN_EPS);
    unsigned char* op = F.MIX() + (size_t)tq * D + head * 128 + 4 * h;
    const float* gp = F.g_attn() + layer * 1024 + head * 128 + 4 * h;
#pragma unroll
    for (int db = 0; db < 4; ++db)
#pragma unroll
        for (int g4 = 0; g4 < 4; ++g4) {
            const f32x4 gv = *(const f32x4*)(gp + 32 * db + 8 * g4);
            int w = __builtin_amdgcn_cvt_pk_fp8_f32(o[db][4 * g4] * rn * gv.x, o[db][4 * g4 + 1] * rn * gv.y, 0, false);
            w = __builtin_amdgcn_cvt_pk_fp8_f32(o[db][4 * g4 + 2] * rn * gv.z, o[db][4 * g4 + 3] * rn * gv.w, w, true);
            *(unsigned*)(op + 32 * db + 8 * g4) = (unsigned)w;
        }
}

__device__ __forceinline__ void unpack8(const u32x4 v, float (&f)[8]) {
#pragma unroll
    for (int w = 0; w < 4; ++w) { f[2 * w] = bf_lo(v[w]); f[2 * w + 1] = bf_hi(v[w]); }
}
__device__ __forceinline__ void conv_row(Frame& F, int layer, int t) {
    bool first, last;
    if (t < TL) { const int pos = t & (SEQ - 1); first = pos == 0; last = pos == SEQ - 1; } else { const int pc = (t - TL) & (CTXL - 1); first = pc == 0; last = pc == CTXL - 1; }
    const bf16_t* p = F.PROJ() + (size_t)t * INC;
    const LAS unsigned char* cvc = F.lds + CONV_LDS + F.lane * 16;
#pragma unroll
    for (int jc = 0; jc < 2; ++jc) {
        const int c = 8 * F.lane + 512 * jc;
        float gb[8], a[8], bq[8], um[8], ut[8], up[8];
        unpack8(*(const u32x4*)(p + c), gb);
        unpack8(*(const u32x4*)(p + OFF_C + c), a); unpack8(*(const u32x4*)(p + OFF_X + c), bq);
#pragma unroll
        for (int e = 0; e < 8; ++e) ut[e] = a[e] * bq[e];
        if (!first) { unpack8(*(const u32x4*)(p - INC + OFF_C + c), a); unpack8(*(const u32x4*)(p - INC + OFF_X + c), bq);
#pragma unroll
            for (int e = 0; e < 8; ++e) um[e] = a[e] * bq[e]; }
        else {
#pragma unroll
            for (int e = 0; e < 8; ++e) um[e] = 0.f; }
        if (!last) { unpack8(*(const u32x4*)(p + INC + OFF_C + c), a); unpack8(*(const u32x4*)(p + INC + OFF_X + c), bq);
#pragma unroll
            for (int e = 0; e < 8; ++e) up[e] = a[e] * bq[e]; }
        else {
#pragma unroll
            for (int e = 0; e < 8; ++e) up[e] = 0.f; }
        float y[8], ss = 0.f;
#pragma unroll
        for (int q = 0; q < 2; ++q) { const f32x4 w0 = *(const LAS f32x4*)(cvc + (2 * jc + q) * 1024), w1 = *(const LAS f32x4*)(cvc + 4096 + (2 * jc + q) * 1024), w2 = *(const LAS f32x4*)(cvc + 8192 + (2 * jc + q) * 1024);
#pragma unroll
            for (int e = 0; e < 4; ++e) { const int i = 4 * q + e; y[i] = gb[i] * (w0[e] * um[i] + w1[e] * ut[i] + w2[e] * up[i]); ss += y[i] * y[i]; } }
        ss += dpp_f<DPP_XOR1>(ss); ss += dpp_f<DPP_XOR2>(ss); ss += dpp_f<DPP_ROR4>(ss); ss += dpp_f<DPP_ROR8>(ss);
        const float rn = 1.f / sqrtf(ss * (1.f / 128.f) + LN_EPS);
        u32x2 w;
#pragma unroll
        for (int q = 0; q < 2; ++q) { const f32x4 gcv = *(const LAS f32x4*)(cvc + 12288 + (2 * jc + q) * 1024);
            int t8 = __builtin_amdgcn_cvt_pk_fp8_f32(y[4 * q] * rn * gcv[0], y[4 * q + 1] * rn * gcv[1], 0, false); t8 = __builtin_amdgcn_cvt_pk_fp8_f32(y[4 * q + 2] * rn * gcv[2], y[4 * q + 3] * rn * gcv[3], t8, true); w[q] = (unsigned)t8; }
        *(u32x2*)(F.MIX() + (size_t)t * D + 1024 + c) = w;
    }
}

__device__ __forceinline__ void ln_phase(Frame& F, int layer, int rows) {
    const int lane = F.lane;
    const bf16_t* Y = F.PROJ();
    u32x4 w[4], wn[4], yw[4], yn[4];
    int t = F.gw;
    if (t < rows) {
#pragma unroll
        for (int j = 0; j < 4; ++j) { yw[j] = *(const u32x4*)(Y + (size_t)t * D + 8 * lane + 512 * j); if (layer > 0) w[j] = *(const u32x4*)(F.X() + (size_t)t * D + 8 * lane + 512 * j); }
    }
    {
        const int ch = F.tid, jj = ch >> 7, rem = ch & 127, ll = rem >> 1, qq = rem & 1;
        LAS unsigned char* dst = F.lds + ((2 * jj + qq) * 64 + ll) * 16;
        *(LAS f32x4*)(dst) = *(const f32x4*)(F.ln1_g() + layer * D + 4 * ch);
        *(LAS f32x4*)(dst + 8192) = *(const f32x4*)(F.ln1_b() + layer * D + 4 * ch);
#pragma unroll 1
        for (int v = 0; v < 9; ++v) { const int mrv = v % 3; const size_t off = ((size_t)layer * 3 + mrv) * 12288 + (v < 3 ? 3 * D : (v < 6 ? 4 * D : 2 * D));
            *(LAS f32x4*)(dst + (2 + v) * 8192) = *(const f32x4*)(F.MODS() + off + 4 * ch); }
    }
    __syncthreads();
    const LAS unsigned char* vc = F.lds + lane * 16;
    while (t < rows) {
        const int tn = t + F.NGW;
        if (tn < rows) {
#pragma unroll
            for (int j = 0; j < 4; ++j) { yn[j] = *(const u32x4*)(Y + (size_t)tn * D + 8 * lane + 512 * j); if (layer > 0) wn[j] = *(const u32x4*)(F.X() + (size_t)tn * D + 8 * lane + 512 * j); }
        }
        const int mrl = modrow(t);
        float v[32]; float s = 0.f;
#pragma unroll
        for (int j = 0; j < 4; ++j) {
            float xin[8], yv[8];
            unpack8(yw[j], yv);
            if (layer > 0) unpack8(w[j], xin);
            else { const float* xp = (t < TL ? F.x() + (size_t)t * D : F.ctx() + (size_t)(t - TL) * D) + 8 * lane + 512 * j; const f32x4 a0 = *(const f32x4*)xp, a1 = *(const f32x4*)(xp + 4);
                xin[0] = a0[0]; xin[1] = a0[1]; xin[2] = a0[2]; xin[3] = a0[3]; xin[4] = a1[0]; xin[5] = a1[1]; xin[6] = a1[2]; xin[7] = a1[3]; }
#pragma unroll
            for (int q = 0; q < 2; ++q) { const f32x4 ga = *(const LAS f32x4*)(vc + (8 + mrl) * 8192 + (2 * j + q) * 1024);
#pragma unroll
                for (int e = 0; e < 4; ++e) { const float r = DN_ALPHA * xin[4 * q + e] + ga[e] * yv[4 * q + e]; v[8 * j + 4 * q + e] = r; s += r; } } }
        const float mean = wave_sum(s) * (1.f / D);
        float s2 = 0.f;
#pragma unroll
        for (int i = 0; i < 32; ++i) { v[i] -= mean; s2 += v[i] * v[i]; }
        const float rstd = 1.f / sqrtf(wave_sum(s2) * (1.f / D) + LN_EPS);
        float s3 = 0.f;
#pragma unroll
        for (int j = 0; j < 4; ++j) { const int c = 8 * lane + 512 * j; u32x4 o;
#pragma unroll
            for (int q = 0; q < 2; ++q) { const f32x4 gg = *(const LAS f32x4*)(vc + (2 * j + q) * 1024), bb = *(const LAS f32x4*)(vc + 8192 + (2 * j + q) * 1024);
#pragma unroll
                for (int e = 0; e < 4; ++e) { const float y = v[8 * j + 4 * q + e] * rstd * gg[e] + bb[e]; v[8 * j + 4 * q + e] = y; s3 += y; }
                o[2 * q] = pk2(v[8 * j + 4 * q], v[8 * j + 4 * q + 1]); o[2 * q + 1] = pk2(v[8 * j + 4 * q + 2], v[8 * j + 4 * q + 3]); }
            *(u32x4*)(F.X() + (size_t)t * D + c) = o; }
        const float mean2 = wave_sum(s3) * (1.f / D);
        float s4 = 0.f;
#pragma unroll
        for (int i = 0; i < 32; ++i) { v[i] -= mean2; s4 += v[i] * v[i]; }
        const float rstd2 = 1.f / sqrtf(wave_sum(s4) * (1.f / D) + LN_EPS);
#pragma unroll
        for (int j = 0; j < 4; ++j) { const int c = 8 * lane + 512 * j; u32x4 o;
#pragma unroll
            for (int q = 0; q < 2; ++q) { const f32x4 sh = *(const LAS f32x4*)(vc + (2 + mrl) * 8192 + (2 * j + q) * 1024), sc = *(const LAS f32x4*)(vc + (5 + mrl) * 8192 + (2 * j + q) * 1024);
                const float y0 = v[8 * j + 4 * q] * rstd2 * (1.f + sc[0]) + sh[0], y1 = v[8 * j + 4 * q + 1] * rstd2 * (1.f + sc[1]) + sh[1];
                const float y2 = v[8 * j + 4 * q + 2] * rstd2 * (1.f + sc[2]) + sh[2], y3 = v[8 * j + 4 * q + 3] * rstd2 * (1.f + sc[3]) + sh[3];
                o[2 * q] = pk2(y0, y1); o[2 * q + 1] = pk2(y2, y3); }
            *(u32x4*)(F.H() + (size_t)t * D + c) = o; }
#pragma unroll
        for (int j = 0; j < 4; ++j) { w[j] = wn[j]; yw[j] = yn[j]; }
        t = tn;
    }
}

__device__ __forceinline__ unsigned ordkey(float f) { const unsigned u = __float_as_uint(f); return u ^ ((u >> 31) ? 0xFFFFFFFFu : 0x80000000u); }
__device__ __forceinline__ float gelu_erf(float a) { return 0.5f * a * (1.f + erff(a * 0.70710678118654752f)); }

__device__ __forceinline__ float unordkey(unsigned k) { return __uint_as_float(k ^ ((k >> 31) ? 0x80000000u : 0xFFFFFFFFu)); }
__device__ __forceinline__ float gelu_as(float v) {
    const float av = fabsf(v), t = __builtin_amdgcn_rcpf(av * 0.2316418882f + 1.0f);
    float q = t * 0.5307027145f + (-0.7265760135f); q = q * t + 0.7107068705f; q = q * t + (-0.142248368f); q = q * t + 0.127414796f; q = q * t;
    const float e = __builtin_amdgcn_exp2f((v * v) * (-0.72134752044f));
    const float m = v * (q * e);
    return v < 0.f ? m : v - m;
}

template <class O> struct QuadNet {
    typedef typename O::V V; typedef typename O::B B;
    template <bool ASC> static __device__ __forceinline__ void ce_reg(V& a, V& b) { const V lo = O::vmin(a, b), hi = O::vmax(a, b); a = ASC ? lo : hi; b = ASC ? hi : lo; }
    template <bool ASC> static __device__ __forceinline__ void ce_l1(V& x, B low1) { const V p = O::x1(x); const V mn = O::vmin(p, x), mx = O::vmax(p, x); x = ASC ? O::vsel(low1, mn, mx) : O::vsel(low1, mx, mn); }
    template <bool ASC> static __device__ __forceinline__ void ce_l2(V& x, B low2) { const V p = O::x2(x); const V mn = O::vmin(p, x), mx = O::vmax(p, x); x = ASC ? O::vsel(low2, mn, mx) : O::vsel(low2, mx, mn); }
    template <int NR> static __device__ __forceinline__ void sort_blocks(V (&R)[NR], B low1, B low2, B eq12) {
#pragma unroll
        for (int r = 0; r < NR; ++r) { const V p = O::x1(R[r]); const V mn = O::vmin(p, R[r]), mx = O::vmax(p, R[r]); R[r] = O::vsel(eq12, mn, mx); }
#pragma unroll
        for (int r = 0; r < NR; ++r) { if ((r & 1) == 0) ce_l2<true>(R[r], low2); else ce_l2<false>(R[r], low2); }
#pragma unroll
        for (int r = 0; r < NR; ++r) { if ((r & 1) == 0) ce_l1<true>(R[r], low1); else ce_l1<false>(R[r], low1); }
#pragma unroll
        for (int r = 0; r < NR; r += 2) { if ((r & 2) == 0) ce_reg<true>(R[r], R[r + 1]); else ce_reg<false>(R[r], R[r + 1]); }
#pragma unroll
        for (int r = 0; r < NR; ++r) { if ((r & 2) == 0) ce_l2<true>(R[r], low2); else ce_l2<false>(R[r], low2); }
#pragma unroll
        for (int r = 0; r < NR; ++r) { if ((r & 2) == 0) ce_l1<true>(R[r], low1); else ce_l1<false>(R[r], low1); }
#pragma unroll
        for (int r = 0; r < NR; ++r) { if ((r & 2) == 0) { if ((r & 4) == 0) ce_reg<true>(R[r], R[r + 2]); else ce_reg<false>(R[r], R[r + 2]); } }
#pragma unroll
        for (int r = 0; r < NR; r += 2) { if ((r & 4) == 0) ce_reg<true>(R[r], R[r + 1]); else ce_reg<false>(R[r], R[r + 1]); }
#pragma unroll
        for (int r = 0; r < NR; ++r) { if ((r & 4) == 0) ce_l2<true>(R[r], low2); else ce_l2<false>(R[r], low2); }
#pragma unroll
        for (int r = 0; r < NR; ++r) { if ((r & 4) == 0) ce_l1<true>(R[r], low1); else ce_l1<false>(R[r], low1); }
    }
    template <int NR> static __device__ __forceinline__ void halve_merge(const V (&R)[NR], V (&Q)[NR / 2], B low1, B low2) {
#pragma unroll
        for (int m = 0; m < NR / 8; ++m)
#pragma unroll
            for (int i = 0; i < 4; ++i) Q[4 * m + i] = O::vmax(R[8 * m + i], R[8 * m + 4 + i]);
#pragma unroll
        for (int r = 0; r < NR / 2; ++r) { if ((r & 2) == 0) { if ((r & 4) == 0) ce_reg<false>(Q[r], Q[r + 2]); else ce_reg<true>(Q[r], Q[r + 2]); } }
#pragma unroll
        for (int r = 0; r < NR / 2; r += 2) { if ((r & 4) == 0) ce_reg<false>(Q[r], Q[r + 1]); else ce_reg<true>(Q[r], Q[r + 1]); }
#pragma unroll
        for (int r = 0; r < NR / 2; ++r) { if ((r & 4) == 0) ce_l2<false>(Q[r], low2); else ce_l2<true>(Q[r], low2); }
#pragma unroll
        for (int r = 0; r < NR / 2; ++r) { if ((r & 4) == 0) ce_l1<false>(Q[r], low1); else ce_l1<true>(Q[r], low1); }
    }
    static __device__ __forceinline__ void top16_of_128(V (&R)[32], V (&T)[4], B low1, B low2, B eq12) {
        sort_blocks<32>(R, low1, low2, eq12);
        V A[16]; halve_merge<32>(R, A, low1, low2);
        V Bq[8]; halve_merge<16>(A, Bq, low1, low2);
        halve_merge<8>(Bq, T, low1, low2);
    }
    static __device__ __forceinline__ void top16_of_64(V (&R)[16], V (&T)[4], B low1, B low2, B eq12) {
        sort_blocks<16>(R, low1, low2, eq12);
        V A[8]; halve_merge<16>(R, A, low1, low2);
        halve_merge<8>(A, T, low1, low2);
    }
};

struct DevOps {
    typedef unsigned V; typedef bool B;
    static __device__ __forceinline__ V vmin(V a, V b) { return a < b ? a : b; }
    static __device__ __forceinline__ V vmax(V a, V b) { return a > b ? a : b; }
    static __device__ __forceinline__ V vsel(B m, V a, V b) { return m ? a : b; }
    static __device__ __forceinline__ V x1(V a) { return (V)dpp_i<DPP_XOR1>((int)a); }
    static __device__ __forceinline__ V x2(V a) { return (V)dpp_i<DPP_XOR2>((int)a); }
};
__device__ __forceinline__ void stair_ab(int c, int& a, int& b) {
    if (c < 16) { a = 0; b = c; } else if (c < 24) { a = 1; b = c - 16; } else if (c < 28) { a = 2; b = c - 24; } else if (c < 32) { a = 3; b = c - 28; }
    else if (c < 36) { a = 4; b = c - 32; } else if (c < 40) { a = 5 + ((c - 36) >> 1); b = (c - 36) & 1; } else if (c < 44) { a = 7 + ((c - 40) >> 1); b = (c - 40) & 1; }
    else if (c < 48) { a = 9 + (c - 44); b = 0; } else if (c < 51) { a = 13 + (c - 48); b = 0; } else { a = 2; b = 4; }
}
constexpr int PE_WS = 5120, PE_TAB = 8 * PE_WS;
constexpr int PE_VEC = PE_TAB + 512;
static_assert(PE_VEC + 11 * 8192 <= LDSCTL_OFF, "PE vector cache");
__device__ __forceinline__ void peer_topk(Frame& F, LAS unsigned char* ws, int t) {
    const int lane = F.lane, sub = lane & 3;
    const bool low1 = (sub & 1) == 0, low2 = (sub & 2) == 0, eq12 = low1 == low2;
    LAS unsigned* S1K = (LAS unsigned*)ws; LAS int* EL = (LAS int*)(ws + 3328); LAS float* GL = (LAS float*)(ws + 3840);
    const LAS unsigned short* TAB = (const LAS unsigned short*)(F.lds + PE_TAB);
    {
        const int L = lane >> 2;
        const bf16_t* sp = F.SC() + (size_t)t * D + L * 128 + sub * 32;
        unsigned R[32];
#pragma unroll
        for (int q = 0; q < 4; ++q) { const u32x4 v = *(const u32x4*)(sp + 8 * q);
#pragma unroll
            for (int e = 0; e < 4; ++e) {
                R[8 * q + 2 * e] = (ordkey(bf_lo(v[e])) & ~127u) | (unsigned)(127 - (32 * sub + 8 * q + 2 * e));
                R[8 * q + 2 * e + 1] = (ordkey(bf_hi(v[e])) & ~127u) | (unsigned)(127 - (32 * sub + 8 * q + 2 * e + 1)); } }
        unsigned T[4];
        QuadNet<DevOps>::top16_of_128(R, T, low1, low2, eq12);
#pragma unroll
        for (int r = 0; r < 4; ++r) S1K[L * 16 + 4 * r + sub] = T[r];
    }
    LDS_WAIT(); __builtin_amdgcn_wave_barrier();
    {
        const int hd = (lane >> 2) & 7;
        const LAS unsigned char* la = (const LAS unsigned char*)(S1K + (2 * hd) * 16); const LAS unsigned char* lb = (const LAS unsigned char*)(S1K + (2 * hd + 1) * 16);
        unsigned C[16];
#pragma unroll
        for (int r = 0; r < 13; ++r) { const unsigned ab = TAB[4 * r + sub];
            const unsigned ka = *(const LAS unsigned*)(la + (ab & 255u)), kb = *(const LAS unsigned*)(lb + (ab >> 8));
            const float sum = unordkey(ka & ~127u) + unordkey(kb & ~127u);
            C[r] = (ordkey(sum) & ~63u) | (unsigned)(63 - (4 * r + sub)); }
        C[13] = 0u; C[14] = 0u; C[15] = 0u;
        unsigned W[4];
        QuadNet<DevOps>::top16_of_64(C, W, low1, low2, eq12);
        float sv[4]; int ex[4];
#pragma unroll
        for (int r = 0; r < 4; ++r) { const unsigned ab = TAB[63 - (W[r] & 63u)];
            const unsigned ka = *(const LAS unsigned*)(la + (ab & 255u)), kb = *(const LAS unsigned*)(lb + (ab >> 8));
            ex[r] = (int)(127u - (ka & 127u)) * 128 + (int)(127u - (kb & 127u)); sv[r] = unordkey(W[r] & ~63u); }
        const float mx = dpp_f<0x00>(sv[0]);
        float e4[4], es = 0.f;
#pragma unroll
        for (int r = 0; r < 4; ++r) { e4[r] = __expf(sv[r] - mx); es += e4[r]; }
        es += dpp_f<DPP_XOR1>(es); es += dpp_f<DPP_XOR2>(es);
        const float rd = 1.f / es;
#pragma unroll
        for (int r = 0; r < 4; ++r) { GL[hd * 16 + 4 * r + sub] = e4[r] * rd; EL[hd * 16 + 4 * r + sub] = ex[r]; }
    }
    LDS_WAIT(); __builtin_amdgcn_wave_barrier();
}

#ifndef PROBE_PHASE
#define PROBE_PHASE -1
#endif
#ifndef PROBE_MULT
#define PROBE_MULT 1
#endif
constexpr int EB = 4;
constexpr int CW_TICKET = 20480;

struct GBuf { LpRow<U_FMT> u[EB]; LpRow<V_FMT> v[EB]; };
__device__ __forceinline__ void gather_issue(GBuf& B, const LAS int* EL, int i0, const unsigned char* UTl, const unsigned char* VTl, int lane) {
#pragma unroll
    for (int q = 0; q < EB; ++q) {
        const int ex = __builtin_amdgcn_readfirstlane(EL[i0 + q]);
        B.u[q].load(UTl + (size_t)ex * UROW, lane); B.v[q].load(VTl + (size_t)ex * VROW, lane);
    }
}
__device__ __forceinline__ void gather_compute(const GBuf& B, const LAS int* EL, const LAS float* GL, int i0, const float* USl, const float* VSl, const unsigned (&hv)[16], f32x2 (&acc)[16]) {
    float dot[EB], su[EB], sv[EB], g[EB];
#pragma unroll
    for (int q = 0; q < EB; ++q) { const int ex = __builtin_amdgcn_readfirstlane(EL[i0 + q]); { const f32x2 s2 = *(const f32x2*)(USl + 2 * ex); su[q] = s2.x; sv[q] = s2.y; }
        g[q] = __uint_as_float(__builtin_amdgcn_readfirstlane(__float_as_uint(GL[i0 + q]))); }
#pragma unroll
    for (int q = 0; q < EB; ++q) { float s0 = 0.f, s1 = 0.f;
        B.u[q].each_bf([&](int i, bf16x2_t x) { if (i & 1) s1 = __builtin_amdgcn_fdot2_f32_bf16(x, __builtin_bit_cast(bf16x2_t, hv[i]), s1, false); else s0 = __builtin_amdgcn_fdot2_f32_bf16(x, __builtin_bit_cast(bf16x2_t, hv[i]), s0, false); });
        dot[q] = s0 + s1; __builtin_amdgcn_sched_barrier(0); }
#pragma unroll
    for (int q = 0; q < EB; ++q) dot[q] = wave_sum_u(dot[q]);
#pragma unroll
    for (int q = 0; q < EB; ++q) { const float cf = g[q] * gelu_as(dot[q] * su[q]) * sv[q]; const f32x2 c2 = {cf, cf};
        B.v[q].each([&](int i, float x0, float x1) { const f32x2 x = {x0, x1}; acc[i >> 1] = __builtin_elementwise_fma(x, c2, acc[i >> 1]); }); __builtin_amdgcn_sched_barrier(0); }
}

__device__ __forceinline__ void peer_phase(Frame& F, int layer, int rows, unsigned* ctl, unsigned long long& pr_acc) {
    unsigned long long pt0 = 0ull;
#define SUB_BEGIN(ty) do { if (PROBE_PHASE == (ty)) pt0 = __builtin_amdgcn_s_memrealtime(); } while (0)
#define SUB_END(ty) do { if (PROBE_PHASE == (ty)) pr_acc += __builtin_amdgcn_s_memrealtime() - pt0; } while (0)
    if (F.tid < 64) { int a = 0, b = 0; stair_ab(F.tid < 52 ? F.tid : 0, a, b); *(LAS unsigned short*)(F.lds + PE_TAB + 2 * F.tid) = (unsigned short)((4 * a) | ((4 * b) << 8)); }
    {
        const int ch = F.tid, ll = ch >> 3, q = ch & 7;
        LAS unsigned char* dst = F.lds + PE_VEC + (q * 64 + ll) * 16;
        const int nl = layer < NLAYER - 1 ? layer + 1 : layer;
#pragma unroll 1
        for (int v = 0; v < 9; ++v) {
            const int g3 = v / 3, mrv = v - 3 * g3;
            const size_t off = ((size_t)(g3 == 0 ? layer : nl) * 3 + mrv) * 12288 + (g3 == 0 ? 5 * D : (g3 == 1 ? 0 : D));
            *(LAS f32x4*)(dst + v * 8192) = *(const f32x4*)(F.MODS() + off + 4 * ch);
        }
        *(LAS f32x4*)(dst + 9 * 8192) = *(const f32x4*)(F.ln2_g() + layer * D + 4 * ch);
        *(LAS f32x4*)(dst + 10 * 8192) = *(const f32x4*)(F.ln2_b() + layer * D + 4 * ch);
    }
    __syncthreads();
    LAS unsigned char* ws = F.lds + F.wave * PE_WS;
    LAS int* EL = (LAS int*)(ws + 3328); LAS float* GL = (LAS float*)(ws + 3840);
    const int lane = F.lane;
    const LAS unsigned char* vcache = F.lds + PE_VEC + lane * 16;
    const unsigned char* UTl = F.UT() + (size_t)layer * NEXP * UROW;
    const unsigned char* VTl = F.VT() + (size_t)layer * NEXP * VROW;
    const float* USl = F.US() + 2 * (size_t)layer * NEXP; const float* VSl = nullptr;
    unsigned* ticket = ctl + CW_TICKET + 64 * layer;
    unsigned tk = 0u;
    if (lane == 0) tk = __hip_atomic_fetch_add(ticket, 1u, __ATOMIC_RELAXED, __HIP_MEMORY_SCOPE_AGENT);
    int t = (int)__builtin_amdgcn_readfirstlane(tk);
    while (t < rows) {
        unsigned tkn = 0u;
        if (lane == 0) tkn = __hip_atomic_fetch_add(ticket, 1u, __ATOMIC_RELAXED, __HIP_MEMORY_SCOPE_AGENT);
        SUB_BEGIN(8); peer_topk(F, ws, t); SUB_END(8);
        SUB_BEGIN(9);
        unsigned hv[16]; f32x2 acc[16];
#pragma unroll
        for (int q = 0; q < 4; ++q) { const u32x4 w = *(const u32x4*)(F.H() + (size_t)t * D + 32 * lane + 8 * q);
#pragma unroll
            for (int e = 0; e < 4; ++e) { hv[4 * q + e] = w[e]; acc[4 * q + e] = (f32x2){0.f, 0.f}; } }
        {
            GBuf A, B, C;
            gather_issue(A, EL, 0, UTl, VTl, lane);
            gather_issue(B, EL, EB, UTl, VTl, lane);
            for (int i0 = 0; i0 < 30 * EB; i0 += 3 * EB) {
                gather_issue(C, EL, i0 + 2 * EB, UTl, VTl, lane);
                gather_compute(A, EL, GL, i0, USl, VSl, hv, acc);
                gather_issue(A, EL, i0 + 3 * EB, UTl, VTl, lane);
                gather_compute(B, EL, GL, i0 + EB, USl, VSl, hv, acc);
                gather_issue(B, EL, i0 + 4 * EB, UTl, VTl, lane);
                gather_compute(C, EL, GL, i0 + 2 * EB, USl, VSl, hv, acc);
            }
            gather_compute(A, EL, GL, 30 * EB, USl, VSl, hv, acc);
            gather_compute(B, EL, GL, 31 * EB, USl, VSl, hv, acc);
        }
        SUB_END(9); SUB_BEGIN(10);
        const int mr = modrow(t);
        const float* mp = F.MODS() + ((size_t)layer * 3 + mr) * 12288;
        bf16_t* xr = F.X() + (size_t)t * D;
        float rr[32]; float s = 0.f;
#pragma unroll
        for (int q2 = 0; q2 < 4; ++q2) { const u32x4 xw = *(const u32x4*)(xr + 32 * lane + 8 * q2);
#pragma unroll
            for (int h2 = 0; h2 < 2; ++h2) { const int q = 2 * q2 + h2; const f32x4 gv = *(const LAS f32x4*)(vcache + mr * 8192 + q * 1024);
                const f32x4 xv = {bf_lo(xw[2 * h2]), bf_hi(xw[2 * h2]), bf_lo(xw[2 * h2 + 1]), bf_hi(xw[2 * h2 + 1])};
                const f32x4 av = {acc[2 * q].x, acc[2 * q].y, acc[2 * q + 1].x, acc[2 * q + 1].y};
#pragma unroll
                for (int e = 0; e < 4; ++e) { const float v = DN_ALPHA * xv[e] + gv[e] * av[e]; rr[4 * q + e] = v; s += v; } } }
        const float mean = wave_sum_u(s) * (1.f / D);
        float s2 = 0.f;
#pragma unroll
        for (int i = 0; i < 32; ++i) { rr[i] -= mean; s2 += rr[i] * rr[i]; }
        const float rstd = 1.f / sqrtf(wave_sum_u(s2) * (1.f / D) + LN_EPS);
        const float* g2 = F.ln2_g() + layer * D; const float* b2 = F.ln2_b() + layer * D;
        float s3 = 0.f;
#pragma unroll
        for (int q = 0; q < 8; ++q) { const int c = 32 * lane + 4 * q; const f32x4 gg = *(const LAS f32x4*)(vcache + 9 * 8192 + q * 1024), bb = *(const LAS f32x4*)(vcache + 10 * 8192 + q * 1024);
            f32x4 xo;
#pragma unroll
            for (int e = 0; e < 4; ++e) { xo[e] = rr[4 * q + e] * rstd * gg[e] + bb[e]; rr[4 * q + e] = xo[e]; s3 += xo[e]; }
            if (layer == NLAYER - 1 && t < TL) *(f32x4*)(F.out() + (size_t)t * D + c) = xo; }
        if (layer < NLAYER - 1) {
#pragma unroll
            for (int q2 = 0; q2 < 4; ++q2) { u32x4 o4; o4.x = pk2(rr[8 * q2], rr[8 * q2 + 1]); o4.y = pk2(rr[8 * q2 + 2], rr[8 * q2 + 3]); o4.z = pk2(rr[8 * q2 + 4], rr[8 * q2 + 5]); o4.w = pk2(rr[8 * q2 + 6], rr[8 * q2 + 7]);
                *(u32x4*)(xr + 32 * lane + 8 * q2) = o4; }
            const float mean2 = wave_sum_u(s3) * (1.f / D);
            float s4 = 0.f;
#pragma unroll
            for (int i = 0; i < 32; ++i) { rr[i] -= mean2; s4 += rr[i] * rr[i]; }
            const float rstd2 = 1.f / sqrtf(wave_sum_u(s4) * (1.f / D) + LN_EPS);
            const float* np = F.MODS() + ((size_t)(layer + 1) * 3 + mr) * 12288;
#pragma unroll
            for (int q4 = 0; q4 < 2; ++q4) { u32x4 w;
#pragma unroll
                for (int q = 0; q < 4; ++q) { const int qq = 4 * q4 + q; const f32x4 sh = *(const LAS f32x4*)(vcache + (3 + mr) * 8192 + qq * 1024), sc = *(const LAS f32x4*)(vcache + (6 + mr) * 8192 + qq * 1024); const int ri = 4 * qq;
                    const float y0 = rr[ri] * rstd2 * (1.f + sc[0]) + sh[0], y1 = rr[ri + 1] * rstd2 * (1.f + sc[1]) + sh[1];
                    const float y2 = rr[ri + 2] * rstd2 * (1.f + sc[2]) + sh[2], y3 = rr[ri + 3] * rstd2 * (1.f + sc[3]) + sh[3];
                    int o = __builtin_amdgcn_cvt_pk_fp8_f32(y0, y1, 0, false); o = __builtin_amdgcn_cvt_pk_fp8_f32(y2, y3, o, true); w[q] = (unsigned)o; }
                *(u32x4*)(F.H8() + (size_t)t * D + 32 * lane + 16 * q4) = w; }
        }
        SUB_END(10);
        t = (int)__builtin_amdgcn_readfirstlane(tkn);
    }
#undef SUB_BEGIN
#undef SUB_END
}

__global__ void __launch_bounds__(NWAVES * 64, 2) skel_fwd(Args args) {
    extern __shared__ __attribute__((aligned(16))) unsigned char lds[];
    Frame F;
    F.lds = (LAS unsigned char*)lds;
    F.tid = threadIdx.x; F.lane = F.tid & 63; F.wave = __builtin_amdgcn_readfirstlane(F.tid >> 6);
    F.G = gridDim.x; F.gw = blockIdx.x * NWAVES + F.wave; F.NGW = F.G * NWAVES;
    unsigned char* ws = args.ws;
    F.ka = (const CAS unsigned char*)__builtin_amdgcn_kernarg_segment_ptr();
    for (int u = F.tid; u < (LDS_BYTES - LDSCTL_OFF) / 4; u += NWAVES * 64) ((LAS unsigned*)(F.lds + LDSCTL_OFF))[u] = 0u;
    __syncthreads();
    unsigned* ctl = (unsigned*)(ws + WS_CTL);
    const int lo = args.ph_lo, hi = args.ph_hi;
    XcdBarrier bar; bar.bar = ctl + CW_BAR + args.li * XCD_BAR_WORDS; bar.x = 0; bar.st = nullptr;
    if (hi - lo > 1) bar = xcd_barrier_post(ctl + CW_BAR + args.li * XCD_BAR_WORDS, (volatile LAS unsigned*)(F.lds + MISC_OFF) + 8);
#define IN(k) (lo <= (k) && (k) < hi)
    unsigned long long pr_acc = 0ull, pr_t0 = 0ull;
#define PR_BEGIN(ty) do { if (PROBE_PHASE == (ty)) pr_t0 = __builtin_amdgcn_s_memrealtime(); } while (0)
#define PR_END(ty) do { if (PROBE_PHASE == (ty)) pr_acc += __builtin_amdgcn_s_memrealtime() - pr_t0; } while (0)
#define BOTH(k) (IN(k) && IN((k) + 1))
#define SEAM(k) do { if (BOTH(k)) xcd_barrier(bar); } while (0)

    if (IN(0)) { PR_BEGIN(0); frame_ids(F); p0a_prologue(F); SEAM(0); PR_END(0); }
    if (IN(1)) {
        PR_BEGIN(1); frame_ids(F);
        { pg8::Gemm g{F.KBD(), F.WQR(), 32 * 256, 2048, 256}; pg8::BatchOrder S{F.G, (int)blockIdx.x}; pg8::EpiBf16 E{F.WEFFT(), D, 1.f};
          pg8::gemm_phase<pg8::EpiBf16, pg8::BatchOrder, false, true>(F.lds, g, S, E); }
        p0b_mod0(F);
        SEAM(1); PR_END(1);
    }
    for (int layer = 0; layer < NLAYER; ++layer) {
        const int pb = 2 + 6 * layer;
        const bool lastl = layer == NLAYER - 1;
        const int rows = lastl ? TL : TT;
        if (IN(pb + 0)) {
            PR_BEGIN(2); frame_ids(F);
            pg8::Gemm g{(const bf16_t*)F.H8(), (const bf16_t*)(F.WINT() + (size_t)layer * INC * D), TT, INC, D / 2}; pg8::StaticOrder S; S.init(TT, 2 * INC, F.G, (int)blockIdx.x);
            pg8::EpiBf16H E{F.PROJ(), INC, 1.f / WIN_SCALE};
            pg8::gemm_phase<pg8::EpiBf16H, pg8::StaticOrder, false, true, true, true>(F.lds, g, S, E);
            SEAM(pb + 0); PR_END(2);
        }
        if (IN(pb + 1)) {
            PR_BEGIN(3); frame_ids(F);
            const int nunits = lastl ? 512 : 528;
            {
                const int ch = F.tid & 255, vsel = F.tid >> 8;
                LAS unsigned char* dst = F.lds + CONV_LDS + ((2 * (ch >> 7) + (ch & 1)) * 64 + ((ch & 127) >> 1)) * 16;
                *(LAS f32x4*)(dst + vsel * 4096) = *(const f32x4*)(F.conv_w() + (size_t)layer * 3 * 1024 + vsel * 1024 + 4 * ch);
                *(LAS f32x4*)(dst + (2 + vsel) * 4096) = vsel == 0 ? *(const f32x4*)(F.conv_w() + (size_t)layer * 3 * 1024 + 2048 + 4 * ch) : *(const f32x4*)(F.g_conv() + layer * 1024 + 4 * ch);
            }
            for (int i = F.tid; i < 192 * 32 * 2 / 4; i += NWAVES * 64) *(LAS f32x4*)(F.lds + ROPE_LDS + i * 16) = *(const f32x4*)(F.ROPE() + 4 * i);
            __syncthreads();
            { unsigned long long q0 = 0; if (PROBE_PHASE == 11) q0 = __builtin_amdgcn_s_memrealtime();
            { const int bx = (int)blockIdx.x, vcu = (F.G % 8 == 0) ? (bx % 8) * (F.G / 8) + bx / 8 : bx;
              for (int u = vcu; u < nunits; u += F.G) attn_unit(F, layer, u); }
            if (PROBE_PHASE == 11) pr_acc += __builtin_amdgcn_s_memrealtime() - q0; if (PROBE_PHASE == 12) q0 = __builtin_amdgcn_s_memrealtime();
            {
              const int nx = nunits - 2 * F.G; const bool uneven = nx > 0 && nx < F.G;
              const int bx2 = (int)blockIdx.x, vc2 = (F.G % 8 == 0) ? (bx2 % 8) * (F.G / 8) + bx2 / 8 : bx2;
              const int c0 = uneven ? vc2 - nx : vc2, nb = uneven ? F.G - nx : F.G;
              if (c0 >= 0) for (int t = c0 * NWAVES + F.wave; t < rows; t += nb * NWAVES) conv_row(F, layer, t); }
            if (PROBE_PHASE == 12) pr_acc += __builtin_amdgcn_s_memrealtime() - q0; }
            SEAM(pb + 1); PR_END(3);
        }
        if (IN(pb + 2)) {
            PR_BEGIN(4); frame_ids(F);
            pg8::Gemm g{(const bf16_t*)F.MIX(), (const bf16_t*)(F.WOUTT() + (size_t)layer * D * D), rows, D, D / 2}; pg8::StaticOrder S; S.init(rows, 2 * D, F.G, (int)blockIdx.x);
            pg8::EpiBf16H E{F.PROJ(), D, 1.f / WOUT_SCALE};
            pg8::gemm_phase<pg8::EpiBf16H, pg8::StaticOrder, false, true, true, true>(F.lds, g, S, E);
            frame_ids(F); convert_in_tail(F, layer, (rows / 256) * (D / 128), 0);
            SEAM(pb + 2); PR_END(4);
        }
        if (IN(pb + 3)) { PR_BEGIN(5); frame_ids(F); ln_phase(F, layer, rows); SEAM(pb + 3); PR_END(5); }
        if (IN(pb + 4)) {
            PR_BEGIN(6); frame_ids(F);
            pg8::Gemm g{F.H(), F.WEFFT() + (size_t)layer * D * D, rows, D, D}; pg8::StaticOrder S; S.init(rows, D, F.G, (int)blockIdx.x);
            pg8::EpiBf16 E{F.SC(), D, 1.f};
            pg8::gemm_phase<pg8::EpiBf16, pg8::StaticOrder, true, true>(F.lds, g, S, E);
            frame_ids(F); convert_in_tail(F, layer, (rows / 256) * (D / 256), 1);
            SEAM(pb + 4); PR_END(6);
        }
        if (IN(pb + 5)) { PR_BEGIN(7); frame_ids(F); peer_phase(F, layer, rows, ctl, pr_acc); SEAM(pb + 5); PR_END(7); }
    }
    if (PROBE_PHASE >= 0 && hi - lo > 1) xcd_barrier(bar);
    if (PROBE_PHASE >= 0 && blockIdx.x == 0 && threadIdx.x == 0) { const unsigned long long t1 = __builtin_amdgcn_s_memrealtime() + (unsigned long long)PROBE_MULT * pr_acc; while (__builtin_amdgcn_s_memrealtime() < t1) __builtin_amdgcn_s_sleep(8); }
#undef IN
#undef BOTH
#undef SEAM
}

extern "C" void kernel_launch(void* const* d_in, const int* in_sizes, int n_in, void* d_out, int out_size, void* d_ws, size_t ws_size, hipStream_t stream) {
    static int grid = 0;
    if (grid == 0) {
        if (n_in != 20 || in_sizes[0] != TL * D || out_size != TL * D || ws_size < WS_END) {
            fprintf(stderr, "kernel_launch: unexpected problem shape (n_in %d, in0 %d, out %d, ws %zu, need %zu)\n", n_in, n_in > 0 ? in_sizes[0] : -1, out_size, ws_size, (size_t)WS_END); grid = -1; return; }
        int dev = 0, cus = 0, per_cu = 0;
        if (hipGetDevice(&dev) != hipSuccess || hipDeviceGetAttribute(&cus, hipDeviceAttributeMultiprocessorCount, dev) != hipSuccess) { grid = -1; return; }
        if (hipFuncSetAttribute((const void*)skel_fwd, hipFuncAttributeMaxDynamicSharedMemorySize, LDS_BYTES) != hipSuccess) { fprintf(stderr, "kernel_launch: hipFuncSetAttribute failed\n"); grid = -1; return; }
        if (hipOccupancyMaxActiveBlocksPerMultiprocessor(&per_cu, (const void*)skel_fwd, NWAVES * 64, LDS_BYTES) != hipSuccess || per_cu < 1)
            fprintf(stderr, "kernel_launch: occupancy query reports %d workgroups per CU\n", per_cu);
        (void)hipGetLastError();
        grid = cus;
    }
    if (grid < 0) return;
    if (hipMemsetAsync((char*)d_ws + WS_CTL, 0, CTL_ZERO_BYTES, stream) != hipSuccess) return;
    Args a{};
    for (int i = 0; i < 20; ++i) a.in[i] = (const float*)d_in[i];
    a.out = (float*)d_out; a.ws = (unsigned char*)d_ws; a.pad = 0;
#if MK_N_LAUNCHES == 1
    a.ph_lo = 0; a.ph_hi = NPHASE; a.li = 0;
    hipLaunchKernelGGL(skel_fwd, dim3(grid), dim3(NWAVES * 64), LDS_BYTES, stream, a);
#else
    for (int ph = 0; ph < NPHASE; ++ph) { a.ph_lo = ph; a.ph_hi = ph + 1; a.li = 0;
        hipLaunchKernelGGL(skel_fwd, dim3(grid), dim3(NWAVES * 64), LDS_BYTES, stream, a); }
#endif
}
```

```cpp
#include <hip/hip_runtime.h>
#include <cstdio>
#include <cstdint>

#ifndef MK_N_LAUNCHES
#define MK_N_LAUNCHES 1
#endif

#define LAS __attribute__((address_space(3)))
typedef unsigned short bf16_t;
typedef short bf16x8 __attribute__((ext_vector_type(8)));
typedef short s16x4 __attribute__((ext_vector_type(4)));
typedef float f32x2 __attribute__((ext_vector_type(2)));
typedef float f32x4 __attribute__((ext_vector_type(4)));
typedef float f32x16 __attribute__((ext_vector_type(16)));
typedef unsigned u32x2 __attribute__((ext_vector_type(2)));
typedef unsigned u32x4 __attribute__((ext_vector_type(4)));
typedef __bf16 bf16x2_t __attribute__((ext_vector_type(2)));
typedef int i32x8 __attribute__((ext_vector_type(8)));

constexpr int D = 2048, NB = 2, SEQ = 8192, CTXL = 256, NLAYER = 4;
constexpr int TL = NB * SEQ, TC = NB * CTXL, TT = TL + TC;
constexpr int INC = 4608, OFF_C = 1024, OFF_X = 2048, OFF_Q = 3072, OFF_K = 4096, OFF_V = 4352;
constexpr float WOUT_SCALE = 128.f;
constexpr float WIN_SCALE = 64.f;
constexpr int NEXP = 16384;
#ifndef U_FMT
#define U_FMT 4
#endif
#ifndef V_FMT
#define V_FMT 4
#endif
constexpr int UROW = D * U_FMT / 8, VROW = D * V_FMT / 8;
constexpr float LN_EPS = 1e-6f;
constexpr float DN_ALPHA = 1.681792830507429f;
constexpr float QSCALE = 0.08838834764831845f * 1.4426950408889634f;
constexpr float LOG2E = 1.4426950408889634f;

constexpr size_t MiB = 1u << 20;
constexpr size_t WS_CTL = 0, CTL_ZERO_BYTES = 2 * MiB;
constexpr size_t WS_MODS = 1 * MiB;
constexpr size_t WS_ROPE = 2 * MiB;
constexpr size_t WS_KBD = 3 * MiB;
constexpr size_t WS_WQR = 8 * MiB;
constexpr size_t WS_WINT = 40 * MiB;
constexpr size_t WS_WOUTT = 112 * MiB;
constexpr size_t WS_WEFFT = 144 * MiB;
constexpr size_t WS_X = 176 * MiB;
constexpr size_t WS_H = 308 * MiB;
constexpr size_t WS_PROJ = 374 * MiB;
constexpr size_t WS_MIX = 523 * MiB;
constexpr size_t WS_SC = 589 * MiB;
constexpr size_t WS_UT = 721 * MiB;
constexpr size_t WS_VT = 849 * MiB;
constexpr size_t WS_US = 977 * MiB;
constexpr size_t WS_VS = 978 * MiB;
constexpr size_t WS_H8 = 979 * MiB;
constexpr size_t WS_END = 1013 * MiB;

constexpr int CW_BAR = 4096;

namespace pg8 {
constexpr int BM = 256, BK = 64, HALF = 128, HTB = HALF * BK * 2, STAGE_BYTES = 8 * HTB, NXCD = 8, WGM = 8;
__host__ __device__ __forceinline__ int lds_byte(int r, int c) { const int st = (r >> 4) * 2 + (c >> 5), rr = r & 15, cc = c & 31, ob = rr * 64 + cc * 2; return st * 1024 + (ob ^ (((ob >> 9) & 1) << 5)); }
__host__ __device__ __forceinline__ void stage_rc(int b, int& R, int& C) { const int st = b / 1024, sb = b % 1024, swz = sb ^ (((sb >> 9) & 1) << 5); R = (st >> 1) * 16 + swz / 64; C = (st & 1) * 32 + (swz % 64) / 2; }
__host__ __device__ __forceinline__ int lds_byte8(int r, int c) { const int st = (r >> 4) * 2 + (c >> 2); return st * 1024 + (((r & 15) * 64 + (c & 3) * 16) ^ (((r >> 3) & 1) << 4)); }
__host__ __device__ __forceinline__ void stage_rc8(int b, int& R, int& C) { const int st = b / 1024, sb = b % 1024, rr = sb / 64, cj = ((sb % 64) / 16) ^ ((rr >> 3) & 1); R = (st >> 1) * 16 + rr; C = ((st & 1) * 4 + cj) * 8; }
__host__ __device__ __forceinline__ int perm32(int rho) { const int n = rho >> 4, i = rho & 15; return 8 * (i >> 2) + 4 * n + (i & 3); }

struct Unit { int pm, pn; };
struct Gemm { const bf16_t* A; const bf16_t* Bt; int M, N, K; };

struct StaticOrder {
    int nM, nN, nwg, G, c;
    __host__ __device__ void init(int M, int N, int G_, int c_) { nM = M / BM; nN = N / BM; nwg = nM * nN; G = G_; c = c_; }
    __host__ __device__ bool next(int i, Unit& u) const {
        const long L = (long)i * G + c; if (L >= nwg) return false;
        int wgid = (int)L; { const int q = nwg / NXCD, r = nwg % NXCD, xcd = wgid % NXCD, off = wgid / NXCD; wgid = (xcd < r ? xcd * (q + 1) : r * (q + 1) + (xcd - r) * q) + off; }
        const int nig = WGM * nN, gid = wgid / nig, fm = gid * WGM, gsz = (nM - fm) < WGM ? (nM - fm) : WGM;
        u.pm = fm + ((wgid % nig) % gsz); u.pn = (wgid % nig) / gsz; return true;
    }
    __device__ __forceinline__ int btile(const Unit& u) const { return u.pn; }
    __device__ __forceinline__ void a_ready(const Unit&) const {}
    __device__ __forceinline__ void done(const Unit&) const {}
};
struct BatchOrder {
    int G, c;
    __device__ bool next(int i, Unit& u) const { const int L = i * G + c; if (L >= 256) return false; u.pm = L >> 3; u.pn = L & 7; return true; }
    __device__ __forceinline__ int btile(const Unit& u) const { return u.pm * 8 + u.pn; }
    __device__ __forceinline__ void a_ready(const Unit&) const {}
    __device__ __forceinline__ void done(const Unit&) const {}
};

__device__ __forceinline__ unsigned cvt_pk_bf16(float lo, float hi) { f32x2 x = {lo, hi}; bf16x2_t y = __builtin_convertvector(x, bf16x2_t); return __builtin_bit_cast(unsigned, y); }

struct EpiBf16 {
    static constexpr bool PERM = true;
    bf16_t* O; int ldc; float scale;
    __device__ __forceinline__ void operator()(const f32x4 (&acc)[2][2][4][2], const Unit& u, int wr, int wc, int fr, int fq) const {
        const int row0 = u.pm * BM + wr * 64 + fr, col0 = u.pn * BM + wc * 32 + 8 * fq;
#pragma unroll
        for (int ai = 0; ai < 2; ++ai)
#pragma unroll
            for (int m = 0; m < 4; ++m) { bf16_t* rowp = O + (size_t)(row0 + ai * HALF + m * 16) * ldc + col0;
#pragma unroll
                for (int bj = 0; bj < 2; ++bj) { const f32x4 v0 = acc[ai][bj][m][0] * scale, v1 = acc[ai][bj][m][1] * scale;
                    u32x4 w; w.x = cvt_pk_bf16(v0[0], v0[1]); w.y = cvt_pk_bf16(v0[2], v0[3]); w.z = cvt_pk_bf16(v1[0], v1[1]); w.w = cvt_pk_bf16(v1[2], v1[3]);
                    *(u32x4*)(rowp + bj * HALF) = w; } }
    }
};
struct EpiBf16H {
    static constexpr bool PERM = true;
    bf16_t* O; int ldc; float scale;
    __device__ __forceinline__ void operator()(const f32x4 (&acc)[2][2][4][2], const Unit& u, int wr, int wc, int fr, int fq) const {
        const int row0 = u.pm * BM + wr * 64 + fr, col0 = u.pn * HALF + wc * 32 + 8 * fq;
#pragma unroll
        for (int ai = 0; ai < 2; ++ai)
#pragma unroll
            for (int m = 0; m < 4; ++m) { const f32x4 v0 = acc[ai][0][m][0] * scale, v1 = acc[ai][0][m][1] * scale;
                u32x4 w; w.x = cvt_pk_bf16(v0[0], v0[1]); w.y = cvt_pk_bf16(v0[2], v0[3]); w.z = cvt_pk_bf16(v1[0], v1[1]); w.w = cvt_pk_bf16(v1[2], v1[3]);
                *(u32x4*)(O + (size_t)(row0 + ai * HALF + m * 16) * ldc + col0) = w; }
    }
};
struct EpiF32 {
    static constexpr bool PERM = false;
    float* C; int ldc;
    __device__ __forceinline__ void operator()(const f32x4 (&acc)[2][2][4][2], const Unit& u, int wr, int wc, int fr, int fq) const {
        const int row0 = u.pm * BM + wr * 64 + fr, col0 = u.pn * BM + wc * 32 + 4 * fq;
#pragma unroll
        for (int ai = 0; ai < 2; ++ai)
#pragma unroll
            for (int m = 0; m < 4; ++m) { float* rowp = C + (size_t)(row0 + ai * HALF + m * 16) * ldc + col0;
#pragma unroll
                for (int bj = 0; bj < 2; ++bj)
#pragma unroll
                    for (int n = 0; n < 2; ++n) *(f32x4*)(rowp + bj * HALF + n * 16) = acc[ai][bj][m][n]; }
    }
};
struct EpiResid {
    static constexpr bool PERM = true;
    const float* x32_lat; const float* x32_ctx;
    bf16_t* X; const float* gate;
    __device__ __forceinline__ void operator()(const f32x4 (&acc)[2][2][4][2], const Unit& u, int wr, int wc, int fr, int fq) const {
        const int rt = u.pm * BM;
        const int mr = rt < TL ? rt / SEQ : 2;
        const int row0 = rt + wr * 64 + fr, col0 = u.pn * BM + wc * 32 + 8 * fq;
        f32x4 gv[2][2];
#pragma unroll
        for (int bj = 0; bj < 2; ++bj)
#pragma unroll
            for (int n = 0; n < 2; ++n) gv[bj][n] = *(const f32x4*)(gate + (size_t)mr * 12288 + col0 + bj * HALF + 4 * n);
#pragma unroll
        for (int ai = 0; ai < 2; ++ai)
#pragma unroll
            for (int m = 0; m < 4; ++m) { const int row = row0 + ai * HALF + m * 16;
#pragma unroll
                for (int bj = 0; bj < 2; ++bj) {
                    f32x4 x0, x1;
                    if (x32_lat) { const float* xp = (row < TL ? x32_lat + (size_t)row * D : x32_ctx + (size_t)(row - TL) * D) + col0 + bj * HALF; x0 = *(const f32x4*)xp; x1 = *(const f32x4*)(xp + 4); }
                    else { const u32x4 w = *(const u32x4*)(X + (size_t)row * D + col0 + bj * HALF);
                        x0 = (f32x4){__uint_as_float(w.x << 16), __uint_as_float(w.x & 0xffff0000u), __uint_as_float(w.y << 16), __uint_as_float(w.y & 0xffff0000u)};
                        x1 = (f32x4){__uint_as_float(w.z << 16), __uint_as_float(w.z & 0xffff0000u), __uint_as_float(w.w << 16), __uint_as_float(w.w & 0xffff0000u)}; }
                    const f32x4 r0 = x0 * DN_ALPHA + gv[bj][0] * acc[ai][bj][m][0], r1 = x1 * DN_ALPHA + gv[bj][1] * acc[ai][bj][m][1];
                    u32x4 o; o.x = cvt_pk_bf16(r0[0], r0[1]); o.y = cvt_pk_bf16(r0[2], r0[3]); o.z = cvt_pk_bf16(r1[0], r1[1]); o.w = cvt_pk_bf16(r1[2], r1[3]);
                    *(u32x4*)(X + (size_t)row * D + col0 + bj * HALF) = o; } }
    }
};

template <class Epi, class Sched, bool ALIGN_EPI = false, bool SP2 = false, bool FP8 = false, bool HN = false>
__device__ __forceinline__ void gemm_phase(LAS unsigned char* lds, const Gemm g, const Sched& S, const Epi& E) {
    int tid = threadIdx.x; asm volatile("" : "+v"(tid));
    const int wid = __builtin_amdgcn_readfirstlane(tid >> 6), lane = tid & 63, wr = wid >> 2, wc = wid & 3, fr = lane & 15, fq = lane >> 4;
    const int K = g.K, nt = K / BK;
    unsigned voffA[2], voffB[2];
#pragma unroll
    for (int i = 0; i < 2; ++i) { int R, C; if constexpr (FP8) stage_rc8(tid * 16 + i * 8192, R, C); else stage_rc(tid * 16 + i * 8192, R, C); const int Rb = Epi::PERM ? ((R & ~31) + perm32(R & 31)) : R;
        voffA[i] = (unsigned)(R * K + C) * 2u; voffB[i] = (unsigned)(Rb * K + C) * 2u; }
    const size_t kstep = (size_t)(BK * 2);
    const size_t hstep = (size_t)HALF * K * 2;
    const size_t tstep = 2 * hstep;
    const unsigned ldsw = (unsigned)wid * 1024u;
    const int aoff = lds_byte(wr * 64 + fr, fq * 8), boff = lds_byte(wc * 32 + fr, fq * 8);
    const int aoff8a = lds_byte8(wr * 64 + fr, 2 * fq), boff8a = lds_byte8(wc * 32 + fr, 2 * fq), aoff8b = aoff8a ^ 16, boff8b = boff8a ^ 16;
#define PG8_SA(b, h) (((b) * 2 + (h)) * HTB)
#define PG8_SB(b, h) ((4 + (b) * 2 + (h)) * HTB)
#define PG8_STAGE(bufoff, gbase, voff) do { _Pragma("unroll") for (int _i = 0; _i < 2; ++_i) \
        __builtin_amdgcn_global_load_lds((const unsigned*)((const char*)(gbase) + (voff)[_i]), (LAS unsigned*)(lds + (bufoff) + ldsw + _i * 8192), 16, 0, 0); } while (0)
#define PG8_LDA(dst, b, h) do { if constexpr (FP8) { _Pragma("unroll") for (int m = 0; m < 4; ++m) { const u32x4 _x = *(const LAS u32x4*)(lds + PG8_SA(b, h) + aoff8a + m * 2048), _y = *(const LAS u32x4*)(lds + PG8_SA(b, h) + aoff8b + m * 2048); \
            dst##8[m] = (i32x8){(int)_x.x, (int)_x.y, (int)_x.z, (int)_x.w, (int)_y.x, (int)_y.y, (int)_y.z, (int)_y.w}; } } \
        else { _Pragma("unroll") for (int m = 0; m < 4; ++m) _Pragma("unroll") for (int k = 0; k < 2; ++k) dst[m][k] = *(const LAS bf16x8*)(lds + PG8_SA(b, h) + aoff + m * 2048 + k * 1024); } } while (0)
#define PG8_LDB(dst, b, h) do { if constexpr (FP8) { _Pragma("unroll") for (int n = 0; n < 2; ++n) { const u32x4 _x = *(const LAS u32x4*)(lds + PG8_SB(b, h) + boff8a + n * 2048), _y = *(const LAS u32x4*)(lds + PG8_SB(b, h) + boff8b + n * 2048); \
            dst##8[n] = (i32x8){(int)_x.x, (int)_x.y, (int)_x.z, (int)_x.w, (int)_y.x, (int)_y.y, (int)_y.z, (int)_y.w}; } } \
        else { _Pragma("unroll") for (int n = 0; n < 2; ++n) _Pragma("unroll") for (int k = 0; k < 2; ++k) dst[n][k] = *(const LAS bf16x8*)(lds + PG8_SB(b, h) + boff + n * 2048 + k * 1024); } } while (0)
#define PG8_MMA(ai, bj, At, Bt) do { __builtin_amdgcn_s_setprio(1); if constexpr (FP8) { _Pragma("unroll") for (int m = 0; m < 4; ++m) _Pragma("unroll") for (int n = 0; n < 2; ++n) \
            acc[ai][bj][m][n] = __builtin_amdgcn_mfma_scale_f32_16x16x128_f8f6f4(Bt##8[n], At##8[m], acc[ai][bj][m][n], 0, 0, 0, 0x7F7F7F7F, 0, 0x7F7F7F7F); } \
        else { _Pragma("unroll") for (int m = 0; m < 4; ++m) _Pragma("unroll") for (int n = 0; n < 2; ++n) _Pragma("unroll") for (int k = 0; k < 2; ++k) \
            acc[ai][bj][m][n] = __builtin_amdgcn_mfma_f32_16x16x32_bf16(Bt[n][k], At[m][k], acc[ai][bj][m][n], 0, 0, 0); } __builtin_amdgcn_s_setprio(0); } while (0)
#define PG8_WAIT_V(n) asm volatile("s_waitcnt vmcnt(" #n ")" ::: "memory")
#define PG8_WAIT_L(n) asm volatile("s_waitcnt lgkmcnt(" #n ")" ::: "memory")
#define PG8_BAR __builtin_amdgcn_s_barrier()
#define PG8_SCHED __builtin_amdgcn_sched_barrier(0)
    Unit cur, nxt; int ui = 0;
    if (!S.next(0, cur)) return;
    f32x4 acc[2][2][4][2];
#pragma unroll
    for (int a = 0; a < 2; ++a)
#pragma unroll
        for (int b = 0; b < 2; ++b)
#pragma unroll
            for (int m = 0; m < 4; ++m)
#pragma unroll
                for (int n = 0; n < 2; ++n) acc[a][b][m][n] = (f32x4){0.f, 0.f, 0.f, 0.f};
    bf16x8 At[4][2], B0[2][2], B1[2][2];
    i32x8 At8[4], B08[2], B18[2];
    const size_t bstep = HN ? hstep : tstep;
    const char* cA = (const char*)g.A + (size_t)cur.pm * tstep; const char* cB = (const char*)g.Bt + (size_t)S.btile(cur) * bstep;
    S.a_ready(cur);
    if constexpr (HN) {
        static_assert(!HN || SP2, "HN needs the SP2 loop");
        PG8_STAGE(PG8_SB(0, 0), cB, voffB); PG8_STAGE(PG8_SA(0, 0), cA, voffA); PG8_STAGE(PG8_SA(0, 1), cA + hstep, voffA);
        if (wr == 1) PG8_BAR;
        PG8_WAIT_V(2); PG8_BAR;
        PG8_STAGE(PG8_SB(1, 0), cB + kstep, voffB); PG8_STAGE(PG8_SA(1, 0), cA + kstep, voffA);
        PG8_WAIT_V(4); PG8_BAR;
    } else if constexpr (SP2) {
        PG8_STAGE(PG8_SB(0, 0), cB, voffB); PG8_STAGE(PG8_SB(0, 1), cB + hstep, voffB); PG8_STAGE(PG8_SA(0, 0), cA, voffA); PG8_STAGE(PG8_SA(0, 1), cA + hstep, voffA);
        if (wr == 1) PG8_BAR;
        PG8_WAIT_V(2); PG8_BAR;
        PG8_STAGE(PG8_SB(1, 0), cB + kstep, voffB); PG8_STAGE(PG8_SA(1, 0), cA + kstep, voffA); PG8_STAGE(PG8_SB(1, 1), cB + hstep + kstep, voffB);
        PG8_WAIT_V(6); PG8_BAR;
    } else {
        PG8_STAGE(PG8_SB(0, 0), cB, voffB); PG8_STAGE(PG8_SA(0, 0), cA, voffA); PG8_STAGE(PG8_SB(0, 1), cB + hstep, voffB); PG8_STAGE(PG8_SA(0, 1), cA + hstep, voffA);
        if (wr == 1) PG8_BAR;
        PG8_WAIT_V(4); PG8_BAR;
        PG8_STAGE(PG8_SB(1, 0), cB + kstep, voffB); PG8_STAGE(PG8_SA(1, 0), cA + kstep, voffA); PG8_STAGE(PG8_SB(1, 1), cB + hstep + kstep, voffB);
        PG8_WAIT_V(6); PG8_BAR;
    }
    for (;;) {
        const bool has_next = S.next(ui + 1, nxt);
        const char* nA = has_next ? (const char*)g.A + (size_t)nxt.pm * tstep : cA; const char* nB = has_next ? (const char*)g.Bt + (size_t)S.btile(nxt) * bstep : cB;
        for (int t = 0; t < nt; t += 2) {
            const bool last = (t == nt - 2);
            const char* a1 = cA + (size_t)(t + 1) * kstep;
            const char* a2 = last ? nA : cA + (size_t)(t + 2) * kstep; const char* b2 = last ? nB : cB + (size_t)(t + 2) * kstep;
            const char* a3 = a2 + kstep; const char* b3 = b2 + kstep;
            if (last && has_next) S.a_ready(nxt);
            if constexpr (HN) {
            PG8_LDB(B0, 0, 0); PG8_SCHED; PG8_LDA(At, 0, 0); PG8_STAGE(PG8_SA(1, 1), a1 + hstep, voffA);
            PG8_WAIT_V(6); PG8_WAIT_L(0); PG8_BAR; PG8_MMA(0, 0, At, B0); PG8_BAR; PG8_SCHED;
            PG8_LDA(At, 0, 1); PG8_STAGE(PG8_SB(0, 0), b2, voffB); PG8_STAGE(PG8_SA(0, 0), a2, voffA);
            PG8_WAIT_V(6); PG8_WAIT_L(0); PG8_BAR; PG8_MMA(1, 0, At, B0); PG8_BAR; PG8_SCHED;
            PG8_LDB(B0, 1, 0); PG8_SCHED; PG8_LDA(At, 1, 0); PG8_STAGE(PG8_SA(0, 1), a2 + hstep, voffA);
            PG8_WAIT_V(6); PG8_WAIT_L(0); PG8_BAR; PG8_MMA(0, 0, At, B0); PG8_BAR; PG8_SCHED;
            PG8_LDA(At, 1, 1); PG8_STAGE(PG8_SB(1, 0), b3, voffB); PG8_STAGE(PG8_SA(1, 0), a3, voffA);
            PG8_WAIT_V(6); PG8_WAIT_L(0); PG8_BAR; PG8_MMA(1, 0, At, B0); PG8_BAR; PG8_SCHED;
            } else if constexpr (SP2) {
            PG8_LDB(B0, 0, 0); PG8_LDB(B1, 0, 1); PG8_SCHED; PG8_LDA(At, 0, 0); PG8_STAGE(PG8_SA(1, 1), a1 + hstep, voffA);
            PG8_WAIT_V(8); PG8_WAIT_L(0); PG8_BAR; PG8_MMA(0, 0, At, B0); PG8_MMA(0, 1, At, B1); PG8_BAR; PG8_SCHED;
            PG8_LDA(At, 0, 1); PG8_STAGE(PG8_SB(0, 0), b2, voffB); PG8_STAGE(PG8_SB(0, 1), b2 + hstep, voffB); PG8_STAGE(PG8_SA(0, 0), a2, voffA);
            PG8_WAIT_V(8); PG8_WAIT_L(0); PG8_BAR; PG8_MMA(1, 0, At, B0); PG8_MMA(1, 1, At, B1); PG8_BAR; PG8_SCHED;
            PG8_LDB(B0, 1, 0); PG8_LDB(B1, 1, 1); PG8_SCHED; PG8_LDA(At, 1, 0); PG8_STAGE(PG8_SA(0, 1), a2 + hstep, voffA);
            PG8_WAIT_V(8); PG8_WAIT_L(0); PG8_BAR; PG8_MMA(0, 0, At, B0); PG8_MMA(0, 1, At, B1); PG8_BAR; PG8_SCHED;
            PG8_LDA(At, 1, 1); PG8_STAGE(PG8_SB(1, 0), b3, voffB); PG8_STAGE(PG8_SB(1, 1), b3 + hstep, voffB); PG8_STAGE(PG8_SA(1, 0), a3, voffA);
            PG8_WAIT_V(8); PG8_WAIT_L(0); PG8_BAR; PG8_MMA(1, 0, At, B0); PG8_MMA(1, 1, At, B1); PG8_BAR; PG8_SCHED;
            } else {
            PG8_LDB(B0, 0, 0); PG8_SCHED; PG8_LDA(At, 0, 0); PG8_STAGE(PG8_SA(1, 1), a1 + hstep, voffA);
            PG8_WAIT_L(8); PG8_BAR; PG8_WAIT_L(0); PG8_MMA(0, 0, At, B0); PG8_BAR; PG8_SCHED;
            PG8_LDB(B1, 0, 1); PG8_STAGE(PG8_SB(0, 0), b2, voffB);
            PG8_BAR; PG8_WAIT_L(0); PG8_MMA(0, 1, At, B1); PG8_BAR;
            PG8_LDA(At, 0, 1); PG8_STAGE(PG8_SA(0, 0), a2, voffA);
            PG8_BAR; PG8_WAIT_L(0); PG8_MMA(1, 0, At, B0); PG8_BAR; PG8_SCHED;
            PG8_STAGE(PG8_SB(0, 1), b2 + hstep, voffB);
            PG8_WAIT_V(6); PG8_BAR; PG8_MMA(1, 1, At, B1); PG8_BAR;
            PG8_LDB(B0, 1, 0); PG8_SCHED; PG8_LDA(At, 1, 0); PG8_STAGE(PG8_SA(0, 1), a2 + hstep, voffA);
            PG8_WAIT_L(8); PG8_BAR; PG8_WAIT_L(0); PG8_MMA(0, 0, At, B0); PG8_BAR; PG8_SCHED;
            PG8_LDB(B1, 1, 1); PG8_STAGE(PG8_SB(1, 0), b3, voffB);
            PG8_BAR; PG8_WAIT_L(0); PG8_MMA(0, 1, At, B1); PG8_BAR;
            PG8_LDA(At, 1, 1); PG8_STAGE(PG8_SA(1, 0), a3, voffA);
            PG8_BAR; PG8_WAIT_L(0); PG8_MMA(1, 0, At, B0); PG8_BAR; PG8_SCHED;
            PG8_STAGE(PG8_SB(1, 1), b3 + hstep, voffB);
            PG8_WAIT_V(6); PG8_BAR; PG8_MMA(1, 1, At, B1); PG8_BAR;
            }
        }
        if constexpr (ALIGN_EPI) { if (wr == 0) PG8_BAR; }
        E(acc, cur, wr, wc, fr, fq); S.done(cur);
        if (!has_next) break;
#pragma unroll
        for (int a = 0; a < 2; ++a)
#pragma unroll
            for (int b = 0; b < 2; ++b)
#pragma unroll
                for (int m = 0; m < 4; ++m)
#pragma unroll
                    for (int n = 0; n < 2; ++n) acc[a][b][m][n] = (f32x4){0.f, 0.f, 0.f, 0.f};
        cur = nxt; cA = nA; cB = nB; ++ui;
        if constexpr (ALIGN_EPI) { if (wr == 1) PG8_BAR; }
    }
    PG8_WAIT_V(0);
    if constexpr (!ALIGN_EPI) { if (wr == 0) PG8_BAR; }
    PG8_BAR;
#undef PG8_SA
#undef PG8_SB
#undef PG8_STAGE
#undef PG8_LDA
#undef PG8_LDB
#undef PG8_MMA
#undef PG8_WAIT_V
#undef PG8_WAIT_L
#undef PG8_BAR
#undef PG8_SCHED
}
}

#define XB_TMO      128
#define XB_XCNT(j)  (256  + 64 * (j))
#define XB_XSUB(j)  (1280 + 64 * (j))
#define XB_XGEN(j)  (2304 + 64 * (j))
#define XB_TOP      3328
#define XB_TOPGEN   3392
#define XCD_BAR_WORDS 3456
#define XB_SPIN_CAP (1u << 18)

__device__ __forceinline__ unsigned xb_ld(unsigned* p)              { return __hip_atomic_load(p, __ATOMIC_RELAXED, __HIP_MEMORY_SCOPE_AGENT); }
__device__ __forceinline__ unsigned xb_add(unsigned* p, unsigned v) { return __hip_atomic_fetch_add(p, v, __ATOMIC_RELAXED, __HIP_MEMORY_SCOPE_AGENT); }
__device__ __forceinline__ unsigned xb_xcc_id() { return (unsigned)__builtin_amdgcn_s_getreg((3 << 11) | 20) & 0xFu; }
#define XB_SPIN(cond, bar) do { unsigned _sp = 0; while (cond) { __builtin_amdgcn_s_sleep(1); \
    if ((++_sp & 255u) == 0u) { if (xb_ld(&(bar)[XB_TMO])) break; if (_sp > XB_SPIN_CAP) { atomicAdd(&(bar)[XB_TMO], 1u); break; } } } } while (0)

struct XcdBarrier { unsigned* bar; unsigned x; volatile LAS unsigned* st; };

__device__ __forceinline__ XcdBarrier xcd_barrier_post(unsigned* bar, volatile LAS unsigned* st) {
    XcdBarrier b; b.bar = bar; b.x = xb_xcc_id(); b.st = st;
    if (threadIdx.x == 0) (void)xb_add(&bar[XB_XCNT(b.x)], 1u);
    return b;
}
__device__ __forceinline__ void xcd_barrier_complete(unsigned* bar, unsigned x, unsigned& nloc, unsigned& nx) {
    const unsigned G = gridDim.x * gridDim.y * gridDim.z;
    unsigned sum, cnt, mine, sp = 0u;
    for (;;) {
        sum = 0u; cnt = 0u; mine = 0u;
#pragma unroll
        for (unsigned j = 0; j < 16; ++j) { const unsigned c = xb_ld(&bar[XB_XCNT(j)]); sum += c; cnt += (c > 0u) ? 1u : 0u; mine = (j == x) ? c : mine; }
        if (sum == G) break;
        __builtin_amdgcn_s_sleep(1);
        if ((++sp & 255u) == 0u) { if (xb_ld(&bar[XB_TMO])) break; if (sp > XB_SPIN_CAP) { atomicAdd(&bar[XB_TMO], 1u); break; } }
    }
    nloc = mine > 0u ? mine : 1u; nx = cnt > 0u ? cnt : 1u;
}
__device__ __forceinline__ void xcd_barrier(const XcdBarrier& b) {
    asm volatile("s_waitcnt vmcnt(0)" ::: "memory");
    __syncthreads();
    if (threadIdx.x == 0) {
        unsigned* bar = b.bar;
        __builtin_amdgcn_s_waitcnt(0);
        unsigned nloc = b.st[0], nx = b.st[1];
        if (nloc == 0u) { xcd_barrier_complete(bar, b.x, nloc, nx); b.st[0] = nloc; b.st[1] = nx; }
        const unsigned old = xb_add(&bar[XB_XSUB(b.x)], 1u);
        const unsigned gen = old / nloc;
        if (old + 1u == (gen + 1u) * nloc) {
            __builtin_amdgcn_fence(__ATOMIC_RELEASE, "agent");
            asm volatile("s_waitcnt vmcnt(0)" ::: "memory");
            const unsigned og = xb_add(&bar[XB_TOP], 1u);
            const unsigned tg = og / nx;
            if (og + 1u == (tg + 1u) * nx) xb_add(&bar[XB_TOPGEN], 1u);
            else XB_SPIN(xb_ld(&bar[XB_TOPGEN]) == tg, bar);
            __builtin_amdgcn_fence(__ATOMIC_ACQUIRE, "agent");
            xb_add(&bar[XB_XGEN(b.x)], 1u);
            asm volatile("s_waitcnt vmcnt(0)" ::: "memory");
        } else {
            XB_SPIN(xb_ld(&bar[XB_XGEN(b.x)]) == gen, bar);
            __builtin_amdgcn_fence(__ATOMIC_ACQUIRE, "agent");
            asm volatile("s_waitcnt vmcnt(0)" ::: "memory");
        }
    }
    __syncthreads();
}

constexpr int NWAVES = 8;
constexpr int LDS_BYTES = 163840;
constexpr int LDSCTL_OFF = LDS_BYTES - 512, MISC_OFF = LDSCTL_OFF + 320;
constexpr int NPHASE = 2 + 6 * NLAYER;

#define LDS_WAIT() asm volatile("s_waitcnt lgkmcnt(0)" ::: "memory")

struct Args { const float* in[20]; float* out; unsigned char* ws; int ph_lo, ph_hi, li, pad; };

#define CAS __attribute__((address_space(4)))
struct Frame {
    LAS unsigned char* lds;
    int tid, lane, wave, G, gw, NGW;
    const CAS unsigned char* ka;
    __device__ __forceinline__ const float* x() const { return *(const float* const CAS*)(ka + 0); }
    __device__ __forceinline__ const float* c() const { return *(const float* const CAS*)(ka + 8); }
    __device__ __forceinline__ const float* ctx() const { return *(const float* const CAS*)(ka + 16); }
    __device__ __forceinline__ const float* c_ctx() const { return *(const float* const CAS*)(ka + 24); }
    __device__ __forceinline__ const float* w_ada() const { return *(const float* const CAS*)(ka + 32); }
    __device__ __forceinline__ const float* b_ada() const { return *(const float* const CAS*)(ka + 40); }
    __device__ __forceinline__ const float* w_in() const { return *(const float* const CAS*)(ka + 48); }
    __device__ __forceinline__ const float* conv_w() const { return *(const float* const CAS*)(ka + 56); }
    __device__ __forceinline__ const float* sink() const { return *(const float* const CAS*)(ka + 64); }
    __device__ __forceinline__ const float* g_attn() const { return *(const float* const CAS*)(ka + 72); }
    __device__ __forceinline__ const float* g_conv() const { return *(const float* const CAS*)(ka + 80); }
    __device__ __forceinline__ const float* w_out() const { return *(const float* const CAS*)(ka + 88); }
    __device__ __forceinline__ const float* ln1_g() const { return *(const float* const CAS*)(ka + 96); }
    __device__ __forceinline__ const float* ln1_b() const { return *(const float* const CAS*)(ka + 104); }
    __device__ __forceinline__ const float* wq() const { return *(const float* const CAS*)(ka + 112); }
    __device__ __forceinline__ const float* keys() const { return *(const float* const CAS*)(ka + 120); }
    __device__ __forceinline__ const float* pu() const { return *(const float* const CAS*)(ka + 128); }
    __device__ __forceinline__ const float* pv() const { return *(const float* const CAS*)(ka + 136); }
    __device__ __forceinline__ const float* ln2_g() const { return *(const float* const CAS*)(ka + 144); }
    __device__ __forceinline__ const float* ln2_b() const { return *(const float* const CAS*)(ka + 152); }
    __device__ __forceinline__ float* out() const { return *(float* const CAS*)(ka + 160); }
    __device__ __forceinline__ unsigned char* ws() const { return *(unsigned char* const CAS*)(ka + 168); }
    __device__ __forceinline__ float* MODS() const { return (float*)(ws() + WS_MODS); }
    __device__ __forceinline__ float* ROPE() const { return (float*)(ws() + WS_ROPE); }
    __device__ __forceinline__ bf16_t* X() const { return (bf16_t*)(ws() + WS_X); }
    __device__ __forceinline__ bf16_t* SC() const { return (bf16_t*)(ws() + WS_SC); }
    __device__ __forceinline__ bf16_t* KBD() const { return (bf16_t*)(ws() + WS_KBD); }
    __device__ __forceinline__ bf16_t* WQR() const { return (bf16_t*)(ws() + WS_WQR); }
    __device__ __forceinline__ unsigned char* WINT() const { return ws() + WS_WINT; }
    __device__ __forceinline__ unsigned char* H8() const { return ws() + WS_H8; }
    __device__ __forceinline__ unsigned char* WOUTT() const { return ws() + WS_WOUTT; }
    __device__ __forceinline__ bf16_t* WEFFT() const { return (bf16_t*)(ws() + WS_WEFFT); }
    __device__ __forceinline__ bf16_t* H() const { return (bf16_t*)(ws() + WS_H); }
    __device__ __forceinline__ bf16_t* PROJ() const { return (bf16_t*)(ws() + WS_PROJ); }
    __device__ __forceinline__ unsigned char* MIX() const { return ws() + WS_MIX; }
    __device__ __forceinline__ unsigned char* UT() const { return (unsigned char*)(ws() + WS_UT); }
    __device__ __forceinline__ unsigned char* VT() const { return (unsigned char*)(ws() + WS_VT); }
    __device__ __forceinline__ float* US() const { return (float*)(ws() + WS_US); }
    __device__ __forceinline__ float* VS() const { return (float*)(ws() + WS_VS); }
};

__device__ __forceinline__ void frame_ids(Frame& F) {
    int tz = threadIdx.x; asm volatile("" : "+v"(tz));
    F.tid = tz; F.lane = tz & 63; F.wave = __builtin_amdgcn_readfirstlane(tz >> 6);
    F.gw = blockIdx.x * NWAVES + F.wave;
    const CAS unsigned char* k = (const CAS unsigned char*)__builtin_amdgcn_kernarg_segment_ptr(); asm volatile("" : "+s"(k)); F.ka = k;
}
template <int CTRL> __device__ __forceinline__ int dpp_i(int v) { return __builtin_amdgcn_update_dpp(0, v, CTRL, 0xf, 0xf, true); }
template <int CTRL> __device__ __forceinline__ float dpp_f(float v) { return __int_as_float(dpp_i<CTRL>(__float_as_int(v))); }
constexpr int DPP_XOR1 = 0xB1, DPP_XOR2 = 0x4E, DPP_HMIRROR = 0x141, DPP_ROR4 = 0x124, DPP_ROR8 = 0x128;
__device__ __forceinline__ float wave_sum_u(float v) {
    v += dpp_f<DPP_XOR1>(v); v += dpp_f<DPP_XOR2>(v); v += dpp_f<DPP_ROR4>(v); v += dpp_f<DPP_ROR8>(v);
    const float r0 = __int_as_float(__builtin_amdgcn_readlane(__float_as_int(v), 0)), r1 = __int_as_float(__builtin_amdgcn_readlane(__float_as_int(v), 16));
    const float r2 = __int_as_float(__builtin_amdgcn_readlane(__float_as_int(v), 32)), r3 = __int_as_float(__builtin_amdgcn_readlane(__float_as_int(v), 48));
    return (r0 + r1) + (r2 + r3);
}
__device__ __forceinline__ float wave_max_u(float v) {
    v = fmaxf(v, dpp_f<DPP_XOR1>(v)); v = fmaxf(v, dpp_f<DPP_XOR2>(v)); v = fmaxf(v, dpp_f<DPP_ROR4>(v)); v = fmaxf(v, dpp_f<DPP_ROR8>(v));
    const float r0 = __int_as_float(__builtin_amdgcn_readlane(__float_as_int(v), 0)), r1 = __int_as_float(__builtin_amdgcn_readlane(__float_as_int(v), 16));
    const float r2 = __int_as_float(__builtin_amdgcn_readlane(__float_as_int(v), 32)), r3 = __int_as_float(__builtin_amdgcn_readlane(__float_as_int(v), 48));
    return fmaxf(fmaxf(r0, r1), fmaxf(r2, r3));
}
__device__ __forceinline__ float xor32_f(float v, int lane) { return __int_as_float(__builtin_amdgcn_ds_bpermute((lane ^ 32) << 2, __float_as_int(v))); }
__device__ __forceinline__ float wave_sum(float v) { return wave_sum_u(v); }
__device__ __forceinline__ unsigned pk2(float lo, float hi) { return pg8::cvt_pk_bf16(lo, hi); }
__device__ __forceinline__ float bf_lo(unsigned u) { return __uint_as_float(u << 16); }
__device__ __forceinline__ float bf_hi(unsigned u) { return __uint_as_float(u & 0xffff0000u); }
__device__ __forceinline__ int modrow(int t) { return t < TL ? t / SEQ : 2; }

__device__ __forceinline__ void transpose_item(const float* W, int K, int N, bf16_t* WT, LAS float* scr, int item, int lane) {
    const int nblk = N / 32, kb = item / nblk, nb = item % nblk, k0 = 64 * kb, n0 = 32 * nb;
#pragma unroll 8
    for (int i = 0; i < 32; ++i) { const int kk = 2 * i + (lane >> 5); scr[kk * 33 + (lane & 31)] = W[(size_t)(k0 + kk) * N + n0 + (lane & 31)]; }
    LDS_WAIT(); asm volatile("" ::: "memory");
    const int c = lane & 7;
#pragma unroll
    for (int j = 0; j < 4; ++j) { const int n = (lane >> 3) + 8 * j; const LAS float* s = scr + (8 * c) * 33 + n;
        u32x4 o; o.x = pk2(s[0 * 33], s[1 * 33]); o.y = pk2(s[2 * 33], s[3 * 33]); o.z = pk2(s[4 * 33], s[5 * 33]); o.w = pk2(s[6 * 33], s[7 * 33]);
        *(u32x4*)(WT + (size_t)(n0 + n) * K + k0 + 8 * c) = o; }
    LDS_WAIT(); asm volatile("" ::: "memory");
}

__device__ __forceinline__ void transpose_item8(const float* W, int K, int N, unsigned char* WT, LAS float* scr, int item, int lane, float wscale) {
    const int nblk = N / 32, kb = item / nblk, nb = item % nblk, k0 = 64 * kb, n0 = 32 * nb;
    float wv[32];
#pragma unroll
    for (int i = 0; i < 32; ++i) wv[i] = __builtin_nontemporal_load(W + (size_t)(k0 + 2 * i + (lane >> 5)) * N + n0 + (lane & 31));
#pragma unroll
    for (int i = 0; i < 32; ++i) scr[(2 * i + (lane >> 5)) * 33 + (lane & 31)] = wv[i];
    LDS_WAIT(); asm volatile("" ::: "memory");
    const int c = lane & 7;
#pragma unroll
    for (int j = 0; j < 4; ++j) { const int n = (lane >> 3) + 8 * j; const LAS float* s = scr + (8 * c) * 33 + n;
        u32x2 o; int t0 = __builtin_amdgcn_cvt_pk_fp8_f32(s[0 * 33] * wscale, s[1 * 33] * wscale, 0, false); t0 = __builtin_amdgcn_cvt_pk_fp8_f32(s[2 * 33] * wscale, s[3 * 33] * wscale, t0, true);
        int t1 = __builtin_amdgcn_cvt_pk_fp8_f32(s[4 * 33] * wscale, s[5 * 33] * wscale, 0, false); t1 = __builtin_amdgcn_cvt_pk_fp8_f32(s[6 * 33] * wscale, s[7 * 33] * wscale, t1, true);
        o.x = (unsigned)t0; o.y = (unsigned)t1;
        *(u32x2*)(WT + (size_t)(n0 + n) * K + k0 + 8 * c) = o; }
    LDS_WAIT(); asm volatile("" ::: "memory");
}
__device__ __forceinline__ void cvt_row_bf16(const float* src, bf16_t* dst, int lane) {
    const f32x4* s = (const f32x4*)src + lane; u32x2* d = (u32x2*)dst + lane;
    f32x4 v[8];
#pragma unroll
    for (int j = 0; j < 8; ++j) v[j] = __builtin_nontemporal_load(s + 64 * j);
#pragma unroll
    for (int j = 0; j < 8; ++j) { u32x2 o; o.x = pk2(v[j].x, v[j].y); o.y = pk2(v[j].z, v[j].w); d[64 * j] = o; }
}

struct RowF32 { f32x4 v[4][2]; };
__device__ __forceinline__ void row_load_nt(RowF32& R, const float* src, int lane) {
    const f32x4* s = (const f32x4*)src + 2 * lane;
#pragma unroll
    for (int j = 0; j < 4; ++j) { R.v[j][0] = __builtin_nontemporal_load(s + 128 * j); R.v[j][1] = __builtin_nontemporal_load(s + 128 * j + 1); }
}
template <int FMT>
__device__ __forceinline__ void cvt_row_lp(const RowF32& R, unsigned char* dst, float* inv, int lane) {
    constexpr float QMAX = FMT == 8 ? 224.f : 6.f;
    float am = 0.f;
#pragma unroll
    for (int j = 0; j < 4; ++j)
#pragma unroll
        for (int q = 0; q < 2; ++q) am = fmaxf(fmaxf(am, fmaxf(fabsf(R.v[j][q].x), fabsf(R.v[j][q].y))), fmaxf(fabsf(R.v[j][q].z), fabsf(R.v[j][q].w)));
    am = wave_max_u(am);
    const float sc = am > 0.f ? QMAX / am : 1.f;
#pragma unroll
    for (int j = 0; j < 4; ++j) {
        if constexpr (FMT == 8) {
            u32x2 w;
#pragma unroll
            for (int q = 0; q < 2; ++q) { int t = __builtin_amdgcn_cvt_pk_fp8_f32(R.v[j][q].x * sc, R.v[j][q].y * sc, 0, false); t = __builtin_amdgcn_cvt_pk_fp8_f32(R.v[j][q].z * sc, R.v[j][q].w * sc, t, true); w[q] = (unsigned)t; }
            *((u32x2*)dst + lane + 64 * j) = w;
        } else {
            unsigned w = 0u;
            w = __builtin_amdgcn_cvt_scalef32_pk_fp4_f32(w, R.v[j][0].x * sc, R.v[j][0].y * sc, 1.0f, 0);
            w = __builtin_amdgcn_cvt_scalef32_pk_fp4_f32(w, R.v[j][0].z * sc, R.v[j][0].w * sc, 1.0f, 1);
            w = __builtin_amdgcn_cvt_scalef32_pk_fp4_f32(w, R.v[j][1].x * sc, R.v[j][1].y * sc, 1.0f, 2);
            w = __builtin_amdgcn_cvt_scalef32_pk_fp4_f32(w, R.v[j][1].z * sc, R.v[j][1].w * sc, 1.0f, 3);
            *((unsigned*)dst + lane + 64 * j) = w;
        }
    }
    if (lane == 0) *inv = am > 0.f ? am * (1.f / QMAX) : 1.f;
}
template <int FMT> struct LpRow;
template <> struct LpRow<8> { u32x4 a, b;
    __device__ __forceinline__ void load(const unsigned char* rowp, int lane) { a = *(const u32x4*)(rowp + 32 * lane); b = *(const u32x4*)(rowp + 32 * lane + 16); }
    template <class Fn> __device__ __forceinline__ void each(Fn&& f) const {
#pragma unroll
        for (int w = 0; w < 4; ++w) { const f32x2 l0 = __builtin_amdgcn_cvt_pk_f32_fp8((int)a[w], false), h0 = __builtin_amdgcn_cvt_pk_f32_fp8((int)a[w], true);
            f(4 * w, l0.x, l0.y); f(4 * w + 2, h0.x, h0.y); }
#pragma unroll
        for (int w = 0; w < 4; ++w) { const f32x2 l0 = __builtin_amdgcn_cvt_pk_f32_fp8((int)b[w], false), h0 = __builtin_amdgcn_cvt_pk_f32_fp8((int)b[w], true);
            f(16 + 4 * w, l0.x, l0.y); f(16 + 4 * w + 2, h0.x, h0.y); }
    } };
template <> struct LpRow<4> { u32x4 a;
    __device__ __forceinline__ void load(const unsigned char* rowp, int lane) { a = *(const u32x4*)(rowp + 16 * lane); }
    template <class Fn> __device__ __forceinline__ void each(Fn&& f) const {
#pragma unroll
        for (int w = 0; w < 4; ++w) {
            const f32x2 d0 = __builtin_amdgcn_cvt_scalef32_pk_f32_fp4(a[w], 1.0f, 0), d1 = __builtin_amdgcn_cvt_scalef32_pk_f32_fp4(a[w], 1.0f, 1);
            const f32x2 d2 = __builtin_amdgcn_cvt_scalef32_pk_f32_fp4(a[w], 1.0f, 2), d3 = __builtin_amdgcn_cvt_scalef32_pk_f32_fp4(a[w], 1.0f, 3);
            f(8 * w, d0.x, d0.y); f(8 * w + 2, d1.x, d1.y); f(8 * w + 4, d2.x, d2.y); f(8 * w + 6, d3.x, d3.y); }
    }
    template <class Fn> __device__ __forceinline__ void each_bf(Fn&& f) const {
#pragma unroll
        for (int w = 0; w < 4; ++w) {
            f(4 * w, __builtin_amdgcn_cvt_scalef32_pk_bf16_fp4(a[w], 1.0f, 0)); f(4 * w + 1, __builtin_amdgcn_cvt_scalef32_pk_bf16_fp4(a[w], 1.0f, 1));
            f(4 * w + 2, __builtin_amdgcn_cvt_scalef32_pk_bf16_fp4(a[w], 1.0f, 2)); f(4 * w + 3, __builtin_amdgcn_cvt_scalef32_pk_bf16_fp4(a[w], 1.0f, 3)); }
    } };

__device__ __forceinline__ void row_stats(const f32x4 (&v)[8], float& mean, float& rstd) {
    float s = 0.f;
#pragma unroll
    for (int j = 0; j < 8; ++j) s += (v[j].x + v[j].y) + (v[j].z + v[j].w);
    mean = wave_sum(s) * (1.f / D);
    float s2 = 0.f;
#pragma unroll
    for (int j = 0; j < 8; ++j) { const f32x4 d = v[j] - mean; s2 += (d.x * d.x + d.y * d.y) + (d.z * d.z + d.w * d.w); }
    rstd = 1.f / sqrtf(wave_sum(s2) * (1.f / D) + LN_EPS);
}
__device__ __forceinline__ void modulate_store(const f32x4 (&v)[8], const float* shift, const float* scale, bf16_t* dst, int lane) {
    float mean, rstd; row_stats(v, mean, rstd);
    u32x2* d = (u32x2*)dst + lane;
#pragma unroll
    for (int j = 0; j < 8; ++j) { const f32x4 sc = *((const f32x4*)scale + lane + 64 * j), sh = *((const f32x4*)shift + lane + 64 * j);
        const f32x4 y = (v[j] - mean) * rstd * (sc + 1.f) + sh;
        u32x2 o; o.x = pk2(y.x, y.y); o.y = pk2(y.z, y.w); d[64 * j] = o; }
}

__device__ __forceinline__ void convert_tables(Frame& F, int row0, int row1, int w0, int wstride) {
    RowF32 ru, rv, nu, nv;
    int row = row0 + w0;
    if (row < row1) { row_load_nt(ru, F.pu() + (size_t)row * D, F.lane); row_load_nt(rv, F.pv() + (size_t)row * D, F.lane); }
    while (row < row1) {
        const int nrow = row + wstride;
        if (nrow < row1) { row_load_nt(nu, F.pu() + (size_t)nrow * D, F.lane); row_load_nt(nv, F.pv() + (size_t)nrow * D, F.lane); }
        cvt_row_lp<U_FMT>(ru, F.UT() + (size_t)row * UROW, F.US() + 2 * (size_t)row, F.lane);
        cvt_row_lp<V_FMT>(rv, F.VT() + (size_t)row * VROW, F.US() + 2 * (size_t)row + 1, F.lane);
        ru = nu; rv = nv; row = nrow;
    }
}
__device__ __forceinline__ void convert_in_tail(Frame& F, int layer, int nunits, int part) {
    if (layer + 1 >= NLAYER) return;
    const int G = F.G, rounds = (nunits + G - 1) / G, nlast = nunits - (rounds - 1) * G;
    const int c = (int)blockIdx.x;
    int nshort = G - nlast, sidx = c - nlast;
    if (nshort <= 0) { nshort = G; sidx = c; }
    else if (sidx < 0) return;
    const int r0 = (layer + 1) * NEXP + part * (NEXP / 2);
    convert_tables(F, r0, r0 + NEXP / 2, sidx * NWAVES + F.wave, nshort * NWAVES);
}
__device__ __forceinline__ void p0a_prologue(Frame& F) {
    LAS float* condL = (LAS float*)F.lds;
    LAS float* red = (LAS float*)(F.lds + 24576);
    for (int i = F.tid; i < 3 * D; i += NWAVES * 64) { const int r = i / D, k = i % D; const float v = r < 2 ? F.c()[r * D + k] : F.c_ctx()[k]; condL[i] = v / (1.f + __expf(-v)); }
    __syncthreads();
    const bool bal = (F.G == 256);
    for (int pass = 0; pass < (bal ? 2 : 384); ++pass) {
        int item, kw, kbase;
        if (bal) { item = pass == 0 ? (int)blockIdx.x : 256 + ((int)blockIdx.x >> 1); kw = pass == 0 ? 256 : 128; kbase = pass == 0 ? F.wave * 256 : ((int)blockIdx.x & 1) * 1024 + F.wave * 128; }
        else { item = (int)blockIdx.x + pass * F.G; kw = 256; kbase = F.wave * 256; if (item >= 384) break; }
        const int l = item / 96, n0 = (item % 96) * 128;
        const float* wp = F.w_ada() + ((size_t)l * D + kbase) * 12288 + n0 + 2 * F.lane;
        f32x2 a0 = {0.f, 0.f}, a1 = {0.f, 0.f}, a2 = {0.f, 0.f};
#pragma unroll 8
        for (int k = 0; k < kw; ++k) { const f32x2 w = __builtin_nontemporal_load((const f32x2*)(wp + (size_t)k * 12288)); const int kk = kbase + k;
            a0 += w * condL[kk]; a1 += w * condL[D + kk]; a2 += w * condL[2 * D + kk]; }
        LAS float* rp = red + F.wave * 384 + 2 * F.lane;
        rp[0] = a0.x; rp[1] = a0.y; rp[128] = a1.x; rp[129] = a1.y; rp[256] = a2.x; rp[257] = a2.y;
        __syncthreads();
        if (F.tid < 384) { const int r = F.tid / 128, n = F.tid % 128; float s = 0.f;
#pragma unroll
            for (int w = 0; w < 8; ++w) s += red[w * 384 + r * 128 + n];
            if (!(bal && pass == 1 && (blockIdx.x & 1))) s += F.b_ada()[(size_t)l * 12288 + n0 + n];
            atomicAdd(F.MODS() + ((size_t)l * 3 + r) * 12288 + n0 + n, s); }
        __syncthreads();
    }
    LAS float* scr = (LAS float*)(F.lds + 40960 + F.wave * 8448);
    constexpr int I_IN = (D / 64) * (INC / 32), I_OUT = (D / 64) * (D / 32);
    for (int it = F.gw; it < NLAYER * (I_IN + I_OUT); it += F.NGW) {
        const int l = it / (I_IN + I_OUT); int r = it % (I_IN + I_OUT);
        if (r < I_IN) transpose_item8(F.w_in() + (size_t)l * D * INC, D, INC, F.WINT() + (size_t)l * INC * D, scr, r, F.lane, WIN_SCALE);
        else transpose_item8(F.w_out() + (size_t)l * D * D, D, D, F.WOUTT() + (size_t)l * D * D, scr, r - I_IN, F.lane, WOUT_SCALE);
    }
    for (int row = F.gw; row < NLAYER * D; row += F.NGW) {
        const int l = row / D, c = row % D; const f32x4* s = (const f32x4*)(F.wq() + (size_t)row * D) + F.lane;
#pragma unroll
        for (int j = 0; j < 8; ++j) { const f32x4 v = s[64 * j]; u32x2 o; o.x = pk2(v.x, v.y); o.y = pk2(v.z, v.w);
            *((u32x2*)(F.WQR() + ((size_t)(l * 8 + j) * D + c) * 256) + F.lane) = o; }
    }
    for (int row = F.gw; row < 32 * 256; row += F.NGW) {
        const int lh = row >> 8, pk = row & 255, p = pk >> 7;
        u32x2 o = {0u, 0u};
        if ((F.lane >> 5) == p) { const f32x4 v = *((const f32x4*)(F.keys() + ((size_t)lh * 256 + pk) * 128) + (F.lane & 31)); o.x = pk2(v.x, v.y); o.y = pk2(v.z, v.w); }
        *((u32x2*)(F.KBD() + (size_t)row * 256) + F.lane) = o;
    }
    convert_tables(F, 0, NEXP, F.gw, F.NGW);
    for (int i = blockIdx.x * (NWAVES * 64) + F.tid; i < 192 * 32; i += F.G * NWAVES * 64) {
        const int idx = i >> 5, f = i & 31; const float pos = (float)(idx < 128 ? idx : idx - 128);
        const float inv = powf(10000.f, -(float)(2 * f) / 64.f); const float ang = pos * inv;
        F.ROPE()[2 * i] = cosf(ang); F.ROPE()[2 * i + 1] = sinf(ang);
    }
}

__device__ __forceinline__ void p0b_mod0(Frame& F) {
    __syncthreads();
#pragma unroll 1
    for (int v = 0; v < 6; ++v)
        *(LAS f32x4*)(F.lds + v * 8192 + F.tid * 16) = *(const f32x4*)(F.MODS() + (size_t)(v % 3) * 12288 + (v < 3 ? 0 : D) + 4 * F.tid);
    __syncthreads();
    for (int t = F.gw; t < TT; t += F.NGW) {
        const float* src = t < TL ? F.x() + (size_t)t * D : F.ctx() + (size_t)(t - TL) * D;
        f32x4 v[8];
#pragma unroll
        for (int j = 0; j < 8; ++j) v[j] = *((const f32x4*)src + F.lane + 64 * j);
        const int mr = modrow(t);
        float mean, rstd; row_stats(v, mean, rstd);
        unsigned* d = (unsigned*)(F.H8() + (size_t)t * D) + F.lane;
#pragma unroll
        for (int j = 0; j < 8; ++j) { const f32x4 sh = *(const LAS f32x4*)(F.lds + mr * 8192 + (64 * j + F.lane) * 16), sc = *(const LAS f32x4*)(F.lds + (3 + mr) * 8192 + (64 * j + F.lane) * 16);
            const f32x4 y = (v[j] - mean) * rstd * (sc + 1.f) + sh;
            int o = __builtin_amdgcn_cvt_pk_fp8_f32(y.x, y.y, 0, false); o = __builtin_amdgcn_cvt_pk_fp8_f32(y.z, y.w, o, true); d[64 * j] = (unsigned)o; }
    }
}

constexpr int ROPE_LDS = 98304;
constexpr int CONV_LDS = 81920;
constexpr int KP = 272, VP = 320, KS_BYTES = 64 * KP, VS_BYTES = 64 * VP;
struct KVRegs { u32x4 k1, k2, v1, v2; f32x4 cs[4]; };

__device__ __forceinline__ void attn_load_tile(Frame& F, KVRegs& R, int ti, int b, int n, int g) {
    const int key = F.tid >> 3, c8 = F.tid & 7;
    int row, pos = 0;
    if (ti < 6) { pos = (n - 1) * 128 + 64 * ti + key; row = b * SEQ + pos; } else row = TL + b * CTXL + 64 * (ti - 6) + key;
    const bf16_t* base = F.PROJ() + (size_t)row * INC;
    const int d1 = (c8 >> 2) * 64 + (c8 & 3) * 8;
    R.k1 = *(const u32x4*)(base + OFF_K + g * 128 + d1); R.k2 = *(const u32x4*)(base + OFF_K + g * 128 + d1 + 32);
    R.v1 = *(const u32x4*)(base + OFF_V + g * 128 + 8 * c8); R.v2 = *(const u32x4*)(base + OFF_V + g * 128 + 64 + 8 * c8);
    if (ti < 6) { const int tidx = (c8 >> 2) ? 128 + (pos & 63) : (pos >> 6); const LAS f32x4* cp = (const LAS f32x4*)(F.lds + ROPE_LDS + (tidx * 32 + (c8 & 3) * 8) * 8);
#pragma unroll
        for (int m = 0; m < 4; ++m) R.cs[m] = cp[m]; }
}
__device__ __forceinline__ void rope8(u32x4& a, u32x4& bq, const f32x4 (&cs)[4], float scale) {
    u32x4 oa, ob;
#pragma unroll
    for (int w = 0; w < 4; ++w) {
        const float x1l = bf_lo(a[w]), x1h = bf_hi(a[w]), x2l = bf_lo(bq[w]), x2h = bf_hi(bq[w]);
        const float cl = cs[w].x, sl = cs[w].y, ch = cs[w].z, sh = cs[w].w;
        oa[w] = pk2((x1l * cl - x2l * sl) * scale, (x1h * ch - x2h * sh) * scale);
        ob[w] = pk2((x2l * cl + x1l * sl) * scale, (x2h * ch + x1h * sh) * scale);
    }
    a = oa; bq = ob;
}
__device__ __forceinline__ void attn_store_tile(Frame& F, KVRegs& R, int ti, int buf) {
    const int key = F.tid >> 3, c8 = F.tid & 7;
    if (ti < 6) rope8(R.k1, R.k2, R.cs, 1.f);
    const int d1 = (c8 >> 2) * 64 + (c8 & 3) * 8;
    LAS unsigned char* kp = F.lds + buf * KS_BYTES + key * KP;
    *(LAS u32x4*)(kp + d1 * 2) = R.k1; *(LAS u32x4*)(kp + (d1 + 32) * 2) = R.k2;
    LAS unsigned char* vp = F.lds + 2 * KS_BYTES + buf * VS_BYTES + key * VP;
    *(LAS u32x4*)(vp + 16 * c8) = R.v1; *(LAS u32x4*)(vp + 128 + 16 * c8) = R.v2;
}

#define MFMA32(a, b, c) __builtin_amdgcn_mfma_f32_32x32x16_bf16((a), (b), (c), 0, 0, 0)

__device__ __forceinline__ void attn_unit(Frame& F, int layer, int u) {
    const bool latent = u < 512;
    int b, n, g, hp;
    if (latent) { hp = u & 1; g = (u >> 1) & 1; n = (u >> 2) & 63; b = u >> 8; }
    else { const int v = u - 512; hp = v & 1; g = (v >> 1) & 1; n = (v >> 2) & 1; b = v >> 3; }
    const int lane = F.lane, r = lane & 31, h = lane >> 5, wave = F.wave;
    const int head = g * 4 + hp * 2 + (wave >> 2), qb = wave & 3;
    const int tq = latent ? b * SEQ + n * 128 + 32 * qb + r : TL + b * CTXL + n * 128 + 32 * qb + r;
    bf16x8 qf[8];
    {
        u32x4 raw[8];
        const bf16_t* qp = F.PROJ() + (size_t)tq * INC + OFF_Q + head * 128 + 8 * h;
#pragma unroll
        for (int ks = 0; ks < 8; ++ks) raw[ks] = *(const u32x4*)(qp + 16 * ks);
        if (latent) {
            const int pos = n * 128 + 32 * qb + r;
#pragma unroll
            for (int half = 0; half < 2; ++half) {
                const int tidx = half ? 128 + (pos & 63) : (pos >> 6);
#pragma unroll
                for (int kk = 0; kk < 2; ++kk) {
                    const LAS f32x4* cp = (const LAS f32x4*)(F.lds + ROPE_LDS + (tidx * 32 + 16 * kk + 8 * h) * 8);
                    f32x4 cs[4];
#pragma unroll
                    for (int m = 0; m < 4; ++m) cs[m] = cp[m];
                    rope8(raw[4 * half + kk], raw[4 * half + kk + 2], cs, QSCALE);
                }
            }
        } else {
#pragma unroll
            for (int ks = 0; ks < 8; ++ks)
#pragma unroll
                for (int w = 0; w < 4; ++w) raw[ks][w] = pk2(bf_lo(raw[ks][w]) * QSCALE, bf_hi(raw[ks][w]) * QSCALE);
        }
#pragma unroll
        for (int ks = 0; ks < 8; ++ks) qf[ks] = __builtin_bit_cast(bf16x8, raw[ks]);
    }
    int tlo = 6, nw = 0;
    if (latent) { tlo = (n == 0) ? 2 : 0; const int thi = (n == 63) ? 3 : 5; nw = thi - tlo + 1; }
    const int ntiles = nw + 4;
    f32x16 o[4];
#pragma unroll
    for (int db = 0; db < 4; ++db)
#pragma unroll
        for (int i = 0; i < 16; ++i) o[db][i] = 0.f;
    float m_run = F.sink()[layer * 8 + head] * LOG2E;
    float lsum = h == 0 ? 1.f : 0.f;
    const int iq = 32 * qb + r;
    KVRegs R;
    __syncthreads();
    attn_load_tile(F, R, nw > 0 ? tlo : 6, b, n, g);
    attn_store_tile(F, R, nw > 0 ? tlo : 6, 0);
    __syncthreads();
    const int i16 = lane & 15, tq4 = i16 >> 2, tp = i16 & 3, blk = (lane >> 4) & 1;
    for (int j = 0; j < ntiles; ++j) {
        const int ti = j < nw ? tlo + j : 6 + (j - nw);
        const int buf = j & 1;
        const bool more = j + 1 < ntiles;
        const int tin = (j + 1) < nw ? tlo + j + 1 : 6 + (j + 1 - nw);
        if (more) attn_load_tile(F, R, tin, b, n, g);
        const bool part = ti >= 6 || (ti >= (qb >> 1) && ti <= (qb >> 1) + 4);
        if (part) {
            f32x16 s0, s1;
#pragma unroll
            for (int i = 0; i < 16; ++i) { s0[i] = 0.f; s1[i] = 0.f; }
            const LAS unsigned char* kb = F.lds + buf * KS_BYTES + r * KP + h * 16;
#pragma unroll
            for (int ks = 0; ks < 8; ++ks) {
                const bf16x8 a0 = *(const LAS bf16x8*)(kb + ks * 32), a1 = *(const LAS bf16x8*)(kb + 32 * KP + ks * 32);
                s0 = MFMA32(a0, qf[ks], s0); s1 = MFMA32(a1, qf[ks], s1);
            }
            float mx = -INFINITY;
            if (ti < 6 && (ti == (qb >> 1) || ti == (qb >> 1) + 4)) {
                const int jb = 64 * ti + 4 * h - iq;
#pragma unroll
                for (int i = 0; i < 16; ++i) { const int j0 = jb + (i & 3) + 8 * (i >> 2), j1 = j0 + 32;
                    s0[i] = (j0 >= 0 && j0 <= 256) ? s0[i] : -INFINITY; s1[i] = (j1 >= 0 && j1 <= 256) ? s1[i] : -INFINITY; }
            }
#pragma unroll
            for (int i = 0; i < 16; ++i) mx = fmaxf(mx, fmaxf(s0[i], s1[i]));
            mx = fmaxf(mx, xor32_f(mx, lane));
            if (__any(mx > m_run + 8.f)) {
                const float m_new = mx > m_run + 8.f ? mx : m_run, alpha = __builtin_amdgcn_exp2f(m_run - m_new);
                m_run = m_new; lsum *= alpha;
#pragma unroll
                for (int db = 0; db < 4; ++db)
#pragma unroll
                    for (int i = 0; i < 16; ++i) o[db][i] *= alpha;
            }
#pragma unroll
            for (int i = 0; i < 16; ++i) { s0[i] = __builtin_amdgcn_exp2f(s0[i] - m_run); s1[i] = __builtin_amdgcn_exp2f(s1[i] - m_run); lsum += s0[i] + s1[i]; }
            bf16x8 pf[2][2];
#pragma unroll
            for (int s2 = 0; s2 < 2; ++s2) {
                u32x4 p0, p1;
#pragma unroll
                for (int w = 0; w < 4; ++w) { p0[w] = pk2(s0[8 * s2 + 2 * w], s0[8 * s2 + 2 * w + 1]); p1[w] = pk2(s1[8 * s2 + 2 * w], s1[8 * s2 + 2 * w + 1]); }
                pf[0][s2] = __builtin_bit_cast(bf16x8, p0); pf[1][s2] = __builtin_bit_cast(bf16x8, p1);
            }
            const LAS unsigned char* vb = F.lds + 2 * KS_BYTES + buf * VS_BYTES + (4 * h + tq4) * VP + 32 * blk + 8 * tp;
#pragma unroll
            for (int db = 0; db < 4; ++db)
#pragma unroll
                for (int kb2 = 0; kb2 < 2; ++kb2)
#pragma unroll
                    for (int s2 = 0; s2 < 2; ++s2) {
                        const int off = (32 * kb2 + 16 * s2) * VP + db * 64;
                        const s16x4 lo = __builtin_amdgcn_ds_read_tr16_b64_v4i16((LAS s16x4*)(vb + off));
                        const s16x4 hi = __builtin_amdgcn_ds_read_tr16_b64_v4i16((LAS s16x4*)(vb + off + 8 * VP));
                        const bf16x8 av = __builtin_shufflevector(lo, hi, 0, 1, 2, 3, 4, 5, 6, 7);
                        o[db] = MFMA32(av, pf[kb2][s2], o[db]);
                    }
        }
        if (more) attn_store_tile(F, R, tin, buf ^ 1);
        __syncthreads();
    }
    const float lt = lsum + xor32_f(lsum, lane);
    const float inv = 1.f / lt;
    float ss = 0.f;
#pragma unroll
    for (int db = 0; db < 4; ++db)
#pragma unroll
        for (int i = 0; i < 16; ++i) { o[db][i] *= inv; ss += o[db][i] * o[db][i]; }
    ss += xor32_f(ss, lane);
    const float rn = 1.f / sqrtf(ss * (1.f / 128.f) + LN_EPS);
    unsigned char* op = F.MIX() + (size_t)tq * D + head * 128 + 4 * h;
    const float* gp = F.g_attn() + layer * 1024 + head * 128 + 4 * h;
#pragma unroll
    for (int db = 0; db < 4; ++db)
#pragma unroll
        for (int g4 = 0; g4 < 4; ++g4) {
            const f32x4 gv = *(const f32x4*)(gp + 32 * db + 8 * g4);
            int w = __builtin_amdgcn_cvt_pk_fp8_f32(o[db][4 * g4] * rn * gv.x, o[db][4 * g4 + 1] * rn * gv.y, 0, false);
            w = __builtin_amdgcn_cvt_pk_fp8_f32(o[db][4 * g4 + 2] * rn * gv.z, o[db][4 * g4 + 3] * rn * gv.w, w, true);
            *(unsigned*)(op + 32 * db + 8 * g4) = (unsigned)w;
        }
}

__device__ __forceinline__ void unpack8(const u32x4 v, float (&f)[8]) {
#pragma unroll
    for (int w = 0; w < 4; ++w) { f[2 * w] = bf_lo(v[w]); f[2 * w + 1] = bf_hi(v[w]); }
}
__device__ __forceinline__ void conv_row(Frame& F, int layer, int t) {
    bool first, last;
    if (t < TL) { const int pos = t & (SEQ - 1); first = pos == 0; last = pos == SEQ - 1; } else { const int pc = (t - TL) & (CTXL - 1); first = pc == 0; last = pc == CTXL - 1; }
    const bf16_t* p = F.PROJ() + (size_t)t * INC;
    const LAS unsigned char* cvc = F.lds + CONV_LDS + F.lane * 16;
#pragma unroll
    for (int jc = 0; jc < 2; ++jc) {
        const int c = 8 * F.lane + 512 * jc;
        float gb[8], a[8], bq[8], um[8], ut[8], up[8];
        unpack8(*(const u32x4*)(p + c), gb);
        unpack8(*(const u32x4*)(p + OFF_C + c), a); unpack8(*(const u32x4*)(p + OFF_X + c), bq);
#pragma unroll
        for (int e = 0; e < 8; ++e) ut[e] = a[e] * bq[e];
        if (!first) { unpack8(*(const u32x4*)(p - INC + OFF_C + c), a); unpack8(*(const u32x4*)(p - INC + OFF_X + c), bq);
#pragma unroll
            for (int e = 0; e < 8; ++e) um[e] = a[e] * bq[e]; }
        else {
#pragma unroll
            for (int e = 0; e < 8; ++e) um[e] = 0.f; }
        if (!last) { unpack8(*(const u32x4*)(p + INC + OFF_C + c), a); unpack8(*(const u32x4*)(p + INC + OFF_X + c), bq);
#pragma unroll
            for (int e = 0; e < 8; ++e) up[e] = a[e] * bq[e]; }
        else {
#pragma unroll
            for (int e = 0; e < 8; ++e) up[e] = 0.f; }
        float y[8], ss = 0.f;
#pragma unroll
        for (int q = 0; q < 2; ++q) { const f32x4 w0 = *(const LAS f32x4*)(cvc + (2 * jc + q) * 1024), w1 = *(const LAS f32x4*)(cvc + 4096 + (2 * jc + q) * 1024), w2 = *(const LAS f32x4*)(cvc + 8192 + (2 * jc + q) * 1024);
#pragma unroll
            for (int e = 0; e < 4; ++e) { const int i = 4 * q + e; y[i] = gb[i] * (w0[e] * um[i] + w1[e] * ut[i] + w2[e] * up[i]); ss += y[i] * y[i]; } }
        ss += dpp_f<DPP_XOR1>(ss); ss += dpp_f<DPP_XOR2>(ss); ss += dpp_f<DPP_ROR4>(ss); ss += dpp_f<DPP_ROR8>(ss);
        const float rn = 1.f / sqrtf(ss * (1.f / 128.f) + LN_EPS);
        u32x2 w;
#pragma unroll
        for (int q = 0; q < 2; ++q) { const f32x4 gcv = *(const LAS f32x4*)(cvc + 12288 + (2 * jc + q) * 1024);
            int t8 = __builtin_amdgcn_cvt_pk_fp8_f32(y[4 * q] * rn * gcv[0], y[4 * q + 1] * rn * gcv[1], 0, false); t8 = __builtin_amdgcn_cvt_pk_fp8_f32(y[4 * q + 2] * rn * gcv[2], y[4 * q + 3] * rn * gcv[3], t8, true); w[q] = (unsigned)t8; }
        *(u32x2*)(F.MIX() + (size_t)t * D + 1024 + c) = w;
    }
}

__device__ __forceinline__ void ln_phase(Frame& F, int layer, int rows) {
    const int lane = F.lane;
    const bf16_t* Y = F.PROJ();
    u32x4 w[4], wn[4], yw[4], yn[4];
    int t = F.gw;
    if (t < rows) {
#pragma unroll
        for (int j = 0; j < 4; ++j) { yw[j] = *(const u32x4*)(Y + (size_t)t * D + 8 * lane + 512 * j); if (layer > 0) w[j] = *(const u32x4*)(F.X() + (size_t)t * D + 8 * lane + 512 * j); }
    }
    {
        const int ch = F.tid, jj = ch >> 7, rem = ch & 127, ll = rem >> 1, qq = rem & 1;
        LAS unsigned char* dst = F.lds + ((2 * jj + qq) * 64 + ll) * 16;
        *(LAS f32x4*)(dst) = *(const f32x4*)(F.ln1_g() + layer * D + 4 * ch);
        *(LAS f32x4*)(dst + 8192) = *(const f32x4*)(F.ln1_b() + layer * D + 4 * ch);
#pragma unroll 1
        for (int v = 0; v < 9; ++v) { const int mrv = v % 3; const size_t off = ((size_t)layer * 3 + mrv) * 12288 + (v < 3 ? 3 * D : (v < 6 ? 4 * D : 2 * D));
            *(LAS f32x4*)(dst + (2 + v) * 8192) = *(const f32x4*)(F.MODS() + off + 4 * ch); }
    }
    __syncthreads();
    const LAS unsigned char* vc = F.lds + lane * 16;
    while (t < rows) {
        const int tn = t + F.NGW;
        if (tn < rows) {
#pragma unroll
            for (int j = 0; j < 4; ++j) { yn[j] = *(const u32x4*)(Y + (size_t)tn * D + 8 * lane + 512 * j); if (layer > 0) wn[j] = *(const u32x4*)(F.X() + (size_t)tn * D + 8 * lane + 512 * j); }
        }
        const int mrl = modrow(t);
        float v[32]; float s = 0.f;
#pragma unroll
        for (int j = 0; j < 4; ++j) {
            float xin[8], yv[8];
            unpack8(yw[j], yv);
            if (layer > 0) unpack8(w[j], xin);
            else { const float* xp = (t < TL ? F.x() + (size_t)t * D : F.ctx() + (size_t)(t - TL) * D) + 8 * lane + 512 * j; const f32x4 a0 = *(const f32x4*)xp, a1 = *(const f32x4*)(xp + 4);
                xin[0] = a0[0]; xin[1] = a0[1]; xin[2] = a0[2]; xin[3] = a0[3]; xin[4] = a1[0]; xin[5] = a1[1]; xin[6] = a1[2]; xin[7] = a1[3]; }
#pragma unroll
            for (int q = 0; q < 2; ++q) { const f32x4 ga = *(const LAS f32x4*)(vc + (8 + mrl) * 8192 + (2 * j + q) * 1024);
#pragma unroll
                for (int e = 0; e < 4; ++e) { const float r = DN_ALPHA * xin[4 * q + e] + ga[e] * yv[4 * q + e]; v[8 * j + 4 * q + e] = r; s += r; } } }
        const float mean = wave_sum(s) * (1.f / D);
        float s2 = 0.f;
#pragma unroll
        for (int i = 0; i < 32; ++i) { v[i] -= mean; s2 += v[i] * v[i]; }
        const float rstd = 1.f / sqrtf(wave_sum(s2) * (1.f / D) + LN_EPS);
        float s3 = 0.f;
#pragma unroll
        for (int j = 0; j < 4; ++j) { const int c = 8 * lane + 512 * j; u32x4 o;
#pragma unroll
            for (int q = 0; q < 2; ++q) { const f32x4 gg = *(const LAS f32x4*)(vc + (2 * j + q) * 1024), bb = *(const LAS f32x4*)(vc + 8192 + (2 * j + q) * 1024);
#pragma unroll
                for (int e = 0; e < 4; ++e) { const float y = v[8 * j + 4 * q + e] * rstd * gg[e] + bb[e]; v[8 * j + 4 * q + e] = y; s3 += y; }
                o[2 * q] = pk2(v[8 * j + 4 * q], v[8 * j + 4 * q + 1]); o[2 * q + 1] = pk2(v[8 * j + 4 * q + 2], v[8 * j + 4 * q + 3]); }
            *(u32x4*)(F.X() + (size_t)t * D + c) = o; }
        const float mean2 = wave_sum(s3) * (1.f / D);
        float s4 = 0.f;
#pragma unroll
        for (int i = 0; i < 32; ++i) { v[i] -= mean2; s4 += v[i] * v[i]; }
        const float rstd2 = 1.f / sqrtf(wave_sum(s4) * (1.f / D) + LN_EPS);
#pragma unroll
        for (int j = 0; j < 4; ++j) { const int c = 8 * lane + 512 * j; u32x4 o;
#pragma unroll
            for (int q = 0; q < 2; ++q) { const f32x4 sh = *(const LAS f32x4*)(vc + (2 + mrl) * 8192 + (2 * j + q) * 1024), sc = *(const LAS f32x4*)(vc + (5 + mrl) * 8192 + (2 * j + q) * 1024);
                const float y0 = v[8 * j + 4 * q] * rstd2 * (1.f + sc[0]) + sh[0], y1 = v[8 * j + 4 * q + 1] * rstd2 * (1.f + sc[1]) + sh[1];
                const float y2 = v[8 * j + 4 * q + 2] * rstd2 * (1.f + sc[2]) + sh[2], y3 = v[8 * j + 4 * q + 3] * rstd2 * (1.f + sc[3]) + sh[3];
                o[2 * q] = pk2(y0, y1); o[2 * q + 1] = pk2(y2, y3); }
            *(u32x4*)(F.H() + (size_t)t * D + c) = o; }
#pragma unroll
        for (int j = 0; j < 4; ++j) { w[j] = wn[j]; yw[j] = yn[j]; }
        t = tn;
    }
}

__device__ __forceinline__ unsigned ordkey(float f) { const unsigned u = __float_as_uint(f); return u ^ ((u >> 31) ? 0xFFFFFFFFu : 0x80000000u); }
__device__ __forceinline__ float gelu_erf(float a) { return 0.5f * a * (1.f + erff(a * 0.70710678118654752f)); }

__device__ __forceinline__ float unordkey(unsigned k) { return __uint_as_float(k ^ ((k >> 31) ? 0x80000000u : 0xFFFFFFFFu)); }
__device__ __forceinline__ float gelu_as(float v) {
    const float av = fabsf(v), t = __builtin_amdgcn_rcpf(av * 0.2316418882f + 1.0f);
    float q = t * 0.5307027145f + (-0.7265760135f); q = q * t + 0.7107068705f; q = q * t + (-0.142248368f); q = q * t + 0.127414796f; q = q * t;
    const float e = __builtin_amdgcn_exp2f((v * v) * (-0.72134752044f));
    const float m = v * (q * e);
    return v < 0.f ? m : v - m;
}

template <class O> struct QuadNet {
    typedef typename O::V V; typedef typename O::B B;
    template <bool ASC> static __device__ __forceinline__ void ce_reg(V& a, V& b) { const V lo = O::vmin(a, b), hi = O::vmax(a, b); a = ASC ? lo : hi; b = ASC ? hi : lo; }
    template <bool ASC> static __device__ __forceinline__ void ce_l1(V& x, B low1) { const V p = O::x1(x); const V mn = O::vmin(p, x), mx = O::vmax(p, x); x = ASC ? O::vsel(low1, mn, mx) : O::vsel(low1, mx, mn); }
    template <bool ASC> static __device__ __forceinline__ void ce_l2(V& x, B low2) { const V p = O::x2(x); const V mn = O::vmin(p, x), mx = O::vmax(p, x); x = ASC ? O::vsel(low2, mn, mx) : O::vsel(low2, mx, mn); }
    template <int NR> static __device__ __forceinline__ void sort_blocks(V (&R)[NR], B low1, B low2, B eq12) {
#pragma unroll
        for (int r = 0; r < NR; ++r) { const V p = O::x1(R[r]); const V mn = O::vmin(p, R[r]), mx = O::vmax(p, R[r]); R[r] = O::vsel(eq12, mn, mx); }
#pragma unroll
        for (int r = 0; r < NR; ++r) { if ((r & 1) == 0) ce_l2<true>(R[r], low2); else ce_l2<false>(R[r], low2); }
#pragma unroll
        for (int r = 0; r < NR; ++r) { if ((r & 1) == 0) ce_l1<true>(R[r], low1); else ce_l1<false>(R[r], low1); }
#pragma unroll
        for (int r = 0; r < NR; r += 2) { if ((r & 2) == 0) ce_reg<true>(R[r], R[r + 1]); else ce_reg<false>(R[r], R[r + 1]); }
#pragma unroll
        for (int r = 0; r < NR; ++r) { if ((r & 2) == 0) ce_l2<true>(R[r], low2); else ce_l2<false>(R[r], low2); }
#pragma unroll
        for (int r = 0; r < NR; ++r) { if ((r & 2) == 0) ce_l1<true>(R[r], low1); else ce_l1<false>(R[r], low1); }
#pragma unroll
        for (int r = 0; r < NR; ++r) { if ((r & 2) == 0) { if ((r & 4) == 0) ce_reg<true>(R[r], R[r + 2]); else ce_reg<false>(R[r], R[r + 2]); } }
#pragma unroll
        for (int r = 0; r < NR; r += 2) { if ((r & 4) == 0) ce_reg<true>(R[r], R[r + 1]); else ce_reg<false>(R[r], R[r + 1]); }
#pragma unroll
        for (int r = 0; r < NR; ++r) { if ((r & 4) == 0) ce_l2<true>(R[r], low2); else ce_l2<false>(R[r], low2); }
#pragma unroll
        for (int r = 0; r < NR; ++r) { if ((r & 4) == 0) ce_l1<true>(R[r], low1); else ce_l1<false>(R[r], low1); }
    }
    template <int NR> static __device__ __forceinline__ void halve_merge(const V (&R)[NR], V (&Q)[NR / 2], B low1, B low2) {
#pragma unroll
        for (int m = 0; m < NR / 8; ++m)
#pragma unroll
            for (int i = 0; i < 4; ++i) Q[4 * m + i] = O::vmax(R[8 * m + i], R[8 * m + 4 + i]);
#pragma unroll
        for (int r = 0; r < NR / 2; ++r) { if ((r & 2) == 0) { if ((r & 4) == 0) ce_reg<false>(Q[r], Q[r + 2]); else ce_reg<true>(Q[r], Q[r + 2]); } }
#pragma unroll
        for (int r = 0; r < NR / 2; r += 2) { if ((r & 4) == 0) ce_reg<false>(Q[r], Q[r + 1]); else ce_reg<true>(Q[r], Q[r + 1]); }
#pragma unroll
        for (int r = 0; r < NR / 2; ++r) { if ((r & 4) == 0) ce_l2<false>(Q[r], low2); else ce_l2<true>(Q[r], low2); }
#pragma unroll
        for (int r = 0; r < NR / 2; ++r) { if ((r & 4) == 0) ce_l1<false>(Q[r], low1); else ce_l1<true>(Q[r], low1); }
    }
    static __device__ __forceinline__ void top16_of_128(V (&R)[32], V (&T)[4], B low1, B low2, B eq12) {
        sort_blocks<32>(R, low1, low2, eq12);
        V A[16]; halve_merge<32>(R, A, low1, low2);
        V Bq[8]; halve_merge<16>(A, Bq, low1, low2);
        halve_merge<8>(Bq, T, low1, low2);
    }
    static __device__ __forceinline__ void top16_of_64(V (&R)[16], V (&T)[4], B low1, B low2, B eq12) {
        sort_blocks<16>(R, low1, low2, eq12);
        V A[8]; halve_merge<16>(R, A, low1, low2);
        halve_merge<8>(A, T, low1, low2);
    }
};

struct DevOps {
    typedef unsigned V; typedef bool B;
    static __device__ __forceinline__ V vmin(V a, V b) { return a < b ? a : b; }
    static __device__ __forceinline__ V vmax(V a, V b) { return a > b ? a : b; }
    static __device__ __forceinline__ V vsel(B m, V a, V b) { return m ? a : b; }
    static __device__ __forceinline__ V x1(V a) { return (V)dpp_i<DPP_XOR1>((int)a); }
    static __device__ __forceinline__ V x2(V a) { return (V)dpp_i<DPP_XOR2>((int)a); }
};
__device__ __forceinline__ void stair_ab(int c, int& a, int& b) {
    if (c < 16) { a = 0; b = c; } else if (c < 24) { a = 1; b = c - 16; } else if (c < 28) { a = 2; b = c - 24; } else if (c < 32) { a = 3; b = c - 28; }
    else if (c < 36) { a = 4; b = c - 32; } else if (c < 40) { a = 5 + ((c - 36) >> 1); b = (c - 36) & 1; } else if (c < 44) { a = 7 + ((c - 40) >> 1); b = (c - 40) & 1; }
    else if (c < 48) { a = 9 + (c - 44); b = 0; } else if (c < 51) { a = 13 + (c - 48); b = 0; } else { a = 2; b = 4; }
}
constexpr int PE_WS = 5120, PE_TAB = 8 * PE_WS;
constexpr int PE_VEC = PE_TAB + 512;
static_assert(PE_VEC + 11 * 8192 <= LDSCTL_OFF, "PE vector cache");
__device__ __forceinline__ void peer_topk(Frame& F, LAS unsigned char* ws, int t) {
    const int lane = F.lane, sub = lane & 3;
    const bool low1 = (sub & 1) == 0, low2 = (sub & 2) == 0, eq12 = low1 == low2;
    LAS unsigned* S1K = (LAS unsigned*)ws; LAS int* EL = (LAS int*)(ws + 3328); LAS float* GL = (LAS float*)(ws + 3840);
    const LAS unsigned short* TAB = (const LAS unsigned short*)(F.lds + PE_TAB);
    {
        const int L = lane >> 2;
        const bf16_t* sp = F.SC() + (size_t)t * D + L * 128 + sub * 32;
        unsigned R[32];
#pragma unroll
        for (int q = 0; q < 4; ++q) { const u32x4 v = *(const u32x4*)(sp + 8 * q);
#pragma unroll
            for (int e = 0; e < 4; ++e) {
                R[8 * q + 2 * e] = (ordkey(bf_lo(v[e])) & ~127u) | (unsigned)(127 - (32 * sub + 8 * q + 2 * e));
                R[8 * q + 2 * e + 1] = (ordkey(bf_hi(v[e])) & ~127u) | (unsigned)(127 - (32 * sub + 8 * q + 2 * e + 1)); } }
        unsigned T[4];
        QuadNet<DevOps>::top16_of_128(R, T, low1, low2, eq12);
#pragma unroll
        for (int r = 0; r < 4; ++r) S1K[L * 16 + 4 * r + sub] = T[r];
    }
    LDS_WAIT(); __builtin_amdgcn_wave_barrier();
    {
        const int hd = (lane >> 2) & 7;
        const LAS unsigned char* la = (const LAS unsigned char*)(S1K + (2 * hd) * 16); const LAS unsigned char* lb = (const LAS unsigned char*)(S1K + (2 * hd + 1) * 16);
        unsigned C[16];
#pragma unroll
        for (int r = 0; r < 13; ++r) { const unsigned ab = TAB[4 * r + sub];
            const unsigned ka = *(const LAS unsigned*)(la + (ab & 255u)), kb = *(const LAS unsigned*)(lb + (ab >> 8));
            const float sum = unordkey(ka & ~127u) + unordkey(kb & ~127u);
            C[r] = (ordkey(sum) & ~63u) | (unsigned)(63 - (4 * r + sub)); }
        C[13] = 0u; C[14] = 0u; C[15] = 0u;
        unsigned W[4];
        QuadNet<DevOps>::top16_of_64(C, W, low1, low2, eq12);
        float sv[4]; int ex[4];
#pragma unroll
        for (int r = 0; r < 4; ++r) { const unsigned ab = TAB[63 - (W[r] & 63u)];
            const unsigned ka = *(const LAS unsigned*)(la + (ab & 255u)), kb = *(const LAS unsigned*)(lb + (ab >> 8));
            ex[r] = (int)(127u - (ka & 127u)) * 128 + (int)(127u - (kb & 127u)); sv[r] = unordkey(W[r] & ~63u); }
        const float mx = dpp_f<0x00>(sv[0]);
        float e4[4], es = 0.f;
#pragma unroll
        for (int r = 0; r < 4; ++r) { e4[r] = __expf(sv[r] - mx); es += e4[r]; }
        es += dpp_f<DPP_XOR1>(es); es += dpp_f<DPP_XOR2>(es);
        const float rd = 1.f / es;
#pragma unroll
        for (int r = 0; r < 4; ++r) { GL[hd * 16 + 4 * r + sub] = e4[r] * rd; EL[hd * 16 + 4 * r + sub] = ex[r]; }
    }
    LDS_WAIT(); __builtin_amdgcn_wave_barrier();
}

#ifndef PROBE_PHASE
#define PROBE_PHASE -1
#endif
#ifndef PROBE_MULT
#define PROBE_MULT 1
#endif
constexpr int EB = 4;
constexpr int CW_TICKET = 20480;

struct GBuf { LpRow<U_FMT> u[EB]; LpRow<V_FMT> v[EB]; };
__device__ __forceinline__ void gather_issue(GBuf& B, const LAS int* EL, int i0, const unsigned char* UTl, const unsigned char* VTl, int lane) {
#pragma unroll
    for (int q = 0; q < EB; ++q) {
        const int ex = __builtin_amdgcn_readfirstlane(EL[i0 + q]);
        B.u[q].load(UTl + (size_t)ex * UROW, lane); B.v[q].load(VTl + (size_t)ex * VROW, lane);
    }
}
__device__ __forceinline__ void gather_compute(const GBuf& B, const LAS int* EL, const LAS float* GL, int i0, const float* USl, const float* VSl, const unsigned (&hv)[16], f32x2 (&acc)[16]) {
    float dot[EB], su[EB], sv[EB], g[EB];
#pragma unroll
    for (int q = 0; q < EB; ++q) { const int ex = __builtin_amdgcn_readfirstlane(EL[i0 + q]); { const f32x2 s2 = *(const f32x2*)(USl + 2 * ex); su[q] = s2.x; sv[q] = s2.y; }
        g[q] = __uint_as_float(__builtin_amdgcn_readfirstlane(__float_as_uint(GL[i0 + q]))); }
#pragma unroll
    for (int q = 0; q < EB; ++q) { float s0 = 0.f, s1 = 0.f;
        B.u[q].each_bf([&](int i, bf16x2_t x) { if (i & 1) s1 = __builtin_amdgcn_fdot2_f32_bf16(x, __builtin_bit_cast(bf16x2_t, hv[i]), s1, false); else s0 = __builtin_amdgcn_fdot2_f32_bf16(x, __builtin_bit_cast(bf16x2_t, hv[i]), s0, false); });
        dot[q] = s0 + s1; __builtin_amdgcn_sched_barrier(0); }
#pragma unroll
    for (int q = 0; q < EB; ++q) dot[q] = wave_sum_u(dot[q]);
#pragma unroll
    for (int q = 0; q < EB; ++q) { const float cf = g[q] * gelu_as(dot[q] * su[q]) * sv[q]; const f32x2 c2 = {cf, cf};
        B.v[q].each([&](int i, float x0, float x1) { const f32x2 x = {x0, x1}; acc[i >> 1] = __builtin_elementwise_fma(x, c2, acc[i >> 1]); }); __builtin_amdgcn_sched_barrier(0); }
}

__device__ __forceinline__ void peer_phase(Frame& F, int layer, int rows, unsigned* ctl, unsigned long long& pr_acc) {
    unsigned long long pt0 = 0ull;
#define SUB_BEGIN(ty) do { if (PROBE_PHASE == (ty)) pt0 = __builtin_amdgcn_s_memrealtime(); } while (0)
#define SUB_END(ty) do { if (PROBE_PHASE == (ty)) pr_acc += __builtin_amdgcn_s_memrealtime() - pt0; } while (0)
    if (F.tid < 64) { int a = 0, b = 0; stair_ab(F.tid < 52 ? F.tid : 0, a, b); *(LAS unsigned short*)(F.lds + PE_TAB + 2 * F.tid) = (unsigned short)((4 * a) | ((4 * b) << 8)); }
    {
        const int ch = F.tid, ll = ch >> 3, q = ch & 7;
        LAS unsigned char* dst = F.lds + PE_VEC + (q * 64 + ll) * 16;
        const int nl = layer < NLAYER - 1 ? layer + 1 : layer;
#pragma unroll 1
        for (int v = 0; v < 9; ++v) {
            const int g3 = v / 3, mrv = v - 3 * g3;
            const size_t off = ((size_t)(g3 == 0 ? layer : nl) * 3 + mrv) * 12288 + (g3 == 0 ? 5 * D : (g3 == 1 ? 0 : D));
            *(LAS f32x4*)(dst + v * 8192) = *(const f32x4*)(F.MODS() + off + 4 * ch);
        }
        *(LAS f32x4*)(dst + 9 * 8192) = *(const f32x4*)(F.ln2_g() + layer * D + 4 * ch);
        *(LAS f32x4*)(dst + 10 * 8192) = *(const f32x4*)(F.ln2_b() + layer * D + 4 * ch);
    }
    __syncthreads();
    LAS unsigned char* ws = F.lds + F.wave * PE_WS;
    LAS int* EL = (LAS int*)(ws + 3328); LAS float* GL = (LAS float*)(ws + 3840);
    const int lane = F.lane;
    const LAS unsigned char* vcache = F.lds + PE_VEC + lane * 16;
    const unsigned char* UTl = F.UT() + (size_t)layer * NEXP * UROW;
    const unsigned char* VTl = F.VT() + (size_t)layer * NEXP * VROW;
    const float* USl = F.US() + 2 * (size_t)layer * NEXP; const float* VSl = nullptr;
    unsigned* ticket = ctl + CW_TICKET + 64 * layer;
    unsigned tk = 0u;
    if (lane == 0) tk = __hip_atomic_fetch_add(ticket, 1u, __ATOMIC_RELAXED, __HIP_MEMORY_SCOPE_AGENT);
    int t = (int)__builtin_amdgcn_readfirstlane(tk);
    while (t < rows) {
        unsigned tkn = 0u;
        if (lane == 0) tkn = __hip_atomic_fetch_add(ticket, 1u, __ATOMIC_RELAXED, __HIP_MEMORY_SCOPE_AGENT);
        SUB_BEGIN(8); peer_topk(F, ws, t); SUB_END(8);
        SUB_BEGIN(9);
        unsigned hv[16]; f32x2 acc[16];
#pragma unroll
        for (int q = 0; q < 4; ++q) { const u32x4 w = *(const u32x4*)(F.H() + (size_t)t * D + 32 * lane + 8 * q);
#pragma unroll
            for (int e = 0; e < 4; ++e) { hv[4 * q + e] = w[e]; acc[4 * q + e] = (f32x2){0.f, 0.f}; } }
        {
            GBuf A, B, C;
            gather_issue(A, EL, 0, UTl, VTl, lane);
            gather_issue(B, EL, EB, UTl, VTl, lane);
            for (int i0 = 0; i0 < 30 * EB; i0 += 3 * EB) {
                gather_issue(C, EL, i0 + 2 * EB, UTl, VTl, lane);
                gather_compute(A, EL, GL, i0, USl, VSl, hv, acc);
                gather_issue(A, EL, i0 + 3 * EB, UTl, VTl, lane);
                gather_compute(B, EL, GL, i0 + EB, USl, VSl, hv, acc);
                gather_issue(B, EL, i0 + 4 * EB, UTl, VTl, lane);
                gather_compute(C, EL, GL, i0 + 2 * EB, USl, VSl, hv, acc);
            }
            gather_compute(A, EL, GL, 30 * EB, USl, VSl, hv, acc);
            gather_compute(B, EL, GL, 31 * EB, USl, VSl, hv, acc);
        }
        SUB_END(9); SUB_BEGIN(10);
        const int mr = modrow(t);
        const float* mp = F.MODS() + ((size_t)layer * 3 + mr) * 12288;
        bf16_t* xr = F.X() + (size_t)t * D;
        float rr[32]; float s = 0.f;
#pragma unroll
        for (int q2 = 0; q2 < 4; ++q2) { const u32x4 xw = *(const u32x4*)(xr + 32 * lane + 8 * q2);
#pragma unroll
            for (int h2 = 0; h2 < 2; ++h2) { const int q = 2 * q2 + h2; const f32x4 gv = *(const LAS f32x4*)(vcache + mr * 8192 + q * 1024);
                const f32x4 xv = {bf_lo(xw[2 * h2]), bf_hi(xw[2 * h2]), bf_lo(xw[2 * h2 + 1]), bf_hi(xw[2 * h2 + 1])};
                const f32x4 av = {acc[2 * q].x, acc[2 * q].y, acc[2 * q + 1].x, acc[2 * q + 1].y};
#pragma unroll
                for (int e = 0; e < 4; ++e) { const float v = DN_ALPHA * xv[e] + gv[e] * av[e]; rr[4 * q + e] = v; s += v; } } }
        const float mean = wave_sum_u(s) * (1.f / D);
        float s2 = 0.f;
#pragma unroll
        for (int i = 0; i < 32; ++i) { rr[i] -= mean; s2 += rr[i] * rr[i]; }
        const float rstd = 1.f / sqrtf(wave_sum_u(s2) * (1.f / D) + LN_EPS);
        const float* g2 = F.ln2_g() + layer * D; const float* b2 = F.ln2_b() + layer * D;
        float s3 = 0.f;
#pragma unroll
        for (int q = 0; q < 8; ++q) { const int c = 32 * lane + 4 * q; const f32x4 gg = *(const LAS f32x4*)(vcache + 9 * 8192 + q * 1024), bb = *(const LAS f32x4*)(vcache + 10 * 8192 + q * 1024);
            f32x4 xo;
#pragma unroll
            for (int e = 0; e < 4; ++e) { xo[e] = rr[4 * q + e] * rstd * gg[e] + bb[e]; rr[4 * q + e] = xo[e]; s3 += xo[e]; }
            if (layer == NLAYER - 1 && t < TL) *(f32x4*)(F.out() + (size_t)t * D + c) = xo; }
        if (layer < NLAYER - 1) {
#pragma unroll
            for (int q2 = 0; q2 < 4; ++q2) { u32x4 o4; o4.x = pk2(rr[8 * q2], rr[8 * q2 + 1]); o4.y = pk2(rr[8 * q2 + 2], rr[8 * q2 + 3]); o4.z = pk2(rr[8 * q2 + 4], rr[8 * q2 + 5]); o4.w = pk2(rr[8 * q2 + 6], rr[8 * q2 + 7]);
                *(u32x4*)(xr + 32 * lane + 8 * q2) = o4; }
            const float mean2 = wave_sum_u(s3) * (1.f / D);
            float s4 = 0.f;
#pragma unroll
            for (int i = 0; i < 32; ++i) { rr[i] -= mean2; s4 += rr[i] * rr[i]; }
            const float rstd2 = 1.f / sqrtf(wave_sum_u(s4) * (1.f / D) + LN_EPS);
            const float* np = F.MODS() + ((size_t)(layer + 1) * 3 + mr) * 12288;
#pragma unroll
            for (int q4 = 0; q4 < 2; ++q4) { u32x4 w;
#pragma unroll
                for (int q = 0; q < 4; ++q) { const int qq = 4 * q4 + q; const f32x4 sh = *(const LAS f32x4*)(vcache + (3 + mr) * 8192 + qq * 1024), sc = *(const LAS f32x4*)(vcache + (6 + mr) * 8192 + qq * 1024); const int ri = 4 * qq;
                    const float y0 = rr[ri] * rstd2 * (1.f + sc[0]) + sh[0], y1 = rr[ri + 1] * rstd2 * (1.f + sc[1]) + sh[1];
                    const float y2 = rr[ri + 2] * rstd2 * (1.f + sc[2]) + sh[2], y3 = rr[ri + 3] * rstd2 * (1.f + sc[3]) + sh[3];
                    int o = __builtin_amdgcn_cvt_pk_fp8_f32(y0, y1, 0, false); o = __builtin_amdgcn_cvt_pk_fp8_f32(y2, y3, o, true); w[q] = (unsigned)o; }
                *(u32x4*)(F.H8() + (size_t)t * D + 32 * lane + 16 * q4) = w; }
        }
        SUB_END(10);
        t = (int)__builtin_amdgcn_readfirstlane(tkn);
    }
#undef SUB_BEGIN
#undef SUB_END
}

__global__ void __launch_bounds__(NWAVES * 64, 2) skel_fwd(Args args) {
    extern __shared__ __attribute__((aligned(16))) unsigned char lds[];
    Frame F;
    F.lds = (LAS unsigned char*)lds;
    F.tid = threadIdx.x; F.lane = F.tid & 63; F.wave = __builtin_amdgcn_readfirstlane(F.tid >> 6);
    F.G = gridDim.x; F.gw = blockIdx.x * NWAVES + F.wave; F.NGW = F.G * NWAVES;
    unsigned char* ws = args.ws;
    F.ka = (const CAS unsigned char*)__builtin_amdgcn_kernarg_segment_ptr();
    for (int u = F.tid; u < (LDS_BYTES - LDSCTL_OFF) / 4; u += NWAVES * 64) ((LAS unsigned*)(F.lds + LDSCTL_OFF))[u] = 0u;
    __syncthreads();
    unsigned* ctl = (unsigned*)(ws + WS_CTL);
    const int lo = args.ph_lo, hi = args.ph_hi;
    XcdBarrier bar; bar.bar = ctl + CW_BAR + args.li * XCD_BAR_WORDS; bar.x = 0; bar.st = nullptr;
    if (hi - lo > 1) bar = xcd_barrier_post(ctl + CW_BAR + args.li * XCD_BAR_WORDS, (volatile LAS unsigned*)(F.lds + MISC_OFF) + 8);
#define IN(k) (lo <= (k) && (k) < hi)
    unsigned long long pr_acc = 0ull, pr_t0 = 0ull;
#define PR_BEGIN(ty) do { if (PROBE_PHASE == (ty)) pr_t0 = __builtin_amdgcn_s_memrealtime(); } while (0)
#define PR_END(ty) do { if (PROBE_PHASE == (ty)) pr_acc += __builtin_amdgcn_s_memrealtime() - pr_t0; } while (0)
#define BOTH(k) (IN(k) && IN((k) + 1))
#define SEAM(k) do { if (BOTH(k)) xcd_barrier(bar); } while (0)

    if (IN(0)) { PR_BEGIN(0); frame_ids(F); p0a_prologue(F); SEAM(0); PR_END(0); }
    if (IN(1)) {
        PR_BEGIN(1); frame_ids(F);
        { pg8::Gemm g{F.KBD(), F.WQR(), 32 * 256, 2048, 256}; pg8::BatchOrder S{F.G, (int)blockIdx.x}; pg8::EpiBf16 E{F.WEFFT(), D, 1.f};
          pg8::gemm_phase<pg8::EpiBf16, pg8::BatchOrder, false, true>(F.lds, g, S, E); }
        p0b_mod0(F);
        SEAM(1); PR_END(1);
    }
    for (int layer = 0; layer < NLAYER; ++layer) {
        const int pb = 2 + 6 * layer;
        const bool lastl = layer == NLAYER - 1;
        const int rows = lastl ? TL : TT;
        if (IN(pb + 0)) {
            PR_BEGIN(2); frame_ids(F);
            pg8::Gemm g{(const bf16_t*)F.H8(), (const bf16_t*)(F.WINT() + (size_t)layer * INC * D), TT, INC, D / 2}; pg8::StaticOrder S; S.init(TT, 2 * INC, F.G, (int)blockIdx.x);
            pg8::EpiBf16H E{F.PROJ(), INC, 1.f / WIN_SCALE};
            pg8::gemm_phase<pg8::EpiBf16H, pg8::StaticOrder, false, true, true, true>(F.lds, g, S, E);
            SEAM(pb + 0); PR_END(2);
        }
        if (IN(pb + 1)) {
            PR_BEGIN(3); frame_ids(F);
            const int nunits = lastl ? 512 : 528;
            {
                const int ch = F.tid & 255, vsel = F.tid >> 8;
                LAS unsigned char* dst = F.lds + CONV_LDS + ((2 * (ch >> 7) + (ch & 1)) * 64 + ((ch & 127) >> 1)) * 16;
                *(LAS f32x4*)(dst + vsel * 4096) = *(const f32x4*)(F.conv_w() + (size_t)layer * 3 * 1024 + vsel * 1024 + 4 * ch);
                *(LAS f32x4*)(dst + (2 + vsel) * 4096) = vsel == 0 ? *(const f32x4*)(F.conv_w() + (size_t)layer * 3 * 1024 + 2048 + 4 * ch) : *(const f32x4*)(F.g_conv() + layer * 1024 + 4 * ch);
            }
            for (int i = F.tid; i < 192 * 32 * 2 / 4; i += NWAVES * 64) *(LAS f32x4*)(F.lds + ROPE_LDS + i * 16) = *(const f32x4*)(F.ROPE() + 4 * i);
            __syncthreads();
            { unsigned long long q0 = 0; if (PROBE_PHASE == 11) q0 = __builtin_amdgcn_s_memrealtime();
            { const int bx = (int)blockIdx.x, vcu = (F.G % 8 == 0) ? (bx % 8) * (F.G / 8) + bx / 8 : bx;
              for (int u = vcu; u < nunits; u += F.G) attn_unit(F, layer, u); }
            if (PROBE_PHASE == 11) pr_acc += __builtin_amdgcn_s_memrealtime() - q0; if (PROBE_PHASE == 12) q0 = __builtin_amdgcn_s_memrealtime();
            {
              const int nx = nunits - 2 * F.G; const bool uneven = nx > 0 && nx < F.G;
              const int bx2 = (int)blockIdx.x, vc2 = (F.G % 8 == 0) ? (bx2 % 8) * (F.G / 8) + bx2 / 8 : bx2;
              const int c0 = uneven ? vc2 - nx : vc2, nb = uneven ? F.G - nx : F.G;
              if (c0 >= 0) for (int t = c0 * NWAVES + F.wave; t < rows; t += nb * NWAVES) conv_row(F, layer, t); }
            if (PROBE_PHASE == 12) pr_acc += __builtin_amdgcn_s_memrealtime() - q0; }
            SEAM(pb + 1); PR_END(3);
        }
        if (IN(pb + 2)) {
            PR_BEGIN(4); frame_ids(F);
            pg8::Gemm g{(const bf16_t*)F.MIX(), (const bf16_t*)(F.WOUTT() + (size_t)layer * D * D), rows, D, D / 2}; pg8::StaticOrder S; S.init(rows, 2 * D, F.G, (int)blockIdx.x);
            pg8::EpiBf16H E{F.PROJ(), D, 1.f / WOUT_SCALE};
            pg8::gemm_phase<pg8::EpiBf16H, pg8::StaticOrder, false, true, true, true>(F.lds, g, S, E);
            frame_ids(F); convert_in_tail(F, layer, (rows / 256) * (D / 128), 0);
            SEAM(pb + 2); PR_END(4);
        }
        if (IN(pb + 3)) { PR_BEGIN(5); frame_ids(F); ln_phase(F, layer, rows); SEAM(pb + 3); PR_END(5); }
        if (IN(pb + 4)) {
            PR_BEGIN(6); frame_ids(F);
            pg8::Gemm g{F.H(), F.WEFFT() + (size_t)layer * D * D, rows, D, D}; pg8::StaticOrder S; S.init(rows, D, F.G, (int)blockIdx.x);
            pg8::EpiBf16 E{F.SC(), D, 1.f};
            pg8::gemm_phase<pg8::EpiBf16, pg8::StaticOrder, true, true>(F.lds, g, S, E);
            frame_ids(F); convert_in_tail(F, layer, (rows / 256) * (D / 256), 1);
            SEAM(pb + 4); PR_END(6);
        }
        if (IN(pb + 5)) { PR_BEGIN(7); frame_ids(F); peer_phase(F, layer, rows, ctl, pr_acc); SEAM(pb + 5); PR_END(7); }
    }
    if (PROBE_PHASE >= 0 && hi - lo > 1) xcd_barrier(bar);
    if (PROBE_PHASE >= 0 && blockIdx.x == 0 && threadIdx.x == 0) { const unsigned long long t1 = __builtin_amdgcn_s_memrealtime() + (unsigned long long)PROBE_MULT * pr_acc; while (__builtin_amdgcn_s_memrealtime() < t1) __builtin_amdgcn_s_sleep(8); }
#undef IN
#undef BOTH
#undef SEAM
}

extern "C" void kernel_launch(void* const* d_in, const int* in_sizes, int n_in, void* d_out, int out_size, void* d_ws, size_t ws_size, hipStream_t stream) {
    static int grid = 0;
    if (grid == 0) {
        if (n_in != 20 || in_sizes[0] != TL * D || out_size != TL * D || ws_size < WS_END) {
            fprintf(stderr, "kernel_launch: unexpected problem shape (n_in %d, in0 %d, out %d, ws %zu, need %zu)\n", n_in, n_in > 0 ? in_sizes[0] : -1, out_size, ws_size, (size_t)WS_END); grid = -1; return; }
        int dev = 0, cus = 0, per_cu = 0;
        if (hipGetDevice(&dev) != hipSuccess || hipDeviceGetAttribute(&cus, hipDeviceAttributeMultiprocessorCount, dev) != hipSuccess) { grid = -1; return; }
        if (hipFuncSetAttribute((const void*)skel_fwd, hipFuncAttributeMaxDynamicSharedMemorySize, LDS_BYTES) != hipSuccess) { fprintf(stderr, "kernel_launch: hipFuncSetAttribute failed\n"); grid = -1; return; }
        if (hipOccupancyMaxActiveBlocksPerMultiprocessor(&per_cu, (const void*)skel_fwd, NWAVES * 64, LDS_BYTES) != hipSuccess || per_cu < 1)
            fprintf(stderr, "kernel_launch: occupancy query reports %d workgroups per CU\n", per_cu);
        (void)hipGetLastError();
        grid = cus;
    }
    if (grid < 0) return;
    if (hipMemsetAsync((char*)d_ws + WS_CTL, 0, CTL_ZERO_BYTES, stream) != hipSuccess) return;
    Args a{};
    for (int i = 0; i < 20; ++i) a.in[i] = (const float*)d_in[i];
    a.out = (float*)d_out; a.ws = (unsigned char*)d_ws; a.pad = 0;
#if MK_N_LAUNCHES == 1
    a.ph_lo = 0; a.ph_hi = NPHASE; a.li = 0;
    hipLaunchKernelGGL(skel_fwd, dim3(grid), dim3(NWAVES * 64), LDS_BYTES, stream, a);
#else
    for (int ph = 0; ph < NPHASE; ++ph) { a.ph_lo = ph; a.ph_hi = ph + 1; a.li = 0;
        hipLaunchKernelGGL(skel_fwd, dim3(grid), dim3(NWAVES * 64), LDS_BYTES, stream, a); }
#endif
}
```

```cpp
#include <hip/hip_runtime.h>
#include <cstdio>
#include <cstdint>

#ifndef MK_N_LAUNCHES
#define MK_N_LAUNCHES 1
#endif

#define LAS __attribute__((address_space(3)))
typedef unsigned short bf16_t;
typedef short bf16x8 __attribute__((ext_vector_type(8)));
typedef short s16x4 __attribute__((ext_vector_type(4)));
typedef float f32x2 __attribute__((ext_vector_type(2)));
typedef float f32x4 __attribute__((ext_vector_type(4)));
typedef float f32x16 __attribute__((ext_vector_type(16)));
typedef unsigned u32x2 __attribute__((ext_vector_type(2)));
typedef unsigned u32x4 __attribute__((ext_vector_type(4)));
typedef __bf16 bf16x2_t __attribute__((ext_vector_type(2)));
typedef int i32x8 __attribute__((ext_vector_type(8)));

constexpr int D = 2048, NB = 2, SEQ = 8192, CTXL = 256, NLAYER = 4;
constexpr int TL = NB * SEQ, TC = NB * CTXL, TT = TL + TC;
constexpr int INC = 4608, OFF_C = 1024, OFF_X = 2048, OFF_Q = 3072, OFF_K = 4096, OFF_V = 4352;
constexpr float WOUT_SCALE = 128.f;
constexpr float WIN_SCALE = 64.f;
constexpr int NEXP = 16384;
#ifndef U_FMT
#define U_FMT 4
#endif
#ifndef V_FMT
#define V_FMT 4
#endif
constexpr int UROW = D * U_FMT / 8, VROW = D * V_FMT / 8;
constexpr float LN_EPS = 1e-6f;
constexpr float DN_ALPHA = 1.681792830507429f;
constexpr float QSCALE = 0.08838834764831845f * 1.4426950408889634f;
constexpr float LOG2E = 1.4426950408889634f;

constexpr size_t MiB = 1u << 20;
constexpr size_t WS_CTL = 0, CTL_ZERO_BYTES = 2 * MiB;
constexpr size_t WS_MODS = 1 * MiB;
constexpr size_t WS_ROPE = 2 * MiB;
constexpr size_t WS_KBD = 3 * MiB;
constexpr size_t WS_WQR = 8 * MiB;
constexpr size_t WS_WINT = 40 * MiB;
constexpr size_t WS_WOUTT = 112 * MiB;
constexpr size_t WS_WEFFT = 144 * MiB;
constexpr size_t WS_X = 176 * MiB;
constexpr size_t WS_H = 308 * MiB;
constexpr size_t WS_PROJ = 374 * MiB;
constexpr size_t WS_MIX = 523 * MiB;
constexpr size_t WS_SC = 589 * MiB;
constexpr size_t WS_UT = 721 * MiB;
constexpr size_t WS_VT = 849 * MiB;
constexpr size_t WS_US = 977 * MiB;
constexpr size_t WS_VS = 978 * MiB;
constexpr size_t WS_H8 = 979 * MiB;
constexpr size_t WS_END = 1013 * MiB;

constexpr int CW_BAR = 4096;

namespace pg8 {
constexpr int BM = 256, BK = 64, HALF = 128, HTB = HALF * BK * 2, STAGE_BYTES = 8 * HTB, NXCD = 8, WGM = 8;
__host__ __device__ __forceinline__ int lds_byte(int r, int c) { const int st = (r >> 4) * 2 + (c >> 5), rr = r & 15, cc = c & 31, ob = rr * 64 + cc * 2; return st * 1024 + (ob ^ (((ob >> 9) & 1) << 5)); }
__host__ __device__ __forceinline__ void stage_rc(int b, int& R, int& C) { const int st = b / 1024, sb = b % 1024, swz = sb ^ (((sb >> 9) & 1) << 5); R = (st >> 1) * 16 + swz / 64; C = (st & 1) * 32 + (swz % 64) / 2; }
__host__ __device__ __forceinline__ int lds_byte8(int r, int c) { const int st = (r >> 4) * 2 + (c >> 2); return st * 1024 + (((r & 15) * 64 + (c & 3) * 16) ^ (((r >> 3) & 1) << 4)); }
__host__ __device__ __forceinline__ void stage_rc8(int b, int& R, int& C) { const int st = b / 1024, sb = b % 1024, rr = sb / 64, cj = ((sb % 64) / 16) ^ ((rr >> 3) & 1); R = (st >> 1) * 16 + rr; C = ((st & 1) * 4 + cj) * 8; }
__host__ __device__ __forceinline__ int perm32(int rho) { const int n = rho >> 4, i = rho & 15; return 8 * (i >> 2) + 4 * n + (i & 3); }

struct Unit { int pm, pn; };
struct Gemm { const bf16_t* A; const bf16_t* Bt; int M, N, K; };

struct StaticOrder {
    int nM, nN, nwg, G, c;
    __host__ __device__ void init(int M, int N, int G_, int c_) { nM = M / BM; nN = N / BM; nwg = nM * nN; G = G_; c = c_; }
    __host__ __device__ bool next(int i, Unit& u) const {
        const long L = (long)i * G + c; if (L >= nwg) return false;
        int wgid = (int)L; { const int q = nwg / NXCD, r = nwg % NXCD, xcd = wgid % NXCD, off = wgid / NXCD; wgid = (xcd < r ? xcd * (q + 1) : r * (q + 1) + (xcd - r) * q) + off; }
        const int nig = WGM * nN, gid = wgid / nig, fm = gid * WGM, gsz = (nM - fm) < WGM ? (nM - fm) : WGM;
        u.pm = fm + ((wgid % nig) % gsz); u.pn = (wgid % nig) / gsz; return true;
    }
    __device__ __forceinline__ int btile(const Unit& u) const { return u.pn; }
    __device__ __forceinline__ void a_ready(const Unit&) const {}
    __device__ __forceinline__ void done(const Unit&) const {}
};
struct BatchOrder {
    int G, c;
    __device__ bool next(int i, Unit& u) const { const int L = i * G + c; if (L >= 256) return false; u.pm = L >> 3; u.pn = L & 7; return true; }
    __device__ __forceinline__ int btile(const Unit& u) const { return u.pm * 8 + u.pn; }
    __device__ __forceinline__ void a_ready(const Unit&) const {}
    __device__ __forceinline__ void done(const Unit&) const {}
};

__device__ __forceinline__ unsigned cvt_pk_bf16(float lo, float hi) { f32x2 x = {lo, hi}; bf16x2_t y = __builtin_convertvector(x, bf16x2_t); return __builtin_bit_cast(unsigned, y); }

struct EpiBf16 {
    static constexpr bool PERM = true;
    bf16_t* O; int ldc; float scale;
    __device__ __forceinline__ void operator()(const f32x4 (&acc)[2][2][4][2], const Unit& u, int wr, int wc, int fr, int fq) const {
        const int row0 = u.pm * BM + wr * 64 + fr, col0 = u.pn * BM + wc * 32 + 8 * fq;
#pragma unroll
        for (int ai = 0; ai < 2; ++ai)
#pragma unroll
            for (int m = 0; m < 4; ++m) { bf16_t* rowp = O + (size_t)(row0 + ai * HALF + m * 16) * ldc + col0;
#pragma unroll
                for (int bj = 0; bj < 2; ++bj) { const f32x4 v0 = acc[ai][bj][m][0] * scale, v1 = acc[ai][bj][m][1] * scale;
                    u32x4 w; w.x = cvt_pk_bf16(v0[0], v0[1]); w.y = cvt_pk_bf16(v0[2], v0[3]); w.z = cvt_pk_bf16(v1[0], v1[1]); w.w = cvt_pk_bf16(v1[2], v1[3]);
                    *(u32x4*)(rowp + bj * HALF) = w; } }
    }
};
struct EpiBf16H {
    static constexpr bool PERM = true;
    bf16_t* O; int ldc; float scale;
    __device__ __forceinline__ void operator()(const f32x4 (&acc)[2][2][4][2], const Unit& u, int wr, int wc, int fr, int fq) const {
        const int row0 = u.pm * BM + wr * 64 + fr, col0 = u.pn * HALF + wc * 32 + 8 * fq;
#pragma unroll
        for (int ai = 0; ai < 2; ++ai)
#pragma unroll
            for (int m = 0; m < 4; ++m) { const f32x4 v0 = acc[ai][0][m][0] * scale, v1 = acc[ai][0][m][1] * scale;
                u32x4 w; w.x = cvt_pk_bf16(v0[0], v0[1]); w.y = cvt_pk_bf16(v0[2], v0[3]); w.z = cvt_pk_bf16(v1[0], v1[1]); w.w = cvt_pk_bf16(v1[2], v1[3]);
                *(u32x4*)(O + (size_t)(row0 + ai * HALF + m * 16) * ldc + col0) = w; }
    }
};
struct EpiF32 {
    static constexpr bool PERM = false;
    float* C; int ldc;
    __device__ __forceinline__ void operator()(const f32x4 (&acc)[2][2][4][2], const Unit& u, int wr, int wc, int fr, int fq) const {
        const int row0 = u.pm * BM + wr * 64 + fr, col0 = u.pn * BM + wc * 32 + 4 * fq;
#pragma unroll
        for (int ai = 0; ai < 2; ++ai)
#pragma unroll
            for (int m = 0; m < 4; ++m) { float* rowp = C + (size_t)(row0 + ai * HALF + m * 16) * ldc + col0;
#pragma unroll
                for (int bj = 0; bj < 2; ++bj)
#pragma unroll
                    for (int n = 0; n < 2; ++n) *(f32x4*)(rowp + bj * HALF + n * 16) = acc[ai][bj][m][n]; }
    }
};
struct EpiResid {
    static constexpr bool PERM = true;
    const float* x32_lat; const float* x32_ctx;
    bf16_t* X; const float* gate;
    __device__ __forceinline__ void operator()(const f32x4 (&acc)[2][2][4][2], const Unit& u, int wr, int wc, int fr, int fq) const {
        const int rt = u.pm * BM;
        const int mr = rt < TL ? rt / SEQ : 2;
        const int row0 = rt + wr * 64 + fr, col0 = u.pn * BM + wc * 32 + 8 * fq;
        f32x4 gv[2][2];
#pragma unroll
        for (int bj = 0; bj < 2; ++bj)
#pragma unroll
            for (int n = 0; n < 2; ++n) gv[bj][n] = *(const f32x4*)(gate + (size_t)mr * 12288 + col0 + bj * HALF + 4 * n);
#pragma unroll
        for (int ai = 0; ai < 2; ++ai)
#pragma unroll
            for (int m = 0; m < 4; ++m) { const int row = row0 + ai * HALF + m * 16;
#pragma unroll
                for (int bj = 0; bj < 2; ++bj) {
                    f32x4 x0, x1;
                    if (x32_lat) { const float* xp = (row < TL ? x32_lat + (size_t)row * D : x32_ctx + (size_t)(row - TL) * D) + col0 + bj * HALF; x0 = *(const f32x4*)xp; x1 = *(const f32x4*)(xp + 4); }
                    else { const u32x4 w = *(const u32x4*)(X + (size_t)row * D + col0 + bj * HALF);
                        x0 = (f32x4){__uint_as_float(w.x << 16), __uint_as_float(w.x & 0xffff0000u), __uint_as_float(w.y << 16), __uint_as_float(w.y & 0xffff0000u)};
                        x1 = (f32x4){__uint_as_float(w.z << 16), __uint_as_float(w.z & 0xffff0000u), __uint_as_float(w.w << 16), __uint_as_float(w.w & 0xffff0000u)}; }
                    const f32x4 r0 = x0 * DN_ALPHA + gv[bj][0] * acc[ai][bj][m][0], r1 = x1 * DN_ALPHA + gv[bj][1] * acc[ai][bj][m][1];
                    u32x4 o; o.x = cvt_pk_bf16(r0[0], r0[1]); o.y = cvt_pk_bf16(r0[2], r0[3]); o.z = cvt_pk_bf16(r1[0], r1[1]); o.w = cvt_pk_bf16(r1[2], r1[3]);
                    *(u32x4*)(X + (size_t)row * D + col0 + bj * HALF) = o; } }
    }
};

template <class Epi, class Sched, bool ALIGN_EPI = false, bool SP2 = false, bool FP8 = false, bool HN = false>
__device__ __forceinline__ void gemm_phase(LAS unsigned char* lds, const Gemm g, const Sched& S, const Epi& E) {
    int tid = threadIdx.x; asm volatile("" : "+v"(tid));
    const int wid = __builtin_amdgcn_readfirstlane(tid >> 6), lane = tid & 63, wr = wid >> 2, wc = wid & 3, fr = lane & 15, fq = lane >> 4;
    const int K = g.K, nt = K / BK;
    unsigned voffA[2], voffB[2];
#pragma unroll
    for (int i = 0; i < 2; ++i) { int R, C; if constexpr (FP8) stage_rc8(tid * 16 + i * 8192, R, C); else stage_rc(tid * 16 + i * 8192, R, C); const int Rb = Epi::PERM ? ((R & ~31) + perm32(R & 31)) : R;
        voffA[i] = (unsigned)(R * K + C) * 2u; voffB[i] = (unsigned)(Rb * K + C) * 2u; }
    const size_t kstep = (size_t)(BK * 2);
    const size_t hstep = (size_t)HALF * K * 2;
    const size_t tstep = 2 * hstep;
    const unsigned ldsw = (unsigned)wid * 1024u;
    const int aoff = lds_byte(wr * 64 + fr, fq * 8), boff = lds_byte(wc * 32 + fr, fq * 8);
    const int aoff8a = lds_byte8(wr * 64 + fr, 2 * fq), boff8a = lds_byte8(wc * 32 + fr, 2 * fq), aoff8b = aoff8a ^ 16, boff8b = boff8a ^ 16;
#define PG8_SA(b, h) (((b) * 2 + (h)) * HTB)
#define PG8_SB(b, h) ((4 + (b) * 2 + (h)) * HTB)
#define PG8_STAGE(bufoff, gbase, voff) do { _Pragma("unroll") for (int _i = 0; _i < 2; ++_i) \
        __builtin_amdgcn_global_load_lds((const unsigned*)((const char*)(gbase) + (voff)[_i]), (LAS unsigned*)(lds + (bufoff) + ldsw + _i * 8192), 16, 0, 0); } while (0)
#define PG8_LDA(dst, b, h) do { if constexpr (FP8) { _Pragma("unroll") for (int m = 0; m < 4; ++m) { const u32x4 _x = *(const LAS u32x4*)(lds + PG8_SA(b, h) + aoff8a + m * 2048), _y = *(const LAS u32x4*)(lds + PG8_SA(b, h) + aoff8b + m * 2048); \
            dst##8[m] = (i32x8){(int)_x.x, (int)_x.y, (int)_x.z, (int)_x.w, (int)_y.x, (int)_y.y, (int)_y.z, (int)_y.w}; } } \
        else { _Pragma("unroll") for (int m = 0; m < 4; ++m) _Pragma("unroll") for (int k = 0; k < 2; ++k) dst[m][k] = *(const LAS bf16x8*)(lds + PG8_SA(b, h) + aoff + m * 2048 + k * 1024); } } while (0)
#define PG8_LDB(dst, b, h) do { if constexpr (FP8) { _Pragma("unroll") for (int n = 0; n < 2; ++n) { const u32x4 _x = *(const LAS u32x4*)(lds + PG8_SB(b, h) + boff8a + n * 2048), _y = *(const LAS u32x4*)(lds + PG8_SB(b, h) + boff8b + n * 2048); \
            dst##8[n] = (i32x8){(int)_x.x, (int)_x.y, (int)_x.z, (int)_x.w, (int)_y.x, (int)_y.y, (int)_y.z, (int)_y.w}; } } \
        else { _Pragma("unroll") for (int n = 0; n < 2; ++n) _Pragma("unroll") for (int k = 0; k < 2; ++k) dst[n][k] = *(const LAS bf16x8*)(lds + PG8_SB(b, h) + boff + n * 2048 + k * 1024); } } while (0)
#define PG8_MMA(ai, bj, At, Bt) do { __builtin_amdgcn_s_setprio(1); if constexpr (FP8) { _Pragma("unroll") for (int m = 0; m < 4; ++m) _Pragma("unroll") for (int n = 0; n < 2; ++n) \
            acc[ai][bj][m][n] = __builtin_amdgcn_mfma_scale_f32_16x16x128_f8f6f4(Bt##8[n], At##8[m], acc[ai][bj][m][n], 0, 0, 0, 0x7F7F7F7F, 0, 0x7F7F7F7F); } \
        else { _Pragma("unroll") for (int m = 0; m < 4; ++m) _Pragma("unroll") for (int n = 0; n < 2; ++n) _Pragma("unroll") for (int k = 0; k < 2; ++k) \
            acc[ai][bj][m][n] = __builtin_amdgcn_mfma_f32_16x16x32_bf16(Bt[n][k], At[m][k], acc[ai][bj][m][n], 0, 0, 0); } __builtin_amdgcn_s_setprio(0); } while (0)
#define PG8_WAIT_V(n) asm volatile("s_waitcnt vmcnt(" #n ")" ::: "memory")
#define PG8_WAIT_L(n) asm volatile("s_waitcnt lgkmcnt(" #n ")" ::: "memory")
#define PG8_BAR __builtin_amdgcn_s_barrier()
#define PG8_SCHED __builtin_amdgcn_sched_barrier(0)
    Unit cur, nxt; int ui = 0;
    if (!S.next(0, cur)) return;
    f32x4 acc[2][2][4][2];
#pragma unroll
    for (int a = 0; a < 2; ++a)
#pragma unroll
        for (int b = 0; b < 2; ++b)
#pragma unroll
            for (int m = 0; m < 4; ++m)
#pragma unroll
                for (int n = 0; n < 2; ++n) acc[a][b][m][n] = (f32x4){0.f, 0.f, 0.f, 0.f};
    bf16x8 At[4][2], B0[2][2], B1[2][2];
    i32x8 At8[4], B08[2], B18[2];
    const size_t bstep = HN ? hstep : tstep;
    const char* cA = (const char*)g.A + (size_t)cur.pm * tstep; const char* cB = (const char*)g.Bt + (size_t)S.btile(cur) * bstep;
    S.a_ready(cur);
    if constexpr (HN) {
        static_assert(!HN || SP2, "HN needs the SP2 loop");
        PG8_STAGE(PG8_SB(0, 0), cB, voffB); PG8_STAGE(PG8_SA(0, 0), cA, voffA); PG8_STAGE(PG8_SA(0, 1), cA + hstep, voffA);
        if (wr == 1) PG8_BAR;
        PG8_WAIT_V(2); PG8_BAR;
        PG8_STAGE(PG8_SB(1, 0), cB + kstep, voffB); PG8_STAGE(PG8_SA(1, 0), cA + kstep, voffA);
        PG8_WAIT_V(4); PG8_BAR;
    } else if constexpr (SP2) {
        PG8_STAGE(PG8_SB(0, 0), cB, voffB); PG8_STAGE(PG8_SB(0, 1), cB + hstep, voffB); PG8_STAGE(PG8_SA(0, 0), cA, voffA); PG8_STAGE(PG8_SA(0, 1), cA + hstep, voffA);
        if (wr == 1) PG8_BAR;
        PG8_WAIT_V(2); PG8_BAR;
        PG8_STAGE(PG8_SB(1, 0), cB + kstep, voffB); PG8_STAGE(PG8_SA(1, 0), cA + kstep, voffA); PG8_STAGE(PG8_SB(1, 1), cB + hstep + kstep, voffB);
        PG8_WAIT_V(6); PG8_BAR;
    } else {
        PG8_STAGE(PG8_SB(0, 0), cB, voffB); PG8_STAGE(PG8_SA(0, 0), cA, voffA); PG8_STAGE(PG8_SB(0, 1), cB + hstep, voffB); PG8_STAGE(PG8_SA(0, 1), cA + hstep, voffA);
        if (wr == 1) PG8_BAR;
        PG8_WAIT_V(4); PG8_BAR;
        PG8_STAGE(PG8_SB(1, 0), cB + kstep, voffB); PG8_STAGE(PG8_SA(1, 0), cA + kstep, voffA); PG8_STAGE(PG8_SB(1, 1), cB + hstep + kstep, voffB);
        PG8_WAIT_V(6); PG8_BAR;
    }
    for (;;) {
        const bool has_next = S.next(ui + 1, nxt);
        const char* nA = has_next ? (const char*)g.A + (size_t)nxt.pm * tstep : cA; const char* nB = has_next ? (const char*)g.Bt + (size_t)S.btile(nxt) * bstep : cB;
        for (int t = 0; t < nt; t += 2) {
            const bool last = (t == nt - 2);
            const char* a1 = cA + (size_t)(t + 1) * kstep;
            const char* a2 = last ? nA : cA + (size_t)(t + 2) * kstep; const char* b2 = last ? nB : cB + (size_t)(t + 2) * kstep;
            const char* a3 = a2 + kstep; const char* b3 = b2 + kstep;
            if (last && has_next) S.a_ready(nxt);
            if constexpr (HN) {
            PG8_LDB(B0, 0, 0); PG8_SCHED; PG8_LDA(At, 0, 0); PG8_STAGE(PG8_SA(1, 1), a1 + hstep, voffA);
            PG8_WAIT_V(6); PG8_WAIT_L(0); PG8_BAR; PG8_MMA(0, 0, At, B0); PG8_BAR; PG8_SCHED;
            PG8_LDA(At, 0, 1); PG8_STAGE(PG8_SB(0, 0), b2, voffB); PG8_STAGE(PG8_SA(0, 0), a2, voffA);
            PG8_WAIT_V(6); PG8_WAIT_L(0); PG8_BAR; PG8_MMA(1, 0, At, B0); PG8_BAR; PG8_SCHED;
            PG8_LDB(B0, 1, 0); PG8_SCHED; PG8_LDA(At, 1, 0); PG8_STAGE(PG8_SA(0, 1), a2 + hstep, voffA);
            PG8_WAIT_V(6); PG8_WAIT_L(0); PG8_BAR; PG8_MMA(0, 0, At, B0); PG8_BAR; PG8_SCHED;
            PG8_LDA(At, 1, 1); PG8_STAGE(PG8_SB(1, 0), b3, voffB); PG8_STAGE(PG8_SA(1, 0), a3, voffA);
            PG8_WAIT_V(6); PG8_WAIT_L(0); PG8_BAR; PG8_MMA(1, 0, At, B0); PG8_BAR; PG8_SCHED;
            } else if constexpr (SP2) {
            PG8_LDB(B0, 0, 0); PG8_LDB(B1, 0, 1); PG8_SCHED; PG8_LDA(At, 0, 0); PG8_STAGE(PG8_SA(1, 1), a1 + hstep, voffA);
            PG8_WAIT_V(8); PG8_WAIT_L(0); PG8_BAR; PG8_MMA(0, 0, At, B0); PG8_MMA(0, 1, At, B1); PG8_BAR; PG8_SCHED;
            PG8_LDA(At, 0, 1); PG8_STAGE(PG8_SB(0, 0), b2, voffB); PG8_STAGE(PG8_SB(0, 1), b2 + hstep, voffB); PG8_STAGE(PG8_SA(0, 0), a2, voffA);
            PG8_WAIT_V(8); PG8_WAIT_L(0); PG8_BAR; PG8_MMA(1, 0, At, B0); PG8_MMA(1, 1, At, B1); PG8_BAR; PG8_SCHED;
            PG8_LDB(B0, 1, 0); PG8_LDB(B1, 1, 1); PG8_SCHED; PG8_LDA(At, 1, 0); PG8_STAGE(PG8_SA(0, 1), a2 + hstep, voffA);
            PG8_WAIT_V(8); PG8_WAIT_L(0); PG8_BAR; PG8_MMA(0, 0, At, B0); PG8_MMA(0, 1, At, B1); PG8_BAR; PG8_SCHED;
            PG8_LDA(At, 1, 1); PG8_STAGE(PG8_SB(1, 0), b3, voffB); PG8_STAGE(PG8_SB(1, 1), b3 + hstep, voffB); PG8_STAGE(PG8_SA(1, 0), a3, voffA);
            PG8_WAIT_V(8); PG8_WAIT_L(0); PG8_BAR; PG8_MMA(1, 0, At, B0); PG8_MMA(1, 1, At, B1); PG8_BAR; PG8_SCHED;
            } else {
            PG8_LDB(B0, 0, 0); PG8_SCHED; PG8_LDA(At, 0, 0); PG8_STAGE(PG8_SA(1, 1), a1 + hstep, voffA);
            PG8_WAIT_L(8); PG8_BAR; PG8_WAIT_L(0); PG8_MMA(0, 0, At, B0); PG8_BAR; PG8_SCHED;
            PG8_LDB(B1, 0, 1); PG8_STAGE(PG8_SB(0, 0), b2, voffB);
            PG8_BAR; PG8_WAIT_L(0); PG8_MMA(0, 1, At, B1); PG8_BAR;
            PG8_LDA(At, 0, 1); PG8_STAGE(PG8_SA(0, 0), a2, voffA);
            PG8_BAR; PG8_WAIT_L(0); PG8_MMA(1, 0, At, B0); PG8_BAR; PG8_SCHED;
            PG8_STAGE(PG8_SB(0, 1), b2 + hstep, voffB);
            PG8_WAIT_V(6); PG8_BAR; PG8_MMA(1, 1, At, B1); PG8_BAR;
            PG8_LDB(B0, 1, 0); PG8_SCHED; PG8_LDA(At, 1, 0); PG8_STAGE(PG8_SA(0, 1), a2 + hstep, voffA);
            PG8_WAIT_L(8); PG8_BAR; PG8_WAIT_L(0); PG8_MMA(0, 0, At, B0); PG8_BAR; PG8_SCHED;
            PG8_LDB(B1, 1, 1); PG8_STAGE(PG8_SB(1, 0), b3, voffB);
            PG8_BAR; PG8_WAIT_L(0); PG8_MMA(0, 1, At, B1); PG8_BAR;
            PG8_LDA(At, 1, 1); PG8_STAGE(PG8_SA(1, 0), a3, voffA);
            PG8_BAR; PG8_WAIT_L(0); PG8_MMA(1, 0, At, B0); PG8_BAR; PG8_SCHED;
            PG8_STAGE(PG8_SB(1, 1), b3 + hstep, voffB);
            PG8_WAIT_V(6); PG8_BAR; PG8_MMA(1, 1, At, B1); PG8_BAR;
            }
        }
        if constexpr (ALIGN_EPI) { if (wr == 0) PG8_BAR; }
        E(acc, cur, wr, wc, fr, fq); S.done(cur);
        if (!has_next) break;
#pragma unroll
        for (int a = 0; a < 2; ++a)
#pragma unroll
            for (int b = 0; b < 2; ++b)
#pragma unroll
                for (int m = 0; m < 4; ++m)
#pragma unroll
                    for (int n = 0; n < 2; ++n) acc[a][b][m][n] = (f32x4){0.f, 0.f, 0.f, 0.f};
        cur = nxt; cA = nA; cB = nB; ++ui;
        if constexpr (ALIGN_EPI) { if (wr == 1) PG8_BAR; }
    }
    PG8_WAIT_V(0);
    if constexpr (!ALIGN_EPI) { if (wr == 0) PG8_BAR; }
    PG8_BAR;
#undef PG8_SA
#undef PG8_SB
#undef PG8_STAGE
#undef PG8_LDA
#undef PG8_LDB
#undef PG8_MMA
#undef PG8_WAIT_V
#undef PG8_WAIT_L
#undef PG8_BAR
#undef PG8_SCHED
}
}

#define XB_TMO      128
#define XB_XCNT(j)  (256  + 64 * (j))
#define XB_XSUB(j)  (1280 + 64 * (j))
#define XB_XGEN(j)  (2304 + 64 * (j))
#define XB_TOP      3328
#define XB_TOPGEN   3392
#define XCD_BAR_WORDS 3456
#define XB_SPIN_CAP (1u << 18)

__device__ __forceinline__ unsigned xb_ld(unsigned* p)              { return __hip_atomic_load(p, __ATOMIC_RELAXED, __HIP_MEMORY_SCOPE_AGENT); }
__device__ __forceinline__ unsigned xb_add(unsigned* p, unsigned v) { return __hip_atomic_fetch_add(p, v, __ATOMIC_RELAXED, __HIP_MEMORY_SCOPE_AGENT); }
__device__ __forceinline__ unsigned xb_xcc_id() { return (unsigned)__builtin_amdgcn_s_getreg((3 << 11) | 20) & 0xFu; }
#define XB_SPIN(cond, bar) do { unsigned _sp = 0; while (cond) { __builtin_amdgcn_s_sleep(1); \
    if ((++_sp & 255u) == 0u) { if (xb_ld(&(bar)[XB_TMO])) break; if (_sp > XB_SPIN_CAP) { atomicAdd(&(bar)[XB_TMO], 1u); break; } } } } while (0)

struct XcdBarrier { unsigned* bar; unsigned x; volatile LAS unsigned* st; };

__device__ __forceinline__ XcdBarrier xcd_barrier_post(unsigned* bar, volatile LAS unsigned* st) {
    XcdBarrier b; b.bar = bar; b.x = xb_xcc_id(); b.st = st;
    if (threadIdx.x == 0) (void)xb_add(&bar[XB_XCNT(b.x)], 1u);
    return b;
}
__device__ __forceinline__ void xcd_barrier_complete(unsigned* bar, unsigned x, unsigned& nloc, unsigned& nx) {
    const unsigned G = gridDim.x * gridDim.y * gridDim.z;
    unsigned sum, cnt, mine, sp = 0u;
    for (;;) {
        sum = 0u; cnt = 0u; mine = 0u;
#pragma unroll
        for (unsigned j = 0; j < 16; ++j) { const unsigned c = xb_ld(&bar[XB_XCNT(j)]); sum += c; cnt += (c > 0u) ? 1u : 0u; mine = (j == x) ? c : mine; }
        if (sum == G) break;
        __builtin_amdgcn_s_sleep(1);
        if ((++sp & 255u) == 0u) { if (xb_ld(&bar[XB_TMO])) break; if (sp > XB_SPIN_CAP) { atomicAdd(&bar[XB_TMO], 1u); break; } }
    }
    nloc = mine > 0u ? mine : 1u; nx = cnt > 0u ? cnt : 1u;
}
__device__ __forceinline__ void xcd_barrier(const XcdBarrier& b) {
    asm volatile("s_waitcnt vmcnt(0)" ::: "memory");
    __syncthreads();
    if (threadIdx.x == 0) {
        unsigned* bar = b.bar;
        __builtin_amdgcn_s_waitcnt(0);
        unsigned nloc = b.st[0], nx = b.st[1];
        if (nloc == 0u) { xcd_barrier_complete(bar, b.x, nloc, nx); b.st[0] = nloc; b.st[1] = nx; }
        const unsigned old = xb_add(&bar[XB_XSUB(b.x)], 1u);
        const unsigned gen = old / nloc;
        if (old + 1u == (gen + 1u) * nloc) {
            __builtin_amdgcn_fence(__ATOMIC_RELEASE, "agent");
            asm volatile("s_waitcnt vmcnt(0)" ::: "memory");
            const unsigned og = xb_add(&bar[XB_TOP], 1u);
            const unsigned tg = og / nx;
            if (og + 1u == (tg + 1u) * nx) xb_add(&bar[XB_TOPGEN], 1u);
            else XB_SPIN(xb_ld(&bar[XB_TOPGEN]) == tg, bar);
            __builtin_amdgcn_fence(__ATOMIC_ACQUIRE, "agent");
            xb_add(&bar[XB_XGEN(b.x)], 1u);
            asm volatile("s_waitcnt vmcnt(0)" ::: "memory");
        } else {
            XB_SPIN(xb_ld(&bar[XB_XGEN(b.x)]) == gen, bar);
            __builtin_amdgcn_fence(__ATOMIC_ACQUIRE, "agent");
            asm volatile("s_waitcnt vmcnt(0)" ::: "memory");
        }
    }
    __syncthreads();
}

constexpr int NWAVES = 8;
constexpr int LDS_BYTES = 163840;
constexpr int LDSCTL_OFF = LDS_BYTES - 512, MISC_OFF = LDSCTL_OFF + 320;
constexpr int NPHASE = 2 + 6 * NLAYER;

#define LDS_WAIT() asm volatile("s_waitcnt lgkmcnt(0)" ::: "memory")

struct Args { const float* in[20]; float* out; unsigned char* ws; int ph_lo, ph_hi, li, pad; };

#define CAS __attribute__((address_space(4)))
struct Frame {
    LAS unsigned char* lds;
    int tid, lane, wave, G, gw, NGW;
    const CAS unsigned char* ka;
    __device__ __forceinline__ const float* x() const { return *(const float* const CAS*)(ka + 0); }
    __device__ __forceinline__ const float* c() const { return *(const float* const CAS*)(ka + 8); }
    __device__ __forceinline__ const float* ctx() const { return *(const float* const CAS*)(ka + 16); }
    __device__ __forceinline__ const float* c_ctx() const { return *(const float* const CAS*)(ka + 24); }
    __device__ __forceinline__ const float* w_ada() const { return *(const float* const CAS*)(ka + 32); }
    __device__ __forceinline__ const float* b_ada() const { return *(const float* const CAS*)(ka + 40); }
    __device__ __forceinline__ const float* w_in() const { return *(const float* const CAS*)(ka + 48); }
    __device__ __forceinline__ const float* conv_w() const { return *(const float* const CAS*)(ka + 56); }
    __device__ __forceinline__ const float* sink() const { return *(const float* const CAS*)(ka + 64); }
    __device__ __forceinline__ const float* g_attn() const { return *(const float* const CAS*)(ka + 72); }
    __device__ __forceinline__ const float* g_conv() const { return *(const float* const CAS*)(ka + 80); }
    __device__ __forceinline__ const float* w_out() const { return *(const float* const CAS*)(ka + 88); }
    __device__ __forceinline__ const float* ln1_g() const { return *(const float* const CAS*)(ka + 96); }
    __device__ __forceinline__ const float* ln1_b() const { return *(const float* const CAS*)(ka + 104); }
    __device__ __forceinline__ const float* wq() const { return *(const float* const CAS*)(ka + 112); }
    __device__ __forceinline__ const float* keys() const { return *(const float* const CAS*)(ka + 120); }
    __device__ __forceinline__ const float* pu() const { return *(const float* const CAS*)(ka + 128); }
    __device__ __forceinline__ const float* pv() const { return *(const float* const CAS*)(ka + 136); }
    __device__ __forceinline__ const float* ln2_g() const { return *(const float* const CAS*)(ka + 144); }
    __device__ __forceinline__ const float* ln2_b() const { return *(const float* const CAS*)(ka + 152); }
    __device__ __forceinline__ float* out() const { return *(float* const CAS*)(ka + 160); }
    __device__ __forceinline__ unsigned char* ws() const { return *(unsigned char* const CAS*)(ka + 168); }
    __device__ __forceinline__ float* MODS() const { return (float*)(ws() + WS_MODS); }
    __device__ __forceinline__ float* ROPE() const { return (float*)(ws() + WS_ROPE); }
    __device__ __forceinline__ bf16_t* X() const { return (bf16_t*)(ws() + WS_X); }
    __device__ __forceinline__ bf16_t* SC() const { return (bf16_t*)(ws() + WS_SC); }
    __device__ __forceinline__ bf16_t* KBD() const { return (bf16_t*)(ws() + WS_KBD); }
    __device__ __forceinline__ bf16_t* WQR() const { return (bf16_t*)(ws() + WS_WQR); }
    __device__ __forceinline__ unsigned char* WINT() const { return ws() + WS_WINT; }
    __device__ __forceinline__ unsigned char* H8() const { return ws() + WS_H8; }
    __device__ __forceinline__ unsigned char* WOUTT() const { return ws() + WS_WOUTT; }
    __device__ __forceinline__ bf16_t* WEFFT() const { return (bf16_t*)(ws() + WS_WEFFT); }
    __device__ __forceinline__ bf16_t* H() const { return (bf16_t*)(ws() + WS_H); }
    __device__ __forceinline__ bf16_t* PROJ() const { return (bf16_t*)(ws() + WS_PROJ); }
    __device__ __forceinline__ unsigned char* MIX() const { return ws() + WS_MIX; }
    __device__ __forceinline__ unsigned char* UT() const { return (unsigned char*)(ws() + WS_UT); }
    __device__ __forceinline__ unsigned char* VT() const { return (unsigned char*)(ws() + WS_VT); }
    __device__ __forceinline__ float* US() const { return (float*)(ws() + WS_US); }
    __device__ __forceinline__ float* VS() const { return (float*)(ws() + WS_VS); }
};

__device__ __forceinline__ void frame_ids(Frame& F) {
    int tz = threadIdx.x; asm volatile("" : "+v"(tz));
    F.tid = tz; F.lane = tz & 63; F.wave = __builtin_amdgcn_readfirstlane(tz >> 6);
    F.gw = blockIdx.x * NWAVES + F.wave;
    const CAS unsigned char* k = (const CAS unsigned char*)__builtin_amdgcn_kernarg_segment_ptr(); asm volatile("" : "+s"(k)); F.ka = k;
}
template <int CTRL> __device__ __forceinline__ int dpp_i(int v) { return __builtin_amdgcn_update_dpp(0, v, CTRL, 0xf, 0xf, true); }
template <int CTRL> __device__ __forceinline__ float dpp_f(float v) { return __int_as_float(dpp_i<CTRL>(__float_as_int(v))); }
constexpr int DPP_XOR1 = 0xB1, DPP_XOR2 = 0x4E, DPP_HMIRROR = 0x141, DPP_ROR4 = 0x124, DPP_ROR8 = 0x128;
__device__ __forceinline__ float wave_sum_u(float v) {
    v += dpp_f<DPP_XOR1>(v); v += dpp_f<DPP_XOR2>(v); v += dpp_f<DPP_ROR4>(v); v += dpp_f<DPP_ROR8>(v);
    const float r0 = __int_as_float(__builtin_amdgcn_readlane(__float_as_int(v), 0)), r1 = __int_as_float(__builtin_amdgcn_readlane(__float_as_int(v), 16));
    const float r2 = __int_as_float(__builtin_amdgcn_readlane(__float_as_int(v), 32)), r3 = __int_as_float(__builtin_amdgcn_readlane(__float_as_int(v), 48));
    return (r0 + r1) + (r2 + r3);
}
__device__ __forceinline__ float wave_max_u(float v) {
    v = fmaxf(v, dpp_f<DPP_XOR1>(v)); v = fmaxf(v, dpp_f<DPP_XOR2>(v)); v = fmaxf(v, dpp_f<DPP_ROR4>(v)); v = fmaxf(v, dpp_f<DPP_ROR8>(v));
    const float r0 = __int_as_float(__builtin_amdgcn_readlane(__float_as_int(v), 0)), r1 = __int_as_float(__builtin_amdgcn_readlane(__float_as_int(v), 16));
    const float r2 = __int_as_float(__builtin_amdgcn_readlane(__float_as_int(v), 32)), r3 = __int_as_float(__builtin_amdgcn_readlane(__float_as_int(v), 48));
    return fmaxf(fmaxf(r0, r1), fmaxf(r2, r3));
}
__device__ __forceinline__ float xor32_f(float v, int lane) { return __int_as_float(__builtin_amdgcn_ds_bpermute((lane ^ 32) << 2, __float_as_int(v))); }
__device__ __forceinline__ float wave_sum(float v) { return wave_sum_u(v); }
__device__ __forceinline__ unsigned pk2(float lo, float hi) { return pg8::cvt_pk_bf16(lo, hi); }
__device__ __forceinline__ float bf_lo(unsigned u) { return __uint_as_float(u << 16); }
__device__ __forceinline__ float bf_hi(unsigned u) { return __uint_as_float(u & 0xffff0000u); }
__device__ __forceinline__ int modrow(int t) { return t < TL ? t / SEQ : 2; }

__device__ __forceinline__ void transpose_item(const float* W, int K, int N, bf16_t* WT, LAS float* scr, int item, int lane) {
    const int nblk = N / 32, kb = item / nblk, nb = item % nblk, k0 = 64 * kb, n0 = 32 * nb;
#pragma unroll 8
    for (int i = 0; i < 32; ++i) { const int kk = 2 * i + (lane >> 5); scr[kk * 33 + (lane & 31)] = W[(size_t)(k0 + kk) * N + n0 + (lane & 31)]; }
    LDS_WAIT(); asm volatile("" ::: "memory");
    const int c = lane & 7;
#pragma unroll
    for (int j = 0; j < 4; ++j) { const int n = (lane >> 3) + 8 * j; const LAS float* s = scr + (8 * c) * 33 + n;
        u32x4 o; o.x = pk2(s[0 * 33], s[1 * 33]); o.y = pk2(s[2 * 33], s[3 * 33]); o.z = pk2(s[4 * 33], s[5 * 33]); o.w = pk2(s[6 * 33], s[7 * 33]);
        *(u32x4*)(WT + (size_t)(n0 + n) * K + k0 + 8 * c) = o; }
    LDS_WAIT(); asm volatile("" ::: "memory");
}

__device__ __forceinline__ void transpose_item8(const float* W, int K, int N, unsigned char* WT, LAS float* scr, int item, int lane, float wscale) {
    const int nblk = N / 32, kb = item / nblk, nb = item % nblk, k0 = 64 * kb, n0 = 32 * nb;
    float wv[32];
#pragma unroll
    for (int i = 0; i < 32; ++i) wv[i] = __builtin_nontemporal_load(W + (size_t)(k0 + 2 * i + (lane >> 5)) * N + n0 + (lane & 31));
#pragma unroll
    for (int i = 0; i < 32; ++i) scr[(2 * i + (lane >> 5)) * 33 + (lane & 31)] = wv[i];
    LDS_WAIT(); asm volatile("" ::: "memory");
    const int c = lane & 7;
#pragma unroll
    for (int j = 0; j < 4; ++j) { const int n = (lane >> 3) + 8 * j; const LAS float* s = scr + (8 * c) * 33 + n;
        u32x2 o; int t0 = __builtin_amdgcn_cvt_pk_fp8_f32(s[0 * 33] * wscale, s[1 * 33] * wscale, 0, false); t0 = __builtin_amdgcn_cvt_pk_fp8_f32(s[2 * 33] * wscale, s[3 * 33] * wscale, t0, true);
        int t1 = __builtin_amdgcn_cvt_pk_fp8_f32(s[4 * 33] * wscale, s[5 * 33] * wscale, 0, false); t1 = __builtin_amdgcn_cvt_pk_fp8_f32(s[6 * 33] * wscale, s[7 * 33] * wscale, t1, true);
        o.x = (unsigned)t0; o.y = (unsigned)t1;
        *(u32x2*)(WT + (size_t)(n0 + n) * K + k0 + 8 * c) = o; }
    LDS_WAIT(); asm volatile("" ::: "memory");
}
__device__ __forceinline__ void cvt_row_bf16(const float* src, bf16_t* dst, int lane) {
    const f32x4* s = (const f32x4*)src + lane; u32x2* d = (u32x2*)dst + lane;
    f32x4 v[8];
#pragma unroll
    for (int j = 0; j < 8; ++j) v[j] = __builtin_nontemporal_load(s + 64 * j);
#pragma unroll
    for (int j = 0; j < 8; ++j) { u32x2 o; o.x = pk2(v[j].x, v[j].y); o.y = pk2(v[j].z, v[j].w); d[64 * j] = o; }
}

struct RowF32 { f32x4 v[4][2]; };
__device__ __forceinline__ void row_load_nt(RowF32& R, const float* src, int lane) {
    const f32x4* s = (const f32x4*)src + 2 * lane;
#pragma unroll
    for (int j = 0; j < 4; ++j) { R.v[j][0] = __builtin_nontemporal_load(s + 128 * j); R.v[j][1] = __builtin_nontemporal_load(s + 128 * j + 1); }
}
template <int FMT>
__device__ __forceinline__ void cvt_row_lp(const RowF32& R, unsigned char* dst, float* inv, int lane) {
    constexpr float QMAX = FMT == 8 ? 224.f : 6.f;
    float am = 0.f;
#pragma unroll
    for (int j = 0; j < 4; ++j)
#pragma unroll
        for (int q = 0; q < 2; ++q) am = fmaxf(fmaxf(am, fmaxf(fabsf(R.v[j][q].x), fabsf(R.v[j][q].y))), fmaxf(fabsf(R.v[j][q].z), fabsf(R.v[j][q].w)));
    am = wave_max_u(am);
    const float sc = am > 0.f ? QMAX / am : 1.f;
#pragma unroll
    for (int j = 0; j < 4; ++j) {
        if constexpr (FMT == 8) {
            u32x2 w;
#pragma unroll
            for (int q = 0; q < 2; ++q) { int t = __builtin_amdgcn_cvt_pk_fp8_f32(R.v[j][q].x * sc, R.v[j][q].y * sc, 0, false); t = __builtin_amdgcn_cvt_pk_fp8_f32(R.v[j][q].z * sc, R.v[j][q].w * sc, t, true); w[q] = (unsigned)t; }
            *((u32x2*)dst + lane + 64 * j) = w;
        } else {
            unsigned w = 0u;
            w = __builtin_amdgcn_cvt_scalef32_pk_fp4_f32(w, R.v[j][0].x * sc, R.v[j][0].y * sc, 1.0f, 0);
            w = __builtin_amdgcn_cvt_scalef32_pk_fp4_f32(w, R.v[j][0].z * sc, R.v[j][0].w * sc, 1.0f, 1);
            w = __builtin_amdgcn_cvt_scalef32_pk_fp4_f32(w, R.v[j][1].x * sc, R.v[j][1].y * sc, 1.0f, 2);
            w = __builtin_amdgcn_cvt_scalef32_pk_fp4_f32(w, R.v[j][1].z * sc, R.v[j][1].w * sc, 1.0f, 3);
            *((unsigned*)dst + lane + 64 * j) = w;
        }
    }
    if (lane == 0) *inv = am > 0.f ? am * (1.f / QMAX) : 1.f;
}
template <int FMT> struct LpRow;
template <> struct LpRow<8> { u32x4 a, b;
    __device__ __forceinline__ void load(const unsigned char* rowp, int lane) { a = *(const u32x4*)(rowp + 32 * lane); b = *(const u32x4*)(rowp + 32 * lane + 16); }
    template <class Fn> __device__ __forceinline__ void each(Fn&& f) const {
#pragma unroll
        for (int w = 0; w < 4; ++w) { const f32x2 l0 = __builtin_amdgcn_cvt_pk_f32_fp8((int)a[w], false), h0 = __builtin_amdgcn_cvt_pk_f32_fp8((int)a[w], true);
            f(4 * w, l0.x, l0.y); f(4 * w + 2, h0.x, h0.y); }
#pragma unroll
        for (int w = 0; w < 4; ++w) { const f32x2 l0 = __builtin_amdgcn_cvt_pk_f32_fp8((int)b[w], false), h0 = __builtin_amdgcn_cvt_pk_f32_fp8((int)b[w], true);
            f(16 + 4 * w, l0.x, l0.y); f(16 + 4 * w + 2, h0.x, h0.y); }
    } };
template <> struct LpRow<4> { u32x4 a;
    __device__ __forceinline__ void load(const unsigned char* rowp, int lane) { a = *(const u32x4*)(rowp + 16 * lane); }
    template <class Fn> __device__ __forceinline__ void each(Fn&& f) const {
#pragma unroll
        for (int w = 0; w < 4; ++w) {
            const f32x2 d0 = __builtin_amdgcn_cvt_scalef32_pk_f32_fp4(a[w], 1.0f, 0), d1 = __builtin_amdgcn_cvt_scalef32_pk_f32_fp4(a[w], 1.0f, 1);
            const f32x2 d2 = __builtin_amdgcn_cvt_scalef32_pk_f32_fp4(a[w], 1.0f, 2), d3 = __builtin_amdgcn_cvt_scalef32_pk_f32_fp4(a[w], 1.0f, 3);
            f(8 * w, d0.x, d0.y); f(8 * w + 2, d1.x, d1.y); f(8 * w + 4, d2.x, d2.y); f(8 * w + 6, d3.x, d3.y); }
    }
    template <class Fn> __device__ __forceinline__ void each_bf(Fn&& f) const {
#pragma unroll
        for (int w = 0; w < 4; ++w) {
            f(4 * w, __builtin_amdgcn_cvt_scalef32_pk_bf16_fp4(a[w], 1.0f, 0)); f(4 * w + 1, __builtin_amdgcn_cvt_scalef32_pk_bf16_fp4(a[w], 1.0f, 1));
            f(4 * w + 2, __builtin_amdgcn_cvt_scalef32_pk_bf16_fp4(a[w], 1.0f, 2)); f(4 * w + 3, __builtin_amdgcn_cvt_scalef32_pk_bf16_fp4(a[w], 1.0f, 3)); }
    } };

__device__ __forceinline__ void row_stats(const f32x4 (&v)[8], float& mean, float& rstd) {
    float s = 0.f;
#pragma unroll
    for (int j = 0; j < 8; ++j) s += (v[j].x + v[j].y) + (v[j].z + v[j].w);
    mean = wave_sum(s) * (1.f / D);
    float s2 = 0.f;
#pragma unroll
    for (int j = 0; j < 8; ++j) { const f32x4 d = v[j] - mean; s2 += (d.x * d.x + d.y * d.y) + (d.z * d.z + d.w * d.w); }
    rstd = 1.f / sqrtf(wave_sum(s2) * (1.f / D) + LN_EPS);
}
__device__ __forceinline__ void modulate_store(const f32x4 (&v)[8], const float* shift, const float* scale, bf16_t* dst, int lane) {
    float mean, rstd; row_stats(v, mean, rstd);
    u32x2* d = (u32x2*)dst + lane;
#pragma unroll
    for (int j = 0; j < 8; ++j) { const f32x4 sc = *((const f32x4*)scale + lane + 64 * j), sh = *((const f32x4*)shift + lane + 64 * j);
        const f32x4 y = (v[j] - mean) * rstd * (sc + 1.f) + sh;
        u32x2 o; o.x = pk2(y.x, y.y); o.y = pk2(y.z, y.w); d[64 * j] = o; }
}

__device__ __forceinline__ void convert_tables(Frame& F, int row0, int row1, int w0, int wstride) {
    RowF32 ru, rv, nu, nv;
    int row = row0 + w0;
    if (row < row1) { row_load_nt(ru, F.pu() + (size_t)row * D, F.lane); row_load_nt(rv, F.pv() + (size_t)row * D, F.lane); }
    while (row < row1) {
        const int nrow = row + wstride;
        if (nrow < row1) { row_load_nt(nu, F.pu() + (size_t)nrow * D, F.lane); row_load_nt(nv, F.pv() + (size_t)nrow * D, F.lane); }
        cvt_row_lp<U_FMT>(ru, F.UT() + (size_t)row * UROW, F.US() + 2 * (size_t)row, F.lane);
        cvt_row_lp<V_FMT>(rv, F.VT() + (size_t)row * VROW, F.US() + 2 * (size_t)row + 1, F.lane);
        ru = nu; rv = nv; row = nrow;
    }
}
__device__ __forceinline__ void convert_in_tail(Frame& F, int layer, int nunits, int part) {
    if (layer + 1 >= NLAYER) return;
    const int G = F.G, rounds = (nunits + G - 1) / G, nlast = nunits - (rounds - 1) * G;
    const int c = (int)blockIdx.x;
    int nshort = G - nlast, sidx = c - nlast;
    if (nshort <= 0) { nshort = G; sidx = c; }
    else if (sidx < 0) return;
    const int r0 = (layer + 1) * NEXP + part * (NEXP / 2);
    convert_tables(F, r0, r0 + NEXP / 2, sidx * NWAVES + F.wave, nshort * NWAVES);
}
__device__ __forceinline__ void p0a_prologue(Frame& F) {
    LAS float* condL = (LAS float*)F.lds;
    LAS float* red = (LAS float*)(F.lds + 24576);
    for (int i = F.tid; i < 3 * D; i += NWAVES * 64) { const int r = i / D, k = i % D; const float v = r < 2 ? F.c()[r * D + k] : F.c_ctx()[k]; condL[i] = v / (1.f + __expf(-v)); }
    __syncthreads();
    const bool bal = (F.G == 256);
    for (int pass = 0; pass < (bal ? 2 : 384); ++pass) {
        int item, kw, kbase;
        if (bal) { item = pass == 0 ? (int)blockIdx.x : 256 + ((int)blockIdx.x >> 1); kw = pass == 0 ? 256 : 128; kbase = pass == 0 ? F.wave * 256 : ((int)blockIdx.x & 1) * 1024 + F.wave * 128; }
        else { item = (int)blockIdx.x + pass * F.G; kw = 256; kbase = F.wave * 256; if (item >= 384) break; }
        const int l = item / 96, n0 = (item % 96) * 128;
        const float* wp = F.w_ada() + ((size_t)l * D + kbase) * 12288 + n0 + 2 * F.lane;
        f32x2 a0 = {0.f, 0.f}, a1 = {0.f, 0.f}, a2 = {0.f, 0.f};
#pragma unroll 8
        for (int k = 0; k < kw; ++k) { const f32x2 w = __builtin_nontemporal_load((const f32x2*)(wp + (size_t)k * 12288)); const int kk = kbase + k;
            a0 += w * condL[kk]; a1 += w * condL[D + kk]; a2 += w * condL[2 * D + kk]; }
        LAS float* rp = red + F.wave * 384 + 2 * F.lane;
        rp[0] = a0.x; rp[1] = a0.y; rp[128] = a1.x; rp[129] = a1.y; rp[256] = a2.x; rp[257] = a2.y;
        __syncthreads();
        if (F.tid < 384) { const int r = F.tid / 128, n = F.tid % 128; float s = 0.f;
#pragma unroll
            for (int w = 0; w < 8; ++w) s += red[w * 384 + r * 128 + n];
            if (!(bal && pass == 1 && (blockIdx.x & 1))) s += F.b_ada()[(size_t)l * 12288 + n0 + n];
            atomicAdd(F.MODS() + ((size_t)l * 3 + r) * 12288 + n0 + n, s); }
        __syncthreads();
    }
    LAS float* scr = (LAS float*)(F.lds + 40960 + F.wave * 8448);
    constexpr int I_IN = (D / 64) * (INC / 32), I_OUT = (D / 64) * (D / 32);
    for (int it = F.gw; it < NLAYER * (I_IN + I_OUT); it += F.NGW) {
        const int l = it / (I_IN + I_OUT); int r = it % (I_IN + I_OUT);
        if (r < I_IN) transpose_item8(F.w_in() + (size_t)l * D * INC, D, INC, F.WINT() + (size_t)l * INC * D, scr, r, F.lane, WIN_SCALE);
        else transpose_item8(F.w_out() + (size_t)l * D * D, D, D, F.WOUTT() + (size_t)l * D * D, scr, r - I_IN, F.lane, WOUT_SCALE);
    }
    for (int row = F.gw; row < NLAYER * D; row += F.NGW) {
        const int l = row / D, c = row % D; const f32x4* s = (const f32x4*)(F.wq() + (size_t)row * D) + F.lane;
#pragma unroll
        for (int j = 0; j < 8; ++j) { const f32x4 v = s[64 * j]; u32x2 o; o.x = pk2(v.x, v.y); o.y = pk2(v.z, v.w);
            *((u32x2*)(F.WQR() + ((size_t)(l * 8 + j) * D + c) * 256) + F.lane) = o; }
    }
    for (int row = F.gw; row < 32 * 256; row += F.NGW) {
        const int lh = row >> 8, pk = row & 255, p = pk >> 7;
        u32x2 o = {0u, 0u};
        if ((F.lane >> 5) == p) { const f32x4 v = *((const f32x4*)(F.keys() + ((size_t)lh * 256 + pk) * 128) + (F.lane & 31)); o.x = pk2(v.x, v.y); o.y = pk2(v.z, v.w); }
        *((u32x2*)(F.KBD() + (size_t)row * 256) + F.lane) = o;
    }
    convert_tables(F, 0, NEXP, F.gw, F.NGW);
    for (int i = blockIdx.x * (NWAVES * 64) + F.tid; i < 192 * 32; i += F.G * NWAVES * 64) {
        const int idx = i >> 5, f = i & 31; const float pos = (float)(idx < 128 ? idx : idx - 128);
        const float inv = powf(10000.f, -(float)(2 * f) / 64.f); const float ang = pos * inv;
        F.ROPE()[2 * i] = cosf(ang); F.ROPE()[2 * i + 1] = sinf(ang);
    }
}

__device__ __forceinline__ void p0b_mod0(Frame& F) {
    __syncthreads();
#pragma unroll 1
    for (int v = 0; v < 6; ++v)
        *(LAS f32x4*)(F.lds + v * 8192 + F.tid * 16) = *(const f32x4*)(F.MODS() + (size_t)(v % 3) * 12288 + (v < 3 ? 0 : D) + 4 * F.tid);
    __syncthreads();
    for (int t = F.gw; t < TT; t += F.NGW) {
        const float* src = t < TL ? F.x() + (size_t)t * D : F.ctx() + (size_t)(t - TL) * D;
        f32x4 v[8];
#pragma unroll
        for (int j = 0; j < 8; ++j) v[j] = *((const f32x4*)src + F.lane + 64 * j);
        const int mr = modrow(t);
        float mean, rstd; row_stats(v, mean, rstd);
        unsigned* d = (unsigned*)(F.H8() + (size_t)t * D) + F.lane;
#pragma unroll
        for (int j = 0; j < 8; ++j) { const f32x4 sh = *(const LAS f32x4*)(F.lds + mr * 8192 + (64 * j + F.lane) * 16), sc = *(const LAS f32x4*)(F.lds + (3 + mr) * 8192 + (64 * j + F.lane) * 16);
            const f32x4 y = (v[j] - mean) * rstd * (sc + 1.f) + sh;
            int o = __builtin_amdgcn_cvt_pk_fp8_f32(y.x, y.y, 0, false); o = __builtin_amdgcn_cvt_pk_fp8_f32(y.z, y.w, o, true); d[64 * j] = (unsigned)o; }
    }
}

constexpr int ROPE_LDS = 98304, ROPE_RS = 272;
constexpr int CONV_LDS = 81920;
constexpr int KP = 272, VP = 320, KS_BYTES = 64 * KP, VS_BYTES = 64 * VP;
struct KVRegs { u32x4 k1, k2, v1, v2; };

__device__ __forceinline__ void attn_load_tile(Frame& F, KVRegs& R, int ti, int b, int n, int g) {
    const int key = F.tid >> 3, c8 = F.tid & 7;
    int row;
    if (ti < 6) row = b * SEQ + (n - 1) * 128 + 64 * ti + key; else row = TL + b * CTXL + 64 * (ti - 6) + key;
    const bf16_t* base = F.PROJ() + (size_t)row * INC;
    const int d1 = (c8 >> 2) * 64 + (c8 & 3) * 8;
    R.k1 = *(const u32x4*)(base + OFF_K + g * 128 + d1); R.k2 = *(const u32x4*)(base + OFF_K + g * 128 + d1 + 32);
    R.v1 = *(const u32x4*)(base + OFF_V + g * 128 + 8 * c8); R.v2 = *(const u32x4*)(base + OFF_V + g * 128 + 64 + 8 * c8);
}
__device__ __forceinline__ void rope8(u32x4& a, u32x4& bq, const f32x4 (&cs)[4], float scale) {
    u32x4 oa, ob;
#pragma unroll
    for (int w = 0; w < 4; ++w) {
        const float x1l = bf_lo(a[w]), x1h = bf_hi(a[w]), x2l = bf_lo(bq[w]), x2h = bf_hi(bq[w]);
        const float cl = cs[w].x, sl = cs[w].y, ch = cs[w].z, sh = cs[w].w;
        oa[w] = pk2((x1l * cl - x2l * sl) * scale, (x1h * ch - x2h * sh) * scale);
        ob[w] = pk2((x2l * cl + x1l * sl) * scale, (x2h * ch + x1h * sh) * scale);
    }
    a = oa; bq = ob;
}
__device__ __forceinline__ void attn_store_tile(Frame& F, KVRegs& R, int ti, int buf, int n) {
    const int key = F.tid >> 3, c8 = F.tid & 7;
    if (ti < 6) {
        const int pos = (n - 1) * 128 + 64 * ti + key;
        const int tidx = (c8 >> 2) ? 128 + (pos & 63) : (pos >> 6); const LAS f32x4* cp = (const LAS f32x4*)(F.lds + ROPE_LDS + tidx * ROPE_RS + (c8 & 3) * 64);
        f32x4 cs[4];
#pragma unroll
        for (int m = 0; m < 4; ++m) cs[m] = cp[m];
        rope8(R.k1, R.k2, cs, 1.f);
    }
    const int d1 = (c8 >> 2) * 64 + (c8 & 3) * 8;
    LAS unsigned char* kp = F.lds + buf * KS_BYTES + key * KP;
    *(LAS u32x4*)(kp + d1 * 2) = R.k1; *(LAS u32x4*)(kp + (d1 + 32) * 2) = R.k2;
    LAS unsigned char* vp = F.lds + 2 * KS_BYTES + buf * VS_BYTES + key * VP;
    *(LAS u32x4*)(vp + 16 * c8) = R.v1; *(LAS u32x4*)(vp + 128 + 16 * c8) = R.v2;
}

#define MFMA32(a, b, c) __builtin_amdgcn_mfma_f32_32x32x16_bf16((a), (b), (c), 0, 0, 0)

struct AUnit { bool latent; int b, n, g, tq, head, tlo, nw; };
__device__ __forceinline__ AUnit attn_decode(int u, int wave, int r) {
    AUnit U; int hp;
    U.latent = u < 512;
    if (U.latent) { hp = u & 1; U.g = (u >> 1) & 1; U.n = (u >> 2) & 63; U.b = u >> 8; }
    else { const int v = u - 512; hp = v & 1; U.g = (v >> 1) & 1; U.n = (v >> 2) & 1; U.b = v >> 3; }
    const int qb = wave & 3;
    U.head = U.g * 4 + hp * 2 + (wave >> 2);
    U.tq = U.latent ? U.b * SEQ + U.n * 128 + 32 * qb + r : TL + U.b * CTXL + U.n * 128 + 32 * qb + r;
    U.tlo = 6; U.nw = 0;
    if (U.latent) { U.tlo = (U.n == 0) ? 2 : 0; const int thi = (U.n == 63) ? 3 : 5; U.nw = thi - U.tlo + 1; }
    return U;
}
#define TILE_OF(U, j) ((j) < (U).nw ? (U).tlo + (j) : 6 + ((j) - (U).nw))
__device__ __forceinline__ void attn_units(Frame& F, int layer, int u0, int ustep, int nunits) {
    if (u0 >= nunits) return;
    const int lane = F.lane, r = lane & 31, h = lane >> 5, wave = F.wave, qb = wave & 3;
    const int i16 = lane & 15, tq4 = i16 >> 2, tp = i16 & 3, blk = (lane >> 4) & 1;
    u32x4 raw[8]; KVRegs R, R2;
    AUnit U = attn_decode(u0, wave, r);
    {
        const bf16_t* qp = F.PROJ() + (size_t)U.tq * INC + OFF_Q + U.head * 128 + 8 * h;
#pragma unroll
        for (int ks = 0; ks < 8; ++ks) raw[ks] = *(const u32x4*)(qp + 16 * ks);
        attn_load_tile(F, R2, TILE_OF(U, 0), U.b, U.n, U.g);
        attn_load_tile(F, R, TILE_OF(U, 1), U.b, U.n, U.g);
    }
    for (int u = u0;; u += ustep) {
        const bool latent = U.latent; const int b = U.b, n = U.n, g = U.g, head = U.head, tq = U.tq, tlo = U.tlo, nw = U.nw;
        bf16x8 qf[8];
        if (latent) {
            const int pos = n * 128 + 32 * qb + r;
#pragma unroll
            for (int half = 0; half < 2; ++half) {
                const int tidx = half ? 128 + (pos & 63) : (pos >> 6);
#pragma unroll
                for (int kk = 0; kk < 2; ++kk) {
                    const LAS f32x4* cp = (const LAS f32x4*)(F.lds + ROPE_LDS + tidx * ROPE_RS + (16 * kk + 8 * h) * 8);
                    f32x4 cs[4];
#pragma unroll
                    for (int m = 0; m < 4; ++m) cs[m] = cp[m];
                    rope8(raw[4 * half + kk], raw[4 * half + kk + 2], cs, QSCALE);
                }
            }
        } else {
#pragma unroll
            for (int ks = 0; ks < 8; ++ks)
#pragma unroll
                for (int w = 0; w < 4; ++w) raw[ks][w] = pk2(bf_lo(raw[ks][w]) * QSCALE, bf_hi(raw[ks][w]) * QSCALE);
        }
#pragma unroll
        for (int ks = 0; ks < 8; ++ks) qf[ks] = __builtin_bit_cast(bf16x8, raw[ks]);
        const int ntiles = nw + 4;
        f32x16 o[4];
#pragma unroll
        for (int db = 0; db < 4; ++db)
#pragma unroll
            for (int i = 0; i < 16; ++i) o[db][i] = 0.f;
        float m_run = F.sink()[layer * 8 + head] * LOG2E;
        float lsum = h == 0 ? 1.f : 0.f;
        const int iq = 32 * qb + r;
        __syncthreads();
        attn_store_tile(F, R2, TILE_OF(U, 0), 0, n);
        __syncthreads();
        for (int j = 0; j < ntiles; ++j) {
            const int ti = TILE_OF(U, j);
            const int buf = j & 1;
            const bool more = j + 1 < ntiles;
            const int tin = TILE_OF(U, j + 1);
            if (j + 2 < ntiles) attn_load_tile(F, R2, TILE_OF(U, j + 2), b, n, g);
            const bool part = ti >= 6 || (ti >= (qb >> 1) && ti <= (qb >> 1) + 4);
            if (part) {
                f32x16 s0, s1;
#pragma unroll
                for (int i = 0; i < 16; ++i) { s0[i] = 0.f; s1[i] = 0.f; }
                const LAS unsigned char* kb = F.lds + buf * KS_BYTES + r * KP + h * 16;
#pragma unroll
                for (int ks = 0; ks < 8; ++ks) {
                    const bf16x8 a0 = *(const LAS bf16x8*)(kb + ks * 32), a1 = *(const LAS bf16x8*)(kb + 32 * KP + ks * 32);
                    s0 = MFMA32(a0, qf[ks], s0); s1 = MFMA32(a1, qf[ks], s1);
                }
                float mx = -INFINITY;
                if (ti < 6 && (ti == (qb >> 1) || ti == (qb >> 1) + 4)) {
                    const int jb = 64 * ti + 4 * h - iq;
#pragma unroll
                    for (int i = 0; i < 16; ++i) { const int j0 = jb + (i & 3) + 8 * (i >> 2), j1 = j0 + 32;
                        s0[i] = (j0 >= 0 && j0 <= 256) ? s0[i] : -INFINITY; s1[i] = (j1 >= 0 && j1 <= 256) ? s1[i] : -INFINITY; }
                }
#pragma unroll
                for (int i = 0; i < 16; ++i) mx = fmaxf(mx, fmaxf(s0[i], s1[i]));
                mx = fmaxf(mx, xor32_f(mx, lane));
                if (__any(mx > m_run + 8.f)) {
                    const float m_new = mx > m_run + 8.f ? mx : m_run, alpha = __builtin_amdgcn_exp2f(m_run - m_new);
                    m_run = m_new; lsum *= alpha;
#pragma unroll
                    for (int db = 0; db < 4; ++db)
#pragma unroll
                        for (int i = 0; i < 16; ++i) o[db][i] *= alpha;
                }
                const LAS unsigned char* vb = F.lds + 2 * KS_BYTES + buf * VS_BYTES + (4 * h + tq4) * VP + 32 * blk + 8 * tp;
                u32x4 pc;
#pragma unroll
                for (int w = 0; w < 4; ++w) { const float e0 = __builtin_amdgcn_exp2f(s0[2 * w] - m_run), e1 = __builtin_amdgcn_exp2f(s0[2 * w + 1] - m_run); lsum += e0 + e1; pc[w] = pk2(e0, e1); }
#pragma unroll
                for (int c = 0; c < 4; ++c) {
                    const int kb2 = c >> 1, s2 = c & 1;
                    const bf16x8 pf = __builtin_bit_cast(bf16x8, pc);
                    s16x4 lo[4], hi[4];
#pragma unroll
                    for (int db = 0; db < 4; ++db) { const int off = (32 * kb2 + 16 * s2) * VP + db * 64;
                        lo[db] = __builtin_amdgcn_ds_read_tr16_b64_v4i16((LAS s16x4*)(vb + off)); hi[db] = __builtin_amdgcn_ds_read_tr16_b64_v4i16((LAS s16x4*)(vb + off + 8 * VP)); }
#pragma unroll
                    for (int db = 0; db < 4; ++db) {
                        const bf16x8 av = __builtin_shufflevector(lo[db], hi[db], 0, 1, 2, 3, 4, 5, 6, 7);
                        o[db] = MFMA32(av, pf, o[db]);
                        if (c < 3) {
                            const int cn = c + 1, base = 8 * (cn & 1) + 2 * db;
                            const float x0 = (cn >> 1) ? s1[base] : s0[base], x1 = (cn >> 1) ? s1[base + 1] : s0[base + 1];
                            const float e0 = __builtin_amdgcn_exp2f(x0 - m_run), e1 = __builtin_amdgcn_exp2f(x1 - m_run); lsum += e0 + e1; pc[db] = pk2(e0, e1);
                        }
                    }
                }
            }
            if (more) attn_store_tile(F, R, tin, buf ^ 1, n);
            R = R2;
            __syncthreads();
        }
        const bool hasn = u + ustep < nunits;
        if (hasn) {
            U = attn_decode(u + ustep, wave, r);
            const bf16_t* qp = F.PROJ() + (size_t)U.tq * INC + OFF_Q + U.head * 128 + 8 * h;
#pragma unroll
            for (int ks = 0; ks < 8; ++ks) raw[ks] = *(const u32x4*)(qp + 16 * ks);
            attn_load_tile(F, R2, TILE_OF(U, 0), U.b, U.n, U.g);
            attn_load_tile(F, R, TILE_OF(U, 1), U.b, U.n, U.g);
        }
        const float lt = lsum + xor32_f(lsum, lane);
        const float inv = 1.f / lt;
        float ss = 0.f;
#pragma unroll
        for (int db = 0; db < 4; ++db)
#pragma unroll
            for (int i = 0; i < 16; ++i) { o[db][i] *= inv; ss += o[db][i] * o[db][i]; }
        ss += xor32_f(ss, lane);
        const float rn = 1.f / sqrtf(ss * (1.f / 128.f) + LN_EPS);
        unsigned char* op = F.MIX() + (size_t)tq * D + head * 128 + 16 * h;
        const float* gp = F.g_attn() + layer * 1024 + head * 128 + 4 * h;
#pragma unroll
        for (int db = 0; db < 4; ++db) {
            unsigned wv[4];
#pragma unroll
            for (int g4 = 0; g4 < 4; ++g4) {
                const f32x4 gv = *(const f32x4*)(gp + 32 * db + 8 * g4);
                int w = __builtin_amdgcn_cvt_pk_fp8_f32(o[db][4 * g4] * rn * gv.x, o[db][4 * g4 + 1] * rn * gv.y, 0, false);
                w = __builtin_amdgcn_cvt_pk_fp8_f32(o[db][4 * g4 + 2] * rn * gv.z, o[db][4 * g4 + 3] * rn * gv.w, w, true);
                wv[g4] = (unsigned)w;
            }
            const auto s02 = __builtin_amdgcn_permlane32_swap(wv[0], wv[2], false, false), s13 = __builtin_amdgcn_permlane32_swap(wv[1], wv[3], false, false);
            u32x4 ov; ov.x = s02[0]; ov.y = s02[1]; ov.z = s13[0]; ov.w = s13[1];
            *(u32x4*)(op + 32 * db) = ov;
        }
        if (!hasn) break;
    }
}
#undef TILE_OF

__device__ __forceinline__ void unpack8(const u32x4 v, float (&f)[8]) {
#pragma unroll
    for (int w = 0; w < 4; ++w) { f[2 * w] = bf_lo(v[w]); f[2 * w + 1] = bf_hi(v[w]); }
}
struct ConvRaw { u32x4 c[2], x[2]; };
__device__ __forceinline__ void conv_load(Frame& F, ConvRaw& R, int t, int lane) {
    const bf16_t* p = F.PROJ() + (size_t)t * INC + 8 * lane;
#pragma unroll
    for (int jc = 0; jc < 2; ++jc) { R.c[jc] = *(const u32x4*)(p + OFF_C + 512 * jc); R.x[jc] = *(const u32x4*)(p + OFF_X + 512 * jc); }
}
__device__ __forceinline__ void conv_prod(const ConvRaw& R, float (&P)[16]) {
#pragma unroll
    for (int jc = 0; jc < 2; ++jc) { float a[8], bq[8]; unpack8(R.c[jc], a); unpack8(R.x[jc], bq);
#pragma unroll
        for (int e = 0; e < 8; ++e) P[8 * jc + e] = a[e] * bq[e]; }
}
__device__ __forceinline__ bool conv_first(int t) { return t < TL ? (t & (SEQ - 1)) == 0 : ((t - TL) & (CTXL - 1)) == 0; }
__device__ __forceinline__ bool conv_last(int t) { return t < TL ? (t & (SEQ - 1)) == SEQ - 1 : ((t - TL) & (CTXL - 1)) == CTXL - 1; }
__device__ __forceinline__ void conv_rows(Frame& F, int layer, int t0, int t1) {
    if (t0 >= t1) return;
    const int lane = F.lane;
    const LAS unsigned char* cvc = F.lds + CONV_LDS + lane * 16;
    float Pm[16], Pt[16];
    ConvRaw Rn; u32x4 gcur[2];
    {
        ConvRaw R0;
        if (!conv_first(t0)) { conv_load(F, R0, t0 - 1, lane); conv_prod(R0, Pm); }
        else {
#pragma unroll
            for (int e = 0; e < 16; ++e) Pm[e] = 0.f; }
        conv_load(F, R0, t0, lane); conv_prod(R0, Pt);
    }
    conv_load(F, Rn, t0 + 1 < TT ? t0 + 1 : TT - 1, lane);
    { const bf16_t* gp = F.PROJ() + (size_t)t0 * INC + 8 * lane; gcur[0] = *(const u32x4*)gp; gcur[1] = *(const u32x4*)(gp + 512); }
    for (int t = t0; t < t1; ++t) {
        ConvRaw R2; u32x4 gnext[2];
        const bool more = t + 1 < t1;
        if (more) { conv_load(F, R2, t + 2 < TT ? t + 2 : TT - 1, lane); const bf16_t* gp = F.PROJ() + (size_t)(t + 1) * INC + 8 * lane; gnext[0] = *(const u32x4*)gp; gnext[1] = *(const u32x4*)(gp + 512); }
        float Pp[16]; conv_prod(Rn, Pp);
        const float fm = conv_first(t) ? 0.f : 1.f, fp = conv_last(t) ? 0.f : 1.f;
#pragma unroll
        for (int jc = 0; jc < 2; ++jc) {
            float gb[8]; unpack8(gcur[jc], gb);
            float y[8], ss = 0.f;
#pragma unroll
            for (int q = 0; q < 2; ++q) { const f32x4 w0 = *(const LAS f32x4*)(cvc + (2 * jc + q) * 1024) * fm, w1 = *(const LAS f32x4*)(cvc + 4096 + (2 * jc + q) * 1024), w2 = *(const LAS f32x4*)(cvc + 8192 + (2 * jc + q) * 1024) * fp;
#pragma unroll
                for (int e = 0; e < 4; ++e) { const int i = 4 * q + e; y[i] = gb[i] * (w0[e] * Pm[8 * jc + i] + w1[e] * Pt[8 * jc + i] + w2[e] * Pp[8 * jc + i]); ss += y[i] * y[i]; } }
            ss += dpp_f<DPP_XOR1>(ss); ss += dpp_f<DPP_XOR2>(ss); ss += dpp_f<DPP_ROR4>(ss); ss += dpp_f<DPP_ROR8>(ss);
            const float rn = 1.f / sqrtf(ss * (1.f / 128.f) + LN_EPS);
            u32x2 w;
#pragma unroll
            for (int q = 0; q < 2; ++q) { const f32x4 gcv = *(const LAS f32x4*)(cvc + 12288 + (2 * jc + q) * 1024);
                int t8 = __builtin_amdgcn_cvt_pk_fp8_f32(y[4 * q] * rn * gcv[0], y[4 * q + 1] * rn * gcv[1], 0, false); t8 = __builtin_amdgcn_cvt_pk_fp8_f32(y[4 * q + 2] * rn * gcv[2], y[4 * q + 3] * rn * gcv[3], t8, true); w[q] = (unsigned)t8; }
            *(u32x2*)(F.MIX() + (size_t)t * D + 1024 + 8 * lane + 512 * jc) = w;
        }
#pragma unroll
        for (int e = 0; e < 16; ++e) { Pm[e] = Pt[e]; Pt[e] = Pp[e]; }
        if (more) { Rn = R2; gcur[0] = gnext[0]; gcur[1] = gnext[1]; }
    }
}

__device__ __forceinline__ void ln_phase(Frame& F, int layer, int rows) {
    const int lane = F.lane;
    const bf16_t* Y = F.PROJ();
    u32x4 w[4], wn[4], yw[4], yn[4];
    int t = F.gw;
    if (t < rows) {
#pragma unroll
        for (int j = 0; j < 4; ++j) { yw[j] = *(const u32x4*)(Y + (size_t)t * D + 8 * lane + 512 * j); if (layer > 0) w[j] = *(const u32x4*)(F.X() + (size_t)t * D + 8 * lane + 512 * j); }
    }
    {
        const int ch = F.tid, jj = ch >> 7, rem = ch & 127, ll = rem >> 1, qq = rem & 1;
        LAS unsigned char* dst = F.lds + ((2 * jj + qq) * 64 + ll) * 16;
        *(LAS f32x4*)(dst) = *(const f32x4*)(F.ln1_g() + layer * D + 4 * ch);
        *(LAS f32x4*)(dst + 8192) = *(const f32x4*)(F.ln1_b() + layer * D + 4 * ch);
#pragma unroll 1
        for (int v = 0; v < 9; ++v) { const int mrv = v % 3; const size_t off = ((size_t)layer * 3 + mrv) * 12288 + (v < 3 ? 3 * D : (v < 6 ? 4 * D : 2 * D));
            *(LAS f32x4*)(dst + (2 + v) * 8192) = *(const f32x4*)(F.MODS() + off + 4 * ch); }
    }
    __syncthreads();
    const LAS unsigned char* vc = F.lds + lane * 16;
    while (t < rows) {
        const int tn = t + F.NGW;
        if (tn < rows) {
#pragma unroll
            for (int j = 0; j < 4; ++j) { yn[j] = *(const u32x4*)(Y + (size_t)tn * D + 8 * lane + 512 * j); if (layer > 0) wn[j] = *(const u32x4*)(F.X() + (size_t)tn * D + 8 * lane + 512 * j); }
        }
        const int mrl = modrow(t);
        float v[32]; float s = 0.f;
#pragma unroll
        for (int j = 0; j < 4; ++j) {
            float xin[8], yv[8];
            unpack8(yw[j], yv);
            if (layer > 0) unpack8(w[j], xin);
            else { const float* xp = (t < TL ? F.x() + (size_t)t * D : F.ctx() + (size_t)(t - TL) * D) + 8 * lane + 512 * j; const f32x4 a0 = *(const f32x4*)xp, a1 = *(const f32x4*)(xp + 4);
                xin[0] = a0[0]; xin[1] = a0[1]; xin[2] = a0[2]; xin[3] = a0[3]; xin[4] = a1[0]; xin[5] = a1[1]; xin[6] = a1[2]; xin[7] = a1[3]; }
#pragma unroll
            for (int q = 0; q < 2; ++q) { const f32x4 ga = *(const LAS f32x4*)(vc + (8 + mrl) * 8192 + (2 * j + q) * 1024);
#pragma unroll
                for (int e = 0; e < 4; ++e) { const float r = DN_ALPHA * xin[4 * q + e] + ga[e] * yv[4 * q + e]; v[8 * j + 4 * q + e] = r; s += r; } } }
        const float mean = wave_sum(s) * (1.f / D);
        float s2 = 0.f;
#pragma unroll
        for (int i = 0; i < 32; ++i) { v[i] -= mean; s2 += v[i] * v[i]; }
        const float rstd = 1.f / sqrtf(wave_sum(s2) * (1.f / D) + LN_EPS);
        float s3 = 0.f;
#pragma unroll
        for (int j = 0; j < 4; ++j) { const int c = 8 * lane + 512 * j; u32x4 o;
#pragma unroll
            for (int q = 0; q < 2; ++q) { const f32x4 gg = *(const LAS f32x4*)(vc + (2 * j + q) * 1024), bb = *(const LAS f32x4*)(vc + 8192 + (2 * j + q) * 1024);
#pragma unroll
                for (int e = 0; e < 4; ++e) { const float y = v[8 * j + 4 * q + e] * rstd * gg[e] + bb[e]; v[8 * j + 4 * q + e] = y; s3 += y; }
                o[2 * q] = pk2(v[8 * j + 4 * q], v[8 * j + 4 * q + 1]); o[2 * q + 1] = pk2(v[8 * j + 4 * q + 2], v[8 * j + 4 * q + 3]); }
            *(u32x4*)(F.X() + (size_t)t * D + c) = o; }
        const float mean2 = wave_sum(s3) * (1.f / D);
        float s4 = 0.f;
#pragma unroll
        for (int i = 0; i < 32; ++i) { v[i] -= mean2; s4 += v[i] * v[i]; }
        const float rstd2 = 1.f / sqrtf(wave_sum(s4) * (1.f / D) + LN_EPS);
#pragma unroll
        for (int j = 0; j < 4; ++j) { const int c = 8 * lane + 512 * j; u32x4 o;
#pragma unroll
            for (int q = 0; q < 2; ++q) { const f32x4 sh = *(const LAS f32x4*)(vc + (2 + mrl) * 8192 + (2 * j + q) * 1024), sc = *(const LAS f32x4*)(vc + (5 + mrl) * 8192 + (2 * j + q) * 1024);
                const float y0 = v[8 * j + 4 * q] * rstd2 * (1.f + sc[0]) + sh[0], y1 = v[8 * j + 4 * q + 1] * rstd2 * (1.f + sc[1]) + sh[1];
                const float y2 = v[8 * j + 4 * q + 2] * rstd2 * (1.f + sc[2]) + sh[2], y3 = v[8 * j + 4 * q + 3] * rstd2 * (1.f + sc[3]) + sh[3];
                o[2 * q] = pk2(y0, y1); o[2 * q + 1] = pk2(y2, y3); }
            *(u32x4*)(F.H() + (size_t)t * D + c) = o; }
#pragma unroll
        for (int j = 0; j < 4; ++j) { w[j] = wn[j]; yw[j] = yn[j]; }
        t = tn;
    }
}

__device__ __forceinline__ unsigned ordkey(float f) { const unsigned u = __float_as_uint(f); return u ^ ((u >> 31) ? 0xFFFFFFFFu : 0x80000000u); }
__device__ __forceinline__ float gelu_erf(float a) { return 0.5f * a * (1.f + erff(a * 0.70710678118654752f)); }

__device__ __forceinline__ float unordkey(unsigned k) { return __uint_as_float(k ^ ((k >> 31) ? 0x80000000u : 0xFFFFFFFFu)); }
__device__ __forceinline__ float gelu_as(float v) {
    const float av = fabsf(v), t = __builtin_amdgcn_rcpf(av * 0.2316418882f + 1.0f);
    float q = t * 0.5307027145f + (-0.7265760135f); q = q * t + 0.7107068705f; q = q * t + (-0.142248368f); q = q * t + 0.127414796f; q = q * t;
    const float e = __builtin_amdgcn_exp2f((v * v) * (-0.72134752044f));
    const float m = v * (q * e);
    return v < 0.f ? m : v - m;
}

template <class O> struct QuadNet {
    typedef typename O::V V; typedef typename O::B B;
    template <bool ASC> static __device__ __forceinline__ void ce_reg(V& a, V& b) { const V lo = O::vmin(a, b), hi = O::vmax(a, b); a = ASC ? lo : hi; b = ASC ? hi : lo; }
    template <bool ASC> static __device__ __forceinline__ void ce_l1(V& x, B low1) { const V p = O::x1(x); const V mn = O::vmin(p, x), mx = O::vmax(p, x); x = ASC ? O::vsel(low1, mn, mx) : O::vsel(low1, mx, mn); }
    template <bool ASC> static __device__ __forceinline__ void ce_l2(V& x, B low2) { const V p = O::x2(x); const V mn = O::vmin(p, x), mx = O::vmax(p, x); x = ASC ? O::vsel(low2, mn, mx) : O::vsel(low2, mx, mn); }
    template <int NR> static __device__ __forceinline__ void sort_blocks(V (&R)[NR], B low1, B low2, B eq12) {
#pragma unroll
        for (int r = 0; r < NR; ++r) { const V p = O::x1(R[r]); const V mn = O::vmin(p, R[r]), mx = O::vmax(p, R[r]); R[r] = O::vsel(eq12, mn, mx); }
#pragma unroll
        for (int r = 0; r < NR; ++r) { if ((r & 1) == 0) ce_l2<true>(R[r], low2); else ce_l2<false>(R[r], low2); }
#pragma unroll
        for (int r = 0; r < NR; ++r) { if ((r & 1) == 0) ce_l1<true>(R[r], low1); else ce_l1<false>(R[r], low1); }
#pragma unroll
        for (int r = 0; r < NR; r += 2) { if ((r & 2) == 0) ce_reg<true>(R[r], R[r + 1]); else ce_reg<false>(R[r], R[r + 1]); }
#pragma unroll
        for (int r = 0; r < NR; ++r) { if ((r & 2) == 0) ce_l2<true>(R[r], low2); else ce_l2<false>(R[r], low2); }
#pragma unroll
        for (int r = 0; r < NR; ++r) { if ((r & 2) == 0) ce_l1<true>(R[r], low1); else ce_l1<false>(R[r], low1); }
#pragma unroll
        for (int r = 0; r < NR; ++r) { if ((r & 2) == 0) { if ((r & 4) == 0) ce_reg<true>(R[r], R[r + 2]); else ce_reg<false>(R[r], R[r + 2]); } }
#pragma unroll
        for (int r = 0; r < NR; r += 2) { if ((r & 4) == 0) ce_reg<true>(R[r], R[r + 1]); else ce_reg<false>(R[r], R[r + 1]); }
#pragma unroll
        for (int r = 0; r < NR; ++r) { if ((r & 4) == 0) ce_l2<true>(R[r], low2); else ce_l2<false>(R[r], low2); }
#pragma unroll
        for (int r = 0; r < NR; ++r) { if ((r & 4) == 0) ce_l1<true>(R[r], low1); else ce_l1<false>(R[r], low1); }
    }
    template <int NR> static __device__ __forceinline__ void halve_merge(const V (&R)[NR], V (&Q)[NR / 2], B low1, B low2) {
#pragma unroll
        for (int m = 0; m < NR / 8; ++m)
#pragma unroll
            for (int i = 0; i < 4; ++i) Q[4 * m + i] = O::vmax(R[8 * m + i], R[8 * m + 4 + i]);
#pragma unroll
        for (int r = 0; r < NR / 2; ++r) { if ((r & 2) == 0) { if ((r & 4) == 0) ce_reg<false>(Q[r], Q[r + 2]); else ce_reg<true>(Q[r], Q[r + 2]); } }
#pragma unroll
        for (int r = 0; r < NR / 2; r += 2) { if ((r & 4) == 0) ce_reg<false>(Q[r], Q[r + 1]); else ce_reg<true>(Q[r], Q[r + 1]); }
#pragma unroll
        for (int r = 0; r < NR / 2; ++r) { if ((r & 4) == 0) ce_l2<false>(Q[r], low2); else ce_l2<true>(Q[r], low2); }
#pragma unroll
        for (int r = 0; r < NR / 2; ++r) { if ((r & 4) == 0) ce_l1<false>(Q[r], low1); else ce_l1<true>(Q[r], low1); }
    }
    static __device__ __forceinline__ void top16_of_128(V (&R)[32], V (&T)[4], B low1, B low2, B eq12) {
        sort_blocks<32>(R, low1, low2, eq12);
        V A[16]; halve_merge<32>(R, A, low1, low2);
        V Bq[8]; halve_merge<16>(A, Bq, low1, low2);
        halve_merge<8>(Bq, T, low1, low2);
    }
    static __device__ __forceinline__ void top16_of_64(V (&R)[16], V (&T)[4], B low1, B low2, B eq12) {
        sort_blocks<16>(R, low1, low2, eq12);
        V A[8]; halve_merge<16>(R, A, low1, low2);
        halve_merge<8>(A, T, low1, low2);
    }
};

struct DevOps {
    typedef unsigned V; typedef bool B;
    static __device__ __forceinline__ V vmin(V a, V b) { return a < b ? a : b; }
    static __device__ __forceinline__ V vmax(V a, V b) { return a > b ? a : b; }
    static __device__ __forceinline__ V vsel(B m, V a, V b) { return m ? a : b; }
    static __device__ __forceinline__ V x1(V a) { return (V)dpp_i<DPP_XOR1>((int)a); }
    static __device__ __forceinline__ V x2(V a) { return (V)dpp_i<DPP_XOR2>((int)a); }
};
__device__ __forceinline__ void stair_ab(int c, int& a, int& b) {
    if (c < 16) { a = 0; b = c; } else if (c < 24) { a = 1; b = c - 16; } else if (c < 28) { a = 2; b = c - 24; } else if (c < 32) { a = 3; b = c - 28; }
    else if (c < 36) { a = 4; b = c - 32; } else if (c < 40) { a = 5 + ((c - 36) >> 1); b = (c - 36) & 1; } else if (c < 44) { a = 7 + ((c - 40) >> 1); b = (c - 40) & 1; }
    else if (c < 48) { a = 9 + (c - 44); b = 0; } else if (c < 51) { a = 13 + (c - 48); b = 0; } else { a = 2; b = 4; }
}
constexpr int PE_WS = 5120, PE_TAB = 8 * PE_WS;
constexpr int PE_VEC = PE_TAB + 512;
static_assert(PE_VEC + 11 * 8192 <= LDSCTL_OFF, "PE vector cache");
__device__ __forceinline__ void peer_topk(Frame& F, LAS unsigned char* ws, int t) {
    const int lane = F.lane, sub = lane & 3;
    const bool low1 = (sub & 1) == 0, low2 = (sub & 2) == 0, eq12 = low1 == low2;
    LAS unsigned* S1K = (LAS unsigned*)ws; LAS int* EL = (LAS int*)(ws + 3328); LAS float* GL = (LAS float*)(ws + 3840);
    const LAS unsigned short* TAB = (const LAS unsigned short*)(F.lds + PE_TAB);
    {
        const int L = lane >> 2;
        const bf16_t* sp = F.SC() + (size_t)t * D + L * 128 + sub * 32;
        unsigned R[32];
#pragma unroll
        for (int q = 0; q < 4; ++q) { const u32x4 v = *(const u32x4*)(sp + 8 * q);
#pragma unroll
            for (int e = 0; e < 4; ++e) {
                R[8 * q + 2 * e] = (ordkey(bf_lo(v[e])) & ~127u) | (unsigned)(127 - (32 * sub + 8 * q + 2 * e));
                R[8 * q + 2 * e + 1] = (ordkey(bf_hi(v[e])) & ~127u) | (unsigned)(127 - (32 * sub + 8 * q + 2 * e + 1)); } }
        unsigned T[4];
        QuadNet<DevOps>::top16_of_128(R, T, low1, low2, eq12);
#pragma unroll
        for (int r = 0; r < 4; ++r) S1K[L * 16 + 4 * r + sub] = T[r];
    }
    LDS_WAIT(); __builtin_amdgcn_wave_barrier();
    {
        const int hd = (lane >> 2) & 7;
        const LAS unsigned char* la = (const LAS unsigned char*)(S1K + (2 * hd) * 16); const LAS unsigned char* lb = (const LAS unsigned char*)(S1K + (2 * hd + 1) * 16);
        unsigned C[16];
#pragma unroll
        for (int r = 0; r < 13; ++r) { const unsigned ab = TAB[4 * r + sub];
            const unsigned ka = *(const LAS unsigned*)(la + (ab & 255u)), kb = *(const LAS unsigned*)(lb + (ab >> 8));
            const float sum = unordkey(ka & ~127u) + unordkey(kb & ~127u);
            C[r] = (ordkey(sum) & ~63u) | (unsigned)(63 - (4 * r + sub)); }
        C[13] = 0u; C[14] = 0u; C[15] = 0u;
        unsigned W[4];
        QuadNet<DevOps>::top16_of_64(C, W, low1, low2, eq12);
        float sv[4]; int ex[4];
#pragma unroll
        for (int r = 0; r < 4; ++r) { const unsigned ab = TAB[63 - (W[r] & 63u)];
            const unsigned ka = *(const LAS unsigned*)(la + (ab & 255u)), kb = *(const LAS unsigned*)(lb + (ab >> 8));
            ex[r] = (int)(127u - (ka & 127u)) * 128 + (int)(127u - (kb & 127u)); sv[r] = unordkey(W[r] & ~63u); }
        const float mx = dpp_f<0x00>(sv[0]);
        float e4[4], es = 0.f;
#pragma unroll
        for (int r = 0; r < 4; ++r) { e4[r] = __expf(sv[r] - mx); es += e4[r]; }
        es += dpp_f<DPP_XOR1>(es); es += dpp_f<DPP_XOR2>(es);
        const float rd = 1.f / es;
#pragma unroll
        for (int r = 0; r < 4; ++r) { GL[hd * 16 + 4 * r + sub] = e4[r] * rd; EL[hd * 16 + 4 * r + sub] = ex[r]; }
    }
    LDS_WAIT(); __builtin_amdgcn_wave_barrier();
}

#ifndef PROBE_PHASE
#define PROBE_PHASE -1
#endif
#ifndef PROBE_MULT
#define PROBE_MULT 1
#endif
constexpr int EB = 4;
constexpr int CW_TICKET = 20480;

struct GBuf { LpRow<U_FMT> u[EB]; LpRow<V_FMT> v[EB]; };
__device__ __forceinline__ void gather_issue(GBuf& B, const LAS int* EL, int i0, const unsigned char* UTl, const unsigned char* VTl, int lane) {
#pragma unroll
    for (int q = 0; q < EB; ++q) {
        const int ex = __builtin_amdgcn_readfirstlane(EL[i0 + q]);
        B.u[q].load(UTl + (size_t)ex * UROW, lane); B.v[q].load(VTl + (size_t)ex * VROW, lane);
    }
}
__device__ __forceinline__ void gather_compute(const GBuf& B, const LAS int* EL, const LAS float* GL, int i0, const float* USl, const float* VSl, const unsigned (&hv)[16], f32x2 (&acc)[16]) {
    float dot[EB], su[EB], sv[EB], g[EB];
#pragma unroll
    for (int q = 0; q < EB; ++q) { const int ex = __builtin_amdgcn_readfirstlane(EL[i0 + q]); { const f32x2 s2 = *(const f32x2*)(USl + 2 * ex); su[q] = s2.x; sv[q] = s2.y; }
        g[q] = __uint_as_float(__builtin_amdgcn_readfirstlane(__float_as_uint(GL[i0 + q]))); }
#pragma unroll
    for (int q = 0; q < EB; ++q) { float s0 = 0.f, s1 = 0.f;
        B.u[q].each_bf([&](int i, bf16x2_t x) { if (i & 1) s1 = __builtin_amdgcn_fdot2_f32_bf16(x, __builtin_bit_cast(bf16x2_t, hv[i]), s1, false); else s0 = __builtin_amdgcn_fdot2_f32_bf16(x, __builtin_bit_cast(bf16x2_t, hv[i]), s0, false); });
        dot[q] = s0 + s1; __builtin_amdgcn_sched_barrier(0); }
#pragma unroll
    for (int q = 0; q < EB; ++q) dot[q] = wave_sum_u(dot[q]);
#pragma unroll
    for (int q = 0; q < EB; ++q) { const float cf = g[q] * gelu_as(dot[q] * su[q]) * sv[q]; const f32x2 c2 = {cf, cf};
        B.v[q].each([&](int i, float x0, float x1) { const f32x2 x = {x0, x1}; acc[i >> 1] = __builtin_elementwise_fma(x, c2, acc[i >> 1]); }); __builtin_amdgcn_sched_barrier(0); }
}

__device__ __forceinline__ void peer_phase(Frame& F, int layer, int rows, unsigned* ctl, unsigned long long& pr_acc) {
    unsigned long long pt0 = 0ull;
#define SUB_BEGIN(ty) do { if (PROBE_PHASE == (ty)) pt0 = __builtin_amdgcn_s_memrealtime(); } while (0)
#define SUB_END(ty) do { if (PROBE_PHASE == (ty)) pr_acc += __builtin_amdgcn_s_memrealtime() - pt0; } while (0)
    if (F.tid < 64) { int a = 0, b = 0; stair_ab(F.tid < 52 ? F.tid : 0, a, b); *(LAS unsigned short*)(F.lds + PE_TAB + 2 * F.tid) = (unsigned short)((4 * a) | ((4 * b) << 8)); }
    {
        const int ch = F.tid, ll = ch >> 3, q = ch & 7;
        LAS unsigned char* dst = F.lds + PE_VEC + (q * 64 + ll) * 16;
        const int nl = layer < NLAYER - 1 ? layer + 1 : layer;
#pragma unroll 1
        for (int v = 0; v < 9; ++v) {
            const int g3 = v / 3, mrv = v - 3 * g3;
            const size_t off = ((size_t)(g3 == 0 ? layer : nl) * 3 + mrv) * 12288 + (g3 == 0 ? 5 * D : (g3 == 1 ? 0 : D));
            *(LAS f32x4*)(dst + v * 8192) = *(const f32x4*)(F.MODS() + off + 4 * ch);
        }
        *(LAS f32x4*)(dst + 9 * 8192) = *(const f32x4*)(F.ln2_g() + layer * D + 4 * ch);
        *(LAS f32x4*)(dst + 10 * 8192) = *(const f32x4*)(F.ln2_b() + layer * D + 4 * ch);
    }
    __syncthreads();
    LAS unsigned char* ws = F.lds + F.wave * PE_WS;
    LAS int* EL = (LAS int*)(ws + 3328); LAS float* GL = (LAS float*)(ws + 3840);
    const int lane = F.lane;
    const LAS unsigned char* vcache = F.lds + PE_VEC + lane * 16;
    const unsigned char* UTl = F.UT() + (size_t)layer * NEXP * UROW;
    const unsigned char* VTl = F.VT() + (size_t)layer * NEXP * VROW;
    const float* USl = F.US() + 2 * (size_t)layer * NEXP; const float* VSl = nullptr;
    unsigned* ticket = ctl + CW_TICKET + 64 * layer;
    unsigned tk = 0u;
    if (lane == 0) tk = __hip_atomic_fetch_add(ticket, 1u, __ATOMIC_RELAXED, __HIP_MEMORY_SCOPE_AGENT);
    int t = (int)__builtin_amdgcn_readfirstlane(tk);
    while (t < rows) {
        unsigned tkn = 0u;
        if (lane == 0) tkn = __hip_atomic_fetch_add(ticket, 1u, __ATOMIC_RELAXED, __HIP_MEMORY_SCOPE_AGENT);
        SUB_BEGIN(8); peer_topk(F, ws, t); SUB_END(8);
        SUB_BEGIN(9);
        unsigned hv[16]; f32x2 acc[16];
#pragma unroll
        for (int q = 0; q < 4; ++q) { const u32x4 w = *(const u32x4*)(F.H() + (size_t)t * D + 32 * lane + 8 * q);
#pragma unroll
            for (int e = 0; e < 4; ++e) { hv[4 * q + e] = w[e]; acc[4 * q + e] = (f32x2){0.f, 0.f}; } }
        {
            GBuf A, B, C;
            gather_issue(A, EL, 0, UTl, VTl, lane);
            gather_issue(B, EL, EB, UTl, VTl, lane);
            for (int i0 = 0; i0 < 30 * EB; i0 += 3 * EB) {
                gather_issue(C, EL, i0 + 2 * EB, UTl, VTl, lane);
                gather_compute(A, EL, GL, i0, USl, VSl, hv, acc);
                gather_issue(A, EL, i0 + 3 * EB, UTl, VTl, lane);
                gather_compute(B, EL, GL, i0 + EB, USl, VSl, hv, acc);
                gather_issue(B, EL, i0 + 4 * EB, UTl, VTl, lane);
                gather_compute(C, EL, GL, i0 + 2 * EB, USl, VSl, hv, acc);
            }
            gather_compute(A, EL, GL, 30 * EB, USl, VSl, hv, acc);
            gather_compute(B, EL, GL, 31 * EB, USl, VSl, hv, acc);
        }
        SUB_END(9); SUB_BEGIN(10);
        const int mr = modrow(t);
        const float* mp = F.MODS() + ((size_t)layer * 3 + mr) * 12288;
        bf16_t* xr = F.X() + (size_t)t * D;
        float rr[32]; float s = 0.f;
#pragma unroll
        for (int q2 = 0; q2 < 4; ++q2) { const u32x4 xw = *(const u32x4*)(xr + 32 * lane + 8 * q2);
#pragma unroll
            for (int h2 = 0; h2 < 2; ++h2) { const int q = 2 * q2 + h2; const f32x4 gv = *(const LAS f32x4*)(vcache + mr * 8192 + q * 1024);
                const f32x4 xv = {bf_lo(xw[2 * h2]), bf_hi(xw[2 * h2]), bf_lo(xw[2 * h2 + 1]), bf_hi(xw[2 * h2 + 1])};
                const f32x4 av = {acc[2 * q].x, acc[2 * q].y, acc[2 * q + 1].x, acc[2 * q + 1].y};
#pragma unroll
                for (int e = 0; e < 4; ++e) { const float v = DN_ALPHA * xv[e] + gv[e] * av[e]; rr[4 * q + e] = v; s += v; } } }
        const float mean = wave_sum_u(s) * (1.f / D);
        float s2 = 0.f;
#pragma unroll
        for (int i = 0; i < 32; ++i) { rr[i] -= mean; s2 += rr[i] * rr[i]; }
        const float rstd = 1.f / sqrtf(wave_sum_u(s2) * (1.f / D) + LN_EPS);
        const float* g2 = F.ln2_g() + layer * D; const float* b2 = F.ln2_b() + layer * D;
        float s3 = 0.f;
#pragma unroll
        for (int q = 0; q < 8; ++q) { const int c = 32 * lane + 4 * q; const f32x4 gg = *(const LAS f32x4*)(vcache + 9 * 8192 + q * 1024), bb = *(const LAS f32x4*)(vcache + 10 * 8192 + q * 1024);
            f32x4 xo;
#pragma unroll
            for (int e = 0; e < 4; ++e) { xo[e] = rr[4 * q + e] * rstd * gg[e] + bb[e]; rr[4 * q + e] = xo[e]; s3 += xo[e]; }
            if (layer == NLAYER - 1 && t < TL) *(f32x4*)(F.out() + (size_t)t * D + c) = xo; }
        if (layer < NLAYER - 1) {
#pragma unroll
            for (int q2 = 0; q2 < 4; ++q2) { u32x4 o4; o4.x = pk2(rr[8 * q2], rr[8 * q2 + 1]); o4.y = pk2(rr[8 * q2 + 2], rr[8 * q2 + 3]); o4.z = pk2(rr[8 * q2 + 4], rr[8 * q2 + 5]); o4.w = pk2(rr[8 * q2 + 6], rr[8 * q2 + 7]);
                *(u32x4*)(xr + 32 * lane + 8 * q2) = o4; }
            const float mean2 = wave_sum_u(s3) * (1.f / D);
            float s4 = 0.f;
#pragma unroll
            for (int i = 0; i < 32; ++i) { rr[i] -= mean2; s4 += rr[i] * rr[i]; }
            const float rstd2 = 1.f / sqrtf(wave_sum_u(s4) * (1.f / D) + LN_EPS);
            const float* np = F.MODS() + ((size_t)(layer + 1) * 3 + mr) * 12288;
#pragma unroll
            for (int q4 = 0; q4 < 2; ++q4) { u32x4 w;
#pragma unroll
                for (int q = 0; q < 4; ++q) { const int qq = 4 * q4 + q; const f32x4 sh = *(const LAS f32x4*)(vcache + (3 + mr) * 8192 + qq * 1024), sc = *(const LAS f32x4*)(vcache + (6 + mr) * 8192 + qq * 1024); const int ri = 4 * qq;
                    const float y0 = rr[ri] * rstd2 * (1.f + sc[0]) + sh[0], y1 = rr[ri + 1] * rstd2 * (1.f + sc[1]) + sh[1];
                    const float y2 = rr[ri + 2] * rstd2 * (1.f + sc[2]) + sh[2], y3 = rr[ri + 3] * rstd2 * (1.f + sc[3]) + sh[3];
                    int o = __builtin_amdgcn_cvt_pk_fp8_f32(y0, y1, 0, false); o = __builtin_amdgcn_cvt_pk_fp8_f32(y2, y3, o, true); w[q] = (unsigned)o; }
                *(u32x4*)(F.H8() + (size_t)t * D + 32 * lane + 16 * q4) = w; }
        }
        SUB_END(10);
        t = (int)__builtin_amdgcn_readfirstlane(tkn);
    }
#undef SUB_BEGIN
#undef SUB_END
}

__global__ void __launch_bounds__(NWAVES * 64, 2) skel_fwd(Args args) {
    extern __shared__ __attribute__((aligned(16))) unsigned char lds[];
    Frame F;
    F.lds = (LAS unsigned char*)lds;
    F.tid = threadIdx.x; F.lane = F.tid & 63; F.wave = __builtin_amdgcn_readfirstlane(F.tid >> 6);
    F.G = gridDim.x; F.gw = blockIdx.x * NWAVES + F.wave; F.NGW = F.G * NWAVES;
    unsigned char* ws = args.ws;
    F.ka = (const CAS unsigned char*)__builtin_amdgcn_kernarg_segment_ptr();
    for (int u = F.tid; u < (LDS_BYTES - LDSCTL_OFF) / 4; u += NWAVES * 64) ((LAS unsigned*)(F.lds + LDSCTL_OFF))[u] = 0u;
    __syncthreads();
    unsigned* ctl = (unsigned*)(ws + WS_CTL);
    const int lo = args.ph_lo, hi = args.ph_hi;
    XcdBarrier bar; bar.bar = ctl + CW_BAR + args.li * XCD_BAR_WORDS; bar.x = 0; bar.st = nullptr;
    if (hi - lo > 1) bar = xcd_barrier_post(ctl + CW_BAR + args.li * XCD_BAR_WORDS, (volatile LAS unsigned*)(F.lds + MISC_OFF) + 8);
#define IN(k) (lo <= (k) && (k) < hi)
    unsigned long long pr_acc = 0ull, pr_t0 = 0ull;
#define PR_BEGIN(ty) do { if (PROBE_PHASE == (ty)) pr_t0 = __builtin_amdgcn_s_memrealtime(); } while (0)
#define PR_END(ty) do { if (PROBE_PHASE == (ty)) pr_acc += __builtin_amdgcn_s_memrealtime() - pr_t0; } while (0)
#define BOTH(k) (IN(k) && IN((k) + 1))
#define SEAM(k) do { if (BOTH(k)) xcd_barrier(bar); } while (0)

    if (IN(0)) { PR_BEGIN(0); frame_ids(F); p0a_prologue(F); SEAM(0); PR_END(0); }
    if (IN(1)) {
        PR_BEGIN(1); frame_ids(F);
        { pg8::Gemm g{F.KBD(), F.WQR(), 32 * 256, 2048, 256}; pg8::BatchOrder S{F.G, (int)blockIdx.x}; pg8::EpiBf16 E{F.WEFFT(), D, 1.f};
          pg8::gemm_phase<pg8::EpiBf16, pg8::BatchOrder, false, true>(F.lds, g, S, E); }
        p0b_mod0(F);
        SEAM(1); PR_END(1);
    }
    for (int layer = 0; layer < NLAYER; ++layer) {
        const int pb = 2 + 6 * layer;
        const bool lastl = layer == NLAYER - 1;
        const int rows = lastl ? TL : TT;
        if (IN(pb + 0)) {
            PR_BEGIN(2); frame_ids(F);
            pg8::Gemm g{(const bf16_t*)F.H8(), (const bf16_t*)(F.WINT() + (size_t)layer * INC * D), TT, INC, D / 2}; pg8::StaticOrder S; S.init(TT, 2 * INC, F.G, (int)blockIdx.x);
            pg8::EpiBf16H E{F.PROJ(), INC, 1.f / WIN_SCALE};
            pg8::gemm_phase<pg8::EpiBf16H, pg8::StaticOrder, false, true, true, true>(F.lds, g, S, E);
            SEAM(pb + 0); PR_END(2);
        }
        if (IN(pb + 1)) {
            PR_BEGIN(3); frame_ids(F);
            const int nunits = lastl ? 512 : 528;
            {
                const int ch = F.tid & 255, vsel = F.tid >> 8;
                LAS unsigned char* dst = F.lds + CONV_LDS + ((2 * (ch >> 7) + (ch & 1)) * 64 + ((ch & 127) >> 1)) * 16;
                *(LAS f32x4*)(dst + vsel * 4096) = *(const f32x4*)(F.conv_w() + (size_t)layer * 3 * 1024 + vsel * 1024 + 4 * ch);
                *(LAS f32x4*)(dst + (2 + vsel) * 4096) = vsel == 0 ? *(const f32x4*)(F.conv_w() + (size_t)layer * 3 * 1024 + 2048 + 4 * ch) : *(const f32x4*)(F.g_conv() + layer * 1024 + 4 * ch);
            }
            for (int i = F.tid; i < 192 * 32 * 2 / 4; i += NWAVES * 64) *(LAS f32x4*)(F.lds + ROPE_LDS + (i >> 4) * ROPE_RS + (i & 15) * 16) = *(const f32x4*)(F.ROPE() + 4 * i);
            __syncthreads();
            { unsigned long long q0 = 0; if (PROBE_PHASE == 11) q0 = __builtin_amdgcn_s_memrealtime();
            { const int bx = (int)blockIdx.x, vcu = (F.G % 8 == 0) ? (bx % 8) * (F.G / 8) + bx / 8 : bx;
              attn_units(F, layer, vcu, F.G, nunits); }
            if (PROBE_PHASE == 11) pr_acc += __builtin_amdgcn_s_memrealtime() - q0; if (PROBE_PHASE == 12) q0 = __builtin_amdgcn_s_memrealtime();
            {
              const int nx = nunits - 2 * F.G; const bool uneven = nx > 0 && nx < F.G;
              const int bx2 = (int)blockIdx.x, vc2 = (F.G % 8 == 0) ? (bx2 % 8) * (F.G / 8) + bx2 / 8 : bx2;
              const int c0 = uneven ? vc2 - nx : vc2, nb = uneven ? F.G - nx : F.G;
              if (c0 >= 0) { const int nwv = nb * NWAVES, chn = (rows + nwv - 1) / nwv, wi = c0 * NWAVES + F.wave;
                  conv_rows(F, layer, wi * chn, (wi + 1) * chn < rows ? (wi + 1) * chn : rows); } }
            if (PROBE_PHASE == 12) pr_acc += __builtin_amdgcn_s_memrealtime() - q0; }
            SEAM(pb + 1); PR_END(3);
        }
        if (IN(pb + 2)) {
            PR_BEGIN(4); frame_ids(F);
            pg8::Gemm g{(const bf16_t*)F.MIX(), (const bf16_t*)(F.WOUTT() + (size_t)layer * D * D), rows, D, D / 2}; pg8::StaticOrder S; S.init(rows, 2 * D, F.G, (int)blockIdx.x);
            pg8::EpiBf16H E{F.PROJ(), D, 1.f / WOUT_SCALE};
            pg8::gemm_phase<pg8::EpiBf16H, pg8::StaticOrder, false, true, true, true>(F.lds, g, S, E);
            frame_ids(F); convert_in_tail(F, layer, (rows / 256) * (D / 128), 0);
            SEAM(pb + 2); PR_END(4);
        }
        if (IN(pb + 3)) { PR_BEGIN(5); frame_ids(F); ln_phase(F, layer, rows); SEAM(pb + 3); PR_END(5); }
        if (IN(pb + 4)) {
            PR_BEGIN(6); frame_ids(F);
            pg8::Gemm g{F.H(), F.WEFFT() + (size_t)layer * D * D, rows, D, D}; pg8::StaticOrder S; S.init(rows, D, F.G, (int)blockIdx.x);
            pg8::EpiBf16 E{F.SC(), D, 1.f};
            pg8::gemm_phase<pg8::EpiBf16, pg8::StaticOrder, true, true>(F.lds, g, S, E);
            frame_ids(F); convert_in_tail(F, layer, (rows / 256) * (D / 256), 1);
            SEAM(pb + 4); PR_END(6);
        }
        if (IN(pb + 5)) { PR_BEGIN(7); frame_ids(F); peer_phase(F, layer, rows, ctl, pr_acc); SEAM(pb + 5); PR_END(7); }
    }
    if (PROBE_PHASE >= 0 && hi - lo > 1) xcd_barrier(bar);
    if (PROBE_PHASE >= 0 && blockIdx.x == 0 && threadIdx.x == 0) { const unsigned long long t1 = __builtin_amdgcn_s_memrealtime() + (unsigned long long)PROBE_MULT * pr_acc; while (__builtin_amdgcn_s_memrealtime() < t1) __builtin_amdgcn_s_sleep(8); }
#undef IN
#undef BOTH
#undef SEAM
}

extern "C" void kernel_launch(void* const* d_in, const int* in_sizes, int n_in, void* d_out, int out_size, void* d_ws, size_t ws_size, hipStream_t stream) {
    static int grid = 0;
    if (grid == 0) {
        if (n_in != 20 || in_sizes[0] != TL * D || out_size != TL * D || ws_size < WS_END) {
            fprintf(stderr, "kernel_launch: unexpected problem shape (n_in %d, in0 %d, out %d, ws %zu, need %zu)\n", n_in, n_in > 0 ? in_sizes[0] : -1, out_size, ws_size, (size_t)WS_END); grid = -1; return; }
        int dev = 0, cus = 0, per_cu = 0;
        if (hipGetDevice(&dev) != hipSuccess || hipDeviceGetAttribute(&cus, hipDeviceAttributeMultiprocessorCount, dev) != hipSuccess) { grid = -1; return; }
        if (hipFuncSetAttribute((const void*)skel_fwd, hipFuncAttributeMaxDynamicSharedMemorySize, LDS_BYTES) != hipSuccess) { fprintf(stderr, "kernel_launch: hipFuncSetAttribute failed\n"); grid = -1; return; }
        if (hipOccupancyMaxActiveBlocksPerMultiprocessor(&per_cu, (const void*)skel_fwd, NWAVES * 64, LDS_BYTES) != hipSuccess || per_cu < 1)
            fprintf(stderr, "kernel_launch: occupancy query reports %d workgroups per CU\n", per_cu);
        (void)hipGetLastError();
        grid = cus;
    }
    if (grid < 0) return;
    if (hipMemsetAsync((char*)d_ws + WS_CTL, 0, CTL_ZERO_BYTES, stream) != hipSuccess) return;
    Args a{};
    for (int i = 0; i < 20; ++i) a.in[i] = (const float*)d_in[i];
    a.out = (float*)d_out; a.ws = (unsigned char*)d_ws; a.pad = 0;
#if MK_N_LAUNCHES == 1
    a.ph_lo = 0; a.ph_hi = NPHASE; a.li = 0;
    hipLaunchKernelGGL(skel_fwd, dim3(grid), dim3(NWAVES * 64), LDS_BYTES, stream, a);
#else
    for (int ph = 0; ph < NPHASE; ++ph) { a.ph_lo = ph; a.ph_hi = ph + 1; a.li = 0;
        hipLaunchKernelGGL(skel_fwd, dim3(grid), dim3(NWAVES * 64), LDS_BYTES, stream, a); }
#endif
}
```

```cpp
#include <hip/hip_runtime.h>
#include <cstdio>
#include <cstdint>

#ifndef MK_N_LAUNCHES
#define MK_N_LAUNCHES 1
#endif

#define LAS __attribute__((address_space(3)))
typedef unsigned short bf16_t;
typedef short bf16x8 __attribute__((ext_vector_type(8)));
typedef short s16x4 __attribute__((ext_vector_type(4)));
typedef float f32x2 __attribute__((ext_vector_type(2)));
typedef float f32x4 __attribute__((ext_vector_type(4)));
typedef float f32x16 __attribute__((ext_vector_type(16)));
typedef unsigned u32x2 __attribute__((ext_vector_type(2)));
typedef unsigned u32x4 __attribute__((ext_vector_type(4)));
typedef __bf16 bf16x2_t __attribute__((ext_vector_type(2)));
typedef int i32x8 __attribute__((ext_vector_type(8)));

constexpr int D = 2048, NB = 2, SEQ = 8192, CTXL = 256, NLAYER = 4;
constexpr int TL = NB * SEQ, TC = NB * CTXL, TT = TL + TC;
constexpr int INC = 4608, OFF_C = 1024, OFF_X = 2048, OFF_Q = 3072, OFF_K = 4096, OFF_V = 4352;
constexpr float WOUT_SCALE = 128.f;
constexpr float WIN_SCALE = 64.f;
constexpr int NEXP = 16384;
#ifndef U_FMT
#define U_FMT 4
#endif
#ifndef V_FMT
#define V_FMT 4
#endif
constexpr int UROW = D * U_FMT / 8, VROW = D * V_FMT / 8;
constexpr float LN_EPS = 1e-6f;
constexpr float DN_ALPHA = 1.681792830507429f;
constexpr float QSCALE = 0.08838834764831845f * 1.4426950408889634f;
constexpr float LOG2E = 1.4426950408889634f;

constexpr size_t MiB = 1u << 20;
constexpr size_t WS_CTL = 0, CTL_ZERO_BYTES = 2 * MiB;
constexpr size_t WS_MODS = 1 * MiB;
constexpr size_t WS_ROPE = 2 * MiB;
constexpr size_t WS_KBD = 3 * MiB;
constexpr size_t WS_WQR = 8 * MiB;
constexpr size_t WS_WINT = 40 * MiB;
constexpr size_t WS_WOUTT = 112 * MiB;
constexpr size_t WS_WEFFT = 144 * MiB;
constexpr size_t WS_X = 176 * MiB;
constexpr size_t WS_H = 308 * MiB;
constexpr size_t WS_PROJ = 374 * MiB;
constexpr size_t WS_MIX = 523 * MiB;
constexpr size_t WS_SC = 589 * MiB;
constexpr size_t WS_UT = 721 * MiB;
constexpr size_t WS_VT = 849 * MiB;
constexpr size_t WS_US = 977 * MiB;
constexpr size_t WS_VS = 978 * MiB;
constexpr size_t WS_H8 = 979 * MiB;
constexpr size_t WS_END = 1013 * MiB;

constexpr int CW_BAR = 4096;

namespace pg8 {
constexpr int BM = 256, BK = 64, HALF = 128, HTB = HALF * BK * 2, STAGE_BYTES = 8 * HTB, NXCD = 8, WGM = 8;
__host__ __device__ __forceinline__ int lds_byte(int r, int c) { const int st = (r >> 4) * 2 + (c >> 5), rr = r & 15, cc = c & 31, ob = rr * 64 + cc * 2; return st * 1024 + (ob ^ (((ob >> 9) & 1) << 5)); }
__host__ __device__ __forceinline__ void stage_rc(int b, int& R, int& C) { const int st = b / 1024, sb = b % 1024, swz = sb ^ (((sb >> 9) & 1) << 5); R = (st >> 1) * 16 + swz / 64; C = (st & 1) * 32 + (swz % 64) / 2; }
__host__ __device__ __forceinline__ int lds_byte8(int r, int c) { const int st = (r >> 4) * 2 + (c >> 2); return st * 1024 + (((r & 15) * 64 + (c & 3) * 16) ^ (((r >> 3) & 1) << 4)); }
__host__ __device__ __forceinline__ void stage_rc8(int b, int& R, int& C) { const int st = b / 1024, sb = b % 1024, rr = sb / 64, cj = ((sb % 64) / 16) ^ ((rr >> 3) & 1); R = (st >> 1) * 16 + rr; C = ((st & 1) * 4 + cj) * 8; }
__host__ __device__ __forceinline__ int perm32(int rho) { const int n = rho >> 4, i = rho & 15; return 8 * (i >> 2) + 4 * n + (i & 3); }

struct Unit { int pm, pn; };
struct Gemm { const bf16_t* A; const bf16_t* Bt; int M, N, K; };

struct StaticOrder {
    int nM, nN, nwg, G, c;
    __host__ __device__ void init(int M, int N, int G_, int c_) { nM = M / BM; nN = N / BM; nwg = nM * nN; G = G_; c = c_; }
    __host__ __device__ bool next(int i, Unit& u) const {
        const long L = (long)i * G + c; if (L >= nwg) return false;
        int wgid = (int)L; { const int q = nwg / NXCD, r = nwg % NXCD, xcd = wgid % NXCD, off = wgid / NXCD; wgid = (xcd < r ? xcd * (q + 1) : r * (q + 1) + (xcd - r) * q) + off; }
        const int nig = WGM * nN, gid = wgid / nig, fm = gid * WGM, gsz = (nM - fm) < WGM ? (nM - fm) : WGM;
        u.pm = fm + ((wgid % nig) % gsz); u.pn = (wgid % nig) / gsz; return true;
    }
    __device__ __forceinline__ int btile(const Unit& u) const { return u.pn; }
    __device__ __forceinline__ void a_ready(const Unit&) const {}
    __device__ __forceinline__ void done(const Unit&) const {}
};
struct BatchOrder {
    int G, c;
    __device__ bool next(int i, Unit& u) const { const int L = i * G + c; if (L >= 256) return false; u.pm = L >> 3; u.pn = L & 7; return true; }
    __device__ __forceinline__ int btile(const Unit& u) const { return u.pm * 8 + u.pn; }
    __device__ __forceinline__ void a_ready(const Unit&) const {}
    __device__ __forceinline__ void done(const Unit&) const {}
};

__device__ __forceinline__ unsigned cvt_pk_bf16(float lo, float hi) { f32x2 x = {lo, hi}; bf16x2_t y = __builtin_convertvector(x, bf16x2_t); return __builtin_bit_cast(unsigned, y); }

struct EpiBf16 {
    static constexpr bool PERM = true;
    bf16_t* O; int ldc; float scale;
    __device__ __forceinline__ void operator()(const f32x4 (&acc)[2][2][4][2], const Unit& u, int wr, int wc, int fr, int fq) const {
        const int row0 = u.pm * BM + wr * 64 + fr, col0 = u.pn * BM + wc * 32 + 8 * fq;
#pragma unroll
        for (int ai = 0; ai < 2; ++ai)
#pragma unroll
            for (int m = 0; m < 4; ++m) { bf16_t* rowp = O + (size_t)(row0 + ai * HALF + m * 16) * ldc + col0;
#pragma unroll
                for (int bj = 0; bj < 2; ++bj) { const f32x4 v0 = acc[ai][bj][m][0] * scale, v1 = acc[ai][bj][m][1] * scale;
                    u32x4 w; w.x = cvt_pk_bf16(v0[0], v0[1]); w.y = cvt_pk_bf16(v0[2], v0[3]); w.z = cvt_pk_bf16(v1[0], v1[1]); w.w = cvt_pk_bf16(v1[2], v1[3]);
                    *(u32x4*)(rowp + bj * HALF) = w; } }
    }
};
struct EpiBf16H {
    static constexpr bool PERM = true;
    bf16_t* O; int ldc; float scale;
    __device__ __forceinline__ void operator()(const f32x4 (&acc)[2][2][4][2], const Unit& u, int wr, int wc, int fr, int fq) const {
        const int row0 = u.pm * BM + wr * 64 + fr, col0 = u.pn * HALF + wc * 32 + 8 * fq;
#pragma unroll
        for (int ai = 0; ai < 2; ++ai)
#pragma unroll
            for (int m = 0; m < 4; ++m) { const f32x4 v0 = acc[ai][0][m][0] * scale, v1 = acc[ai][0][m][1] * scale;
                u32x4 w; w.x = cvt_pk_bf16(v0[0], v0[1]); w.y = cvt_pk_bf16(v0[2], v0[3]); w.z = cvt_pk_bf16(v1[0], v1[1]); w.w = cvt_pk_bf16(v1[2], v1[3]);
                *(u32x4*)(O + (size_t)(row0 + ai * HALF + m * 16) * ldc + col0) = w; }
    }
};
struct EpiF32 {
    static constexpr bool PERM = false;
    float* C; int ldc;
    __device__ __forceinline__ void operator()(const f32x4 (&acc)[2][2][4][2], const Unit& u, int wr, int wc, int fr, int fq) const {
        const int row0 = u.pm * BM + wr * 64 + fr, col0 = u.pn * BM + wc * 32 + 4 * fq;
#pragma unroll
        for (int ai = 0; ai < 2; ++ai)
#pragma unroll
            for (int m = 0; m < 4; ++m) { float* rowp = C + (size_t)(row0 + ai * HALF + m * 16) * ldc + col0;
#pragma unroll
                for (int bj = 0; bj < 2; ++bj)
#pragma unroll
                    for (int n = 0; n < 2; ++n) *(f32x4*)(rowp + bj * HALF + n * 16) = acc[ai][bj][m][n]; }
    }
};
struct EpiResid {
    static constexpr bool PERM = true;
    const float* x32_lat; const float* x32_ctx;
    bf16_t* X; const float* gate;
    __device__ __forceinline__ void operator()(const f32x4 (&acc)[2][2][4][2], const Unit& u, int wr, int wc, int fr, int fq) const {
        const int rt = u.pm * BM;
        const int mr = rt < TL ? rt / SEQ : 2;
        const int row0 = rt + wr * 64 + fr, col0 = u.pn * BM + wc * 32 + 8 * fq;
        f32x4 gv[2][2];
#pragma unroll
        for (int bj = 0; bj < 2; ++bj)
#pragma unroll
            for (int n = 0; n < 2; ++n) gv[bj][n] = *(const f32x4*)(gate + (size_t)mr * 12288 + col0 + bj * HALF + 4 * n);
#pragma unroll
        for (int ai = 0; ai < 2; ++ai)
#pragma unroll
            for (int m = 0; m < 4; ++m) { const int row = row0 + ai * HALF + m * 16;
#pragma unroll
                for (int bj = 0; bj < 2; ++bj) {
                    f32x4 x0, x1;
                    if (x32_lat) { const float* xp = (row < TL ? x32_lat + (size_t)row * D : x32_ctx + (size_t)(row - TL) * D) + col0 + bj * HALF; x0 = *(const f32x4*)xp; x1 = *(const f32x4*)(xp + 4); }
                    else { const u32x4 w = *(const u32x4*)(X + (size_t)row * D + col0 + bj * HALF);
                        x0 = (f32x4){__uint_as_float(w.x << 16), __uint_as_float(w.x & 0xffff0000u), __uint_as_float(w.y << 16), __uint_as_float(w.y & 0xffff0000u)};
                        x1 = (f32x4){__uint_as_float(w.z << 16), __uint_as_float(w.z & 0xffff0000u), __uint_as_float(w.w << 16), __uint_as_float(w.w & 0xffff0000u)}; }
                    const f32x4 r0 = x0 * DN_ALPHA + gv[bj][0] * acc[ai][bj][m][0], r1 = x1 * DN_ALPHA + gv[bj][1] * acc[ai][bj][m][1];
                    u32x4 o; o.x = cvt_pk_bf16(r0[0], r0[1]); o.y = cvt_pk_bf16(r0[2], r0[3]); o.z = cvt_pk_bf16(r1[0], r1[1]); o.w = cvt_pk_bf16(r1[2], r1[3]);
                    *(u32x4*)(X + (size_t)row * D + col0 + bj * HALF) = o; } }
    }
};

template <class Epi, class Sched, bool ALIGN_EPI = false, bool SP2 = false, bool FP8 = false, bool HN = false, bool BR = false>
__device__ __forceinline__ void gemm_phase(LAS unsigned char* lds, const Gemm g, const Sched& S, const Epi& E) {
    int tid = threadIdx.x; asm volatile("" : "+v"(tid));
    const int wid = __builtin_amdgcn_readfirstlane(tid >> 6), lane = tid & 63, wr = wid >> 2, wc = wid & 3, fr = lane & 15, fq = lane >> 4;
    const int K = g.K, nt = K / BK;
    unsigned voffA[2], voffB[2];
#pragma unroll
    for (int i = 0; i < 2; ++i) { int R, C; if constexpr (FP8) stage_rc8(tid * 16 + i * 8192, R, C); else stage_rc(tid * 16 + i * 8192, R, C); const int Rb = Epi::PERM ? ((R & ~31) + perm32(R & 31)) : R;
        voffA[i] = (unsigned)(R * K + C) * 2u; voffB[i] = (unsigned)(Rb * K + C) * 2u; }
    const size_t kstep = (size_t)(BK * 2);
    const size_t hstep = (size_t)HALF * K * 2;
    const size_t tstep = 2 * hstep;
    const unsigned ldsw = (unsigned)wid * 1024u;
    const int aoff = lds_byte(wr * 64 + fr, fq * 8), boff = lds_byte(wc * 32 + fr, fq * 8);
    const int aoff8a = lds_byte8(wr * 64 + fr, 2 * fq), boff8a = lds_byte8(wc * 32 + fr, 2 * fq), aoff8b = aoff8a ^ 16, boff8b = boff8a ^ 16;
#define PG8_SA(b, h) (((b) * 2 + (h)) * HTB)
#define PG8_SB(b, h) ((4 + (b) * 2 + (h)) * HTB)
#define PG8_STAGE(bufoff, gbase, voff) do { _Pragma("unroll") for (int _i = 0; _i < 2; ++_i) \
        __builtin_amdgcn_global_load_lds((const unsigned*)((const char*)(gbase) + (voff)[_i]), (LAS unsigned*)(lds + (bufoff) + ldsw + _i * 8192), 16, 0, 0); } while (0)
#define PG8_LDA(dst, b, h) do { if constexpr (FP8) { _Pragma("unroll") for (int m = 0; m < 4; ++m) { const u32x4 _x = *(const LAS u32x4*)(lds + PG8_SA(b, h) + aoff8a + m * 2048), _y = *(const LAS u32x4*)(lds + PG8_SA(b, h) + aoff8b + m * 2048); \
            dst##8[m] = (i32x8){(int)_x.x, (int)_x.y, (int)_x.z, (int)_x.w, (int)_y.x, (int)_y.y, (int)_y.z, (int)_y.w}; } } \
        else { _Pragma("unroll") for (int m = 0; m < 4; ++m) _Pragma("unroll") for (int k = 0; k < 2; ++k) dst[m][k] = *(const LAS bf16x8*)(lds + PG8_SA(b, h) + aoff + m * 2048 + k * 1024); } } while (0)
#define PG8_LDB(dst, b, h) do { if constexpr (FP8) { _Pragma("unroll") for (int n = 0; n < 2; ++n) { const u32x4 _x = *(const LAS u32x4*)(lds + PG8_SB(b, h) + boff8a + n * 2048), _y = *(const LAS u32x4*)(lds + PG8_SB(b, h) + boff8b + n * 2048); \
            dst##8[n] = (i32x8){(int)_x.x, (int)_x.y, (int)_x.z, (int)_x.w, (int)_y.x, (int)_y.y, (int)_y.z, (int)_y.w}; } } \
        else { _Pragma("unroll") for (int n = 0; n < 2; ++n) _Pragma("unroll") for (int k = 0; k < 2; ++k) dst[n][k] = *(const LAS bf16x8*)(lds + PG8_SB(b, h) + boff + n * 2048 + k * 1024); } } while (0)
#define PG8_MMA(ai, bj, At, Bt) do { __builtin_amdgcn_s_setprio(1); if constexpr (FP8) { _Pragma("unroll") for (int m = 0; m < 4; ++m) _Pragma("unroll") for (int n = 0; n < 2; ++n) \
            acc[ai][bj][m][n] = __builtin_amdgcn_mfma_scale_f32_16x16x128_f8f6f4(Bt##8[n], At##8[m], acc[ai][bj][m][n], 0, 0, 0, 0x7F7F7F7F, 0, 0x7F7F7F7F); } \
        else { _Pragma("unroll") for (int m = 0; m < 4; ++m) _Pragma("unroll") for (int n = 0; n < 2; ++n) _Pragma("unroll") for (int k = 0; k < 2; ++k) \
            acc[ai][bj][m][n] = __builtin_amdgcn_mfma_f32_16x16x32_bf16(Bt[n][k], At[m][k], acc[ai][bj][m][n], 0, 0, 0); } __builtin_amdgcn_s_setprio(0); } while (0)
#define PG8_WAIT_V(n) asm volatile("s_waitcnt vmcnt(" #n ")" ::: "memory")
#define PG8_WAIT_L(n) asm volatile("s_waitcnt lgkmcnt(" #n ")" ::: "memory")
#define PG8_BAR __builtin_amdgcn_s_barrier()
#define PG8_SCHED __builtin_amdgcn_sched_barrier(0)
    Unit cur, nxt; int ui = 0;
    if (!S.next(0, cur)) return;
    f32x4 acc[2][2][4][2];
#pragma unroll
    for (int a = 0; a < 2; ++a)
#pragma unroll
        for (int b = 0; b < 2; ++b)
#pragma unroll
            for (int m = 0; m < 4; ++m)
#pragma unroll
                for (int n = 0; n < 2; ++n) acc[a][b][m][n] = (f32x4){0.f, 0.f, 0.f, 0.f};
    bf16x8 At[4][2], B0[2][2], B1[2][2];
    i32x8 At8[4], B08[2], B18[2];
    const size_t bstep = HN ? hstep : tstep;
    const char* cA = (const char*)g.A + (size_t)cur.pm * tstep; const char* cB = (const char*)g.Bt + (size_t)S.btile(cur) * bstep;
    S.a_ready(cur);
    if constexpr (BR) {
        static_assert(!BR || (FP8 && !HN && !SP2), "BR is an fp8 256x256 variant");
        PG8_STAGE(PG8_SB(0, 0), cB, voffB); PG8_STAGE(PG8_SA(0, 0), cA, voffA); PG8_STAGE(PG8_SB(0, 1), cB + hstep, voffB); PG8_STAGE(PG8_SA(0, 1), cA + hstep, voffA);
        if (wr == 1) PG8_BAR;
        PG8_WAIT_V(4); PG8_BAR;
        PG8_STAGE(PG8_SA(1, 0), cA + kstep, voffA); PG8_STAGE(PG8_SB(1, 1), cB + hstep + kstep, voffB); PG8_STAGE(PG8_SA(1, 1), cA + hstep + kstep, voffA);
        PG8_WAIT_V(6); PG8_BAR;
    } else if constexpr (HN) {
        static_assert(!HN || SP2, "HN needs the SP2 loop");
        PG8_STAGE(PG8_SB(0, 0), cB, voffB); PG8_STAGE(PG8_SA(0, 0), cA, voffA); PG8_STAGE(PG8_SA(0, 1), cA + hstep, voffA);
        if (wr == 1) PG8_BAR;
        PG8_WAIT_V(2); PG8_BAR;
        PG8_STAGE(PG8_SB(1, 0), cB + kstep, voffB); PG8_STAGE(PG8_SA(1, 0), cA + kstep, voffA);
        PG8_WAIT_V(4); PG8_BAR;
    } else if constexpr (SP2) {
        PG8_STAGE(PG8_SB(0, 0), cB, voffB); PG8_STAGE(PG8_SB(0, 1), cB + hstep, voffB); PG8_STAGE(PG8_SA(0, 0), cA, voffA); PG8_STAGE(PG8_SA(0, 1), cA + hstep, voffA);
        if (wr == 1) PG8_BAR;
        PG8_WAIT_V(2); PG8_BAR;
        PG8_STAGE(PG8_SB(1, 0), cB + kstep, voffB); PG8_STAGE(PG8_SA(1, 0), cA + kstep, voffA); PG8_STAGE(PG8_SB(1, 1), cB + hstep + kstep, voffB);
        PG8_WAIT_V(6); PG8_BAR;
    } else {
        PG8_STAGE(PG8_SB(0, 0), cB, voffB); PG8_STAGE(PG8_SA(0, 0), cA, voffA); PG8_STAGE(PG8_SB(0, 1), cB + hstep, voffB); PG8_STAGE(PG8_SA(0, 1), cA + hstep, voffA);
        if (wr == 1) PG8_BAR;
        PG8_WAIT_V(4); PG8_BAR;
        PG8_STAGE(PG8_SB(1, 0), cB + kstep, voffB); PG8_STAGE(PG8_SA(1, 0), cA + kstep, voffA); PG8_STAGE(PG8_SB(1, 1), cB + hstep + kstep, voffB);
        PG8_WAIT_V(6); PG8_BAR;
    }
    for (;;) {
        const bool has_next = S.next(ui + 1, nxt);
        const char* nA = has_next ? (const char*)g.A + (size_t)nxt.pm * tstep : cA; const char* nB = has_next ? (const char*)g.Bt + (size_t)S.btile(nxt) * bstep : cB;
        for (int t = 0; t < nt; t += 2) {
            const bool last = (t == nt - 2);
            const char* a1 = cA + (size_t)(t + 1) * kstep; const char* b1 = cB + (size_t)(t + 1) * kstep;
            const char* a2 = last ? nA : cA + (size_t)(t + 2) * kstep; const char* b2 = last ? nB : cB + (size_t)(t + 2) * kstep;
            const char* a3 = a2 + kstep; const char* b3 = b2 + kstep;
            if (last && has_next) S.a_ready(nxt);
            if constexpr (BR) {
            PG8_LDB(B0, 0, 0); PG8_SCHED; PG8_LDA(At, 0, 0); PG8_STAGE(PG8_SB(1, 0), b1, voffB);
            PG8_WAIT_V(6); PG8_WAIT_L(0); PG8_BAR; PG8_MMA(0, 0, At, B0); PG8_BAR; PG8_SCHED;
            PG8_LDB(B0, 0, 1); PG8_STAGE(PG8_SA(0, 0), a2, voffA);
            PG8_WAIT_V(6); PG8_WAIT_L(0); PG8_BAR; PG8_MMA(0, 1, At, B0); PG8_BAR; PG8_SCHED;
            PG8_LDA(At, 0, 1); PG8_STAGE(PG8_SB(0, 1), b2 + hstep, voffB);
            PG8_WAIT_V(6); PG8_WAIT_L(0); PG8_BAR; PG8_MMA(1, 1, At, B0); PG8_BAR; PG8_SCHED;
            PG8_LDB(B0, 0, 0); PG8_STAGE(PG8_SA(0, 1), a2 + hstep, voffA);
            PG8_WAIT_V(6); PG8_WAIT_L(0); PG8_BAR; PG8_MMA(1, 0, At, B0); PG8_BAR; PG8_SCHED;
            PG8_LDB(B0, 1, 0); PG8_SCHED; PG8_LDA(At, 1, 0); PG8_STAGE(PG8_SB(0, 0), b2, voffB);
            PG8_WAIT_V(6); PG8_WAIT_L(0); PG8_BAR; PG8_MMA(0, 0, At, B0); PG8_BAR; PG8_SCHED;
            PG8_LDB(B0, 1, 1); PG8_STAGE(PG8_SA(1, 0), a3, voffA);
            PG8_WAIT_V(6); PG8_WAIT_L(0); PG8_BAR; PG8_MMA(0, 1, At, B0); PG8_BAR; PG8_SCHED;
            PG8_LDA(At, 1, 1); PG8_STAGE(PG8_SB(1, 1), b3 + hstep, voffB);
            PG8_WAIT_V(6); PG8_WAIT_L(0); PG8_BAR; PG8_MMA(1, 1, At, B0); PG8_BAR; PG8_SCHED;
            PG8_LDB(B0, 1, 0); PG8_STAGE(PG8_SA(1, 1), a3 + hstep, voffA);
            PG8_WAIT_V(6); PG8_WAIT_L(0); PG8_BAR; PG8_MMA(1, 0, At, B0); PG8_BAR; PG8_SCHED;
            } else if constexpr (HN) {
            PG8_LDB(B0, 0, 0); PG8_SCHED; PG8_LDA(At, 0, 0); PG8_STAGE(PG8_SA(1, 1), a1 + hstep, voffA);
            PG8_WAIT_V(6); PG8_WAIT_L(0); PG8_BAR; PG8_MMA(0, 0, At, B0); PG8_BAR; PG8_SCHED;
            PG8_LDA(At, 0, 1); PG8_STAGE(PG8_SB(0, 0), b2, voffB); PG8_STAGE(PG8_SA(0, 0), a2, voffA);
            PG8_WAIT_V(6); PG8_WAIT_L(0); PG8_BAR; PG8_MMA(1, 0, At, B0); PG8_BAR; PG8_SCHED;
            PG8_LDB(B0, 1, 0); PG8_SCHED; PG8_LDA(At, 1, 0); PG8_STAGE(PG8_SA(0, 1), a2 + hstep, voffA);
            PG8_WAIT_V(6); PG8_WAIT_L(0); PG8_BAR; PG8_MMA(0, 0, At, B0); PG8_BAR; PG8_SCHED;
            PG8_LDA(At, 1, 1); PG8_STAGE(PG8_SB(1, 0), b3, voffB); PG8_STAGE(PG8_SA(1, 0), a3, voffA);
            PG8_WAIT_V(6); PG8_WAIT_L(0); PG8_BAR; PG8_MMA(1, 0, At, B0); PG8_BAR; PG8_SCHED;
            } else if constexpr (SP2) {
            PG8_LDB(B0, 0, 0); PG8_LDB(B1, 0, 1); PG8_SCHED; PG8_LDA(At, 0, 0); PG8_STAGE(PG8_SA(1, 1), a1 + hstep, voffA);
            PG8_WAIT_V(8); PG8_WAIT_L(0); PG8_BAR; PG8_MMA(0, 0, At, B0); PG8_MMA(0, 1, At, B1); PG8_BAR; PG8_SCHED;
            PG8_LDA(At, 0, 1); PG8_STAGE(PG8_SB(0, 0), b2, voffB); PG8_STAGE(PG8_SB(0, 1), b2 + hstep, voffB); PG8_STAGE(PG8_SA(0, 0), a2, voffA);
            PG8_WAIT_V(8); PG8_WAIT_L(0); PG8_BAR; PG8_MMA(1, 0, At, B0); PG8_MMA(1, 1, At, B1); PG8_BAR; PG8_SCHED;
            PG8_LDB(B0, 1, 0); PG8_LDB(B1, 1, 1); PG8_SCHED; PG8_LDA(At, 1, 0); PG8_STAGE(PG8_SA(0, 1), a2 + hstep, voffA);
            PG8_WAIT_V(8); PG8_WAIT_L(0); PG8_BAR; PG8_MMA(0, 0, At, B0); PG8_MMA(0, 1, At, B1); PG8_BAR; PG8_SCHED;
            PG8_LDA(At, 1, 1); PG8_STAGE(PG8_SB(1, 0), b3, voffB); PG8_STAGE(PG8_SB(1, 1), b3 + hstep, voffB); PG8_STAGE(PG8_SA(1, 0), a3, voffA);
            PG8_WAIT_V(8); PG8_WAIT_L(0); PG8_BAR; PG8_MMA(1, 0, At, B0); PG8_MMA(1, 1, At, B1); PG8_BAR; PG8_SCHED;
            } else {
            PG8_LDB(B0, 0, 0); PG8_SCHED; PG8_LDA(At, 0, 0); PG8_STAGE(PG8_SA(1, 1), a1 + hstep, voffA);
            PG8_WAIT_L(8); PG8_BAR; PG8_WAIT_L(0); PG8_MMA(0, 0, At, B0); PG8_BAR; PG8_SCHED;
            PG8_LDB(B1, 0, 1); PG8_STAGE(PG8_SB(0, 0), b2, voffB);
            PG8_BAR; PG8_WAIT_L(0); PG8_MMA(0, 1, At, B1); PG8_BAR;
            PG8_LDA(At, 0, 1); PG8_STAGE(PG8_SA(0, 0), a2, voffA);
            PG8_BAR; PG8_WAIT_L(0); PG8_MMA(1, 0, At, B0); PG8_BAR; PG8_SCHED;
            PG8_STAGE(PG8_SB(0, 1), b2 + hstep, voffB);
            PG8_WAIT_V(6); PG8_BAR; PG8_MMA(1, 1, At, B1); PG8_BAR;
            PG8_LDB(B0, 1, 0); PG8_SCHED; PG8_LDA(At, 1, 0); PG8_STAGE(PG8_SA(0, 1), a2 + hstep, voffA);
            PG8_WAIT_L(8); PG8_BAR; PG8_WAIT_L(0); PG8_MMA(0, 0, At, B0); PG8_BAR; PG8_SCHED;
            PG8_LDB(B1, 1, 1); PG8_STAGE(PG8_SB(1, 0), b3, voffB);
            PG8_BAR; PG8_WAIT_L(0); PG8_MMA(0, 1, At, B1); PG8_BAR;
            PG8_LDA(At, 1, 1); PG8_STAGE(PG8_SA(1, 0), a3, voffA);
            PG8_BAR; PG8_WAIT_L(0); PG8_MMA(1, 0, At, B0); PG8_BAR; PG8_SCHED;
            PG8_STAGE(PG8_SB(1, 1), b3 + hstep, voffB);
            PG8_WAIT_V(6); PG8_BAR; PG8_MMA(1, 1, At, B1); PG8_BAR;
            }
        }
        if constexpr (ALIGN_EPI) { if (wr == 0) PG8_BAR; }
        E(acc, cur, wr, wc, fr, fq); S.done(cur);
        if (!has_next) break;
#pragma unroll
        for (int a = 0; a < 2; ++a)
#pragma unroll
            for (int b = 0; b < 2; ++b)
#pragma unroll
                for (int m = 0; m < 4; ++m)
#pragma unroll
                    for (int n = 0; n < 2; ++n) acc[a][b][m][n] = (f32x4){0.f, 0.f, 0.f, 0.f};
        cur = nxt; cA = nA; cB = nB; ++ui;
        if constexpr (ALIGN_EPI) { if (wr == 1) PG8_BAR; }
    }
    PG8_WAIT_V(0);
    if constexpr (!ALIGN_EPI) { if (wr == 0) PG8_BAR; }
    PG8_BAR;
#undef PG8_SA
#undef PG8_SB
#undef PG8_STAGE
#undef PG8_LDA
#undef PG8_LDB
#undef PG8_MMA
#undef PG8_WAIT_V
#undef PG8_WAIT_L
#undef PG8_BAR
#undef PG8_SCHED
}
}

#define XB_TMO      128
#define XB_XCNT(j)  (256  + 64 * (j))
#define XB_XSUB(j)  (1280 + 64 * (j))
#define XB_XGEN(j)  (2304 + 64 * (j))
#define XB_TOP      3328
#define XB_TOPGEN   3392
#define XCD_BAR_WORDS 3456
#define XB_SPIN_CAP (1u << 18)

__device__ __forceinline__ unsigned xb_ld(unsigned* p)              { return __hip_atomic_load(p, __ATOMIC_RELAXED, __HIP_MEMORY_SCOPE_AGENT); }
__device__ __forceinline__ unsigned xb_add(unsigned* p, unsigned v) { return __hip_atomic_fetch_add(p, v, __ATOMIC_RELAXED, __HIP_MEMORY_SCOPE_AGENT); }
__device__ __forceinline__ unsigned xb_xcc_id() { return (unsigned)__builtin_amdgcn_s_getreg((3 << 11) | 20) & 0xFu; }
#define XB_SPIN(cond, bar) do { unsigned _sp = 0; while (cond) { __builtin_amdgcn_s_sleep(1); \
    if ((++_sp & 255u) == 0u) { if (xb_ld(&(bar)[XB_TMO])) break; if (_sp > XB_SPIN_CAP) { atomicAdd(&(bar)[XB_TMO], 1u); break; } } } } while (0)

struct XcdBarrier { unsigned* bar; unsigned x; volatile LAS unsigned* st; };

__device__ __forceinline__ XcdBarrier xcd_barrier_post(unsigned* bar, volatile LAS unsigned* st) {
    XcdBarrier b; b.bar = bar; b.x = xb_xcc_id(); b.st = st;
    if (threadIdx.x == 0) (void)xb_add(&bar[XB_XCNT(b.x)], 1u);
    return b;
}
__device__ __forceinline__ void xcd_barrier_complete(unsigned* bar, unsigned x, unsigned& nloc, unsigned& nx) {
    const unsigned G = gridDim.x * gridDim.y * gridDim.z;
    unsigned sum, cnt, mine, sp = 0u;
    for (;;) {
        sum = 0u; cnt = 0u; mine = 0u;
#pragma unroll
        for (unsigned j = 0; j < 16; ++j) { const unsigned c = xb_ld(&bar[XB_XCNT(j)]); sum += c; cnt += (c > 0u) ? 1u : 0u; mine = (j == x) ? c : mine; }
        if (sum == G) break;
        __builtin_amdgcn_s_sleep(1);
        if ((++sp & 255u) == 0u) { if (xb_ld(&bar[XB_TMO])) break; if (sp > XB_SPIN_CAP) { atomicAdd(&bar[XB_TMO], 1u); break; } }
    }
    nloc = mine > 0u ? mine : 1u; nx = cnt > 0u ? cnt : 1u;
}
__device__ __forceinline__ void xcd_barrier(const XcdBarrier& b) {
    asm volatile("s_waitcnt vmcnt(0)" ::: "memory");
    __syncthreads();
    if (threadIdx.x == 0) {
        unsigned* bar = b.bar;
        __builtin_amdgcn_s_waitcnt(0);
        unsigned nloc = b.st[0], nx = b.st[1];
        if (nloc == 0u) { xcd_barrier_complete(bar, b.x, nloc, nx); b.st[0] = nloc; b.st[1] = nx; }
        const unsigned old = xb_add(&bar[XB_XSUB(b.x)], 1u);
        const unsigned gen = old / nloc;
        if (old + 1u == (gen + 1u) * nloc) {
            __builtin_amdgcn_fence(__ATOMIC_RELEASE, "agent");
            asm volatile("s_waitcnt vmcnt(0)" ::: "memory");
            const unsigned og = xb_add(&bar[XB_TOP], 1u);
            const unsigned tg = og / nx;
            if (og + 1u == (tg + 1u) * nx) xb_add(&bar[XB_TOPGEN], 1u);
            else XB_SPIN(xb_ld(&bar[XB_TOPGEN]) == tg, bar);
            __builtin_amdgcn_fence(__ATOMIC_ACQUIRE, "agent");
            xb_add(&bar[XB_XGEN(b.x)], 1u);
            asm volatile("s_waitcnt vmcnt(0)" ::: "memory");
        } else {
            XB_SPIN(xb_ld(&bar[XB_XGEN(b.x)]) == gen, bar);
            __builtin_amdgcn_fence(__ATOMIC_ACQUIRE, "agent");
            asm volatile("s_waitcnt vmcnt(0)" ::: "memory");
        }
    }
    __syncthreads();
}

constexpr int NWAVES = 8;
constexpr int LDS_BYTES = 163840;
constexpr int LDSCTL_OFF = LDS_BYTES - 512, MISC_OFF = LDSCTL_OFF + 320;
constexpr int NPHASE = 2 + 6 * NLAYER;

#define LDS_WAIT() asm volatile("s_waitcnt lgkmcnt(0)" ::: "memory")

struct Args { const float* in[20]; float* out; unsigned char* ws; int ph_lo, ph_hi, li, pad; };

#define CAS __attribute__((address_space(4)))
struct Frame {
    LAS unsigned char* lds;
    int tid, lane, wave, G, gw, NGW;
    const CAS unsigned char* ka;
    __device__ __forceinline__ const float* x() const { return *(const float* const CAS*)(ka + 0); }
    __device__ __forceinline__ const float* c() const { return *(const float* const CAS*)(ka + 8); }
    __device__ __forceinline__ const float* ctx() const { return *(const float* const CAS*)(ka + 16); }
    __device__ __forceinline__ const float* c_ctx() const { return *(const float* const CAS*)(ka + 24); }
    __device__ __forceinline__ const float* w_ada() const { return *(const float* const CAS*)(ka + 32); }
    __device__ __forceinline__ const float* b_ada() const { return *(const float* const CAS*)(ka + 40); }
    __device__ __forceinline__ const float* w_in() const { return *(const float* const CAS*)(ka + 48); }
    __device__ __forceinline__ const float* conv_w() const { return *(const float* const CAS*)(ka + 56); }
    __device__ __forceinline__ const float* sink() const { return *(const float* const CAS*)(ka + 64); }
    __device__ __forceinline__ const float* g_attn() const { return *(const float* const CAS*)(ka + 72); }
    __device__ __forceinline__ const float* g_conv() const { return *(const float* const CAS*)(ka + 80); }
    __device__ __forceinline__ const float* w_out() const { return *(const float* const CAS*)(ka + 88); }
    __device__ __forceinline__ const float* ln1_g() const { return *(const float* const CAS*)(ka + 96); }
    __device__ __forceinline__ const float* ln1_b() const { return *(const float* const CAS*)(ka + 104); }
    __device__ __forceinline__ const float* wq() const { return *(const float* const CAS*)(ka + 112); }
    __device__ __forceinline__ const float* keys() const { return *(const float* const CAS*)(ka + 120); }
    __device__ __forceinline__ const float* pu() const { return *(const float* const CAS*)(ka + 128); }
    __device__ __forceinline__ const float* pv() const { return *(const float* const CAS*)(ka + 136); }
    __device__ __forceinline__ const float* ln2_g() const { return *(const float* const CAS*)(ka + 144); }
    __device__ __forceinline__ const float* ln2_b() const { return *(const float* const CAS*)(ka + 152); }
    __device__ __forceinline__ float* out() const { return *(float* const CAS*)(ka + 160); }
    __device__ __forceinline__ unsigned char* ws() const { return *(unsigned char* const CAS*)(ka + 168); }
    __device__ __forceinline__ float* MODS() const { return (float*)(ws() + WS_MODS); }
    __device__ __forceinline__ float* ROPE() const { return (float*)(ws() + WS_ROPE); }
    __device__ __forceinline__ bf16_t* X() const { return (bf16_t*)(ws() + WS_X); }
    __device__ __forceinline__ bf16_t* SC() const { return (bf16_t*)(ws() + WS_SC); }
    __device__ __forceinline__ bf16_t* KBD() const { return (bf16_t*)(ws() + WS_KBD); }
    __device__ __forceinline__ bf16_t* WQR() const { return (bf16_t*)(ws() + WS_WQR); }
    __device__ __forceinline__ unsigned char* WINT() const { return ws() + WS_WINT; }
    __device__ __forceinline__ unsigned char* H8() const { return ws() + WS_H8; }
    __device__ __forceinline__ unsigned char* WOUTT() const { return ws() + WS_WOUTT; }
    __device__ __forceinline__ bf16_t* WEFFT() const { return (bf16_t*)(ws() + WS_WEFFT); }
    __device__ __forceinline__ bf16_t* H() const { return (bf16_t*)(ws() + WS_H); }
    __device__ __forceinline__ bf16_t* PROJ() const { return (bf16_t*)(ws() + WS_PROJ); }
    __device__ __forceinline__ unsigned char* MIX() const { return ws() + WS_MIX; }
    __device__ __forceinline__ unsigned char* UT() const { return (unsigned char*)(ws() + WS_UT); }
    __device__ __forceinline__ unsigned char* VT() const { return (unsigned char*)(ws() + WS_VT); }
    __device__ __forceinline__ float* US() const { return (float*)(ws() + WS_US); }
    __device__ __forceinline__ float* VS() const { return (float*)(ws() + WS_VS); }
};

__device__ __forceinline__ void frame_ids(Frame& F) {
    int tz = threadIdx.x; asm volatile("" : "+v"(tz));
    F.tid = tz; F.lane = tz & 63; F.wave = __builtin_amdgcn_readfirstlane(tz >> 6);
    F.gw = blockIdx.x * NWAVES + F.wave;
    const CAS unsigned char* k = (const CAS unsigned char*)__builtin_amdgcn_kernarg_segment_ptr(); asm volatile("" : "+s"(k)); F.ka = k;
}
template <int CTRL> __device__ __forceinline__ int dpp_i(int v) { return __builtin_amdgcn_update_dpp(0, v, CTRL, 0xf, 0xf, true); }
template <int CTRL> __device__ __forceinline__ float dpp_f(float v) { return __int_as_float(dpp_i<CTRL>(__float_as_int(v))); }
constexpr int DPP_XOR1 = 0xB1, DPP_XOR2 = 0x4E, DPP_HMIRROR = 0x141, DPP_ROR4 = 0x124, DPP_ROR8 = 0x128;
__device__ __forceinline__ float wave_sum_u(float v) {
    v += dpp_f<DPP_XOR1>(v); v += dpp_f<DPP_XOR2>(v); v += dpp_f<DPP_ROR4>(v); v += dpp_f<DPP_ROR8>(v);
    const float r0 = __int_as_float(__builtin_amdgcn_readlane(__float_as_int(v), 0)), r1 = __int_as_float(__builtin_amdgcn_readlane(__float_as_int(v), 16));
    const float r2 = __int_as_float(__builtin_amdgcn_readlane(__float_as_int(v), 32)), r3 = __int_as_float(__builtin_amdgcn_readlane(__float_as_int(v), 48));
    return (r0 + r1) + (r2 + r3);
}
__device__ __forceinline__ float wave_max_u(float v) {
    v = fmaxf(v, dpp_f<DPP_XOR1>(v)); v = fmaxf(v, dpp_f<DPP_XOR2>(v)); v = fmaxf(v, dpp_f<DPP_ROR4>(v)); v = fmaxf(v, dpp_f<DPP_ROR8>(v));
    const float r0 = __int_as_float(__builtin_amdgcn_readlane(__float_as_int(v), 0)), r1 = __int_as_float(__builtin_amdgcn_readlane(__float_as_int(v), 16));
    const float r2 = __int_as_float(__builtin_amdgcn_readlane(__float_as_int(v), 32)), r3 = __int_as_float(__builtin_amdgcn_readlane(__float_as_int(v), 48));
    return fmaxf(fmaxf(r0, r1), fmaxf(r2, r3));
}
__device__ __forceinline__ float xor32_f(float v, int lane) { return __int_as_float(__builtin_amdgcn_ds_bpermute((lane ^ 32) << 2, __float_as_int(v))); }
__device__ __forceinline__ float wave_sum(float v) { return wave_sum_u(v); }
__device__ __forceinline__ unsigned pk2(float lo, float hi) { return pg8::cvt_pk_bf16(lo, hi); }
__device__ __forceinline__ float bf_lo(unsigned u) { return __uint_as_float(u << 16); }
__device__ __forceinline__ float bf_hi(unsigned u) { return __uint_as_float(u & 0xffff0000u); }
__device__ __forceinline__ int modrow(int t) { return t < TL ? t / SEQ : 2; }

__device__ __forceinline__ void transpose_item(const float* W, int K, int N, bf16_t* WT, LAS float* scr, int item, int lane) {
    const int nblk = N / 32, kb = item / nblk, nb = item % nblk, k0 = 64 * kb, n0 = 32 * nb;
#pragma unroll 8
    for (int i = 0; i < 32; ++i) { const int kk = 2 * i + (lane >> 5); scr[kk * 33 + (lane & 31)] = W[(size_t)(k0 + kk) * N + n0 + (lane & 31)]; }
    LDS_WAIT(); asm volatile("" ::: "memory");
    const int c = lane & 7;
#pragma unroll
    for (int j = 0; j < 4; ++j) { const int n = (lane >> 3) + 8 * j; const LAS float* s = scr + (8 * c) * 33 + n;
        u32x4 o; o.x = pk2(s[0 * 33], s[1 * 33]); o.y = pk2(s[2 * 33], s[3 * 33]); o.z = pk2(s[4 * 33], s[5 * 33]); o.w = pk2(s[6 * 33], s[7 * 33]);
        *(u32x4*)(WT + (size_t)(n0 + n) * K + k0 + 8 * c) = o; }
    LDS_WAIT(); asm volatile("" ::: "memory");
}

__device__ __forceinline__ void transpose_item8(const float* W, int K, int N, unsigned char* WT, LAS float* scr, int item, int lane, float wscale) {
    const int nblk = N / 32, kb = item / nblk, nb = item % nblk, k0 = 64 * kb, n0 = 32 * nb;
    float wv[32];
#pragma unroll
    for (int i = 0; i < 32; ++i) wv[i] = __builtin_nontemporal_load(W + (size_t)(k0 + 2 * i + (lane >> 5)) * N + n0 + (lane & 31));
#pragma unroll
    for (int i = 0; i < 32; ++i) scr[(2 * i + (lane >> 5)) * 33 + (lane & 31)] = wv[i];
    LDS_WAIT(); asm volatile("" ::: "memory");
    const int c = lane & 7;
#pragma unroll
    for (int j = 0; j < 4; ++j) { const int n = (lane >> 3) + 8 * j; const LAS float* s = scr + (8 * c) * 33 + n;
        u32x2 o; int t0 = __builtin_amdgcn_cvt_pk_fp8_f32(s[0 * 33] * wscale, s[1 * 33] * wscale, 0, false); t0 = __builtin_amdgcn_cvt_pk_fp8_f32(s[2 * 33] * wscale, s[3 * 33] * wscale, t0, true);
        int t1 = __builtin_amdgcn_cvt_pk_fp8_f32(s[4 * 33] * wscale, s[5 * 33] * wscale, 0, false); t1 = __builtin_amdgcn_cvt_pk_fp8_f32(s[6 * 33] * wscale, s[7 * 33] * wscale, t1, true);
        o.x = (unsigned)t0; o.y = (unsigned)t1;
        *(u32x2*)(WT + (size_t)(n0 + n) * K + k0 + 8 * c) = o; }
    LDS_WAIT(); asm volatile("" ::: "memory");
}
__device__ __forceinline__ void cvt_row_bf16(const float* src, bf16_t* dst, int lane) {
    const f32x4* s = (const f32x4*)src + lane; u32x2* d = (u32x2*)dst + lane;
    f32x4 v[8];
#pragma unroll
    for (int j = 0; j < 8; ++j) v[j] = __builtin_nontemporal_load(s + 64 * j);
#pragma unroll
    for (int j = 0; j < 8; ++j) { u32x2 o; o.x = pk2(v[j].x, v[j].y); o.y = pk2(v[j].z, v[j].w); d[64 * j] = o; }
}

struct RowF32 { f32x4 v[4][2]; };
__device__ __forceinline__ void row_load_nt(RowF32& R, const float* src, int lane) {
    const f32x4* s = (const f32x4*)src + 2 * lane;
#pragma unroll
    for (int j = 0; j < 4; ++j) { R.v[j][0] = __builtin_nontemporal_load(s + 128 * j); R.v[j][1] = __builtin_nontemporal_load(s + 128 * j + 1); }
}
template <int FMT>
__device__ __forceinline__ void cvt_row_lp(const RowF32& R, unsigned char* dst, float* inv, int lane) {
    constexpr float QMAX = FMT == 8 ? 224.f : 6.f;
    float am = 0.f;
#pragma unroll
    for (int j = 0; j < 4; ++j)
#pragma unroll
        for (int q = 0; q < 2; ++q) am = fmaxf(fmaxf(am, fmaxf(fabsf(R.v[j][q].x), fabsf(R.v[j][q].y))), fmaxf(fabsf(R.v[j][q].z), fabsf(R.v[j][q].w)));
    am = wave_max_u(am);
    const float sc = am > 0.f ? QMAX / am : 1.f;
#pragma unroll
    for (int j = 0; j < 4; ++j) {
        if constexpr (FMT == 8) {
            u32x2 w;
#pragma unroll
            for (int q = 0; q < 2; ++q) { int t = __builtin_amdgcn_cvt_pk_fp8_f32(R.v[j][q].x * sc, R.v[j][q].y * sc, 0, false); t = __builtin_amdgcn_cvt_pk_fp8_f32(R.v[j][q].z * sc, R.v[j][q].w * sc, t, true); w[q] = (unsigned)t; }
            *((u32x2*)dst + lane + 64 * j) = w;
        } else {
            unsigned w = 0u;
            w = __builtin_amdgcn_cvt_scalef32_pk_fp4_f32(w, R.v[j][0].x * sc, R.v[j][0].y * sc, 1.0f, 0);
            w = __builtin_amdgcn_cvt_scalef32_pk_fp4_f32(w, R.v[j][0].z * sc, R.v[j][0].w * sc, 1.0f, 1);
            w = __builtin_amdgcn_cvt_scalef32_pk_fp4_f32(w, R.v[j][1].x * sc, R.v[j][1].y * sc, 1.0f, 2);
            w = __builtin_amdgcn_cvt_scalef32_pk_fp4_f32(w, R.v[j][1].z * sc, R.v[j][1].w * sc, 1.0f, 3);
            *((unsigned*)dst + lane + 64 * j) = w;
        }
    }
    if (lane == 0) *inv = am > 0.f ? am * (1.f / QMAX) : 1.f;
}
template <int FMT> struct LpRow;
template <> struct LpRow<8> { u32x4 a, b;
    __device__ __forceinline__ void load(const unsigned char* rowp, int lane) { a = *(const u32x4*)(rowp + 32 * lane); b = *(const u32x4*)(rowp + 32 * lane + 16); }
    template <class Fn> __device__ __forceinline__ void each(Fn&& f) const {
#pragma unroll
        for (int w = 0; w < 4; ++w) { const f32x2 l0 = __builtin_amdgcn_cvt_pk_f32_fp8((int)a[w], false), h0 = __builtin_amdgcn_cvt_pk_f32_fp8((int)a[w], true);
            f(4 * w, l0.x, l0.y); f(4 * w + 2, h0.x, h0.y); }
#pragma unroll
        for (int w = 0; w < 4; ++w) { const f32x2 l0 = __builtin_amdgcn_cvt_pk_f32_fp8((int)b[w], false), h0 = __builtin_amdgcn_cvt_pk_f32_fp8((int)b[w], true);
            f(16 + 4 * w, l0.x, l0.y); f(16 + 4 * w + 2, h0.x, h0.y); }
    } };
template <> struct LpRow<4> { u32x4 a;
    __device__ __forceinline__ void load(const unsigned char* rowp, int lane) { a = *(const u32x4*)(rowp + 16 * lane); }
    template <class Fn> __device__ __forceinline__ void each(Fn&& f) const {
#pragma unroll
        for (int w = 0; w < 4; ++w) {
            const f32x2 d0 = __builtin_amdgcn_cvt_scalef32_pk_f32_fp4(a[w], 1.0f, 0), d1 = __builtin_amdgcn_cvt_scalef32_pk_f32_fp4(a[w], 1.0f, 1);
            const f32x2 d2 = __builtin_amdgcn_cvt_scalef32_pk_f32_fp4(a[w], 1.0f, 2), d3 = __builtin_amdgcn_cvt_scalef32_pk_f32_fp4(a[w], 1.0f, 3);
            f(8 * w, d0.x, d0.y); f(8 * w + 2, d1.x, d1.y); f(8 * w + 4, d2.x, d2.y); f(8 * w + 6, d3.x, d3.y); }
    }
    template <class Fn> __device__ __forceinline__ void each_bf(Fn&& f) const {
#pragma unroll
        for (int w = 0; w < 4; ++w) {
            f(4 * w, __builtin_amdgcn_cvt_scalef32_pk_bf16_fp4(a[w], 1.0f, 0)); f(4 * w + 1, __builtin_amdgcn_cvt_scalef32_pk_bf16_fp4(a[w], 1.0f, 1));
            f(4 * w + 2, __builtin_amdgcn_cvt_scalef32_pk_bf16_fp4(a[w], 1.0f, 2)); f(4 * w + 3, __builtin_amdgcn_cvt_scalef32_pk_bf16_fp4(a[w], 1.0f, 3)); }
    } };

__device__ __forceinline__ void row_stats(const f32x4 (&v)[8], float& mean, float& rstd) {
    float s = 0.f;
#pragma unroll
    for (int j = 0; j < 8; ++j) s += (v[j].x + v[j].y) + (v[j].z + v[j].w);
    mean = wave_sum(s) * (1.f / D);
    float s2 = 0.f;
#pragma unroll
    for (int j = 0; j < 8; ++j) { const f32x4 d = v[j] - mean; s2 += (d.x * d.x + d.y * d.y) + (d.z * d.z + d.w * d.w); }
    rstd = 1.f / sqrtf(wave_sum(s2) * (1.f / D) + LN_EPS);
}
__device__ __forceinline__ void modulate_store(const f32x4 (&v)[8], const float* shift, const float* scale, bf16_t* dst, int lane) {
    float mean, rstd; row_stats(v, mean, rstd);
    u32x2* d = (u32x2*)dst + lane;
#pragma unroll
    for (int j = 0; j < 8; ++j) { const f32x4 sc = *((const f32x4*)scale + lane + 64 * j), sh = *((const f32x4*)shift + lane + 64 * j);
        const f32x4 y = (v[j] - mean) * rstd * (sc + 1.f) + sh;
        u32x2 o; o.x = pk2(y.x, y.y); o.y = pk2(y.z, y.w); d[64 * j] = o; }
}

__device__ __forceinline__ void convert_tables(Frame& F, int row0, int row1, int w0, int wstride) {
    RowF32 ru, rv, nu, nv;
    int row = row0 + w0;
    if (row < row1) { row_load_nt(ru, F.pu() + (size_t)row * D, F.lane); row_load_nt(rv, F.pv() + (size_t)row * D, F.lane); }
    while (row < row1) {
        const int nrow = row + wstride;
        if (nrow < row1) { row_load_nt(nu, F.pu() + (size_t)nrow * D, F.lane); row_load_nt(nv, F.pv() + (size_t)nrow * D, F.lane); }
        cvt_row_lp<U_FMT>(ru, F.UT() + (size_t)row * UROW, F.US() + 2 * (size_t)row, F.lane);
        cvt_row_lp<V_FMT>(rv, F.VT() + (size_t)row * VROW, F.US() + 2 * (size_t)row + 1, F.lane);
        ru = nu; rv = nv; row = nrow;
    }
}
__device__ __forceinline__ void convert_in_tail(Frame& F, int layer, int nunits, int part) {
    if (layer + 1 >= NLAYER) return;
    const int G = F.G, rounds = (nunits + G - 1) / G, nlast = nunits - (rounds - 1) * G;
    const int c = (int)blockIdx.x;
    int nshort = G - nlast, sidx = c - nlast;
    if (nshort <= 0) { nshort = G; sidx = c; }
    else if (sidx < 0) return;
    const int r0 = (layer + 1) * NEXP + part * (NEXP / 2);
    convert_tables(F, r0, r0 + NEXP / 2, sidx * NWAVES + F.wave, nshort * NWAVES);
}
__device__ __forceinline__ void p0a_prologue(Frame& F) {
    LAS float* condL = (LAS float*)F.lds;
    LAS float* red = (LAS float*)(F.lds + 24576);
    for (int i = F.tid; i < 3 * D; i += NWAVES * 64) { const int r = i / D, k = i % D; const float v = r < 2 ? F.c()[r * D + k] : F.c_ctx()[k]; condL[i] = v / (1.f + __expf(-v)); }
    __syncthreads();
    const bool bal = (F.G == 256);
    for (int pass = 0; pass < (bal ? 2 : 384); ++pass) {
        int item, kw, kbase;
        if (bal) { item = pass == 0 ? (int)blockIdx.x : 256 + ((int)blockIdx.x >> 1); kw = pass == 0 ? 256 : 128; kbase = pass == 0 ? F.wave * 256 : ((int)blockIdx.x & 1) * 1024 + F.wave * 128; }
        else { item = (int)blockIdx.x + pass * F.G; kw = 256; kbase = F.wave * 256; if (item >= 384) break; }
        const int l = item / 96, n0 = (item % 96) * 128;
        const float* wp = F.w_ada() + ((size_t)l * D + kbase) * 12288 + n0 + 2 * F.lane;
        f32x2 a0 = {0.f, 0.f}, a1 = {0.f, 0.f}, a2 = {0.f, 0.f};
#pragma unroll 8
        for (int k = 0; k < kw; ++k) { const f32x2 w = __builtin_nontemporal_load((const f32x2*)(wp + (size_t)k * 12288)); const int kk = kbase + k;
            a0 += w * condL[kk]; a1 += w * condL[D + kk]; a2 += w * condL[2 * D + kk]; }
        LAS float* rp = red + F.wave * 384 + 2 * F.lane;
        rp[0] = a0.x; rp[1] = a0.y; rp[128] = a1.x; rp[129] = a1.y; rp[256] = a2.x; rp[257] = a2.y;
        __syncthreads();
        if (F.tid < 384) { const int r = F.tid / 128, n = F.tid % 128; float s = 0.f;
#pragma unroll
            for (int w = 0; w < 8; ++w) s += red[w * 384 + r * 128 + n];
            if (!(bal && pass == 1 && (blockIdx.x & 1))) s += F.b_ada()[(size_t)l * 12288 + n0 + n];
            atomicAdd(F.MODS() + ((size_t)l * 3 + r) * 12288 + n0 + n, s); }
        __syncthreads();
    }
    LAS float* scr = (LAS float*)(F.lds + 40960 + F.wave * 8448);
    constexpr int I_IN = (D / 64) * (INC / 32), I_OUT = (D / 64) * (D / 32);
    for (int it = F.gw; it < NLAYER * (I_IN + I_OUT); it += F.NGW) {
        const int l = it / (I_IN + I_OUT); int r = it % (I_IN + I_OUT);
        if (r < I_IN) transpose_item8(F.w_in() + (size_t)l * D * INC, D, INC, F.WINT() + (size_t)l * INC * D, scr, r, F.lane, WIN_SCALE);
        else transpose_item8(F.w_out() + (size_t)l * D * D, D, D, F.WOUTT() + (size_t)l * D * D, scr, r - I_IN, F.lane, WOUT_SCALE);
    }
    for (int row = F.gw; row < NLAYER * D; row += F.NGW) {
        const int l = row / D, c = row % D; const f32x4* s = (const f32x4*)(F.wq() + (size_t)row * D) + F.lane;
#pragma unroll
        for (int j = 0; j < 8; ++j) { const f32x4 v = s[64 * j]; u32x2 o; o.x = pk2(v.x, v.y); o.y = pk2(v.z, v.w);
            *((u32x2*)(F.WQR() + ((size_t)(l * 8 + j) * D + c) * 256) + F.lane) = o; }
    }
    for (int row = F.gw; row < 32 * 256; row += F.NGW) {
        const int lh = row >> 8, pk = row & 255, p = pk >> 7;
        u32x2 o = {0u, 0u};
        if ((F.lane >> 5) == p) { const f32x4 v = *((const f32x4*)(F.keys() + ((size_t)lh * 256 + pk) * 128) + (F.lane & 31)); o.x = pk2(v.x, v.y); o.y = pk2(v.z, v.w); }
        *((u32x2*)(F.KBD() + (size_t)row * 256) + F.lane) = o;
    }
    convert_tables(F, 0, NEXP, F.gw, F.NGW);
    for (int i = blockIdx.x * (NWAVES * 64) + F.tid; i < 192 * 32; i += F.G * NWAVES * 64) {
        const int idx = i >> 5, f = i & 31; const float pos = (float)(idx < 128 ? idx : idx - 128);
        const float inv = powf(10000.f, -(float)(2 * f) / 64.f); const float ang = pos * inv;
        F.ROPE()[2 * i] = cosf(ang); F.ROPE()[2 * i + 1] = sinf(ang);
    }
}

__device__ __forceinline__ void p0b_mod0(Frame& F) {
    __syncthreads();
#pragma unroll 1
    for (int v = 0; v < 6; ++v)
        *(LAS f32x4*)(F.lds + v * 8192 + F.tid * 16) = *(const f32x4*)(F.MODS() + (size_t)(v % 3) * 12288 + (v < 3 ? 0 : D) + 4 * F.tid);
    __syncthreads();
    for (int t = F.gw; t < TT; t += F.NGW) {
        const float* src = t < TL ? F.x() + (size_t)t * D : F.ctx() + (size_t)(t - TL) * D;
        f32x4 v[8];
#pragma unroll
        for (int j = 0; j < 8; ++j) v[j] = *((const f32x4*)src + F.lane + 64 * j);
        const int mr = modrow(t);
        float mean, rstd; row_stats(v, mean, rstd);
        unsigned* d = (unsigned*)(F.H8() + (size_t)t * D) + F.lane;
#pragma unroll
        for (int j = 0; j < 8; ++j) { const f32x4 sh = *(const LAS f32x4*)(F.lds + mr * 8192 + (64 * j + F.lane) * 16), sc = *(const LAS f32x4*)(F.lds + (3 + mr) * 8192 + (64 * j + F.lane) * 16);
            const f32x4 y = (v[j] - mean) * rstd * (sc + 1.f) + sh;
            int o = __builtin_amdgcn_cvt_pk_fp8_f32(y.x, y.y, 0, false); o = __builtin_amdgcn_cvt_pk_fp8_f32(y.z, y.w, o, true); d[64 * j] = (unsigned)o; }
    }
}

constexpr int ROPE_LDS = 98304, ROPE_RS = 272;
constexpr int CONV_LDS = 81920;
constexpr int KP = 272, VP = 320, KS_BYTES = 64 * KP, VS_BYTES = 64 * VP;
struct KVRegs { u32x4 k1, k2, v1, v2; };

__device__ __forceinline__ void attn_load_tile(Frame& F, KVRegs& R, int ti, int b, int n, int g) {
    const int key = F.tid >> 3, c8 = F.tid & 7;
    int row;
    if (ti < 6) row = b * SEQ + (n - 1) * 128 + 64 * ti + key; else row = TL + b * CTXL + 64 * (ti - 6) + key;
    const bf16_t* base = F.PROJ() + (size_t)row * INC;
    const int d1 = (c8 >> 2) * 64 + (c8 & 3) * 8;
    R.k1 = *(const u32x4*)(base + OFF_K + g * 128 + d1); R.k2 = *(const u32x4*)(base + OFF_K + g * 128 + d1 + 32);
    R.v1 = *(const u32x4*)(base + OFF_V + g * 128 + 8 * c8); R.v2 = *(const u32x4*)(base + OFF_V + g * 128 + 64 + 8 * c8);
}
__device__ __forceinline__ void rope8(u32x4& a, u32x4& bq, const f32x4 (&cs)[4], float scale) {
    u32x4 oa, ob;
#pragma unroll
    for (int w = 0; w < 4; ++w) {
        const float x1l = bf_lo(a[w]), x1h = bf_hi(a[w]), x2l = bf_lo(bq[w]), x2h = bf_hi(bq[w]);
        const float cl = cs[w].x, sl = cs[w].y, ch = cs[w].z, sh = cs[w].w;
        oa[w] = pk2((x1l * cl - x2l * sl) * scale, (x1h * ch - x2h * sh) * scale);
        ob[w] = pk2((x2l * cl + x1l * sl) * scale, (x2h * ch + x1h * sh) * scale);
    }
    a = oa; bq = ob;
}
__device__ __forceinline__ void attn_store_tile(Frame& F, KVRegs& R, int ti, int buf, int n) {
    const int key = F.tid >> 3, c8 = F.tid & 7;
    if (ti < 6) {
        const int pos = (n - 1) * 128 + 64 * ti + key;
        const int tidx = (c8 >> 2) ? 128 + (pos & 63) : (pos >> 6); const LAS f32x4* cp = (const LAS f32x4*)(F.lds + ROPE_LDS + tidx * ROPE_RS + (c8 & 3) * 64);
        f32x4 cs[4];
#pragma unroll
        for (int m = 0; m < 4; ++m) cs[m] = cp[m];
        rope8(R.k1, R.k2, cs, 1.f);
    }
    const int d1 = (c8 >> 2) * 64 + (c8 & 3) * 8;
    LAS unsigned char* kp = F.lds + buf * KS_BYTES + key * KP;
    *(LAS u32x4*)(kp + d1 * 2) = R.k1; *(LAS u32x4*)(kp + (d1 + 32) * 2) = R.k2;
    LAS unsigned char* vp = F.lds + 2 * KS_BYTES + buf * VS_BYTES + key * VP;
    *(LAS u32x4*)(vp + 16 * c8) = R.v1; *(LAS u32x4*)(vp + 128 + 16 * c8) = R.v2;
}

#define MFMA32(a, b, c) __builtin_amdgcn_mfma_f32_32x32x16_bf16((a), (b), (c), 0, 0, 0)

struct AUnit { bool latent; int b, n, g, tq, head, tlo, nw; };
__device__ __forceinline__ AUnit attn_decode(int u, int wave, int r) {
    AUnit U; int hp;
    U.latent = u < 512;
    if (U.latent) { hp = u & 1; U.g = (u >> 1) & 1; U.n = (u >> 2) & 63; U.b = u >> 8; }
    else { const int v = u - 512; hp = v & 1; U.g = (v >> 1) & 1; U.n = (v >> 2) & 1; U.b = v >> 3; }
    const int qb = wave & 3;
    U.head = U.g * 4 + hp * 2 + (wave >> 2);
    U.tq = U.latent ? U.b * SEQ + U.n * 128 + 32 * qb + r : TL + U.b * CTXL + U.n * 128 + 32 * qb + r;
    U.tlo = 6; U.nw = 0;
    if (U.latent) { U.tlo = (U.n == 0) ? 2 : 0; const int thi = (U.n == 63) ? 3 : 5; U.nw = thi - U.tlo + 1; }
    return U;
}
#define TILE_OF(U, j) ((j) < (U).nw ? (U).tlo + (j) : 6 + ((j) - (U).nw))
__device__ __forceinline__ void attn_units(Frame& F, int layer, int u0, int ustep, int nunits) {
    if (u0 >= nunits) return;
    const int lane = F.lane, r = lane & 31, h = lane >> 5, wave = F.wave, qb = wave & 3;
    const int i16 = lane & 15, tq4 = i16 >> 2, tp = i16 & 3, blk = (lane >> 4) & 1;
    u32x4 raw[8]; KVRegs R, R2;
    AUnit U = attn_decode(u0, wave, r);
    {
        const bf16_t* qp = F.PROJ() + (size_t)U.tq * INC + OFF_Q + U.head * 128 + 8 * h;
#pragma unroll
        for (int ks = 0; ks < 8; ++ks) raw[ks] = *(const u32x4*)(qp + 16 * ks);
        attn_load_tile(F, R2, TILE_OF(U, 0), U.b, U.n, U.g);
        attn_load_tile(F, R, TILE_OF(U, 1), U.b, U.n, U.g);
    }
    for (int u = u0;; u += ustep) {
        const bool latent = U.latent; const int b = U.b, n = U.n, g = U.g, head = U.head, tq = U.tq, tlo = U.tlo, nw = U.nw;
        bf16x8 qf[8];
        if (latent) {
            const int pos = n * 128 + 32 * qb + r;
#pragma unroll
            for (int half = 0; half < 2; ++half) {
                const int tidx = half ? 128 + (pos & 63) : (pos >> 6);
#pragma unroll
                for (int kk = 0; kk < 2; ++kk) {
                    const LAS f32x4* cp = (const LAS f32x4*)(F.lds + ROPE_LDS + tidx * ROPE_RS + (16 * kk + 8 * h) * 8);
                    f32x4 cs[4];
#pragma unroll
                    for (int m = 0; m < 4; ++m) cs[m] = cp[m];
                    rope8(raw[4 * half + kk], raw[4 * half + kk + 2], cs, QSCALE);
                }
            }
        } else {
#pragma unroll
            for (int ks = 0; ks < 8; ++ks)
#pragma unroll
                for (int w = 0; w < 4; ++w) raw[ks][w] = pk2(bf_lo(raw[ks][w]) * QSCALE, bf_hi(raw[ks][w]) * QSCALE);
        }
#pragma unroll
        for (int ks = 0; ks < 8; ++ks) qf[ks] = __builtin_bit_cast(bf16x8, raw[ks]);
        const int ntiles = nw + 4;
        f32x16 o[4];
#pragma unroll
        for (int db = 0; db < 4; ++db)
#pragma unroll
            for (int i = 0; i < 16; ++i) o[db][i] = 0.f;
        float m_run = F.sink()[layer * 8 + head] * LOG2E;
        float lsum = h == 0 ? 1.f : 0.f;
        const int iq = 32 * qb + r;
        __syncthreads();
        attn_store_tile(F, R2, TILE_OF(U, 0), 0, n);
        __syncthreads();
        for (int j = 0; j < ntiles; ++j) {
            const int ti = TILE_OF(U, j);
            const int buf = j & 1;
            const bool more = j + 1 < ntiles;
            const int tin = TILE_OF(U, j + 1);
            if (j + 2 < ntiles) attn_load_tile(F, R2, TILE_OF(U, j + 2), b, n, g);
            const bool part = ti >= 6 || (ti >= (qb >> 1) && ti <= (qb >> 1) + 4);
            if (part) {
                f32x16 s0, s1;
#pragma unroll
                for (int i = 0; i < 16; ++i) { s0[i] = 0.f; s1[i] = 0.f; }
                const LAS unsigned char* kb = F.lds + buf * KS_BYTES + r * KP + h * 16;
#pragma unroll
                for (int ks = 0; ks < 8; ++ks) {
                    const bf16x8 a0 = *(const LAS bf16x8*)(kb + ks * 32), a1 = *(const LAS bf16x8*)(kb + 32 * KP + ks * 32);
                    s0 = MFMA32(a0, qf[ks], s0); s1 = MFMA32(a1, qf[ks], s1);
                }
                float mx = -INFINITY;
                if (ti < 6 && (ti == (qb >> 1) || ti == (qb >> 1) + 4)) {
                    const int jb = 64 * ti + 4 * h - iq;
#pragma unroll
                    for (int i = 0; i < 16; ++i) { const int j0 = jb + (i & 3) + 8 * (i >> 2), j1 = j0 + 32;
                        s0[i] = (j0 >= 0 && j0 <= 256) ? s0[i] : -INFINITY; s1[i] = (j1 >= 0 && j1 <= 256) ? s1[i] : -INFINITY; }
                }
#pragma unroll
                for (int i = 0; i < 16; ++i) mx = fmaxf(mx, fmaxf(s0[i], s1[i]));
                mx = fmaxf(mx, xor32_f(mx, lane));
                if (__any(mx > m_run + 8.f)) {
                    const float m_new = mx > m_run + 8.f ? mx : m_run, alpha = __builtin_amdgcn_exp2f(m_run - m_new);
                    m_run = m_new; lsum *= alpha;
#pragma unroll
                    for (int db = 0; db < 4; ++db)
#pragma unroll
                        for (int i = 0; i < 16; ++i) o[db][i] *= alpha;
                }
                const LAS unsigned char* vb = F.lds + 2 * KS_BYTES + buf * VS_BYTES + (4 * h + tq4) * VP + 32 * blk + 8 * tp;
                u32x4 pc;
#pragma unroll
                for (int w = 0; w < 4; ++w) { const float e0 = __builtin_amdgcn_exp2f(s0[2 * w] - m_run), e1 = __builtin_amdgcn_exp2f(s0[2 * w + 1] - m_run); lsum += e0 + e1; pc[w] = pk2(e0, e1); }
#pragma unroll
                for (int c = 0; c < 4; ++c) {
                    const int kb2 = c >> 1, s2 = c & 1;
                    const bf16x8 pf = __builtin_bit_cast(bf16x8, pc);
                    s16x4 lo[4], hi[4];
#pragma unroll
                    for (int db = 0; db < 4; ++db) { const int off = (32 * kb2 + 16 * s2) * VP + db * 64;
                        lo[db] = __builtin_amdgcn_ds_read_tr16_b64_v4i16((LAS s16x4*)(vb + off)); hi[db] = __builtin_amdgcn_ds_read_tr16_b64_v4i16((LAS s16x4*)(vb + off + 8 * VP)); }
#pragma unroll
                    for (int db = 0; db < 4; ++db) {
                        const bf16x8 av = __builtin_shufflevector(lo[db], hi[db], 0, 1, 2, 3, 4, 5, 6, 7);
                        o[db] = MFMA32(av, pf, o[db]);
                        if (c < 3) {
                            const int cn = c + 1, base = 8 * (cn & 1) + 2 * db;
                            const float x0 = (cn >> 1) ? s1[base] : s0[base], x1 = (cn >> 1) ? s1[base + 1] : s0[base + 1];
                            const float e0 = __builtin_amdgcn_exp2f(x0 - m_run), e1 = __builtin_amdgcn_exp2f(x1 - m_run); lsum += e0 + e1; pc[db] = pk2(e0, e1);
                        }
                    }
                }
            }
            if (more) attn_store_tile(F, R, tin, buf ^ 1, n);
            R = R2;
            __syncthreads();
        }
        const bool hasn = u + ustep < nunits;
        if (hasn) {
            U = attn_decode(u + ustep, wave, r);
            const bf16_t* qp = F.PROJ() + (size_t)U.tq * INC + OFF_Q + U.head * 128 + 8 * h;
#pragma unroll
            for (int ks = 0; ks < 8; ++ks) raw[ks] = *(const u32x4*)(qp + 16 * ks);
            attn_load_tile(F, R2, TILE_OF(U, 0), U.b, U.n, U.g);
            attn_load_tile(F, R, TILE_OF(U, 1), U.b, U.n, U.g);
        }
        const float lt = lsum + xor32_f(lsum, lane);
        const float inv = 1.f / lt;
        float ss = 0.f;
#pragma unroll
        for (int db = 0; db < 4; ++db)
#pragma unroll
            for (int i = 0; i < 16; ++i) { o[db][i] *= inv; ss += o[db][i] * o[db][i]; }
        ss += xor32_f(ss, lane);
        const float rn = 1.f / sqrtf(ss * (1.f / 128.f) + LN_EPS);
        unsigned char* op = F.MIX() + (size_t)tq * D + head * 128 + 16 * h;
        const float* gp = F.g_attn() + layer * 1024 + head * 128 + 4 * h;
#pragma unroll
        for (int db = 0; db < 4; ++db) {
            unsigned wv[4];
#pragma unroll
            for (int g4 = 0; g4 < 4; ++g4) {
                const f32x4 gv = *(const f32x4*)(gp + 32 * db + 8 * g4);
                int w = __builtin_amdgcn_cvt_pk_fp8_f32(o[db][4 * g4] * rn * gv.x, o[db][4 * g4 + 1] * rn * gv.y, 0, false);
                w = __builtin_amdgcn_cvt_pk_fp8_f32(o[db][4 * g4 + 2] * rn * gv.z, o[db][4 * g4 + 3] * rn * gv.w, w, true);
                wv[g4] = (unsigned)w;
            }
            const auto s02 = __builtin_amdgcn_permlane32_swap(wv[0], wv[2], false, false), s13 = __builtin_amdgcn_permlane32_swap(wv[1], wv[3], false, false);
            u32x4 ov; ov.x = s02[0]; ov.y = s02[1]; ov.z = s13[0]; ov.w = s13[1];
            *(u32x4*)(op + 32 * db) = ov;
        }
        if (!hasn) break;
    }
}
#undef TILE_OF

__device__ __forceinline__ void unpack8(const u32x4 v, float (&f)[8]) {
#pragma unroll
    for (int w = 0; w < 4; ++w) { f[2 * w] = bf_lo(v[w]); f[2 * w + 1] = bf_hi(v[w]); }
}
struct ConvRaw { u32x4 c[2], x[2]; };
__device__ __forceinline__ void conv_load(Frame& F, ConvRaw& R, int t, int lane) {
    const bf16_t* p = F.PROJ() + (size_t)t * INC + 8 * lane;
#pragma unroll
    for (int jc = 0; jc < 2; ++jc) { R.c[jc] = *(const u32x4*)(p + OFF_C + 512 * jc); R.x[jc] = *(const u32x4*)(p + OFF_X + 512 * jc); }
}
__device__ __forceinline__ void conv_prod(const ConvRaw& R, float (&P)[16]) {
#pragma unroll
    for (int jc = 0; jc < 2; ++jc) { float a[8], bq[8]; unpack8(R.c[jc], a); unpack8(R.x[jc], bq);
#pragma unroll
        for (int e = 0; e < 8; ++e) P[8 * jc + e] = a[e] * bq[e]; }
}
__device__ __forceinline__ bool conv_first(int t) { return t < TL ? (t & (SEQ - 1)) == 0 : ((t - TL) & (CTXL - 1)) == 0; }
__device__ __forceinline__ bool conv_last(int t) { return t < TL ? (t & (SEQ - 1)) == SEQ - 1 : ((t - TL) & (CTXL - 1)) == CTXL - 1; }
__device__ __forceinline__ void conv_rows(Frame& F, int layer, int t0, int t1) {
    if (t0 >= t1) return;
    const int lane = F.lane;
    const LAS unsigned char* cvc = F.lds + CONV_LDS + lane * 16;
    float Pm[16], Pt[16];
    ConvRaw Rn; u32x4 gcur[2];
    {
        ConvRaw R0;
        if (!conv_first(t0)) { conv_load(F, R0, t0 - 1, lane); conv_prod(R0, Pm); }
        else {
#pragma unroll
            for (int e = 0; e < 16; ++e) Pm[e] = 0.f; }
        conv_load(F, R0, t0, lane); conv_prod(R0, Pt);
    }
    conv_load(F, Rn, t0 + 1 < TT ? t0 + 1 : TT - 1, lane);
    { const bf16_t* gp = F.PROJ() + (size_t)t0 * INC + 8 * lane; gcur[0] = *(const u32x4*)gp; gcur[1] = *(const u32x4*)(gp + 512); }
    for (int t = t0; t < t1; ++t) {
        ConvRaw R2; u32x4 gnext[2];
        const bool more = t + 1 < t1;
        if (more) { conv_load(F, R2, t + 2 < TT ? t + 2 : TT - 1, lane); const bf16_t* gp = F.PROJ() + (size_t)(t + 1) * INC + 8 * lane; gnext[0] = *(const u32x4*)gp; gnext[1] = *(const u32x4*)(gp + 512); }
        float Pp[16]; conv_prod(Rn, Pp);
        const float fm = conv_first(t) ? 0.f : 1.f, fp = conv_last(t) ? 0.f : 1.f;
#pragma unroll
        for (int jc = 0; jc < 2; ++jc) {
            float gb[8]; unpack8(gcur[jc], gb);
            float y[8], ss = 0.f;
#pragma unroll
            for (int q = 0; q < 2; ++q) { const f32x4 w0 = *(const LAS f32x4*)(cvc + (2 * jc + q) * 1024) * fm, w1 = *(const LAS f32x4*)(cvc + 4096 + (2 * jc + q) * 1024), w2 = *(const LAS f32x4*)(cvc + 8192 + (2 * jc + q) * 1024) * fp;
#pragma unroll
                for (int e = 0; e < 4; ++e) { const int i = 4 * q + e; y[i] = gb[i] * (w0[e] * Pm[8 * jc + i] + w1[e] * Pt[8 * jc + i] + w2[e] * Pp[8 * jc + i]); ss += y[i] * y[i]; } }
            ss += dpp_f<DPP_XOR1>(ss); ss += dpp_f<DPP_XOR2>(ss); ss += dpp_f<DPP_ROR4>(ss); ss += dpp_f<DPP_ROR8>(ss);
            const float rn = 1.f / sqrtf(ss * (1.f / 128.f) + LN_EPS);
            u32x2 w;
#pragma unroll
            for (int q = 0; q < 2; ++q) { const f32x4 gcv = *(const LAS f32x4*)(cvc + 12288 + (2 * jc + q) * 1024);
                int t8 = __builtin_amdgcn_cvt_pk_fp8_f32(y[4 * q] * rn * gcv[0], y[4 * q + 1] * rn * gcv[1], 0, false); t8 = __builtin_amdgcn_cvt_pk_fp8_f32(y[4 * q + 2] * rn * gcv[2], y[4 * q + 3] * rn * gcv[3], t8, true); w[q] = (unsigned)t8; }
            *(u32x2*)(F.MIX() + (size_t)t * D + 1024 + 8 * lane + 512 * jc) = w;
        }
#pragma unroll
        for (int e = 0; e < 16; ++e) { Pm[e] = Pt[e]; Pt[e] = Pp[e]; }
        if (more) { Rn = R2; gcur[0] = gnext[0]; gcur[1] = gnext[1]; }
    }
}

__device__ __forceinline__ void ln_phase(Frame& F, int layer, int rows) {
    const int lane = F.lane;
    const bf16_t* Y = F.PROJ();
    u32x4 w[4], wn[4], yw[4], yn[4];
    int t = F.gw;
    if (t < rows) {
#pragma unroll
        for (int j = 0; j < 4; ++j) { yw[j] = *(const u32x4*)(Y + (size_t)t * D + 8 * lane + 512 * j); if (layer > 0) w[j] = *(const u32x4*)(F.X() + (size_t)t * D + 8 * lane + 512 * j); }
    }
    {
        const int ch = F.tid, jj = ch >> 7, rem = ch & 127, ll = rem >> 1, qq = rem & 1;
        LAS unsigned char* dst = F.lds + ((2 * jj + qq) * 64 + ll) * 16;
        *(LAS f32x4*)(dst) = *(const f32x4*)(F.ln1_g() + layer * D + 4 * ch);
        *(LAS f32x4*)(dst + 8192) = *(const f32x4*)(F.ln1_b() + layer * D + 4 * ch);
#pragma unroll 1
        for (int v = 0; v < 9; ++v) { const int mrv = v % 3; const size_t off = ((size_t)layer * 3 + mrv) * 12288 + (v < 3 ? 3 * D : (v < 6 ? 4 * D : 2 * D));
            *(LAS f32x4*)(dst + (2 + v) * 8192) = *(const f32x4*)(F.MODS() + off + 4 * ch); }
    }
    __syncthreads();
    const LAS unsigned char* vc = F.lds + lane * 16;
    while (t < rows) {
        const int tn = t + F.NGW;
        if (tn < rows) {
#pragma unroll
            for (int j = 0; j < 4; ++j) { yn[j] = *(const u32x4*)(Y + (size_t)tn * D + 8 * lane + 512 * j); if (layer > 0) wn[j] = *(const u32x4*)(F.X() + (size_t)tn * D + 8 * lane + 512 * j); }
        }
        const int mrl = modrow(t);
        float v[32]; float s = 0.f;
#pragma unroll
        for (int j = 0; j < 4; ++j) {
            float xin[8], yv[8];
            unpack8(yw[j], yv);
            if (layer > 0) unpack8(w[j], xin);
            else { const float* xp = (t < TL ? F.x() + (size_t)t * D : F.ctx() + (size_t)(t - TL) * D) + 8 * lane + 512 * j; const f32x4 a0 = *(const f32x4*)xp, a1 = *(const f32x4*)(xp + 4);
                xin[0] = a0[0]; xin[1] = a0[1]; xin[2] = a0[2]; xin[3] = a0[3]; xin[4] = a1[0]; xin[5] = a1[1]; xin[6] = a1[2]; xin[7] = a1[3]; }
#pragma unroll
            for (int q = 0; q < 2; ++q) { const f32x4 ga = *(const LAS f32x4*)(vc + (8 + mrl) * 8192 + (2 * j + q) * 1024);
#pragma unroll
                for (int e = 0; e < 4; ++e) { const float r = DN_ALPHA * xin[4 * q + e] + ga[e] * yv[4 * q + e]; v[8 * j + 4 * q + e] = r; s += r; } } }
        const float mean = wave_sum(s) * (1.f / D);
        float s2 = 0.f;
#pragma unroll
        for (int i = 0; i < 32; ++i) { v[i] -= mean; s2 += v[i] * v[i]; }
        const float rstd = 1.f / sqrtf(wave_sum(s2) * (1.f / D) + LN_EPS);
        float s3 = 0.f;
#pragma unroll
        for (int j = 0; j < 4; ++j) { const int c = 8 * lane + 512 * j; u32x4 o;
#pragma unroll
            for (int q = 0; q < 2; ++q) { const f32x4 gg = *(const LAS f32x4*)(vc + (2 * j + q) * 1024), bb = *(const LAS f32x4*)(vc + 8192 + (2 * j + q) * 1024);
#pragma unroll
                for (int e = 0; e < 4; ++e) { const float y = v[8 * j + 4 * q + e] * rstd * gg[e] + bb[e]; v[8 * j + 4 * q + e] = y; s3 += y; }
                o[2 * q] = pk2(v[8 * j + 4 * q], v[8 * j + 4 * q + 1]); o[2 * q + 1] = pk2(v[8 * j + 4 * q + 2], v[8 * j + 4 * q + 3]); }
            *(u32x4*)(F.X() + (size_t)t * D + c) = o; }
        const float mean2 = wave_sum(s3) * (1.f / D);
        float s4 = 0.f;
#pragma unroll
        for (int i = 0; i < 32; ++i) { v[i] -= mean2; s4 += v[i] * v[i]; }
        const float rstd2 = 1.f / sqrtf(wave_sum(s4) * (1.f / D) + LN_EPS);
#pragma unroll
        for (int j = 0; j < 4; ++j) { const int c = 8 * lane + 512 * j; u32x4 o;
#pragma unroll
            for (int q = 0; q < 2; ++q) { const f32x4 sh = *(const LAS f32x4*)(vc + (2 + mrl) * 8192 + (2 * j + q) * 1024), sc = *(const LAS f32x4*)(vc + (5 + mrl) * 8192 + (2 * j + q) * 1024);
                const float y0 = v[8 * j + 4 * q] * rstd2 * (1.f + sc[0]) + sh[0], y1 = v[8 * j + 4 * q + 1] * rstd2 * (1.f + sc[1]) + sh[1];
                const float y2 = v[8 * j + 4 * q + 2] * rstd2 * (1.f + sc[2]) + sh[2], y3 = v[8 * j + 4 * q + 3] * rstd2 * (1.f + sc[3]) + sh[3];
                o[2 * q] = pk2(y0, y1); o[2 * q + 1] = pk2(y2, y3); }
            *(u32x4*)(F.H() + (size_t)t * D + c) = o; }
#pragma unroll
        for (int j = 0; j < 4; ++j) { w[j] = wn[j]; yw[j] = yn[j]; }
        t = tn;
    }
}

__device__ __forceinline__ unsigned ordkey(float f) { const unsigned u = __float_as_uint(f); return u ^ ((u >> 31) ? 0xFFFFFFFFu : 0x80000000u); }
__device__ __forceinline__ float gelu_erf(float a) { return 0.5f * a * (1.f + erff(a * 0.70710678118654752f)); }

__device__ __forceinline__ float unordkey(unsigned k) { return __uint_as_float(k ^ ((k >> 31) ? 0x80000000u : 0xFFFFFFFFu)); }
__device__ __forceinline__ float gelu_as(float v) {
    const float av = fabsf(v), t = __builtin_amdgcn_rcpf(av * 0.2316418882f + 1.0f);
    float q = t * 0.5307027145f + (-0.7265760135f); q = q * t + 0.7107068705f; q = q * t + (-0.142248368f); q = q * t + 0.127414796f; q = q * t;
    const float e = __builtin_amdgcn_exp2f((v * v) * (-0.72134752044f));
    const float m = v * (q * e);
    return v < 0.f ? m : v - m;
}

template <class O> struct QuadNet {
    typedef typename O::V V; typedef typename O::B B;
    template <bool ASC> static __device__ __forceinline__ void ce_reg(V& a, V& b) { const V lo = O::vmin(a, b), hi = O::vmax(a, b); a = ASC ? lo : hi; b = ASC ? hi : lo; }
    template <bool ASC> static __device__ __forceinline__ void ce_l1(V& x, B low1) { const V p = O::x1(x); const V mn = O::vmin(p, x), mx = O::vmax(p, x); x = ASC ? O::vsel(low1, mn, mx) : O::vsel(low1, mx, mn); }
    template <bool ASC> static __device__ __forceinline__ void ce_l2(V& x, B low2) { const V p = O::x2(x); const V mn = O::vmin(p, x), mx = O::vmax(p, x); x = ASC ? O::vsel(low2, mn, mx) : O::vsel(low2, mx, mn); }
    template <int NR> static __device__ __forceinline__ void sort_blocks(V (&R)[NR], B low1, B low2, B eq12) {
#pragma unroll
        for (int r = 0; r < NR; ++r) { const V p = O::x1(R[r]); const V mn = O::vmin(p, R[r]), mx = O::vmax(p, R[r]); R[r] = O::vsel(eq12, mn, mx); }
#pragma unroll
        for (int r = 0; r < NR; ++r) { if ((r & 1) == 0) ce_l2<true>(R[r], low2); else ce_l2<false>(R[r], low2); }
#pragma unroll
        for (int r = 0; r < NR; ++r) { if ((r & 1) == 0) ce_l1<true>(R[r], low1); else ce_l1<false>(R[r], low1); }
#pragma unroll
        for (int r = 0; r < NR; r += 2) { if ((r & 2) == 0) ce_reg<true>(R[r], R[r + 1]); else ce_reg<false>(R[r], R[r + 1]); }
#pragma unroll
        for (int r = 0; r < NR; ++r) { if ((r & 2) == 0) ce_l2<true>(R[r], low2); else ce_l2<false>(R[r], low2); }
#pragma unroll
        for (int r = 0; r < NR; ++r) { if ((r & 2) == 0) ce_l1<true>(R[r], low1); else ce_l1<false>(R[r], low1); }
#pragma unroll
        for (int r = 0; r < NR; ++r) { if ((r & 2) == 0) { if ((r & 4) == 0) ce_reg<true>(R[r], R[r + 2]); else ce_reg<false>(R[r], R[r + 2]); } }
#pragma unroll
        for (int r = 0; r < NR; r += 2) { if ((r & 4) == 0) ce_reg<true>(R[r], R[r + 1]); else ce_reg<false>(R[r], R[r + 1]); }
#pragma unroll
        for (int r = 0; r < NR; ++r) { if ((r & 4) == 0) ce_l2<true>(R[r], low2); else ce_l2<false>(R[r], low2); }
#pragma unroll
        for (int r = 0; r < NR; ++r) { if ((r & 4) == 0) ce_l1<true>(R[r], low1); else ce_l1<false>(R[r], low1); }
    }
    template <int NR> static __device__ __forceinline__ void halve_merge(const V (&R)[NR], V (&Q)[NR / 2], B low1, B low2) {
#pragma unroll
        for (int m = 0; m < NR / 8; ++m)
#pragma unroll
            for (int i = 0; i < 4; ++i) Q[4 * m + i] = O::vmax(R[8 * m + i], R[8 * m + 4 + i]);
#pragma unroll
        for (int r = 0; r < NR / 2; ++r) { if ((r & 2) == 0) { if ((r & 4) == 0) ce_reg<false>(Q[r], Q[r + 2]); else ce_reg<true>(Q[r], Q[r + 2]); } }
#pragma unroll
        for (int r = 0; r < NR / 2; r += 2) { if ((r & 4) == 0) ce_reg<false>(Q[r], Q[r + 1]); else ce_reg<true>(Q[r], Q[r + 1]); }
#pragma unroll
        for (int r = 0; r < NR / 2; ++r) { if ((r & 4) == 0) ce_l2<false>(Q[r], low2); else ce_l2<true>(Q[r], low2); }
#pragma unroll
        for (int r = 0; r < NR / 2; ++r) { if ((r & 4) == 0) ce_l1<false>(Q[r], low1); else ce_l1<true>(Q[r], low1); }
    }
    static __device__ __forceinline__ void top16_of_128(V (&R)[32], V (&T)[4], B low1, B low2, B eq12) {
        sort_blocks<32>(R, low1, low2, eq12);
        V A[16]; halve_merge<32>(R, A, low1, low2);
        V Bq[8]; halve_merge<16>(A, Bq, low1, low2);
        halve_merge<8>(Bq, T, low1, low2);
    }
    static __device__ __forceinline__ void top16_of_64(V (&R)[16], V (&T)[4], B low1, B low2, B eq12) {
        sort_blocks<16>(R, low1, low2, eq12);
        V A[8]; halve_merge<16>(R, A, low1, low2);
        halve_merge<8>(A, T, low1, low2);
    }
};

struct DevOps {
    typedef unsigned V; typedef bool B;
    static __device__ __forceinline__ V vmin(V a, V b) { return a < b ? a : b; }
    static __device__ __forceinline__ V vmax(V a, V b) { return a > b ? a : b; }
    static __device__ __forceinline__ V vsel(B m, V a, V b) { return m ? a : b; }
    static __device__ __forceinline__ V x1(V a) { return (V)dpp_i<DPP_XOR1>((int)a); }
    static __device__ __forceinline__ V x2(V a) { return (V)dpp_i<DPP_XOR2>((int)a); }
};
__device__ __forceinline__ void stair_ab(int c, int& a, int& b) {
    if (c < 16) { a = 0; b = c; } else if (c < 24) { a = 1; b = c - 16; } else if (c < 28) { a = 2; b = c - 24; } else if (c < 32) { a = 3; b = c - 28; }
    else if (c < 36) { a = 4; b = c - 32; } else if (c < 40) { a = 5 + ((c - 36) >> 1); b = (c - 36) & 1; } else if (c < 44) { a = 7 + ((c - 40) >> 1); b = (c - 40) & 1; }
    else if (c < 48) { a = 9 + (c - 44); b = 0; } else if (c < 51) { a = 13 + (c - 48); b = 0; } else { a = 2; b = 4; }
}
constexpr int PE_WS = 5120, PE_TAB = 8 * PE_WS;
constexpr int PE_VEC = PE_TAB + 512;
static_assert(PE_VEC + 11 * 8192 <= LDSCTL_OFF, "PE vector cache");
__device__ __forceinline__ void peer_topk(Frame& F, LAS unsigned char* ws, int t) {
    const int lane = F.lane, sub = lane & 3;
    const bool low1 = (sub & 1) == 0, low2 = (sub & 2) == 0, eq12 = low1 == low2;
    LAS unsigned* S1K = (LAS unsigned*)ws; LAS int* EL = (LAS int*)(ws + 3328); LAS float* GL = (LAS float*)(ws + 3840);
    const LAS unsigned short* TAB = (const LAS unsigned short*)(F.lds + PE_TAB);
    {
        const int L = lane >> 2;
        const bf16_t* sp = F.SC() + (size_t)t * D + L * 128 + sub * 32;
        unsigned R[32];
#pragma unroll
        for (int q = 0; q < 4; ++q) { const u32x4 v = *(const u32x4*)(sp + 8 * q);
#pragma unroll
            for (int e = 0; e < 4; ++e) {
                R[8 * q + 2 * e] = (ordkey(bf_lo(v[e])) & ~127u) | (unsigned)(127 - (32 * sub + 8 * q + 2 * e));
                R[8 * q + 2 * e + 1] = (ordkey(bf_hi(v[e])) & ~127u) | (unsigned)(127 - (32 * sub + 8 * q + 2 * e + 1)); } }
        unsigned T[4];
        QuadNet<DevOps>::top16_of_128(R, T, low1, low2, eq12);
#pragma unroll
        for (int r = 0; r < 4; ++r) S1K[L * 16 + 4 * r + sub] = T[r];
    }
    LDS_WAIT(); __builtin_amdgcn_wave_barrier();
    {
        const int hd = (lane >> 2) & 7;
        const LAS unsigned char* la = (const LAS unsigned char*)(S1K + (2 * hd) * 16); const LAS unsigned char* lb = (const LAS unsigned char*)(S1K + (2 * hd + 1) * 16);
        unsigned C[16];
#pragma unroll
        for (int r = 0; r < 13; ++r) { const unsigned ab = TAB[4 * r + sub];
            const unsigned ka = *(const LAS unsigned*)(la + (ab & 255u)), kb = *(const LAS unsigned*)(lb + (ab >> 8));
            const float sum = unordkey(ka & ~127u) + unordkey(kb & ~127u);
            C[r] = (ordkey(sum) & ~63u) | (unsigned)(63 - (4 * r + sub)); }
        C[13] = 0u; C[14] = 0u; C[15] = 0u;
        unsigned W[4];
        QuadNet<DevOps>::top16_of_64(C, W, low1, low2, eq12);
        float sv[4]; int ex[4];
#pragma unroll
        for (int r = 0; r < 4; ++r) { const unsigned ab = TAB[63 - (W[r] & 63u)];
            const unsigned ka = *(const LAS unsigned*)(la + (ab & 255u)), kb = *(const LAS unsigned*)(lb + (ab >> 8));
            ex[r] = (int)(127u - (ka & 127u)) * 128 + (int)(127u - (kb & 127u)); sv[r] = unordkey(W[r] & ~63u); }
        const float mx = dpp_f<0x00>(sv[0]);
        float e4[4], es = 0.f;
#pragma unroll
        for (int r = 0; r < 4; ++r) { e4[r] = __expf(sv[r] - mx); es += e4[r]; }
        es += dpp_f<DPP_XOR1>(es); es += dpp_f<DPP_XOR2>(es);
        const float rd = 1.f / es;
#pragma unroll
        for (int r = 0; r < 4; ++r) { GL[hd * 16 + 4 * r + sub] = e4[r] * rd; EL[hd * 16 + 4 * r + sub] = ex[r]; }
    }
    LDS_WAIT(); __builtin_amdgcn_wave_barrier();
}

#ifndef PROBE_PHASE
#define PROBE_PHASE -1
#endif
#ifndef PROBE_MULT
#define PROBE_MULT 1
#endif
constexpr int EB = 4;
constexpr int CW_TICKET = 20480;

struct GBuf { LpRow<U_FMT> u[EB]; LpRow<V_FMT> v[EB]; };
__device__ __forceinline__ void gather_issue(GBuf& B, const LAS int* EL, int i0, const unsigned char* UTl, const unsigned char* VTl, int lane) {
#pragma unroll
    for (int q = 0; q < EB; ++q) {
        const int ex = __builtin_amdgcn_readfirstlane(EL[i0 + q]);
        B.u[q].load(UTl + (size_t)ex * UROW, lane); B.v[q].load(VTl + (size_t)ex * VROW, lane);
    }
}
__device__ __forceinline__ void gather_compute(const GBuf& B, const LAS int* EL, const LAS float* GL, int i0, const float* USl, const float* VSl, const unsigned (&hv)[16], f32x2 (&acc)[16]) {
    float dot[EB], su[EB], sv[EB], g[EB];
#pragma unroll
    for (int q = 0; q < EB; ++q) { const int ex = __builtin_amdgcn_readfirstlane(EL[i0 + q]); { const f32x2 s2 = *(const f32x2*)(USl + 2 * ex); su[q] = s2.x; sv[q] = s2.y; }
        g[q] = __uint_as_float(__builtin_amdgcn_readfirstlane(__float_as_uint(GL[i0 + q]))); }
#pragma unroll
    for (int q = 0; q < EB; ++q) { float s0 = 0.f, s1 = 0.f;
        B.u[q].each_bf([&](int i, bf16x2_t x) { if (i & 1) s1 = __builtin_amdgcn_fdot2_f32_bf16(x, __builtin_bit_cast(bf16x2_t, hv[i]), s1, false); else s0 = __builtin_amdgcn_fdot2_f32_bf16(x, __builtin_bit_cast(bf16x2_t, hv[i]), s0, false); });
        dot[q] = s0 + s1; __builtin_amdgcn_sched_barrier(0); }
#pragma unroll
    for (int q = 0; q < EB; ++q) dot[q] = wave_sum_u(dot[q]);
#pragma unroll
    for (int q = 0; q < EB; ++q) { const float cf = g[q] * gelu_as(dot[q] * su[q]) * sv[q]; const f32x2 c2 = {cf, cf};
        B.v[q].each([&](int i, float x0, float x1) { const f32x2 x = {x0, x1}; acc[i >> 1] = __builtin_elementwise_fma(x, c2, acc[i >> 1]); }); __builtin_amdgcn_sched_barrier(0); }
}

__device__ __forceinline__ void peer_phase(Frame& F, int layer, int rows, unsigned* ctl, unsigned long long& pr_acc) {
    unsigned long long pt0 = 0ull;
#define SUB_BEGIN(ty) do { if (PROBE_PHASE == (ty)) pt0 = __builtin_amdgcn_s_memrealtime(); } while (0)
#define SUB_END(ty) do { if (PROBE_PHASE == (ty)) pr_acc += __builtin_amdgcn_s_memrealtime() - pt0; } while (0)
    if (F.tid < 64) { int a = 0, b = 0; stair_ab(F.tid < 52 ? F.tid : 0, a, b); *(LAS unsigned short*)(F.lds + PE_TAB + 2 * F.tid) = (unsigned short)((4 * a) | ((4 * b) << 8)); }
    {
        const int ch = F.tid, ll = ch >> 3, q = ch & 7;
        LAS unsigned char* dst = F.lds + PE_VEC + (q * 64 + ll) * 16;
        const int nl = layer < NLAYER - 1 ? layer + 1 : layer;
#pragma unroll 1
        for (int v = 0; v < 9; ++v) {
            const int g3 = v / 3, mrv = v - 3 * g3;
            const size_t off = ((size_t)(g3 == 0 ? layer : nl) * 3 + mrv) * 12288 + (g3 == 0 ? 5 * D : (g3 == 1 ? 0 : D));
            *(LAS f32x4*)(dst + v * 8192) = *(const f32x4*)(F.MODS() + off + 4 * ch);
        }
        *(LAS f32x4*)(dst + 9 * 8192) = *(const f32x4*)(F.ln2_g() + layer * D + 4 * ch);
        *(LAS f32x4*)(dst + 10 * 8192) = *(const f32x4*)(F.ln2_b() + layer * D + 4 * ch);
    }
    __syncthreads();
    LAS unsigned char* ws = F.lds + F.wave * PE_WS;
    LAS int* EL = (LAS int*)(ws + 3328); LAS float* GL = (LAS float*)(ws + 3840);
    const int lane = F.lane;
    const LAS unsigned char* vcache = F.lds + PE_VEC + lane * 16;
    const unsigned char* UTl = F.UT() + (size_t)layer * NEXP * UROW;
    const unsigned char* VTl = F.VT() + (size_t)layer * NEXP * VROW;
    const float* USl = F.US() + 2 * (size_t)layer * NEXP; const float* VSl = nullptr;
    unsigned* ticket = ctl + CW_TICKET + 64 * layer;
    unsigned tk = 0u;
    if (lane == 0) tk = __hip_atomic_fetch_add(ticket, 1u, __ATOMIC_RELAXED, __HIP_MEMORY_SCOPE_AGENT);
    int t = (int)__builtin_amdgcn_readfirstlane(tk);
    while (t < rows) {
        unsigned tkn = 0u;
        if (lane == 0) tkn = __hip_atomic_fetch_add(ticket, 1u, __ATOMIC_RELAXED, __HIP_MEMORY_SCOPE_AGENT);
        SUB_BEGIN(8); peer_topk(F, ws, t); SUB_END(8);
        SUB_BEGIN(9);
        unsigned hv[16]; f32x2 acc[16];
#pragma unroll
        for (int q = 0; q < 4; ++q) { const u32x4 w = *(const u32x4*)(F.H() + (size_t)t * D + 32 * lane + 8 * q);
#pragma unroll
            for (int e = 0; e < 4; ++e) { hv[4 * q + e] = w[e]; acc[4 * q + e] = (f32x2){0.f, 0.f}; } }
        {
            GBuf A, B, C;
            gather_issue(A, EL, 0, UTl, VTl, lane);
            gather_issue(B, EL, EB, UTl, VTl, lane);
            for (int i0 = 0; i0 < 30 * EB; i0 += 3 * EB) {
                gather_issue(C, EL, i0 + 2 * EB, UTl, VTl, lane);
                gather_compute(A, EL, GL, i0, USl, VSl, hv, acc);
                gather_issue(A, EL, i0 + 3 * EB, UTl, VTl, lane);
                gather_compute(B, EL, GL, i0 + EB, USl, VSl, hv, acc);
                gather_issue(B, EL, i0 + 4 * EB, UTl, VTl, lane);
                gather_compute(C, EL, GL, i0 + 2 * EB, USl, VSl, hv, acc);
            }
            gather_compute(A, EL, GL, 30 * EB, USl, VSl, hv, acc);
            gather_compute(B, EL, GL, 31 * EB, USl, VSl, hv, acc);
        }
        SUB_END(9); SUB_BEGIN(10);
        const int mr = modrow(t);
        const float* mp = F.MODS() + ((size_t)layer * 3 + mr) * 12288;
        bf16_t* xr = F.X() + (size_t)t * D;
        float rr[32]; float s = 0.f;
#pragma unroll
        for (int q2 = 0; q2 < 4; ++q2) { const u32x4 xw = *(const u32x4*)(xr + 32 * lane + 8 * q2);
#pragma unroll
            for (int h2 = 0; h2 < 2; ++h2) { const int q = 2 * q2 + h2; const f32x4 gv = *(const LAS f32x4*)(vcache + mr * 8192 + q * 1024);
                const f32x4 xv = {bf_lo(xw[2 * h2]), bf_hi(xw[2 * h2]), bf_lo(xw[2 * h2 + 1]), bf_hi(xw[2 * h2 + 1])};
                const f32x4 av = {acc[2 * q].x, acc[2 * q].y, acc[2 * q + 1].x, acc[2 * q + 1].y};
#pragma unroll
                for (int e = 0; e < 4; ++e) { const float v = DN_ALPHA * xv[e] + gv[e] * av[e]; rr[4 * q + e] = v; s += v; } } }
        const float mean = wave_sum_u(s) * (1.f / D);
        float s2 = 0.f;
#pragma unroll
        for (int i = 0; i < 32; ++i) { rr[i] -= mean; s2 += rr[i] * rr[i]; }
        const float rstd = 1.f / sqrtf(wave_sum_u(s2) * (1.f / D) + LN_EPS);
        const float* g2 = F.ln2_g() + layer * D; const float* b2 = F.ln2_b() + layer * D;
        float s3 = 0.f;
#pragma unroll
        for (int q = 0; q < 8; ++q) { const int c = 32 * lane + 4 * q; const f32x4 gg = *(const LAS f32x4*)(vcache + 9 * 8192 + q * 1024), bb = *(const LAS f32x4*)(vcache + 10 * 8192 + q * 1024);
            f32x4 xo;
#pragma unroll
            for (int e = 0; e < 4; ++e) { xo[e] = rr[4 * q + e] * rstd * gg[e] + bb[e]; rr[4 * q + e] = xo[e]; s3 += xo[e]; }
            if (layer == NLAYER - 1 && t < TL) *(f32x4*)(F.out() + (size_t)t * D + c) = xo; }
        if (layer < NLAYER - 1) {
#pragma unroll
            for (int q2 = 0; q2 < 4; ++q2) { u32x4 o4; o4.x = pk2(rr[8 * q2], rr[8 * q2 + 1]); o4.y = pk2(rr[8 * q2 + 2], rr[8 * q2 + 3]); o4.z = pk2(rr[8 * q2 + 4], rr[8 * q2 + 5]); o4.w = pk2(rr[8 * q2 + 6], rr[8 * q2 + 7]);
                *(u32x4*)(xr + 32 * lane + 8 * q2) = o4; }
            const float mean2 = wave_sum_u(s3) * (1.f / D);
            float s4 = 0.f;
#pragma unroll
            for (int i = 0; i < 32; ++i) { rr[i] -= mean2; s4 += rr[i] * rr[i]; }
            const float rstd2 = 1.f / sqrtf(wave_sum_u(s4) * (1.f / D) + LN_EPS);
            const float* np = F.MODS() + ((size_t)(layer + 1) * 3 + mr) * 12288;
#pragma unroll
            for (int q4 = 0; q4 < 2; ++q4) { u32x4 w;
#pragma unroll
                for (int q = 0; q < 4; ++q) { const int qq = 4 * q4 + q; const f32x4 sh = *(const LAS f32x4*)(vcache + (3 + mr) * 8192 + qq * 1024), sc = *(const LAS f32x4*)(vcache + (6 + mr) * 8192 + qq * 1024); const int ri = 4 * qq;
                    const float y0 = rr[ri] * rstd2 * (1.f + sc[0]) + sh[0], y1 = rr[ri + 1] * rstd2 * (1.f + sc[1]) + sh[1];
                    const float y2 = rr[ri + 2] * rstd2 * (1.f + sc[2]) + sh[2], y3 = rr[ri + 3] * rstd2 * (1.f + sc[3]) + sh[3];
                    int o = __builtin_amdgcn_cvt_pk_fp8_f32(y0, y1, 0, false); o = __builtin_amdgcn_cvt_pk_fp8_f32(y2, y3, o, true); w[q] = (unsigned)o; }
                *(u32x4*)(F.H8() + (size_t)t * D + 32 * lane + 16 * q4) = w; }
        }
        SUB_END(10);
        t = (int)__builtin_amdgcn_readfirstlane(tkn);
    }
#undef SUB_BEGIN
#undef SUB_END
}

__global__ void __launch_bounds__(NWAVES * 64, 2) skel_fwd(Args args) {
    extern __shared__ __attribute__((aligned(16))) unsigned char lds[];
    Frame F;
    F.lds = (LAS unsigned char*)lds;
    F.tid = threadIdx.x; F.lane = F.tid & 63; F.wave = __builtin_amdgcn_readfirstlane(F.tid >> 6);
    F.G = gridDim.x; F.gw = blockIdx.x * NWAVES + F.wave; F.NGW = F.G * NWAVES;
    unsigned char* ws = args.ws;
    F.ka = (const CAS unsigned char*)__builtin_amdgcn_kernarg_segment_ptr();
    for (int u = F.tid; u < (LDS_BYTES - LDSCTL_OFF) / 4; u += NWAVES * 64) ((LAS unsigned*)(F.lds + LDSCTL_OFF))[u] = 0u;
    __syncthreads();
    unsigned* ctl = (unsigned*)(ws + WS_CTL);
    const int lo = args.ph_lo, hi = args.ph_hi;
    XcdBarrier bar; bar.bar = ctl + CW_BAR + args.li * XCD_BAR_WORDS; bar.x = 0; bar.st = nullptr;
    if (hi - lo > 1) bar = xcd_barrier_post(ctl + CW_BAR + args.li * XCD_BAR_WORDS, (volatile LAS unsigned*)(F.lds + MISC_OFF) + 8);
#define IN(k) (lo <= (k) && (k) < hi)
    unsigned long long pr_acc = 0ull, pr_t0 = 0ull;
#define PR_BEGIN(ty) do { if (PROBE_PHASE == (ty)) pr_t0 = __builtin_amdgcn_s_memrealtime(); } while (0)
#define PR_END(ty) do { if (PROBE_PHASE == (ty)) pr_acc += __builtin_amdgcn_s_memrealtime() - pr_t0; } while (0)
#define BOTH(k) (IN(k) && IN((k) + 1))
#define SEAM(k) do { if (BOTH(k)) xcd_barrier(bar); } while (0)

    if (IN(0)) { PR_BEGIN(0); frame_ids(F); p0a_prologue(F); SEAM(0); PR_END(0); }
    if (IN(1)) {
        PR_BEGIN(1); frame_ids(F);
        { pg8::Gemm g{F.KBD(), F.WQR(), 32 * 256, 2048, 256}; pg8::BatchOrder S{F.G, (int)blockIdx.x}; pg8::EpiBf16 E{F.WEFFT(), D, 1.f};
          pg8::gemm_phase<pg8::EpiBf16, pg8::BatchOrder, false, true>(F.lds, g, S, E); }
        p0b_mod0(F);
        SEAM(1); PR_END(1);
    }
    for (int layer = 0; layer < NLAYER; ++layer) {
        const int pb = 2 + 6 * layer;
        const bool lastl = layer == NLAYER - 1;
        const int rows = lastl ? TL : TT;
        if (IN(pb + 0)) {
            PR_BEGIN(2); frame_ids(F);
            pg8::Gemm g{(const bf16_t*)F.H8(), (const bf16_t*)(F.WINT() + (size_t)layer * INC * D), TT, INC, D / 2}; pg8::StaticOrder S; S.init(TT, INC, F.G, (int)blockIdx.x);
            pg8::EpiBf16 E{F.PROJ(), INC, 1.f / WIN_SCALE};
            pg8::gemm_phase<pg8::EpiBf16, pg8::StaticOrder, false, false, true, false, true>(F.lds, g, S, E);
            SEAM(pb + 0); PR_END(2);
        }
        if (IN(pb + 1)) {
            PR_BEGIN(3); frame_ids(F);
            const int nunits = lastl ? 512 : 528;
            {
                const int ch = F.tid & 255, vsel = F.tid >> 8;
                LAS unsigned char* dst = F.lds + CONV_LDS + ((2 * (ch >> 7) + (ch & 1)) * 64 + ((ch & 127) >> 1)) * 16;
                *(LAS f32x4*)(dst + vsel * 4096) = *(const f32x4*)(F.conv_w() + (size_t)layer * 3 * 1024 + vsel * 1024 + 4 * ch);
                *(LAS f32x4*)(dst + (2 + vsel) * 4096) = vsel == 0 ? *(const f32x4*)(F.conv_w() + (size_t)layer * 3 * 1024 + 2048 + 4 * ch) : *(const f32x4*)(F.g_conv() + layer * 1024 + 4 * ch);
            }
            for (int i = F.tid; i < 192 * 32 * 2 / 4; i += NWAVES * 64) *(LAS f32x4*)(F.lds + ROPE_LDS + (i >> 4) * ROPE_RS + (i & 15) * 16) = *(const f32x4*)(F.ROPE() + 4 * i);
            __syncthreads();
            { unsigned long long q0 = 0; if (PROBE_PHASE == 11) q0 = __builtin_amdgcn_s_memrealtime();
            { const int bx = (int)blockIdx.x, vcu = (F.G % 8 == 0) ? (bx % 8) * (F.G / 8) + bx / 8 : bx;
              attn_units(F, layer, vcu, F.G, nunits); }
            if (PROBE_PHASE == 11) pr_acc += __builtin_amdgcn_s_memrealtime() - q0; if (PROBE_PHASE == 12) q0 = __builtin_amdgcn_s_memrealtime();
            {
              const int nx = nunits - 2 * F.G; const bool uneven = nx > 0 && nx < F.G;
              const int bx2 = (int)blockIdx.x, vc2 = (F.G % 8 == 0) ? (bx2 % 8) * (F.G / 8) + bx2 / 8 : bx2;
              const int c0 = uneven ? vc2 - nx : vc2, nb = uneven ? F.G - nx : F.G;
              if (c0 >= 0) { const int nwv = nb * NWAVES, chn = (rows + nwv - 1) / nwv, wi = c0 * NWAVES + F.wave;
                  conv_rows(F, layer, wi * chn, (wi + 1) * chn < rows ? (wi + 1) * chn : rows); } }
            if (PROBE_PHASE == 12) pr_acc += __builtin_amdgcn_s_memrealtime() - q0; }
            SEAM(pb + 1); PR_END(3);
        }
        if (IN(pb + 2)) {
            PR_BEGIN(4); frame_ids(F);
            pg8::Gemm g{(const bf16_t*)F.MIX(), (const bf16_t*)(F.WOUTT() + (size_t)layer * D * D), rows, D, D / 2}; pg8::StaticOrder S; S.init(rows, D, F.G, (int)blockIdx.x);
            pg8::EpiBf16 E{F.PROJ(), D, 1.f / WOUT_SCALE};
            pg8::gemm_phase<pg8::EpiBf16, pg8::StaticOrder, false, false, true, false, true>(F.lds, g, S, E);
            frame_ids(F); convert_in_tail(F, layer, (rows / 256) * (D / 256), 0);
            SEAM(pb + 2); PR_END(4);
        }
        if (IN(pb + 3)) { PR_BEGIN(5); frame_ids(F); ln_phase(F, layer, rows); SEAM(pb + 3); PR_END(5); }
        if (IN(pb + 4)) {
            PR_BEGIN(6); frame_ids(F);
            pg8::Gemm g{F.H(), F.WEFFT() + (size_t)layer * D * D, rows, D, D}; pg8::StaticOrder S; S.init(rows, D, F.G, (int)blockIdx.x);
            pg8::EpiBf16 E{F.SC(), D, 1.f};
            pg8::gemm_phase<pg8::EpiBf16, pg8::StaticOrder, true, true>(F.lds, g, S, E);
            frame_ids(F); convert_in_tail(F, layer, (rows / 256) * (D / 256), 1);
            SEAM(pb + 4); PR_END(6);
        }
        if (IN(pb + 5)) { PR_BEGIN(7); frame_ids(F); peer_phase(F, layer, rows, ctl, pr_acc); SEAM(pb + 5); PR_END(7); }
    }
    if (PROBE_PHASE >= 0 && hi - lo > 1) xcd_barrier(bar);
    if (PROBE_PHASE >= 0 && blockIdx.x == 0 && threadIdx.x == 0) { const unsigned long long t1 = __builtin_amdgcn_s_memrealtime() + (unsigned long long)PROBE_MULT * pr_acc; while (__builtin_amdgcn_s_memrealtime() < t1) __builtin_amdgcn_s_sleep(8); }
#undef IN
#undef BOTH
#undef SEAM
}

extern "C" void kernel_launch(void* const* d_in, const int* in_sizes, int n_in, void* d_out, int out_size, void* d_ws, size_t ws_size, hipStream_t stream) {
    static int grid = 0;
    if (grid == 0) {
        if (n_in != 20 || in_sizes[0] != TL * D || out_size != TL * D || ws_size < WS_END) {
            fprintf(stderr, "kernel_launch: unexpected problem shape (n_in %d, in0 %d, out %d, ws %zu, need %zu)\n", n_in, n_in > 0 ? in_sizes[0] : -1, out_size, ws_size, (size_t)WS_END); grid = -1; return; }
        int dev = 0, cus = 0, per_cu = 0;
        if (hipGetDevice(&dev) != hipSuccess || hipDeviceGetAttribute(&cus, hipDeviceAttributeMultiprocessorCount, dev) != hipSuccess) { grid = -1; return; }
        if (hipFuncSetAttribute((const void*)skel_fwd, hipFuncAttributeMaxDynamicSharedMemorySize, LDS_BYTES) != hipSuccess) { fprintf(stderr, "kernel_launch: hipFuncSetAttribute failed\n"); grid = -1; return; }
        if (hipOccupancyMaxActiveBlocksPerMultiprocessor(&per_cu, (const void*)skel_fwd, NWAVES * 64, LDS_BYTES) != hipSuccess || per_cu < 1)
            fprintf(stderr, "kernel_launch: occupancy query reports %d workgroups per CU\n", per_cu);
        (void)hipGetLastError();
        grid = cus;
    }
    if (grid < 0) return;
    if (hipMemsetAsync((char*)d_ws + WS_CTL, 0, CTL_ZERO_BYTES, stream) != hipSuccess) return;
    Args a{};
    for (int i = 0; i < 20; ++i) a.in[i] = (const float*)d_in[i];
    a.out = (float*)d_out; a.ws = (unsigned char*)d_ws; a.pad = 0;
#if MK_N_LAUNCHES == 1
    a.ph_lo = 0; a.ph_hi = NPHASE; a.li = 0;
    hipLaunchKernelGGL(skel_fwd, dim3(grid), dim3(NWAVES * 64), LDS_BYTES, stream, a);
#else
    for (int ph = 0; ph < NPHASE; ++ph) { a.ph_lo = ph; a.ph_hi = ph + 1; a.li = 0;
        hipLaunchKernelGGL(skel_fwd, dim3(grid), dim3(NWAVES * 64), LDS_BYTES, stream, a); }
#endif
}
```

```cpp
#include <hip/hip_runtime.h>
#include <cstdio>
#include <cstdint>

#ifndef MK_N_LAUNCHES
#define MK_N_LAUNCHES 1
#endif

#define LAS __attribute__((address_space(3)))
typedef unsigned short bf16_t;
typedef short bf16x8 __attribute__((ext_vector_type(8)));
typedef short s16x4 __attribute__((ext_vector_type(4)));
typedef float f32x2 __attribute__((ext_vector_type(2)));
typedef float f32x4 __attribute__((ext_vector_type(4)));
typedef float f32x16 __attribute__((ext_vector_type(16)));
typedef unsigned u32x2 __attribute__((ext_vector_type(2)));
typedef unsigned u32x4 __attribute__((ext_vector_type(4)));
typedef __bf16 bf16x2_t __attribute__((ext_vector_type(2)));
typedef int i32x8 __attribute__((ext_vector_type(8)));

constexpr int D = 2048, NB = 2, SEQ = 8192, CTXL = 256, NLAYER = 4;
constexpr int TL = NB * SEQ, TC = NB * CTXL, TT = TL + TC;
constexpr int INC = 4608, OFF_C = 1024, OFF_X = 2048, OFF_Q = 3072, OFF_K = 4096, OFF_V = 4352;
constexpr float WOUT_SCALE = 128.f;
constexpr float WEFF_SCALE = 64.f;
constexpr float WIN_SCALE = 64.f;
constexpr int NEXP = 16384;
#ifndef U_FMT
#define U_FMT 4
#endif
#ifndef V_FMT
#define V_FMT 4
#endif
constexpr int UROW = D * U_FMT / 8, VROW = D * V_FMT / 8;
constexpr float LN_EPS = 1e-6f;
constexpr float DN_ALPHA = 1.681792830507429f;
constexpr float QSCALE = 0.08838834764831845f * 1.4426950408889634f;
constexpr float LOG2E = 1.4426950408889634f;

constexpr size_t MiB = 1u << 20;
constexpr size_t WS_CTL = 0, CTL_ZERO_BYTES = 2 * MiB;
constexpr size_t WS_MODS = 1 * MiB;
constexpr size_t WS_ROPE = 2 * MiB;
constexpr size_t WS_KBD = 3 * MiB;
constexpr size_t WS_WQR = 8 * MiB;
constexpr size_t WS_WINT = 40 * MiB;
constexpr size_t WS_WOUTT = 112 * MiB;
constexpr size_t WS_WEFFT = 144 * MiB;
constexpr size_t WS_X = 176 * MiB;
constexpr size_t WS_H = 308 * MiB;
constexpr size_t WS_PROJ = 374 * MiB;
constexpr size_t WS_MIX = 523 * MiB;
constexpr size_t WS_SC = 589 * MiB;
constexpr size_t WS_UT = 721 * MiB;
constexpr size_t WS_VT = 849 * MiB;
constexpr size_t WS_US = 977 * MiB;
constexpr size_t WS_VS = 978 * MiB;
constexpr size_t WS_H8 = 979 * MiB;
constexpr size_t WS_END = 1013 * MiB;

constexpr int CW_BAR = 4096;

namespace pg8 {
constexpr int BM = 256, BK = 64, HALF = 128, HTB = HALF * BK * 2, STAGE_BYTES = 8 * HTB, NXCD = 8, WGM = 4;
__host__ __device__ __forceinline__ int lds_byte(int r, int c) { const int st = (r >> 4) * 2 + (c >> 5), rr = r & 15, cc = c & 31, ob = rr * 64 + cc * 2; return st * 1024 + (ob ^ (((ob >> 9) & 1) << 5)); }
__host__ __device__ __forceinline__ void stage_rc(int b, int& R, int& C) { const int st = b / 1024, sb = b % 1024, swz = sb ^ (((sb >> 9) & 1) << 5); R = (st >> 1) * 16 + swz / 64; C = (st & 1) * 32 + (swz % 64) / 2; }
__host__ __device__ __forceinline__ int lds_byte8(int r, int c) { const int st = (r >> 4) * 2 + (c >> 2); return st * 1024 + (((r & 15) * 64 + (c & 3) * 16) ^ (((r >> 3) & 1) << 4)); }
__host__ __device__ __forceinline__ void stage_rc8(int b, int& R, int& C) { const int st = b / 1024, sb = b % 1024, rr = sb / 64, cj = ((sb % 64) / 16) ^ ((rr >> 3) & 1); R = (st >> 1) * 16 + rr; C = ((st & 1) * 4 + cj) * 8; }
__host__ __device__ __forceinline__ int perm32(int rho) { const int n = rho >> 4, i = rho & 15; return 8 * (i >> 2) + 4 * n + (i & 3); }

struct Unit { int pm, pn; };
struct Gemm { const bf16_t* A; const bf16_t* Bt; int M, N, K; };

struct StaticOrder {
    static constexpr bool BD = false;
    int nM, nN, nwg, G, c;
    __host__ __device__ void init(int M, int N, int G_, int c_) { nM = M / BM; nN = N / BM; nwg = nM * nN; G = G_; c = c_; }
    __host__ __device__ bool next(int i, Unit& u) const {
        const long L = (long)i * G + c; if (L >= nwg) return false;
        int wgid = (int)L; { const int q = nwg / NXCD, r = nwg % NXCD, xcd = wgid % NXCD, off = wgid / NXCD; wgid = (xcd < r ? xcd * (q + 1) : r * (q + 1) + (xcd - r) * q) + off; }
        const int nig = WGM * nN, gid = wgid / nig, fm = gid * WGM, gsz = (nM - fm) < WGM ? (nM - fm) : WGM;
        u.pm = fm + ((wgid % nig) % gsz); u.pn = (wgid % nig) / gsz; return true;
    }
    __device__ __forceinline__ int btile(const Unit& u) const { return u.pn; }
    __device__ __forceinline__ void a_ready(const Unit&) const {}
    __device__ __forceinline__ void done(const Unit&) const {}
};
struct BatchOrder {
    static constexpr bool BD = true;
    int G, c;
    __device__ bool next(int i, Unit& u) const { const int L = i * G + c; if (L >= 256) return false; u.pm = L >> 3; u.pn = L & 7; return true; }
    __device__ __forceinline__ int btile(const Unit& u) const { return u.pm * 8 + u.pn; }
    __device__ __forceinline__ void a_ready(const Unit&) const {}
    __device__ __forceinline__ void done(const Unit&) const {}
};

__device__ __forceinline__ unsigned cvt_pk_bf16(float lo, float hi) { f32x2 x = {lo, hi}; bf16x2_t y = __builtin_convertvector(x, bf16x2_t); return __builtin_bit_cast(unsigned, y); }

struct EpiBf16 {
    static constexpr bool PERM = true;
    bf16_t* O; int ldc; float scale;
    __device__ __forceinline__ void operator()(const f32x4 (&acc)[2][2][4][2], const Unit& u, int wr, int wc, int fr, int fq) const {
        const int row0 = u.pm * BM + wr * 64 + fr, col0 = u.pn * BM + wc * 32 + 8 * fq;
#pragma unroll
        for (int ai = 0; ai < 2; ++ai)
#pragma unroll
            for (int m = 0; m < 4; ++m) { bf16_t* rowp = O + (size_t)(row0 + ai * HALF + m * 16) * ldc + col0;
#pragma unroll
                for (int bj = 0; bj < 2; ++bj) { const f32x4 v0 = acc[ai][bj][m][0] * scale, v1 = acc[ai][bj][m][1] * scale;
                    u32x4 w; w.x = cvt_pk_bf16(v0[0], v0[1]); w.y = cvt_pk_bf16(v0[2], v0[3]); w.z = cvt_pk_bf16(v1[0], v1[1]); w.w = cvt_pk_bf16(v1[2], v1[3]);
                    *(u32x4*)(rowp + bj * HALF) = w; } }
    }
};
struct EpiFp8 {
    static constexpr bool PERM = true;
    unsigned char* O; int ldc; float scale;
    __device__ __forceinline__ void operator()(const f32x4 (&acc)[2][2][4][2], const Unit& u, int wr, int wc, int fr, int fq) const {
        const int row0 = u.pm * BM + wr * 64 + fr, col0 = u.pn * BM + wc * 32 + 8 * fq;
#pragma unroll
        for (int ai = 0; ai < 2; ++ai)
#pragma unroll
            for (int m = 0; m < 4; ++m) { unsigned char* rowp = O + (size_t)(row0 + ai * HALF + m * 16) * ldc + col0;
#pragma unroll
                for (int bj = 0; bj < 2; ++bj)
#pragma unroll
                    for (int n = 0; n < 2; ++n) { const f32x4 v0 = acc[ai][bj][m][n];
                        int t0 = __builtin_amdgcn_cvt_pk_fp8_f32(v0[0] * scale, v0[1] * scale, 0, false); t0 = __builtin_amdgcn_cvt_pk_fp8_f32(v0[2] * scale, v0[3] * scale, t0, true);
                        *(unsigned*)(rowp + bj * HALF + 4 * n) = (unsigned)t0; } }
    }
};
struct EpiBf16H {
    static constexpr bool PERM = true;
    bf16_t* O; int ldc; float scale;
    __device__ __forceinline__ void operator()(const f32x4 (&acc)[2][2][4][2], const Unit& u, int wr, int wc, int fr, int fq) const {
        const int row0 = u.pm * BM + wr * 64 + fr, col0 = u.pn * HALF + wc * 32 + 8 * fq;
#pragma unroll
        for (int ai = 0; ai < 2; ++ai)
#pragma unroll
            for (int m = 0; m < 4; ++m) { const f32x4 v0 = acc[ai][0][m][0] * scale, v1 = acc[ai][0][m][1] * scale;
                u32x4 w; w.x = cvt_pk_bf16(v0[0], v0[1]); w.y = cvt_pk_bf16(v0[2], v0[3]); w.z = cvt_pk_bf16(v1[0], v1[1]); w.w = cvt_pk_bf16(v1[2], v1[3]);
                *(u32x4*)(O + (size_t)(row0 + ai * HALF + m * 16) * ldc + col0) = w; }
    }
};
struct EpiF32 {
    static constexpr bool PERM = false;
    float* C; int ldc;
    __device__ __forceinline__ void operator()(const f32x4 (&acc)[2][2][4][2], const Unit& u, int wr, int wc, int fr, int fq) const {
        const int row0 = u.pm * BM + wr * 64 + fr, col0 = u.pn * BM + wc * 32 + 4 * fq;
#pragma unroll
        for (int ai = 0; ai < 2; ++ai)
#pragma unroll
            for (int m = 0; m < 4; ++m) { float* rowp = C + (size_t)(row0 + ai * HALF + m * 16) * ldc + col0;
#pragma unroll
                for (int bj = 0; bj < 2; ++bj)
#pragma unroll
                    for (int n = 0; n < 2; ++n) *(f32x4*)(rowp + bj * HALF + n * 16) = acc[ai][bj][m][n]; }
    }
};
struct EpiResid {
    static constexpr bool PERM = true;
    const float* x32_lat; const float* x32_ctx;
    bf16_t* X; const float* gate;
    __device__ __forceinline__ void operator()(const f32x4 (&acc)[2][2][4][2], const Unit& u, int wr, int wc, int fr, int fq) const {
        const int rt = u.pm * BM;
        const int mr = rt < TL ? rt / SEQ : 2;
        const int row0 = rt + wr * 64 + fr, col0 = u.pn * BM + wc * 32 + 8 * fq;
        f32x4 gv[2][2];
#pragma unroll
        for (int bj = 0; bj < 2; ++bj)
#pragma unroll
            for (int n = 0; n < 2; ++n) gv[bj][n] = *(const f32x4*)(gate + (size_t)mr * 12288 + col0 + bj * HALF + 4 * n);
#pragma unroll
        for (int ai = 0; ai < 2; ++ai)
#pragma unroll
            for (int m = 0; m < 4; ++m) { const int row = row0 + ai * HALF + m * 16;
#pragma unroll
                for (int bj = 0; bj < 2; ++bj) {
                    f32x4 x0, x1;
                    if (x32_lat) { const float* xp = (row < TL ? x32_lat + (size_t)row * D : x32_ctx + (size_t)(row - TL) * D) + col0 + bj * HALF; x0 = *(const f32x4*)xp; x1 = *(const f32x4*)(xp + 4); }
                    else { const u32x4 w = *(const u32x4*)(X + (size_t)row * D + col0 + bj * HALF);
                        x0 = (f32x4){__uint_as_float(w.x << 16), __uint_as_float(w.x & 0xffff0000u), __uint_as_float(w.y << 16), __uint_as_float(w.y & 0xffff0000u)};
                        x1 = (f32x4){__uint_as_float(w.z << 16), __uint_as_float(w.z & 0xffff0000u), __uint_as_float(w.w << 16), __uint_as_float(w.w & 0xffff0000u)}; }
                    const f32x4 r0 = x0 * DN_ALPHA + gv[bj][0] * acc[ai][bj][m][0], r1 = x1 * DN_ALPHA + gv[bj][1] * acc[ai][bj][m][1];
                    u32x4 o; o.x = cvt_pk_bf16(r0[0], r0[1]); o.y = cvt_pk_bf16(r0[2], r0[3]); o.z = cvt_pk_bf16(r1[0], r1[1]); o.w = cvt_pk_bf16(r1[2], r1[3]);
                    *(u32x4*)(X + (size_t)row * D + col0 + bj * HALF) = o; } }
    }
};

template <class Epi, class Sched, bool ALIGN_EPI = false, bool SP2 = false, bool FP8 = false, bool HN = false, bool BR = false>
__device__ __forceinline__ void gemm_phase(LAS unsigned char* lds, const Gemm g, const Sched& S, const Epi& E) {
    int tid = threadIdx.x; asm volatile("" : "+v"(tid));
    const int wid = __builtin_amdgcn_readfirstlane(tid >> 6), lane = tid & 63, wr = wid >> 2, wc = wid & 3, fr = lane & 15, fq = lane >> 4;
    const int K = g.K, nt = K / BK;
    unsigned voffA[2], voffB[2];
#pragma unroll
    for (int i = 0; i < 2; ++i) { int R, C; if constexpr (FP8) stage_rc8(tid * 16 + i * 8192, R, C); else stage_rc(tid * 16 + i * 8192, R, C); const int Rb = Epi::PERM ? ((R & ~31) + perm32(R & 31)) : R;
        voffA[i] = (unsigned)(R * K + C) * 2u; voffB[i] = (unsigned)(Rb * K + C) * 2u; }
    const size_t kstep = (size_t)(BK * 2);
    const size_t hstep = (size_t)HALF * K * 2;
    const size_t tstep = 2 * hstep;
    const unsigned ldsw = (unsigned)wid * 1024u;
    const int aoff = lds_byte(wr * 64 + fr, fq * 8), boff = lds_byte(wc * 32 + fr, fq * 8);
    const int aoff8a = lds_byte8(wr * 64 + fr, 2 * fq), boff8a = lds_byte8(wc * 32 + fr, 2 * fq), aoff8b = aoff8a ^ 16, boff8b = boff8a ^ 16;
#define PG8_SA(b, h) (((b) * 2 + (h)) * HTB)
#define PG8_SB(b, h) ((4 + (b) * 2 + (h)) * HTB)
#define PG8_STAGE(bufoff, gbase, voff) do { _Pragma("unroll") for (int _i = 0; _i < 2; ++_i) \
        __builtin_amdgcn_global_load_lds((const unsigned*)((const char*)(gbase) + (voff)[_i]), (LAS unsigned*)(lds + (bufoff) + ldsw + _i * 8192), 16, 0, 0); } while (0)
#define PG8_LDA(dst, b, h) do { if constexpr (FP8) { _Pragma("unroll") for (int m = 0; m < 4; ++m) { const u32x4 _x = *(const LAS u32x4*)(lds + PG8_SA(b, h) + aoff8a + m * 2048), _y = *(const LAS u32x4*)(lds + PG8_SA(b, h) + aoff8b + m * 2048); \
            dst##8[m] = (i32x8){(int)_x.x, (int)_x.y, (int)_x.z, (int)_x.w, (int)_y.x, (int)_y.y, (int)_y.z, (int)_y.w}; } } \
        else { _Pragma("unroll") for (int m = 0; m < 4; ++m) _Pragma("unroll") for (int k = 0; k < 2; ++k) dst[m][k] = *(const LAS bf16x8*)(lds + PG8_SA(b, h) + aoff + m * 2048 + k * 1024); } } while (0)
#define PG8_LDB(dst, b, h) do { if constexpr (FP8) { _Pragma("unroll") for (int n = 0; n < 2; ++n) { const u32x4 _x = *(const LAS u32x4*)(lds + PG8_SB(b, h) + boff8a + n * 2048), _y = *(const LAS u32x4*)(lds + PG8_SB(b, h) + boff8b + n * 2048); \
            dst##8[n] = (i32x8){(int)_x.x, (int)_x.y, (int)_x.z, (int)_x.w, (int)_y.x, (int)_y.y, (int)_y.z, (int)_y.w}; } } \
        else { _Pragma("unroll") for (int n = 0; n < 2; ++n) _Pragma("unroll") for (int k = 0; k < 2; ++k) dst[n][k] = *(const LAS bf16x8*)(lds + PG8_SB(b, h) + boff + n * 2048 + k * 1024); } } while (0)
#define PG8_MMA(ai, bj, At, Bt) do { __builtin_amdgcn_s_setprio(1); if constexpr (FP8) { _Pragma("unroll") for (int m = 0; m < 4; ++m) _Pragma("unroll") for (int n = 0; n < 2; ++n) \
            acc[ai][bj][m][n] = __builtin_amdgcn_mfma_scale_f32_16x16x128_f8f6f4(Bt##8[n], At##8[m], acc[ai][bj][m][n], 0, 0, 0, 0x7F7F7F7F, 0, 0x7F7F7F7F); } \
        else { _Pragma("unroll") for (int m = 0; m < 4; ++m) _Pragma("unroll") for (int n = 0; n < 2; ++n) _Pragma("unroll") for (int k = 0; k < 2; ++k) \
            acc[ai][bj][m][n] = __builtin_amdgcn_mfma_f32_16x16x32_bf16(Bt[n][k], At[m][k], acc[ai][bj][m][n], 0, 0, 0); } __builtin_amdgcn_s_setprio(0); } while (0)
#define PG8_WAIT_V(n) asm volatile("s_waitcnt vmcnt(" #n ")" ::: "memory")
#define PG8_WAIT_L(n) asm volatile("s_waitcnt lgkmcnt(" #n ")" ::: "memory")
#define PG8_BAR __builtin_amdgcn_s_barrier()
#define PG8_SCHED __builtin_amdgcn_sched_barrier(0)
    Unit cur, nxt; int ui = 0;
    if (!S.next(0, cur)) return;
    f32x4 acc[2][2][4][2];
#pragma unroll
    for (int a = 0; a < 2; ++a)
#pragma unroll
        for (int b = 0; b < 2; ++b)
#pragma unroll
            for (int m = 0; m < 4; ++m)
#pragma unroll
                for (int n = 0; n < 2; ++n) acc[a][b][m][n] = (f32x4){0.f, 0.f, 0.f, 0.f};
    bf16x8 At[4][2], B0[2][2], B1[2][2];
    i32x8 At8[4], B08[2], B18[2];
    const size_t bstep = HN ? hstep : tstep;
    const char* cA = (const char*)g.A + (size_t)cur.pm * tstep; const char* cB = (const char*)g.Bt + (size_t)S.btile(cur) * bstep;
    S.a_ready(cur);
    if constexpr (BR) {
        static_assert(!BR || (FP8 && !HN && !SP2), "BR is an fp8 256x256 variant");
        PG8_STAGE(PG8_SB(0, 0), cB, voffB); PG8_STAGE(PG8_SA(0, 0), cA, voffA); PG8_STAGE(PG8_SB(0, 1), cB + hstep, voffB); PG8_STAGE(PG8_SA(0, 1), cA + hstep, voffA);
        if (wr == 1) PG8_BAR;
        PG8_WAIT_V(4); PG8_BAR;
        PG8_STAGE(PG8_SA(1, 0), cA + kstep, voffA); PG8_STAGE(PG8_SB(1, 1), cB + hstep + kstep, voffB); PG8_STAGE(PG8_SA(1, 1), cA + hstep + kstep, voffA);
        PG8_WAIT_V(6); PG8_BAR;
    } else if constexpr (HN) {
        static_assert(!HN || SP2, "HN needs the SP2 loop");
        PG8_STAGE(PG8_SB(0, 0), cB, voffB); PG8_STAGE(PG8_SA(0, 0), cA, voffA); PG8_STAGE(PG8_SA(0, 1), cA + hstep, voffA);
        if (wr == 1) PG8_BAR;
        PG8_WAIT_V(2); PG8_BAR;
        PG8_STAGE(PG8_SB(1, 0), cB + kstep, voffB); PG8_STAGE(PG8_SA(1, 0), cA + kstep, voffA);
        PG8_WAIT_V(4); PG8_BAR;
    } else if constexpr (SP2) {
        PG8_STAGE(PG8_SB(0, 0), cB, voffB); PG8_STAGE(PG8_SB(0, 1), cB + hstep, voffB); PG8_STAGE(PG8_SA(0, 0), cA, voffA); PG8_STAGE(PG8_SA(0, 1), cA + hstep, voffA);
        if (wr == 1) PG8_BAR;
        PG8_WAIT_V(2); PG8_BAR;
        PG8_STAGE(PG8_SB(1, 0), cB + kstep, voffB); PG8_STAGE(PG8_SA(1, 0), cA + kstep, voffA); PG8_STAGE(PG8_SB(1, 1), cB + hstep + kstep, voffB);
        PG8_WAIT_V(6); PG8_BAR;
    } else {
        PG8_STAGE(PG8_SB(0, 0), cB, voffB); PG8_STAGE(PG8_SA(0, 0), cA, voffA); PG8_STAGE(PG8_SB(0, 1), cB + hstep, voffB); PG8_STAGE(PG8_SA(0, 1), cA + hstep, voffA);
        if (wr == 1) PG8_BAR;
        PG8_WAIT_V(4); PG8_BAR;
        PG8_STAGE(PG8_SB(1, 0), cB + kstep, voffB); PG8_STAGE(PG8_SA(1, 0), cA + kstep, voffA); PG8_STAGE(PG8_SB(1, 1), cB + hstep + kstep, voffB);
        PG8_WAIT_V(6); PG8_BAR;
    }
    for (;;) {
        const bool has_next = S.next(ui + 1, nxt);
        const char* nA = has_next ? (const char*)g.A + (size_t)nxt.pm * tstep : cA; const char* nB = has_next ? (const char*)g.Bt + (size_t)S.btile(nxt) * bstep : cB;
        for (int t = 0; t < nt; t += 2) {
            const bool last = (t == nt - 2);
            const char* a1 = cA + (size_t)(t + 1) * kstep; const char* b1 = cB + (size_t)(t + 1) * kstep;
            const char* a2 = last ? nA : cA + (size_t)(t + 2) * kstep; const char* b2 = last ? nB : cB + (size_t)(t + 2) * kstep;
            const char* a3 = a2 + kstep; const char* b3 = b2 + kstep;
            if (last && has_next) S.a_ready(nxt);
            if constexpr (BR) {
            PG8_LDB(B0, 0, 0); PG8_SCHED; PG8_LDA(At, 0, 0); PG8_STAGE(PG8_SB(1, 0), b1, voffB);
            PG8_WAIT_V(6); PG8_WAIT_L(0); PG8_BAR; PG8_MMA(0, 0, At, B0); PG8_BAR; PG8_SCHED;
            PG8_LDB(B0, 0, 1); PG8_STAGE(PG8_SA(0, 0), a2, voffA);
            PG8_WAIT_V(6); PG8_WAIT_L(0); PG8_BAR; PG8_MMA(0, 1, At, B0); PG8_BAR; PG8_SCHED;
            PG8_LDA(At, 0, 1); PG8_STAGE(PG8_SB(0, 1), b2 + hstep, voffB);
            PG8_WAIT_V(6); PG8_WAIT_L(0); PG8_BAR; PG8_MMA(1, 1, At, B0); PG8_BAR; PG8_SCHED;
            PG8_LDB(B0, 0, 0); PG8_STAGE(PG8_SA(0, 1), a2 + hstep, voffA);
            PG8_WAIT_V(6); PG8_WAIT_L(0); PG8_BAR; PG8_MMA(1, 0, At, B0); PG8_BAR; PG8_SCHED;
            PG8_LDB(B0, 1, 0); PG8_SCHED; PG8_LDA(At, 1, 0); PG8_STAGE(PG8_SB(0, 0), b2, voffB);
            PG8_WAIT_V(6); PG8_WAIT_L(0); PG8_BAR; PG8_MMA(0, 0, At, B0); PG8_BAR; PG8_SCHED;
            PG8_LDB(B0, 1, 1); PG8_STAGE(PG8_SA(1, 0), a3, voffA);
            PG8_WAIT_V(6); PG8_WAIT_L(0); PG8_BAR; PG8_MMA(0, 1, At, B0); PG8_BAR; PG8_SCHED;
            PG8_LDA(At, 1, 1); PG8_STAGE(PG8_SB(1, 1), b3 + hstep, voffB);
            PG8_WAIT_V(6); PG8_WAIT_L(0); PG8_BAR; PG8_MMA(1, 1, At, B0); PG8_BAR; PG8_SCHED;
            PG8_LDB(B0, 1, 0); PG8_STAGE(PG8_SA(1, 1), a3 + hstep, voffA);
            PG8_WAIT_V(6); PG8_WAIT_L(0); PG8_BAR; PG8_MMA(1, 0, At, B0); PG8_BAR; PG8_SCHED;
            } else if constexpr (HN) {
            PG8_LDB(B0, 0, 0); PG8_SCHED; PG8_LDA(At, 0, 0); PG8_STAGE(PG8_SA(1, 1), a1 + hstep, voffA);
            PG8_WAIT_V(6); PG8_WAIT_L(0); PG8_BAR; PG8_MMA(0, 0, At, B0); PG8_BAR; PG8_SCHED;
            PG8_LDA(At, 0, 1); PG8_STAGE(PG8_SB(0, 0), b2, voffB); PG8_STAGE(PG8_SA(0, 0), a2, voffA);
            PG8_WAIT_V(6); PG8_WAIT_L(0); PG8_BAR; PG8_MMA(1, 0, At, B0); PG8_BAR; PG8_SCHED;
            PG8_LDB(B0, 1, 0); PG8_SCHED; PG8_LDA(At, 1, 0); PG8_STAGE(PG8_SA(0, 1), a2 + hstep, voffA);
            PG8_WAIT_V(6); PG8_WAIT_L(0); PG8_BAR; PG8_MMA(0, 0, At, B0); PG8_BAR; PG8_SCHED;
            PG8_LDA(At, 1, 1); PG8_STAGE(PG8_SB(1, 0), b3, voffB); PG8_STAGE(PG8_SA(1, 0), a3, voffA);
            PG8_WAIT_V(6); PG8_WAIT_L(0); PG8_BAR; PG8_MMA(1, 0, At, B0); PG8_BAR; PG8_SCHED;
            } else if constexpr (SP2) {
            const bool mlo = !Sched::BD || t < nt / 2, mhi = !Sched::BD || t >= nt / 2;
            PG8_LDB(B0, 0, 0); PG8_LDB(B1, 0, 1); PG8_SCHED; PG8_LDA(At, 0, 0); PG8_STAGE(PG8_SA(1, 1), a1 + hstep, voffA);
            PG8_WAIT_V(8); PG8_WAIT_L(0); PG8_BAR; if (mlo) { PG8_MMA(0, 0, At, B0); PG8_MMA(0, 1, At, B1); } PG8_BAR; PG8_SCHED;
            PG8_LDA(At, 0, 1); PG8_STAGE(PG8_SB(0, 0), b2, voffB); PG8_STAGE(PG8_SB(0, 1), b2 + hstep, voffB); PG8_STAGE(PG8_SA(0, 0), a2, voffA);
            PG8_WAIT_V(8); PG8_WAIT_L(0); PG8_BAR; if (mhi) { PG8_MMA(1, 0, At, B0); PG8_MMA(1, 1, At, B1); } PG8_BAR; PG8_SCHED;
            PG8_LDB(B0, 1, 0); PG8_LDB(B1, 1, 1); PG8_SCHED; PG8_LDA(At, 1, 0); PG8_STAGE(PG8_SA(0, 1), a2 + hstep, voffA);
            PG8_WAIT_V(8); PG8_WAIT_L(0); PG8_BAR; if (mlo) { PG8_MMA(0, 0, At, B0); PG8_MMA(0, 1, At, B1); } PG8_BAR; PG8_SCHED;
            PG8_LDA(At, 1, 1); PG8_STAGE(PG8_SB(1, 0), b3, voffB); PG8_STAGE(PG8_SB(1, 1), b3 + hstep, voffB); PG8_STAGE(PG8_SA(1, 0), a3, voffA);
            PG8_WAIT_V(8); PG8_WAIT_L(0); PG8_BAR; if (mhi) { PG8_MMA(1, 0, At, B0); PG8_MMA(1, 1, At, B1); } PG8_BAR; PG8_SCHED;
            } else {
            PG8_LDB(B0, 0, 0); PG8_SCHED; PG8_LDA(At, 0, 0); PG8_STAGE(PG8_SA(1, 1), a1 + hstep, voffA);
            PG8_WAIT_L(8); PG8_BAR; PG8_WAIT_L(0); PG8_MMA(0, 0, At, B0); PG8_BAR; PG8_SCHED;
            PG8_LDB(B1, 0, 1); PG8_STAGE(PG8_SB(0, 0), b2, voffB);
            PG8_BAR; PG8_WAIT_L(0); PG8_MMA(0, 1, At, B1); PG8_BAR;
            PG8_LDA(At, 0, 1); PG8_STAGE(PG8_SA(0, 0), a2, voffA);
            PG8_BAR; PG8_WAIT_L(0); PG8_MMA(1, 0, At, B0); PG8_BAR; PG8_SCHED;
            PG8_STAGE(PG8_SB(0, 1), b2 + hstep, voffB);
            PG8_WAIT_V(6); PG8_BAR; PG8_MMA(1, 1, At, B1); PG8_BAR;
            PG8_LDB(B0, 1, 0); PG8_SCHED; PG8_LDA(At, 1, 0); PG8_STAGE(PG8_SA(0, 1), a2 + hstep, voffA);
            PG8_WAIT_L(8); PG8_BAR; PG8_WAIT_L(0); PG8_MMA(0, 0, At, B0); PG8_BAR; PG8_SCHED;
            PG8_LDB(B1, 1, 1); PG8_STAGE(PG8_SB(1, 0), b3, voffB);
            PG8_BAR; PG8_WAIT_L(0); PG8_MMA(0, 1, At, B1); PG8_BAR;
            PG8_LDA(At, 1, 1); PG8_STAGE(PG8_SA(1, 0), a3, voffA);
            PG8_BAR; PG8_WAIT_L(0); PG8_MMA(1, 0, At, B0); PG8_BAR; PG8_SCHED;
            PG8_STAGE(PG8_SB(1, 1), b3 + hstep, voffB);
            PG8_WAIT_V(6); PG8_BAR; PG8_MMA(1, 1, At, B1); PG8_BAR;
            }
        }
        if constexpr (ALIGN_EPI) { if (wr == 0) PG8_BAR; }
        E(acc, cur, wr, wc, fr, fq); S.done(cur);
        if (!has_next) break;
#pragma unroll
        for (int a = 0; a < 2; ++a)
#pragma unroll
            for (int b = 0; b < 2; ++b)
#pragma unroll
                for (int m = 0; m < 4; ++m)
#pragma unroll
                    for (int n = 0; n < 2; ++n) acc[a][b][m][n] = (f32x4){0.f, 0.f, 0.f, 0.f};
        cur = nxt; cA = nA; cB = nB; ++ui;
        if constexpr (ALIGN_EPI) { if (wr == 1) PG8_BAR; }
    }
    PG8_WAIT_V(0);
    if constexpr (!ALIGN_EPI) { if (wr == 0) PG8_BAR; }
    PG8_BAR;
#undef PG8_SA
#undef PG8_SB
#undef PG8_STAGE
#undef PG8_LDA
#undef PG8_LDB
#undef PG8_MMA
#undef PG8_WAIT_V
#undef PG8_WAIT_L
#undef PG8_BAR
#undef PG8_SCHED
}
}

#define XB_TMO      128
#define XB_XCNT(j)  (256  + 64 * (j))
#define XB_XSUB(j)  (1280 + 64 * (j))
#define XB_XGEN(j)  (2304 + 64 * (j))
#define XB_TOP      3328
#define XB_TOPGEN   3392
#define XCD_BAR_WORDS 3456
#define XB_SPIN_CAP (1u << 18)

__device__ __forceinline__ unsigned xb_ld(unsigned* p)              { return __hip_atomic_load(p, __ATOMIC_RELAXED, __HIP_MEMORY_SCOPE_AGENT); }
__device__ __forceinline__ unsigned xb_add(unsigned* p, unsigned v) { return __hip_atomic_fetch_add(p, v, __ATOMIC_RELAXED, __HIP_MEMORY_SCOPE_AGENT); }
__device__ __forceinline__ unsigned xb_xcc_id() { return (unsigned)__builtin_amdgcn_s_getreg((3 << 11) | 20) & 0xFu; }
#define XB_SPIN(cond, bar) do { unsigned _sp = 0; while (cond) { __builtin_amdgcn_s_sleep(1); \
    if ((++_sp & 255u) == 0u) { if (xb_ld(&(bar)[XB_TMO])) break; if (_sp > XB_SPIN_CAP) { atomicAdd(&(bar)[XB_TMO], 1u); break; } } } } while (0)

struct XcdBarrier { unsigned* bar; unsigned x; volatile LAS unsigned* st; };

__device__ __forceinline__ XcdBarrier xcd_barrier_post(unsigned* bar, volatile LAS unsigned* st) {
    XcdBarrier b; b.bar = bar; b.x = xb_xcc_id(); b.st = st;
    if (threadIdx.x == 0) (void)xb_add(&bar[XB_XCNT(b.x)], 1u);
    return b;
}
__device__ __forceinline__ void xcd_barrier_complete(unsigned* bar, unsigned x, unsigned& nloc, unsigned& nx) {
    const unsigned G = gridDim.x * gridDim.y * gridDim.z;
    unsigned sum, cnt, mine, sp = 0u;
    for (;;) {
        sum = 0u; cnt = 0u; mine = 0u;
#pragma unroll
        for (unsigned j = 0; j < 16; ++j) { const unsigned c = xb_ld(&bar[XB_XCNT(j)]); sum += c; cnt += (c > 0u) ? 1u : 0u; mine = (j == x) ? c : mine; }
        if (sum == G) break;
        __builtin_amdgcn_s_sleep(1);
        if ((++sp & 255u) == 0u) { if (xb_ld(&bar[XB_TMO])) break; if (sp > XB_SPIN_CAP) { atomicAdd(&bar[XB_TMO], 1u); break; } }
    }
    nloc = mine > 0u ? mine : 1u; nx = cnt > 0u ? cnt : 1u;
}
__device__ __forceinline__ void xcd_barrier(const XcdBarrier& b) {
    asm volatile("s_waitcnt vmcnt(0)" ::: "memory");
    __syncthreads();
    if (threadIdx.x == 0) {
        unsigned* bar = b.bar;
        __builtin_amdgcn_s_waitcnt(0);
        unsigned nloc = b.st[0], nx = b.st[1];
        if (nloc == 0u) { xcd_barrier_complete(bar, b.x, nloc, nx); b.st[0] = nloc; b.st[1] = nx; }
        const unsigned old = xb_add(&bar[XB_XSUB(b.x)], 1u);
        const unsigned gen = old / nloc;
        if (old + 1u == (gen + 1u) * nloc) {
            __builtin_amdgcn_fence(__ATOMIC_RELEASE, "agent");
            asm volatile("s_waitcnt vmcnt(0)" ::: "memory");
            const unsigned og = xb_add(&bar[XB_TOP], 1u);
            const unsigned tg = og / nx;
            if (og + 1u == (tg + 1u) * nx) xb_add(&bar[XB_TOPGEN], 1u);
            else XB_SPIN(xb_ld(&bar[XB_TOPGEN]) == tg, bar);
            __builtin_amdgcn_fence(__ATOMIC_ACQUIRE, "agent");
            xb_add(&bar[XB_XGEN(b.x)], 1u);
            asm volatile("s_waitcnt vmcnt(0)" ::: "memory");
        } else {
            XB_SPIN(xb_ld(&bar[XB_XGEN(b.x)]) == gen, bar);
            __builtin_amdgcn_fence(__ATOMIC_ACQUIRE, "agent");
            asm volatile("s_waitcnt vmcnt(0)" ::: "memory");
        }
    }
    __syncthreads();
}

constexpr int NWAVES = 8;
constexpr int LDS_BYTES = 163840;
constexpr int LDSCTL_OFF = LDS_BYTES - 512, MISC_OFF = LDSCTL_OFF + 320;
constexpr int NPHASE = 2 + 6 * NLAYER;

#define LDS_WAIT() asm volatile("s_waitcnt lgkmcnt(0)" ::: "memory")

struct Args { const float* in[20]; float* out; unsigned char* ws; int ph_lo, ph_hi, li, pad; };

#define CAS __attribute__((address_space(4)))
struct Frame {
    LAS unsigned char* lds;
    int tid, lane, wave, G, gw, NGW;
    const CAS unsigned char* ka;
    __device__ __forceinline__ const float* x() const { return *(const float* const CAS*)(ka + 0); }
    __device__ __forceinline__ const float* c() const { return *(const float* const CAS*)(ka + 8); }
    __device__ __forceinline__ const float* ctx() const { return *(const float* const CAS*)(ka + 16); }
    __device__ __forceinline__ const float* c_ctx() const { return *(const float* const CAS*)(ka + 24); }
    __device__ __forceinline__ const float* w_ada() const { return *(const float* const CAS*)(ka + 32); }
    __device__ __forceinline__ const float* b_ada() const { return *(const float* const CAS*)(ka + 40); }
    __device__ __forceinline__ const float* w_in() const { return *(const float* const CAS*)(ka + 48); }
    __device__ __forceinline__ const float* conv_w() const { return *(const float* const CAS*)(ka + 56); }
    __device__ __forceinline__ const float* sink() const { return *(const float* const CAS*)(ka + 64); }
    __device__ __forceinline__ const float* g_attn() const { return *(const float* const CAS*)(ka + 72); }
    __device__ __forceinline__ const float* g_conv() const { return *(const float* const CAS*)(ka + 80); }
    __device__ __forceinline__ const float* w_out() const { return *(const float* const CAS*)(ka + 88); }
    __device__ __forceinline__ const float* ln1_g() const { return *(const float* const CAS*)(ka + 96); }
    __device__ __forceinline__ const float* ln1_b() const { return *(const float* const CAS*)(ka + 104); }
    __device__ __forceinline__ const float* wq() const { return *(const float* const CAS*)(ka + 112); }
    __device__ __forceinline__ const float* keys() const { return *(const float* const CAS*)(ka + 120); }
    __device__ __forceinline__ const float* pu() const { return *(const float* const CAS*)(ka + 128); }
    __device__ __forceinline__ const float* pv() const { return *(const float* const CAS*)(ka + 136); }
    __device__ __forceinline__ const float* ln2_g() const { return *(const float* const CAS*)(ka + 144); }
    __device__ __forceinline__ const float* ln2_b() const { return *(const float* const CAS*)(ka + 152); }
    __device__ __forceinline__ float* out() const { return *(float* const CAS*)(ka + 160); }
    __device__ __forceinline__ unsigned char* ws() const { return *(unsigned char* const CAS*)(ka + 168); }
    __device__ __forceinline__ float* MODS() const { return (float*)(ws() + WS_MODS); }
    __device__ __forceinline__ float* ROPE() const { return (float*)(ws() + WS_ROPE); }
    __device__ __forceinline__ bf16_t* X() const { return (bf16_t*)(ws() + WS_X); }
    __device__ __forceinline__ bf16_t* SC() const { return (bf16_t*)(ws() + WS_SC); }
    __device__ __forceinline__ bf16_t* KBD() const { return (bf16_t*)(ws() + WS_KBD); }
    __device__ __forceinline__ bf16_t* WQR() const { return (bf16_t*)(ws() + WS_WQR); }
    __device__ __forceinline__ unsigned char* WINT() const { return ws() + WS_WINT; }
    __device__ __forceinline__ unsigned char* H8() const { return ws() + WS_H8; }
    __device__ __forceinline__ unsigned char* WOUTT() const { return ws() + WS_WOUTT; }
    __device__ __forceinline__ bf16_t* WEFFT() const { return (bf16_t*)(ws() + WS_WEFFT); }
    __device__ __forceinline__ bf16_t* H() const { return (bf16_t*)(ws() + WS_H); }
    __device__ __forceinline__ bf16_t* PROJ() const { return (bf16_t*)(ws() + WS_PROJ); }
    __device__ __forceinline__ unsigned char* MIX() const { return ws() + WS_MIX; }
    __device__ __forceinline__ unsigned char* UT() const { return (unsigned char*)(ws() + WS_UT); }
    __device__ __forceinline__ unsigned char* VT() const { return (unsigned char*)(ws() + WS_VT); }
    __device__ __forceinline__ float* US() const { return (float*)(ws() + WS_US); }
    __device__ __forceinline__ float* VS() const { return (float*)(ws() + WS_VS); }
};

__device__ __forceinline__ void frame_ids(Frame& F) {
    int tz = threadIdx.x; asm volatile("" : "+v"(tz));
    F.tid = tz; F.lane = tz & 63; F.wave = __builtin_amdgcn_readfirstlane(tz >> 6);
    F.gw = blockIdx.x * NWAVES + F.wave;
    const CAS unsigned char* k = (const CAS unsigned char*)__builtin_amdgcn_kernarg_segment_ptr(); asm volatile("" : "+s"(k)); F.ka = k;
}
template <int CTRL> __device__ __forceinline__ int dpp_i(int v) { return __builtin_amdgcn_update_dpp(0, v, CTRL, 0xf, 0xf, true); }
template <int CTRL> __device__ __forceinline__ float dpp_f(float v) { return __int_as_float(dpp_i<CTRL>(__float_as_int(v))); }
constexpr int DPP_XOR1 = 0xB1, DPP_XOR2 = 0x4E, DPP_HMIRROR = 0x141, DPP_ROR4 = 0x124, DPP_ROR8 = 0x128;
__device__ __forceinline__ float wave_sum_u(float v) {
    v += dpp_f<DPP_XOR1>(v); v += dpp_f<DPP_XOR2>(v); v += dpp_f<DPP_ROR4>(v); v += dpp_f<DPP_ROR8>(v);
    const float r0 = __int_as_float(__builtin_amdgcn_readlane(__float_as_int(v), 0)), r1 = __int_as_float(__builtin_amdgcn_readlane(__float_as_int(v), 16));
    const float r2 = __int_as_float(__builtin_amdgcn_readlane(__float_as_int(v), 32)), r3 = __int_as_float(__builtin_amdgcn_readlane(__float_as_int(v), 48));
    return (r0 + r1) + (r2 + r3);
}
__device__ __forceinline__ float wave_max_u(float v) {
    v = fmaxf(v, dpp_f<DPP_XOR1>(v)); v = fmaxf(v, dpp_f<DPP_XOR2>(v)); v = fmaxf(v, dpp_f<DPP_ROR4>(v)); v = fmaxf(v, dpp_f<DPP_ROR8>(v));
    const float r0 = __int_as_float(__builtin_amdgcn_readlane(__float_as_int(v), 0)), r1 = __int_as_float(__builtin_amdgcn_readlane(__float_as_int(v), 16));
    const float r2 = __int_as_float(__builtin_amdgcn_readlane(__float_as_int(v), 32)), r3 = __int_as_float(__builtin_amdgcn_readlane(__float_as_int(v), 48));
    return fmaxf(fmaxf(r0, r1), fmaxf(r2, r3));
}
__device__ __forceinline__ float xor32_f(float v, int lane) { return __int_as_float(__builtin_amdgcn_ds_bpermute((lane ^ 32) << 2, __float_as_int(v))); }
__device__ __forceinline__ float wave_sum(float v) { return wave_sum_u(v); }
__device__ __forceinline__ unsigned pk2(float lo, float hi) { return pg8::cvt_pk_bf16(lo, hi); }
__device__ __forceinline__ float bf_lo(unsigned u) { return __uint_as_float(u << 16); }
__device__ __forceinline__ float bf_hi(unsigned u) { return __uint_as_float(u & 0xffff0000u); }
__device__ __forceinline__ int modrow(int t) { return t < TL ? t / SEQ : 2; }

__device__ __forceinline__ void transpose_item(const float* W, int K, int N, bf16_t* WT, LAS float* scr, int item, int lane) {
    const int nblk = N / 32, kb = item / nblk, nb = item % nblk, k0 = 64 * kb, n0 = 32 * nb;
#pragma unroll 8
    for (int i = 0; i < 32; ++i) { const int kk = 2 * i + (lane >> 5); scr[kk * 33 + (lane & 31)] = W[(size_t)(k0 + kk) * N + n0 + (lane & 31)]; }
    LDS_WAIT(); asm volatile("" ::: "memory");
    const int c = lane & 7;
#pragma unroll
    for (int j = 0; j < 4; ++j) { const int n = (lane >> 3) + 8 * j; const LAS float* s = scr + (8 * c) * 33 + n;
        u32x4 o; o.x = pk2(s[0 * 33], s[1 * 33]); o.y = pk2(s[2 * 33], s[3 * 33]); o.z = pk2(s[4 * 33], s[5 * 33]); o.w = pk2(s[6 * 33], s[7 * 33]);
        *(u32x4*)(WT + (size_t)(n0 + n) * K + k0 + 8 * c) = o; }
    LDS_WAIT(); asm volatile("" ::: "memory");
}

__device__ __forceinline__ void transpose_item8(const float* W, int K, int N, unsigned char* WT, LAS float* scr, int item, int lane, float wscale) {
    const int nblk = N / 32, kb = item / nblk, nb = item % nblk, k0 = 64 * kb, n0 = 32 * nb;
    float wv[32];
#pragma unroll
    for (int i = 0; i < 32; ++i) wv[i] = __builtin_nontemporal_load(W + (size_t)(k0 + 2 * i + (lane >> 5)) * N + n0 + (lane & 31));
#pragma unroll
    for (int i = 0; i < 32; ++i) scr[(2 * i + (lane >> 5)) * 33 + (lane & 31)] = wv[i];
    LDS_WAIT(); asm volatile("" ::: "memory");
    const int c = lane & 7;
#pragma unroll
    for (int j = 0; j < 4; ++j) { const int n = (lane >> 3) + 8 * j; const LAS float* s = scr + (8 * c) * 33 + n;
        u32x2 o; int t0 = __builtin_amdgcn_cvt_pk_fp8_f32(s[0 * 33] * wscale, s[1 * 33] * wscale, 0, false); t0 = __builtin_amdgcn_cvt_pk_fp8_f32(s[2 * 33] * wscale, s[3 * 33] * wscale, t0, true);
        int t1 = __builtin_amdgcn_cvt_pk_fp8_f32(s[4 * 33] * wscale, s[5 * 33] * wscale, 0, false); t1 = __builtin_amdgcn_cvt_pk_fp8_f32(s[6 * 33] * wscale, s[7 * 33] * wscale, t1, true);
        o.x = (unsigned)t0; o.y = (unsigned)t1;
        *(u32x2*)(WT + (size_t)(n0 + n) * K + k0 + 8 * c) = o; }
    LDS_WAIT(); asm volatile("" ::: "memory");
}
__device__ __forceinline__ void cvt_row_bf16(const float* src, bf16_t* dst, int lane) {
    const f32x4* s = (const f32x4*)src + lane; u32x2* d = (u32x2*)dst + lane;
    f32x4 v[8];
#pragma unroll
    for (int j = 0; j < 8; ++j) v[j] = __builtin_nontemporal_load(s + 64 * j);
#pragma unroll
    for (int j = 0; j < 8; ++j) { u32x2 o; o.x = pk2(v[j].x, v[j].y); o.y = pk2(v[j].z, v[j].w); d[64 * j] = o; }
}

struct RowF32 { f32x4 v[4][2]; };
__device__ __forceinline__ void row_load_nt(RowF32& R, const float* src, int lane) {
    const f32x4* s = (const f32x4*)src + 2 * lane;
#pragma unroll
    for (int j = 0; j < 4; ++j) { R.v[j][0] = __builtin_nontemporal_load(s + 128 * j); R.v[j][1] = __builtin_nontemporal_load(s + 128 * j + 1); }
}
template <int FMT>
__device__ __forceinline__ void cvt_row_lp(const RowF32& R, unsigned char* dst, float* inv, int lane) {
    constexpr float QMAX = FMT == 8 ? 224.f : 6.f;
    float am = 0.f;
#pragma unroll
    for (int j = 0; j < 4; ++j)
#pragma unroll
        for (int q = 0; q < 2; ++q) am = fmaxf(fmaxf(am, fmaxf(fabsf(R.v[j][q].x), fabsf(R.v[j][q].y))), fmaxf(fabsf(R.v[j][q].z), fabsf(R.v[j][q].w)));
    am = wave_max_u(am);
    const float sc = am > 0.f ? QMAX / am : 1.f;
#pragma unroll
    for (int j = 0; j < 4; ++j) {
        if constexpr (FMT == 8) {
            u32x2 w;
#pragma unroll
            for (int q = 0; q < 2; ++q) { int t = __builtin_amdgcn_cvt_pk_fp8_f32(R.v[j][q].x * sc, R.v[j][q].y * sc, 0, false); t = __builtin_amdgcn_cvt_pk_fp8_f32(R.v[j][q].z * sc, R.v[j][q].w * sc, t, true); w[q] = (unsigned)t; }
            *((u32x2*)dst + lane + 64 * j) = w;
        } else {
            unsigned w = 0u;
            w = __builtin_amdgcn_cvt_scalef32_pk_fp4_f32(w, R.v[j][0].x * sc, R.v[j][0].y * sc, 1.0f, 0);
            w = __builtin_amdgcn_cvt_scalef32_pk_fp4_f32(w, R.v[j][0].z * sc, R.v[j][0].w * sc, 1.0f, 1);
            w = __builtin_amdgcn_cvt_scalef32_pk_fp4_f32(w, R.v[j][1].x * sc, R.v[j][1].y * sc, 1.0f, 2);
            w = __builtin_amdgcn_cvt_scalef32_pk_fp4_f32(w, R.v[j][1].z * sc, R.v[j][1].w * sc, 1.0f, 3);
            *((unsigned*)dst + lane + 64 * j) = w;
        }
    }
    if (lane == 0) *inv = am > 0.f ? am * (1.f / QMAX) : 1.f;
}
__device__ __forceinline__ void cvt_row_i4(const RowF32& R, unsigned char* dst, float* inv, int lane) {
    float s2 = 0.f;
#pragma unroll
    for (int j = 0; j < 4; ++j)
#pragma unroll
        for (int q = 0; q < 2; ++q) s2 += (R.v[j][q].x * R.v[j][q].x + R.v[j][q].y * R.v[j][q].y) + (R.v[j][q].z * R.v[j][q].z + R.v[j][q].w * R.v[j][q].w);
    s2 = wave_sum_u(s2);
    const float step = s2 > 0.f ? 0.3352f * sqrtf(s2 * (1.f / D)) : 1.f, rs = 1.f / step;
#pragma unroll
    for (int j = 0; j < 4; ++j) {
        unsigned w = 0u;
#pragma unroll
        for (int q = 0; q < 2; ++q)
#pragma unroll
            for (int e = 0; e < 4; ++e) { const float x = fminf(fmaxf(rintf(R.v[j][q][e] * rs), -8.f), 7.f); w |= ((unsigned)(int)x & 15u) << (4 * (4 * q + e)); }
        *((unsigned*)dst + lane + 64 * j) = w;
    }
    if (lane == 0) *inv = step;
}
template <int FMT> struct LpRow;
template <> struct LpRow<8> { u32x4 a, b;
    __device__ __forceinline__ void load(const unsigned char* rowp, int lane) { a = *(const u32x4*)(rowp + 32 * lane); b = *(const u32x4*)(rowp + 32 * lane + 16); }
    template <class Fn> __device__ __forceinline__ void each(Fn&& f) const {
#pragma unroll
        for (int w = 0; w < 4; ++w) { const f32x2 l0 = __builtin_amdgcn_cvt_pk_f32_fp8((int)a[w], false), h0 = __builtin_amdgcn_cvt_pk_f32_fp8((int)a[w], true);
            f(4 * w, l0.x, l0.y); f(4 * w + 2, h0.x, h0.y); }
#pragma unroll
        for (int w = 0; w < 4; ++w) { const f32x2 l0 = __builtin_amdgcn_cvt_pk_f32_fp8((int)b[w], false), h0 = __builtin_amdgcn_cvt_pk_f32_fp8((int)b[w], true);
            f(16 + 4 * w, l0.x, l0.y); f(16 + 4 * w + 2, h0.x, h0.y); }
    } };
template <> struct LpRow<4> { u32x4 a;
    __device__ __forceinline__ void load(const unsigned char* rowp, int lane) { a = *(const u32x4*)(rowp + 16 * lane); }
    template <class Fn> __device__ __forceinline__ void each(Fn&& f) const {
#pragma unroll
        for (int w = 0; w < 4; ++w) {
            const f32x2 d0 = __builtin_amdgcn_cvt_scalef32_pk_f32_fp4(a[w], 1.0f, 0), d1 = __builtin_amdgcn_cvt_scalef32_pk_f32_fp4(a[w], 1.0f, 1);
            const f32x2 d2 = __builtin_amdgcn_cvt_scalef32_pk_f32_fp4(a[w], 1.0f, 2), d3 = __builtin_amdgcn_cvt_scalef32_pk_f32_fp4(a[w], 1.0f, 3);
            f(8 * w, d0.x, d0.y); f(8 * w + 2, d1.x, d1.y); f(8 * w + 4, d2.x, d2.y); f(8 * w + 6, d3.x, d3.y); }
    }
    template <class Fn> __device__ __forceinline__ void each_bf(Fn&& f) const {
#pragma unroll
        for (int w = 0; w < 4; ++w) {
            f(4 * w, __builtin_amdgcn_cvt_scalef32_pk_bf16_fp4(a[w], 1.0f, 0)); f(4 * w + 1, __builtin_amdgcn_cvt_scalef32_pk_bf16_fp4(a[w], 1.0f, 1));
            f(4 * w + 2, __builtin_amdgcn_cvt_scalef32_pk_bf16_fp4(a[w], 1.0f, 2)); f(4 * w + 3, __builtin_amdgcn_cvt_scalef32_pk_bf16_fp4(a[w], 1.0f, 3)); }
    } };

__device__ __forceinline__ void row_stats(const f32x4 (&v)[8], float& mean, float& rstd) {
    float s = 0.f;
#pragma unroll
    for (int j = 0; j < 8; ++j) s += (v[j].x + v[j].y) + (v[j].z + v[j].w);
    mean = wave_sum(s) * (1.f / D);
    float s2 = 0.f;
#pragma unroll
    for (int j = 0; j < 8; ++j) { const f32x4 d = v[j] - mean; s2 += (d.x * d.x + d.y * d.y) + (d.z * d.z + d.w * d.w); }
    rstd = 1.f / sqrtf(wave_sum(s2) * (1.f / D) + LN_EPS);
}
__device__ __forceinline__ void modulate_store(const f32x4 (&v)[8], const float* shift, const float* scale, bf16_t* dst, int lane) {
    float mean, rstd; row_stats(v, mean, rstd);
    u32x2* d = (u32x2*)dst + lane;
#pragma unroll
    for (int j = 0; j < 8; ++j) { const f32x4 sc = *((const f32x4*)scale + lane + 64 * j), sh = *((const f32x4*)shift + lane + 64 * j);
        const f32x4 y = (v[j] - mean) * rstd * (sc + 1.f) + sh;
        u32x2 o; o.x = pk2(y.x, y.y); o.y = pk2(y.z, y.w); d[64 * j] = o; }
}

__device__ __forceinline__ void convert_tables(Frame& F, int row0, int row1, int w0, int wstride) {
    RowF32 ru, rv, nu, nv;
    int row = row0 + w0;
    if (row < row1) { row_load_nt(ru, F.pu() + (size_t)row * D, F.lane); row_load_nt(rv, F.pv() + (size_t)row * D, F.lane); }
    while (row < row1) {
        const int nrow = row + wstride;
        if (nrow < row1) { row_load_nt(nu, F.pu() + (size_t)nrow * D, F.lane); row_load_nt(nv, F.pv() + (size_t)nrow * D, F.lane); }
        cvt_row_i4(ru, F.UT() + (size_t)row * UROW, F.US() + 2 * (size_t)row, F.lane);
        cvt_row_lp<V_FMT>(rv, F.VT() + (size_t)row * VROW, F.US() + 2 * (size_t)row + 1, F.lane);
        ru = nu; rv = nv; row = nrow;
    }
}
__device__ __forceinline__ void convert_in_tail(Frame& F, int layer, int nunits, int part) {
    if (layer + 1 >= NLAYER) return;
    const int G = F.G, rounds = (nunits + G - 1) / G, nlast = nunits - (rounds - 1) * G;
    const int c = (int)blockIdx.x;
    int nshort = G - nlast, sidx = c - nlast;
    if (nshort <= 0) { nshort = G; sidx = c; }
    else if (sidx < 0) return;
    const int r0 = (layer + 1) * NEXP + part * (NEXP / 2);
    convert_tables(F, r0, r0 + NEXP / 2, sidx * NWAVES + F.wave, nshort * NWAVES);
}
__device__ __forceinline__ void p0_pre(Frame& F) {
    for (int row = F.gw; row < NLAYER * D; row += F.NGW) {
        const int l = row / D, c = row % D; const f32x4* s = (const f32x4*)(F.wq() + (size_t)row * D) + F.lane;
#pragma unroll
        for (int j = 0; j < 8; ++j) { const f32x4 v = s[64 * j]; u32x2 o; o.x = pk2(v.x, v.y); o.y = pk2(v.z, v.w);
            *((u32x2*)(F.WQR() + ((size_t)(l * 8 + j) * D + c) * 256) + F.lane) = o; }
    }
    for (int row = F.gw; row < 32 * 256; row += F.NGW) {
        const int lh = row >> 8, pk = row & 255, p = pk >> 7;
        u32x2 o = {0u, 0u};
        if ((F.lane >> 5) == p) { const f32x4 v = *((const f32x4*)(F.keys() + ((size_t)lh * 256 + pk) * 128) + (F.lane & 31)); o.x = pk2(v.x, v.y); o.y = pk2(v.z, v.w); }
        *((u32x2*)(F.KBD() + (size_t)row * 256) + F.lane) = o;
    }
    for (int i = blockIdx.x * (NWAVES * 64) + F.tid; i < 192 * 32; i += F.G * NWAVES * 64) {
        const int idx = i >> 5, f = i & 31; const float pos = (float)(idx < 128 ? idx : idx - 128);
        const float inv = powf(10000.f, -(float)(2 * f) / 64.f); const float ang = pos * inv;
        F.ROPE()[2 * i] = cosf(ang); F.ROPE()[2 * i + 1] = sinf(ang);
    }
}
__device__ __forceinline__ void p0_stream(Frame& F, int sc, int SG) {
    const int sgw = sc * NWAVES + F.wave, sngw = SG * NWAVES;
    LAS float* condL = (LAS float*)F.lds;
    LAS float* red = (LAS float*)(F.lds + 24576);
    for (int i = F.tid; i < 3 * D; i += NWAVES * 64) { const int r = i / D, k = i % D; const float v = r < 2 ? F.c()[r * D + k] : F.c_ctx()[k]; condL[i] = v / (1.f + __expf(-v)); }
    __syncthreads();
    for (int item = sc; item < 384; item += SG) {
        const int kw = 256, kbase = F.wave * 256;
        const int l = item / 96, n0 = (item % 96) * 128;
        const float* wp = F.w_ada() + ((size_t)l * D + kbase) * 12288 + n0 + 2 * F.lane;
        f32x2 a0 = {0.f, 0.f}, a1 = {0.f, 0.f}, a2 = {0.f, 0.f};
#pragma unroll 8
        for (int k = 0; k < kw; ++k) { const f32x2 w = __builtin_nontemporal_load((const f32x2*)(wp + (size_t)k * 12288)); const int kk = kbase + k;
            a0 += w * condL[kk]; a1 += w * condL[D + kk]; a2 += w * condL[2 * D + kk]; }
        LAS float* rp = red + F.wave * 384 + 2 * F.lane;
        rp[0] = a0.x; rp[1] = a0.y; rp[128] = a1.x; rp[129] = a1.y; rp[256] = a2.x; rp[257] = a2.y;
        __syncthreads();
        if (F.tid < 384) { const int r = F.tid / 128, n = F.tid % 128; float s = 0.f;
#pragma unroll
            for (int w = 0; w < 8; ++w) s += red[w * 384 + r * 128 + n];
            s += F.b_ada()[(size_t)l * 12288 + n0 + n];
            atomicAdd(F.MODS() + ((size_t)l * 3 + r) * 12288 + n0 + n, s); }
        __syncthreads();
    }
    LAS float* scr = (LAS float*)(F.lds + 40960 + F.wave * 8448);
    constexpr int I_IN = (D / 64) * (INC / 32), I_OUT = (D / 64) * (D / 32);
    for (int it = sgw; it < NLAYER * (I_IN + I_OUT); it += sngw) {
        const int l = it / (I_IN + I_OUT); int r = it % (I_IN + I_OUT);
        if (r < I_IN) transpose_item8(F.w_in() + (size_t)l * D * INC, D, INC, F.WINT() + (size_t)l * INC * D, scr, r, F.lane, WIN_SCALE);
        else transpose_item8(F.w_out() + (size_t)l * D * D, D, D, F.WOUTT() + (size_t)l * D * D, scr, r - I_IN, F.lane, WOUT_SCALE);
    }
    convert_tables(F, 0, NEXP, sgw, sngw);
}

__device__ __forceinline__ void p0b_mod0(Frame& F) {
    __syncthreads();
#pragma unroll 1
    for (int v = 0; v < 6; ++v)
        *(LAS f32x4*)(F.lds + v * 8192 + F.tid * 16) = *(const f32x4*)(F.MODS() + (size_t)(v % 3) * 12288 + (v < 3 ? 0 : D) + 4 * F.tid);
    __syncthreads();
    for (int t = F.gw; t < TT; t += F.NGW) {
        const float* src = t < TL ? F.x() + (size_t)t * D : F.ctx() + (size_t)(t - TL) * D;
        f32x4 v[8];
#pragma unroll
        for (int j = 0; j < 8; ++j) v[j] = *((const f32x4*)src + F.lane + 64 * j);
        const int mr = modrow(t);
        float mean, rstd; row_stats(v, mean, rstd);
        unsigned* d = (unsigned*)(F.H8() + (size_t)t * D) + F.lane;
#pragma unroll
        for (int j = 0; j < 8; ++j) { const f32x4 sh = *(const LAS f32x4*)(F.lds + mr * 8192 + (64 * j + F.lane) * 16), sc = *(const LAS f32x4*)(F.lds + (3 + mr) * 8192 + (64 * j + F.lane) * 16);
            const f32x4 y = (v[j] - mean) * rstd * (sc + 1.f) + sh;
            int o = __builtin_amdgcn_cvt_pk_fp8_f32(y.x, y.y, 0, false); o = __builtin_amdgcn_cvt_pk_fp8_f32(y.z, y.w, o, true); d[64 * j] = (unsigned)o; }
    }
}

constexpr int ROPE_LDS = 98304, ROPE_RS = 272;
constexpr int CONV_LDS = 81920;
constexpr int KP = 272, VP = 320, KS_BYTES = 64 * KP, VS_BYTES = 64 * VP;
struct KVRegs { u32x4 k1, k2, v1, v2; };

__device__ __forceinline__ void attn_load_tile(Frame& F, KVRegs& R, int ti, int b, int n, int g) {
    const int key = F.tid >> 3, c8 = F.tid & 7;
    int row;
    if (ti < 6) row = b * SEQ + (n - 1) * 128 + 64 * ti + key; else row = TL + b * CTXL + 64 * (ti - 6) + key;
    const bf16_t* base = F.PROJ() + (size_t)row * INC;
    const int d1 = (c8 >> 2) * 64 + (c8 & 3) * 8;
    R.k1 = *(const u32x4*)(base + OFF_K + g * 128 + d1); R.k2 = *(const u32x4*)(base + OFF_K + g * 128 + d1 + 32);
    R.v1 = *(const u32x4*)(base + OFF_V + g * 128 + 8 * c8); R.v2 = *(const u32x4*)(base + OFF_V + g * 128 + 64 + 8 * c8);
}
__device__ __forceinline__ void rope8(u32x4& a, u32x4& bq, const f32x4 (&cs)[4], float scale) {
    u32x4 oa, ob;
#pragma unroll
    for (int w = 0; w < 4; ++w) {
        const float x1l = bf_lo(a[w]), x1h = bf_hi(a[w]), x2l = bf_lo(bq[w]), x2h = bf_hi(bq[w]);
        const float cl = cs[w].x, sl = cs[w].y, ch = cs[w].z, sh = cs[w].w;
        oa[w] = pk2((x1l * cl - x2l * sl) * scale, (x1h * ch - x2h * sh) * scale);
        ob[w] = pk2((x2l * cl + x1l * sl) * scale, (x2h * ch + x1h * sh) * scale);
    }
    a = oa; bq = ob;
}
__device__ __forceinline__ void attn_store_tile(Frame& F, KVRegs& R, int ti, int buf, int n) {
    const int key = F.tid >> 3, c8 = F.tid & 7;
    if (ti < 6) {
        const int pos = (n - 1) * 128 + 64 * ti + key;
        const int tidx = (c8 >> 2) ? 128 + (pos & 63) : (pos >> 6); const LAS f32x4* cp = (const LAS f32x4*)(F.lds + ROPE_LDS + tidx * ROPE_RS + (c8 & 3) * 64);
        f32x4 cs[4];
#pragma unroll
        for (int m = 0; m < 4; ++m) cs[m] = cp[m];
        rope8(R.k1, R.k2, cs, 1.f);
    }
    const int d1 = (c8 >> 2) * 64 + (c8 & 3) * 8;
    LAS unsigned char* kp = F.lds + buf * KS_BYTES + key * KP;
    *(LAS u32x4*)(kp + d1 * 2) = R.k1; *(LAS u32x4*)(kp + (d1 + 32) * 2) = R.k2;
    LAS unsigned char* vp = F.lds + 2 * KS_BYTES + buf * VS_BYTES + key * VP;
    *(LAS u32x4*)(vp + 16 * c8) = R.v1; *(LAS u32x4*)(vp + 128 + 16 * c8) = R.v2;
}

#define MFMA32(a, b, c) __builtin_amdgcn_mfma_f32_32x32x16_bf16((a), (b), (c), 0, 0, 0)

struct AUnit { bool latent; int b, n, g, tq, head, tlo, nw; };
__device__ __forceinline__ AUnit attn_decode(int u, int wave, int r) {
    AUnit U; int hp;
    U.latent = u < 512;
    if (U.latent) { hp = u & 1; U.g = (u >> 1) & 1; U.n = (u >> 2) & 63; U.b = u >> 8; }
    else { const int v = u - 512; hp = v & 1; U.g = (v >> 1) & 1; U.n = (v >> 2) & 1; U.b = v >> 3; }
    const int qb = wave & 3;
    U.head = U.g * 4 + hp * 2 + (wave >> 2);
    U.tq = U.latent ? U.b * SEQ + U.n * 128 + 32 * qb + r : TL + U.b * CTXL + U.n * 128 + 32 * qb + r;
    U.tlo = 6; U.nw = 0;
    if (U.latent) { U.tlo = (U.n == 0) ? 2 : 0; const int thi = (U.n == 63) ? 3 : 5; U.nw = thi - U.tlo + 1; }
    return U;
}
#define TILE_OF(U, j) ((j) < (U).nw ? (U).tlo + (j) : 6 + ((j) - (U).nw))
__device__ __forceinline__ void attn_units(Frame& F, int layer, int u0, int ustep, int nunits) {
    if (u0 >= nunits) return;
    const int lane = F.lane, r = lane & 31, h = lane >> 5, wave = F.wave, qb = wave & 3;
    const int i16 = lane & 15, tq4 = i16 >> 2, tp = i16 & 3, blk = (lane >> 4) & 1;
    u32x4 raw[8]; KVRegs R, R2;
    AUnit U = attn_decode(u0, wave, r);
    {
        const bf16_t* qp = F.PROJ() + (size_t)U.tq * INC + OFF_Q + U.head * 128 + 8 * h;
#pragma unroll
        for (int ks = 0; ks < 8; ++ks) raw[ks] = *(const u32x4*)(qp + 16 * ks);
        attn_load_tile(F, R2, TILE_OF(U, 0), U.b, U.n, U.g);
        attn_load_tile(F, R, TILE_OF(U, 1), U.b, U.n, U.g);
    }
    for (int u = u0;; u += ustep) {
        const bool latent = U.latent; const int b = U.b, n = U.n, g = U.g, head = U.head, tq = U.tq, tlo = U.tlo, nw = U.nw;
        bf16x8 qf[8];
        if (latent) {
            const int pos = n * 128 + 32 * qb + r;
#pragma unroll
            for (int half = 0; half < 2; ++half) {
                const int tidx = half ? 128 + (pos & 63) : (pos >> 6);
#pragma unroll
                for (int kk = 0; kk < 2; ++kk) {
                    const LAS f32x4* cp = (const LAS f32x4*)(F.lds + ROPE_LDS + tidx * ROPE_RS + (16 * kk + 8 * h) * 8);
                    f32x4 cs[4];
#pragma unroll
                    for (int m = 0; m < 4; ++m) cs[m] = cp[m];
                    rope8(raw[4 * half + kk], raw[4 * half + kk + 2], cs, QSCALE);
                }
            }
        } else {
#pragma unroll
            for (int ks = 0; ks < 8; ++ks)
#pragma unroll
                for (int w = 0; w < 4; ++w) raw[ks][w] = pk2(bf_lo(raw[ks][w]) * QSCALE, bf_hi(raw[ks][w]) * QSCALE);
        }
#pragma unroll
        for (int ks = 0; ks < 8; ++ks) qf[ks] = __builtin_bit_cast(bf16x8, raw[ks]);
        const int ntiles = nw + 4;
        f32x16 o[4];
#pragma unroll
        for (int db = 0; db < 4; ++db)
#pragma unroll
            for (int i = 0; i < 16; ++i) o[db][i] = 0.f;
        float m_run = F.sink()[layer * 8 + head] * LOG2E;
        float lsum = h == 0 ? 1.f : 0.f;
        const int iq = 32 * qb + r;
        __syncthreads();
        attn_store_tile(F, R2, TILE_OF(U, 0), 0, n);
        __syncthreads();
        for (int j = 0; j < ntiles; ++j) {
            const int ti = TILE_OF(U, j);
            const int buf = j & 1;
            const bool more = j + 1 < ntiles;
            const int tin = TILE_OF(U, j + 1);
            if (j + 2 < ntiles) attn_load_tile(F, R2, TILE_OF(U, j + 2), b, n, g);
            const bool part = ti >= 6 || (ti >= (qb >> 1) && ti <= (qb >> 1) + 4);
            if (part) {
                f32x16 s0, s1;
#pragma unroll
                for (int i = 0; i < 16; ++i) { s0[i] = 0.f; s1[i] = 0.f; }
                const LAS unsigned char* kb = F.lds + buf * KS_BYTES + r * KP + h * 16;
#pragma unroll
                for (int ks = 0; ks < 8; ++ks) {
                    const bf16x8 a0 = *(const LAS bf16x8*)(kb + ks * 32), a1 = *(const LAS bf16x8*)(kb + 32 * KP + ks * 32);
                    s0 = MFMA32(a0, qf[ks], s0); s1 = MFMA32(a1, qf[ks], s1);
                }
                float mx = -INFINITY;
                if (ti < 6 && (ti == (qb >> 1) || ti == (qb >> 1) + 4)) {
                    const int jb = 64 * ti + 4 * h - iq;
#pragma unroll
                    for (int i = 0; i < 16; ++i) { const int j0 = jb + (i & 3) + 8 * (i >> 2), j1 = j0 + 32;
                        s0[i] = (j0 >= 0 && j0 <= 256) ? s0[i] : -INFINITY; s1[i] = (j1 >= 0 && j1 <= 256) ? s1[i] : -INFINITY; }
                }
#pragma unroll
                for (int i = 0; i < 16; ++i) mx = fmaxf(mx, fmaxf(s0[i], s1[i]));
                mx = fmaxf(mx, xor32_f(mx, lane));
                if (__any(mx > m_run + 8.f)) {
                    const float m_new = mx > m_run + 8.f ? mx : m_run, alpha = __builtin_amdgcn_exp2f(m_run - m_new);
                    m_run = m_new; lsum *= alpha;
#pragma unroll
                    for (int db = 0; db < 4; ++db)
#pragma unroll
                        for (int i = 0; i < 16; ++i) o[db][i] *= alpha;
                }
                const LAS unsigned char* vb = F.lds + 2 * KS_BYTES + buf * VS_BYTES + (4 * h + tq4) * VP + 32 * blk + 8 * tp;
                u32x4 pc;
#pragma unroll
                for (int w = 0; w < 4; ++w) { const float e0 = __builtin_amdgcn_exp2f(s0[2 * w] - m_run), e1 = __builtin_amdgcn_exp2f(s0[2 * w + 1] - m_run); lsum += e0 + e1; pc[w] = pk2(e0, e1); }
#pragma unroll
                for (int c = 0; c < 4; ++c) {
                    const int kb2 = c >> 1, s2 = c & 1;
                    const bf16x8 pf = __builtin_bit_cast(bf16x8, pc);
                    s16x4 lo[4], hi[4];
#pragma unroll
                    for (int db = 0; db < 4; ++db) { const int off = (32 * kb2 + 16 * s2) * VP + db * 64;
                        lo[db] = __builtin_amdgcn_ds_read_tr16_b64_v4i16((LAS s16x4*)(vb + off)); hi[db] = __builtin_amdgcn_ds_read_tr16_b64_v4i16((LAS s16x4*)(vb + off + 8 * VP)); }
#pragma unroll
                    for (int db = 0; db < 4; ++db) {
                        const bf16x8 av = __builtin_shufflevector(lo[db], hi[db], 0, 1, 2, 3, 4, 5, 6, 7);
                        o[db] = MFMA32(av, pf, o[db]);
                        if (c < 3) {
                            const int cn = c + 1, base = 8 * (cn & 1) + 2 * db;
                            const float x0 = (cn >> 1) ? s1[base] : s0[base], x1 = (cn >> 1) ? s1[base + 1] : s0[base + 1];
                            const float e0 = __builtin_amdgcn_exp2f(x0 - m_run), e1 = __builtin_amdgcn_exp2f(x1 - m_run); lsum += e0 + e1; pc[db] = pk2(e0, e1);
                        }
                    }
                }
            }
            if (more) attn_store_tile(F, R, tin, buf ^ 1, n);
            R = R2;
            __syncthreads();
        }
        const bool hasn = u + ustep < nunits;
        if (hasn) {
            U = attn_decode(u + ustep, wave, r);
            const bf16_t* qp = F.PROJ() + (size_t)U.tq * INC + OFF_Q + U.head * 128 + 8 * h;
#pragma unroll
            for (int ks = 0; ks < 8; ++ks) raw[ks] = *(const u32x4*)(qp + 16 * ks);
            attn_load_tile(F, R2, TILE_OF(U, 0), U.b, U.n, U.g);
            attn_load_tile(F, R, TILE_OF(U, 1), U.b, U.n, U.g);
        }
        const float lt = lsum + xor32_f(lsum, lane);
        const float inv = 1.f / lt;
        float ss = 0.f;
#pragma unroll
        for (int db = 0; db < 4; ++db)
#pragma unroll
            for (int i = 0; i < 16; ++i) { o[db][i] *= inv; ss += o[db][i] * o[db][i]; }
        ss += xor32_f(ss, lane);
        const float rn = 1.f / sqrtf(ss * (1.f / 128.f) + LN_EPS);
        unsigned char* op = F.MIX() + (size_t)tq * D + head * 128 + 16 * h;
        const float* gp = F.g_attn() + layer * 1024 + head * 128 + 4 * h;
#pragma unroll
        for (int db = 0; db < 4; ++db) {
            unsigned wv[4];
#pragma unroll
            for (int g4 = 0; g4 < 4; ++g4) {
                const f32x4 gv = *(const f32x4*)(gp + 32 * db + 8 * g4);
                int w = __builtin_amdgcn_cvt_pk_fp8_f32(o[db][4 * g4] * rn * gv.x, o[db][4 * g4 + 1] * rn * gv.y, 0, false);
                w = __builtin_amdgcn_cvt_pk_fp8_f32(o[db][4 * g4 + 2] * rn * gv.z, o[db][4 * g4 + 3] * rn * gv.w, w, true);
                wv[g4] = (unsigned)w;
            }
            const auto s02 = __builtin_amdgcn_permlane32_swap(wv[0], wv[2], false, false), s13 = __builtin_amdgcn_permlane32_swap(wv[1], wv[3], false, false);
            u32x4 ov; ov.x = s02[0]; ov.y = s02[1]; ov.z = s13[0]; ov.w = s13[1];
            *(u32x4*)(op + 32 * db) = ov;
        }
        if (!hasn) break;
    }
}
#undef TILE_OF

__device__ __forceinline__ void unpack8(const u32x4 v, float (&f)[8]) {
#pragma unroll
    for (int w = 0; w < 4; ++w) { f[2 * w] = bf_lo(v[w]); f[2 * w + 1] = bf_hi(v[w]); }
}
struct ConvRaw { u32x4 c[2], x[2]; };
__device__ __forceinline__ void conv_load(Frame& F, ConvRaw& R, int t, int lane) {
    const bf16_t* p = F.PROJ() + (size_t)t * INC + 8 * lane;
#pragma unroll
    for (int jc = 0; jc < 2; ++jc) { R.c[jc] = *(const u32x4*)(p + OFF_C + 512 * jc); R.x[jc] = *(const u32x4*)(p + OFF_X + 512 * jc); }
}
__device__ __forceinline__ void conv_prod(const ConvRaw& R, float (&P)[16]) {
#pragma unroll
    for (int jc = 0; jc < 2; ++jc) { float a[8], bq[8]; unpack8(R.c[jc], a); unpack8(R.x[jc], bq);
#pragma unroll
        for (int e = 0; e < 8; ++e) P[8 * jc + e] = a[e] * bq[e]; }
}
__device__ __forceinline__ bool conv_first(int t) { return t < TL ? (t & (SEQ - 1)) == 0 : ((t - TL) & (CTXL - 1)) == 0; }
__device__ __forceinline__ bool conv_last(int t) { return t < TL ? (t & (SEQ - 1)) == SEQ - 1 : ((t - TL) & (CTXL - 1)) == CTXL - 1; }
__device__ __forceinline__ void conv_rows(Frame& F, int layer, int t0, int t1) {
    if (t0 >= t1) return;
    const int lane = F.lane;
    const LAS unsigned char* cvc = F.lds + CONV_LDS + lane * 16;
    float Pm[16], Pt[16];
    ConvRaw Rn; u32x4 gcur[2];
    {
        ConvRaw R0;
        if (!conv_first(t0)) { conv_load(F, R0, t0 - 1, lane); conv_prod(R0, Pm); }
        else {
#pragma unroll
            for (int e = 0; e < 16; ++e) Pm[e] = 0.f; }
        conv_load(F, R0, t0, lane); conv_prod(R0, Pt);
    }
    conv_load(F, Rn, t0 + 1 < TT ? t0 + 1 : TT - 1, lane);
    { const bf16_t* gp = F.PROJ() + (size_t)t0 * INC + 8 * lane; gcur[0] = *(const u32x4*)gp; gcur[1] = *(const u32x4*)(gp + 512); }
    for (int t = t0; t < t1; ++t) {
        ConvRaw R2; u32x4 gnext[2];
        const bool more = t + 1 < t1;
        if (more) { conv_load(F, R2, t + 2 < TT ? t + 2 : TT - 1, lane); const bf16_t* gp = F.PROJ() + (size_t)(t + 1) * INC + 8 * lane; gnext[0] = *(const u32x4*)gp; gnext[1] = *(const u32x4*)(gp + 512); }
        float Pp[16]; conv_prod(Rn, Pp);
        const float fm = conv_first(t) ? 0.f : 1.f, fp = conv_last(t) ? 0.f : 1.f;
#pragma unroll
        for (int jc = 0; jc < 2; ++jc) {
            float gb[8]; unpack8(gcur[jc], gb);
            float y[8], ss = 0.f;
#pragma unroll
            for (int q = 0; q < 2; ++q) { const f32x4 w0 = *(const LAS f32x4*)(cvc + (2 * jc + q) * 1024) * fm, w1 = *(const LAS f32x4*)(cvc + 4096 + (2 * jc + q) * 1024), w2 = *(const LAS f32x4*)(cvc + 8192 + (2 * jc + q) * 1024) * fp;
#pragma unroll
                for (int e = 0; e < 4; ++e) { const int i = 4 * q + e; y[i] = gb[i] * (w0[e] * Pm[8 * jc + i] + w1[e] * Pt[8 * jc + i] + w2[e] * Pp[8 * jc + i]); ss += y[i] * y[i]; } }
            ss += dpp_f<DPP_XOR1>(ss); ss += dpp_f<DPP_XOR2>(ss); ss += dpp_f<DPP_ROR4>(ss); ss += dpp_f<DPP_ROR8>(ss);
            const float rn = 1.f / sqrtf(ss * (1.f / 128.f) + LN_EPS);
            u32x2 w;
#pragma unroll
            for (int q = 0; q < 2; ++q) { const f32x4 gcv = *(const LAS f32x4*)(cvc + 12288 + (2 * jc + q) * 1024);
                int t8 = __builtin_amdgcn_cvt_pk_fp8_f32(y[4 * q] * rn * gcv[0], y[4 * q + 1] * rn * gcv[1], 0, false); t8 = __builtin_amdgcn_cvt_pk_fp8_f32(y[4 * q + 2] * rn * gcv[2], y[4 * q + 3] * rn * gcv[3], t8, true); w[q] = (unsigned)t8; }
            *(u32x2*)(F.MIX() + (size_t)t * D + 1024 + 8 * lane + 512 * jc) = w;
        }
#pragma unroll
        for (int e = 0; e < 16; ++e) { Pm[e] = Pt[e]; Pt[e] = Pp[e]; }
        if (more) { Rn = R2; gcur[0] = gnext[0]; gcur[1] = gnext[1]; }
    }
}

__device__ __forceinline__ void ln_phase(Frame& F, int layer, int rows) {
    const int lane = F.lane;
    const unsigned char* Y = (const unsigned char*)F.PROJ();
    u32x4 w[4], wn[4]; u32x2 yw[4], yn[4];
    int t = F.gw;
    if (t < rows) {
#pragma unroll
        for (int j = 0; j < 4; ++j) { yw[j] = *(const u32x2*)(Y + (size_t)t * D + 8 * lane + 512 * j); if (layer > 0) w[j] = *(const u32x4*)(F.X() + (size_t)t * D + 8 * lane + 512 * j); }
    }
    {
        const int ch = F.tid, jj = ch >> 7, rem = ch & 127, ll = rem >> 1, qq = rem & 1;
        LAS unsigned char* dst = F.lds + ((2 * jj + qq) * 64 + ll) * 16;
        *(LAS f32x4*)(dst) = *(const f32x4*)(F.ln1_g() + layer * D + 4 * ch);
        *(LAS f32x4*)(dst + 8192) = *(const f32x4*)(F.ln1_b() + layer * D + 4 * ch);
#pragma unroll 1
        for (int v = 0; v < 9; ++v) { const int mrv = v % 3; const size_t off = ((size_t)layer * 3 + mrv) * 12288 + (v < 3 ? 3 * D : (v < 6 ? 4 * D : 2 * D));
            *(LAS f32x4*)(dst + (2 + v) * 8192) = *(const f32x4*)(F.MODS() + off + 4 * ch); }
    }
    __syncthreads();
    const LAS unsigned char* vc = F.lds + lane * 16;
    while (t < rows) {
        const int tn = t + F.NGW;
        if (tn < rows) {
#pragma unroll
            for (int j = 0; j < 4; ++j) { yn[j] = *(const u32x2*)(Y + (size_t)tn * D + 8 * lane + 512 * j); if (layer > 0) wn[j] = *(const u32x4*)(F.X() + (size_t)tn * D + 8 * lane + 512 * j); }
        }
        const int mrl = modrow(t);
        float v[32]; float s = 0.f;
#pragma unroll
        for (int j = 0; j < 4; ++j) {
            float xin[8], yv[8];
            { const f32x2 a0 = __builtin_amdgcn_cvt_pk_f32_fp8((int)yw[j].x, false), a1 = __builtin_amdgcn_cvt_pk_f32_fp8((int)yw[j].x, true), a2 = __builtin_amdgcn_cvt_pk_f32_fp8((int)yw[j].y, false), a3 = __builtin_amdgcn_cvt_pk_f32_fp8((int)yw[j].y, true);
              yv[0] = a0.x; yv[1] = a0.y; yv[2] = a1.x; yv[3] = a1.y; yv[4] = a2.x; yv[5] = a2.y; yv[6] = a3.x; yv[7] = a3.y; }
            if (layer > 0) unpack8(w[j], xin);
            else { const float* xp = (t < TL ? F.x() + (size_t)t * D : F.ctx() + (size_t)(t - TL) * D) + 8 * lane + 512 * j; const f32x4 a0 = *(const f32x4*)xp, a1 = *(const f32x4*)(xp + 4);
                xin[0] = a0[0]; xin[1] = a0[1]; xin[2] = a0[2]; xin[3] = a0[3]; xin[4] = a1[0]; xin[5] = a1[1]; xin[6] = a1[2]; xin[7] = a1[3]; }
#pragma unroll
            for (int q = 0; q < 2; ++q) { const f32x4 ga = *(const LAS f32x4*)(vc + (8 + mrl) * 8192 + (2 * j + q) * 1024);
#pragma unroll
                for (int e = 0; e < 4; ++e) { const float r = DN_ALPHA * xin[4 * q + e] + ga[e] * yv[4 * q + e]; v[8 * j + 4 * q + e] = r; s += r; } } }
        const float mean = wave_sum(s) * (1.f / D);
        float s2 = 0.f;
#pragma unroll
        for (int i = 0; i < 32; ++i) { v[i] -= mean; s2 += v[i] * v[i]; }
        const float rstd = 1.f / sqrtf(wave_sum(s2) * (1.f / D) + LN_EPS);
        float s3 = 0.f;
#pragma unroll
        for (int j = 0; j < 4; ++j) { const int c = 8 * lane + 512 * j; u32x4 o;
#pragma unroll
            for (int q = 0; q < 2; ++q) { const f32x4 gg = *(const LAS f32x4*)(vc + (2 * j + q) * 1024), bb = *(const LAS f32x4*)(vc + 8192 + (2 * j + q) * 1024);
#pragma unroll
                for (int e = 0; e < 4; ++e) { const float y = v[8 * j + 4 * q + e] * rstd * gg[e] + bb[e]; v[8 * j + 4 * q + e] = y; s3 += y; }
                o[2 * q] = pk2(v[8 * j + 4 * q], v[8 * j + 4 * q + 1]); o[2 * q + 1] = pk2(v[8 * j + 4 * q + 2], v[8 * j + 4 * q + 3]); }
            *(u32x4*)(F.X() + (size_t)t * D + c) = o; }
        const float mean2 = wave_sum(s3) * (1.f / D);
        float s4 = 0.f;
#pragma unroll
        for (int i = 0; i < 32; ++i) { v[i] -= mean2; s4 += v[i] * v[i]; }
        const float rstd2 = 1.f / sqrtf(wave_sum(s4) * (1.f / D) + LN_EPS);
        float ham = 0.f;
#pragma unroll
        for (int j = 0; j < 4; ++j) { const int c = 8 * lane + 512 * j; u32x2 o8;
#pragma unroll
            for (int q = 0; q < 2; ++q) { const f32x4 sh = *(const LAS f32x4*)(vc + (2 + mrl) * 8192 + (2 * j + q) * 1024), sc = *(const LAS f32x4*)(vc + (5 + mrl) * 8192 + (2 * j + q) * 1024);
                const float y0 = v[8 * j + 4 * q] * rstd2 * (1.f + sc[0]) + sh[0], y1 = v[8 * j + 4 * q + 1] * rstd2 * (1.f + sc[1]) + sh[1];
                const float y2 = v[8 * j + 4 * q + 2] * rstd2 * (1.f + sc[2]) + sh[2], y3 = v[8 * j + 4 * q + 3] * rstd2 * (1.f + sc[3]) + sh[3];
                v[8 * j + 4 * q] = y0; v[8 * j + 4 * q + 1] = y1; v[8 * j + 4 * q + 2] = y2; v[8 * j + 4 * q + 3] = y3;
                ham = fmaxf(fmaxf(ham, fmaxf(fabsf(y0), fabsf(y1))), fmaxf(fabsf(y2), fabsf(y3)));
                { int t8 = __builtin_amdgcn_cvt_pk_fp8_f32(y0, y1, 0, false); t8 = __builtin_amdgcn_cvt_pk_fp8_f32(y2, y3, t8, true); o8[q] = (unsigned)t8; } }
            *(u32x2*)(F.H8() + (size_t)t * D + c) = o8; }
        ham = wave_max_u(ham);
        const float hsq = ham > 0.f ? 119.f / ham : 1.f;
#pragma unroll
        for (int j = 0; j < 4; ++j) { unsigned vh = 0u, vl = 0u;
#pragma unroll
            for (int e = 0; e < 8; ++e) { const int qi = (int)rintf(v[8 * j + e] * hsq); const int lo = ((qi + 8) & 15) - 8, hi = (qi - lo) >> 4;
                vl |= ((unsigned)lo & 15u) << (4 * e); vh |= ((unsigned)hi & 15u) << (4 * e); }
            unsigned* hd = (unsigned*)F.H() + (size_t)t * 512 + lane + 64 * j;
            hd[0] = vh; hd[256] = vl; }
        if (lane == 0) F.VS()[t] = ham > 0.f ? ham * (1.f / 119.f) : 1.f;
#pragma unroll
        for (int j = 0; j < 4; ++j) { w[j] = wn[j]; yw[j] = yn[j]; }
        t = tn;
    }
}

__device__ __forceinline__ unsigned ordkey(float f) { const unsigned u = __float_as_uint(f); return u ^ ((u >> 31) ? 0xFFFFFFFFu : 0x80000000u); }
__device__ __forceinline__ float gelu_erf(float a) { return 0.5f * a * (1.f + erff(a * 0.70710678118654752f)); }

__device__ __forceinline__ float unordkey(unsigned k) { return __uint_as_float(k ^ ((k >> 31) ? 0x80000000u : 0xFFFFFFFFu)); }
__device__ __forceinline__ float gelu_as(float v) {
    const float av = fabsf(v), t = __builtin_amdgcn_rcpf(av * 0.2316418882f + 1.0f);
    float q = t * 0.5307027145f + (-0.7265760135f); q = q * t + 0.7107068705f; q = q * t + (-0.142248368f); q = q * t + 0.127414796f; q = q * t;
    const float e = __builtin_amdgcn_exp2f((v * v) * (-0.72134752044f));
    const float m = v * (q * e);
    return v < 0.f ? m : v - m;
}

template <class O> struct QuadNet {
    typedef typename O::V V; typedef typename O::B B;
    template <bool ASC> static __device__ __forceinline__ void ce_reg(V& a, V& b) { const V lo = O::vmin(a, b), hi = O::vmax(a, b); a = ASC ? lo : hi; b = ASC ? hi : lo; }
    template <bool ASC> static __device__ __forceinline__ void ce_l1(V& x, B low1) { const V p = O::x1(x); const V mn = O::vmin(p, x), mx = O::vmax(p, x); x = ASC ? O::vsel(low1, mn, mx) : O::vsel(low1, mx, mn); }
    template <bool ASC> static __device__ __forceinline__ void ce_l2(V& x, B low2) { const V p = O::x2(x); const V mn = O::vmin(p, x), mx = O::vmax(p, x); x = ASC ? O::vsel(low2, mn, mx) : O::vsel(low2, mx, mn); }
    template <int NR> static __device__ __forceinline__ void sort_blocks(V (&R)[NR], B low1, B low2, B eq12) {
#pragma unroll
        for (int r = 0; r < NR; ++r) { const V p = O::x1(R[r]); const V mn = O::vmin(p, R[r]), mx = O::vmax(p, R[r]); R[r] = O::vsel(eq12, mn, mx); }
#pragma unroll
        for (int r = 0; r < NR; ++r) { if ((r & 1) == 0) ce_l2<true>(R[r], low2); else ce_l2<false>(R[r], low2); }
#pragma unroll
        for (int r = 0; r < NR; ++r) { if ((r & 1) == 0) ce_l1<true>(R[r], low1); else ce_l1<false>(R[r], low1); }
#pragma unroll
        for (int r = 0; r < NR; r += 2) { if ((r & 2) == 0) ce_reg<true>(R[r], R[r + 1]); else ce_reg<false>(R[r], R[r + 1]); }
#pragma unroll
        for (int r = 0; r < NR; ++r) { if ((r & 2) == 0) ce_l2<true>(R[r], low2); else ce_l2<false>(R[r], low2); }
#pragma unroll
        for (int r = 0; r < NR; ++r) { if ((r & 2) == 0) ce_l1<true>(R[r], low1); else ce_l1<false>(R[r], low1); }
#pragma unroll
        for (int r = 0; r < NR; ++r) { if ((r & 2) == 0) { if ((r & 4) == 0) ce_reg<true>(R[r], R[r + 2]); else ce_reg<false>(R[r], R[r + 2]); } }
#pragma unroll
        for (int r = 0; r < NR; r += 2) { if ((r & 4) == 0) ce_reg<true>(R[r], R[r + 1]); else ce_reg<false>(R[r], R[r + 1]); }
#pragma unroll
        for (int r = 0; r < NR; ++r) { if ((r & 4) == 0) ce_l2<true>(R[r], low2); else ce_l2<false>(R[r], low2); }
#pragma unroll
        for (int r = 0; r < NR; ++r) { if ((r & 4) == 0) ce_l1<true>(R[r], low1); else ce_l1<false>(R[r], low1); }
    }
    template <int NR> static __device__ __forceinline__ void halve_merge(const V (&R)[NR], V (&Q)[NR / 2], B low1, B low2) {
#pragma unroll
        for (int m = 0; m < NR / 8; ++m)
#pragma unroll
            for (int i = 0; i < 4; ++i) Q[4 * m + i] = O::vmax(R[8 * m + i], R[8 * m + 4 + i]);
#pragma unroll
        for (int r = 0; r < NR / 2; ++r) { if ((r & 2) == 0) { if ((r & 4) == 0) ce_reg<false>(Q[r], Q[r + 2]); else ce_reg<true>(Q[r], Q[r + 2]); } }
#pragma unroll
        for (int r = 0; r < NR / 2; r += 2) { if ((r & 4) == 0) ce_reg<false>(Q[r], Q[r + 1]); else ce_reg<true>(Q[r], Q[r + 1]); }
#pragma unroll
        for (int r = 0; r < NR / 2; ++r) { if ((r & 4) == 0) ce_l2<false>(Q[r], low2); else ce_l2<true>(Q[r], low2); }
#pragma unroll
        for (int r = 0; r < NR / 2; ++r) { if ((r & 4) == 0) ce_l1<false>(Q[r], low1); else ce_l1<true>(Q[r], low1); }
    }
    static __device__ __forceinline__ void top16_of_128(V (&R)[32], V (&T)[4], B low1, B low2, B eq12) {
        sort_blocks<32>(R, low1, low2, eq12);
        V A[16]; halve_merge<32>(R, A, low1, low2);
        V Bq[8]; halve_merge<16>(A, Bq, low1, low2);
        halve_merge<8>(Bq, T, low1, low2);
    }
    static __device__ __forceinline__ void top16_of_64(V (&R)[16], V (&T)[4], B low1, B low2, B eq12) {
        sort_blocks<16>(R, low1, low2, eq12);
        V A[8]; halve_merge<16>(R, A, low1, low2);
        halve_merge<8>(A, T, low1, low2);
    }
};

struct DevOps {
    typedef unsigned V; typedef bool B;
    static __device__ __forceinline__ V vmin(V a, V b) { return a < b ? a : b; }
    static __device__ __forceinline__ V vmax(V a, V b) { return a > b ? a : b; }
    static __device__ __forceinline__ V vsel(B m, V a, V b) { return m ? a : b; }
    static __device__ __forceinline__ V x1(V a) { return (V)dpp_i<DPP_XOR1>((int)a); }
    static __device__ __forceinline__ V x2(V a) { return (V)dpp_i<DPP_XOR2>((int)a); }
};
template <class O> struct LaneNet {
    typedef typename O::V V;
    static __device__ __forceinline__ void ce_desc(V& a, V& b) { const V hi = O::vmax(a, b), lo = O::vmin(a, b); a = hi; b = lo; }
    static __device__ __forceinline__ void ce_asc(V& a, V& b) { const V hi = O::vmax(a, b), lo = O::vmin(a, b); a = lo; b = hi; }
    template <int N> static __device__ __forceinline__ void sort_desc(V (&R)[N]) {
#pragma unroll
        for (int k = 2; k <= N; k <<= 1)
#pragma unroll
            for (int j = k >> 1; j > 0; j >>= 1)
#pragma unroll
                for (int i = 0; i < N; ++i) { const int l = i ^ j; if (l > i) { if ((i & k) == 0) ce_desc(R[i], R[l]); else ce_asc(R[i], R[l]); } }
    }
    static __device__ __forceinline__ void merge16_desc(V (&Q)[16]) {
#pragma unroll
        for (int j = 8; j > 0; j >>= 1)
#pragma unroll
            for (int i = 0; i < 16; ++i) { if ((i & j) == 0) ce_desc(Q[i], Q[i + j]); }
    }
    static __device__ __forceinline__ void quad_merge(V (&S)[16]) {
        V Q[16];
#pragma unroll
        for (int i = 0; i < 16; ++i) Q[i] = O::vmax(S[i], O::x1(S[15 - i]));
        merge16_desc(Q);
#pragma unroll
        for (int i = 0; i < 16; ++i) S[i] = O::vmax(Q[i], O::x2(Q[15 - i]));
        merge16_desc(S);
    }
    static __device__ __forceinline__ void top16_of_4x32(V (&R)[32], V (&S)[16]) {
        sort_desc<32>(R);
#pragma unroll
        for (int i = 0; i < 16; ++i) S[i] = R[i];
        quad_merge(S);
    }
    static __device__ __forceinline__ void top16_of_4x16(V (&S)[16]) { sort_desc<16>(S); quad_merge(S); }
};
__device__ __forceinline__ void stair_ab(int c, int& a, int& b) {
    if (c < 16) { a = 0; b = c; } else if (c < 24) { a = 1; b = c - 16; } else if (c < 28) { a = 2; b = c - 24; } else if (c < 32) { a = 3; b = c - 28; }
    else if (c < 36) { a = 4; b = c - 32; } else if (c < 40) { a = 5 + ((c - 36) >> 1); b = (c - 36) & 1; } else if (c < 44) { a = 7 + ((c - 40) >> 1); b = (c - 40) & 1; }
    else if (c < 48) { a = 9 + (c - 44); b = 0; } else if (c < 51) { a = 13 + (c - 48); b = 0; } else { a = 2; b = 4; }
}
constexpr int PE_WS = 5120, PE_TAB = 8 * PE_WS;
constexpr int PE_VEC = PE_TAB + 512;
static_assert(PE_VEC + 11 * 8192 <= LDSCTL_OFF, "PE vector cache");
__device__ __forceinline__ void sc_row_load(Frame& F, u32x4 (&scv)[4], int t) {
    const bf16_t* sp = F.SC() + (size_t)t * D + (F.lane >> 2) * 128 + (F.lane & 3) * 32;
#pragma unroll
    for (int q = 0; q < 4; ++q) scv[q] = *(const u32x4*)(sp + 8 * q);
}
__device__ __forceinline__ void peer_topk(Frame& F, LAS unsigned char* ws, const u32x4 (&scv)[4]) {
    const int lane = F.lane, sub = lane & 3;
    const bool low1 = (sub & 1) == 0, low2 = (sub & 2) == 0, eq12 = low1 == low2;
    LAS unsigned* S1K = (LAS unsigned*)ws; LAS int* EL = (LAS int*)(ws + 3328); LAS float* GL = (LAS float*)(ws + 3840);
    const LAS unsigned short* TAB = (const LAS unsigned short*)(F.lds + PE_TAB);
    {
        const int L = lane >> 2;
        unsigned R[32];
#pragma unroll
        for (int q = 0; q < 4; ++q) { const u32x4 v = scv[q];
#pragma unroll
            for (int e = 0; e < 4; ++e) {
                R[8 * q + 2 * e] = (ordkey(bf_lo(v[e])) & ~127u) | (unsigned)(127 - (32 * sub + 8 * q + 2 * e));
                R[8 * q + 2 * e + 1] = (ordkey(bf_hi(v[e])) & ~127u) | (unsigned)(127 - (32 * sub + 8 * q + 2 * e + 1)); } }
        unsigned S[16];
        LaneNet<DevOps>::top16_of_4x32(R, S);
        if (sub == 0) {
#pragma unroll
            for (int r = 0; r < 4; ++r) *(LAS u32x4*)(S1K + L * 16 + 4 * r) = (u32x4){S[4 * r], S[4 * r + 1], S[4 * r + 2], S[4 * r + 3]};
        }
    }
    LDS_WAIT(); __builtin_amdgcn_wave_barrier();
    {
        const int hd = (lane >> 2) & 7;
        const LAS unsigned char* la = (const LAS unsigned char*)(S1K + (2 * hd) * 16); const LAS unsigned char* lb = (const LAS unsigned char*)(S1K + (2 * hd + 1) * 16);
        unsigned C[16];
#pragma unroll
        for (int r = 0; r < 13; ++r) { const unsigned ab = TAB[4 * r + sub];
            const unsigned ka = *(const LAS unsigned*)(la + (ab & 255u)), kb = *(const LAS unsigned*)(lb + (ab >> 8));
            const float sum = unordkey(ka & ~127u) + unordkey(kb & ~127u);
            C[r] = (ordkey(sum) & ~63u) | (unsigned)(63 - (4 * r + sub)); }
        C[13] = 0u; C[14] = 0u; C[15] = 0u;
        LaneNet<DevOps>::top16_of_4x16(C);
        unsigned W[4];
#pragma unroll
        for (int r = 0; r < 4; ++r) W[r] = sub == 0 ? C[4 * r] : (sub == 1 ? C[4 * r + 1] : (sub == 2 ? C[4 * r + 2] : C[4 * r + 3]));
        float sv[4]; int ex[4];
#pragma unroll
        for (int r = 0; r < 4; ++r) { const unsigned ab = TAB[63 - (W[r] & 63u)];
            const unsigned ka = *(const LAS unsigned*)(la + (ab & 255u)), kb = *(const LAS unsigned*)(lb + (ab >> 8));
            ex[r] = (int)(127u - (ka & 127u)) * 128 + (int)(127u - (kb & 127u)); sv[r] = unordkey(W[r] & ~63u); }
        const float mx = dpp_f<0x00>(sv[0]);
        float e4[4], es = 0.f;
#pragma unroll
        for (int r = 0; r < 4; ++r) { e4[r] = __expf(sv[r] - mx); es += e4[r]; }
        es += dpp_f<DPP_XOR1>(es); es += dpp_f<DPP_XOR2>(es);
        const float rd = 1.f / es;
#pragma unroll
        for (int r = 0; r < 4; ++r) { GL[hd * 16 + 4 * r + sub] = e4[r] * rd; EL[hd * 16 + 4 * r + sub] = ex[r]; }
    }
    LDS_WAIT(); __builtin_amdgcn_wave_barrier();
}

#ifndef PROBE_PHASE
#define PROBE_PHASE -1
#endif
#ifndef PROBE_MULT
#define PROBE_MULT 1
#endif
constexpr int EB = 4;
constexpr int CW_TICKET = 20480;

static_assert(EB == 4, "the coefficient vectorisation below handles four experts per buffer");
struct GBuf { LpRow<U_FMT> u[EB]; LpRow<V_FMT> v[EB]; f32x2 sc; };
__device__ __forceinline__ void gather_issue(GBuf& B, const LAS int* EL, int i0, const unsigned char* UTl, const unsigned char* VTl, const float* USl, int lane) {
#pragma unroll
    for (int q = 0; q < EB; ++q) {
        const int ex = __builtin_amdgcn_readfirstlane(EL[i0 + q]);
        B.u[q].load(UTl + (size_t)ex * UROW, lane); B.v[q].load(VTl + (size_t)ex * VROW, lane);
    }
    B.sc = *(const f32x2*)(USl + 2 * EL[i0 + (lane & 3)]);
}
__device__ __forceinline__ void gather_compute(const GBuf& B, const LAS int* EL, const LAS float* GL, int i0, const float* USl, const float* VSl, const unsigned (&hv)[8], float hinv, f32x2 (&acc)[16], int lane) {
    float dot[EB];
#pragma unroll
    for (int q = 0; q < EB; ++q) { int ah = 0, al = 0;
#pragma unroll
        for (int w = 0; w < 4; ++w) { ah = __builtin_amdgcn_sdot8((int)B.u[q].a[w], (int)hv[w], ah, false); al = __builtin_amdgcn_sdot8((int)B.u[q].a[w], (int)hv[4 + w], al, false); }
        dot[q] = (float)(16 * ah + al); }
    const bool o1 = (lane & 1) != 0, o2 = (lane & 2) != 0;
    const float a01 = (o1 ? dot[1] : dot[0]) + dpp_f<DPP_XOR1>(o1 ? dot[0] : dot[1]);
    const float a23 = (o1 ? dot[3] : dot[2]) + dpp_f<DPP_XOR1>(o1 ? dot[2] : dot[3]);
    float d = (o2 ? a23 : a01) + dpp_f<DPP_XOR2>(o2 ? a01 : a23);
    d += dpp_f<DPP_ROR4>(d); d += dpp_f<DPP_ROR8>(d);
    { const auto r = __builtin_amdgcn_permlane32_swap(__float_as_uint(d), __float_as_uint(d), false, false); d = __uint_as_float(r[0]) + __uint_as_float(r[1]); }
    { const auto r = __builtin_amdgcn_permlane16_swap(__float_as_uint(d), __float_as_uint(d), false, false); d = __uint_as_float(r[0]) + __uint_as_float(r[1]); }
    asm volatile("" : "+v"(d));
    float cfv = GL[i0 + (lane & 3)] * gelu_as(d * (B.sc.x * hinv)) * B.sc.y;
    asm volatile("" : "+v"(cfv)); __builtin_amdgcn_sched_barrier(0);
#pragma unroll
    for (int q = 0; q < EB; ++q) { const float cf = __int_as_float(__builtin_amdgcn_readlane(__float_as_int(cfv), q)); const f32x2 c2 = {cf, cf};
        B.v[q].each([&](int i, float x0, float x1) { const f32x2 x = {x0, x1}; acc[i >> 1] = __builtin_elementwise_fma(x, c2, acc[i >> 1]); }); __builtin_amdgcn_sched_barrier(0); }
}

__device__ __forceinline__ void sort_by_slice(LAS int* EL, LAS float* GL, int lane) {
    const int e0 = EL[lane], e1 = EL[64 + lane]; const float g0 = GL[lane], g1 = GL[64 + lane];
    const int s0 = e0 >> 11, s1 = e1 >> 11;
    int pos0 = 0, pos1 = 0, base = 0;
#pragma unroll
    for (int k = 0; k < 8; ++k) {
        const unsigned long long b0 = __ballot(s0 == k), b1 = __ballot(s1 == k);
        const int c0 = __popcll(b0), c1 = __popcll(b1);
        const int r0 = (int)__builtin_amdgcn_mbcnt_hi((unsigned)(b0 >> 32), __builtin_amdgcn_mbcnt_lo((unsigned)b0, 0u));
        const int r1 = (int)__builtin_amdgcn_mbcnt_hi((unsigned)(b1 >> 32), __builtin_amdgcn_mbcnt_lo((unsigned)b1, 0u));
        if (s0 == k) pos0 = base + r0;
        if (s1 == k) pos1 = base + c0 + r1;
        base += c0 + c1;
    }
    EL[pos0] = e0; GL[pos0] = g0; EL[pos1] = e1; GL[pos1] = g1;
    LDS_WAIT(); __builtin_amdgcn_wave_barrier();
}
__device__ __forceinline__ void peer_phase(Frame& F, int layer, int rows, unsigned* ctl, unsigned long long& pr_acc) {
    unsigned long long pt0 = 0ull;
#define SUB_BEGIN(ty) do { if (PROBE_PHASE == (ty)) pt0 = __builtin_amdgcn_s_memrealtime(); } while (0)
#define SUB_END(ty) do { if (PROBE_PHASE == (ty)) pr_acc += __builtin_amdgcn_s_memrealtime() - pt0; } while (0)
    if (F.tid < 64) { int a = 0, b = 0; stair_ab(F.tid < 52 ? F.tid : 0, a, b); *(LAS unsigned short*)(F.lds + PE_TAB + 2 * F.tid) = (unsigned short)((4 * a) | ((4 * b) << 8)); }
    {
        const int ch = F.tid, ll = ch >> 3, q = ch & 7;
        LAS unsigned char* dst = F.lds + PE_VEC + (q * 64 + ll) * 16;
        const int nl = layer < NLAYER - 1 ? layer + 1 : layer;
#pragma unroll 1
        for (int v = 0; v < 9; ++v) {
            const int g3 = v / 3, mrv = v - 3 * g3;
            const size_t off = ((size_t)(g3 == 0 ? layer : nl) * 3 + mrv) * 12288 + (g3 == 0 ? 5 * D : (g3 == 1 ? 0 : D));
            *(LAS f32x4*)(dst + v * 8192) = *(const f32x4*)(F.MODS() + off + 4 * ch);
        }
        *(LAS f32x4*)(dst + 9 * 8192) = *(const f32x4*)(F.ln2_g() + layer * D + 4 * ch);
        *(LAS f32x4*)(dst + 10 * 8192) = *(const f32x4*)(F.ln2_b() + layer * D + 4 * ch);
    }
    __syncthreads();
    LAS unsigned char* ws = F.lds + F.wave * PE_WS;
    LAS int* EL = (LAS int*)(ws + 3328); LAS float* GL = (LAS float*)(ws + 3840);
    const int lane = F.lane;
    const LAS unsigned char* vcache = F.lds + PE_VEC + lane * 16;
    const unsigned char* UTl = F.UT() + (size_t)layer * NEXP * UROW;
    const unsigned char* VTl = F.VT() + (size_t)layer * NEXP * VROW;
    const float* USl = F.US() + 2 * (size_t)layer * NEXP; const float* VSl = nullptr;
    unsigned* ticket = ctl + CW_TICKET + 64 * layer;
    unsigned tk = 0u;
    if (lane == 0) tk = __hip_atomic_fetch_add(ticket, 1u, __ATOMIC_RELAXED, __HIP_MEMORY_SCOPE_AGENT);
    int t = (int)__builtin_amdgcn_readfirstlane(tk);
    u32x4 scv[4];
    if (t < rows) sc_row_load(F, scv, t);
    while (t < rows) {
        unsigned tkn = 0u;
        if (lane == 0) tkn = __hip_atomic_fetch_add(ticket, 1u, __ATOMIC_RELAXED, __HIP_MEMORY_SCOPE_AGENT);
        u32x4 hdh, hdl;
        { const u32x4* hd = (const u32x4*)((const unsigned*)F.H() + (size_t)t * 512) + lane; hdh = hd[0]; hdl = hd[64]; }
        const float hinv = F.VS()[t];
        SUB_BEGIN(8); peer_topk(F, ws, scv); sort_by_slice(EL, GL, lane); SUB_END(8);
        SUB_BEGIN(9);
        unsigned hv[8]; f32x2 acc[16];
        hv[0] = hdh.x; hv[1] = hdh.y; hv[2] = hdh.z; hv[3] = hdh.w; hv[4] = hdl.x; hv[5] = hdl.y; hv[6] = hdl.z; hv[7] = hdl.w;
#pragma unroll
        for (int i = 0; i < 16; ++i) acc[i] = (f32x2){0.f, 0.f};
        {
            GBuf A, B, C;
            gather_issue(A, EL, 0, UTl, VTl, USl, lane);
            gather_issue(B, EL, EB, UTl, VTl, USl, lane);
            for (int i0 = 0; i0 < 30 * EB; i0 += 3 * EB) {
                gather_issue(C, EL, i0 + 2 * EB, UTl, VTl, USl, lane);
                gather_compute(A, EL, GL, i0, USl, VSl, hv, hinv, acc, lane);
                gather_issue(A, EL, i0 + 3 * EB, UTl, VTl, USl, lane);
                gather_compute(B, EL, GL, i0 + EB, USl, VSl, hv, hinv, acc, lane);
                gather_issue(B, EL, i0 + 4 * EB, UTl, VTl, USl, lane);
                gather_compute(C, EL, GL, i0 + 2 * EB, USl, VSl, hv, hinv, acc, lane);
            }
            gather_compute(A, EL, GL, 30 * EB, USl, VSl, hv, hinv, acc, lane);
            gather_compute(B, EL, GL, 31 * EB, USl, VSl, hv, hinv, acc, lane);
        }
        SUB_END(9); SUB_BEGIN(10);
        const int tnx = (int)__builtin_amdgcn_readfirstlane(tkn);
        if (tnx < rows) sc_row_load(F, scv, tnx);
        const int mr = modrow(t);
        const float* mp = F.MODS() + ((size_t)layer * 3 + mr) * 12288;
        bf16_t* xr = F.X() + (size_t)t * D;
        float rr[32]; float s = 0.f;
#pragma unroll
        for (int q2 = 0; q2 < 4; ++q2) { const u32x4 xw = *(const u32x4*)(xr + 32 * lane + 8 * q2);
#pragma unroll
            for (int h2 = 0; h2 < 2; ++h2) { const int q = 2 * q2 + h2; const f32x4 gv = *(const LAS f32x4*)(vcache + mr * 8192 + q * 1024);
                const f32x4 xv = {bf_lo(xw[2 * h2]), bf_hi(xw[2 * h2]), bf_lo(xw[2 * h2 + 1]), bf_hi(xw[2 * h2 + 1])};
                const f32x4 av = {acc[2 * q].x, acc[2 * q].y, acc[2 * q + 1].x, acc[2 * q + 1].y};
#pragma unroll
                for (int e = 0; e < 4; ++e) { const float v = DN_ALPHA * xv[e] + gv[e] * av[e]; rr[4 * q + e] = v; s += v; } } }
        const float mean = wave_sum_u(s) * (1.f / D);
        float s2 = 0.f;
#pragma unroll
        for (int i = 0; i < 32; ++i) { rr[i] -= mean; s2 += rr[i] * rr[i]; }
        const float rstd = 1.f / sqrtf(wave_sum_u(s2) * (1.f / D) + LN_EPS);
        const float* g2 = F.ln2_g() + layer * D; const float* b2 = F.ln2_b() + layer * D;
        float s3 = 0.f;
#pragma unroll
        for (int q = 0; q < 8; ++q) { const int c = 32 * lane + 4 * q; const f32x4 gg = *(const LAS f32x4*)(vcache + 9 * 8192 + q * 1024), bb = *(const LAS f32x4*)(vcache + 10 * 8192 + q * 1024);
            f32x4 xo;
#pragma unroll
            for (int e = 0; e < 4; ++e) { xo[e] = rr[4 * q + e] * rstd * gg[e] + bb[e]; rr[4 * q + e] = xo[e]; s3 += xo[e]; }
            if (layer == NLAYER - 1 && t < TL) *(f32x4*)(F.out() + (size_t)t * D + c) = xo; }
        if (layer < NLAYER - 1) {
#pragma unroll
            for (int q2 = 0; q2 < 4; ++q2) { u32x4 o4; o4.x = pk2(rr[8 * q2], rr[8 * q2 + 1]); o4.y = pk2(rr[8 * q2 + 2], rr[8 * q2 + 3]); o4.z = pk2(rr[8 * q2 + 4], rr[8 * q2 + 5]); o4.w = pk2(rr[8 * q2 + 6], rr[8 * q2 + 7]);
                *(u32x4*)(xr + 32 * lane + 8 * q2) = o4; }
            const float mean2 = wave_sum_u(s3) * (1.f / D);
            float s4 = 0.f;
#pragma unroll
            for (int i = 0; i < 32; ++i) { rr[i] -= mean2; s4 += rr[i] * rr[i]; }
            const float rstd2 = 1.f / sqrtf(wave_sum_u(s4) * (1.f / D) + LN_EPS);
            const float* np = F.MODS() + ((size_t)(layer + 1) * 3 + mr) * 12288;
#pragma unroll
            for (int q4 = 0; q4 < 2; ++q4) { u32x4 w;
#pragma unroll
                for (int q = 0; q < 4; ++q) { const int qq = 4 * q4 + q; const f32x4 sh = *(const LAS f32x4*)(vcache + (3 + mr) * 8192 + qq * 1024), sc = *(const LAS f32x4*)(vcache + (6 + mr) * 8192 + qq * 1024); const int ri = 4 * qq;
                    const float y0 = rr[ri] * rstd2 * (1.f + sc[0]) + sh[0], y1 = rr[ri + 1] * rstd2 * (1.f + sc[1]) + sh[1];
                    const float y2 = rr[ri + 2] * rstd2 * (1.f + sc[2]) + sh[2], y3 = rr[ri + 3] * rstd2 * (1.f + sc[3]) + sh[3];
                    int o = __builtin_amdgcn_cvt_pk_fp8_f32(y0, y1, 0, false); o = __builtin_amdgcn_cvt_pk_fp8_f32(y2, y3, o, true); w[q] = (unsigned)o; }
                *(u32x4*)(F.H8() + (size_t)t * D + 32 * lane + 16 * q4) = w; }
        }
        SUB_END(10);
        t = tnx;
    }
#undef SUB_BEGIN
#undef SUB_END
}

__global__ void __launch_bounds__(NWAVES * 64, 2) skel_fwd(Args args) {
    extern __shared__ __attribute__((aligned(16))) unsigned char lds[];
    Frame F;
    F.lds = (LAS unsigned char*)lds;
    F.tid = threadIdx.x; F.lane = F.tid & 63; F.wave = __builtin_amdgcn_readfirstlane(F.tid >> 6);
    F.G = gridDim.x; F.gw = blockIdx.x * NWAVES + F.wave; F.NGW = F.G * NWAVES;
    unsigned char* ws = args.ws;
    F.ka = (const CAS unsigned char*)__builtin_amdgcn_kernarg_segment_ptr();
    for (int u = F.tid; u < (LDS_BYTES - LDSCTL_OFF) / 4; u += NWAVES * 64) ((LAS unsigned*)(F.lds + LDSCTL_OFF))[u] = 0u;
    __syncthreads();
    unsigned* ctl = (unsigned*)(ws + WS_CTL);
    const int lo = args.ph_lo, hi = args.ph_hi;
    XcdBarrier bar; bar.bar = ctl + CW_BAR + args.li * XCD_BAR_WORDS; bar.x = 0; bar.st = nullptr;
    if (hi - lo > 1) bar = xcd_barrier_post(ctl + CW_BAR + args.li * XCD_BAR_WORDS, (volatile LAS unsigned*)(F.lds + MISC_OFF) + 8);
#define IN(k) (lo <= (k) && (k) < hi)
    unsigned long long pr_acc = 0ull, pr_t0 = 0ull;
#define PR_BEGIN(ty) do { if (PROBE_PHASE == (ty)) pr_t0 = __builtin_amdgcn_s_memrealtime(); } while (0)
#define PR_END(ty) do { if (PROBE_PHASE == (ty)) pr_acc += __builtin_amdgcn_s_memrealtime() - pr_t0; } while (0)
#define BOTH(k) (IN(k) && IN((k) + 1))
#define SEAM(k) do { if (BOTH(k)) xcd_barrier(bar); } while (0)

    if (IN(0)) { PR_BEGIN(0); frame_ids(F); p0_pre(F); SEAM(0); PR_END(0); }
    if (IN(1)) {
        PR_BEGIN(1); frame_ids(F);
        { const int ng = F.G / 4;
          if ((int)blockIdx.x < ng) { pg8::Gemm g{F.KBD(), F.WQR(), 32 * 256, 2048, 256}; pg8::BatchOrder S{ng, (int)blockIdx.x}; pg8::EpiFp8 E{(unsigned char*)F.WEFFT(), D, WEFF_SCALE};
              pg8::gemm_phase<pg8::EpiFp8, pg8::BatchOrder, false, true>(F.lds, g, S, E); }
          else p0_stream(F, (int)blockIdx.x - ng, F.G - ng); }
        if (hi - lo > 1) xcd_barrier(bar);
        frame_ids(F); p0b_mod0(F);
        SEAM(1); PR_END(1);
    }
    for (int layer = 0; layer < NLAYER; ++layer) {
        const int pb = 2 + 6 * layer;
        const bool lastl = layer == NLAYER - 1;
        const int rows = lastl ? TL : TT;
        if (IN(pb + 0)) {
            PR_BEGIN(2); frame_ids(F);
            pg8::Gemm g{(const bf16_t*)F.H8(), (const bf16_t*)(F.WINT() + (size_t)layer * INC * D), TT, INC, D / 2}; pg8::StaticOrder S; S.init(TT, INC, F.G, (int)blockIdx.x);
            pg8::EpiBf16 E{F.PROJ(), INC, 1.f / WIN_SCALE};
            pg8::gemm_phase<pg8::EpiBf16, pg8::StaticOrder, false, false, true, false, true>(F.lds, g, S, E);
            SEAM(pb + 0); PR_END(2);
        }
        if (IN(pb + 1)) {
            PR_BEGIN(3); frame_ids(F);
            const int nunits = lastl ? 512 : 528;
            {
                const int ch = F.tid & 255, vsel = F.tid >> 8;
                LAS unsigned char* dst = F.lds + CONV_LDS + ((2 * (ch >> 7) + (ch & 1)) * 64 + ((ch & 127) >> 1)) * 16;
                *(LAS f32x4*)(dst + vsel * 4096) = *(const f32x4*)(F.conv_w() + (size_t)layer * 3 * 1024 + vsel * 1024 + 4 * ch);
                *(LAS f32x4*)(dst + (2 + vsel) * 4096) = vsel == 0 ? *(const f32x4*)(F.conv_w() + (size_t)layer * 3 * 1024 + 2048 + 4 * ch) : *(const f32x4*)(F.g_conv() + layer * 1024 + 4 * ch);
            }
            for (int i = F.tid; i < 192 * 32 * 2 / 4; i += NWAVES * 64) *(LAS f32x4*)(F.lds + ROPE_LDS + (i >> 4) * ROPE_RS + (i & 15) * 16) = *(const f32x4*)(F.ROPE() + 4 * i);
            __syncthreads();
            { unsigned long long q0 = 0; if (PROBE_PHASE == 11) q0 = __builtin_amdgcn_s_memrealtime();
            { const int bx = (int)blockIdx.x, vcu = (F.G % 8 == 0) ? (bx % 8) * (F.G / 8) + bx / 8 : bx;
              attn_units(F, layer, vcu, F.G, nunits); }
            if (PROBE_PHASE == 11) pr_acc += __builtin_amdgcn_s_memrealtime() - q0; if (PROBE_PHASE == 12) q0 = __builtin_amdgcn_s_memrealtime();
            {
              const int nx = nunits - 2 * F.G; const bool uneven = nx > 0 && nx < F.G;
              const int bx2 = (int)blockIdx.x, vc2 = (F.G % 8 == 0) ? (bx2 % 8) * (F.G / 8) + bx2 / 8 : bx2;
              const int c0 = uneven ? vc2 - nx : vc2, nb = uneven ? F.G - nx : F.G;
              if (c0 >= 0) { const int nwv = nb * NWAVES, chn = (rows + nwv - 1) / nwv, wi = c0 * NWAVES + F.wave;
                  conv_rows(F, layer, wi * chn, (wi + 1) * chn < rows ? (wi + 1) * chn : rows); } }
            if (PROBE_PHASE == 12) pr_acc += __builtin_amdgcn_s_memrealtime() - q0; }
            SEAM(pb + 1); PR_END(3);
        }
        if (IN(pb + 2)) {
            PR_BEGIN(4); frame_ids(F);
            pg8::Gemm g{(const bf16_t*)F.MIX(), (const bf16_t*)(F.WOUTT() + (size_t)layer * D * D), rows, D, D / 2}; pg8::StaticOrder S; S.init(rows, D, F.G, (int)blockIdx.x);
            pg8::EpiFp8 E{(unsigned char*)F.PROJ(), D, 1.f / WOUT_SCALE};
            pg8::gemm_phase<pg8::EpiFp8, pg8::StaticOrder, false, false, true, false, true>(F.lds, g, S, E);
            frame_ids(F); convert_in_tail(F, layer, (rows / 256) * (D / 256), 0);
            SEAM(pb + 2); PR_END(4);
        }
        if (IN(pb + 3)) { PR_BEGIN(5); frame_ids(F); ln_phase(F, layer, rows); SEAM(pb + 3); PR_END(5); }
        if (IN(pb + 4)) {
            PR_BEGIN(6); frame_ids(F);
            pg8::Gemm g{(const bf16_t*)F.H8(), (const bf16_t*)((const unsigned char*)F.WEFFT() + (size_t)layer * D * D), rows, D, D / 2}; pg8::StaticOrder S; S.init(rows, D, F.G, (int)blockIdx.x);
            pg8::EpiBf16 E{F.SC(), D, 1.f / WEFF_SCALE};
            pg8::gemm_phase<pg8::EpiBf16, pg8::StaticOrder, false, false, true, false, true>(F.lds, g, S, E);
            frame_ids(F); convert_in_tail(F, layer, (rows / 256) * (D / 256), 1);
            SEAM(pb + 4); PR_END(6);
        }
        if (IN(pb + 5)) { PR_BEGIN(7); frame_ids(F); peer_phase(F, layer, rows, ctl, pr_acc); SEAM(pb + 5); PR_END(7); }
    }
    if (PROBE_PHASE >= 0 && hi - lo > 1) xcd_barrier(bar);
    if (PROBE_PHASE >= 0 && blockIdx.x == 0 && threadIdx.x == 0) { const unsigned long long t1 = __builtin_amdgcn_s_memrealtime() + (unsigned long long)PROBE_MULT * pr_acc; while (__builtin_amdgcn_s_memrealtime() < t1) __builtin_amdgcn_s_sleep(8); }
#undef IN
#undef BOTH
#undef SEAM
}

extern "C" void kernel_launch(void* const* d_in, const int* in_sizes, int n_in, void* d_out, int out_size, void* d_ws, size_t ws_size, hipStream_t stream) {
    static int grid = 0;
    if (grid == 0) {
        if (n_in != 20 || in_sizes[0] != TL * D || out_size != TL * D || ws_size < WS_END) {
            fprintf(stderr, "kernel_launch: unexpected problem shape (n_in %d, in0 %d, out %d, ws %zu, need %zu)\n", n_in, n_in > 0 ? in_sizes[0] : -1, out_size, ws_size, (size_t)WS_END); grid = -1; return; }
        int dev = 0, cus = 0, per_cu = 0;
        if (hipGetDevice(&dev) != hipSuccess || hipDeviceGetAttribute(&cus, hipDeviceAttributeMultiprocessorCount, dev) != hipSuccess) { grid = -1; return; }
        if (hipFuncSetAttribute((const void*)skel_fwd, hipFuncAttributeMaxDynamicSharedMemorySize, LDS_BYTES) != hipSuccess) { fprintf(stderr, "kernel_launch: hipFuncSetAttribute failed\n"); grid = -1; return; }
        if (hipOccupancyMaxActiveBlocksPerMultiprocessor(&per_cu, (const void*)skel_fwd, NWAVES * 64, LDS_BYTES) != hipSuccess || per_cu < 1)
            fprintf(stderr, "kernel_launch: occupancy query reports %d workgroups per CU\n", per_cu);
        (void)hipGetLastError();
        grid = cus;
    }
    if (grid < 0) return;
    if (hipMemsetAsync((char*)d_ws + WS_CTL, 0, CTL_ZERO_BYTES, stream) != hipSuccess) return;
    Args a{};
    for (int i = 0; i < 20; ++i) a.in[i] = (const float*)d_in[i];
    a.out = (float*)d_out; a.ws = (unsigned char*)d_ws; a.pad = 0;
#if MK_N_LAUNCHES == 1
    a.ph_lo = 0; a.ph_hi = NPHASE; a.li = 0;
    hipLaunchKernelGGL(skel_fwd, dim3(grid), dim3(NWAVES * 64), LDS_BYTES, stream, a);
#else
    for (int ph = 0; ph < NPHASE; ++ph) { a.ph_lo = ph; a.ph_hi = ph + 1; a.li = 0;
        hipLaunchKernelGGL(skel_fwd, dim3(grid), dim3(NWAVES * 64), LDS_BYTES, stream, a); }
#endif
}
```
